# Optimizing an MI355X kernel written in HIP

```python
import math
import jax, jax.numpy as jnp
from jax import lax
import numpy as np

D_MODEL = 1024
BATCH = 32
SEQ = 256
DEPTH = 4
DEC_BATCH = 8
DEC_SEQ = 2048
PAST_LEN = 256

GRID_W = 64
N_EVEN = (DEPTH + 1) // 2
N_ODD = DEPTH // 2
N_DIR = 2
N_MOD = 6
D_FF = 4 * D_MODEL
EPS = 1e-6
POS_BASE = 10000.0
D_A = D_MODEL // 2
S5_GROUP = 16
G_A = D_A // S5_GROUP
P_A = 64
D_B = D_MODEL // 2
H_B = 4
DK_B = D_B // H_B
DV_B = D_B // H_B
CHUNK = 64
CONV_K = 4
CONV_LEFT = (CONV_K - 1) // 2
D_RNN = D_MODEL
LRU_BLOCKS = 4
LRU_BS = D_RNN // LRU_BLOCKS
LRU_C = 8.0
IN_EVEN = 2 * D_A + 4 * D_B + 2 * N_DIR * H_B
IN_ODD = 2 * D_RNN

kernel_name = 'hybrid_s5_gdn_rglru_diffusion_step'


def rms_norm(x, g):
    xf = x.astype(jnp.float32)
    y = xf * lax.rsqrt(jnp.mean(xf * xf, axis=-1, keepdims=True) + EPS)
    return y * g.astype(jnp.float32)


def modulate(h, shift, scale):
    return h * (1.0 + scale) + shift


def split_cols(x, sizes):
    out, start = [], 0
    for s in sizes:
        out.append(x[..., start:start + s])
        start += s
    return out


def l2norm(x):
    return x * lax.rsqrt(jnp.sum(x * x, axis=-1, keepdims=True) + EPS)


def grid_sincos(n_tokens):
    f32 = jnp.float32
    rows = n_tokens // GRID_W
    row = jnp.repeat(jnp.arange(rows, dtype=f32), GRID_W)
    col = jnp.tile(jnp.arange(GRID_W, dtype=f32), rows)
    n_freq = D_MODEL // 4
    omega = POS_BASE ** (-jnp.arange(n_freq, dtype=f32) / n_freq)
    ar = row[:, None] * omega
    ac = col[:, None] * omega
    return jnp.concatenate([jnp.sin(ar), jnp.cos(ar), jnp.sin(ac), jnp.cos(ac)], axis=-1)


def dwconv_centred(x, w, b):
    L = x.shape[1]
    xp = jnp.pad(x, ((0, 0), (CONV_LEFT, CONV_K - 1 - CONV_LEFT), (0, 0)))
    out = b.astype(jnp.float32)
    for j in range(CONV_K):
        out = out + xp[:, j:j + L] * w[j].astype(jnp.float32)
    return out


def _real_combine(l, r):
    a_l, b_l = l
    a_r, b_r = r
    return a_l * a_r, a_r * b_l + b_r


def linear_scan(a, b, h0, reverse):
    a_cum, h = lax.associative_scan(_real_combine, (a, b), axis=1, reverse=reverse)
    h = h + a_cum * h0[:, None]
    final = h[:, 0] if reverse else h[:, -1]
    return h, final


def _complex_combine(l, r):
    ar_l, ai_l, br_l, bi_l = l
    ar_r, ai_r, br_r, bi_r = r
    return (ar_l * ar_r - ai_l * ai_r,
            ar_l * ai_r + ai_l * ar_r,
            ar_r * br_l - ai_r * bi_l + br_r,
            ar_r * bi_l + ai_r * br_l + bi_r)


def complex_scan(a_re, a_im, b_re, b_im, h0_re, h0_im, reverse):
    A_re, A_im, h_re, h_im = lax.associative_scan(
        _complex_combine, (a_re, a_im, b_re, b_im), axis=1, reverse=reverse)
    h0r = h0_re[:, None]
    h0i = h0_im[:, None]
    h_re = h_re + A_re * h0r - A_im * h0i
    h_im = h_im + A_re * h0i + A_im * h0r
    if reverse:
        return h_re, h_im, h_re[:, 0], h_im[:, 0]
    return h_re, h_im, h_re[:, -1], h_im[:, -1]


def s5_mixer(u, z, lam_re, lam_im, log_dt, b_re, b_im, c_re, c_im, d_skip, h0_re, h0_im):
    f32 = jnp.float32
    bsz, L, _ = u.shape
    uf = u.astype(f32)
    ug = uf.reshape(bsz, L, G_A, S5_GROUP)
    bu_re = jnp.einsum('blgc,gpc->blgp', ug, b_re.astype(f32))
    bu_im = jnp.einsum('blgc,gpc->blgp', ug, b_im.astype(f32))
    y = uf * d_skip.astype(f32)
    finals_re, finals_im = [], []
    for d in range(N_DIR):
        lr = lam_re[d].astype(f32)
        li = lam_im[d].astype(f32)
        dt = jnp.exp(log_dt[d].astype(f32))[:, None]
        mag = jnp.exp(lr * dt)
        ar = mag * jnp.cos(li * dt)
        ai = mag * jnp.sin(li * dt)
        den = lr * lr + li * li
        fr = ((ar - 1.0) * lr + ai * li) / den
        fi = (ai * lr - (ar - 1.0) * li) / den
        br = fr * bu_re - fi * bu_im
        bi = fr * bu_im + fi * bu_re
        shape = br.shape
        h_re, h_im, f_re, f_im = complex_scan(
            jnp.broadcast_to(ar, shape), jnp.broadcast_to(ai, shape), br, bi,
            h0_re[:, d].astype(f32), h0_im[:, d].astype(f32), reverse=(d == 1))
        y = y + (jnp.einsum('blgp,gcp->blgc', h_re, c_re.astype(f32))
                 - jnp.einsum('blgp,gcp->blgc', h_im, c_im.astype(f32))).reshape(bsz, L, D_A)
        finals_re.append(f_re)
        finals_im.append(f_im)
    out = jax.nn.gelu(y) * jax.nn.sigmoid(z.astype(f32))
    return out, jnp.stack(finals_re, axis=1), jnp.stack(finals_im, axis=1)


def gated_delta_chunked(q, k, v, beta, g, S0):
    bsz, L, H, _ = q.shape
    dv = v.shape[-1]
    n = L // CHUNK

    def to_chunks(t):
        return t.reshape(bsz, n, CHUNK, H, -1).transpose(1, 0, 3, 2, 4)

    qc, kc, vc = to_chunks(q), to_chunks(k), to_chunks(v)
    bc = beta.reshape(bsz, n, CHUNK, H).transpose(1, 0, 3, 2)
    gc = jnp.cumsum(g.reshape(bsz, n, CHUNK, H).transpose(1, 0, 3, 2), axis=-1)
    idx = jnp.arange(CHUNK)
    incl = idx[:, None] >= idx[None, :]
    strict = idx[:, None] > idx[None, :]
    decay = jnp.exp(jnp.where(incl, gc[..., :, None] - gc[..., None, :], -jnp.inf))
    kb = kc * bc[..., None]
    vb = vc * bc[..., None]
    lmat = jnp.where(strict, jnp.einsum('nbhcd,nbhed->nbhce', kb, kc) * decay, 0.0)
    a_mat = lmat + jnp.eye(CHUNK, dtype=lmat.dtype)
    rhs = jnp.concatenate([vb, kb * jnp.exp(gc)[..., None]], axis=-1)
    sol = lax.linalg.triangular_solve(a_mat, rhs, left_side=True, lower=True, unit_diagonal=True)
    u_c, w_c = sol[..., :dv], sol[..., dv:]
    qk = jnp.where(incl, jnp.einsum('nbhcd,nbhed->nbhce', qc, kc) * decay, 0.0)

    def step(S, xs):
        q_i, k_i, u_i, w_i, g_i, qk_i = xs
        v_new = u_i - jnp.einsum('bhck,bhkv->bhcv', w_i, S)
        o_i = (jnp.einsum('bhck,bhkv->bhcv', q_i * jnp.exp(g_i)[..., None], S)
               + jnp.einsum('bhce,bhev->bhcv', qk_i, v_new))
        g_last = g_i[..., -1:]
        S = (S * jnp.exp(g_last)[..., None]
             + jnp.einsum('bhck,bhcv->bhkv', k_i * jnp.exp(g_last - g_i)[..., None], v_new))
        return S, o_i

    S_fin, o = lax.scan(step, S0, (qc, kc, u_c, w_c, gc, qk))
    o = o.transpose(1, 0, 3, 2, 4).reshape(bsz, L, H, dv)
    return o, S_fin


def gdn_mixer(q, k, v, z, a_raw, b_raw, conv_w, conv_b, a_log, dt_bias, o_norm, S0):
    f32 = jnp.float32
    bsz, L, _ = q.shape
    qkv = jax.nn.silu(dwconv_centred(jnp.concatenate([q, k, v], axis=-1).astype(f32), conv_w, conv_b))
    qh, kh, vh = split_cols(qkv, (D_B, D_B, D_B))
    qh = l2norm(qh.reshape(bsz, L, H_B, DK_B)) * (DK_B ** -0.5)
    kh = l2norm(kh.reshape(bsz, L, H_B, DK_B))
    vh = vh.reshape(bsz, L, H_B, DV_B)
    a_raw = a_raw.astype(f32).reshape(bsz, L, N_DIR, H_B)
    b_raw = b_raw.astype(f32).reshape(bsz, L, N_DIR, H_B)
    o = 0.0
    finals = []
    for d in range(N_DIR):
        beta = jax.nn.sigmoid(b_raw[:, :, d])
        g = -jnp.exp(a_log[d].astype(f32)) * jax.nn.softplus(a_raw[:, :, d] + dt_bias[d].astype(f32))
        s0 = S0[:, d].astype(f32)
        if d == 0:
            o_d, s_d = gated_delta_chunked(qh, kh, vh, beta, g, s0)
        else:
            rev = lambda t: jnp.flip(t, axis=1)
            o_d, s_d = gated_delta_chunked(rev(qh), rev(kh), rev(vh), rev(beta), rev(g), s0)
            o_d = rev(o_d)
        o = o + o_d
        finals.append(s_d)
    o = rms_norm(o, o_norm) * jax.nn.silu(z.astype(f32).reshape(bsz, L, H_B, DV_B))
    return o.reshape(bsz, L, D_B), jnp.stack(finals, axis=1)


def rglru_mixer(xb, yb, conv_w, conv_b, w_r, b_r, w_i, b_i, lam, h0):
    f32 = jnp.float32
    bsz, L, _ = xb.shape
    x = dwconv_centred(xb.astype(f32), conv_w, conv_b)
    xblk = x.reshape(bsz, L, LRU_BLOCKS, LRU_BS)
    h_sum = 0.0
    finals = []
    for d in range(N_DIR):
        r = jax.nn.sigmoid(jnp.einsum('blni,nij->blnj', xblk, w_r[d].astype(f32)).reshape(bsz, L, D_RNN)
                           + b_r[d].astype(f32))
        i = jax.nn.sigmoid(jnp.einsum('blni,nij->blnj', xblk, w_i[d].astype(f32)).reshape(bsz, L, D_RNN)
                           + b_i[d].astype(f32))
        log_a = -LRU_C * r * jax.nn.softplus(-lam[d].astype(f32))
        a = jnp.exp(log_a)
        b = jnp.sqrt(-jnp.expm1(2.0 * log_a)) * (i * x)
        h, h_fin = linear_scan(a, b, h0[:, d].astype(f32), reverse=(d == 1))
        h_sum = h_sum + h
        finals.append(h_fin)
    return h_sum * jax.nn.gelu(yb.astype(f32)), jnp.stack(finals, axis=1)


def trunk(x, mod, s5_re0, s5_im0, delta0, lru0, p):
    dtype = x.dtype
    fin_re, fin_im, fin_delta, fin_lru = [], [], [], []
    for l in range(DEPTH):
        sh_m, sc_m, gt_m, sh_f, sc_f, gt_f = jnp.split(mod[l][:, None, :], N_MOD, axis=-1)
        h = modulate(rms_norm(x, p['norm_mix_pre'][l]), sh_m, sc_m)
        if l % 2 == 0:
            e = l // 2
            u_a, z_a, q, k, v, z_b, a_raw, b_raw = split_cols(
                h @ p['w_in_even'][e], (D_A, D_A, D_B, D_B, D_B, D_B, N_DIR * H_B, N_DIR * H_B))
            y_a, f_re, f_im = s5_mixer(u_a, z_a, p['s5_lam_re'][e], p['s5_lam_im'][e], p['s5_log_dt'][e],
                                       p['s5_b_re'][e], p['s5_b_im'][e], p['s5_c_re'][e], p['s5_c_im'][e],
                                       p['s5_d'][e], s5_re0[:, e], s5_im0[:, e])
            y_b, f_d = gdn_mixer(q, k, v, z_b, a_raw, b_raw, p['gdn_conv_w'][e], p['gdn_conv_b'][e],
                                 p['gdn_a_log'][e], p['gdn_dt_bias'][e], p['gdn_o_norm'][e], delta0[:, e])
            out = jnp.concatenate([y_a, y_b], axis=-1) @ p['w_out_even'][e]
            fin_re.append(f_re)
            fin_im.append(f_im)
            fin_delta.append(f_d)
        else:
            o = l // 2
            x_b, y_g = split_cols(h @ p['w_in_odd'][o], (D_RNN, D_RNN))
            y_c, f_l = rglru_mixer(x_b, y_g, p['lru_conv_w'][o], p['lru_conv_b'][o], p['lru_w_r'][o],
                                   p['lru_b_r'][o], p['lru_w_i'][o], p['lru_b_i'][o], p['lru_lam'][o],
                                   lru0[:, o])
            out = y_c @ p['w_out_odd'][o]
            fin_lru.append(f_l)
        x = (x + gt_m * rms_norm(out, p['norm_mix_post'][l])).astype(dtype)
        h = modulate(rms_norm(x, p['norm_mlp_pre'][l]), sh_f, sc_f)
        f = jnp.square(jax.nn.relu(h @ p['w_mlp_in'][l])) @ p['w_mlp_out'][l]
        x = (x + gt_f * rms_norm(f, p['norm_mlp_post'][l])).astype(dtype)
    return (x, jnp.stack(fin_re, axis=1), jnp.stack(fin_im, axis=1),
            jnp.stack(fin_delta, axis=1), jnp.stack(fin_lru, axis=1))


def setup_inputs(seed: int = 0) -> dict:
    key = jax.random.key(seed)
    ks = iter(jax.random.split(key, 64))
    f32 = jnp.float32

    def normal(shape, scale):
        return jax.random.normal(next(ks), shape, f32) * scale

    def gain(shape):
        return 1.0 + normal(shape, 0.02)

    def inv_softplus_dt(shape):
        dt = jnp.exp(jax.random.uniform(next(ks), shape, f32, math.log(1e-3), math.log(1e-1)))
        return dt + jnp.log(-jnp.expm1(-dt))

    x_prompt = normal((BATCH, SEQ, D_MODEL), 1.0)
    x_sample = normal((DEC_BATCH, DEC_SEQ, D_MODEL), 1.0)
    state_s5_re = normal((DEC_BATCH, N_EVEN, N_DIR, G_A, P_A), 0.1)
    state_s5_im = normal((DEC_BATCH, N_EVEN, N_DIR, G_A, P_A), 0.1)
    state_delta = normal((DEC_BATCH, N_EVEN, N_DIR, H_B, DK_B, DV_B), 0.05)
    state_lru = normal((DEC_BATCH, N_ODD, N_DIR, D_RNN), 0.5)
    c = normal((DEC_BATCH, D_MODEL), 1.0)
    c_ctx = normal((D_MODEL,), 1.0)
    w_ada = normal((DEPTH, D_MODEL, N_MOD * D_MODEL), 0.5 * D_MODEL ** -0.5)
    b_ada = normal((DEPTH, N_MOD * D_MODEL), 0.02)
    norm_mix_pre = gain((DEPTH, D_MODEL))
    norm_mix_post = gain((DEPTH, D_MODEL))
    norm_mlp_pre = gain((DEPTH, D_MODEL))
    norm_mlp_post = gain((DEPTH, D_MODEL))
    w_mlp_in = normal((DEPTH, D_MODEL, D_FF), D_MODEL ** -0.5)
    w_mlp_out = normal((DEPTH, D_FF, D_MODEL), D_FF ** -0.5)
    w_in_even = normal((N_EVEN, D_MODEL, IN_EVEN), D_MODEL ** -0.5)
    w_out_even = normal((N_EVEN, D_A + D_B, D_MODEL), (D_A + D_B) ** -0.5)
    s5_lam_re = -0.5 + normal((N_EVEN, N_DIR, G_A, P_A), 0.01)
    s5_lam_im = jnp.pi * jnp.arange(P_A, dtype=f32) + normal((N_EVEN, N_DIR, G_A, P_A), 0.01)
    s5_log_dt = jax.random.uniform(next(ks), (N_EVEN, N_DIR, G_A), f32, math.log(1e-3), math.log(1e-1))
    s5_b_re = normal((N_EVEN, G_A, P_A, S5_GROUP), (2.0 * S5_GROUP) ** -0.5)
    s5_b_im = normal((N_EVEN, G_A, P_A, S5_GROUP), (2.0 * S5_GROUP) ** -0.5)
    s5_c_re = normal((N_EVEN, G_A, S5_GROUP, P_A), (2.0 * P_A) ** -0.5)
    s5_c_im = normal((N_EVEN, G_A, S5_GROUP, P_A), (2.0 * P_A) ** -0.5)
    s5_d = normal((N_EVEN, D_A), 1.0)
    gdn_conv_w = normal((N_EVEN, CONV_K, 3 * D_B), CONV_K ** -0.5)
    gdn_conv_b = normal((N_EVEN, 3 * D_B), 0.02)
    gdn_a_log = jnp.log(jax.random.uniform(next(ks), (N_EVEN, N_DIR, H_B), f32, 1.0, 16.0))
    gdn_dt_bias = inv_softplus_dt((N_EVEN, N_DIR, H_B))
    gdn_o_norm = gain((N_EVEN, DV_B))
    w_in_odd = normal((N_ODD, D_MODEL, IN_ODD), D_MODEL ** -0.5)
    w_out_odd = normal((N_ODD, D_RNN, D_MODEL), D_RNN ** -0.5)
    lru_conv_w = normal((N_ODD, CONV_K, D_RNN), CONV_K ** -0.5)
    lru_conv_b = normal((N_ODD, D_RNN), 0.02)
    lru_w_r = normal((N_ODD, N_DIR, LRU_BLOCKS, LRU_BS, LRU_BS), LRU_BS ** -0.5)
    lru_b_r = normal((N_ODD, N_DIR, D_RNN), 0.02)
    lru_w_i = normal((N_ODD, N_DIR, LRU_BLOCKS, LRU_BS, LRU_BS), LRU_BS ** -0.5)
    lru_b_i = normal((N_ODD, N_DIR, D_RNN), 0.02)
    a0 = jax.random.uniform(next(ks), (N_ODD, N_DIR, D_RNN), f32, 0.9, 0.999)
    s = a0 ** (1.0 / LRU_C)
    lru_lam = jnp.log(s) - jnp.log1p(-s)
    return {
        'x_prompt': x_prompt, 'x_sample': x_sample,
        'state_s5_re': state_s5_re, 'state_s5_im': state_s5_im,
        'state_delta': state_delta, 'state_lru': state_lru,
        'c': c, 'c_ctx': c_ctx,
        'w_ada': w_ada, 'b_ada': b_ada,
        'norm_mix_pre': norm_mix_pre, 'norm_mix_post': norm_mix_post,
        'norm_mlp_pre': norm_mlp_pre, 'norm_mlp_post': norm_mlp_post,
        'w_mlp_in': w_mlp_in, 'w_mlp_out': w_mlp_out,
        'w_in_even': w_in_even, 'w_out_even': w_out_even,
        's5_lam_re': s5_lam_re, 's5_lam_im': s5_lam_im, 's5_log_dt': s5_log_dt,
        's5_b_re': s5_b_re, 's5_b_im': s5_b_im, 's5_c_re': s5_c_re, 's5_c_im': s5_c_im, 's5_d': s5_d,
        'gdn_conv_w': gdn_conv_w, 'gdn_conv_b': gdn_conv_b, 'gdn_a_log': gdn_a_log,
        'gdn_dt_bias': gdn_dt_bias, 'gdn_o_norm': gdn_o_norm,
        'w_in_odd': w_in_odd, 'w_out_odd': w_out_odd,
        'lru_conv_w': lru_conv_w, 'lru_conv_b': lru_conv_b,
        'lru_w_r': lru_w_r, 'lru_b_r': lru_b_r, 'lru_w_i': lru_w_i, 'lru_b_i': lru_b_i,
        'lru_lam': lru_lam,
    }


def reference(x_prompt, x_sample, state_s5_re, state_s5_im, state_delta, state_lru, c, c_ctx,
              w_ada, b_ada, norm_mix_pre, norm_mix_post, norm_mlp_pre, norm_mlp_post,
              w_mlp_in, w_mlp_out, w_in_even, w_out_even,
              s5_lam_re, s5_lam_im, s5_log_dt, s5_b_re, s5_b_im, s5_c_re, s5_c_im, s5_d,
              gdn_conv_w, gdn_conv_b, gdn_a_log, gdn_dt_bias, gdn_o_norm,
              w_in_odd, w_out_odd, lru_conv_w, lru_conv_b, lru_w_r, lru_b_r, lru_w_i, lru_b_i,
              lru_lam):
    f32 = jnp.float32
    p = dict(norm_mix_pre=norm_mix_pre, norm_mix_post=norm_mix_post,
             norm_mlp_pre=norm_mlp_pre, norm_mlp_post=norm_mlp_post,
             w_mlp_in=w_mlp_in, w_mlp_out=w_mlp_out, w_in_even=w_in_even, w_out_even=w_out_even,
             s5_lam_re=s5_lam_re, s5_lam_im=s5_lam_im, s5_log_dt=s5_log_dt,
             s5_b_re=s5_b_re, s5_b_im=s5_b_im, s5_c_re=s5_c_re, s5_c_im=s5_c_im, s5_d=s5_d,
             gdn_conv_w=gdn_conv_w, gdn_conv_b=gdn_conv_b, gdn_a_log=gdn_a_log,
             gdn_dt_bias=gdn_dt_bias, gdn_o_norm=gdn_o_norm,
             w_in_odd=w_in_odd, w_out_odd=w_out_odd, lru_conv_w=lru_conv_w, lru_conv_b=lru_conv_b,
             lru_w_r=lru_w_r, lru_b_r=lru_b_r, lru_w_i=lru_w_i, lru_b_i=lru_b_i, lru_lam=lru_lam)
    mod_ctx = (jnp.einsum('d,lde->le', jax.nn.silu(c_ctx.astype(f32)), w_ada) + b_ada.astype(f32))[:, None, :]
    mod_lat = jnp.einsum('bd,lde->lbe', jax.nn.silu(c.astype(f32)), w_ada) + b_ada.astype(f32)[:, None, :]

    bp = x_prompt.shape[0]
    zero_re = jnp.zeros((bp, N_EVEN, N_DIR, G_A, P_A), f32)
    zero_delta = jnp.zeros((bp, N_EVEN, N_DIR, H_B, DK_B, DV_B), f32)
    zero_lru = jnp.zeros((bp, N_ODD, N_DIR, D_RNN), f32)
    y_prompt, new_s5_re, new_s5_im, new_delta, new_lru = trunk(
        x_prompt, mod_ctx, zero_re, zero_re, zero_delta, zero_lru, p)

    x_lat = (x_sample.astype(f32) + grid_sincos(x_sample.shape[1])[None]).astype(x_sample.dtype)
    y_sample = trunk(x_lat, mod_lat, state_s5_re, state_s5_im, state_delta, state_lru, p)[0]
    return (y_prompt, y_sample, new_s5_re, new_s5_im, new_delta, new_lru)
```

```cpp
#include <hip/hip_runtime.h>
#include <hip/hip_cooperative_groups.h>
#include <cstdio>
#include <cstdint>
namespace cg = cooperative_groups;
__device__ __forceinline__ int bid_fresh() { int t = blockIdx.x; asm volatile("" : "+s"(t)); return t; }
__device__ __forceinline__ int grid_fresh() { int t = gridDim.x; asm volatile("" : "+s"(t)); return t; }
__device__ __forceinline__ int tid_fresh(int w) { asm volatile("" : "+s"(w)); int l; asm volatile("v_mbcnt_lo_u32_b32 %0, -1, 0\n\tv_mbcnt_hi_u32_b32 %0, -1, %0" : "=v"(l)); return w * 64 + l; }

namespace pg8 {
#define PG8_LAS __attribute__((address_space(3)))
typedef unsigned short bf16_t;
typedef short bf16x8 __attribute__((ext_vector_type(8)));
typedef float f32x4 __attribute__((ext_vector_type(4)));
typedef unsigned u32x4 __attribute__((ext_vector_type(4)));
typedef unsigned u32x2 __attribute__((ext_vector_type(2)));
constexpr int BM = 256, BK = 64, HALF = 128, HTB = HALF * BK * 2, STAGE_BYTES = 8 * HTB, NXCD = 8, WGM = 8;

__host__ __device__ __forceinline__ int lds_byte(int r, int c) { const int st = (r >> 4) * 2 + (c >> 5), rr = r & 15, cc = c & 31, ob = rr * 64 + cc * 2; return st * 1024 + (ob ^ (((ob >> 9) & 1) << 5)); }
__host__ __device__ __forceinline__ void stage_rc(int b, int& R, int& C) { const int st = b / 1024, sb = b % 1024, swz = sb ^ (((sb >> 9) & 1) << 5); R = (st >> 1) * 16 + swz / 64; C = (st & 1) * 32 + (swz % 64) / 2; }
__host__ __device__ __forceinline__ int perm32(int rho) { const int n = rho >> 4, i = rho & 15; return 8 * (i >> 2) + 4 * n + (i & 3); }

struct Unit { int pm, pn; };
struct Gemm { const bf16_t* A; const bf16_t* Bt; int M, N, K, lda, ablk, ashift; };

struct StaticOrder {
    int nM, nN, nwg, G, c;
    __host__ __device__ void init(int M, int N, int G_, int c_) { nM = M / BM; nN = N / BM; nwg = nM * nN; G = G_; c = c_; }
    __host__ __device__ bool next(int i, Unit& u) const {
        const long L = (long)i * G + c; if (L >= nwg) return false;
        int wgid = (int)L; { const int q = nwg / NXCD, r = nwg % NXCD, xcd = wgid % NXCD, off = wgid / NXCD; wgid = (xcd < r ? xcd * (q + 1) : r * (q + 1) + (xcd - r) * q) + off; }
        const int nig = WGM * nN, gid = wgid / nig, fm = gid * WGM, gsz = (nM - fm) < WGM ? (nM - fm) : WGM;
        u.pm = fm + ((wgid % nig) % gsz); u.pn = (wgid % nig) / gsz; return true;
    }
};
__device__ __forceinline__ unsigned cvt_pk_bf16(float lo, float hi) { unsigned r; asm volatile("v_cvt_pk_bf16_f32 %0, %1, %2" : "=v"(r) : "v"(lo), "v"(hi)); return r; }

template <class Epi>
__device__ __forceinline__ void gemm_phase(int wid0, PG8_LAS unsigned char* lds, const Gemm g, const StaticOrder& S, const Epi& E) {
    const int tid = tid_fresh(wid0), wid = __builtin_amdgcn_readfirstlane(tid >> 6), lane = tid & 63, wr = wid >> 2, wc = wid & 3, fr = lane & 15, fq = lane >> 4;
    const int K = g.K, nt = K / BK, lda = g.lda;
    unsigned voffA[2], voffB[2];
#pragma unroll
    for (int i = 0; i < 2; ++i) { int R, C; stage_rc(tid * 16 + i * 8192, R, C); const int Rb = (R & ~31) + perm32(R & 31);
        voffA[i] = (unsigned)(R * lda + C) * 2u; voffB[i] = (unsigned)(Rb * K + C) * 2u; }
    const size_t kstep = (size_t)(BK * 2);
    const size_t hstepA = (size_t)HALF * lda * 2, hstepB = (size_t)HALF * K * 2;
    const size_t tstepA = 2 * hstepA, tstepB = 2 * hstepB;
    const unsigned ldsw = (unsigned)wid * 1024u;
    const int aoff = lds_byte(wr * 64 + fr, fq * 8), boff = lds_byte(wc * 32 + fr, fq * 8);
#define PG8_ACOL(pn) (g.ablk ? (size_t)((((pn) >> g.ashift) & 3) * 512) : (size_t)0)
#define PG8_SA(b, h) (((b) * 2 + (h)) * HTB)
#define PG8_SB(b, h) ((4 + (b) * 2 + (h)) * HTB)
#define PG8_STAGE(bufoff, gbase, voff) do { _Pragma("unroll") for (int _i = 0; _i < 2; ++_i) \
        __builtin_amdgcn_global_load_lds((const unsigned*)((const char*)(gbase) + (voff)[_i]), (PG8_LAS unsigned*)(lds + (bufoff) + ldsw + _i * 8192), 16, 0, 0); } while (0)
#define PG8_LDA(dst, b, h) do { _Pragma("unroll") for (int m = 0; m < 4; ++m) _Pragma("unroll") for (int k = 0; k < 2; ++k) dst[m][k] = *(const PG8_LAS bf16x8*)(lds + PG8_SA(b, h) + aoff + m * 2048 + k * 1024); } while (0)
#define PG8_LDB(dst, b, h) do { _Pragma("unroll") for (int n = 0; n < 2; ++n) _Pragma("unroll") for (int k = 0; k < 2; ++k) dst[n][k] = *(const PG8_LAS bf16x8*)(lds + PG8_SB(b, h) + boff + n * 2048 + k * 1024); } while (0)
#define PG8_MMA(ai, bj, At, Bt) do { __builtin_amdgcn_s_setprio(1); _Pragma("unroll") for (int m = 0; m < 4; ++m) _Pragma("unroll") for (int n = 0; n < 2; ++n) _Pragma("unroll") for (int k = 0; k < 2; ++k) \
        acc[ai][bj][m][n] = __builtin_amdgcn_mfma_f32_16x16x32_bf16(Bt[n][k], At[m][k], acc[ai][bj][m][n], 0, 0, 0); __builtin_amdgcn_s_setprio(0); } while (0)
#define PG8_WAIT_V(n) asm volatile("s_waitcnt vmcnt(" #n ")" ::: "memory")
#define PG8_WAIT_L(n) asm volatile("s_waitcnt lgkmcnt(" #n ")" ::: "memory")
#define PG8_BAR __builtin_amdgcn_s_barrier()
#define PG8_SCHED __builtin_amdgcn_sched_barrier(0)
    Unit cur, nxt; int ui = 0;
    if (!S.next(0, cur)) return;
    f32x4 acc[2][2][4][2];
#pragma unroll
    for (int a = 0; a < 2; ++a)
#pragma unroll
        for (int b = 0; b < 2; ++b)
#pragma unroll
            for (int m = 0; m < 4; ++m)
#pragma unroll
                for (int n = 0; n < 2; ++n) acc[a][b][m][n] = (f32x4){0.f, 0.f, 0.f, 0.f};
    bf16x8 At[4][2], B0[2][2], B1[2][2];
    const char* cA = (const char*)g.A + (size_t)cur.pm * tstepA + PG8_ACOL(cur.pn); const char* cB = (const char*)g.Bt + (size_t)cur.pn * tstepB;
    PG8_STAGE(PG8_SB(0, 0), cB, voffB); PG8_STAGE(PG8_SA(0, 0), cA, voffA); PG8_STAGE(PG8_SB(0, 1), cB + hstepB, voffB); PG8_STAGE(PG8_SA(0, 1), cA + hstepA, voffA);
    if (wr == 1) PG8_BAR;
    PG8_WAIT_V(4); PG8_BAR;
    PG8_STAGE(PG8_SB(1, 0), cB + kstep, voffB); PG8_STAGE(PG8_SA(1, 0), cA + kstep, voffA); PG8_STAGE(PG8_SB(1, 1), cB + hstepB + kstep, voffB);
    PG8_WAIT_V(6); PG8_BAR;
    for (;;) {
        const bool has_next = S.next(ui + 1, nxt);
        const char* nA = has_next ? (const char*)g.A + (size_t)nxt.pm * tstepA + PG8_ACOL(nxt.pn) : cA; const char* nB = has_next ? (const char*)g.Bt + (size_t)nxt.pn * tstepB : cB;
        for (int t = 0; t < nt; t += 2) {
            const bool last = (t == nt - 2);
            const char* a1 = cA + (size_t)(t + 1) * kstep;
            const char* a2 = last ? nA : cA + (size_t)(t + 2) * kstep; const char* b2 = last ? nB : cB + (size_t)(t + 2) * kstep;
            const char* a3 = a2 + kstep; const char* b3 = b2 + kstep;
            PG8_LDB(B0, 0, 0); PG8_SCHED; PG8_LDA(At, 0, 0); PG8_STAGE(PG8_SA(1, 1), a1 + hstepA, voffA);
            PG8_WAIT_L(8); PG8_BAR; PG8_WAIT_L(0); PG8_MMA(0, 0, At, B0); PG8_BAR; PG8_SCHED;
            PG8_LDB(B1, 0, 1); PG8_STAGE(PG8_SB(0, 0), b2, voffB);
            PG8_BAR; PG8_WAIT_L(0); PG8_MMA(0, 1, At, B1); PG8_BAR;
            PG8_LDA(At, 0, 1); PG8_STAGE(PG8_SA(0, 0), a2, voffA);
            PG8_BAR; PG8_WAIT_L(0); PG8_MMA(1, 0, At, B0); PG8_BAR; PG8_SCHED;
            PG8_STAGE(PG8_SB(0, 1), b2 + hstepB, voffB);
            PG8_WAIT_V(6); PG8_BAR; PG8_MMA(1, 1, At, B1); PG8_BAR;
            PG8_LDB(B0, 1, 0); PG8_SCHED; PG8_LDA(At, 1, 0); PG8_STAGE(PG8_SA(0, 1), a2 + hstepA, voffA);
            PG8_WAIT_L(8); PG8_BAR; PG8_WAIT_L(0); PG8_MMA(0, 0, At, B0); PG8_BAR; PG8_SCHED;
            PG8_LDB(B1, 1, 1); PG8_STAGE(PG8_SB(1, 0), b3, voffB);
            PG8_BAR; PG8_WAIT_L(0); PG8_MMA(0, 1, At, B1); PG8_BAR;
            PG8_LDA(At, 1, 1); PG8_STAGE(PG8_SA(1, 0), a3, voffA);
            PG8_BAR; PG8_WAIT_L(0); PG8_MMA(1, 0, At, B0); PG8_BAR; PG8_SCHED;
            PG8_STAGE(PG8_SB(1, 1), b3 + hstepB, voffB);
            PG8_WAIT_V(6); PG8_BAR; PG8_MMA(1, 1, At, B1); PG8_BAR;
        }
        E(acc, cur, wr, wc, fr, fq);
        if (!has_next) break;
#pragma unroll
        for (int a = 0; a < 2; ++a)
#pragma unroll
            for (int b = 0; b < 2; ++b)
#pragma unroll
                for (int m = 0; m < 4; ++m)
#pragma unroll
                    for (int n = 0; n < 2; ++n) acc[a][b][m][n] = (f32x4){0.f, 0.f, 0.f, 0.f};
        cur = nxt; cA = nA; cB = nB; ++ui;
    }
    PG8_WAIT_V(0);
    if (wr == 0) PG8_BAR;
    PG8_BAR;
#undef PG8_ACOL
#undef PG8_SA
#undef PG8_SB
#undef PG8_STAGE
#undef PG8_LDA
#undef PG8_LDB
#undef PG8_MMA
#undef PG8_WAIT_V
#undef PG8_WAIT_L
#undef PG8_BAR
#undef PG8_SCHED
}
}
#define LAS __attribute__((address_space(3)))
typedef unsigned short bf16;
typedef short bf16x8 __attribute__((ext_vector_type(8)));
typedef float f32x4 __attribute__((ext_vector_type(4)));
typedef unsigned u32x4 __attribute__((ext_vector_type(4)));
typedef unsigned u32x2 __attribute__((ext_vector_type(2)));
constexpr int DM = 1024, MT = 24576, MCTX = 8192, LCTX = 256, LLAT = 2048, NWAVES = 8, NTHR = 512;
constexpr int NPROJ_E = 3072, NB_E = 3328, IN_EVEN_LD = 3088;
constexpr float EPSF = 1e-6f;
constexpr size_t MiB = 1u << 20;
constexpr size_t WS_MOD = 0, MOD_BYTES = 4 * 9 * 6144 * 4, WS_S5F = 1 * MiB, WS_AB = 3 * MiB, WS_W1T = 5 * MiB, WS_W2T = 37 * MiB, WS_WINE = 69 * MiB,
                 WS_WOUTE = 82 * MiB, WS_WINO = 86 * MiB, WS_WOUTO = 94 * MiB, WS_WG = 98 * MiB, WS_H = 102 * MiB, WS_BIG = 150 * MiB, WS_YBUF = 294 * MiB,
                 WS_GATES = 246 * MiB, WS_MIX = 342 * MiB, WS_END = 390 * MiB;
constexpr int LDS_BYTES = 147456;
constexpr size_t OUT_S5RE = 25165824, OUT_S5IM = OUT_S5RE + 262144, OUT_DELTA = OUT_S5IM + 262144, OUT_LRU = OUT_DELTA + 8388608;

struct Params { const float* in[40]; float* out; unsigned char* ws; };
enum { I_XP = 0, I_XS, I_S5RE, I_S5IM, I_SDELTA, I_SLRU, I_C, I_CCTX, I_WADA, I_BADA, I_NMIXPRE, I_NMIXPOST, I_NMLPPRE, I_NMLPPOST, I_WMLPIN, I_WMLPOUT, I_WINE, I_WOUTE,
       I_LAMRE, I_LAMIM, I_LOGDT, I_BRE, I_BIM, I_CRE, I_CIM, I_S5D, I_GCONVW, I_GCONVB, I_GALOG, I_GDTB, I_GONORM, I_WINO, I_WOUTO, I_LCONVW, I_LCONVB, I_LWR, I_LBR, I_LWI, I_LBI, I_LLAM };

__device__ __forceinline__ unsigned f2bf(float f) { unsigned u = __builtin_bit_cast(unsigned, f); return (u + 0x7fffu + ((u >> 16) & 1u)) >> 16; }
__device__ __forceinline__ unsigned pk2(float lo, float hi) { return f2bf(lo) | (f2bf(hi) << 16); }
__device__ __forceinline__ float bflo(unsigned w) { return __builtin_bit_cast(float, w << 16); }
__device__ __forceinline__ float bfhi(unsigned w) { return __builtin_bit_cast(float, w & 0xffff0000u); }
__device__ __forceinline__ float bf2f(bf16 b) { return __builtin_bit_cast(float, (unsigned)b << 16); }
__device__ __forceinline__ float sigmoidf_(float x) { return 1.0f / (1.0f + __expf(-x)); }
__device__ __forceinline__ float siluf_(float x) { return x * sigmoidf_(x); }
__device__ __forceinline__ float softplusf_(float x) { return fmaxf(x, 0.f) + log1pf(__expf(-fabsf(x))); }
__device__ __forceinline__ float geluf_(float x) { const float y = 0.7978845608028654f * (x + 0.044715f * x * x * x); const float t = 1.0f - 2.0f / (__expf(2.0f * y) + 1.0f); return 0.5f * x * (1.0f + t); }
__device__ __forceinline__ float shfl_i(float v, int srclane) { return __builtin_bit_cast(float, __builtin_amdgcn_ds_bpermute(srclane << 2, __builtin_bit_cast(int, v))); }
__device__ __forceinline__ float wave_sum(float v, int lane) {
#pragma unroll
    for (int o = 1; o < 64; o <<= 1) v += shfl_i(v, lane ^ o);
    return v;
}
#define LDS_WAIT() asm volatile("s_waitcnt lgkmcnt(0)" ::: "memory")
#define WAVE_SYNC() do { asm volatile("s_waitcnt lgkmcnt(0)" ::: "memory"); __builtin_amdgcn_wave_barrier(); } while (0)
__device__ __forceinline__ f32x4 mfma16(bf16x8 a, bf16x8 b, f32x4 c) { return __builtin_amdgcn_mfma_f32_16x16x32_bf16(a, b, c, 0, 0, 0); }

__device__ __forceinline__ void transpose_item(const float* W, int ldw, int nvalid, int K, bf16* WT, int dst_row0, LAS float* scr, int k0, int n0, int lane) {
    const int nn = n0 + (lane & 31); const bool ok = nn < nvalid;
#pragma unroll 8
    for (int i = 0; i < 32; ++i) { const int kk = 2 * i + (lane >> 5); scr[kk * 33 + (lane & 31)] = ok ? W[(size_t)(k0 + kk) * ldw + nn] : 0.f; }
    WAVE_SYNC();
    const int c = lane & 7;
#pragma unroll
    for (int j = 0; j < 4; ++j) { const int n = (lane >> 3) + 8 * j; const LAS float* s = scr + (8 * c) * 33 + n;
        u32x4 o; o.x = pk2(s[0 * 33], s[1 * 33]); o.y = pk2(s[2 * 33], s[3 * 33]); o.z = pk2(s[4 * 33], s[5 * 33]); o.w = pk2(s[6 * 33], s[7 * 33]);
        *(u32x4*)(WT + (size_t)(dst_row0 + n) * K + k0 + 8 * c) = o; }
    WAVE_SYNC();
}
__device__ __forceinline__ void phase_prologue(int wid0, const Params& P, LAS unsigned char* lds) {
    const int tid = tid_fresh(wid0), lane = tid & 63, wave = tid >> 6;
    LAS float* scr = (LAS float*)(lds + wave * 16384);
    const int gw = bid_fresh() * NWAVES + wave, NGW = grid_fresh() * NWAVES;
    unsigned char* ws = P.ws;
    constexpr int NA = 8192, NB = 8192, NC = 2 * 16 * 97, ND = 1024, NE = 2048, NF = 1024, NG = 1024, NTR = NA + NB + NC + ND + NE + NF + NG, NMOD = 4 * 24 * 16;
    for (int it = gw; it < NTR + NMOD; it += NGW) {
        int r = it;
        if (r < NA) { const int l = r >> 11, q = r & 2047; transpose_item(P.in[I_WMLPIN] + (size_t)l * 1024 * 4096, 4096, 4096, 1024, (bf16*)(ws + WS_W1T) + (size_t)l * 4096 * 1024, 32 * (q & 127), scr, 64 * (q >> 7), 32 * (q & 127), lane); continue; } r -= NA;
        if (r < NB) { const int l = r >> 11, q = r & 2047; transpose_item(P.in[I_WMLPOUT] + (size_t)l * 4096 * 1024, 1024, 1024, 4096, (bf16*)(ws + WS_W2T) + (size_t)l * 1024 * 4096, 32 * (q & 31), scr, 64 * (q >> 5), 32 * (q & 31), lane); continue; } r -= NB;
        if (r < NC) { const int e = r / 1552, q = r % 1552, kb = q / 97, nb = q % 97; transpose_item(P.in[I_WINE] + (size_t)e * 1024 * IN_EVEN_LD, IN_EVEN_LD, IN_EVEN_LD, 1024, (bf16*)(ws + WS_WINE) + (size_t)e * NB_E * 1024, 32 * nb, scr, 64 * kb, 32 * nb, lane); continue; } r -= NC;
        if (r < ND) { const int e = r >> 9, q = r & 511; transpose_item(P.in[I_WOUTE] + (size_t)e * 1024 * 1024, 1024, 1024, 1024, (bf16*)(ws + WS_WOUTE) + (size_t)e * 1024 * 1024, 32 * (q & 31), scr, 64 * (q >> 5), 32 * (q & 31), lane); continue; } r -= ND;
        if (r < NE) { const int o = r >> 10, q = r & 1023; transpose_item(P.in[I_WINO] + (size_t)o * 1024 * 2048, 2048, 2048, 1024, (bf16*)(ws + WS_WINO) + (size_t)o * 2048 * 1024, 32 * (q & 63), scr, 64 * (q >> 6), 32 * (q & 63), lane); continue; } r -= NE;
        if (r < NF) { const int o = r >> 9, q = r & 511; transpose_item(P.in[I_WOUTO] + (size_t)o * 1024 * 1024, 1024, 1024, 1024, (bf16*)(ws + WS_WOUTO) + (size_t)o * 1024 * 1024, 32 * (q & 31), scr, 64 * (q >> 5), 32 * (q & 31), lane); continue; } r -= NF;
        if (r < NG) { const int mat = r >> 5, q = r & 31, kb = q >> 3, nb = q & 7; const int blk = mat & 3, gate = (mat >> 2) & 1, od = mat >> 3;
            const float* src = (gate ? P.in[I_LWI] : P.in[I_LWR]) + (size_t)(od * 4 + blk) * 65536;
            const int j0 = nb * 32; const int drow = (blk * 2 + (j0 >> 7)) * 256 + gate * 128 + (j0 & 127);
            transpose_item(src, 256, 256, 256, (bf16*)(ws + WS_WG) + (size_t)od * 2048 * 256, drow - j0 + j0, scr, 64 * kb, j0, lane);
            continue; } r -= NG;
        {
            const int l = r / 384, rem = r % 384, ec = rem >> 4, ks = rem & 15, k0 = ks * 64;
#pragma unroll
            for (int rr = 0; rr < 9; ++rr) { const float cv = rr == 0 ? P.in[I_CCTX][k0 + lane] : P.in[I_C][(rr - 1) * 1024 + k0 + lane]; scr[rr * 64 + lane] = siluf_(cv); }
            WAVE_SYNC();
            f32x4 acc[9];
#pragma unroll
            for (int rr = 0; rr < 9; ++rr) acc[rr] = (f32x4){0.f, 0.f, 0.f, 0.f};
            const float* wp = P.in[I_WADA] + ((size_t)l * 1024 + k0) * 6144 + ec * 256 + lane * 4;
#pragma unroll 4
            for (int kk = 0; kk < 64; ++kk) { const f32x4 w4 = *(const f32x4*)(wp + (size_t)kk * 6144);
#pragma unroll
                for (int rr = 0; rr < 9; ++rr) acc[rr] += w4 * scr[rr * 64 + kk]; }
            float* part = (float*)(ws + WS_BIG) + ((size_t)(ks * 4 + l) * 9) * 6144 + ec * 256 + lane * 4;
#pragma unroll
            for (int rr = 0; rr < 9; ++rr) *(f32x4*)(part + (size_t)rr * 6144) = acc[rr];
            WAVE_SYNC();
        }
    }
    { u32x4* z = (u32x4*)0; (void)z;
      const size_t per = (size_t)(NB_E - 3104) * 1024 * 2 / 16;
      for (size_t i = (size_t)bid_fresh() * NTHR + tid; i < 2 * per; i += (size_t)grid_fresh() * NTHR) { const size_t e = i / per, q = i % per;
          *(u32x4*)(ws + WS_WINE + (e * NB_E + 3104) * 1024 * 2 + q * 16) = (u32x4){0u, 0u, 0u, 0u}; } }
}

__device__ __forceinline__ void phase_modreduce(int wid0, const Params& P) {
    const int tid = tid_fresh(wid0);
    const float* part = (const float*)(P.ws + WS_BIG); float* mod = (float*)(P.ws + WS_MOD);
    for (int i = bid_fresh() * NTHR + tid; i < 4 * 9 * 6144 / 4; i += grid_fresh() * NTHR) {
        const int l = i / (9 * 1536), e4 = i % 1536;
        f32x4 a = *(const f32x4*)(P.in[I_BADA] + (size_t)l * 6144 + e4 * 4);
#pragma unroll
        for (int ks = 0; ks < 16; ++ks) a += *(const f32x4*)(part + (size_t)ks * 4 * 9 * 6144 + (size_t)i * 4);
        *(f32x4*)(mod + (size_t)i * 4) = a; }
}
__device__ __forceinline__ void phase_rownorm(int wid0, const Params& P, int first, const bf16* obuf, const float* modg, int goff, const float* gpost, int has_next, const float* gpre, const float* mods, int soff, bf16* H) {
    const int tid = tid_fresh(wid0), lane = tid & 63, wave = tid >> 6;
    const int gw = bid_fresh() * NWAVES + wave, NGW = grid_fresh() * NWAVES;
    float* X = P.out;
    for (int m = gw; m < MT; m += NGW) {
        const int modrow = m < MCTX ? 0 : 1 + ((m - MCTX) >> 11);
        const float* mr = modg + (size_t)modrow * 6144; const float* ms = mods + (size_t)modrow * 6144;
        f32x4 x[4];
        if (first) {
            if (m < MCTX) {
#pragma unroll
                for (int j = 0; j < 4; ++j) x[j] = *(const f32x4*)(P.in[I_XP] + (size_t)m * DM + lane * 4 + 256 * j);
            } else {
                const int t = (m - MCTX) & 2047; const float prow = (float)(t >> 6), pcol = (float)(t & 63);
                f32x4 om;
#pragma unroll
                for (int e = 0; e < 4; ++e) om[e] = exp2f(-(float)(lane * 4 + e) * (13.287712379549449f / 256.0f));
#pragma unroll
                for (int j = 0; j < 4; ++j) { x[j] = *(const f32x4*)(P.in[I_XS] + (size_t)(m - MCTX) * DM + lane * 4 + 256 * j);
#pragma unroll
                    for (int e = 0; e < 4; ++e) { const float a = (j < 2 ? prow : pcol) * om[e]; x[j][e] += (j & 1) ? cosf(a) : sinf(a); } }
            }
        } else {
            u32x2 ov[4]; float ss = 0.f;
#pragma unroll
            for (int j = 0; j < 4; ++j) { x[j] = *(const f32x4*)(X + (size_t)m * DM + lane * 4 + 256 * j); ov[j] = *(const u32x2*)(obuf + (size_t)m * DM + lane * 4 + 256 * j); }
#pragma unroll
            for (int j = 0; j < 4; ++j) { const float a = bflo(ov[j].x), b = bfhi(ov[j].x), c = bflo(ov[j].y), d = bfhi(ov[j].y); ss += (a * a + b * b) + (c * c + d * d); }
            const float rs = rsqrtf(wave_sum(ss, lane) * (1.0f / DM) + EPSF);
#pragma unroll
            for (int j = 0; j < 4; ++j) { const f32x4 g4 = *(const f32x4*)(gpost + lane * 4 + 256 * j), gt = *(const f32x4*)(mr + goff + lane * 4 + 256 * j);
                f32x4 o4 = (f32x4){bflo(ov[j].x), bfhi(ov[j].x), bflo(ov[j].y), bfhi(ov[j].y)};
                x[j] += gt * (o4 * rs * g4); }
        }
#pragma unroll
        for (int j = 0; j < 4; ++j) *(f32x4*)(X + (size_t)m * DM + lane * 4 + 256 * j) = x[j];
        if (has_next) {
            float ss = 0.f;
#pragma unroll
            for (int j = 0; j < 4; ++j) ss += (x[j][0] * x[j][0] + x[j][1] * x[j][1]) + (x[j][2] * x[j][2] + x[j][3] * x[j][3]);
            const float rs = rsqrtf(wave_sum(ss, lane) * (1.0f / DM) + EPSF);
#pragma unroll
            for (int j = 0; j < 4; ++j) { const f32x4 g4 = *(const f32x4*)(gpre + lane * 4 + 256 * j), sh = *(const f32x4*)(ms + soff + lane * 4 + 256 * j), sc = *(const f32x4*)(ms + soff + 1024 + lane * 4 + 256 * j);
                const f32x4 h4 = (x[j] * rs * g4) * (sc + 1.0f) + sh;
                u32x2 w; w.x = pk2(h4[0], h4[1]); w.y = pk2(h4[2], h4[3]);
                *(u32x2*)(H + (size_t)m * DM + lane * 4 + 256 * j) = w; }
        }
    }
}

using pg8::Unit;
template <int ACT  > struct EpiBf16 {
    bf16* O; int ldc; float* AB;
    __device__ __forceinline__ void operator()(const f32x4 (&acc)[2][2][4][2], const Unit& u, int wr, int wc, int fr, int fq) const {
        const int row0 = u.pm * 256 + wr * 64 + fr, col0 = u.pn * 256 + wc * 32 + 8 * fq;
        if (AB && u.pn * 256 >= ldc) {
            if (wc == 0 && fq < 2) {
#pragma unroll
                for (int ai = 0; ai < 2; ++ai)
#pragma unroll
                    for (int m = 0; m < 4; ++m) { float* p = AB + (size_t)(row0 + ai * 128 + m * 16) * 16 + 8 * fq; *(f32x4*)p = acc[ai][0][m][0]; *(f32x4*)(p + 4) = acc[ai][0][m][1]; }
            }
            return;
        }
#pragma unroll
        for (int ai = 0; ai < 2; ++ai)
#pragma unroll
            for (int m = 0; m < 4; ++m) { bf16* rowp = O + (size_t)(row0 + ai * 128 + m * 16) * ldc + col0;
#pragma unroll
                for (int bj = 0; bj < 2; ++bj) { f32x4 v0 = acc[ai][bj][m][0], v1 = acc[ai][bj][m][1];
                    if (ACT == 1) {
#pragma unroll
                        for (int j = 0; j < 4; ++j) { const float a = fmaxf(v0[j], 0.f), b = fmaxf(v1[j], 0.f); v0[j] = a * a; v1[j] = b * b; } }
                    u32x4 w; w.x = pg8::cvt_pk_bf16(v0[0], v0[1]); w.y = pg8::cvt_pk_bf16(v0[2], v0[3]); w.z = pg8::cvt_pk_bf16(v1[0], v1[1]); w.w = pg8::cvt_pk_bf16(v1[2], v1[3]);
                    *(u32x4*)(rowp + bj * 128) = w; } }
    }
};
struct EpiGates {
    unsigned* G; const bf16* X; const float* br; const float* bi; const float* lam;
    __device__ __forceinline__ void operator()(const f32x4 (&acc)[2][2][4][2], const Unit& u, int wr, int wc, int fr, int fq) const {
        const int row0 = u.pm * 256 + wr * 64 + fr, ch0 = u.pn * 128 + wc * 32 + 8 * fq;
#pragma unroll
        for (int n = 0; n < 2; ++n) {
            const f32x4 vbr = *(const f32x4*)(br + ch0 + 4 * n), vbi = *(const f32x4*)(bi + ch0 + 4 * n), l4 = *(const f32x4*)(lam + ch0 + 4 * n);
            f32x4 vsp;
#pragma unroll
            for (int e = 0; e < 4; ++e) vsp[e] = -8.0f * softplusf_(-l4[e]);
#pragma unroll
            for (int ai = 0; ai < 2; ++ai)
#pragma unroll
                for (int m = 0; m < 4; ++m) { const size_t row = (size_t)(row0 + ai * 128 + m * 16);
                    const u32x2 xv = *(const u32x2*)(X + row * DM + ch0 + 4 * n);
                    const float xs[4] = {bflo(xv.x), bfhi(xv.x), bflo(xv.y), bfhi(xv.y)};
                    u32x4 w;
#pragma unroll
                    for (int e = 0; e < 4; ++e) { const float r = sigmoidf_(acc[ai][0][m][n][e] + vbr[e]), ig = sigmoidf_(acc[ai][1][m][n][e] + vbi[e]);
                        const float la = r * vsp[e]; const float b = sqrtf(fmaxf(-expm1f(2.0f * la), 0.f)) * ig * xs[e];
                        w[e] = pk2(la * 1.4426950408889634f, b); }
                    *(u32x4*)(G + row * DM + ch0 + 4 * n) = w; }
        }
    }
};
constexpr int S5_WLDS = 12800, BU_P = 132, HS_P = 136;
struct S5Dir { float ar, ai; bf16x8 Bf[8]; };
__device__ __forceinline__ void s5_dir_setup(const Params& P, int e, int d, int g, int lane, float& ar, float& ai, bf16x8 (&Bf)[8], bool needB) {
    const int quad = lane >> 4, l15 = lane & 15;
    const float dt = __expf(P.in[I_LOGDT][(e * 2 + d) * 32 + g]);
    const float lr = P.in[I_LAMRE][((e * 2 + d) * 32 + g) * 64 + lane], li = P.in[I_LAMIM][((e * 2 + d) * 32 + g) * 64 + lane];
    const float mag = expf(lr * dt); ar = mag * cosf(li * dt); ai = mag * sinf(li * dt);
    const float den = lr * lr + li * li;
    const float fr = ((ar - 1.0f) * lr + ai * li) / den, fi = (ai * lr - (ar - 1.0f) * li) / den;
    if (needB) {
#pragma unroll
        for (int nt = 0; nt < 8; ++nt) { const int col = 16 * nt + l15, p = col & 63;
            const float frp = shfl_i(fr, p), fip = shfl_i(fi, p);
            bf16x8 v = (bf16x8){0, 0, 0, 0, 0, 0, 0, 0};
            if (quad < 2) { const float* bre = P.in[I_BRE] + ((size_t)(e * 32 + g) * 64 + p) * 16 + quad * 8; const float* bim = P.in[I_BIM] + ((size_t)(e * 32 + g) * 64 + p) * 16 + quad * 8;
#pragma unroll
                for (int j = 0; j < 8; ++j) { const float br = bre[j], bi = bim[j]; const float val = (nt < 4) ? (frp * br - fip * bi) : (frp * bi + fip * br); v[j] = (short)f2bf(val); } }
            Bf[nt] = v; }
    }
}
__device__ __forceinline__ void s5_c_setup(const Params& P, int e, int g, int lane, bf16x8 (&Cf)[4]) {
    const int quad = lane >> 4, l15 = lane & 15;
#pragma unroll
    for (int ks = 0; ks < 4; ++ks) { const int col0 = 32 * ks + quad * 8; const bool im = col0 >= 64;
        const float* src = (im ? P.in[I_CIM] : P.in[I_CRE]) + ((size_t)(e * 32 + g) * 16 + l15) * 64 + (col0 & 63);
        bf16x8 v;
#pragma unroll
        for (int j = 0; j < 8; ++j) v[j] = (short)f2bf(im ? -src[j] : src[j]);
        Cf[ks] = v; }
}
__device__ __forceinline__ void s5_scan_seg(const Params& P, LAS unsigned char* wl, int lane, int d, int g, int m0, float ar, float ai, const bf16x8 (&Bf)[8], const bf16x8 (&Cf)[4],
                                            float& hr, float& hi, int mode, int ymode, const bf16* proj, float* ybuf, bf16* mixout, float dsk) {
    const int quad = lane >> 4, l15 = lane & 15;
    LAS float* BU = (LAS float*)wl; LAS bf16* HS = (LAS bf16*)(wl + 8448);
    for (int bi_ = 0; bi_ < 16; ++bi_) {
        const int blk = d ? 15 - bi_ : bi_;
        const int mb = m0 + 16 * blk;
        if (mode == 0) {
            bf16x8 a = (bf16x8){0, 0, 0, 0, 0, 0, 0, 0};
            if (quad < 2) { const int tt = d ? 15 - l15 : l15; a = *(const bf16x8*)(proj + (size_t)(mb + tt) * NPROJ_E + g * 16 + quad * 8); }
#pragma unroll
            for (int nt = 0; nt < 8; ++nt) { f32x4 acc = mfma16(a, Bf[nt], (f32x4){0.f, 0.f, 0.f, 0.f});
#pragma unroll
                for (int jj = 0; jj < 4; ++jj) BU[(quad * 4 + jj) * BU_P + 16 * nt + l15] = acc[jj]; }
            WAVE_SYNC();
        }
#pragma unroll
        for (int r = 0; r < 16; ++r) {
            float br = 0.f, bim = 0.f;
            if (mode == 0) { br = BU[r * BU_P + lane]; bim = BU[r * BU_P + 64 + lane]; }
            const float nr = ar * hr - ai * hi + br, ni = ar * hi + ai * hr + bim; hr = nr; hi = ni;
            HS[r * HS_P + lane] = (bf16)f2bf(hr); HS[r * HS_P + 64 + lane] = (bf16)f2bf(hi);
        }
        WAVE_SYNC();
        f32x4 y = (f32x4){0.f, 0.f, 0.f, 0.f};
#pragma unroll
        for (int ks = 0; ks < 4; ++ks) { const bf16x8 a = *(const LAS bf16x8*)(HS + l15 * HS_P + 32 * ks + quad * 8); y = mfma16(a, Cf[ks], y); }
        const int ch = g * 16 + l15;
#pragma unroll
        for (int jj = 0; jj < 4; ++jj) { const int row = quad * 4 + jj; const int tt = d ? 15 - row : row; const size_t m = (size_t)(mb + tt);
            float v = y[jj];
            if (ymode == 0) { v += dsk * bf2f(proj[m * NPROJ_E + ch]); ybuf[m * 512 + ch] = v; }
            else { v += ybuf[m * 512 + ch];
                if (ymode == 1) ybuf[m * 512 + ch] = v;
                else { const float z = bf2f(proj[m * NPROJ_E + 512 + ch]); mixout[m * DM + ch] = (bf16)f2bf(geluf_(v) * sigmoidf_(z)); } }
        }
        WAVE_SYNC();
    }
}
__device__ __forceinline__ void s5_task_main(const Params& P, LAS unsigned char* wl, int lane, int e, int sub, int g) {
    const bf16* proj = (const bf16*)(P.ws + WS_BIG); float* ybuf = (float*)(P.ws + WS_YBUF); bf16* mixout = (bf16*)(P.ws + WS_MIX);
    const bool lat = sub >= 32; const int q = sub - 32, b = lat ? (q >> 3) : sub, seg = lat ? (q & 7) : 0;
    const int m0 = lat ? MCTX + b * LLAT + seg * 256 : sub * 256;
    bf16x8 Cf[4]; s5_c_setup(P, e, g, lane, Cf);
    const float dsk = P.in[I_S5D][e * 512 + g * 16 + (lane & 15)];
#pragma unroll 1
    for (int d = 0; d < 2; ++d) {
        float ar, ai; bf16x8 Bf[8]; s5_dir_setup(P, e, d, g, lane, ar, ai, Bf, true);
        float hr = 0.f, hi = 0.f;
        if (lat && ((d == 0 && seg == 0) || (d == 1 && seg == 7))) { const size_t si = ((((size_t)b * 2 + e) * 2 + d) * 32 + g) * 64 + lane; hr = P.in[I_S5RE][si]; hi = P.in[I_S5IM][si]; }
        const int ymode = d == 0 ? 0 : (lat ? 1 : 2);
        s5_scan_seg(P, wl, lane, d, g, m0, ar, ai, Bf, Cf, hr, hi, 0, ymode, proj, ybuf, mixout, dsk);
        if (!lat) { const size_t si = ((((size_t)b * 2 + e) * 2 + d) * 32 + g) * 64 + lane; P.out[OUT_S5RE + si] = hr; P.out[OUT_S5IM + si] = hi; }
        else { float* F = (float*)(P.ws + WS_S5F) + ((((size_t)d * 64 + q) * 32 + g) * 64 + lane) * 2; F[0] = hr; F[1] = hi; }
    }
}
__device__ __forceinline__ void s5_task_corr(const Params& P, LAS unsigned char* wl, int lane, int e, int q, int g) {
    const bf16* proj = (const bf16*)(P.ws + WS_BIG); float* ybuf = (float*)(P.ws + WS_YBUF); bf16* mixout = (bf16*)(P.ws + WS_MIX);
    const int b = q >> 3, seg = q & 7, m0 = MCTX + b * LLAT + seg * 256;
    bf16x8 Cf[4]; s5_c_setup(P, e, g, lane, Cf);
    bf16x8 Bf[8];
#pragma unroll
    for (int i = 0; i < 8; ++i) Bf[i] = (bf16x8){0, 0, 0, 0, 0, 0, 0, 0};
    const float* Fb = (const float*)(P.ws + WS_S5F);
#pragma unroll 1
    for (int d = 0; d < 2; ++d) {
        float ar, ai; s5_dir_setup(P, e, d, g, lane, ar, ai, Bf, false);
        float pr = ar, pi = ai;
#pragma unroll
        for (int i = 0; i < 8; ++i) { const float nr = pr * pr - pi * pi, ni = 2.0f * pr * pi; pr = nr; pi = ni; }
        float hr = 0.f, hi = 0.f;
        const int cnt = d == 0 ? seg : 7 - seg;
        for (int i = 0; i < cnt; ++i) { const int sj = d == 0 ? i : 7 - i; const float* F = Fb + ((((size_t)d * 64 + b * 8 + sj) * 32 + g) * 64 + lane) * 2;
            const float nr = pr * hr - pi * hi + F[0], ni = pr * hi + pi * hr + F[1]; hr = nr; hi = ni; }
        if (cnt > 0) s5_scan_seg(P, wl, lane, d, g, m0, ar, ai, Bf, Cf, hr, hi, 1, 1, proj, ybuf, mixout, 0.f);
    }
    __builtin_amdgcn_wave_barrier();
    for (int i = lane; i < 256 * 16; i += 64) { const size_t m = (size_t)(m0 + (i >> 4)); const int ch = g * 16 + (i & 15);
        const float v = ybuf[m * 512 + ch]; const float z = bf2f(proj[m * NPROJ_E + 512 + ch]);
        mixout[m * DM + ch] = (bf16)f2bf(geluf_(v) * sigmoidf_(z)); }
}

constexpr int G_Q = 0, G_K = 17408, G_V = 34816, G_KT = 52224, G_LM = 70656, G_QK = 89088, G_ST = 98304, G_SM = 133120;
constexpr int P128 = 136, P64 = 72, LMP = 68;
__device__ __forceinline__ void gdn_chain(int wid0, const Params& P, LAS unsigned char* lds, int e, int s, int hd, int dir) {
    const int tid = tid_fresh(wid0), lane = tid & 63, w = __builtin_amdgcn_readfirstlane(tid >> 6), quad = lane >> 4, l15 = lane & 15;
    const bool lat = s >= 32; const int b = lat ? s - 32 : s; const int L = lat ? LLAT : LCTX; const int m0 = lat ? MCTX + b * LLAT : s * LCTX;
    const bf16* proj = (const bf16*)(P.ws + WS_BIG); const float* AB = (const float*)(P.ws + WS_AB);
    bf16* Odir = (bf16*)(P.ws + WS_H) + (size_t)dir * MT * 512;
    int zv; asm volatile("v_mov_b32 %0, 0" : "=v"(zv));
    lds += zv;
    LAS bf16* Qs = (LAS bf16*)(lds + G_Q); LAS bf16* Ks = (LAS bf16*)(lds + G_K); LAS bf16* Vs = (LAS bf16*)(lds + G_V); LAS bf16* KT = (LAS bf16*)(lds + G_KT);
    LAS float* Lm = (LAS float*)(lds + G_LM); LAS bf16* VNT = (LAS bf16*)(lds + G_LM); LAS bf16* QKs = (LAS bf16*)(lds + G_QK); LAS bf16* ST = (LAS bf16*)(lds + G_ST);
    LAS float* rq = (LAS float*)(lds + G_SM); LAS float* rk = rq + 64; LAS float* gcs = rq + 128; LAS float* betas = rq + 192; LAS float* egs = rq + 256; LAS float* kes = rq + 320;
    f32x4 Sacc[8];
    const size_t sbase = ((((size_t)b * 2 + e) * 2 + dir) * 4 + hd) * 16384;
#pragma unroll
    for (int mt = 0; mt < 8; ++mt) Sacc[mt] = (f32x4){0.f, 0.f, 0.f, 0.f};
    if (lat) { const float* sp = P.in[I_SDELTA] + sbase + (size_t)(quad * 4) * 128 + 16 * w + l15;
#pragma unroll
        for (int mt = 0; mt < 8; ++mt)
#pragma unroll
            for (int jj = 0; jj < 4; ++jj) Sacc[mt][jj] = sp[(16 * mt + jj) * 128]; }
#pragma unroll
    for (int mt = 0; mt < 8; ++mt) {
        u32x2 pw; pw.x = pk2(Sacc[mt][0], Sacc[mt][1]); pw.y = pk2(Sacc[mt][2], Sacc[mt][3]);
        *(LAS u32x2*)(ST + (16 * w + l15) * P128 + 16 * mt + quad * 4) = pw; }
    const float alog_e = __expf(P.in[I_GALOG][(e * 2 + dir) * 4 + hd]), dtb = P.in[I_GDTB][(e * 2 + dir) * 4 + hd];
    const int nchunk = L / 64;
#pragma unroll 1
    for (int ci = 0; ci < nchunk; ++ci) {
        const int c0 = dir ? L - 64 * (ci + 1) : 64 * ci;
        __syncthreads();
#ifndef NO_A
        { const int dd = tid & 127, tq = tid >> 7;
#pragma unroll 1
          for (int part = 0; part < 3; ++part) { const int ccol = part * 512 + hd * 128 + dd; const int pcol = 1024 + ccol;
              const float* cw = P.in[I_GCONVW] + (size_t)e * 4 * 1536 + ccol; const float w0 = cw[0], w1 = cw[1536], w2 = cw[3072], w3 = cw[4608], cb = P.in[I_GCONVB][e * 1536 + ccol];
              LAS bf16* dst = part == 0 ? Qs : (part == 1 ? Ks : Vs);
              const int tb = c0 + tq * 16;
              float xm1, x0, x1, x2;
              { const int t = tb - 1; xm1 = (t >= 0) ? bf2f(proj[(size_t)(m0 + t) * NPROJ_E + pcol]) : 0.f; }
              x0 = bf2f(proj[(size_t)(m0 + tb) * NPROJ_E + pcol]);
              { const int t = tb + 1; x1 = (t < L) ? bf2f(proj[(size_t)(m0 + t) * NPROJ_E + pcol]) : 0.f; }
#pragma unroll 4
              for (int n = 0; n < 16; ++n) { const int t = tb + n + 2; x2 = (t < L) ? bf2f(proj[(size_t)(m0 + t) * NPROJ_E + pcol]) : 0.f;
                  const float v = cb + w0 * xm1 + w1 * x0 + w2 * x1 + w3 * x2;
                  const int nn = tq * 16 + n; const int r = dir ? 63 - nn : nn;
                  dst[r * P128 + dd] = (bf16)f2bf(siluf_(v));
                  xm1 = x0; x0 = x1; x1 = x2; } } }
#endif
        __syncthreads();
        { const int rowid = tid >> 2, part = tid & 3; LAS bf16* src = (rowid < 64 ? Qs : Ks) + (rowid & 63) * P128 + part * 32;
          float ss = 0.f;
#pragma unroll
          for (int i = 0; i < 4; ++i) { const u32x4 v = *(const LAS u32x4*)(src + 8 * i);
#pragma unroll
              for (int j = 0; j < 4; ++j) { const float a = bflo(v[j]), c = bfhi(v[j]); ss += a * a + c * c; } }
          ss += shfl_i(ss, lane ^ 1); ss += shfl_i(ss, lane ^ 2);
          if (part == 0) { if (rowid < 64) rq[rowid] = rsqrtf(ss + EPSF) * 0.08838834764831845f; else rk[rowid - 64] = rsqrtf(ss + EPSF); }
          if (w == 0) { const int t = c0 + (dir ? 63 - lane : lane); const size_t m = (size_t)(m0 + t);
              const float araw = AB[m * 16 + dir * 4 + hd], braw = AB[m * 16 + 8 + dir * 4 + hd];
              const float gg = -alog_e * softplusf_(araw + dtb);
              float gc = gg;
#pragma unroll
              for (int o = 1; o < 64; o <<= 1) { const float t2 = shfl_i(gc, (lane - o) & 63); if (lane >= o) gc += t2; }
              const float glast = shfl_i(gc, 63);
              gcs[lane] = gc; betas[lane] = sigmoidf_(braw); egs[lane] = __expf(gc); kes[lane] = __expf(glast - gc);
              if (lane == 0) rq[384] = __expf(glast); } }
        __syncthreads();
#ifndef NO_C
        { const int mt = w & 3; const bool isq = w >= 4; LAS bf16* src = isq ? Qs : Ks;
          bf16x8 a[4];
#pragma unroll
          for (int ks = 0; ks < 4; ++ks) a[ks] = *(const LAS bf16x8*)(src + (16 * mt + l15) * P128 + 32 * ks + quad * 8);
#pragma unroll 1
          for (int nt = 0; nt < 4; ++nt) { f32x4 acc = (f32x4){0.f, 0.f, 0.f, 0.f};
#pragma unroll
              for (int ks = 0; ks < 4; ++ks) { const bf16x8 bb = *(const LAS bf16x8*)(Ks + (16 * nt + l15) * P128 + 32 * ks + quad * 8); acc = mfma16(a[ks], bb, acc); }
              const int j = 16 * nt + l15; const float rkj = rk[j], gcj = gcs[j];
              f32x4 lv;
#pragma unroll
              for (int jj = 0; jj < 4; ++jj) { const int i = 16 * mt + quad * 4 + jj; const float dec = __expf(fminf(gcs[i] - gcj, 0.f));
                  lv[jj] = (i > j) ? acc[jj] * rk[i] * rkj * betas[i] * dec : 0.f;
                  if (isq) QKs[i * P64 + j] = (bf16)f2bf((i >= j) ? acc[jj] * rq[i] * rkj * dec : 0.f); }
              if (!isq) *(LAS f32x4*)(Lm + j * LMP + 16 * mt + quad * 4) = lv; }
          const int dd = tid & 127, tq = tid >> 7;
          unsigned pw[8];
#pragma unroll
          for (int n = 0; n < 16; n += 2) { const int i0 = tq * 16 + n; const float v0 = bf2f(Ks[i0 * P128 + dd]) * rk[i0] * kes[i0], v1 = bf2f(Ks[(i0 + 1) * P128 + dd]) * rk[i0 + 1] * kes[i0 + 1]; pw[n >> 1] = pk2(v0, v1); }
          *(LAS u32x4*)(KT + dd * P64 + tq * 16) = (u32x4){pw[0], pw[1], pw[2], pw[3]};
          *(LAS u32x4*)(KT + dd * P64 + tq * 16 + 8) = (u32x4){pw[4], pw[5], pw[6], pw[7]}; }
#endif
        __syncthreads();
#ifndef NO_D
        if (tid < 256) { const bool isv = tid < 128; const int cc = tid & 127; LAS bf16* col = (isv ? Vs : Ks) + cc;
#pragma unroll 1
            for (int bb = 0; bb < 4; ++bb) {
                float sx[16];
#pragma unroll
                for (int r = 0; r < 16; ++r) { const int i = 16 * bb + r; const float sc = isv ? betas[i] : rk[i] * betas[i] * egs[i]; sx[r] = bf2f(col[i * P128]) * sc; }
#pragma unroll 2
                for (int j = 0; j < 16 * bb; ++j) { const float xj = bf2f(col[j * P128]);
#pragma unroll
                    for (int q4 = 0; q4 < 4; ++q4) { const f32x4 l4 = *(const LAS f32x4*)(Lm + j * LMP + 16 * bb + 4 * q4);
#pragma unroll
                        for (int jx = 0; jx < 4; ++jx) sx[4 * q4 + jx] -= l4[jx] * xj; } }
#pragma unroll
                for (int rp = 0; rp < 15; ++rp) { const float xj = sx[rp];
#pragma unroll
                    for (int q4 = rp / 4; q4 < 4; ++q4) { const f32x4 l4 = *(const LAS f32x4*)(Lm + (16 * bb + rp) * LMP + 16 * bb + 4 * q4);
#pragma unroll
                        for (int jx = 0; jx < 4; ++jx) if (4 * q4 + jx > rp) sx[4 * q4 + jx] -= l4[jx] * xj; } }
#pragma unroll
                for (int r = 0; r < 16; ++r) col[(16 * bb + r) * P128] = (bf16)f2bf(sx[r]);
            } }
#endif
        __syncthreads();
#ifndef NO_EFG
        bf16x8 Bst[4];
#pragma unroll
        for (int ks = 0; ks < 4; ++ks) Bst[ks] = *(const LAS bf16x8*)(ST + (16 * w + l15) * P128 + 32 * ks + quad * 8);
#pragma unroll 1
        for (int mt = 0; mt < 4; ++mt) { f32x4 acc = (f32x4){0.f, 0.f, 0.f, 0.f};
#pragma unroll
            for (int ks = 0; ks < 4; ++ks) { const bf16x8 a = *(const LAS bf16x8*)(Ks + (16 * mt + l15) * P128 + 32 * ks + quad * 8); acc = mfma16(a, Bst[ks], acc); }
            float vn[4];
#pragma unroll
            for (int jj = 0; jj < 4; ++jj) vn[jj] = bf2f(Vs[(16 * mt + quad * 4 + jj) * P128 + 16 * w + l15]) - acc[jj];
            u32x2 pw; pw.x = pk2(vn[0], vn[1]); pw.y = pk2(vn[2], vn[3]);
            *(LAS u32x2*)(VNT + (16 * w + l15) * P64 + 16 * mt + quad * 4) = pw; }
        WAVE_SYNC();
        bf16x8 Bvn[2];
#pragma unroll
        for (int k2 = 0; k2 < 2; ++k2) Bvn[k2] = *(const LAS bf16x8*)(VNT + (16 * w + l15) * P64 + 32 * k2 + quad * 8);
#pragma unroll 1
        for (int mt = 0; mt < 4; ++mt) { f32x4 acc = (f32x4){0.f, 0.f, 0.f, 0.f};
#pragma unroll
            for (int ks = 0; ks < 4; ++ks) { const bf16x8 a = *(const LAS bf16x8*)(Qs + (16 * mt + l15) * P128 + 32 * ks + quad * 8); acc = mfma16(a, Bst[ks], acc); }
#pragma unroll
            for (int jj = 0; jj < 4; ++jj) { const int i = 16 * mt + quad * 4 + jj; acc[jj] *= rq[i] * egs[i]; }
#pragma unroll
            for (int k2 = 0; k2 < 2; ++k2) { const bf16x8 a = *(const LAS bf16x8*)(QKs + (16 * mt + l15) * P64 + 32 * k2 + quad * 8); acc = mfma16(a, Bvn[k2], acc); }
#pragma unroll
            for (int jj = 0; jj < 4; ++jj) { const int i = 16 * mt + quad * 4 + jj; const int t = c0 + (dir ? 63 - i : i);
                Odir[(size_t)(m0 + t) * 512 + hd * 128 + 16 * w + l15] = (bf16)f2bf(acc[jj]); } }
        const float egl = rq[384];
#pragma unroll
        for (int mt = 0; mt < 8; ++mt) { f32x4 acc = Sacc[mt] * egl;
#pragma unroll
            for (int k2 = 0; k2 < 2; ++k2) { const bf16x8 a = *(const LAS bf16x8*)(KT + (16 * mt + l15) * P64 + 32 * k2 + quad * 8); acc = mfma16(a, Bvn[k2], acc); }
            Sacc[mt] = acc;
            u32x2 pw; pw.x = pk2(acc[0], acc[1]); pw.y = pk2(acc[2], acc[3]);
            *(LAS u32x2*)(ST + (16 * w + l15) * P128 + 16 * mt + quad * 4) = pw; }
#endif
        WAVE_SYNC();
    }
    if (!lat) { float* dp = P.out + OUT_DELTA + sbase + (size_t)(quad * 4) * 128 + 16 * w + l15;
#pragma unroll
        for (int mt = 0; mt < 8; ++mt)
#pragma unroll
            for (int jj = 0; jj < 4; ++jj) dp[(16 * mt + jj) * 128] = Sacc[mt][jj];
    }
    __syncthreads();
}

__device__ __forceinline__ void phase_mix_even(int wid0, const Params& P, LAS unsigned char* lds, int e) {
    const int tid = tid_fresh(wid0), lane = tid & 63, wave = tid >> 6, bid = bid_fresh(), G = grid_fresh();
    if (G == 256) {
        if (bid < 64) { const int s = 32 + (bid >> 3), hd = (bid >> 1) & 3, dir = bid & 1; gdn_chain(wid0, P, lds, e, s, hd, dir); }
        else { const int bb = bid - 64;
            for (int c = bb; c < 256; c += 192) { const int s = c >> 3, hd = (c >> 1) & 3, dir = c & 1; gdn_chain(wid0, P, lds, e, s, hd, dir); }
            for (int t = bb; t < 384; t += 192) { const int wt = t * 8 + wave; s5_task_main(P, lds + wave * S5_WLDS, lane, e, wt >> 5, wt & 31); } }
    } else {
        for (int c = bid; c < 320; c += G) { const int s = c < 64 ? 32 + (c >> 3) : ((c - 64) >> 3), hd = (c >> 1) & 3, dir = c & 1; gdn_chain(wid0, P, lds, e, s, hd, dir); }
        for (int t = bid; t < 384; t += G) { const int wt = t * 8 + wave; s5_task_main(P, lds + wave * S5_WLDS, lane, e, wt >> 5, wt & 31); }
    }
}
__device__ __forceinline__ void phase_fin_even(int wid0, const Params& P, LAS unsigned char* lds, int e) {
    const int tid = tid_fresh(wid0), lane = tid & 63, wave = tid >> 6;
    const int gw = bid_fresh() * NWAVES + wave, NGW = grid_fresh() * NWAVES;
    for (int wt = gw; wt < 2048; wt += NGW) s5_task_corr(P, lds + wave * S5_WLDS, lane, e, wt >> 5, wt & 31);
    const bf16* proj = (const bf16*)(P.ws + WS_BIG); const bf16* Of = (const bf16*)(P.ws + WS_H); const bf16* Ob = Of + (size_t)MT * 512; bf16* mixout = (bf16*)(P.ws + WS_MIX);
    for (int m = gw; m < MT; m += NGW) {
        const u32x4 a = *(const u32x4*)(Of + (size_t)m * 512 + lane * 8), bq = *(const u32x4*)(Ob + (size_t)m * 512 + lane * 8), z = *(const u32x4*)(proj + (size_t)m * NPROJ_E + 2560 + lane * 8);
        float o[8]; float ss = 0.f;
#pragma unroll
        for (int j = 0; j < 4; ++j) { o[2 * j] = bflo(a[j]) + bflo(bq[j]); o[2 * j + 1] = bfhi(a[j]) + bfhi(bq[j]); ss += o[2 * j] * o[2 * j] + o[2 * j + 1] * o[2 * j + 1]; }
        ss += shfl_i(ss, lane ^ 1); ss += shfl_i(ss, lane ^ 2); ss += shfl_i(ss, lane ^ 4); ss += shfl_i(ss, lane ^ 8);
        const float rs = rsqrtf(ss * (1.0f / 128.0f) + EPSF);
        const float* gn = P.in[I_GONORM] + e * 128 + (lane & 15) * 8;
        unsigned pw[4];
#pragma unroll
        for (int j = 0; j < 4; ++j) { const float z0 = bflo(z[j]), z1 = bfhi(z[j]); pw[j] = pk2(o[2 * j] * rs * gn[2 * j] * siluf_(z0), o[2 * j + 1] * rs * gn[2 * j + 1] * siluf_(z1)); }
        *(u32x4*)(mixout + (size_t)m * DM + 512 + lane * 8) = (u32x4){pw[0], pw[1], pw[2], pw[3]};
    }
}

__device__ __forceinline__ void phase_conv_odd(int wid0, const Params& P, int o) {
    const int tid = tid_fresh(wid0), lane = tid & 63, wave = tid >> 6;
    const int gw = bid_fresh() * NWAVES + wave, NGW = grid_fresh() * NWAVES;
    const bf16* proj = (const bf16*)(P.ws + WS_BIG); bf16* cx = (bf16*)(P.ws + WS_H);
    const float* cw = P.in[I_LCONVW] + (size_t)o * 4 * 1024; const float* cb = P.in[I_LCONVB] + o * 1024;
    for (int m = gw; m < MT; m += NGW) {
        const int t = m < MCTX ? (m & 255) : ((m - MCTX) & 2047); const int L = m < MCTX ? LCTX : LLAT;
#pragma unroll
        for (int h2 = 0; h2 < 2; ++h2) { const int ch = lane * 8 + 512 * h2;
            float acc[8];
#pragma unroll
            for (int j = 0; j < 8; ++j) acc[j] = cb[ch + j];
#pragma unroll
            for (int k = 0; k < 4; ++k) { const int tt = t - 1 + k; if (tt >= 0 && tt < L) { const u32x4 v = *(const u32x4*)(proj + (size_t)(m - 1 + k) * 2048 + ch);
#pragma unroll
                    for (int j = 0; j < 4; ++j) { acc[2 * j] += cw[k * 1024 + ch + 2 * j] * bflo(v[j]); acc[2 * j + 1] += cw[k * 1024 + ch + 2 * j + 1] * bfhi(v[j]); } } }
            *(u32x4*)(cx + (size_t)m * DM + ch) = (u32x4){pk2(acc[0], acc[1]), pk2(acc[2], acc[3]), pk2(acc[4], acc[5]), pk2(acc[6], acc[7])}; }
    }
}
__device__ __forceinline__ void phase_lru_scan(int wid0, const Params& P, int o, int d) {
    const int tid = tid_fresh(wid0), lane = tid & 63, wave = tid >> 6;
    const int gw = bid_fresh() * NWAVES + wave, NGW = grid_fresh() * NWAVES;
    const unsigned* G = (const unsigned*)(P.ws + WS_GATES); const bf16* proj = (const bf16*)(P.ws + WS_BIG); bf16* mixout = (bf16*)(P.ws + WS_MIX);
    for (int task = gw; task < 640; task += NGW) {
        int s, cg_;
        if (task < 128) { s = 32 + (task >> 4); cg_ = task & 15; } else { s = (task - 128) >> 4; cg_ = (task - 128) & 15; }
        const bool lat = s >= 32; const int b = lat ? s - 32 : s; const int L = lat ? LLAT : LCTX; const int m0 = lat ? MCTX + b * LLAT : s * LCTX;
        const int ch = cg_ * 64 + lane;
        float h = lat ? P.in[I_SLRU][(((size_t)b * 2 + o) * 2 + d) * 1024 + ch] : 0.f;
        for (int t0 = 0; t0 < L; t0 += 8) {
            unsigned gv[8]; float pv[8], yv[8];
#pragma unroll
            for (int i = 0; i < 8; ++i) { const int t = d ? L - 1 - (t0 + i) : t0 + i; const size_t m = (size_t)(m0 + t);
                gv[i] = G[m * DM + ch];
                if (d) { pv[i] = bf2f(mixout[m * DM + ch]); yv[i] = bf2f(proj[m * 2048 + 1024 + ch]); } }
#pragma unroll
            for (int i = 0; i < 8; ++i) { const int t = d ? L - 1 - (t0 + i) : t0 + i; const size_t m = (size_t)(m0 + t);
                h = exp2f(bflo(gv[i])) * h + bfhi(gv[i]);
                if (d) mixout[m * DM + ch] = (bf16)f2bf((pv[i] + h) * geluf_(yv[i])); else mixout[m * DM + ch] = (bf16)f2bf(h); }
        }
        if (!lat) P.out[OUT_LRU + (((size_t)b * 2 + o) * 2 + d) * 1024 + ch] = h;
    }
}
typedef const __attribute__((address_space(4))) Params* KParams;
__device__ __forceinline__ Params load_params(KParams q) { Params r;
#pragma unroll
    for (int i = 0; i < 40; ++i) r.in[i] = q->in[i];
    r.out = q->out; r.ws = q->ws; return r; }
#define FRESH() const int G = grid_fresh(), bid = bid_fresh(); (void)G; (void)bid; KParams pk_ = (KParams)__builtin_amdgcn_kernarg_segment_ptr(); asm volatile("" : "+s"(pk_)); const Params P = load_params(pk_); unsigned char* ws = P.ws; \
    const float* mod = (const float*)(ws + WS_MOD); bf16* H = (bf16*)(ws + WS_H); bf16* BIG = (bf16*)(ws + WS_BIG); bf16* MIX = (bf16*)(ws + WS_MIX); (void)mod; (void)H; (void)BIG; (void)MIX;
__global__ void __launch_bounds__(NTHR, 2) fwd_kernel(Params Parg) {
    extern __shared__ __attribute__((aligned(16))) unsigned char lds_raw[];
    LAS unsigned char* lds = (LAS unsigned char*)lds_raw;
    cg::grid_group grid = cg::this_grid();
    const int wid0 = __builtin_amdgcn_readfirstlane(threadIdx.x >> 6);

    { FRESH(); phase_prologue(wid0, P, lds); }
    grid.sync();
    { FRESH(); phase_modreduce(wid0, P); }
    grid.sync();
#pragma unroll 1
    for (int l = 0; l < 4; ++l) {
        { FRESH(); const float* modl = mod + (size_t)l * 9 * 6144;
        phase_rownorm(wid0, P, l == 0, MIX, modl - 9 * 6144, 5 * 1024, P.in[I_NMLPPOST] + (l > 0 ? (l - 1) * 1024 : 0), 1, P.in[I_NMIXPRE] + l * 1024, modl, 0, H); }
        grid.sync();
        const int eo = l >> 1;
        {
            FRESH();
            pg8::Gemm g; pg8::StaticOrder S; EpiBf16<0> E;
            if ((l & 1) == 0) { g = pg8::Gemm{H, (const bf16*)(ws + WS_WINE) + (size_t)eo * NB_E * 1024, MT, NB_E, 1024, 1024, 0, 0}; E = EpiBf16<0>{BIG, NPROJ_E, (float*)(ws + WS_AB)}; }
            else { g = pg8::Gemm{H, (const bf16*)(ws + WS_WINO) + (size_t)eo * 2048 * 1024, MT, 2048, 1024, 1024, 0, 0}; E = EpiBf16<0>{BIG, 2048, nullptr}; }
            S.init(g.M, g.N, G, bid);
            pg8::gemm_phase(wid0, lds, g, S, E);
        }
        grid.sync();
        if ((l & 1) == 0) {
            { FRESH(); phase_mix_even(wid0, P, lds, eo); }
            grid.sync();
            { FRESH(); phase_fin_even(wid0, P, lds, eo); }
            grid.sync();
        } else {
            { FRESH(); phase_conv_odd(wid0, P, eo); }
            grid.sync();
#pragma unroll 1
            for (int d = 0; d < 2; ++d) {
                { FRESH();
                pg8::Gemm g{H, (const bf16*)(ws + WS_WG) + (size_t)(eo * 2 + d) * 2048 * 256, MT, 2048, 256, 1024, 1, 1};
                EpiGates E{(unsigned*)(ws + WS_GATES), H, P.in[I_LBR] + (eo * 2 + d) * 1024, P.in[I_LBI] + (eo * 2 + d) * 1024, P.in[I_LLAM] + (eo * 2 + d) * 1024};
                pg8::StaticOrder S; S.init(g.M, g.N, G, bid);
                pg8::gemm_phase(wid0, lds, g, S, E); }
                grid.sync();
                { FRESH(); phase_lru_scan(wid0, P, eo, d); }
                grid.sync();
            }
        }
        {
            FRESH();
            pg8::Gemm g{MIX, (const bf16*)(ws + ((l & 1) ? WS_WOUTO : WS_WOUTE)) + (size_t)eo * 1024 * 1024, MT, 1024, 1024, 1024, 0, 0};
            EpiBf16<0> E{BIG, 1024, nullptr}; pg8::StaticOrder S; S.init(g.M, g.N, G, bid);
            pg8::gemm_phase(wid0, lds, g, S, E);
        }
        grid.sync();
        { FRESH(); const float* modl = mod + (size_t)l * 9 * 6144;
        phase_rownorm(wid0, P, 0, BIG, modl, 2 * 1024, P.in[I_NMIXPOST] + l * 1024, 1, P.in[I_NMLPPRE] + l * 1024, modl, 3 * 1024, H); }
        grid.sync();
        {
            FRESH();
            pg8::Gemm g{H, (const bf16*)(ws + WS_W1T) + (size_t)l * 4096 * 1024, MT, 4096, 1024, 1024, 0, 0};
            EpiBf16<1> E{BIG, 4096, nullptr}; pg8::StaticOrder S; S.init(g.M, g.N, G, bid);
            pg8::gemm_phase(wid0, lds, g, S, E);
        }
        grid.sync();
        {
            FRESH();
            pg8::Gemm g{BIG, (const bf16*)(ws + WS_W2T) + (size_t)l * 1024 * 4096, MT, 1024, 4096, 4096, 0, 0};
            EpiBf16<0> E{MIX, 1024, nullptr}; pg8::StaticOrder S; S.init(g.M, g.N, G, bid);
            pg8::gemm_phase(wid0, lds, g, S, E);
        }
        grid.sync();
    }
    { FRESH();
    phase_rownorm(wid0, P, 0, MIX, mod + (size_t)3 * 9 * 6144, 5 * 1024, P.in[I_NMLPPOST] + 3 * 1024, 0, P.in[I_NMIXPRE], mod, 0, H); }
}

extern "C" void kernel_launch(void* const* d_in, const int* in_sizes, int n_in, void* d_out, int out_size, void* d_ws, size_t ws_size, hipStream_t stream) {
    static int grid = 0;
    if (grid == 0) {
        if (n_in != 40 || ws_size < WS_END) { fprintf(stderr, "kernel_launch: expected 40 inputs and >= %zu bytes of workspace (got %d, %zu)\n", (size_t)WS_END, n_in, ws_size); grid = -1; return; }
        int dev = 0, cus = 0, per_cu = 0;
        if (hipGetDevice(&dev) != hipSuccess || hipDeviceGetAttribute(&cus, hipDeviceAttributeMultiprocessorCount, dev) != hipSuccess) { grid = -1; return; }
        if (hipFuncSetAttribute((const void*)fwd_kernel, hipFuncAttributeMaxDynamicSharedMemorySize, LDS_BYTES) != hipSuccess) { fprintf(stderr, "kernel_launch: hipFuncSetAttribute failed\n"); grid = -1; return; }
        if (hipOccupancyMaxActiveBlocksPerMultiprocessor(&per_cu, (const void*)fwd_kernel, NTHR, LDS_BYTES) != hipSuccess || per_cu < 1) per_cu = 1;
        (void)hipGetLastError();
        grid = cus * per_cu; if (grid > 256) grid = 256;
    }
    if (grid < 0) return;
    Params p{};
    for (int i = 0; i < 40; ++i) p.in[i] = (const float*)d_in[i];
    p.out = (float*)d_out; p.ws = (unsigned char*)d_ws;
    void* args[] = {&p};
    hipError_t e = hipLaunchCooperativeKernel((const void*)fwd_kernel, dim3(grid), dim3(NTHR), args, LDS_BYTES, stream);
    if (e != hipSuccess) fprintf(stderr, "cooperative launch failed: %s (grid %d)\n", hipGetErrorString(e), grid);
}
```

```cpp
#include <hip/hip_runtime.h>
#include <hip/hip_cooperative_groups.h>
#include <cstdio>
#include <cstdint>
namespace cg = cooperative_groups;
__device__ __forceinline__ int bid_fresh() { int t = blockIdx.x; asm volatile("" : "+s"(t)); return t; }
__device__ __forceinline__ int grid_fresh() { int t = gridDim.x; asm volatile("" : "+s"(t)); return t; }
__device__ __forceinline__ int tid_fresh(int w) { asm volatile("" : "+s"(w)); int l; asm volatile("v_mbcnt_lo_u32_b32 %0, -1, 0\n\tv_mbcnt_hi_u32_b32 %0, -1, %0" : "=v"(l)); return w * 64 + l; }

namespace pg8 {
#define PG8_LAS __attribute__((address_space(3)))
typedef unsigned short bf16_t;
typedef short bf16x8 __attribute__((ext_vector_type(8)));
typedef float f32x4 __attribute__((ext_vector_type(4)));
typedef unsigned u32x4 __attribute__((ext_vector_type(4)));
typedef unsigned u32x2 __attribute__((ext_vector_type(2)));
constexpr int BM = 256, BK = 64, HALF = 128, HTB = HALF * BK * 2, STAGE_BYTES = 8 * HTB, NXCD = 8, WGM = 8;

__host__ __device__ __forceinline__ int lds_byte(int r, int c) { const int st = (r >> 4) * 2 + (c >> 5), rr = r & 15, cc = c & 31, ob = rr * 64 + cc * 2; return st * 1024 + (ob ^ (((ob >> 9) & 1) << 5)); }
__host__ __device__ __forceinline__ void stage_rc(int b, int& R, int& C) { const int st = b / 1024, sb = b % 1024, swz = sb ^ (((sb >> 9) & 1) << 5); R = (st >> 1) * 16 + swz / 64; C = (st & 1) * 32 + (swz % 64) / 2; }
__host__ __device__ __forceinline__ int perm32(int rho) { const int n = rho >> 4, i = rho & 15; return 8 * (i >> 2) + 4 * n + (i & 3); }

struct Unit { int pm, pn; };
struct Gemm { const bf16_t* A; const bf16_t* Bt; int M, N, K, lda, ablk, ashift; };

struct StaticOrder {
    int nM, nN, nwg, G, c;
    __host__ __device__ void init(int M, int N, int G_, int c_) { nM = M / BM; nN = N / BM; nwg = nM * nN; G = G_; c = c_; }
    __host__ __device__ bool next(int i, Unit& u) const {
        const long L = (long)i * G + c; if (L >= nwg) return false;
        int wgid = (int)L; { const int q = nwg / NXCD, r = nwg % NXCD, xcd = wgid % NXCD, off = wgid / NXCD; wgid = (xcd < r ? xcd * (q + 1) : r * (q + 1) + (xcd - r) * q) + off; }
        const int nig = WGM * nN, gid = wgid / nig, fm = gid * WGM, gsz = (nM - fm) < WGM ? (nM - fm) : WGM;
        u.pm = fm + ((wgid % nig) % gsz); u.pn = (wgid % nig) / gsz; return true;
    }
};
__device__ __forceinline__ unsigned cvt_pk_bf16(float lo, float hi) { unsigned r; asm volatile("v_cvt_pk_bf16_f32 %0, %1, %2" : "=v"(r) : "v"(lo), "v"(hi)); return r; }

template <class Epi>
__device__ __forceinline__ void gemm_phase(int wid0, PG8_LAS unsigned char* lds, const Gemm g, const StaticOrder& S, const Epi& E) {
    const int tid = tid_fresh(wid0), wid = __builtin_amdgcn_readfirstlane(tid >> 6), lane = tid & 63, wr = wid >> 2, wc = wid & 3, fr = lane & 15, fq = lane >> 4;
    const int K = g.K, nt = K / BK, lda = g.lda;
    unsigned voffA[2], voffB[2];
#pragma unroll
    for (int i = 0; i < 2; ++i) { int R, C; stage_rc(tid * 16 + i * 8192, R, C); const int Rb = (R & ~31) + perm32(R & 31);
        voffA[i] = (unsigned)(R * lda + C) * 2u; voffB[i] = (unsigned)(Rb * K + C) * 2u; }
    const size_t kstep = (size_t)(BK * 2);
    const size_t hstepA = (size_t)HALF * lda * 2, hstepB = (size_t)HALF * K * 2;
    const size_t tstepA = 2 * hstepA, tstepB = 2 * hstepB;
    const unsigned ldsw = (unsigned)wid * 1024u;
    const int aoff = lds_byte(wr * 64 + fr, fq * 8), boff = lds_byte(wc * 32 + fr, fq * 8);
#define PG8_ACOL(pn) (g.ablk ? (size_t)((((pn) >> g.ashift) & 3) * 512) : (size_t)0)
#define PG8_SA(b, h) (((b) * 2 + (h)) * HTB)
#define PG8_SB(b, h) ((4 + (b) * 2 + (h)) * HTB)
#define PG8_STAGE(bufoff, gbase, voff) do { _Pragma("unroll") for (int _i = 0; _i < 2; ++_i) \
        __builtin_amdgcn_global_load_lds((const unsigned*)((const char*)(gbase) + (voff)[_i]), (PG8_LAS unsigned*)(lds + (bufoff) + ldsw + _i * 8192), 16, 0, 0); } while (0)
#define PG8_LDA(dst, b, h) do { _Pragma("unroll") for (int m = 0; m < 4; ++m) _Pragma("unroll") for (int k = 0; k < 2; ++k) dst[m][k] = *(const PG8_LAS bf16x8*)(lds + PG8_SA(b, h) + aoff + m * 2048 + k * 1024); } while (0)
#define PG8_LDB(dst, b, h) do { _Pragma("unroll") for (int n = 0; n < 2; ++n) _Pragma("unroll") for (int k = 0; k < 2; ++k) dst[n][k] = *(const PG8_LAS bf16x8*)(lds + PG8_SB(b, h) + boff + n * 2048 + k * 1024); } while (0)
#define PG8_MMA(ai, bj, At, Bt) do { __builtin_amdgcn_s_setprio(1); _Pragma("unroll") for (int m = 0; m < 4; ++m) _Pragma("unroll") for (int n = 0; n < 2; ++n) _Pragma("unroll") for (int k = 0; k < 2; ++k) \
        acc[ai][bj][m][n] = __builtin_amdgcn_mfma_f32_16x16x32_bf16(Bt[n][k], At[m][k], acc[ai][bj][m][n], 0, 0, 0); __builtin_amdgcn_s_setprio(0); } while (0)
#define PG8_WAIT_V(n) asm volatile("s_waitcnt vmcnt(" #n ")" ::: "memory")
#define PG8_WAIT_L(n) asm volatile("s_waitcnt lgkmcnt(" #n ")" ::: "memory")
#define PG8_BAR __builtin_amdgcn_s_barrier()
#define PG8_SCHED __builtin_amdgcn_sched_barrier(0)
    Unit cur, nxt; int ui = 0;
    if (!S.next(0, cur)) return;
    f32x4 acc[2][2][4][2];
#pragma unroll
    for (int a = 0; a < 2; ++a)
#pragma unroll
        for (int b = 0; b < 2; ++b)
#pragma unroll
            for (int m = 0; m < 4; ++m)
#pragma unroll
                for (int n = 0; n < 2; ++n) acc[a][b][m][n] = (f32x4){0.f, 0.f, 0.f, 0.f};
    bf16x8 At[4][2], B0[2][2], B1[2][2];
    const char* cA = (const char*)g.A + (size_t)cur.pm * tstepA + PG8_ACOL(cur.pn); const char* cB = (const char*)g.Bt + (size_t)cur.pn * tstepB;
    PG8_STAGE(PG8_SB(0, 0), cB, voffB); PG8_STAGE(PG8_SA(0, 0), cA, voffA); PG8_STAGE(PG8_SB(0, 1), cB + hstepB, voffB); PG8_STAGE(PG8_SA(0, 1), cA + hstepA, voffA);
    if (wr == 1) PG8_BAR;
    PG8_WAIT_V(4); PG8_BAR;
    PG8_STAGE(PG8_SB(1, 0), cB + kstep, voffB); PG8_STAGE(PG8_SA(1, 0), cA + kstep, voffA); PG8_STAGE(PG8_SB(1, 1), cB + hstepB + kstep, voffB);
    PG8_WAIT_V(6); PG8_BAR;
    for (;;) {
        const bool has_next = S.next(ui + 1, nxt);
        const char* nA = has_next ? (const char*)g.A + (size_t)nxt.pm * tstepA + PG8_ACOL(nxt.pn) : cA; const char* nB = has_next ? (const char*)g.Bt + (size_t)nxt.pn * tstepB : cB;
        for (int t = 0; t < nt; t += 2) {
            const bool last = (t == nt - 2);
            const char* a1 = cA + (size_t)(t + 1) * kstep;
            const char* a2 = last ? nA : cA + (size_t)(t + 2) * kstep; const char* b2 = last ? nB : cB + (size_t)(t + 2) * kstep;
            const char* a3 = a2 + kstep; const char* b3 = b2 + kstep;
            PG8_LDB(B0, 0, 0); PG8_SCHED; PG8_LDA(At, 0, 0); PG8_STAGE(PG8_SA(1, 1), a1 + hstepA, voffA);
            PG8_WAIT_L(8); PG8_BAR; PG8_WAIT_L(0); PG8_MMA(0, 0, At, B0); PG8_BAR; PG8_SCHED;
            PG8_LDB(B1, 0, 1); PG8_STAGE(PG8_SB(0, 0), b2, voffB);
            PG8_BAR; PG8_WAIT_L(0); PG8_MMA(0, 1, At, B1); PG8_BAR;
            PG8_LDA(At, 0, 1); PG8_STAGE(PG8_SA(0, 0), a2, voffA);
            PG8_BAR; PG8_WAIT_L(0); PG8_MMA(1, 0, At, B0); PG8_BAR; PG8_SCHED;
            PG8_STAGE(PG8_SB(0, 1), b2 + hstepB, voffB);
            PG8_WAIT_V(6); PG8_BAR; PG8_MMA(1, 1, At, B1); PG8_BAR;
            PG8_LDB(B0, 1, 0); PG8_SCHED; PG8_LDA(At, 1, 0); PG8_STAGE(PG8_SA(0, 1), a2 + hstepA, voffA);
            PG8_WAIT_L(8); PG8_BAR; PG8_WAIT_L(0); PG8_MMA(0, 0, At, B0); PG8_BAR; PG8_SCHED;
            PG8_LDB(B1, 1, 1); PG8_STAGE(PG8_SB(1, 0), b3, voffB);
            PG8_BAR; PG8_WAIT_L(0); PG8_MMA(0, 1, At, B1); PG8_BAR;
            PG8_LDA(At, 1, 1); PG8_STAGE(PG8_SA(1, 0), a3, voffA);
            PG8_BAR; PG8_WAIT_L(0); PG8_MMA(1, 0, At, B0); PG8_BAR; PG8_SCHED;
            PG8_STAGE(PG8_SB(1, 1), b3 + hstepB, voffB);
            PG8_WAIT_V(6); PG8_BAR; PG8_MMA(1, 1, At, B1); PG8_BAR;
        }
        E(acc, cur, wr, wc, fr, fq);
        if (!has_next) break;
#pragma unroll
        for (int a = 0; a < 2; ++a)
#pragma unroll
            for (int b = 0; b < 2; ++b)
#pragma unroll
                for (int m = 0; m < 4; ++m)
#pragma unroll
                    for (int n = 0; n < 2; ++n) acc[a][b][m][n] = (f32x4){0.f, 0.f, 0.f, 0.f};
        cur = nxt; cA = nA; cB = nB; ++ui;
    }
    PG8_WAIT_V(0);
    if (wr == 0) PG8_BAR;
    PG8_BAR;
#undef PG8_ACOL
#undef PG8_SA
#undef PG8_SB
#undef PG8_STAGE
#undef PG8_LDA
#undef PG8_LDB
#undef PG8_MMA
#undef PG8_WAIT_V
#undef PG8_WAIT_L
#undef PG8_BAR
#undef PG8_SCHED
}
}
#define LAS __attribute__((address_space(3)))
typedef unsigned short bf16;
typedef short bf16x8 __attribute__((ext_vector_type(8)));
typedef float f32x4 __attribute__((ext_vector_type(4)));
typedef unsigned u32x4 __attribute__((ext_vector_type(4)));
typedef unsigned u32x2 __attribute__((ext_vector_type(2)));
constexpr int DM = 1024, MT = 24576, MCTX = 8192, LCTX = 256, LLAT = 2048, NWAVES = 8, NTHR = 512;
constexpr int NPROJ_E = 3072, NB_E = 3328, IN_EVEN_LD = 3088;
constexpr float EPSF = 1e-6f;
constexpr size_t MiB = 1u << 20;
constexpr size_t WS_MOD = 0, MOD_BYTES = 4 * 9 * 6144 * 4, WS_S5F = 1 * MiB, WS_AB = 3 * MiB, WS_W1T = 5 * MiB, WS_W2T = 37 * MiB, WS_WINE = 69 * MiB,
                 WS_WOUTE = 82 * MiB, WS_WINO = 86 * MiB, WS_WOUTO = 94 * MiB, WS_WG = 98 * MiB, WS_H = 102 * MiB, WS_BIG = 150 * MiB, WS_YBUF = 294 * MiB,
                 WS_GATES = 246 * MiB, WS_MIX = 342 * MiB, WS_END = 390 * MiB;
constexpr int LDS_BYTES = 147456;
constexpr size_t OUT_S5RE = 25165824, OUT_S5IM = OUT_S5RE + 262144, OUT_DELTA = OUT_S5IM + 262144, OUT_LRU = OUT_DELTA + 8388608;

struct Params { const float* in[40]; float* out; unsigned char* ws; };
enum { I_XP = 0, I_XS, I_S5RE, I_S5IM, I_SDELTA, I_SLRU, I_C, I_CCTX, I_WADA, I_BADA, I_NMIXPRE, I_NMIXPOST, I_NMLPPRE, I_NMLPPOST, I_WMLPIN, I_WMLPOUT, I_WINE, I_WOUTE,
       I_LAMRE, I_LAMIM, I_LOGDT, I_BRE, I_BIM, I_CRE, I_CIM, I_S5D, I_GCONVW, I_GCONVB, I_GALOG, I_GDTB, I_GONORM, I_WINO, I_WOUTO, I_LCONVW, I_LCONVB, I_LWR, I_LBR, I_LWI, I_LBI, I_LLAM };

__device__ __forceinline__ unsigned f2bf(float f) { unsigned u = __builtin_bit_cast(unsigned, f); return (u + 0x7fffu + ((u >> 16) & 1u)) >> 16; }
__device__ __forceinline__ unsigned pk2(float lo, float hi) { return f2bf(lo) | (f2bf(hi) << 16); }
__device__ __forceinline__ float bflo(unsigned w) { return __builtin_bit_cast(float, w << 16); }
__device__ __forceinline__ float bfhi(unsigned w) { return __builtin_bit_cast(float, w & 0xffff0000u); }
__device__ __forceinline__ float bf2f(bf16 b) { return __builtin_bit_cast(float, (unsigned)b << 16); }
__device__ __forceinline__ float sigmoidf_(float x) { return 1.0f / (1.0f + __expf(-x)); }
__device__ __forceinline__ float siluf_(float x) { return x * sigmoidf_(x); }
__device__ __forceinline__ float softplusf_(float x) { return fmaxf(x, 0.f) + log1pf(__expf(-fabsf(x))); }
__device__ __forceinline__ float geluf_(float x) { const float y = 0.7978845608028654f * (x + 0.044715f * x * x * x); const float t = 1.0f - 2.0f / (__expf(2.0f * y) + 1.0f); return 0.5f * x * (1.0f + t); }
__device__ __forceinline__ float shfl_i(float v, int srclane) { return __builtin_bit_cast(float, __builtin_amdgcn_ds_bpermute(srclane << 2, __builtin_bit_cast(int, v))); }
__device__ __forceinline__ float wave_sum(float v, int lane) {
#pragma unroll
    for (int o = 1; o < 64; o <<= 1) v += shfl_i(v, lane ^ o);
    return v;
}
#define LDS_WAIT() asm volatile("s_waitcnt lgkmcnt(0)" ::: "memory")
#define WAVE_SYNC() do { asm volatile("s_waitcnt lgkmcnt(0)" ::: "memory"); __builtin_amdgcn_wave_barrier(); } while (0)
__device__ __forceinline__ f32x4 mfma16(bf16x8 a, bf16x8 b, f32x4 c) { return __builtin_amdgcn_mfma_f32_16x16x32_bf16(a, b, c, 0, 0, 0); }


#define XB_TMO      128
#define XB_XCNT(j)  (256  + 64 * (j))
#define XB_XSUB(j)  (1280 + 64 * (j))
#define XB_XGEN(j)  (2304 + 64 * (j))
#define XB_TOP      3328
#define XB_TOPGEN   3392
#define XCD_BAR_WORDS 3456
#define XB_SPIN_CAP (1u << 18)
constexpr size_t WS_BAR = 960 * 1024; constexpr int LDS_BARST = LDS_BYTES - 16;
__device__ __forceinline__ unsigned xb_ld(unsigned* p)              { return __hip_atomic_load(p, __ATOMIC_RELAXED, __HIP_MEMORY_SCOPE_AGENT); }
__device__ __forceinline__ unsigned xb_add(unsigned* p, unsigned v) { return __hip_atomic_fetch_add(p, v, __ATOMIC_RELAXED, __HIP_MEMORY_SCOPE_AGENT); }
__device__ __forceinline__ unsigned xb_xcc_id() { return (unsigned)__builtin_amdgcn_s_getreg((3 << 11) | 20) & 0xFu; }
#define XB_SPIN(cond, bar) do { unsigned _sp = 0; while (cond) { __builtin_amdgcn_s_sleep(1); \
    if ((++_sp & 255u) == 0u) { if (xb_ld(&(bar)[XB_TMO])) break; if (_sp > XB_SPIN_CAP) { atomicAdd(&(bar)[XB_TMO], 1u); break; } } } } while (0)
__device__ __forceinline__ void xcd_barrier_complete(unsigned* bar, unsigned x, unsigned& nloc, unsigned& nx) {
    const unsigned G = gridDim.x;
    unsigned sum, cnt, mine, sp = 0u;
    for (;;) {
        sum = 0u; cnt = 0u; mine = 0u;
#pragma unroll
        for (unsigned j = 0; j < 16; ++j) { const unsigned c = xb_ld(&bar[XB_XCNT(j)]); sum += c; cnt += (c > 0u) ? 1u : 0u; mine = (j == x) ? c : mine; }
        if (sum == G) break;
        __builtin_amdgcn_s_sleep(1);
        if ((++sp & 255u) == 0u) { if (xb_ld(&bar[XB_TMO])) break; if (sp > XB_SPIN_CAP) { atomicAdd(&bar[XB_TMO], 1u); break; } }
    }
    nloc = mine > 0u ? mine : 1u; nx = cnt > 0u ? cnt : 1u;
}
__device__ __forceinline__ void xcd_barrier(int wid0, unsigned* bar, LAS unsigned char* lds) {
    const int tid = tid_fresh(wid0);
    asm volatile("s_waitcnt vmcnt(0)" ::: "memory");
    __syncthreads();
    if (tid == 0) {
        const unsigned x = xb_xcc_id();
        volatile LAS unsigned* st = (volatile LAS unsigned*)(lds + LDS_BARST);
        __builtin_amdgcn_s_waitcnt(0);
        unsigned nloc = st[0], nx = st[1];
        if (nloc == 0u) { xcd_barrier_complete(bar, x, nloc, nx); st[0] = nloc; st[1] = nx; }
        const unsigned old = xb_add(&bar[XB_XSUB(x)], 1u);
        const unsigned gen = old / nloc;
        if (old + 1u == (gen + 1u) * nloc) {
            __builtin_amdgcn_fence(__ATOMIC_RELEASE, "agent");
            asm volatile("s_waitcnt vmcnt(0)" ::: "memory");
            const unsigned og = xb_add(&bar[XB_TOP], 1u);
            const unsigned tg = og / nx;
            if (og + 1u == (tg + 1u) * nx) xb_add(&bar[XB_TOPGEN], 1u);
            else XB_SPIN(xb_ld(&bar[XB_TOPGEN]) == tg, bar);
            __builtin_amdgcn_fence(__ATOMIC_ACQUIRE, "agent");
            xb_add(&bar[XB_XGEN(x)], 1u);
            asm volatile("s_waitcnt vmcnt(0)" ::: "memory");
        } else {
            XB_SPIN(xb_ld(&bar[XB_XGEN(x)]) == gen, bar);
            __builtin_amdgcn_fence(__ATOMIC_ACQUIRE, "agent");
            asm volatile("s_waitcnt vmcnt(0)" ::: "memory");
        }
    }
    __syncthreads();
}
__device__ __forceinline__ void transpose_item(const float* W, int ldw, int nvalid, int K, bf16* WT, int dst_row0, LAS float* scr, int k0, int n0, int lane) {
    const int nn = n0 + (lane & 31); const bool ok = nn < nvalid;
#pragma unroll 8
    for (int i = 0; i < 32; ++i) { const int kk = 2 * i + (lane >> 5); scr[kk * 33 + (lane & 31)] = ok ? W[(size_t)(k0 + kk) * ldw + nn] : 0.f; }
    WAVE_SYNC();
    const int c = lane & 7;
#pragma unroll
    for (int j = 0; j < 4; ++j) { const int n = (lane >> 3) + 8 * j; const LAS float* s = scr + (8 * c) * 33 + n;
        u32x4 o; o.x = pk2(s[0 * 33], s[1 * 33]); o.y = pk2(s[2 * 33], s[3 * 33]); o.z = pk2(s[4 * 33], s[5 * 33]); o.w = pk2(s[6 * 33], s[7 * 33]);
        *(u32x4*)(WT + (size_t)(dst_row0 + n) * K + k0 + 8 * c) = o; }
    WAVE_SYNC();
}
__device__ __forceinline__ void phase_prologue(int wid0, const Params& P, LAS unsigned char* lds) {
    const int tid = tid_fresh(wid0), lane = tid & 63, wave = tid >> 6;
    LAS float* scr = (LAS float*)(lds + wave * 16384);
    const int gw = bid_fresh() * NWAVES + wave, NGW = grid_fresh() * NWAVES;
    unsigned char* ws = P.ws;
    constexpr int NA = 8192, NB = 8192, NC = 2 * 16 * 97, ND = 1024, NE = 2048, NF = 1024, NG = 1024, NTR = NA + NB + NC + ND + NE + NF + NG, NMOD = 4 * 24 * 16;
    for (int it = gw; it < NTR + NMOD; it += NGW) {
        int r = it;
        if (r < NA) { const int l = r >> 11, q = r & 2047; transpose_item(P.in[I_WMLPIN] + (size_t)l * 1024 * 4096, 4096, 4096, 1024, (bf16*)(ws + WS_W1T) + (size_t)l * 4096 * 1024, 32 * (q & 127), scr, 64 * (q >> 7), 32 * (q & 127), lane); continue; } r -= NA;
        if (r < NB) { const int l = r >> 11, q = r & 2047; transpose_item(P.in[I_WMLPOUT] + (size_t)l * 4096 * 1024, 1024, 1024, 4096, (bf16*)(ws + WS_W2T) + (size_t)l * 1024 * 4096, 32 * (q & 31), scr, 64 * (q >> 5), 32 * (q & 31), lane); continue; } r -= NB;
        if (r < NC) { const int e = r / 1552, q = r % 1552, kb = q / 97, nb = q % 97; transpose_item(P.in[I_WINE] + (size_t)e * 1024 * IN_EVEN_LD, IN_EVEN_LD, IN_EVEN_LD, 1024, (bf16*)(ws + WS_WINE) + (size_t)e * NB_E * 1024, 32 * nb, scr, 64 * kb, 32 * nb, lane); continue; } r -= NC;
        if (r < ND) { const int e = r >> 9, q = r & 511; transpose_item(P.in[I_WOUTE] + (size_t)e * 1024 * 1024, 1024, 1024, 1024, (bf16*)(ws + WS_WOUTE) + (size_t)e * 1024 * 1024, 32 * (q & 31), scr, 64 * (q >> 5), 32 * (q & 31), lane); continue; } r -= ND;
        if (r < NE) { const int o = r >> 10, q = r & 1023; transpose_item(P.in[I_WINO] + (size_t)o * 1024 * 2048, 2048, 2048, 1024, (bf16*)(ws + WS_WINO) + (size_t)o * 2048 * 1024, 32 * (q & 63), scr, 64 * (q >> 6), 32 * (q & 63), lane); continue; } r -= NE;
        if (r < NF) { const int o = r >> 9, q = r & 511; transpose_item(P.in[I_WOUTO] + (size_t)o * 1024 * 1024, 1024, 1024, 1024, (bf16*)(ws + WS_WOUTO) + (size_t)o * 1024 * 1024, 32 * (q & 31), scr, 64 * (q >> 5), 32 * (q & 31), lane); continue; } r -= NF;
        if (r < NG) { const int mat = r >> 5, q = r & 31, kb = q >> 3, nb = q & 7; const int blk = mat & 3, gate = (mat >> 2) & 1, od = mat >> 3;
            const float* src = (gate ? P.in[I_LWI] : P.in[I_LWR]) + (size_t)(od * 4 + blk) * 65536;
            const int j0 = nb * 32; const int drow = (blk * 2 + (j0 >> 7)) * 256 + gate * 128 + (j0 & 127);
            transpose_item(src, 256, 256, 256, (bf16*)(ws + WS_WG) + (size_t)od * 2048 * 256, drow - j0 + j0, scr, 64 * kb, j0, lane);
            continue; } r -= NG;
        {
            const int l = r / 384, rem = r % 384, ec = rem >> 4, ks = rem & 15, k0 = ks * 64;
#pragma unroll
            for (int rr = 0; rr < 9; ++rr) { const float cv = rr == 0 ? P.in[I_CCTX][k0 + lane] : P.in[I_C][(rr - 1) * 1024 + k0 + lane]; scr[rr * 64 + lane] = siluf_(cv); }
            WAVE_SYNC();
            f32x4 acc[9];
#pragma unroll
            for (int rr = 0; rr < 9; ++rr) acc[rr] = (f32x4){0.f, 0.f, 0.f, 0.f};
            const float* wp = P.in[I_WADA] + ((size_t)l * 1024 + k0) * 6144 + ec * 256 + lane * 4;
#pragma unroll 4
            for (int kk = 0; kk < 64; ++kk) { const f32x4 w4 = *(const f32x4*)(wp + (size_t)kk * 6144);
#pragma unroll
                for (int rr = 0; rr < 9; ++rr) acc[rr] += w4 * scr[rr * 64 + kk]; }
            float* part = (float*)(ws + WS_BIG) + ((size_t)(ks * 4 + l) * 9) * 6144 + ec * 256 + lane * 4;
#pragma unroll
            for (int rr = 0; rr < 9; ++rr) *(f32x4*)(part + (size_t)rr * 6144) = acc[rr];
            WAVE_SYNC();
        }
    }
    { u32x4* z = (u32x4*)0; (void)z;
      const size_t per = (size_t)(NB_E - 3104) * 1024 * 2 / 16;
      for (size_t i = (size_t)bid_fresh() * NTHR + tid; i < 2 * per; i += (size_t)grid_fresh() * NTHR) { const size_t e = i / per, q = i % per;
          *(u32x4*)(ws + WS_WINE + (e * NB_E + 3104) * 1024 * 2 + q * 16) = (u32x4){0u, 0u, 0u, 0u}; } }
}

__device__ __forceinline__ void phase_modreduce(int wid0, const Params& P) {
    const int tid = tid_fresh(wid0);
    const float* part = (const float*)(P.ws + WS_BIG); float* mod = (float*)(P.ws + WS_MOD);
    for (int i = bid_fresh() * NTHR + tid; i < 4 * 9 * 6144 / 4; i += grid_fresh() * NTHR) {
        const int l = i / (9 * 1536), e4 = i % 1536;
        f32x4 a = *(const f32x4*)(P.in[I_BADA] + (size_t)l * 6144 + e4 * 4);
#pragma unroll
        for (int ks = 0; ks < 16; ++ks) a += *(const f32x4*)(part + (size_t)ks * 4 * 9 * 6144 + (size_t)i * 4);
        *(f32x4*)(mod + (size_t)i * 4) = a; }
}
__device__ __forceinline__ void phase_rownorm(int wid0, const Params& P, int first, const bf16* obuf, const float* modg, int goff, const float* gpost, int has_next, const float* gpre, const float* mods, int soff, bf16* H) {
    const int tid = tid_fresh(wid0), lane = tid & 63, wave = tid >> 6;
    const int gw = bid_fresh() * NWAVES + wave, NGW = grid_fresh() * NWAVES;
    float* X = P.out;
    for (int m = gw; m < MT; m += NGW) {
        const int modrow = m < MCTX ? 0 : 1 + ((m - MCTX) >> 11);
        const float* mr = modg + (size_t)modrow * 6144; const float* ms = mods + (size_t)modrow * 6144;
        f32x4 x[4];
        if (first) {
            if (m < MCTX) {
#pragma unroll
                for (int j = 0; j < 4; ++j) x[j] = *(const f32x4*)(P.in[I_XP] + (size_t)m * DM + lane * 4 + 256 * j);
            } else {
                const int t = (m - MCTX) & 2047; const float prow = (float)(t >> 6), pcol = (float)(t & 63);
                f32x4 om;
#pragma unroll
                for (int e = 0; e < 4; ++e) om[e] = exp2f(-(float)(lane * 4 + e) * (13.287712379549449f / 256.0f));
#pragma unroll
                for (int j = 0; j < 4; ++j) { x[j] = *(const f32x4*)(P.in[I_XS] + (size_t)(m - MCTX) * DM + lane * 4 + 256 * j);
#pragma unroll
                    for (int e = 0; e < 4; ++e) { const float a = (j < 2 ? prow : pcol) * om[e]; x[j][e] += (j & 1) ? cosf(a) : sinf(a); } }
            }
        } else {
            u32x2 ov[4]; float ss = 0.f;
#pragma unroll
            for (int j = 0; j < 4; ++j) { x[j] = *(const f32x4*)(X + (size_t)m * DM + lane * 4 + 256 * j); ov[j] = *(const u32x2*)(obuf + (size_t)m * DM + lane * 4 + 256 * j); }
#pragma unroll
            for (int j = 0; j < 4; ++j) { const float a = bflo(ov[j].x), b = bfhi(ov[j].x), c = bflo(ov[j].y), d = bfhi(ov[j].y); ss += (a * a + b * b) + (c * c + d * d); }
            const float rs = rsqrtf(wave_sum(ss, lane) * (1.0f / DM) + EPSF);
#pragma unroll
            for (int j = 0; j < 4; ++j) { const f32x4 g4 = *(const f32x4*)(gpost + lane * 4 + 256 * j), gt = *(const f32x4*)(mr + goff + lane * 4 + 256 * j);
                f32x4 o4 = (f32x4){bflo(ov[j].x), bfhi(ov[j].x), bflo(ov[j].y), bfhi(ov[j].y)};
                x[j] += gt * (o4 * rs * g4); }
        }
#pragma unroll
        for (int j = 0; j < 4; ++j) *(f32x4*)(X + (size_t)m * DM + lane * 4 + 256 * j) = x[j];
        if (has_next) {
            float ss = 0.f;
#pragma unroll
            for (int j = 0; j < 4; ++j) ss += (x[j][0] * x[j][0] + x[j][1] * x[j][1]) + (x[j][2] * x[j][2] + x[j][3] * x[j][3]);
            const float rs = rsqrtf(wave_sum(ss, lane) * (1.0f / DM) + EPSF);
#pragma unroll
            for (int j = 0; j < 4; ++j) { const f32x4 g4 = *(const f32x4*)(gpre + lane * 4 + 256 * j), sh = *(const f32x4*)(ms + soff + lane * 4 + 256 * j), sc = *(const f32x4*)(ms + soff + 1024 + lane * 4 + 256 * j);
                const f32x4 h4 = (x[j] * rs * g4) * (sc + 1.0f) + sh;
                u32x2 w; w.x = pk2(h4[0], h4[1]); w.y = pk2(h4[2], h4[3]);
                *(u32x2*)(H + (size_t)m * DM + lane * 4 + 256 * j) = w; }
        }
    }
}

using pg8::Unit;
template <int ACT  > struct EpiBf16 {
    bf16* O; int ldc; float* AB;
    __device__ __forceinline__ void operator()(const f32x4 (&acc)[2][2][4][2], const Unit& u, int wr, int wc, int fr, int fq) const {
        const int row0 = u.pm * 256 + wr * 64 + fr, col0 = u.pn * 256 + wc * 32 + 8 * fq;
        if (AB && u.pn * 256 >= ldc) {
            if (wc == 0 && fq < 2) {
#pragma unroll
                for (int ai = 0; ai < 2; ++ai)
#pragma unroll
                    for (int m = 0; m < 4; ++m) { float* p = AB + (size_t)(row0 + ai * 128 + m * 16) * 16 + 8 * fq; *(f32x4*)p = acc[ai][0][m][0]; *(f32x4*)(p + 4) = acc[ai][0][m][1]; }
            }
            return;
        }
#pragma unroll
        for (int ai = 0; ai < 2; ++ai)
#pragma unroll
            for (int m = 0; m < 4; ++m) { bf16* rowp = O + (size_t)(row0 + ai * 128 + m * 16) * ldc + col0;
#pragma unroll
                for (int bj = 0; bj < 2; ++bj) { f32x4 v0 = acc[ai][bj][m][0], v1 = acc[ai][bj][m][1];
                    if (ACT == 1) {
#pragma unroll
                        for (int j = 0; j < 4; ++j) { const float a = fmaxf(v0[j], 0.f), b = fmaxf(v1[j], 0.f); v0[j] = a * a; v1[j] = b * b; } }
                    u32x4 w; w.x = pg8::cvt_pk_bf16(v0[0], v0[1]); w.y = pg8::cvt_pk_bf16(v0[2], v0[3]); w.z = pg8::cvt_pk_bf16(v1[0], v1[1]); w.w = pg8::cvt_pk_bf16(v1[2], v1[3]);
                    *(u32x4*)(rowp + bj * 128) = w; } }
    }
};
struct EpiGates {
    unsigned* G; const bf16* X; const float* br; const float* bi; const float* lam;
    __device__ __forceinline__ void operator()(const f32x4 (&acc)[2][2][4][2], const Unit& u, int wr, int wc, int fr, int fq) const {
        const int row0 = u.pm * 256 + wr * 64 + fr, ch0 = u.pn * 128 + wc * 32 + 8 * fq;
#pragma unroll
        for (int n = 0; n < 2; ++n) {
            const f32x4 vbr = *(const f32x4*)(br + ch0 + 4 * n), vbi = *(const f32x4*)(bi + ch0 + 4 * n), l4 = *(const f32x4*)(lam + ch0 + 4 * n);
            f32x4 vsp;
#pragma unroll
            for (int e = 0; e < 4; ++e) vsp[e] = -8.0f * softplusf_(-l4[e]);
#pragma unroll
            for (int ai = 0; ai < 2; ++ai)
#pragma unroll
                for (int m = 0; m < 4; ++m) { const size_t row = (size_t)(row0 + ai * 128 + m * 16);
                    const u32x2 xv = *(const u32x2*)(X + row * DM + ch0 + 4 * n);
                    const float xs[4] = {bflo(xv.x), bfhi(xv.x), bflo(xv.y), bfhi(xv.y)};
                    u32x4 w;
#pragma unroll
                    for (int e = 0; e < 4; ++e) { const float r = sigmoidf_(acc[ai][0][m][n][e] + vbr[e]), ig = sigmoidf_(acc[ai][1][m][n][e] + vbi[e]);
                        const float la = r * vsp[e]; const float b = sqrtf(fmaxf(-expm1f(2.0f * la), 0.f)) * ig * xs[e];
                        w[e] = pk2(la * 1.4426950408889634f, b); }
                    *(u32x4*)(G + row * DM + ch0 + 4 * n) = w; }
        }
    }
};
constexpr int S5_WLDS = 12800, BU_P = 132, HS_P = 136;
struct S5Dir { float ar, ai; bf16x8 Bf[8]; };
__device__ __forceinline__ void s5_dir_setup(const Params& P, int e, int d, int g, int lane, float& ar, float& ai, bf16x8 (&Bf)[8], bool needB) {
    const int quad = lane >> 4, l15 = lane & 15;
    const float dt = __expf(P.in[I_LOGDT][(e * 2 + d) * 32 + g]);
    const float lr = P.in[I_LAMRE][((e * 2 + d) * 32 + g) * 64 + lane], li = P.in[I_LAMIM][((e * 2 + d) * 32 + g) * 64 + lane];
    const float mag = expf(lr * dt); ar = mag * cosf(li * dt); ai = mag * sinf(li * dt);
    const float den = lr * lr + li * li;
    const float fr = ((ar - 1.0f) * lr + ai * li) / den, fi = (ai * lr - (ar - 1.0f) * li) / den;
    if (needB) {
#pragma unroll
        for (int nt = 0; nt < 8; ++nt) { const int col = 16 * nt + l15, p = col & 63;
            const float frp = shfl_i(fr, p), fip = shfl_i(fi, p);
            bf16x8 v = (bf16x8){0, 0, 0, 0, 0, 0, 0, 0};
            if (quad < 2) { const float* bre = P.in[I_BRE] + ((size_t)(e * 32 + g) * 64 + p) * 16 + quad * 8; const float* bim = P.in[I_BIM] + ((size_t)(e * 32 + g) * 64 + p) * 16 + quad * 8;
#pragma unroll
                for (int j = 0; j < 8; ++j) { const float br = bre[j], bi = bim[j]; const float val = (nt < 4) ? (frp * br - fip * bi) : (frp * bi + fip * br); v[j] = (short)f2bf(val); } }
            Bf[nt] = v; }
    }
}
__device__ __forceinline__ void s5_c_setup(const Params& P, int e, int g, int lane, bf16x8 (&Cf)[4]) {
    const int quad = lane >> 4, l15 = lane & 15;
#pragma unroll
    for (int ks = 0; ks < 4; ++ks) { const int col0 = 32 * ks + quad * 8; const bool im = col0 >= 64;
        const float* src = (im ? P.in[I_CIM] : P.in[I_CRE]) + ((size_t)(e * 32 + g) * 16 + l15) * 64 + (col0 & 63);
        bf16x8 v;
#pragma unroll
        for (int j = 0; j < 8; ++j) v[j] = (short)f2bf(im ? -src[j] : src[j]);
        Cf[ks] = v; }
}
__device__ __forceinline__ void s5_scan_seg(const Params& P, LAS unsigned char* wl, int lane, int d, int g, int m0, float ar, float ai, const bf16x8 (&Bf)[8], const bf16x8 (&Cf)[4],
                                            float& hr, float& hi, int mode, int ymode, const bf16* proj, float* ybuf, bf16* mixout, float dsk) {
    const int quad = lane >> 4, l15 = lane & 15;
    LAS float* BU = (LAS float*)wl; LAS bf16* HS = (LAS bf16*)(wl + 8448);
    for (int bi_ = 0; bi_ < 16; ++bi_) {
        const int blk = d ? 15 - bi_ : bi_;
        const int mb = m0 + 16 * blk;
        if (mode == 0) {
            bf16x8 a = (bf16x8){0, 0, 0, 0, 0, 0, 0, 0};
            if (quad < 2) { const int tt = d ? 15 - l15 : l15; a = *(const bf16x8*)(proj + (size_t)(mb + tt) * NPROJ_E + g * 16 + quad * 8); }
#pragma unroll
            for (int nt = 0; nt < 8; ++nt) { f32x4 acc = mfma16(a, Bf[nt], (f32x4){0.f, 0.f, 0.f, 0.f});
#pragma unroll
                for (int jj = 0; jj < 4; ++jj) BU[(quad * 4 + jj) * BU_P + 16 * nt + l15] = acc[jj]; }
            WAVE_SYNC();
        }
#pragma unroll
        for (int r = 0; r < 16; ++r) {
            float br = 0.f, bim = 0.f;
            if (mode == 0) { br = BU[r * BU_P + lane]; bim = BU[r * BU_P + 64 + lane]; }
            const float nr = ar * hr - ai * hi + br, ni = ar * hi + ai * hr + bim; hr = nr; hi = ni;
            HS[r * HS_P + lane] = (bf16)f2bf(hr); HS[r * HS_P + 64 + lane] = (bf16)f2bf(hi);
        }
        WAVE_SYNC();
        f32x4 y = (f32x4){0.f, 0.f, 0.f, 0.f};
#pragma unroll
        for (int ks = 0; ks < 4; ++ks) { const bf16x8 a = *(const LAS bf16x8*)(HS + l15 * HS_P + 32 * ks + quad * 8); y = mfma16(a, Cf[ks], y); }
        const int ch = g * 16 + l15;
#pragma unroll
        for (int jj = 0; jj < 4; ++jj) { const int row = quad * 4 + jj; const int tt = d ? 15 - row : row; const size_t m = (size_t)(mb + tt);
            float v = y[jj];
            if (ymode == 0) { v += dsk * bf2f(proj[m * NPROJ_E + ch]); ybuf[m * 512 + ch] = v; }
            else { v += ybuf[m * 512 + ch];
                if (ymode == 1) ybuf[m * 512 + ch] = v;
                else { const float z = bf2f(proj[m * NPROJ_E + 512 + ch]); mixout[m * DM + ch] = (bf16)f2bf(geluf_(v) * sigmoidf_(z)); } }
        }
        WAVE_SYNC();
    }
}
__device__ __forceinline__ void s5_task_main(const Params& P, LAS unsigned char* wl, int lane, int e, int sub, int g) {
    const bf16* proj = (const bf16*)(P.ws + WS_BIG); float* ybuf = (float*)(P.ws + WS_YBUF); bf16* mixout = (bf16*)(P.ws + WS_MIX);
    const bool lat = sub >= 32; const int q = sub - 32, b = lat ? (q >> 3) : sub, seg = lat ? (q & 7) : 0;
    const int m0 = lat ? MCTX + b * LLAT + seg * 256 : sub * 256;
    bf16x8 Cf[4]; s5_c_setup(P, e, g, lane, Cf);
    const float dsk = P.in[I_S5D][e * 512 + g * 16 + (lane & 15)];
#pragma unroll 1
    for (int d = 0; d < 2; ++d) {
        float ar, ai; bf16x8 Bf[8]; s5_dir_setup(P, e, d, g, lane, ar, ai, Bf, true);
        float hr = 0.f, hi = 0.f;
        if (lat && ((d == 0 && seg == 0) || (d == 1 && seg == 7))) { const size_t si = ((((size_t)b * 2 + e) * 2 + d) * 32 + g) * 64 + lane; hr = P.in[I_S5RE][si]; hi = P.in[I_S5IM][si]; }
        const int ymode = d == 0 ? 0 : (lat ? 1 : 2);
        s5_scan_seg(P, wl, lane, d, g, m0, ar, ai, Bf, Cf, hr, hi, 0, ymode, proj, ybuf, mixout, dsk);
        if (!lat) { const size_t si = ((((size_t)b * 2 + e) * 2 + d) * 32 + g) * 64 + lane; P.out[OUT_S5RE + si] = hr; P.out[OUT_S5IM + si] = hi; }
        else { float* F = (float*)(P.ws + WS_S5F) + ((((size_t)d * 64 + q) * 32 + g) * 64 + lane) * 2; F[0] = hr; F[1] = hi; }
    }
}
__device__ __forceinline__ void s5_task_corr(const Params& P, LAS unsigned char* wl, int lane, int e, int q, int g) {
    const bf16* proj = (const bf16*)(P.ws + WS_BIG); float* ybuf = (float*)(P.ws + WS_YBUF); bf16* mixout = (bf16*)(P.ws + WS_MIX);
    const int b = q >> 3, seg = q & 7, m0 = MCTX + b * LLAT + seg * 256;
    bf16x8 Cf[4]; s5_c_setup(P, e, g, lane, Cf);
    bf16x8 Bf[8];
#pragma unroll
    for (int i = 0; i < 8; ++i) Bf[i] = (bf16x8){0, 0, 0, 0, 0, 0, 0, 0};
    const float* Fb = (const float*)(P.ws + WS_S5F);
#pragma unroll 1
    for (int d = 0; d < 2; ++d) {
        float ar, ai; s5_dir_setup(P, e, d, g, lane, ar, ai, Bf, false);
        float pr = ar, pi = ai;
#pragma unroll
        for (int i = 0; i < 8; ++i) { const float nr = pr * pr - pi * pi, ni = 2.0f * pr * pi; pr = nr; pi = ni; }
        float hr = 0.f, hi = 0.f;
        const int cnt = d == 0 ? seg : 7 - seg;
        for (int i = 0; i < cnt; ++i) { const int sj = d == 0 ? i : 7 - i; const float* F = Fb + ((((size_t)d * 64 + b * 8 + sj) * 32 + g) * 64 + lane) * 2;
            const float nr = pr * hr - pi * hi + F[0], ni = pr * hi + pi * hr + F[1]; hr = nr; hi = ni; }
        if (cnt > 0) s5_scan_seg(P, wl, lane, d, g, m0, ar, ai, Bf, Cf, hr, hi, 1, 1, proj, ybuf, mixout, 0.f);
    }
    __builtin_amdgcn_wave_barrier();
    for (int i = lane; i < 256 * 16; i += 64) { const size_t m = (size_t)(m0 + (i >> 4)); const int ch = g * 16 + (i & 15);
        const float v = ybuf[m * 512 + ch]; const float z = bf2f(proj[m * NPROJ_E + 512 + ch]);
        mixout[m * DM + ch] = (bf16)f2bf(geluf_(v) * sigmoidf_(z)); }
}

constexpr int G_Q = 0, G_K = 17408, G_V = 34816, G_KT = 52224, G_LM = 70656, G_QK = 89088, G_ST = 98304, G_SM = 133120;
constexpr int P128 = 136, P64 = 72, LMP = 68;
__device__ __forceinline__ void gdn_chain(int wid0, const Params& P, LAS unsigned char* lds, int e, int s, int hd, int dir) {
    const int tid = tid_fresh(wid0), lane = tid & 63, w = __builtin_amdgcn_readfirstlane(tid >> 6), quad = lane >> 4, l15 = lane & 15;
    const bool lat = s >= 32; const int b = lat ? s - 32 : s; const int L = lat ? LLAT : LCTX; const int m0 = lat ? MCTX + b * LLAT : s * LCTX;
    const bf16* proj = (const bf16*)(P.ws + WS_BIG); const float* AB = (const float*)(P.ws + WS_AB);
    bf16* Odir = (bf16*)(P.ws + WS_H) + (size_t)dir * MT * 512;
    int zv; asm volatile("v_mov_b32 %0, 0" : "=v"(zv));
    lds += zv;
    LAS bf16* Qs = (LAS bf16*)(lds + G_Q); LAS bf16* Ks = (LAS bf16*)(lds + G_K); LAS bf16* Vs = (LAS bf16*)(lds + G_V); LAS bf16* KT = (LAS bf16*)(lds + G_KT);
    LAS float* Lm = (LAS float*)(lds + G_LM); LAS bf16* VNT = (LAS bf16*)(lds + G_LM); LAS bf16* QKs = (LAS bf16*)(lds + G_QK); LAS bf16* ST = (LAS bf16*)(lds + G_ST);
    LAS float* rq = (LAS float*)(lds + G_SM); LAS float* rk = rq + 64; LAS float* gcs = rq + 128; LAS float* betas = rq + 192; LAS float* egs = rq + 256; LAS float* kes = rq + 320;
    f32x4 Sacc[8];
    const size_t sbase = ((((size_t)b * 2 + e) * 2 + dir) * 4 + hd) * 16384;
#pragma unroll
    for (int mt = 0; mt < 8; ++mt) Sacc[mt] = (f32x4){0.f, 0.f, 0.f, 0.f};
    if (lat) { const float* sp = P.in[I_SDELTA] + sbase + (size_t)(quad * 4) * 128 + 16 * w + l15;
#pragma unroll
        for (int mt = 0; mt < 8; ++mt)
#pragma unroll
            for (int jj = 0; jj < 4; ++jj) Sacc[mt][jj] = sp[(16 * mt + jj) * 128]; }
#pragma unroll
    for (int mt = 0; mt < 8; ++mt) {
        u32x2 pw; pw.x = pk2(Sacc[mt][0], Sacc[mt][1]); pw.y = pk2(Sacc[mt][2], Sacc[mt][3]);
        *(LAS u32x2*)(ST + (16 * w + l15) * P128 + 16 * mt + quad * 4) = pw; }
    const float alog_e = __expf(P.in[I_GALOG][(e * 2 + dir) * 4 + hd]), dtb = P.in[I_GDTB][(e * 2 + dir) * 4 + hd];
    const int nchunk = L / 64;
#pragma unroll 1
    for (int ci = 0; ci < nchunk; ++ci) {
        const int c0 = dir ? L - 64 * (ci + 1) : 64 * ci;
        __syncthreads();
#ifndef NO_A
        { const int dd = tid & 127, tq = tid >> 7;
#pragma unroll 1
          for (int part = 0; part < 3; ++part) { const int ccol = part * 512 + hd * 128 + dd; const int pcol = 1024 + ccol;
              const float* cw = P.in[I_GCONVW] + (size_t)e * 4 * 1536 + ccol; const float w0 = cw[0], w1 = cw[1536], w2 = cw[3072], w3 = cw[4608], cb = P.in[I_GCONVB][e * 1536 + ccol];
              LAS bf16* dst = part == 0 ? Qs : (part == 1 ? Ks : Vs);
              const int tb = c0 + tq * 16;
              float xm1, x0, x1, x2;
              { const int t = tb - 1; xm1 = (t >= 0) ? bf2f(proj[(size_t)(m0 + t) * NPROJ_E + pcol]) : 0.f; }
              x0 = bf2f(proj[(size_t)(m0 + tb) * NPROJ_E + pcol]);
              { const int t = tb + 1; x1 = (t < L) ? bf2f(proj[(size_t)(m0 + t) * NPROJ_E + pcol]) : 0.f; }
#pragma unroll 4
              for (int n = 0; n < 16; ++n) { const int t = tb + n + 2; x2 = (t < L) ? bf2f(proj[(size_t)(m0 + t) * NPROJ_E + pcol]) : 0.f;
                  const float v = cb + w0 * xm1 + w1 * x0 + w2 * x1 + w3 * x2;
                  const int nn = tq * 16 + n; const int r = dir ? 63 - nn : nn;
                  dst[r * P128 + dd] = (bf16)f2bf(siluf_(v));
                  xm1 = x0; x0 = x1; x1 = x2; } } }
#endif
        __syncthreads();
        { const int rowid = tid >> 2, part = tid & 3; LAS bf16* src = (rowid < 64 ? Qs : Ks) + (rowid & 63) * P128 + part * 32;
          float ss = 0.f;
#pragma unroll
          for (int i = 0; i < 4; ++i) { const u32x4 v = *(const LAS u32x4*)(src + 8 * i);
#pragma unroll
              for (int j = 0; j < 4; ++j) { const float a = bflo(v[j]), c = bfhi(v[j]); ss += a * a + c * c; } }
          ss += shfl_i(ss, lane ^ 1); ss += shfl_i(ss, lane ^ 2);
          if (part == 0) { if (rowid < 64) rq[rowid] = rsqrtf(ss + EPSF) * 0.08838834764831845f; else rk[rowid - 64] = rsqrtf(ss + EPSF); }
          if (w == 0) { const int t = c0 + (dir ? 63 - lane : lane); const size_t m = (size_t)(m0 + t);
              const float araw = AB[m * 16 + dir * 4 + hd], braw = AB[m * 16 + 8 + dir * 4 + hd];
              const float gg = -alog_e * softplusf_(araw + dtb);
              float gc = gg;
#pragma unroll
              for (int o = 1; o < 64; o <<= 1) { const float t2 = shfl_i(gc, (lane - o) & 63); if (lane >= o) gc += t2; }
              const float glast = shfl_i(gc, 63);
              gcs[lane] = gc; betas[lane] = sigmoidf_(braw); egs[lane] = __expf(gc); kes[lane] = __expf(glast - gc);
              if (lane == 0) rq[384] = __expf(glast); } }
        __syncthreads();
#ifndef NO_C
        { const int mt = w & 3; const bool isq = w >= 4; LAS bf16* src = isq ? Qs : Ks;
          bf16x8 a[4];
#pragma unroll
          for (int ks = 0; ks < 4; ++ks) a[ks] = *(const LAS bf16x8*)(src + (16 * mt + l15) * P128 + 32 * ks + quad * 8);
#pragma unroll 1
          for (int nt = 0; nt < 4; ++nt) { f32x4 acc = (f32x4){0.f, 0.f, 0.f, 0.f};
#pragma unroll
              for (int ks = 0; ks < 4; ++ks) { const bf16x8 bb = *(const LAS bf16x8*)(Ks + (16 * nt + l15) * P128 + 32 * ks + quad * 8); acc = mfma16(a[ks], bb, acc); }
              const int j = 16 * nt + l15; const float rkj = rk[j], gcj = gcs[j];
              f32x4 lv;
#pragma unroll
              for (int jj = 0; jj < 4; ++jj) { const int i = 16 * mt + quad * 4 + jj; const float dec = __expf(fminf(gcs[i] - gcj, 0.f));
                  lv[jj] = (i > j) ? acc[jj] * rk[i] * rkj * betas[i] * dec : 0.f;
                  if (isq) QKs[i * P64 + j] = (bf16)f2bf((i >= j) ? acc[jj] * rq[i] * rkj * dec : 0.f); }
              if (!isq) *(LAS f32x4*)(Lm + j * LMP + 16 * mt + quad * 4) = lv; }
          const int dd = tid & 127, tq = tid >> 7;
          unsigned pw[8];
#pragma unroll
          for (int n = 0; n < 16; n += 2) { const int i0 = tq * 16 + n; const float v0 = bf2f(Ks[i0 * P128 + dd]) * rk[i0] * kes[i0], v1 = bf2f(Ks[(i0 + 1) * P128 + dd]) * rk[i0 + 1] * kes[i0 + 1]; pw[n >> 1] = pk2(v0, v1); }
          *(LAS u32x4*)(KT + dd * P64 + tq * 16) = (u32x4){pw[0], pw[1], pw[2], pw[3]};
          *(LAS u32x4*)(KT + dd * P64 + tq * 16 + 8) = (u32x4){pw[4], pw[5], pw[6], pw[7]}; }
#endif
        __syncthreads();
#ifndef NO_D
        if (tid < 256) { const bool isv = tid < 128; const int cc = tid & 127; LAS bf16* col = (isv ? Vs : Ks) + cc;
#pragma unroll 1
            for (int bb = 0; bb < 4; ++bb) {
                float sx[16];
#pragma unroll
                for (int r = 0; r < 16; ++r) { const int i = 16 * bb + r; const float sc = isv ? betas[i] : rk[i] * betas[i] * egs[i]; sx[r] = bf2f(col[i * P128]) * sc; }
#pragma unroll 2
                for (int j = 0; j < 16 * bb; ++j) { const float xj = bf2f(col[j * P128]);
#pragma unroll
                    for (int q4 = 0; q4 < 4; ++q4) { const f32x4 l4 = *(const LAS f32x4*)(Lm + j * LMP + 16 * bb + 4 * q4);
#pragma unroll
                        for (int jx = 0; jx < 4; ++jx) sx[4 * q4 + jx] -= l4[jx] * xj; } }
#pragma unroll
                for (int rp = 0; rp < 15; ++rp) { const float xj = sx[rp];
#pragma unroll
                    for (int q4 = rp / 4; q4 < 4; ++q4) { const f32x4 l4 = *(const LAS f32x4*)(Lm + (16 * bb + rp) * LMP + 16 * bb + 4 * q4);
#pragma unroll
                        for (int jx = 0; jx < 4; ++jx) if (4 * q4 + jx > rp) sx[4 * q4 + jx] -= l4[jx] * xj; } }
#pragma unroll
                for (int r = 0; r < 16; ++r) col[(16 * bb + r) * P128] = (bf16)f2bf(sx[r]);
            } }
#endif
        __syncthreads();
#ifndef NO_EFG
        bf16x8 Bst[4];
#pragma unroll
        for (int ks = 0; ks < 4; ++ks) Bst[ks] = *(const LAS bf16x8*)(ST + (16 * w + l15) * P128 + 32 * ks + quad * 8);
#pragma unroll 1
        for (int mt = 0; mt < 4; ++mt) { f32x4 acc = (f32x4){0.f, 0.f, 0.f, 0.f};
#pragma unroll
            for (int ks = 0; ks < 4; ++ks) { const bf16x8 a = *(const LAS bf16x8*)(Ks + (16 * mt + l15) * P128 + 32 * ks + quad * 8); acc = mfma16(a, Bst[ks], acc); }
            float vn[4];
#pragma unroll
            for (int jj = 0; jj < 4; ++jj) vn[jj] = bf2f(Vs[(16 * mt + quad * 4 + jj) * P128 + 16 * w + l15]) - acc[jj];
            u32x2 pw; pw.x = pk2(vn[0], vn[1]); pw.y = pk2(vn[2], vn[3]);
            *(LAS u32x2*)(VNT + (16 * w + l15) * P64 + 16 * mt + quad * 4) = pw; }
        WAVE_SYNC();
        bf16x8 Bvn[2];
#pragma unroll
        for (int k2 = 0; k2 < 2; ++k2) Bvn[k2] = *(const LAS bf16x8*)(VNT + (16 * w + l15) * P64 + 32 * k2 + quad * 8);
#pragma unroll 1
        for (int mt = 0; mt < 4; ++mt) { f32x4 acc = (f32x4){0.f, 0.f, 0.f, 0.f};
#pragma unroll
            for (int ks = 0; ks < 4; ++ks) { const bf16x8 a = *(const LAS bf16x8*)(Qs + (16 * mt + l15) * P128 + 32 * ks + quad * 8); acc = mfma16(a, Bst[ks], acc); }
#pragma unroll
            for (int jj = 0; jj < 4; ++jj) { const int i = 16 * mt + quad * 4 + jj; acc[jj] *= rq[i] * egs[i]; }
#pragma unroll
            for (int k2 = 0; k2 < 2; ++k2) { const bf16x8 a = *(const LAS bf16x8*)(QKs + (16 * mt + l15) * P64 + 32 * k2 + quad * 8); acc = mfma16(a, Bvn[k2], acc); }
#pragma unroll
            for (int jj = 0; jj < 4; ++jj) { const int i = 16 * mt + quad * 4 + jj; const int t = c0 + (dir ? 63 - i : i);
                Odir[(size_t)(m0 + t) * 512 + hd * 128 + 16 * w + l15] = (bf16)f2bf(acc[jj]); } }
        const float egl = rq[384];
#pragma unroll
        for (int mt = 0; mt < 8; ++mt) { f32x4 acc = Sacc[mt] * egl;
#pragma unroll
            for (int k2 = 0; k2 < 2; ++k2) { const bf16x8 a = *(const LAS bf16x8*)(KT + (16 * mt + l15) * P64 + 32 * k2 + quad * 8); acc = mfma16(a, Bvn[k2], acc); }
            Sacc[mt] = acc;
            u32x2 pw; pw.x = pk2(acc[0], acc[1]); pw.y = pk2(acc[2], acc[3]);
            *(LAS u32x2*)(ST + (16 * w + l15) * P128 + 16 * mt + quad * 4) = pw; }
#endif
        WAVE_SYNC();
    }
    if (!lat) { float* dp = P.out + OUT_DELTA + sbase + (size_t)(quad * 4) * 128 + 16 * w + l15;
#pragma unroll
        for (int mt = 0; mt < 8; ++mt)
#pragma unroll
            for (int jj = 0; jj < 4; ++jj) dp[(16 * mt + jj) * 128] = Sacc[mt][jj];
    }
    __syncthreads();
}

__device__ __forceinline__ void phase_mix_even(int wid0, const Params& P, LAS unsigned char* lds, int e) {
    const int tid = tid_fresh(wid0), lane = tid & 63, wave = tid >> 6, bid = bid_fresh(), G = grid_fresh();
    if (G == 256) {
        if (bid < 64) { const int s = 32 + (bid >> 3), hd = (bid >> 1) & 3, dir = bid & 1; gdn_chain(wid0, P, lds, e, s, hd, dir); }
        else { const int bb = bid - 64;
            for (int c = bb; c < 256; c += 192) { const int s = c >> 3, hd = (c >> 1) & 3, dir = c & 1; gdn_chain(wid0, P, lds, e, s, hd, dir); }
            for (int t = bb; t < 384; t += 192) { const int wt = t * 8 + wave; s5_task_main(P, lds + wave * S5_WLDS, lane, e, wt >> 5, wt & 31); } }
    } else {
        for (int c = bid; c < 320; c += G) { const int s = c < 64 ? 32 + (c >> 3) : ((c - 64) >> 3), hd = (c >> 1) & 3, dir = c & 1; gdn_chain(wid0, P, lds, e, s, hd, dir); }
        for (int t = bid; t < 384; t += G) { const int wt = t * 8 + wave; s5_task_main(P, lds + wave * S5_WLDS, lane, e, wt >> 5, wt & 31); }
    }
}
__device__ __forceinline__ void phase_fin_even(int wid0, const Params& P, LAS unsigned char* lds, int e) {
    const int tid = tid_fresh(wid0), lane = tid & 63, wave = tid >> 6;
    const int gw = bid_fresh() * NWAVES + wave, NGW = grid_fresh() * NWAVES;
    for (int wt = gw; wt < 2048; wt += NGW) s5_task_corr(P, lds + wave * S5_WLDS, lane, e, wt >> 5, wt & 31);
    const bf16* proj = (const bf16*)(P.ws + WS_BIG); const bf16* Of = (const bf16*)(P.ws + WS_H); const bf16* Ob = Of + (size_t)MT * 512; bf16* mixout = (bf16*)(P.ws + WS_MIX);
    for (int m = gw; m < MT; m += NGW) {
        const u32x4 a = *(const u32x4*)(Of + (size_t)m * 512 + lane * 8), bq = *(const u32x4*)(Ob + (size_t)m * 512 + lane * 8), z = *(const u32x4*)(proj + (size_t)m * NPROJ_E + 2560 + lane * 8);
        float o[8]; float ss = 0.f;
#pragma unroll
        for (int j = 0; j < 4; ++j) { o[2 * j] = bflo(a[j]) + bflo(bq[j]); o[2 * j + 1] = bfhi(a[j]) + bfhi(bq[j]); ss += o[2 * j] * o[2 * j] + o[2 * j + 1] * o[2 * j + 1]; }
        ss += shfl_i(ss, lane ^ 1); ss += shfl_i(ss, lane ^ 2); ss += shfl_i(ss, lane ^ 4); ss += shfl_i(ss, lane ^ 8);
        const float rs = rsqrtf(ss * (1.0f / 128.0f) + EPSF);
        const float* gn = P.in[I_GONORM] + e * 128 + (lane & 15) * 8;
        unsigned pw[4];
#pragma unroll
        for (int j = 0; j < 4; ++j) { const float z0 = bflo(z[j]), z1 = bfhi(z[j]); pw[j] = pk2(o[2 * j] * rs * gn[2 * j] * siluf_(z0), o[2 * j + 1] * rs * gn[2 * j + 1] * siluf_(z1)); }
        *(u32x4*)(mixout + (size_t)m * DM + 512 + lane * 8) = (u32x4){pw[0], pw[1], pw[2], pw[3]};
    }
}

__device__ __forceinline__ void phase_conv_odd(int wid0, const Params& P, int o) {
    const int tid = tid_fresh(wid0), lane = tid & 63, wave = tid >> 6;
    const int gw = bid_fresh() * NWAVES + wave, NGW = grid_fresh() * NWAVES;
    const bf16* proj = (const bf16*)(P.ws + WS_BIG); bf16* cx = (bf16*)(P.ws + WS_H);
    const float* cw = P.in[I_LCONVW] + (size_t)o * 4 * 1024; const float* cb = P.in[I_LCONVB] + o * 1024;
    for (int m = gw; m < MT; m += NGW) {
        const int t = m < MCTX ? (m & 255) : ((m - MCTX) & 2047); const int L = m < MCTX ? LCTX : LLAT;
#pragma unroll
        for (int h2 = 0; h2 < 2; ++h2) { const int ch = lane * 8 + 512 * h2;
            float acc[8];
#pragma unroll
            for (int j = 0; j < 8; ++j) acc[j] = cb[ch + j];
#pragma unroll
            for (int k = 0; k < 4; ++k) { const int tt = t - 1 + k; if (tt >= 0 && tt < L) { const u32x4 v = *(const u32x4*)(proj + (size_t)(m - 1 + k) * 2048 + ch);
#pragma unroll
                    for (int j = 0; j < 4; ++j) { acc[2 * j] += cw[k * 1024 + ch + 2 * j] * bflo(v[j]); acc[2 * j + 1] += cw[k * 1024 + ch + 2 * j + 1] * bfhi(v[j]); } } }
            *(u32x4*)(cx + (size_t)m * DM + ch) = (u32x4){pk2(acc[0], acc[1]), pk2(acc[2], acc[3]), pk2(acc[4], acc[5]), pk2(acc[6], acc[7])}; }
    }
}
__device__ __forceinline__ void phase_lru_scan(int wid0, const Params& P, int o, int d) {
    const int tid = tid_fresh(wid0), lane = tid & 63, wave = tid >> 6;
    const int gw = bid_fresh() * NWAVES + wave, NGW = grid_fresh() * NWAVES;
    const unsigned* G = (const unsigned*)(P.ws + WS_GATES); const bf16* proj = (const bf16*)(P.ws + WS_BIG); bf16* mixout = (bf16*)(P.ws + WS_MIX);
    for (int task = gw; task < 640; task += NGW) {
        int s, cg_;
        if (task < 128) { s = 32 + (task >> 4); cg_ = task & 15; } else { s = (task - 128) >> 4; cg_ = (task - 128) & 15; }
        const bool lat = s >= 32; const int b = lat ? s - 32 : s; const int L = lat ? LLAT : LCTX; const int m0 = lat ? MCTX + b * LLAT : s * LCTX;
        const int ch = cg_ * 64 + lane;
        float h = lat ? P.in[I_SLRU][(((size_t)b * 2 + o) * 2 + d) * 1024 + ch] : 0.f;
        for (int t0 = 0; t0 < L; t0 += 8) {
            unsigned gv[8]; float pv[8], yv[8];
#pragma unroll
            for (int i = 0; i < 8; ++i) { const int t = d ? L - 1 - (t0 + i) : t0 + i; const size_t m = (size_t)(m0 + t);
                gv[i] = G[m * DM + ch];
                if (d) { pv[i] = bf2f(mixout[m * DM + ch]); yv[i] = bf2f(proj[m * 2048 + 1024 + ch]); } }
#pragma unroll
            for (int i = 0; i < 8; ++i) { const int t = d ? L - 1 - (t0 + i) : t0 + i; const size_t m = (size_t)(m0 + t);
                h = exp2f(bflo(gv[i])) * h + bfhi(gv[i]);
                if (d) mixout[m * DM + ch] = (bf16)f2bf((pv[i] + h) * geluf_(yv[i])); else mixout[m * DM + ch] = (bf16)f2bf(h); }
        }
        if (!lat) P.out[OUT_LRU + (((size_t)b * 2 + o) * 2 + d) * 1024 + ch] = h;
    }
}
#ifdef PROBE_DUP_GEMM
#define DUPG(x) GSYNC(); x
#else
#define DUPG(x)
#endif
typedef const __attribute__((address_space(4))) Params* KParams;
__device__ __forceinline__ Params load_params(KParams q) { Params r;
#pragma unroll
    for (int i = 0; i < 40; ++i) r.in[i] = q->in[i];
    r.out = q->out; r.ws = q->ws; return r; }
#define FRESH() const int G = grid_fresh(), bid = bid_fresh(); (void)G; (void)bid; KParams pk_ = (KParams)__builtin_amdgcn_kernarg_segment_ptr(); asm volatile("" : "+s"(pk_)); const Params P = load_params(pk_); unsigned char* ws = P.ws; \
    const float* mod = (const float*)(ws + WS_MOD); bf16* H = (bf16*)(ws + WS_H); bf16* BIG = (bf16*)(ws + WS_BIG); bf16* MIX = (bf16*)(ws + WS_MIX); (void)mod; (void)H; (void)BIG; (void)MIX;
#define GSYNC() do { KParams pb_ = (KParams)__builtin_amdgcn_kernarg_segment_ptr(); asm volatile("" : "+s"(pb_)); xcd_barrier(wid0, (unsigned*)(pb_->ws + WS_BAR), lds); } while (0)
__global__ void __launch_bounds__(NTHR, 2) fwd_kernel(Params Parg) {
    extern __shared__ __attribute__((aligned(16))) unsigned char lds_raw[];
    LAS unsigned char* lds = (LAS unsigned char*)lds_raw;
    cg::grid_group grid = cg::this_grid();
    const int wid0 = __builtin_amdgcn_readfirstlane(threadIdx.x >> 6);
    if (threadIdx.x < 4) ((LAS unsigned*)(lds + LDS_BARST))[threadIdx.x] = 0u;
    __syncthreads();
    if (threadIdx.x == 0) (void)xb_add((unsigned*)(Parg.ws + WS_BAR) + XB_XCNT(xb_xcc_id()), 1u);

    { FRESH(); phase_prologue(wid0, P, lds); }
    grid.sync();
#ifdef PROBE_DUP_PRO
    { FRESH(); phase_prologue(wid0, P, lds); }
    GSYNC();
#endif
    { FRESH(); phase_modreduce(wid0, P); }
    GSYNC();
#ifdef PROBE_SYNC
#pragma unroll 1
    for (int i = 0; i < 40; ++i) GSYNC();
#endif
#pragma unroll 1
    for (int l = 0; l < 4; ++l) {
        { FRESH(); const float* modl = mod + (size_t)l * 9 * 6144;
        phase_rownorm(wid0, P, l == 0, MIX, modl - 9 * 6144, 5 * 1024, P.in[I_NMLPPOST] + (l > 0 ? (l - 1) * 1024 : 0), 1, P.in[I_NMIXPRE] + l * 1024, modl, 0, H); }
        GSYNC();
        const int eo = l >> 1;
        {
            FRESH();
            pg8::Gemm g; pg8::StaticOrder S; EpiBf16<0> E;
            if ((l & 1) == 0) { g = pg8::Gemm{H, (const bf16*)(ws + WS_WINE) + (size_t)eo * NB_E * 1024, MT, NB_E, 1024, 1024, 0, 0}; E = EpiBf16<0>{BIG, NPROJ_E, (float*)(ws + WS_AB)}; }
            else { g = pg8::Gemm{H, (const bf16*)(ws + WS_WINO) + (size_t)eo * 2048 * 1024, MT, 2048, 1024, 1024, 0, 0}; E = EpiBf16<0>{BIG, 2048, nullptr}; }
            S.init(g.M, g.N, G, bid);
            pg8::gemm_phase(wid0, lds, g, S, E); DUPG(pg8::gemm_phase(wid0, lds, g, S, E);)
        }
        GSYNC();
        if ((l & 1) == 0) {
            { FRESH(); phase_mix_even(wid0, P, lds, eo); }
            GSYNC();
#ifdef PROBE_DUP_MIX
            { FRESH(); phase_mix_even(wid0, P, lds, eo); }
            GSYNC();
#endif
            { FRESH(); phase_fin_even(wid0, P, lds, eo); }
            GSYNC();
        } else {
            { FRESH(); phase_conv_odd(wid0, P, eo); }
            GSYNC();
#ifdef PROBE_DUP_CONV
            { FRESH(); phase_conv_odd(wid0, P, eo); }
            GSYNC();
#endif
#pragma unroll 1
            for (int d = 0; d < 2; ++d) {
                { FRESH();
                pg8::Gemm g{H, (const bf16*)(ws + WS_WG) + (size_t)(eo * 2 + d) * 2048 * 256, MT, 2048, 256, 1024, 1, 1};
                EpiGates E{(unsigned*)(ws + WS_GATES), H, P.in[I_LBR] + (eo * 2 + d) * 1024, P.in[I_LBI] + (eo * 2 + d) * 1024, P.in[I_LLAM] + (eo * 2 + d) * 1024};
                pg8::StaticOrder S; S.init(g.M, g.N, G, bid);
                pg8::gemm_phase(wid0, lds, g, S, E); DUPG(pg8::gemm_phase(wid0, lds, g, S, E);) }
                GSYNC();
                { FRESH(); phase_lru_scan(wid0, P, eo, d); }
#ifdef PROBE_DUP_LRU0
                if (d == 0) { GSYNC(); FRESH(); phase_lru_scan(wid0, P, eo, d); }
#endif
                GSYNC();
            }
        }
        {
            FRESH();
            pg8::Gemm g{MIX, (const bf16*)(ws + ((l & 1) ? WS_WOUTO : WS_WOUTE)) + (size_t)eo * 1024 * 1024, MT, 1024, 1024, 1024, 0, 0};
            EpiBf16<0> E{BIG, 1024, nullptr}; pg8::StaticOrder S; S.init(g.M, g.N, G, bid);
            pg8::gemm_phase(wid0, lds, g, S, E); DUPG(pg8::gemm_phase(wid0, lds, g, S, E);)
        }
        GSYNC();
        { FRESH(); const float* modl = mod + (size_t)l * 9 * 6144;
        phase_rownorm(wid0, P, 0, BIG, modl, 2 * 1024, P.in[I_NMIXPOST] + l * 1024, 1, P.in[I_NMLPPRE] + l * 1024, modl, 3 * 1024, H); }
        GSYNC();
        {
            FRESH();
            pg8::Gemm g{H, (const bf16*)(ws + WS_W1T) + (size_t)l * 4096 * 1024, MT, 4096, 1024, 1024, 0, 0};
            EpiBf16<1> E{BIG, 4096, nullptr}; pg8::StaticOrder S; S.init(g.M, g.N, G, bid);
            pg8::gemm_phase(wid0, lds, g, S, E); DUPG(pg8::gemm_phase(wid0, lds, g, S, E);)
        }
        GSYNC();
        {
            FRESH();
            pg8::Gemm g{BIG, (const bf16*)(ws + WS_W2T) + (size_t)l * 1024 * 4096, MT, 1024, 4096, 4096, 0, 0};
            EpiBf16<0> E{MIX, 1024, nullptr}; pg8::StaticOrder S; S.init(g.M, g.N, G, bid);
            pg8::gemm_phase(wid0, lds, g, S, E); DUPG(pg8::gemm_phase(wid0, lds, g, S, E);)
        }
        GSYNC();
    }
    { FRESH();
    phase_rownorm(wid0, P, 0, MIX, mod + (size_t)3 * 9 * 6144, 5 * 1024, P.in[I_NMLPPOST] + 3 * 1024, 0, P.in[I_NMIXPRE], mod, 0, H); }
}

extern "C" void kernel_launch(void* const* d_in, const int* in_sizes, int n_in, void* d_out, int out_size, void* d_ws, size_t ws_size, hipStream_t stream) {
    static int grid = 0;
    if (grid == 0) {
        if (n_in != 40 || ws_size < WS_END) { fprintf(stderr, "kernel_launch: expected 40 inputs and >= %zu bytes of workspace (got %d, %zu)\n", (size_t)WS_END, n_in, ws_size); grid = -1; return; }
        int dev = 0, cus = 0, per_cu = 0;
        if (hipGetDevice(&dev) != hipSuccess || hipDeviceGetAttribute(&cus, hipDeviceAttributeMultiprocessorCount, dev) != hipSuccess) { grid = -1; return; }
        if (hipFuncSetAttribute((const void*)fwd_kernel, hipFuncAttributeMaxDynamicSharedMemorySize, LDS_BYTES) != hipSuccess) { fprintf(stderr, "kernel_launch: hipFuncSetAttribute failed\n"); grid = -1; return; }
        if (hipOccupancyMaxActiveBlocksPerMultiprocessor(&per_cu, (const void*)fwd_kernel, NTHR, LDS_BYTES) != hipSuccess || per_cu < 1) per_cu = 1;
        (void)hipGetLastError();
        grid = cus * per_cu; if (grid > 256) grid = 256;
    }
    if (grid < 0) return;
    (void)hipMemsetAsync((char*)d_ws + WS_BAR, 0, 16384, stream);
    Params p{};
    for (int i = 0; i < 40; ++i) p.in[i] = (const float*)d_in[i];
    p.out = (float*)d_out; p.ws = (unsigned char*)d_ws;
    void* args[] = {&p};
    hipError_t e = hipLaunchCooperativeKernel((const void*)fwd_kernel, dim3(grid), dim3(NTHR), args, LDS_BYTES, stream);
    if (e != hipSuccess) fprintf(stderr, "cooperative launch failed: %s (grid %d)\n", hipGetErrorString(e), grid);
}
```

```cpp
#include <hip/hip_runtime.h>
#include <hip/hip_cooperative_groups.h>
#include <cstdio>
#include <cstdint>
namespace cg = cooperative_groups;
__device__ __forceinline__ int bid_fresh() { int t = blockIdx.x; asm volatile("" : "+s"(t)); return t; }
__device__ __forceinline__ int grid_fresh() { int t = gridDim.x; asm volatile("" : "+s"(t)); return t; }
__device__ __forceinline__ int tid_fresh(int w) { asm volatile("" : "+s"(w)); int l; asm volatile("v_mbcnt_lo_u32_b32 %0, -1, 0\n\tv_mbcnt_hi_u32_b32 %0, -1, %0" : "=v"(l)); return w * 64 + l; }

namespace pg8 {
#define PG8_LAS __attribute__((address_space(3)))
typedef unsigned short bf16_t;
typedef short bf16x8 __attribute__((ext_vector_type(8)));
typedef float f32x4 __attribute__((ext_vector_type(4)));
typedef unsigned u32x4 __attribute__((ext_vector_type(4)));
typedef unsigned u32x2 __attribute__((ext_vector_type(2)));
constexpr int BM = 256, BK = 64, HALF = 128, HTB = HALF * BK * 2, STAGE_BYTES = 8 * HTB, NXCD = 8, WGM = 8;

__host__ __device__ __forceinline__ int lds_byte(int r, int c) { const int st = (r >> 4) * 2 + (c >> 5), rr = r & 15, cc = c & 31, ob = rr * 64 + cc * 2; return st * 1024 + (ob ^ (((ob >> 9) & 1) << 5)); }
__host__ __device__ __forceinline__ void stage_rc(int b, int& R, int& C) { const int st = b / 1024, sb = b % 1024, swz = sb ^ (((sb >> 9) & 1) << 5); R = (st >> 1) * 16 + swz / 64; C = (st & 1) * 32 + (swz % 64) / 2; }
__host__ __device__ __forceinline__ int perm32(int rho) { const int n = rho >> 4, i = rho & 15; return 8 * (i >> 2) + 4 * n + (i & 3); }

struct Unit { int pm, pn; };
struct Gemm { const bf16_t* A; const bf16_t* Bt; int M, N, K, lda, ablk, ashift; };

struct StaticOrder {
    int nM, nN, nwg, G, c;
    __host__ __device__ void init(int M, int N, int G_, int c_) { nM = M / BM; nN = N / BM; nwg = nM * nN; G = G_; c = c_; }
    __host__ __device__ bool next(int i, Unit& u) const {
        const long L = (long)i * G + c; if (L >= nwg) return false;
        int wgid = (int)L; { const int q = nwg / NXCD, r = nwg % NXCD, xcd = wgid % NXCD, off = wgid / NXCD; wgid = (xcd < r ? xcd * (q + 1) : r * (q + 1) + (xcd - r) * q) + off; }
        const int nig = WGM * nN, gid = wgid / nig, fm = gid * WGM, gsz = (nM - fm) < WGM ? (nM - fm) : WGM;
        u.pm = fm + ((wgid % nig) % gsz); u.pn = (wgid % nig) / gsz; return true;
    }
};
__device__ __forceinline__ unsigned cvt_pk_bf16(float lo, float hi) { unsigned r; asm volatile("v_cvt_pk_bf16_f32 %0, %1, %2" : "=v"(r) : "v"(lo), "v"(hi)); return r; }

template <class Epi>
__device__ __forceinline__ void gemm_phase(int wid0, PG8_LAS unsigned char* lds, const Gemm g, const StaticOrder& S, const Epi& E) {
    const int tid = tid_fresh(wid0), wid = __builtin_amdgcn_readfirstlane(tid >> 6), lane = tid & 63, wr = wid >> 2, wc = wid & 3, fr = lane & 15, fq = lane >> 4;
    const int K = g.K, nt = K / BK, lda = g.lda;
    unsigned voffA[2], voffB[2];
#pragma unroll
    for (int i = 0; i < 2; ++i) { int R, C; stage_rc(tid * 16 + i * 8192, R, C); const int Rb = (R & ~31) + perm32(R & 31);
        voffA[i] = (unsigned)(R * lda + C) * 2u; voffB[i] = (unsigned)(Rb * K + C) * 2u; }
    const size_t kstep = (size_t)(BK * 2);
    const size_t hstepA = (size_t)HALF * lda * 2, hstepB = (size_t)HALF * K * 2;
    const size_t tstepA = 2 * hstepA, tstepB = 2 * hstepB;
    const unsigned ldsw = (unsigned)wid * 1024u;
    const int aoff = lds_byte(wr * 64 + fr, fq * 8), boff = lds_byte(wc * 32 + fr, fq * 8);
#define PG8_ACOL(pn) (g.ablk ? (size_t)((((pn) >> g.ashift) & 3) * 512) : (size_t)0)
#define PG8_SA(b, h) (((b) * 2 + (h)) * HTB)
#define PG8_SB(b, h) ((4 + (b) * 2 + (h)) * HTB)
#define PG8_STAGE(bufoff, gbase, voff) do { _Pragma("unroll") for (int _i = 0; _i < 2; ++_i) \
        __builtin_amdgcn_global_load_lds((const unsigned*)((const char*)(gbase) + (voff)[_i]), (PG8_LAS unsigned*)(lds + (bufoff) + ldsw + _i * 8192), 16, 0, 0); } while (0)
#define PG8_LDA(dst, b, h) do { _Pragma("unroll") for (int m = 0; m < 4; ++m) _Pragma("unroll") for (int k = 0; k < 2; ++k) dst[m][k] = *(const PG8_LAS bf16x8*)(lds + PG8_SA(b, h) + aoff + m * 2048 + k * 1024); } while (0)
#define PG8_LDB(dst, b, h) do { _Pragma("unroll") for (int n = 0; n < 2; ++n) _Pragma("unroll") for (int k = 0; k < 2; ++k) dst[n][k] = *(const PG8_LAS bf16x8*)(lds + PG8_SB(b, h) + boff + n * 2048 + k * 1024); } while (0)
#define PG8_MMA(ai, bj, At, Bt) do { __builtin_amdgcn_s_setprio(1); _Pragma("unroll") for (int m = 0; m < 4; ++m) _Pragma("unroll") for (int n = 0; n < 2; ++n) _Pragma("unroll") for (int k = 0; k < 2; ++k) \
        acc[ai][bj][m][n] = __builtin_amdgcn_mfma_f32_16x16x32_bf16(Bt[n][k], At[m][k], acc[ai][bj][m][n], 0, 0, 0); __builtin_amdgcn_s_setprio(0); } while (0)
#define PG8_WAIT_V(n) asm volatile("s_waitcnt vmcnt(" #n ")" ::: "memory")
#define PG8_WAIT_L(n) asm volatile("s_waitcnt lgkmcnt(" #n ")" ::: "memory")
#define PG8_BAR __builtin_amdgcn_s_barrier()
#define PG8_SCHED __builtin_amdgcn_sched_barrier(0)
    Unit cur, nxt; int ui = 0;
    if (!S.next(0, cur)) return;
    f32x4 acc[2][2][4][2];
#pragma unroll
    for (int a = 0; a < 2; ++a)
#pragma unroll
        for (int b = 0; b < 2; ++b)
#pragma unroll
            for (int m = 0; m < 4; ++m)
#pragma unroll
                for (int n = 0; n < 2; ++n) acc[a][b][m][n] = (f32x4){0.f, 0.f, 0.f, 0.f};
    bf16x8 At[4][2], B0[2][2], B1[2][2];
    const char* cA = (const char*)g.A + (size_t)cur.pm * tstepA + PG8_ACOL(cur.pn); const char* cB = (const char*)g.Bt + (size_t)cur.pn * tstepB;
    PG8_STAGE(PG8_SB(0, 0), cB, voffB); PG8_STAGE(PG8_SA(0, 0), cA, voffA); PG8_STAGE(PG8_SB(0, 1), cB + hstepB, voffB); PG8_STAGE(PG8_SA(0, 1), cA + hstepA, voffA);
    if (wr == 1) PG8_BAR;
    PG8_WAIT_V(4); PG8_BAR;
    PG8_STAGE(PG8_SB(1, 0), cB + kstep, voffB); PG8_STAGE(PG8_SA(1, 0), cA + kstep, voffA); PG8_STAGE(PG8_SB(1, 1), cB + hstepB + kstep, voffB);
    PG8_WAIT_V(6); PG8_BAR;
    for (;;) {
        const bool has_next = S.next(ui + 1, nxt);
        const char* nA = has_next ? (const char*)g.A + (size_t)nxt.pm * tstepA + PG8_ACOL(nxt.pn) : cA; const char* nB = has_next ? (const char*)g.Bt + (size_t)nxt.pn * tstepB : cB;
        for (int t = 0; t < nt; t += 2) {
            const bool last = (t == nt - 2);
            const char* a1 = cA + (size_t)(t + 1) * kstep;
            const char* a2 = last ? nA : cA + (size_t)(t + 2) * kstep; const char* b2 = last ? nB : cB + (size_t)(t + 2) * kstep;
            const char* a3 = a2 + kstep; const char* b3 = b2 + kstep;
            PG8_LDB(B0, 0, 0); PG8_SCHED; PG8_LDA(At, 0, 0); PG8_STAGE(PG8_SA(1, 1), a1 + hstepA, voffA);
            PG8_WAIT_L(8); PG8_BAR; PG8_WAIT_L(0); PG8_MMA(0, 0, At, B0); PG8_BAR; PG8_SCHED;
            PG8_LDB(B1, 0, 1); PG8_STAGE(PG8_SB(0, 0), b2, voffB);
            PG8_BAR; PG8_WAIT_L(0); PG8_MMA(0, 1, At, B1); PG8_BAR;
            PG8_LDA(At, 0, 1); PG8_STAGE(PG8_SA(0, 0), a2, voffA);
            PG8_BAR; PG8_WAIT_L(0); PG8_MMA(1, 0, At, B0); PG8_BAR; PG8_SCHED;
            PG8_STAGE(PG8_SB(0, 1), b2 + hstepB, voffB);
            PG8_WAIT_V(6); PG8_BAR; PG8_MMA(1, 1, At, B1); PG8_BAR;
            PG8_LDB(B0, 1, 0); PG8_SCHED; PG8_LDA(At, 1, 0); PG8_STAGE(PG8_SA(0, 1), a2 + hstepA, voffA);
            PG8_WAIT_L(8); PG8_BAR; PG8_WAIT_L(0); PG8_MMA(0, 0, At, B0); PG8_BAR; PG8_SCHED;
            PG8_LDB(B1, 1, 1); PG8_STAGE(PG8_SB(1, 0), b3, voffB);
            PG8_BAR; PG8_WAIT_L(0); PG8_MMA(0, 1, At, B1); PG8_BAR;
            PG8_LDA(At, 1, 1); PG8_STAGE(PG8_SA(1, 0), a3, voffA);
            PG8_BAR; PG8_WAIT_L(0); PG8_MMA(1, 0, At, B0); PG8_BAR; PG8_SCHED;
            PG8_STAGE(PG8_SB(1, 1), b3 + hstepB, voffB);
            PG8_WAIT_V(6); PG8_BAR; PG8_MMA(1, 1, At, B1); PG8_BAR;
        }
        E(acc, cur, wr, wc, fr, fq);
        if (!has_next) break;
#pragma unroll
        for (int a = 0; a < 2; ++a)
#pragma unroll
            for (int b = 0; b < 2; ++b)
#pragma unroll
                for (int m = 0; m < 4; ++m)
#pragma unroll
                    for (int n = 0; n < 2; ++n) acc[a][b][m][n] = (f32x4){0.f, 0.f, 0.f, 0.f};
        cur = nxt; cA = nA; cB = nB; ++ui;
    }
    PG8_WAIT_V(0);
    if (wr == 0) PG8_BAR;
    PG8_BAR;
#undef PG8_ACOL
#undef PG8_SA
#undef PG8_SB
#undef PG8_STAGE
#undef PG8_LDA
#undef PG8_LDB
#undef PG8_MMA
#undef PG8_WAIT_V
#undef PG8_WAIT_L
#undef PG8_BAR
#undef PG8_SCHED
}
}
#define LAS __attribute__((address_space(3)))
typedef unsigned short bf16;
typedef short bf16x8 __attribute__((ext_vector_type(8)));
typedef float f32x4 __attribute__((ext_vector_type(4)));
typedef unsigned u32x4 __attribute__((ext_vector_type(4)));
typedef unsigned u32x2 __attribute__((ext_vector_type(2)));
constexpr int DM = 1024, MT = 24576, MCTX = 8192, LCTX = 256, LLAT = 2048, NWAVES = 8, NTHR = 512;
constexpr int NPROJ_E = 3072, NB_E = 3328, IN_EVEN_LD = 3088;
constexpr float EPSF = 1e-6f;
constexpr size_t MiB = 1u << 20;
constexpr size_t WS_MOD = 0, MOD_BYTES = 4 * 9 * 6144 * 4, WS_S5F = 1 * MiB, WS_AB = 3 * MiB, WS_W1T = 5 * MiB, WS_W2T = 37 * MiB, WS_WINE = 69 * MiB,
                 WS_WOUTE = 82 * MiB, WS_WINO = 86 * MiB, WS_WOUTO = 94 * MiB, WS_WG = 98 * MiB, WS_H = 102 * MiB, WS_BIG = 150 * MiB, WS_YBUF = 294 * MiB,
                 WS_GATES = 246 * MiB, WS_MIX = 342 * MiB, WS_END = 390 * MiB;
constexpr int LDS_BYTES = 147456;
constexpr size_t OUT_S5RE = 25165824, OUT_S5IM = OUT_S5RE + 262144, OUT_DELTA = OUT_S5IM + 262144, OUT_LRU = OUT_DELTA + 8388608;

struct Params { const float* in[40]; float* out; unsigned char* ws; };
enum { I_XP = 0, I_XS, I_S5RE, I_S5IM, I_SDELTA, I_SLRU, I_C, I_CCTX, I_WADA, I_BADA, I_NMIXPRE, I_NMIXPOST, I_NMLPPRE, I_NMLPPOST, I_WMLPIN, I_WMLPOUT, I_WINE, I_WOUTE,
       I_LAMRE, I_LAMIM, I_LOGDT, I_BRE, I_BIM, I_CRE, I_CIM, I_S5D, I_GCONVW, I_GCONVB, I_GALOG, I_GDTB, I_GONORM, I_WINO, I_WOUTO, I_LCONVW, I_LCONVB, I_LWR, I_LBR, I_LWI, I_LBI, I_LLAM };

typedef __bf16 bf2_t __attribute__((ext_vector_type(2)));
typedef float f2_t __attribute__((ext_vector_type(2)));
__device__ __forceinline__ unsigned pk2(float lo, float hi) { const bf2_t v = __builtin_convertvector((f2_t){lo, hi}, bf2_t); return __builtin_bit_cast(unsigned, v); }
__device__ __forceinline__ unsigned f2bf(float f) { return pk2(f, f) & 0xffffu; }
__device__ __forceinline__ float bflo(unsigned w) { return __builtin_bit_cast(float, w << 16); }
__device__ __forceinline__ float bfhi(unsigned w) { return __builtin_bit_cast(float, w & 0xffff0000u); }
__device__ __forceinline__ float bf2f(bf16 b) { return __builtin_bit_cast(float, (unsigned)b << 16); }
__device__ __forceinline__ float sigmoidf_(float x) { return __builtin_amdgcn_rcpf(1.0f + __expf(-x)); }
__device__ __forceinline__ float siluf_(float x) { return x * sigmoidf_(x); }
__device__ __forceinline__ float softplusf_(float x) { return fmaxf(x, 0.f) + __logf(1.0f + __expf(-fabsf(x))); }
__device__ __forceinline__ float geluf_(float x) { const float y = 0.7978845608028654f * (x + 0.044715f * x * x * x); const float t = 1.0f - 2.0f * __builtin_amdgcn_rcpf(__expf(2.0f * y) + 1.0f); return 0.5f * x * (1.0f + t); }
__device__ __forceinline__ float shfl_i(float v, int srclane) { return __builtin_bit_cast(float, __builtin_amdgcn_ds_bpermute(srclane << 2, __builtin_bit_cast(int, v))); }
__device__ __forceinline__ float wave_sum(float v, int lane) {
#pragma unroll
    for (int o = 1; o < 64; o <<= 1) v += shfl_i(v, lane ^ o);
    return v;
}
#define LDS_WAIT() asm volatile("s_waitcnt lgkmcnt(0)" ::: "memory")
#define WAVE_SYNC() do { asm volatile("s_waitcnt lgkmcnt(0)" ::: "memory"); __builtin_amdgcn_wave_barrier(); } while (0)
__device__ __forceinline__ f32x4 mfma16(bf16x8 a, bf16x8 b, f32x4 c) { return __builtin_amdgcn_mfma_f32_16x16x32_bf16(a, b, c, 0, 0, 0); }


#define XB_TMO      128
#define XB_XCNT(j)  (256  + 64 * (j))
#define XB_XSUB(j)  (1280 + 64 * (j))
#define XB_XGEN(j)  (2304 + 64 * (j))
#define XB_TOP      3328
#define XB_TOPGEN   3392
#define XCD_BAR_WORDS 3456
#define XB_SPIN_CAP (1u << 18)
constexpr size_t WS_BAR = 960 * 1024; constexpr int LDS_BARST = LDS_BYTES - 16;
__device__ __forceinline__ unsigned xb_ld(unsigned* p)              { return __hip_atomic_load(p, __ATOMIC_RELAXED, __HIP_MEMORY_SCOPE_AGENT); }
__device__ __forceinline__ unsigned xb_add(unsigned* p, unsigned v) { return __hip_atomic_fetch_add(p, v, __ATOMIC_RELAXED, __HIP_MEMORY_SCOPE_AGENT); }
__device__ __forceinline__ unsigned xb_xcc_id() { return (unsigned)__builtin_amdgcn_s_getreg((3 << 11) | 20) & 0xFu; }
#define XB_SPIN(cond, bar) do { unsigned _sp = 0; while (cond) { __builtin_amdgcn_s_sleep(1); \
    if ((++_sp & 255u) == 0u) { if (xb_ld(&(bar)[XB_TMO])) break; if (_sp > XB_SPIN_CAP) { atomicAdd(&(bar)[XB_TMO], 1u); break; } } } } while (0)
__device__ __forceinline__ void xcd_barrier_complete(unsigned* bar, unsigned x, unsigned& nloc, unsigned& nx) {
    const unsigned G = gridDim.x;
    unsigned sum, cnt, mine, sp = 0u;
    for (;;) {
        sum = 0u; cnt = 0u; mine = 0u;
#pragma unroll
        for (unsigned j = 0; j < 16; ++j) { const unsigned c = xb_ld(&bar[XB_XCNT(j)]); sum += c; cnt += (c > 0u) ? 1u : 0u; mine = (j == x) ? c : mine; }
        if (sum == G) break;
        __builtin_amdgcn_s_sleep(1);
        if ((++sp & 255u) == 0u) { if (xb_ld(&bar[XB_TMO])) break; if (sp > XB_SPIN_CAP) { atomicAdd(&bar[XB_TMO], 1u); break; } }
    }
    nloc = mine > 0u ? mine : 1u; nx = cnt > 0u ? cnt : 1u;
}
__device__ __forceinline__ void xcd_barrier(int wid0, unsigned* bar, LAS unsigned char* lds) {
    const int tid = tid_fresh(wid0);
    asm volatile("s_waitcnt vmcnt(0)" ::: "memory");
    __syncthreads();
    if (tid == 0) {
        const unsigned x = xb_xcc_id();
        volatile LAS unsigned* st = (volatile LAS unsigned*)(lds + LDS_BARST);
        __builtin_amdgcn_s_waitcnt(0);
        unsigned nloc = st[0], nx = st[1];
        if (nloc == 0u) { xcd_barrier_complete(bar, x, nloc, nx); st[0] = nloc; st[1] = nx; }
        const unsigned old = xb_add(&bar[XB_XSUB(x)], 1u);
        const unsigned gen = old / nloc;
        if (old + 1u == (gen + 1u) * nloc) {
            __builtin_amdgcn_fence(__ATOMIC_RELEASE, "agent");
            asm volatile("s_waitcnt vmcnt(0)" ::: "memory");
            const unsigned og = xb_add(&bar[XB_TOP], 1u);
            const unsigned tg = og / nx;
            if (og + 1u == (tg + 1u) * nx) xb_add(&bar[XB_TOPGEN], 1u);
            else XB_SPIN(xb_ld(&bar[XB_TOPGEN]) == tg, bar);
            __builtin_amdgcn_fence(__ATOMIC_ACQUIRE, "agent");
            xb_add(&bar[XB_XGEN(x)], 1u);
            asm volatile("s_waitcnt vmcnt(0)" ::: "memory");
        } else {
            XB_SPIN(xb_ld(&bar[XB_XGEN(x)]) == gen, bar);
            __builtin_amdgcn_fence(__ATOMIC_ACQUIRE, "agent");
            asm volatile("s_waitcnt vmcnt(0)" ::: "memory");
        }
    }
    __syncthreads();
}
__device__ __forceinline__ void transpose_item(const float* W, int ldw, int nvalid, int K, bf16* WT, int dst_row0, LAS float* scr, int k0, int n0, int lane) {
    const int nn = n0 + (lane & 31); const bool ok = nn < nvalid;
#pragma unroll 8
    for (int i = 0; i < 32; ++i) { const int kk = 2 * i + (lane >> 5); scr[kk * 33 + (lane & 31)] = ok ? W[(size_t)(k0 + kk) * ldw + nn] : 0.f; }
    WAVE_SYNC();
    const int c = lane & 7;
#pragma unroll
    for (int j = 0; j < 4; ++j) { const int n = (lane >> 3) + 8 * j; const LAS float* s = scr + (8 * c) * 33 + n;
        u32x4 o; o.x = pk2(s[0 * 33], s[1 * 33]); o.y = pk2(s[2 * 33], s[3 * 33]); o.z = pk2(s[4 * 33], s[5 * 33]); o.w = pk2(s[6 * 33], s[7 * 33]);
        *(u32x4*)(WT + (size_t)(dst_row0 + n) * K + k0 + 8 * c) = o; }
    WAVE_SYNC();
}
__device__ __forceinline__ void phase_prologue(int wid0, const Params& P, LAS unsigned char* lds) {
    const int tid = tid_fresh(wid0), lane = tid & 63, wave = tid >> 6;
    LAS float* scr = (LAS float*)(lds + wave * 16384);
    const int gw = bid_fresh() * NWAVES + wave, NGW = grid_fresh() * NWAVES;
    unsigned char* ws = P.ws;
    constexpr int NA = 8192, NB = 8192, NC = 2 * 16 * 97, ND = 1024, NE = 2048, NF = 1024, NG = 1024, NTR = NA + NB + NC + ND + NE + NF + NG, NMOD = 4 * 24 * 16;
    for (int it = gw; it < NTR + NMOD; it += NGW) {
        int r = it;
        if (r < NA) { const int l = r >> 11, q = r & 2047; transpose_item(P.in[I_WMLPIN] + (size_t)l * 1024 * 4096, 4096, 4096, 1024, (bf16*)(ws + WS_W1T) + (size_t)l * 4096 * 1024, 32 * (q & 127), scr, 64 * (q >> 7), 32 * (q & 127), lane); continue; } r -= NA;
        if (r < NB) { const int l = r >> 11, q = r & 2047; transpose_item(P.in[I_WMLPOUT] + (size_t)l * 4096 * 1024, 1024, 1024, 4096, (bf16*)(ws + WS_W2T) + (size_t)l * 1024 * 4096, 32 * (q & 31), scr, 64 * (q >> 5), 32 * (q & 31), lane); continue; } r -= NB;
        if (r < NC) { const int e = r / 1552, q = r % 1552, kb = q / 97, nb = q % 97; transpose_item(P.in[I_WINE] + (size_t)e * 1024 * IN_EVEN_LD, IN_EVEN_LD, IN_EVEN_LD, 1024, (bf16*)(ws + WS_WINE) + (size_t)e * NB_E * 1024, 32 * nb, scr, 64 * kb, 32 * nb, lane); continue; } r -= NC;
        if (r < ND) { const int e = r >> 9, q = r & 511; transpose_item(P.in[I_WOUTE] + (size_t)e * 1024 * 1024, 1024, 1024, 1024, (bf16*)(ws + WS_WOUTE) + (size_t)e * 1024 * 1024, 32 * (q & 31), scr, 64 * (q >> 5), 32 * (q & 31), lane); continue; } r -= ND;
        if (r < NE) { const int o = r >> 10, q = r & 1023; transpose_item(P.in[I_WINO] + (size_t)o * 1024 * 2048, 2048, 2048, 1024, (bf16*)(ws + WS_WINO) + (size_t)o * 2048 * 1024, 32 * (q & 63), scr, 64 * (q >> 6), 32 * (q & 63), lane); continue; } r -= NE;
        if (r < NF) { const int o = r >> 9, q = r & 511; transpose_item(P.in[I_WOUTO] + (size_t)o * 1024 * 1024, 1024, 1024, 1024, (bf16*)(ws + WS_WOUTO) + (size_t)o * 1024 * 1024, 32 * (q & 31), scr, 64 * (q >> 5), 32 * (q & 31), lane); continue; } r -= NF;
        if (r < NG) { const int mat = r >> 5, q = r & 31, kb = q >> 3, nb = q & 7; const int blk = mat & 3, gate = (mat >> 2) & 1, od = mat >> 3;
            const float* src = (gate ? P.in[I_LWI] : P.in[I_LWR]) + (size_t)(od * 4 + blk) * 65536;
            const int j0 = nb * 32; const int drow = (blk * 2 + (j0 >> 7)) * 256 + gate * 128 + (j0 & 127);
            transpose_item(src, 256, 256, 256, (bf16*)(ws + WS_WG) + (size_t)od * 2048 * 256, drow - j0 + j0, scr, 64 * kb, j0, lane);
            continue; } r -= NG;
        {
            const int l = r / 384, rem = r % 384, ec = rem >> 4, ks = rem & 15, k0 = ks * 64;
#pragma unroll
            for (int rr = 0; rr < 9; ++rr) { const float cv = rr == 0 ? P.in[I_CCTX][k0 + lane] : P.in[I_C][(rr - 1) * 1024 + k0 + lane]; scr[rr * 64 + lane] = siluf_(cv); }
            WAVE_SYNC();
            f32x4 acc[9];
#pragma unroll
            for (int rr = 0; rr < 9; ++rr) acc[rr] = (f32x4){0.f, 0.f, 0.f, 0.f};
            const float* wp = P.in[I_WADA] + ((size_t)l * 1024 + k0) * 6144 + ec * 256 + lane * 4;
#pragma unroll 4
            for (int kk = 0; kk < 64; ++kk) { const f32x4 w4 = *(const f32x4*)(wp + (size_t)kk * 6144);
#pragma unroll
                for (int rr = 0; rr < 9; ++rr) acc[rr] += w4 * scr[rr * 64 + kk]; }
            float* part = (float*)(ws + WS_BIG) + ((size_t)(ks * 4 + l) * 9) * 6144 + ec * 256 + lane * 4;
#pragma unroll
            for (int rr = 0; rr < 9; ++rr) *(f32x4*)(part + (size_t)rr * 6144) = acc[rr];
            WAVE_SYNC();
        }
    }
    { u32x4* z = (u32x4*)0; (void)z;
      const size_t per = (size_t)(NB_E - 3104) * 1024 * 2 / 16;
      for (size_t i = (size_t)bid_fresh() * NTHR + tid; i < 2 * per; i += (size_t)grid_fresh() * NTHR) { const size_t e = i / per, q = i % per;
          *(u32x4*)(ws + WS_WINE + (e * NB_E + 3104) * 1024 * 2 + q * 16) = (u32x4){0u, 0u, 0u, 0u}; } }
}

__device__ __forceinline__ void phase_modreduce(int wid0, const Params& P) {
    const int tid = tid_fresh(wid0);
    const float* part = (const float*)(P.ws + WS_BIG); float* mod = (float*)(P.ws + WS_MOD);
    for (int i = bid_fresh() * NTHR + tid; i < 4 * 9 * 6144 / 4; i += grid_fresh() * NTHR) {
        const int l = i / (9 * 1536), e4 = i % 1536;
        f32x4 a = *(const f32x4*)(P.in[I_BADA] + (size_t)l * 6144 + e4 * 4);
#pragma unroll
        for (int ks = 0; ks < 16; ++ks) a += *(const f32x4*)(part + (size_t)ks * 4 * 9 * 6144 + (size_t)i * 4);
        *(f32x4*)(mod + (size_t)i * 4) = a; }
}
__device__ __forceinline__ void phase_rownorm(int wid0, const Params& P, int first, const bf16* obuf, const float* modg, int goff, const float* gpost, int has_next, const float* gpre, const float* mods, int soff, bf16* H) {
    const int tid = tid_fresh(wid0), lane = tid & 63, wave = tid >> 6;
    const int gw = bid_fresh() * NWAVES + wave, NGW = grid_fresh() * NWAVES;
    float* X = P.out;
    for (int m = gw; m < MT; m += NGW) {
        const int modrow = m < MCTX ? 0 : 1 + ((m - MCTX) >> 11);
        const float* mr = modg + (size_t)modrow * 6144; const float* ms = mods + (size_t)modrow * 6144;
        f32x4 x[4];
        if (first) {
            if (m < MCTX) {
#pragma unroll
                for (int j = 0; j < 4; ++j) x[j] = *(const f32x4*)(P.in[I_XP] + (size_t)m * DM + lane * 4 + 256 * j);
            } else {
                const int t = (m - MCTX) & 2047; const float prow = (float)(t >> 6), pcol = (float)(t & 63);
                f32x4 om;
#pragma unroll
                for (int e = 0; e < 4; ++e) om[e] = exp2f(-(float)(lane * 4 + e) * (13.287712379549449f / 256.0f));
#pragma unroll
                for (int j = 0; j < 4; ++j) { x[j] = *(const f32x4*)(P.in[I_XS] + (size_t)(m - MCTX) * DM + lane * 4 + 256 * j);
#pragma unroll
                    for (int e = 0; e < 4; ++e) { const float a = (j < 2 ? prow : pcol) * om[e]; x[j][e] += (j & 1) ? cosf(a) : sinf(a); } }
            }
        } else {
            u32x2 ov[4]; float ss = 0.f;
#pragma unroll
            for (int j = 0; j < 4; ++j) { x[j] = *(const f32x4*)(X + (size_t)m * DM + lane * 4 + 256 * j); ov[j] = *(const u32x2*)(obuf + (size_t)m * DM + lane * 4 + 256 * j); }
#pragma unroll
            for (int j = 0; j < 4; ++j) { const float a = bflo(ov[j].x), b = bfhi(ov[j].x), c = bflo(ov[j].y), d = bfhi(ov[j].y); ss += (a * a + b * b) + (c * c + d * d); }
            const float rs = rsqrtf(wave_sum(ss, lane) * (1.0f / DM) + EPSF);
#pragma unroll
            for (int j = 0; j < 4; ++j) { const f32x4 g4 = *(const f32x4*)(gpost + lane * 4 + 256 * j), gt = *(const f32x4*)(mr + goff + lane * 4 + 256 * j);
                f32x4 o4 = (f32x4){bflo(ov[j].x), bfhi(ov[j].x), bflo(ov[j].y), bfhi(ov[j].y)};
                x[j] += gt * (o4 * rs * g4); }
        }
#pragma unroll
        for (int j = 0; j < 4; ++j) *(f32x4*)(X + (size_t)m * DM + lane * 4 + 256 * j) = x[j];
        if (has_next) {
            float ss = 0.f;
#pragma unroll
            for (int j = 0; j < 4; ++j) ss += (x[j][0] * x[j][0] + x[j][1] * x[j][1]) + (x[j][2] * x[j][2] + x[j][3] * x[j][3]);
            const float rs = rsqrtf(wave_sum(ss, lane) * (1.0f / DM) + EPSF);
#pragma unroll
            for (int j = 0; j < 4; ++j) { const f32x4 g4 = *(const f32x4*)(gpre + lane * 4 + 256 * j), sh = *(const f32x4*)(ms + soff + lane * 4 + 256 * j), sc = *(const f32x4*)(ms + soff + 1024 + lane * 4 + 256 * j);
                const f32x4 h4 = (x[j] * rs * g4) * (sc + 1.0f) + sh;
                u32x2 w; w.x = pk2(h4[0], h4[1]); w.y = pk2(h4[2], h4[3]);
                *(u32x2*)(H + (size_t)m * DM + lane * 4 + 256 * j) = w; }
        }
    }
}

using pg8::Unit;
template <int ACT  > struct EpiBf16 {
    bf16* O; int ldc; float* AB;
    __device__ __forceinline__ void operator()(const f32x4 (&acc)[2][2][4][2], const Unit& u, int wr, int wc, int fr, int fq) const {
        const int row0 = u.pm * 256 + wr * 64 + fr, col0 = u.pn * 256 + wc * 32 + 8 * fq;
        if (AB && u.pn * 256 >= ldc) {
            if (wc == 0 && fq < 2) {
#pragma unroll
                for (int ai = 0; ai < 2; ++ai)
#pragma unroll
                    for (int m = 0; m < 4; ++m) { float* p = AB + (size_t)(row0 + ai * 128 + m * 16) * 16 + 8 * fq; *(f32x4*)p = acc[ai][0][m][0]; *(f32x4*)(p + 4) = acc[ai][0][m][1]; }
            }
            return;
        }
#pragma unroll
        for (int ai = 0; ai < 2; ++ai)
#pragma unroll
            for (int m = 0; m < 4; ++m) { bf16* rowp = O + (size_t)(row0 + ai * 128 + m * 16) * ldc + col0;
#pragma unroll
                for (int bj = 0; bj < 2; ++bj) { f32x4 v0 = acc[ai][bj][m][0], v1 = acc[ai][bj][m][1];
                    if (ACT == 1) {
#pragma unroll
                        for (int j = 0; j < 4; ++j) { const float a = fmaxf(v0[j], 0.f), b = fmaxf(v1[j], 0.f); v0[j] = a * a; v1[j] = b * b; } }
                    u32x4 w; w.x = pk2(v0[0], v0[1]); w.y = pk2(v0[2], v0[3]); w.z = pk2(v1[0], v1[1]); w.w = pk2(v1[2], v1[3]);
                    *(u32x4*)(rowp + bj * 128) = w; } }
    }
};
struct EpiGates {
    unsigned* G; const bf16* X; const float* br; const float* bi; const float* lam;
    __device__ __forceinline__ void operator()(const f32x4 (&acc)[2][2][4][2], const Unit& u, int wr, int wc, int fr, int fq) const {
        const int row0 = u.pm * 256 + wr * 64 + fr, ch0 = u.pn * 128 + wc * 32 + 8 * fq;
#pragma unroll
        for (int n = 0; n < 2; ++n) {
            const f32x4 vbr = *(const f32x4*)(br + ch0 + 4 * n), vbi = *(const f32x4*)(bi + ch0 + 4 * n), l4 = *(const f32x4*)(lam + ch0 + 4 * n);
            f32x4 vsp;
#pragma unroll
            for (int e = 0; e < 4; ++e) vsp[e] = -8.0f * softplusf_(-l4[e]);
#pragma unroll
            for (int ai = 0; ai < 2; ++ai)
#pragma unroll
                for (int m = 0; m < 4; ++m) { const size_t row = (size_t)(row0 + ai * 128 + m * 16);
                    const u32x2 xv = *(const u32x2*)(X + row * DM + ch0 + 4 * n);
                    const float xs[4] = {bflo(xv.x), bfhi(xv.x), bflo(xv.y), bfhi(xv.y)};
                    u32x4 w;
#pragma unroll
                    for (int e = 0; e < 4; ++e) { const float r = sigmoidf_(acc[ai][0][m][n][e] + vbr[e]), ig = sigmoidf_(acc[ai][1][m][n][e] + vbi[e]);
                        const float la = r * vsp[e]; const float a_ = __expf(la); const float b = __builtin_amdgcn_sqrtf(fmaxf(1.0f - a_ * a_, 0.f)) * ig * xs[e];
                        w[e] = pk2(la * 1.4426950408889634f, b); }
                    *(u32x4*)(G + row * DM + ch0 + 4 * n) = w; }
        }
    }
};
constexpr int S5_WLDS = 12800, BU_P = 132, HS_P = 136;
struct S5Dir { float ar, ai; bf16x8 Bf[8]; };
__device__ __forceinline__ void s5_dir_setup(const Params& P, int e, int d, int g, int lane, float& ar, float& ai, bf16x8 (&Bf)[8], bool needB) {
    const int quad = lane >> 4, l15 = lane & 15;
    const float dt = __expf(P.in[I_LOGDT][(e * 2 + d) * 32 + g]);
    const float lr = P.in[I_LAMRE][((e * 2 + d) * 32 + g) * 64 + lane], li = P.in[I_LAMIM][((e * 2 + d) * 32 + g) * 64 + lane];
    const float mag = expf(lr * dt); ar = mag * cosf(li * dt); ai = mag * sinf(li * dt);
    const float den = lr * lr + li * li;
    const float fr = ((ar - 1.0f) * lr + ai * li) / den, fi = (ai * lr - (ar - 1.0f) * li) / den;
    if (needB) {
#pragma unroll
        for (int nt = 0; nt < 8; ++nt) { const int col = 16 * nt + l15, p = col & 63;
            const float frp = shfl_i(fr, p), fip = shfl_i(fi, p);
            bf16x8 v = (bf16x8){0, 0, 0, 0, 0, 0, 0, 0};
            if (quad < 2) { const float* bre = P.in[I_BRE] + ((size_t)(e * 32 + g) * 64 + p) * 16 + quad * 8; const float* bim = P.in[I_BIM] + ((size_t)(e * 32 + g) * 64 + p) * 16 + quad * 8;
#pragma unroll
                for (int j = 0; j < 8; ++j) { const float br = bre[j], bi = bim[j]; const float val = (nt < 4) ? (frp * br - fip * bi) : (frp * bi + fip * br); v[j] = (short)f2bf(val); } }
            Bf[nt] = v; }
    }
}
__device__ __forceinline__ void s5_c_setup(const Params& P, int e, int g, int lane, bf16x8 (&Cf)[4]) {
    const int quad = lane >> 4, l15 = lane & 15;
#pragma unroll
    for (int ks = 0; ks < 4; ++ks) { const int col0 = 32 * ks + quad * 8; const bool im = col0 >= 64;
        const float* src = (im ? P.in[I_CIM] : P.in[I_CRE]) + ((size_t)(e * 32 + g) * 16 + l15) * 64 + (col0 & 63);
        bf16x8 v;
#pragma unroll
        for (int j = 0; j < 8; ++j) v[j] = (short)f2bf(im ? -src[j] : src[j]);
        Cf[ks] = v; }
}
__device__ __forceinline__ void s5_scan_seg(const Params& P, LAS unsigned char* wl, int lane, int d, int g, int m0, float ar, float ai, const bf16x8 (&Bf)[8], const bf16x8 (&Cf)[4],
                                            float& hr, float& hi, int mode, int ymode, const bf16* proj, float* ybuf, bf16* mixout, float dsk) {
    const int quad = lane >> 4, l15 = lane & 15;
    LAS float* BU = (LAS float*)wl; LAS bf16* HS = (LAS bf16*)(wl + 8448);
    for (int bi_ = 0; bi_ < 16; ++bi_) {
        const int blk = d ? 15 - bi_ : bi_;
        const int mb = m0 + 16 * blk;
        if (mode == 0) {
            bf16x8 a = (bf16x8){0, 0, 0, 0, 0, 0, 0, 0};
            if (quad < 2) { const int tt = d ? 15 - l15 : l15; a = *(const bf16x8*)(proj + (size_t)(mb + tt) * NPROJ_E + g * 16 + quad * 8); }
#pragma unroll
            for (int nt = 0; nt < 8; ++nt) { f32x4 acc = mfma16(a, Bf[nt], (f32x4){0.f, 0.f, 0.f, 0.f});
#pragma unroll
                for (int jj = 0; jj < 4; ++jj) BU[(quad * 4 + jj) * BU_P + 16 * nt + l15] = acc[jj]; }
            WAVE_SYNC();
        }
#pragma unroll
        for (int r = 0; r < 16; ++r) {
            float br = 0.f, bim = 0.f;
            if (mode == 0) { br = BU[r * BU_P + lane]; bim = BU[r * BU_P + 64 + lane]; }
            const float nr = ar * hr - ai * hi + br, ni = ar * hi + ai * hr + bim; hr = nr; hi = ni;
            HS[r * HS_P + lane] = (bf16)f2bf(hr); HS[r * HS_P + 64 + lane] = (bf16)f2bf(hi);
        }
        WAVE_SYNC();
        f32x4 y = (f32x4){0.f, 0.f, 0.f, 0.f};
#pragma unroll
        for (int ks = 0; ks < 4; ++ks) { const bf16x8 a = *(const LAS bf16x8*)(HS + l15 * HS_P + 32 * ks + quad * 8); y = mfma16(a, Cf[ks], y); }
        const int ch = g * 16 + l15;
#pragma unroll
        for (int jj = 0; jj < 4; ++jj) { const int row = quad * 4 + jj; const int tt = d ? 15 - row : row; const size_t m = (size_t)(mb + tt);
            float v = y[jj];
            if (ymode == 0) { v += dsk * bf2f(proj[m * NPROJ_E + ch]); ybuf[m * 512 + ch] = v; }
            else { v += ybuf[m * 512 + ch];
                if (ymode == 1) ybuf[m * 512 + ch] = v;
                else { const float z = bf2f(proj[m * NPROJ_E + 512 + ch]); mixout[m * DM + ch] = (bf16)f2bf(geluf_(v) * sigmoidf_(z)); } }
        }
        WAVE_SYNC();
    }
}
__device__ __forceinline__ void s5_task_main(const Params& P, LAS unsigned char* wl, int lane, int e, int sub, int g) {
    const bf16* proj = (const bf16*)(P.ws + WS_BIG); float* ybuf = (float*)(P.ws + WS_YBUF); bf16* mixout = (bf16*)(P.ws + WS_MIX);
    const bool lat = sub >= 32; const int q = sub - 32, b = lat ? (q >> 3) : sub, seg = lat ? (q & 7) : 0;
    const int m0 = lat ? MCTX + b * LLAT + seg * 256 : sub * 256;
    bf16x8 Cf[4]; s5_c_setup(P, e, g, lane, Cf);
    const float dsk = P.in[I_S5D][e * 512 + g * 16 + (lane & 15)];
#pragma unroll 1
    for (int d = 0; d < 2; ++d) {
        float ar, ai; bf16x8 Bf[8]; s5_dir_setup(P, e, d, g, lane, ar, ai, Bf, true);
        float hr = 0.f, hi = 0.f;
        if (lat && ((d == 0 && seg == 0) || (d == 1 && seg == 7))) { const size_t si = ((((size_t)b * 2 + e) * 2 + d) * 32 + g) * 64 + lane; hr = P.in[I_S5RE][si]; hi = P.in[I_S5IM][si]; }
        const int ymode = d == 0 ? 0 : (lat ? 1 : 2);
        s5_scan_seg(P, wl, lane, d, g, m0, ar, ai, Bf, Cf, hr, hi, 0, ymode, proj, ybuf, mixout, dsk);
        if (!lat) { const size_t si = ((((size_t)b * 2 + e) * 2 + d) * 32 + g) * 64 + lane; P.out[OUT_S5RE + si] = hr; P.out[OUT_S5IM + si] = hi; }
        else { float* F = (float*)(P.ws + WS_S5F) + ((((size_t)d * 64 + q) * 32 + g) * 64 + lane) * 2; F[0] = hr; F[1] = hi; }
    }
}
__device__ __forceinline__ void s5_task_corr(const Params& P, LAS unsigned char* wl, int lane, int e, int q, int g) {
    const bf16* proj = (const bf16*)(P.ws + WS_BIG); float* ybuf = (float*)(P.ws + WS_YBUF); bf16* mixout = (bf16*)(P.ws + WS_MIX);
    const int b = q >> 3, seg = q & 7, m0 = MCTX + b * LLAT + seg * 256;
    bf16x8 Cf[4]; s5_c_setup(P, e, g, lane, Cf);
    bf16x8 Bf[8];
#pragma unroll
    for (int i = 0; i < 8; ++i) Bf[i] = (bf16x8){0, 0, 0, 0, 0, 0, 0, 0};
    const float* Fb = (const float*)(P.ws + WS_S5F);
#pragma unroll 1
    for (int d = 0; d < 2; ++d) {
        float ar, ai; s5_dir_setup(P, e, d, g, lane, ar, ai, Bf, false);
        float pr = ar, pi = ai;
#pragma unroll
        for (int i = 0; i < 8; ++i) { const float nr = pr * pr - pi * pi, ni = 2.0f * pr * pi; pr = nr; pi = ni; }
        float hr = 0.f, hi = 0.f;
        const int cnt = d == 0 ? seg : 7 - seg;
        for (int i = 0; i < cnt; ++i) { const int sj = d == 0 ? i : 7 - i; const float* F = Fb + ((((size_t)d * 64 + b * 8 + sj) * 32 + g) * 64 + lane) * 2;
            const float nr = pr * hr - pi * hi + F[0], ni = pr * hi + pi * hr + F[1]; hr = nr; hi = ni; }
        if (cnt > 0) s5_scan_seg(P, wl, lane, d, g, m0, ar, ai, Bf, Cf, hr, hi, 1, 1, proj, ybuf, mixout, 0.f);
    }
    __builtin_amdgcn_wave_barrier();
    for (int i = lane; i < 256 * 16; i += 64) { const size_t m = (size_t)(m0 + (i >> 4)); const int ch = g * 16 + (i & 15);
        const float v = ybuf[m * 512 + ch]; const float z = bf2f(proj[m * NPROJ_E + 512 + ch]);
        mixout[m * DM + ch] = (bf16)f2bf(geluf_(v) * sigmoidf_(z)); }
}

constexpr int G_Q = 0, G_K = 17408, G_V = 34816, G_KT = 52224, G_LM = 70656, G_QK = 89088, G_ST = 98304, G_SM = 133120;
constexpr int P128 = 136, P64 = 72, LMP = 68;
__device__ __forceinline__ bf16x8 ld_split8(const LAS bf16* p) {
    const u32x2 a = *(const LAS u32x2*)p, b = *(const LAS u32x2*)(p + 16);
    return __builtin_bit_cast(bf16x8, (u32x4){a.x, a.y, b.x, b.y});
}
__device__ __forceinline__ bf16x8 pack_acc2(const f32x4& a, const f32x4& b) { return __builtin_bit_cast(bf16x8, (u32x4){pk2(a[0], a[1]), pk2(a[2], a[3]), pk2(b[0], b[1]), pk2(b[2], b[3])}); }
__device__ __forceinline__ void gdn_chain(int wid0, const Params& P, LAS unsigned char* lds, int e, int s, int hd, int dir) {
    const int tid = tid_fresh(wid0), lane = tid & 63, w = __builtin_amdgcn_readfirstlane(tid >> 6), quad = lane >> 4, l15 = lane & 15;
    const bool lat = s >= 32; const int b = lat ? s - 32 : s; const int L = lat ? LLAT : LCTX; const int m0 = lat ? MCTX + b * LLAT : s * LCTX;
    const bf16* proj = (const bf16*)(P.ws + WS_BIG); const float* AB = (const float*)(P.ws + WS_AB);
    bf16* Odir = (bf16*)(P.ws + WS_H) + (size_t)dir * MT * 512;
    int zv; asm volatile("v_mov_b32 %0, 0" : "=v"(zv));
    lds += zv;
    LAS bf16* Qs = (LAS bf16*)(lds + G_Q); LAS bf16* Ks = (LAS bf16*)(lds + G_K); LAS bf16* Vs = (LAS bf16*)(lds + G_V); LAS bf16* KT = (LAS bf16*)(lds + G_KT);
    LAS float* Lm = (LAS float*)(lds + G_LM); LAS bf16* VNT = (LAS bf16*)(lds + G_LM); LAS bf16* QKs = (LAS bf16*)(lds + G_QK); LAS bf16* ST = (LAS bf16*)(lds + G_ST);
    LAS float* rq = (LAS float*)(lds + G_SM); LAS float* rk = rq + 64; LAS float* gcs = rq + 128; LAS float* betas = rq + 192; LAS float* egs = rq + 256; LAS float* kes = rq + 320;
    f32x4 Sacc[8];
    const size_t sbase = ((((size_t)b * 2 + e) * 2 + dir) * 4 + hd) * 16384;
#pragma unroll
    for (int mt = 0; mt < 8; ++mt) Sacc[mt] = (f32x4){0.f, 0.f, 0.f, 0.f};
    if (lat) { const float* sp = P.in[I_SDELTA] + sbase + (size_t)(quad * 4) * 128 + 16 * w + l15;
#pragma unroll
        for (int mt = 0; mt < 8; ++mt)
#pragma unroll
            for (int jj = 0; jj < 4; ++jj) Sacc[mt][jj] = sp[(16 * mt + jj) * 128]; }
    const float alog_e = __expf(P.in[I_GALOG][(e * 2 + dir) * 4 + hd]), dtb = P.in[I_GDTB][(e * 2 + dir) * 4 + hd];
    const int nchunk = L / 64;
#pragma unroll 1
    for (int ci = 0; ci < nchunk; ++ci) {
        const int c0 = dir ? L - 64 * (ci + 1) : 64 * ci;
        __syncthreads();
#ifndef NO_A
        { const int dd = tid & 127, tq = __builtin_amdgcn_readfirstlane(tid >> 7);
          const int tb = c0 + tq * 16;
          float xr[3][19];
#pragma unroll
          for (int k = 0; k < 19; ++k) { const int t = tb - 1 + k; const bool ok = (t >= 0) && (t < L); const bf16* rowp = proj + (size_t)(m0 + (ok ? t : tb)) * NPROJ_E + 1024 + hd * 128 + dd;
#pragma unroll
              for (int part = 0; part < 3; ++part) { const float v = bf2f(rowp[part * 512]); xr[part][k] = ok ? v : 0.f; } }
#pragma unroll
          for (int part = 0; part < 3; ++part) { const int ccol = part * 512 + hd * 128 + dd;
              const float* cw = P.in[I_GCONVW] + (size_t)e * 4 * 1536 + ccol; const float w0 = cw[0], w1 = cw[1536], w2 = cw[3072], w3 = cw[4608], cb = P.in[I_GCONVB][e * 1536 + ccol];
              LAS bf16* dst = part == 0 ? Qs : (part == 1 ? Ks : Vs);
#pragma unroll
              for (int n = 0; n < 16; ++n) { const float v = cb + w0 * xr[part][n] + w1 * xr[part][n + 1] + w2 * xr[part][n + 2] + w3 * xr[part][n + 3];
                  const int nn = tq * 16 + n; const int r = dir ? 63 - nn : nn;
                  dst[r * P128 + dd] = (bf16)f2bf(siluf_(v)); } } }
#endif
        __syncthreads();
        { const int rowid = tid >> 2, part = tid & 3; LAS bf16* src = (rowid < 64 ? Qs : Ks) + (rowid & 63) * P128 + part * 32;
          float ss = 0.f;
#pragma unroll
          for (int i = 0; i < 4; ++i) { const u32x4 v = *(const LAS u32x4*)(src + 8 * i);
#pragma unroll
              for (int j = 0; j < 4; ++j) { const float a = bflo(v[j]), c = bfhi(v[j]); ss += a * a + c * c; } }
          ss += shfl_i(ss, lane ^ 1); ss += shfl_i(ss, lane ^ 2);
          if (part == 0) { if (rowid < 64) rq[rowid] = rsqrtf(ss + EPSF) * 0.08838834764831845f; else rk[rowid - 64] = rsqrtf(ss + EPSF); }
          if (w == 0) { const int t = c0 + (dir ? 63 - lane : lane); const size_t m = (size_t)(m0 + t);
              const float araw = AB[m * 16 + dir * 4 + hd], braw = AB[m * 16 + 8 + dir * 4 + hd];
              const float gg = -alog_e * softplusf_(araw + dtb);
              float gc = gg;
#pragma unroll
              for (int o = 1; o < 64; o <<= 1) { const float t2 = shfl_i(gc, (lane - o) & 63); if (lane >= o) gc += t2; }
              const float glast = shfl_i(gc, 63);
              gcs[lane] = gc; betas[lane] = sigmoidf_(braw); egs[lane] = __expf(gc); kes[lane] = __expf(glast - gc);
              if (lane == 0) rq[384] = __expf(glast); } }
        __syncthreads();
#ifndef NO_C
        { const int mt = w & 3; const bool isq = w >= 4; LAS bf16* src = isq ? Qs : Ks;
          bf16x8 a[4];
#pragma unroll
          for (int ks = 0; ks < 4; ++ks) a[ks] = *(const LAS bf16x8*)(src + (16 * mt + l15) * P128 + 32 * ks + quad * 8);
#pragma unroll 1
          for (int nt = 0; nt < 4; ++nt) { f32x4 acc = (f32x4){0.f, 0.f, 0.f, 0.f};
#pragma unroll
              for (int ks = 0; ks < 4; ++ks) { const bf16x8 bb = *(const LAS bf16x8*)(Ks + (16 * nt + l15) * P128 + 32 * ks + quad * 8); acc = mfma16(a[ks], bb, acc); }
              const int j = 16 * nt + l15; const float rkj = rk[j], gcj = gcs[j];
              f32x4 lv;
#pragma unroll
              for (int jj = 0; jj < 4; ++jj) { const int i = 16 * mt + quad * 4 + jj; const float dec = __expf(fminf(gcs[i] - gcj, 0.f));
                  lv[jj] = (i > j) ? acc[jj] * rk[i] * rkj * betas[i] * dec : 0.f;
                  if (isq) QKs[i * P64 + j] = (bf16)f2bf((i >= j) ? acc[jj] * rq[i] * rkj * dec : 0.f); }
              if (!isq) *(LAS f32x4*)(Lm + j * LMP + 16 * mt + quad * 4) = lv; }
          const int dd = tid & 127, tq = tid >> 7;
          unsigned pw[8];
#pragma unroll
          for (int n = 0; n < 16; n += 2) { const int i0 = tq * 16 + n; const float v0 = bf2f(Ks[i0 * P128 + dd]) * rk[i0] * kes[i0], v1 = bf2f(Ks[(i0 + 1) * P128 + dd]) * rk[i0 + 1] * kes[i0 + 1]; pw[n >> 1] = pk2(v0, v1); }
          *(LAS u32x4*)(KT + dd * P64 + tq * 16) = (u32x4){pw[0], pw[1], pw[2], pw[3]};
          *(LAS u32x4*)(KT + dd * P64 + tq * 16 + 8) = (u32x4){pw[4], pw[5], pw[6], pw[7]}; }
#endif
        __syncthreads();
#ifndef NO_D
        if (tid < 256) { const bool isv = tid < 128; const int cc = tid & 127; LAS bf16* col = (isv ? Vs : Ks) + cc;
#pragma unroll 1
            for (int bb = 0; bb < 4; ++bb) {
                float sx[16];
#pragma unroll
                for (int r = 0; r < 16; ++r) { const int i = 16 * bb + r; const float sc = isv ? betas[i] : rk[i] * betas[i] * egs[i]; sx[r] = bf2f(col[i * P128]) * sc; }
#pragma unroll 2
                for (int j = 0; j < 16 * bb; ++j) { const float xj = bf2f(col[j * P128]);
#pragma unroll
                    for (int q4 = 0; q4 < 4; ++q4) { const f32x4 l4 = *(const LAS f32x4*)(Lm + j * LMP + 16 * bb + 4 * q4);
#pragma unroll
                        for (int jx = 0; jx < 4; ++jx) sx[4 * q4 + jx] -= l4[jx] * xj; } }
#pragma unroll
                for (int rp = 0; rp < 15; ++rp) { const float xj = sx[rp];
#pragma unroll
                    for (int q4 = rp / 4; q4 < 4; ++q4) { const f32x4 l4 = *(const LAS f32x4*)(Lm + (16 * bb + rp) * LMP + 16 * bb + 4 * q4);
#pragma unroll
                        for (int jx = 0; jx < 4; ++jx) if (4 * q4 + jx > rp) sx[4 * q4 + jx] -= l4[jx] * xj; } }
#pragma unroll
                for (int r = 0; r < 16; ++r) col[(16 * bb + r) * P128] = (bf16)f2bf(sx[r]);
            } }
#endif
        __syncthreads();
#ifndef NO_EFG
        bf16x8 Bst[4];
#pragma unroll
        for (int ks = 0; ks < 4; ++ks) Bst[ks] = pack_acc2(Sacc[2 * ks], Sacc[2 * ks + 1]);
        f32x4 vn[4];
#pragma unroll
        for (int mt = 0; mt < 4; ++mt) { f32x4 acc = (f32x4){0.f, 0.f, 0.f, 0.f};
#pragma unroll
            for (int ks = 0; ks < 4; ++ks) { const bf16x8 a = ld_split8(Ks + (16 * mt + l15) * P128 + 32 * ks + quad * 4); acc = mfma16(a, Bst[ks], acc); }
#pragma unroll
            for (int jj = 0; jj < 4; ++jj) vn[mt][jj] = bf2f(Vs[(16 * mt + quad * 4 + jj) * P128 + 16 * w + l15]) - acc[jj]; }
        bf16x8 Bvn[2];
#pragma unroll
        for (int k2 = 0; k2 < 2; ++k2) Bvn[k2] = pack_acc2(vn[2 * k2], vn[2 * k2 + 1]);
#pragma unroll 1
        for (int mt = 0; mt < 4; ++mt) { f32x4 acc = (f32x4){0.f, 0.f, 0.f, 0.f};
#pragma unroll
            for (int ks = 0; ks < 4; ++ks) { const bf16x8 a = ld_split8(Qs + (16 * mt + l15) * P128 + 32 * ks + quad * 4); acc = mfma16(a, Bst[ks], acc); }
#pragma unroll
            for (int jj = 0; jj < 4; ++jj) { const int i = 16 * mt + quad * 4 + jj; acc[jj] *= rq[i] * egs[i]; }
#pragma unroll
            for (int k2 = 0; k2 < 2; ++k2) { const bf16x8 a = ld_split8(QKs + (16 * mt + l15) * P64 + 32 * k2 + quad * 4); acc = mfma16(a, Bvn[k2], acc); }
#pragma unroll
            for (int jj = 0; jj < 4; ++jj) { const int i = 16 * mt + quad * 4 + jj; const int t = c0 + (dir ? 63 - i : i);
                Odir[(size_t)(m0 + t) * 512 + hd * 128 + 16 * w + l15] = (bf16)f2bf(acc[jj]); } }
        const float egl = rq[384];
#pragma unroll
        for (int mt = 0; mt < 8; ++mt) { f32x4 acc = Sacc[mt] * egl;
#pragma unroll
            for (int k2 = 0; k2 < 2; ++k2) { const bf16x8 a = ld_split8(KT + (16 * mt + l15) * P64 + 32 * k2 + quad * 4); acc = mfma16(a, Bvn[k2], acc); }
            Sacc[mt] = acc; }
#endif
        WAVE_SYNC();
    }
    if (!lat) { float* dp = P.out + OUT_DELTA + sbase + (size_t)(quad * 4) * 128 + 16 * w + l15;
#pragma unroll
        for (int mt = 0; mt < 8; ++mt)
#pragma unroll
            for (int jj = 0; jj < 4; ++jj) dp[(16 * mt + jj) * 128] = Sacc[mt][jj];
    }
    __syncthreads();
}

__device__ __forceinline__ void phase_mix_even(int wid0, const Params& P, LAS unsigned char* lds, int e, int mode = 3) {
    const int bid = bid_fresh(), G = grid_fresh();
    if (G == 256) {
        if (bid < 64) { const int s = 32 + (bid >> 3), hd = (bid >> 1) & 3, dir = bid & 1; if (mode & 1) gdn_chain(wid0, P, lds, e, s, hd, dir); }
        else { const int bb = bid - 64;
            if (mode & 1) for (int c = bb; c < 256; c += 192) { const int s = c >> 3, hd = (c >> 1) & 3, dir = c & 1; gdn_chain(wid0, P, lds, e, s, hd, dir); }
            if (mode & 2) { const int tid = tid_fresh(wid0), lane = tid & 63, wave = tid >> 6;
                for (int t = bb; t < 384; t += 192) { const int wt = t * 8 + wave; s5_task_main(P, lds + wave * S5_WLDS, lane, e, wt >> 5, wt & 31); } } }
    } else {
        for (int c = bid; c < 320; c += G) { const int s = c < 64 ? 32 + (c >> 3) : ((c - 64) >> 3), hd = (c >> 1) & 3, dir = c & 1; gdn_chain(wid0, P, lds, e, s, hd, dir); }
        const int tid = tid_fresh(wid0), lane = tid & 63, wave = tid >> 6;
        for (int t = bid; t < 384; t += G) { const int wt = t * 8 + wave; s5_task_main(P, lds + wave * S5_WLDS, lane, e, wt >> 5, wt & 31); }
    }
}
__device__ __forceinline__ void phase_fin_even(int wid0, const Params& P, LAS unsigned char* lds, int e) {
    const int tid = tid_fresh(wid0), lane = tid & 63, wave = tid >> 6;
    const int gw = bid_fresh() * NWAVES + wave, NGW = grid_fresh() * NWAVES;
    for (int wt = gw; wt < 2048; wt += NGW) s5_task_corr(P, lds + wave * S5_WLDS, lane, e, wt >> 5, wt & 31);
    const bf16* proj = (const bf16*)(P.ws + WS_BIG); const bf16* Of = (const bf16*)(P.ws + WS_H); const bf16* Ob = Of + (size_t)MT * 512; bf16* mixout = (bf16*)(P.ws + WS_MIX);
    for (int m = gw; m < MT; m += NGW) {
        const u32x4 a = *(const u32x4*)(Of + (size_t)m * 512 + lane * 8), bq = *(const u32x4*)(Ob + (size_t)m * 512 + lane * 8), z = *(const u32x4*)(proj + (size_t)m * NPROJ_E + 2560 + lane * 8);
        float o[8]; float ss = 0.f;
#pragma unroll
        for (int j = 0; j < 4; ++j) { o[2 * j] = bflo(a[j]) + bflo(bq[j]); o[2 * j + 1] = bfhi(a[j]) + bfhi(bq[j]); ss += o[2 * j] * o[2 * j] + o[2 * j + 1] * o[2 * j + 1]; }
        ss += shfl_i(ss, lane ^ 1); ss += shfl_i(ss, lane ^ 2); ss += shfl_i(ss, lane ^ 4); ss += shfl_i(ss, lane ^ 8);
        const float rs = rsqrtf(ss * (1.0f / 128.0f) + EPSF);
        const float* gn = P.in[I_GONORM] + e * 128 + (lane & 15) * 8;
        unsigned pw[4];
#pragma unroll
        for (int j = 0; j < 4; ++j) { const float z0 = bflo(z[j]), z1 = bfhi(z[j]); pw[j] = pk2(o[2 * j] * rs * gn[2 * j] * siluf_(z0), o[2 * j + 1] * rs * gn[2 * j + 1] * siluf_(z1)); }
        *(u32x4*)(mixout + (size_t)m * DM + 512 + lane * 8) = (u32x4){pw[0], pw[1], pw[2], pw[3]};
    }
}

__device__ __forceinline__ void phase_conv_odd(int wid0, const Params& P, int o) {
    const int tid = tid_fresh(wid0), lane = tid & 63, wave = tid >> 6;
    const int gw = bid_fresh() * NWAVES + wave, NGW = grid_fresh() * NWAVES;
    const bf16* proj = (const bf16*)(P.ws + WS_BIG); bf16* cx = (bf16*)(P.ws + WS_H);
    const float* cw = P.in[I_LCONVW] + (size_t)o * 4 * 1024; const float* cb = P.in[I_LCONVB] + o * 1024;
    for (int m = gw; m < MT; m += NGW) {
        const int t = m < MCTX ? (m & 255) : ((m - MCTX) & 2047); const int L = m < MCTX ? LCTX : LLAT;
#pragma unroll
        for (int h2 = 0; h2 < 2; ++h2) { const int ch = lane * 8 + 512 * h2;
            float acc[8];
#pragma unroll
            for (int j = 0; j < 8; ++j) acc[j] = cb[ch + j];
#pragma unroll
            for (int k = 0; k < 4; ++k) { const int tt = t - 1 + k; if (tt >= 0 && tt < L) { const u32x4 v = *(const u32x4*)(proj + (size_t)(m - 1 + k) * 2048 + ch);
#pragma unroll
                    for (int j = 0; j < 4; ++j) { acc[2 * j] += cw[k * 1024 + ch + 2 * j] * bflo(v[j]); acc[2 * j + 1] += cw[k * 1024 + ch + 2 * j + 1] * bfhi(v[j]); } } }
            *(u32x4*)(cx + (size_t)m * DM + ch) = (u32x4){pk2(acc[0], acc[1]), pk2(acc[2], acc[3]), pk2(acc[4], acc[5]), pk2(acc[6], acc[7])}; }
    }
}
__device__ __forceinline__ void phase_lru_scan(int wid0, const Params& P, int o, int d) {
    const int tid = tid_fresh(wid0), lane = tid & 63, wave = tid >> 6;
    const int gw = bid_fresh() * NWAVES + wave, NGW = grid_fresh() * NWAVES;
    const unsigned* G = (const unsigned*)(P.ws + WS_GATES); const bf16* proj = (const bf16*)(P.ws + WS_BIG); bf16* mixout = (bf16*)(P.ws + WS_MIX);
    for (int task = gw; task < 640; task += NGW) {
        int s, cg_;
        if (task < 128) { s = 32 + (task >> 4); cg_ = task & 15; } else { s = (task - 128) >> 4; cg_ = (task - 128) & 15; }
        const bool lat = s >= 32; const int b = lat ? s - 32 : s; const int L = lat ? LLAT : LCTX; const int m0 = lat ? MCTX + b * LLAT : s * LCTX;
        const int ch = cg_ * 64 + lane;
        float h = lat ? P.in[I_SLRU][(((size_t)b * 2 + o) * 2 + d) * 1024 + ch] : 0.f;
        if (d == 0) {
            for (int t0 = 0; t0 < L; t0 += 32) {
                unsigned gv[32];
#pragma unroll
                for (int i = 0; i < 32; ++i) gv[i] = G[(size_t)(m0 + t0 + i) * DM + ch];
#pragma unroll
                for (int i = 0; i < 32; ++i) { h = __builtin_amdgcn_exp2f(bflo(gv[i])) * h + bfhi(gv[i]); mixout[(size_t)(m0 + t0 + i) * DM + ch] = (bf16)f2bf(h); }
            }
        } else {
            for (int t0 = 0; t0 < L; t0 += 16) {
                unsigned gv[16]; bf16 pv[16], yv[16];
#pragma unroll
                for (int i = 0; i < 16; ++i) { const size_t m = (size_t)(m0 + L - 1 - (t0 + i)); gv[i] = G[m * DM + ch]; pv[i] = mixout[m * DM + ch]; yv[i] = proj[m * 2048 + 1024 + ch]; }
#pragma unroll
                for (int i = 0; i < 16; ++i) { const size_t m = (size_t)(m0 + L - 1 - (t0 + i));
                    h = __builtin_amdgcn_exp2f(bflo(gv[i])) * h + bfhi(gv[i]);
                    mixout[m * DM + ch] = (bf16)f2bf((bf2f(pv[i]) + h) * geluf_(bf2f(yv[i]))); }
            }
        }
        if (!lat) P.out[OUT_LRU + (((size_t)b * 2 + o) * 2 + d) * 1024 + ch] = h;
    }
}
#ifdef PROBE_DUP_GEMM
#define DUPG(x) GSYNC(); x
#else
#define DUPG(x)
#endif
typedef const __attribute__((address_space(4))) Params* KParams;
__device__ __forceinline__ Params load_params(KParams q) { Params r;
#pragma unroll
    for (int i = 0; i < 40; ++i) r.in[i] = q->in[i];
    r.out = q->out; r.ws = q->ws; return r; }
#define FRESH() const int G = grid_fresh(), bid = bid_fresh(); (void)G; (void)bid; KParams pk_ = (KParams)__builtin_amdgcn_kernarg_segment_ptr(); asm volatile("" : "+s"(pk_)); const Params P = load_params(pk_); unsigned char* ws = P.ws; \
    const float* mod = (const float*)(ws + WS_MOD); bf16* H = (bf16*)(ws + WS_H); bf16* BIG = (bf16*)(ws + WS_BIG); bf16* MIX = (bf16*)(ws + WS_MIX); (void)mod; (void)H; (void)BIG; (void)MIX;
#define GSYNC() do { KParams pb_ = (KParams)__builtin_amdgcn_kernarg_segment_ptr(); asm volatile("" : "+s"(pb_)); xcd_barrier(wid0, (unsigned*)(pb_->ws + WS_BAR), lds); } while (0)
__global__ void __launch_bounds__(NTHR, 2) fwd_kernel(Params Parg) {
    extern __shared__ __attribute__((aligned(16))) unsigned char lds_raw[];
    LAS unsigned char* lds = (LAS unsigned char*)lds_raw;
    cg::grid_group grid = cg::this_grid();
    const int wid0 = __builtin_amdgcn_readfirstlane(threadIdx.x >> 6);
    if (threadIdx.x < 4) ((LAS unsigned*)(lds + LDS_BARST))[threadIdx.x] = 0u;
    __syncthreads();
    if (threadIdx.x == 0) (void)xb_add((unsigned*)(Parg.ws + WS_BAR) + XB_XCNT(xb_xcc_id()), 1u);

    { FRESH(); phase_prologue(wid0, P, lds); }
    grid.sync();
#ifdef PROBE_DUP_PRO
    { FRESH(); phase_prologue(wid0, P, lds); }
    GSYNC();
#endif
    { FRESH(); phase_modreduce(wid0, P); }
    GSYNC();
#ifdef PROBE_SYNC
#pragma unroll 1
    for (int i = 0; i < 40; ++i) GSYNC();
#endif
#pragma unroll 1
    for (int l = 0; l < 4; ++l) {
        { FRESH(); const float* modl = mod + (size_t)l * 9 * 6144;
        phase_rownorm(wid0, P, l == 0, MIX, modl - 9 * 6144, 5 * 1024, P.in[I_NMLPPOST] + (l > 0 ? (l - 1) * 1024 : 0), 1, P.in[I_NMIXPRE] + l * 1024, modl, 0, H); }
        GSYNC();
        const int eo = l >> 1;
        {
            FRESH();
            pg8::Gemm g; pg8::StaticOrder S; EpiBf16<0> E;
            if ((l & 1) == 0) { g = pg8::Gemm{H, (const bf16*)(ws + WS_WINE) + (size_t)eo * NB_E * 1024, MT, NB_E, 1024, 1024, 0, 0}; E = EpiBf16<0>{BIG, NPROJ_E, (float*)(ws + WS_AB)}; }
            else { g = pg8::Gemm{H, (const bf16*)(ws + WS_WINO) + (size_t)eo * 2048 * 1024, MT, 2048, 1024, 1024, 0, 0}; E = EpiBf16<0>{BIG, 2048, nullptr}; }
            S.init(g.M, g.N, G, bid);
            pg8::gemm_phase(wid0, lds, g, S, E); DUPG(pg8::gemm_phase(wid0, lds, g, S, E);)
        }
        GSYNC();
        if ((l & 1) == 0) {
#ifdef PROBE_DUP_MIX
#pragma unroll 1
            for (int rep = 0; rep < 2; ++rep) { { FRESH(); phase_mix_even(wid0, P, lds, eo, rep == 0 ? 3 : PROBE_DUP_MIX); } GSYNC(); }
#else
            { FRESH(); phase_mix_even(wid0, P, lds, eo); }
            GSYNC();
#endif
            { FRESH(); phase_fin_even(wid0, P, lds, eo); }
            GSYNC();
        } else {
            { FRESH(); phase_conv_odd(wid0, P, eo); }
            GSYNC();
#ifdef PROBE_DUP_CONV
            { FRESH(); phase_conv_odd(wid0, P, eo); }
            GSYNC();
#endif
#pragma unroll 1
            for (int d = 0; d < 2; ++d) {
                { FRESH();
                pg8::Gemm g{H, (const bf16*)(ws + WS_WG) + (size_t)(eo * 2 + d) * 2048 * 256, MT, 2048, 256, 1024, 1, 1};
                EpiGates E{(unsigned*)(ws + WS_GATES), H, P.in[I_LBR] + (eo * 2 + d) * 1024, P.in[I_LBI] + (eo * 2 + d) * 1024, P.in[I_LLAM] + (eo * 2 + d) * 1024};
                pg8::StaticOrder S; S.init(g.M, g.N, G, bid);
                pg8::gemm_phase(wid0, lds, g, S, E); DUPG(pg8::gemm_phase(wid0, lds, g, S, E);) }
                GSYNC();
                { FRESH(); phase_lru_scan(wid0, P, eo, d); }
#ifdef PROBE_DUP_LRU0
                if (d == 0) { GSYNC(); FRESH(); phase_lru_scan(wid0, P, eo, d); }
#endif
                GSYNC();
            }
        }
        {
            FRESH();
            pg8::Gemm g{MIX, (const bf16*)(ws + ((l & 1) ? WS_WOUTO : WS_WOUTE)) + (size_t)eo * 1024 * 1024, MT, 1024, 1024, 1024, 0, 0};
            EpiBf16<0> E{BIG, 1024, nullptr}; pg8::StaticOrder S; S.init(g.M, g.N, G, bid);
            pg8::gemm_phase(wid0, lds, g, S, E); DUPG(pg8::gemm_phase(wid0, lds, g, S, E);)
        }
        GSYNC();
        { FRESH(); const float* modl = mod + (size_t)l * 9 * 6144;
        phase_rownorm(wid0, P, 0, BIG, modl, 2 * 1024, P.in[I_NMIXPOST] + l * 1024, 1, P.in[I_NMLPPRE] + l * 1024, modl, 3 * 1024, H); }
        GSYNC();
        {
            FRESH();
            pg8::Gemm g{H, (const bf16*)(ws + WS_W1T) + (size_t)l * 4096 * 1024, MT, 4096, 1024, 1024, 0, 0};
            EpiBf16<1> E{BIG, 4096, nullptr}; pg8::StaticOrder S; S.init(g.M, g.N, G, bid);
            pg8::gemm_phase(wid0, lds, g, S, E); DUPG(pg8::gemm_phase(wid0, lds, g, S, E);)
        }
        GSYNC();
        {
            FRESH();
            pg8::Gemm g{BIG, (const bf16*)(ws + WS_W2T) + (size_t)l * 1024 * 4096, MT, 1024, 4096, 4096, 0, 0};
            EpiBf16<0> E{MIX, 1024, nullptr}; pg8::StaticOrder S; S.init(g.M, g.N, G, bid);
            pg8::gemm_phase(wid0, lds, g, S, E); DUPG(pg8::gemm_phase(wid0, lds, g, S, E);)
        }
        GSYNC();
    }
    { FRESH();
    phase_rownorm(wid0, P, 0, MIX, mod + (size_t)3 * 9 * 6144, 5 * 1024, P.in[I_NMLPPOST] + 3 * 1024, 0, P.in[I_NMIXPRE], mod, 0, H); }
}

extern "C" void kernel_launch(void* const* d_in, const int* in_sizes, int n_in, void* d_out, int out_size, void* d_ws, size_t ws_size, hipStream_t stream) {
    static int grid = 0;
    if (grid == 0) {
        if (n_in != 40 || ws_size < WS_END) { fprintf(stderr, "kernel_launch: expected 40 inputs and >= %zu bytes of workspace (got %d, %zu)\n", (size_t)WS_END, n_in, ws_size); grid = -1; return; }
        int dev = 0, cus = 0, per_cu = 0;
        if (hipGetDevice(&dev) != hipSuccess || hipDeviceGetAttribute(&cus, hipDeviceAttributeMultiprocessorCount, dev) != hipSuccess) { grid = -1; return; }
        if (hipFuncSetAttribute((const void*)fwd_kernel, hipFuncAttributeMaxDynamicSharedMemorySize, LDS_BYTES) != hipSuccess) { fprintf(stderr, "kernel_launch: hipFuncSetAttribute failed\n"); grid = -1; return; }
        if (hipOccupancyMaxActiveBlocksPerMultiprocessor(&per_cu, (const void*)fwd_kernel, NTHR, LDS_BYTES) != hipSuccess || per_cu < 1) per_cu = 1;
        (void)hipGetLastError();
        grid = cus * per_cu; if (grid > 256) grid = 256;
    }
    if (grid < 0) return;
    (void)hipMemsetAsync((char*)d_ws + WS_BAR, 0, 16384, stream);
    Params p{};
    for (int i = 0; i < 40; ++i) p.in[i] = (const float*)d_in[i];
    p.out = (float*)d_out; p.ws = (unsigned char*)d_ws;
    void* args[] = {&p};
    hipError_t e = hipLaunchCooperativeKernel((const void*)fwd_kernel, dim3(grid), dim3(NTHR), args, LDS_BYTES, stream);
    if (e != hipSuccess) fprintf(stderr, "cooperative launch failed: %s (grid %d)\n", hipGetErrorString(e), grid);
}
```

```cpp
#include <hip/hip_runtime.h>
#include <hip/hip_cooperative_groups.h>
#include <cstdio>
#include <cstdint>
namespace cg = cooperative_groups;
__device__ __forceinline__ int bid_fresh() { int t = blockIdx.x; asm volatile("" : "+s"(t)); return t; }
__device__ __forceinline__ int grid_fresh() { int t = gridDim.x; asm volatile("" : "+s"(t)); return t; }
__device__ __forceinline__ int tid_fresh(int w) { asm volatile("" : "+s"(w)); int l; asm volatile("v_mbcnt_lo_u32_b32 %0, -1, 0\n\tv_mbcnt_hi_u32_b32 %0, -1, %0" : "=v"(l)); return w * 64 + l; }

namespace pg8 {
#define PG8_LAS __attribute__((address_space(3)))
typedef unsigned short bf16_t;
typedef short bf16x8 __attribute__((ext_vector_type(8)));
typedef float f32x4 __attribute__((ext_vector_type(4)));
typedef unsigned u32x4 __attribute__((ext_vector_type(4)));
typedef unsigned u32x2 __attribute__((ext_vector_type(2)));
constexpr int BM = 256, BK = 64, HALF = 128, HTB = HALF * BK * 2, STAGE_BYTES = 8 * HTB, NXCD = 8, WGM = 8;

__host__ __device__ __forceinline__ int lds_byte(int r, int c) { const int st = (r >> 4) * 2 + (c >> 5), rr = r & 15, cc = c & 31, ob = rr * 64 + cc * 2; return st * 1024 + (ob ^ (((ob >> 9) & 1) << 5)); }
__host__ __device__ __forceinline__ void stage_rc(int b, int& R, int& C) { const int st = b / 1024, sb = b % 1024, swz = sb ^ (((sb >> 9) & 1) << 5); R = (st >> 1) * 16 + swz / 64; C = (st & 1) * 32 + (swz % 64) / 2; }
__host__ __device__ __forceinline__ int perm32(int rho) { const int n = rho >> 4, i = rho & 15; return 8 * (i >> 2) + 4 * n + (i & 3); }

struct Unit { int pm, pn; };
struct Gemm { const bf16_t* A; const bf16_t* Bt; int M, N, K, lda, ablk, ashift; };

struct StaticOrder {
    int nM, nN, nwg, G, c;
    __host__ __device__ void init(int M, int N, int G_, int c_) { nM = M / BM; nN = N / BM; nwg = nM * nN; G = G_; c = c_; }
    __host__ __device__ bool next(int i, Unit& u) const {
        const long L = (long)i * G + c; if (L >= nwg) return false;
        int wgid = (int)L; { const int q = nwg / NXCD, r = nwg % NXCD, xcd = wgid % NXCD, off = wgid / NXCD; wgid = (xcd < r ? xcd * (q + 1) : r * (q + 1) + (xcd - r) * q) + off; }
        const int nig = WGM * nN, gid = wgid / nig, fm = gid * WGM, gsz = (nM - fm) < WGM ? (nM - fm) : WGM;
        u.pm = fm + ((wgid % nig) % gsz); u.pn = (wgid % nig) / gsz; return true;
    }
};
__device__ __forceinline__ unsigned cvt_pk_bf16(float lo, float hi) { unsigned r; asm volatile("v_cvt_pk_bf16_f32 %0, %1, %2" : "=v"(r) : "v"(lo), "v"(hi)); return r; }

template <class Epi>
__device__ __forceinline__ void gemm_phase(int wid0, PG8_LAS unsigned char* lds, const Gemm g, const StaticOrder& S, const Epi& E) {
    const int tid = tid_fresh(wid0), wid = __builtin_amdgcn_readfirstlane(tid >> 6), lane = tid & 63, wr = wid >> 2, wc = wid & 3, fr = lane & 15, fq = lane >> 4;
    const int K = g.K, nt = K / BK, lda = g.lda;
    unsigned voffA[2], voffB[2];
#pragma unroll
    for (int i = 0; i < 2; ++i) { int R, C; stage_rc(tid * 16 + i * 8192, R, C); const int Rb = (R & ~31) + perm32(R & 31);
        voffA[i] = (unsigned)(R * lda + C) * 2u; voffB[i] = (unsigned)(Rb * K + C) * 2u; }
    const size_t kstep = (size_t)(BK * 2);
    const size_t hstepA = (size_t)HALF * lda * 2, hstepB = (size_t)HALF * K * 2;
    const size_t tstepA = 2 * hstepA, tstepB = 2 * hstepB;
    const unsigned ldsw = (unsigned)wid * 1024u;
    const int aoff = lds_byte(wr * 64 + fr, fq * 8), boff = lds_byte(wc * 32 + fr, fq * 8);
#define PG8_ACOL(pn) (g.ablk ? (size_t)((((pn) >> g.ashift) & 3) * 512) : (size_t)0)
#define PG8_SA(b, h) (((b) * 2 + (h)) * HTB)
#define PG8_SB(b, h) ((4 + (b) * 2 + (h)) * HTB)
#define PG8_STAGE(bufoff, gbase, voff) do { _Pragma("unroll") for (int _i = 0; _i < 2; ++_i) \
        __builtin_amdgcn_global_load_lds((const unsigned*)((const char*)(gbase) + (voff)[_i]), (PG8_LAS unsigned*)(lds + (bufoff) + ldsw + _i * 8192), 16, 0, 0); } while (0)
#define PG8_LDA(dst, b, h) do { _Pragma("unroll") for (int m = 0; m < 4; ++m) _Pragma("unroll") for (int k = 0; k < 2; ++k) dst[m][k] = *(const PG8_LAS bf16x8*)(lds + PG8_SA(b, h) + aoff + m * 2048 + k * 1024); } while (0)
#define PG8_LDB(dst, b, h) do { _Pragma("unroll") for (int n = 0; n < 2; ++n) _Pragma("unroll") for (int k = 0; k < 2; ++k) dst[n][k] = *(const PG8_LAS bf16x8*)(lds + PG8_SB(b, h) + boff + n * 2048 + k * 1024); } while (0)
#define PG8_MMA(ai, bj, At, Bt) do { __builtin_amdgcn_s_setprio(1); _Pragma("unroll") for (int m = 0; m < 4; ++m) _Pragma("unroll") for (int n = 0; n < 2; ++n) _Pragma("unroll") for (int k = 0; k < 2; ++k) \
        acc[ai][bj][m][n] = __builtin_amdgcn_mfma_f32_16x16x32_bf16(Bt[n][k], At[m][k], acc[ai][bj][m][n], 0, 0, 0); __builtin_amdgcn_s_setprio(0); } while (0)
#define PG8_WAIT_V(n) asm volatile("s_waitcnt vmcnt(" #n ")" ::: "memory")
#define PG8_WAIT_L(n) asm volatile("s_waitcnt lgkmcnt(" #n ")" ::: "memory")
#define PG8_BAR __builtin_amdgcn_s_barrier()
#define PG8_SCHED __builtin_amdgcn_sched_barrier(0)
    Unit cur, nxt; int ui = 0;
    if (!S.next(0, cur)) return;
    f32x4 acc[2][2][4][2];
#pragma unroll
    for (int a = 0; a < 2; ++a)
#pragma unroll
        for (int b = 0; b < 2; ++b)
#pragma unroll
            for (int m = 0; m < 4; ++m)
#pragma unroll
                for (int n = 0; n < 2; ++n) acc[a][b][m][n] = (f32x4){0.f, 0.f, 0.f, 0.f};
    bf16x8 At[4][2], B0[2][2], B1[2][2];
    const char* cA = (const char*)g.A + (size_t)cur.pm * tstepA + PG8_ACOL(cur.pn); const char* cB = (const char*)g.Bt + (size_t)cur.pn * tstepB;
    PG8_STAGE(PG8_SB(0, 0), cB, voffB); PG8_STAGE(PG8_SA(0, 0), cA, voffA); PG8_STAGE(PG8_SB(0, 1), cB + hstepB, voffB); PG8_STAGE(PG8_SA(0, 1), cA + hstepA, voffA);
    if (wr == 1) PG8_BAR;
    PG8_WAIT_V(4); PG8_BAR;
    PG8_STAGE(PG8_SB(1, 0), cB + kstep, voffB); PG8_STAGE(PG8_SA(1, 0), cA + kstep, voffA); PG8_STAGE(PG8_SB(1, 1), cB + hstepB + kstep, voffB);
    PG8_WAIT_V(6); PG8_BAR;
    for (;;) {
        const bool has_next = S.next(ui + 1, nxt);
        const char* nA = has_next ? (const char*)g.A + (size_t)nxt.pm * tstepA + PG8_ACOL(nxt.pn) : cA; const char* nB = has_next ? (const char*)g.Bt + (size_t)nxt.pn * tstepB : cB;
        for (int t = 0; t < nt; t += 2) {
            const bool last = (t == nt - 2);
            const char* a1 = cA + (size_t)(t + 1) * kstep;
            const char* a2 = last ? nA : cA + (size_t)(t + 2) * kstep; const char* b2 = last ? nB : cB + (size_t)(t + 2) * kstep;
            const char* a3 = a2 + kstep; const char* b3 = b2 + kstep;
            PG8_LDB(B0, 0, 0); PG8_SCHED; PG8_LDA(At, 0, 0); PG8_STAGE(PG8_SA(1, 1), a1 + hstepA, voffA);
            PG8_WAIT_L(8); PG8_BAR; PG8_WAIT_L(0); PG8_MMA(0, 0, At, B0); PG8_BAR; PG8_SCHED;
            PG8_LDB(B1, 0, 1); PG8_STAGE(PG8_SB(0, 0), b2, voffB);
            PG8_BAR; PG8_WAIT_L(0); PG8_MMA(0, 1, At, B1); PG8_BAR;
            PG8_LDA(At, 0, 1); PG8_STAGE(PG8_SA(0, 0), a2, voffA);
            PG8_BAR; PG8_WAIT_L(0); PG8_MMA(1, 0, At, B0); PG8_BAR; PG8_SCHED;
            PG8_STAGE(PG8_SB(0, 1), b2 + hstepB, voffB);
            PG8_WAIT_V(6); PG8_BAR; PG8_MMA(1, 1, At, B1); PG8_BAR;
            PG8_LDB(B0, 1, 0); PG8_SCHED; PG8_LDA(At, 1, 0); PG8_STAGE(PG8_SA(0, 1), a2 + hstepA, voffA);
            PG8_WAIT_L(8); PG8_BAR; PG8_WAIT_L(0); PG8_MMA(0, 0, At, B0); PG8_BAR; PG8_SCHED;
            PG8_LDB(B1, 1, 1); PG8_STAGE(PG8_SB(1, 0), b3, voffB);
            PG8_BAR; PG8_WAIT_L(0); PG8_MMA(0, 1, At, B1); PG8_BAR;
            PG8_LDA(At, 1, 1); PG8_STAGE(PG8_SA(1, 0), a3, voffA);
            PG8_BAR; PG8_WAIT_L(0); PG8_MMA(1, 0, At, B0); PG8_BAR; PG8_SCHED;
            PG8_STAGE(PG8_SB(1, 1), b3 + hstepB, voffB);
            PG8_WAIT_V(6); PG8_BAR; PG8_MMA(1, 1, At, B1); PG8_BAR;
        }
        E(acc, cur, wr, wc, fr, fq);
        if (!has_next) break;
#pragma unroll
        for (int a = 0; a < 2; ++a)
#pragma unroll
            for (int b = 0; b < 2; ++b)
#pragma unroll
                for (int m = 0; m < 4; ++m)
#pragma unroll
                    for (int n = 0; n < 2; ++n) acc[a][b][m][n] = (f32x4){0.f, 0.f, 0.f, 0.f};
        cur = nxt; cA = nA; cB = nB; ++ui;
    }
    PG8_WAIT_V(0);
    if (wr == 0) PG8_BAR;
    PG8_BAR;
#undef PG8_ACOL
#undef PG8_SA
#undef PG8_SB
#undef PG8_STAGE
#undef PG8_LDA
#undef PG8_LDB
#undef PG8_MMA
#undef PG8_WAIT_V
#undef PG8_WAIT_L
#undef PG8_BAR
#undef PG8_SCHED
}
}
#define LAS __attribute__((address_space(3)))
typedef unsigned short bf16;
typedef short bf16x8 __attribute__((ext_vector_type(8)));
typedef float f32x4 __attribute__((ext_vector_type(4)));
typedef unsigned u32x4 __attribute__((ext_vector_type(4)));
typedef unsigned u32x2 __attribute__((ext_vector_type(2)));
constexpr int DM = 1024, MT = 24576, MCTX = 8192, LCTX = 256, LLAT = 2048, NWAVES = 8, NTHR = 512;
constexpr int NPROJ_E = 3072, NB_E = 3328, IN_EVEN_LD = 3088;
constexpr float EPSF = 1e-6f;
constexpr size_t MiB = 1u << 20;
constexpr size_t WS_MOD = 0, MOD_BYTES = 4 * 9 * 6144 * 4, WS_S5F = 1 * MiB, WS_AB = 3 * MiB, WS_W1T = 5 * MiB, WS_W2T = 37 * MiB, WS_WINE = 69 * MiB,
                 WS_WOUTE = 82 * MiB, WS_WINO = 86 * MiB, WS_WOUTO = 94 * MiB, WS_WG = 98 * MiB, WS_H = 102 * MiB, WS_BIG = 150 * MiB, WS_YBUF = 294 * MiB,
                 WS_GATES = 246 * MiB, WS_MIX = 342 * MiB, WS_END = 390 * MiB;
constexpr int LDS_BYTES = 147456;
constexpr size_t OUT_S5RE = 25165824, OUT_S5IM = OUT_S5RE + 262144, OUT_DELTA = OUT_S5IM + 262144, OUT_LRU = OUT_DELTA + 8388608;

struct Params { const float* in[40]; float* out; unsigned char* ws; };
enum { I_XP = 0, I_XS, I_S5RE, I_S5IM, I_SDELTA, I_SLRU, I_C, I_CCTX, I_WADA, I_BADA, I_NMIXPRE, I_NMIXPOST, I_NMLPPRE, I_NMLPPOST, I_WMLPIN, I_WMLPOUT, I_WINE, I_WOUTE,
       I_LAMRE, I_LAMIM, I_LOGDT, I_BRE, I_BIM, I_CRE, I_CIM, I_S5D, I_GCONVW, I_GCONVB, I_GALOG, I_GDTB, I_GONORM, I_WINO, I_WOUTO, I_LCONVW, I_LCONVB, I_LWR, I_LBR, I_LWI, I_LBI, I_LLAM };

typedef __bf16 bf2_t __attribute__((ext_vector_type(2)));
typedef float f2_t __attribute__((ext_vector_type(2)));
__device__ __forceinline__ unsigned pk2(float lo, float hi) { const bf2_t v = __builtin_convertvector((f2_t){lo, hi}, bf2_t); return __builtin_bit_cast(unsigned, v); }
__device__ __forceinline__ unsigned f2bf(float f) { return pk2(f, f) & 0xffffu; }
__device__ __forceinline__ float bflo(unsigned w) { return __builtin_bit_cast(float, w << 16); }
__device__ __forceinline__ float bfhi(unsigned w) { return __builtin_bit_cast(float, w & 0xffff0000u); }
__device__ __forceinline__ float bf2f(bf16 b) { return __builtin_bit_cast(float, (unsigned)b << 16); }
__device__ __forceinline__ float sigmoidf_(float x) { return __builtin_amdgcn_rcpf(1.0f + __expf(-x)); }
__device__ __forceinline__ float siluf_(float x) { return x * sigmoidf_(x); }
__device__ __forceinline__ float softplusf_(float x) { return fmaxf(x, 0.f) + __logf(1.0f + __expf(-fabsf(x))); }
__device__ __forceinline__ float geluf_(float x) { const float y = 0.7978845608028654f * (x + 0.044715f * x * x * x); const float t = 1.0f - 2.0f * __builtin_amdgcn_rcpf(__expf(2.0f * y) + 1.0f); return 0.5f * x * (1.0f + t); }
__device__ __forceinline__ float shfl_i(float v, int srclane) { return __builtin_bit_cast(float, __builtin_amdgcn_ds_bpermute(srclane << 2, __builtin_bit_cast(int, v))); }
__device__ __forceinline__ float wave_sum(float v, int lane) {
#pragma unroll
    for (int o = 1; o < 64; o <<= 1) v += shfl_i(v, lane ^ o);
    return v;
}
#define LDS_WAIT() asm volatile("s_waitcnt lgkmcnt(0)" ::: "memory")
#define WAVE_SYNC() do { asm volatile("s_waitcnt lgkmcnt(0)" ::: "memory"); __builtin_amdgcn_wave_barrier(); } while (0)
__device__ __forceinline__ f32x4 mfma16(bf16x8 a, bf16x8 b, f32x4 c) { return __builtin_amdgcn_mfma_f32_16x16x32_bf16(a, b, c, 0, 0, 0); }


#define XB_TMO      128
#define XB_XCNT(j)  (256  + 64 * (j))
#define XB_XSUB(j)  (1280 + 64 * (j))
#define XB_XGEN(j)  (2304 + 64 * (j))
#define XB_TOP      3328
#define XB_TOPGEN   3392
#define XCD_BAR_WORDS 3456
#define XB_SPIN_CAP (1u << 18)
constexpr size_t WS_BAR = 960 * 1024; constexpr int LDS_BARST = LDS_BYTES - 16;
__device__ __forceinline__ unsigned xb_ld(unsigned* p)              { return __hip_atomic_load(p, __ATOMIC_RELAXED, __HIP_MEMORY_SCOPE_AGENT); }
__device__ __forceinline__ unsigned xb_add(unsigned* p, unsigned v) { return __hip_atomic_fetch_add(p, v, __ATOMIC_RELAXED, __HIP_MEMORY_SCOPE_AGENT); }
__device__ __forceinline__ unsigned xb_xcc_id() { return (unsigned)__builtin_amdgcn_s_getreg((3 << 11) | 20) & 0xFu; }
#define XB_SPIN(cond, bar) do { unsigned _sp = 0; while (cond) { __builtin_amdgcn_s_sleep(1); \
    if ((++_sp & 255u) == 0u) { if (xb_ld(&(bar)[XB_TMO])) break; if (_sp > XB_SPIN_CAP) { atomicAdd(&(bar)[XB_TMO], 1u); break; } } } } while (0)
__device__ __forceinline__ void xcd_barrier_complete(unsigned* bar, unsigned x, unsigned& nloc, unsigned& nx) {
    const unsigned G = gridDim.x;
    unsigned sum, cnt, mine, sp = 0u;
    for (;;) {
        sum = 0u; cnt = 0u; mine = 0u;
#pragma unroll
        for (unsigned j = 0; j < 16; ++j) { const unsigned c = xb_ld(&bar[XB_XCNT(j)]); sum += c; cnt += (c > 0u) ? 1u : 0u; mine = (j == x) ? c : mine; }
        if (sum == G) break;
        __builtin_amdgcn_s_sleep(1);
        if ((++sp & 255u) == 0u) { if (xb_ld(&bar[XB_TMO])) break; if (sp > XB_SPIN_CAP) { atomicAdd(&bar[XB_TMO], 1u); break; } }
    }
    nloc = mine > 0u ? mine : 1u; nx = cnt > 0u ? cnt : 1u;
}
__device__ __forceinline__ void xcd_barrier(int wid0, unsigned* bar, LAS unsigned char* lds) {
    const int tid = tid_fresh(wid0);
    asm volatile("s_waitcnt vmcnt(0)" ::: "memory");
    __syncthreads();
    if (tid == 0) {
        const unsigned x = xb_xcc_id();
        volatile LAS unsigned* st = (volatile LAS unsigned*)(lds + LDS_BARST);
        __builtin_amdgcn_s_waitcnt(0);
        unsigned nloc = st[0], nx = st[1];
        if (nloc == 0u) { xcd_barrier_complete(bar, x, nloc, nx); st[0] = nloc; st[1] = nx; }
        const unsigned old = xb_add(&bar[XB_XSUB(x)], 1u);
        const unsigned gen = old / nloc;
        if (old + 1u == (gen + 1u) * nloc) {
            __builtin_amdgcn_fence(__ATOMIC_RELEASE, "agent");
            asm volatile("s_waitcnt vmcnt(0)" ::: "memory");
            const unsigned og = xb_add(&bar[XB_TOP], 1u);
            const unsigned tg = og / nx;
            if (og + 1u == (tg + 1u) * nx) xb_add(&bar[XB_TOPGEN], 1u);
            else XB_SPIN(xb_ld(&bar[XB_TOPGEN]) == tg, bar);
            __builtin_amdgcn_fence(__ATOMIC_ACQUIRE, "agent");
            xb_add(&bar[XB_XGEN(x)], 1u);
            asm volatile("s_waitcnt vmcnt(0)" ::: "memory");
        } else {
            XB_SPIN(xb_ld(&bar[XB_XGEN(x)]) == gen, bar);
            __builtin_amdgcn_fence(__ATOMIC_ACQUIRE, "agent");
            asm volatile("s_waitcnt vmcnt(0)" ::: "memory");
        }
    }
    __syncthreads();
}
__device__ __forceinline__ void transpose_item(const float* W, int ldw, int nvalid, int K, bf16* WT, int dst_row0, LAS float* scr, int k0, int n0, int lane) {
    const int nn = n0 + (lane & 31); const bool ok = nn < nvalid;
#pragma unroll 8
    for (int i = 0; i < 32; ++i) { const int kk = 2 * i + (lane >> 5); scr[kk * 33 + (lane & 31)] = ok ? W[(size_t)(k0 + kk) * ldw + nn] : 0.f; }
    WAVE_SYNC();
    const int c = lane & 7;
#pragma unroll
    for (int j = 0; j < 4; ++j) { const int n = (lane >> 3) + 8 * j; const LAS float* s = scr + (8 * c) * 33 + n;
        u32x4 o; o.x = pk2(s[0 * 33], s[1 * 33]); o.y = pk2(s[2 * 33], s[3 * 33]); o.z = pk2(s[4 * 33], s[5 * 33]); o.w = pk2(s[6 * 33], s[7 * 33]);
        *(u32x4*)(WT + (size_t)(dst_row0 + n) * K + k0 + 8 * c) = o; }
    WAVE_SYNC();
}
__device__ __forceinline__ void phase_prologue(int wid0, const Params& P, LAS unsigned char* lds) {
    const int tid = tid_fresh(wid0), lane = tid & 63, wave = tid >> 6;
    LAS float* scr = (LAS float*)(lds + wave * 16384);
    const int gw = bid_fresh() * NWAVES + wave, NGW = grid_fresh() * NWAVES;
    unsigned char* ws = P.ws;
    constexpr int NA = 8192, NB = 8192, NC = 2 * 16 * 97, ND = 1024, NE = 2048, NF = 1024, NG = 1024, NTR = NA + NB + NC + ND + NE + NF + NG, NMOD = 4 * 24 * 16;
    for (int it = gw; it < NTR + NMOD; it += NGW) {
        int r = it;
        if (r < NA) { const int l = r >> 11, q = r & 2047; transpose_item(P.in[I_WMLPIN] + (size_t)l * 1024 * 4096, 4096, 4096, 1024, (bf16*)(ws + WS_W1T) + (size_t)l * 4096 * 1024, 32 * (q & 127), scr, 64 * (q >> 7), 32 * (q & 127), lane); continue; } r -= NA;
        if (r < NB) { const int l = r >> 11, q = r & 2047; transpose_item(P.in[I_WMLPOUT] + (size_t)l * 4096 * 1024, 1024, 1024, 4096, (bf16*)(ws + WS_W2T) + (size_t)l * 1024 * 4096, 32 * (q & 31), scr, 64 * (q >> 5), 32 * (q & 31), lane); continue; } r -= NB;
        if (r < NC) { const int e = r / 1552, q = r % 1552, kb = q / 97, nb = q % 97; transpose_item(P.in[I_WINE] + (size_t)e * 1024 * IN_EVEN_LD, IN_EVEN_LD, IN_EVEN_LD, 1024, (bf16*)(ws + WS_WINE) + (size_t)e * NB_E * 1024, 32 * nb, scr, 64 * kb, 32 * nb, lane); continue; } r -= NC;
        if (r < ND) { const int e = r >> 9, q = r & 511; transpose_item(P.in[I_WOUTE] + (size_t)e * 1024 * 1024, 1024, 1024, 1024, (bf16*)(ws + WS_WOUTE) + (size_t)e * 1024 * 1024, 32 * (q & 31), scr, 64 * (q >> 5), 32 * (q & 31), lane); continue; } r -= ND;
        if (r < NE) { const int o = r >> 10, q = r & 1023; transpose_item(P.in[I_WINO] + (size_t)o * 1024 * 2048, 2048, 2048, 1024, (bf16*)(ws + WS_WINO) + (size_t)o * 2048 * 1024, 32 * (q & 63), scr, 64 * (q >> 6), 32 * (q & 63), lane); continue; } r -= NE;
        if (r < NF) { const int o = r >> 9, q = r & 511; transpose_item(P.in[I_WOUTO] + (size_t)o * 1024 * 1024, 1024, 1024, 1024, (bf16*)(ws + WS_WOUTO) + (size_t)o * 1024 * 1024, 32 * (q & 31), scr, 64 * (q >> 5), 32 * (q & 31), lane); continue; } r -= NF;
        if (r < NG) { const int mat = r >> 5, q = r & 31, kb = q >> 3, nb = q & 7; const int blk = mat & 3, gate = (mat >> 2) & 1, od = mat >> 3;
            const float* src = (gate ? P.in[I_LWI] : P.in[I_LWR]) + (size_t)(od * 4 + blk) * 65536;
            const int j0 = nb * 32; const int drow = (blk * 2 + (j0 >> 7)) * 256 + gate * 128 + (j0 & 127);
            transpose_item(src, 256, 256, 256, (bf16*)(ws + WS_WG) + (size_t)od * 2048 * 256, drow - j0 + j0, scr, 64 * kb, j0, lane);
            continue; } r -= NG;
        {
            const int l = r / 384, rem = r % 384, ec = rem >> 4, ks = rem & 15, k0 = ks * 64;
#pragma unroll
            for (int rr = 0; rr < 9; ++rr) { const float cv = rr == 0 ? P.in[I_CCTX][k0 + lane] : P.in[I_C][(rr - 1) * 1024 + k0 + lane]; scr[rr * 64 + lane] = siluf_(cv); }
            WAVE_SYNC();
            f32x4 acc[9];
#pragma unroll
            for (int rr = 0; rr < 9; ++rr) acc[rr] = (f32x4){0.f, 0.f, 0.f, 0.f};
            const float* wp = P.in[I_WADA] + ((size_t)l * 1024 + k0) * 6144 + ec * 256 + lane * 4;
#pragma unroll 4
            for (int kk = 0; kk < 64; ++kk) { const f32x4 w4 = *(const f32x4*)(wp + (size_t)kk * 6144);
#pragma unroll
                for (int rr = 0; rr < 9; ++rr) acc[rr] += w4 * scr[rr * 64 + kk]; }
            float* part = (float*)(ws + WS_BIG) + ((size_t)(ks * 4 + l) * 9) * 6144 + ec * 256 + lane * 4;
#pragma unroll
            for (int rr = 0; rr < 9; ++rr) *(f32x4*)(part + (size_t)rr * 6144) = acc[rr];
            WAVE_SYNC();
        }
    }
    { u32x4* z = (u32x4*)0; (void)z;
      const size_t per = (size_t)(NB_E - 3104) * 1024 * 2 / 16;
      for (size_t i = (size_t)bid_fresh() * NTHR + tid; i < 2 * per; i += (size_t)grid_fresh() * NTHR) { const size_t e = i / per, q = i % per;
          *(u32x4*)(ws + WS_WINE + (e * NB_E + 3104) * 1024 * 2 + q * 16) = (u32x4){0u, 0u, 0u, 0u}; } }
}

__device__ __forceinline__ void phase_modreduce(int wid0, const Params& P) {
    const int tid = tid_fresh(wid0);
    const float* part = (const float*)(P.ws + WS_BIG); float* mod = (float*)(P.ws + WS_MOD);
    for (int i = bid_fresh() * NTHR + tid; i < 4 * 9 * 6144 / 4; i += grid_fresh() * NTHR) {
        const int l = i / (9 * 1536), e4 = i % 1536;
        f32x4 a = *(const f32x4*)(P.in[I_BADA] + (size_t)l * 6144 + e4 * 4);
#pragma unroll
        for (int ks = 0; ks < 16; ++ks) a += *(const f32x4*)(part + (size_t)ks * 4 * 9 * 6144 + (size_t)i * 4);
        *(f32x4*)(mod + (size_t)i * 4) = a; }
}
__device__ __forceinline__ void phase_rownorm(int wid0, const Params& P, int first, const bf16* obuf, const float* modg, int goff, const float* gpost, int has_next, const float* gpre, const float* mods, int soff, bf16* H) {
    const int tid = tid_fresh(wid0), lane = tid & 63, wave = tid >> 6;
    const int gw = bid_fresh() * NWAVES + wave, NGW = grid_fresh() * NWAVES;
    float* X = P.out;
    for (int m = gw; m < MT; m += NGW) {
        const int modrow = m < MCTX ? 0 : 1 + ((m - MCTX) >> 11);
        const float* mr = modg + (size_t)modrow * 6144; const float* ms = mods + (size_t)modrow * 6144;
        f32x4 x[4];
        if (first) {
            if (m < MCTX) {
#pragma unroll
                for (int j = 0; j < 4; ++j) x[j] = *(const f32x4*)(P.in[I_XP] + (size_t)m * DM + lane * 4 + 256 * j);
            } else {
                const int t = (m - MCTX) & 2047; const float prow = (float)(t >> 6), pcol = (float)(t & 63);
                f32x4 om;
#pragma unroll
                for (int e = 0; e < 4; ++e) om[e] = exp2f(-(float)(lane * 4 + e) * (13.287712379549449f / 256.0f));
#pragma unroll
                for (int j = 0; j < 4; ++j) { x[j] = *(const f32x4*)(P.in[I_XS] + (size_t)(m - MCTX) * DM + lane * 4 + 256 * j);
#pragma unroll
                    for (int e = 0; e < 4; ++e) { const float a = (j < 2 ? prow : pcol) * om[e]; x[j][e] += (j & 1) ? cosf(a) : sinf(a); } }
            }
        } else {
            u32x2 ov[4]; float ss = 0.f;
#pragma unroll
            for (int j = 0; j < 4; ++j) { x[j] = *(const f32x4*)(X + (size_t)m * DM + lane * 4 + 256 * j); ov[j] = *(const u32x2*)(obuf + (size_t)m * DM + lane * 4 + 256 * j); }
#pragma unroll
            for (int j = 0; j < 4; ++j) { const float a = bflo(ov[j].x), b = bfhi(ov[j].x), c = bflo(ov[j].y), d = bfhi(ov[j].y); ss += (a * a + b * b) + (c * c + d * d); }
            const float rs = rsqrtf(wave_sum(ss, lane) * (1.0f / DM) + EPSF);
#pragma unroll
            for (int j = 0; j < 4; ++j) { const f32x4 g4 = *(const f32x4*)(gpost + lane * 4 + 256 * j), gt = *(const f32x4*)(mr + goff + lane * 4 + 256 * j);
                f32x4 o4 = (f32x4){bflo(ov[j].x), bfhi(ov[j].x), bflo(ov[j].y), bfhi(ov[j].y)};
                x[j] += gt * (o4 * rs * g4); }
        }
#pragma unroll
        for (int j = 0; j < 4; ++j) *(f32x4*)(X + (size_t)m * DM + lane * 4 + 256 * j) = x[j];
        if (has_next) {
            float ss = 0.f;
#pragma unroll
            for (int j = 0; j < 4; ++j) ss += (x[j][0] * x[j][0] + x[j][1] * x[j][1]) + (x[j][2] * x[j][2] + x[j][3] * x[j][3]);
            const float rs = rsqrtf(wave_sum(ss, lane) * (1.0f / DM) + EPSF);
#pragma unroll
            for (int j = 0; j < 4; ++j) { const f32x4 g4 = *(const f32x4*)(gpre + lane * 4 + 256 * j), sh = *(const f32x4*)(ms + soff + lane * 4 + 256 * j), sc = *(const f32x4*)(ms + soff + 1024 + lane * 4 + 256 * j);
                const f32x4 h4 = (x[j] * rs * g4) * (sc + 1.0f) + sh;
                u32x2 w; w.x = pk2(h4[0], h4[1]); w.y = pk2(h4[2], h4[3]);
                *(u32x2*)(H + (size_t)m * DM + lane * 4 + 256 * j) = w; }
        }
    }
}

using pg8::Unit;
template <int ACT  > struct EpiBf16 {
    bf16* O; int ldc; float* AB;
    __device__ __forceinline__ void operator()(const f32x4 (&acc)[2][2][4][2], const Unit& u, int wr, int wc, int fr, int fq) const {
        const int row0 = u.pm * 256 + wr * 64 + fr, col0 = u.pn * 256 + wc * 32 + 8 * fq;
        if (AB && u.pn * 256 >= ldc) {
            if (wc == 0 && fq < 2) {
#pragma unroll
                for (int ai = 0; ai < 2; ++ai)
#pragma unroll
                    for (int m = 0; m < 4; ++m) { float* p = AB + (size_t)(row0 + ai * 128 + m * 16) * 16 + 8 * fq; *(f32x4*)p = acc[ai][0][m][0]; *(f32x4*)(p + 4) = acc[ai][0][m][1]; }
            }
            return;
        }
#pragma unroll
        for (int ai = 0; ai < 2; ++ai)
#pragma unroll
            for (int m = 0; m < 4; ++m) { bf16* rowp = O + (size_t)(row0 + ai * 128 + m * 16) * ldc + col0;
#pragma unroll
                for (int bj = 0; bj < 2; ++bj) { f32x4 v0 = acc[ai][bj][m][0], v1 = acc[ai][bj][m][1];
                    if (ACT == 1) {
#pragma unroll
                        for (int j = 0; j < 4; ++j) { const float a = fmaxf(v0[j], 0.f), b = fmaxf(v1[j], 0.f); v0[j] = a * a; v1[j] = b * b; } }
                    u32x4 w; w.x = pk2(v0[0], v0[1]); w.y = pk2(v0[2], v0[3]); w.z = pk2(v1[0], v1[1]); w.w = pk2(v1[2], v1[3]);
                    *(u32x4*)(rowp + bj * 128) = w; } }
    }
};
struct EpiGates {
    unsigned* G; const bf16* X; const float* br; const float* bi; const float* lam;
    __device__ __forceinline__ void operator()(const f32x4 (&acc)[2][2][4][2], const Unit& u, int wr, int wc, int fr, int fq) const {
        const int row0 = u.pm * 256 + wr * 64 + fr, ch0 = u.pn * 128 + wc * 32 + 8 * fq;
#pragma unroll
        for (int n = 0; n < 2; ++n) {
            const f32x4 vbr = *(const f32x4*)(br + ch0 + 4 * n), vbi = *(const f32x4*)(bi + ch0 + 4 * n), l4 = *(const f32x4*)(lam + ch0 + 4 * n);
            f32x4 vsp;
#pragma unroll
            for (int e = 0; e < 4; ++e) vsp[e] = -8.0f * softplusf_(-l4[e]);
#pragma unroll
            for (int ai = 0; ai < 2; ++ai)
#pragma unroll
                for (int m = 0; m < 4; ++m) { const size_t row = (size_t)(row0 + ai * 128 + m * 16);
                    const u32x2 xv = *(const u32x2*)(X + row * DM + ch0 + 4 * n);
                    const float xs[4] = {bflo(xv.x), bfhi(xv.x), bflo(xv.y), bfhi(xv.y)};
                    u32x4 w;
#pragma unroll
                    for (int e = 0; e < 4; ++e) { const float r = sigmoidf_(acc[ai][0][m][n][e] + vbr[e]), ig = sigmoidf_(acc[ai][1][m][n][e] + vbi[e]);
                        const float la = r * vsp[e]; const float a_ = __expf(la); const float b = __builtin_amdgcn_sqrtf(fmaxf(1.0f - a_ * a_, 0.f)) * ig * xs[e];
                        w[e] = pk2(la * 1.4426950408889634f, b); }
                    *(u32x4*)(G + row * DM + ch0 + 4 * n) = w; }
        }
    }
};
constexpr int S5_WLDS = 12800, BU_P = 132, HS_P = 136;
struct S5Dir { float ar, ai; bf16x8 Bf[8]; };
__device__ __forceinline__ void s5_dir_setup(const Params& P, int e, int d, int g, int lane, float& ar, float& ai, bf16x8 (&Bf)[8], bool needB) {
    const int quad = lane >> 4, l15 = lane & 15;
    const float dt = __expf(P.in[I_LOGDT][(e * 2 + d) * 32 + g]);
    const float lr = P.in[I_LAMRE][((e * 2 + d) * 32 + g) * 64 + lane], li = P.in[I_LAMIM][((e * 2 + d) * 32 + g) * 64 + lane];
    const float mag = expf(lr * dt); ar = mag * cosf(li * dt); ai = mag * sinf(li * dt);
    const float den = lr * lr + li * li;
    const float fr = ((ar - 1.0f) * lr + ai * li) / den, fi = (ai * lr - (ar - 1.0f) * li) / den;
    if (needB) {
#pragma unroll
        for (int nt = 0; nt < 8; ++nt) { const int col = 16 * nt + l15, p = col & 63;
            const float frp = shfl_i(fr, p), fip = shfl_i(fi, p);
            bf16x8 v = (bf16x8){0, 0, 0, 0, 0, 0, 0, 0};
            if (quad < 2) { const float* bre = P.in[I_BRE] + ((size_t)(e * 32 + g) * 64 + p) * 16 + quad * 8; const float* bim = P.in[I_BIM] + ((size_t)(e * 32 + g) * 64 + p) * 16 + quad * 8;
#pragma unroll
                for (int j = 0; j < 8; ++j) { const float br = bre[j], bi = bim[j]; const float val = (nt < 4) ? (frp * br - fip * bi) : (frp * bi + fip * br); v[j] = (short)f2bf(val); } }
            Bf[nt] = v; }
    }
}
__device__ __forceinline__ void s5_c_setup(const Params& P, int e, int g, int lane, bf16x8 (&Cf)[4]) {
    const int quad = lane >> 4, l15 = lane & 15;
#pragma unroll
    for (int ks = 0; ks < 4; ++ks) { const int col0 = 32 * ks + quad * 8; const bool im = col0 >= 64;
        const float* src = (im ? P.in[I_CIM] : P.in[I_CRE]) + ((size_t)(e * 32 + g) * 16 + l15) * 64 + (col0 & 63);
        bf16x8 v;
#pragma unroll
        for (int j = 0; j < 8; ++j) v[j] = (short)f2bf(im ? -src[j] : src[j]);
        Cf[ks] = v; }
}
__device__ __forceinline__ void s5_scan_seg(const Params& P, LAS unsigned char* wl, int lane, int d, int g, int m0, float ar, float ai, const bf16x8 (&Bf)[8], const bf16x8 (&Cf)[4],
                                            float& hr, float& hi, int mode, int ymode, const bf16* proj, float* ybuf, bf16* mixout, float dsk) {
    const int quad = lane >> 4, l15 = lane & 15;
    LAS float* BU = (LAS float*)wl; LAS bf16* HS = (LAS bf16*)(wl + 8448);
    for (int bi_ = 0; bi_ < 16; ++bi_) {
        const int blk = d ? 15 - bi_ : bi_;
        const int mb = m0 + 16 * blk;
        if (mode == 0) {
            bf16x8 a = (bf16x8){0, 0, 0, 0, 0, 0, 0, 0};
            if (quad < 2) { const int tt = d ? 15 - l15 : l15; a = *(const bf16x8*)(proj + (size_t)(mb + tt) * NPROJ_E + g * 16 + quad * 8); }
#pragma unroll
            for (int nt = 0; nt < 8; ++nt) { f32x4 acc = mfma16(a, Bf[nt], (f32x4){0.f, 0.f, 0.f, 0.f});
#pragma unroll
                for (int jj = 0; jj < 4; ++jj) BU[(quad * 4 + jj) * BU_P + 16 * nt + l15] = acc[jj]; }
            WAVE_SYNC();
        }
#pragma unroll
        for (int r = 0; r < 16; ++r) {
            float br = 0.f, bim = 0.f;
            if (mode == 0) { br = BU[r * BU_P + lane]; bim = BU[r * BU_P + 64 + lane]; }
            const float nr = ar * hr - ai * hi + br, ni = ar * hi + ai * hr + bim; hr = nr; hi = ni;
            HS[r * HS_P + lane] = (bf16)f2bf(hr); HS[r * HS_P + 64 + lane] = (bf16)f2bf(hi);
        }
        WAVE_SYNC();
        f32x4 y = (f32x4){0.f, 0.f, 0.f, 0.f};
#pragma unroll
        for (int ks = 0; ks < 4; ++ks) { const bf16x8 a = *(const LAS bf16x8*)(HS + l15 * HS_P + 32 * ks + quad * 8); y = mfma16(a, Cf[ks], y); }
        const int ch = g * 16 + l15;
#pragma unroll
        for (int jj = 0; jj < 4; ++jj) { const int row = quad * 4 + jj; const int tt = d ? 15 - row : row; const size_t m = (size_t)(mb + tt);
            float v = y[jj];
            if (ymode == 0) { v += dsk * bf2f(proj[m * NPROJ_E + ch]); ybuf[m * 512 + ch] = v; }
            else { v += ybuf[m * 512 + ch];
                if (ymode == 1) ybuf[m * 512 + ch] = v;
                else { const float z = bf2f(proj[m * NPROJ_E + 512 + ch]); mixout[m * DM + ch] = (bf16)f2bf(geluf_(v) * sigmoidf_(z)); } }
        }
        WAVE_SYNC();
    }
}
__device__ __forceinline__ void s5_task_main(const Params& P, LAS unsigned char* wl, int lane, int e, int sub, int g) {
    const bf16* proj = (const bf16*)(P.ws + WS_BIG); float* ybuf = (float*)(P.ws + WS_YBUF); bf16* mixout = (bf16*)(P.ws + WS_MIX);
    const bool lat = sub >= 32; const int q = sub - 32, b = lat ? (q >> 3) : sub, seg = lat ? (q & 7) : 0;
    const int m0 = lat ? MCTX + b * LLAT + seg * 256 : sub * 256;
    bf16x8 Cf[4]; s5_c_setup(P, e, g, lane, Cf);
    const float dsk = P.in[I_S5D][e * 512 + g * 16 + (lane & 15)];
#pragma unroll 1
    for (int d = 0; d < 2; ++d) {
        float ar, ai; bf16x8 Bf[8]; s5_dir_setup(P, e, d, g, lane, ar, ai, Bf, true);
        float hr = 0.f, hi = 0.f;
        if (lat && ((d == 0 && seg == 0) || (d == 1 && seg == 7))) { const size_t si = ((((size_t)b * 2 + e) * 2 + d) * 32 + g) * 64 + lane; hr = P.in[I_S5RE][si]; hi = P.in[I_S5IM][si]; }
        const int ymode = d == 0 ? 0 : (lat ? 1 : 2);
        s5_scan_seg(P, wl, lane, d, g, m0, ar, ai, Bf, Cf, hr, hi, 0, ymode, proj, ybuf, mixout, dsk);
        if (!lat) { const size_t si = ((((size_t)b * 2 + e) * 2 + d) * 32 + g) * 64 + lane; P.out[OUT_S5RE + si] = hr; P.out[OUT_S5IM + si] = hi; }
        else { float* F = (float*)(P.ws + WS_S5F) + ((((size_t)d * 64 + q) * 32 + g) * 64 + lane) * 2; F[0] = hr; F[1] = hi; }
    }
}
__device__ __forceinline__ void s5_task_corr(const Params& P, LAS unsigned char* wl, int lane, int e, int q, int g) {
    const bf16* proj = (const bf16*)(P.ws + WS_BIG); float* ybuf = (float*)(P.ws + WS_YBUF); bf16* mixout = (bf16*)(P.ws + WS_MIX);
    const int b = q >> 3, seg = q & 7, m0 = MCTX + b * LLAT + seg * 256;
    bf16x8 Cf[4]; s5_c_setup(P, e, g, lane, Cf);
    bf16x8 Bf[8];
#pragma unroll
    for (int i = 0; i < 8; ++i) Bf[i] = (bf16x8){0, 0, 0, 0, 0, 0, 0, 0};
    const float* Fb = (const float*)(P.ws + WS_S5F);
#pragma unroll 1
    for (int d = 0; d < 2; ++d) {
        float ar, ai; s5_dir_setup(P, e, d, g, lane, ar, ai, Bf, false);
        float pr = ar, pi = ai;
#pragma unroll
        for (int i = 0; i < 8; ++i) { const float nr = pr * pr - pi * pi, ni = 2.0f * pr * pi; pr = nr; pi = ni; }
        float hr = 0.f, hi = 0.f;
        const int cnt = d == 0 ? seg : 7 - seg;
        for (int i = 0; i < cnt; ++i) { const int sj = d == 0 ? i : 7 - i; const float* F = Fb + ((((size_t)d * 64 + b * 8 + sj) * 32 + g) * 64 + lane) * 2;
            const float nr = pr * hr - pi * hi + F[0], ni = pr * hi + pi * hr + F[1]; hr = nr; hi = ni; }
        if (cnt > 0) s5_scan_seg(P, wl, lane, d, g, m0, ar, ai, Bf, Cf, hr, hi, 1, 1, proj, ybuf, mixout, 0.f);
    }
    __builtin_amdgcn_wave_barrier();
    for (int i = lane; i < 256 * 16; i += 64) { const size_t m = (size_t)(m0 + (i >> 4)); const int ch = g * 16 + (i & 15);
        const float v = ybuf[m * 512 + ch]; const float z = bf2f(proj[m * NPROJ_E + 512 + ch]);
        mixout[m * DM + ch] = (bf16)f2bf(geluf_(v) * sigmoidf_(z)); }
}

#ifndef REP_A
#define REP_A 1
#endif
#ifndef REP_B
#define REP_B 1
#endif
#ifndef REP_C
#define REP_C 1
#endif
constexpr int G_Q = 0, G_K = 17408, G_V = 34816, G_KT = 52224, G_LM = 70656, G_QK = 89088, G_ST = 98304, G_SM = 133120;
constexpr int P128 = 136, P64 = 72, LMP = 68;
__device__ __forceinline__ bf16x8 ld_split8(const LAS bf16* p) {
    const u32x2 a = *(const LAS u32x2*)p, b = *(const LAS u32x2*)(p + 16);
    return __builtin_bit_cast(bf16x8, (u32x4){a.x, a.y, b.x, b.y});
}
__device__ __forceinline__ bf16x8 pack_acc2(const f32x4& a, const f32x4& b) { return __builtin_bit_cast(bf16x8, (u32x4){pk2(a[0], a[1]), pk2(a[2], a[3]), pk2(b[0], b[1]), pk2(b[2], b[3])}); }
__device__ __forceinline__ void gdn_chain(int wid0, const Params& P, LAS unsigned char* lds, int e, int s, int hd, int dir) {
    const int tid = tid_fresh(wid0), lane = tid & 63, w = __builtin_amdgcn_readfirstlane(tid >> 6), quad = lane >> 4, l15 = lane & 15;
    const bool lat = s >= 32; const int b = lat ? s - 32 : s; const int L = lat ? LLAT : LCTX; const int m0 = lat ? MCTX + b * LLAT : s * LCTX;
    const bf16* proj = (const bf16*)(P.ws + WS_BIG); const float* AB = (const float*)(P.ws + WS_AB);
    bf16* Odir = (bf16*)(P.ws + WS_H) + (size_t)dir * MT * 512;
    int zv; asm volatile("v_mov_b32 %0, 0" : "=v"(zv));
    lds += zv;
    LAS bf16* Qs = (LAS bf16*)(lds + G_Q); LAS bf16* Ks = (LAS bf16*)(lds + G_K); LAS bf16* Vs = (LAS bf16*)(lds + G_V); LAS bf16* KT = (LAS bf16*)(lds + G_KT);
    LAS float* Lm = (LAS float*)(lds + G_LM); LAS bf16* VNT = (LAS bf16*)(lds + G_LM); LAS bf16* QKs = (LAS bf16*)(lds + G_QK); LAS bf16* ST = (LAS bf16*)(lds + G_ST);
    LAS bf16* TM = (LAS bf16*)(lds + G_ST); LAS bf16* TT = TM + 64 * P64; LAS bf16* LR = TT + 64 * P64;
    LAS float* rq = (LAS float*)(lds + G_SM); LAS float* rk = rq + 64; LAS float* gcs = rq + 128; LAS float* betas = rq + 192; LAS float* egs = rq + 256; LAS float* kes = rq + 320;
    f32x4 Sacc[8];
    const size_t sbase = ((((size_t)b * 2 + e) * 2 + dir) * 4 + hd) * 16384;
#pragma unroll
    for (int mt = 0; mt < 8; ++mt) Sacc[mt] = (f32x4){0.f, 0.f, 0.f, 0.f};
    if (lat) { const float* sp = P.in[I_SDELTA] + sbase + (size_t)(quad * 4) * 128 + 16 * w + l15;
#pragma unroll
        for (int mt = 0; mt < 8; ++mt)
#pragma unroll
            for (int jj = 0; jj < 4; ++jj) Sacc[mt][jj] = sp[(16 * mt + jj) * 128]; }
    for (int i = tid; i < 2 * 64 * P64 / 2; i += NTHR) ((LAS unsigned*)TM)[i] = 0u;
    const float alog_e = __expf(P.in[I_GALOG][(e * 2 + dir) * 4 + hd]), dtb = P.in[I_GDTB][(e * 2 + dir) * 4 + hd];
    const int nchunk = L / 64;
#pragma unroll 1
    for (int ci = 0; ci < nchunk; ++ci) {
        const int tid = tid_fresh(wid0), lane = tid & 63, quad = lane >> 4, l15 = lane & 15;
        const int c0 = dir ? L - 64 * (ci + 1) : 64 * ci;
        __syncthreads();
#ifndef NO_A
#pragma unroll 1
        for (int repA = 0; repA < REP_A; ++repA)
        { const int dd = tid & 127, tq = __builtin_amdgcn_readfirstlane(tid >> 7);
          const int tb = c0 + tq * 16;
          unsigned xqk[19]; bf16 xv[19];
#pragma unroll
          for (int k = 0; k < 19; ++k) { const int t = tb - 1 + k; const bool ok = (t >= 0) && (t < L); const bf16* rowp = proj + (size_t)(m0 + (ok ? t : tb)) * NPROJ_E + 1024 + hd * 128 + dd;
              const unsigned a = rowp[0], bq = rowp[512]; const bf16 c = rowp[1024];
              xqk[k] = ok ? (a | (bq << 16)) : 0u; xv[k] = ok ? c : (bf16)0; }
#pragma unroll
          for (int part = 0; part < 3; ++part) { const int ccol = part * 512 + hd * 128 + dd;
              const float* cw = P.in[I_GCONVW] + (size_t)e * 4 * 1536 + ccol; const float w0 = cw[0], w1 = cw[1536], w2 = cw[3072], w3 = cw[4608], cb = P.in[I_GCONVB][e * 1536 + ccol];
              LAS bf16* dst = part == 0 ? Qs : (part == 1 ? Ks : Vs);
#pragma unroll
              for (int n = 0; n < 16; ++n) {
                  float x0, x1, x2, x3;
                  if (part == 0) { x0 = bflo(xqk[n]); x1 = bflo(xqk[n + 1]); x2 = bflo(xqk[n + 2]); x3 = bflo(xqk[n + 3]); }
                  else if (part == 1) { x0 = bfhi(xqk[n]); x1 = bfhi(xqk[n + 1]); x2 = bfhi(xqk[n + 2]); x3 = bfhi(xqk[n + 3]); }
                  else { x0 = bf2f(xv[n]); x1 = bf2f(xv[n + 1]); x2 = bf2f(xv[n + 2]); x3 = bf2f(xv[n + 3]); }
                  const float v = cb + w0 * x0 + w1 * x1 + w2 * x2 + w3 * x3;
                  const int nn = tq * 16 + n; const int r = dir ? 63 - nn : nn;
                  dst[r * P128 + dd] = (bf16)f2bf(siluf_(v)); } } }
#endif
        __syncthreads();
#pragma unroll 1
        for (int repB = 0; repB < REP_B; ++repB)
        { const int rowid = tid >> 2, part = tid & 3; LAS bf16* src = (rowid < 64 ? Qs : Ks) + (rowid & 63) * P128 + part * 32;
          float ss = 0.f;
#pragma unroll
          for (int i = 0; i < 4; ++i) { const u32x4 v = *(const LAS u32x4*)(src + 8 * i);
#pragma unroll
              for (int j = 0; j < 4; ++j) { const float a = bflo(v[j]), c = bfhi(v[j]); ss += a * a + c * c; } }
          ss += shfl_i(ss, lane ^ 1); ss += shfl_i(ss, lane ^ 2);
          if (part == 0) { if (rowid < 64) rq[rowid] = rsqrtf(ss + EPSF) * 0.08838834764831845f; else rk[rowid - 64] = rsqrtf(ss + EPSF); }
          if (w == 0) { const int t = c0 + (dir ? 63 - lane : lane); const size_t m = (size_t)(m0 + t);
              const float araw = AB[m * 16 + dir * 4 + hd], braw = AB[m * 16 + 8 + dir * 4 + hd];
              const float gg = -alog_e * softplusf_(araw + dtb);
              float gc = gg;
#pragma unroll
              for (int o = 1; o < 64; o <<= 1) { const float t2 = shfl_i(gc, (lane - o) & 63); if (lane >= o) gc += t2; }
              const float glast = shfl_i(gc, 63);
              gcs[lane] = gc; betas[lane] = sigmoidf_(braw); egs[lane] = __expf(gc); kes[lane] = __expf(glast - gc);
              if (lane == 0) rq[384] = __expf(glast); } }
        __syncthreads();
#ifndef NO_C
#pragma unroll 1
        for (int repC = 0; repC < REP_C; ++repC)
        { const int mt = w & 3; const bool isq = w >= 4; LAS bf16* src = isq ? Qs : Ks;
          bf16x8 a[4];
#pragma unroll
          for (int ks = 0; ks < 4; ++ks) a[ks] = *(const LAS bf16x8*)(src + (16 * mt + l15) * P128 + 32 * ks + quad * 8);
#pragma unroll 1
          for (int nt = 0; nt < 4; ++nt) { f32x4 acc = (f32x4){0.f, 0.f, 0.f, 0.f};
#pragma unroll
              for (int ks = 0; ks < 4; ++ks) { const bf16x8 bb = *(const LAS bf16x8*)(Ks + (16 * nt + l15) * P128 + 32 * ks + quad * 8); acc = mfma16(a[ks], bb, acc); }
              const int j = 16 * nt + l15; const float rkj = rk[j], gcj = gcs[j];
              f32x4 lv;
#pragma unroll
              for (int jj = 0; jj < 4; ++jj) { const int i = 16 * mt + quad * 4 + jj; const float dec = __expf(fminf(gcs[i] - gcj, 0.f));
                  lv[jj] = (i > j) ? acc[jj] * rk[i] * rkj * betas[i] * dec : 0.f;
                  if (isq) QKs[i * P64 + j] = (bf16)f2bf((i >= j) ? acc[jj] * rq[i] * rkj * dec : 0.f); }
              if (!isq) { *(LAS f32x4*)(Lm + j * LMP + 16 * mt + quad * 4) = lv;
#pragma unroll
                  for (int jj = 0; jj < 4; ++jj) LR[(16 * mt + quad * 4 + jj) * P64 + j] = (bf16)f2bf(nt < mt ? lv[jj] : 0.f); } }
          const int dd = tid & 127, tq = tid >> 7;
          unsigned pw[8];
#pragma unroll
          for (int n = 0; n < 16; n += 2) { const int i0 = tq * 16 + n; const float v0 = bf2f(Ks[i0 * P128 + dd]) * rk[i0] * kes[i0], v1 = bf2f(Ks[(i0 + 1) * P128 + dd]) * rk[i0 + 1] * kes[i0 + 1]; pw[n >> 1] = pk2(v0, v1); }
          *(LAS u32x4*)(KT + dd * P64 + tq * 16) = (u32x4){pw[0], pw[1], pw[2], pw[3]};
          *(LAS u32x4*)(KT + dd * P64 + tq * 16 + 8) = (u32x4){pw[4], pw[5], pw[6], pw[7]}; }
#endif
        __syncthreads();
        { const int i = tid >> 3, c0k = (tid & 7) * 16; const float sc = rk[i] * betas[i] * egs[i];
#pragma unroll
          for (int h2 = 0; h2 < 2; ++h2) { u32x4 v = *(LAS u32x4*)(Ks + i * P128 + c0k + 8 * h2);
#pragma unroll
              for (int q = 0; q < 4; ++q) v[q] = pk2(bflo(v[q]) * sc, bfhi(v[q]) * sc);
              *(LAS u32x4*)(Ks + i * P128 + c0k + 8 * h2) = v; } }
        if (w == 0) { const int bb = lane >> 4, c = lane & 15;
            float x[16];
#pragma unroll
            for (int r = 0; r < 16; ++r) x[r] = (r == c) ? 1.f : 0.f;
#pragma unroll
            for (int j = 0; j < 15; ++j) {
#pragma unroll
                for (int q4 = j / 4; q4 < 4; ++q4) { const f32x4 l4 = *(const LAS f32x4*)(Lm + (16 * bb + j) * LMP + 16 * bb + 4 * q4);
#pragma unroll
                    for (int jx = 0; jx < 4; ++jx) if (4 * q4 + jx > j) x[4 * q4 + jx] -= l4[jx] * x[j]; } }
            unsigned pw[8];
#pragma unroll
            for (int r = 0; r < 16; r += 2) { pw[r >> 1] = pk2(x[r], x[r + 1]); TM[(16 * bb + r) * P64 + 16 * bb + c] = (bf16)(pw[r >> 1] & 0xffffu); TM[(16 * bb + r + 1) * P64 + 16 * bb + c] = (bf16)(pw[r >> 1] >> 16); }
            *(LAS u32x4*)(TT + (16 * bb + c) * P64 + 16 * bb) = (u32x4){pw[0], pw[1], pw[2], pw[3]};
            *(LAS u32x4*)(TT + (16 * bb + c) * P64 + 16 * bb + 8) = (u32x4){pw[4], pw[5], pw[6], pw[7]}; }
        __syncthreads();
#pragma unroll 1
        for (int lev = 1; lev < 4; ++lev) {
            if (w < 4 - lev) { const int bj = w, bi = w + lev;
                f32x4 m = (f32x4){0.f, 0.f, 0.f, 0.f};
#pragma unroll
                for (int ks = 0; ks < 2; ++ks) { const bf16x8 a = *(const LAS bf16x8*)(LR + (16 * bi + l15) * P64 + 32 * ks + quad * 8), bq = *(const LAS bf16x8*)(TT + (16 * bj + l15) * P64 + 32 * ks + quad * 8); m = mfma16(a, bq, m); }
                const u32x2 tl = *(const LAS u32x2*)(TM + (16 * bi + l15) * P64 + 16 * bi + quad * 4);
                const bf16x8 a2 = __builtin_bit_cast(bf16x8, (u32x4){tl.x, tl.y, 0u, 0u}), b2 = __builtin_bit_cast(bf16x8, (u32x4){pk2(m[0], m[1]), pk2(m[2], m[3]), 0u, 0u});
                const f32x4 t = mfma16(a2, b2, (f32x4){0.f, 0.f, 0.f, 0.f});
                const unsigned p0 = pk2(-t[0], -t[1]), p1 = pk2(-t[2], -t[3]);
                TM[(16 * bi + quad * 4 + 0) * P64 + 16 * bj + l15] = (bf16)(p0 & 0xffffu); TM[(16 * bi + quad * 4 + 1) * P64 + 16 * bj + l15] = (bf16)(p0 >> 16);
                TM[(16 * bi + quad * 4 + 2) * P64 + 16 * bj + l15] = (bf16)(p1 & 0xffffu); TM[(16 * bi + quad * 4 + 3) * P64 + 16 * bj + l15] = (bf16)(p1 >> 16);
                *(LAS u32x2*)(TT + (16 * bj + l15) * P64 + 16 * bi + quad * 4) = (u32x2){p0, p1}; }
            __syncthreads();
        }
#ifndef NO_EFG
        bf16x8 Bst[4];
#pragma unroll
        for (int ks = 0; ks < 4; ++ks) Bst[ks] = pack_acc2(Sacc[2 * ks], Sacc[2 * ks + 1]);
        f32x4 vn[4];
#pragma unroll
        for (int mt = 0; mt < 4; ++mt) { f32x4 acc = (f32x4){0.f, 0.f, 0.f, 0.f};
#pragma unroll
            for (int ks = 0; ks < 4; ++ks) { const bf16x8 a = ld_split8(Ks + (16 * mt + l15) * P128 + 32 * ks + quad * 4); acc = mfma16(a, Bst[ks], acc); }
#pragma unroll
            for (int jj = 0; jj < 4; ++jj) { const int i = 16 * mt + quad * 4 + jj; vn[mt][jj] = bf2f(Vs[i * P128 + 16 * w + l15]) * betas[i] - acc[jj]; } }
        bf16x8 Bvn[2];
#pragma unroll
        for (int k2 = 0; k2 < 2; ++k2) Bvn[k2] = pack_acc2(vn[2 * k2], vn[2 * k2 + 1]);
#pragma unroll
        for (int mt = 0; mt < 4; ++mt) { f32x4 acc = (f32x4){0.f, 0.f, 0.f, 0.f};
#pragma unroll
            for (int k2 = 0; k2 < 2; ++k2) { const bf16x8 a = ld_split8(TM + (16 * mt + l15) * P64 + 32 * k2 + quad * 4); acc = mfma16(a, Bvn[k2], acc); }
            vn[mt] = acc; }
#pragma unroll
        for (int k2 = 0; k2 < 2; ++k2) Bvn[k2] = pack_acc2(vn[2 * k2], vn[2 * k2 + 1]);
#pragma unroll 1
        for (int mt = 0; mt < 4; ++mt) { f32x4 acc = (f32x4){0.f, 0.f, 0.f, 0.f};
#pragma unroll
            for (int ks = 0; ks < 4; ++ks) { const bf16x8 a = ld_split8(Qs + (16 * mt + l15) * P128 + 32 * ks + quad * 4); acc = mfma16(a, Bst[ks], acc); }
#pragma unroll
            for (int jj = 0; jj < 4; ++jj) { const int i = 16 * mt + quad * 4 + jj; acc[jj] *= rq[i] * egs[i]; }
#pragma unroll
            for (int k2 = 0; k2 < 2; ++k2) { const bf16x8 a = ld_split8(QKs + (16 * mt + l15) * P64 + 32 * k2 + quad * 4); acc = mfma16(a, Bvn[k2], acc); }
#pragma unroll
            for (int jj = 0; jj < 4; ++jj) { const int i = 16 * mt + quad * 4 + jj; const int t = c0 + (dir ? 63 - i : i);
                Odir[(size_t)(m0 + t) * 512 + hd * 128 + 16 * w + l15] = (bf16)f2bf(acc[jj]); } }
        const float egl = rq[384];
#pragma unroll
        for (int mt = 0; mt < 8; ++mt) { f32x4 acc = Sacc[mt] * egl;
#pragma unroll
            for (int k2 = 0; k2 < 2; ++k2) { const bf16x8 a = ld_split8(KT + (16 * mt + l15) * P64 + 32 * k2 + quad * 4); acc = mfma16(a, Bvn[k2], acc); }
            Sacc[mt] = acc; }
#endif
        WAVE_SYNC();
    }
    if (!lat) { const int tid2 = tid_fresh(wid0), lane2 = tid2 & 63; float* dp = P.out + OUT_DELTA + sbase + (size_t)((lane2 >> 4) * 4) * 128 + 16 * w + (lane2 & 15);
#pragma unroll
        for (int mt = 0; mt < 8; ++mt)
#pragma unroll
            for (int jj = 0; jj < 4; ++jj) dp[(16 * mt + jj) * 128] = Sacc[mt][jj];
    }
    __syncthreads();
}

__device__ __forceinline__ void phase_mix_even(int wid0, const Params& P, LAS unsigned char* lds, int e, int mode = 3) {
    const int bid = bid_fresh(), G = grid_fresh();
    if (G == 256) {
        if (bid < 64) { const int s = 32 + (bid >> 3), hd = (bid >> 1) & 3, dir = bid & 1; if (mode & 1) gdn_chain(wid0, P, lds, e, s, hd, dir); }
        else { const int bb = bid - 64;
            if (mode & 1) for (int c = bb; c < 256; c += 192) { const int s = c >> 3, hd = (c >> 1) & 3, dir = c & 1; gdn_chain(wid0, P, lds, e, s, hd, dir); }
            if (mode & 2) { const int tid = tid_fresh(wid0), lane = tid & 63, wave = tid >> 6;
                for (int t = bb; t < 384; t += 192) { const int wt = t * 8 + wave; s5_task_main(P, lds + wave * S5_WLDS, lane, e, wt >> 5, wt & 31); } } }
    } else {
        for (int c = bid; c < 320; c += G) { const int s = c < 64 ? 32 + (c >> 3) : ((c - 64) >> 3), hd = (c >> 1) & 3, dir = c & 1; gdn_chain(wid0, P, lds, e, s, hd, dir); }
        const int tid = tid_fresh(wid0), lane = tid & 63, wave = tid >> 6;
        for (int t = bid; t < 384; t += G) { const int wt = t * 8 + wave; s5_task_main(P, lds + wave * S5_WLDS, lane, e, wt >> 5, wt & 31); }
    }
}
__device__ __forceinline__ void phase_fin_even(int wid0, const Params& P, LAS unsigned char* lds, int e) {
    const int tid = tid_fresh(wid0), lane = tid & 63, wave = tid >> 6;
    const int gw = bid_fresh() * NWAVES + wave, NGW = grid_fresh() * NWAVES;
    for (int wt = gw; wt < 2048; wt += NGW) s5_task_corr(P, lds + wave * S5_WLDS, lane, e, wt >> 5, wt & 31);
    const bf16* proj = (const bf16*)(P.ws + WS_BIG); const bf16* Of = (const bf16*)(P.ws + WS_H); const bf16* Ob = Of + (size_t)MT * 512; bf16* mixout = (bf16*)(P.ws + WS_MIX);
    for (int m = gw; m < MT; m += NGW) {
        const u32x4 a = *(const u32x4*)(Of + (size_t)m * 512 + lane * 8), bq = *(const u32x4*)(Ob + (size_t)m * 512 + lane * 8), z = *(const u32x4*)(proj + (size_t)m * NPROJ_E + 2560 + lane * 8);
        float o[8]; float ss = 0.f;
#pragma unroll
        for (int j = 0; j < 4; ++j) { o[2 * j] = bflo(a[j]) + bflo(bq[j]); o[2 * j + 1] = bfhi(a[j]) + bfhi(bq[j]); ss += o[2 * j] * o[2 * j] + o[2 * j + 1] * o[2 * j + 1]; }
        ss += shfl_i(ss, lane ^ 1); ss += shfl_i(ss, lane ^ 2); ss += shfl_i(ss, lane ^ 4); ss += shfl_i(ss, lane ^ 8);
        const float rs = rsqrtf(ss * (1.0f / 128.0f) + EPSF);
        const float* gn = P.in[I_GONORM] + e * 128 + (lane & 15) * 8;
        unsigned pw[4];
#pragma unroll
        for (int j = 0; j < 4; ++j) { const float z0 = bflo(z[j]), z1 = bfhi(z[j]); pw[j] = pk2(o[2 * j] * rs * gn[2 * j] * siluf_(z0), o[2 * j + 1] * rs * gn[2 * j + 1] * siluf_(z1)); }
        *(u32x4*)(mixout + (size_t)m * DM + 512 + lane * 8) = (u32x4){pw[0], pw[1], pw[2], pw[3]};
    }
}

__device__ __forceinline__ void phase_conv_odd(int wid0, const Params& P, int o) {
    const int tid = tid_fresh(wid0), lane = tid & 63, wave = tid >> 6;
    const int gw = bid_fresh() * NWAVES + wave, NGW = grid_fresh() * NWAVES;
    const bf16* proj = (const bf16*)(P.ws + WS_BIG); bf16* cx = (bf16*)(P.ws + WS_H);
    const float* cw = P.in[I_LCONVW] + (size_t)o * 4 * 1024; const float* cb = P.in[I_LCONVB] + o * 1024;
    for (int m = gw; m < MT; m += NGW) {
        const int t = m < MCTX ? (m & 255) : ((m - MCTX) & 2047); const int L = m < MCTX ? LCTX : LLAT;
#pragma unroll
        for (int h2 = 0; h2 < 2; ++h2) { const int ch = lane * 8 + 512 * h2;
            float acc[8];
#pragma unroll
            for (int j = 0; j < 8; ++j) acc[j] = cb[ch + j];
#pragma unroll
            for (int k = 0; k < 4; ++k) { const int tt = t - 1 + k; if (tt >= 0 && tt < L) { const u32x4 v = *(const u32x4*)(proj + (size_t)(m - 1 + k) * 2048 + ch);
#pragma unroll
                    for (int j = 0; j < 4; ++j) { acc[2 * j] += cw[k * 1024 + ch + 2 * j] * bflo(v[j]); acc[2 * j + 1] += cw[k * 1024 + ch + 2 * j + 1] * bfhi(v[j]); } } }
            *(u32x4*)(cx + (size_t)m * DM + ch) = (u32x4){pk2(acc[0], acc[1]), pk2(acc[2], acc[3]), pk2(acc[4], acc[5]), pk2(acc[6], acc[7])}; }
    }
}
__device__ __forceinline__ void phase_lru_scan(int wid0, const Params& P, int o, int d) {
    const int tid = tid_fresh(wid0), lane = tid & 63, wave = tid >> 6;
    const int gw = bid_fresh() * NWAVES + wave, NGW = grid_fresh() * NWAVES;
    const unsigned* G = (const unsigned*)(P.ws + WS_GATES); const bf16* proj = (const bf16*)(P.ws + WS_BIG); bf16* mixout = (bf16*)(P.ws + WS_MIX);
    for (int task = gw; task < 640; task += NGW) {
        int s, cg_;
        if (task < 128) { s = 32 + (task >> 4); cg_ = task & 15; } else { s = (task - 128) >> 4; cg_ = (task - 128) & 15; }
        const bool lat = s >= 32; const int b = lat ? s - 32 : s; const int L = lat ? LLAT : LCTX; const int m0 = lat ? MCTX + b * LLAT : s * LCTX;
        const int ch = cg_ * 64 + lane;
        float h = lat ? P.in[I_SLRU][(((size_t)b * 2 + o) * 2 + d) * 1024 + ch] : 0.f;
        if (d == 0) {
            for (int t0 = 0; t0 < L; t0 += 32) {
                unsigned gv[32];
#pragma unroll
                for (int i = 0; i < 32; ++i) gv[i] = G[(size_t)(m0 + t0 + i) * DM + ch];
#pragma unroll
                for (int i = 0; i < 32; ++i) { h = __builtin_amdgcn_exp2f(bflo(gv[i])) * h + bfhi(gv[i]); mixout[(size_t)(m0 + t0 + i) * DM + ch] = (bf16)f2bf(h); }
            }
        } else {
            for (int t0 = 0; t0 < L; t0 += 16) {
                unsigned gv[16]; bf16 pv[16], yv[16];
#pragma unroll
                for (int i = 0; i < 16; ++i) { const size_t m = (size_t)(m0 + L - 1 - (t0 + i)); gv[i] = G[m * DM + ch]; pv[i] = mixout[m * DM + ch]; yv[i] = proj[m * 2048 + 1024 + ch]; }
#pragma unroll
                for (int i = 0; i < 16; ++i) { const size_t m = (size_t)(m0 + L - 1 - (t0 + i));
                    h = __builtin_amdgcn_exp2f(bflo(gv[i])) * h + bfhi(gv[i]);
                    mixout[m * DM + ch] = (bf16)f2bf((bf2f(pv[i]) + h) * geluf_(bf2f(yv[i]))); }
            }
        }
        if (!lat) P.out[OUT_LRU + (((size_t)b * 2 + o) * 2 + d) * 1024 + ch] = h;
    }
}
#ifdef PROBE_DUP_GEMM
#define DUPG(x) GSYNC(); x
#else
#define DUPG(x)
#endif
typedef const __attribute__((address_space(4))) Params* KParams;
__device__ __forceinline__ Params load_params(KParams q) { Params r;
#pragma unroll
    for (int i = 0; i < 40; ++i) r.in[i] = q->in[i];
    r.out = q->out; r.ws = q->ws; return r; }
#define FRESH() const int G = grid_fresh(), bid = bid_fresh(); (void)G; (void)bid; KParams pk_ = (KParams)__builtin_amdgcn_kernarg_segment_ptr(); asm volatile("" : "+s"(pk_)); const Params P = load_params(pk_); unsigned char* ws = P.ws; \
    const float* mod = (const float*)(ws + WS_MOD); bf16* H = (bf16*)(ws + WS_H); bf16* BIG = (bf16*)(ws + WS_BIG); bf16* MIX = (bf16*)(ws + WS_MIX); (void)mod; (void)H; (void)BIG; (void)MIX;
#define GSYNC() do { KParams pb_ = (KParams)__builtin_amdgcn_kernarg_segment_ptr(); asm volatile("" : "+s"(pb_)); xcd_barrier(wid0, (unsigned*)(pb_->ws + WS_BAR), lds); } while (0)
__global__ void __launch_bounds__(NTHR, 2) fwd_kernel(Params Parg) {
    extern __shared__ __attribute__((aligned(16))) unsigned char lds_raw[];
    LAS unsigned char* lds = (LAS unsigned char*)lds_raw;
    cg::grid_group grid = cg::this_grid();
    const int wid0 = __builtin_amdgcn_readfirstlane(threadIdx.x >> 6);
    if (threadIdx.x < 4) ((LAS unsigned*)(lds + LDS_BARST))[threadIdx.x] = 0u;
    __syncthreads();
    if (threadIdx.x == 0) (void)xb_add((unsigned*)(Parg.ws + WS_BAR) + XB_XCNT(xb_xcc_id()), 1u);

    { FRESH(); phase_prologue(wid0, P, lds); }
    grid.sync();
#ifdef PROBE_DUP_PRO
    { FRESH(); phase_prologue(wid0, P, lds); }
    GSYNC();
#endif
    { FRESH(); phase_modreduce(wid0, P); }
    GSYNC();
#ifdef PROBE_SYNC
#pragma unroll 1
    for (int i = 0; i < 40; ++i) GSYNC();
#endif
#pragma unroll 1
    for (int l = 0; l < 4; ++l) {
        { FRESH(); const float* modl = mod + (size_t)l * 9 * 6144;
        phase_rownorm(wid0, P, l == 0, MIX, modl - 9 * 6144, 5 * 1024, P.in[I_NMLPPOST] + (l > 0 ? (l - 1) * 1024 : 0), 1, P.in[I_NMIXPRE] + l * 1024, modl, 0, H); }
        GSYNC();
        const int eo = l >> 1;
        {
            FRESH();
            pg8::Gemm g; pg8::StaticOrder S; EpiBf16<0> E;
            if ((l & 1) == 0) { g = pg8::Gemm{H, (const bf16*)(ws + WS_WINE) + (size_t)eo * NB_E * 1024, MT, NB_E, 1024, 1024, 0, 0}; E = EpiBf16<0>{BIG, NPROJ_E, (float*)(ws + WS_AB)}; }
            else { g = pg8::Gemm{H, (const bf16*)(ws + WS_WINO) + (size_t)eo * 2048 * 1024, MT, 2048, 1024, 1024, 0, 0}; E = EpiBf16<0>{BIG, 2048, nullptr}; }
            S.init(g.M, g.N, G, bid);
            pg8::gemm_phase(wid0, lds, g, S, E); DUPG(pg8::gemm_phase(wid0, lds, g, S, E);)
        }
        GSYNC();
        if ((l & 1) == 0) {
#ifdef PROBE_DUP_MIX
#pragma unroll 1
            for (int rep = 0; rep < 2; ++rep) { { FRESH(); phase_mix_even(wid0, P, lds, eo, rep == 0 ? 3 : PROBE_DUP_MIX); } GSYNC(); }
#else
            { FRESH(); phase_mix_even(wid0, P, lds, eo); }
            GSYNC();
#endif
            { FRESH(); phase_fin_even(wid0, P, lds, eo); }
            GSYNC();
        } else {
            { FRESH(); phase_conv_odd(wid0, P, eo); }
            GSYNC();
#ifdef PROBE_DUP_CONV
            { FRESH(); phase_conv_odd(wid0, P, eo); }
            GSYNC();
#endif
#pragma unroll 1
            for (int d = 0; d < 2; ++d) {
                { FRESH();
                pg8::Gemm g{H, (const bf16*)(ws + WS_WG) + (size_t)(eo * 2 + d) * 2048 * 256, MT, 2048, 256, 1024, 1, 1};
                EpiGates E{(unsigned*)(ws + WS_GATES), H, P.in[I_LBR] + (eo * 2 + d) * 1024, P.in[I_LBI] + (eo * 2 + d) * 1024, P.in[I_LLAM] + (eo * 2 + d) * 1024};
                pg8::StaticOrder S; S.init(g.M, g.N, G, bid);
                pg8::gemm_phase(wid0, lds, g, S, E); DUPG(pg8::gemm_phase(wid0, lds, g, S, E);) }
                GSYNC();
                { FRESH(); phase_lru_scan(wid0, P, eo, d); }
#ifdef PROBE_DUP_LRU0
                if (d == 0) { GSYNC(); FRESH(); phase_lru_scan(wid0, P, eo, d); }
#endif
                GSYNC();
            }
        }
        {
            FRESH();
            pg8::Gemm g{MIX, (const bf16*)(ws + ((l & 1) ? WS_WOUTO : WS_WOUTE)) + (size_t)eo * 1024 * 1024, MT, 1024, 1024, 1024, 0, 0};
            EpiBf16<0> E{BIG, 1024, nullptr}; pg8::StaticOrder S; S.init(g.M, g.N, G, bid);
            pg8::gemm_phase(wid0, lds, g, S, E); DUPG(pg8::gemm_phase(wid0, lds, g, S, E);)
        }
        GSYNC();
        { FRESH(); const float* modl = mod + (size_t)l * 9 * 6144;
        phase_rownorm(wid0, P, 0, BIG, modl, 2 * 1024, P.in[I_NMIXPOST] + l * 1024, 1, P.in[I_NMLPPRE] + l * 1024, modl, 3 * 1024, H); }
        GSYNC();
        {
            FRESH();
            pg8::Gemm g{H, (const bf16*)(ws + WS_W1T) + (size_t)l * 4096 * 1024, MT, 4096, 1024, 1024, 0, 0};
            EpiBf16<1> E{BIG, 4096, nullptr}; pg8::StaticOrder S; S.init(g.M, g.N, G, bid);
            pg8::gemm_phase(wid0, lds, g, S, E); DUPG(pg8::gemm_phase(wid0, lds, g, S, E);)
        }
        GSYNC();
        {
            FRESH();
            pg8::Gemm g{BIG, (const bf16*)(ws + WS_W2T) + (size_t)l * 1024 * 4096, MT, 1024, 4096, 4096, 0, 0};
            EpiBf16<0> E{MIX, 1024, nullptr}; pg8::StaticOrder S; S.init(g.M, g.N, G, bid);
            pg8::gemm_phase(wid0, lds, g, S, E); DUPG(pg8::gemm_phase(wid0, lds, g, S, E);)
        }
        GSYNC();
    }
    { FRESH();
    phase_rownorm(wid0, P, 0, MIX, mod + (size_t)3 * 9 * 6144, 5 * 1024, P.in[I_NMLPPOST] + 3 * 1024, 0, P.in[I_NMIXPRE], mod, 0, H); }
}

extern "C" void kernel_launch(void* const* d_in, const int* in_sizes, int n_in, void* d_out, int out_size, void* d_ws, size_t ws_size, hipStream_t stream) {
    static int grid = 0;
    if (grid == 0) {
        if (n_in != 40 || ws_size < WS_END) { fprintf(stderr, "kernel_launch: expected 40 inputs and >= %zu bytes of workspace (got %d, %zu)\n", (size_t)WS_END, n_in, ws_size); grid = -1; return; }
        int dev = 0, cus = 0, per_cu = 0;
        if (hipGetDevice(&dev) != hipSuccess || hipDeviceGetAttribute(&cus, hipDeviceAttributeMultiprocessorCount, dev) != hipSuccess) { grid = -1; return; }
        if (hipFuncSetAttribute((const void*)fwd_kernel, hipFuncAttributeMaxDynamicSharedMemorySize, LDS_BYTES) != hipSuccess) { fprintf(stderr, "kernel_launch: hipFuncSetAttribute failed\n"); grid = -1; return; }
        if (hipOccupancyMaxActiveBlocksPerMultiprocessor(&per_cu, (const void*)fwd_kernel, NTHR, LDS_BYTES) != hipSuccess || per_cu < 1) per_cu = 1;
        (void)hipGetLastError();
        grid = cus * per_cu; if (grid > 256) grid = 256;
    }
    if (grid < 0) return;
    (void)hipMemsetAsync((char*)d_ws + WS_BAR, 0, 16384, stream);
    Params p{};
    for (int i = 0; i < 40; ++i) p.in[i] = (const float*)d_in[i];
    p.out = (float*)d_out; p.ws = (unsigned char*)d_ws;
    void* args[] = {&p};
    hipError_t e = hipLaunchCooperativeKernel((const void*)fwd_kernel, dim3(grid), dim3(NTHR), args, LDS_BYTES, stream);
    if (e != hipSuccess) fprintf(stderr, "cooperative launch failed: %s (grid %d)\n", hipGetErrorString(e), grid);
}
```

```cpp
#include <hip/hip_runtime.h>
#include <hip/hip_cooperative_groups.h>
#include <cstdio>
#include <cstdint>
namespace cg = cooperative_groups;
__device__ __forceinline__ int bid_fresh() { int t = blockIdx.x; asm volatile("" : "+s"(t)); return t; }
__device__ __forceinline__ int grid_fresh() { int t = gridDim.x; asm volatile("" : "+s"(t)); return t; }
__device__ __forceinline__ int tid_fresh(int w) { asm volatile("" : "+s"(w)); int l; asm volatile("v_mbcnt_lo_u32_b32 %0, -1, 0\n\tv_mbcnt_hi_u32_b32 %0, -1, %0" : "=v"(l)); return w * 64 + l; }

namespace pg8 {
#define PG8_LAS __attribute__((address_space(3)))
typedef unsigned short bf16_t;
typedef short bf16x8 __attribute__((ext_vector_type(8)));
typedef float f32x4 __attribute__((ext_vector_type(4)));
typedef unsigned u32x4 __attribute__((ext_vector_type(4)));
typedef unsigned u32x2 __attribute__((ext_vector_type(2)));
constexpr int BM = 256, BK = 64, HALF = 128, HTB = HALF * BK * 2, STAGE_BYTES = 8 * HTB, NXCD = 8, WGM = 8;

__host__ __device__ __forceinline__ int lds_byte(int r, int c) { const int st = (r >> 4) * 2 + (c >> 5), rr = r & 15, cc = c & 31, ob = rr * 64 + cc * 2; return st * 1024 + (ob ^ (((ob >> 9) & 1) << 5)); }
__host__ __device__ __forceinline__ void stage_rc(int b, int& R, int& C) { const int st = b / 1024, sb = b % 1024, swz = sb ^ (((sb >> 9) & 1) << 5); R = (st >> 1) * 16 + swz / 64; C = (st & 1) * 32 + (swz % 64) / 2; }
__host__ __device__ __forceinline__ int perm32(int rho) { const int n = rho >> 4, i = rho & 15; return 8 * (i >> 2) + 4 * n + (i & 3); }

struct Unit { int pm, pn; };
struct Gemm { const bf16_t* A; const bf16_t* Bt; int M, N, K, lda, ablk, ashift; };

struct StaticOrder {
    int nM, nN, nwg, G, c;
    __host__ __device__ void init(int M, int N, int G_, int c_) { nM = M / BM; nN = N / BM; nwg = nM * nN; G = G_; c = c_; }
    __host__ __device__ bool next(int i, Unit& u) const {
        const long L = (long)i * G + c; if (L >= nwg) return false;
        int wgid = (int)L; { const int q = nwg / NXCD, r = nwg % NXCD, xcd = wgid % NXCD, off = wgid / NXCD; wgid = (xcd < r ? xcd * (q + 1) : r * (q + 1) + (xcd - r) * q) + off; }
        const int nig = WGM * nN, gid = wgid / nig, fm = gid * WGM, gsz = (nM - fm) < WGM ? (nM - fm) : WGM;
        u.pm = fm + ((wgid % nig) % gsz); u.pn = (wgid % nig) / gsz; return true;
    }
};
__device__ __forceinline__ unsigned cvt_pk_bf16(float lo, float hi) { unsigned r; asm volatile("v_cvt_pk_bf16_f32 %0, %1, %2" : "=v"(r) : "v"(lo), "v"(hi)); return r; }

template <class Epi>
__device__ __forceinline__ void gemm_phase(int wid0, PG8_LAS unsigned char* lds, const Gemm g, const StaticOrder& S, const Epi& E) {
    const int tid = tid_fresh(wid0), wid = __builtin_amdgcn_readfirstlane(tid >> 6), lane = tid & 63, wr = wid >> 2, wc = wid & 3, fr = lane & 15, fq = lane >> 4;
    const int K = g.K, nt = K / BK, lda = g.lda;
    unsigned voffA[2], voffB[2];
#pragma unroll
    for (int i = 0; i < 2; ++i) { int R, C; stage_rc(tid * 16 + i * 8192, R, C); const int Rb = (R & ~31) + perm32(R & 31);
        voffA[i] = (unsigned)(R * lda + C) * 2u; voffB[i] = (unsigned)(Rb * K + C) * 2u; }
    const size_t kstep = (size_t)(BK * 2);
    const size_t hstepA = (size_t)HALF * lda * 2, hstepB = (size_t)HALF * K * 2;
    const size_t tstepA = 2 * hstepA, tstepB = 2 * hstepB;
    const unsigned ldsw = (unsigned)wid * 1024u;
    const int aoff = lds_byte(wr * 64 + fr, fq * 8), boff = lds_byte(wc * 32 + fr, fq * 8);
#define PG8_ACOL(pn) (g.ablk ? (size_t)((((pn) >> g.ashift) & 3) * 512) : (size_t)0)
#define PG8_SA(b, h) (((b) * 2 + (h)) * HTB)
#define PG8_SB(b, h) ((4 + (b) * 2 + (h)) * HTB)
#define PG8_STAGE(bufoff, gbase, voff) do { _Pragma("unroll") for (int _i = 0; _i < 2; ++_i) \
        __builtin_amdgcn_global_load_lds((const unsigned*)((const char*)(gbase) + (voff)[_i]), (PG8_LAS unsigned*)(lds + (bufoff) + ldsw + _i * 8192), 16, 0, 0); } while (0)
#define PG8_LDA(dst, b, h) do { _Pragma("unroll") for (int m = 0; m < 4; ++m) _Pragma("unroll") for (int k = 0; k < 2; ++k) dst[m][k] = *(const PG8_LAS bf16x8*)(lds + PG8_SA(b, h) + aoff + m * 2048 + k * 1024); } while (0)
#define PG8_LDB(dst, b, h) do { _Pragma("unroll") for (int n = 0; n < 2; ++n) _Pragma("unroll") for (int k = 0; k < 2; ++k) dst[n][k] = *(const PG8_LAS bf16x8*)(lds + PG8_SB(b, h) + boff + n * 2048 + k * 1024); } while (0)
#define PG8_MMA(ai, bj, At, Bt) do { __builtin_amdgcn_s_setprio(1); _Pragma("unroll") for (int m = 0; m < 4; ++m) _Pragma("unroll") for (int n = 0; n < 2; ++n) _Pragma("unroll") for (int k = 0; k < 2; ++k) \
        acc[ai][bj][m][n] = __builtin_amdgcn_mfma_f32_16x16x32_bf16(Bt[n][k], At[m][k], acc[ai][bj][m][n], 0, 0, 0); __builtin_amdgcn_s_setprio(0); } while (0)
#define PG8_WAIT_V(n) asm volatile("s_waitcnt vmcnt(" #n ")" ::: "memory")
#define PG8_WAIT_L(n) asm volatile("s_waitcnt lgkmcnt(" #n ")" ::: "memory")
#define PG8_BAR __builtin_amdgcn_s_barrier()
#define PG8_SCHED __builtin_amdgcn_sched_barrier(0)
    Unit cur, nxt; int ui = 0;
    if (!S.next(0, cur)) return;
    f32x4 acc[2][2][4][2];
#pragma unroll
    for (int a = 0; a < 2; ++a)
#pragma unroll
        for (int b = 0; b < 2; ++b)
#pragma unroll
            for (int m = 0; m < 4; ++m)
#pragma unroll
                for (int n = 0; n < 2; ++n) acc[a][b][m][n] = (f32x4){0.f, 0.f, 0.f, 0.f};
    bf16x8 At[4][2], B0[2][2], B1[2][2];
    const char* cA = (const char*)g.A + (size_t)cur.pm * tstepA + PG8_ACOL(cur.pn); const char* cB = (const char*)g.Bt + (size_t)cur.pn * tstepB;
    PG8_STAGE(PG8_SB(0, 0), cB, voffB); PG8_STAGE(PG8_SA(0, 0), cA, voffA); PG8_STAGE(PG8_SB(0, 1), cB + hstepB, voffB); PG8_STAGE(PG8_SA(0, 1), cA + hstepA, voffA);
    if (wr == 1) PG8_BAR;
    PG8_WAIT_V(4); PG8_BAR;
    PG8_STAGE(PG8_SB(1, 0), cB + kstep, voffB); PG8_STAGE(PG8_SA(1, 0), cA + kstep, voffA); PG8_STAGE(PG8_SB(1, 1), cB + hstepB + kstep, voffB);
    PG8_WAIT_V(6); PG8_BAR;
    for (;;) {
        const bool has_next = S.next(ui + 1, nxt);
        const char* nA = has_next ? (const char*)g.A + (size_t)nxt.pm * tstepA + PG8_ACOL(nxt.pn) : cA; const char* nB = has_next ? (const char*)g.Bt + (size_t)nxt.pn * tstepB : cB;
        for (int t = 0; t < nt; t += 2) {
            const bool last = (t == nt - 2);
            const char* a1 = cA + (size_t)(t + 1) * kstep;
            const char* a2 = last ? nA : cA + (size_t)(t + 2) * kstep; const char* b2 = last ? nB : cB + (size_t)(t + 2) * kstep;
            const char* a3 = a2 + kstep; const char* b3 = b2 + kstep;
            PG8_LDB(B0, 0, 0); PG8_SCHED; PG8_LDA(At, 0, 0); PG8_STAGE(PG8_SA(1, 1), a1 + hstepA, voffA);
            PG8_WAIT_L(8); PG8_BAR; PG8_WAIT_L(0); PG8_MMA(0, 0, At, B0); PG8_BAR; PG8_SCHED;
            PG8_LDB(B1, 0, 1); PG8_STAGE(PG8_SB(0, 0), b2, voffB);
            PG8_BAR; PG8_WAIT_L(0); PG8_MMA(0, 1, At, B1); PG8_BAR;
            PG8_LDA(At, 0, 1); PG8_STAGE(PG8_SA(0, 0), a2, voffA);
            PG8_BAR; PG8_WAIT_L(0); PG8_MMA(1, 0, At, B0); PG8_BAR; PG8_SCHED;
            PG8_STAGE(PG8_SB(0, 1), b2 + hstepB, voffB);
            PG8_WAIT_V(6); PG8_BAR; PG8_MMA(1, 1, At, B1); PG8_BAR;
            PG8_LDB(B0, 1, 0); PG8_SCHED; PG8_LDA(At, 1, 0); PG8_STAGE(PG8_SA(0, 1), a2 + hstepA, voffA);
            PG8_WAIT_L(8); PG8_BAR; PG8_WAIT_L(0); PG8_MMA(0, 0, At, B0); PG8_BAR; PG8_SCHED;
            PG8_LDB(B1, 1, 1); PG8_STAGE(PG8_SB(1, 0), b3, voffB);
            PG8_BAR; PG8_WAIT_L(0); PG8_MMA(0, 1, At, B1); PG8_BAR;
            PG8_LDA(At, 1, 1); PG8_STAGE(PG8_SA(1, 0), a3, voffA);
            PG8_BAR; PG8_WAIT_L(0); PG8_MMA(1, 0, At, B0); PG8_BAR; PG8_SCHED;
            PG8_STAGE(PG8_SB(1, 1), b3 + hstepB, voffB);
            PG8_WAIT_V(6); PG8_BAR; PG8_MMA(1, 1, At, B1); PG8_BAR;
        }
        E(acc, cur, wr, wc, fr, fq);
        if (!has_next) break;
#pragma unroll
        for (int a = 0; a < 2; ++a)
#pragma unroll
            for (int b = 0; b < 2; ++b)
#pragma unroll
                for (int m = 0; m < 4; ++m)
#pragma unroll
                    for (int n = 0; n < 2; ++n) acc[a][b][m][n] = (f32x4){0.f, 0.f, 0.f, 0.f};
        cur = nxt; cA = nA; cB = nB; ++ui;
    }
    PG8_WAIT_V(0);
    if (wr == 0) PG8_BAR;
    PG8_BAR;
#undef PG8_ACOL
#undef PG8_SA
#undef PG8_SB
#undef PG8_STAGE
#undef PG8_LDA
#undef PG8_LDB
#undef PG8_MMA
#undef PG8_WAIT_V
#undef PG8_WAIT_L
#undef PG8_BAR
#undef PG8_SCHED
}
}
#define LAS __attribute__((address_space(3)))
typedef unsigned short bf16;
typedef short bf16x8 __attribute__((ext_vector_type(8)));
typedef float f32x4 __attribute__((ext_vector_type(4)));
typedef unsigned u32x4 __attribute__((ext_vector_type(4)));
typedef unsigned u32x2 __attribute__((ext_vector_type(2)));
constexpr int DM = 1024, MT = 24576, MCTX = 8192, LCTX = 256, LLAT = 2048, NWAVES = 8, NTHR = 512;
constexpr int NPROJ_E = 3072, NB_E = 3328, IN_EVEN_LD = 3088;
constexpr float EPSF = 1e-6f;
constexpr size_t MiB = 1u << 20;
constexpr size_t WS_MOD = 0, MOD_BYTES = 4 * 9 * 6144 * 4, WS_S5F = 1 * MiB, WS_AB = 3 * MiB, WS_W1T = 5 * MiB, WS_W2T = 37 * MiB, WS_WINE = 69 * MiB,
                 WS_WOUTE = 82 * MiB, WS_WINO = 86 * MiB, WS_WOUTO = 94 * MiB, WS_WG = 98 * MiB, WS_H = 102 * MiB, WS_BIG = 150 * MiB, WS_YBUF = 294 * MiB,
                 WS_GATES = 246 * MiB, WS_MIX = 342 * MiB, WS_END = 390 * MiB;
constexpr int LDS_BYTES = 147456;
constexpr size_t OUT_S5RE = 25165824, OUT_S5IM = OUT_S5RE + 262144, OUT_DELTA = OUT_S5IM + 262144, OUT_LRU = OUT_DELTA + 8388608;

struct Params { const float* in[40]; float* out; unsigned char* ws; };
enum { I_XP = 0, I_XS, I_S5RE, I_S5IM, I_SDELTA, I_SLRU, I_C, I_CCTX, I_WADA, I_BADA, I_NMIXPRE, I_NMIXPOST, I_NMLPPRE, I_NMLPPOST, I_WMLPIN, I_WMLPOUT, I_WINE, I_WOUTE,
       I_LAMRE, I_LAMIM, I_LOGDT, I_BRE, I_BIM, I_CRE, I_CIM, I_S5D, I_GCONVW, I_GCONVB, I_GALOG, I_GDTB, I_GONORM, I_WINO, I_WOUTO, I_LCONVW, I_LCONVB, I_LWR, I_LBR, I_LWI, I_LBI, I_LLAM };

typedef __bf16 bf2_t __attribute__((ext_vector_type(2)));
typedef float f2_t __attribute__((ext_vector_type(2)));
__device__ __forceinline__ unsigned pk2(float lo, float hi) { const bf2_t v = __builtin_convertvector((f2_t){lo, hi}, bf2_t); return __builtin_bit_cast(unsigned, v); }
__device__ __forceinline__ unsigned f2bf(float f) { return pk2(f, f) & 0xffffu; }
__device__ __forceinline__ float bflo(unsigned w) { return __builtin_bit_cast(float, w << 16); }
__device__ __forceinline__ float bfhi(unsigned w) { return __builtin_bit_cast(float, w & 0xffff0000u); }
__device__ __forceinline__ float bf2f(bf16 b) { return __builtin_bit_cast(float, (unsigned)b << 16); }
__device__ __forceinline__ float sigmoidf_(float x) { return __builtin_amdgcn_rcpf(1.0f + __expf(-x)); }
__device__ __forceinline__ float siluf_(float x) { return x * sigmoidf_(x); }
__device__ __forceinline__ float softplusf_(float x) { return fmaxf(x, 0.f) + __logf(1.0f + __expf(-fabsf(x))); }
__device__ __forceinline__ float geluf_(float x) { const float y = 0.7978845608028654f * (x + 0.044715f * x * x * x); const float t = 1.0f - 2.0f * __builtin_amdgcn_rcpf(__expf(2.0f * y) + 1.0f); return 0.5f * x * (1.0f + t); }
__device__ __forceinline__ float shfl_i(float v, int srclane) { return __builtin_bit_cast(float, __builtin_amdgcn_ds_bpermute(srclane << 2, __builtin_bit_cast(int, v))); }
__device__ __forceinline__ float wave_sum(float v, int lane) {
#pragma unroll
    for (int o = 1; o < 64; o <<= 1) v += shfl_i(v, lane ^ o);
    return v;
}
#define LDS_WAIT() asm volatile("s_waitcnt lgkmcnt(0)" ::: "memory")
#define WAVE_SYNC() do { asm volatile("s_waitcnt lgkmcnt(0)" ::: "memory"); __builtin_amdgcn_wave_barrier(); } while (0)
__device__ __forceinline__ f32x4 mfma16(bf16x8 a, bf16x8 b, f32x4 c) { return __builtin_amdgcn_mfma_f32_16x16x32_bf16(a, b, c, 0, 0, 0); }


#define XB_TMO      128
#define XB_XCNT(j)  (256  + 64 * (j))
#define XB_XSUB(j)  (1280 + 64 * (j))
#define XB_XGEN(j)  (2304 + 64 * (j))
#define XB_TOP      3328
#define XB_TOPGEN   3392
#define XCD_BAR_WORDS 3456
#define XB_SPIN_CAP (1u << 18)
constexpr size_t WS_BAR = 960 * 1024; constexpr int LDS_BARST = LDS_BYTES - 16;
__device__ __forceinline__ unsigned xb_ld(unsigned* p)              { return __hip_atomic_load(p, __ATOMIC_RELAXED, __HIP_MEMORY_SCOPE_AGENT); }
__device__ __forceinline__ unsigned xb_add(unsigned* p, unsigned v) { return __hip_atomic_fetch_add(p, v, __ATOMIC_RELAXED, __HIP_MEMORY_SCOPE_AGENT); }
__device__ __forceinline__ unsigned xb_xcc_id() { return (unsigned)__builtin_amdgcn_s_getreg((3 << 11) | 20) & 0xFu; }
#define XB_SPIN(cond, bar) do { unsigned _sp = 0; while (cond) { __builtin_amdgcn_s_sleep(1); \
    if ((++_sp & 255u) == 0u) { if (xb_ld(&(bar)[XB_TMO])) break; if (_sp > XB_SPIN_CAP) { atomicAdd(&(bar)[XB_TMO], 1u); break; } } } } while (0)
__device__ __forceinline__ void xcd_barrier_complete(unsigned* bar, unsigned x, unsigned& nloc, unsigned& nx) {
    const unsigned G = gridDim.x;
    unsigned sum, cnt, mine, sp = 0u;
    for (;;) {
        sum = 0u; cnt = 0u; mine = 0u;
#pragma unroll
        for (unsigned j = 0; j < 16; ++j) { const unsigned c = xb_ld(&bar[XB_XCNT(j)]); sum += c; cnt += (c > 0u) ? 1u : 0u; mine = (j == x) ? c : mine; }
        if (sum == G) break;
        __builtin_amdgcn_s_sleep(1);
        if ((++sp & 255u) == 0u) { if (xb_ld(&bar[XB_TMO])) break; if (sp > XB_SPIN_CAP) { atomicAdd(&bar[XB_TMO], 1u); break; } }
    }
    nloc = mine > 0u ? mine : 1u; nx = cnt > 0u ? cnt : 1u;
}
__device__ __forceinline__ void xcd_barrier(int wid0, unsigned* bar, LAS unsigned char* lds) {
    const int tid = tid_fresh(wid0);
    asm volatile("s_waitcnt vmcnt(0)" ::: "memory");
    __syncthreads();
    if (tid == 0) {
        const unsigned x = xb_xcc_id();
        volatile LAS unsigned* st = (volatile LAS unsigned*)(lds + LDS_BARST);
        __builtin_amdgcn_s_waitcnt(0);
        unsigned nloc = st[0], nx = st[1];
        if (nloc == 0u) { xcd_barrier_complete(bar, x, nloc, nx); st[0] = nloc; st[1] = nx; }
        const unsigned old = xb_add(&bar[XB_XSUB(x)], 1u);
        const unsigned gen = old / nloc;
        if (old + 1u == (gen + 1u) * nloc) {
            __builtin_amdgcn_fence(__ATOMIC_RELEASE, "agent");
            asm volatile("s_waitcnt vmcnt(0)" ::: "memory");
            const unsigned og = xb_add(&bar[XB_TOP], 1u);
            const unsigned tg = og / nx;
            if (og + 1u == (tg + 1u) * nx) xb_add(&bar[XB_TOPGEN], 1u);
            else XB_SPIN(xb_ld(&bar[XB_TOPGEN]) == tg, bar);
            __builtin_amdgcn_fence(__ATOMIC_ACQUIRE, "agent");
            xb_add(&bar[XB_XGEN(x)], 1u);
            asm volatile("s_waitcnt vmcnt(0)" ::: "memory");
        } else {
            XB_SPIN(xb_ld(&bar[XB_XGEN(x)]) == gen, bar);
            __builtin_amdgcn_fence(__ATOMIC_ACQUIRE, "agent");
            asm volatile("s_waitcnt vmcnt(0)" ::: "memory");
        }
    }
    __syncthreads();
}
__device__ __forceinline__ void transpose_item(const float* W, int ldw, int nvalid, int K, bf16* WT, int dst_row0, LAS float* scr, int k0, int n0, int lane) {
    const int nn = n0 + (lane & 31); const bool ok = nn < nvalid;
#pragma unroll 8
    for (int i = 0; i < 32; ++i) { const int kk = 2 * i + (lane >> 5); scr[kk * 33 + (lane & 31)] = ok ? W[(size_t)(k0 + kk) * ldw + nn] : 0.f; }
    WAVE_SYNC();
    const int c = lane & 7;
#pragma unroll
    for (int j = 0; j < 4; ++j) { const int n = (lane >> 3) + 8 * j; const LAS float* s = scr + (8 * c) * 33 + n;
        u32x4 o; o.x = pk2(s[0 * 33], s[1 * 33]); o.y = pk2(s[2 * 33], s[3 * 33]); o.z = pk2(s[4 * 33], s[5 * 33]); o.w = pk2(s[6 * 33], s[7 * 33]);
        *(u32x4*)(WT + (size_t)(dst_row0 + n) * K + k0 + 8 * c) = o; }
    WAVE_SYNC();
}
__device__ __forceinline__ void phase_prologue(int wid0, const Params& P, LAS unsigned char* lds) {
    const int tid = tid_fresh(wid0), lane = tid & 63, wave = tid >> 6;
    LAS float* scr = (LAS float*)(lds + wave * 16384);
    const int gw = bid_fresh() * NWAVES + wave, NGW = grid_fresh() * NWAVES;
    unsigned char* ws = P.ws;
    constexpr int NA = 8192, NB = 8192, NC = 2 * 16 * 97, ND = 1024, NE = 2048, NF = 1024, NG = 1024, NTR = NA + NB + NC + ND + NE + NF + NG, NMOD = 4 * 24 * 16;
    for (int it = gw; it < NTR + NMOD; it += NGW) {
        int r = it;
        if (r < NA) { const int l = r >> 11, q = r & 2047; transpose_item(P.in[I_WMLPIN] + (size_t)l * 1024 * 4096, 4096, 4096, 1024, (bf16*)(ws + WS_W1T) + (size_t)l * 4096 * 1024, 32 * (q & 127), scr, 64 * (q >> 7), 32 * (q & 127), lane); continue; } r -= NA;
        if (r < NB) { const int l = r >> 11, q = r & 2047; transpose_item(P.in[I_WMLPOUT] + (size_t)l * 4096 * 1024, 1024, 1024, 4096, (bf16*)(ws + WS_W2T) + (size_t)l * 1024 * 4096, 32 * (q & 31), scr, 64 * (q >> 5), 32 * (q & 31), lane); continue; } r -= NB;
        if (r < NC) { const int e = r / 1552, q = r % 1552, kb = q / 97, nb = q % 97; transpose_item(P.in[I_WINE] + (size_t)e * 1024 * IN_EVEN_LD, IN_EVEN_LD, IN_EVEN_LD, 1024, (bf16*)(ws + WS_WINE) + (size_t)e * NB_E * 1024, 32 * nb, scr, 64 * kb, 32 * nb, lane); continue; } r -= NC;
        if (r < ND) { const int e = r >> 9, q = r & 511; transpose_item(P.in[I_WOUTE] + (size_t)e * 1024 * 1024, 1024, 1024, 1024, (bf16*)(ws + WS_WOUTE) + (size_t)e * 1024 * 1024, 32 * (q & 31), scr, 64 * (q >> 5), 32 * (q & 31), lane); continue; } r -= ND;
        if (r < NE) { const int o = r >> 10, q = r & 1023; transpose_item(P.in[I_WINO] + (size_t)o * 1024 * 2048, 2048, 2048, 1024, (bf16*)(ws + WS_WINO) + (size_t)o * 2048 * 1024, 32 * (q & 63), scr, 64 * (q >> 6), 32 * (q & 63), lane); continue; } r -= NE;
        if (r < NF) { const int o = r >> 9, q = r & 511; transpose_item(P.in[I_WOUTO] + (size_t)o * 1024 * 1024, 1024, 1024, 1024, (bf16*)(ws + WS_WOUTO) + (size_t)o * 1024 * 1024, 32 * (q & 31), scr, 64 * (q >> 5), 32 * (q & 31), lane); continue; } r -= NF;
        if (r < NG) { const int mat = r >> 5, q = r & 31, kb = q >> 3, nb = q & 7; const int blk = mat & 3, gate = (mat >> 2) & 1, od = mat >> 3;
            const float* src = (gate ? P.in[I_LWI] : P.in[I_LWR]) + (size_t)(od * 4 + blk) * 65536;
            const int j0 = nb * 32; const int drow = (blk * 2 + (j0 >> 7)) * 256 + gate * 128 + (j0 & 127);
            transpose_item(src, 256, 256, 256, (bf16*)(ws + WS_WG) + (size_t)od * 2048 * 256, drow - j0 + j0, scr, 64 * kb, j0, lane);
            continue; } r -= NG;
        {
            const int l = r / 384, rem = r % 384, ec = rem >> 4, ks = rem & 15, k0 = ks * 64;
#pragma unroll
            for (int rr = 0; rr < 9; ++rr) { const float cv = rr == 0 ? P.in[I_CCTX][k0 + lane] : P.in[I_C][(rr - 1) * 1024 + k0 + lane]; scr[rr * 64 + lane] = siluf_(cv); }
            WAVE_SYNC();
            f32x4 acc[9];
#pragma unroll
            for (int rr = 0; rr < 9; ++rr) acc[rr] = (f32x4){0.f, 0.f, 0.f, 0.f};
            const float* wp = P.in[I_WADA] + ((size_t)l * 1024 + k0) * 6144 + ec * 256 + lane * 4;
#pragma unroll 4
            for (int kk = 0; kk < 64; ++kk) { const f32x4 w4 = *(const f32x4*)(wp + (size_t)kk * 6144);
#pragma unroll
                for (int rr = 0; rr < 9; ++rr) acc[rr] += w4 * scr[rr * 64 + kk]; }
            float* part = (float*)(ws + WS_BIG) + ((size_t)(ks * 4 + l) * 9) * 6144 + ec * 256 + lane * 4;
#pragma unroll
            for (int rr = 0; rr < 9; ++rr) *(f32x4*)(part + (size_t)rr * 6144) = acc[rr];
            WAVE_SYNC();
        }
    }
    { u32x4* z = (u32x4*)0; (void)z;
      const size_t per = (size_t)(NB_E - 3104) * 1024 * 2 / 16;
      for (size_t i = (size_t)bid_fresh() * NTHR + tid; i < 2 * per; i += (size_t)grid_fresh() * NTHR) { const size_t e = i / per, q = i % per;
          *(u32x4*)(ws + WS_WINE + (e * NB_E + 3104) * 1024 * 2 + q * 16) = (u32x4){0u, 0u, 0u, 0u}; } }
}

__device__ __forceinline__ void phase_modreduce(int wid0, const Params& P) {
    const int tid = tid_fresh(wid0);
    const float* part = (const float*)(P.ws + WS_BIG); float* mod = (float*)(P.ws + WS_MOD);
    for (int i = bid_fresh() * NTHR + tid; i < 4 * 9 * 6144 / 4; i += grid_fresh() * NTHR) {
        const int l = i / (9 * 1536), e4 = i % 1536;
        f32x4 a = *(const f32x4*)(P.in[I_BADA] + (size_t)l * 6144 + e4 * 4);
#pragma unroll
        for (int ks = 0; ks < 16; ++ks) a += *(const f32x4*)(part + (size_t)ks * 4 * 9 * 6144 + (size_t)i * 4);
        *(f32x4*)(mod + (size_t)i * 4) = a; }
}
__device__ __forceinline__ void phase_rownorm(int wid0, const Params& P, int first, const bf16* obuf, const float* modg, int goff, const float* gpost, int has_next, const float* gpre, const float* mods, int soff, bf16* H) {
    const int tid = tid_fresh(wid0), lane = tid & 63, wave = tid >> 6;
    const int gw = bid_fresh() * NWAVES + wave, NGW = grid_fresh() * NWAVES;
    float* X = P.out;
    for (int m = gw; m < MT; m += NGW) {
        const int modrow = m < MCTX ? 0 : 1 + ((m - MCTX) >> 11);
        const float* mr = modg + (size_t)modrow * 6144; const float* ms = mods + (size_t)modrow * 6144;
        f32x4 x[4];
        if (first) {
            if (m < MCTX) {
#pragma unroll
                for (int j = 0; j < 4; ++j) x[j] = *(const f32x4*)(P.in[I_XP] + (size_t)m * DM + lane * 4 + 256 * j);
            } else {
                const int t = (m - MCTX) & 2047; const float prow = (float)(t >> 6), pcol = (float)(t & 63);
                f32x4 om;
#pragma unroll
                for (int e = 0; e < 4; ++e) om[e] = exp2f(-(float)(lane * 4 + e) * (13.287712379549449f / 256.0f));
#pragma unroll
                for (int j = 0; j < 4; ++j) { x[j] = *(const f32x4*)(P.in[I_XS] + (size_t)(m - MCTX) * DM + lane * 4 + 256 * j);
#pragma unroll
                    for (int e = 0; e < 4; ++e) { const float a = (j < 2 ? prow : pcol) * om[e]; x[j][e] += (j & 1) ? cosf(a) : sinf(a); } }
            }
        } else {
            u32x2 ov[4]; float ss = 0.f;
#pragma unroll
            for (int j = 0; j < 4; ++j) { x[j] = *(const f32x4*)(X + (size_t)m * DM + lane * 4 + 256 * j); ov[j] = *(const u32x2*)(obuf + (size_t)m * DM + lane * 4 + 256 * j); }
#pragma unroll
            for (int j = 0; j < 4; ++j) { const float a = bflo(ov[j].x), b = bfhi(ov[j].x), c = bflo(ov[j].y), d = bfhi(ov[j].y); ss += (a * a + b * b) + (c * c + d * d); }
            const float rs = rsqrtf(wave_sum(ss, lane) * (1.0f / DM) + EPSF);
#pragma unroll
            for (int j = 0; j < 4; ++j) { const f32x4 g4 = *(const f32x4*)(gpost + lane * 4 + 256 * j), gt = *(const f32x4*)(mr + goff + lane * 4 + 256 * j);
                f32x4 o4 = (f32x4){bflo(ov[j].x), bfhi(ov[j].x), bflo(ov[j].y), bfhi(ov[j].y)};
                x[j] += gt * (o4 * rs * g4); }
        }
#pragma unroll
        for (int j = 0; j < 4; ++j) *(f32x4*)(X + (size_t)m * DM + lane * 4 + 256 * j) = x[j];
        if (has_next) {
            float ss = 0.f;
#pragma unroll
            for (int j = 0; j < 4; ++j) ss += (x[j][0] * x[j][0] + x[j][1] * x[j][1]) + (x[j][2] * x[j][2] + x[j][3] * x[j][3]);
            const float rs = rsqrtf(wave_sum(ss, lane) * (1.0f / DM) + EPSF);
#pragma unroll
            for (int j = 0; j < 4; ++j) { const f32x4 g4 = *(const f32x4*)(gpre + lane * 4 + 256 * j), sh = *(const f32x4*)(ms + soff + lane * 4 + 256 * j), sc = *(const f32x4*)(ms + soff + 1024 + lane * 4 + 256 * j);
                const f32x4 h4 = (x[j] * rs * g4) * (sc + 1.0f) + sh;
                u32x2 w; w.x = pk2(h4[0], h4[1]); w.y = pk2(h4[2], h4[3]);
                *(u32x2*)(H + (size_t)m * DM + lane * 4 + 256 * j) = w; }
        }
    }
}

using pg8::Unit;
template <int ACT  > struct EpiBf16 {
    bf16* O; int ldc; float* AB;
    __device__ __forceinline__ void operator()(const f32x4 (&acc)[2][2][4][2], const Unit& u, int wr, int wc, int fr, int fq) const {
        const int row0 = u.pm * 256 + wr * 64 + fr, col0 = u.pn * 256 + wc * 32 + 8 * fq;
        if (AB && u.pn * 256 >= ldc) {
            if (wc == 0 && fq < 2) {
#pragma unroll
                for (int ai = 0; ai < 2; ++ai)
#pragma unroll
                    for (int m = 0; m < 4; ++m) { float* p = AB + (size_t)(row0 + ai * 128 + m * 16) * 16 + 8 * fq; *(f32x4*)p = acc[ai][0][m][0]; *(f32x4*)(p + 4) = acc[ai][0][m][1]; }
            }
            return;
        }
#pragma unroll
        for (int ai = 0; ai < 2; ++ai)
#pragma unroll
            for (int m = 0; m < 4; ++m) { bf16* rowp = O + (size_t)(row0 + ai * 128 + m * 16) * ldc + col0;
#pragma unroll
                for (int bj = 0; bj < 2; ++bj) { f32x4 v0 = acc[ai][bj][m][0], v1 = acc[ai][bj][m][1];
                    if (ACT == 1) {
#pragma unroll
                        for (int j = 0; j < 4; ++j) { const float a = fmaxf(v0[j], 0.f), b = fmaxf(v1[j], 0.f); v0[j] = a * a; v1[j] = b * b; } }
                    u32x4 w; w.x = pk2(v0[0], v0[1]); w.y = pk2(v0[2], v0[3]); w.z = pk2(v1[0], v1[1]); w.w = pk2(v1[2], v1[3]);
                    *(u32x4*)(rowp + bj * 128) = w; } }
    }
};
struct EpiGates {
    unsigned* G; const bf16* X; const float* br; const float* bi; const float* lam;
    __device__ __forceinline__ void operator()(const f32x4 (&acc)[2][2][4][2], const Unit& u, int wr, int wc, int fr, int fq) const {
        const int row0 = u.pm * 256 + wr * 64 + fr, ch0 = u.pn * 128 + wc * 32 + 8 * fq;
#pragma unroll
        for (int n = 0; n < 2; ++n) {
            const f32x4 vbr = *(const f32x4*)(br + ch0 + 4 * n), vbi = *(const f32x4*)(bi + ch0 + 4 * n), l4 = *(const f32x4*)(lam + ch0 + 4 * n);
            f32x4 vsp;
#pragma unroll
            for (int e = 0; e < 4; ++e) vsp[e] = -8.0f * softplusf_(-l4[e]);
#pragma unroll
            for (int ai = 0; ai < 2; ++ai)
#pragma unroll
                for (int m = 0; m < 4; ++m) { const size_t row = (size_t)(row0 + ai * 128 + m * 16);
                    const u32x2 xv = *(const u32x2*)(X + row * DM + ch0 + 4 * n);
                    const float xs[4] = {bflo(xv.x), bfhi(xv.x), bflo(xv.y), bfhi(xv.y)};
                    u32x4 w;
#pragma unroll
                    for (int e = 0; e < 4; ++e) { const float r = sigmoidf_(acc[ai][0][m][n][e] + vbr[e]), ig = sigmoidf_(acc[ai][1][m][n][e] + vbi[e]);
                        const float la = r * vsp[e]; const float a_ = __expf(la); const float b = __builtin_amdgcn_sqrtf(fmaxf(1.0f - a_ * a_, 0.f)) * ig * xs[e];
                        w[e] = pk2(la * 1.4426950408889634f, b); }
                    *(u32x4*)(G + row * DM + ch0 + 4 * n) = w; }
        }
    }
};
constexpr int S5_WLDS = 12800, BU_P = 132, HS_P = 136;
struct S5Dir { float ar, ai; bf16x8 Bf[8]; };
__device__ __forceinline__ void s5_dir_setup(const Params& P, int e, int d, int g, int lane, float& ar, float& ai, bf16x8 (&Bf)[8], bool needB) {
    const int quad = lane >> 4, l15 = lane & 15;
    const float dt = __expf(P.in[I_LOGDT][(e * 2 + d) * 32 + g]);
    const float lr = P.in[I_LAMRE][((e * 2 + d) * 32 + g) * 64 + lane], li = P.in[I_LAMIM][((e * 2 + d) * 32 + g) * 64 + lane];
    const float mag = expf(lr * dt); ar = mag * cosf(li * dt); ai = mag * sinf(li * dt);
    const float den = lr * lr + li * li;
    const float fr = ((ar - 1.0f) * lr + ai * li) / den, fi = (ai * lr - (ar - 1.0f) * li) / den;
    if (needB) {
#pragma unroll
        for (int nt = 0; nt < 8; ++nt) { const int col = 16 * nt + l15, p = col & 63;
            const float frp = shfl_i(fr, p), fip = shfl_i(fi, p);
            bf16x8 v = (bf16x8){0, 0, 0, 0, 0, 0, 0, 0};
            if (quad < 2) { const float* bre = P.in[I_BRE] + ((size_t)(e * 32 + g) * 64 + p) * 16 + quad * 8; const float* bim = P.in[I_BIM] + ((size_t)(e * 32 + g) * 64 + p) * 16 + quad * 8;
#pragma unroll
                for (int j = 0; j < 8; ++j) { const float br = bre[j], bi = bim[j]; const float val = (nt < 4) ? (frp * br - fip * bi) : (frp * bi + fip * br); v[j] = (short)f2bf(val); } }
            Bf[nt] = v; }
    }
}
__device__ __forceinline__ void s5_c_setup(const Params& P, int e, int g, int lane, bf16x8 (&Cf)[4]) {
    const int quad = lane >> 4, l15 = lane & 15;
#pragma unroll
    for (int ks = 0; ks < 4; ++ks) { const int col0 = 32 * ks + quad * 8; const bool im = col0 >= 64;
        const float* src = (im ? P.in[I_CIM] : P.in[I_CRE]) + ((size_t)(e * 32 + g) * 16 + l15) * 64 + (col0 & 63);
        bf16x8 v;
#pragma unroll
        for (int j = 0; j < 8; ++j) v[j] = (short)f2bf(im ? -src[j] : src[j]);
        Cf[ks] = v; }
}
__device__ __forceinline__ void s5_scan_seg(const Params& P, LAS unsigned char* wl, int lane, int d, int g, int m0, float ar, float ai, const bf16x8 (&Bf)[8], const bf16x8 (&Cf)[4],
                                            float& hr, float& hi, int mode, int ymode, const bf16* proj, float* ybuf, bf16* mixout, float dsk) {
    const int quad = lane >> 4, l15 = lane & 15;
    LAS float* BU = (LAS float*)wl; LAS bf16* HS = (LAS bf16*)(wl + 8448);
    for (int bi_ = 0; bi_ < 16; ++bi_) {
        const int blk = d ? 15 - bi_ : bi_;
        const int mb = m0 + 16 * blk;
        if (mode == 0) {
            bf16x8 a = (bf16x8){0, 0, 0, 0, 0, 0, 0, 0};
            if (quad < 2) { const int tt = d ? 15 - l15 : l15; a = *(const bf16x8*)(proj + (size_t)(mb + tt) * NPROJ_E + g * 16 + quad * 8); }
#pragma unroll
            for (int nt = 0; nt < 8; ++nt) { f32x4 acc = mfma16(a, Bf[nt], (f32x4){0.f, 0.f, 0.f, 0.f});
#pragma unroll
                for (int jj = 0; jj < 4; ++jj) BU[(quad * 4 + jj) * BU_P + 16 * nt + l15] = acc[jj]; }
            WAVE_SYNC();
        }
#pragma unroll
        for (int r = 0; r < 16; ++r) {
            float br = 0.f, bim = 0.f;
            if (mode == 0) { br = BU[r * BU_P + lane]; bim = BU[r * BU_P + 64 + lane]; }
            const float nr = ar * hr - ai * hi + br, ni = ar * hi + ai * hr + bim; hr = nr; hi = ni;
            HS[r * HS_P + lane] = (bf16)f2bf(hr); HS[r * HS_P + 64 + lane] = (bf16)f2bf(hi);
        }
        WAVE_SYNC();
        f32x4 y = (f32x4){0.f, 0.f, 0.f, 0.f};
#pragma unroll
        for (int ks = 0; ks < 4; ++ks) { const bf16x8 a = *(const LAS bf16x8*)(HS + l15 * HS_P + 32 * ks + quad * 8); y = mfma16(a, Cf[ks], y); }
        const int ch = g * 16 + l15;
#pragma unroll
        for (int jj = 0; jj < 4; ++jj) { const int row = quad * 4 + jj; const int tt = d ? 15 - row : row; const size_t m = (size_t)(mb + tt);
            float v = y[jj];
            if (ymode == 0) { v += dsk * bf2f(proj[m * NPROJ_E + ch]); ybuf[m * 512 + ch] = v; }
            else { v += ybuf[m * 512 + ch];
                if (ymode == 1) ybuf[m * 512 + ch] = v;
                else { const float z = bf2f(proj[m * NPROJ_E + 512 + ch]); mixout[m * DM + ch] = (bf16)f2bf(geluf_(v) * sigmoidf_(z)); } }
        }
        WAVE_SYNC();
    }
}
__device__ __forceinline__ void s5_task_main(const Params& P, LAS unsigned char* wl, int lane, int e, int sub, int g) {
    const bf16* proj = (const bf16*)(P.ws + WS_BIG); float* ybuf = (float*)(P.ws + WS_YBUF); bf16* mixout = (bf16*)(P.ws + WS_MIX);
    const bool lat = sub >= 32; const int q = sub - 32, b = lat ? (q >> 3) : sub, seg = lat ? (q & 7) : 0;
    const int m0 = lat ? MCTX + b * LLAT + seg * 256 : sub * 256;
    bf16x8 Cf[4]; s5_c_setup(P, e, g, lane, Cf);
    const float dsk = P.in[I_S5D][e * 512 + g * 16 + (lane & 15)];
#pragma unroll 1
    for (int d = 0; d < 2; ++d) {
        float ar, ai; bf16x8 Bf[8]; s5_dir_setup(P, e, d, g, lane, ar, ai, Bf, true);
        float hr = 0.f, hi = 0.f;
        if (lat && ((d == 0 && seg == 0) || (d == 1 && seg == 7))) { const size_t si = ((((size_t)b * 2 + e) * 2 + d) * 32 + g) * 64 + lane; hr = P.in[I_S5RE][si]; hi = P.in[I_S5IM][si]; }
        const int ymode = d == 0 ? 0 : (lat ? 1 : 2);
        s5_scan_seg(P, wl, lane, d, g, m0, ar, ai, Bf, Cf, hr, hi, 0, ymode, proj, ybuf, mixout, dsk);
        if (!lat) { const size_t si = ((((size_t)b * 2 + e) * 2 + d) * 32 + g) * 64 + lane; P.out[OUT_S5RE + si] = hr; P.out[OUT_S5IM + si] = hi; }
        else { float* F = (float*)(P.ws + WS_S5F) + ((((size_t)d * 64 + q) * 32 + g) * 64 + lane) * 2; F[0] = hr; F[1] = hi; }
    }
}
__device__ __forceinline__ void s5_task_corr(const Params& P, LAS unsigned char* wl, int lane, int e, int q, int g) {
    const bf16* proj = (const bf16*)(P.ws + WS_BIG); float* ybuf = (float*)(P.ws + WS_YBUF); bf16* mixout = (bf16*)(P.ws + WS_MIX);
    const int b = q >> 3, seg = q & 7, m0 = MCTX + b * LLAT + seg * 256;
    bf16x8 Cf[4]; s5_c_setup(P, e, g, lane, Cf);
    bf16x8 Bf[8];
#pragma unroll
    for (int i = 0; i < 8; ++i) Bf[i] = (bf16x8){0, 0, 0, 0, 0, 0, 0, 0};
    const float* Fb = (const float*)(P.ws + WS_S5F);
#pragma unroll 1
    for (int d = 0; d < 2; ++d) {
        float ar, ai; s5_dir_setup(P, e, d, g, lane, ar, ai, Bf, false);
        float pr = ar, pi = ai;
#pragma unroll
        for (int i = 0; i < 8; ++i) { const float nr = pr * pr - pi * pi, ni = 2.0f * pr * pi; pr = nr; pi = ni; }
        float hr = 0.f, hi = 0.f;
        const int cnt = d == 0 ? seg : 7 - seg;
        for (int i = 0; i < cnt; ++i) { const int sj = d == 0 ? i : 7 - i; const float* F = Fb + ((((size_t)d * 64 + b * 8 + sj) * 32 + g) * 64 + lane) * 2;
            const float nr = pr * hr - pi * hi + F[0], ni = pr * hi + pi * hr + F[1]; hr = nr; hi = ni; }
        if (cnt > 0) s5_scan_seg(P, wl, lane, d, g, m0, ar, ai, Bf, Cf, hr, hi, 1, 1, proj, ybuf, mixout, 0.f);
    }
    __builtin_amdgcn_wave_barrier();
    for (int i = lane; i < 256 * 16; i += 64) { const size_t m = (size_t)(m0 + (i >> 4)); const int ch = g * 16 + (i & 15);
        const float v = ybuf[m * 512 + ch]; const float z = bf2f(proj[m * NPROJ_E + 512 + ch]);
        mixout[m * DM + ch] = (bf16)f2bf(geluf_(v) * sigmoidf_(z)); }
}

#ifndef REP_A
#define REP_A 1
#endif
#ifndef REP_B
#define REP_B 1
#endif
#ifndef REP_C
#define REP_C 1
#endif
#define LDS_BARRIER() do { asm volatile("s_waitcnt lgkmcnt(0)" ::: "memory"); __builtin_amdgcn_s_barrier(); asm volatile("" ::: "memory"); } while (0)
constexpr int G_Q = 0, G_K = 17408, G_V = 34816, G_KT = 52224, G_LM = 70656, G_QK = 89088, G_ST = 98304, G_SM = 133120;
constexpr int P128 = 136, P64 = 72, LMP = 68;
__device__ __forceinline__ bf16x8 ld_split8(const LAS bf16* p) {
    const u32x2 a = *(const LAS u32x2*)p, b = *(const LAS u32x2*)(p + 16);
    return __builtin_bit_cast(bf16x8, (u32x4){a.x, a.y, b.x, b.y});
}
__device__ __forceinline__ bf16x8 pack_acc2(const f32x4& a, const f32x4& b) { return __builtin_bit_cast(bf16x8, (u32x4){pk2(a[0], a[1]), pk2(a[2], a[3]), pk2(b[0], b[1]), pk2(b[2], b[3])}); }
__device__ __forceinline__ void gdn_chain(int wid0, const Params& P, LAS unsigned char* lds, int e, int s, int hd, int dir) {
    const int tid = tid_fresh(wid0), lane = tid & 63, w = __builtin_amdgcn_readfirstlane(tid >> 6), quad = lane >> 4, l15 = lane & 15;
    const bool lat = s >= 32; const int b = lat ? s - 32 : s; const int L = lat ? LLAT : LCTX; const int m0 = lat ? MCTX + b * LLAT : s * LCTX;
    const bf16* proj = (const bf16*)(P.ws + WS_BIG); const float* AB = (const float*)(P.ws + WS_AB);
    bf16* Odir = (bf16*)(P.ws + WS_H) + (size_t)dir * MT * 512;
    int zv; asm volatile("v_mov_b32 %0, 0" : "=v"(zv));
    lds += zv;
    LAS bf16* Qs = (LAS bf16*)(lds + G_Q); LAS bf16* Ks = (LAS bf16*)(lds + G_K); LAS bf16* Vs = (LAS bf16*)(lds + G_V); LAS bf16* KT = (LAS bf16*)(lds + G_KT);
    LAS float* Lm = (LAS float*)(lds + G_LM); LAS bf16* VNT = (LAS bf16*)(lds + G_LM); LAS bf16* QKs = (LAS bf16*)(lds + G_QK); LAS bf16* ST = (LAS bf16*)(lds + G_ST);
    LAS bf16* TM = (LAS bf16*)(lds + G_ST); LAS bf16* TT = TM + 64 * P64; LAS bf16* LR = TT + 64 * P64;
    LAS float* rq = (LAS float*)(lds + G_SM); LAS float* rk = rq + 64; LAS float* gcs = rq + 128; LAS float* betas = rq + 192; LAS float* egs = rq + 256; LAS float* kes = rq + 320;
    f32x4 Sacc[8];
    const size_t sbase = ((((size_t)b * 2 + e) * 2 + dir) * 4 + hd) * 16384;
#pragma unroll
    for (int mt = 0; mt < 8; ++mt) Sacc[mt] = (f32x4){0.f, 0.f, 0.f, 0.f};
    if (lat) { const float* sp = P.in[I_SDELTA] + sbase + (size_t)(quad * 4) * 128 + 16 * w + l15;
#pragma unroll
        for (int mt = 0; mt < 8; ++mt)
#pragma unroll
            for (int jj = 0; jj < 4; ++jj) Sacc[mt][jj] = sp[(16 * mt + jj) * 128]; }
    for (int i = tid; i < 2 * 64 * P64 / 2; i += NTHR) ((LAS unsigned*)TM)[i] = 0u;
    const float alog_e = __expf(P.in[I_GALOG][(e * 2 + dir) * 4 + hd]), dtb = P.in[I_GDTB][(e * 2 + dir) * 4 + hd];
    const int nchunk = L / 64;
    unsigned xqk[19]; bf16 xv[19]; float ab_a = 0.f, ab_b = 0.f;
#define GDN_LOAD(ci_) do { const int tid_ = tid_fresh(wid0); const int dd_ = tid_ & 127, tq_ = __builtin_amdgcn_readfirstlane(tid_ >> 7); \
        const int c0_ = dir ? L - 64 * ((ci_) + 1) : 64 * (ci_); const int tb_ = c0_ + tq_ * 16; \
        _Pragma("unroll") for (int k = 0; k < 19; ++k) { const int t = tb_ - 1 + k; const bool ok = (t >= 0) && (t < L); const bf16* rowp = proj + (size_t)(m0 + (ok ? t : tb_)) * NPROJ_E + 1024 + hd * 128 + dd_; \
            const unsigned a = rowp[0], bq = rowp[512]; const bf16 c = rowp[1024]; xqk[k] = ok ? (a | (bq << 16)) : 0u; xv[k] = ok ? c : (bf16)0; } \
        if (w == 0) { const int ln_ = tid_ & 63; const size_t m_ = (size_t)(m0 + c0_ + (dir ? 63 - ln_ : ln_)); ab_a = AB[m_ * 16 + dir * 4 + hd]; ab_b = AB[m_ * 16 + 8 + dir * 4 + hd]; } } while (0)
    GDN_LOAD(0);
#pragma unroll 1
    for (int ci = 0; ci < nchunk; ++ci) {
        const int tid = tid_fresh(wid0), lane = tid & 63, quad = lane >> 4, l15 = lane & 15;
        const int c0 = dir ? L - 64 * (ci + 1) : 64 * ci;
        LDS_BARRIER();
#ifndef NO_A
        const float cur_a = ab_a, cur_b = ab_b;
        { const int dd = tid & 127, tq = __builtin_amdgcn_readfirstlane(tid >> 7);
#pragma unroll
          for (int part = 0; part < 3; ++part) { const int ccol = part * 512 + hd * 128 + dd;
              const float* cw = P.in[I_GCONVW] + (size_t)e * 4 * 1536 + ccol; const float w0 = cw[0], w1 = cw[1536], w2 = cw[3072], w3 = cw[4608], cb = P.in[I_GCONVB][e * 1536 + ccol];
              LAS bf16* dst = part == 0 ? Qs : (part == 1 ? Ks : Vs);
#pragma unroll
              for (int n = 0; n < 16; ++n) {
                  float x0, x1, x2, x3;
                  if (part == 0) { x0 = bflo(xqk[n]); x1 = bflo(xqk[n + 1]); x2 = bflo(xqk[n + 2]); x3 = bflo(xqk[n + 3]); }
                  else if (part == 1) { x0 = bfhi(xqk[n]); x1 = bfhi(xqk[n + 1]); x2 = bfhi(xqk[n + 2]); x3 = bfhi(xqk[n + 3]); }
                  else { x0 = bf2f(xv[n]); x1 = bf2f(xv[n + 1]); x2 = bf2f(xv[n + 2]); x3 = bf2f(xv[n + 3]); }
                  const float v = cb + w0 * x0 + w1 * x1 + w2 * x2 + w3 * x3;
                  const int nn = tq * 16 + n; const int r = dir ? 63 - nn : nn;
                  dst[r * P128 + dd] = (bf16)f2bf(siluf_(v)); } } }
        if (ci + 1 < nchunk) GDN_LOAD(ci + 1);
#endif
        LDS_BARRIER();
#pragma unroll 1
        for (int repB = 0; repB < REP_B; ++repB)
        { const int rowid = tid >> 2, part = tid & 3; LAS bf16* src = (rowid < 64 ? Qs : Ks) + (rowid & 63) * P128 + part * 32;
          float ss = 0.f;
#pragma unroll
          for (int i = 0; i < 4; ++i) { const u32x4 v = *(const LAS u32x4*)(src + 8 * i);
#pragma unroll
              for (int j = 0; j < 4; ++j) { const float a = bflo(v[j]), c = bfhi(v[j]); ss += a * a + c * c; } }
          ss += shfl_i(ss, lane ^ 1); ss += shfl_i(ss, lane ^ 2);
          if (part == 0) { if (rowid < 64) rq[rowid] = rsqrtf(ss + EPSF) * 0.08838834764831845f; else rk[rowid - 64] = rsqrtf(ss + EPSF); }
          if (w == 0) { const int t = c0 + (dir ? 63 - lane : lane); const size_t m = (size_t)(m0 + t);
              const float araw = cur_a, braw = cur_b;
              const float gg = -alog_e * softplusf_(araw + dtb);
              float gc = gg;
#pragma unroll
              for (int o = 1; o < 64; o <<= 1) { const float t2 = shfl_i(gc, (lane - o) & 63); if (lane >= o) gc += t2; }
              const float glast = shfl_i(gc, 63);
              gcs[lane] = gc; betas[lane] = sigmoidf_(braw); egs[lane] = __expf(gc); kes[lane] = __expf(glast - gc);
              if (lane == 0) rq[384] = __expf(glast); } }
        LDS_BARRIER();
#ifndef NO_C
#pragma unroll 1
        for (int repC = 0; repC < REP_C; ++repC)
        { const int mt = w & 3; const bool isq = w >= 4; LAS bf16* src = isq ? Qs : Ks;
          bf16x8 a[4];
#pragma unroll
          for (int ks = 0; ks < 4; ++ks) a[ks] = *(const LAS bf16x8*)(src + (16 * mt + l15) * P128 + 32 * ks + quad * 8);
#pragma unroll 1
          for (int nt = 0; nt < 4; ++nt) { f32x4 acc = (f32x4){0.f, 0.f, 0.f, 0.f};
#pragma unroll
              for (int ks = 0; ks < 4; ++ks) { const bf16x8 bb = *(const LAS bf16x8*)(Ks + (16 * nt + l15) * P128 + 32 * ks + quad * 8); acc = mfma16(a[ks], bb, acc); }
              const int j = 16 * nt + l15; const float rkj = rk[j], gcj = gcs[j];
              f32x4 lv;
#pragma unroll
              for (int jj = 0; jj < 4; ++jj) { const int i = 16 * mt + quad * 4 + jj; const float dec = __expf(fminf(gcs[i] - gcj, 0.f));
                  lv[jj] = (i > j) ? acc[jj] * rk[i] * rkj * betas[i] * dec : 0.f;
                  if (isq) QKs[i * P64 + j] = (bf16)f2bf((i >= j) ? acc[jj] * rq[i] * rkj * dec : 0.f); }
              if (!isq) { *(LAS f32x4*)(Lm + j * LMP + 16 * mt + quad * 4) = lv;
#pragma unroll
                  for (int jj = 0; jj < 4; ++jj) LR[(16 * mt + quad * 4 + jj) * P64 + j] = (bf16)f2bf(nt < mt ? lv[jj] : 0.f); } }
          const int dd = tid & 127, tq = tid >> 7;
          unsigned pw[8];
#pragma unroll
          for (int n = 0; n < 16; n += 2) { const int i0 = tq * 16 + n; const float v0 = bf2f(Ks[i0 * P128 + dd]) * rk[i0] * kes[i0], v1 = bf2f(Ks[(i0 + 1) * P128 + dd]) * rk[i0 + 1] * kes[i0 + 1]; pw[n >> 1] = pk2(v0, v1); }
          *(LAS u32x4*)(KT + dd * P64 + tq * 16) = (u32x4){pw[0], pw[1], pw[2], pw[3]};
          *(LAS u32x4*)(KT + dd * P64 + tq * 16 + 8) = (u32x4){pw[4], pw[5], pw[6], pw[7]}; }
#endif
        LDS_BARRIER();
        { const int i = tid >> 3, c0k = (tid & 7) * 16; const float sc = rk[i] * betas[i] * egs[i];
#pragma unroll
          for (int h2 = 0; h2 < 2; ++h2) { u32x4 v = *(LAS u32x4*)(Ks + i * P128 + c0k + 8 * h2);
#pragma unroll
              for (int q = 0; q < 4; ++q) v[q] = pk2(bflo(v[q]) * sc, bfhi(v[q]) * sc);
              *(LAS u32x4*)(Ks + i * P128 + c0k + 8 * h2) = v; } }
        if (w == 0) { const int bb = lane >> 4, c = lane & 15;
            float x[16];
#pragma unroll
            for (int r = 0; r < 16; ++r) x[r] = (r == c) ? 1.f : 0.f;
#pragma unroll
            for (int j = 0; j < 15; ++j) {
#pragma unroll
                for (int q4 = j / 4; q4 < 4; ++q4) { const f32x4 l4 = *(const LAS f32x4*)(Lm + (16 * bb + j) * LMP + 16 * bb + 4 * q4);
#pragma unroll
                    for (int jx = 0; jx < 4; ++jx) if (4 * q4 + jx > j) x[4 * q4 + jx] -= l4[jx] * x[j]; } }
            unsigned pw[8];
#pragma unroll
            for (int r = 0; r < 16; r += 2) { pw[r >> 1] = pk2(x[r], x[r + 1]); TM[(16 * bb + r) * P64 + 16 * bb + c] = (bf16)(pw[r >> 1] & 0xffffu); TM[(16 * bb + r + 1) * P64 + 16 * bb + c] = (bf16)(pw[r >> 1] >> 16); }
            *(LAS u32x4*)(TT + (16 * bb + c) * P64 + 16 * bb) = (u32x4){pw[0], pw[1], pw[2], pw[3]};
            *(LAS u32x4*)(TT + (16 * bb + c) * P64 + 16 * bb + 8) = (u32x4){pw[4], pw[5], pw[6], pw[7]}; }
        LDS_BARRIER();
#pragma unroll 1
        for (int lev = 1; lev < 4; ++lev) {
            if (w < 4 - lev) { const int bj = w, bi = w + lev;
                f32x4 m = (f32x4){0.f, 0.f, 0.f, 0.f};
#pragma unroll
                for (int ks = 0; ks < 2; ++ks) { const bf16x8 a = *(const LAS bf16x8*)(LR + (16 * bi + l15) * P64 + 32 * ks + quad * 8), bq = *(const LAS bf16x8*)(TT + (16 * bj + l15) * P64 + 32 * ks + quad * 8); m = mfma16(a, bq, m); }
                const u32x2 tl = *(const LAS u32x2*)(TM + (16 * bi + l15) * P64 + 16 * bi + quad * 4);
                const bf16x8 a2 = __builtin_bit_cast(bf16x8, (u32x4){tl.x, tl.y, 0u, 0u}), b2 = __builtin_bit_cast(bf16x8, (u32x4){pk2(m[0], m[1]), pk2(m[2], m[3]), 0u, 0u});
                const f32x4 t = mfma16(a2, b2, (f32x4){0.f, 0.f, 0.f, 0.f});
                const unsigned p0 = pk2(-t[0], -t[1]), p1 = pk2(-t[2], -t[3]);
                TM[(16 * bi + quad * 4 + 0) * P64 + 16 * bj + l15] = (bf16)(p0 & 0xffffu); TM[(16 * bi + quad * 4 + 1) * P64 + 16 * bj + l15] = (bf16)(p0 >> 16);
                TM[(16 * bi + quad * 4 + 2) * P64 + 16 * bj + l15] = (bf16)(p1 & 0xffffu); TM[(16 * bi + quad * 4 + 3) * P64 + 16 * bj + l15] = (bf16)(p1 >> 16);
                *(LAS u32x2*)(TT + (16 * bj + l15) * P64 + 16 * bi + quad * 4) = (u32x2){p0, p1}; }
            LDS_BARRIER();
        }
#ifndef NO_EFG
        bf16x8 Bst[4];
#pragma unroll
        for (int ks = 0; ks < 4; ++ks) Bst[ks] = pack_acc2(Sacc[2 * ks], Sacc[2 * ks + 1]);
        f32x4 vn[4];
#pragma unroll
        for (int mt = 0; mt < 4; ++mt) { f32x4 acc = (f32x4){0.f, 0.f, 0.f, 0.f};
#pragma unroll
            for (int ks = 0; ks < 4; ++ks) { const bf16x8 a = ld_split8(Ks + (16 * mt + l15) * P128 + 32 * ks + quad * 4); acc = mfma16(a, Bst[ks], acc); }
#pragma unroll
            for (int jj = 0; jj < 4; ++jj) { const int i = 16 * mt + quad * 4 + jj; vn[mt][jj] = bf2f(Vs[i * P128 + 16 * w + l15]) * betas[i] - acc[jj]; } }
        bf16x8 Bvn[2];
#pragma unroll
        for (int k2 = 0; k2 < 2; ++k2) Bvn[k2] = pack_acc2(vn[2 * k2], vn[2 * k2 + 1]);
#pragma unroll
        for (int mt = 0; mt < 4; ++mt) { f32x4 acc = (f32x4){0.f, 0.f, 0.f, 0.f};
#pragma unroll
            for (int k2 = 0; k2 < 2; ++k2) { const bf16x8 a = ld_split8(TM + (16 * mt + l15) * P64 + 32 * k2 + quad * 4); acc = mfma16(a, Bvn[k2], acc); }
            vn[mt] = acc; }
#pragma unroll
        for (int k2 = 0; k2 < 2; ++k2) Bvn[k2] = pack_acc2(vn[2 * k2], vn[2 * k2 + 1]);
#pragma unroll 1
        for (int mt = 0; mt < 4; ++mt) { f32x4 acc = (f32x4){0.f, 0.f, 0.f, 0.f};
#pragma unroll
            for (int ks = 0; ks < 4; ++ks) { const bf16x8 a = ld_split8(Qs + (16 * mt + l15) * P128 + 32 * ks + quad * 4); acc = mfma16(a, Bst[ks], acc); }
#pragma unroll
            for (int jj = 0; jj < 4; ++jj) { const int i = 16 * mt + quad * 4 + jj; acc[jj] *= rq[i] * egs[i]; }
#pragma unroll
            for (int k2 = 0; k2 < 2; ++k2) { const bf16x8 a = ld_split8(QKs + (16 * mt + l15) * P64 + 32 * k2 + quad * 4); acc = mfma16(a, Bvn[k2], acc); }
#pragma unroll
            for (int jj = 0; jj < 4; ++jj) { const int i = 16 * mt + quad * 4 + jj; const int t = c0 + (dir ? 63 - i : i);
                Odir[(size_t)(m0 + t) * 512 + hd * 128 + 16 * w + l15] = (bf16)f2bf(acc[jj]); } }
        const float egl = rq[384];
#pragma unroll
        for (int mt = 0; mt < 8; ++mt) { f32x4 acc = Sacc[mt] * egl;
#pragma unroll
            for (int k2 = 0; k2 < 2; ++k2) { const bf16x8 a = ld_split8(KT + (16 * mt + l15) * P64 + 32 * k2 + quad * 4); acc = mfma16(a, Bvn[k2], acc); }
            Sacc[mt] = acc; }
#endif
        WAVE_SYNC();
    }
    if (!lat) { const int tid2 = tid_fresh(wid0), lane2 = tid2 & 63; float* dp = P.out + OUT_DELTA + sbase + (size_t)((lane2 >> 4) * 4) * 128 + 16 * w + (lane2 & 15);
#pragma unroll
        for (int mt = 0; mt < 8; ++mt)
#pragma unroll
            for (int jj = 0; jj < 4; ++jj) dp[(16 * mt + jj) * 128] = Sacc[mt][jj];
    }
    __syncthreads();
}

__device__ __forceinline__ void phase_mix_even(int wid0, const Params& P, LAS unsigned char* lds, int e, int mode = 3) {
    const int bid = bid_fresh(), G = grid_fresh();
    if (G == 256) {
        if (bid < 64) { const int s = 32 + (bid >> 3), hd = (bid >> 1) & 3, dir = bid & 1; if (mode & 1) gdn_chain(wid0, P, lds, e, s, hd, dir); }
        else { const int bb = bid - 64;
            if (mode & 1) for (int c = bb; c < 256; c += 192) { const int s = c >> 3, hd = (c >> 1) & 3, dir = c & 1; gdn_chain(wid0, P, lds, e, s, hd, dir); }
            if (mode & 2) { const int tid = tid_fresh(wid0), lane = tid & 63, wave = tid >> 6;
                for (int t = bb; t < 384; t += 192) { const int wt = t * 8 + wave; s5_task_main(P, lds + wave * S5_WLDS, lane, e, wt >> 5, wt & 31); } } }
    } else {
        for (int c = bid; c < 320; c += G) { const int s = c < 64 ? 32 + (c >> 3) : ((c - 64) >> 3), hd = (c >> 1) & 3, dir = c & 1; gdn_chain(wid0, P, lds, e, s, hd, dir); }
        const int tid = tid_fresh(wid0), lane = tid & 63, wave = tid >> 6;
        for (int t = bid; t < 384; t += G) { const int wt = t * 8 + wave; s5_task_main(P, lds + wave * S5_WLDS, lane, e, wt >> 5, wt & 31); }
    }
}
__device__ __forceinline__ void phase_fin_even(int wid0, const Params& P, LAS unsigned char* lds, int e) {
    const int tid = tid_fresh(wid0), lane = tid & 63, wave = tid >> 6;
    const int gw = bid_fresh() * NWAVES + wave, NGW = grid_fresh() * NWAVES;
    for (int wt = gw; wt < 2048; wt += NGW) s5_task_corr(P, lds + wave * S5_WLDS, lane, e, wt >> 5, wt & 31);
    const bf16* proj = (const bf16*)(P.ws + WS_BIG); const bf16* Of = (const bf16*)(P.ws + WS_H); const bf16* Ob = Of + (size_t)MT * 512; bf16* mixout = (bf16*)(P.ws + WS_MIX);
    for (int m = gw; m < MT; m += NGW) {
        const u32x4 a = *(const u32x4*)(Of + (size_t)m * 512 + lane * 8), bq = *(const u32x4*)(Ob + (size_t)m * 512 + lane * 8), z = *(const u32x4*)(proj + (size_t)m * NPROJ_E + 2560 + lane * 8);
        float o[8]; float ss = 0.f;
#pragma unroll
        for (int j = 0; j < 4; ++j) { o[2 * j] = bflo(a[j]) + bflo(bq[j]); o[2 * j + 1] = bfhi(a[j]) + bfhi(bq[j]); ss += o[2 * j] * o[2 * j] + o[2 * j + 1] * o[2 * j + 1]; }
        ss += shfl_i(ss, lane ^ 1); ss += shfl_i(ss, lane ^ 2); ss += shfl_i(ss, lane ^ 4); ss += shfl_i(ss, lane ^ 8);
        const float rs = rsqrtf(ss * (1.0f / 128.0f) + EPSF);
        const float* gn = P.in[I_GONORM] + e * 128 + (lane & 15) * 8;
        unsigned pw[4];
#pragma unroll
        for (int j = 0; j < 4; ++j) { const float z0 = bflo(z[j]), z1 = bfhi(z[j]); pw[j] = pk2(o[2 * j] * rs * gn[2 * j] * siluf_(z0), o[2 * j + 1] * rs * gn[2 * j + 1] * siluf_(z1)); }
        *(u32x4*)(mixout + (size_t)m * DM + 512 + lane * 8) = (u32x4){pw[0], pw[1], pw[2], pw[3]};
    }
}

__device__ __forceinline__ void phase_conv_odd(int wid0, const Params& P, int o) {
    const int tid = tid_fresh(wid0), lane = tid & 63, wave = tid >> 6;
    const int gw = bid_fresh() * NWAVES + wave, NGW = grid_fresh() * NWAVES;
    const bf16* proj = (const bf16*)(P.ws + WS_BIG); bf16* cx = (bf16*)(P.ws + WS_H);
    const float* cw = P.in[I_LCONVW] + (size_t)o * 4 * 1024; const float* cb = P.in[I_LCONVB] + o * 1024;
    for (int m = gw; m < MT; m += NGW) {
        const int t = m < MCTX ? (m & 255) : ((m - MCTX) & 2047); const int L = m < MCTX ? LCTX : LLAT;
#pragma unroll
        for (int h2 = 0; h2 < 2; ++h2) { const int ch = lane * 8 + 512 * h2;
            float acc[8];
#pragma unroll
            for (int j = 0; j < 8; ++j) acc[j] = cb[ch + j];
#pragma unroll
            for (int k = 0; k < 4; ++k) { const int tt = t - 1 + k; if (tt >= 0 && tt < L) { const u32x4 v = *(const u32x4*)(proj + (size_t)(m - 1 + k) * 2048 + ch);
#pragma unroll
                    for (int j = 0; j < 4; ++j) { acc[2 * j] += cw[k * 1024 + ch + 2 * j] * bflo(v[j]); acc[2 * j + 1] += cw[k * 1024 + ch + 2 * j + 1] * bfhi(v[j]); } } }
            *(u32x4*)(cx + (size_t)m * DM + ch) = (u32x4){pk2(acc[0], acc[1]), pk2(acc[2], acc[3]), pk2(acc[4], acc[5]), pk2(acc[6], acc[7])}; }
    }
}
__device__ __forceinline__ void phase_lru_scan(int wid0, const Params& P, int o, int d) {
    const int tid = tid_fresh(wid0), lane = tid & 63, wave = tid >> 6;
    const int gw = bid_fresh() * NWAVES + wave, NGW = grid_fresh() * NWAVES;
    const unsigned* G = (const unsigned*)(P.ws + WS_GATES); const bf16* proj = (const bf16*)(P.ws + WS_BIG); bf16* mixout = (bf16*)(P.ws + WS_MIX);
    for (int task = gw; task < 640; task += NGW) {
        int s, cg_;
        if (task < 128) { s = 32 + (task >> 4); cg_ = task & 15; } else { s = (task - 128) >> 4; cg_ = (task - 128) & 15; }
        const bool lat = s >= 32; const int b = lat ? s - 32 : s; const int L = lat ? LLAT : LCTX; const int m0 = lat ? MCTX + b * LLAT : s * LCTX;
        const int ch = cg_ * 64 + lane;
        float h = lat ? P.in[I_SLRU][(((size_t)b * 2 + o) * 2 + d) * 1024 + ch] : 0.f;
        if (d == 0) {
            for (int t0 = 0; t0 < L; t0 += 32) {
                unsigned gv[32];
#pragma unroll
                for (int i = 0; i < 32; ++i) gv[i] = G[(size_t)(m0 + t0 + i) * DM + ch];
#pragma unroll
                for (int i = 0; i < 32; ++i) { h = __builtin_amdgcn_exp2f(bflo(gv[i])) * h + bfhi(gv[i]); mixout[(size_t)(m0 + t0 + i) * DM + ch] = (bf16)f2bf(h); }
            }
        } else {
            for (int t0 = 0; t0 < L; t0 += 16) {
                unsigned gv[16]; bf16 pv[16], yv[16];
#pragma unroll
                for (int i = 0; i < 16; ++i) { const size_t m = (size_t)(m0 + L - 1 - (t0 + i)); gv[i] = G[m * DM + ch]; pv[i] = mixout[m * DM + ch]; yv[i] = proj[m * 2048 + 1024 + ch]; }
#pragma unroll
                for (int i = 0; i < 16; ++i) { const size_t m = (size_t)(m0 + L - 1 - (t0 + i));
                    h = __builtin_amdgcn_exp2f(bflo(gv[i])) * h + bfhi(gv[i]);
                    mixout[m * DM + ch] = (bf16)f2bf((bf2f(pv[i]) + h) * geluf_(bf2f(yv[i]))); }
            }
        }
        if (!lat) P.out[OUT_LRU + (((size_t)b * 2 + o) * 2 + d) * 1024 + ch] = h;
    }
}
#ifdef PROBE_DUP_GEMM
#define DUPG(x) GSYNC(); x
#else
#define DUPG(x)
#endif
typedef const __attribute__((address_space(4))) Params* KParams;
__device__ __forceinline__ Params load_params(KParams q) { Params r;
#pragma unroll
    for (int i = 0; i < 40; ++i) r.in[i] = q->in[i];
    r.out = q->out; r.ws = q->ws; return r; }
#define FRESH() const int G = grid_fresh(), bid = bid_fresh(); (void)G; (void)bid; KParams pk_ = (KParams)__builtin_amdgcn_kernarg_segment_ptr(); asm volatile("" : "+s"(pk_)); const Params P = load_params(pk_); unsigned char* ws = P.ws; \
    const float* mod = (const float*)(ws + WS_MOD); bf16* H = (bf16*)(ws + WS_H); bf16* BIG = (bf16*)(ws + WS_BIG); bf16* MIX = (bf16*)(ws + WS_MIX); (void)mod; (void)H; (void)BIG; (void)MIX;
#define GSYNC() do { KParams pb_ = (KParams)__builtin_amdgcn_kernarg_segment_ptr(); asm volatile("" : "+s"(pb_)); xcd_barrier(wid0, (unsigned*)(pb_->ws + WS_BAR), lds); } while (0)
__global__ void __launch_bounds__(NTHR, 2) fwd_kernel(Params Parg) {
    extern __shared__ __attribute__((aligned(16))) unsigned char lds_raw[];
    LAS unsigned char* lds = (LAS unsigned char*)lds_raw;
    cg::grid_group grid = cg::this_grid();
    const int wid0 = __builtin_amdgcn_readfirstlane(threadIdx.x >> 6);
    if (threadIdx.x < 4) ((LAS unsigned*)(lds + LDS_BARST))[threadIdx.x] = 0u;
    __syncthreads();
    if (threadIdx.x == 0) (void)xb_add((unsigned*)(Parg.ws + WS_BAR) + XB_XCNT(xb_xcc_id()), 1u);

    { FRESH(); phase_prologue(wid0, P, lds); }
    grid.sync();
#ifdef PROBE_DUP_PRO
    { FRESH(); phase_prologue(wid0, P, lds); }
    GSYNC();
#endif
    { FRESH(); phase_modreduce(wid0, P); }
    GSYNC();
#ifdef PROBE_SYNC
#pragma unroll 1
    for (int i = 0; i < 40; ++i) GSYNC();
#endif
#pragma unroll 1
    for (int l = 0; l < 4; ++l) {
        { FRESH(); const float* modl = mod + (size_t)l * 9 * 6144;
        phase_rownorm(wid0, P, l == 0, MIX, modl - 9 * 6144, 5 * 1024, P.in[I_NMLPPOST] + (l > 0 ? (l - 1) * 1024 : 0), 1, P.in[I_NMIXPRE] + l * 1024, modl, 0, H); }
        GSYNC();
        const int eo = l >> 1;
        {
            FRESH();
            pg8::Gemm g; pg8::StaticOrder S; EpiBf16<0> E;
            if ((l & 1) == 0) { g = pg8::Gemm{H, (const bf16*)(ws + WS_WINE) + (size_t)eo * NB_E * 1024, MT, NB_E, 1024, 1024, 0, 0}; E = EpiBf16<0>{BIG, NPROJ_E, (float*)(ws + WS_AB)}; }
            else { g = pg8::Gemm{H, (const bf16*)(ws + WS_WINO) + (size_t)eo * 2048 * 1024, MT, 2048, 1024, 1024, 0, 0}; E = EpiBf16<0>{BIG, 2048, nullptr}; }
            S.init(g.M, g.N, G, bid);
            pg8::gemm_phase(wid0, lds, g, S, E); DUPG(pg8::gemm_phase(wid0, lds, g, S, E);)
        }
        GSYNC();
        if ((l & 1) == 0) {
#ifdef PROBE_DUP_MIX
#pragma unroll 1
            for (int rep = 0; rep < 2; ++rep) { { FRESH(); phase_mix_even(wid0, P, lds, eo, rep == 0 ? 3 : PROBE_DUP_MIX); } GSYNC(); }
#else
            { FRESH(); phase_mix_even(wid0, P, lds, eo); }
            GSYNC();
#endif
            { FRESH(); phase_fin_even(wid0, P, lds, eo); }
            GSYNC();
        } else {
            { FRESH(); phase_conv_odd(wid0, P, eo); }
            GSYNC();
#ifdef PROBE_DUP_CONV
            { FRESH(); phase_conv_odd(wid0, P, eo); }
            GSYNC();
#endif
#pragma unroll 1
            for (int d = 0; d < 2; ++d) {
                { FRESH();
                pg8::Gemm g{H, (const bf16*)(ws + WS_WG) + (size_t)(eo * 2 + d) * 2048 * 256, MT, 2048, 256, 1024, 1, 1};
                EpiGates E{(unsigned*)(ws + WS_GATES), H, P.in[I_LBR] + (eo * 2 + d) * 1024, P.in[I_LBI] + (eo * 2 + d) * 1024, P.in[I_LLAM] + (eo * 2 + d) * 1024};
                pg8::StaticOrder S; S.init(g.M, g.N, G, bid);
                pg8::gemm_phase(wid0, lds, g, S, E); DUPG(pg8::gemm_phase(wid0, lds, g, S, E);) }
                GSYNC();
                { FRESH(); phase_lru_scan(wid0, P, eo, d); }
#ifdef PROBE_DUP_LRU0
                if (d == 0) { GSYNC(); FRESH(); phase_lru_scan(wid0, P, eo, d); }
#endif
                GSYNC();
            }
        }
        {
            FRESH();
            pg8::Gemm g{MIX, (const bf16*)(ws + ((l & 1) ? WS_WOUTO : WS_WOUTE)) + (size_t)eo * 1024 * 1024, MT, 1024, 1024, 1024, 0, 0};
            EpiBf16<0> E{BIG, 1024, nullptr}; pg8::StaticOrder S; S.init(g.M, g.N, G, bid);
            pg8::gemm_phase(wid0, lds, g, S, E); DUPG(pg8::gemm_phase(wid0, lds, g, S, E);)
        }
        GSYNC();
        { FRESH(); const float* modl = mod + (size_t)l * 9 * 6144;
        phase_rownorm(wid0, P, 0, BIG, modl, 2 * 1024, P.in[I_NMIXPOST] + l * 1024, 1, P.in[I_NMLPPRE] + l * 1024, modl, 3 * 1024, H); }
        GSYNC();
        {
            FRESH();
            pg8::Gemm g{H, (const bf16*)(ws + WS_W1T) + (size_t)l * 4096 * 1024, MT, 4096, 1024, 1024, 0, 0};
            EpiBf16<1> E{BIG, 4096, nullptr}; pg8::StaticOrder S; S.init(g.M, g.N, G, bid);
            pg8::gemm_phase(wid0, lds, g, S, E); DUPG(pg8::gemm_phase(wid0, lds, g, S, E);)
        }
        GSYNC();
        {
            FRESH();
            pg8::Gemm g{BIG, (const bf16*)(ws + WS_W2T) + (size_t)l * 1024 * 4096, MT, 1024, 4096, 4096, 0, 0};
            EpiBf16<0> E{MIX, 1024, nullptr}; pg8::StaticOrder S; S.init(g.M, g.N, G, bid);
            pg8::gemm_phase(wid0, lds, g, S, E); DUPG(pg8::gemm_phase(wid0, lds, g, S, E);)
        }
        GSYNC();
    }
    { FRESH();
    phase_rownorm(wid0, P, 0, MIX, mod + (size_t)3 * 9 * 6144, 5 * 1024, P.in[I_NMLPPOST] + 3 * 1024, 0, P.in[I_NMIXPRE], mod, 0, H); }
}

extern "C" void kernel_launch(void* const* d_in, const int* in_sizes, int n_in, void* d_out, int out_size, void* d_ws, size_t ws_size, hipStream_t stream) {
    static int grid = 0;
    if (grid == 0) {
        if (n_in != 40 || ws_size < WS_END) { fprintf(stderr, "kernel_launch: expected 40 inputs and >= %zu bytes of workspace (got %d, %zu)\n", (size_t)WS_END, n_in, ws_size); grid = -1; return; }
        int dev = 0, cus = 0, per_cu = 0;
        if (hipGetDevice(&dev) != hipSuccess || hipDeviceGetAttribute(&cus, hipDeviceAttributeMultiprocessorCount, dev) != hipSuccess) { grid = -1; return; }
        if (hipFuncSetAttribute((const void*)fwd_kernel, hipFuncAttributeMaxDynamicSharedMemorySize, LDS_BYTES) != hipSuccess) { fprintf(stderr, "kernel_launch: hipFuncSetAttribute failed\n"); grid = -1; return; }
        if (hipOccupancyMaxActiveBlocksPerMultiprocessor(&per_cu, (const void*)fwd_kernel, NTHR, LDS_BYTES) != hipSuccess || per_cu < 1) per_cu = 1;
        (void)hipGetLastError();
        grid = cus * per_cu; if (grid > 256) grid = 256;
    }
    if (grid < 0) return;
    (void)hipMemsetAsync((char*)d_ws + WS_BAR, 0, 16384, stream);
    Params p{};
    for (int i = 0; i < 40; ++i) p.in[i] = (const float*)d_in[i];
    p.out = (float*)d_out; p.ws = (unsigned char*)d_ws;
    void* args[] = {&p};
    hipError_t e = hipLaunchCooperativeKernel((const void*)fwd_kernel, dim3(grid), dim3(NTHR), args, LDS_BYTES, stream);
    if (e != hipSuccess) fprintf(stderr, "cooperative launch failed: %s (grid %d)\n", hipGetErrorString(e), grid);
}
```

```cpp
#include <hip/hip_runtime.h>
#include <hip/hip_cooperative_groups.h>
#include <cstdio>
#include <cstdint>
namespace cg = cooperative_groups;
__device__ __forceinline__ int bid_fresh() { int t = blockIdx.x; asm volatile("" : "+s"(t)); return t; }
__device__ __forceinline__ int grid_fresh() { int t = gridDim.x; asm volatile("" : "+s"(t)); return t; }
__device__ __forceinline__ int tid_fresh(int w) { asm volatile("" : "+s"(w)); int l; asm volatile("v_mbcnt_lo_u32_b32 %0, -1, 0\n\tv_mbcnt_hi_u32_b32 %0, -1, %0" : "=v"(l)); return w * 64 + l; }

namespace pg8 {
#define PG8_LAS __attribute__((address_space(3)))
typedef unsigned short bf16_t;
typedef short bf16x8 __attribute__((ext_vector_type(8)));
typedef float f32x4 __attribute__((ext_vector_type(4)));
typedef unsigned u32x4 __attribute__((ext_vector_type(4)));
typedef unsigned u32x2 __attribute__((ext_vector_type(2)));
constexpr int BM = 256, BK = 64, HALF = 128, HTB = HALF * BK * 2, STAGE_BYTES = 8 * HTB, NXCD = 8, WGM = 8;

__host__ __device__ __forceinline__ int lds_byte(int r, int c) { const int st = (r >> 4) * 2 + (c >> 5), rr = r & 15, cc = c & 31, ob = rr * 64 + cc * 2; return st * 1024 + (ob ^ (((ob >> 9) & 1) << 5)); }
__host__ __device__ __forceinline__ void stage_rc(int b, int& R, int& C) { const int st = b / 1024, sb = b % 1024, swz = sb ^ (((sb >> 9) & 1) << 5); R = (st >> 1) * 16 + swz / 64; C = (st & 1) * 32 + (swz % 64) / 2; }
__host__ __device__ __forceinline__ int perm32(int rho) { const int n = rho >> 4, i = rho & 15; return 8 * (i >> 2) + 4 * n + (i & 3); }

struct Unit { int pm, pn; };
struct Gemm { const bf16_t* A; const bf16_t* Bt; int M, N, K, lda, ablk, ashift, ldb, ksplit; };

struct StaticOrder {
    int nM, nN, nwg, G, c;
    __host__ __device__ void init(int M, int N, int G_, int c_) { nM = M / BM; nN = N / BM; nwg = nM * nN; G = G_; c = c_; }
    __host__ __device__ bool next(int i, Unit& u) const {
        const long L = (long)i * G + c; if (L >= nwg) return false;
        int wgid = (int)L; { const int q = nwg / NXCD, r = nwg % NXCD, xcd = wgid % NXCD, off = wgid / NXCD; wgid = (xcd < r ? xcd * (q + 1) : r * (q + 1) + (xcd - r) * q) + off; }
        const int nig = WGM * nN, gid = wgid / nig, fm = gid * WGM, gsz = (nM - fm) < WGM ? (nM - fm) : WGM;
        u.pm = fm + ((wgid % nig) % gsz); u.pn = (wgid % nig) / gsz; return true;
    }
};
__device__ __forceinline__ unsigned cvt_pk_bf16(float lo, float hi) { unsigned r; asm volatile("v_cvt_pk_bf16_f32 %0, %1, %2" : "=v"(r) : "v"(lo), "v"(hi)); return r; }

template <class Epi>
__device__ __forceinline__ void gemm_phase(int wid0, PG8_LAS unsigned char* lds, const Gemm g, const StaticOrder& S, const Epi& E) {
    const int tid = tid_fresh(wid0), wid = __builtin_amdgcn_readfirstlane(tid >> 6), lane = tid & 63, wr = wid >> 2, wc = wid & 3, fr = lane & 15, fq = lane >> 4;
    const int K = g.K, nt = K / BK, lda = g.lda, ldb = g.ldb;
    unsigned voffA[2], voffB[2];
#pragma unroll
    for (int i = 0; i < 2; ++i) { int R, C; stage_rc(tid * 16 + i * 8192, R, C); const int Rb = (R & ~31) + perm32(R & 31);
        voffA[i] = (unsigned)(R * lda + C) * 2u; voffB[i] = (unsigned)(Rb * ldb + C) * 2u; }
    const size_t kstep = (size_t)(BK * 2);
    const size_t hstepA = (size_t)HALF * lda * 2, hstepB = (size_t)HALF * ldb * 2;
    const size_t tstepA = 2 * hstepA, tstepB = 2 * hstepB;
    const unsigned ldsw = (unsigned)wid * 1024u;
    const int aoff = lds_byte(wr * 64 + fr, fq * 8), boff = lds_byte(wc * 32 + fr, fq * 8);
#define PG8_ACOL(pn) (g.ablk ? (size_t)((((pn) >> g.ashift) & 3) * 512) : (g.ksplit ? (size_t)((pn) & 1) * (size_t)K * 2 : (size_t)0))
#define PG8_BOFF(pn) (g.ksplit ? (size_t)((pn) >> 1) * tstepB + (size_t)((pn) & 1) * (size_t)K * 2 : (size_t)(pn) * tstepB)
#define PG8_SA(b, h) (((b) * 2 + (h)) * HTB)
#define PG8_SB(b, h) ((4 + (b) * 2 + (h)) * HTB)
#define PG8_STAGE(bufoff, gbase, voff) do { _Pragma("unroll") for (int _i = 0; _i < 2; ++_i) \
        __builtin_amdgcn_global_load_lds((const unsigned*)((const char*)(gbase) + (voff)[_i]), (PG8_LAS unsigned*)(lds + (bufoff) + ldsw + _i * 8192), 16, 0, 0); } while (0)
#define PG8_LDA(dst, b, h) do { _Pragma("unroll") for (int m = 0; m < 4; ++m) _Pragma("unroll") for (int k = 0; k < 2; ++k) dst[m][k] = *(const PG8_LAS bf16x8*)(lds + PG8_SA(b, h) + aoff + m * 2048 + k * 1024); } while (0)
#define PG8_LDB(dst, b, h) do { _Pragma("unroll") for (int n = 0; n < 2; ++n) _Pragma("unroll") for (int k = 0; k < 2; ++k) dst[n][k] = *(const PG8_LAS bf16x8*)(lds + PG8_SB(b, h) + boff + n * 2048 + k * 1024); } while (0)
#define PG8_MMA(ai, bj, At, Bt) do { __builtin_amdgcn_s_setprio(1); _Pragma("unroll") for (int m = 0; m < 4; ++m) _Pragma("unroll") for (int n = 0; n < 2; ++n) _Pragma("unroll") for (int k = 0; k < 2; ++k) \
        acc[ai][bj][m][n] = __builtin_amdgcn_mfma_f32_16x16x32_bf16(Bt[n][k], At[m][k], acc[ai][bj][m][n], 0, 0, 0); __builtin_amdgcn_s_setprio(0); } while (0)
#define PG8_WAIT_V(n) asm volatile("s_waitcnt vmcnt(" #n ")" ::: "memory")
#define PG8_WAIT_L(n) asm volatile("s_waitcnt lgkmcnt(" #n ")" ::: "memory")
#define PG8_BAR __builtin_amdgcn_s_barrier()
#define PG8_SCHED __builtin_amdgcn_sched_barrier(0)
    Unit cur, nxt; int ui = 0;
    if (!S.next(0, cur)) return;
    f32x4 acc[2][2][4][2];
#pragma unroll
    for (int a = 0; a < 2; ++a)
#pragma unroll
        for (int b = 0; b < 2; ++b)
#pragma unroll
            for (int m = 0; m < 4; ++m)
#pragma unroll
                for (int n = 0; n < 2; ++n) acc[a][b][m][n] = (f32x4){0.f, 0.f, 0.f, 0.f};
    bf16x8 At[4][2], B0[2][2], B1[2][2];
    const char* cA = (const char*)g.A + (size_t)cur.pm * tstepA + PG8_ACOL(cur.pn); const char* cB = (const char*)g.Bt + PG8_BOFF(cur.pn);
    PG8_STAGE(PG8_SB(0, 0), cB, voffB); PG8_STAGE(PG8_SA(0, 0), cA, voffA); PG8_STAGE(PG8_SB(0, 1), cB + hstepB, voffB); PG8_STAGE(PG8_SA(0, 1), cA + hstepA, voffA);
    if (wr == 1) PG8_BAR;
    PG8_WAIT_V(4); PG8_BAR;
    PG8_STAGE(PG8_SB(1, 0), cB + kstep, voffB); PG8_STAGE(PG8_SA(1, 0), cA + kstep, voffA); PG8_STAGE(PG8_SB(1, 1), cB + hstepB + kstep, voffB);
    PG8_WAIT_V(6); PG8_BAR;
    for (;;) {
        const bool has_next = S.next(ui + 1, nxt);
        const char* nA = has_next ? (const char*)g.A + (size_t)nxt.pm * tstepA + PG8_ACOL(nxt.pn) : cA; const char* nB = has_next ? (const char*)g.Bt + PG8_BOFF(nxt.pn) : cB;
        for (int t = 0; t < nt; t += 2) {
            const bool last = (t == nt - 2);
            const char* a1 = cA + (size_t)(t + 1) * kstep;
            const char* a2 = last ? nA : cA + (size_t)(t + 2) * kstep; const char* b2 = last ? nB : cB + (size_t)(t + 2) * kstep;
            const char* a3 = a2 + kstep; const char* b3 = b2 + kstep;
            PG8_LDB(B0, 0, 0); PG8_SCHED; PG8_LDA(At, 0, 0); PG8_STAGE(PG8_SA(1, 1), a1 + hstepA, voffA);
            PG8_WAIT_L(8); PG8_BAR; PG8_WAIT_L(0); PG8_MMA(0, 0, At, B0); PG8_BAR; PG8_SCHED;
            PG8_LDB(B1, 0, 1); PG8_STAGE(PG8_SB(0, 0), b2, voffB);
            PG8_BAR; PG8_WAIT_L(0); PG8_MMA(0, 1, At, B1); PG8_BAR;
            PG8_LDA(At, 0, 1); PG8_STAGE(PG8_SA(0, 0), a2, voffA);
            PG8_BAR; PG8_WAIT_L(0); PG8_MMA(1, 0, At, B0); PG8_BAR; PG8_SCHED;
            PG8_STAGE(PG8_SB(0, 1), b2 + hstepB, voffB);
            PG8_WAIT_V(6); PG8_BAR; PG8_MMA(1, 1, At, B1); PG8_BAR;
            PG8_LDB(B0, 1, 0); PG8_SCHED; PG8_LDA(At, 1, 0); PG8_STAGE(PG8_SA(0, 1), a2 + hstepA, voffA);
            PG8_WAIT_L(8); PG8_BAR; PG8_WAIT_L(0); PG8_MMA(0, 0, At, B0); PG8_BAR; PG8_SCHED;
            PG8_LDB(B1, 1, 1); PG8_STAGE(PG8_SB(1, 0), b3, voffB);
            PG8_BAR; PG8_WAIT_L(0); PG8_MMA(0, 1, At, B1); PG8_BAR;
            PG8_LDA(At, 1, 1); PG8_STAGE(PG8_SA(1, 0), a3, voffA);
            PG8_BAR; PG8_WAIT_L(0); PG8_MMA(1, 0, At, B0); PG8_BAR; PG8_SCHED;
            PG8_STAGE(PG8_SB(1, 1), b3 + hstepB, voffB);
            PG8_WAIT_V(6); PG8_BAR; PG8_MMA(1, 1, At, B1); PG8_BAR;
        }
        E(acc, cur, wr, wc, fr, fq);
        if (!has_next) break;
#pragma unroll
        for (int a = 0; a < 2; ++a)
#pragma unroll
            for (int b = 0; b < 2; ++b)
#pragma unroll
                for (int m = 0; m < 4; ++m)
#pragma unroll
                    for (int n = 0; n < 2; ++n) acc[a][b][m][n] = (f32x4){0.f, 0.f, 0.f, 0.f};
        cur = nxt; cA = nA; cB = nB; ++ui;
    }
    PG8_WAIT_V(0);
    if (wr == 0) PG8_BAR;
    PG8_BAR;
#undef PG8_ACOL
#undef PG8_BOFF
#undef PG8_SA
#undef PG8_SB
#undef PG8_STAGE
#undef PG8_LDA
#undef PG8_LDB
#undef PG8_MMA
#undef PG8_WAIT_V
#undef PG8_WAIT_L
#undef PG8_BAR
#undef PG8_SCHED
}
}
#define LAS __attribute__((address_space(3)))
typedef unsigned short bf16;
typedef short bf16x8 __attribute__((ext_vector_type(8)));
typedef float f32x4 __attribute__((ext_vector_type(4)));
typedef unsigned u32x4 __attribute__((ext_vector_type(4)));
typedef unsigned u32x2 __attribute__((ext_vector_type(2)));
constexpr int DM = 1024, MT = 24576, MCTX = 8192, LCTX = 256, LLAT = 2048, NWAVES = 8, NTHR = 512;
constexpr int NPROJ_E = 3072, NB_E = 3328, IN_EVEN_LD = 3088;
constexpr float EPSF = 1e-6f;
constexpr size_t MiB = 1u << 20;
constexpr size_t WS_MOD = 0, MOD_BYTES = 4 * 9 * 6144 * 4, WS_S5F = 1 * MiB, WS_AB = 3 * MiB, WS_W1T = 5 * MiB, WS_W2T = 37 * MiB, WS_WINE = 69 * MiB,
                 WS_WOUTE = 82 * MiB, WS_WINO = 86 * MiB, WS_WOUTO = 94 * MiB, WS_WG = 98 * MiB, WS_H = 102 * MiB, WS_BIG = 150 * MiB, WS_YBUF = 294 * MiB,
                 WS_GATES = 246 * MiB, WS_MIX = 342 * MiB, WS_END = 390 * MiB;
constexpr int LDS_BYTES = 147456;
constexpr size_t OUT_S5RE = 25165824, OUT_S5IM = OUT_S5RE + 262144, OUT_DELTA = OUT_S5IM + 262144, OUT_LRU = OUT_DELTA + 8388608;

struct Params { const float* in[40]; float* out; unsigned char* ws; };
enum { I_XP = 0, I_XS, I_S5RE, I_S5IM, I_SDELTA, I_SLRU, I_C, I_CCTX, I_WADA, I_BADA, I_NMIXPRE, I_NMIXPOST, I_NMLPPRE, I_NMLPPOST, I_WMLPIN, I_WMLPOUT, I_WINE, I_WOUTE,
       I_LAMRE, I_LAMIM, I_LOGDT, I_BRE, I_BIM, I_CRE, I_CIM, I_S5D, I_GCONVW, I_GCONVB, I_GALOG, I_GDTB, I_GONORM, I_WINO, I_WOUTO, I_LCONVW, I_LCONVB, I_LWR, I_LBR, I_LWI, I_LBI, I_LLAM };

typedef __bf16 bf2_t __attribute__((ext_vector_type(2)));
typedef float f2_t __attribute__((ext_vector_type(2)));
__device__ __forceinline__ unsigned pk2(float lo, float hi) { const bf2_t v = __builtin_convertvector((f2_t){lo, hi}, bf2_t); return __builtin_bit_cast(unsigned, v); }
__device__ __forceinline__ unsigned f2bf(float f) { return pk2(f, f) & 0xffffu; }
__device__ __forceinline__ float bflo(unsigned w) { return __builtin_bit_cast(float, w << 16); }
__device__ __forceinline__ float bfhi(unsigned w) { return __builtin_bit_cast(float, w & 0xffff0000u); }
__device__ __forceinline__ float bf2f(bf16 b) { return __builtin_bit_cast(float, (unsigned)b << 16); }
__device__ __forceinline__ float sigmoidf_(float x) { return __builtin_amdgcn_rcpf(1.0f + __expf(-x)); }
__device__ __forceinline__ float siluf_(float x) { return x * sigmoidf_(x); }
__device__ __forceinline__ float softplusf_(float x) { return fmaxf(x, 0.f) + __logf(1.0f + __expf(-fabsf(x))); }
__device__ __forceinline__ float geluf_(float x) { const float y = 0.7978845608028654f * (x + 0.044715f * x * x * x); const float t = 1.0f - 2.0f * __builtin_amdgcn_rcpf(__expf(2.0f * y) + 1.0f); return 0.5f * x * (1.0f + t); }
__device__ __forceinline__ float shfl_i(float v, int srclane) { return __builtin_bit_cast(float, __builtin_amdgcn_ds_bpermute(srclane << 2, __builtin_bit_cast(int, v))); }
__device__ __forceinline__ float wave_sum(float v, int lane) {
#pragma unroll
    for (int o = 1; o < 64; o <<= 1) v += shfl_i(v, lane ^ o);
    return v;
}
#define LDS_WAIT() asm volatile("s_waitcnt lgkmcnt(0)" ::: "memory")
#define WAVE_SYNC() do { asm volatile("s_waitcnt lgkmcnt(0)" ::: "memory"); __builtin_amdgcn_wave_barrier(); } while (0)
__device__ __forceinline__ f32x4 mfma16(bf16x8 a, bf16x8 b, f32x4 c) { return __builtin_amdgcn_mfma_f32_16x16x32_bf16(a, b, c, 0, 0, 0); }


#define XB_TMO      128
#define XB_XCNT(j)  (256  + 64 * (j))
#define XB_XSUB(j)  (1280 + 64 * (j))
#define XB_XGEN(j)  (2304 + 64 * (j))
#define XB_TOP      3328
#define XB_TOPGEN   3392
#define XCD_BAR_WORDS 3456
#define XB_SPIN_CAP (1u << 18)
constexpr size_t WS_BAR = 960 * 1024; constexpr int LDS_BARST = LDS_BYTES - 16;
__device__ __forceinline__ unsigned xb_ld(unsigned* p)              { return __hip_atomic_load(p, __ATOMIC_RELAXED, __HIP_MEMORY_SCOPE_AGENT); }
__device__ __forceinline__ unsigned xb_add(unsigned* p, unsigned v) { return __hip_atomic_fetch_add(p, v, __ATOMIC_RELAXED, __HIP_MEMORY_SCOPE_AGENT); }
__device__ __forceinline__ unsigned xb_xcc_id() { return (unsigned)__builtin_amdgcn_s_getreg((3 << 11) | 20) & 0xFu; }
#define XB_SPIN(cond, bar) do { unsigned _sp = 0; while (cond) { __builtin_amdgcn_s_sleep(1); \
    if ((++_sp & 255u) == 0u) { if (xb_ld(&(bar)[XB_TMO])) break; if (_sp > XB_SPIN_CAP) { atomicAdd(&(bar)[XB_TMO], 1u); break; } } } } while (0)
__device__ __forceinline__ void xcd_barrier_complete(unsigned* bar, unsigned x, unsigned& nloc, unsigned& nx) {
    const unsigned G = gridDim.x;
    unsigned sum, cnt, mine, sp = 0u;
    for (;;) {
        sum = 0u; cnt = 0u; mine = 0u;
#pragma unroll
        for (unsigned j = 0; j < 16; ++j) { const unsigned c = xb_ld(&bar[XB_XCNT(j)]); sum += c; cnt += (c > 0u) ? 1u : 0u; mine = (j == x) ? c : mine; }
        if (sum == G) break;
        __builtin_amdgcn_s_sleep(1);
        if ((++sp & 255u) == 0u) { if (xb_ld(&bar[XB_TMO])) break; if (sp > XB_SPIN_CAP) { atomicAdd(&bar[XB_TMO], 1u); break; } }
    }
    nloc = mine > 0u ? mine : 1u; nx = cnt > 0u ? cnt : 1u;
}
__device__ __forceinline__ void xcd_barrier(int wid0, unsigned* bar, LAS unsigned char* lds) {
    const int tid = tid_fresh(wid0);
    asm volatile("s_waitcnt vmcnt(0)" ::: "memory");
    __syncthreads();
    if (tid == 0) {
        const unsigned x = xb_xcc_id();
        volatile LAS unsigned* st = (volatile LAS unsigned*)(lds + LDS_BARST);
        __builtin_amdgcn_s_waitcnt(0);
        unsigned nloc = st[0], nx = st[1];
        if (nloc == 0u) { xcd_barrier_complete(bar, x, nloc, nx); st[0] = nloc; st[1] = nx; }
        const unsigned old = xb_add(&bar[XB_XSUB(x)], 1u);
        const unsigned gen = old / nloc;
        if (old + 1u == (gen + 1u) * nloc) {
            __builtin_amdgcn_fence(__ATOMIC_RELEASE, "agent");
            asm volatile("s_waitcnt vmcnt(0)" ::: "memory");
            const unsigned og = xb_add(&bar[XB_TOP], 1u);
            const unsigned tg = og / nx;
            if (og + 1u == (tg + 1u) * nx) xb_add(&bar[XB_TOPGEN], 1u);
            else XB_SPIN(xb_ld(&bar[XB_TOPGEN]) == tg, bar);
            __builtin_amdgcn_fence(__ATOMIC_ACQUIRE, "agent");
            xb_add(&bar[XB_XGEN(x)], 1u);
            asm volatile("s_waitcnt vmcnt(0)" ::: "memory");
        } else {
            XB_SPIN(xb_ld(&bar[XB_XGEN(x)]) == gen, bar);
            __builtin_amdgcn_fence(__ATOMIC_ACQUIRE, "agent");
            asm volatile("s_waitcnt vmcnt(0)" ::: "memory");
        }
    }
    __syncthreads();
}
__device__ __forceinline__ void transpose_item(const float* W, int ldw, int nvalid, int K, bf16* WT, int dst_row0, LAS float* scr, int k0, int n0, int lane) {
    const int nn = n0 + (lane & 31); const bool ok = nn < nvalid;
#pragma unroll 8
    for (int i = 0; i < 32; ++i) { const int kk = 2 * i + (lane >> 5); scr[kk * 33 + (lane & 31)] = ok ? W[(size_t)(k0 + kk) * ldw + nn] : 0.f; }
    WAVE_SYNC();
    const int c = lane & 7;
#pragma unroll
    for (int j = 0; j < 4; ++j) { const int n = (lane >> 3) + 8 * j; const LAS float* s = scr + (8 * c) * 33 + n;
        u32x4 o; o.x = pk2(s[0 * 33], s[1 * 33]); o.y = pk2(s[2 * 33], s[3 * 33]); o.z = pk2(s[4 * 33], s[5 * 33]); o.w = pk2(s[6 * 33], s[7 * 33]);
        *(u32x4*)(WT + (size_t)(dst_row0 + n) * K + k0 + 8 * c) = o; }
    WAVE_SYNC();
}
__device__ __forceinline__ void phase_prologue(int wid0, const Params& P, LAS unsigned char* lds) {
    const int tid = tid_fresh(wid0), lane = tid & 63, wave = tid >> 6;
    LAS float* scr = (LAS float*)(lds + wave * 16384);
    const int gw = bid_fresh() * NWAVES + wave, NGW = grid_fresh() * NWAVES;
    unsigned char* ws = P.ws;
    constexpr int NA = 8192, NB = 8192, NC = 2 * 16 * 97, ND = 1024, NE = 2048, NF = 1024, NG = 1024, NTR = NA + NB + NC + ND + NE + NF + NG, NMOD = 4 * 24 * 16;
    for (int it = gw; it < NTR + NMOD; it += NGW) {
        int r = it;
        if (r < NA) { const int l = r >> 11, q = r & 2047; transpose_item(P.in[I_WMLPIN] + (size_t)l * 1024 * 4096, 4096, 4096, 1024, (bf16*)(ws + WS_W1T) + (size_t)l * 4096 * 1024, 32 * (q & 127), scr, 64 * (q >> 7), 32 * (q & 127), lane); continue; } r -= NA;
        if (r < NB) { const int l = r >> 11, q = r & 2047; transpose_item(P.in[I_WMLPOUT] + (size_t)l * 4096 * 1024, 1024, 1024, 4096, (bf16*)(ws + WS_W2T) + (size_t)l * 1024 * 4096, 32 * (q & 31), scr, 64 * (q >> 5), 32 * (q & 31), lane); continue; } r -= NB;
        if (r < NC) { const int e = r / 1552, q = r % 1552, kb = q / 97, nb = q % 97; transpose_item(P.in[I_WINE] + (size_t)e * 1024 * IN_EVEN_LD, IN_EVEN_LD, IN_EVEN_LD, 1024, (bf16*)(ws + WS_WINE) + (size_t)e * NB_E * 1024, 32 * nb, scr, 64 * kb, 32 * nb, lane); continue; } r -= NC;
        if (r < ND) { const int e = r >> 9, q = r & 511; transpose_item(P.in[I_WOUTE] + (size_t)e * 1024 * 1024, 1024, 1024, 1024, (bf16*)(ws + WS_WOUTE) + (size_t)e * 1024 * 1024, 32 * (q & 31), scr, 64 * (q >> 5), 32 * (q & 31), lane); continue; } r -= ND;
        if (r < NE) { const int o = r >> 10, q = r & 1023; transpose_item(P.in[I_WINO] + (size_t)o * 1024 * 2048, 2048, 2048, 1024, (bf16*)(ws + WS_WINO) + (size_t)o * 2048 * 1024, 32 * (q & 63), scr, 64 * (q >> 6), 32 * (q & 63), lane); continue; } r -= NE;
        if (r < NF) { const int o = r >> 9, q = r & 511; transpose_item(P.in[I_WOUTO] + (size_t)o * 1024 * 1024, 1024, 1024, 1024, (bf16*)(ws + WS_WOUTO) + (size_t)o * 1024 * 1024, 32 * (q & 31), scr, 64 * (q >> 5), 32 * (q & 31), lane); continue; } r -= NF;
        if (r < NG) { const int mat = r >> 5, q = r & 31, kb = q >> 3, nb = q & 7; const int blk = mat & 3, gate = (mat >> 2) & 1, od = mat >> 3;
            const float* src = (gate ? P.in[I_LWI] : P.in[I_LWR]) + (size_t)(od * 4 + blk) * 65536;
            const int j0 = nb * 32; const int drow = (blk * 2 + (j0 >> 7)) * 256 + gate * 128 + (j0 & 127);
            transpose_item(src, 256, 256, 256, (bf16*)(ws + WS_WG) + (size_t)od * 2048 * 256, drow - j0 + j0, scr, 64 * kb, j0, lane);
            continue; } r -= NG;
        {
            const int l = r / 384, rem = r % 384, ec = rem >> 4, ks = rem & 15, k0 = ks * 64;
#pragma unroll
            for (int rr = 0; rr < 9; ++rr) { const float cv = rr == 0 ? P.in[I_CCTX][k0 + lane] : P.in[I_C][(rr - 1) * 1024 + k0 + lane]; scr[rr * 64 + lane] = siluf_(cv); }
            WAVE_SYNC();
            f32x4 acc[9];
#pragma unroll
            for (int rr = 0; rr < 9; ++rr) acc[rr] = (f32x4){0.f, 0.f, 0.f, 0.f};
            const float* wp = P.in[I_WADA] + ((size_t)l * 1024 + k0) * 6144 + ec * 256 + lane * 4;
#pragma unroll 4
            for (int kk = 0; kk < 64; ++kk) { const f32x4 w4 = *(const f32x4*)(wp + (size_t)kk * 6144);
#pragma unroll
                for (int rr = 0; rr < 9; ++rr) acc[rr] += w4 * scr[rr * 64 + kk]; }
            float* part = (float*)(ws + WS_BIG) + ((size_t)(ks * 4 + l) * 9) * 6144 + ec * 256 + lane * 4;
#pragma unroll
            for (int rr = 0; rr < 9; ++rr) *(f32x4*)(part + (size_t)rr * 6144) = acc[rr];
            WAVE_SYNC();
        }
    }
    { u32x4* z = (u32x4*)0; (void)z;
      const size_t per = (size_t)(NB_E - 3104) * 1024 * 2 / 16;
      for (size_t i = (size_t)bid_fresh() * NTHR + tid; i < 2 * per; i += (size_t)grid_fresh() * NTHR) { const size_t e = i / per, q = i % per;
          *(u32x4*)(ws + WS_WINE + (e * NB_E + 3104) * 1024 * 2 + q * 16) = (u32x4){0u, 0u, 0u, 0u}; } }
}

__device__ __forceinline__ void phase_modreduce(int wid0, const Params& P) {
    const int tid = tid_fresh(wid0);
    const float* part = (const float*)(P.ws + WS_BIG); float* mod = (float*)(P.ws + WS_MOD);
    for (int i = bid_fresh() * NTHR + tid; i < 4 * 9 * 6144 / 4; i += grid_fresh() * NTHR) {
        const int l = i / (9 * 1536), e4 = i % 1536;
        f32x4 a = *(const f32x4*)(P.in[I_BADA] + (size_t)l * 6144 + e4 * 4);
#pragma unroll
        for (int ks = 0; ks < 16; ++ks) a += *(const f32x4*)(part + (size_t)ks * 4 * 9 * 6144 + (size_t)i * 4);
        *(f32x4*)(mod + (size_t)i * 4) = a; }
}
__device__ __forceinline__ void phase_rownorm(int wid0, const Params& P, int first, const bf16* obuf, const float* modg, int goff, const float* gpost, int has_next, const float* gpre, const float* mods, int soff, bf16* H) {
    const int tid = tid_fresh(wid0), lane = tid & 63, wave = tid >> 6;
    const int gw = bid_fresh() * NWAVES + wave, NGW = grid_fresh() * NWAVES;
    float* X = P.out;
    for (int m = gw; m < MT; m += NGW) {
        const int modrow = m < MCTX ? 0 : 1 + ((m - MCTX) >> 11);
        const float* mr = modg + (size_t)modrow * 6144; const float* ms = mods + (size_t)modrow * 6144;
        f32x4 x[4];
        if (first) {
            if (m < MCTX) {
#pragma unroll
                for (int j = 0; j < 4; ++j) x[j] = *(const f32x4*)(P.in[I_XP] + (size_t)m * DM + lane * 4 + 256 * j);
            } else {
                const int t = (m - MCTX) & 2047; const float prow = (float)(t >> 6), pcol = (float)(t & 63);
                f32x4 om;
#pragma unroll
                for (int e = 0; e < 4; ++e) om[e] = exp2f(-(float)(lane * 4 + e) * (13.287712379549449f / 256.0f));
#pragma unroll
                for (int j = 0; j < 4; ++j) { x[j] = *(const f32x4*)(P.in[I_XS] + (size_t)(m - MCTX) * DM + lane * 4 + 256 * j);
#pragma unroll
                    for (int e = 0; e < 4; ++e) { const float a = (j < 2 ? prow : pcol) * om[e]; x[j][e] += (j & 1) ? cosf(a) : sinf(a); } }
            }
        } else {
            u32x2 ov[4]; float ss = 0.f;
#pragma unroll
            for (int j = 0; j < 4; ++j) { x[j] = *(const f32x4*)(X + (size_t)m * DM + lane * 4 + 256 * j); ov[j] = *(const u32x2*)(obuf + (size_t)m * DM + lane * 4 + 256 * j); }
#pragma unroll
            for (int j = 0; j < 4; ++j) { const float a = bflo(ov[j].x), b = bfhi(ov[j].x), c = bflo(ov[j].y), d = bfhi(ov[j].y); ss += (a * a + b * b) + (c * c + d * d); }
            const float rs = rsqrtf(wave_sum(ss, lane) * (1.0f / DM) + EPSF);
#pragma unroll
            for (int j = 0; j < 4; ++j) { const f32x4 g4 = *(const f32x4*)(gpost + lane * 4 + 256 * j), gt = *(const f32x4*)(mr + goff + lane * 4 + 256 * j);
                f32x4 o4 = (f32x4){bflo(ov[j].x), bfhi(ov[j].x), bflo(ov[j].y), bfhi(ov[j].y)};
                x[j] += gt * (o4 * rs * g4); }
        }
#pragma unroll
        for (int j = 0; j < 4; ++j) *(f32x4*)(X + (size_t)m * DM + lane * 4 + 256 * j) = x[j];
        if (has_next) {
            float ss = 0.f;
#pragma unroll
            for (int j = 0; j < 4; ++j) ss += (x[j][0] * x[j][0] + x[j][1] * x[j][1]) + (x[j][2] * x[j][2] + x[j][3] * x[j][3]);
            const float rs = rsqrtf(wave_sum(ss, lane) * (1.0f / DM) + EPSF);
#pragma unroll
            for (int j = 0; j < 4; ++j) { const f32x4 g4 = *(const f32x4*)(gpre + lane * 4 + 256 * j), sh = *(const f32x4*)(ms + soff + lane * 4 + 256 * j), sc = *(const f32x4*)(ms + soff + 1024 + lane * 4 + 256 * j);
                const f32x4 h4 = (x[j] * rs * g4) * (sc + 1.0f) + sh;
                u32x2 w; w.x = pk2(h4[0], h4[1]); w.y = pk2(h4[2], h4[3]);
                *(u32x2*)(H + (size_t)m * DM + lane * 4 + 256 * j) = w; }
        }
    }
}

using pg8::Unit;
template <int ACT  > struct EpiBf16 {
    bf16* O; int ldc; float* AB;
    __device__ __forceinline__ void operator()(const f32x4 (&acc)[2][2][4][2], const Unit& u, int wr, int wc, int fr, int fq) const {
        const int row0 = u.pm * 256 + wr * 64 + fr, col0 = u.pn * 256 + wc * 32 + 8 * fq;
        if (AB && u.pn * 256 >= ldc) {
            if (wc == 0 && fq < 2) {
#pragma unroll
                for (int ai = 0; ai < 2; ++ai)
#pragma unroll
                    for (int m = 0; m < 4; ++m) { float* p = AB + (size_t)(row0 + ai * 128 + m * 16) * 16 + 8 * fq; *(f32x4*)p = acc[ai][0][m][0]; *(f32x4*)(p + 4) = acc[ai][0][m][1]; }
            }
            return;
        }
#pragma unroll
        for (int ai = 0; ai < 2; ++ai)
#pragma unroll
            for (int m = 0; m < 4; ++m) { bf16* rowp = O + (size_t)(row0 + ai * 128 + m * 16) * ldc + col0;
#pragma unroll
                for (int bj = 0; bj < 2; ++bj) { f32x4 v0 = acc[ai][bj][m][0], v1 = acc[ai][bj][m][1];
                    if (ACT == 1) {
#pragma unroll
                        for (int j = 0; j < 4; ++j) { const float a = fmaxf(v0[j], 0.f), b = fmaxf(v1[j], 0.f); v0[j] = a * a; v1[j] = b * b; } }
                    u32x4 w; w.x = pk2(v0[0], v0[1]); w.y = pk2(v0[2], v0[3]); w.z = pk2(v1[0], v1[1]); w.w = pk2(v1[2], v1[3]);
                    *(u32x4*)(rowp + bj * 128) = w; } }
    }
};
struct EpiSplit {
    bf16* O0; long stride;
    __device__ __forceinline__ void operator()(const f32x4 (&acc)[2][2][4][2], const Unit& u, int wr, int wc, int fr, int fq) const {
        const int row0 = u.pm * 256 + wr * 64 + fr, col0 = (u.pn >> 1) * 256 + wc * 32 + 8 * fq; bf16* O = O0 + (long)(u.pn & 1) * stride;
#pragma unroll
        for (int ai = 0; ai < 2; ++ai)
#pragma unroll
            for (int m = 0; m < 4; ++m) { bf16* rowp = O + (size_t)(row0 + ai * 128 + m * 16) * DM + col0;
#pragma unroll
                for (int bj = 0; bj < 2; ++bj) { const f32x4 v0 = acc[ai][bj][m][0], v1 = acc[ai][bj][m][1];
                    u32x4 w; w.x = pk2(v0[0], v0[1]); w.y = pk2(v0[2], v0[3]); w.z = pk2(v1[0], v1[1]); w.w = pk2(v1[2], v1[3]);
                    *(u32x4*)(rowp + bj * 128) = w; } }
    }
};
struct EpiGates {
    unsigned* G; const bf16* X; const float* br; const float* bi; const float* lam;
    __device__ __forceinline__ void operator()(const f32x4 (&acc)[2][2][4][2], const Unit& u, int wr, int wc, int fr, int fq) const {
        const int row0 = u.pm * 256 + wr * 64 + fr, ch0 = u.pn * 128 + wc * 32 + 8 * fq;
#pragma unroll
        for (int n = 0; n < 2; ++n) {
            const f32x4 vbr = *(const f32x4*)(br + ch0 + 4 * n), vbi = *(const f32x4*)(bi + ch0 + 4 * n), l4 = *(const f32x4*)(lam + ch0 + 4 * n);
            f32x4 vsp;
#pragma unroll
            for (int e = 0; e < 4; ++e) vsp[e] = -8.0f * softplusf_(-l4[e]);
#pragma unroll
            for (int ai = 0; ai < 2; ++ai)
#pragma unroll
                for (int m = 0; m < 4; ++m) { const size_t row = (size_t)(row0 + ai * 128 + m * 16);
                    const u32x2 xv = *(const u32x2*)(X + row * DM + ch0 + 4 * n);
                    const float xs[4] = {bflo(xv.x), bfhi(xv.x), bflo(xv.y), bfhi(xv.y)};
                    u32x4 w;
#pragma unroll
                    for (int e = 0; e < 4; ++e) { const float r = sigmoidf_(acc[ai][0][m][n][e] + vbr[e]), ig = sigmoidf_(acc[ai][1][m][n][e] + vbi[e]);
                        const float la = r * vsp[e]; const float a_ = __expf(la); const float b = __builtin_amdgcn_sqrtf(fmaxf(1.0f - a_ * a_, 0.f)) * ig * xs[e];
                        w[e] = pk2(la * 1.4426950408889634f, b); }
                    *(u32x4*)(G + row * DM + ch0 + 4 * n) = w; }
        }
    }
};
constexpr int S5_WLDS = 12800, BU_P = 132, HS_P = 136;
struct S5Dir { float ar, ai; bf16x8 Bf[8]; };
__device__ __forceinline__ void s5_dir_setup(const Params& P, int e, int d, int g, int lane, float& ar, float& ai, bf16x8 (&Bf)[8], bool needB) {
    const int quad = lane >> 4, l15 = lane & 15;
    const float dt = __expf(P.in[I_LOGDT][(e * 2 + d) * 32 + g]);
    const float lr = P.in[I_LAMRE][((e * 2 + d) * 32 + g) * 64 + lane], li = P.in[I_LAMIM][((e * 2 + d) * 32 + g) * 64 + lane];
    const float mag = expf(lr * dt); ar = mag * cosf(li * dt); ai = mag * sinf(li * dt);
    const float den = lr * lr + li * li;
    const float fr = ((ar - 1.0f) * lr + ai * li) / den, fi = (ai * lr - (ar - 1.0f) * li) / den;
    if (needB) {
#pragma unroll
        for (int nt = 0; nt < 8; ++nt) { const int col = 16 * nt + l15, p = col & 63;
            const float frp = shfl_i(fr, p), fip = shfl_i(fi, p);
            bf16x8 v = (bf16x8){0, 0, 0, 0, 0, 0, 0, 0};
            if (quad < 2) { const float* bre = P.in[I_BRE] + ((size_t)(e * 32 + g) * 64 + p) * 16 + quad * 8; const float* bim = P.in[I_BIM] + ((size_t)(e * 32 + g) * 64 + p) * 16 + quad * 8;
#pragma unroll
                for (int j = 0; j < 8; ++j) { const float br = bre[j], bi = bim[j]; const float val = (nt < 4) ? (frp * br - fip * bi) : (frp * bi + fip * br); v[j] = (short)f2bf(val); } }
            Bf[nt] = v; }
    }
}
__device__ __forceinline__ void s5_c_setup(const Params& P, int e, int g, int lane, bf16x8 (&Cf)[4]) {
    const int quad = lane >> 4, l15 = lane & 15;
#pragma unroll
    for (int ks = 0; ks < 4; ++ks) { const int col0 = 32 * ks + quad * 8; const bool im = col0 >= 64;
        const float* src = (im ? P.in[I_CIM] : P.in[I_CRE]) + ((size_t)(e * 32 + g) * 16 + l15) * 64 + (col0 & 63);
        bf16x8 v;
#pragma unroll
        for (int j = 0; j < 8; ++j) v[j] = (short)f2bf(im ? -src[j] : src[j]);
        Cf[ks] = v; }
}
__device__ __forceinline__ void s5_scan_seg(const Params& P, LAS unsigned char* wl, int lane, int d, int g, int m0, float ar, float ai, const bf16x8 (&Bf)[8], const bf16x8 (&Cf)[4],
                                            float& hr, float& hi, int mode, int ymode, const bf16* proj, float* ybuf, bf16* mixout, float dsk) {
    const int quad = lane >> 4, l15 = lane & 15;
    LAS float* BU = (LAS float*)wl; LAS bf16* HS = (LAS bf16*)(wl + 8448);
    for (int bi_ = 0; bi_ < 16; ++bi_) {
        const int blk = d ? 15 - bi_ : bi_;
        const int mb = m0 + 16 * blk;
        if (mode == 0) {
            bf16x8 a = (bf16x8){0, 0, 0, 0, 0, 0, 0, 0};
            if (quad < 2) { const int tt = d ? 15 - l15 : l15; a = *(const bf16x8*)(proj + (size_t)(mb + tt) * NPROJ_E + g * 16 + quad * 8); }
#pragma unroll
            for (int nt = 0; nt < 8; ++nt) { f32x4 acc = mfma16(a, Bf[nt], (f32x4){0.f, 0.f, 0.f, 0.f});
#pragma unroll
                for (int jj = 0; jj < 4; ++jj) BU[(quad * 4 + jj) * BU_P + 16 * nt + l15] = acc[jj]; }
            WAVE_SYNC();
        }
#pragma unroll
        for (int r = 0; r < 16; ++r) {
            float br = 0.f, bim = 0.f;
            if (mode == 0) { br = BU[r * BU_P + lane]; bim = BU[r * BU_P + 64 + lane]; }
            const float nr = ar * hr - ai * hi + br, ni = ar * hi + ai * hr + bim; hr = nr; hi = ni;
            HS[r * HS_P + lane] = (bf16)f2bf(hr); HS[r * HS_P + 64 + lane] = (bf16)f2bf(hi);
        }
        WAVE_SYNC();
        f32x4 y = (f32x4){0.f, 0.f, 0.f, 0.f};
#pragma unroll
        for (int ks = 0; ks < 4; ++ks) { const bf16x8 a = *(const LAS bf16x8*)(HS + l15 * HS_P + 32 * ks + quad * 8); y = mfma16(a, Cf[ks], y); }
        const int ch = g * 16 + l15;
#pragma unroll
        for (int jj = 0; jj < 4; ++jj) { const int row = quad * 4 + jj; const int tt = d ? 15 - row : row; const size_t m = (size_t)(mb + tt);
            float v = y[jj];
            if (ymode == 0) { v += dsk * bf2f(proj[m * NPROJ_E + ch]); ybuf[m * 512 + ch] = v; }
            else { v += ybuf[m * 512 + ch];
                if (ymode == 1) ybuf[m * 512 + ch] = v;
                else { const float z = bf2f(proj[m * NPROJ_E + 512 + ch]); mixout[m * DM + ch] = (bf16)f2bf(geluf_(v) * sigmoidf_(z)); } }
        }
        WAVE_SYNC();
    }
}
__device__ __forceinline__ void s5_task_main(const Params& P, LAS unsigned char* wl, int lane, int e, int sub, int g) {
    const bf16* proj = (const bf16*)(P.ws + WS_BIG); float* ybuf = (float*)(P.ws + WS_YBUF); bf16* mixout = (bf16*)(P.ws + WS_MIX);
    const bool lat = sub >= 32; const int q = sub - 32, b = lat ? (q >> 3) : sub, seg = lat ? (q & 7) : 0;
    const int m0 = lat ? MCTX + b * LLAT + seg * 256 : sub * 256;
    bf16x8 Cf[4]; s5_c_setup(P, e, g, lane, Cf);
    const float dsk = P.in[I_S5D][e * 512 + g * 16 + (lane & 15)];
#pragma unroll 1
    for (int d = 0; d < 2; ++d) {
        float ar, ai; bf16x8 Bf[8]; s5_dir_setup(P, e, d, g, lane, ar, ai, Bf, true);
        float hr = 0.f, hi = 0.f;
        if (lat && ((d == 0 && seg == 0) || (d == 1 && seg == 7))) { const size_t si = ((((size_t)b * 2 + e) * 2 + d) * 32 + g) * 64 + lane; hr = P.in[I_S5RE][si]; hi = P.in[I_S5IM][si]; }
        const int ymode = d == 0 ? 0 : (lat ? 1 : 2);
        s5_scan_seg(P, wl, lane, d, g, m0, ar, ai, Bf, Cf, hr, hi, 0, ymode, proj, ybuf, mixout, dsk);
        if (!lat) { const size_t si = ((((size_t)b * 2 + e) * 2 + d) * 32 + g) * 64 + lane; P.out[OUT_S5RE + si] = hr; P.out[OUT_S5IM + si] = hi; }
        else { float* F = (float*)(P.ws + WS_S5F) + ((((size_t)d * 64 + q) * 32 + g) * 64 + lane) * 2; F[0] = hr; F[1] = hi; }
    }
}
__device__ __forceinline__ void s5_task_corr(const Params& P, LAS unsigned char* wl, int lane, int e, int q, int g) {
    const bf16* proj = (const bf16*)(P.ws + WS_BIG); float* ybuf = (float*)(P.ws + WS_YBUF); bf16* mixout = (bf16*)(P.ws + WS_MIX);
    const int b = q >> 3, seg = q & 7, m0 = MCTX + b * LLAT + seg * 256;
    bf16x8 Cf[4]; s5_c_setup(P, e, g, lane, Cf);
    bf16x8 Bf[8];
#pragma unroll
    for (int i = 0; i < 8; ++i) Bf[i] = (bf16x8){0, 0, 0, 0, 0, 0, 0, 0};
    const float* Fb = (const float*)(P.ws + WS_S5F);
#pragma unroll 1
    for (int d = 0; d < 2; ++d) {
        float ar, ai; s5_dir_setup(P, e, d, g, lane, ar, ai, Bf, false);
        float pr = ar, pi = ai;
#pragma unroll
        for (int i = 0; i < 8; ++i) { const float nr = pr * pr - pi * pi, ni = 2.0f * pr * pi; pr = nr; pi = ni; }
        float hr = 0.f, hi = 0.f;
        const int cnt = d == 0 ? seg : 7 - seg;
        for (int i = 0; i < cnt; ++i) { const int sj = d == 0 ? i : 7 - i; const float* F = Fb + ((((size_t)d * 64 + b * 8 + sj) * 32 + g) * 64 + lane) * 2;
            const float nr = pr * hr - pi * hi + F[0], ni = pr * hi + pi * hr + F[1]; hr = nr; hi = ni; }
        if (cnt > 0) s5_scan_seg(P, wl, lane, d, g, m0, ar, ai, Bf, Cf, hr, hi, 1, 1, proj, ybuf, mixout, 0.f);
    }
    __builtin_amdgcn_wave_barrier();
    for (int i = lane; i < 256 * 16; i += 64) { const size_t m = (size_t)(m0 + (i >> 4)); const int ch = g * 16 + (i & 15);
        const float v = ybuf[m * 512 + ch]; const float z = bf2f(proj[m * NPROJ_E + 512 + ch]);
        mixout[m * DM + ch] = (bf16)f2bf(geluf_(v) * sigmoidf_(z)); }
}

#ifndef REP_A
#define REP_A 1
#endif
#ifndef REP_B
#define REP_B 1
#endif
#ifndef REP_C
#define REP_C 1
#endif
#define LDS_BARRIER() do { asm volatile("s_waitcnt lgkmcnt(0)" ::: "memory"); __builtin_amdgcn_s_barrier(); asm volatile("" ::: "memory"); } while (0)
constexpr int G_Q = 0, G_K = 17408, G_V = 34816, G_KT = 52224, G_LM = 70656, G_QK = 89088, G_ST = 98304, G_SM = 133120;
constexpr int P128 = 136, P64 = 72, LMP = 68;
__device__ __forceinline__ bf16x8 ld_split8(const LAS bf16* p) {
    const u32x2 a = *(const LAS u32x2*)p, b = *(const LAS u32x2*)(p + 16);
    return __builtin_bit_cast(bf16x8, (u32x4){a.x, a.y, b.x, b.y});
}
__device__ __forceinline__ bf16x8 pack_acc2(const f32x4& a, const f32x4& b) { return __builtin_bit_cast(bf16x8, (u32x4){pk2(a[0], a[1]), pk2(a[2], a[3]), pk2(b[0], b[1]), pk2(b[2], b[3])}); }
__device__ __forceinline__ void gdn_chain(int wid0, const Params& P, LAS unsigned char* lds, int e, int s, int hd, int dir) {
    const int tid = tid_fresh(wid0), lane = tid & 63, w = __builtin_amdgcn_readfirstlane(tid >> 6), quad = lane >> 4, l15 = lane & 15;
    const bool lat = s >= 32; const int b = lat ? s - 32 : s; const int L = lat ? LLAT : LCTX; const int m0 = lat ? MCTX + b * LLAT : s * LCTX;
    const bf16* proj = (const bf16*)(P.ws + WS_BIG); const float* AB = (const float*)(P.ws + WS_AB);
    bf16* Odir = (bf16*)(P.ws + WS_H) + (size_t)dir * MT * 512;
    int zv; asm volatile("v_mov_b32 %0, 0" : "=v"(zv));
    lds += zv;
    LAS bf16* Qs = (LAS bf16*)(lds + G_Q); LAS bf16* Ks = (LAS bf16*)(lds + G_K); LAS bf16* Vs = (LAS bf16*)(lds + G_V); LAS bf16* KT = (LAS bf16*)(lds + G_KT);
    LAS float* Lm = (LAS float*)(lds + G_LM); LAS bf16* VNT = (LAS bf16*)(lds + G_LM); LAS bf16* QKs = (LAS bf16*)(lds + G_QK); LAS bf16* ST = (LAS bf16*)(lds + G_ST);
    LAS bf16* TM = (LAS bf16*)(lds + G_ST); LAS bf16* TT = TM + 64 * P64; LAS bf16* LR = TT + 64 * P64;
    LAS float* rq = (LAS float*)(lds + G_SM); LAS float* rk = rq + 64; LAS float* gcs = rq + 128; LAS float* betas = rq + 192; LAS float* egs = rq + 256; LAS float* kes = rq + 320;
    f32x4 Sacc[8];
    const size_t sbase = ((((size_t)b * 2 + e) * 2 + dir) * 4 + hd) * 16384;
#pragma unroll
    for (int mt = 0; mt < 8; ++mt) Sacc[mt] = (f32x4){0.f, 0.f, 0.f, 0.f};
    if (lat) { const float* sp = P.in[I_SDELTA] + sbase + (size_t)(quad * 4) * 128 + 16 * w + l15;
#pragma unroll
        for (int mt = 0; mt < 8; ++mt)
#pragma unroll
            for (int jj = 0; jj < 4; ++jj) Sacc[mt][jj] = sp[(16 * mt + jj) * 128]; }
    for (int i = tid; i < 2 * 64 * P64 / 2; i += NTHR) ((LAS unsigned*)TM)[i] = 0u;
    const float alog_e = __expf(P.in[I_GALOG][(e * 2 + dir) * 4 + hd]), dtb = P.in[I_GDTB][(e * 2 + dir) * 4 + hd];
    const int nchunk = L / 64;
    unsigned xqk[19]; bf16 xv[19]; float ab_a = 0.f, ab_b = 0.f;
#define GDN_LOAD(ci_) do { const int tid_ = tid_fresh(wid0); const int dd_ = tid_ & 127, tq_ = __builtin_amdgcn_readfirstlane(tid_ >> 7); \
        const int c0_ = dir ? L - 64 * ((ci_) + 1) : 64 * (ci_); const int tb_ = c0_ + tq_ * 16; \
        _Pragma("unroll") for (int k = 0; k < 19; ++k) { const int t = tb_ - 1 + k; const bool ok = (t >= 0) && (t < L); const bf16* rowp = proj + (size_t)(m0 + (ok ? t : tb_)) * NPROJ_E + 1024 + hd * 128 + dd_; \
            const unsigned a = rowp[0], bq = rowp[512]; const bf16 c = rowp[1024]; xqk[k] = ok ? (a | (bq << 16)) : 0u; xv[k] = ok ? c : (bf16)0; } \
        if (w == 0) { const int ln_ = tid_ & 63; const size_t m_ = (size_t)(m0 + c0_ + (dir ? 63 - ln_ : ln_)); ab_a = AB[m_ * 16 + dir * 4 + hd]; ab_b = AB[m_ * 16 + 8 + dir * 4 + hd]; } } while (0)
    GDN_LOAD(0);
#pragma unroll 1
    for (int ci = 0; ci < nchunk; ++ci) {
        const int tid = tid_fresh(wid0), lane = tid & 63, quad = lane >> 4, l15 = lane & 15;
        const int c0 = dir ? L - 64 * (ci + 1) : 64 * ci;
        LDS_BARRIER();
#ifndef NO_A
        const float cur_a = ab_a, cur_b = ab_b;
        { const int dd = tid & 127, tq = __builtin_amdgcn_readfirstlane(tid >> 7);
#pragma unroll
          for (int part = 0; part < 3; ++part) { const int ccol = part * 512 + hd * 128 + dd;
              const float* cw = P.in[I_GCONVW] + (size_t)e * 4 * 1536 + ccol; const float w0 = cw[0], w1 = cw[1536], w2 = cw[3072], w3 = cw[4608], cb = P.in[I_GCONVB][e * 1536 + ccol];
              LAS bf16* dst = part == 0 ? Qs : (part == 1 ? Ks : Vs);
#pragma unroll
              for (int n = 0; n < 16; ++n) {
                  float x0, x1, x2, x3;
                  if (part == 0) { x0 = bflo(xqk[n]); x1 = bflo(xqk[n + 1]); x2 = bflo(xqk[n + 2]); x3 = bflo(xqk[n + 3]); }
                  else if (part == 1) { x0 = bfhi(xqk[n]); x1 = bfhi(xqk[n + 1]); x2 = bfhi(xqk[n + 2]); x3 = bfhi(xqk[n + 3]); }
                  else { x0 = bf2f(xv[n]); x1 = bf2f(xv[n + 1]); x2 = bf2f(xv[n + 2]); x3 = bf2f(xv[n + 3]); }
                  const float v = cb + w0 * x0 + w1 * x1 + w2 * x2 + w3 * x3;
                  const int nn = tq * 16 + n; const int r = dir ? 63 - nn : nn;
                  dst[r * P128 + dd] = (bf16)f2bf(siluf_(v)); } } }
        if (ci + 1 < nchunk) GDN_LOAD(ci + 1);
#endif
        LDS_BARRIER();
#pragma unroll 1
        for (int repB = 0; repB < REP_B; ++repB)
        { const int rowid = tid >> 2, part = tid & 3; LAS bf16* src = (rowid < 64 ? Qs : Ks) + (rowid & 63) * P128 + part * 32;
          float ss = 0.f;
#pragma unroll
          for (int i = 0; i < 4; ++i) { const u32x4 v = *(const LAS u32x4*)(src + 8 * i);
#pragma unroll
              for (int j = 0; j < 4; ++j) { const float a = bflo(v[j]), c = bfhi(v[j]); ss += a * a + c * c; } }
          ss += shfl_i(ss, lane ^ 1); ss += shfl_i(ss, lane ^ 2);
          if (part == 0) { if (rowid < 64) rq[rowid] = rsqrtf(ss + EPSF) * 0.08838834764831845f; else rk[rowid - 64] = rsqrtf(ss + EPSF); }
          if (w == 0) { const int t = c0 + (dir ? 63 - lane : lane); const size_t m = (size_t)(m0 + t);
              const float araw = cur_a, braw = cur_b;
              const float gg = -alog_e * softplusf_(araw + dtb);
              float gc = gg;
#pragma unroll
              for (int o = 1; o < 64; o <<= 1) { const float t2 = shfl_i(gc, (lane - o) & 63); if (lane >= o) gc += t2; }
              const float glast = shfl_i(gc, 63);
              gcs[lane] = gc; betas[lane] = sigmoidf_(braw); egs[lane] = __expf(gc); kes[lane] = __expf(glast - gc);
              if (lane == 0) rq[384] = __expf(glast); } }
        LDS_BARRIER();
#ifndef NO_C
#pragma unroll 1
        for (int repC = 0; repC < REP_C; ++repC)
        { const int mt = w & 3; const bool isq = w >= 4; LAS bf16* src = isq ? Qs : Ks;
          bf16x8 a[4];
#pragma unroll
          for (int ks = 0; ks < 4; ++ks) a[ks] = *(const LAS bf16x8*)(src + (16 * mt + l15) * P128 + 32 * ks + quad * 8);
#pragma unroll 1
          for (int nt = 0; nt < 4; ++nt) { f32x4 acc = (f32x4){0.f, 0.f, 0.f, 0.f};
#pragma unroll
              for (int ks = 0; ks < 4; ++ks) { const bf16x8 bb = *(const LAS bf16x8*)(Ks + (16 * nt + l15) * P128 + 32 * ks + quad * 8); acc = mfma16(a[ks], bb, acc); }
              const int j = 16 * nt + l15; const float rkj = rk[j], gcj = gcs[j];
              f32x4 lv;
#pragma unroll
              for (int jj = 0; jj < 4; ++jj) { const int i = 16 * mt + quad * 4 + jj; const float dec = __expf(fminf(gcs[i] - gcj, 0.f));
                  lv[jj] = (i > j) ? acc[jj] * rk[i] * rkj * betas[i] * dec : 0.f;
                  if (isq) QKs[i * P64 + j] = (bf16)f2bf((i >= j) ? acc[jj] * rq[i] * rkj * dec : 0.f); }
              if (!isq) { *(LAS f32x4*)(Lm + j * LMP + 16 * mt + quad * 4) = lv;
#pragma unroll
                  for (int jj = 0; jj < 4; ++jj) LR[(16 * mt + quad * 4 + jj) * P64 + j] = (bf16)f2bf(nt < mt ? lv[jj] : 0.f); } }
          const int dd = tid & 127, tq = tid >> 7;
          unsigned pw[8];
#pragma unroll
          for (int n = 0; n < 16; n += 2) { const int i0 = tq * 16 + n; const float v0 = bf2f(Ks[i0 * P128 + dd]) * rk[i0] * kes[i0], v1 = bf2f(Ks[(i0 + 1) * P128 + dd]) * rk[i0 + 1] * kes[i0 + 1]; pw[n >> 1] = pk2(v0, v1); }
          *(LAS u32x4*)(KT + dd * P64 + tq * 16) = (u32x4){pw[0], pw[1], pw[2], pw[3]};
          *(LAS u32x4*)(KT + dd * P64 + tq * 16 + 8) = (u32x4){pw[4], pw[5], pw[6], pw[7]}; }
#endif
        LDS_BARRIER();
        { const int i = tid >> 3, c0k = (tid & 7) * 16; const float sc = rk[i] * betas[i] * egs[i];
#pragma unroll
          for (int h2 = 0; h2 < 2; ++h2) { u32x4 v = *(LAS u32x4*)(Ks + i * P128 + c0k + 8 * h2);
#pragma unroll
              for (int q = 0; q < 4; ++q) v[q] = pk2(bflo(v[q]) * sc, bfhi(v[q]) * sc);
              *(LAS u32x4*)(Ks + i * P128 + c0k + 8 * h2) = v; } }
        if (w == 0) { const int bb = lane >> 4, c = lane & 15;
            float x[16];
#pragma unroll
            for (int r = 0; r < 16; ++r) x[r] = (r == c) ? 1.f : 0.f;
#pragma unroll
            for (int j = 0; j < 15; ++j) {
#pragma unroll
                for (int q4 = j / 4; q4 < 4; ++q4) { const f32x4 l4 = *(const LAS f32x4*)(Lm + (16 * bb + j) * LMP + 16 * bb + 4 * q4);
#pragma unroll
                    for (int jx = 0; jx < 4; ++jx) if (4 * q4 + jx > j) x[4 * q4 + jx] -= l4[jx] * x[j]; } }
            unsigned pw[8];
#pragma unroll
            for (int r = 0; r < 16; r += 2) { pw[r >> 1] = pk2(x[r], x[r + 1]); TM[(16 * bb + r) * P64 + 16 * bb + c] = (bf16)(pw[r >> 1] & 0xffffu); TM[(16 * bb + r + 1) * P64 + 16 * bb + c] = (bf16)(pw[r >> 1] >> 16); }
            *(LAS u32x4*)(TT + (16 * bb + c) * P64 + 16 * bb) = (u32x4){pw[0], pw[1], pw[2], pw[3]};
            *(LAS u32x4*)(TT + (16 * bb + c) * P64 + 16 * bb + 8) = (u32x4){pw[4], pw[5], pw[6], pw[7]}; }
        LDS_BARRIER();
#pragma unroll 1
        for (int lev = 1; lev < 4; ++lev) {
            if (w < 4 - lev) { const int bj = w, bi = w + lev;
                f32x4 m = (f32x4){0.f, 0.f, 0.f, 0.f};
#pragma unroll
                for (int ks = 0; ks < 2; ++ks) { const bf16x8 a = *(const LAS bf16x8*)(LR + (16 * bi + l15) * P64 + 32 * ks + quad * 8), bq = *(const LAS bf16x8*)(TT + (16 * bj + l15) * P64 + 32 * ks + quad * 8); m = mfma16(a, bq, m); }
                const u32x2 tl = *(const LAS u32x2*)(TM + (16 * bi + l15) * P64 + 16 * bi + quad * 4);
                const bf16x8 a2 = __builtin_bit_cast(bf16x8, (u32x4){tl.x, tl.y, 0u, 0u}), b2 = __builtin_bit_cast(bf16x8, (u32x4){pk2(m[0], m[1]), pk2(m[2], m[3]), 0u, 0u});
                const f32x4 t = mfma16(a2, b2, (f32x4){0.f, 0.f, 0.f, 0.f});
                const unsigned p0 = pk2(-t[0], -t[1]), p1 = pk2(-t[2], -t[3]);
                TM[(16 * bi + quad * 4 + 0) * P64 + 16 * bj + l15] = (bf16)(p0 & 0xffffu); TM[(16 * bi + quad * 4 + 1) * P64 + 16 * bj + l15] = (bf16)(p0 >> 16);
                TM[(16 * bi + quad * 4 + 2) * P64 + 16 * bj + l15] = (bf16)(p1 & 0xffffu); TM[(16 * bi + quad * 4 + 3) * P64 + 16 * bj + l15] = (bf16)(p1 >> 16);
                *(LAS u32x2*)(TT + (16 * bj + l15) * P64 + 16 * bi + quad * 4) = (u32x2){p0, p1}; }
            LDS_BARRIER();
        }
#ifndef NO_EFG
        bf16x8 Bst[4];
#pragma unroll
        for (int ks = 0; ks < 4; ++ks) Bst[ks] = pack_acc2(Sacc[2 * ks], Sacc[2 * ks + 1]);
        f32x4 vn[4];
#pragma unroll
        for (int mt = 0; mt < 4; ++mt) { f32x4 acc = (f32x4){0.f, 0.f, 0.f, 0.f};
#pragma unroll
            for (int ks = 0; ks < 4; ++ks) { const bf16x8 a = ld_split8(Ks + (16 * mt + l15) * P128 + 32 * ks + quad * 4); acc = mfma16(a, Bst[ks], acc); }
#pragma unroll
            for (int jj = 0; jj < 4; ++jj) { const int i = 16 * mt + quad * 4 + jj; vn[mt][jj] = bf2f(Vs[i * P128 + 16 * w + l15]) * betas[i] - acc[jj]; } }
        bf16x8 Bvn[2];
#pragma unroll
        for (int k2 = 0; k2 < 2; ++k2) Bvn[k2] = pack_acc2(vn[2 * k2], vn[2 * k2 + 1]);
#pragma unroll
        for (int mt = 0; mt < 4; ++mt) { f32x4 acc = (f32x4){0.f, 0.f, 0.f, 0.f};
#pragma unroll
            for (int k2 = 0; k2 < 2; ++k2) { const bf16x8 a = ld_split8(TM + (16 * mt + l15) * P64 + 32 * k2 + quad * 4); acc = mfma16(a, Bvn[k2], acc); }
            vn[mt] = acc; }
#pragma unroll
        for (int k2 = 0; k2 < 2; ++k2) Bvn[k2] = pack_acc2(vn[2 * k2], vn[2 * k2 + 1]);
#pragma unroll 1
        for (int mt = 0; mt < 4; ++mt) { f32x4 acc = (f32x4){0.f, 0.f, 0.f, 0.f};
#pragma unroll
            for (int ks = 0; ks < 4; ++ks) { const bf16x8 a = ld_split8(Qs + (16 * mt + l15) * P128 + 32 * ks + quad * 4); acc = mfma16(a, Bst[ks], acc); }
#pragma unroll
            for (int jj = 0; jj < 4; ++jj) { const int i = 16 * mt + quad * 4 + jj; acc[jj] *= rq[i] * egs[i]; }
#pragma unroll
            for (int k2 = 0; k2 < 2; ++k2) { const bf16x8 a = ld_split8(QKs + (16 * mt + l15) * P64 + 32 * k2 + quad * 4); acc = mfma16(a, Bvn[k2], acc); }
#pragma unroll
            for (int jj = 0; jj < 4; ++jj) { const int i = 16 * mt + quad * 4 + jj; const int t = c0 + (dir ? 63 - i : i);
                Odir[(size_t)(m0 + t) * 512 + hd * 128 + 16 * w + l15] = (bf16)f2bf(acc[jj]); } }
        const float egl = rq[384];
#pragma unroll
        for (int mt = 0; mt < 8; ++mt) { f32x4 acc = Sacc[mt] * egl;
#pragma unroll
            for (int k2 = 0; k2 < 2; ++k2) { const bf16x8 a = ld_split8(KT + (16 * mt + l15) * P64 + 32 * k2 + quad * 4); acc = mfma16(a, Bvn[k2], acc); }
            Sacc[mt] = acc; }
#endif
        WAVE_SYNC();
    }
    if (!lat) { const int tid2 = tid_fresh(wid0), lane2 = tid2 & 63; float* dp = P.out + OUT_DELTA + sbase + (size_t)((lane2 >> 4) * 4) * 128 + 16 * w + (lane2 & 15);
#pragma unroll
        for (int mt = 0; mt < 8; ++mt)
#pragma unroll
            for (int jj = 0; jj < 4; ++jj) dp[(16 * mt + jj) * 128] = Sacc[mt][jj];
    }
    __syncthreads();
}

__device__ __forceinline__ void phase_mix_even(int wid0, const Params& P, LAS unsigned char* lds, int e, int mode = 3) {
    const int bid = bid_fresh(), G = grid_fresh();
    if (G == 256) {
        if (bid < 64) { const int s = 32 + (bid >> 3), hd = (bid >> 1) & 3, dir = bid & 1; if (mode & 1) gdn_chain(wid0, P, lds, e, s, hd, dir); }
        else { const int bb = bid - 64;
            if (mode & 1) for (int c = bb; c < 256; c += 192) { const int s = c >> 3, hd = (c >> 1) & 3, dir = c & 1; gdn_chain(wid0, P, lds, e, s, hd, dir); }
            if (mode & 2) { const int tid = tid_fresh(wid0), lane = tid & 63, wave = tid >> 6;
                for (int t = bb; t < 384; t += 192) { const int wt = t * 8 + wave; s5_task_main(P, lds + wave * S5_WLDS, lane, e, wt >> 5, wt & 31); } } }
    } else {
        for (int c = bid; c < 320; c += G) { const int s = c < 64 ? 32 + (c >> 3) : ((c - 64) >> 3), hd = (c >> 1) & 3, dir = c & 1; gdn_chain(wid0, P, lds, e, s, hd, dir); }
        const int tid = tid_fresh(wid0), lane = tid & 63, wave = tid >> 6;
        for (int t = bid; t < 384; t += G) { const int wt = t * 8 + wave; s5_task_main(P, lds + wave * S5_WLDS, lane, e, wt >> 5, wt & 31); }
    }
}
__device__ __forceinline__ void phase_fin_even(int wid0, const Params& P, LAS unsigned char* lds, int e) {
    const int tid = tid_fresh(wid0), lane = tid & 63, wave = tid >> 6;
    const int gw = bid_fresh() * NWAVES + wave, NGW = grid_fresh() * NWAVES;
    for (int wt = gw; wt < 2048; wt += NGW) s5_task_corr(P, lds + wave * S5_WLDS, lane, e, wt >> 5, wt & 31);
    const bf16* proj = (const bf16*)(P.ws + WS_BIG); const bf16* Of = (const bf16*)(P.ws + WS_H); const bf16* Ob = Of + (size_t)MT * 512; bf16* mixout = (bf16*)(P.ws + WS_MIX);
    for (int m = gw; m < MT; m += NGW) {
        const u32x4 a = *(const u32x4*)(Of + (size_t)m * 512 + lane * 8), bq = *(const u32x4*)(Ob + (size_t)m * 512 + lane * 8), z = *(const u32x4*)(proj + (size_t)m * NPROJ_E + 2560 + lane * 8);
        float o[8]; float ss = 0.f;
#pragma unroll
        for (int j = 0; j < 4; ++j) { o[2 * j] = bflo(a[j]) + bflo(bq[j]); o[2 * j + 1] = bfhi(a[j]) + bfhi(bq[j]); ss += o[2 * j] * o[2 * j] + o[2 * j + 1] * o[2 * j + 1]; }
        ss += shfl_i(ss, lane ^ 1); ss += shfl_i(ss, lane ^ 2); ss += shfl_i(ss, lane ^ 4); ss += shfl_i(ss, lane ^ 8);
        const float rs = rsqrtf(ss * (1.0f / 128.0f) + EPSF);
        const float* gn = P.in[I_GONORM] + e * 128 + (lane & 15) * 8;
        unsigned pw[4];
#pragma unroll
        for (int j = 0; j < 4; ++j) { const float z0 = bflo(z[j]), z1 = bfhi(z[j]); pw[j] = pk2(o[2 * j] * rs * gn[2 * j] * siluf_(z0), o[2 * j + 1] * rs * gn[2 * j + 1] * siluf_(z1)); }
        *(u32x4*)(mixout + (size_t)m * DM + 512 + lane * 8) = (u32x4){pw[0], pw[1], pw[2], pw[3]};
    }
}

__device__ __forceinline__ void phase_conv_odd(int wid0, const Params& P, int o) {
    const int tid = tid_fresh(wid0), lane = tid & 63, wave = tid >> 6;
    const int gw = bid_fresh() * NWAVES + wave, NGW = grid_fresh() * NWAVES;
    const bf16* proj = (const bf16*)(P.ws + WS_BIG); bf16* cx = (bf16*)(P.ws + WS_H);
    const float* cw = P.in[I_LCONVW] + (size_t)o * 4 * 1024; const float* cb = P.in[I_LCONVB] + o * 1024;
    for (int m = gw; m < MT; m += NGW) {
        const int t = m < MCTX ? (m & 255) : ((m - MCTX) & 2047); const int L = m < MCTX ? LCTX : LLAT;
#pragma unroll
        for (int h2 = 0; h2 < 2; ++h2) { const int ch = lane * 8 + 512 * h2;
            float acc[8];
#pragma unroll
            for (int j = 0; j < 8; ++j) acc[j] = cb[ch + j];
#pragma unroll
            for (int k = 0; k < 4; ++k) { const int tt = t - 1 + k; if (tt >= 0 && tt < L) { const u32x4 v = *(const u32x4*)(proj + (size_t)(m - 1 + k) * 2048 + ch);
#pragma unroll
                    for (int j = 0; j < 4; ++j) { acc[2 * j] += cw[k * 1024 + ch + 2 * j] * bflo(v[j]); acc[2 * j + 1] += cw[k * 1024 + ch + 2 * j + 1] * bfhi(v[j]); } } }
            *(u32x4*)(cx + (size_t)m * DM + ch) = (u32x4){pk2(acc[0], acc[1]), pk2(acc[2], acc[3]), pk2(acc[4], acc[5]), pk2(acc[6], acc[7])}; }
    }
}
__device__ __forceinline__ void phase_lru_scan(int wid0, const Params& P, int o, int d) {
    const int tid = tid_fresh(wid0), lane = tid & 63, wave = tid >> 6;
    const int gw = bid_fresh() * NWAVES + wave, NGW = grid_fresh() * NWAVES;
    const unsigned* G = (const unsigned*)(P.ws + WS_GATES); const bf16* proj = (const bf16*)(P.ws + WS_BIG); bf16* mixout = (bf16*)(P.ws + WS_MIX);
    for (int task = gw; task < 640; task += NGW) {
        int s, cg_;
        if (task < 128) { s = 32 + (task >> 4); cg_ = task & 15; } else { s = (task - 128) >> 4; cg_ = (task - 128) & 15; }
        const bool lat = s >= 32; const int b = lat ? s - 32 : s; const int L = lat ? LLAT : LCTX; const int m0 = lat ? MCTX + b * LLAT : s * LCTX;
        const int ch = cg_ * 64 + lane;
        float h = lat ? P.in[I_SLRU][(((size_t)b * 2 + o) * 2 + d) * 1024 + ch] : 0.f;
        if (d == 0) {
            unsigned ga[32], gb[32];
#define LRU_LD0(dst, tt) _Pragma("unroll") for (int i = 0; i < 32; ++i) dst[i] = G[(size_t)(m0 + (tt) + i) * DM + ch]
#define LRU_CP0(src, tt) _Pragma("unroll") for (int i = 0; i < 32; ++i) { h = __builtin_amdgcn_exp2f(bflo(src[i])) * h + bfhi(src[i]); mixout[(size_t)(m0 + (tt) + i) * DM + ch] = (bf16)f2bf(h); }
            LRU_LD0(ga, 0);
            for (int t0 = 0; t0 < L; t0 += 64) {
                LRU_LD0(gb, t0 + 32);
                LRU_CP0(ga, t0);
                if (t0 + 64 < L) { LRU_LD0(ga, t0 + 64); }
                LRU_CP0(gb, t0 + 32);
            }
        } else {
            unsigned ga[16], gb[16]; bf16 pa[16], pb[16], ya[16], yb[16];
#define LRU_LD1(g_, p_, y_, tt) _Pragma("unroll") for (int i = 0; i < 16; ++i) { const size_t m = (size_t)(m0 + L - 1 - ((tt) + i)); g_[i] = G[m * DM + ch]; p_[i] = mixout[m * DM + ch]; y_[i] = proj[m * 2048 + 1024 + ch]; }
#define LRU_CP1(g_, p_, y_, tt) _Pragma("unroll") for (int i = 0; i < 16; ++i) { const size_t m = (size_t)(m0 + L - 1 - ((tt) + i)); \
                h = __builtin_amdgcn_exp2f(bflo(g_[i])) * h + bfhi(g_[i]); mixout[m * DM + ch] = (bf16)f2bf((bf2f(p_[i]) + h) * geluf_(bf2f(y_[i]))); }
            LRU_LD1(ga, pa, ya, 0);
            for (int t0 = 0; t0 < L; t0 += 32) {
                LRU_LD1(gb, pb, yb, t0 + 16);
                LRU_CP1(ga, pa, ya, t0);
                if (t0 + 32 < L) { LRU_LD1(ga, pa, ya, t0 + 32); }
                LRU_CP1(gb, pb, yb, t0 + 16);
            }
        }
        if (!lat) P.out[OUT_LRU + (((size_t)b * 2 + o) * 2 + d) * 1024 + ch] = h;
    }
}
#ifdef PROBE_DUP_GEMM
#define DUPG(x) GSYNC(); x
#else
#define DUPG(x)
#endif
typedef const __attribute__((address_space(4))) Params* KParams;
__device__ __forceinline__ Params load_params(KParams q) { Params r;
#pragma unroll
    for (int i = 0; i < 40; ++i) r.in[i] = q->in[i];
    r.out = q->out; r.ws = q->ws; return r; }
#define FRESH() const int G = grid_fresh(), bid = bid_fresh(); (void)G; (void)bid; KParams pk_ = (KParams)__builtin_amdgcn_kernarg_segment_ptr(); asm volatile("" : "+s"(pk_)); const Params P = load_params(pk_); unsigned char* ws = P.ws; \
    const float* mod = (const float*)(ws + WS_MOD); bf16* H = (bf16*)(ws + WS_H); bf16* BIG = (bf16*)(ws + WS_BIG); bf16* MIX = (bf16*)(ws + WS_MIX); (void)mod; (void)H; (void)BIG; (void)MIX;
#define GSYNC() do { KParams pb_ = (KParams)__builtin_amdgcn_kernarg_segment_ptr(); asm volatile("" : "+s"(pb_)); xcd_barrier(wid0, (unsigned*)(pb_->ws + WS_BAR), lds); } while (0)
__global__ void __launch_bounds__(NTHR, 2) fwd_kernel(Params Parg) {
    extern __shared__ __attribute__((aligned(16))) unsigned char lds_raw[];
    LAS unsigned char* lds = (LAS unsigned char*)lds_raw;
    cg::grid_group grid = cg::this_grid();
    const int wid0 = __builtin_amdgcn_readfirstlane(threadIdx.x >> 6);
    if (threadIdx.x < 4) ((LAS unsigned*)(lds + LDS_BARST))[threadIdx.x] = 0u;
    __syncthreads();
    if (threadIdx.x == 0) (void)xb_add((unsigned*)(Parg.ws + WS_BAR) + XB_XCNT(xb_xcc_id()), 1u);

    { FRESH(); phase_prologue(wid0, P, lds); }
    if (grid_fresh() == 0) grid.sync();
    GSYNC();
#ifdef PROBE_DUP_PRO
    { FRESH(); phase_prologue(wid0, P, lds); }
    GSYNC();
#endif
    { FRESH(); phase_modreduce(wid0, P); }
    GSYNC();
#ifdef PROBE_SYNC
#pragma unroll 1
    for (int i = 0; i < 40; ++i) GSYNC();
#endif
#pragma unroll 1
    for (int l = 0; l < 4; ++l) {
        { FRESH(); const float* modl = mod + (size_t)l * 9 * 6144;
        phase_rownorm(wid0, P, l == 0, MIX, modl - 9 * 6144, 5 * 1024, P.in[I_NMLPPOST] + (l > 0 ? (l - 1) * 1024 : 0), 1, P.in[I_NMIXPRE] + l * 1024, modl, 0, H); }
        GSYNC();
        const int eo = l >> 1;
        {
            FRESH();
            pg8::Gemm g; pg8::StaticOrder S; EpiBf16<0> E;
            if ((l & 1) == 0) { g = pg8::Gemm{H, (const bf16*)(ws + WS_WINE) + (size_t)eo * NB_E * 1024, MT, NB_E, 1024, 1024, 0, 0, 1024, 0}; E = EpiBf16<0>{BIG, NPROJ_E, (float*)(ws + WS_AB)}; }
            else { g = pg8::Gemm{H, (const bf16*)(ws + WS_WINO) + (size_t)eo * 2048 * 1024, MT, 2048, 1024, 1024, 0, 0, 1024, 0}; E = EpiBf16<0>{BIG, 2048, nullptr}; }
            S.init(g.M, g.N, G, bid);
            pg8::gemm_phase(wid0, lds, g, S, E); DUPG(pg8::gemm_phase(wid0, lds, g, S, E);)
        }
        GSYNC();
        if ((l & 1) == 0) {
#ifdef PROBE_DUP_MIX
#pragma unroll 1
            for (int rep = 0; rep < 2; ++rep) { { FRESH(); phase_mix_even(wid0, P, lds, eo, rep == 0 ? 3 : PROBE_DUP_MIX); } GSYNC(); }
#else
            { FRESH(); phase_mix_even(wid0, P, lds, eo); }
            GSYNC();
#endif
            { FRESH(); phase_fin_even(wid0, P, lds, eo); }
            GSYNC();
        } else {
            { FRESH(); phase_conv_odd(wid0, P, eo); }
            GSYNC();
#ifdef PROBE_DUP_CONV
            { FRESH(); phase_conv_odd(wid0, P, eo); }
            GSYNC();
#endif
#pragma unroll 1
            for (int d = 0; d < 2; ++d) {
                { FRESH();
                pg8::Gemm g{H, (const bf16*)(ws + WS_WG) + (size_t)(eo * 2 + d) * 2048 * 256, MT, 2048, 256, 1024, 1, 1, 256, 0};
                EpiGates E{(unsigned*)(ws + WS_GATES), H, P.in[I_LBR] + (eo * 2 + d) * 1024, P.in[I_LBI] + (eo * 2 + d) * 1024, P.in[I_LLAM] + (eo * 2 + d) * 1024};
                pg8::StaticOrder S; S.init(g.M, g.N, G, bid);
                pg8::gemm_phase(wid0, lds, g, S, E); DUPG(pg8::gemm_phase(wid0, lds, g, S, E);) }
                GSYNC();
                { FRESH(); phase_lru_scan(wid0, P, eo, d); }
#ifdef PROBE_DUP_LRU0
                if (d == 0) { GSYNC(); FRESH(); phase_lru_scan(wid0, P, eo, d); }
#endif
                GSYNC();
            }
        }
        {
            FRESH();
            pg8::Gemm g{MIX, (const bf16*)(ws + ((l & 1) ? WS_WOUTO : WS_WOUTE)) + (size_t)eo * 1024 * 1024, MT, 1024, 1024, 1024, 0, 0, 1024, 0};
            EpiBf16<0> E{BIG, 1024, nullptr}; pg8::StaticOrder S; S.init(g.M, g.N, G, bid);
            pg8::gemm_phase(wid0, lds, g, S, E); DUPG(pg8::gemm_phase(wid0, lds, g, S, E);)
        }
        GSYNC();
        { FRESH(); const float* modl = mod + (size_t)l * 9 * 6144;
        phase_rownorm(wid0, P, 0, BIG, modl, 2 * 1024, P.in[I_NMIXPOST] + l * 1024, 1, P.in[I_NMLPPRE] + l * 1024, modl, 3 * 1024, H); }
        GSYNC();
        {
            FRESH();
            pg8::Gemm g{H, (const bf16*)(ws + WS_W1T) + (size_t)l * 4096 * 1024, MT, 4096, 1024, 1024, 0, 0, 1024, 0};
            EpiBf16<1> E{BIG, 4096, nullptr}; pg8::StaticOrder S; S.init(g.M, g.N, G, bid);
            pg8::gemm_phase(wid0, lds, g, S, E); DUPG(pg8::gemm_phase(wid0, lds, g, S, E);)
        }
        GSYNC();
        {
            FRESH();
            pg8::Gemm g{BIG, (const bf16*)(ws + WS_W2T) + (size_t)l * 1024 * 4096, MT, 1024, 4096, 4096, 0, 0, 4096, 0};
            EpiBf16<0> E{MIX, 1024, nullptr}; pg8::StaticOrder S; S.init(g.M, g.N, G, bid);
            pg8::gemm_phase(wid0, lds, g, S, E); DUPG(pg8::gemm_phase(wid0, lds, g, S, E);)
        }
        GSYNC();
    }
    { FRESH();
    phase_rownorm(wid0, P, 0, MIX, mod + (size_t)3 * 9 * 6144, 5 * 1024, P.in[I_NMLPPOST] + 3 * 1024, 0, P.in[I_NMIXPRE], mod, 0, H); }
}

extern "C" void kernel_launch(void* const* d_in, const int* in_sizes, int n_in, void* d_out, int out_size, void* d_ws, size_t ws_size, hipStream_t stream) {
    static int grid = 0;
    if (grid == 0) {
        if (n_in != 40 || ws_size < WS_END) { fprintf(stderr, "kernel_launch: expected 40 inputs and >= %zu bytes of workspace (got %d, %zu)\n", (size_t)WS_END, n_in, ws_size); grid = -1; return; }
        int dev = 0, cus = 0, per_cu = 0;
        if (hipGetDevice(&dev) != hipSuccess || hipDeviceGetAttribute(&cus, hipDeviceAttributeMultiprocessorCount, dev) != hipSuccess) { grid = -1; return; }
        if (hipFuncSetAttribute((const void*)fwd_kernel, hipFuncAttributeMaxDynamicSharedMemorySize, LDS_BYTES) != hipSuccess) { fprintf(stderr, "kernel_launch: hipFuncSetAttribute failed\n"); grid = -1; return; }
        if (hipOccupancyMaxActiveBlocksPerMultiprocessor(&per_cu, (const void*)fwd_kernel, NTHR, LDS_BYTES) != hipSuccess || per_cu < 1) per_cu = 1;
        (void)hipGetLastError();
        grid = cus * per_cu; if (grid > 256) grid = 256;
    }
    if (grid < 0) return;
    (void)hipMemsetAsync((char*)d_ws + WS_BAR, 0, 16384, stream);
    Params p{};
    for (int i = 0; i < 40; ++i) p.in[i] = (const float*)d_in[i];
    p.out = (float*)d_out; p.ws = (unsigned char*)d_ws;
    void* args[] = {&p};
    hipError_t e = hipLaunchCooperativeKernel((const void*)fwd_kernel, dim3(grid), dim3(NTHR), args, LDS_BYTES, stream);
    if (e != hipSuccess) fprintf(stderr, "cooperative launch failed: %s (grid %d)\n", hipGetErrorString(e), grid);
}
```

```cpp
#include <hip/hip_runtime.h>
#include <hip/hip_cooperative_groups.h>
#include <cstdio>
#include <cstdint>
namespace cg = cooperative_groups;
__device__ __forceinline__ int bid_fresh() { int t = blockIdx.x; asm volatile("" : "+s"(t)); return t; }
__device__ __forceinline__ int grid_fresh() { int t = gridDim.x; asm volatile("" : "+s"(t)); return t; }
__device__ __forceinline__ int tid_fresh(int w) { asm volatile("" : "+s"(w)); int l; asm volatile("v_mbcnt_lo_u32_b32 %0, -1, 0\n\tv_mbcnt_hi_u32_b32 %0, -1, %0" : "=v"(l)); return w * 64 + l; }

namespace pg8 {
#define PG8_LAS __attribute__((address_space(3)))
typedef unsigned short bf16_t;
typedef short bf16x8 __attribute__((ext_vector_type(8)));
typedef float f32x4 __attribute__((ext_vector_type(4)));
typedef unsigned u32x4 __attribute__((ext_vector_type(4)));
typedef unsigned u32x2 __attribute__((ext_vector_type(2)));
constexpr int BM = 256, BK = 64, HALF = 128, HTB = HALF * BK * 2, STAGE_BYTES = 8 * HTB, NXCD = 8, WGM = 8;

__host__ __device__ __forceinline__ int lds_byte(int r, int c) { const int st = (r >> 4) * 2 + (c >> 5), rr = r & 15, cc = c & 31, ob = rr * 64 + cc * 2; return st * 1024 + (ob ^ (((ob >> 9) & 1) << 5)); }
__host__ __device__ __forceinline__ void stage_rc(int b, int& R, int& C) { const int st = b / 1024, sb = b % 1024, swz = sb ^ (((sb >> 9) & 1) << 5); R = (st >> 1) * 16 + swz / 64; C = (st & 1) * 32 + (swz % 64) / 2; }
__host__ __device__ __forceinline__ int perm32(int rho) { const int n = rho >> 4, i = rho & 15; return 8 * (i >> 2) + 4 * n + (i & 3); }

struct Unit { int pm, pn; };
struct Gemm { const bf16_t* A; const bf16_t* Bt; int M, N, K, lda, ablk, ashift, ldb, ksplit; };

struct StaticOrder {
    int nM, nN, nwg, G, c;
    __host__ __device__ void init(int M, int N, int G_, int c_) { nM = M / BM; nN = N / BM; nwg = nM * nN; G = G_; c = c_; }
    __host__ __device__ bool next(int i, Unit& u) const {
        const long L = (long)i * G + c; if (L >= nwg) return false;
        int wgid = (int)L; { const int q = nwg / NXCD, r = nwg % NXCD, xcd = wgid % NXCD, off = wgid / NXCD; wgid = (xcd < r ? xcd * (q + 1) : r * (q + 1) + (xcd - r) * q) + off; }
        const int nig = WGM * nN, gid = wgid / nig, fm = gid * WGM, gsz = (nM - fm) < WGM ? (nM - fm) : WGM;
        u.pm = fm + ((wgid % nig) % gsz); u.pn = (wgid % nig) / gsz; return true;
    }
};
__device__ __forceinline__ unsigned cvt_pk_bf16(float lo, float hi) { unsigned r; asm volatile("v_cvt_pk_bf16_f32 %0, %1, %2" : "=v"(r) : "v"(lo), "v"(hi)); return r; }

template <class Epi>
__device__ __forceinline__ void gemm_phase(int wid0, PG8_LAS unsigned char* lds, const Gemm g, const StaticOrder& S, const Epi& E) {
    const int tid = tid_fresh(wid0), wid = __builtin_amdgcn_readfirstlane(tid >> 6), lane = tid & 63, wr = wid >> 2, wc = wid & 3, fr = lane & 15, fq = lane >> 4;
    const int K = g.K, nt = K / BK, lda = g.lda, ldb = g.ldb;
    unsigned voffA[2], voffB[2];
#pragma unroll
    for (int i = 0; i < 2; ++i) { int R, C; stage_rc(tid * 16 + i * 8192, R, C); const int Rb = (R & ~31) + perm32(R & 31);
        voffA[i] = (unsigned)(R * lda + C) * 2u; voffB[i] = (unsigned)(Rb * ldb + C) * 2u; }
    const size_t kstep = (size_t)(BK * 2);
    const size_t hstepA = (size_t)HALF * lda * 2, hstepB = (size_t)HALF * ldb * 2;
    const size_t tstepA = 2 * hstepA, tstepB = 2 * hstepB;
    const unsigned ldsw = (unsigned)wid * 1024u;
    const int aoff = lds_byte(wr * 64 + fr, fq * 8), boff = lds_byte(wc * 32 + fr, fq * 8);
#define PG8_ACOL(pn) (g.ablk ? (size_t)((((pn) >> g.ashift) & 3) * 512) : (g.ksplit ? (size_t)((pn) & 1) * (size_t)K * 2 : (size_t)0))
#define PG8_BOFF(pn) (g.ksplit ? (size_t)((pn) >> 1) * tstepB + (size_t)((pn) & 1) * (size_t)K * 2 : (size_t)(pn) * tstepB)
#define PG8_SA(b, h) (((b) * 2 + (h)) * HTB)
#define PG8_SB(b, h) ((4 + (b) * 2 + (h)) * HTB)
#define PG8_STAGE(bufoff, gbase, voff) do { _Pragma("unroll") for (int _i = 0; _i < 2; ++_i) \
        __builtin_amdgcn_global_load_lds((const unsigned*)((const char*)(gbase) + (voff)[_i]), (PG8_LAS unsigned*)(lds + (bufoff) + ldsw + _i * 8192), 16, 0, 0); } while (0)
#define PG8_LDA(dst, b, h) do { _Pragma("unroll") for (int m = 0; m < 4; ++m) _Pragma("unroll") for (int k = 0; k < 2; ++k) dst[m][k] = *(const PG8_LAS bf16x8*)(lds + PG8_SA(b, h) + aoff + m * 2048 + k * 1024); } while (0)
#define PG8_LDB(dst, b, h) do { _Pragma("unroll") for (int n = 0; n < 2; ++n) _Pragma("unroll") for (int k = 0; k < 2; ++k) dst[n][k] = *(const PG8_LAS bf16x8*)(lds + PG8_SB(b, h) + boff + n * 2048 + k * 1024); } while (0)
#define PG8_MMA(ai, bj, At, Bt) do { __builtin_amdgcn_s_setprio(1); _Pragma("unroll") for (int m = 0; m < 4; ++m) _Pragma("unroll") for (int n = 0; n < 2; ++n) _Pragma("unroll") for (int k = 0; k < 2; ++k) \
        acc[ai][bj][m][n] = __builtin_amdgcn_mfma_f32_16x16x32_bf16(Bt[n][k], At[m][k], acc[ai][bj][m][n], 0, 0, 0); __builtin_amdgcn_s_setprio(0); } while (0)
#define PG8_WAIT_V(n) asm volatile("s_waitcnt vmcnt(" #n ")" ::: "memory")
#define PG8_WAIT_L(n) asm volatile("s_waitcnt lgkmcnt(" #n ")" ::: "memory")
#define PG8_BAR __builtin_amdgcn_s_barrier()
#define PG8_SCHED __builtin_amdgcn_sched_barrier(0)
    Unit cur, nxt; int ui = 0;
    if (!S.next(0, cur)) return;
    f32x4 acc[2][2][4][2];
#pragma unroll
    for (int a = 0; a < 2; ++a)
#pragma unroll
        for (int b = 0; b < 2; ++b)
#pragma unroll
            for (int m = 0; m < 4; ++m)
#pragma unroll
                for (int n = 0; n < 2; ++n) acc[a][b][m][n] = (f32x4){0.f, 0.f, 0.f, 0.f};
    bf16x8 At[4][2], B0[2][2], B1[2][2];
    const char* cA = (const char*)g.A + (size_t)cur.pm * tstepA + PG8_ACOL(cur.pn); const char* cB = (const char*)g.Bt + PG8_BOFF(cur.pn);
    PG8_STAGE(PG8_SB(0, 0), cB, voffB); PG8_STAGE(PG8_SA(0, 0), cA, voffA); PG8_STAGE(PG8_SB(0, 1), cB + hstepB, voffB); PG8_STAGE(PG8_SA(0, 1), cA + hstepA, voffA);
    if (wr == 1) PG8_BAR;
    PG8_WAIT_V(4); PG8_BAR;
    PG8_STAGE(PG8_SB(1, 0), cB + kstep, voffB); PG8_STAGE(PG8_SA(1, 0), cA + kstep, voffA); PG8_STAGE(PG8_SB(1, 1), cB + hstepB + kstep, voffB);
    PG8_WAIT_V(6); PG8_BAR;
    for (;;) {
        const bool has_next = S.next(ui + 1, nxt);
        const char* nA = has_next ? (const char*)g.A + (size_t)nxt.pm * tstepA + PG8_ACOL(nxt.pn) : cA; const char* nB = has_next ? (const char*)g.Bt + PG8_BOFF(nxt.pn) : cB;
        for (int t = 0; t < nt; t += 2) {
            const bool last = (t == nt - 2);
            const char* a1 = cA + (size_t)(t + 1) * kstep;
            const char* a2 = last ? nA : cA + (size_t)(t + 2) * kstep; const char* b2 = last ? nB : cB + (size_t)(t + 2) * kstep;
            const char* a3 = a2 + kstep; const char* b3 = b2 + kstep;
            PG8_LDB(B0, 0, 0); PG8_SCHED; PG8_LDA(At, 0, 0); PG8_STAGE(PG8_SA(1, 1), a1 + hstepA, voffA);
            PG8_WAIT_L(8); PG8_BAR; PG8_WAIT_L(0); PG8_MMA(0, 0, At, B0); PG8_BAR; PG8_SCHED;
            PG8_LDB(B1, 0, 1); PG8_STAGE(PG8_SB(0, 0), b2, voffB);
            PG8_BAR; PG8_WAIT_L(0); PG8_MMA(0, 1, At, B1); PG8_BAR;
            PG8_LDA(At, 0, 1); PG8_STAGE(PG8_SA(0, 0), a2, voffA);
            PG8_BAR; PG8_WAIT_L(0); PG8_MMA(1, 0, At, B0); PG8_BAR; PG8_SCHED;
            PG8_STAGE(PG8_SB(0, 1), b2 + hstepB, voffB);
            PG8_WAIT_V(6); PG8_BAR; PG8_MMA(1, 1, At, B1); PG8_BAR;
            PG8_LDB(B0, 1, 0); PG8_SCHED; PG8_LDA(At, 1, 0); PG8_STAGE(PG8_SA(0, 1), a2 + hstepA, voffA);
            PG8_WAIT_L(8); PG8_BAR; PG8_WAIT_L(0); PG8_MMA(0, 0, At, B0); PG8_BAR; PG8_SCHED;
            PG8_LDB(B1, 1, 1); PG8_STAGE(PG8_SB(1, 0), b3, voffB);
            PG8_BAR; PG8_WAIT_L(0); PG8_MMA(0, 1, At, B1); PG8_BAR;
            PG8_LDA(At, 1, 1); PG8_STAGE(PG8_SA(1, 0), a3, voffA);
            PG8_BAR; PG8_WAIT_L(0); PG8_MMA(1, 0, At, B0); PG8_BAR; PG8_SCHED;
            PG8_STAGE(PG8_SB(1, 1), b3 + hstepB, voffB);
            PG8_WAIT_V(6); PG8_BAR; PG8_MMA(1, 1, At, B1); PG8_BAR;
        }
        E(acc, cur, wr, wc, fr, fq);
        if (!has_next) break;
#pragma unroll
        for (int a = 0; a < 2; ++a)
#pragma unroll
            for (int b = 0; b < 2; ++b)
#pragma unroll
                for (int m = 0; m < 4; ++m)
#pragma unroll
                    for (int n = 0; n < 2; ++n) acc[a][b][m][n] = (f32x4){0.f, 0.f, 0.f, 0.f};
        cur = nxt; cA = nA; cB = nB; ++ui;
    }
    PG8_WAIT_V(0);
    if (wr == 0) PG8_BAR;
    PG8_BAR;
#undef PG8_ACOL
#undef PG8_BOFF
#undef PG8_SA
#undef PG8_SB
#undef PG8_STAGE
#undef PG8_LDA
#undef PG8_LDB
#undef PG8_MMA
#undef PG8_WAIT_V
#undef PG8_WAIT_L
#undef PG8_BAR
#undef PG8_SCHED
}
}
#define LAS __attribute__((address_space(3)))
typedef unsigned short bf16;
typedef short bf16x8 __attribute__((ext_vector_type(8)));
typedef float f32x4 __attribute__((ext_vector_type(4)));
typedef unsigned u32x4 __attribute__((ext_vector_type(4)));
typedef unsigned u32x2 __attribute__((ext_vector_type(2)));
constexpr int DM = 1024, MT = 24576, MCTX = 8192, LCTX = 256, LLAT = 2048, NWAVES = 8, NTHR = 512;
constexpr int NPROJ_E = 3072, NB_E = 3328, IN_EVEN_LD = 3088;
constexpr float EPSF = 1e-6f;
constexpr size_t MiB = 1u << 20;
constexpr size_t WS_MOD = 0, MOD_BYTES = 4 * 9 * 6144 * 4, WS_S5F = 1 * MiB, WS_AB = 3 * MiB, WS_W1T = 5 * MiB, WS_W2T = 37 * MiB, WS_WINE = 69 * MiB,
                 WS_WOUTE = 82 * MiB, WS_WINO = 86 * MiB, WS_WOUTO = 94 * MiB, WS_WG = 98 * MiB, WS_H = 102 * MiB, WS_BIG = 150 * MiB, WS_YBUF = 294 * MiB,
                 WS_GATES = 246 * MiB, WS_MIX = 342 * MiB, WS_HALO = 390 * MiB, WS_END = 390 * MiB + 384 * 3 * 1536 * 2;
constexpr int LDS_BYTES = 147456;
constexpr size_t OUT_S5RE = 25165824, OUT_S5IM = OUT_S5RE + 262144, OUT_DELTA = OUT_S5IM + 262144, OUT_LRU = OUT_DELTA + 8388608;

struct Params { const float* in[40]; float* out; unsigned char* ws; };
enum { I_XP = 0, I_XS, I_S5RE, I_S5IM, I_SDELTA, I_SLRU, I_C, I_CCTX, I_WADA, I_BADA, I_NMIXPRE, I_NMIXPOST, I_NMLPPRE, I_NMLPPOST, I_WMLPIN, I_WMLPOUT, I_WINE, I_WOUTE,
       I_LAMRE, I_LAMIM, I_LOGDT, I_BRE, I_BIM, I_CRE, I_CIM, I_S5D, I_GCONVW, I_GCONVB, I_GALOG, I_GDTB, I_GONORM, I_WINO, I_WOUTO, I_LCONVW, I_LCONVB, I_LWR, I_LBR, I_LWI, I_LBI, I_LLAM };

typedef __bf16 bf2_t __attribute__((ext_vector_type(2)));
typedef float f2_t __attribute__((ext_vector_type(2)));
__device__ __forceinline__ unsigned pk2(float lo, float hi) { const bf2_t v = __builtin_convertvector((f2_t){lo, hi}, bf2_t); return __builtin_bit_cast(unsigned, v); }
__device__ __forceinline__ unsigned f2bf(float f) { return pk2(f, f) & 0xffffu; }
__device__ __forceinline__ float bflo(unsigned w) { return __builtin_bit_cast(float, w << 16); }
__device__ __forceinline__ float bfhi(unsigned w) { return __builtin_bit_cast(float, w & 0xffff0000u); }
__device__ __forceinline__ float bf2f(bf16 b) { return __builtin_bit_cast(float, (unsigned)b << 16); }
__device__ __forceinline__ float sigmoidf_(float x) { return __builtin_amdgcn_rcpf(1.0f + __expf(-x)); }
__device__ __forceinline__ float siluf_(float x) { return x * sigmoidf_(x); }
__device__ __forceinline__ float softplusf_(float x) { return fmaxf(x, 0.f) + __logf(1.0f + __expf(-fabsf(x))); }
__device__ __forceinline__ float geluf_(float x) { const float y = 0.7978845608028654f * (x + 0.044715f * x * x * x); const float t = 1.0f - 2.0f * __builtin_amdgcn_rcpf(__expf(2.0f * y) + 1.0f); return 0.5f * x * (1.0f + t); }
__device__ __forceinline__ float shfl_i(float v, int srclane) { return __builtin_bit_cast(float, __builtin_amdgcn_ds_bpermute(srclane << 2, __builtin_bit_cast(int, v))); }
__device__ __forceinline__ float wave_sum(float v, int lane) {
#pragma unroll
    for (int o = 1; o < 64; o <<= 1) v += shfl_i(v, lane ^ o);
    return v;
}
#define LDS_WAIT() asm volatile("s_waitcnt lgkmcnt(0)" ::: "memory")
#define WAVE_SYNC() do { asm volatile("s_waitcnt lgkmcnt(0)" ::: "memory"); __builtin_amdgcn_wave_barrier(); } while (0)
__device__ __forceinline__ f32x4 mfma16(bf16x8 a, bf16x8 b, f32x4 c) { return __builtin_amdgcn_mfma_f32_16x16x32_bf16(a, b, c, 0, 0, 0); }


#define XB_TMO      128
#define XB_XCNT(j)  (256  + 64 * (j))
#define XB_XSUB(j)  (1280 + 64 * (j))
#define XB_XGEN(j)  (2304 + 64 * (j))
#define XB_TOP      3328
#define XB_TOPGEN   3392
#define XCD_BAR_WORDS 3456
#define XB_SPIN_CAP (1u << 18)
constexpr size_t WS_BAR = 960 * 1024; constexpr int LDS_BARST = LDS_BYTES - 16;
__device__ __forceinline__ unsigned xb_ld(unsigned* p)              { return __hip_atomic_load(p, __ATOMIC_RELAXED, __HIP_MEMORY_SCOPE_AGENT); }
__device__ __forceinline__ unsigned xb_add(unsigned* p, unsigned v) { return __hip_atomic_fetch_add(p, v, __ATOMIC_RELAXED, __HIP_MEMORY_SCOPE_AGENT); }
__device__ __forceinline__ unsigned xb_xcc_id() { return (unsigned)__builtin_amdgcn_s_getreg((3 << 11) | 20) & 0xFu; }
#define XB_SPIN(cond, bar) do { unsigned _sp = 0; while (cond) { __builtin_amdgcn_s_sleep(1); \
    if ((++_sp & 255u) == 0u) { if (xb_ld(&(bar)[XB_TMO])) break; if (_sp > XB_SPIN_CAP) { atomicAdd(&(bar)[XB_TMO], 1u); break; } } } } while (0)
__device__ __forceinline__ void xcd_barrier_complete(unsigned* bar, unsigned x, unsigned& nloc, unsigned& nx) {
    const unsigned G = gridDim.x;
    unsigned sum, cnt, mine, sp = 0u;
    for (;;) {
        sum = 0u; cnt = 0u; mine = 0u;
#pragma unroll
        for (unsigned j = 0; j < 16; ++j) { const unsigned c = xb_ld(&bar[XB_XCNT(j)]); sum += c; cnt += (c > 0u) ? 1u : 0u; mine = (j == x) ? c : mine; }
        if (sum == G) break;
        __builtin_amdgcn_s_sleep(1);
        if ((++sp & 255u) == 0u) { if (xb_ld(&bar[XB_TMO])) break; if (sp > XB_SPIN_CAP) { atomicAdd(&bar[XB_TMO], 1u); break; } }
    }
    nloc = mine > 0u ? mine : 1u; nx = cnt > 0u ? cnt : 1u;
}
__device__ __forceinline__ void xcd_barrier(int wid0, unsigned* bar, LAS unsigned char* lds) {
    const int tid = tid_fresh(wid0);
    asm volatile("s_waitcnt vmcnt(0)" ::: "memory");
    __syncthreads();
    if (tid == 0) {
        const unsigned x = xb_xcc_id();
        volatile LAS unsigned* st = (volatile LAS unsigned*)(lds + LDS_BARST);
        __builtin_amdgcn_s_waitcnt(0);
        unsigned nloc = st[0], nx = st[1];
        if (nloc == 0u) { xcd_barrier_complete(bar, x, nloc, nx); st[0] = nloc; st[1] = nx; }
        const unsigned old = xb_add(&bar[XB_XSUB(x)], 1u);
        const unsigned gen = old / nloc;
        if (old + 1u == (gen + 1u) * nloc) {
            __builtin_amdgcn_fence(__ATOMIC_RELEASE, "agent");
            asm volatile("s_waitcnt vmcnt(0)" ::: "memory");
            const unsigned og = xb_add(&bar[XB_TOP], 1u);
            const unsigned tg = og / nx;
            if (og + 1u == (tg + 1u) * nx) xb_add(&bar[XB_TOPGEN], 1u);
            else XB_SPIN(xb_ld(&bar[XB_TOPGEN]) == tg, bar);
            __builtin_amdgcn_fence(__ATOMIC_ACQUIRE, "agent");
            xb_add(&bar[XB_XGEN(x)], 1u);
            asm volatile("s_waitcnt vmcnt(0)" ::: "memory");
        } else {
            XB_SPIN(xb_ld(&bar[XB_XGEN(x)]) == gen, bar);
            __builtin_amdgcn_fence(__ATOMIC_ACQUIRE, "agent");
            asm volatile("s_waitcnt vmcnt(0)" ::: "memory");
        }
    }
    __syncthreads();
}
__device__ __forceinline__ void transpose_item(const float* W, int ldw, int nvalid, int K, bf16* WT, int dst_row0, LAS float* scr, int k0, int n0, int lane) {
    const int nn = n0 + (lane & 31); const bool ok = nn < nvalid;
#pragma unroll 8
    for (int i = 0; i < 32; ++i) { const int kk = 2 * i + (lane >> 5); scr[kk * 33 + (lane & 31)] = ok ? W[(size_t)(k0 + kk) * ldw + nn] : 0.f; }
    WAVE_SYNC();
    const int c = lane & 7;
#pragma unroll
    for (int j = 0; j < 4; ++j) { const int n = (lane >> 3) + 8 * j; const LAS float* s = scr + (8 * c) * 33 + n;
        u32x4 o; o.x = pk2(s[0 * 33], s[1 * 33]); o.y = pk2(s[2 * 33], s[3 * 33]); o.z = pk2(s[4 * 33], s[5 * 33]); o.w = pk2(s[6 * 33], s[7 * 33]);
        *(u32x4*)(WT + (size_t)(dst_row0 + n) * K + k0 + 8 * c) = o; }
    WAVE_SYNC();
}
__device__ __forceinline__ void phase_prologue(int wid0, const Params& P, LAS unsigned char* lds) {
    const int tid = tid_fresh(wid0), lane = tid & 63, wave = tid >> 6;
    LAS float* scr = (LAS float*)(lds + wave * 16384);
    const int gw = bid_fresh() * NWAVES + wave, NGW = grid_fresh() * NWAVES;
    unsigned char* ws = P.ws;
    constexpr int NA = 8192, NB = 8192, NC = 2 * 16 * 97, ND = 1024, NE = 2048, NF = 1024, NG = 1024, NTR = NA + NB + NC + ND + NE + NF + NG, NMOD = 4 * 24 * 16;
    for (int it = gw; it < NTR + NMOD; it += NGW) {
        int r = it;
        if (r < NA) { const int l = r >> 11, q = r & 2047; transpose_item(P.in[I_WMLPIN] + (size_t)l * 1024 * 4096, 4096, 4096, 1024, (bf16*)(ws + WS_W1T) + (size_t)l * 4096 * 1024, 32 * (q & 127), scr, 64 * (q >> 7), 32 * (q & 127), lane); continue; } r -= NA;
        if (r < NB) { const int l = r >> 11, q = r & 2047; transpose_item(P.in[I_WMLPOUT] + (size_t)l * 4096 * 1024, 1024, 1024, 4096, (bf16*)(ws + WS_W2T) + (size_t)l * 1024 * 4096, 32 * (q & 31), scr, 64 * (q >> 5), 32 * (q & 31), lane); continue; } r -= NB;
        if (r < NC) { const int e = r / 1552, q = r % 1552, kb = q / 97, nb = q % 97; transpose_item(P.in[I_WINE] + (size_t)e * 1024 * IN_EVEN_LD, IN_EVEN_LD, IN_EVEN_LD, 1024, (bf16*)(ws + WS_WINE) + (size_t)e * NB_E * 1024, 32 * nb, scr, 64 * kb, 32 * nb, lane); continue; } r -= NC;
        if (r < ND) { const int e = r >> 9, q = r & 511; transpose_item(P.in[I_WOUTE] + (size_t)e * 1024 * 1024, 1024, 1024, 1024, (bf16*)(ws + WS_WOUTE) + (size_t)e * 1024 * 1024, 32 * (q & 31), scr, 64 * (q >> 5), 32 * (q & 31), lane); continue; } r -= ND;
        if (r < NE) { const int o = r >> 10, q = r & 1023; transpose_item(P.in[I_WINO] + (size_t)o * 1024 * 2048, 2048, 2048, 1024, (bf16*)(ws + WS_WINO) + (size_t)o * 2048 * 1024, 32 * (q & 63), scr, 64 * (q >> 6), 32 * (q & 63), lane); continue; } r -= NE;
        if (r < NF) { const int o = r >> 9, q = r & 511; transpose_item(P.in[I_WOUTO] + (size_t)o * 1024 * 1024, 1024, 1024, 1024, (bf16*)(ws + WS_WOUTO) + (size_t)o * 1024 * 1024, 32 * (q & 31), scr, 64 * (q >> 5), 32 * (q & 31), lane); continue; } r -= NF;
        if (r < NG) { const int mat = r >> 5, q = r & 31, kb = q >> 3, nb = q & 7; const int blk = mat & 3, gate = (mat >> 2) & 1, od = mat >> 3;
            const float* src = (gate ? P.in[I_LWI] : P.in[I_LWR]) + (size_t)(od * 4 + blk) * 65536;
            const int j0 = nb * 32; const int drow = (blk * 2 + (j0 >> 7)) * 256 + gate * 128 + (j0 & 127);
            transpose_item(src, 256, 256, 256, (bf16*)(ws + WS_WG) + (size_t)od * 2048 * 256, drow - j0 + j0, scr, 64 * kb, j0, lane);
            continue; } r -= NG;
        {
            const int l = r / 384, rem = r % 384, ec = rem >> 4, ks = rem & 15, k0 = ks * 64;
#pragma unroll
            for (int rr = 0; rr < 9; ++rr) { const float cv = rr == 0 ? P.in[I_CCTX][k0 + lane] : P.in[I_C][(rr - 1) * 1024 + k0 + lane]; scr[rr * 64 + lane] = siluf_(cv); }
            WAVE_SYNC();
            f32x4 acc[9];
#pragma unroll
            for (int rr = 0; rr < 9; ++rr) acc[rr] = (f32x4){0.f, 0.f, 0.f, 0.f};
            const float* wp = P.in[I_WADA] + ((size_t)l * 1024 + k0) * 6144 + ec * 256 + lane * 4;
#pragma unroll 4
            for (int kk = 0; kk < 64; ++kk) { const f32x4 w4 = *(const f32x4*)(wp + (size_t)kk * 6144);
#pragma unroll
                for (int rr = 0; rr < 9; ++rr) acc[rr] += w4 * scr[rr * 64 + kk]; }
            float* part = (float*)(ws + WS_BIG) + ((size_t)(ks * 4 + l) * 9) * 6144 + ec * 256 + lane * 4;
#pragma unroll
            for (int rr = 0; rr < 9; ++rr) *(f32x4*)(part + (size_t)rr * 6144) = acc[rr];
            WAVE_SYNC();
        }
    }
    { u32x4* z = (u32x4*)0; (void)z;
      const size_t per = (size_t)(NB_E - 3104) * 1024 * 2 / 16;
      for (size_t i = (size_t)bid_fresh() * NTHR + tid; i < 2 * per; i += (size_t)grid_fresh() * NTHR) { const size_t e = i / per, q = i % per;
          *(u32x4*)(ws + WS_WINE + (e * NB_E + 3104) * 1024 * 2 + q * 16) = (u32x4){0u, 0u, 0u, 0u}; } }
}

__device__ __forceinline__ void phase_modreduce(int wid0, const Params& P) {
    const int tid = tid_fresh(wid0);
    const float* part = (const float*)(P.ws + WS_BIG); float* mod = (float*)(P.ws + WS_MOD);
    for (int i = bid_fresh() * NTHR + tid; i < 4 * 9 * 6144 / 4; i += grid_fresh() * NTHR) {
        const int l = i / (9 * 1536), e4 = i % 1536;
        f32x4 a = *(const f32x4*)(P.in[I_BADA] + (size_t)l * 6144 + e4 * 4);
#pragma unroll
        for (int ks = 0; ks < 16; ++ks) a += *(const f32x4*)(part + (size_t)ks * 4 * 9 * 6144 + (size_t)i * 4);
        *(f32x4*)(mod + (size_t)i * 4) = a; }
}
__device__ __forceinline__ void phase_rownorm(int wid0, const Params& P, int first, const bf16* obuf, const float* modg, int goff, const float* gpost, int has_next, const float* gpre, const float* mods, int soff, bf16* H) {
    const int tid = tid_fresh(wid0), lane = tid & 63, wave = tid >> 6;
    const int gw = bid_fresh() * NWAVES + wave, NGW = grid_fresh() * NWAVES;
    float* X = P.out;
    for (int m = gw; m < MT; m += NGW) {
        const int modrow = m < MCTX ? 0 : 1 + ((m - MCTX) >> 11);
        const float* mr = modg + (size_t)modrow * 6144; const float* ms = mods + (size_t)modrow * 6144;
        f32x4 x[4];
        if (first) {
            if (m < MCTX) {
#pragma unroll
                for (int j = 0; j < 4; ++j) x[j] = *(const f32x4*)(P.in[I_XP] + (size_t)m * DM + lane * 4 + 256 * j);
            } else {
                const int t = (m - MCTX) & 2047; const float prow = (float)(t >> 6), pcol = (float)(t & 63);
                f32x4 om;
#pragma unroll
                for (int e = 0; e < 4; ++e) om[e] = exp2f(-(float)(lane * 4 + e) * (13.287712379549449f / 256.0f));
#pragma unroll
                for (int j = 0; j < 4; ++j) { x[j] = *(const f32x4*)(P.in[I_XS] + (size_t)(m - MCTX) * DM + lane * 4 + 256 * j);
#pragma unroll
                    for (int e = 0; e < 4; ++e) { const float a = (j < 2 ? prow : pcol) * om[e]; x[j][e] += (j & 1) ? cosf(a) : sinf(a); } }
            }
        } else {
            u32x2 ov[4]; float ss = 0.f;
#pragma unroll
            for (int j = 0; j < 4; ++j) { x[j] = *(const f32x4*)(X + (size_t)m * DM + lane * 4 + 256 * j); ov[j] = *(const u32x2*)(obuf + (size_t)m * DM + lane * 4 + 256 * j); }
#pragma unroll
            for (int j = 0; j < 4; ++j) { const float a = bflo(ov[j].x), b = bfhi(ov[j].x), c = bflo(ov[j].y), d = bfhi(ov[j].y); ss += (a * a + b * b) + (c * c + d * d); }
            const float rs = rsqrtf(wave_sum(ss, lane) * (1.0f / DM) + EPSF);
#pragma unroll
            for (int j = 0; j < 4; ++j) { const f32x4 g4 = *(const f32x4*)(gpost + lane * 4 + 256 * j), gt = *(const f32x4*)(mr + goff + lane * 4 + 256 * j);
                f32x4 o4 = (f32x4){bflo(ov[j].x), bfhi(ov[j].x), bflo(ov[j].y), bfhi(ov[j].y)};
                x[j] += gt * (o4 * rs * g4); }
        }
#pragma unroll
        for (int j = 0; j < 4; ++j) *(f32x4*)(X + (size_t)m * DM + lane * 4 + 256 * j) = x[j];
        if (has_next) {
            float ss = 0.f;
#pragma unroll
            for (int j = 0; j < 4; ++j) ss += (x[j][0] * x[j][0] + x[j][1] * x[j][1]) + (x[j][2] * x[j][2] + x[j][3] * x[j][3]);
            const float rs = rsqrtf(wave_sum(ss, lane) * (1.0f / DM) + EPSF);
#pragma unroll
            for (int j = 0; j < 4; ++j) { const f32x4 g4 = *(const f32x4*)(gpre + lane * 4 + 256 * j), sh = *(const f32x4*)(ms + soff + lane * 4 + 256 * j), sc = *(const f32x4*)(ms + soff + 1024 + lane * 4 + 256 * j);
                const f32x4 h4 = (x[j] * rs * g4) * (sc + 1.0f) + sh;
                u32x2 w; w.x = pk2(h4[0], h4[1]); w.y = pk2(h4[2], h4[3]);
                *(u32x2*)(H + (size_t)m * DM + lane * 4 + 256 * j) = w; }
        }
    }
}

using pg8::Unit;
template <int ACT  > struct EpiBf16 {
    bf16* O; int ldc; float* AB;
    bf16* HALO;
    __device__ __forceinline__ void operator()(const f32x4 (&acc)[2][2][4][2], const Unit& u, int wr, int wc, int fr, int fq) const {
        const int row0 = u.pm * 256 + wr * 64 + fr, col0 = u.pn * 256 + wc * 32 + 8 * fq;
        if (AB && u.pn * 256 >= ldc) {
            if (wc == 0 && fq < 2) {
#pragma unroll
                for (int ai = 0; ai < 2; ++ai)
#pragma unroll
                    for (int m = 0; m < 4; ++m) { float* p = AB + (size_t)(row0 + ai * 128 + m * 16) * 16 + 8 * fq; *(f32x4*)p = acc[ai][0][m][0]; *(f32x4*)(p + 4) = acc[ai][0][m][1]; }
            }
            return;
        }
#pragma unroll
        for (int ai = 0; ai < 2; ++ai)
#pragma unroll
            for (int m = 0; m < 4; ++m) { bf16* rowp = O + (size_t)(row0 + ai * 128 + m * 16) * ldc + col0;
#pragma unroll
                for (int bj = 0; bj < 2; ++bj) { f32x4 v0 = acc[ai][bj][m][0], v1 = acc[ai][bj][m][1];
                    if (ACT == 1) {
#pragma unroll
                        for (int j = 0; j < 4; ++j) { const float a = fmaxf(v0[j], 0.f), b = fmaxf(v1[j], 0.f); v0[j] = a * a; v1[j] = b * b; } }
                    u32x4 w; w.x = pk2(v0[0], v0[1]); w.y = pk2(v0[2], v0[3]); w.z = pk2(v1[0], v1[1]); w.w = pk2(v1[2], v1[3]);
                    *(u32x4*)(rowp + bj * 128) = w;
                    if (ACT == 0 && HALO && u.pn >= 4 && u.pn < 10 && ((m == 3 && fr == 15) || (m == 0 && fr < 2))) {
                        const int r = row0 + ai * 128 + m * 16; const int which = (m == 3) ? 0 : 1 + fr;
                        *(u32x4*)(HALO + ((size_t)(r >> 6) * 3 + which) * 1536 + (col0 + bj * 128 - 1024)) = w; } } }
    }
};
struct EpiSplit {
    bf16* O0; long stride;
    __device__ __forceinline__ void operator()(const f32x4 (&acc)[2][2][4][2], const Unit& u, int wr, int wc, int fr, int fq) const {
        const int row0 = u.pm * 256 + wr * 64 + fr, col0 = (u.pn >> 1) * 256 + wc * 32 + 8 * fq; bf16* O = O0 + (long)(u.pn & 1) * stride;
#pragma unroll
        for (int ai = 0; ai < 2; ++ai)
#pragma unroll
            for (int m = 0; m < 4; ++m) { bf16* rowp = O + (size_t)(row0 + ai * 128 + m * 16) * DM + col0;
#pragma unroll
                for (int bj = 0; bj < 2; ++bj) { const f32x4 v0 = acc[ai][bj][m][0], v1 = acc[ai][bj][m][1];
                    u32x4 w; w.x = pk2(v0[0], v0[1]); w.y = pk2(v0[2], v0[3]); w.z = pk2(v1[0], v1[1]); w.w = pk2(v1[2], v1[3]);
                    *(u32x4*)(rowp + bj * 128) = w; } }
    }
};
struct EpiGates {
    unsigned* G; const bf16* X; const float* br; const float* bi; const float* lam;
    __device__ __forceinline__ void operator()(const f32x4 (&acc)[2][2][4][2], const Unit& u, int wr, int wc, int fr, int fq) const {
        const int row0 = u.pm * 256 + wr * 64 + fr, ch0 = u.pn * 128 + wc * 32 + 8 * fq;
#pragma unroll
        for (int n = 0; n < 2; ++n) {
            const f32x4 vbr = *(const f32x4*)(br + ch0 + 4 * n), vbi = *(const f32x4*)(bi + ch0 + 4 * n), l4 = *(const f32x4*)(lam + ch0 + 4 * n);
            f32x4 vsp;
#pragma unroll
            for (int e = 0; e < 4; ++e) vsp[e] = -8.0f * softplusf_(-l4[e]);
#pragma unroll
            for (int ai = 0; ai < 2; ++ai)
#pragma unroll
                for (int m = 0; m < 4; ++m) { const size_t row = (size_t)(row0 + ai * 128 + m * 16);
                    const u32x2 xv = *(const u32x2*)(X + row * DM + ch0 + 4 * n);
                    const float xs[4] = {bflo(xv.x), bfhi(xv.x), bflo(xv.y), bfhi(xv.y)};
                    u32x4 w;
#pragma unroll
                    for (int e = 0; e < 4; ++e) { const float r = sigmoidf_(acc[ai][0][m][n][e] + vbr[e]), ig = sigmoidf_(acc[ai][1][m][n][e] + vbi[e]);
                        const float la = r * vsp[e]; const float a_ = __expf(la); const float b = __builtin_amdgcn_sqrtf(fmaxf(1.0f - a_ * a_, 0.f)) * ig * xs[e];
                        w[e] = pk2(la * 1.4426950408889634f, b); }
                    *(u32x4*)(G + row * DM + ch0 + 4 * n) = w; }
        }
    }
};
constexpr int S5_WLDS = 12800, BU_P = 132, HS_P = 136;
struct S5Dir { float ar, ai; bf16x8 Bf[8]; };
__device__ __forceinline__ void s5_dir_setup(const Params& P, int e, int d, int g, int lane, float& ar, float& ai, bf16x8 (&Bf)[8], bool needB) {
    const int quad = lane >> 4, l15 = lane & 15;
    const float dt = __expf(P.in[I_LOGDT][(e * 2 + d) * 32 + g]);
    const float lr = P.in[I_LAMRE][((e * 2 + d) * 32 + g) * 64 + lane], li = P.in[I_LAMIM][((e * 2 + d) * 32 + g) * 64 + lane];
    const float mag = expf(lr * dt); ar = mag * cosf(li * dt); ai = mag * sinf(li * dt);
    const float den = lr * lr + li * li;
    const float fr = ((ar - 1.0f) * lr + ai * li) / den, fi = (ai * lr - (ar - 1.0f) * li) / den;
    if (needB) {
#pragma unroll
        for (int nt = 0; nt < 8; ++nt) { const int col = 16 * nt + l15, p = col & 63;
            const float frp = shfl_i(fr, p), fip = shfl_i(fi, p);
            bf16x8 v = (bf16x8){0, 0, 0, 0, 0, 0, 0, 0};
            if (quad < 2) { const float* bre = P.in[I_BRE] + ((size_t)(e * 32 + g) * 64 + p) * 16 + quad * 8; const float* bim = P.in[I_BIM] + ((size_t)(e * 32 + g) * 64 + p) * 16 + quad * 8;
#pragma unroll
                for (int j = 0; j < 8; ++j) { const float br = bre[j], bi = bim[j]; const float val = (nt < 4) ? (frp * br - fip * bi) : (frp * bi + fip * br); v[j] = (short)f2bf(val); } }
            Bf[nt] = v; }
    }
}
__device__ __forceinline__ void s5_c_setup(const Params& P, int e, int g, int lane, bf16x8 (&Cf)[4]) {
    const int quad = lane >> 4, l15 = lane & 15;
#pragma unroll
    for (int ks = 0; ks < 4; ++ks) { const int col0 = 32 * ks + quad * 8; const bool im = col0 >= 64;
        const float* src = (im ? P.in[I_CIM] : P.in[I_CRE]) + ((size_t)(e * 32 + g) * 16 + l15) * 64 + (col0 & 63);
        bf16x8 v;
#pragma unroll
        for (int j = 0; j < 8; ++j) v[j] = (short)f2bf(im ? -src[j] : src[j]);
        Cf[ks] = v; }
}
__device__ __forceinline__ void s5_scan_seg(const Params& P, LAS unsigned char* wl, int lane, int d, int g, int m0, float ar, float ai, const bf16x8 (&Bf)[8], const bf16x8 (&Cf)[4],
                                            float& hr, float& hi, int mode, int ymode, const bf16* proj, float* ybuf, bf16* mixout, float dsk) {
    const int quad = lane >> 4, l15 = lane & 15;
    LAS float* BU = (LAS float*)wl; LAS bf16* HS = (LAS bf16*)(wl + 8448);
    for (int bi_ = 0; bi_ < 16; ++bi_) {
        const int blk = d ? 15 - bi_ : bi_;
        const int mb = m0 + 16 * blk;
        if (mode == 0) {
            bf16x8 a = (bf16x8){0, 0, 0, 0, 0, 0, 0, 0};
            if (quad < 2) { const int tt = d ? 15 - l15 : l15; a = *(const bf16x8*)(proj + (size_t)(mb + tt) * NPROJ_E + g * 16 + quad * 8); }
#pragma unroll
            for (int nt = 0; nt < 8; ++nt) { f32x4 acc = mfma16(a, Bf[nt], (f32x4){0.f, 0.f, 0.f, 0.f});
#pragma unroll
                for (int jj = 0; jj < 4; ++jj) BU[(quad * 4 + jj) * BU_P + 16 * nt + l15] = acc[jj]; }
            WAVE_SYNC();
        }
#pragma unroll
        for (int r = 0; r < 16; ++r) {
            float br = 0.f, bim = 0.f;
            if (mode == 0) { br = BU[r * BU_P + lane]; bim = BU[r * BU_P + 64 + lane]; }
            const float nr = ar * hr - ai * hi + br, ni = ar * hi + ai * hr + bim; hr = nr; hi = ni;
            HS[r * HS_P + lane] = (bf16)f2bf(hr); HS[r * HS_P + 64 + lane] = (bf16)f2bf(hi);
        }
        WAVE_SYNC();
        f32x4 y = (f32x4){0.f, 0.f, 0.f, 0.f};
#pragma unroll
        for (int ks = 0; ks < 4; ++ks) { const bf16x8 a = *(const LAS bf16x8*)(HS + l15 * HS_P + 32 * ks + quad * 8); y = mfma16(a, Cf[ks], y); }
        const int ch = g * 16 + l15;
#pragma unroll
        for (int jj = 0; jj < 4; ++jj) { const int row = quad * 4 + jj; const int tt = d ? 15 - row : row; const size_t m = (size_t)(mb + tt);
            float v = y[jj];
            if (ymode == 0) { v += dsk * bf2f(proj[m * NPROJ_E + ch]); ybuf[m * 512 + ch] = v; }
            else { v += ybuf[m * 512 + ch];
                if (ymode == 1) ybuf[m * 512 + ch] = v;
                else { const float z = bf2f(proj[m * NPROJ_E + 512 + ch]); mixout[m * DM + ch] = (bf16)f2bf(geluf_(v) * sigmoidf_(z)); } }
        }
        WAVE_SYNC();
    }
}
__device__ __forceinline__ void s5_task_main(const Params& P, LAS unsigned char* wl, int lane, int e, int sub, int g) {
    const bf16* proj = (const bf16*)(P.ws + WS_BIG); float* ybuf = (float*)(P.ws + WS_YBUF); bf16* mixout = (bf16*)(P.ws + WS_MIX);
    const bool lat = sub >= 32; const int q = sub - 32, b = lat ? (q >> 3) : sub, seg = lat ? (q & 7) : 0;
    const int m0 = lat ? MCTX + b * LLAT + seg * 256 : sub * 256;
    bf16x8 Cf[4]; s5_c_setup(P, e, g, lane, Cf);
    const float dsk = P.in[I_S5D][e * 512 + g * 16 + (lane & 15)];
#pragma unroll 1
    for (int d = 0; d < 2; ++d) {
        float ar, ai; bf16x8 Bf[8]; s5_dir_setup(P, e, d, g, lane, ar, ai, Bf, true);
        float hr = 0.f, hi = 0.f;
        if (lat && ((d == 0 && seg == 0) || (d == 1 && seg == 7))) { const size_t si = ((((size_t)b * 2 + e) * 2 + d) * 32 + g) * 64 + lane; hr = P.in[I_S5RE][si]; hi = P.in[I_S5IM][si]; }
        const int ymode = d == 0 ? 0 : (lat ? 1 : 2);
        s5_scan_seg(P, wl, lane, d, g, m0, ar, ai, Bf, Cf, hr, hi, 0, ymode, proj, ybuf, mixout, dsk);
        if (!lat) { const size_t si = ((((size_t)b * 2 + e) * 2 + d) * 32 + g) * 64 + lane; P.out[OUT_S5RE + si] = hr; P.out[OUT_S5IM + si] = hi; }
        else { float* F = (float*)(P.ws + WS_S5F) + ((((size_t)d * 64 + q) * 32 + g) * 64 + lane) * 2; F[0] = hr; F[1] = hi; }
    }
}
__device__ __forceinline__ void s5_task_corr(const Params& P, LAS unsigned char* wl, int lane, int e, int q, int g) {
    const bf16* proj = (const bf16*)(P.ws + WS_BIG); float* ybuf = (float*)(P.ws + WS_YBUF); bf16* mixout = (bf16*)(P.ws + WS_MIX);
    const int b = q >> 3, seg = q & 7, m0 = MCTX + b * LLAT + seg * 256;
    bf16x8 Cf[4]; s5_c_setup(P, e, g, lane, Cf);
    bf16x8 Bf[8];
#pragma unroll
    for (int i = 0; i < 8; ++i) Bf[i] = (bf16x8){0, 0, 0, 0, 0, 0, 0, 0};
    const float* Fb = (const float*)(P.ws + WS_S5F);
#pragma unroll 1
    for (int d = 0; d < 2; ++d) {
        float ar, ai; s5_dir_setup(P, e, d, g, lane, ar, ai, Bf, false);
        float pr = ar, pi = ai;
#pragma unroll
        for (int i = 0; i < 8; ++i) { const float nr = pr * pr - pi * pi, ni = 2.0f * pr * pi; pr = nr; pi = ni; }
        float hr = 0.f, hi = 0.f;
        const int cnt = d == 0 ? seg : 7 - seg;
        for (int i = 0; i < cnt; ++i) { const int sj = d == 0 ? i : 7 - i; const float* F = Fb + ((((size_t)d * 64 + b * 8 + sj) * 32 + g) * 64 + lane) * 2;
            const float nr = pr * hr - pi * hi + F[0], ni = pr * hi + pi * hr + F[1]; hr = nr; hi = ni; }
        if (cnt > 0) s5_scan_seg(P, wl, lane, d, g, m0, ar, ai, Bf, Cf, hr, hi, 1, 1, proj, ybuf, mixout, 0.f);
    }
    __builtin_amdgcn_wave_barrier();
    for (int i = lane; i < 256 * 16; i += 64) { const size_t m = (size_t)(m0 + (i >> 4)); const int ch = g * 16 + (i & 15);
        const float v = ybuf[m * 512 + ch]; const float z = bf2f(proj[m * NPROJ_E + 512 + ch]);
        mixout[m * DM + ch] = (bf16)f2bf(geluf_(v) * sigmoidf_(z)); }
}

#ifndef REP_A
#define REP_A 1
#endif
#ifndef REP_B
#define REP_B 1
#endif
#ifndef REP_C
#define REP_C 1
#endif
__device__ __forceinline__ void phase_conv_even(int wid0, const Params& P, int e) {
    const int tid = tid_fresh(wid0), lane = tid & 63, wave = tid >> 6;
    const int gw = bid_fresh() * NWAVES + wave, NGW = grid_fresh() * NWAVES;
    bf16* proj = (bf16*)(P.ws + WS_BIG); const bf16* HALO = (const bf16*)(P.ws + WS_HALO);
    for (int it = gw; it < 384 * 24; it += NGW) {
        const int c = it / 24, cgp = it % 24, ccol = cgp * 64 + lane;
        const int r0 = c * 64;
        const bool lat = r0 >= MCTX; const int t0 = lat ? ((r0 - MCTX) & 2047) : (r0 & 255); const int L = lat ? LLAT : LCTX;
        bf16* base = proj + (size_t)r0 * NPROJ_E + 1024 + ccol;
        bf16 x[67];
#pragma unroll
        for (int i = 0; i < 64; ++i) x[i + 1] = base[(size_t)i * NPROJ_E];
        x[0] = (t0 > 0) ? HALO[((size_t)(c - 1) * 3 + 0) * 1536 + ccol] : (bf16)0;
        x[65] = (t0 + 64 < L) ? HALO[((size_t)(c + 1) * 3 + 1) * 1536 + ccol] : (bf16)0;
        x[66] = (t0 + 64 < L) ? HALO[((size_t)(c + 1) * 3 + 2) * 1536 + ccol] : (bf16)0;
        const float* cw = P.in[I_GCONVW] + (size_t)e * 4 * 1536 + ccol; const float w0 = cw[0], w1 = cw[1536], w2 = cw[3072], w3 = cw[4608], cb = P.in[I_GCONVB][e * 1536 + ccol];
#pragma unroll
        for (int i = 0; i < 64; ++i) { const float v = cb + w0 * bf2f(x[i]) + w1 * bf2f(x[i + 1]) + w2 * bf2f(x[i + 2]) + w3 * bf2f(x[i + 3]);
            base[(size_t)i * NPROJ_E] = (bf16)f2bf(siluf_(v)); }
    }
}
#define LDS_BARRIER() do { asm volatile("s_waitcnt lgkmcnt(0)" ::: "memory"); __builtin_amdgcn_s_barrier(); asm volatile("" ::: "memory"); } while (0)
constexpr int G_Q = 0, G_K = 17408, G_V = 34816, G_KT = 52224, G_LM = 70656, G_QK = 89088, G_ST = 98304, G_SM = 133120;
constexpr int P128 = 136, P64 = 72, LMP = 68;
__device__ __forceinline__ bf16x8 ld_split8(const LAS bf16* p) {
    const u32x2 a = *(const LAS u32x2*)p, b = *(const LAS u32x2*)(p + 16);
    return __builtin_bit_cast(bf16x8, (u32x4){a.x, a.y, b.x, b.y});
}
__device__ __forceinline__ bf16x8 pack_acc2(const f32x4& a, const f32x4& b) { return __builtin_bit_cast(bf16x8, (u32x4){pk2(a[0], a[1]), pk2(a[2], a[3]), pk2(b[0], b[1]), pk2(b[2], b[3])}); }
__device__ __forceinline__ void gdn_chain(int wid0, const Params& P, LAS unsigned char* lds, int e, int s, int hd, int dir) {
    const int tid = tid_fresh(wid0), lane = tid & 63, w = __builtin_amdgcn_readfirstlane(tid >> 6), quad = lane >> 4, l15 = lane & 15;
    const bool lat = s >= 32; const int b = lat ? s - 32 : s; const int L = lat ? LLAT : LCTX; const int m0 = lat ? MCTX + b * LLAT : s * LCTX;
    const bf16* proj = (const bf16*)(P.ws + WS_BIG); const float* AB = (const float*)(P.ws + WS_AB);
    bf16* Odir = (bf16*)(P.ws + WS_H) + (size_t)dir * MT * 512;
    int zv; asm volatile("v_mov_b32 %0, 0" : "=v"(zv));
    lds += zv;
    LAS bf16* Qs = (LAS bf16*)(lds + G_Q); LAS bf16* Ks = (LAS bf16*)(lds + G_K); LAS bf16* Vs = (LAS bf16*)(lds + G_V); LAS bf16* KT = (LAS bf16*)(lds + G_KT);
    LAS float* Lm = (LAS float*)(lds + G_LM); LAS bf16* VNT = (LAS bf16*)(lds + G_LM); LAS bf16* QKs = (LAS bf16*)(lds + G_QK); LAS bf16* ST = (LAS bf16*)(lds + G_ST);
    LAS bf16* TM = (LAS bf16*)(lds + G_ST); LAS bf16* TT = TM + 64 * P64; LAS bf16* LR = TT + 64 * P64;
    LAS float* rq = (LAS float*)(lds + G_SM); LAS float* rk = rq + 64; LAS float* gcs = rq + 128; LAS float* betas = rq + 192; LAS float* egs = rq + 256; LAS float* kes = rq + 320;
    f32x4 Sacc[8];
    const size_t sbase = ((((size_t)b * 2 + e) * 2 + dir) * 4 + hd) * 16384;
#pragma unroll
    for (int mt = 0; mt < 8; ++mt) Sacc[mt] = (f32x4){0.f, 0.f, 0.f, 0.f};
    if (lat) { const float* sp = P.in[I_SDELTA] + sbase + (size_t)(quad * 4) * 128 + 16 * w + l15;
#pragma unroll
        for (int mt = 0; mt < 8; ++mt)
#pragma unroll
            for (int jj = 0; jj < 4; ++jj) Sacc[mt][jj] = sp[(16 * mt + jj) * 128]; }
    for (int i = tid; i < 2 * 64 * P64 / 2; i += NTHR) ((LAS unsigned*)TM)[i] = 0u;
    const float alog_e = __expf(P.in[I_GALOG][(e * 2 + dir) * 4 + hd]), dtb = P.in[I_GDTB][(e * 2 + dir) * 4 + hd];
    const int nchunk = L / 64;
    u32x4 xr[6]; float ab_a = 0.f, ab_b = 0.f;
#define GDN_LOAD(ci_) do { const int tid_ = tid_fresh(wid0); const int c0_ = dir ? L - 64 * ((ci_) + 1) : 64 * (ci_); \
        _Pragma("unroll") for (int k = 0; k < 6; ++k) { const int p_ = tid_ + 512 * k, part_ = p_ >> 10, row_ = (p_ & 1023) >> 4, pc_ = p_ & 15; \
            xr[k] = *(const u32x4*)(proj + (size_t)(m0 + c0_ + row_) * NPROJ_E + 1024 + part_ * 512 + hd * 128 + pc_ * 8); } \
        if (w == 0) { const int ln_ = tid_ & 63; const size_t m_ = (size_t)(m0 + c0_ + (dir ? 63 - ln_ : ln_)); ab_a = AB[m_ * 16 + dir * 4 + hd]; ab_b = AB[m_ * 16 + 8 + dir * 4 + hd]; } } while (0)
    GDN_LOAD(0);
#pragma unroll 1
    for (int ci = 0; ci < nchunk; ++ci) {
        const int tid = tid_fresh(wid0), lane = tid & 63, quad = lane >> 4, l15 = lane & 15;
        const int c0 = dir ? L - 64 * (ci + 1) : 64 * ci;
        LDS_BARRIER();
#ifndef NO_A
        const float cur_a = ab_a, cur_b = ab_b;
#pragma unroll
        for (int k = 0; k < 6; ++k) { const int p_ = tid + 512 * k, part_ = p_ >> 10, row_ = (p_ & 1023) >> 4, pc_ = p_ & 15;
            LAS bf16* dst = part_ == 0 ? Qs : (part_ == 1 ? Ks : Vs);
            *(LAS u32x4*)(dst + (dir ? 63 - row_ : row_) * P128 + pc_ * 8) = xr[k]; }
        if (ci + 1 < nchunk) GDN_LOAD(ci + 1);
#endif
        LDS_BARRIER();
#pragma unroll 1
        for (int repB = 0; repB < REP_B; ++repB)
        { const int rowid = tid >> 2, part = tid & 3; LAS bf16* src = (rowid < 64 ? Qs : Ks) + (rowid & 63) * P128 + part * 32;
          float ss = 0.f;
#pragma unroll
          for (int i = 0; i < 4; ++i) { const u32x4 v = *(const LAS u32x4*)(src + 8 * i);
#pragma unroll
              for (int j = 0; j < 4; ++j) { const float a = bflo(v[j]), c = bfhi(v[j]); ss += a * a + c * c; } }
          ss += shfl_i(ss, lane ^ 1); ss += shfl_i(ss, lane ^ 2);
          if (part == 0) { if (rowid < 64) rq[rowid] = rsqrtf(ss + EPSF) * 0.08838834764831845f; else rk[rowid - 64] = rsqrtf(ss + EPSF); }
          if (w == 0) { const int t = c0 + (dir ? 63 - lane : lane); const size_t m = (size_t)(m0 + t);
              const float araw = cur_a, braw = cur_b;
              const float gg = -alog_e * softplusf_(araw + dtb);
              float gc = gg;
#pragma unroll
              for (int o = 1; o < 64; o <<= 1) { const float t2 = shfl_i(gc, (lane - o) & 63); if (lane >= o) gc += t2; }
              const float glast = shfl_i(gc, 63);
              gcs[lane] = gc; betas[lane] = sigmoidf_(braw); egs[lane] = __expf(gc); kes[lane] = __expf(glast - gc);
              if (lane == 0) rq[384] = __expf(glast); } }
        LDS_BARRIER();
#ifndef NO_C
#pragma unroll 1
        for (int repC = 0; repC < REP_C; ++repC)
        { const int mt = w & 3; const bool isq = w >= 4; LAS bf16* src = isq ? Qs : Ks;
          bf16x8 a[4];
#pragma unroll
          for (int ks = 0; ks < 4; ++ks) a[ks] = *(const LAS bf16x8*)(src + (16 * mt + l15) * P128 + 32 * ks + quad * 8);
#pragma unroll 1
          for (int nt = 0; nt < 4; ++nt) { f32x4 acc = (f32x4){0.f, 0.f, 0.f, 0.f};
#pragma unroll
              for (int ks = 0; ks < 4; ++ks) { const bf16x8 bb = *(const LAS bf16x8*)(Ks + (16 * nt + l15) * P128 + 32 * ks + quad * 8); acc = mfma16(a[ks], bb, acc); }
              const int j = 16 * nt + l15; const float rkj = rk[j], gcj = gcs[j];
              f32x4 lv;
#pragma unroll
              for (int jj = 0; jj < 4; ++jj) { const int i = 16 * mt + quad * 4 + jj; const float dec = __expf(fminf(gcs[i] - gcj, 0.f));
                  lv[jj] = (i > j) ? acc[jj] * rk[i] * rkj * betas[i] * dec : 0.f;
                  if (isq) QKs[i * P64 + j] = (bf16)f2bf((i >= j) ? acc[jj] * rq[i] * rkj * dec : 0.f); }
              if (!isq) { *(LAS f32x4*)(Lm + j * LMP + 16 * mt + quad * 4) = lv;
#pragma unroll
                  for (int jj = 0; jj < 4; ++jj) LR[(16 * mt + quad * 4 + jj) * P64 + j] = (bf16)f2bf(nt < mt ? lv[jj] : 0.f); } }
          const int dd = tid & 127, tq = tid >> 7;
          unsigned pw[8];
#pragma unroll
          for (int n = 0; n < 16; n += 2) { const int i0 = tq * 16 + n; const float v0 = bf2f(Ks[i0 * P128 + dd]) * rk[i0] * kes[i0], v1 = bf2f(Ks[(i0 + 1) * P128 + dd]) * rk[i0 + 1] * kes[i0 + 1]; pw[n >> 1] = pk2(v0, v1); }
          *(LAS u32x4*)(KT + dd * P64 + tq * 16) = (u32x4){pw[0], pw[1], pw[2], pw[3]};
          *(LAS u32x4*)(KT + dd * P64 + tq * 16 + 8) = (u32x4){pw[4], pw[5], pw[6], pw[7]}; }
#endif
        LDS_BARRIER();
        { const int i = tid >> 3, c0k = (tid & 7) * 16; const float sc = rk[i] * betas[i] * egs[i];
#pragma unroll
          for (int h2 = 0; h2 < 2; ++h2) { u32x4 v = *(LAS u32x4*)(Ks + i * P128 + c0k + 8 * h2);
#pragma unroll
              for (int q = 0; q < 4; ++q) v[q] = pk2(bflo(v[q]) * sc, bfhi(v[q]) * sc);
              *(LAS u32x4*)(Ks + i * P128 + c0k + 8 * h2) = v; } }
        if (w == 0) { const int bb = lane >> 4, c = lane & 15;
            float x[16];
#pragma unroll
            for (int r = 0; r < 16; ++r) x[r] = (r == c) ? 1.f : 0.f;
#pragma unroll
            for (int j = 0; j < 15; ++j) {
#pragma unroll
                for (int q4 = j / 4; q4 < 4; ++q4) { const f32x4 l4 = *(const LAS f32x4*)(Lm + (16 * bb + j) * LMP + 16 * bb + 4 * q4);
#pragma unroll
                    for (int jx = 0; jx < 4; ++jx) if (4 * q4 + jx > j) x[4 * q4 + jx] -= l4[jx] * x[j]; } }
            unsigned pw[8];
#pragma unroll
            for (int r = 0; r < 16; r += 2) { pw[r >> 1] = pk2(x[r], x[r + 1]); TM[(16 * bb + r) * P64 + 16 * bb + c] = (bf16)(pw[r >> 1] & 0xffffu); TM[(16 * bb + r + 1) * P64 + 16 * bb + c] = (bf16)(pw[r >> 1] >> 16); }
            *(LAS u32x4*)(TT + (16 * bb + c) * P64 + 16 * bb) = (u32x4){pw[0], pw[1], pw[2], pw[3]};
            *(LAS u32x4*)(TT + (16 * bb + c) * P64 + 16 * bb + 8) = (u32x4){pw[4], pw[5], pw[6], pw[7]}; }
        LDS_BARRIER();
#pragma unroll 1
        for (int lev = 1; lev < 4; ++lev) {
            if (w < 4 - lev) { const int bj = w, bi = w + lev;
                f32x4 m = (f32x4){0.f, 0.f, 0.f, 0.f};
#pragma unroll
                for (int ks = 0; ks < 2; ++ks) { const bf16x8 a = *(const LAS bf16x8*)(LR + (16 * bi + l15) * P64 + 32 * ks + quad * 8), bq = *(const LAS bf16x8*)(TT + (16 * bj + l15) * P64 + 32 * ks + quad * 8); m = mfma16(a, bq, m); }
                const u32x2 tl = *(const LAS u32x2*)(TM + (16 * bi + l15) * P64 + 16 * bi + quad * 4);
                const bf16x8 a2 = __builtin_bit_cast(bf16x8, (u32x4){tl.x, tl.y, 0u, 0u}), b2 = __builtin_bit_cast(bf16x8, (u32x4){pk2(m[0], m[1]), pk2(m[2], m[3]), 0u, 0u});
                const f32x4 t = mfma16(a2, b2, (f32x4){0.f, 0.f, 0.f, 0.f});
                const unsigned p0 = pk2(-t[0], -t[1]), p1 = pk2(-t[2], -t[3]);
                TM[(16 * bi + quad * 4 + 0) * P64 + 16 * bj + l15] = (bf16)(p0 & 0xffffu); TM[(16 * bi + quad * 4 + 1) * P64 + 16 * bj + l15] = (bf16)(p0 >> 16);
                TM[(16 * bi + quad * 4 + 2) * P64 + 16 * bj + l15] = (bf16)(p1 & 0xffffu); TM[(16 * bi + quad * 4 + 3) * P64 + 16 * bj + l15] = (bf16)(p1 >> 16);
                *(LAS u32x2*)(TT + (16 * bj + l15) * P64 + 16 * bi + quad * 4) = (u32x2){p0, p1}; }
            LDS_BARRIER();
        }
#ifndef NO_EFG
        bf16x8 Bst[4];
#pragma unroll
        for (int ks = 0; ks < 4; ++ks) Bst[ks] = pack_acc2(Sacc[2 * ks], Sacc[2 * ks + 1]);
        f32x4 vn[4];
#pragma unroll
        for (int mt = 0; mt < 4; ++mt) { f32x4 acc = (f32x4){0.f, 0.f, 0.f, 0.f};
#pragma unroll
            for (int ks = 0; ks < 4; ++ks) { const bf16x8 a = ld_split8(Ks + (16 * mt + l15) * P128 + 32 * ks + quad * 4); acc = mfma16(a, Bst[ks], acc); }
#pragma unroll
            for (int jj = 0; jj < 4; ++jj) { const int i = 16 * mt + quad * 4 + jj; vn[mt][jj] = bf2f(Vs[i * P128 + 16 * w + l15]) * betas[i] - acc[jj]; } }
        bf16x8 Bvn[2];
#pragma unroll
        for (int k2 = 0; k2 < 2; ++k2) Bvn[k2] = pack_acc2(vn[2 * k2], vn[2 * k2 + 1]);
#pragma unroll
        for (int mt = 0; mt < 4; ++mt) { f32x4 acc = (f32x4){0.f, 0.f, 0.f, 0.f};
#pragma unroll
            for (int k2 = 0; k2 < 2; ++k2) { const bf16x8 a = ld_split8(TM + (16 * mt + l15) * P64 + 32 * k2 + quad * 4); acc = mfma16(a, Bvn[k2], acc); }
            vn[mt] = acc; }
#pragma unroll
        for (int k2 = 0; k2 < 2; ++k2) Bvn[k2] = pack_acc2(vn[2 * k2], vn[2 * k2 + 1]);
#pragma unroll 1
        for (int mt = 0; mt < 4; ++mt) { f32x4 acc = (f32x4){0.f, 0.f, 0.f, 0.f};
#pragma unroll
            for (int ks = 0; ks < 4; ++ks) { const bf16x8 a = ld_split8(Qs + (16 * mt + l15) * P128 + 32 * ks + quad * 4); acc = mfma16(a, Bst[ks], acc); }
#pragma unroll
            for (int jj = 0; jj < 4; ++jj) { const int i = 16 * mt + quad * 4 + jj; acc[jj] *= rq[i] * egs[i]; }
#pragma unroll
            for (int k2 = 0; k2 < 2; ++k2) { const bf16x8 a = ld_split8(QKs + (16 * mt + l15) * P64 + 32 * k2 + quad * 4); acc = mfma16(a, Bvn[k2], acc); }
#pragma unroll
            for (int jj = 0; jj < 4; ++jj) { const int i = 16 * mt + quad * 4 + jj; const int t = c0 + (dir ? 63 - i : i);
                Odir[(size_t)(m0 + t) * 512 + hd * 128 + 16 * w + l15] = (bf16)f2bf(acc[jj]); } }
        const float egl = rq[384];
#pragma unroll
        for (int mt = 0; mt < 8; ++mt) { f32x4 acc = Sacc[mt] * egl;
#pragma unroll
            for (int k2 = 0; k2 < 2; ++k2) { const bf16x8 a = ld_split8(KT + (16 * mt + l15) * P64 + 32 * k2 + quad * 4); acc = mfma16(a, Bvn[k2], acc); }
            Sacc[mt] = acc; }
#endif
        WAVE_SYNC();
    }
    if (!lat) { const int tid2 = tid_fresh(wid0), lane2 = tid2 & 63; float* dp = P.out + OUT_DELTA + sbase + (size_t)((lane2 >> 4) * 4) * 128 + 16 * w + (lane2 & 15);
#pragma unroll
        for (int mt = 0; mt < 8; ++mt)
#pragma unroll
            for (int jj = 0; jj < 4; ++jj) dp[(16 * mt + jj) * 128] = Sacc[mt][jj];
    }
    __syncthreads();
}

__device__ __forceinline__ void phase_mix_even(int wid0, const Params& P, LAS unsigned char* lds, int e, int mode = 3) {
    const int bid = bid_fresh(), G = grid_fresh();
    if (G == 256) {
        if (bid < 64) { const int s = 32 + (bid >> 3), hd = (bid >> 1) & 3, dir = bid & 1; if (mode & 1) gdn_chain(wid0, P, lds, e, s, hd, dir); }
        else { const int bb = bid - 64;
            if (mode & 1) for (int c = bb; c < 256; c += 192) { const int s = c >> 3, hd = (c >> 1) & 3, dir = c & 1; gdn_chain(wid0, P, lds, e, s, hd, dir); }
            if (mode & 2) { const int tid = tid_fresh(wid0), lane = tid & 63, wave = tid >> 6;
                for (int t = bb; t < 384; t += 192) { const int wt = t * 8 + wave; s5_task_main(P, lds + wave * S5_WLDS, lane, e, wt >> 5, wt & 31); } } }
    } else {
        for (int c = bid; c < 320; c += G) { const int s = c < 64 ? 32 + (c >> 3) : ((c - 64) >> 3), hd = (c >> 1) & 3, dir = c & 1; gdn_chain(wid0, P, lds, e, s, hd, dir); }
        const int tid = tid_fresh(wid0), lane = tid & 63, wave = tid >> 6;
        for (int t = bid; t < 384; t += G) { const int wt = t * 8 + wave; s5_task_main(P, lds + wave * S5_WLDS, lane, e, wt >> 5, wt & 31); }
    }
}
__device__ __forceinline__ void phase_fin_even(int wid0, const Params& P, LAS unsigned char* lds, int e) {
    const int tid = tid_fresh(wid0), lane = tid & 63, wave = tid >> 6;
    const int gw = bid_fresh() * NWAVES + wave, NGW = grid_fresh() * NWAVES;
    for (int wt = gw; wt < 2048; wt += NGW) s5_task_corr(P, lds + wave * S5_WLDS, lane, e, wt >> 5, wt & 31);
    const bf16* proj = (const bf16*)(P.ws + WS_BIG); const bf16* Of = (const bf16*)(P.ws + WS_H); const bf16* Ob = Of + (size_t)MT * 512; bf16* mixout = (bf16*)(P.ws + WS_MIX);
    for (int m = gw; m < MT; m += NGW) {
        const u32x4 a = *(const u32x4*)(Of + (size_t)m * 512 + lane * 8), bq = *(const u32x4*)(Ob + (size_t)m * 512 + lane * 8), z = *(const u32x4*)(proj + (size_t)m * NPROJ_E + 2560 + lane * 8);
        float o[8]; float ss = 0.f;
#pragma unroll
        for (int j = 0; j < 4; ++j) { o[2 * j] = bflo(a[j]) + bflo(bq[j]); o[2 * j + 1] = bfhi(a[j]) + bfhi(bq[j]); ss += o[2 * j] * o[2 * j] + o[2 * j + 1] * o[2 * j + 1]; }
        ss += shfl_i(ss, lane ^ 1); ss += shfl_i(ss, lane ^ 2); ss += shfl_i(ss, lane ^ 4); ss += shfl_i(ss, lane ^ 8);
        const float rs = rsqrtf(ss * (1.0f / 128.0f) + EPSF);
        const float* gn = P.in[I_GONORM] + e * 128 + (lane & 15) * 8;
        unsigned pw[4];
#pragma unroll
        for (int j = 0; j < 4; ++j) { const float z0 = bflo(z[j]), z1 = bfhi(z[j]); pw[j] = pk2(o[2 * j] * rs * gn[2 * j] * siluf_(z0), o[2 * j + 1] * rs * gn[2 * j + 1] * siluf_(z1)); }
        *(u32x4*)(mixout + (size_t)m * DM + 512 + lane * 8) = (u32x4){pw[0], pw[1], pw[2], pw[3]};
    }
}

__device__ __forceinline__ void phase_conv_odd(int wid0, const Params& P, int o) {
    const int tid = tid_fresh(wid0), lane = tid & 63, wave = tid >> 6;
    const int gw = bid_fresh() * NWAVES + wave, NGW = grid_fresh() * NWAVES;
    const bf16* proj = (const bf16*)(P.ws + WS_BIG); bf16* cx = (bf16*)(P.ws + WS_H);
    const float* cw = P.in[I_LCONVW] + (size_t)o * 4 * 1024; const float* cb = P.in[I_LCONVB] + o * 1024;
    for (int m = gw; m < MT; m += NGW) {
        const int t = m < MCTX ? (m & 255) : ((m - MCTX) & 2047); const int L = m < MCTX ? LCTX : LLAT;
#pragma unroll
        for (int h2 = 0; h2 < 2; ++h2) { const int ch = lane * 8 + 512 * h2;
            float acc[8];
#pragma unroll
            for (int j = 0; j < 8; ++j) acc[j] = cb[ch + j];
#pragma unroll
            for (int k = 0; k < 4; ++k) { const int tt = t - 1 + k; if (tt >= 0 && tt < L) { const u32x4 v = *(const u32x4*)(proj + (size_t)(m - 1 + k) * 2048 + ch);
#pragma unroll
                    for (int j = 0; j < 4; ++j) { acc[2 * j] += cw[k * 1024 + ch + 2 * j] * bflo(v[j]); acc[2 * j + 1] += cw[k * 1024 + ch + 2 * j + 1] * bfhi(v[j]); } } }
            *(u32x4*)(cx + (size_t)m * DM + ch) = (u32x4){pk2(acc[0], acc[1]), pk2(acc[2], acc[3]), pk2(acc[4], acc[5]), pk2(acc[6], acc[7])}; }
    }
}
__device__ __forceinline__ void phase_lru_scan(int wid0, const Params& P, int o, int d) {
    const int tid = tid_fresh(wid0), lane = tid & 63, wave = tid >> 6;
    const int gw = bid_fresh() * NWAVES + wave, NGW = grid_fresh() * NWAVES;
    const unsigned* G = (const unsigned*)(P.ws + WS_GATES); const bf16* proj = (const bf16*)(P.ws + WS_BIG); bf16* mixout = (bf16*)(P.ws + WS_MIX);
    for (int task = gw; task < 640; task += NGW) {
        int s, cg_;
        if (task < 128) { s = 32 + (task >> 4); cg_ = task & 15; } else { s = (task - 128) >> 4; cg_ = (task - 128) & 15; }
        const bool lat = s >= 32; const int b = lat ? s - 32 : s; const int L = lat ? LLAT : LCTX; const int m0 = lat ? MCTX + b * LLAT : s * LCTX;
        const int ch = cg_ * 64 + lane;
        float h = lat ? P.in[I_SLRU][(((size_t)b * 2 + o) * 2 + d) * 1024 + ch] : 0.f;
        if (d == 0) {
            unsigned ga[32], gb[32];
#define LRU_LD0(dst, tt) _Pragma("unroll") for (int i = 0; i < 32; ++i) dst[i] = G[(size_t)(m0 + (tt) + i) * DM + ch]
#define LRU_CP0(src, tt) _Pragma("unroll") for (int i = 0; i < 32; ++i) { h = __builtin_amdgcn_exp2f(bflo(src[i])) * h + bfhi(src[i]); mixout[(size_t)(m0 + (tt) + i) * DM + ch] = (bf16)f2bf(h); }
            LRU_LD0(ga, 0);
            for (int t0 = 0; t0 < L; t0 += 64) {
                LRU_LD0(gb, t0 + 32);
                LRU_CP0(ga, t0);
                if (t0 + 64 < L) { LRU_LD0(ga, t0 + 64); }
                LRU_CP0(gb, t0 + 32);
            }
        } else {
            unsigned ga[16], gb[16]; bf16 pa[16], pb[16], ya[16], yb[16];
#define LRU_LD1(g_, p_, y_, tt) _Pragma("unroll") for (int i = 0; i < 16; ++i) { const size_t m = (size_t)(m0 + L - 1 - ((tt) + i)); g_[i] = G[m * DM + ch]; p_[i] = mixout[m * DM + ch]; y_[i] = proj[m * 2048 + 1024 + ch]; }
#define LRU_CP1(g_, p_, y_, tt) _Pragma("unroll") for (int i = 0; i < 16; ++i) { const size_t m = (size_t)(m0 + L - 1 - ((tt) + i)); \
                h = __builtin_amdgcn_exp2f(bflo(g_[i])) * h + bfhi(g_[i]); mixout[m * DM + ch] = (bf16)f2bf((bf2f(p_[i]) + h) * geluf_(bf2f(y_[i]))); }
            LRU_LD1(ga, pa, ya, 0);
            for (int t0 = 0; t0 < L; t0 += 32) {
                LRU_LD1(gb, pb, yb, t0 + 16);
                LRU_CP1(ga, pa, ya, t0);
                if (t0 + 32 < L) { LRU_LD1(ga, pa, ya, t0 + 32); }
                LRU_CP1(gb, pb, yb, t0 + 16);
            }
        }
        if (!lat) P.out[OUT_LRU + (((size_t)b * 2 + o) * 2 + d) * 1024 + ch] = h;
    }
}
#ifdef PROBE_DUP_GEMM
#define DUPG(x) GSYNC(); x
#else
#define DUPG(x)
#endif
typedef const __attribute__((address_space(4))) Params* KParams;
__device__ __forceinline__ Params load_params(KParams q) { Params r;
#pragma unroll
    for (int i = 0; i < 40; ++i) r.in[i] = q->in[i];
    r.out = q->out; r.ws = q->ws; return r; }
#define FRESH() const int G = grid_fresh(), bid = bid_fresh(); (void)G; (void)bid; KParams pk_ = (KParams)__builtin_amdgcn_kernarg_segment_ptr(); asm volatile("" : "+s"(pk_)); const Params P = load_params(pk_); unsigned char* ws = P.ws; \
    const float* mod = (const float*)(ws + WS_MOD); bf16* H = (bf16*)(ws + WS_H); bf16* BIG = (bf16*)(ws + WS_BIG); bf16* MIX = (bf16*)(ws + WS_MIX); (void)mod; (void)H; (void)BIG; (void)MIX;
#define GSYNC() do { KParams pb_ = (KParams)__builtin_amdgcn_kernarg_segment_ptr(); asm volatile("" : "+s"(pb_)); xcd_barrier(wid0, (unsigned*)(pb_->ws + WS_BAR), lds); } while (0)
__global__ void __launch_bounds__(NTHR, 2) fwd_kernel(Params Parg) {
    extern __shared__ __attribute__((aligned(16))) unsigned char lds_raw[];
    LAS unsigned char* lds = (LAS unsigned char*)lds_raw;
    cg::grid_group grid = cg::this_grid();
    const int wid0 = __builtin_amdgcn_readfirstlane(threadIdx.x >> 6);
    if (threadIdx.x < 4) ((LAS unsigned*)(lds + LDS_BARST))[threadIdx.x] = 0u;
    __syncthreads();
    if (threadIdx.x == 0) (void)xb_add((unsigned*)(Parg.ws + WS_BAR) + XB_XCNT(xb_xcc_id()), 1u);

    { FRESH(); phase_prologue(wid0, P, lds); }
    if (grid_fresh() == 0) grid.sync();
    GSYNC();
#ifdef PROBE_DUP_PRO
    { FRESH(); phase_prologue(wid0, P, lds); }
    GSYNC();
#endif
    { FRESH(); phase_modreduce(wid0, P); }
    GSYNC();
#ifdef PROBE_SYNC
#pragma unroll 1
    for (int i = 0; i < 40; ++i) GSYNC();
#endif
#pragma unroll 1
    for (int l = 0; l < 4; ++l) {
        { FRESH(); const float* modl = mod + (size_t)l * 9 * 6144;
        phase_rownorm(wid0, P, l == 0, MIX, modl - 9 * 6144, 5 * 1024, P.in[I_NMLPPOST] + (l > 0 ? (l - 1) * 1024 : 0), 1, P.in[I_NMIXPRE] + l * 1024, modl, 0, H); }
        GSYNC();
        const int eo = l >> 1;
        {
            FRESH();
            pg8::Gemm g; pg8::StaticOrder S; EpiBf16<0> E;
            if ((l & 1) == 0) { g = pg8::Gemm{H, (const bf16*)(ws + WS_WINE) + (size_t)eo * NB_E * 1024, MT, NB_E, 1024, 1024, 0, 0, 1024, 0}; E = EpiBf16<0>{BIG, NPROJ_E, (float*)(ws + WS_AB), (bf16*)(ws + WS_HALO)}; }
            else { g = pg8::Gemm{H, (const bf16*)(ws + WS_WINO) + (size_t)eo * 2048 * 1024, MT, 2048, 1024, 1024, 0, 0, 1024, 0}; E = EpiBf16<0>{BIG, 2048, nullptr, nullptr}; }
            S.init(g.M, g.N, G, bid);
            pg8::gemm_phase(wid0, lds, g, S, E); DUPG(pg8::gemm_phase(wid0, lds, g, S, E);)
        }
        GSYNC();
        if ((l & 1) == 0) {
            { FRESH(); phase_conv_even(wid0, P, eo); }
            GSYNC();
#ifdef PROBE_DUP_MIX
#pragma unroll 1
            for (int rep = 0; rep < 2; ++rep) { { FRESH(); phase_mix_even(wid0, P, lds, eo, rep == 0 ? 3 : PROBE_DUP_MIX); } GSYNC(); }
#else
            { FRESH(); phase_mix_even(wid0, P, lds, eo); }
            GSYNC();
#endif
            { FRESH(); phase_fin_even(wid0, P, lds, eo); }
            GSYNC();
        } else {
            { FRESH(); phase_conv_odd(wid0, P, eo); }
            GSYNC();
#ifdef PROBE_DUP_CONV
            { FRESH(); phase_conv_odd(wid0, P, eo); }
            GSYNC();
#endif
#pragma unroll 1
            for (int d = 0; d < 2; ++d) {
                { FRESH();
                pg8::Gemm g{H, (const bf16*)(ws + WS_WG) + (size_t)(eo * 2 + d) * 2048 * 256, MT, 2048, 256, 1024, 1, 1, 256, 0};
                EpiGates E{(unsigned*)(ws + WS_GATES), H, P.in[I_LBR] + (eo * 2 + d) * 1024, P.in[I_LBI] + (eo * 2 + d) * 1024, P.in[I_LLAM] + (eo * 2 + d) * 1024};
                pg8::StaticOrder S; S.init(g.M, g.N, G, bid);
                pg8::gemm_phase(wid0, lds, g, S, E); DUPG(pg8::gemm_phase(wid0, lds, g, S, E);) }
                GSYNC();
                { FRESH(); phase_lru_scan(wid0, P, eo, d); }
#ifdef PROBE_DUP_LRU0
                if (d == 0) { GSYNC(); FRESH(); phase_lru_scan(wid0, P, eo, d); }
#endif
                GSYNC();
            }
        }
        {
            FRESH();
            pg8::Gemm g{MIX, (const bf16*)(ws + ((l & 1) ? WS_WOUTO : WS_WOUTE)) + (size_t)eo * 1024 * 1024, MT, 1024, 1024, 1024, 0, 0, 1024, 0};
            EpiBf16<0> E{BIG, 1024, nullptr, nullptr}; pg8::StaticOrder S; S.init(g.M, g.N, G, bid);
            pg8::gemm_phase(wid0, lds, g, S, E); DUPG(pg8::gemm_phase(wid0, lds, g, S, E);)
        }
        GSYNC();
        { FRESH(); const float* modl = mod + (size_t)l * 9 * 6144;
        phase_rownorm(wid0, P, 0, BIG, modl, 2 * 1024, P.in[I_NMIXPOST] + l * 1024, 1, P.in[I_NMLPPRE] + l * 1024, modl, 3 * 1024, H); }
        GSYNC();
        {
            FRESH();
            pg8::Gemm g{H, (const bf16*)(ws + WS_W1T) + (size_t)l * 4096 * 1024, MT, 4096, 1024, 1024, 0, 0, 1024, 0};
            EpiBf16<1> E{BIG, 4096, nullptr, nullptr}; pg8::StaticOrder S; S.init(g.M, g.N, G, bid);
            pg8::gemm_phase(wid0, lds, g, S, E); DUPG(pg8::gemm_phase(wid0, lds, g, S, E);)
        }
        GSYNC();
        {
            FRESH();
            pg8::Gemm g{BIG, (const bf16*)(ws + WS_W2T) + (size_t)l * 1024 * 4096, MT, 1024, 4096, 4096, 0, 0, 4096, 0};
            EpiBf16<0> E{MIX, 1024, nullptr, nullptr}; pg8::StaticOrder S; S.init(g.M, g.N, G, bid);
            pg8::gemm_phase(wid0, lds, g, S, E); DUPG(pg8::gemm_phase(wid0, lds, g, S, E);)
        }
        GSYNC();
    }
    { FRESH();
    phase_rownorm(wid0, P, 0, MIX, mod + (size_t)3 * 9 * 6144, 5 * 1024, P.in[I_NMLPPOST] + 3 * 1024, 0, P.in[I_NMIXPRE], mod, 0, H); }
}

extern "C" void kernel_launch(void* const* d_in, const int* in_sizes, int n_in, void* d_out, int out_size, void* d_ws, size_t ws_size, hipStream_t stream) {
    static int grid = 0;
    if (grid == 0) {
        if (n_in != 40 || ws_size < WS_END) { fprintf(stderr, "kernel_launch: expected 40 inputs and >= %zu bytes of workspace (got %d, %zu)\n", (size_t)WS_END, n_in, ws_size); grid = -1; return; }
        int dev = 0, cus = 0, per_cu = 0;
        if (hipGetDevice(&dev) != hipSuccess || hipDeviceGetAttribute(&cus, hipDeviceAttributeMultiprocessorCount, dev) != hipSuccess) { grid = -1; return; }
        if (hipFuncSetAttribute((const void*)fwd_kernel, hipFuncAttributeMaxDynamicSharedMemorySize, LDS_BYTES) != hipSuccess) { fprintf(stderr, "kernel_launch: hipFuncSetAttribute failed\n"); grid = -1; return; }
        if (hipOccupancyMaxActiveBlocksPerMultiprocessor(&per_cu, (const void*)fwd_kernel, NTHR, LDS_BYTES) != hipSuccess || per_cu < 1) per_cu = 1;
        (void)hipGetLastError();
        grid = cus * per_cu; if (grid > 256) grid = 256;
    }
    if (grid < 0) return;
    (void)hipMemsetAsync((char*)d_ws + WS_BAR, 0, 16384, stream);
    Params p{};
    for (int i = 0; i < 40; ++i) p.in[i] = (const float*)d_in[i];
    p.out = (float*)d_out; p.ws = (unsigned char*)d_ws;
    void* args[] = {&p};
    hipError_t e = hipLaunchCooperativeKernel((const void*)fwd_kernel, dim3(grid), dim3(NTHR), args, LDS_BYTES, stream);
    if (e != hipSuccess) fprintf(stderr, "cooperative launch failed: %s (grid %d)\n", hipGetErrorString(e), grid);
}
```

```cpp
#include <hip/hip_runtime.h>
#include <hip/hip_cooperative_groups.h>
#include <cstdio>
#include <cstdint>
namespace cg = cooperative_groups;
__device__ __forceinline__ int bid_fresh() { int t = blockIdx.x; asm volatile("" : "+s"(t)); return t; }
__device__ __forceinline__ int grid_fresh() { int t = gridDim.x; asm volatile("" : "+s"(t)); return t; }
__device__ __forceinline__ int tid_fresh(int w) { asm volatile("" : "+s"(w)); int l; asm volatile("v_mbcnt_lo_u32_b32 %0, -1, 0\n\tv_mbcnt_hi_u32_b32 %0, -1, %0" : "=v"(l)); return w * 64 + l; }

namespace pg8 {
#define PG8_LAS __attribute__((address_space(3)))
typedef unsigned short bf16_t;
typedef short bf16x8 __attribute__((ext_vector_type(8)));
typedef float f32x4 __attribute__((ext_vector_type(4)));
typedef unsigned u32x4 __attribute__((ext_vector_type(4)));
typedef unsigned u32x2 __attribute__((ext_vector_type(2)));
constexpr int BM = 256, BK = 64, HALF = 128, HTB = HALF * BK * 2, STAGE_BYTES = 8 * HTB, NXCD = 8, WGM = 8;

__host__ __device__ __forceinline__ int lds_byte(int r, int c) { const int st = (r >> 4) * 2 + (c >> 5), rr = r & 15, cc = c & 31, ob = rr * 64 + cc * 2; return st * 1024 + (ob ^ (((ob >> 9) & 1) << 5)); }
__host__ __device__ __forceinline__ void stage_rc(int b, int& R, int& C) { const int st = b / 1024, sb = b % 1024, swz = sb ^ (((sb >> 9) & 1) << 5); R = (st >> 1) * 16 + swz / 64; C = (st & 1) * 32 + (swz % 64) / 2; }
__host__ __device__ __forceinline__ int perm32(int rho) { const int n = rho >> 4, i = rho & 15; return 8 * (i >> 2) + 4 * n + (i & 3); }

struct Unit { int pm, pn; };
struct Gemm { const bf16_t* A; const bf16_t* Bt; int M, N, K, lda, ablk, ashift, ldb, ksplit; };

struct StaticOrder {
    int nM, nN, nwg, G, c;
    __host__ __device__ void init(int M, int N, int G_, int c_) { nM = M / BM; nN = N / BM; nwg = nM * nN; G = G_; c = c_; }
    __host__ __device__ bool next(int i, Unit& u) const {
        const long L = (long)i * G + c; if (L >= nwg) return false;
        int wgid = (int)L; { const int q = nwg / NXCD, r = nwg % NXCD, xcd = wgid % NXCD, off = wgid / NXCD; wgid = (xcd < r ? xcd * (q + 1) : r * (q + 1) + (xcd - r) * q) + off; }
        const int nig = WGM * nN, gid = wgid / nig, fm = gid * WGM, gsz = (nM - fm) < WGM ? (nM - fm) : WGM;
        u.pm = fm + ((wgid % nig) % gsz); u.pn = (wgid % nig) / gsz; return true;
    }
};
__device__ __forceinline__ unsigned cvt_pk_bf16(float lo, float hi) { unsigned r; asm volatile("v_cvt_pk_bf16_f32 %0, %1, %2" : "=v"(r) : "v"(lo), "v"(hi)); return r; }

template <class Epi>
__device__ __forceinline__ void gemm_phase(int wid0, PG8_LAS unsigned char* lds, const Gemm g, const StaticOrder& S, const Epi& E) {
    const int tid = tid_fresh(wid0), wid = __builtin_amdgcn_readfirstlane(tid >> 6), lane = tid & 63, wr = wid >> 2, wc = wid & 3, fr = lane & 15, fq = lane >> 4;
    const int K = g.K, nt = K / BK, lda = g.lda, ldb = g.ldb;
    unsigned voffA[2], voffB[2];
#pragma unroll
    for (int i = 0; i < 2; ++i) { int R, C; stage_rc(tid * 16 + i * 8192, R, C); const int Rb = (R & ~31) + perm32(R & 31);
        voffA[i] = (unsigned)(R * lda + C) * 2u; voffB[i] = (unsigned)(Rb * ldb + C) * 2u; }
    const size_t kstep = (size_t)(BK * 2);
    const size_t hstepA = (size_t)HALF * lda * 2, hstepB = (size_t)HALF * ldb * 2;
    const size_t tstepA = 2 * hstepA, tstepB = 2 * hstepB;
    const unsigned ldsw = (unsigned)wid * 1024u;
    const int aoff = lds_byte(wr * 64 + fr, fq * 8), boff = lds_byte(wc * 32 + fr, fq * 8);
#define PG8_ACOL(pn) (g.ablk ? (size_t)((((pn) >> g.ashift) & 3) * 512) : (g.ksplit ? (size_t)((pn) & 1) * (size_t)K * 2 : (size_t)0))
#define PG8_BOFF(pn) (g.ksplit ? (size_t)((pn) >> 1) * tstepB + (size_t)((pn) & 1) * (size_t)K * 2 : (size_t)(pn) * tstepB)
#define PG8_SA(b, h) (((b) * 2 + (h)) * HTB)
#define PG8_SB(b, h) ((4 + (b) * 2 + (h)) * HTB)
#define PG8_STAGE(bufoff, gbase, voff) do { _Pragma("unroll") for (int _i = 0; _i < 2; ++_i) \
        __builtin_amdgcn_global_load_lds((const unsigned*)((const char*)(gbase) + (voff)[_i]), (PG8_LAS unsigned*)(lds + (bufoff) + ldsw + _i * 8192), 16, 0, 0); } while (0)
#define PG8_LDA(dst, b, h) do { _Pragma("unroll") for (int m = 0; m < 4; ++m) _Pragma("unroll") for (int k = 0; k < 2; ++k) dst[m][k] = *(const PG8_LAS bf16x8*)(lds + PG8_SA(b, h) + aoff + m * 2048 + k * 1024); } while (0)
#define PG8_LDB(dst, b, h) do { _Pragma("unroll") for (int n = 0; n < 2; ++n) _Pragma("unroll") for (int k = 0; k < 2; ++k) dst[n][k] = *(const PG8_LAS bf16x8*)(lds + PG8_SB(b, h) + boff + n * 2048 + k * 1024); } while (0)
#define PG8_MMA(ai, bj, At, Bt) do { __builtin_amdgcn_s_setprio(1); _Pragma("unroll") for (int m = 0; m < 4; ++m) _Pragma("unroll") for (int n = 0; n < 2; ++n) _Pragma("unroll") for (int k = 0; k < 2; ++k) \
        acc[ai][bj][m][n] = __builtin_amdgcn_mfma_f32_16x16x32_bf16(Bt[n][k], At[m][k], acc[ai][bj][m][n], 0, 0, 0); __builtin_amdgcn_s_setprio(0); } while (0)
#define PG8_WAIT_V(n) asm volatile("s_waitcnt vmcnt(" #n ")" ::: "memory")
#define PG8_WAIT_L(n) asm volatile("s_waitcnt lgkmcnt(" #n ")" ::: "memory")
#define PG8_BAR __builtin_amdgcn_s_barrier()
#define PG8_SCHED __builtin_amdgcn_sched_barrier(0)
    Unit cur, nxt; int ui = 0;
    if (!S.next(0, cur)) return;
    f32x4 acc[2][2][4][2];
#pragma unroll
    for (int a = 0; a < 2; ++a)
#pragma unroll
        for (int b = 0; b < 2; ++b)
#pragma unroll
            for (int m = 0; m < 4; ++m)
#pragma unroll
                for (int n = 0; n < 2; ++n) acc[a][b][m][n] = (f32x4){0.f, 0.f, 0.f, 0.f};
    bf16x8 At[4][2], B0[2][2], B1[2][2];
    const char* cA = (const char*)g.A + (size_t)cur.pm * tstepA + PG8_ACOL(cur.pn); const char* cB = (const char*)g.Bt + PG8_BOFF(cur.pn);
    PG8_STAGE(PG8_SB(0, 0), cB, voffB); PG8_STAGE(PG8_SA(0, 0), cA, voffA); PG8_STAGE(PG8_SB(0, 1), cB + hstepB, voffB); PG8_STAGE(PG8_SA(0, 1), cA + hstepA, voffA);
    if (wr == 1) PG8_BAR;
    PG8_WAIT_V(4); PG8_BAR;
    PG8_STAGE(PG8_SB(1, 0), cB + kstep, voffB); PG8_STAGE(PG8_SA(1, 0), cA + kstep, voffA); PG8_STAGE(PG8_SB(1, 1), cB + hstepB + kstep, voffB);
    PG8_WAIT_V(6); PG8_BAR;
    for (;;) {
        const bool has_next = S.next(ui + 1, nxt);
        const char* nA = has_next ? (const char*)g.A + (size_t)nxt.pm * tstepA + PG8_ACOL(nxt.pn) : cA; const char* nB = has_next ? (const char*)g.Bt + PG8_BOFF(nxt.pn) : cB;
        for (int t = 0; t < nt; t += 2) {
            const bool last = (t == nt - 2);
            const char* a1 = cA + (size_t)(t + 1) * kstep;
            const char* a2 = last ? nA : cA + (size_t)(t + 2) * kstep; const char* b2 = last ? nB : cB + (size_t)(t + 2) * kstep;
            const char* a3 = a2 + kstep; const char* b3 = b2 + kstep;
            PG8_LDB(B0, 0, 0); PG8_SCHED; PG8_LDA(At, 0, 0); PG8_STAGE(PG8_SA(1, 1), a1 + hstepA, voffA);
            PG8_WAIT_L(8); PG8_BAR; PG8_WAIT_L(0); PG8_MMA(0, 0, At, B0); PG8_BAR; PG8_SCHED;
            PG8_LDB(B1, 0, 1); PG8_STAGE(PG8_SB(0, 0), b2, voffB);
            PG8_BAR; PG8_WAIT_L(0); PG8_MMA(0, 1, At, B1); PG8_BAR;
            PG8_LDA(At, 0, 1); PG8_STAGE(PG8_SA(0, 0), a2, voffA);
            PG8_BAR; PG8_WAIT_L(0); PG8_MMA(1, 0, At, B0); PG8_BAR; PG8_SCHED;
            PG8_STAGE(PG8_SB(0, 1), b2 + hstepB, voffB);
            PG8_WAIT_V(6); PG8_BAR; PG8_MMA(1, 1, At, B1); PG8_BAR;
            PG8_LDB(B0, 1, 0); PG8_SCHED; PG8_LDA(At, 1, 0); PG8_STAGE(PG8_SA(0, 1), a2 + hstepA, voffA);
            PG8_WAIT_L(8); PG8_BAR; PG8_WAIT_L(0); PG8_MMA(0, 0, At, B0); PG8_BAR; PG8_SCHED;
            PG8_LDB(B1, 1, 1); PG8_STAGE(PG8_SB(1, 0), b3, voffB);
            PG8_BAR; PG8_WAIT_L(0); PG8_MMA(0, 1, At, B1); PG8_BAR;
            PG8_LDA(At, 1, 1); PG8_STAGE(PG8_SA(1, 0), a3, voffA);
            PG8_BAR; PG8_WAIT_L(0); PG8_MMA(1, 0, At, B0); PG8_BAR; PG8_SCHED;
            PG8_STAGE(PG8_SB(1, 1), b3 + hstepB, voffB);
            PG8_WAIT_V(6); PG8_BAR; PG8_MMA(1, 1, At, B1); PG8_BAR;
        }
        E(acc, cur, wr, wc, fr, fq);
        if (!has_next) break;
#pragma unroll
        for (int a = 0; a < 2; ++a)
#pragma unroll
            for (int b = 0; b < 2; ++b)
#pragma unroll
                for (int m = 0; m < 4; ++m)
#pragma unroll
                    for (int n = 0; n < 2; ++n) acc[a][b][m][n] = (f32x4){0.f, 0.f, 0.f, 0.f};
        cur = nxt; cA = nA; cB = nB; ++ui;
    }
    PG8_WAIT_V(0);
    if (wr == 0) PG8_BAR;
    PG8_BAR;
#undef PG8_ACOL
#undef PG8_BOFF
#undef PG8_SA
#undef PG8_SB
#undef PG8_STAGE
#undef PG8_LDA
#undef PG8_LDB
#undef PG8_MMA
#undef PG8_WAIT_V
#undef PG8_WAIT_L
#undef PG8_BAR
#undef PG8_SCHED
}
}
#define LAS __attribute__((address_space(3)))
typedef unsigned short bf16;
typedef short bf16x8 __attribute__((ext_vector_type(8)));
typedef float f32x4 __attribute__((ext_vector_type(4)));
typedef unsigned u32x4 __attribute__((ext_vector_type(4)));
typedef unsigned u32x2 __attribute__((ext_vector_type(2)));
constexpr int DM = 1024, MT = 24576, MCTX = 8192, LCTX = 256, LLAT = 2048, NWAVES = 8, NTHR = 512;
constexpr int NPROJ_E = 3072, NB_E = 3328, IN_EVEN_LD = 3088;
constexpr float EPSF = 1e-6f;
constexpr size_t MiB = 1u << 20;
constexpr size_t WS_MOD = 0, MOD_BYTES = 4 * 9 * 6144 * 4, WS_S5F = 1 * MiB, WS_AB = 3 * MiB, WS_W1T = 5 * MiB, WS_W2T = 37 * MiB, WS_WINE = 69 * MiB,
                 WS_WOUTE = 82 * MiB, WS_WINO = 86 * MiB, WS_WOUTO = 94 * MiB, WS_WG = 98 * MiB, WS_H = 102 * MiB, WS_BIG = 150 * MiB, WS_YBUF = 294 * MiB,
                 WS_GATES = 246 * MiB, WS_MIX = 342 * MiB, WS_HALO = 390 * MiB, WS_END = 390 * MiB + 384 * 3 * 1536 * 2;
constexpr int LDS_BYTES = 147456;
constexpr size_t OUT_S5RE = 25165824, OUT_S5IM = OUT_S5RE + 262144, OUT_DELTA = OUT_S5IM + 262144, OUT_LRU = OUT_DELTA + 8388608;

struct Params { const float* in[40]; float* out; unsigned char* ws; };
enum { I_XP = 0, I_XS, I_S5RE, I_S5IM, I_SDELTA, I_SLRU, I_C, I_CCTX, I_WADA, I_BADA, I_NMIXPRE, I_NMIXPOST, I_NMLPPRE, I_NMLPPOST, I_WMLPIN, I_WMLPOUT, I_WINE, I_WOUTE,
       I_LAMRE, I_LAMIM, I_LOGDT, I_BRE, I_BIM, I_CRE, I_CIM, I_S5D, I_GCONVW, I_GCONVB, I_GALOG, I_GDTB, I_GONORM, I_WINO, I_WOUTO, I_LCONVW, I_LCONVB, I_LWR, I_LBR, I_LWI, I_LBI, I_LLAM };

typedef __bf16 bf2_t __attribute__((ext_vector_type(2)));
typedef float f2_t __attribute__((ext_vector_type(2)));
__device__ __forceinline__ unsigned pk2(float lo, float hi) { const bf2_t v = __builtin_convertvector((f2_t){lo, hi}, bf2_t); return __builtin_bit_cast(unsigned, v); }
__device__ __forceinline__ unsigned f2bf(float f) { return pk2(f, f) & 0xffffu; }
__device__ __forceinline__ float bflo(unsigned w) { return __builtin_bit_cast(float, w << 16); }
__device__ __forceinline__ float bfhi(unsigned w) { return __builtin_bit_cast(float, w & 0xffff0000u); }
__device__ __forceinline__ float bf2f(bf16 b) { return __builtin_bit_cast(float, (unsigned)b << 16); }
__device__ __forceinline__ float sigmoidf_(float x) { return __builtin_amdgcn_rcpf(1.0f + __expf(-x)); }
__device__ __forceinline__ float siluf_(float x) { return x * sigmoidf_(x); }
__device__ __forceinline__ float softplusf_(float x) { return fmaxf(x, 0.f) + __logf(1.0f + __expf(-fabsf(x))); }
__device__ __forceinline__ float geluf_(float x) { const float y = 0.7978845608028654f * (x + 0.044715f * x * x * x); const float t = 1.0f - 2.0f * __builtin_amdgcn_rcpf(__expf(2.0f * y) + 1.0f); return 0.5f * x * (1.0f + t); }
__device__ __forceinline__ float shfl_i(float v, int srclane) { return __builtin_bit_cast(float, __builtin_amdgcn_ds_bpermute(srclane << 2, __builtin_bit_cast(int, v))); }
__device__ __forceinline__ float wave_sum(float v, int lane) {
#pragma unroll
    for (int o = 1; o < 64; o <<= 1) v += shfl_i(v, lane ^ o);
    return v;
}
#define LDS_WAIT() asm volatile("s_waitcnt lgkmcnt(0)" ::: "memory")
#define WAVE_SYNC() do { asm volatile("s_waitcnt lgkmcnt(0)" ::: "memory"); __builtin_amdgcn_wave_barrier(); } while (0)
__device__ __forceinline__ f32x4 mfma16(bf16x8 a, bf16x8 b, f32x4 c) { return __builtin_amdgcn_mfma_f32_16x16x32_bf16(a, b, c, 0, 0, 0); }


#define XB_TMO      128
#define XB_XCNT(j)  (256  + 64 * (j))
#define XB_XSUB(j)  (1280 + 64 * (j))
#define XB_XGEN(j)  (2304 + 64 * (j))
#define XB_TOP      3328
#define XB_TOPGEN   3392
#define XCD_BAR_WORDS 3456
#define XB_SPIN_CAP (1u << 18)
constexpr size_t WS_BAR = 960 * 1024; constexpr int LDS_BARST = LDS_BYTES - 16;
__device__ __forceinline__ unsigned xb_ld(unsigned* p)              { return __hip_atomic_load(p, __ATOMIC_RELAXED, __HIP_MEMORY_SCOPE_AGENT); }
__device__ __forceinline__ unsigned xb_add(unsigned* p, unsigned v) { return __hip_atomic_fetch_add(p, v, __ATOMIC_RELAXED, __HIP_MEMORY_SCOPE_AGENT); }
__device__ __forceinline__ unsigned xb_xcc_id() { return (unsigned)__builtin_amdgcn_s_getreg((3 << 11) | 20) & 0xFu; }
#define XB_SPIN(cond, bar) do { unsigned _sp = 0; while (cond) { __builtin_amdgcn_s_sleep(1); \
    if ((++_sp & 255u) == 0u) { if (xb_ld(&(bar)[XB_TMO])) break; if (_sp > XB_SPIN_CAP) { atomicAdd(&(bar)[XB_TMO], 1u); break; } } } } while (0)
__device__ __forceinline__ void xcd_barrier_complete(unsigned* bar, unsigned x, unsigned& nloc, unsigned& nx) {
    const unsigned G = gridDim.x;
    unsigned sum, cnt, mine, sp = 0u;
    for (;;) {
        sum = 0u; cnt = 0u; mine = 0u;
#pragma unroll
        for (unsigned j = 0; j < 16; ++j) { const unsigned c = xb_ld(&bar[XB_XCNT(j)]); sum += c; cnt += (c > 0u) ? 1u : 0u; mine = (j == x) ? c : mine; }
        if (sum == G) break;
        __builtin_amdgcn_s_sleep(1);
        if ((++sp & 255u) == 0u) { if (xb_ld(&bar[XB_TMO])) break; if (sp > XB_SPIN_CAP) { atomicAdd(&bar[XB_TMO], 1u); break; } }
    }
    nloc = mine > 0u ? mine : 1u; nx = cnt > 0u ? cnt : 1u;
}
__device__ __forceinline__ void xcd_barrier(int wid0, unsigned* bar, LAS unsigned char* lds) {
    const int tid = tid_fresh(wid0);
    asm volatile("s_waitcnt vmcnt(0)" ::: "memory");
    __syncthreads();
    if (tid == 0) {
        const unsigned x = xb_xcc_id();
        volatile LAS unsigned* st = (volatile LAS unsigned*)(lds + LDS_BARST);
        __builtin_amdgcn_s_waitcnt(0);
        unsigned nloc = st[0], nx = st[1];
        if (nloc == 0u) { xcd_barrier_complete(bar, x, nloc, nx); st[0] = nloc; st[1] = nx; }
        const unsigned old = xb_add(&bar[XB_XSUB(x)], 1u);
        const unsigned gen = old / nloc;
        if (old + 1u == (gen + 1u) * nloc) {
            __builtin_amdgcn_fence(__ATOMIC_RELEASE, "agent");
            asm volatile("s_waitcnt vmcnt(0)" ::: "memory");
            const unsigned og = xb_add(&bar[XB_TOP], 1u);
            const unsigned tg = og / nx;
            if (og + 1u == (tg + 1u) * nx) xb_add(&bar[XB_TOPGEN], 1u);
            else XB_SPIN(xb_ld(&bar[XB_TOPGEN]) == tg, bar);
            __builtin_amdgcn_fence(__ATOMIC_ACQUIRE, "agent");
            xb_add(&bar[XB_XGEN(x)], 1u);
            asm volatile("s_waitcnt vmcnt(0)" ::: "memory");
        } else {
            XB_SPIN(xb_ld(&bar[XB_XGEN(x)]) == gen, bar);
            __builtin_amdgcn_fence(__ATOMIC_ACQUIRE, "agent");
            asm volatile("s_waitcnt vmcnt(0)" ::: "memory");
        }
    }
    __syncthreads();
}
__device__ __forceinline__ void transpose_item(const float* W, int ldw, int nvalid, int K, bf16* WT, int dst_row0, LAS float* scr, int k0, int n0, int lane) {
    const int nn = n0 + (lane & 31); const bool ok = nn < nvalid;
#pragma unroll 8
    for (int i = 0; i < 32; ++i) { const int kk = 2 * i + (lane >> 5); scr[kk * 33 + (lane & 31)] = ok ? W[(size_t)(k0 + kk) * ldw + nn] : 0.f; }
    WAVE_SYNC();
    const int c = lane & 7;
#pragma unroll
    for (int j = 0; j < 4; ++j) { const int n = (lane >> 3) + 8 * j; const LAS float* s = scr + (8 * c) * 33 + n;
        u32x4 o; o.x = pk2(s[0 * 33], s[1 * 33]); o.y = pk2(s[2 * 33], s[3 * 33]); o.z = pk2(s[4 * 33], s[5 * 33]); o.w = pk2(s[6 * 33], s[7 * 33]);
        *(u32x4*)(WT + (size_t)(dst_row0 + n) * K + k0 + 8 * c) = o; }
    WAVE_SYNC();
}
constexpr int WITEMS_EVEN = 4096 + 1552 + 512, WITEMS_ODD = 4096 + 1024 + 512 + 512;
__device__ __forceinline__ void weight_item(const Params& P, LAS float* scr, int l, int r, int lane) {
    unsigned char* ws = P.ws; const int eo = l >> 1;
    if (r < 2048) { const int q = r; transpose_item(P.in[I_WMLPIN] + (size_t)l * 1024 * 4096, 4096, 4096, 1024, (bf16*)(ws + WS_W1T) + (size_t)l * 4096 * 1024, 32 * (q & 127), scr, 64 * (q >> 7), 32 * (q & 127), lane); return; } r -= 2048;
    if (r < 2048) { const int q = r; transpose_item(P.in[I_WMLPOUT] + (size_t)l * 4096 * 1024, 1024, 1024, 4096, (bf16*)(ws + WS_W2T) + (size_t)l * 1024 * 4096, 32 * (q & 31), scr, 64 * (q >> 5), 32 * (q & 31), lane); return; } r -= 2048;
    if ((l & 1) == 0) {
        if (r < 1552) { const int kb = r / 97, nb = r % 97; transpose_item(P.in[I_WINE] + (size_t)eo * 1024 * IN_EVEN_LD, IN_EVEN_LD, IN_EVEN_LD, 1024, (bf16*)(ws + WS_WINE) + (size_t)eo * NB_E * 1024, 32 * nb, scr, 64 * kb, 32 * nb, lane); return; } r -= 1552;
        { const int q = r; transpose_item(P.in[I_WOUTE] + (size_t)eo * 1024 * 1024, 1024, 1024, 1024, (bf16*)(ws + WS_WOUTE) + (size_t)eo * 1024 * 1024, 32 * (q & 31), scr, 64 * (q >> 5), 32 * (q & 31), lane); return; }
    } else {
        if (r < 1024) { const int q = r; transpose_item(P.in[I_WINO] + (size_t)eo * 1024 * 2048, 2048, 2048, 1024, (bf16*)(ws + WS_WINO) + (size_t)eo * 2048 * 1024, 32 * (q & 63), scr, 64 * (q >> 6), 32 * (q & 63), lane); return; } r -= 1024;
        if (r < 512) { const int q = r; transpose_item(P.in[I_WOUTO] + (size_t)eo * 1024 * 1024, 1024, 1024, 1024, (bf16*)(ws + WS_WOUTO) + (size_t)eo * 1024 * 1024, 32 * (q & 31), scr, 64 * (q >> 5), 32 * (q & 31), lane); return; } r -= 512;
        { const int mat = eo * 16 + (r >> 5), q = r & 31, kb = q >> 3, nb = q & 7; const int blk = mat & 3, gate = (mat >> 2) & 1, od = mat >> 3;
          const float* src = (gate ? P.in[I_LWI] : P.in[I_LWR]) + (size_t)(od * 4 + blk) * 65536;
          const int j0 = nb * 32; const int drow = (blk * 2 + (j0 >> 7)) * 256 + gate * 128 + (j0 & 127);
          transpose_item(src, 256, 256, 256, (bf16*)(ws + WS_WG) + (size_t)od * 2048 * 256, drow, scr, 64 * kb, j0, lane); return; }
    }
}
__device__ __forceinline__ void phase_prologue(int wid0, const Params& P, LAS unsigned char* lds) {
    const int tid = tid_fresh(wid0), lane = tid & 63, wave = tid >> 6;
    LAS float* scr = (LAS float*)(lds + wave * 16384);
    const int gw = bid_fresh() * NWAVES + wave, NGW = grid_fresh() * NWAVES;
    unsigned char* ws = P.ws;
    constexpr int NTR = WITEMS_EVEN, NMOD = 4 * 24 * 16;
    for (int it = gw; it < NTR + NMOD; it += NGW) {
        int r = it;
        if (r < NTR) { weight_item(P, scr, 0, r, lane); continue; } r -= NTR;
        {
            const int l = r / 384, rem = r % 384, ec = rem >> 4, ks = rem & 15, k0 = ks * 64;
#pragma unroll
            for (int rr = 0; rr < 9; ++rr) { const float cv = rr == 0 ? P.in[I_CCTX][k0 + lane] : P.in[I_C][(rr - 1) * 1024 + k0 + lane]; scr[rr * 64 + lane] = siluf_(cv); }
            WAVE_SYNC();
            f32x4 acc[9];
#pragma unroll
            for (int rr = 0; rr < 9; ++rr) acc[rr] = (f32x4){0.f, 0.f, 0.f, 0.f};
            const float* wp = P.in[I_WADA] + ((size_t)l * 1024 + k0) * 6144 + ec * 256 + lane * 4;
#pragma unroll 4
            for (int kk = 0; kk < 64; ++kk) { const f32x4 w4 = *(const f32x4*)(wp + (size_t)kk * 6144);
#pragma unroll
                for (int rr = 0; rr < 9; ++rr) acc[rr] += w4 * scr[rr * 64 + kk]; }
            float* part = (float*)(ws + WS_BIG) + ((size_t)(ks * 4 + l) * 9) * 6144 + ec * 256 + lane * 4;
#pragma unroll
            for (int rr = 0; rr < 9; ++rr) *(f32x4*)(part + (size_t)rr * 6144) = acc[rr];
            WAVE_SYNC();
        }
    }
    { const size_t per = (size_t)(NB_E - 3104) * 1024 * 2 / 16;
      for (size_t i = (size_t)bid_fresh() * NTHR + tid; i < 2 * per; i += (size_t)grid_fresh() * NTHR) { const size_t e = i / per, q = i % per;
          *(u32x4*)(ws + WS_WINE + (e * NB_E + 3104) * 1024 * 2 + q * 16) = (u32x4){0u, 0u, 0u, 0u}; } }
}
__device__ __forceinline__ void phase_modreduce(int wid0, const Params& P) {
    const int tid = tid_fresh(wid0);
    const float* part = (const float*)(P.ws + WS_BIG); float* mod = (float*)(P.ws + WS_MOD);
    for (int i = bid_fresh() * NTHR + tid; i < 4 * 9 * 6144 / 4; i += grid_fresh() * NTHR) {
        const int l = i / (9 * 1536), e4 = i % 1536;
        f32x4 a = *(const f32x4*)(P.in[I_BADA] + (size_t)l * 6144 + e4 * 4);
#pragma unroll
        for (int ks = 0; ks < 16; ++ks) a += *(const f32x4*)(part + (size_t)ks * 4 * 9 * 6144 + (size_t)i * 4);
        *(f32x4*)(mod + (size_t)i * 4) = a; }
}
__device__ __forceinline__ void phase_rownorm(int wid0, const Params& P, int first, const bf16* obuf, const float* modg, int goff, const float* gpost, int has_next, const float* gpre, const float* mods, int soff, bf16* H) {
    const int tid = tid_fresh(wid0), lane = tid & 63, wave = tid >> 6;
    const int gw = bid_fresh() * NWAVES + wave, NGW = grid_fresh() * NWAVES;
    float* X = P.out;
    for (int m = gw; m < MT; m += NGW) {
        const int modrow = m < MCTX ? 0 : 1 + ((m - MCTX) >> 11);
        const float* mr = modg + (size_t)modrow * 6144; const float* ms = mods + (size_t)modrow * 6144;
        f32x4 x[4];
        if (first) {
            if (m < MCTX) {
#pragma unroll
                for (int j = 0; j < 4; ++j) x[j] = *(const f32x4*)(P.in[I_XP] + (size_t)m * DM + lane * 4 + 256 * j);
            } else {
                const int t = (m - MCTX) & 2047; const float prow = (float)(t >> 6), pcol = (float)(t & 63);
                f32x4 om;
#pragma unroll
                for (int e = 0; e < 4; ++e) om[e] = exp2f(-(float)(lane * 4 + e) * (13.287712379549449f / 256.0f));
#pragma unroll
                for (int j = 0; j < 4; ++j) { x[j] = *(const f32x4*)(P.in[I_XS] + (size_t)(m - MCTX) * DM + lane * 4 + 256 * j);
#pragma unroll
                    for (int e = 0; e < 4; ++e) { const float a = (j < 2 ? prow : pcol) * om[e]; x[j][e] += (j & 1) ? cosf(a) : sinf(a); } }
            }
        } else {
            u32x2 ov[4]; float ss = 0.f;
#pragma unroll
            for (int j = 0; j < 4; ++j) { x[j] = *(const f32x4*)(X + (size_t)m * DM + lane * 4 + 256 * j); ov[j] = *(const u32x2*)(obuf + (size_t)m * DM + lane * 4 + 256 * j); }
#pragma unroll
            for (int j = 0; j < 4; ++j) { const float a = bflo(ov[j].x), b = bfhi(ov[j].x), c = bflo(ov[j].y), d = bfhi(ov[j].y); ss += (a * a + b * b) + (c * c + d * d); }
            const float rs = rsqrtf(wave_sum(ss, lane) * (1.0f / DM) + EPSF);
#pragma unroll
            for (int j = 0; j < 4; ++j) { const f32x4 g4 = *(const f32x4*)(gpost + lane * 4 + 256 * j), gt = *(const f32x4*)(mr + goff + lane * 4 + 256 * j);
                f32x4 o4 = (f32x4){bflo(ov[j].x), bfhi(ov[j].x), bflo(ov[j].y), bfhi(ov[j].y)};
                x[j] += gt * (o4 * rs * g4); }
        }
#pragma unroll
        for (int j = 0; j < 4; ++j) *(f32x4*)(X + (size_t)m * DM + lane * 4 + 256 * j) = x[j];
        if (has_next) {
            float ss = 0.f;
#pragma unroll
            for (int j = 0; j < 4; ++j) ss += (x[j][0] * x[j][0] + x[j][1] * x[j][1]) + (x[j][2] * x[j][2] + x[j][3] * x[j][3]);
            const float rs = rsqrtf(wave_sum(ss, lane) * (1.0f / DM) + EPSF);
#pragma unroll
            for (int j = 0; j < 4; ++j) { const f32x4 g4 = *(const f32x4*)(gpre + lane * 4 + 256 * j), sh = *(const f32x4*)(ms + soff + lane * 4 + 256 * j), sc = *(const f32x4*)(ms + soff + 1024 + lane * 4 + 256 * j);
                const f32x4 h4 = (x[j] * rs * g4) * (sc + 1.0f) + sh;
                u32x2 w; w.x = pk2(h4[0], h4[1]); w.y = pk2(h4[2], h4[3]);
                *(u32x2*)(H + (size_t)m * DM + lane * 4 + 256 * j) = w; }
        }
    }
}

using pg8::Unit;
template <int ACT  > struct EpiBf16 {
    bf16* O; int ldc; float* AB;
    bf16* HALO;
    __device__ __forceinline__ void operator()(const f32x4 (&acc)[2][2][4][2], const Unit& u, int wr, int wc, int fr, int fq) const {
        const int row0 = u.pm * 256 + wr * 64 + fr, col0 = u.pn * 256 + wc * 32 + 8 * fq;
        if (AB && u.pn * 256 >= ldc) {
            if (wc == 0 && fq < 2) {
#pragma unroll
                for (int ai = 0; ai < 2; ++ai)
#pragma unroll
                    for (int m = 0; m < 4; ++m) { float* p = AB + (size_t)(row0 + ai * 128 + m * 16) * 16 + 8 * fq; *(f32x4*)p = acc[ai][0][m][0]; *(f32x4*)(p + 4) = acc[ai][0][m][1]; }
            }
            return;
        }
#pragma unroll
        for (int ai = 0; ai < 2; ++ai)
#pragma unroll
            for (int m = 0; m < 4; ++m) { bf16* rowp = O + (size_t)(row0 + ai * 128 + m * 16) * ldc + col0;
#pragma unroll
                for (int bj = 0; bj < 2; ++bj) { f32x4 v0 = acc[ai][bj][m][0], v1 = acc[ai][bj][m][1];
                    if (ACT == 1) {
#pragma unroll
                        for (int j = 0; j < 4; ++j) { const float a = fmaxf(v0[j], 0.f), b = fmaxf(v1[j], 0.f); v0[j] = a * a; v1[j] = b * b; } }
                    u32x4 w; w.x = pk2(v0[0], v0[1]); w.y = pk2(v0[2], v0[3]); w.z = pk2(v1[0], v1[1]); w.w = pk2(v1[2], v1[3]);
                    *(u32x4*)(rowp + bj * 128) = w;
                    if (ACT == 0 && HALO && u.pn >= 4 && u.pn < 10 && ((m == 3 && fr == 15) || (m == 0 && fr < 2))) {
                        const int r = row0 + ai * 128 + m * 16; const int which = (m == 3) ? 0 : 1 + fr;
                        *(u32x4*)(HALO + ((size_t)(r >> 6) * 3 + which) * 1536 + (col0 + bj * 128 - 1024)) = w; } } }
    }
};
struct EpiSplit {
    bf16* O0; long stride;
    __device__ __forceinline__ void operator()(const f32x4 (&acc)[2][2][4][2], const Unit& u, int wr, int wc, int fr, int fq) const {
        const int row0 = u.pm * 256 + wr * 64 + fr, col0 = (u.pn >> 1) * 256 + wc * 32 + 8 * fq; bf16* O = O0 + (long)(u.pn & 1) * stride;
#pragma unroll
        for (int ai = 0; ai < 2; ++ai)
#pragma unroll
            for (int m = 0; m < 4; ++m) { bf16* rowp = O + (size_t)(row0 + ai * 128 + m * 16) * DM + col0;
#pragma unroll
                for (int bj = 0; bj < 2; ++bj) { const f32x4 v0 = acc[ai][bj][m][0], v1 = acc[ai][bj][m][1];
                    u32x4 w; w.x = pk2(v0[0], v0[1]); w.y = pk2(v0[2], v0[3]); w.z = pk2(v1[0], v1[1]); w.w = pk2(v1[2], v1[3]);
                    *(u32x4*)(rowp + bj * 128) = w; } }
    }
};
struct EpiGates {
    unsigned* G; const bf16* X; const float* br; const float* bi; const float* lam;
    __device__ __forceinline__ void operator()(const f32x4 (&acc)[2][2][4][2], const Unit& u, int wr, int wc, int fr, int fq) const {
        const int row0 = u.pm * 256 + wr * 64 + fr, ch0 = u.pn * 128 + wc * 32 + 8 * fq;
#pragma unroll
        for (int n = 0; n < 2; ++n) {
            const f32x4 vbr = *(const f32x4*)(br + ch0 + 4 * n), vbi = *(const f32x4*)(bi + ch0 + 4 * n), l4 = *(const f32x4*)(lam + ch0 + 4 * n);
            f32x4 vsp;
#pragma unroll
            for (int e = 0; e < 4; ++e) vsp[e] = -8.0f * softplusf_(-l4[e]);
#pragma unroll
            for (int ai = 0; ai < 2; ++ai)
#pragma unroll
                for (int m = 0; m < 4; ++m) { const size_t row = (size_t)(row0 + ai * 128 + m * 16);
                    const u32x2 xv = *(const u32x2*)(X + row * DM + ch0 + 4 * n);
                    const float xs[4] = {bflo(xv.x), bfhi(xv.x), bflo(xv.y), bfhi(xv.y)};
                    u32x4 w;
#pragma unroll
                    for (int e = 0; e < 4; ++e) { const float r = sigmoidf_(acc[ai][0][m][n][e] + vbr[e]), ig = sigmoidf_(acc[ai][1][m][n][e] + vbi[e]);
                        const float la = r * vsp[e]; const float a_ = __expf(la); const float b = __builtin_amdgcn_sqrtf(fmaxf(1.0f - a_ * a_, 0.f)) * ig * xs[e];
                        w[e] = pk2(la * 1.4426950408889634f, b); }
                    *(u32x4*)(G + row * DM + ch0 + 4 * n) = w; }
        }
    }
};
constexpr int S5_WLDS = 12800, BU_P = 132, HS_P = 136;
struct S5Dir { float ar, ai; bf16x8 Bf[8]; };
__device__ __forceinline__ void s5_dir_setup(const Params& P, int e, int d, int g, int lane, float& ar, float& ai, bf16x8 (&Bf)[8], bool needB) {
    const int quad = lane >> 4, l15 = lane & 15;
    const float dt = __expf(P.in[I_LOGDT][(e * 2 + d) * 32 + g]);
    const float lr = P.in[I_LAMRE][((e * 2 + d) * 32 + g) * 64 + lane], li = P.in[I_LAMIM][((e * 2 + d) * 32 + g) * 64 + lane];
    const float mag = expf(lr * dt); ar = mag * cosf(li * dt); ai = mag * sinf(li * dt);
    const float den = lr * lr + li * li;
    const float fr = ((ar - 1.0f) * lr + ai * li) / den, fi = (ai * lr - (ar - 1.0f) * li) / den;
    if (needB) {
#pragma unroll
        for (int nt = 0; nt < 8; ++nt) { const int col = 16 * nt + l15, p = col & 63;
            const float frp = shfl_i(fr, p), fip = shfl_i(fi, p);
            bf16x8 v = (bf16x8){0, 0, 0, 0, 0, 0, 0, 0};
            if (quad < 2) { const float* bre = P.in[I_BRE] + ((size_t)(e * 32 + g) * 64 + p) * 16 + quad * 8; const float* bim = P.in[I_BIM] + ((size_t)(e * 32 + g) * 64 + p) * 16 + quad * 8;
#pragma unroll
                for (int j = 0; j < 8; ++j) { const float br = bre[j], bi = bim[j]; const float val = (nt < 4) ? (frp * br - fip * bi) : (frp * bi + fip * br); v[j] = (short)f2bf(val); } }
            Bf[nt] = v; }
    }
}
__device__ __forceinline__ void s5_c_setup(const Params& P, int e, int g, int lane, bf16x8 (&Cf)[4]) {
    const int quad = lane >> 4, l15 = lane & 15;
#pragma unroll
    for (int ks = 0; ks < 4; ++ks) { const int col0 = 32 * ks + quad * 8; const bool im = col0 >= 64;
        const float* src = (im ? P.in[I_CIM] : P.in[I_CRE]) + ((size_t)(e * 32 + g) * 16 + l15) * 64 + (col0 & 63);
        bf16x8 v;
#pragma unroll
        for (int j = 0; j < 8; ++j) v[j] = (short)f2bf(im ? -src[j] : src[j]);
        Cf[ks] = v; }
}
__device__ __forceinline__ void s5_scan_seg(const Params& P, LAS unsigned char* wl, int lane, int d, int g, int m0, float ar, float ai, const bf16x8 (&Bf)[8], const bf16x8 (&Cf)[4],
                                            float& hr, float& hi, int mode, int ymode, const bf16* proj, float* ybuf, bf16* mixout, float dsk) {
    const int quad = lane >> 4, l15 = lane & 15;
    LAS float* BU = (LAS float*)wl; LAS bf16* HS = (LAS bf16*)(wl + 8448);
    const int ch = g * 16 + l15;
    bf16x8 a_next = (bf16x8){0, 0, 0, 0, 0, 0, 0, 0};
    if (mode == 0 && quad < 2) { const int blk0 = d ? 15 : 0; const int tt = d ? 15 - l15 : l15; a_next = *(const bf16x8*)(proj + (size_t)(m0 + 16 * blk0 + tt) * NPROJ_E + g * 16 + quad * 8); }
    for (int bi_ = 0; bi_ < 16; ++bi_) {
        const int blk = d ? 15 - bi_ : bi_;
        const int mb = m0 + 16 * blk;
        const bf16x8 a = a_next;
        if (mode == 0 && quad < 2 && bi_ + 1 < 16) { const int blkn = d ? 14 - bi_ : bi_ + 1; const int tt = d ? 15 - l15 : l15; a_next = *(const bf16x8*)(proj + (size_t)(m0 + 16 * blkn + tt) * NPROJ_E + g * 16 + quad * 8); }
        float pre[4], zz[4];
#pragma unroll
        for (int jj = 0; jj < 4; ++jj) { const int row = quad * 4 + jj; const int tt = d ? 15 - row : row; const size_t m = (size_t)(mb + tt);
            pre[jj] = (ymode == 0) ? dsk * bf2f(proj[m * NPROJ_E + ch]) : ybuf[m * 512 + ch];
            zz[jj] = (ymode == 2) ? bf2f(proj[m * NPROJ_E + 512 + ch]) : 0.f; }
        if (mode == 0) {
#pragma unroll
            for (int nt = 0; nt < 8; ++nt) { f32x4 acc = mfma16(a, Bf[nt], (f32x4){0.f, 0.f, 0.f, 0.f});
#pragma unroll
                for (int jj = 0; jj < 4; ++jj) BU[(quad * 4 + jj) * BU_P + 16 * nt + l15] = acc[jj]; }
            WAVE_SYNC();
        }
#pragma unroll
        for (int r = 0; r < 16; ++r) {
            float br = 0.f, bim = 0.f;
            if (mode == 0) { br = BU[r * BU_P + lane]; bim = BU[r * BU_P + 64 + lane]; }
            const float nr = ar * hr - ai * hi + br, ni = ar * hi + ai * hr + bim; hr = nr; hi = ni;
            HS[r * HS_P + lane] = (bf16)f2bf(hr); HS[r * HS_P + 64 + lane] = (bf16)f2bf(hi);
        }
        WAVE_SYNC();
        f32x4 y = (f32x4){0.f, 0.f, 0.f, 0.f};
#pragma unroll
        for (int ks = 0; ks < 4; ++ks) { const bf16x8 af = *(const LAS bf16x8*)(HS + l15 * HS_P + 32 * ks + quad * 8); y = mfma16(af, Cf[ks], y); }
#pragma unroll
        for (int jj = 0; jj < 4; ++jj) { const int row = quad * 4 + jj; const int tt = d ? 15 - row : row; const size_t m = (size_t)(mb + tt);
            const float v = y[jj] + pre[jj];
            if (ymode != 2) ybuf[m * 512 + ch] = v;
            else mixout[m * DM + ch] = (bf16)f2bf(geluf_(v) * sigmoidf_(zz[jj]));
        }
        WAVE_SYNC();
    }
}
__device__ __forceinline__ void s5_task_main(const Params& P, LAS unsigned char* wl, int lane, int e, int sub, int g) {
    const bf16* proj = (const bf16*)(P.ws + WS_BIG); float* ybuf = (float*)(P.ws + WS_YBUF); bf16* mixout = (bf16*)(P.ws + WS_MIX);
    const bool lat = sub >= 32; const int q = sub - 32, b = lat ? (q >> 3) : sub, seg = lat ? (q & 7) : 0;
    const int m0 = lat ? MCTX + b * LLAT + seg * 256 : sub * 256;
    bf16x8 Cf[4]; s5_c_setup(P, e, g, lane, Cf);
    const float dsk = P.in[I_S5D][e * 512 + g * 16 + (lane & 15)];
#pragma unroll 1
    for (int d = 0; d < 2; ++d) {
        float ar, ai; bf16x8 Bf[8]; s5_dir_setup(P, e, d, g, lane, ar, ai, Bf, true);
        float hr = 0.f, hi = 0.f;
        if (lat && ((d == 0 && seg == 0) || (d == 1 && seg == 7))) { const size_t si = ((((size_t)b * 2 + e) * 2 + d) * 32 + g) * 64 + lane; hr = P.in[I_S5RE][si]; hi = P.in[I_S5IM][si]; }
        const int ymode = d == 0 ? 0 : (lat ? 1 : 2);
        s5_scan_seg(P, wl, lane, d, g, m0, ar, ai, Bf, Cf, hr, hi, 0, ymode, proj, ybuf, mixout, dsk);
        if (!lat) { const size_t si = ((((size_t)b * 2 + e) * 2 + d) * 32 + g) * 64 + lane; P.out[OUT_S5RE + si] = hr; P.out[OUT_S5IM + si] = hi; }
        else { float* F = (float*)(P.ws + WS_S5F) + ((((size_t)d * 64 + q) * 32 + g) * 64 + lane) * 2; F[0] = hr; F[1] = hi; }
    }
}
__device__ __forceinline__ void s5_task_corr(const Params& P, LAS unsigned char* wl, int lane, int e, int q, int g) {
    const bf16* proj = (const bf16*)(P.ws + WS_BIG); float* ybuf = (float*)(P.ws + WS_YBUF); bf16* mixout = (bf16*)(P.ws + WS_MIX);
    const int b = q >> 3, seg = q & 7, m0 = MCTX + b * LLAT + seg * 256;
    bf16x8 Cf[4]; s5_c_setup(P, e, g, lane, Cf);
    bf16x8 Bf[8];
#pragma unroll
    for (int i = 0; i < 8; ++i) Bf[i] = (bf16x8){0, 0, 0, 0, 0, 0, 0, 0};
    const float* Fb = (const float*)(P.ws + WS_S5F);
#pragma unroll 1
    for (int d = 0; d < 2; ++d) {
        float ar, ai; s5_dir_setup(P, e, d, g, lane, ar, ai, Bf, false);
        float pr = ar, pi = ai;
#pragma unroll
        for (int i = 0; i < 8; ++i) { const float nr = pr * pr - pi * pi, ni = 2.0f * pr * pi; pr = nr; pi = ni; }
        float hr = 0.f, hi = 0.f;
        const int cnt = d == 0 ? seg : 7 - seg;
        for (int i = 0; i < cnt; ++i) { const int sj = d == 0 ? i : 7 - i; const float* F = Fb + ((((size_t)d * 64 + b * 8 + sj) * 32 + g) * 64 + lane) * 2;
            const float nr = pr * hr - pi * hi + F[0], ni = pr * hi + pi * hr + F[1]; hr = nr; hi = ni; }
        if (cnt > 0) s5_scan_seg(P, wl, lane, d, g, m0, ar, ai, Bf, Cf, hr, hi, 1, 1, proj, ybuf, mixout, 0.f);
    }
    __builtin_amdgcn_wave_barrier();
    for (int i = lane; i < 256 * 16; i += 64) { const size_t m = (size_t)(m0 + (i >> 4)); const int ch = g * 16 + (i & 15);
        const float v = ybuf[m * 512 + ch]; const float z = bf2f(proj[m * NPROJ_E + 512 + ch]);
        mixout[m * DM + ch] = (bf16)f2bf(geluf_(v) * sigmoidf_(z)); }
}

#ifndef REP_A
#define REP_A 1
#endif
#ifndef REP_B
#define REP_B 1
#endif
#ifndef REP_C
#define REP_C 1
#endif
__device__ __forceinline__ void phase_conv_even(int wid0, const Params& P, int e) {
    const int tid = tid_fresh(wid0), lane = tid & 63, wave = tid >> 6;
    const int gw = bid_fresh() * NWAVES + wave, NGW = grid_fresh() * NWAVES;
    bf16* proj = (bf16*)(P.ws + WS_BIG); const bf16* HALO = (const bf16*)(P.ws + WS_HALO);
    for (int it = gw; it < 384 * 24; it += NGW) {
        const int c = it / 24, cgp = it % 24, ccol = cgp * 64 + lane;
        const int r0 = c * 64;
        const bool lat = r0 >= MCTX; const int t0 = lat ? ((r0 - MCTX) & 2047) : (r0 & 255); const int L = lat ? LLAT : LCTX;
        bf16* base = proj + (size_t)r0 * NPROJ_E + 1024 + ccol;
        bf16 x[67];
#pragma unroll
        for (int i = 0; i < 64; ++i) x[i + 1] = base[(size_t)i * NPROJ_E];
        x[0] = (t0 > 0) ? HALO[((size_t)(c - 1) * 3 + 0) * 1536 + ccol] : (bf16)0;
        x[65] = (t0 + 64 < L) ? HALO[((size_t)(c + 1) * 3 + 1) * 1536 + ccol] : (bf16)0;
        x[66] = (t0 + 64 < L) ? HALO[((size_t)(c + 1) * 3 + 2) * 1536 + ccol] : (bf16)0;
        const float* cw = P.in[I_GCONVW] + (size_t)e * 4 * 1536 + ccol; const float w0 = cw[0], w1 = cw[1536], w2 = cw[3072], w3 = cw[4608], cb = P.in[I_GCONVB][e * 1536 + ccol];
#pragma unroll
        for (int i = 0; i < 64; ++i) { const float v = cb + w0 * bf2f(x[i]) + w1 * bf2f(x[i + 1]) + w2 * bf2f(x[i + 2]) + w3 * bf2f(x[i + 3]);
            base[(size_t)i * NPROJ_E] = (bf16)f2bf(siluf_(v)); }
    }
}
#define LDS_BARRIER() do { asm volatile("s_waitcnt lgkmcnt(0)" ::: "memory"); __builtin_amdgcn_s_barrier(); asm volatile("" ::: "memory"); } while (0)
constexpr int G_Q = 0, G_K = 17408, G_V = 34816, G_KT = 52224, G_LM = 70656, G_QK = 89088, G_ST = 98304, G_SM = 133120;
constexpr int P128 = 136, P64 = 72, LMP = 68;
__device__ __forceinline__ bf16x8 ld_split8(const LAS bf16* p) {
    const u32x2 a = *(const LAS u32x2*)p, b = *(const LAS u32x2*)(p + 16);
    return __builtin_bit_cast(bf16x8, (u32x4){a.x, a.y, b.x, b.y});
}
__device__ __forceinline__ bf16x8 pack_acc2(const f32x4& a, const f32x4& b) { return __builtin_bit_cast(bf16x8, (u32x4){pk2(a[0], a[1]), pk2(a[2], a[3]), pk2(b[0], b[1]), pk2(b[2], b[3])}); }
__device__ __forceinline__ void gdn_chain(int wid0, const Params& P, LAS unsigned char* lds, int e, int s, int hd, int dir) {
    const int tid = tid_fresh(wid0), lane = tid & 63, w = __builtin_amdgcn_readfirstlane(tid >> 6), quad = lane >> 4, l15 = lane & 15;
    const bool lat = s >= 32; const int b = lat ? s - 32 : s; const int L = lat ? LLAT : LCTX; const int m0 = lat ? MCTX + b * LLAT : s * LCTX;
    const bf16* proj = (const bf16*)(P.ws + WS_BIG); const float* AB = (const float*)(P.ws + WS_AB);
    bf16* Odir = (bf16*)(P.ws + WS_H) + (size_t)dir * MT * 512;
    int zv; asm volatile("v_mov_b32 %0, 0" : "=v"(zv));
    lds += zv;
    LAS bf16* Qs = (LAS bf16*)(lds + G_Q); LAS bf16* Ks = (LAS bf16*)(lds + G_K); LAS bf16* Vs = (LAS bf16*)(lds + G_V); LAS bf16* KT = (LAS bf16*)(lds + G_KT);
    LAS float* Lm = (LAS float*)(lds + G_LM); LAS bf16* VNT = (LAS bf16*)(lds + G_LM); LAS bf16* QKs = (LAS bf16*)(lds + G_QK); LAS bf16* ST = (LAS bf16*)(lds + G_ST);
    LAS bf16* TM = (LAS bf16*)(lds + G_ST); LAS bf16* TT = TM + 64 * P64; LAS bf16* LR = TT + 64 * P64;
    LAS float* rq = (LAS float*)(lds + G_SM); LAS float* rk = rq + 64; LAS float* gcs = rq + 128; LAS float* betas = rq + 192; LAS float* egs = rq + 256; LAS float* kes = rq + 320;
    f32x4 Sacc[8];
    const size_t sbase = ((((size_t)b * 2 + e) * 2 + dir) * 4 + hd) * 16384;
#pragma unroll
    for (int mt = 0; mt < 8; ++mt) Sacc[mt] = (f32x4){0.f, 0.f, 0.f, 0.f};
    if (lat) { const float* sp = P.in[I_SDELTA] + sbase + (size_t)(quad * 4) * 128 + 16 * w + l15;
#pragma unroll
        for (int mt = 0; mt < 8; ++mt)
#pragma unroll
            for (int jj = 0; jj < 4; ++jj) Sacc[mt][jj] = sp[(16 * mt + jj) * 128]; }
    for (int i = tid; i < 2 * 64 * P64 / 2; i += NTHR) ((LAS unsigned*)TM)[i] = 0u;
    const float alog_e = __expf(P.in[I_GALOG][(e * 2 + dir) * 4 + hd]), dtb = P.in[I_GDTB][(e * 2 + dir) * 4 + hd];
    const int nchunk = L / 64;
    u32x4 xr[6]; float ab_a = 0.f, ab_b = 0.f;
#define GDN_LOAD(ci_) do { const int tid_ = tid_fresh(wid0); const int c0_ = dir ? L - 64 * ((ci_) + 1) : 64 * (ci_); \
        _Pragma("unroll") for (int k = 0; k < 6; ++k) { const int p_ = tid_ + 512 * k, part_ = p_ >> 10, row_ = (p_ & 1023) >> 4, pc_ = p_ & 15; \
            xr[k] = *(const u32x4*)(proj + (size_t)(m0 + c0_ + row_) * NPROJ_E + 1024 + part_ * 512 + hd * 128 + pc_ * 8); } \
        if (w == 0) { const int ln_ = tid_ & 63; const size_t m_ = (size_t)(m0 + c0_ + (dir ? 63 - ln_ : ln_)); ab_a = AB[m_ * 16 + dir * 4 + hd]; ab_b = AB[m_ * 16 + 8 + dir * 4 + hd]; } } while (0)
    GDN_LOAD(0);
#pragma unroll 1
    for (int ci = 0; ci < nchunk; ++ci) {
        const int tid = tid_fresh(wid0), lane = tid & 63, quad = lane >> 4, l15 = lane & 15;
        const int c0 = dir ? L - 64 * (ci + 1) : 64 * ci;
        LDS_BARRIER();
#ifndef NO_A
        const float cur_a = ab_a, cur_b = ab_b;
#pragma unroll
        for (int k = 0; k < 6; ++k) { const int p_ = tid + 512 * k, part_ = p_ >> 10, row_ = (p_ & 1023) >> 4, pc_ = p_ & 15;
            LAS bf16* dst = part_ == 0 ? Qs : (part_ == 1 ? Ks : Vs);
            *(LAS u32x4*)(dst + (dir ? 63 - row_ : row_) * P128 + pc_ * 8) = xr[k]; }
        if (ci + 1 < nchunk) GDN_LOAD(ci + 1);
#endif
        LDS_BARRIER();
#pragma unroll 1
        for (int repB = 0; repB < REP_B; ++repB)
        { const int rowid = tid >> 2, part = tid & 3; LAS bf16* src = (rowid < 64 ? Qs : Ks) + (rowid & 63) * P128 + part * 32;
          float ss = 0.f;
#pragma unroll
          for (int i = 0; i < 4; ++i) { const u32x4 v = *(const LAS u32x4*)(src + 8 * i);
#pragma unroll
              for (int j = 0; j < 4; ++j) { const float a = bflo(v[j]), c = bfhi(v[j]); ss += a * a + c * c; } }
          ss += shfl_i(ss, lane ^ 1); ss += shfl_i(ss, lane ^ 2);
          if (part == 0) { if (rowid < 64) rq[rowid] = rsqrtf(ss + EPSF) * 0.08838834764831845f; else rk[rowid - 64] = rsqrtf(ss + EPSF); }
          if (w == 0) { const int t = c0 + (dir ? 63 - lane : lane); const size_t m = (size_t)(m0 + t);
              const float araw = cur_a, braw = cur_b;
              const float gg = -alog_e * softplusf_(araw + dtb);
              float gc = gg;
#pragma unroll
              for (int o = 1; o < 64; o <<= 1) { const float t2 = shfl_i(gc, (lane - o) & 63); if (lane >= o) gc += t2; }
              const float glast = shfl_i(gc, 63);
              gcs[lane] = gc; betas[lane] = sigmoidf_(braw); egs[lane] = __expf(gc); kes[lane] = __expf(glast - gc);
              if (lane == 0) rq[384] = __expf(glast); } }
        LDS_BARRIER();
#ifndef NO_C
#pragma unroll 1
        for (int repC = 0; repC < REP_C; ++repC)
        { const int mt = w & 3; const bool isq = w >= 4; LAS bf16* src = isq ? Qs : Ks;
          bf16x8 a[4];
#pragma unroll
          for (int ks = 0; ks < 4; ++ks) a[ks] = *(const LAS bf16x8*)(src + (16 * mt + l15) * P128 + 32 * ks + quad * 8);
#pragma unroll 1
          for (int nt = 0; nt < 4; ++nt) { f32x4 acc = (f32x4){0.f, 0.f, 0.f, 0.f};
#pragma unroll
              for (int ks = 0; ks < 4; ++ks) { const bf16x8 bb = *(const LAS bf16x8*)(Ks + (16 * nt + l15) * P128 + 32 * ks + quad * 8); acc = mfma16(a[ks], bb, acc); }
              const int j = 16 * nt + l15; const float rkj = rk[j], gcj = gcs[j];
              f32x4 lv;
#pragma unroll
              for (int jj = 0; jj < 4; ++jj) { const int i = 16 * mt + quad * 4 + jj; const float dec = __expf(fminf(gcs[i] - gcj, 0.f));
                  lv[jj] = (i > j) ? acc[jj] * rk[i] * rkj * betas[i] * dec : 0.f;
                  if (isq) QKs[i * P64 + j] = (bf16)f2bf((i >= j) ? acc[jj] * rq[i] * rkj * dec : 0.f); }
              if (!isq) { *(LAS f32x4*)(Lm + j * LMP + 16 * mt + quad * 4) = lv;
#pragma unroll
                  for (int jj = 0; jj < 4; ++jj) LR[(16 * mt + quad * 4 + jj) * P64 + j] = (bf16)f2bf(nt < mt ? lv[jj] : 0.f); } }
          const int dd = tid & 127, tq = tid >> 7;
          unsigned pw[8];
#pragma unroll
          for (int n = 0; n < 16; n += 2) { const int i0 = tq * 16 + n; const float v0 = bf2f(Ks[i0 * P128 + dd]) * rk[i0] * kes[i0], v1 = bf2f(Ks[(i0 + 1) * P128 + dd]) * rk[i0 + 1] * kes[i0 + 1]; pw[n >> 1] = pk2(v0, v1); }
          *(LAS u32x4*)(KT + dd * P64 + tq * 16) = (u32x4){pw[0], pw[1], pw[2], pw[3]};
          *(LAS u32x4*)(KT + dd * P64 + tq * 16 + 8) = (u32x4){pw[4], pw[5], pw[6], pw[7]}; }
#endif
        LDS_BARRIER();
        { const int i = tid >> 3, c0k = (tid & 7) * 16; const float sc = rk[i] * betas[i] * egs[i];
#pragma unroll
          for (int h2 = 0; h2 < 2; ++h2) { u32x4 v = *(LAS u32x4*)(Ks + i * P128 + c0k + 8 * h2);
#pragma unroll
              for (int q = 0; q < 4; ++q) v[q] = pk2(bflo(v[q]) * sc, bfhi(v[q]) * sc);
              *(LAS u32x4*)(Ks + i * P128 + c0k + 8 * h2) = v; } }
        if (w == 0) { const int bb = lane >> 4, c = lane & 15;
            float x[16];
#pragma unroll
            for (int r = 0; r < 16; ++r) x[r] = (r == c) ? 1.f : 0.f;
#pragma unroll
            for (int j = 0; j < 15; ++j) {
#pragma unroll
                for (int q4 = j / 4; q4 < 4; ++q4) { const f32x4 l4 = *(const LAS f32x4*)(Lm + (16 * bb + j) * LMP + 16 * bb + 4 * q4);
#pragma unroll
                    for (int jx = 0; jx < 4; ++jx) if (4 * q4 + jx > j) x[4 * q4 + jx] -= l4[jx] * x[j]; } }
            unsigned pw[8];
#pragma unroll
            for (int r = 0; r < 16; r += 2) { pw[r >> 1] = pk2(x[r], x[r + 1]); TM[(16 * bb + r) * P64 + 16 * bb + c] = (bf16)(pw[r >> 1] & 0xffffu); TM[(16 * bb + r + 1) * P64 + 16 * bb + c] = (bf16)(pw[r >> 1] >> 16); }
            *(LAS u32x4*)(TT + (16 * bb + c) * P64 + 16 * bb) = (u32x4){pw[0], pw[1], pw[2], pw[3]};
            *(LAS u32x4*)(TT + (16 * bb + c) * P64 + 16 * bb + 8) = (u32x4){pw[4], pw[5], pw[6], pw[7]}; }
        LDS_BARRIER();
#pragma unroll 1
        for (int lev = 1; lev < 4; ++lev) {
            if (w < 4 - lev) { const int bj = w, bi = w + lev;
                f32x4 m = (f32x4){0.f, 0.f, 0.f, 0.f};
#pragma unroll
                for (int ks = 0; ks < 2; ++ks) { const bf16x8 a = *(const LAS bf16x8*)(LR + (16 * bi + l15) * P64 + 32 * ks + quad * 8), bq = *(const LAS bf16x8*)(TT + (16 * bj + l15) * P64 + 32 * ks + quad * 8); m = mfma16(a, bq, m); }
                const u32x2 tl = *(const LAS u32x2*)(TM + (16 * bi + l15) * P64 + 16 * bi + quad * 4);
                const bf16x8 a2 = __builtin_bit_cast(bf16x8, (u32x4){tl.x, tl.y, 0u, 0u}), b2 = __builtin_bit_cast(bf16x8, (u32x4){pk2(m[0], m[1]), pk2(m[2], m[3]), 0u, 0u});
                const f32x4 t = mfma16(a2, b2, (f32x4){0.f, 0.f, 0.f, 0.f});
                const unsigned p0 = pk2(-t[0], -t[1]), p1 = pk2(-t[2], -t[3]);
                TM[(16 * bi + quad * 4 + 0) * P64 + 16 * bj + l15] = (bf16)(p0 & 0xffffu); TM[(16 * bi + quad * 4 + 1) * P64 + 16 * bj + l15] = (bf16)(p0 >> 16);
                TM[(16 * bi + quad * 4 + 2) * P64 + 16 * bj + l15] = (bf16)(p1 & 0xffffu); TM[(16 * bi + quad * 4 + 3) * P64 + 16 * bj + l15] = (bf16)(p1 >> 16);
                *(LAS u32x2*)(TT + (16 * bj + l15) * P64 + 16 * bi + quad * 4) = (u32x2){p0, p1}; }
            LDS_BARRIER();
        }
#ifndef NO_EFG
        bf16x8 Bst[4];
#pragma unroll
        for (int ks = 0; ks < 4; ++ks) Bst[ks] = pack_acc2(Sacc[2 * ks], Sacc[2 * ks + 1]);
        f32x4 vn[4];
#pragma unroll
        for (int mt = 0; mt < 4; ++mt) { f32x4 acc = (f32x4){0.f, 0.f, 0.f, 0.f};
#pragma unroll
            for (int ks = 0; ks < 4; ++ks) { const bf16x8 a = ld_split8(Ks + (16 * mt + l15) * P128 + 32 * ks + quad * 4); acc = mfma16(a, Bst[ks], acc); }
#pragma unroll
            for (int jj = 0; jj < 4; ++jj) { const int i = 16 * mt + quad * 4 + jj; vn[mt][jj] = bf2f(Vs[i * P128 + 16 * w + l15]) * betas[i] - acc[jj]; } }
        bf16x8 Bvn[2];
#pragma unroll
        for (int k2 = 0; k2 < 2; ++k2) Bvn[k2] = pack_acc2(vn[2 * k2], vn[2 * k2 + 1]);
#pragma unroll
        for (int mt = 0; mt < 4; ++mt) { f32x4 acc = (f32x4){0.f, 0.f, 0.f, 0.f};
#pragma unroll
            for (int k2 = 0; k2 < 2; ++k2) { const bf16x8 a = ld_split8(TM + (16 * mt + l15) * P64 + 32 * k2 + quad * 4); acc = mfma16(a, Bvn[k2], acc); }
            vn[mt] = acc; }
#pragma unroll
        for (int k2 = 0; k2 < 2; ++k2) Bvn[k2] = pack_acc2(vn[2 * k2], vn[2 * k2 + 1]);
#pragma unroll 1
        for (int mt = 0; mt < 4; ++mt) { f32x4 acc = (f32x4){0.f, 0.f, 0.f, 0.f};
#pragma unroll
            for (int ks = 0; ks < 4; ++ks) { const bf16x8 a = ld_split8(Qs + (16 * mt + l15) * P128 + 32 * ks + quad * 4); acc = mfma16(a, Bst[ks], acc); }
#pragma unroll
            for (int jj = 0; jj < 4; ++jj) { const int i = 16 * mt + quad * 4 + jj; acc[jj] *= rq[i] * egs[i]; }
#pragma unroll
            for (int k2 = 0; k2 < 2; ++k2) { const bf16x8 a = ld_split8(QKs + (16 * mt + l15) * P64 + 32 * k2 + quad * 4); acc = mfma16(a, Bvn[k2], acc); }
#pragma unroll
            for (int jj = 0; jj < 4; ++jj) { const int i = 16 * mt + quad * 4 + jj; const int t = c0 + (dir ? 63 - i : i);
                Odir[(size_t)(m0 + t) * 512 + hd * 128 + 16 * w + l15] = (bf16)f2bf(acc[jj]); } }
        const float egl = rq[384];
#pragma unroll
        for (int mt = 0; mt < 8; ++mt) { f32x4 acc = Sacc[mt] * egl;
#pragma unroll
            for (int k2 = 0; k2 < 2; ++k2) { const bf16x8 a = ld_split8(KT + (16 * mt + l15) * P64 + 32 * k2 + quad * 4); acc = mfma16(a, Bvn[k2], acc); }
            Sacc[mt] = acc; }
#endif
        WAVE_SYNC();
    }
    if (!lat) { const int tid2 = tid_fresh(wid0), lane2 = tid2 & 63; float* dp = P.out + OUT_DELTA + sbase + (size_t)((lane2 >> 4) * 4) * 128 + 16 * w + (lane2 & 15);
#pragma unroll
        for (int mt = 0; mt < 8; ++mt)
#pragma unroll
            for (int jj = 0; jj < 4; ++jj) dp[(16 * mt + jj) * 128] = Sacc[mt][jj];
    }
    __syncthreads();
}

__device__ __forceinline__ void phase_mix_even(int wid0, const Params& P, LAS unsigned char* lds, int e, int mode = 3) {
    const int bid = bid_fresh(), G = grid_fresh();
    if (G == 256) {
        if (bid < 64) { const int s = 32 + (bid >> 3), hd = (bid >> 1) & 3, dir = bid & 1; if (mode & 1) gdn_chain(wid0, P, lds, e, s, hd, dir); }
        else { const int bb = bid - 64;
            if (mode & 1) for (int c = bb; c < 256; c += 192) { const int s = c >> 3, hd = (c >> 1) & 3, dir = c & 1; gdn_chain(wid0, P, lds, e, s, hd, dir); }
            if (mode & 2) { const int tid = tid_fresh(wid0), lane = tid & 63, wave = tid >> 6;
                for (int t = bb; t < 384; t += 192) { const int wt = t * 8 + wave; s5_task_main(P, lds + wave * S5_WLDS, lane, e, wt >> 5, wt & 31); } }
            if (mode == 3) { __syncthreads(); const int tid = tid_fresh(wid0), lane = tid & 63, wave = tid >> 6;
                for (int it = bb * NWAVES + wave; it < WITEMS_ODD; it += 192 * NWAVES) weight_item(P, (LAS float*)(lds + wave * 16384), 2 * e + 1, it, lane); } }
    } else {
        for (int c = bid; c < 320; c += G) { const int s = c < 64 ? 32 + (c >> 3) : ((c - 64) >> 3), hd = (c >> 1) & 3, dir = c & 1; gdn_chain(wid0, P, lds, e, s, hd, dir); }
        const int tid = tid_fresh(wid0), lane = tid & 63, wave = tid >> 6;
        for (int t = bid; t < 384; t += G) { const int wt = t * 8 + wave; s5_task_main(P, lds + wave * S5_WLDS, lane, e, wt >> 5, wt & 31); }
        __syncthreads();
        for (int it = bid * NWAVES + wave; it < WITEMS_ODD; it += G * NWAVES) weight_item(P, (LAS float*)(lds + wave * 16384), 2 * e + 1, it, lane);
    }
}
__device__ __forceinline__ void phase_fin_even(int wid0, const Params& P, LAS unsigned char* lds, int e) {
    const int tid = tid_fresh(wid0), lane = tid & 63, wave = tid >> 6;
    const int gw = bid_fresh() * NWAVES + wave, NGW = grid_fresh() * NWAVES;
    for (int wt = gw; wt < 2048; wt += NGW) s5_task_corr(P, lds + wave * S5_WLDS, lane, e, wt >> 5, wt & 31);
    const bf16* proj = (const bf16*)(P.ws + WS_BIG); const bf16* Of = (const bf16*)(P.ws + WS_H); const bf16* Ob = Of + (size_t)MT * 512; bf16* mixout = (bf16*)(P.ws + WS_MIX);
    for (int m = gw; m < MT; m += NGW) {
        const u32x4 a = *(const u32x4*)(Of + (size_t)m * 512 + lane * 8), bq = *(const u32x4*)(Ob + (size_t)m * 512 + lane * 8), z = *(const u32x4*)(proj + (size_t)m * NPROJ_E + 2560 + lane * 8);
        float o[8]; float ss = 0.f;
#pragma unroll
        for (int j = 0; j < 4; ++j) { o[2 * j] = bflo(a[j]) + bflo(bq[j]); o[2 * j + 1] = bfhi(a[j]) + bfhi(bq[j]); ss += o[2 * j] * o[2 * j] + o[2 * j + 1] * o[2 * j + 1]; }
        ss += shfl_i(ss, lane ^ 1); ss += shfl_i(ss, lane ^ 2); ss += shfl_i(ss, lane ^ 4); ss += shfl_i(ss, lane ^ 8);
        const float rs = rsqrtf(ss * (1.0f / 128.0f) + EPSF);
        const float* gn = P.in[I_GONORM] + e * 128 + (lane & 15) * 8;
        unsigned pw[4];
#pragma unroll
        for (int j = 0; j < 4; ++j) { const float z0 = bflo(z[j]), z1 = bfhi(z[j]); pw[j] = pk2(o[2 * j] * rs * gn[2 * j] * siluf_(z0), o[2 * j + 1] * rs * gn[2 * j + 1] * siluf_(z1)); }
        *(u32x4*)(mixout + (size_t)m * DM + 512 + lane * 8) = (u32x4){pw[0], pw[1], pw[2], pw[3]};
    }
}

__device__ __forceinline__ void phase_conv_odd(int wid0, const Params& P, int o) {
    const int tid = tid_fresh(wid0), lane = tid & 63, wave = tid >> 6;
    const int gw = bid_fresh() * NWAVES + wave, NGW = grid_fresh() * NWAVES;
    const bf16* proj = (const bf16*)(P.ws + WS_BIG); bf16* cx = (bf16*)(P.ws + WS_H);
    const float* cw = P.in[I_LCONVW] + (size_t)o * 4 * 1024; const float* cb = P.in[I_LCONVB] + o * 1024;
    for (int m = gw; m < MT; m += NGW) {
        const int t = m < MCTX ? (m & 255) : ((m - MCTX) & 2047); const int L = m < MCTX ? LCTX : LLAT;
#pragma unroll
        for (int h2 = 0; h2 < 2; ++h2) { const int ch = lane * 8 + 512 * h2;
            float acc[8];
#pragma unroll
            for (int j = 0; j < 8; ++j) acc[j] = cb[ch + j];
#pragma unroll
            for (int k = 0; k < 4; ++k) { const int tt = t - 1 + k; if (tt >= 0 && tt < L) { const u32x4 v = *(const u32x4*)(proj + (size_t)(m - 1 + k) * 2048 + ch);
#pragma unroll
                    for (int j = 0; j < 4; ++j) { acc[2 * j] += cw[k * 1024 + ch + 2 * j] * bflo(v[j]); acc[2 * j + 1] += cw[k * 1024 + ch + 2 * j + 1] * bfhi(v[j]); } } }
            *(u32x4*)(cx + (size_t)m * DM + ch) = (u32x4){pk2(acc[0], acc[1]), pk2(acc[2], acc[3]), pk2(acc[4], acc[5]), pk2(acc[6], acc[7])}; }
    }
}
__device__ __forceinline__ void phase_lru_scan(int wid0, const Params& P, LAS unsigned char* lds, int o, int d) {
    const int tid = tid_fresh(wid0), lane = tid & 63, wave = tid >> 6;
    const int gw = bid_fresh() * NWAVES + wave, NGW = grid_fresh() * NWAVES;
    const unsigned* G = (const unsigned*)(P.ws + WS_GATES); const bf16* proj = (const bf16*)(P.ws + WS_BIG); bf16* mixout = (bf16*)(P.ws + WS_MIX);
    if (d == 0 && o == 0 && NGW > 640) {
        for (int it = gw - 640; it >= 0 && it < WITEMS_EVEN; it += NGW - 640) weight_item(P, (LAS float*)(lds + wave * 16384), 2, it, lane); }
    for (int task = gw; task < 640; task += NGW) {
        int s, cg_;
        if (task < 128) { s = 32 + (task >> 4); cg_ = task & 15; } else { s = (task - 128) >> 4; cg_ = (task - 128) & 15; }
        const bool lat = s >= 32; const int b = lat ? s - 32 : s; const int L = lat ? LLAT : LCTX; const int m0 = lat ? MCTX + b * LLAT : s * LCTX;
        const int ch = cg_ * 64 + lane;
        float h = lat ? P.in[I_SLRU][(((size_t)b * 2 + o) * 2 + d) * 1024 + ch] : 0.f;
        if (d == 0) {
            unsigned ga[32], gb[32];
#define LRU_LD0(dst, tt) _Pragma("unroll") for (int i = 0; i < 32; ++i) dst[i] = G[(size_t)(m0 + (tt) + i) * DM + ch]
#define LRU_CP0(src, tt) _Pragma("unroll") for (int i = 0; i < 32; ++i) { h = __builtin_amdgcn_exp2f(bflo(src[i])) * h + bfhi(src[i]); mixout[(size_t)(m0 + (tt) + i) * DM + ch] = (bf16)f2bf(h); }
            LRU_LD0(ga, 0);
            for (int t0 = 0; t0 < L; t0 += 64) {
                LRU_LD0(gb, t0 + 32);
                LRU_CP0(ga, t0);
                if (t0 + 64 < L) { LRU_LD0(ga, t0 + 64); }
                LRU_CP0(gb, t0 + 32);
            }
        } else {
            unsigned ga[16], gb[16]; bf16 pa[16], pb[16], ya[16], yb[16];
#define LRU_LD1(g_, p_, y_, tt) _Pragma("unroll") for (int i = 0; i < 16; ++i) { const size_t m = (size_t)(m0 + L - 1 - ((tt) + i)); g_[i] = G[m * DM + ch]; p_[i] = mixout[m * DM + ch]; y_[i] = proj[m * 2048 + 1024 + ch]; }
#define LRU_CP1(g_, p_, y_, tt) _Pragma("unroll") for (int i = 0; i < 16; ++i) { const size_t m = (size_t)(m0 + L - 1 - ((tt) + i)); \
                h = __builtin_amdgcn_exp2f(bflo(g_[i])) * h + bfhi(g_[i]); mixout[m * DM + ch] = (bf16)f2bf((bf2f(p_[i]) + h) * geluf_(bf2f(y_[i]))); }
            LRU_LD1(ga, pa, ya, 0);
            for (int t0 = 0; t0 < L; t0 += 32) {
                LRU_LD1(gb, pb, yb, t0 + 16);
                LRU_CP1(ga, pa, ya, t0);
                if (t0 + 32 < L) { LRU_LD1(ga, pa, ya, t0 + 32); }
                LRU_CP1(gb, pb, yb, t0 + 16);
            }
        }
        if (!lat) P.out[OUT_LRU + (((size_t)b * 2 + o) * 2 + d) * 1024 + ch] = h;
    }
}
#ifdef PROBE_DUP_GEMM
#define DUPG(x) GSYNC(); x
#else
#define DUPG(x)
#endif
typedef const __attribute__((address_space(4))) Params* KParams;
__device__ __forceinline__ Params load_params(KParams q) { Params r;
#pragma unroll
    for (int i = 0; i < 40; ++i) r.in[i] = q->in[i];
    r.out = q->out; r.ws = q->ws; return r; }
#define FRESH() const int G = grid_fresh(), bid = bid_fresh(); (void)G; (void)bid; KParams pk_ = (KParams)__builtin_amdgcn_kernarg_segment_ptr(); asm volatile("" : "+s"(pk_)); const Params P = load_params(pk_); unsigned char* ws = P.ws; \
    const float* mod = (const float*)(ws + WS_MOD); bf16* H = (bf16*)(ws + WS_H); bf16* BIG = (bf16*)(ws + WS_BIG); bf16* MIX = (bf16*)(ws + WS_MIX); (void)mod; (void)H; (void)BIG; (void)MIX;
#define GSYNC() do { KParams pb_ = (KParams)__builtin_amdgcn_kernarg_segment_ptr(); asm volatile("" : "+s"(pb_)); xcd_barrier(wid0, (unsigned*)(pb_->ws + WS_BAR), lds); } while (0)
__global__ void __launch_bounds__(NTHR, 2) fwd_kernel(Params Parg) {
    extern __shared__ __attribute__((aligned(16))) unsigned char lds_raw[];
    LAS unsigned char* lds = (LAS unsigned char*)lds_raw;
    cg::grid_group grid = cg::this_grid();
    const int wid0 = __builtin_amdgcn_readfirstlane(threadIdx.x >> 6);
    if (threadIdx.x < 4) ((LAS unsigned*)(lds + LDS_BARST))[threadIdx.x] = 0u;
    __syncthreads();
    if (threadIdx.x == 0) (void)xb_add((unsigned*)(Parg.ws + WS_BAR) + XB_XCNT(xb_xcc_id()), 1u);

    { FRESH(); phase_prologue(wid0, P, lds); }
    if (grid_fresh() == 0) grid.sync();
    GSYNC();
#ifdef PROBE_DUP_PRO
    { FRESH(); phase_prologue(wid0, P, lds); }
    GSYNC();
#endif
    { FRESH(); phase_modreduce(wid0, P); }
    GSYNC();
#ifdef PROBE_SYNC
#pragma unroll 1
    for (int i = 0; i < 40; ++i) GSYNC();
#endif
#pragma unroll 1
    for (int l = 0; l < 4; ++l) {
        { FRESH(); const float* modl = mod + (size_t)l * 9 * 6144;
        phase_rownorm(wid0, P, l == 0, MIX, modl - 9 * 6144, 5 * 1024, P.in[I_NMLPPOST] + (l > 0 ? (l - 1) * 1024 : 0), 1, P.in[I_NMIXPRE] + l * 1024, modl, 0, H); }
        GSYNC();
        const int eo = l >> 1;
        {
            FRESH();
            pg8::Gemm g; pg8::StaticOrder S; EpiBf16<0> E;
            if ((l & 1) == 0) { g = pg8::Gemm{H, (const bf16*)(ws + WS_WINE) + (size_t)eo * NB_E * 1024, MT, NB_E, 1024, 1024, 0, 0, 1024, 0}; E = EpiBf16<0>{BIG, NPROJ_E, (float*)(ws + WS_AB), (bf16*)(ws + WS_HALO)}; }
            else { g = pg8::Gemm{H, (const bf16*)(ws + WS_WINO) + (size_t)eo * 2048 * 1024, MT, 2048, 1024, 1024, 0, 0, 1024, 0}; E = EpiBf16<0>{BIG, 2048, nullptr, nullptr}; }
            S.init(g.M, g.N, G, bid);
            pg8::gemm_phase(wid0, lds, g, S, E); DUPG(pg8::gemm_phase(wid0, lds, g, S, E);)
        }
        GSYNC();
        if ((l & 1) == 0) {
            { FRESH(); phase_conv_even(wid0, P, eo); }
            GSYNC();
#ifdef PROBE_DUP_MIX
#pragma unroll 1
            for (int rep = 0; rep < 2; ++rep) { { FRESH(); phase_mix_even(wid0, P, lds, eo, rep == 0 ? 3 : PROBE_DUP_MIX); } GSYNC(); }
#else
            { FRESH(); phase_mix_even(wid0, P, lds, eo); }
            GSYNC();
#endif
            { FRESH(); phase_fin_even(wid0, P, lds, eo); }
            GSYNC();
        } else {
            { FRESH(); phase_conv_odd(wid0, P, eo); }
            GSYNC();
#ifdef PROBE_DUP_CONV
            { FRESH(); phase_conv_odd(wid0, P, eo); }
            GSYNC();
#endif
#pragma unroll 1
            for (int d = 0; d < 2; ++d) {
                { FRESH();
                pg8::Gemm g{H, (const bf16*)(ws + WS_WG) + (size_t)(eo * 2 + d) * 2048 * 256, MT, 2048, 256, 1024, 1, 1, 256, 0};
                EpiGates E{(unsigned*)(ws + WS_GATES), H, P.in[I_LBR] + (eo * 2 + d) * 1024, P.in[I_LBI] + (eo * 2 + d) * 1024, P.in[I_LLAM] + (eo * 2 + d) * 1024};
                pg8::StaticOrder S; S.init(g.M, g.N, G, bid);
                pg8::gemm_phase(wid0, lds, g, S, E); DUPG(pg8::gemm_phase(wid0, lds, g, S, E);) }
                GSYNC();
                { FRESH(); phase_lru_scan(wid0, P, lds, eo, d); }
#ifdef PROBE_DUP_LRU0
                if (d == 0) { GSYNC(); FRESH(); phase_lru_scan(wid0, P, lds, eo, d); }
#endif
                GSYNC();
            }
        }
        {
            FRESH();
            pg8::Gemm g{MIX, (const bf16*)(ws + ((l & 1) ? WS_WOUTO : WS_WOUTE)) + (size_t)eo * 1024 * 1024, MT, 1024, 1024, 1024, 0, 0, 1024, 0};
            EpiBf16<0> E{BIG, 1024, nullptr, nullptr}; pg8::StaticOrder S; S.init(g.M, g.N, G, bid);
            pg8::gemm_phase(wid0, lds, g, S, E); DUPG(pg8::gemm_phase(wid0, lds, g, S, E);)
        }
        GSYNC();
        { FRESH(); const float* modl = mod + (size_t)l * 9 * 6144;
        phase_rownorm(wid0, P, 0, BIG, modl, 2 * 1024, P.in[I_NMIXPOST] + l * 1024, 1, P.in[I_NMLPPRE] + l * 1024, modl, 3 * 1024, H); }
        GSYNC();
        {
            FRESH();
            pg8::Gemm g{H, (const bf16*)(ws + WS_W1T) + (size_t)l * 4096 * 1024, MT, 4096, 1024, 1024, 0, 0, 1024, 0};
            EpiBf16<1> E{BIG, 4096, nullptr, nullptr}; pg8::StaticOrder S; S.init(g.M, g.N, G, bid);
            pg8::gemm_phase(wid0, lds, g, S, E); DUPG(pg8::gemm_phase(wid0, lds, g, S, E);)
        }
        GSYNC();
        {
            FRESH();
            pg8::Gemm g{BIG, (const bf16*)(ws + WS_W2T) + (size_t)l * 1024 * 4096, MT, 1024, 4096, 4096, 0, 0, 4096, 0};
            EpiBf16<0> E{MIX, 1024, nullptr, nullptr}; pg8::StaticOrder S; S.init(g.M, g.N, G, bid);
            pg8::gemm_phase(wid0, lds, g, S, E); DUPG(pg8::gemm_phase(wid0, lds, g, S, E);)
        }
        GSYNC();
    }
    { FRESH();
    phase_rownorm(wid0, P, 0, MIX, mod + (size_t)3 * 9 * 6144, 5 * 1024, P.in[I_NMLPPOST] + 3 * 1024, 0, P.in[I_NMIXPRE], mod, 0, H); }
}

extern "C" void kernel_launch(void* const* d_in, const int* in_sizes, int n_in, void* d_out, int out_size, void* d_ws, size_t ws_size, hipStream_t stream) {
    static int grid = 0;
    if (grid == 0) {
        if (n_in != 40 || ws_size < WS_END) { fprintf(stderr, "kernel_launch: expected 40 inputs and >= %zu bytes of workspace (got %d, %zu)\n", (size_t)WS_END, n_in, ws_size); grid = -1; return; }
        int dev = 0, cus = 0, per_cu = 0;
        if (hipGetDevice(&dev) != hipSuccess || hipDeviceGetAttribute(&cus, hipDeviceAttributeMultiprocessorCount, dev) != hipSuccess) { grid = -1; return; }
        if (hipFuncSetAttribute((const void*)fwd_kernel, hipFuncAttributeMaxDynamicSharedMemorySize, LDS_BYTES) != hipSuccess) { fprintf(stderr, "kernel_launch: hipFuncSetAttribute failed\n"); grid = -1; return; }
        if (hipOccupancyMaxActiveBlocksPerMultiprocessor(&per_cu, (const void*)fwd_kernel, NTHR, LDS_BYTES) != hipSuccess || per_cu < 1) per_cu = 1;
        (void)hipGetLastError();
        grid = cus * per_cu; if (grid > 256) grid = 256;
    }
    if (grid < 0) return;
    (void)hipMemsetAsync((char*)d_ws + WS_BAR, 0, 16384, stream);
    Params p{};
    for (int i = 0; i < 40; ++i) p.in[i] = (const float*)d_in[i];
    p.out = (float*)d_out; p.ws = (unsigned char*)d_ws;
    void* args[] = {&p};
    hipError_t e = hipLaunchCooperativeKernel((const void*)fwd_kernel, dim3(grid), dim3(NTHR), args, LDS_BYTES, stream);
    if (e != hipSuccess) fprintf(stderr, "cooperative launch failed: %s (grid %d)\n", hipGetErrorString(e), grid);
}
```

```cpp
#include <hip/hip_runtime.h>
#include <hip/hip_cooperative_groups.h>
#include <cstdio>
#include <cstdint>
namespace cg = cooperative_groups;
__device__ __forceinline__ int bid_fresh() { int t = blockIdx.x; asm volatile("" : "+s"(t)); return t; }
__device__ __forceinline__ int grid_fresh() { int t = gridDim.x; asm volatile("" : "+s"(t)); return t; }
__device__ __forceinline__ int tid_fresh(int w) { asm volatile("" : "+s"(w)); int l; asm volatile("v_mbcnt_lo_u32_b32 %0, -1, 0\n\tv_mbcnt_hi_u32_b32 %0, -1, %0" : "=v"(l)); return w * 64 + l; }

namespace pg8 {
#define PG8_LAS __attribute__((address_space(3)))
typedef unsigned short bf16_t;
typedef short bf16x8 __attribute__((ext_vector_type(8)));
typedef float f32x4 __attribute__((ext_vector_type(4)));
typedef unsigned u32x4 __attribute__((ext_vector_type(4)));
typedef unsigned u32x2 __attribute__((ext_vector_type(2)));
constexpr int BM = 256, BK = 64, HALF = 128, HTB = HALF * BK * 2, STAGE_BYTES = 8 * HTB, NXCD = 8, WGM = 8;

__host__ __device__ __forceinline__ int lds_byte(int r, int c) { const int st = (r >> 4) * 2 + (c >> 5), rr = r & 15, cc = c & 31, ob = rr * 64 + cc * 2; return st * 1024 + (ob ^ (((ob >> 9) & 1) << 5)); }
__host__ __device__ __forceinline__ void stage_rc(int b, int& R, int& C) { const int st = b / 1024, sb = b % 1024, swz = sb ^ (((sb >> 9) & 1) << 5); R = (st >> 1) * 16 + swz / 64; C = (st & 1) * 32 + (swz % 64) / 2; }
__host__ __device__ __forceinline__ int perm32(int rho) { const int n = rho >> 4, i = rho & 15; return 8 * (i >> 2) + 4 * n + (i & 3); }

struct Unit { int pm, pn; };
struct Gemm { const bf16_t* A; const bf16_t* Bt; int M, N, K, lda, ablk, ashift, ldb, ksplit; };

struct StaticOrder {
    int nM, nN, nwg, G, c;
    __host__ __device__ void init(int M, int N, int G_, int c_) { nM = M / BM; nN = N / BM; nwg = nM * nN; G = G_; c = c_; }
    __host__ __device__ bool next(int i, Unit& u) const {
        const long L = (long)i * G + c; if (L >= nwg) return false;
        int wgid = (int)L; { const int q = nwg / NXCD, r = nwg % NXCD, xcd = wgid % NXCD, off = wgid / NXCD; wgid = (xcd < r ? xcd * (q + 1) : r * (q + 1) + (xcd - r) * q) + off; }
        const int nig = WGM * nN, gid = wgid / nig, fm = gid * WGM, gsz = (nM - fm) < WGM ? (nM - fm) : WGM;
        u.pm = fm + ((wgid % nig) % gsz); u.pn = (wgid % nig) / gsz; return true;
    }
};
__device__ __forceinline__ unsigned cvt_pk_bf16(float lo, float hi) { unsigned r; asm volatile("v_cvt_pk_bf16_f32 %0, %1, %2" : "=v"(r) : "v"(lo), "v"(hi)); return r; }

template <class Epi>
__device__ __forceinline__ void gemm_phase(int wid0, PG8_LAS unsigned char* lds, const Gemm g, const StaticOrder& S, const Epi& E) {
    const int tid = tid_fresh(wid0), wid = __builtin_amdgcn_readfirstlane(tid >> 6), lane = tid & 63, wr = wid >> 2, wc = wid & 3, fr = lane & 15, fq = lane >> 4;
    const int K = g.K, nt = K / BK, lda = g.lda, ldb = g.ldb;
    unsigned voffA[2], voffB[2];
#pragma unroll
    for (int i = 0; i < 2; ++i) { int R, C; stage_rc(tid * 16 + i * 8192, R, C); const int Rb = (R & ~31) + perm32(R & 31);
        voffA[i] = (unsigned)(R * lda + C) * 2u; voffB[i] = (unsigned)(Rb * ldb + C) * 2u; }
    const size_t kstep = (size_t)(BK * 2);
    const size_t hstepA = (size_t)HALF * lda * 2, hstepB = (size_t)HALF * ldb * 2;
    const size_t tstepA = 2 * hstepA, tstepB = 2 * hstepB;
    const unsigned ldsw = (unsigned)wid * 1024u;
    const int aoff = lds_byte(wr * 64 + fr, fq * 8), boff = lds_byte(wc * 32 + fr, fq * 8);
#define PG8_ACOL(pn) (g.ablk ? (size_t)((((pn) >> g.ashift) & 3) * 512) : (g.ksplit ? (size_t)((pn) & 1) * (size_t)K * 2 : (size_t)0))
#define PG8_BOFF(pn) (g.ksplit ? (size_t)((pn) >> 1) * tstepB + (size_t)((pn) & 1) * (size_t)K * 2 : (size_t)(pn) * tstepB)
#define PG8_SA(b, h) (((b) * 2 + (h)) * HTB)
#define PG8_SB(b, h) ((4 + (b) * 2 + (h)) * HTB)
#define PG8_STAGE(bufoff, gbase, voff) do { _Pragma("unroll") for (int _i = 0; _i < 2; ++_i) \
        __builtin_amdgcn_global_load_lds((const unsigned*)((const char*)(gbase) + (voff)[_i]), (PG8_LAS unsigned*)(lds + (bufoff) + ldsw + _i * 8192), 16, 0, 0); } while (0)
#define PG8_LDA(dst, b, h) do { _Pragma("unroll") for (int m = 0; m < 4; ++m) _Pragma("unroll") for (int k = 0; k < 2; ++k) dst[m][k] = *(const PG8_LAS bf16x8*)(lds + PG8_SA(b, h) + aoff + m * 2048 + k * 1024); } while (0)
#define PG8_LDB(dst, b, h) do { _Pragma("unroll") for (int n = 0; n < 2; ++n) _Pragma("unroll") for (int k = 0; k < 2; ++k) dst[n][k] = *(const PG8_LAS bf16x8*)(lds + PG8_SB(b, h) + boff + n * 2048 + k * 1024); } while (0)
#define PG8_MMA(ai, bj, At, Bt) do { __builtin_amdgcn_s_setprio(1); _Pragma("unroll") for (int m = 0; m < 4; ++m) _Pragma("unroll") for (int n = 0; n < 2; ++n) _Pragma("unroll") for (int k = 0; k < 2; ++k) \
        acc[ai][bj][m][n] = __builtin_amdgcn_mfma_f32_16x16x32_bf16(Bt[n][k], At[m][k], acc[ai][bj][m][n], 0, 0, 0); __builtin_amdgcn_s_setprio(0); } while (0)
#define PG8_WAIT_V(n) asm volatile("s_waitcnt vmcnt(" #n ")" ::: "memory")
#define PG8_WAIT_L(n) asm volatile("s_waitcnt lgkmcnt(" #n ")" ::: "memory")
#define PG8_BAR __builtin_amdgcn_s_barrier()
#define PG8_SCHED __builtin_amdgcn_sched_barrier(0)
    Unit cur, nxt; int ui = 0;
    if (!S.next(0, cur)) return;
    f32x4 acc[2][2][4][2];
#pragma unroll
    for (int a = 0; a < 2; ++a)
#pragma unroll
        for (int b = 0; b < 2; ++b)
#pragma unroll
            for (int m = 0; m < 4; ++m)
#pragma unroll
                for (int n = 0; n < 2; ++n) acc[a][b][m][n] = (f32x4){0.f, 0.f, 0.f, 0.f};
    bf16x8 At[4][2], B0[2][2], B1[2][2];
    const char* cA = (const char*)g.A + (size_t)cur.pm * tstepA + PG8_ACOL(cur.pn); const char* cB = (const char*)g.Bt + PG8_BOFF(cur.pn);
    PG8_STAGE(PG8_SB(0, 0), cB, voffB); PG8_STAGE(PG8_SA(0, 0), cA, voffA); PG8_STAGE(PG8_SB(0, 1), cB + hstepB, voffB); PG8_STAGE(PG8_SA(0, 1), cA + hstepA, voffA);
    if (wr == 1) PG8_BAR;
    PG8_WAIT_V(4); PG8_BAR;
    PG8_STAGE(PG8_SB(1, 0), cB + kstep, voffB); PG8_STAGE(PG8_SA(1, 0), cA + kstep, voffA); PG8_STAGE(PG8_SB(1, 1), cB + hstepB + kstep, voffB);
    PG8_WAIT_V(6); PG8_BAR;
    for (;;) {
        const bool has_next = S.next(ui + 1, nxt);
        const char* nA = has_next ? (const char*)g.A + (size_t)nxt.pm * tstepA + PG8_ACOL(nxt.pn) : cA; const char* nB = has_next ? (const char*)g.Bt + PG8_BOFF(nxt.pn) : cB;
        for (int t = 0; t < nt; t += 2) {
            const bool last = (t == nt - 2);
            const char* a1 = cA + (size_t)(t + 1) * kstep;
            const char* a2 = last ? nA : cA + (size_t)(t + 2) * kstep; const char* b2 = last ? nB : cB + (size_t)(t + 2) * kstep;
            const char* a3 = a2 + kstep; const char* b3 = b2 + kstep;
            PG8_LDB(B0, 0, 0); PG8_SCHED; PG8_LDA(At, 0, 0); PG8_STAGE(PG8_SA(1, 1), a1 + hstepA, voffA);
            PG8_WAIT_L(8); PG8_BAR; PG8_WAIT_L(0); PG8_MMA(0, 0, At, B0); PG8_BAR; PG8_SCHED;
            PG8_LDB(B1, 0, 1); PG8_STAGE(PG8_SB(0, 0), b2, voffB);
            PG8_BAR; PG8_WAIT_L(0); PG8_MMA(0, 1, At, B1); PG8_BAR;
            PG8_LDA(At, 0, 1); PG8_STAGE(PG8_SA(0, 0), a2, voffA);
            PG8_BAR; PG8_WAIT_L(0); PG8_MMA(1, 0, At, B0); PG8_BAR; PG8_SCHED;
            PG8_STAGE(PG8_SB(0, 1), b2 + hstepB, voffB);
            PG8_WAIT_V(6); PG8_BAR; PG8_MMA(1, 1, At, B1); PG8_BAR;
            PG8_LDB(B0, 1, 0); PG8_SCHED; PG8_LDA(At, 1, 0); PG8_STAGE(PG8_SA(0, 1), a2 + hstepA, voffA);
            PG8_WAIT_L(8); PG8_BAR; PG8_WAIT_L(0); PG8_MMA(0, 0, At, B0); PG8_BAR; PG8_SCHED;
            PG8_LDB(B1, 1, 1); PG8_STAGE(PG8_SB(1, 0), b3, voffB);
            PG8_BAR; PG8_WAIT_L(0); PG8_MMA(0, 1, At, B1); PG8_BAR;
            PG8_LDA(At, 1, 1); PG8_STAGE(PG8_SA(1, 0), a3, voffA);
            PG8_BAR; PG8_WAIT_L(0); PG8_MMA(1, 0, At, B0); PG8_BAR; PG8_SCHED;
            PG8_STAGE(PG8_SB(1, 1), b3 + hstepB, voffB);
            PG8_WAIT_V(6); PG8_BAR; PG8_MMA(1, 1, At, B1); PG8_BAR;
        }
        E(acc, cur, wr, wc, fr, fq);
        if (!has_next) break;
#pragma unroll
        for (int a = 0; a < 2; ++a)
#pragma unroll
            for (int b = 0; b < 2; ++b)
#pragma unroll
                for (int m = 0; m < 4; ++m)
#pragma unroll
                    for (int n = 0; n < 2; ++n) acc[a][b][m][n] = (f32x4){0.f, 0.f, 0.f, 0.f};
        cur = nxt; cA = nA; cB = nB; ++ui;
    }
    PG8_WAIT_V(0);
    if (wr == 0) PG8_BAR;
    PG8_BAR;
#undef PG8_ACOL
#undef PG8_BOFF
#undef PG8_SA
#undef PG8_SB
#undef PG8_STAGE
#undef PG8_LDA
#undef PG8_LDB
#undef PG8_MMA
#undef PG8_WAIT_V
#undef PG8_WAIT_L
#undef PG8_BAR
#undef PG8_SCHED
}
}
#define LAS __attribute__((address_space(3)))
typedef unsigned short bf16;
typedef short bf16x8 __attribute__((ext_vector_type(8)));
typedef float f32x4 __attribute__((ext_vector_type(4)));
typedef unsigned u32x4 __attribute__((ext_vector_type(4)));
typedef unsigned u32x2 __attribute__((ext_vector_type(2)));
constexpr int DM = 1024, MT = 24576, MCTX = 8192, LCTX = 256, LLAT = 2048, NWAVES = 8, NTHR = 512;
constexpr int NPROJ_E = 3072, NB_E = 3328, IN_EVEN_LD = 3088;
constexpr float EPSF = 1e-6f;
constexpr size_t MiB = 1u << 20;
constexpr size_t WS_MOD = 0, MOD_BYTES = 4 * 9 * 6144 * 4, WS_S5F = 1 * MiB, WS_AB = 3 * MiB, WS_W1T = 5 * MiB, WS_W2T = 37 * MiB, WS_WINE = 69 * MiB,
                 WS_WOUTE = 82 * MiB, WS_WINO = 86 * MiB, WS_WOUTO = 94 * MiB, WS_WG = 98 * MiB, WS_H = 102 * MiB, WS_BIG = 150 * MiB, WS_YBUF = 294 * MiB,
                 WS_GATES = 246 * MiB, WS_MIX = 342 * MiB, WS_HALO = 390 * MiB, WS_END = 390 * MiB + 384 * 3 * 1536 * 2;
constexpr int LDS_BYTES = 147456;
constexpr size_t OUT_S5RE = 25165824, OUT_S5IM = OUT_S5RE + 262144, OUT_DELTA = OUT_S5IM + 262144, OUT_LRU = OUT_DELTA + 8388608;

struct Params { const float* in[40]; float* out; unsigned char* ws; };
enum { I_XP = 0, I_XS, I_S5RE, I_S5IM, I_SDELTA, I_SLRU, I_C, I_CCTX, I_WADA, I_BADA, I_NMIXPRE, I_NMIXPOST, I_NMLPPRE, I_NMLPPOST, I_WMLPIN, I_WMLPOUT, I_WINE, I_WOUTE,
       I_LAMRE, I_LAMIM, I_LOGDT, I_BRE, I_BIM, I_CRE, I_CIM, I_S5D, I_GCONVW, I_GCONVB, I_GALOG, I_GDTB, I_GONORM, I_WINO, I_WOUTO, I_LCONVW, I_LCONVB, I_LWR, I_LBR, I_LWI, I_LBI, I_LLAM };

typedef __bf16 bf2_t __attribute__((ext_vector_type(2)));
typedef float f2_t __attribute__((ext_vector_type(2)));
__device__ __forceinline__ unsigned pk2(float lo, float hi) { const bf2_t v = __builtin_convertvector((f2_t){lo, hi}, bf2_t); return __builtin_bit_cast(unsigned, v); }
__device__ __forceinline__ unsigned f2bf(float f) { return pk2(f, f) & 0xffffu; }
__device__ __forceinline__ float bflo(unsigned w) { return __builtin_bit_cast(float, w << 16); }
__device__ __forceinline__ float bfhi(unsigned w) { return __builtin_bit_cast(float, w & 0xffff0000u); }
__device__ __forceinline__ float bf2f(bf16 b) { return __builtin_bit_cast(float, (unsigned)b << 16); }
__device__ __forceinline__ float sigmoidf_(float x) { return __builtin_amdgcn_rcpf(1.0f + __expf(-x)); }
__device__ __forceinline__ float siluf_(float x) { return x * sigmoidf_(x); }
__device__ __forceinline__ float softplusf_(float x) { return fmaxf(x, 0.f) + __logf(1.0f + __expf(-fabsf(x))); }
__device__ __forceinline__ float geluf_(float x) { const float y = 0.7978845608028654f * (x + 0.044715f * x * x * x); const float t = 1.0f - 2.0f * __builtin_amdgcn_rcpf(__expf(2.0f * y) + 1.0f); return 0.5f * x * (1.0f + t); }
__device__ __forceinline__ float shfl_i(float v, int srclane) { return __builtin_bit_cast(float, __builtin_amdgcn_ds_bpermute(srclane << 2, __builtin_bit_cast(int, v))); }
__device__ __forceinline__ float wave_sum(float v, int lane) {
#pragma unroll
    for (int o = 1; o < 64; o <<= 1) v += shfl_i(v, lane ^ o);
    return v;
}
#define LDS_WAIT() asm volatile("s_waitcnt lgkmcnt(0)" ::: "memory")
#define WAVE_SYNC() do { asm volatile("s_waitcnt lgkmcnt(0)" ::: "memory"); __builtin_amdgcn_wave_barrier(); } while (0)
__device__ __forceinline__ f32x4 mfma16(bf16x8 a, bf16x8 b, f32x4 c) { return __builtin_amdgcn_mfma_f32_16x16x32_bf16(a, b, c, 0, 0, 0); }


#define XB_TMO      128
#define XB_XCNT(j)  (256  + 64 * (j))
#define XB_XSUB(j)  (1280 + 64 * (j))
#define XB_XGEN(j)  (2304 + 64 * (j))
#define XB_TOP      3328
#define XB_TOPGEN   3392
#define XCD_BAR_WORDS 3456
#define XB_SPIN_CAP (1u << 18)
constexpr size_t WS_BAR = 960 * 1024; constexpr int LDS_BARST = LDS_BYTES - 16;
__device__ __forceinline__ unsigned xb_ld(unsigned* p)              { return __hip_atomic_load(p, __ATOMIC_RELAXED, __HIP_MEMORY_SCOPE_AGENT); }
__device__ __forceinline__ unsigned xb_add(unsigned* p, unsigned v) { return __hip_atomic_fetch_add(p, v, __ATOMIC_RELAXED, __HIP_MEMORY_SCOPE_AGENT); }
__device__ __forceinline__ unsigned xb_xcc_id() { return (unsigned)__builtin_amdgcn_s_getreg((3 << 11) | 20) & 0xFu; }
#define XB_SPIN(cond, bar) do { unsigned _sp = 0; while (cond) { __builtin_amdgcn_s_sleep(1); \
    if ((++_sp & 255u) == 0u) { if (xb_ld(&(bar)[XB_TMO])) break; if (_sp > XB_SPIN_CAP) { atomicAdd(&(bar)[XB_TMO], 1u); break; } } } } while (0)
__device__ __forceinline__ void xcd_barrier_complete(unsigned* bar, unsigned x, unsigned& nloc, unsigned& nx) {
    const unsigned G = gridDim.x;
    unsigned sum, cnt, mine, sp = 0u;
    for (;;) {
        sum = 0u; cnt = 0u; mine = 0u;
#pragma unroll
        for (unsigned j = 0; j < 16; ++j) { const unsigned c = xb_ld(&bar[XB_XCNT(j)]); sum += c; cnt += (c > 0u) ? 1u : 0u; mine = (j == x) ? c : mine; }
        if (sum == G) break;
        __builtin_amdgcn_s_sleep(1);
        if ((++sp & 255u) == 0u) { if (xb_ld(&bar[XB_TMO])) break; if (sp > XB_SPIN_CAP) { atomicAdd(&bar[XB_TMO], 1u); break; } }
    }
    nloc = mine > 0u ? mine : 1u; nx = cnt > 0u ? cnt : 1u;
}
__device__ __forceinline__ void xcd_barrier(int wid0, unsigned* bar, LAS unsigned char* lds) {
    const int tid = tid_fresh(wid0);
    asm volatile("s_waitcnt vmcnt(0)" ::: "memory");
    __syncthreads();
    if (tid == 0) {
        const unsigned x = xb_xcc_id();
        volatile LAS unsigned* st = (volatile LAS unsigned*)(lds + LDS_BARST);
        __builtin_amdgcn_s_waitcnt(0);
        unsigned nloc = st[0], nx = st[1];
        if (nloc == 0u) { xcd_barrier_complete(bar, x, nloc, nx); st[0] = nloc; st[1] = nx; }
        const unsigned old = xb_add(&bar[XB_XSUB(x)], 1u);
        const unsigned gen = old / nloc;
        if (old + 1u == (gen + 1u) * nloc) {
            __builtin_amdgcn_fence(__ATOMIC_RELEASE, "agent");
            asm volatile("s_waitcnt vmcnt(0)" ::: "memory");
            const unsigned og = xb_add(&bar[XB_TOP], 1u);
            const unsigned tg = og / nx;
            if (og + 1u == (tg + 1u) * nx) xb_add(&bar[XB_TOPGEN], 1u);
            else XB_SPIN(xb_ld(&bar[XB_TOPGEN]) == tg, bar);
            __builtin_amdgcn_fence(__ATOMIC_ACQUIRE, "agent");
            xb_add(&bar[XB_XGEN(x)], 1u);
            asm volatile("s_waitcnt vmcnt(0)" ::: "memory");
        } else {
            XB_SPIN(xb_ld(&bar[XB_XGEN(x)]) == gen, bar);
            __builtin_amdgcn_fence(__ATOMIC_ACQUIRE, "agent");
            asm volatile("s_waitcnt vmcnt(0)" ::: "memory");
        }
    }
    __syncthreads();
}
__device__ __forceinline__ void transpose_item(const float* W, int ldw, int nvalid, int K, bf16* WT, int dst_row0, LAS float* scr, int k0, int n0, int lane) {
    const int nn = n0 + (lane & 31); const bool ok = nn < nvalid;
#pragma unroll 8
    for (int i = 0; i < 32; ++i) { const int kk = 2 * i + (lane >> 5); scr[kk * 33 + (lane & 31)] = ok ? W[(size_t)(k0 + kk) * ldw + nn] : 0.f; }
    WAVE_SYNC();
    const int c = lane & 7;
#pragma unroll
    for (int j = 0; j < 4; ++j) { const int n = (lane >> 3) + 8 * j; const LAS float* s = scr + (8 * c) * 33 + n;
        u32x4 o; o.x = pk2(s[0 * 33], s[1 * 33]); o.y = pk2(s[2 * 33], s[3 * 33]); o.z = pk2(s[4 * 33], s[5 * 33]); o.w = pk2(s[6 * 33], s[7 * 33]);
        *(u32x4*)(WT + (size_t)(dst_row0 + n) * K + k0 + 8 * c) = o; }
    WAVE_SYNC();
}
constexpr int WITEMS_EVEN = 4096 + 1552 + 512, WITEMS_ODD = 4096 + 1024 + 512 + 512;
__device__ __forceinline__ void weight_item(const Params& P, LAS float* scr, int l, int r, int lane) {
    unsigned char* ws = P.ws; const int eo = l >> 1;
    if (r < 2048) { const int q = r; transpose_item(P.in[I_WMLPIN] + (size_t)l * 1024 * 4096, 4096, 4096, 1024, (bf16*)(ws + WS_W1T) + (size_t)l * 4096 * 1024, 32 * (q & 127), scr, 64 * (q >> 7), 32 * (q & 127), lane); return; } r -= 2048;
    if (r < 2048) { const int q = r; transpose_item(P.in[I_WMLPOUT] + (size_t)l * 4096 * 1024, 1024, 1024, 4096, (bf16*)(ws + WS_W2T) + (size_t)l * 1024 * 4096, 32 * (q & 31), scr, 64 * (q >> 5), 32 * (q & 31), lane); return; } r -= 2048;
    if ((l & 1) == 0) {
        if (r < 1552) { const int kb = r / 97, nb = r % 97; transpose_item(P.in[I_WINE] + (size_t)eo * 1024 * IN_EVEN_LD, IN_EVEN_LD, IN_EVEN_LD, 1024, (bf16*)(ws + WS_WINE) + (size_t)eo * NB_E * 1024, 32 * nb, scr, 64 * kb, 32 * nb, lane); return; } r -= 1552;
        { const int q = r; transpose_item(P.in[I_WOUTE] + (size_t)eo * 1024 * 1024, 1024, 1024, 1024, (bf16*)(ws + WS_WOUTE) + (size_t)eo * 1024 * 1024, 32 * (q & 31), scr, 64 * (q >> 5), 32 * (q & 31), lane); return; }
    } else {
        if (r < 1024) { const int q = r; transpose_item(P.in[I_WINO] + (size_t)eo * 1024 * 2048, 2048, 2048, 1024, (bf16*)(ws + WS_WINO) + (size_t)eo * 2048 * 1024, 32 * (q & 63), scr, 64 * (q >> 6), 32 * (q & 63), lane); return; } r -= 1024;
        if (r < 512) { const int q = r; transpose_item(P.in[I_WOUTO] + (size_t)eo * 1024 * 1024, 1024, 1024, 1024, (bf16*)(ws + WS_WOUTO) + (size_t)eo * 1024 * 1024, 32 * (q & 31), scr, 64 * (q >> 5), 32 * (q & 31), lane); return; } r -= 512;
        { const int mat = eo * 16 + (r >> 5), q = r & 31, kb = q >> 3, nb = q & 7; const int blk = mat & 3, gate = (mat >> 2) & 1, od = mat >> 3;
          const float* src = (gate ? P.in[I_LWI] : P.in[I_LWR]) + (size_t)(od * 4 + blk) * 65536;
          const int j0 = nb * 32; const int drow = (blk * 2 + (j0 >> 7)) * 256 + gate * 128 + (j0 & 127);
          transpose_item(src, 256, 256, 256, (bf16*)(ws + WS_WG) + (size_t)od * 2048 * 256, drow, scr, 64 * kb, j0, lane); return; }
    }
}
__device__ __forceinline__ void phase_prologue(int wid0, const Params& P, LAS unsigned char* lds) {
    const int tid = tid_fresh(wid0), lane = tid & 63, wave = tid >> 6;
    LAS float* scr = (LAS float*)(lds + wave * 16384);
    const int gw = bid_fresh() * NWAVES + wave, NGW = grid_fresh() * NWAVES;
    unsigned char* ws = P.ws;
    constexpr int NTR = WITEMS_EVEN, NMOD = 4 * 24 * 16;
    for (int it = gw; it < NTR + NMOD; it += NGW) {
        int r = it;
        if (r < NTR) { weight_item(P, scr, 0, r, lane); continue; } r -= NTR;
        {
            const int l = r / 384, rem = r % 384, ec = rem >> 4, ks = rem & 15, k0 = ks * 64;
#pragma unroll
            for (int rr = 0; rr < 9; ++rr) { const float cv = rr == 0 ? P.in[I_CCTX][k0 + lane] : P.in[I_C][(rr - 1) * 1024 + k0 + lane]; scr[rr * 64 + lane] = siluf_(cv); }
            WAVE_SYNC();
            f32x4 acc[9];
#pragma unroll
            for (int rr = 0; rr < 9; ++rr) acc[rr] = (f32x4){0.f, 0.f, 0.f, 0.f};
            const float* wp = P.in[I_WADA] + ((size_t)l * 1024 + k0) * 6144 + ec * 256 + lane * 4;
#pragma unroll 4
            for (int kk = 0; kk < 64; ++kk) { const f32x4 w4 = *(const f32x4*)(wp + (size_t)kk * 6144);
#pragma unroll
                for (int rr = 0; rr < 9; ++rr) acc[rr] += w4 * scr[rr * 64 + kk]; }
            float* part = (float*)(ws + WS_BIG) + ((size_t)(ks * 4 + l) * 9) * 6144 + ec * 256 + lane * 4;
#pragma unroll
            for (int rr = 0; rr < 9; ++rr) *(f32x4*)(part + (size_t)rr * 6144) = acc[rr];
            WAVE_SYNC();
        }
    }
    { const size_t per = (size_t)(NB_E - 3104) * 1024 * 2 / 16;
      for (size_t i = (size_t)bid_fresh() * NTHR + tid; i < 2 * per; i += (size_t)grid_fresh() * NTHR) { const size_t e = i / per, q = i % per;
          *(u32x4*)(ws + WS_WINE + (e * NB_E + 3104) * 1024 * 2 + q * 16) = (u32x4){0u, 0u, 0u, 0u}; } }
}
__device__ __forceinline__ void phase_modreduce(int wid0, const Params& P) {
    const int tid = tid_fresh(wid0);
    const float* part = (const float*)(P.ws + WS_BIG); float* mod = (float*)(P.ws + WS_MOD);
    for (int i = bid_fresh() * NTHR + tid; i < 4 * 9 * 6144 / 4; i += grid_fresh() * NTHR) {
        const int l = i / (9 * 1536), e4 = i % 1536;
        f32x4 a = *(const f32x4*)(P.in[I_BADA] + (size_t)l * 6144 + e4 * 4);
#pragma unroll
        for (int ks = 0; ks < 16; ++ks) a += *(const f32x4*)(part + (size_t)ks * 4 * 9 * 6144 + (size_t)i * 4);
        *(f32x4*)(mod + (size_t)i * 4) = a; }
}
__device__ __forceinline__ void phase_rownorm(int wid0, const Params& P, int first, const bf16* obuf, const float* modg, int goff, const float* gpost, int has_next, const float* gpre, const float* mods, int soff, bf16* H) {
    const int tid = tid_fresh(wid0), lane = tid & 63, wave = tid >> 6;
    const int gw = bid_fresh() * NWAVES + wave, NGW = grid_fresh() * NWAVES;
    float* X = P.out;
    for (int m = gw; m < MT; m += NGW) {
        const int modrow = m < MCTX ? 0 : 1 + ((m - MCTX) >> 11);
        const float* mr = modg + (size_t)modrow * 6144; const float* ms = mods + (size_t)modrow * 6144;
        f32x4 x[4];
        if (first) {
            if (m < MCTX) {
#pragma unroll
                for (int j = 0; j < 4; ++j) x[j] = *(const f32x4*)(P.in[I_XP] + (size_t)m * DM + lane * 4 + 256 * j);
            } else {
                const int t = (m - MCTX) & 2047; const float prow = (float)(t >> 6), pcol = (float)(t & 63);
                f32x4 om;
#pragma unroll
                for (int e = 0; e < 4; ++e) om[e] = exp2f(-(float)(lane * 4 + e) * (13.287712379549449f / 256.0f));
#pragma unroll
                for (int j = 0; j < 4; ++j) { x[j] = *(const f32x4*)(P.in[I_XS] + (size_t)(m - MCTX) * DM + lane * 4 + 256 * j);
#pragma unroll
                    for (int e = 0; e < 4; ++e) { const float a = (j < 2 ? prow : pcol) * om[e]; x[j][e] += (j & 1) ? cosf(a) : sinf(a); } }
            }
        } else {
            u32x2 ov[4]; float ss = 0.f;
#pragma unroll
            for (int j = 0; j < 4; ++j) { x[j] = *(const f32x4*)(X + (size_t)m * DM + lane * 4 + 256 * j); ov[j] = *(const u32x2*)(obuf + (size_t)m * DM + lane * 4 + 256 * j); }
#pragma unroll
            for (int j = 0; j < 4; ++j) { const float a = bflo(ov[j].x), b = bfhi(ov[j].x), c = bflo(ov[j].y), d = bfhi(ov[j].y); ss += (a * a + b * b) + (c * c + d * d); }
            const float rs = rsqrtf(wave_sum(ss, lane) * (1.0f / DM) + EPSF);
#pragma unroll
            for (int j = 0; j < 4; ++j) { const f32x4 g4 = *(const f32x4*)(gpost + lane * 4 + 256 * j), gt = *(const f32x4*)(mr + goff + lane * 4 + 256 * j);
                f32x4 o4 = (f32x4){bflo(ov[j].x), bfhi(ov[j].x), bflo(ov[j].y), bfhi(ov[j].y)};
                x[j] += gt * (o4 * rs * g4); }
        }
#pragma unroll
        for (int j = 0; j < 4; ++j) *(f32x4*)(X + (size_t)m * DM + lane * 4 + 256 * j) = x[j];
        if (has_next) {
            float ss = 0.f;
#pragma unroll
            for (int j = 0; j < 4; ++j) ss += (x[j][0] * x[j][0] + x[j][1] * x[j][1]) + (x[j][2] * x[j][2] + x[j][3] * x[j][3]);
            const float rs = rsqrtf(wave_sum(ss, lane) * (1.0f / DM) + EPSF);
#pragma unroll
            for (int j = 0; j < 4; ++j) { const f32x4 g4 = *(const f32x4*)(gpre + lane * 4 + 256 * j), sh = *(const f32x4*)(ms + soff + lane * 4 + 256 * j), sc = *(const f32x4*)(ms + soff + 1024 + lane * 4 + 256 * j);
                const f32x4 h4 = (x[j] * rs * g4) * (sc + 1.0f) + sh;
                u32x2 w; w.x = pk2(h4[0], h4[1]); w.y = pk2(h4[2], h4[3]);
                *(u32x2*)(H + (size_t)m * DM + lane * 4 + 256 * j) = w; }
        }
    }
}

using pg8::Unit;
template <int ACT  > struct EpiBf16 {
    bf16* O; int ldc; float* AB;
    bf16* HALO;
    __device__ __forceinline__ void operator()(const f32x4 (&acc)[2][2][4][2], const Unit& u, int wr, int wc, int fr, int fq) const {
        const int row0 = u.pm * 256 + wr * 64 + fr, col0 = u.pn * 256 + wc * 32 + 8 * fq;
        if (AB && u.pn * 256 >= ldc) {
            if (wc == 0 && fq < 2) {
#pragma unroll
                for (int ai = 0; ai < 2; ++ai)
#pragma unroll
                    for (int m = 0; m < 4; ++m) { float* p = AB + (size_t)(row0 + ai * 128 + m * 16) * 16 + 8 * fq; *(f32x4*)p = acc[ai][0][m][0]; *(f32x4*)(p + 4) = acc[ai][0][m][1]; }
            }
            return;
        }
#pragma unroll
        for (int ai = 0; ai < 2; ++ai)
#pragma unroll
            for (int m = 0; m < 4; ++m) { bf16* rowp = O + (size_t)(row0 + ai * 128 + m * 16) * ldc + col0;
#pragma unroll
                for (int bj = 0; bj < 2; ++bj) { f32x4 v0 = acc[ai][bj][m][0], v1 = acc[ai][bj][m][1];
                    if (ACT == 1) {
#pragma unroll
                        for (int j = 0; j < 4; ++j) { const float a = fmaxf(v0[j], 0.f), b = fmaxf(v1[j], 0.f); v0[j] = a * a; v1[j] = b * b; } }
                    u32x4 w; w.x = pk2(v0[0], v0[1]); w.y = pk2(v0[2], v0[3]); w.z = pk2(v1[0], v1[1]); w.w = pk2(v1[2], v1[3]);
                    *(u32x4*)(rowp + bj * 128) = w;
                    if (ACT == 0 && HALO && u.pn >= 4 && u.pn < 10 && ((m == 3 && fr == 15) || (m == 0 && fr < 2))) {
                        const int r = row0 + ai * 128 + m * 16; const int which = (m == 3) ? 0 : 1 + fr;
                        *(u32x4*)(HALO + ((size_t)(r >> 6) * 3 + which) * 1536 + (col0 + bj * 128 - 1024)) = w; } } }
    }
};
struct EpiSplit {
    bf16* O0; long stride;
    __device__ __forceinline__ void operator()(const f32x4 (&acc)[2][2][4][2], const Unit& u, int wr, int wc, int fr, int fq) const {
        const int row0 = u.pm * 256 + wr * 64 + fr, col0 = (u.pn >> 1) * 256 + wc * 32 + 8 * fq; bf16* O = O0 + (long)(u.pn & 1) * stride;
#pragma unroll
        for (int ai = 0; ai < 2; ++ai)
#pragma unroll
            for (int m = 0; m < 4; ++m) { bf16* rowp = O + (size_t)(row0 + ai * 128 + m * 16) * DM + col0;
#pragma unroll
                for (int bj = 0; bj < 2; ++bj) { const f32x4 v0 = acc[ai][bj][m][0], v1 = acc[ai][bj][m][1];
                    u32x4 w; w.x = pk2(v0[0], v0[1]); w.y = pk2(v0[2], v0[3]); w.z = pk2(v1[0], v1[1]); w.w = pk2(v1[2], v1[3]);
                    *(u32x4*)(rowp + bj * 128) = w; } }
    }
};
struct EpiGates {
    unsigned* G; const bf16* X; const float* br; const float* bi; const float* lam;
    __device__ __forceinline__ void operator()(const f32x4 (&acc)[2][2][4][2], const Unit& u, int wr, int wc, int fr, int fq) const {
        const int row0 = u.pm * 256 + wr * 64 + fr, ch0 = u.pn * 128 + wc * 32 + 8 * fq;
#pragma unroll
        for (int n = 0; n < 2; ++n) {
            const f32x4 vbr = *(const f32x4*)(br + ch0 + 4 * n), vbi = *(const f32x4*)(bi + ch0 + 4 * n), l4 = *(const f32x4*)(lam + ch0 + 4 * n);
            f32x4 vsp;
#pragma unroll
            for (int e = 0; e < 4; ++e) vsp[e] = -8.0f * softplusf_(-l4[e]);
#pragma unroll
            for (int ai = 0; ai < 2; ++ai)
#pragma unroll
                for (int m = 0; m < 4; ++m) { const size_t row = (size_t)(row0 + ai * 128 + m * 16);
                    const u32x2 xv = *(const u32x2*)(X + row * DM + ch0 + 4 * n);
                    const float xs[4] = {bflo(xv.x), bfhi(xv.x), bflo(xv.y), bfhi(xv.y)};
                    u32x4 w;
#pragma unroll
                    for (int e = 0; e < 4; ++e) { const float r = sigmoidf_(acc[ai][0][m][n][e] + vbr[e]), ig = sigmoidf_(acc[ai][1][m][n][e] + vbi[e]);
                        const float la = r * vsp[e]; const float a_ = __expf(la); const float b = __builtin_amdgcn_sqrtf(fmaxf(1.0f - a_ * a_, 0.f)) * ig * xs[e];
                        w[e] = pk2(la * 1.4426950408889634f, b); }
                    *(u32x4*)(G + row * DM + ch0 + 4 * n) = w; }
        }
    }
};
constexpr int S5_WLDS = 12800, BU_P = 132, HS_P = 136;
struct S5Dir { float ar, ai; bf16x8 Bf[8]; };
__device__ __forceinline__ void s5_dir_setup(const Params& P, int e, int d, int g, int lane, float& ar, float& ai, bf16x8 (&Bf)[8], bool needB) {
    const int quad = lane >> 4, l15 = lane & 15;
    const float dt = __expf(P.in[I_LOGDT][(e * 2 + d) * 32 + g]);
    const float lr = P.in[I_LAMRE][((e * 2 + d) * 32 + g) * 64 + lane], li = P.in[I_LAMIM][((e * 2 + d) * 32 + g) * 64 + lane];
    const float mag = expf(lr * dt); ar = mag * cosf(li * dt); ai = mag * sinf(li * dt);
    const float den = lr * lr + li * li;
    const float fr = ((ar - 1.0f) * lr + ai * li) / den, fi = (ai * lr - (ar - 1.0f) * li) / den;
    if (needB) {
#pragma unroll
        for (int nt = 0; nt < 8; ++nt) { const int col = 16 * nt + l15, p = col & 63;
            const float frp = shfl_i(fr, p), fip = shfl_i(fi, p);
            bf16x8 v = (bf16x8){0, 0, 0, 0, 0, 0, 0, 0};
            if (quad < 2) { const float* bre = P.in[I_BRE] + ((size_t)(e * 32 + g) * 64 + p) * 16 + quad * 8; const float* bim = P.in[I_BIM] + ((size_t)(e * 32 + g) * 64 + p) * 16 + quad * 8;
#pragma unroll
                for (int j = 0; j < 8; ++j) { const float br = bre[j], bi = bim[j]; const float val = (nt < 4) ? (frp * br - fip * bi) : (frp * bi + fip * br); v[j] = (short)f2bf(val); } }
            Bf[nt] = v; }
    }
}
__device__ __forceinline__ void s5_c_setup(const Params& P, int e, int g, int lane, bf16x8 (&Cf)[4]) {
    const int quad = lane >> 4, l15 = lane & 15;
#pragma unroll
    for (int ks = 0; ks < 4; ++ks) { const int col0 = 32 * ks + quad * 8; const bool im = col0 >= 64;
        const float* src = (im ? P.in[I_CIM] : P.in[I_CRE]) + ((size_t)(e * 32 + g) * 16 + l15) * 64 + (col0 & 63);
        bf16x8 v;
#pragma unroll
        for (int j = 0; j < 8; ++j) v[j] = (short)f2bf(im ? -src[j] : src[j]);
        Cf[ks] = v; }
}
__device__ __forceinline__ void s5_scan_seg(const Params& P, LAS unsigned char* wl, int lane, int d, int g, int m0, float ar, float ai, const bf16x8 (&Bf)[8], const bf16x8 (&Cf)[4],
                                            float& hr, float& hi, int mode, int ymode, const bf16* proj, float* ybuf, bf16* mixout, float dsk) {
    const int quad = lane >> 4, l15 = lane & 15;
    LAS float* BU = (LAS float*)wl; LAS bf16* HS = (LAS bf16*)(wl + 8448);
    const int ch = g * 16 + l15;
    bf16x8 a_next = (bf16x8){0, 0, 0, 0, 0, 0, 0, 0};
    if (mode == 0 && quad < 2) { const int blk0 = d ? 15 : 0; const int tt = d ? 15 - l15 : l15; a_next = *(const bf16x8*)(proj + (size_t)(m0 + 16 * blk0 + tt) * NPROJ_E + g * 16 + quad * 8); }
    for (int bi_ = 0; bi_ < 16; ++bi_) {
        const int blk = d ? 15 - bi_ : bi_;
        const int mb = m0 + 16 * blk;
        const bf16x8 a = a_next;
        if (mode == 0 && quad < 2 && bi_ + 1 < 16) { const int blkn = d ? 14 - bi_ : bi_ + 1; const int tt = d ? 15 - l15 : l15; a_next = *(const bf16x8*)(proj + (size_t)(m0 + 16 * blkn + tt) * NPROJ_E + g * 16 + quad * 8); }
        float pre[4], zz[4];
#pragma unroll
        for (int jj = 0; jj < 4; ++jj) { const int row = quad * 4 + jj; const int tt = d ? 15 - row : row; const size_t m = (size_t)(mb + tt);
            pre[jj] = (ymode == 0) ? dsk * bf2f(proj[m * NPROJ_E + ch]) : ybuf[m * 512 + ch];
            zz[jj] = (ymode == 2) ? bf2f(proj[m * NPROJ_E + 512 + ch]) : 0.f; }
        if (mode == 0) {
#pragma unroll
            for (int nt = 0; nt < 8; ++nt) { f32x4 acc = mfma16(a, Bf[nt], (f32x4){0.f, 0.f, 0.f, 0.f});
#pragma unroll
                for (int jj = 0; jj < 4; ++jj) BU[(quad * 4 + jj) * BU_P + 16 * nt + l15] = acc[jj]; }
            WAVE_SYNC();
        }
#pragma unroll
        for (int r = 0; r < 16; ++r) {
            float br = 0.f, bim = 0.f;
            if (mode == 0) { br = BU[r * BU_P + lane]; bim = BU[r * BU_P + 64 + lane]; }
            const float nr = ar * hr - ai * hi + br, ni = ar * hi + ai * hr + bim; hr = nr; hi = ni;
            HS[r * HS_P + lane] = (bf16)f2bf(hr); HS[r * HS_P + 64 + lane] = (bf16)f2bf(hi);
        }
        WAVE_SYNC();
        f32x4 y = (f32x4){0.f, 0.f, 0.f, 0.f};
#pragma unroll
        for (int ks = 0; ks < 4; ++ks) { const bf16x8 af = *(const LAS bf16x8*)(HS + l15 * HS_P + 32 * ks + quad * 8); y = mfma16(af, Cf[ks], y); }
#pragma unroll
        for (int jj = 0; jj < 4; ++jj) { const int row = quad * 4 + jj; const int tt = d ? 15 - row : row; const size_t m = (size_t)(mb + tt);
            const float v = y[jj] + pre[jj];
            if (ymode != 2) ybuf[m * 512 + ch] = v;
            else mixout[m * DM + ch] = (bf16)f2bf(geluf_(v) * sigmoidf_(zz[jj]));
        }
        WAVE_SYNC();
    }
}
__device__ __forceinline__ void s5_task_main(const Params& P, LAS unsigned char* wl, int lane, int e, int sub, int g) {
    const bf16* proj = (const bf16*)(P.ws + WS_BIG); float* ybuf = (float*)(P.ws + WS_YBUF); bf16* mixout = (bf16*)(P.ws + WS_MIX);
    const bool lat = sub >= 32; const int q = sub - 32, b = lat ? (q >> 3) : sub, seg = lat ? (q & 7) : 0;
    const int m0 = lat ? MCTX + b * LLAT + seg * 256 : sub * 256;
    bf16x8 Cf[4]; s5_c_setup(P, e, g, lane, Cf);
    const float dsk = P.in[I_S5D][e * 512 + g * 16 + (lane & 15)];
#pragma unroll 1
    for (int d = 0; d < 2; ++d) {
        float ar, ai; bf16x8 Bf[8]; s5_dir_setup(P, e, d, g, lane, ar, ai, Bf, true);
        float hr = 0.f, hi = 0.f;
        if (lat && ((d == 0 && seg == 0) || (d == 1 && seg == 7))) { const size_t si = ((((size_t)b * 2 + e) * 2 + d) * 32 + g) * 64 + lane; hr = P.in[I_S5RE][si]; hi = P.in[I_S5IM][si]; }
        const int ymode = d == 0 ? 0 : (lat ? 1 : 2);
        s5_scan_seg(P, wl, lane, d, g, m0, ar, ai, Bf, Cf, hr, hi, 0, ymode, proj, ybuf, mixout, dsk);
        if (!lat) { const size_t si = ((((size_t)b * 2 + e) * 2 + d) * 32 + g) * 64 + lane; P.out[OUT_S5RE + si] = hr; P.out[OUT_S5IM + si] = hi; }
        else { float* F = (float*)(P.ws + WS_S5F) + ((((size_t)d * 64 + q) * 32 + g) * 64 + lane) * 2; F[0] = hr; F[1] = hi; }
    }
}
__device__ __forceinline__ void s5_task_corr(const Params& P, LAS unsigned char* wl, int lane, int e, int q, int g) {
    const bf16* proj = (const bf16*)(P.ws + WS_BIG); float* ybuf = (float*)(P.ws + WS_YBUF); bf16* mixout = (bf16*)(P.ws + WS_MIX);
    const int b = q >> 3, seg = q & 7, m0 = MCTX + b * LLAT + seg * 256;
    bf16x8 Cf[4]; s5_c_setup(P, e, g, lane, Cf);
    bf16x8 Bf[8];
#pragma unroll
    for (int i = 0; i < 8; ++i) Bf[i] = (bf16x8){0, 0, 0, 0, 0, 0, 0, 0};
    const float* Fb = (const float*)(P.ws + WS_S5F);
#pragma unroll 1
    for (int d = 0; d < 2; ++d) {
        float ar, ai; s5_dir_setup(P, e, d, g, lane, ar, ai, Bf, false);
        float pr = ar, pi = ai;
#pragma unroll
        for (int i = 0; i < 8; ++i) { const float nr = pr * pr - pi * pi, ni = 2.0f * pr * pi; pr = nr; pi = ni; }
        float hr = 0.f, hi = 0.f;
        const int cnt = d == 0 ? seg : 7 - seg;
        for (int i = 0; i < cnt; ++i) { const int sj = d == 0 ? i : 7 - i; const float* F = Fb + ((((size_t)d * 64 + b * 8 + sj) * 32 + g) * 64 + lane) * 2;
            const float nr = pr * hr - pi * hi + F[0], ni = pr * hi + pi * hr + F[1]; hr = nr; hi = ni; }
        if (cnt > 0) s5_scan_seg(P, wl, lane, d, g, m0, ar, ai, Bf, Cf, hr, hi, 1, 1, proj, ybuf, mixout, 0.f);
    }
    __builtin_amdgcn_wave_barrier();
    for (int i = lane; i < 256 * 16; i += 64) { const size_t m = (size_t)(m0 + (i >> 4)); const int ch = g * 16 + (i & 15);
        const float v = ybuf[m * 512 + ch]; const float z = bf2f(proj[m * NPROJ_E + 512 + ch]);
        mixout[m * DM + ch] = (bf16)f2bf(geluf_(v) * sigmoidf_(z)); }
}

#ifndef REP_A
#define REP_A 1
#endif
#ifndef REP_B
#define REP_B 1
#endif
#ifndef REP_C
#define REP_C 1
#endif
__device__ __forceinline__ void phase_conv_even(int wid0, const Params& P, int e) {
    const int tid = tid_fresh(wid0), lane = tid & 63, wave = tid >> 6;
    const int gw = bid_fresh() * NWAVES + wave, NGW = grid_fresh() * NWAVES;
    bf16* proj = (bf16*)(P.ws + WS_BIG); const bf16* HALO = (const bf16*)(P.ws + WS_HALO);
    for (int it = gw; it < 384 * 24; it += NGW) {
        const int c = it / 24, cgp = it % 24, ccol = cgp * 64 + lane;
        const int r0 = c * 64;
        const bool lat = r0 >= MCTX; const int t0 = lat ? ((r0 - MCTX) & 2047) : (r0 & 255); const int L = lat ? LLAT : LCTX;
        bf16* base = proj + (size_t)r0 * NPROJ_E + 1024 + ccol;
        bf16 x[67];
#pragma unroll
        for (int i = 0; i < 64; ++i) x[i + 1] = base[(size_t)i * NPROJ_E];
        x[0] = (t0 > 0) ? HALO[((size_t)(c - 1) * 3 + 0) * 1536 + ccol] : (bf16)0;
        x[65] = (t0 + 64 < L) ? HALO[((size_t)(c + 1) * 3 + 1) * 1536 + ccol] : (bf16)0;
        x[66] = (t0 + 64 < L) ? HALO[((size_t)(c + 1) * 3 + 2) * 1536 + ccol] : (bf16)0;
        const float* cw = P.in[I_GCONVW] + (size_t)e * 4 * 1536 + ccol; const float w0 = cw[0], w1 = cw[1536], w2 = cw[3072], w3 = cw[4608], cb = P.in[I_GCONVB][e * 1536 + ccol];
#pragma unroll
        for (int i = 0; i < 64; ++i) { const float v = cb + w0 * bf2f(x[i]) + w1 * bf2f(x[i + 1]) + w2 * bf2f(x[i + 2]) + w3 * bf2f(x[i + 3]);
            base[(size_t)i * NPROJ_E] = (bf16)f2bf(siluf_(v)); }
    }
}
#define LDS_BARRIER() do { asm volatile("s_waitcnt lgkmcnt(0)" ::: "memory"); __builtin_amdgcn_s_barrier(); asm volatile("" ::: "memory"); } while (0)
constexpr int G_Q = 0, G_K = 17408, G_V = 34816, G_KT = 52224, G_LM = 70656, G_QK = 89088, G_ST = 98304, G_SM = 133120;
constexpr int P128 = 136, P64 = 72, LMP = 68;
__device__ __forceinline__ bf16x8 ld_split8(const LAS bf16* p) {
    const u32x2 a = *(const LAS u32x2*)p, b = *(const LAS u32x2*)(p + 16);
    return __builtin_bit_cast(bf16x8, (u32x4){a.x, a.y, b.x, b.y});
}
__device__ __forceinline__ bf16x8 pack_acc2(const f32x4& a, const f32x4& b) { return __builtin_bit_cast(bf16x8, (u32x4){pk2(a[0], a[1]), pk2(a[2], a[3]), pk2(b[0], b[1]), pk2(b[2], b[3])}); }
__device__ __forceinline__ void gdn_chain(int wid0, const Params& P, LAS unsigned char* lds, int e, int s, int hd, int dir) {
    const int tid = tid_fresh(wid0), lane = tid & 63, w = __builtin_amdgcn_readfirstlane(tid >> 6), quad = lane >> 4, l15 = lane & 15;
    const bool lat = s >= 32; const int b = lat ? s - 32 : s; const int L = lat ? LLAT : LCTX; const int m0 = lat ? MCTX + b * LLAT : s * LCTX;
    const bf16* proj = (const bf16*)(P.ws + WS_BIG); const float* AB = (const float*)(P.ws + WS_AB);
    bf16* Odir = (bf16*)(P.ws + WS_H) + (size_t)dir * MT * 512;
    int zv; asm volatile("v_mov_b32 %0, 0" : "=v"(zv));
    lds += zv;
    LAS bf16* Qs = (LAS bf16*)(lds + G_Q); LAS bf16* Ks = (LAS bf16*)(lds + G_K); LAS bf16* Vs = (LAS bf16*)(lds + G_V); LAS bf16* KT = (LAS bf16*)(lds + G_KT);
    LAS float* Lm = (LAS float*)(lds + G_LM); LAS bf16* VNT = (LAS bf16*)(lds + G_LM); LAS bf16* QKs = (LAS bf16*)(lds + G_QK); LAS bf16* ST = (LAS bf16*)(lds + G_ST);
    LAS bf16* TM = (LAS bf16*)(lds + G_ST); LAS bf16* TT = TM + 64 * P64; LAS bf16* LR = TT + 64 * P64;
    LAS float* rq = (LAS float*)(lds + G_SM); LAS float* rk = rq + 64; LAS float* gcs = rq + 128; LAS float* betas = rq + 192; LAS float* egs = rq + 256; LAS float* kes = rq + 320;
    f32x4 Sacc[8];
    const size_t sbase = ((((size_t)b * 2 + e) * 2 + dir) * 4 + hd) * 16384;
#pragma unroll
    for (int mt = 0; mt < 8; ++mt) Sacc[mt] = (f32x4){0.f, 0.f, 0.f, 0.f};
    if (lat) { const float* sp = P.in[I_SDELTA] + sbase + (size_t)(quad * 4) * 128 + 16 * w + l15;
#pragma unroll
        for (int mt = 0; mt < 8; ++mt)
#pragma unroll
            for (int jj = 0; jj < 4; ++jj) Sacc[mt][jj] = sp[(16 * mt + jj) * 128]; }
    for (int i = tid; i < 2 * 64 * P64 / 2; i += NTHR) ((LAS unsigned*)TM)[i] = 0u;
    const float alog_e = __expf(P.in[I_GALOG][(e * 2 + dir) * 4 + hd]), dtb = P.in[I_GDTB][(e * 2 + dir) * 4 + hd];
    const int nchunk = L / 64;
    u32x4 xr[6]; float ab_a = 0.f, ab_b = 0.f;
#define GDN_LOAD(ci_) do { const int tid_ = tid_fresh(wid0); const int c0_ = dir ? L - 64 * ((ci_) + 1) : 64 * (ci_); \
        _Pragma("unroll") for (int k = 0; k < 6; ++k) { const int p_ = tid_ + 512 * k, part_ = p_ >> 10, row_ = (p_ & 1023) >> 4, pc_ = p_ & 15; \
            xr[k] = *(const u32x4*)(proj + (size_t)(m0 + c0_ + row_) * NPROJ_E + 1024 + part_ * 512 + hd * 128 + pc_ * 8); } \
        if (w == 0) { const int ln_ = tid_ & 63; const size_t m_ = (size_t)(m0 + c0_ + (dir ? 63 - ln_ : ln_)); ab_a = AB[m_ * 16 + dir * 4 + hd]; ab_b = AB[m_ * 16 + 8 + dir * 4 + hd]; } } while (0)
    GDN_LOAD(0);
#pragma unroll 1
    for (int ci = 0; ci < nchunk; ++ci) {
        const int tid = tid_fresh(wid0), lane = tid & 63, quad = lane >> 4, l15 = lane & 15;
        const int c0 = dir ? L - 64 * (ci + 1) : 64 * ci;
        LDS_BARRIER();
#ifndef NO_A
        const float cur_a = ab_a, cur_b = ab_b;
#pragma unroll
        for (int k = 0; k < 6; ++k) { const int p_ = tid + 512 * k, part_ = p_ >> 10, row_ = (p_ & 1023) >> 4, pc_ = p_ & 15;
            LAS bf16* dst = part_ == 0 ? Qs : (part_ == 1 ? Ks : Vs);
            *(LAS u32x4*)(dst + (dir ? 63 - row_ : row_) * P128 + pc_ * 8) = xr[k]; }
        if (ci + 1 < nchunk) GDN_LOAD(ci + 1);
#endif
        LDS_BARRIER();
#pragma unroll 1
        for (int repB = 0; repB < REP_B; ++repB)
        { const int rowid = tid >> 2, part = tid & 3; LAS bf16* src = (rowid < 64 ? Qs : Ks) + (rowid & 63) * P128 + part * 32;
          float ss = 0.f;
#pragma unroll
          for (int i = 0; i < 4; ++i) { const u32x4 v = *(const LAS u32x4*)(src + 8 * i);
#pragma unroll
              for (int j = 0; j < 4; ++j) { const float a = bflo(v[j]), c = bfhi(v[j]); ss += a * a + c * c; } }
          ss += shfl_i(ss, lane ^ 1); ss += shfl_i(ss, lane ^ 2);
          if (part == 0) { if (rowid < 64) rq[rowid] = rsqrtf(ss + EPSF) * 0.08838834764831845f; else rk[rowid - 64] = rsqrtf(ss + EPSF); }
          if (w == 0) { const int t = c0 + (dir ? 63 - lane : lane); const size_t m = (size_t)(m0 + t);
              const float araw = cur_a, braw = cur_b;
              const float gg = -alog_e * softplusf_(araw + dtb);
              float gc = gg;
#pragma unroll
              for (int o = 1; o < 64; o <<= 1) { const float t2 = shfl_i(gc, (lane - o) & 63); if (lane >= o) gc += t2; }
              const float glast = shfl_i(gc, 63);
              gcs[lane] = gc; betas[lane] = sigmoidf_(braw); egs[lane] = __expf(gc); kes[lane] = __expf(glast - gc);
              if (lane == 0) rq[384] = __expf(glast); } }
        LDS_BARRIER();
#ifndef NO_C
#pragma unroll 1
        for (int repC = 0; repC < REP_C; ++repC)
        { const int mt = w & 3; const bool isq = w >= 4; LAS bf16* src = isq ? Qs : Ks;
          bf16x8 a[4];
#pragma unroll
          for (int ks = 0; ks < 4; ++ks) a[ks] = *(const LAS bf16x8*)(src + (16 * mt + l15) * P128 + 32 * ks + quad * 8);
#pragma unroll 1
          for (int nt = 0; nt < 4; ++nt) { f32x4 acc = (f32x4){0.f, 0.f, 0.f, 0.f};
#pragma unroll
              for (int ks = 0; ks < 4; ++ks) { const bf16x8 bb = *(const LAS bf16x8*)(Ks + (16 * nt + l15) * P128 + 32 * ks + quad * 8); acc = mfma16(a[ks], bb, acc); }
              const int j = 16 * nt + l15; const float rkj = rk[j], gcj = gcs[j];
              f32x4 lv;
#pragma unroll
              for (int jj = 0; jj < 4; ++jj) { const int i = 16 * mt + quad * 4 + jj; const float dec = __expf(fminf(gcs[i] - gcj, 0.f));
                  lv[jj] = (i > j) ? acc[jj] * rk[i] * rkj * betas[i] * dec : 0.f;
                  if (isq) QKs[i * P64 + j] = (bf16)f2bf((i >= j) ? acc[jj] * rq[i] * rkj * dec : 0.f); }
              if (!isq) { *(LAS f32x4*)(Lm + j * LMP + 16 * mt + quad * 4) = lv;
#pragma unroll
                  for (int jj = 0; jj < 4; ++jj) LR[(16 * mt + quad * 4 + jj) * P64 + j] = (bf16)f2bf(nt < mt ? lv[jj] : 0.f); } }
          const int dd = tid & 127, tq = tid >> 7;
          unsigned pw[8];
#pragma unroll
          for (int n = 0; n < 16; n += 2) { const int i0 = tq * 16 + n; const float v0 = bf2f(Ks[i0 * P128 + dd]) * rk[i0] * kes[i0], v1 = bf2f(Ks[(i0 + 1) * P128 + dd]) * rk[i0 + 1] * kes[i0 + 1]; pw[n >> 1] = pk2(v0, v1); }
          *(LAS u32x4*)(KT + dd * P64 + tq * 16) = (u32x4){pw[0], pw[1], pw[2], pw[3]};
          *(LAS u32x4*)(KT + dd * P64 + tq * 16 + 8) = (u32x4){pw[4], pw[5], pw[6], pw[7]}; }
#endif
        LDS_BARRIER();
        { const int i = tid >> 3, c0k = (tid & 7) * 16; const float sc = rk[i] * betas[i] * egs[i];
#pragma unroll
          for (int h2 = 0; h2 < 2; ++h2) { u32x4 v = *(LAS u32x4*)(Ks + i * P128 + c0k + 8 * h2);
#pragma unroll
              for (int q = 0; q < 4; ++q) v[q] = pk2(bflo(v[q]) * sc, bfhi(v[q]) * sc);
              *(LAS u32x4*)(Ks + i * P128 + c0k + 8 * h2) = v; } }
        if (w == 0) { const int bb = lane >> 4, c = lane & 15;
            float x[16];
#pragma unroll
            for (int r = 0; r < 16; ++r) x[r] = (r == c) ? 1.f : 0.f;
#pragma unroll
            for (int j = 0; j < 15; ++j) {
#pragma unroll
                for (int q4 = j / 4; q4 < 4; ++q4) { const f32x4 l4 = *(const LAS f32x4*)(Lm + (16 * bb + j) * LMP + 16 * bb + 4 * q4);
#pragma unroll
                    for (int jx = 0; jx < 4; ++jx) if (4 * q4 + jx > j) x[4 * q4 + jx] -= l4[jx] * x[j]; } }
            unsigned pw[8];
#pragma unroll
            for (int r = 0; r < 16; r += 2) { pw[r >> 1] = pk2(x[r], x[r + 1]); TM[(16 * bb + r) * P64 + 16 * bb + c] = (bf16)(pw[r >> 1] & 0xffffu); TM[(16 * bb + r + 1) * P64 + 16 * bb + c] = (bf16)(pw[r >> 1] >> 16); }
            *(LAS u32x4*)(TT + (16 * bb + c) * P64 + 16 * bb) = (u32x4){pw[0], pw[1], pw[2], pw[3]};
            *(LAS u32x4*)(TT + (16 * bb + c) * P64 + 16 * bb + 8) = (u32x4){pw[4], pw[5], pw[6], pw[7]}; }
        LDS_BARRIER();
#pragma unroll 1
        for (int lev = 1; lev < 4; ++lev) {
            if (w < 4 - lev) { const int bj = w, bi = w + lev;
                f32x4 m = (f32x4){0.f, 0.f, 0.f, 0.f};
#pragma unroll
                for (int ks = 0; ks < 2; ++ks) { const bf16x8 a = *(const LAS bf16x8*)(LR + (16 * bi + l15) * P64 + 32 * ks + quad * 8), bq = *(const LAS bf16x8*)(TT + (16 * bj + l15) * P64 + 32 * ks + quad * 8); m = mfma16(a, bq, m); }
                const u32x2 tl = *(const LAS u32x2*)(TM + (16 * bi + l15) * P64 + 16 * bi + quad * 4);
                const bf16x8 a2 = __builtin_bit_cast(bf16x8, (u32x4){tl.x, tl.y, 0u, 0u}), b2 = __builtin_bit_cast(bf16x8, (u32x4){pk2(m[0], m[1]), pk2(m[2], m[3]), 0u, 0u});
                const f32x4 t = mfma16(a2, b2, (f32x4){0.f, 0.f, 0.f, 0.f});
                const unsigned p0 = pk2(-t[0], -t[1]), p1 = pk2(-t[2], -t[3]);
                TM[(16 * bi + quad * 4 + 0) * P64 + 16 * bj + l15] = (bf16)(p0 & 0xffffu); TM[(16 * bi + quad * 4 + 1) * P64 + 16 * bj + l15] = (bf16)(p0 >> 16);
                TM[(16 * bi + quad * 4 + 2) * P64 + 16 * bj + l15] = (bf16)(p1 & 0xffffu); TM[(16 * bi + quad * 4 + 3) * P64 + 16 * bj + l15] = (bf16)(p1 >> 16);
                *(LAS u32x2*)(TT + (16 * bj + l15) * P64 + 16 * bi + quad * 4) = (u32x2){p0, p1}; }
            LDS_BARRIER();
        }
#ifndef NO_EFG
        bf16x8 Bst[4];
#pragma unroll
        for (int ks = 0; ks < 4; ++ks) Bst[ks] = pack_acc2(Sacc[2 * ks], Sacc[2 * ks + 1]);
        f32x4 vn[4];
#pragma unroll
        for (int mt = 0; mt < 4; ++mt) { f32x4 acc = (f32x4){0.f, 0.f, 0.f, 0.f};
#pragma unroll
            for (int ks = 0; ks < 4; ++ks) { const bf16x8 a = ld_split8(Ks + (16 * mt + l15) * P128 + 32 * ks + quad * 4); acc = mfma16(a, Bst[ks], acc); }
#pragma unroll
            for (int jj = 0; jj < 4; ++jj) { const int i = 16 * mt + quad * 4 + jj; vn[mt][jj] = bf2f(Vs[i * P128 + 16 * w + l15]) * betas[i] - acc[jj]; } }
        bf16x8 Bvn[2];
#pragma unroll
        for (int k2 = 0; k2 < 2; ++k2) Bvn[k2] = pack_acc2(vn[2 * k2], vn[2 * k2 + 1]);
#pragma unroll
        for (int mt = 0; mt < 4; ++mt) { f32x4 acc = (f32x4){0.f, 0.f, 0.f, 0.f};
#pragma unroll
            for (int k2 = 0; k2 < 2; ++k2) { const bf16x8 a = ld_split8(TM + (16 * mt + l15) * P64 + 32 * k2 + quad * 4); acc = mfma16(a, Bvn[k2], acc); }
            vn[mt] = acc; }
#pragma unroll
        for (int k2 = 0; k2 < 2; ++k2) Bvn[k2] = pack_acc2(vn[2 * k2], vn[2 * k2 + 1]);
#pragma unroll 1
        for (int mt = 0; mt < 4; ++mt) { f32x4 acc = (f32x4){0.f, 0.f, 0.f, 0.f};
#pragma unroll
            for (int ks = 0; ks < 4; ++ks) { const bf16x8 a = ld_split8(Qs + (16 * mt + l15) * P128 + 32 * ks + quad * 4); acc = mfma16(a, Bst[ks], acc); }
#pragma unroll
            for (int jj = 0; jj < 4; ++jj) { const int i = 16 * mt + quad * 4 + jj; acc[jj] *= rq[i] * egs[i]; }
#pragma unroll
            for (int k2 = 0; k2 < 2; ++k2) { const bf16x8 a = ld_split8(QKs + (16 * mt + l15) * P64 + 32 * k2 + quad * 4); acc = mfma16(a, Bvn[k2], acc); }
#pragma unroll
            for (int jj = 0; jj < 4; ++jj) { const int i = 16 * mt + quad * 4 + jj; const int t = c0 + (dir ? 63 - i : i);
                Odir[(size_t)(m0 + t) * 512 + hd * 128 + 16 * w + l15] = (bf16)f2bf(acc[jj]); } }
        const float egl = rq[384];
#pragma unroll
        for (int mt = 0; mt < 8; ++mt) { f32x4 acc = Sacc[mt] * egl;
#pragma unroll
            for (int k2 = 0; k2 < 2; ++k2) { const bf16x8 a = ld_split8(KT + (16 * mt + l15) * P64 + 32 * k2 + quad * 4); acc = mfma16(a, Bvn[k2], acc); }
            Sacc[mt] = acc; }
#endif
        WAVE_SYNC();
    }
    if (!lat) { const int tid2 = tid_fresh(wid0), lane2 = tid2 & 63; float* dp = P.out + OUT_DELTA + sbase + (size_t)((lane2 >> 4) * 4) * 128 + 16 * w + (lane2 & 15);
#pragma unroll
        for (int mt = 0; mt < 8; ++mt)
#pragma unroll
            for (int jj = 0; jj < 4; ++jj) dp[(16 * mt + jj) * 128] = Sacc[mt][jj];
    }
    __syncthreads();
}

__device__ __forceinline__ void phase_mix_even(int wid0, const Params& P, LAS unsigned char* lds, int e, int mode = 3) {
    const int bid = bid_fresh(), G = grid_fresh();
    if (G == 256) {
        if (bid < 64) { const int s = 32 + (bid >> 3), hd = (bid >> 1) & 3, dir = bid & 1; if (mode & 1) gdn_chain(wid0, P, lds, e, s, hd, dir); }
        else { const int bb = bid - 64;
            if (mode & 1) for (int c = bb; c < 256; c += 192) { const int s = c >> 3, hd = (c >> 1) & 3, dir = c & 1; gdn_chain(wid0, P, lds, e, s, hd, dir); }
            if (mode & 2) { const int tid = tid_fresh(wid0), lane = tid & 63, wave = tid >> 6;
                for (int t = bb; t < 384; t += 192) { const int wt = t * 8 + wave; s5_task_main(P, lds + wave * S5_WLDS, lane, e, wt >> 5, wt & 31); } }
            if (mode == 3) { __syncthreads(); const int tid = tid_fresh(wid0), lane = tid & 63, wave = tid >> 6;
                for (int it = bb * NWAVES + wave; it < WITEMS_ODD; it += 192 * NWAVES) weight_item(P, (LAS float*)(lds + wave * 16384), 2 * e + 1, it, lane); } }
    } else {
        for (int c = bid; c < 320; c += G) { const int s = c < 64 ? 32 + (c >> 3) : ((c - 64) >> 3), hd = (c >> 1) & 3, dir = c & 1; gdn_chain(wid0, P, lds, e, s, hd, dir); }
        const int tid = tid_fresh(wid0), lane = tid & 63, wave = tid >> 6;
        for (int t = bid; t < 384; t += G) { const int wt = t * 8 + wave; s5_task_main(P, lds + wave * S5_WLDS, lane, e, wt >> 5, wt & 31); }
        __syncthreads();
        for (int it = bid * NWAVES + wave; it < WITEMS_ODD; it += G * NWAVES) weight_item(P, (LAS float*)(lds + wave * 16384), 2 * e + 1, it, lane);
    }
}
__device__ __forceinline__ void phase_fin_even(int wid0, const Params& P, LAS unsigned char* lds, int e) {
    const int tid = tid_fresh(wid0), lane = tid & 63, wave = tid >> 6;
    const int gw = bid_fresh() * NWAVES + wave, NGW = grid_fresh() * NWAVES;
    for (int wt = gw; wt < 2048; wt += NGW) s5_task_corr(P, lds + wave * S5_WLDS, lane, e, wt >> 5, wt & 31);
    const bf16* proj = (const bf16*)(P.ws + WS_BIG); const bf16* Of = (const bf16*)(P.ws + WS_H); const bf16* Ob = Of + (size_t)MT * 512; bf16* mixout = (bf16*)(P.ws + WS_MIX);
    for (int m = gw; m < MT; m += NGW) {
        const u32x4 a = *(const u32x4*)(Of + (size_t)m * 512 + lane * 8), bq = *(const u32x4*)(Ob + (size_t)m * 512 + lane * 8), z = *(const u32x4*)(proj + (size_t)m * NPROJ_E + 2560 + lane * 8);
        float o[8]; float ss = 0.f;
#pragma unroll
        for (int j = 0; j < 4; ++j) { o[2 * j] = bflo(a[j]) + bflo(bq[j]); o[2 * j + 1] = bfhi(a[j]) + bfhi(bq[j]); ss += o[2 * j] * o[2 * j] + o[2 * j + 1] * o[2 * j + 1]; }
        ss += shfl_i(ss, lane ^ 1); ss += shfl_i(ss, lane ^ 2); ss += shfl_i(ss, lane ^ 4); ss += shfl_i(ss, lane ^ 8);
        const float rs = rsqrtf(ss * (1.0f / 128.0f) + EPSF);
        const float* gn = P.in[I_GONORM] + e * 128 + (lane & 15) * 8;
        unsigned pw[4];
#pragma unroll
        for (int j = 0; j < 4; ++j) { const float z0 = bflo(z[j]), z1 = bfhi(z[j]); pw[j] = pk2(o[2 * j] * rs * gn[2 * j] * siluf_(z0), o[2 * j + 1] * rs * gn[2 * j + 1] * siluf_(z1)); }
        *(u32x4*)(mixout + (size_t)m * DM + 512 + lane * 8) = (u32x4){pw[0], pw[1], pw[2], pw[3]};
    }
}

__device__ __forceinline__ void phase_conv_odd(int wid0, const Params& P, int o) {
    const int tid = tid_fresh(wid0), lane = tid & 63, wave = tid >> 6;
    const int gw = bid_fresh() * NWAVES + wave, NGW = grid_fresh() * NWAVES;
    const bf16* proj = (const bf16*)(P.ws + WS_BIG); bf16* cx = (bf16*)(P.ws + WS_H);
    const float* cw = P.in[I_LCONVW] + (size_t)o * 4 * 1024; const float* cb = P.in[I_LCONVB] + o * 1024;
    for (int m = gw; m < MT; m += NGW) {
        const int t = m < MCTX ? (m & 255) : ((m - MCTX) & 2047); const int L = m < MCTX ? LCTX : LLAT;
#pragma unroll
        for (int h2 = 0; h2 < 2; ++h2) { const int ch = lane * 8 + 512 * h2;
            float acc[8];
#pragma unroll
            for (int j = 0; j < 8; ++j) acc[j] = cb[ch + j];
#pragma unroll
            for (int k = 0; k < 4; ++k) { const int tt = t - 1 + k; if (tt >= 0 && tt < L) { const u32x4 v = *(const u32x4*)(proj + (size_t)(m - 1 + k) * 2048 + ch);
#pragma unroll
                    for (int j = 0; j < 4; ++j) { acc[2 * j] += cw[k * 1024 + ch + 2 * j] * bflo(v[j]); acc[2 * j + 1] += cw[k * 1024 + ch + 2 * j + 1] * bfhi(v[j]); } } }
            *(u32x4*)(cx + (size_t)m * DM + ch) = (u32x4){pk2(acc[0], acc[1]), pk2(acc[2], acc[3]), pk2(acc[4], acc[5]), pk2(acc[6], acc[7])}; }
    }
}
__device__ __forceinline__ void phase_lru_scan(int wid0, const Params& P, LAS unsigned char* lds, int o, int d) {
    const int tid = tid_fresh(wid0), lane = tid & 63, wave = tid >> 6;
    const int gw = bid_fresh() * NWAVES + wave, NGW = grid_fresh() * NWAVES;
    const unsigned* G = (const unsigned*)(P.ws + WS_GATES); const bf16* proj = (const bf16*)(P.ws + WS_BIG); bf16* mixout = (bf16*)(P.ws + WS_MIX);
    const int Gn = NGW / NWAVES, vw = wave * Gn + (gw / NWAVES);
    if (d == 0 && o == 0 && NGW > 640) {
        for (int it = vw - 640; it >= 0 && it < WITEMS_EVEN; it += NGW - 640) weight_item(P, (LAS float*)(lds + wave * 16384), 2, it, lane); }
    for (int task = vw; task < 640; task += NGW) {
        int s, cg_;
        if (task < 128) { s = 32 + (task >> 4); cg_ = task & 15; } else { s = (task - 128) >> 4; cg_ = (task - 128) & 15; }
        const bool lat = s >= 32; const int b = lat ? s - 32 : s; const int L = lat ? LLAT : LCTX; const int m0 = lat ? MCTX + b * LLAT : s * LCTX;
        const int ch = cg_ * 64 + lane;
        float h = lat ? P.in[I_SLRU][(((size_t)b * 2 + o) * 2 + d) * 1024 + ch] : 0.f;
        if (d == 0) {
            unsigned ga[32], gb[32];
#define LRU_LD0(dst, tt) _Pragma("unroll") for (int i = 0; i < 32; ++i) dst[i] = G[(size_t)(m0 + (tt) + i) * DM + ch]
#define LRU_CP0(src, tt) _Pragma("unroll") for (int i = 0; i < 32; ++i) { h = __builtin_amdgcn_exp2f(bflo(src[i])) * h + bfhi(src[i]); mixout[(size_t)(m0 + (tt) + i) * DM + ch] = (bf16)f2bf(h); }
            LRU_LD0(ga, 0);
            for (int t0 = 0; t0 < L; t0 += 64) {
                LRU_LD0(gb, t0 + 32);
                LRU_CP0(ga, t0);
                if (t0 + 64 < L) { LRU_LD0(ga, t0 + 64); }
                LRU_CP0(gb, t0 + 32);
            }
        } else {
            unsigned ga[16], gb[16]; bf16 pa[16], pb[16], ya[16], yb[16];
#define LRU_LD1(g_, p_, y_, tt) _Pragma("unroll") for (int i = 0; i < 16; ++i) { const size_t m = (size_t)(m0 + L - 1 - ((tt) + i)); g_[i] = G[m * DM + ch]; p_[i] = mixout[m * DM + ch]; y_[i] = proj[m * 2048 + 1024 + ch]; }
#define LRU_CP1(g_, p_, y_, tt) _Pragma("unroll") for (int i = 0; i < 16; ++i) { const size_t m = (size_t)(m0 + L - 1 - ((tt) + i)); \
                h = __builtin_amdgcn_exp2f(bflo(g_[i])) * h + bfhi(g_[i]); mixout[m * DM + ch] = (bf16)f2bf((bf2f(p_[i]) + h) * geluf_(bf2f(y_[i]))); }
            LRU_LD1(ga, pa, ya, 0);
            for (int t0 = 0; t0 < L; t0 += 32) {
                LRU_LD1(gb, pb, yb, t0 + 16);
                LRU_CP1(ga, pa, ya, t0);
                if (t0 + 32 < L) { LRU_LD1(ga, pa, ya, t0 + 32); }
                LRU_CP1(gb, pb, yb, t0 + 16);
            }
        }
        if (!lat) P.out[OUT_LRU + (((size_t)b * 2 + o) * 2 + d) * 1024 + ch] = h;
    }
}
#ifdef PROBE_DUP_GEMM
#define DUPG(x) GSYNC(); x
#else
#define DUPG(x)
#endif
typedef const __attribute__((address_space(4))) Params* KParams;
__device__ __forceinline__ Params load_params(KParams q) { Params r;
#pragma unroll
    for (int i = 0; i < 40; ++i) r.in[i] = q->in[i];
    r.out = q->out; r.ws = q->ws; return r; }
#define FRESH() const int G = grid_fresh(), bid = bid_fresh(); (void)G; (void)bid; KParams pk_ = (KParams)__builtin_amdgcn_kernarg_segment_ptr(); asm volatile("" : "+s"(pk_)); const Params P = load_params(pk_); unsigned char* ws = P.ws; \
    const float* mod = (const float*)(ws + WS_MOD); bf16* H = (bf16*)(ws + WS_H); bf16* BIG = (bf16*)(ws + WS_BIG); bf16* MIX = (bf16*)(ws + WS_MIX); (void)mod; (void)H; (void)BIG; (void)MIX;
#define GSYNC() do { KParams pb_ = (KParams)__builtin_amdgcn_kernarg_segment_ptr(); asm volatile("" : "+s"(pb_)); xcd_barrier(wid0, (unsigned*)(pb_->ws + WS_BAR), lds); } while (0)
__global__ void __launch_bounds__(NTHR, 2) fwd_kernel(Params Parg) {
    extern __shared__ __attribute__((aligned(16))) unsigned char lds_raw[];
    LAS unsigned char* lds = (LAS unsigned char*)lds_raw;
    cg::grid_group grid = cg::this_grid();
    const int wid0 = __builtin_amdgcn_readfirstlane(threadIdx.x >> 6);
    if (threadIdx.x < 4) ((LAS unsigned*)(lds + LDS_BARST))[threadIdx.x] = 0u;
    __syncthreads();
    if (threadIdx.x == 0) (void)xb_add((unsigned*)(Parg.ws + WS_BAR) + XB_XCNT(xb_xcc_id()), 1u);

    { FRESH(); phase_prologue(wid0, P, lds); }
    if (grid_fresh() == 0) grid.sync();
    GSYNC();
#ifdef PROBE_DUP_PRO
    { FRESH(); phase_prologue(wid0, P, lds); }
    GSYNC();
#endif
    { FRESH(); phase_modreduce(wid0, P); }
    GSYNC();
#ifdef PROBE_SYNC
#pragma unroll 1
    for (int i = 0; i < 40; ++i) GSYNC();
#endif
#pragma unroll 1
    for (int l = 0; l < 4; ++l) {
        { FRESH(); const float* modl = mod + (size_t)l * 9 * 6144;
        phase_rownorm(wid0, P, l == 0, MIX, modl - 9 * 6144, 5 * 1024, P.in[I_NMLPPOST] + (l > 0 ? (l - 1) * 1024 : 0), 1, P.in[I_NMIXPRE] + l * 1024, modl, 0, H); }
        GSYNC();
        const int eo = l >> 1;
        {
            FRESH();
            pg8::Gemm g; pg8::StaticOrder S; EpiBf16<0> E;
            if ((l & 1) == 0) { g = pg8::Gemm{H, (const bf16*)(ws + WS_WINE) + (size_t)eo * NB_E * 1024, MT, NB_E, 1024, 1024, 0, 0, 1024, 0}; E = EpiBf16<0>{BIG, NPROJ_E, (float*)(ws + WS_AB), (bf16*)(ws + WS_HALO)}; }
            else { g = pg8::Gemm{H, (const bf16*)(ws + WS_WINO) + (size_t)eo * 2048 * 1024, MT, 2048, 1024, 1024, 0, 0, 1024, 0}; E = EpiBf16<0>{BIG, 2048, nullptr, nullptr}; }
            S.init(g.M, g.N, G, bid);
            pg8::gemm_phase(wid0, lds, g, S, E); DUPG(pg8::gemm_phase(wid0, lds, g, S, E);)
        }
        GSYNC();
        if ((l & 1) == 0) {
            { FRESH(); phase_conv_even(wid0, P, eo); }
            GSYNC();
#ifdef PROBE_DUP_MIX
#pragma unroll 1
            for (int rep = 0; rep < 2; ++rep) { { FRESH(); phase_mix_even(wid0, P, lds, eo, rep == 0 ? 3 : PROBE_DUP_MIX); } GSYNC(); }
#else
            { FRESH(); phase_mix_even(wid0, P, lds, eo); }
            GSYNC();
#endif
            { FRESH(); phase_fin_even(wid0, P, lds, eo); }
            GSYNC();
        } else {
            { FRESH(); phase_conv_odd(wid0, P, eo); }
            GSYNC();
#ifdef PROBE_DUP_CONV
            { FRESH(); phase_conv_odd(wid0, P, eo); }
            GSYNC();
#endif
#pragma unroll 1
            for (int d = 0; d < 2; ++d) {
                { FRESH();
                pg8::Gemm g{H, (const bf16*)(ws + WS_WG) + (size_t)(eo * 2 + d) * 2048 * 256, MT, 2048, 256, 1024, 1, 1, 256, 0};
                EpiGates E{(unsigned*)(ws + WS_GATES), H, P.in[I_LBR] + (eo * 2 + d) * 1024, P.in[I_LBI] + (eo * 2 + d) * 1024, P.in[I_LLAM] + (eo * 2 + d) * 1024};
                pg8::StaticOrder S; S.init(g.M, g.N, G, bid);
                pg8::gemm_phase(wid0, lds, g, S, E); DUPG(pg8::gemm_phase(wid0, lds, g, S, E);) }
                GSYNC();
                { FRESH(); phase_lru_scan(wid0, P, lds, eo, d); }
#ifdef PROBE_DUP_LRU0
                if (d == 0) { GSYNC(); FRESH(); phase_lru_scan(wid0, P, lds, eo, d); }
#endif
                GSYNC();
            }
        }
        {
            FRESH();
            pg8::Gemm g{MIX, (const bf16*)(ws + ((l & 1) ? WS_WOUTO : WS_WOUTE)) + (size_t)eo * 1024 * 1024, MT, 1024, 1024, 1024, 0, 0, 1024, 0};
            EpiBf16<0> E{BIG, 1024, nullptr, nullptr}; pg8::StaticOrder S; S.init(g.M, g.N, G, bid);
            pg8::gemm_phase(wid0, lds, g, S, E); DUPG(pg8::gemm_phase(wid0, lds, g, S, E);)
        }
        GSYNC();
        { FRESH(); const float* modl = mod + (size_t)l * 9 * 6144;
        phase_rownorm(wid0, P, 0, BIG, modl, 2 * 1024, P.in[I_NMIXPOST] + l * 1024, 1, P.in[I_NMLPPRE] + l * 1024, modl, 3 * 1024, H); }
        GSYNC();
        {
            FRESH();
            pg8::Gemm g{H, (const bf16*)(ws + WS_W1T) + (size_t)l * 4096 * 1024, MT, 4096, 1024, 1024, 0, 0, 1024, 0};
            EpiBf16<1> E{BIG, 4096, nullptr, nullptr}; pg8::StaticOrder S; S.init(g.M, g.N, G, bid);
            pg8::gemm_phase(wid0, lds, g, S, E); DUPG(pg8::gemm_phase(wid0, lds, g, S, E);)
        }
        GSYNC();
        {
            FRESH();
            pg8::Gemm g{BIG, (const bf16*)(ws + WS_W2T) + (size_t)l * 1024 * 4096, MT, 1024, 4096, 4096, 0, 0, 4096, 0};
            EpiBf16<0> E{MIX, 1024, nullptr, nullptr}; pg8::StaticOrder S; S.init(g.M, g.N, G, bid);
            pg8::gemm_phase(wid0, lds, g, S, E); DUPG(pg8::gemm_phase(wid0, lds, g, S, E);)
        }
        GSYNC();
    }
    { FRESH();
    phase_rownorm(wid0, P, 0, MIX, mod + (size_t)3 * 9 * 6144, 5 * 1024, P.in[I_NMLPPOST] + 3 * 1024, 0, P.in[I_NMIXPRE], mod, 0, H); }
}

extern "C" void kernel_launch(void* const* d_in, const int* in_sizes, int n_in, void* d_out, int out_size, void* d_ws, size_t ws_size, hipStream_t stream) {
    static int grid = 0;
    if (grid == 0) {
        if (n_in != 40 || ws_size < WS_END) { fprintf(stderr, "kernel_launch: expected 40 inputs and >= %zu bytes of workspace (got %d, %zu)\n", (size_t)WS_END, n_in, ws_size); grid = -1; return; }
        int dev = 0, cus = 0, per_cu = 0;
        if (hipGetDevice(&dev) != hipSuccess || hipDeviceGetAttribute(&cus, hipDeviceAttributeMultiprocessorCount, dev) != hipSuccess) { grid = -1; return; }
        if (hipFuncSetAttribute((const void*)fwd_kernel, hipFuncAttributeMaxDynamicSharedMemorySize, LDS_BYTES) != hipSuccess) { fprintf(stderr, "kernel_launch: hipFuncSetAttribute failed\n"); grid = -1; return; }
        if (hipOccupancyMaxActiveBlocksPerMultiprocessor(&per_cu, (const void*)fwd_kernel, NTHR, LDS_BYTES) != hipSuccess || per_cu < 1) per_cu = 1;
        (void)hipGetLastError();
        grid = cus * per_cu; if (grid > 256) grid = 256;
    }
    if (grid < 0) return;
    (void)hipMemsetAsync((char*)d_ws + WS_BAR, 0, 16384, stream);
    Params p{};
    for (int i = 0; i < 40; ++i) p.in[i] = (const float*)d_in[i];
    p.out = (float*)d_out; p.ws = (unsigned char*)d_ws;
    void* args[] = {&p};
    hipError_t e = hipLaunchCooperativeKernel((const void*)fwd_kernel, dim3(grid), dim3(NTHR), args, LDS_BYTES, stream);
    if (e != hipSuccess) fprintf(stderr, "cooperative launch failed: %s (grid %d)\n", hipGetErrorString(e), grid);
}
```

```cpp
#include <hip/hip_runtime.h>
#include <hip/hip_cooperative_groups.h>
#include <cstdio>
#include <cstdint>
namespace cg = cooperative_groups;
__device__ __forceinline__ int bid_fresh() { int t = blockIdx.x; asm volatile("" : "+s"(t)); return t; }
__device__ __forceinline__ int grid_fresh() { int t = gridDim.x; asm volatile("" : "+s"(t)); return t; }
__device__ __forceinline__ int tid_fresh(int w) { asm volatile("" : "+s"(w)); int l; asm volatile("v_mbcnt_lo_u32_b32 %0, -1, 0\n\tv_mbcnt_hi_u32_b32 %0, -1, %0" : "=v"(l)); return w * 64 + l; }

namespace pg8 {
#define PG8_LAS __attribute__((address_space(3)))
typedef unsigned short bf16_t;
typedef short bf16x8 __attribute__((ext_vector_type(8)));
typedef float f32x4 __attribute__((ext_vector_type(4)));
typedef unsigned u32x4 __attribute__((ext_vector_type(4)));
typedef unsigned u32x2 __attribute__((ext_vector_type(2)));
constexpr int BM = 256, BK = 64, HALF = 128, HTB = HALF * BK * 2, STAGE_BYTES = 8 * HTB, NXCD = 8, WGM = 8;

__host__ __device__ __forceinline__ int lds_byte(int r, int c) { const int st = (r >> 4) * 2 + (c >> 5), rr = r & 15, cc = c & 31, ob = rr * 64 + cc * 2; return st * 1024 + (ob ^ (((ob >> 9) & 1) << 5)); }
__host__ __device__ __forceinline__ void stage_rc(int b, int& R, int& C) { const int st = b / 1024, sb = b % 1024, swz = sb ^ (((sb >> 9) & 1) << 5); R = (st >> 1) * 16 + swz / 64; C = (st & 1) * 32 + (swz % 64) / 2; }
__host__ __device__ __forceinline__ int perm32(int rho) { const int n = rho >> 4, i = rho & 15; return 8 * (i >> 2) + 4 * n + (i & 3); }

struct Unit { int pm, pn; };
struct Gemm { const bf16_t* A; const bf16_t* Bt; int M, N, K, lda, ablk, ashift, ldb, ksplit; };

struct StaticOrder {
    int nM, nN, nwg, G, c;
    __host__ __device__ void init(int M, int N, int G_, int c_) { nM = M / BM; nN = N / BM; nwg = nM * nN; G = G_; c = c_; }
    __host__ __device__ bool next(int i, Unit& u) const {
        const long L = (long)i * G + c; if (L >= nwg) return false;
        int wgid = (int)L; { const int q = nwg / NXCD, r = nwg % NXCD, xcd = wgid % NXCD, off = wgid / NXCD; wgid = (xcd < r ? xcd * (q + 1) : r * (q + 1) + (xcd - r) * q) + off; }
        const int nig = WGM * nN, gid = wgid / nig, fm = gid * WGM, gsz = (nM - fm) < WGM ? (nM - fm) : WGM;
        u.pm = fm + ((wgid % nig) % gsz); u.pn = (wgid % nig) / gsz; return true;
    }
};
__device__ __forceinline__ unsigned cvt_pk_bf16(float lo, float hi) { unsigned r; asm volatile("v_cvt_pk_bf16_f32 %0, %1, %2" : "=v"(r) : "v"(lo), "v"(hi)); return r; }

template <class Epi>
__device__ __forceinline__ void gemm_phase(int wid0, PG8_LAS unsigned char* lds, const Gemm g, const StaticOrder& S, const Epi& E) {
    const int tid = tid_fresh(wid0), wid = __builtin_amdgcn_readfirstlane(tid >> 6), lane = tid & 63, wr = wid >> 2, wc = wid & 3, fr = lane & 15, fq = lane >> 4;
    const int K = g.K, nt = K / BK, lda = g.lda, ldb = g.ldb;
    unsigned voffA[2], voffB[2];
#pragma unroll
    for (int i = 0; i < 2; ++i) { int R, C; stage_rc(tid * 16 + i * 8192, R, C); const int Rb = (R & ~31) + perm32(R & 31);
        voffA[i] = (unsigned)(R * lda + C) * 2u; voffB[i] = (unsigned)(Rb * ldb + C) * 2u; }
    const size_t kstep = (size_t)(BK * 2);
    const size_t hstepA = (size_t)HALF * lda * 2, hstepB = (size_t)HALF * ldb * 2;
    const size_t tstepA = 2 * hstepA, tstepB = 2 * hstepB;
    const unsigned ldsw = (unsigned)wid * 1024u;
    const int aoff = lds_byte(wr * 64 + fr, fq * 8), boff = lds_byte(wc * 32 + fr, fq * 8);
#define PG8_ACOL(pn) (g.ablk ? (size_t)((((pn) >> g.ashift) & 3) * 512) : (g.ksplit ? (size_t)((pn) & 1) * (size_t)K * 2 : (size_t)0))
#define PG8_BOFF(pn) (g.ksplit ? (size_t)((pn) >> 1) * tstepB + (size_t)((pn) & 1) * (size_t)K * 2 : (size_t)(pn) * tstepB)
#define PG8_SA(b, h) (((b) * 2 + (h)) * HTB)
#define PG8_SB(b, h) ((4 + (b) * 2 + (h)) * HTB)
#define PG8_STAGE(bufoff, gbase, voff) do { _Pragma("unroll") for (int _i = 0; _i < 2; ++_i) \
        __builtin_amdgcn_global_load_lds((const unsigned*)((const char*)(gbase) + (voff)[_i]), (PG8_LAS unsigned*)(lds + (bufoff) + ldsw + _i * 8192), 16, 0, 0); } while (0)
#define PG8_LDA(dst, b, h) do { _Pragma("unroll") for (int m = 0; m < 4; ++m) _Pragma("unroll") for (int k = 0; k < 2; ++k) dst[m][k] = *(const PG8_LAS bf16x8*)(lds + PG8_SA(b, h) + aoff + m * 2048 + k * 1024); } while (0)
#define PG8_LDB(dst, b, h) do { _Pragma("unroll") for (int n = 0; n < 2; ++n) _Pragma("unroll") for (int k = 0; k < 2; ++k) dst[n][k] = *(const PG8_LAS bf16x8*)(lds + PG8_SB(b, h) + boff + n * 2048 + k * 1024); } while (0)
#define PG8_MMA(ai, bj, At, Bt) do { __builtin_amdgcn_s_setprio(1); _Pragma("unroll") for (int m = 0; m < 4; ++m) _Pragma("unroll") for (int n = 0; n < 2; ++n) _Pragma("unroll") for (int k = 0; k < 2; ++k) \
        acc[ai][bj][m][n] = __builtin_amdgcn_mfma_f32_16x16x32_bf16(Bt[n][k], At[m][k], acc[ai][bj][m][n], 0, 0, 0); __builtin_amdgcn_s_setprio(0); } while (0)
#define PG8_WAIT_V(n) asm volatile("s_waitcnt vmcnt(" #n ")" ::: "memory")
#define PG8_WAIT_L(n) asm volatile("s_waitcnt lgkmcnt(" #n ")" ::: "memory")
#define PG8_BAR __builtin_amdgcn_s_barrier()
#define PG8_SCHED __builtin_amdgcn_sched_barrier(0)
    Unit cur, nxt; int ui = 0;
    if (!S.next(0, cur)) return;
    f32x4 acc[2][2][4][2];
#pragma unroll
    for (int a = 0; a < 2; ++a)
#pragma unroll
        for (int b = 0; b < 2; ++b)
#pragma unroll
            for (int m = 0; m < 4; ++m)
#pragma unroll
                for (int n = 0; n < 2; ++n) acc[a][b][m][n] = (f32x4){0.f, 0.f, 0.f, 0.f};
    bf16x8 At[4][2], B0[2][2], B1[2][2];
    const char* cA = (const char*)g.A + (size_t)cur.pm * tstepA + PG8_ACOL(cur.pn); const char* cB = (const char*)g.Bt + PG8_BOFF(cur.pn);
    PG8_STAGE(PG8_SB(0, 0), cB, voffB); PG8_STAGE(PG8_SA(0, 0), cA, voffA); PG8_STAGE(PG8_SB(0, 1), cB + hstepB, voffB); PG8_STAGE(PG8_SA(0, 1), cA + hstepA, voffA);
    if (wr == 1) PG8_BAR;
    PG8_WAIT_V(4); PG8_BAR;
    PG8_STAGE(PG8_SB(1, 0), cB + kstep, voffB); PG8_STAGE(PG8_SA(1, 0), cA + kstep, voffA); PG8_STAGE(PG8_SB(1, 1), cB + hstepB + kstep, voffB);
    PG8_WAIT_V(6); PG8_BAR;
    for (;;) {
        const bool has_next = S.next(ui + 1, nxt);
        const char* nA = has_next ? (const char*)g.A + (size_t)nxt.pm * tstepA + PG8_ACOL(nxt.pn) : cA; const char* nB = has_next ? (const char*)g.Bt + PG8_BOFF(nxt.pn) : cB;
        for (int t = 0; t < nt; t += 2) {
            const bool last = (t == nt - 2);
            const char* a1 = cA + (size_t)(t + 1) * kstep;
            const char* a2 = last ? nA : cA + (size_t)(t + 2) * kstep; const char* b2 = last ? nB : cB + (size_t)(t + 2) * kstep;
            const char* a3 = a2 + kstep; const char* b3 = b2 + kstep;
            PG8_LDB(B0, 0, 0); PG8_SCHED; PG8_LDA(At, 0, 0); PG8_STAGE(PG8_SA(1, 1), a1 + hstepA, voffA);
            PG8_WAIT_L(8); PG8_BAR; PG8_WAIT_L(0); PG8_MMA(0, 0, At, B0); PG8_BAR; PG8_SCHED;
            PG8_LDB(B1, 0, 1); PG8_STAGE(PG8_SB(0, 0), b2, voffB);
            PG8_BAR; PG8_WAIT_L(0); PG8_MMA(0, 1, At, B1); PG8_BAR;
            PG8_LDA(At, 0, 1); PG8_STAGE(PG8_SA(0, 0), a2, voffA);
            PG8_BAR; PG8_WAIT_L(0); PG8_MMA(1, 0, At, B0); PG8_BAR; PG8_SCHED;
            PG8_STAGE(PG8_SB(0, 1), b2 + hstepB, voffB);
            PG8_WAIT_V(6); PG8_BAR; PG8_MMA(1, 1, At, B1); PG8_BAR;
            PG8_LDB(B0, 1, 0); PG8_SCHED; PG8_LDA(At, 1, 0); PG8_STAGE(PG8_SA(0, 1), a2 + hstepA, voffA);
            PG8_WAIT_L(8); PG8_BAR; PG8_WAIT_L(0); PG8_MMA(0, 0, At, B0); PG8_BAR; PG8_SCHED;
            PG8_LDB(B1, 1, 1); PG8_STAGE(PG8_SB(1, 0), b3, voffB);
            PG8_BAR; PG8_WAIT_L(0); PG8_MMA(0, 1, At, B1); PG8_BAR;
            PG8_LDA(At, 1, 1); PG8_STAGE(PG8_SA(1, 0), a3, voffA);
            PG8_BAR; PG8_WAIT_L(0); PG8_MMA(1, 0, At, B0); PG8_BAR; PG8_SCHED;
            PG8_STAGE(PG8_SB(1, 1), b3 + hstepB, voffB);
            PG8_WAIT_V(6); PG8_BAR; PG8_MMA(1, 1, At, B1); PG8_BAR;
        }
        E(acc, cur, wr, wc, fr, fq);
        if (!has_next) break;
#pragma unroll
        for (int a = 0; a < 2; ++a)
#pragma unroll
            for (int b = 0; b < 2; ++b)
#pragma unroll
                for (int m = 0; m < 4; ++m)
#pragma unroll
                    for (int n = 0; n < 2; ++n) acc[a][b][m][n] = (f32x4){0.f, 0.f, 0.f, 0.f};
        cur = nxt; cA = nA; cB = nB; ++ui;
    }
    PG8_WAIT_V(0);
    if (wr == 0) PG8_BAR;
    PG8_BAR;
#undef PG8_ACOL
#undef PG8_BOFF
#undef PG8_SA
#undef PG8_SB
#undef PG8_STAGE
#undef PG8_LDA
#undef PG8_LDB
#undef PG8_MMA
#undef PG8_WAIT_V
#undef PG8_WAIT_L
#undef PG8_BAR
#undef PG8_SCHED
}
}
#define LAS __attribute__((address_space(3)))
typedef unsigned short bf16;
typedef short bf16x8 __attribute__((ext_vector_type(8)));
typedef float f32x4 __attribute__((ext_vector_type(4)));
typedef unsigned u32x4 __attribute__((ext_vector_type(4)));
typedef unsigned u32x2 __attribute__((ext_vector_type(2)));
constexpr int DM = 1024, MT = 24576, MCTX = 8192, LCTX = 256, LLAT = 2048, NWAVES = 8, NTHR = 512;
constexpr int NPROJ_E = 3072, NB_E = 3328, IN_EVEN_LD = 3088;
constexpr float EPSF = 1e-6f;
constexpr size_t MiB = 1u << 20;
constexpr size_t WS_MOD = 0, MOD_BYTES = 4 * 9 * 6144 * 4, WS_S5F = 1 * MiB, WS_AB = 3 * MiB, WS_W1T = 5 * MiB, WS_W2T = 37 * MiB, WS_WINE = 69 * MiB,
                 WS_WOUTE = 82 * MiB, WS_WINO = 86 * MiB, WS_WOUTO = 94 * MiB, WS_WG = 98 * MiB, WS_H = 102 * MiB, WS_BIG = 150 * MiB, WS_YBUF = 294 * MiB,
                 WS_GATES = 246 * MiB, WS_MIX = 342 * MiB, WS_HALO = 390 * MiB, WS_END = 390 * MiB + 384 * 3 * 1536 * 2;
constexpr int LDS_BYTES = 147456;
constexpr size_t OUT_S5RE = 25165824, OUT_S5IM = OUT_S5RE + 262144, OUT_DELTA = OUT_S5IM + 262144, OUT_LRU = OUT_DELTA + 8388608;

struct Params { const float* in[40]; float* out; unsigned char* ws; };
enum { I_XP = 0, I_XS, I_S5RE, I_S5IM, I_SDELTA, I_SLRU, I_C, I_CCTX, I_WADA, I_BADA, I_NMIXPRE, I_NMIXPOST, I_NMLPPRE, I_NMLPPOST, I_WMLPIN, I_WMLPOUT, I_WINE, I_WOUTE,
       I_LAMRE, I_LAMIM, I_LOGDT, I_BRE, I_BIM, I_CRE, I_CIM, I_S5D, I_GCONVW, I_GCONVB, I_GALOG, I_GDTB, I_GONORM, I_WINO, I_WOUTO, I_LCONVW, I_LCONVB, I_LWR, I_LBR, I_LWI, I_LBI, I_LLAM };

typedef __bf16 bf2_t __attribute__((ext_vector_type(2)));
typedef float f2_t __attribute__((ext_vector_type(2)));
__device__ __forceinline__ unsigned pk2(float lo, float hi) { const bf2_t v = __builtin_convertvector((f2_t){lo, hi}, bf2_t); return __builtin_bit_cast(unsigned, v); }
__device__ __forceinline__ unsigned f2bf(float f) { return pk2(f, f) & 0xffffu; }
__device__ __forceinline__ float bflo(unsigned w) { return __builtin_bit_cast(float, w << 16); }
__device__ __forceinline__ float bfhi(unsigned w) { return __builtin_bit_cast(float, w & 0xffff0000u); }
__device__ __forceinline__ float bf2f(bf16 b) { return __builtin_bit_cast(float, (unsigned)b << 16); }
__device__ __forceinline__ float sigmoidf_(float x) { return __builtin_amdgcn_rcpf(1.0f + __expf(-x)); }
__device__ __forceinline__ float siluf_(float x) { return x * sigmoidf_(x); }
__device__ __forceinline__ float softplusf_(float x) { return fmaxf(x, 0.f) + __logf(1.0f + __expf(-fabsf(x))); }
__device__ __forceinline__ float geluf_(float x) { const float y = 0.7978845608028654f * (x + 0.044715f * x * x * x); const float t = 1.0f - 2.0f * __builtin_amdgcn_rcpf(__expf(2.0f * y) + 1.0f); return 0.5f * x * (1.0f + t); }
__device__ __forceinline__ float shfl_i(float v, int srclane) { return __builtin_bit_cast(float, __builtin_amdgcn_ds_bpermute(srclane << 2, __builtin_bit_cast(int, v))); }
__device__ __forceinline__ float wave_sum(float v, int lane) {
#pragma unroll
    for (int o = 1; o < 64; o <<= 1) v += shfl_i(v, lane ^ o);
    return v;
}
#define LDS_WAIT() asm volatile("s_waitcnt lgkmcnt(0)" ::: "memory")
#define WAVE_SYNC() do { asm volatile("s_waitcnt lgkmcnt(0)" ::: "memory"); __builtin_amdgcn_wave_barrier(); } while (0)
__device__ __forceinline__ f32x4 mfma16(bf16x8 a, bf16x8 b, f32x4 c) { return __builtin_amdgcn_mfma_f32_16x16x32_bf16(a, b, c, 0, 0, 0); }


#define XB_TMO      128
#define XB_XCNT(j)  (256  + 64 * (j))
#define XB_XSUB(j)  (1280 + 64 * (j))
#define XB_XGEN(j)  (2304 + 64 * (j))
#define XB_TOP      3328
#define XB_TOPGEN   3392
#define XCD_BAR_WORDS 3456
#define XB_SPIN_CAP (1u << 18)
constexpr size_t WS_BAR = 960 * 1024; constexpr int LDS_BARST = LDS_BYTES - 16;
__device__ __forceinline__ unsigned xb_ld(unsigned* p)              { return __hip_atomic_load(p, __ATOMIC_RELAXED, __HIP_MEMORY_SCOPE_AGENT); }
__device__ __forceinline__ unsigned xb_add(unsigned* p, unsigned v) { return __hip_atomic_fetch_add(p, v, __ATOMIC_RELAXED, __HIP_MEMORY_SCOPE_AGENT); }
__device__ __forceinline__ unsigned xb_xcc_id() { return (unsigned)__builtin_amdgcn_s_getreg((3 << 11) | 20) & 0xFu; }
#define XB_SPIN(cond, bar) do { unsigned _sp = 0; while (cond) { __builtin_amdgcn_s_sleep(1); \
    if ((++_sp & 255u) == 0u) { if (xb_ld(&(bar)[XB_TMO])) break; if (_sp > XB_SPIN_CAP) { atomicAdd(&(bar)[XB_TMO], 1u); break; } } } } while (0)
__device__ __forceinline__ void xcd_barrier_complete(unsigned* bar, unsigned x, unsigned& nloc, unsigned& nx) {
    const unsigned G = gridDim.x;
    unsigned sum, cnt, mine, sp = 0u;
    for (;;) {
        sum = 0u; cnt = 0u; mine = 0u;
#pragma unroll
        for (unsigned j = 0; j < 16; ++j) { const unsigned c = xb_ld(&bar[XB_XCNT(j)]); sum += c; cnt += (c > 0u) ? 1u : 0u; mine = (j == x) ? c : mine; }
        if (sum == G) break;
        __builtin_amdgcn_s_sleep(1);
        if ((++sp & 255u) == 0u) { if (xb_ld(&bar[XB_TMO])) break; if (sp > XB_SPIN_CAP) { atomicAdd(&bar[XB_TMO], 1u); break; } }
    }
    nloc = mine > 0u ? mine : 1u; nx = cnt > 0u ? cnt : 1u;
}
__device__ __forceinline__ void xcd_barrier(int wid0, unsigned* bar, LAS unsigned char* lds) {
    const int tid = tid_fresh(wid0);
    asm volatile("s_waitcnt vmcnt(0)" ::: "memory");
    __syncthreads();
    if (tid == 0) {
        const unsigned x = xb_xcc_id();
        volatile LAS unsigned* st = (volatile LAS unsigned*)(lds + LDS_BARST);
        __builtin_amdgcn_s_waitcnt(0);
        unsigned nloc = st[0], nx = st[1];
        if (nloc == 0u) { xcd_barrier_complete(bar, x, nloc, nx); st[0] = nloc; st[1] = nx; }
        const unsigned old = xb_add(&bar[XB_XSUB(x)], 1u);
        const unsigned gen = old / nloc;
        if (old + 1u == (gen + 1u) * nloc) {
            __builtin_amdgcn_fence(__ATOMIC_RELEASE, "agent");
            asm volatile("s_waitcnt vmcnt(0)" ::: "memory");
            const unsigned og = xb_add(&bar[XB_TOP], 1u);
            const unsigned tg = og / nx;
            if (og + 1u == (tg + 1u) * nx) xb_add(&bar[XB_TOPGEN], 1u);
            else XB_SPIN(xb_ld(&bar[XB_TOPGEN]) == tg, bar);
            __builtin_amdgcn_fence(__ATOMIC_ACQUIRE, "agent");
            xb_add(&bar[XB_XGEN(x)], 1u);
            asm volatile("s_waitcnt vmcnt(0)" ::: "memory");
        } else {
            XB_SPIN(xb_ld(&bar[XB_XGEN(x)]) == gen, bar);
            __builtin_amdgcn_fence(__ATOMIC_ACQUIRE, "agent");
            asm volatile("s_waitcnt vmcnt(0)" ::: "memory");
        }
    }
    __syncthreads();
}
__device__ __forceinline__ void transpose_item(const float* W, int ldw, int nvalid, int K, bf16* WT, int dst_row0, LAS float* scr, int k0, int n0, int lane) {
    const int nn = n0 + (lane & 31); const bool ok = nn < nvalid;
#pragma unroll 8
    for (int i = 0; i < 32; ++i) { const int kk = 2 * i + (lane >> 5); scr[kk * 33 + (lane & 31)] = ok ? W[(size_t)(k0 + kk) * ldw + nn] : 0.f; }
    WAVE_SYNC();
    const int c = lane & 7;
#pragma unroll
    for (int j = 0; j < 4; ++j) { const int n = (lane >> 3) + 8 * j; const LAS float* s = scr + (8 * c) * 33 + n;
        u32x4 o; o.x = pk2(s[0 * 33], s[1 * 33]); o.y = pk2(s[2 * 33], s[3 * 33]); o.z = pk2(s[4 * 33], s[5 * 33]); o.w = pk2(s[6 * 33], s[7 * 33]);
        *(u32x4*)(WT + (size_t)(dst_row0 + n) * K + k0 + 8 * c) = o; }
    WAVE_SYNC();
}
constexpr int WITEMS_EVEN = 4096 + 1552 + 512, WITEMS_ODD = 4096 + 1024 + 512 + 512;
__device__ __forceinline__ void weight_item(const Params& P, LAS float* scr, int l, int r, int lane) {
    unsigned char* ws = P.ws; const int eo = l >> 1;
    if (r < 2048) { const int q = r; transpose_item(P.in[I_WMLPIN] + (size_t)l * 1024 * 4096, 4096, 4096, 1024, (bf16*)(ws + WS_W1T) + (size_t)l * 4096 * 1024, 32 * (q & 127), scr, 64 * (q >> 7), 32 * (q & 127), lane); return; } r -= 2048;
    if (r < 2048) { const int q = r; transpose_item(P.in[I_WMLPOUT] + (size_t)l * 4096 * 1024, 1024, 1024, 4096, (bf16*)(ws + WS_W2T) + (size_t)l * 1024 * 4096, 32 * (q & 31), scr, 64 * (q >> 5), 32 * (q & 31), lane); return; } r -= 2048;
    if ((l & 1) == 0) {
        if (r < 1552) { const int kb = r / 97, nb = r % 97; transpose_item(P.in[I_WINE] + (size_t)eo * 1024 * IN_EVEN_LD, IN_EVEN_LD, IN_EVEN_LD, 1024, (bf16*)(ws + WS_WINE) + (size_t)eo * NB_E * 1024, 32 * nb, scr, 64 * kb, 32 * nb, lane); return; } r -= 1552;
        { const int q = r; transpose_item(P.in[I_WOUTE] + (size_t)eo * 1024 * 1024, 1024, 1024, 1024, (bf16*)(ws + WS_WOUTE) + (size_t)eo * 1024 * 1024, 32 * (q & 31), scr, 64 * (q >> 5), 32 * (q & 31), lane); return; }
    } else {
        if (r < 1024) { const int q = r; transpose_item(P.in[I_WINO] + (size_t)eo * 1024 * 2048, 2048, 2048, 1024, (bf16*)(ws + WS_WINO) + (size_t)eo * 2048 * 1024, 32 * (q & 63), scr, 64 * (q >> 6), 32 * (q & 63), lane); return; } r -= 1024;
        if (r < 512) { const int q = r; transpose_item(P.in[I_WOUTO] + (size_t)eo * 1024 * 1024, 1024, 1024, 1024, (bf16*)(ws + WS_WOUTO) + (size_t)eo * 1024 * 1024, 32 * (q & 31), scr, 64 * (q >> 5), 32 * (q & 31), lane); return; } r -= 512;
        { const int mat = eo * 16 + (r >> 5), q = r & 31, kb = q >> 3, nb = q & 7; const int blk = mat & 3, gate = (mat >> 2) & 1, od = mat >> 3;
          const float* src = (gate ? P.in[I_LWI] : P.in[I_LWR]) + (size_t)(od * 4 + blk) * 65536;
          const int j0 = nb * 32; const int drow = (blk * 2 + (j0 >> 7)) * 256 + gate * 128 + (j0 & 127);
          transpose_item(src, 256, 256, 256, (bf16*)(ws + WS_WG) + (size_t)od * 2048 * 256, drow, scr, 64 * kb, j0, lane); return; }
    }
}
__device__ __forceinline__ void phase_prologue(int wid0, const Params& P, LAS unsigned char* lds) {
    const int tid = tid_fresh(wid0), lane = tid & 63, wave = tid >> 6;
    LAS float* scr = (LAS float*)(lds + wave * 16384);
    const int gw = bid_fresh() * NWAVES + wave, NGW = grid_fresh() * NWAVES;
    unsigned char* ws = P.ws;
    constexpr int NTR = WITEMS_EVEN, NMOD = 4 * 24 * 16;
    for (int it = gw; it < NTR + NMOD; it += NGW) {
        int r = it;
        if (r < NTR) { weight_item(P, scr, 0, r, lane); continue; } r -= NTR;
        {
            const int l = r / 384, rem = r % 384, ec = rem >> 4, ks = rem & 15, k0 = ks * 64;
#pragma unroll
            for (int rr = 0; rr < 9; ++rr) { const float cv = rr == 0 ? P.in[I_CCTX][k0 + lane] : P.in[I_C][(rr - 1) * 1024 + k0 + lane]; scr[rr * 64 + lane] = siluf_(cv); }
            WAVE_SYNC();
            f32x4 acc[9];
#pragma unroll
            for (int rr = 0; rr < 9; ++rr) acc[rr] = (f32x4){0.f, 0.f, 0.f, 0.f};
            const float* wp = P.in[I_WADA] + ((size_t)l * 1024 + k0) * 6144 + ec * 256 + lane * 4;
#pragma unroll 4
            for (int kk = 0; kk < 64; ++kk) { const f32x4 w4 = *(const f32x4*)(wp + (size_t)kk * 6144);
#pragma unroll
                for (int rr = 0; rr < 9; ++rr) acc[rr] += w4 * scr[rr * 64 + kk]; }
            float* part = (float*)(ws + WS_BIG) + ((size_t)(ks * 4 + l) * 9) * 6144 + ec * 256 + lane * 4;
#pragma unroll
            for (int rr = 0; rr < 9; ++rr) *(f32x4*)(part + (size_t)rr * 6144) = acc[rr];
            WAVE_SYNC();
        }
    }
    { const size_t per = (size_t)(NB_E - 3104) * 1024 * 2 / 16;
      for (size_t i = (size_t)bid_fresh() * NTHR + tid; i < 2 * per; i += (size_t)grid_fresh() * NTHR) { const size_t e = i / per, q = i % per;
          *(u32x4*)(ws + WS_WINE + (e * NB_E + 3104) * 1024 * 2 + q * 16) = (u32x4){0u, 0u, 0u, 0u}; } }
}
__device__ __forceinline__ void phase_modreduce(int wid0, const Params& P) {
    const int tid = tid_fresh(wid0);
    const float* part = (const float*)(P.ws + WS_BIG); float* mod = (float*)(P.ws + WS_MOD);
    for (int i = bid_fresh() * NTHR + tid; i < 4 * 9 * 6144 / 4; i += grid_fresh() * NTHR) {
        const int l = i / (9 * 1536), e4 = i % 1536;
        f32x4 a = *(const f32x4*)(P.in[I_BADA] + (size_t)l * 6144 + e4 * 4);
#pragma unroll
        for (int ks = 0; ks < 16; ++ks) a += *(const f32x4*)(part + (size_t)ks * 4 * 9 * 6144 + (size_t)i * 4);
        *(f32x4*)(mod + (size_t)i * 4) = a; }
}
__device__ __forceinline__ void phase_rownorm(int wid0, const Params& P, int first, const bf16* obuf, const float* modg, int goff, const float* gpost, int has_next, const float* gpre, const float* mods, int soff, bf16* H) {
    const int tid = tid_fresh(wid0), lane = tid & 63, wave = tid >> 6;
    const int gw = bid_fresh() * NWAVES + wave, NGW = grid_fresh() * NWAVES;
    float* X = P.out;
    for (int m = gw; m < MT; m += NGW) {
        const int modrow = m < MCTX ? 0 : 1 + ((m - MCTX) >> 11);
        const float* mr = modg + (size_t)modrow * 6144; const float* ms = mods + (size_t)modrow * 6144;
        f32x4 x[4];
        if (first) {
            if (m < MCTX) {
#pragma unroll
                for (int j = 0; j < 4; ++j) x[j] = *(const f32x4*)(P.in[I_XP] + (size_t)m * DM + lane * 4 + 256 * j);
            } else {
                const int t = (m - MCTX) & 2047; const float prow = (float)(t >> 6), pcol = (float)(t & 63);
                f32x4 om;
#pragma unroll
                for (int e = 0; e < 4; ++e) om[e] = exp2f(-(float)(lane * 4 + e) * (13.287712379549449f / 256.0f));
#pragma unroll
                for (int j = 0; j < 4; ++j) { x[j] = *(const f32x4*)(P.in[I_XS] + (size_t)(m - MCTX) * DM + lane * 4 + 256 * j);
#pragma unroll
                    for (int e = 0; e < 4; ++e) { const float a = (j < 2 ? prow : pcol) * om[e]; x[j][e] += (j & 1) ? cosf(a) : sinf(a); } }
            }
        } else {
            u32x2 ov[4]; float ss = 0.f;
#pragma unroll
            for (int j = 0; j < 4; ++j) { x[j] = *(const f32x4*)(X + (size_t)m * DM + lane * 4 + 256 * j); ov[j] = *(const u32x2*)(obuf + (size_t)m * DM + lane * 4 + 256 * j); }
#pragma unroll
            for (int j = 0; j < 4; ++j) { const float a = bflo(ov[j].x), b = bfhi(ov[j].x), c = bflo(ov[j].y), d = bfhi(ov[j].y); ss += (a * a + b * b) + (c * c + d * d); }
            const float rs = rsqrtf(wave_sum(ss, lane) * (1.0f / DM) + EPSF);
#pragma unroll
            for (int j = 0; j < 4; ++j) { const f32x4 g4 = *(const f32x4*)(gpost + lane * 4 + 256 * j), gt = *(const f32x4*)(mr + goff + lane * 4 + 256 * j);
                f32x4 o4 = (f32x4){bflo(ov[j].x), bfhi(ov[j].x), bflo(ov[j].y), bfhi(ov[j].y)};
                x[j] += gt * (o4 * rs * g4); }
        }
#pragma unroll
        for (int j = 0; j < 4; ++j) *(f32x4*)(X + (size_t)m * DM + lane * 4 + 256 * j) = x[j];
        if (has_next) {
            float ss = 0.f;
#pragma unroll
            for (int j = 0; j < 4; ++j) ss += (x[j][0] * x[j][0] + x[j][1] * x[j][1]) + (x[j][2] * x[j][2] + x[j][3] * x[j][3]);
            const float rs = rsqrtf(wave_sum(ss, lane) * (1.0f / DM) + EPSF);
#pragma unroll
            for (int j = 0; j < 4; ++j) { const f32x4 g4 = *(const f32x4*)(gpre + lane * 4 + 256 * j), sh = *(const f32x4*)(ms + soff + lane * 4 + 256 * j), sc = *(const f32x4*)(ms + soff + 1024 + lane * 4 + 256 * j);
                const f32x4 h4 = (x[j] * rs * g4) * (sc + 1.0f) + sh;
                u32x2 w; w.x = pk2(h4[0], h4[1]); w.y = pk2(h4[2], h4[3]);
                *(u32x2*)(H + (size_t)m * DM + lane * 4 + 256 * j) = w; }
        }
    }
}

using pg8::Unit;
template <int ACT  > struct EpiBf16 {
    bf16* O; int ldc; float* AB;
    bf16* HALO;
    __device__ __forceinline__ void operator()(const f32x4 (&acc)[2][2][4][2], const Unit& u, int wr, int wc, int fr, int fq) const {
        const int row0 = u.pm * 256 + wr * 64 + fr, col0 = u.pn * 256 + wc * 32 + 8 * fq;
        if (AB && u.pn * 256 >= ldc) {
            if (wc == 0 && fq < 2) {
#pragma unroll
                for (int ai = 0; ai < 2; ++ai)
#pragma unroll
                    for (int m = 0; m < 4; ++m) { float* p = AB + (size_t)(row0 + ai * 128 + m * 16) * 16 + 8 * fq; *(f32x4*)p = acc[ai][0][m][0]; *(f32x4*)(p + 4) = acc[ai][0][m][1]; }
            }
            return;
        }
#pragma unroll
        for (int ai = 0; ai < 2; ++ai)
#pragma unroll
            for (int m = 0; m < 4; ++m) { bf16* rowp = O + (size_t)(row0 + ai * 128 + m * 16) * ldc + col0;
#pragma unroll
                for (int bj = 0; bj < 2; ++bj) { f32x4 v0 = acc[ai][bj][m][0], v1 = acc[ai][bj][m][1];
                    if (ACT == 1) {
#pragma unroll
                        for (int j = 0; j < 4; ++j) { const float a = fmaxf(v0[j], 0.f), b = fmaxf(v1[j], 0.f); v0[j] = a * a; v1[j] = b * b; } }
                    u32x4 w; w.x = pk2(v0[0], v0[1]); w.y = pk2(v0[2], v0[3]); w.z = pk2(v1[0], v1[1]); w.w = pk2(v1[2], v1[3]);
                    *(u32x4*)(rowp + bj * 128) = w;
                    if (ACT == 0 && HALO && u.pn >= 4 && u.pn < 10 && ((m == 3 && fr == 15) || (m == 0 && fr < 2))) {
                        const int r = row0 + ai * 128 + m * 16; const int which = (m == 3) ? 0 : 1 + fr;
                        *(u32x4*)(HALO + ((size_t)(r >> 6) * 3 + which) * 1536 + (col0 + bj * 128 - 1024)) = w; } } }
    }
};
struct EpiSplit {
    bf16* O0; long stride;
    __device__ __forceinline__ void operator()(const f32x4 (&acc)[2][2][4][2], const Unit& u, int wr, int wc, int fr, int fq) const {
        const int row0 = u.pm * 256 + wr * 64 + fr, col0 = (u.pn >> 1) * 256 + wc * 32 + 8 * fq; bf16* O = O0 + (long)(u.pn & 1) * stride;
#pragma unroll
        for (int ai = 0; ai < 2; ++ai)
#pragma unroll
            for (int m = 0; m < 4; ++m) { bf16* rowp = O + (size_t)(row0 + ai * 128 + m * 16) * DM + col0;
#pragma unroll
                for (int bj = 0; bj < 2; ++bj) { const f32x4 v0 = acc[ai][bj][m][0], v1 = acc[ai][bj][m][1];
                    u32x4 w; w.x = pk2(v0[0], v0[1]); w.y = pk2(v0[2], v0[3]); w.z = pk2(v1[0], v1[1]); w.w = pk2(v1[2], v1[3]);
                    *(u32x4*)(rowp + bj * 128) = w; } }
    }
};
struct EpiGates {
    unsigned* G; const bf16* X; const float* br; const float* bi; const float* lam;
    __device__ __forceinline__ void operator()(const f32x4 (&acc)[2][2][4][2], const Unit& u, int wr, int wc, int fr, int fq) const {
        const int row0 = u.pm * 256 + wr * 64 + fr, ch0 = u.pn * 128 + wc * 32 + 8 * fq;
#pragma unroll
        for (int n = 0; n < 2; ++n) {
            const f32x4 vbr = *(const f32x4*)(br + ch0 + 4 * n), vbi = *(const f32x4*)(bi + ch0 + 4 * n), l4 = *(const f32x4*)(lam + ch0 + 4 * n);
            f32x4 vsp;
#pragma unroll
            for (int e = 0; e < 4; ++e) vsp[e] = -8.0f * softplusf_(-l4[e]);
#pragma unroll
            for (int ai = 0; ai < 2; ++ai)
#pragma unroll
                for (int m = 0; m < 4; ++m) { const size_t row = (size_t)(row0 + ai * 128 + m * 16);
                    const u32x2 xv = *(const u32x2*)(X + row * DM + ch0 + 4 * n);
                    const float xs[4] = {bflo(xv.x), bfhi(xv.x), bflo(xv.y), bfhi(xv.y)};
                    u32x4 w;
#pragma unroll
                    for (int e = 0; e < 4; ++e) { const float r = sigmoidf_(acc[ai][0][m][n][e] + vbr[e]), ig = sigmoidf_(acc[ai][1][m][n][e] + vbi[e]);
                        const float la = r * vsp[e]; const float a_ = __expf(la); const float b = __builtin_amdgcn_sqrtf(fmaxf(1.0f - a_ * a_, 0.f)) * ig * xs[e];
                        w[e] = pk2(la * 1.4426950408889634f, b); }
                    *(u32x4*)(G + row * DM + ch0 + 4 * n) = w; }
        }
    }
};
constexpr int S5_WLDS = 12800, BU_P = 132, HS_P = 136;
struct S5Dir { float ar, ai; bf16x8 Bf[8]; };
__device__ __forceinline__ void s5_dir_setup(const Params& P, int e, int d, int g, int lane, float& ar, float& ai, bf16x8 (&Bf)[8], bool needB) {
    const int quad = lane >> 4, l15 = lane & 15;
    const float dt = __expf(P.in[I_LOGDT][(e * 2 + d) * 32 + g]);
    const float lr = P.in[I_LAMRE][((e * 2 + d) * 32 + g) * 64 + lane], li = P.in[I_LAMIM][((e * 2 + d) * 32 + g) * 64 + lane];
    const float mag = expf(lr * dt); ar = mag * cosf(li * dt); ai = mag * sinf(li * dt);
    const float den = lr * lr + li * li;
    const float fr = ((ar - 1.0f) * lr + ai * li) / den, fi = (ai * lr - (ar - 1.0f) * li) / den;
    if (needB) {
#pragma unroll
        for (int nt = 0; nt < 8; ++nt) { const int col = 16 * nt + l15, p = col & 63;
            const float frp = shfl_i(fr, p), fip = shfl_i(fi, p);
            bf16x8 v = (bf16x8){0, 0, 0, 0, 0, 0, 0, 0};
            if (quad < 2) { const float* bre = P.in[I_BRE] + ((size_t)(e * 32 + g) * 64 + p) * 16 + quad * 8; const float* bim = P.in[I_BIM] + ((size_t)(e * 32 + g) * 64 + p) * 16 + quad * 8;
#pragma unroll
                for (int j = 0; j < 8; ++j) { const float br = bre[j], bi = bim[j]; const float val = (nt < 4) ? (frp * br - fip * bi) : (frp * bi + fip * br); v[j] = (short)f2bf(val); } }
            Bf[nt] = v; }
    }
}
__device__ __forceinline__ void s5_c_setup(const Params& P, int e, int g, int lane, bf16x8 (&Cf)[4]) {
    const int quad = lane >> 4, l15 = lane & 15;
#pragma unroll
    for (int ks = 0; ks < 4; ++ks) { const int col0 = 32 * ks + quad * 8; const bool im = col0 >= 64;
        const float* src = (im ? P.in[I_CIM] : P.in[I_CRE]) + ((size_t)(e * 32 + g) * 16 + l15) * 64 + (col0 & 63);
        bf16x8 v;
#pragma unroll
        for (int j = 0; j < 8; ++j) v[j] = (short)f2bf(im ? -src[j] : src[j]);
        Cf[ks] = v; }
}
__device__ __forceinline__ void s5_scan_seg(const Params& P, LAS unsigned char* wl, int lane, int d, int g, int m0, float ar, float ai, const bf16x8 (&Bf)[8], const bf16x8 (&Cf)[4],
                                            float& hr, float& hi, int mode, int ymode, const bf16* proj, float* ybuf, bf16* mixout, float dsk) {
    const int quad = lane >> 4, l15 = lane & 15;
    LAS float* BU = (LAS float*)wl; LAS bf16* HS = (LAS bf16*)(wl + 8448);
    const int ch = g * 16 + l15;
    bf16x8 a_next = (bf16x8){0, 0, 0, 0, 0, 0, 0, 0};
    if (mode == 0 && quad < 2) { const int blk0 = d ? 15 : 0; const int tt = d ? 15 - l15 : l15; a_next = *(const bf16x8*)(proj + (size_t)(m0 + 16 * blk0 + tt) * NPROJ_E + g * 16 + quad * 8); }
    for (int bi_ = 0; bi_ < 16; ++bi_) {
        const int blk = d ? 15 - bi_ : bi_;
        const int mb = m0 + 16 * blk;
        const bf16x8 a = a_next;
        if (mode == 0 && quad < 2 && bi_ + 1 < 16) { const int blkn = d ? 14 - bi_ : bi_ + 1; const int tt = d ? 15 - l15 : l15; a_next = *(const bf16x8*)(proj + (size_t)(m0 + 16 * blkn + tt) * NPROJ_E + g * 16 + quad * 8); }
        float pre[4], zz[4];
#pragma unroll
        for (int jj = 0; jj < 4; ++jj) { const int row = quad * 4 + jj; const int tt = d ? 15 - row : row; const size_t m = (size_t)(mb + tt);
            pre[jj] = (ymode == 0) ? dsk * bf2f(proj[m * NPROJ_E + ch]) : ybuf[m * 512 + ch];
            zz[jj] = (ymode == 2) ? bf2f(proj[m * NPROJ_E + 512 + ch]) : 0.f; }
        if (mode == 0) {
#pragma unroll
            for (int nt = 0; nt < 8; ++nt) { f32x4 acc = mfma16(a, Bf[nt], (f32x4){0.f, 0.f, 0.f, 0.f});
#pragma unroll
                for (int jj = 0; jj < 4; ++jj) BU[(quad * 4 + jj) * BU_P + 16 * nt + l15] = acc[jj]; }
            WAVE_SYNC();
        }
#pragma unroll
        for (int r = 0; r < 16; ++r) {
            float br = 0.f, bim = 0.f;
            if (mode == 0) { br = BU[r * BU_P + lane]; bim = BU[r * BU_P + 64 + lane]; }
            const float nr = ar * hr - ai * hi + br, ni = ar * hi + ai * hr + bim; hr = nr; hi = ni;
            HS[r * HS_P + lane] = (bf16)f2bf(hr); HS[r * HS_P + 64 + lane] = (bf16)f2bf(hi);
        }
        WAVE_SYNC();
        f32x4 y = (f32x4){0.f, 0.f, 0.f, 0.f};
#pragma unroll
        for (int ks = 0; ks < 4; ++ks) { const bf16x8 af = *(const LAS bf16x8*)(HS + l15 * HS_P + 32 * ks + quad * 8); y = mfma16(af, Cf[ks], y); }
#pragma unroll
        for (int jj = 0; jj < 4; ++jj) { const int row = quad * 4 + jj; const int tt = d ? 15 - row : row; const size_t m = (size_t)(mb + tt);
            const float v = y[jj] + pre[jj];
            if (ymode != 2) ybuf[m * 512 + ch] = v;
            else mixout[m * DM + ch] = (bf16)f2bf(geluf_(v) * sigmoidf_(zz[jj]));
        }
        WAVE_SYNC();
    }
}
__device__ __forceinline__ void s5_task_main(const Params& P, LAS unsigned char* wl, int lane, int e, int sub, int g) {
    const bf16* proj = (const bf16*)(P.ws + WS_BIG); float* ybuf = (float*)(P.ws + WS_YBUF); bf16* mixout = (bf16*)(P.ws + WS_MIX);
    const bool lat = sub >= 32; const int q = sub - 32, b = lat ? (q >> 3) : sub, seg = lat ? (q & 7) : 0;
    const int m0 = lat ? MCTX + b * LLAT + seg * 256 : sub * 256;
    bf16x8 Cf[4]; s5_c_setup(P, e, g, lane, Cf);
    const float dsk = P.in[I_S5D][e * 512 + g * 16 + (lane & 15)];
#pragma unroll 1
    for (int d = 0; d < 2; ++d) {
        float ar, ai; bf16x8 Bf[8]; s5_dir_setup(P, e, d, g, lane, ar, ai, Bf, true);
        float hr = 0.f, hi = 0.f;
        if (lat && ((d == 0 && seg == 0) || (d == 1 && seg == 7))) { const size_t si = ((((size_t)b * 2 + e) * 2 + d) * 32 + g) * 64 + lane; hr = P.in[I_S5RE][si]; hi = P.in[I_S5IM][si]; }
        const int ymode = d == 0 ? 0 : (lat ? 1 : 2);
        s5_scan_seg(P, wl, lane, d, g, m0, ar, ai, Bf, Cf, hr, hi, 0, ymode, proj, ybuf, mixout, dsk);
        if (!lat) { const size_t si = ((((size_t)b * 2 + e) * 2 + d) * 32 + g) * 64 + lane; P.out[OUT_S5RE + si] = hr; P.out[OUT_S5IM + si] = hi; }
        else { float* F = (float*)(P.ws + WS_S5F) + ((((size_t)d * 64 + q) * 32 + g) * 64 + lane) * 2; F[0] = hr; F[1] = hi; }
    }
}
__device__ __forceinline__ void s5_task_corr(const Params& P, LAS unsigned char* wl, int lane, int e, int q, int g) {
    const bf16* proj = (const bf16*)(P.ws + WS_BIG); float* ybuf = (float*)(P.ws + WS_YBUF); bf16* mixout = (bf16*)(P.ws + WS_MIX);
    const int b = q >> 3, seg = q & 7, m0 = MCTX + b * LLAT + seg * 256;
    bf16x8 Cf[4]; s5_c_setup(P, e, g, lane, Cf);
    bf16x8 Bf[8];
#pragma unroll
    for (int i = 0; i < 8; ++i) Bf[i] = (bf16x8){0, 0, 0, 0, 0, 0, 0, 0};
    const float* Fb = (const float*)(P.ws + WS_S5F);
#pragma unroll 1
    for (int d = 0; d < 2; ++d) {
        float ar, ai; s5_dir_setup(P, e, d, g, lane, ar, ai, Bf, false);
        float pr = ar, pi = ai;
#pragma unroll
        for (int i = 0; i < 8; ++i) { const float nr = pr * pr - pi * pi, ni = 2.0f * pr * pi; pr = nr; pi = ni; }
        float hr = 0.f, hi = 0.f;
        const int cnt = d == 0 ? seg : 7 - seg;
        for (int i = 0; i < cnt; ++i) { const int sj = d == 0 ? i : 7 - i; const float* F = Fb + ((((size_t)d * 64 + b * 8 + sj) * 32 + g) * 64 + lane) * 2;
            const float nr = pr * hr - pi * hi + F[0], ni = pr * hi + pi * hr + F[1]; hr = nr; hi = ni; }
        const int ym = (d == 1 || seg == 7) ? 2 : 1;
        if (cnt > 0) s5_scan_seg(P, wl, lane, d, g, m0, ar, ai, Bf, Cf, hr, hi, 1, ym, proj, ybuf, mixout, 0.f);
    }
}

#ifndef REP_A
#define REP_A 1
#endif
#ifndef REP_B
#define REP_B 1
#endif
#ifndef REP_C
#define REP_C 1
#endif
__device__ __forceinline__ void phase_conv_even(int wid0, const Params& P, int e) {
    const int tid = tid_fresh(wid0), lane = tid & 63, wave = tid >> 6;
    const int gw = bid_fresh() * NWAVES + wave, NGW = grid_fresh() * NWAVES;
    bf16* proj = (bf16*)(P.ws + WS_BIG); const bf16* HALO = (const bf16*)(P.ws + WS_HALO);
    for (int it = gw; it < 384 * 24; it += NGW) {
        const int c = it / 24, cgp = it % 24, ccol = cgp * 64 + lane;
        const int r0 = c * 64;
        const bool lat = r0 >= MCTX; const int t0 = lat ? ((r0 - MCTX) & 2047) : (r0 & 255); const int L = lat ? LLAT : LCTX;
        bf16* base = proj + (size_t)r0 * NPROJ_E + 1024 + ccol;
        bf16 x[67];
#pragma unroll
        for (int i = 0; i < 64; ++i) x[i + 1] = base[(size_t)i * NPROJ_E];
        x[0] = (t0 > 0) ? HALO[((size_t)(c - 1) * 3 + 0) * 1536 + ccol] : (bf16)0;
        x[65] = (t0 + 64 < L) ? HALO[((size_t)(c + 1) * 3 + 1) * 1536 + ccol] : (bf16)0;
        x[66] = (t0 + 64 < L) ? HALO[((size_t)(c + 1) * 3 + 2) * 1536 + ccol] : (bf16)0;
        const float* cw = P.in[I_GCONVW] + (size_t)e * 4 * 1536 + ccol; const float w0 = cw[0], w1 = cw[1536], w2 = cw[3072], w3 = cw[4608], cb = P.in[I_GCONVB][e * 1536 + ccol];
#pragma unroll
        for (int i = 0; i < 64; ++i) { const float v = cb + w0 * bf2f(x[i]) + w1 * bf2f(x[i + 1]) + w2 * bf2f(x[i + 2]) + w3 * bf2f(x[i + 3]);
            base[(size_t)i * NPROJ_E] = (bf16)f2bf(siluf_(v)); }
    }
}
#define LDS_BARRIER() do { asm volatile("s_waitcnt lgkmcnt(0)" ::: "memory"); __builtin_amdgcn_s_barrier(); asm volatile("" ::: "memory"); } while (0)
constexpr int G_Q = 0, G_K = 17408, G_V = 34816, G_KT = 52224, G_LM = 70656, G_QK = 89088, G_ST = 98304, G_SM = 133120;
constexpr int P128 = 136, P64 = 72, LMP = 68;
__device__ __forceinline__ bf16x8 ld_split8(const LAS bf16* p) {
    const u32x2 a = *(const LAS u32x2*)p, b = *(const LAS u32x2*)(p + 16);
    return __builtin_bit_cast(bf16x8, (u32x4){a.x, a.y, b.x, b.y});
}
__device__ __forceinline__ bf16x8 pack_acc2(const f32x4& a, const f32x4& b) { return __builtin_bit_cast(bf16x8, (u32x4){pk2(a[0], a[1]), pk2(a[2], a[3]), pk2(b[0], b[1]), pk2(b[2], b[3])}); }
__device__ __forceinline__ void gdn_chain(int wid0, const Params& P, LAS unsigned char* lds, int e, int s, int hd, int dir) {
    const int tid = tid_fresh(wid0), lane = tid & 63, w = __builtin_amdgcn_readfirstlane(tid >> 6), quad = lane >> 4, l15 = lane & 15;
    const bool lat = s >= 32; const int b = lat ? s - 32 : s; const int L = lat ? LLAT : LCTX; const int m0 = lat ? MCTX + b * LLAT : s * LCTX;
    const bf16* proj = (const bf16*)(P.ws + WS_BIG); const float* AB = (const float*)(P.ws + WS_AB);
    bf16* Odir = (bf16*)(P.ws + WS_H) + (size_t)dir * MT * 512;
    int zv; asm volatile("v_mov_b32 %0, 0" : "=v"(zv));
    lds += zv;
    LAS bf16* Qs = (LAS bf16*)(lds + G_Q); LAS bf16* Ks = (LAS bf16*)(lds + G_K); LAS bf16* Vs = (LAS bf16*)(lds + G_V); LAS bf16* KT = (LAS bf16*)(lds + G_KT);
    LAS float* Lm = (LAS float*)(lds + G_LM); LAS bf16* VNT = (LAS bf16*)(lds + G_LM); LAS bf16* QKs = (LAS bf16*)(lds + G_QK); LAS bf16* ST = (LAS bf16*)(lds + G_ST);
    LAS bf16* TM = (LAS bf16*)(lds + G_ST); LAS bf16* TT = TM + 64 * P64; LAS bf16* LR = TT + 64 * P64;
    LAS float* rq = (LAS float*)(lds + G_SM); LAS float* rk = rq + 64; LAS float* gcs = rq + 128; LAS float* betas = rq + 192; LAS float* egs = rq + 256; LAS float* kes = rq + 320;
    f32x4 Sacc[8];
    const size_t sbase = ((((size_t)b * 2 + e) * 2 + dir) * 4 + hd) * 16384;
#pragma unroll
    for (int mt = 0; mt < 8; ++mt) Sacc[mt] = (f32x4){0.f, 0.f, 0.f, 0.f};
    if (lat) { const float* sp = P.in[I_SDELTA] + sbase + (size_t)(quad * 4) * 128 + 16 * w + l15;
#pragma unroll
        for (int mt = 0; mt < 8; ++mt)
#pragma unroll
            for (int jj = 0; jj < 4; ++jj) Sacc[mt][jj] = sp[(16 * mt + jj) * 128]; }
    for (int i = tid; i < 2 * 64 * P64 / 2; i += NTHR) ((LAS unsigned*)TM)[i] = 0u;
    const float alog_e = __expf(P.in[I_GALOG][(e * 2 + dir) * 4 + hd]), dtb = P.in[I_GDTB][(e * 2 + dir) * 4 + hd];
    const int nchunk = L / 64;
    u32x4 xr[6]; float ab_a = 0.f, ab_b = 0.f;
#define GDN_LOAD(ci_) do { const int tid_ = tid_fresh(wid0); const int c0_ = dir ? L - 64 * ((ci_) + 1) : 64 * (ci_); \
        _Pragma("unroll") for (int k = 0; k < 6; ++k) { const int p_ = tid_ + 512 * k, part_ = p_ >> 10, row_ = (p_ & 1023) >> 4, pc_ = p_ & 15; \
            xr[k] = *(const u32x4*)(proj + (size_t)(m0 + c0_ + row_) * NPROJ_E + 1024 + part_ * 512 + hd * 128 + pc_ * 8); } \
        if (w == 0) { const int ln_ = tid_ & 63; const size_t m_ = (size_t)(m0 + c0_ + (dir ? 63 - ln_ : ln_)); ab_a = AB[m_ * 16 + dir * 4 + hd]; ab_b = AB[m_ * 16 + 8 + dir * 4 + hd]; } } while (0)
    GDN_LOAD(0);
#pragma unroll 1
    for (int ci = 0; ci < nchunk; ++ci) {
        const int tid = tid_fresh(wid0), lane = tid & 63, quad = lane >> 4, l15 = lane & 15;
        const int c0 = dir ? L - 64 * (ci + 1) : 64 * ci;
        LDS_BARRIER();
#ifndef NO_A
        const float cur_a = ab_a, cur_b = ab_b;
#pragma unroll
        for (int k = 0; k < 6; ++k) { const int p_ = tid + 512 * k, part_ = p_ >> 10, row_ = (p_ & 1023) >> 4, pc_ = p_ & 15;
            LAS bf16* dst = part_ == 0 ? Qs : (part_ == 1 ? Ks : Vs);
            *(LAS u32x4*)(dst + (dir ? 63 - row_ : row_) * P128 + pc_ * 8) = xr[k]; }
        if (ci + 1 < nchunk) GDN_LOAD(ci + 1);
#endif
        LDS_BARRIER();
#pragma unroll 1
        for (int repB = 0; repB < REP_B; ++repB)
        { const int rowid = tid >> 2, part = tid & 3; LAS bf16* src = (rowid < 64 ? Qs : Ks) + (rowid & 63) * P128 + part * 32;
          float ss = 0.f;
#pragma unroll
          for (int i = 0; i < 4; ++i) { const u32x4 v = *(const LAS u32x4*)(src + 8 * i);
#pragma unroll
              for (int j = 0; j < 4; ++j) { const float a = bflo(v[j]), c = bfhi(v[j]); ss += a * a + c * c; } }
          ss += shfl_i(ss, lane ^ 1); ss += shfl_i(ss, lane ^ 2);
          if (part == 0) { if (rowid < 64) rq[rowid] = rsqrtf(ss + EPSF) * 0.08838834764831845f; else rk[rowid - 64] = rsqrtf(ss + EPSF); }
          if (w == 0) { const int t = c0 + (dir ? 63 - lane : lane); const size_t m = (size_t)(m0 + t);
              const float araw = cur_a, braw = cur_b;
              const float gg = -alog_e * softplusf_(araw + dtb);
              float gc = gg;
#pragma unroll
              for (int o = 1; o < 64; o <<= 1) { const float t2 = shfl_i(gc, (lane - o) & 63); if (lane >= o) gc += t2; }
              const float glast = shfl_i(gc, 63);
              gcs[lane] = gc; betas[lane] = sigmoidf_(braw); egs[lane] = __expf(gc); kes[lane] = __expf(glast - gc);
              if (lane == 0) rq[384] = __expf(glast); } }
        LDS_BARRIER();
#ifndef NO_C
#pragma unroll 1
        for (int repC = 0; repC < REP_C; ++repC)
        { const int mt = w & 3; const bool isq = w >= 4; LAS bf16* src = isq ? Qs : Ks;
          bf16x8 a[4];
#pragma unroll
          for (int ks = 0; ks < 4; ++ks) a[ks] = *(const LAS bf16x8*)(src + (16 * mt + l15) * P128 + 32 * ks + quad * 8);
#pragma unroll 1
          for (int nt = 0; nt < 4; ++nt) { f32x4 acc = (f32x4){0.f, 0.f, 0.f, 0.f};
#pragma unroll
              for (int ks = 0; ks < 4; ++ks) { const bf16x8 bb = *(const LAS bf16x8*)(Ks + (16 * nt + l15) * P128 + 32 * ks + quad * 8); acc = mfma16(a[ks], bb, acc); }
              const int j = 16 * nt + l15; const float rkj = rk[j], gcj = gcs[j];
              f32x4 lv;
#pragma unroll
              for (int jj = 0; jj < 4; ++jj) { const int i = 16 * mt + quad * 4 + jj; const float dec = __expf(fminf(gcs[i] - gcj, 0.f));
                  lv[jj] = (i > j) ? acc[jj] * rk[i] * rkj * betas[i] * dec : 0.f;
                  if (isq) QKs[i * P64 + j] = (bf16)f2bf((i >= j) ? acc[jj] * rq[i] * rkj * dec : 0.f); }
              if (!isq) { *(LAS f32x4*)(Lm + j * LMP + 16 * mt + quad * 4) = lv;
#pragma unroll
                  for (int jj = 0; jj < 4; ++jj) LR[(16 * mt + quad * 4 + jj) * P64 + j] = (bf16)f2bf(nt < mt ? lv[jj] : 0.f); } }
          const int dd = tid & 127, tq = tid >> 7;
          unsigned pw[8];
#pragma unroll
          for (int n = 0; n < 16; n += 2) { const int i0 = tq * 16 + n; const float v0 = bf2f(Ks[i0 * P128 + dd]) * rk[i0] * kes[i0], v1 = bf2f(Ks[(i0 + 1) * P128 + dd]) * rk[i0 + 1] * kes[i0 + 1]; pw[n >> 1] = pk2(v0, v1); }
          *(LAS u32x4*)(KT + dd * P64 + tq * 16) = (u32x4){pw[0], pw[1], pw[2], pw[3]};
          *(LAS u32x4*)(KT + dd * P64 + tq * 16 + 8) = (u32x4){pw[4], pw[5], pw[6], pw[7]}; }
#endif
        LDS_BARRIER();
        { const int i = tid >> 3, c0k = (tid & 7) * 16; const float sc = rk[i] * betas[i] * egs[i];
#pragma unroll
          for (int h2 = 0; h2 < 2; ++h2) { u32x4 v = *(LAS u32x4*)(Ks + i * P128 + c0k + 8 * h2);
#pragma unroll
              for (int q = 0; q < 4; ++q) v[q] = pk2(bflo(v[q]) * sc, bfhi(v[q]) * sc);
              *(LAS u32x4*)(Ks + i * P128 + c0k + 8 * h2) = v; } }
        if (w == 0) { const int bb = lane >> 4, c = lane & 15;
            float x[16];
#pragma unroll
            for (int r = 0; r < 16; ++r) x[r] = (r == c) ? 1.f : 0.f;
#pragma unroll
            for (int j = 0; j < 15; ++j) {
#pragma unroll
                for (int q4 = j / 4; q4 < 4; ++q4) { const f32x4 l4 = *(const LAS f32x4*)(Lm + (16 * bb + j) * LMP + 16 * bb + 4 * q4);
#pragma unroll
                    for (int jx = 0; jx < 4; ++jx) if (4 * q4 + jx > j) x[4 * q4 + jx] -= l4[jx] * x[j]; } }
            unsigned pw[8];
#pragma unroll
            for (int r = 0; r < 16; r += 2) { pw[r >> 1] = pk2(x[r], x[r + 1]); TM[(16 * bb + r) * P64 + 16 * bb + c] = (bf16)(pw[r >> 1] & 0xffffu); TM[(16 * bb + r + 1) * P64 + 16 * bb + c] = (bf16)(pw[r >> 1] >> 16); }
            *(LAS u32x4*)(TT + (16 * bb + c) * P64 + 16 * bb) = (u32x4){pw[0], pw[1], pw[2], pw[3]};
            *(LAS u32x4*)(TT + (16 * bb + c) * P64 + 16 * bb + 8) = (u32x4){pw[4], pw[5], pw[6], pw[7]}; }
        LDS_BARRIER();
#pragma unroll 1
        for (int lev = 1; lev < 4; ++lev) {
            if (w < 4 - lev) { const int bj = w, bi = w + lev;
                f32x4 m = (f32x4){0.f, 0.f, 0.f, 0.f};
#pragma unroll
                for (int ks = 0; ks < 2; ++ks) { const bf16x8 a = *(const LAS bf16x8*)(LR + (16 * bi + l15) * P64 + 32 * ks + quad * 8), bq = *(const LAS bf16x8*)(TT + (16 * bj + l15) * P64 + 32 * ks + quad * 8); m = mfma16(a, bq, m); }
                const u32x2 tl = *(const LAS u32x2*)(TM + (16 * bi + l15) * P64 + 16 * bi + quad * 4);
                const bf16x8 a2 = __builtin_bit_cast(bf16x8, (u32x4){tl.x, tl.y, 0u, 0u}), b2 = __builtin_bit_cast(bf16x8, (u32x4){pk2(m[0], m[1]), pk2(m[2], m[3]), 0u, 0u});
                const f32x4 t = mfma16(a2, b2, (f32x4){0.f, 0.f, 0.f, 0.f});
                const unsigned p0 = pk2(-t[0], -t[1]), p1 = pk2(-t[2], -t[3]);
                TM[(16 * bi + quad * 4 + 0) * P64 + 16 * bj + l15] = (bf16)(p0 & 0xffffu); TM[(16 * bi + quad * 4 + 1) * P64 + 16 * bj + l15] = (bf16)(p0 >> 16);
                TM[(16 * bi + quad * 4 + 2) * P64 + 16 * bj + l15] = (bf16)(p1 & 0xffffu); TM[(16 * bi + quad * 4 + 3) * P64 + 16 * bj + l15] = (bf16)(p1 >> 16);
                *(LAS u32x2*)(TT + (16 * bj + l15) * P64 + 16 * bi + quad * 4) = (u32x2){p0, p1}; }
            LDS_BARRIER();
        }
#ifndef NO_EFG
        bf16x8 Bst[4];
#pragma unroll
        for (int ks = 0; ks < 4; ++ks) Bst[ks] = pack_acc2(Sacc[2 * ks], Sacc[2 * ks + 1]);
        f32x4 vn[4];
#pragma unroll
        for (int mt = 0; mt < 4; ++mt) { f32x4 acc = (f32x4){0.f, 0.f, 0.f, 0.f};
#pragma unroll
            for (int ks = 0; ks < 4; ++ks) { const bf16x8 a = ld_split8(Ks + (16 * mt + l15) * P128 + 32 * ks + quad * 4); acc = mfma16(a, Bst[ks], acc); }
#pragma unroll
            for (int jj = 0; jj < 4; ++jj) { const int i = 16 * mt + quad * 4 + jj; vn[mt][jj] = bf2f(Vs[i * P128 + 16 * w + l15]) * betas[i] - acc[jj]; } }
        bf16x8 Bvn[2];
#pragma unroll
        for (int k2 = 0; k2 < 2; ++k2) Bvn[k2] = pack_acc2(vn[2 * k2], vn[2 * k2 + 1]);
#pragma unroll
        for (int mt = 0; mt < 4; ++mt) { f32x4 acc = (f32x4){0.f, 0.f, 0.f, 0.f};
#pragma unroll
            for (int k2 = 0; k2 < 2; ++k2) { const bf16x8 a = ld_split8(TM + (16 * mt + l15) * P64 + 32 * k2 + quad * 4); acc = mfma16(a, Bvn[k2], acc); }
            vn[mt] = acc; }
#pragma unroll
        for (int k2 = 0; k2 < 2; ++k2) Bvn[k2] = pack_acc2(vn[2 * k2], vn[2 * k2 + 1]);
#pragma unroll 1
        for (int mt = 0; mt < 4; ++mt) { f32x4 acc = (f32x4){0.f, 0.f, 0.f, 0.f};
#pragma unroll
            for (int ks = 0; ks < 4; ++ks) { const bf16x8 a = ld_split8(Qs + (16 * mt + l15) * P128 + 32 * ks + quad * 4); acc = mfma16(a, Bst[ks], acc); }
#pragma unroll
            for (int jj = 0; jj < 4; ++jj) { const int i = 16 * mt + quad * 4 + jj; acc[jj] *= rq[i] * egs[i]; }
#pragma unroll
            for (int k2 = 0; k2 < 2; ++k2) { const bf16x8 a = ld_split8(QKs + (16 * mt + l15) * P64 + 32 * k2 + quad * 4); acc = mfma16(a, Bvn[k2], acc); }
#pragma unroll
            for (int jj = 0; jj < 4; ++jj) { const int i = 16 * mt + quad * 4 + jj; const int t = c0 + (dir ? 63 - i : i);
                Odir[(size_t)(m0 + t) * 512 + hd * 128 + 16 * w + l15] = (bf16)f2bf(acc[jj]); } }
        const float egl = rq[384];
#pragma unroll
        for (int mt = 0; mt < 8; ++mt) { f32x4 acc = Sacc[mt] * egl;
#pragma unroll
            for (int k2 = 0; k2 < 2; ++k2) { const bf16x8 a = ld_split8(KT + (16 * mt + l15) * P64 + 32 * k2 + quad * 4); acc = mfma16(a, Bvn[k2], acc); }
            Sacc[mt] = acc; }
#endif
        WAVE_SYNC();
    }
    if (!lat) { const int tid2 = tid_fresh(wid0), lane2 = tid2 & 63; float* dp = P.out + OUT_DELTA + sbase + (size_t)((lane2 >> 4) * 4) * 128 + 16 * w + (lane2 & 15);
#pragma unroll
        for (int mt = 0; mt < 8; ++mt)
#pragma unroll
            for (int jj = 0; jj < 4; ++jj) dp[(16 * mt + jj) * 128] = Sacc[mt][jj];
    }
    __syncthreads();
}

__device__ __forceinline__ void phase_mix_even(int wid0, const Params& P, LAS unsigned char* lds, int e, int mode = 3) {
    const int bid = bid_fresh(), G = grid_fresh();
    if (G == 256) {
        if (bid < 64) { const int s = 32 + (bid >> 3), hd = (bid >> 1) & 3, dir = bid & 1; if (mode & 1) gdn_chain(wid0, P, lds, e, s, hd, dir); }
        else { const int bb = bid - 64;
            if (mode & 1) for (int c = bb; c < 256; c += 192) { const int s = c >> 3, hd = (c >> 1) & 3, dir = c & 1; gdn_chain(wid0, P, lds, e, s, hd, dir); }
            if (mode & 2) { const int tid = tid_fresh(wid0), lane = tid & 63, wave = tid >> 6;
                for (int t = bb; t < 384; t += 192) { const int wt = t * 8 + wave; s5_task_main(P, lds + wave * S5_WLDS, lane, e, wt >> 5, wt & 31); } }
            if (mode == 3) { __syncthreads(); const int tid = tid_fresh(wid0), lane = tid & 63, wave = tid >> 6;
                for (int it = bb * NWAVES + wave; it < WITEMS_ODD; it += 192 * NWAVES) weight_item(P, (LAS float*)(lds + wave * 16384), 2 * e + 1, it, lane); } }
    } else {
        for (int c = bid; c < 320; c += G) { const int s = c < 64 ? 32 + (c >> 3) : ((c - 64) >> 3), hd = (c >> 1) & 3, dir = c & 1; gdn_chain(wid0, P, lds, e, s, hd, dir); }
        const int tid = tid_fresh(wid0), lane = tid & 63, wave = tid >> 6;
        for (int t = bid; t < 384; t += G) { const int wt = t * 8 + wave; s5_task_main(P, lds + wave * S5_WLDS, lane, e, wt >> 5, wt & 31); }
        __syncthreads();
        for (int it = bid * NWAVES + wave; it < WITEMS_ODD; it += G * NWAVES) weight_item(P, (LAS float*)(lds + wave * 16384), 2 * e + 1, it, lane);
    }
}
__device__ __forceinline__ void phase_fin_even(int wid0, const Params& P, LAS unsigned char* lds, int e) {
    const int tid = tid_fresh(wid0), lane = tid & 63, wave = tid >> 6;
    const int gw = bid_fresh() * NWAVES + wave, NGW = grid_fresh() * NWAVES;
    for (int wt = gw; wt < 2048; wt += NGW) s5_task_corr(P, lds + wave * S5_WLDS, lane, e, wt >> 5, wt & 31);
    const bf16* proj = (const bf16*)(P.ws + WS_BIG); const bf16* Of = (const bf16*)(P.ws + WS_H); const bf16* Ob = Of + (size_t)MT * 512; bf16* mixout = (bf16*)(P.ws + WS_MIX);
    for (int mb2 = gw; mb2 < MT; mb2 += 2 * NGW) {
        u32x4 a[2], bq[2], z[2];
#pragma unroll
        for (int u = 0; u < 2; ++u) { const int m = mb2 + u * NGW; if (m < MT) { a[u] = *(const u32x4*)(Of + (size_t)m * 512 + lane * 8); bq[u] = *(const u32x4*)(Ob + (size_t)m * 512 + lane * 8); z[u] = *(const u32x4*)(proj + (size_t)m * NPROJ_E + 2560 + lane * 8); } }
#pragma unroll
        for (int u = 0; u < 2; ++u) { const int m = mb2 + u * NGW; if (m < MT) {
            float o[8]; float ss = 0.f;
#pragma unroll
            for (int j = 0; j < 4; ++j) { o[2 * j] = bflo(a[u][j]) + bflo(bq[u][j]); o[2 * j + 1] = bfhi(a[u][j]) + bfhi(bq[u][j]); ss += o[2 * j] * o[2 * j] + o[2 * j + 1] * o[2 * j + 1]; }
            ss += shfl_i(ss, lane ^ 1); ss += shfl_i(ss, lane ^ 2); ss += shfl_i(ss, lane ^ 4); ss += shfl_i(ss, lane ^ 8);
            const float rs = rsqrtf(ss * (1.0f / 128.0f) + EPSF);
            const float* gn = P.in[I_GONORM] + e * 128 + (lane & 15) * 8;
            unsigned pw[4];
#pragma unroll
            for (int j = 0; j < 4; ++j) { const float z0 = bflo(z[u][j]), z1 = bfhi(z[u][j]); pw[j] = pk2(o[2 * j] * rs * gn[2 * j] * siluf_(z0), o[2 * j + 1] * rs * gn[2 * j + 1] * siluf_(z1)); }
            *(u32x4*)(mixout + (size_t)m * DM + 512 + lane * 8) = (u32x4){pw[0], pw[1], pw[2], pw[3]}; } }
    }
}

__device__ __forceinline__ void phase_conv_odd(int wid0, const Params& P, int o) {
    const int tid = tid_fresh(wid0), lane = tid & 63, wave = tid >> 6;
    const int gw = bid_fresh() * NWAVES + wave, NGW = grid_fresh() * NWAVES;
    const bf16* proj = (const bf16*)(P.ws + WS_BIG); bf16* cx = (bf16*)(P.ws + WS_H);
    const float* cw = P.in[I_LCONVW] + (size_t)o * 4 * 1024; const float* cb = P.in[I_LCONVB] + o * 1024;
    for (int m = gw; m < MT; m += NGW) {
        const int t = m < MCTX ? (m & 255) : ((m - MCTX) & 2047); const int L = m < MCTX ? LCTX : LLAT;
#pragma unroll
        for (int h2 = 0; h2 < 2; ++h2) { const int ch = lane * 8 + 512 * h2;
            float acc[8];
#pragma unroll
            for (int j = 0; j < 8; ++j) acc[j] = cb[ch + j];
#pragma unroll
            for (int k = 0; k < 4; ++k) { const int tt = t - 1 + k; if (tt >= 0 && tt < L) { const u32x4 v = *(const u32x4*)(proj + (size_t)(m - 1 + k) * 2048 + ch);
#pragma unroll
                    for (int j = 0; j < 4; ++j) { acc[2 * j] += cw[k * 1024 + ch + 2 * j] * bflo(v[j]); acc[2 * j + 1] += cw[k * 1024 + ch + 2 * j + 1] * bfhi(v[j]); } } }
            *(u32x4*)(cx + (size_t)m * DM + ch) = (u32x4){pk2(acc[0], acc[1]), pk2(acc[2], acc[3]), pk2(acc[4], acc[5]), pk2(acc[6], acc[7])}; }
    }
}
__device__ __forceinline__ void phase_lru_scan(int wid0, const Params& P, LAS unsigned char* lds, int o, int d) {
    const int tid = tid_fresh(wid0), lane = tid & 63, wave = tid >> 6;
    const int gw = bid_fresh() * NWAVES + wave, NGW = grid_fresh() * NWAVES;
    const unsigned* G = (const unsigned*)(P.ws + WS_GATES); const bf16* proj = (const bf16*)(P.ws + WS_BIG); bf16* mixout = (bf16*)(P.ws + WS_MIX);
    const int Gn = NGW / NWAVES, vw = wave * Gn + (gw / NWAVES);
    if (d == 0 && o == 0 && NGW > 640) {
        for (int it = vw - 640; it >= 0 && it < WITEMS_EVEN; it += NGW - 640) weight_item(P, (LAS float*)(lds + wave * 16384), 2, it, lane); }
    for (int task = vw; task < 640; task += NGW) {
        int s, cg_;
        if (task < 128) { s = 32 + (task >> 4); cg_ = task & 15; } else { s = (task - 128) >> 4; cg_ = (task - 128) & 15; }
        const bool lat = s >= 32; const int b = lat ? s - 32 : s; const int L = lat ? LLAT : LCTX; const int m0 = lat ? MCTX + b * LLAT : s * LCTX;
        const int ch = cg_ * 64 + lane;
        float h = lat ? P.in[I_SLRU][(((size_t)b * 2 + o) * 2 + d) * 1024 + ch] : 0.f;
        if (d == 0) {
            unsigned ga[32], gb[32];
#define LRU_LD0(dst, tt) _Pragma("unroll") for (int i = 0; i < 32; ++i) dst[i] = G[(size_t)(m0 + (tt) + i) * DM + ch]
#define LRU_CP0(src, tt) _Pragma("unroll") for (int i = 0; i < 32; ++i) { h = __builtin_amdgcn_exp2f(bflo(src[i])) * h + bfhi(src[i]); mixout[(size_t)(m0 + (tt) + i) * DM + ch] = (bf16)f2bf(h); }
            LRU_LD0(ga, 0);
            for (int t0 = 0; t0 < L; t0 += 64) {
                LRU_LD0(gb, t0 + 32);
                LRU_CP0(ga, t0);
                if (t0 + 64 < L) { LRU_LD0(ga, t0 + 64); }
                LRU_CP0(gb, t0 + 32);
            }
        } else {
            unsigned ga[16], gb[16]; bf16 pa[16], pb[16], ya[16], yb[16];
#define LRU_LD1(g_, p_, y_, tt) _Pragma("unroll") for (int i = 0; i < 16; ++i) { const size_t m = (size_t)(m0 + L - 1 - ((tt) + i)); g_[i] = G[m * DM + ch]; p_[i] = mixout[m * DM + ch]; y_[i] = proj[m * 2048 + 1024 + ch]; }
#define LRU_CP1(g_, p_, y_, tt) _Pragma("unroll") for (int i = 0; i < 16; ++i) { const size_t m = (size_t)(m0 + L - 1 - ((tt) + i)); \
                h = __builtin_amdgcn_exp2f(bflo(g_[i])) * h + bfhi(g_[i]); mixout[m * DM + ch] = (bf16)f2bf((bf2f(p_[i]) + h) * geluf_(bf2f(y_[i]))); }
            LRU_LD1(ga, pa, ya, 0);
            for (int t0 = 0; t0 < L; t0 += 32) {
                LRU_LD1(gb, pb, yb, t0 + 16);
                LRU_CP1(ga, pa, ya, t0);
                if (t0 + 32 < L) { LRU_LD1(ga, pa, ya, t0 + 32); }
                LRU_CP1(gb, pb, yb, t0 + 16);
            }
        }
        if (!lat) P.out[OUT_LRU + (((size_t)b * 2 + o) * 2 + d) * 1024 + ch] = h;
    }
}
#ifdef PROBE_DUP_GEMM
#define DUPG(x) GSYNC(); x
#else
#define DUPG(x)
#endif
typedef const __attribute__((address_space(4))) Params* KParams;
__device__ __forceinline__ Params load_params(KParams q) { Params r;
#pragma unroll
    for (int i = 0; i < 40; ++i) r.in[i] = q->in[i];
    r.out = q->out; r.ws = q->ws; return r; }
#define FRESH() const int G = grid_fresh(), bid = bid_fresh(); (void)G; (void)bid; KParams pk_ = (KParams)__builtin_amdgcn_kernarg_segment_ptr(); asm volatile("" : "+s"(pk_)); const Params P = load_params(pk_); unsigned char* ws = P.ws; \
    const float* mod = (const float*)(ws + WS_MOD); bf16* H = (bf16*)(ws + WS_H); bf16* BIG = (bf16*)(ws + WS_BIG); bf16* MIX = (bf16*)(ws + WS_MIX); (void)mod; (void)H; (void)BIG; (void)MIX;
#define GSYNC() do { KParams pb_ = (KParams)__builtin_amdgcn_kernarg_segment_ptr(); asm volatile("" : "+s"(pb_)); xcd_barrier(wid0, (unsigned*)(pb_->ws + WS_BAR), lds); } while (0)
__global__ void __launch_bounds__(NTHR, 2) fwd_kernel(Params Parg) {
    extern __shared__ __attribute__((aligned(16))) unsigned char lds_raw[];
    LAS unsigned char* lds = (LAS unsigned char*)lds_raw;
    cg::grid_group grid = cg::this_grid();
    const int wid0 = __builtin_amdgcn_readfirstlane(threadIdx.x >> 6);
    if (threadIdx.x < 4) ((LAS unsigned*)(lds + LDS_BARST))[threadIdx.x] = 0u;
    __syncthreads();
    if (threadIdx.x == 0) (void)xb_add((unsigned*)(Parg.ws + WS_BAR) + XB_XCNT(xb_xcc_id()), 1u);

    { FRESH(); phase_prologue(wid0, P, lds); }
    if (grid_fresh() == 0) grid.sync();
    GSYNC();
#ifdef PROBE_DUP_PRO
    { FRESH(); phase_prologue(wid0, P, lds); }
    GSYNC();
#endif
    { FRESH(); phase_modreduce(wid0, P); }
    GSYNC();
#ifdef PROBE_SYNC
#pragma unroll 1
    for (int i = 0; i < 40; ++i) GSYNC();
#endif
#pragma unroll 1
    for (int l = 0; l < 4; ++l) {
        { FRESH(); const float* modl = mod + (size_t)l * 9 * 6144;
        phase_rownorm(wid0, P, l == 0, MIX, modl - 9 * 6144, 5 * 1024, P.in[I_NMLPPOST] + (l > 0 ? (l - 1) * 1024 : 0), 1, P.in[I_NMIXPRE] + l * 1024, modl, 0, H); }
        GSYNC();
        const int eo = l >> 1;
        {
            FRESH();
            pg8::Gemm g; pg8::StaticOrder S; EpiBf16<0> E;
            if ((l & 1) == 0) { g = pg8::Gemm{H, (const bf16*)(ws + WS_WINE) + (size_t)eo * NB_E * 1024, MT, NB_E, 1024, 1024, 0, 0, 1024, 0}; E = EpiBf16<0>{BIG, NPROJ_E, (float*)(ws + WS_AB), (bf16*)(ws + WS_HALO)}; }
            else { g = pg8::Gemm{H, (const bf16*)(ws + WS_WINO) + (size_t)eo * 2048 * 1024, MT, 2048, 1024, 1024, 0, 0, 1024, 0}; E = EpiBf16<0>{BIG, 2048, nullptr, nullptr}; }
            S.init(g.M, g.N, G, bid);
            pg8::gemm_phase(wid0, lds, g, S, E); DUPG(pg8::gemm_phase(wid0, lds, g, S, E);)
        }
        GSYNC();
        if ((l & 1) == 0) {
            { FRESH(); phase_conv_even(wid0, P, eo); }
            GSYNC();
#ifdef PROBE_DUP_MIX
#pragma unroll 1
            for (int rep = 0; rep < 2; ++rep) { { FRESH(); phase_mix_even(wid0, P, lds, eo, rep == 0 ? 3 : PROBE_DUP_MIX); } GSYNC(); }
#else
            { FRESH(); phase_mix_even(wid0, P, lds, eo); }
            GSYNC();
#endif
            { FRESH(); phase_fin_even(wid0, P, lds, eo); }
            GSYNC();
        } else {
            { FRESH(); phase_conv_odd(wid0, P, eo); }
            GSYNC();
#ifdef PROBE_DUP_CONV
            { FRESH(); phase_conv_odd(wid0, P, eo); }
            GSYNC();
#endif
#pragma unroll 1
            for (int d = 0; d < 2; ++d) {
                { FRESH();
                pg8::Gemm g{H, (const bf16*)(ws + WS_WG) + (size_t)(eo * 2 + d) * 2048 * 256, MT, 2048, 256, 1024, 1, 1, 256, 0};
                EpiGates E{(unsigned*)(ws + WS_GATES), H, P.in[I_LBR] + (eo * 2 + d) * 1024, P.in[I_LBI] + (eo * 2 + d) * 1024, P.in[I_LLAM] + (eo * 2 + d) * 1024};
                pg8::StaticOrder S; S.init(g.M, g.N, G, bid);
                pg8::gemm_phase(wid0, lds, g, S, E); DUPG(pg8::gemm_phase(wid0, lds, g, S, E);) }
                GSYNC();
                { FRESH(); phase_lru_scan(wid0, P, lds, eo, d); }
#ifdef PROBE_DUP_LRU0
                if (d == 0) { GSYNC(); FRESH(); phase_lru_scan(wid0, P, lds, eo, d); }
#endif
                GSYNC();
            }
        }
        {
            FRESH();
            pg8::Gemm g{MIX, (const bf16*)(ws + ((l & 1) ? WS_WOUTO : WS_WOUTE)) + (size_t)eo * 1024 * 1024, MT, 1024, 1024, 1024, 0, 0, 1024, 0};
            EpiBf16<0> E{BIG, 1024, nullptr, nullptr}; pg8::StaticOrder S; S.init(g.M, g.N, G, bid);
            pg8::gemm_phase(wid0, lds, g, S, E); DUPG(pg8::gemm_phase(wid0, lds, g, S, E);)
        }
        GSYNC();
        { FRESH(); const float* modl = mod + (size_t)l * 9 * 6144;
        phase_rownorm(wid0, P, 0, BIG, modl, 2 * 1024, P.in[I_NMIXPOST] + l * 1024, 1, P.in[I_NMLPPRE] + l * 1024, modl, 3 * 1024, H); }
        GSYNC();
        {
            FRESH();
            pg8::Gemm g{H, (const bf16*)(ws + WS_W1T) + (size_t)l * 4096 * 1024, MT, 4096, 1024, 1024, 0, 0, 1024, 0};
            EpiBf16<1> E{BIG, 4096, nullptr, nullptr}; pg8::StaticOrder S; S.init(g.M, g.N, G, bid);
            pg8::gemm_phase(wid0, lds, g, S, E); DUPG(pg8::gemm_phase(wid0, lds, g, S, E);)
        }
        GSYNC();
        {
            FRESH();
            pg8::Gemm g{BIG, (const bf16*)(ws + WS_W2T) + (size_t)l * 1024 * 4096, MT, 1024, 4096, 4096, 0, 0, 4096, 0};
            EpiBf16<0> E{MIX, 1024, nullptr, nullptr}; pg8::StaticOrder S; S.init(g.M, g.N, G, bid);
            pg8::gemm_phase(wid0, lds, g, S, E); DUPG(pg8::gemm_phase(wid0, lds, g, S, E);)
        }
        GSYNC();
    }
    { FRESH();
    phase_rownorm(wid0, P, 0, MIX, mod + (size_t)3 * 9 * 6144, 5 * 1024, P.in[I_NMLPPOST] + 3 * 1024, 0, P.in[I_NMIXPRE], mod, 0, H); }
}

extern "C" void kernel_launch(void* const* d_in, const int* in_sizes, int n_in, void* d_out, int out_size, void* d_ws, size_t ws_size, hipStream_t stream) {
    static int grid = 0;
    if (grid == 0) {
        if (n_in != 40 || ws_size < WS_END) { fprintf(stderr, "kernel_launch: expected 40 inputs and >= %zu bytes of workspace (got %d, %zu)\n", (size_t)WS_END, n_in, ws_size); grid = -1; return; }
        int dev = 0, cus = 0, per_cu = 0;
        if (hipGetDevice(&dev) != hipSuccess || hipDeviceGetAttribute(&cus, hipDeviceAttributeMultiprocessorCount, dev) != hipSuccess) { grid = -1; return; }
        if (hipFuncSetAttribute((const void*)fwd_kernel, hipFuncAttributeMaxDynamicSharedMemorySize, LDS_BYTES) != hipSuccess) { fprintf(stderr, "kernel_launch: hipFuncSetAttribute failed\n"); grid = -1; return; }
        if (hipOccupancyMaxActiveBlocksPerMultiprocessor(&per_cu, (const void*)fwd_kernel, NTHR, LDS_BYTES) != hipSuccess || per_cu < 1) per_cu = 1;
        (void)hipGetLastError();
        grid = cus * per_cu; if (grid > 256) grid = 256;
    }
    if (grid < 0) return;
    (void)hipMemsetAsync((char*)d_ws + WS_BAR, 0, 16384, stream);
    Params p{};
    for (int i = 0; i < 40; ++i) p.in[i] = (const float*)d_in[i];
    p.out = (float*)d_out; p.ws = (unsigned char*)d_ws;
    void* args[] = {&p};
    hipError_t e = hipLaunchCooperativeKernel((const void*)fwd_kernel, dim3(grid), dim3(NTHR), args, LDS_BYTES, stream);
    if (e != hipSuccess) fprintf(stderr, "cooperative launch failed: %s (grid %d)\n", hipGetErrorString(e), grid);
}
```

```cpp
#include <hip/hip_runtime.h>
#include <hip/hip_cooperative_groups.h>
#include <cstdio>
#include <cstdint>
namespace cg = cooperative_groups;
__device__ __forceinline__ int bid_fresh() { int t = blockIdx.x; asm volatile("" : "+s"(t)); return t; }
__device__ __forceinline__ int grid_fresh() { int t = gridDim.x; asm volatile("" : "+s"(t)); return t; }
__device__ __forceinline__ int tid_fresh(int w) { asm volatile("" : "+s"(w)); int l; asm volatile("v_mbcnt_lo_u32_b32 %0, -1, 0\n\tv_mbcnt_hi_u32_b32 %0, -1, %0" : "=v"(l)); return w * 64 + l; }

namespace pg8 {
#define PG8_LAS __attribute__((address_space(3)))
typedef unsigned short bf16_t;
typedef short bf16x8 __attribute__((ext_vector_type(8)));
typedef float f32x4 __attribute__((ext_vector_type(4)));
typedef unsigned u32x4 __attribute__((ext_vector_type(4)));
typedef unsigned u32x2 __attribute__((ext_vector_type(2)));
constexpr int BM = 256, BK = 64, HALF = 128, HTB = HALF * BK * 2, STAGE_BYTES = 8 * HTB, NXCD = 8, WGM = 8;

__host__ __device__ __forceinline__ int lds_byte(int r, int c) { const int st = (r >> 4) * 2 + (c >> 5), rr = r & 15, cc = c & 31, ob = rr * 64 + cc * 2; return st * 1024 + (ob ^ (((ob >> 9) & 1) << 5)); }
__host__ __device__ __forceinline__ void stage_rc(int b, int& R, int& C) { const int st = b / 1024, sb = b % 1024, swz = sb ^ (((sb >> 9) & 1) << 5); R = (st >> 1) * 16 + swz / 64; C = (st & 1) * 32 + (swz % 64) / 2; }
__host__ __device__ __forceinline__ int perm32(int rho) { const int n = rho >> 4, i = rho & 15; return 8 * (i >> 2) + 4 * n + (i & 3); }

struct Unit { int pm, pn; };
struct Gemm { const bf16_t* A; const bf16_t* Bt; int M, N, K, lda, ablk, ashift, ldb, ksplit; };

struct StaticOrder {
    int nM, nN, nwg, G, c;
    __host__ __device__ void init(int M, int N, int G_, int c_) { nM = M / BM; nN = N / BM; nwg = nM * nN; G = G_; c = c_; }
    __host__ __device__ bool next(int i, Unit& u) const {
        const long L = (long)i * G + c; if (L >= nwg) return false;
        int wgid = (int)L; { const int q = nwg / NXCD, r = nwg % NXCD, xcd = wgid % NXCD, off = wgid / NXCD; wgid = (xcd < r ? xcd * (q + 1) : r * (q + 1) + (xcd - r) * q) + off; }
        const int nig = WGM * nN, gid = wgid / nig, fm = gid * WGM, gsz = (nM - fm) < WGM ? (nM - fm) : WGM;
        u.pm = fm + ((wgid % nig) % gsz); u.pn = (wgid % nig) / gsz; return true;
    }
};
__device__ __forceinline__ unsigned cvt_pk_bf16(float lo, float hi) { unsigned r; asm volatile("v_cvt_pk_bf16_f32 %0, %1, %2" : "=v"(r) : "v"(lo), "v"(hi)); return r; }

template <class Epi>
__device__ __forceinline__ void gemm_phase(int wid0, PG8_LAS unsigned char* lds, const Gemm g, const StaticOrder& S, const Epi& E) {
    const int tid = tid_fresh(wid0), wid = __builtin_amdgcn_readfirstlane(tid >> 6), lane = tid & 63, wr = wid >> 2, wc = wid & 3, fr = lane & 15, fq = lane >> 4;
    const int K = g.K, nt = K / BK, lda = g.lda, ldb = g.ldb;
    unsigned voffA[2], voffB[2];
#pragma unroll
    for (int i = 0; i < 2; ++i) { int R, C; stage_rc(tid * 16 + i * 8192, R, C); const int Rb = (R & ~31) + perm32(R & 31);
        voffA[i] = (unsigned)(R * lda + C) * 2u; voffB[i] = (unsigned)(Rb * ldb + C) * 2u; }
    const size_t kstep = (size_t)(BK * 2);
    const size_t hstepA = (size_t)HALF * lda * 2, hstepB = (size_t)HALF * ldb * 2;
    const size_t tstepA = 2 * hstepA, tstepB = 2 * hstepB;
    const unsigned ldsw = (unsigned)wid * 1024u;
    const int aoff = lds_byte(wr * 64 + fr, fq * 8), boff = lds_byte(wc * 32 + fr, fq * 8);
#define PG8_ACOL(pn) (g.ablk ? (size_t)((((pn) >> g.ashift) & 3) * 512) : (g.ksplit ? (size_t)((pn) & 1) * (size_t)K * 2 : (size_t)0))
#define PG8_BOFF(pn) (g.ksplit ? (size_t)((pn) >> 1) * tstepB + (size_t)((pn) & 1) * (size_t)K * 2 : (size_t)(pn) * tstepB)
#define PG8_SA(b, h) (((b) * 2 + (h)) * HTB)
#define PG8_SB(b, h) ((4 + (b) * 2 + (h)) * HTB)
#define PG8_STAGE(bufoff, gbase, voff) do { _Pragma("unroll") for (int _i = 0; _i < 2; ++_i) \
        __builtin_amdgcn_global_load_lds((const unsigned*)((const char*)(gbase) + (voff)[_i]), (PG8_LAS unsigned*)(lds + (bufoff) + ldsw + _i * 8192), 16, 0, 0); } while (0)
#define PG8_LDA(dst, b, h) do { _Pragma("unroll") for (int m = 0; m < 4; ++m) _Pragma("unroll") for (int k = 0; k < 2; ++k) dst[m][k] = *(const PG8_LAS bf16x8*)(lds + PG8_SA(b, h) + aoff + m * 2048 + k * 1024); } while (0)
#define PG8_LDB(dst, b, h) do { _Pragma("unroll") for (int n = 0; n < 2; ++n) _Pragma("unroll") for (int k = 0; k < 2; ++k) dst[n][k] = *(const PG8_LAS bf16x8*)(lds + PG8_SB(b, h) + boff + n * 2048 + k * 1024); } while (0)
#define PG8_MMA(ai, bj, At, Bt) do { __builtin_amdgcn_s_setprio(1); _Pragma("unroll") for (int m = 0; m < 4; ++m) _Pragma("unroll") for (int n = 0; n < 2; ++n) _Pragma("unroll") for (int k = 0; k < 2; ++k) \
        acc[ai][bj][m][n] = __builtin_amdgcn_mfma_f32_16x16x32_bf16(Bt[n][k], At[m][k], acc[ai][bj][m][n], 0, 0, 0); __builtin_amdgcn_s_setprio(0); } while (0)
#define PG8_WAIT_V(n) asm volatile("s_waitcnt vmcnt(" #n ")" ::: "memory")
#define PG8_WAIT_L(n) asm volatile("s_waitcnt lgkmcnt(" #n ")" ::: "memory")
#define PG8_BAR __builtin_amdgcn_s_barrier()
#define PG8_SCHED __builtin_amdgcn_sched_barrier(0)
    Unit cur, nxt; int ui = 0;
    if (!S.next(0, cur)) return;
    f32x4 acc[2][2][4][2];
#pragma unroll
    for (int a = 0; a < 2; ++a)
#pragma unroll
        for (int b = 0; b < 2; ++b)
#pragma unroll
            for (int m = 0; m < 4; ++m)
#pragma unroll
                for (int n = 0; n < 2; ++n) acc[a][b][m][n] = (f32x4){0.f, 0.f, 0.f, 0.f};
    bf16x8 At[4][2], B0[2][2], B1[2][2];
    const char* cA = (const char*)g.A + (size_t)cur.pm * tstepA + PG8_ACOL(cur.pn); const char* cB = (const char*)g.Bt + PG8_BOFF(cur.pn);
    PG8_STAGE(PG8_SB(0, 0), cB, voffB); PG8_STAGE(PG8_SA(0, 0), cA, voffA); PG8_STAGE(PG8_SB(0, 1), cB + hstepB, voffB); PG8_STAGE(PG8_SA(0, 1), cA + hstepA, voffA);
    if (wr == 1) PG8_BAR;
    PG8_WAIT_V(4); PG8_BAR;
    PG8_STAGE(PG8_SB(1, 0), cB + kstep, voffB); PG8_STAGE(PG8_SA(1, 0), cA + kstep, voffA); PG8_STAGE(PG8_SB(1, 1), cB + hstepB + kstep, voffB);
    PG8_WAIT_V(6); PG8_BAR;
    for (;;) {
        const bool has_next = S.next(ui + 1, nxt);
        const char* nA = has_next ? (const char*)g.A + (size_t)nxt.pm * tstepA + PG8_ACOL(nxt.pn) : cA; const char* nB = has_next ? (const char*)g.Bt + PG8_BOFF(nxt.pn) : cB;
        for (int t = 0; t < nt; t += 2) {
            const bool last = (t == nt - 2);
            const char* a1 = cA + (size_t)(t + 1) * kstep;
            const char* a2 = last ? nA : cA + (size_t)(t + 2) * kstep; const char* b2 = last ? nB : cB + (size_t)(t + 2) * kstep;
            const char* a3 = a2 + kstep; const char* b3 = b2 + kstep;
            PG8_LDB(B0, 0, 0); PG8_SCHED; PG8_LDA(At, 0, 0); PG8_STAGE(PG8_SA(1, 1), a1 + hstepA, voffA);
            PG8_WAIT_L(8); PG8_BAR; PG8_WAIT_L(0); PG8_MMA(0, 0, At, B0); PG8_BAR; PG8_SCHED;
            PG8_LDB(B1, 0, 1); PG8_STAGE(PG8_SB(0, 0), b2, voffB);
            PG8_BAR; PG8_WAIT_L(0); PG8_MMA(0, 1, At, B1); PG8_BAR;
            PG8_LDA(At, 0, 1); PG8_STAGE(PG8_SA(0, 0), a2, voffA);
            PG8_BAR; PG8_WAIT_L(0); PG8_MMA(1, 0, At, B0); PG8_BAR; PG8_SCHED;
            PG8_STAGE(PG8_SB(0, 1), b2 + hstepB, voffB);
            PG8_WAIT_V(6); PG8_BAR; PG8_MMA(1, 1, At, B1); PG8_BAR;
            PG8_LDB(B0, 1, 0); PG8_SCHED; PG8_LDA(At, 1, 0); PG8_STAGE(PG8_SA(0, 1), a2 + hstepA, voffA);
            PG8_WAIT_L(8); PG8_BAR; PG8_WAIT_L(0); PG8_MMA(0, 0, At, B0); PG8_BAR; PG8_SCHED;
            PG8_LDB(B1, 1, 1); PG8_STAGE(PG8_SB(1, 0), b3, voffB);
            PG8_BAR; PG8_WAIT_L(0); PG8_MMA(0, 1, At, B1); PG8_BAR;
            PG8_LDA(At, 1, 1); PG8_STAGE(PG8_SA(1, 0), a3, voffA);
            PG8_BAR; PG8_WAIT_L(0); PG8_MMA(1, 0, At, B0); PG8_BAR; PG8_SCHED;
            PG8_STAGE(PG8_SB(1, 1), b3 + hstepB, voffB);
            PG8_WAIT_V(6); PG8_BAR; PG8_MMA(1, 1, At, B1); PG8_BAR;
        }
        E(acc, cur, wr, wc, fr, fq);
        if (!has_next) break;
#pragma unroll
        for (int a = 0; a < 2; ++a)
#pragma unroll
            for (int b = 0; b < 2; ++b)
#pragma unroll
                for (int m = 0; m < 4; ++m)
#pragma unroll
                    for (int n = 0; n < 2; ++n) acc[a][b][m][n] = (f32x4){0.f, 0.f, 0.f, 0.f};
        cur = nxt; cA = nA; cB = nB; ++ui;
    }
    PG8_WAIT_V(0);
    if (wr == 0) PG8_BAR;
    PG8_BAR;
#undef PG8_ACOL
#undef PG8_BOFF
#undef PG8_SA
#undef PG8_SB
#undef PG8_STAGE
#undef PG8_LDA
#undef PG8_LDB
#undef PG8_MMA
#undef PG8_WAIT_V
#undef PG8_WAIT_L
#undef PG8_BAR
#undef PG8_SCHED
}
}
#define LAS __attribute__((address_space(3)))
typedef unsigned short bf16;
typedef short bf16x8 __attribute__((ext_vector_type(8)));
typedef float f32x4 __attribute__((ext_vector_type(4)));
typedef unsigned u32x4 __attribute__((ext_vector_type(4)));
typedef unsigned u32x2 __attribute__((ext_vector_type(2)));
constexpr int DM = 1024, MT = 24576, MCTX = 8192, LCTX = 256, LLAT = 2048, NWAVES = 8, NTHR = 512;
constexpr int NPROJ_E = 3072, NB_E = 3328, IN_EVEN_LD = 3088;
constexpr float EPSF = 1e-6f;
constexpr size_t MiB = 1u << 20;
constexpr size_t WS_MOD = 0, MOD_BYTES = 4 * 9 * 6144 * 4, WS_S5F = 1 * MiB, WS_AB = 3 * MiB, WS_W1T = 5 * MiB, WS_W2T = 37 * MiB, WS_WINE = 69 * MiB,
                 WS_WOUTE = 82 * MiB, WS_WINO = 86 * MiB, WS_WOUTO = 94 * MiB, WS_WG = 98 * MiB, WS_H = 102 * MiB, WS_BIG = 150 * MiB, WS_YBUF = 294 * MiB,
                 WS_GATES = 246 * MiB, WS_MIX = 342 * MiB, WS_HALO = 390 * MiB, WS_END = 390 * MiB + 384 * 3 * 1536 * 2;
constexpr int LDS_BYTES = 147456;
constexpr size_t OUT_S5RE = 25165824, OUT_S5IM = OUT_S5RE + 262144, OUT_DELTA = OUT_S5IM + 262144, OUT_LRU = OUT_DELTA + 8388608;

struct Params { const float* in[40]; float* out; unsigned char* ws; };
enum { I_XP = 0, I_XS, I_S5RE, I_S5IM, I_SDELTA, I_SLRU, I_C, I_CCTX, I_WADA, I_BADA, I_NMIXPRE, I_NMIXPOST, I_NMLPPRE, I_NMLPPOST, I_WMLPIN, I_WMLPOUT, I_WINE, I_WOUTE,
       I_LAMRE, I_LAMIM, I_LOGDT, I_BRE, I_BIM, I_CRE, I_CIM, I_S5D, I_GCONVW, I_GCONVB, I_GALOG, I_GDTB, I_GONORM, I_WINO, I_WOUTO, I_LCONVW, I_LCONVB, I_LWR, I_LBR, I_LWI, I_LBI, I_LLAM };

typedef __bf16 bf2_t __attribute__((ext_vector_type(2)));
typedef float f2_t __attribute__((ext_vector_type(2)));
__device__ __forceinline__ unsigned pk2(float lo, float hi) { const bf2_t v = __builtin_convertvector((f2_t){lo, hi}, bf2_t); return __builtin_bit_cast(unsigned, v); }
__device__ __forceinline__ unsigned f2bf(float f) { return pk2(f, f) & 0xffffu; }
__device__ __forceinline__ float bflo(unsigned w) { return __builtin_bit_cast(float, w << 16); }
__device__ __forceinline__ float bfhi(unsigned w) { return __builtin_bit_cast(float, w & 0xffff0000u); }
__device__ __forceinline__ float bf2f(bf16 b) { return __builtin_bit_cast(float, (unsigned)b << 16); }
__device__ __forceinline__ float sigmoidf_(float x) { return __builtin_amdgcn_rcpf(1.0f + __expf(-x)); }
__device__ __forceinline__ float siluf_(float x) { return x * sigmoidf_(x); }
__device__ __forceinline__ float softplusf_(float x) { return fmaxf(x, 0.f) + __logf(1.0f + __expf(-fabsf(x))); }
__device__ __forceinline__ float geluf_(float x) { const float y = 0.7978845608028654f * (x + 0.044715f * x * x * x); const float t = 1.0f - 2.0f * __builtin_amdgcn_rcpf(__expf(2.0f * y) + 1.0f); return 0.5f * x * (1.0f + t); }
__device__ __forceinline__ float shfl_i(float v, int srclane) { return __builtin_bit_cast(float, __builtin_amdgcn_ds_bpermute(srclane << 2, __builtin_bit_cast(int, v))); }
__device__ __forceinline__ float wave_sum(float v, int lane) {
#pragma unroll
    for (int o = 1; o < 64; o <<= 1) v += shfl_i(v, lane ^ o);
    return v;
}
#define LDS_WAIT() asm volatile("s_waitcnt lgkmcnt(0)" ::: "memory")
#define WAVE_SYNC() do { asm volatile("s_waitcnt lgkmcnt(0)" ::: "memory"); __builtin_amdgcn_wave_barrier(); } while (0)
__device__ __forceinline__ f32x4 mfma16(bf16x8 a, bf16x8 b, f32x4 c) { return __builtin_amdgcn_mfma_f32_16x16x32_bf16(a, b, c, 0, 0, 0); }


#define XB_TMO      128
#define XB_XCNT(j)  (256  + 64 * (j))
#define XB_XSUB(j)  (1280 + 64 * (j))
#define XB_XGEN(j)  (2304 + 64 * (j))
#define XB_TOP      3328
#define XB_TOPGEN   3392
#define XCD_BAR_WORDS 3456
#define XB_SPIN_CAP (1u << 18)
constexpr size_t WS_BAR = 960 * 1024; constexpr int LDS_BARST = LDS_BYTES - 16;
__device__ __forceinline__ unsigned xb_ld(unsigned* p)              { return __hip_atomic_load(p, __ATOMIC_RELAXED, __HIP_MEMORY_SCOPE_AGENT); }
__device__ __forceinline__ unsigned xb_add(unsigned* p, unsigned v) { return __hip_atomic_fetch_add(p, v, __ATOMIC_RELAXED, __HIP_MEMORY_SCOPE_AGENT); }
__device__ __forceinline__ unsigned xb_xcc_id() { return (unsigned)__builtin_amdgcn_s_getreg((3 << 11) | 20) & 0xFu; }
#define XB_SPIN(cond, bar) do { unsigned _sp = 0; while (cond) { __builtin_amdgcn_s_sleep(1); \
    if ((++_sp & 255u) == 0u) { if (xb_ld(&(bar)[XB_TMO])) break; if (_sp > XB_SPIN_CAP) { atomicAdd(&(bar)[XB_TMO], 1u); break; } } } } while (0)
__device__ __forceinline__ void xcd_barrier_complete(unsigned* bar, unsigned x, unsigned& nloc, unsigned& nx) {
    const unsigned G = gridDim.x;
    unsigned sum, cnt, mine, sp = 0u;
    for (;;) {
        sum = 0u; cnt = 0u; mine = 0u;
#pragma unroll
        for (unsigned j = 0; j < 16; ++j) { const unsigned c = xb_ld(&bar[XB_XCNT(j)]); sum += c; cnt += (c > 0u) ? 1u : 0u; mine = (j == x) ? c : mine; }
        if (sum == G) break;
        __builtin_amdgcn_s_sleep(1);
        if ((++sp & 255u) == 0u) { if (xb_ld(&bar[XB_TMO])) break; if (sp > XB_SPIN_CAP) { atomicAdd(&bar[XB_TMO], 1u); break; } }
    }
    nloc = mine > 0u ? mine : 1u; nx = cnt > 0u ? cnt : 1u;
}
__device__ __forceinline__ void xcd_barrier(int wid0, unsigned* bar, LAS unsigned char* lds) {
    const int tid = tid_fresh(wid0);
    asm volatile("s_waitcnt vmcnt(0)" ::: "memory");
    __syncthreads();
    if (tid == 0) {
        const unsigned x = xb_xcc_id();
        volatile LAS unsigned* st = (volatile LAS unsigned*)(lds + LDS_BARST);
        __builtin_amdgcn_s_waitcnt(0);
        unsigned nloc = st[0], nx = st[1];
        if (nloc == 0u) { xcd_barrier_complete(bar, x, nloc, nx); st[0] = nloc; st[1] = nx; }
        const unsigned old = xb_add(&bar[XB_XSUB(x)], 1u);
        const unsigned gen = old / nloc;
        if (old + 1u == (gen + 1u) * nloc) {
            __builtin_amdgcn_fence(__ATOMIC_RELEASE, "agent");
            asm volatile("s_waitcnt vmcnt(0)" ::: "memory");
            const unsigned og = xb_add(&bar[XB_TOP], 1u);
            const unsigned tg = og / nx;
            if (og + 1u == (tg + 1u) * nx) xb_add(&bar[XB_TOPGEN], 1u);
            else XB_SPIN(xb_ld(&bar[XB_TOPGEN]) == tg, bar);
            __builtin_amdgcn_fence(__ATOMIC_ACQUIRE, "agent");
            xb_add(&bar[XB_XGEN(x)], 1u);
            asm volatile("s_waitcnt vmcnt(0)" ::: "memory");
        } else {
            XB_SPIN(xb_ld(&bar[XB_XGEN(x)]) == gen, bar);
            __builtin_amdgcn_fence(__ATOMIC_ACQUIRE, "agent");
            asm volatile("s_waitcnt vmcnt(0)" ::: "memory");
        }
    }
    __syncthreads();
}
__device__ __forceinline__ void transpose_item(const float* W, int ldw, int nvalid, int K, bf16* WT, int dst_row0, LAS float* scr, int k0, int n0, int lane) {
    const int nn = n0 + (lane & 31); const bool ok = nn < nvalid;
#pragma unroll 8
    for (int i = 0; i < 32; ++i) { const int kk = 2 * i + (lane >> 5); scr[kk * 33 + (lane & 31)] = ok ? W[(size_t)(k0 + kk) * ldw + nn] : 0.f; }
    WAVE_SYNC();
    const int c = lane & 7;
#pragma unroll
    for (int j = 0; j < 4; ++j) { const int n = (lane >> 3) + 8 * j; const LAS float* s = scr + (8 * c) * 33 + n;
        u32x4 o; o.x = pk2(s[0 * 33], s[1 * 33]); o.y = pk2(s[2 * 33], s[3 * 33]); o.z = pk2(s[4 * 33], s[5 * 33]); o.w = pk2(s[6 * 33], s[7 * 33]);
        *(u32x4*)(WT + (size_t)(dst_row0 + n) * K + k0 + 8 * c) = o; }
    WAVE_SYNC();
}
constexpr int WITEMS_EVEN = 4096 + 1552 + 512, WITEMS_ODD = 4096 + 1024 + 512 + 512;
__device__ __forceinline__ void weight_item(const Params& P, LAS float* scr, int l, int r, int lane) {
    unsigned char* ws = P.ws; const int eo = l >> 1;
    if (r < 2048) { const int q = r; transpose_item(P.in[I_WMLPIN] + (size_t)l * 1024 * 4096, 4096, 4096, 1024, (bf16*)(ws + WS_W1T) + (size_t)l * 4096 * 1024, 32 * (q & 127), scr, 64 * (q >> 7), 32 * (q & 127), lane); return; } r -= 2048;
    if (r < 2048) { const int q = r; transpose_item(P.in[I_WMLPOUT] + (size_t)l * 4096 * 1024, 1024, 1024, 4096, (bf16*)(ws + WS_W2T) + (size_t)l * 1024 * 4096, 32 * (q & 31), scr, 64 * (q >> 5), 32 * (q & 31), lane); return; } r -= 2048;
    if ((l & 1) == 0) {
        if (r < 1552) { const int kb = r / 97, nb = r % 97; transpose_item(P.in[I_WINE] + (size_t)eo * 1024 * IN_EVEN_LD, IN_EVEN_LD, IN_EVEN_LD, 1024, (bf16*)(ws + WS_WINE) + (size_t)eo * NB_E * 1024, 32 * nb, scr, 64 * kb, 32 * nb, lane); return; } r -= 1552;
        { const int q = r; transpose_item(P.in[I_WOUTE] + (size_t)eo * 1024 * 1024, 1024, 1024, 1024, (bf16*)(ws + WS_WOUTE) + (size_t)eo * 1024 * 1024, 32 * (q & 31), scr, 64 * (q >> 5), 32 * (q & 31), lane); return; }
    } else {
        if (r < 1024) { const int q = r; transpose_item(P.in[I_WINO] + (size_t)eo * 1024 * 2048, 2048, 2048, 1024, (bf16*)(ws + WS_WINO) + (size_t)eo * 2048 * 1024, 32 * (q & 63), scr, 64 * (q >> 6), 32 * (q & 63), lane); return; } r -= 1024;
        if (r < 512) { const int q = r; transpose_item(P.in[I_WOUTO] + (size_t)eo * 1024 * 1024, 1024, 1024, 1024, (bf16*)(ws + WS_WOUTO) + (size_t)eo * 1024 * 1024, 32 * (q & 31), scr, 64 * (q >> 5), 32 * (q & 31), lane); return; } r -= 512;
        { const int mat = eo * 16 + (r >> 5), q = r & 31, kb = q >> 3, nb = q & 7; const int blk = mat & 3, gate = (mat >> 2) & 1, od = mat >> 3;
          const float* src = (gate ? P.in[I_LWI] : P.in[I_LWR]) + (size_t)(od * 4 + blk) * 65536;
          const int j0 = nb * 32; const int drow = (blk * 2 + (j0 >> 7)) * 256 + gate * 128 + (j0 & 127);
          transpose_item(src, 256, 256, 256, (bf16*)(ws + WS_WG) + (size_t)od * 2048 * 256, drow, scr, 64 * kb, j0, lane); return; }
    }
}
__device__ __forceinline__ void phase_prologue(int wid0, const Params& P, LAS unsigned char* lds) {
    const int tid = tid_fresh(wid0), lane = tid & 63, wave = tid >> 6;
    LAS float* scr = (LAS float*)(lds + wave * 16384);
    const int gw = bid_fresh() * NWAVES + wave, NGW = grid_fresh() * NWAVES;
    unsigned char* ws = P.ws;
    constexpr int NTR = WITEMS_EVEN, NMOD = 4 * 24 * 16;
    for (int it = gw; it < NTR + NMOD; it += NGW) {
        int r = it;
        if (r < NTR) { weight_item(P, scr, 0, r, lane); continue; } r -= NTR;
        {
            const int l = r / 384, rem = r % 384, ec = rem >> 4, ks = rem & 15, k0 = ks * 64;
#pragma unroll
            for (int rr = 0; rr < 9; ++rr) { const float cv = rr == 0 ? P.in[I_CCTX][k0 + lane] : P.in[I_C][(rr - 1) * 1024 + k0 + lane]; scr[rr * 64 + lane] = siluf_(cv); }
            WAVE_SYNC();
            f32x4 acc[9];
#pragma unroll
            for (int rr = 0; rr < 9; ++rr) acc[rr] = (f32x4){0.f, 0.f, 0.f, 0.f};
            const float* wp = P.in[I_WADA] + ((size_t)l * 1024 + k0) * 6144 + ec * 256 + lane * 4;
#pragma unroll 4
            for (int kk = 0; kk < 64; ++kk) { const f32x4 w4 = *(const f32x4*)(wp + (size_t)kk * 6144);
#pragma unroll
                for (int rr = 0; rr < 9; ++rr) acc[rr] += w4 * scr[rr * 64 + kk]; }
            float* part = (float*)(ws + WS_BIG) + ((size_t)(ks * 4 + l) * 9) * 6144 + ec * 256 + lane * 4;
#pragma unroll
            for (int rr = 0; rr < 9; ++rr) *(f32x4*)(part + (size_t)rr * 6144) = acc[rr];
            WAVE_SYNC();
        }
    }
    { const size_t per = (size_t)(NB_E - 3104) * 1024 * 2 / 16;
      for (size_t i = (size_t)bid_fresh() * NTHR + tid; i < 2 * per; i += (size_t)grid_fresh() * NTHR) { const size_t e = i / per, q = i % per;
          *(u32x4*)(ws + WS_WINE + (e * NB_E + 3104) * 1024 * 2 + q * 16) = (u32x4){0u, 0u, 0u, 0u}; } }
}
__device__ __forceinline__ void phase_modreduce(int wid0, const Params& P) {
    const int tid = tid_fresh(wid0);
    const float* part = (const float*)(P.ws + WS_BIG); float* mod = (float*)(P.ws + WS_MOD);
    for (int i = bid_fresh() * NTHR + tid; i < 4 * 9 * 6144 / 4; i += grid_fresh() * NTHR) {
        const int l = i / (9 * 1536), e4 = i % 1536;
        f32x4 a = *(const f32x4*)(P.in[I_BADA] + (size_t)l * 6144 + e4 * 4);
#pragma unroll
        for (int ks = 0; ks < 16; ++ks) a += *(const f32x4*)(part + (size_t)ks * 4 * 9 * 6144 + (size_t)i * 4);
        *(f32x4*)(mod + (size_t)i * 4) = a; }
}
__device__ __forceinline__ void phase_rownorm(int wid0, const Params& P, int first, const bf16* obuf, const float* modg, int goff, const float* gpost, int has_next, const float* gpre, const float* mods, int soff, bf16* H) {
    const int tid = tid_fresh(wid0), lane = tid & 63, wave = tid >> 6;
    const int gw = bid_fresh() * NWAVES + wave, NGW = grid_fresh() * NWAVES;
    float* X = P.out;
    f32x4 xn[4]; u32x2 on[4];
#define RN_LOAD(mm) do { const int m_ = (mm); const float* xs_ = first ? (m_ < MCTX ? P.in[I_XP] + (size_t)m_ * DM : P.in[I_XS] + (size_t)(m_ - MCTX) * DM) : X + (size_t)m_ * DM; \
        _Pragma("unroll") for (int j = 0; j < 4; ++j) { xn[j] = *(const f32x4*)(xs_ + lane * 4 + 256 * j); if (!first) on[j] = *(const u32x2*)(obuf + (size_t)m_ * DM + lane * 4 + 256 * j); } } while (0)
    if (gw < MT) RN_LOAD(gw);
    for (int m = gw; m < MT; m += NGW) {
        const int modrow = m < MCTX ? 0 : 1 + ((m - MCTX) >> 11);
        const float* mr = modg + (size_t)modrow * 6144; const float* ms = mods + (size_t)modrow * 6144;
        f32x4 x[4]; u32x2 ov[4];
#pragma unroll
        for (int j = 0; j < 4; ++j) { x[j] = xn[j]; ov[j] = on[j]; }
        if (m + NGW < MT) RN_LOAD(m + NGW);
        if (first) {
            if (m >= MCTX) {
                const int t = (m - MCTX) & 2047; const float prow = (float)(t >> 6), pcol = (float)(t & 63);
                f32x4 om;
#pragma unroll
                for (int e = 0; e < 4; ++e) om[e] = exp2f(-(float)(lane * 4 + e) * (13.287712379549449f / 256.0f));
#pragma unroll
                for (int j = 0; j < 4; ++j) {
#pragma unroll
                    for (int e = 0; e < 4; ++e) { const float a = (j < 2 ? prow : pcol) * om[e]; x[j][e] += (j & 1) ? cosf(a) : sinf(a); } }
            }
        } else {
            float ss = 0.f;
#pragma unroll
            for (int j = 0; j < 4; ++j) { const float a = bflo(ov[j].x), b = bfhi(ov[j].x), c = bflo(ov[j].y), d = bfhi(ov[j].y); ss += (a * a + b * b) + (c * c + d * d); }
            const float rs = rsqrtf(wave_sum(ss, lane) * (1.0f / DM) + EPSF);
#pragma unroll
            for (int j = 0; j < 4; ++j) { const f32x4 g4 = *(const f32x4*)(gpost + lane * 4 + 256 * j), gt = *(const f32x4*)(mr + goff + lane * 4 + 256 * j);
                f32x4 o4 = (f32x4){bflo(ov[j].x), bfhi(ov[j].x), bflo(ov[j].y), bfhi(ov[j].y)};
                x[j] += gt * (o4 * rs * g4); }
        }
#pragma unroll
        for (int j = 0; j < 4; ++j) *(f32x4*)(X + (size_t)m * DM + lane * 4 + 256 * j) = x[j];
        if (has_next) {
            float ss = 0.f;
#pragma unroll
            for (int j = 0; j < 4; ++j) ss += (x[j][0] * x[j][0] + x[j][1] * x[j][1]) + (x[j][2] * x[j][2] + x[j][3] * x[j][3]);
            const float rs = rsqrtf(wave_sum(ss, lane) * (1.0f / DM) + EPSF);
#pragma unroll
            for (int j = 0; j < 4; ++j) { const f32x4 g4 = *(const f32x4*)(gpre + lane * 4 + 256 * j), sh = *(const f32x4*)(ms + soff + lane * 4 + 256 * j), sc = *(const f32x4*)(ms + soff + 1024 + lane * 4 + 256 * j);
                const f32x4 h4 = (x[j] * rs * g4) * (sc + 1.0f) + sh;
                u32x2 w; w.x = pk2(h4[0], h4[1]); w.y = pk2(h4[2], h4[3]);
                *(u32x2*)(H + (size_t)m * DM + lane * 4 + 256 * j) = w; }
        }
    }
}

using pg8::Unit;
template <int ACT  > struct EpiBf16 {
    bf16* O; int ldc; float* AB;
    bf16* HALO;
    __device__ __forceinline__ void operator()(const f32x4 (&acc)[2][2][4][2], const Unit& u, int wr, int wc, int fr, int fq) const {
        const int row0 = u.pm * 256 + wr * 64 + fr, col0 = u.pn * 256 + wc * 32 + 8 * fq;
        if (AB && u.pn * 256 >= ldc) {
            if (wc == 0 && fq < 2) {
#pragma unroll
                for (int ai = 0; ai < 2; ++ai)
#pragma unroll
                    for (int m = 0; m < 4; ++m) { float* p = AB + (size_t)(row0 + ai * 128 + m * 16) * 16 + 8 * fq; *(f32x4*)p = acc[ai][0][m][0]; *(f32x4*)(p + 4) = acc[ai][0][m][1]; }
            }
            return;
        }
#pragma unroll
        for (int ai = 0; ai < 2; ++ai)
#pragma unroll
            for (int m = 0; m < 4; ++m) { bf16* rowp = O + (size_t)(row0 + ai * 128 + m * 16) * ldc + col0;
#pragma unroll
                for (int bj = 0; bj < 2; ++bj) { f32x4 v0 = acc[ai][bj][m][0], v1 = acc[ai][bj][m][1];
                    if (ACT == 1) {
#pragma unroll
                        for (int j = 0; j < 4; ++j) { const float a = fmaxf(v0[j], 0.f), b = fmaxf(v1[j], 0.f); v0[j] = a * a; v1[j] = b * b; } }
                    u32x4 w; w.x = pk2(v0[0], v0[1]); w.y = pk2(v0[2], v0[3]); w.z = pk2(v1[0], v1[1]); w.w = pk2(v1[2], v1[3]);
                    *(u32x4*)(rowp + bj * 128) = w;
                    if (ACT == 0 && HALO && u.pn >= 4 && u.pn < 10 && ((m == 3 && fr == 15) || (m == 0 && fr < 2))) {
                        const int r = row0 + ai * 128 + m * 16; const int which = (m == 3) ? 0 : 1 + fr;
                        *(u32x4*)(HALO + ((size_t)(r >> 6) * 3 + which) * 1536 + (col0 + bj * 128 - 1024)) = w; } } }
    }
};
struct EpiSplit {
    bf16* O0; long stride;
    __device__ __forceinline__ void operator()(const f32x4 (&acc)[2][2][4][2], const Unit& u, int wr, int wc, int fr, int fq) const {
        const int row0 = u.pm * 256 + wr * 64 + fr, col0 = (u.pn >> 1) * 256 + wc * 32 + 8 * fq; bf16* O = O0 + (long)(u.pn & 1) * stride;
#pragma unroll
        for (int ai = 0; ai < 2; ++ai)
#pragma unroll
            for (int m = 0; m < 4; ++m) { bf16* rowp = O + (size_t)(row0 + ai * 128 + m * 16) * DM + col0;
#pragma unroll
                for (int bj = 0; bj < 2; ++bj) { const f32x4 v0 = acc[ai][bj][m][0], v1 = acc[ai][bj][m][1];
                    u32x4 w; w.x = pk2(v0[0], v0[1]); w.y = pk2(v0[2], v0[3]); w.z = pk2(v1[0], v1[1]); w.w = pk2(v1[2], v1[3]);
                    *(u32x4*)(rowp + bj * 128) = w; } }
    }
};
struct EpiGates {
    unsigned* G; const bf16* X; const float* br; const float* bi; const float* lam;
    __device__ __forceinline__ void operator()(const f32x4 (&acc)[2][2][4][2], const Unit& u, int wr, int wc, int fr, int fq) const {
        const int row0 = u.pm * 256 + wr * 64 + fr, ch0 = u.pn * 128 + wc * 32 + 8 * fq;
#pragma unroll
        for (int n = 0; n < 2; ++n) {
            const f32x4 vbr = *(const f32x4*)(br + ch0 + 4 * n), vbi = *(const f32x4*)(bi + ch0 + 4 * n), l4 = *(const f32x4*)(lam + ch0 + 4 * n);
            f32x4 vsp;
#pragma unroll
            for (int e = 0; e < 4; ++e) vsp[e] = -8.0f * softplusf_(-l4[e]);
#pragma unroll
            for (int ai = 0; ai < 2; ++ai)
#pragma unroll
                for (int m = 0; m < 4; ++m) { const size_t row = (size_t)(row0 + ai * 128 + m * 16);
                    const u32x2 xv = *(const u32x2*)(X + row * DM + ch0 + 4 * n);
                    const float xs[4] = {bflo(xv.x), bfhi(xv.x), bflo(xv.y), bfhi(xv.y)};
                    u32x4 w;
#pragma unroll
                    for (int e = 0; e < 4; ++e) { const float r = sigmoidf_(acc[ai][0][m][n][e] + vbr[e]), ig = sigmoidf_(acc[ai][1][m][n][e] + vbi[e]);
                        const float la = r * vsp[e]; const float a_ = __expf(la); const float b = __builtin_amdgcn_sqrtf(fmaxf(1.0f - a_ * a_, 0.f)) * ig * xs[e];
                        w[e] = pk2(la * 1.4426950408889634f, b); }
                    *(u32x4*)(G + row * DM + ch0 + 4 * n) = w; }
        }
    }
};
constexpr int S5_WLDS = 12800, BU_P = 132, HS_P = 136;
struct S5Dir { float ar, ai; bf16x8 Bf[8]; };
__device__ __forceinline__ void s5_dir_setup(const Params& P, int e, int d, int g, int lane, float& ar, float& ai, bf16x8 (&Bf)[8], bool needB) {
    const int quad = lane >> 4, l15 = lane & 15;
    const float dt = __expf(P.in[I_LOGDT][(e * 2 + d) * 32 + g]);
    const float lr = P.in[I_LAMRE][((e * 2 + d) * 32 + g) * 64 + lane], li = P.in[I_LAMIM][((e * 2 + d) * 32 + g) * 64 + lane];
    const float mag = expf(lr * dt); ar = mag * cosf(li * dt); ai = mag * sinf(li * dt);
    const float den = lr * lr + li * li;
    const float fr = ((ar - 1.0f) * lr + ai * li) / den, fi = (ai * lr - (ar - 1.0f) * li) / den;
    if (needB) {
#pragma unroll
        for (int nt = 0; nt < 8; ++nt) { const int col = 16 * nt + l15, p = col & 63;
            const float frp = shfl_i(fr, p), fip = shfl_i(fi, p);
            bf16x8 v = (bf16x8){0, 0, 0, 0, 0, 0, 0, 0};
            if (quad < 2) { const float* bre = P.in[I_BRE] + ((size_t)(e * 32 + g) * 64 + p) * 16 + quad * 8; const float* bim = P.in[I_BIM] + ((size_t)(e * 32 + g) * 64 + p) * 16 + quad * 8;
#pragma unroll
                for (int j = 0; j < 8; ++j) { const float br = bre[j], bi = bim[j]; const float val = (nt < 4) ? (frp * br - fip * bi) : (frp * bi + fip * br); v[j] = (short)f2bf(val); } }
            Bf[nt] = v; }
    }
}
__device__ __forceinline__ void s5_c_setup(const Params& P, int e, int g, int lane, bf16x8 (&Cf)[4]) {
    const int quad = lane >> 4, l15 = lane & 15;
#pragma unroll
    for (int ks = 0; ks < 4; ++ks) { const int col0 = 32 * ks + quad * 8; const bool im = col0 >= 64;
        const float* src = (im ? P.in[I_CIM] : P.in[I_CRE]) + ((size_t)(e * 32 + g) * 16 + l15) * 64 + (col0 & 63);
        bf16x8 v;
#pragma unroll
        for (int j = 0; j < 8; ++j) v[j] = (short)f2bf(im ? -src[j] : src[j]);
        Cf[ks] = v; }
}
__device__ __forceinline__ void s5_scan_seg(const Params& P, LAS unsigned char* wl, int lane, int d, int g, int m0, float ar, float ai, const bf16x8 (&Bf)[8], const bf16x8 (&Cf)[4],
                                            float& hr, float& hi, int mode, int ymode, const bf16* proj, float* ybuf, bf16* mixout, float dsk) {
    const int quad = lane >> 4, l15 = lane & 15;
    LAS float* BU = (LAS float*)wl; LAS bf16* HS = (LAS bf16*)(wl + 8448);
    const int ch = g * 16 + l15;
    bf16x8 a_next = (bf16x8){0, 0, 0, 0, 0, 0, 0, 0};
    if (mode == 0 && quad < 2) { const int blk0 = d ? 15 : 0; const int tt = d ? 15 - l15 : l15; a_next = *(const bf16x8*)(proj + (size_t)(m0 + 16 * blk0 + tt) * NPROJ_E + g * 16 + quad * 8); }
    for (int bi_ = 0; bi_ < 16; ++bi_) {
        const int blk = d ? 15 - bi_ : bi_;
        const int mb = m0 + 16 * blk;
        const bf16x8 a = a_next;
        if (mode == 0 && quad < 2 && bi_ + 1 < 16) { const int blkn = d ? 14 - bi_ : bi_ + 1; const int tt = d ? 15 - l15 : l15; a_next = *(const bf16x8*)(proj + (size_t)(m0 + 16 * blkn + tt) * NPROJ_E + g * 16 + quad * 8); }
        float pre[4], zz[4];
#pragma unroll
        for (int jj = 0; jj < 4; ++jj) { const int row = quad * 4 + jj; const int tt = d ? 15 - row : row; const size_t m = (size_t)(mb + tt);
            pre[jj] = (ymode == 0) ? dsk * bf2f(proj[m * NPROJ_E + ch]) : ybuf[m * 512 + ch];
            zz[jj] = (ymode == 2) ? bf2f(proj[m * NPROJ_E + 512 + ch]) : 0.f; }
        if (mode == 0) {
#pragma unroll
            for (int nt = 0; nt < 8; ++nt) { f32x4 acc = mfma16(a, Bf[nt], (f32x4){0.f, 0.f, 0.f, 0.f});
#pragma unroll
                for (int jj = 0; jj < 4; ++jj) BU[(quad * 4 + jj) * BU_P + 16 * nt + l15] = acc[jj]; }
            WAVE_SYNC();
        }
#pragma unroll
        for (int r = 0; r < 16; ++r) {
            float br = 0.f, bim = 0.f;
            if (mode == 0) { br = BU[r * BU_P + lane]; bim = BU[r * BU_P + 64 + lane]; }
            const float nr = ar * hr - ai * hi + br, ni = ar * hi + ai * hr + bim; hr = nr; hi = ni;
            HS[r * HS_P + lane] = (bf16)f2bf(hr); HS[r * HS_P + 64 + lane] = (bf16)f2bf(hi);
        }
        WAVE_SYNC();
        f32x4 y = (f32x4){0.f, 0.f, 0.f, 0.f};
#pragma unroll
        for (int ks = 0; ks < 4; ++ks) { const bf16x8 af = *(const LAS bf16x8*)(HS + l15 * HS_P + 32 * ks + quad * 8); y = mfma16(af, Cf[ks], y); }
#pragma unroll
        for (int jj = 0; jj < 4; ++jj) { const int row = quad * 4 + jj; const int tt = d ? 15 - row : row; const size_t m = (size_t)(mb + tt);
            const float v = y[jj] + pre[jj];
            if (ymode != 2) ybuf[m * 512 + ch] = v;
            else mixout[m * DM + ch] = (bf16)f2bf(geluf_(v) * sigmoidf_(zz[jj]));
        }
        WAVE_SYNC();
    }
}
__device__ __forceinline__ void s5_task_main(const Params& P, LAS unsigned char* wl, int lane, int e, int sub, int g) {
    const bf16* proj = (const bf16*)(P.ws + WS_BIG); float* ybuf = (float*)(P.ws + WS_YBUF); bf16* mixout = (bf16*)(P.ws + WS_MIX);
    const bool lat = sub >= 32; const int q = sub - 32, b = lat ? (q >> 3) : sub, seg = lat ? (q & 7) : 0;
    const int m0 = lat ? MCTX + b * LLAT + seg * 256 : sub * 256;
    bf16x8 Cf[4]; s5_c_setup(P, e, g, lane, Cf);
    const float dsk = P.in[I_S5D][e * 512 + g * 16 + (lane & 15)];
#pragma unroll 1
    for (int d = 0; d < 2; ++d) {
        float ar, ai; bf16x8 Bf[8]; s5_dir_setup(P, e, d, g, lane, ar, ai, Bf, true);
        float hr = 0.f, hi = 0.f;
        if (lat && ((d == 0 && seg == 0) || (d == 1 && seg == 7))) { const size_t si = ((((size_t)b * 2 + e) * 2 + d) * 32 + g) * 64 + lane; hr = P.in[I_S5RE][si]; hi = P.in[I_S5IM][si]; }
        const int ymode = d == 0 ? 0 : (lat ? 1 : 2);
        s5_scan_seg(P, wl, lane, d, g, m0, ar, ai, Bf, Cf, hr, hi, 0, ymode, proj, ybuf, mixout, dsk);
        if (!lat) { const size_t si = ((((size_t)b * 2 + e) * 2 + d) * 32 + g) * 64 + lane; P.out[OUT_S5RE + si] = hr; P.out[OUT_S5IM + si] = hi; }
        else { float* F = (float*)(P.ws + WS_S5F) + ((((size_t)d * 64 + q) * 32 + g) * 64 + lane) * 2; F[0] = hr; F[1] = hi; }
    }
}
__device__ __forceinline__ void s5_task_corr(const Params& P, LAS unsigned char* wl, int lane, int e, int q, int g) {
    const bf16* proj = (const bf16*)(P.ws + WS_BIG); float* ybuf = (float*)(P.ws + WS_YBUF); bf16* mixout = (bf16*)(P.ws + WS_MIX);
    const int b = q >> 3, seg = q & 7, m0 = MCTX + b * LLAT + seg * 256;
    bf16x8 Cf[4]; s5_c_setup(P, e, g, lane, Cf);
    bf16x8 Bf[8];
#pragma unroll
    for (int i = 0; i < 8; ++i) Bf[i] = (bf16x8){0, 0, 0, 0, 0, 0, 0, 0};
    const float* Fb = (const float*)(P.ws + WS_S5F);
#pragma unroll 1
    for (int d = 0; d < 2; ++d) {
        float ar, ai; s5_dir_setup(P, e, d, g, lane, ar, ai, Bf, false);
        float pr = ar, pi = ai;
#pragma unroll
        for (int i = 0; i < 8; ++i) { const float nr = pr * pr - pi * pi, ni = 2.0f * pr * pi; pr = nr; pi = ni; }
        float hr = 0.f, hi = 0.f;
        const int cnt = d == 0 ? seg : 7 - seg;
        for (int i = 0; i < cnt; ++i) { const int sj = d == 0 ? i : 7 - i; const float* F = Fb + ((((size_t)d * 64 + b * 8 + sj) * 32 + g) * 64 + lane) * 2;
            const float nr = pr * hr - pi * hi + F[0], ni = pr * hi + pi * hr + F[1]; hr = nr; hi = ni; }
        const int ym = (d == 1 || seg == 7) ? 2 : 1;
        if (cnt > 0) s5_scan_seg(P, wl, lane, d, g, m0, ar, ai, Bf, Cf, hr, hi, 1, ym, proj, ybuf, mixout, 0.f);
    }
}

#ifndef REP_A
#define REP_A 1
#endif
#ifndef REP_B
#define REP_B 1
#endif
#ifndef REP_C
#define REP_C 1
#endif
__device__ __forceinline__ void phase_conv_even(int wid0, const Params& P, int e) {
    const int tid = tid_fresh(wid0), lane = tid & 63, wave = tid >> 6;
    const int gw = bid_fresh() * NWAVES + wave, NGW = grid_fresh() * NWAVES;
    bf16* proj = (bf16*)(P.ws + WS_BIG); const bf16* HALO = (const bf16*)(P.ws + WS_HALO);
    for (int it = gw; it < 384 * 24; it += NGW) {
        const int c = it / 24, cgp = it % 24, ccol = cgp * 64 + lane;
        const int r0 = c * 64;
        const bool lat = r0 >= MCTX; const int t0 = lat ? ((r0 - MCTX) & 2047) : (r0 & 255); const int L = lat ? LLAT : LCTX;
        bf16* base = proj + (size_t)r0 * NPROJ_E + 1024 + ccol;
        bf16 x[67];
#pragma unroll
        for (int i = 0; i < 64; ++i) x[i + 1] = base[(size_t)i * NPROJ_E];
        x[0] = (t0 > 0) ? HALO[((size_t)(c - 1) * 3 + 0) * 1536 + ccol] : (bf16)0;
        x[65] = (t0 + 64 < L) ? HALO[((size_t)(c + 1) * 3 + 1) * 1536 + ccol] : (bf16)0;
        x[66] = (t0 + 64 < L) ? HALO[((size_t)(c + 1) * 3 + 2) * 1536 + ccol] : (bf16)0;
        const float* cw = P.in[I_GCONVW] + (size_t)e * 4 * 1536 + ccol; const float w0 = cw[0], w1 = cw[1536], w2 = cw[3072], w3 = cw[4608], cb = P.in[I_GCONVB][e * 1536 + ccol];
#pragma unroll
        for (int i = 0; i < 64; ++i) { const float v = cb + w0 * bf2f(x[i]) + w1 * bf2f(x[i + 1]) + w2 * bf2f(x[i + 2]) + w3 * bf2f(x[i + 3]);
            base[(size_t)i * NPROJ_E] = (bf16)f2bf(siluf_(v)); }
    }
}
#define LDS_BARRIER() do { asm volatile("s_waitcnt lgkmcnt(0)" ::: "memory"); __builtin_amdgcn_s_barrier(); asm volatile("" ::: "memory"); } while (0)
constexpr int G_Q = 0, G_K = 17408, G_V = 34816, G_KT = 52224, G_LM = 70656, G_QK = 89088, G_ST = 98304, G_SM = 133120;
constexpr int P128 = 136, P64 = 72, LMP = 68;
__device__ __forceinline__ bf16x8 ld_split8(const LAS bf16* p) {
    const u32x2 a = *(const LAS u32x2*)p, b = *(const LAS u32x2*)(p + 16);
    return __builtin_bit_cast(bf16x8, (u32x4){a.x, a.y, b.x, b.y});
}
__device__ __forceinline__ bf16x8 pack_acc2(const f32x4& a, const f32x4& b) { return __builtin_bit_cast(bf16x8, (u32x4){pk2(a[0], a[1]), pk2(a[2], a[3]), pk2(b[0], b[1]), pk2(b[2], b[3])}); }
__device__ __forceinline__ void gdn_chain(int wid0, const Params& P, LAS unsigned char* lds, int e, int s, int hd, int dir) {
    const int tid = tid_fresh(wid0), lane = tid & 63, w = __builtin_amdgcn_readfirstlane(tid >> 6), quad = lane >> 4, l15 = lane & 15;
    const bool lat = s >= 32; const int b = lat ? s - 32 : s; const int L = lat ? LLAT : LCTX; const int m0 = lat ? MCTX + b * LLAT : s * LCTX;
    const bf16* proj = (const bf16*)(P.ws + WS_BIG); const float* AB = (const float*)(P.ws + WS_AB);
    bf16* Odir = (bf16*)(P.ws + WS_H) + (size_t)dir * MT * 512;
    int zv; asm volatile("v_mov_b32 %0, 0" : "=v"(zv));
    lds += zv;
    LAS bf16* Qs = (LAS bf16*)(lds + G_Q); LAS bf16* Ks = (LAS bf16*)(lds + G_K); LAS bf16* Vs = (LAS bf16*)(lds + G_V); LAS bf16* KT = (LAS bf16*)(lds + G_KT);
    LAS float* Lm = (LAS float*)(lds + G_LM); LAS bf16* VNT = (LAS bf16*)(lds + G_LM); LAS bf16* QKs = (LAS bf16*)(lds + G_QK); LAS bf16* ST = (LAS bf16*)(lds + G_ST);
    LAS bf16* TM = (LAS bf16*)(lds + G_ST); LAS bf16* TT = TM + 64 * P64; LAS bf16* LR = TT + 64 * P64;
    LAS float* rq = (LAS float*)(lds + G_SM); LAS float* rk = rq + 64; LAS float* gcs = rq + 128; LAS float* betas = rq + 192; LAS float* egs = rq + 256; LAS float* kes = rq + 320;
    f32x4 Sacc[8];
    const size_t sbase = ((((size_t)b * 2 + e) * 2 + dir) * 4 + hd) * 16384;
#pragma unroll
    for (int mt = 0; mt < 8; ++mt) Sacc[mt] = (f32x4){0.f, 0.f, 0.f, 0.f};
    if (lat) { const float* sp = P.in[I_SDELTA] + sbase + (size_t)(quad * 4) * 128 + 16 * w + l15;
#pragma unroll
        for (int mt = 0; mt < 8; ++mt)
#pragma unroll
            for (int jj = 0; jj < 4; ++jj) Sacc[mt][jj] = sp[(16 * mt + jj) * 128]; }
    for (int i = tid; i < 2 * 64 * P64 / 2; i += NTHR) ((LAS unsigned*)TM)[i] = 0u;
    const float alog_e = __expf(P.in[I_GALOG][(e * 2 + dir) * 4 + hd]), dtb = P.in[I_GDTB][(e * 2 + dir) * 4 + hd];
    const int nchunk = L / 64;
    u32x4 xr[6]; float ab_a = 0.f, ab_b = 0.f;
#define GDN_LOAD(ci_) do { const int tid_ = tid_fresh(wid0); const int c0_ = dir ? L - 64 * ((ci_) + 1) : 64 * (ci_); \
        _Pragma("unroll") for (int k = 0; k < 6; ++k) { const int p_ = tid_ + 512 * k, part_ = p_ >> 10, row_ = (p_ & 1023) >> 4, pc_ = p_ & 15; \
            xr[k] = *(const u32x4*)(proj + (size_t)(m0 + c0_ + row_) * NPROJ_E + 1024 + part_ * 512 + hd * 128 + pc_ * 8); } \
        if (w == 0) { const int ln_ = tid_ & 63; const size_t m_ = (size_t)(m0 + c0_ + (dir ? 63 - ln_ : ln_)); ab_a = AB[m_ * 16 + dir * 4 + hd]; ab_b = AB[m_ * 16 + 8 + dir * 4 + hd]; } } while (0)
    GDN_LOAD(0);
#pragma unroll 1
    for (int ci = 0; ci < nchunk; ++ci) {
        const int tid = tid_fresh(wid0), lane = tid & 63, quad = lane >> 4, l15 = lane & 15;
        const int c0 = dir ? L - 64 * (ci + 1) : 64 * ci;
        LDS_BARRIER();
#ifndef NO_A
        const float cur_a = ab_a, cur_b = ab_b;
#pragma unroll
        for (int k = 0; k < 6; ++k) { const int p_ = tid + 512 * k, part_ = p_ >> 10, row_ = (p_ & 1023) >> 4, pc_ = p_ & 15;
            LAS bf16* dst = part_ == 0 ? Qs : (part_ == 1 ? Ks : Vs);
            *(LAS u32x4*)(dst + (dir ? 63 - row_ : row_) * P128 + pc_ * 8) = xr[k]; }
        if (ci + 1 < nchunk) GDN_LOAD(ci + 1);
#endif
        LDS_BARRIER();
#pragma unroll 1
        for (int repB = 0; repB < REP_B; ++repB)
        { const int rowid = tid >> 2, part = tid & 3; LAS bf16* src = (rowid < 64 ? Qs : Ks) + (rowid & 63) * P128 + part * 32;
          float ss = 0.f;
#pragma unroll
          for (int i = 0; i < 4; ++i) { const u32x4 v = *(const LAS u32x4*)(src + 8 * i);
#pragma unroll
              for (int j = 0; j < 4; ++j) { const float a = bflo(v[j]), c = bfhi(v[j]); ss += a * a + c * c; } }
          ss += shfl_i(ss, lane ^ 1); ss += shfl_i(ss, lane ^ 2);
          if (part == 0) { if (rowid < 64) rq[rowid] = rsqrtf(ss + EPSF) * 0.08838834764831845f; else rk[rowid - 64] = rsqrtf(ss + EPSF); }
          if (w == 0) { const int t = c0 + (dir ? 63 - lane : lane); const size_t m = (size_t)(m0 + t);
              const float araw = cur_a, braw = cur_b;
              const float gg = -alog_e * softplusf_(araw + dtb);
              float gc = gg;
#pragma unroll
              for (int o = 1; o < 64; o <<= 1) { const float t2 = shfl_i(gc, (lane - o) & 63); if (lane >= o) gc += t2; }
              const float glast = shfl_i(gc, 63);
              gcs[lane] = gc; betas[lane] = sigmoidf_(braw); egs[lane] = __expf(gc); kes[lane] = __expf(glast - gc);
              if (lane == 0) rq[384] = __expf(glast); } }
        LDS_BARRIER();
#ifndef NO_C
#pragma unroll 1
        for (int repC = 0; repC < REP_C; ++repC)
        { const int mt = w & 3; const bool isq = w >= 4; LAS bf16* src = isq ? Qs : Ks;
          bf16x8 a[4];
#pragma unroll
          for (int ks = 0; ks < 4; ++ks) a[ks] = *(const LAS bf16x8*)(src + (16 * mt + l15) * P128 + 32 * ks + quad * 8);
#pragma unroll 1
          for (int nt = 0; nt < 4; ++nt) { f32x4 acc = (f32x4){0.f, 0.f, 0.f, 0.f};
#pragma unroll
              for (int ks = 0; ks < 4; ++ks) { const bf16x8 bb = *(const LAS bf16x8*)(Ks + (16 * nt + l15) * P128 + 32 * ks + quad * 8); acc = mfma16(a[ks], bb, acc); }
              const int j = 16 * nt + l15; const float rkj = rk[j], gcj = gcs[j];
              f32x4 lv;
#pragma unroll
              for (int jj = 0; jj < 4; ++jj) { const int i = 16 * mt + quad * 4 + jj; const float dec = __expf(fminf(gcs[i] - gcj, 0.f));
                  lv[jj] = (i > j) ? acc[jj] * rk[i] * rkj * betas[i] * dec : 0.f;
                  if (isq) QKs[i * P64 + j] = (bf16)f2bf((i >= j) ? acc[jj] * rq[i] * rkj * dec : 0.f); }
              if (!isq) { *(LAS f32x4*)(Lm + j * LMP + 16 * mt + quad * 4) = lv;
#pragma unroll
                  for (int jj = 0; jj < 4; ++jj) LR[(16 * mt + quad * 4 + jj) * P64 + j] = (bf16)f2bf(nt < mt ? lv[jj] : 0.f); } }
          const int dd = tid & 127, tq = tid >> 7;
          unsigned pw[8];
#pragma unroll
          for (int n = 0; n < 16; n += 2) { const int i0 = tq * 16 + n; const float v0 = bf2f(Ks[i0 * P128 + dd]) * rk[i0] * kes[i0], v1 = bf2f(Ks[(i0 + 1) * P128 + dd]) * rk[i0 + 1] * kes[i0 + 1]; pw[n >> 1] = pk2(v0, v1); }
          *(LAS u32x4*)(KT + dd * P64 + tq * 16) = (u32x4){pw[0], pw[1], pw[2], pw[3]};
          *(LAS u32x4*)(KT + dd * P64 + tq * 16 + 8) = (u32x4){pw[4], pw[5], pw[6], pw[7]}; }
#endif
        LDS_BARRIER();
        { const int i = tid >> 3, c0k = (tid & 7) * 16; const float sc = rk[i] * betas[i] * egs[i];
#pragma unroll
          for (int h2 = 0; h2 < 2; ++h2) { u32x4 v = *(LAS u32x4*)(Ks + i * P128 + c0k + 8 * h2);
#pragma unroll
              for (int q = 0; q < 4; ++q) v[q] = pk2(bflo(v[q]) * sc, bfhi(v[q]) * sc);
              *(LAS u32x4*)(Ks + i * P128 + c0k + 8 * h2) = v; } }
        if (w == 0) { const int bb = lane >> 4, c = lane & 15;
            float x[16];
#pragma unroll
            for (int r = 0; r < 16; ++r) x[r] = (r == c) ? 1.f : 0.f;
#pragma unroll
            for (int j = 0; j < 15; ++j) {
#pragma unroll
                for (int q4 = j / 4; q4 < 4; ++q4) { const f32x4 l4 = *(const LAS f32x4*)(Lm + (16 * bb + j) * LMP + 16 * bb + 4 * q4);
#pragma unroll
                    for (int jx = 0; jx < 4; ++jx) if (4 * q4 + jx > j) x[4 * q4 + jx] -= l4[jx] * x[j]; } }
            unsigned pw[8];
#pragma unroll
            for (int r = 0; r < 16; r += 2) { pw[r >> 1] = pk2(x[r], x[r + 1]); TM[(16 * bb + r) * P64 + 16 * bb + c] = (bf16)(pw[r >> 1] & 0xffffu); TM[(16 * bb + r + 1) * P64 + 16 * bb + c] = (bf16)(pw[r >> 1] >> 16); }
            *(LAS u32x4*)(TT + (16 * bb + c) * P64 + 16 * bb) = (u32x4){pw[0], pw[1], pw[2], pw[3]};
            *(LAS u32x4*)(TT + (16 * bb + c) * P64 + 16 * bb + 8) = (u32x4){pw[4], pw[5], pw[6], pw[7]}; }
        LDS_BARRIER();
#pragma unroll 1
        for (int lev = 1; lev < 4; ++lev) {
            if (w < 4 - lev) { const int bj = w, bi = w + lev;
                f32x4 m = (f32x4){0.f, 0.f, 0.f, 0.f};
#pragma unroll
                for (int ks = 0; ks < 2; ++ks) { const bf16x8 a = *(const LAS bf16x8*)(LR + (16 * bi + l15) * P64 + 32 * ks + quad * 8), bq = *(const LAS bf16x8*)(TT + (16 * bj + l15) * P64 + 32 * ks + quad * 8); m = mfma16(a, bq, m); }
                const u32x2 tl = *(const LAS u32x2*)(TM + (16 * bi + l15) * P64 + 16 * bi + quad * 4);
                const bf16x8 a2 = __builtin_bit_cast(bf16x8, (u32x4){tl.x, tl.y, 0u, 0u}), b2 = __builtin_bit_cast(bf16x8, (u32x4){pk2(m[0], m[1]), pk2(m[2], m[3]), 0u, 0u});
                const f32x4 t = mfma16(a2, b2, (f32x4){0.f, 0.f, 0.f, 0.f});
                const unsigned p0 = pk2(-t[0], -t[1]), p1 = pk2(-t[2], -t[3]);
                TM[(16 * bi + quad * 4 + 0) * P64 + 16 * bj + l15] = (bf16)(p0 & 0xffffu); TM[(16 * bi + quad * 4 + 1) * P64 + 16 * bj + l15] = (bf16)(p0 >> 16);
                TM[(16 * bi + quad * 4 + 2) * P64 + 16 * bj + l15] = (bf16)(p1 & 0xffffu); TM[(16 * bi + quad * 4 + 3) * P64 + 16 * bj + l15] = (bf16)(p1 >> 16);
                *(LAS u32x2*)(TT + (16 * bj + l15) * P64 + 16 * bi + quad * 4) = (u32x2){p0, p1}; }
            LDS_BARRIER();
        }
#ifndef NO_EFG
        bf16x8 Bst[4];
#pragma unroll
        for (int ks = 0; ks < 4; ++ks) Bst[ks] = pack_acc2(Sacc[2 * ks], Sacc[2 * ks + 1]);
        f32x4 vn[4];
#pragma unroll
        for (int mt = 0; mt < 4; ++mt) { f32x4 acc = (f32x4){0.f, 0.f, 0.f, 0.f};
#pragma unroll
            for (int ks = 0; ks < 4; ++ks) { const bf16x8 a = ld_split8(Ks + (16 * mt + l15) * P128 + 32 * ks + quad * 4); acc = mfma16(a, Bst[ks], acc); }
#pragma unroll
            for (int jj = 0; jj < 4; ++jj) { const int i = 16 * mt + quad * 4 + jj; vn[mt][jj] = bf2f(Vs[i * P128 + 16 * w + l15]) * betas[i] - acc[jj]; } }
        bf16x8 Bvn[2];
#pragma unroll
        for (int k2 = 0; k2 < 2; ++k2) Bvn[k2] = pack_acc2(vn[2 * k2], vn[2 * k2 + 1]);
#pragma unroll
        for (int mt = 0; mt < 4; ++mt) { f32x4 acc = (f32x4){0.f, 0.f, 0.f, 0.f};
#pragma unroll
            for (int k2 = 0; k2 < 2; ++k2) { const bf16x8 a = ld_split8(TM + (16 * mt + l15) * P64 + 32 * k2 + quad * 4); acc = mfma16(a, Bvn[k2], acc); }
            vn[mt] = acc; }
#pragma unroll
        for (int k2 = 0; k2 < 2; ++k2) Bvn[k2] = pack_acc2(vn[2 * k2], vn[2 * k2 + 1]);
#pragma unroll 1
        for (int mt = 0; mt < 4; ++mt) { f32x4 acc = (f32x4){0.f, 0.f, 0.f, 0.f};
#pragma unroll
            for (int ks = 0; ks < 4; ++ks) { const bf16x8 a = ld_split8(Qs + (16 * mt + l15) * P128 + 32 * ks + quad * 4); acc = mfma16(a, Bst[ks], acc); }
#pragma unroll
            for (int jj = 0; jj < 4; ++jj) { const int i = 16 * mt + quad * 4 + jj; acc[jj] *= rq[i] * egs[i]; }
#pragma unroll
            for (int k2 = 0; k2 < 2; ++k2) { const bf16x8 a = ld_split8(QKs + (16 * mt + l15) * P64 + 32 * k2 + quad * 4); acc = mfma16(a, Bvn[k2], acc); }
#pragma unroll
            for (int jj = 0; jj < 4; ++jj) { const int i = 16 * mt + quad * 4 + jj; const int t = c0 + (dir ? 63 - i : i);
                Odir[(size_t)(m0 + t) * 512 + hd * 128 + 16 * w + l15] = (bf16)f2bf(acc[jj]); } }
        const float egl = rq[384];
#pragma unroll
        for (int mt = 0; mt < 8; ++mt) { f32x4 acc = Sacc[mt] * egl;
#pragma unroll
            for (int k2 = 0; k2 < 2; ++k2) { const bf16x8 a = ld_split8(KT + (16 * mt + l15) * P64 + 32 * k2 + quad * 4); acc = mfma16(a, Bvn[k2], acc); }
            Sacc[mt] = acc; }
#endif
        WAVE_SYNC();
    }
    if (!lat) { const int tid2 = tid_fresh(wid0), lane2 = tid2 & 63; float* dp = P.out + OUT_DELTA + sbase + (size_t)((lane2 >> 4) * 4) * 128 + 16 * w + (lane2 & 15);
#pragma unroll
        for (int mt = 0; mt < 8; ++mt)
#pragma unroll
            for (int jj = 0; jj < 4; ++jj) dp[(16 * mt + jj) * 128] = Sacc[mt][jj];
    }
    __syncthreads();
}

__device__ __forceinline__ void phase_mix_even(int wid0, const Params& P, LAS unsigned char* lds, int e, int mode = 3) {
    const int bid = bid_fresh(), G = grid_fresh();
    if (G == 256) {
        if (bid < 64) { const int s = 32 + (bid >> 3), hd = (bid >> 1) & 3, dir = bid & 1; if (mode & 1) gdn_chain(wid0, P, lds, e, s, hd, dir); }
        else { const int bb = bid - 64;
            if (mode & 1) for (int c = bb; c < 256; c += 192) { const int s = c >> 3, hd = (c >> 1) & 3, dir = c & 1; gdn_chain(wid0, P, lds, e, s, hd, dir); }
            if (mode & 2) { const int tid = tid_fresh(wid0), lane = tid & 63, wave = tid >> 6;
                for (int t = bb; t < 384; t += 192) { const int wt = t * 8 + wave; s5_task_main(P, lds + wave * S5_WLDS, lane, e, wt >> 5, wt & 31); } }
            if (mode == 3) { __syncthreads(); const int tid = tid_fresh(wid0), lane = tid & 63, wave = tid >> 6;
                for (int it = bb * NWAVES + wave; it < WITEMS_ODD; it += 192 * NWAVES) weight_item(P, (LAS float*)(lds + wave * 16384), 2 * e + 1, it, lane); } }
    } else {
        for (int c = bid; c < 320; c += G) { const int s = c < 64 ? 32 + (c >> 3) : ((c - 64) >> 3), hd = (c >> 1) & 3, dir = c & 1; gdn_chain(wid0, P, lds, e, s, hd, dir); }
        const int tid = tid_fresh(wid0), lane = tid & 63, wave = tid >> 6;
        for (int t = bid; t < 384; t += G) { const int wt = t * 8 + wave; s5_task_main(P, lds + wave * S5_WLDS, lane, e, wt >> 5, wt & 31); }
        __syncthreads();
        for (int it = bid * NWAVES + wave; it < WITEMS_ODD; it += G * NWAVES) weight_item(P, (LAS float*)(lds + wave * 16384), 2 * e + 1, it, lane);
    }
}
__device__ __forceinline__ void phase_fin_even(int wid0, const Params& P, LAS unsigned char* lds, int e) {
    const int tid = tid_fresh(wid0), lane = tid & 63, wave = tid >> 6;
    const int gw = bid_fresh() * NWAVES + wave, NGW = grid_fresh() * NWAVES;
    for (int wt = gw; wt < 2048; wt += NGW) s5_task_corr(P, lds + wave * S5_WLDS, lane, e, wt >> 5, wt & 31);
    const bf16* proj = (const bf16*)(P.ws + WS_BIG); const bf16* Of = (const bf16*)(P.ws + WS_H); const bf16* Ob = Of + (size_t)MT * 512; bf16* mixout = (bf16*)(P.ws + WS_MIX);
    for (int mb2 = gw; mb2 < MT; mb2 += 2 * NGW) {
        u32x4 a[2], bq[2], z[2];
#pragma unroll
        for (int u = 0; u < 2; ++u) { const int m = mb2 + u * NGW; if (m < MT) { a[u] = *(const u32x4*)(Of + (size_t)m * 512 + lane * 8); bq[u] = *(const u32x4*)(Ob + (size_t)m * 512 + lane * 8); z[u] = *(const u32x4*)(proj + (size_t)m * NPROJ_E + 2560 + lane * 8); } }
#pragma unroll
        for (int u = 0; u < 2; ++u) { const int m = mb2 + u * NGW; if (m < MT) {
            float o[8]; float ss = 0.f;
#pragma unroll
            for (int j = 0; j < 4; ++j) { o[2 * j] = bflo(a[u][j]) + bflo(bq[u][j]); o[2 * j + 1] = bfhi(a[u][j]) + bfhi(bq[u][j]); ss += o[2 * j] * o[2 * j] + o[2 * j + 1] * o[2 * j + 1]; }
            ss += shfl_i(ss, lane ^ 1); ss += shfl_i(ss, lane ^ 2); ss += shfl_i(ss, lane ^ 4); ss += shfl_i(ss, lane ^ 8);
            const float rs = rsqrtf(ss * (1.0f / 128.0f) + EPSF);
            const float* gn = P.in[I_GONORM] + e * 128 + (lane & 15) * 8;
            unsigned pw[4];
#pragma unroll
            for (int j = 0; j < 4; ++j) { const float z0 = bflo(z[u][j]), z1 = bfhi(z[u][j]); pw[j] = pk2(o[2 * j] * rs * gn[2 * j] * siluf_(z0), o[2 * j + 1] * rs * gn[2 * j + 1] * siluf_(z1)); }
            *(u32x4*)(mixout + (size_t)m * DM + 512 + lane * 8) = (u32x4){pw[0], pw[1], pw[2], pw[3]}; } }
    }
}

__device__ __forceinline__ void phase_conv_odd(int wid0, const Params& P, int o) {
    const int tid = tid_fresh(wid0), lane = tid & 63, wave = tid >> 6;
    const int gw = bid_fresh() * NWAVES + wave, NGW = grid_fresh() * NWAVES;
    const bf16* proj = (const bf16*)(P.ws + WS_BIG); bf16* cx = (bf16*)(P.ws + WS_H);
    const float* cw = P.in[I_LCONVW] + (size_t)o * 4 * 1024; const float* cb = P.in[I_LCONVB] + o * 1024;
    for (int m = gw; m < MT; m += NGW) {
        const int t = m < MCTX ? (m & 255) : ((m - MCTX) & 2047); const int L = m < MCTX ? LCTX : LLAT;
#pragma unroll
        for (int h2 = 0; h2 < 2; ++h2) { const int ch = lane * 8 + 512 * h2;
            float acc[8];
#pragma unroll
            for (int j = 0; j < 8; ++j) acc[j] = cb[ch + j];
#pragma unroll
            for (int k = 0; k < 4; ++k) { const int tt = t - 1 + k; if (tt >= 0 && tt < L) { const u32x4 v = *(const u32x4*)(proj + (size_t)(m - 1 + k) * 2048 + ch);
#pragma unroll
                    for (int j = 0; j < 4; ++j) { acc[2 * j] += cw[k * 1024 + ch + 2 * j] * bflo(v[j]); acc[2 * j + 1] += cw[k * 1024 + ch + 2 * j + 1] * bfhi(v[j]); } } }
            *(u32x4*)(cx + (size_t)m * DM + ch) = (u32x4){pk2(acc[0], acc[1]), pk2(acc[2], acc[3]), pk2(acc[4], acc[5]), pk2(acc[6], acc[7])}; }
    }
}
__device__ __forceinline__ void phase_lru_scan(int wid0, const Params& P, LAS unsigned char* lds, int o, int d) {
    const int tid = tid_fresh(wid0), lane = tid & 63, wave = tid >> 6;
    const int gw = bid_fresh() * NWAVES + wave, NGW = grid_fresh() * NWAVES;
    const unsigned* G = (const unsigned*)(P.ws + WS_GATES); const bf16* proj = (const bf16*)(P.ws + WS_BIG); bf16* mixout = (bf16*)(P.ws + WS_MIX);
    const int Gn = NGW / NWAVES, vw = wave * Gn + (gw / NWAVES);
    if (d == 0 && o == 0 && NGW > 640) {
        for (int it = vw - 640; it >= 0 && it < WITEMS_EVEN; it += NGW - 640) weight_item(P, (LAS float*)(lds + wave * 16384), 2, it, lane); }
    for (int task = vw; task < 640; task += NGW) {
        int s, cg_;
        if (task < 128) { s = 32 + (task >> 4); cg_ = task & 15; } else { s = (task - 128) >> 4; cg_ = (task - 128) & 15; }
        const bool lat = s >= 32; const int b = lat ? s - 32 : s; const int L = lat ? LLAT : LCTX; const int m0 = lat ? MCTX + b * LLAT : s * LCTX;
        const int ch = cg_ * 64 + lane;
        float h = lat ? P.in[I_SLRU][(((size_t)b * 2 + o) * 2 + d) * 1024 + ch] : 0.f;
        if (d == 0) {
            unsigned ga[32], gb[32];
#define LRU_LD0(dst, tt) _Pragma("unroll") for (int i = 0; i < 32; ++i) dst[i] = G[(size_t)(m0 + (tt) + i) * DM + ch]
#define LRU_CP0(src, tt) _Pragma("unroll") for (int i = 0; i < 32; ++i) { h = __builtin_amdgcn_exp2f(bflo(src[i])) * h + bfhi(src[i]); mixout[(size_t)(m0 + (tt) + i) * DM + ch] = (bf16)f2bf(h); }
            LRU_LD0(ga, 0);
            for (int t0 = 0; t0 < L; t0 += 64) {
                LRU_LD0(gb, t0 + 32);
                LRU_CP0(ga, t0);
                if (t0 + 64 < L) { LRU_LD0(ga, t0 + 64); }
                LRU_CP0(gb, t0 + 32);
            }
        } else {
            unsigned ga[16], gb[16]; bf16 pa[16], pb[16], ya[16], yb[16];
#define LRU_LD1(g_, p_, y_, tt) _Pragma("unroll") for (int i = 0; i < 16; ++i) { const size_t m = (size_t)(m0 + L - 1 - ((tt) + i)); g_[i] = G[m * DM + ch]; p_[i] = mixout[m * DM + ch]; y_[i] = proj[m * 2048 + 1024 + ch]; }
#define LRU_CP1(g_, p_, y_, tt) _Pragma("unroll") for (int i = 0; i < 16; ++i) { const size_t m = (size_t)(m0 + L - 1 - ((tt) + i)); \
                h = __builtin_amdgcn_exp2f(bflo(g_[i])) * h + bfhi(g_[i]); mixout[m * DM + ch] = (bf16)f2bf((bf2f(p_[i]) + h) * geluf_(bf2f(y_[i]))); }
            LRU_LD1(ga, pa, ya, 0);
            for (int t0 = 0; t0 < L; t0 += 32) {
                LRU_LD1(gb, pb, yb, t0 + 16);
                LRU_CP1(ga, pa, ya, t0);
                if (t0 + 32 < L) { LRU_LD1(ga, pa, ya, t0 + 32); }
                LRU_CP1(gb, pb, yb, t0 + 16);
            }
        }
        if (!lat) P.out[OUT_LRU + (((size_t)b * 2 + o) * 2 + d) * 1024 + ch] = h;
    }
}
#ifdef PROBE_DUP_GEMM
#define DUPG(x) GSYNC(); x
#else
#define DUPG(x)
#endif
typedef const __attribute__((address_space(4))) Params* KParams;
__device__ __forceinline__ Params load_params(KParams q) { Params r;
#pragma unroll
    for (int i = 0; i < 40; ++i) r.in[i] = q->in[i];
    r.out = q->out; r.ws = q->ws; return r; }
#define FRESH() const int G = grid_fresh(), bid = bid_fresh(); (void)G; (void)bid; KParams pk_ = (KParams)__builtin_amdgcn_kernarg_segment_ptr(); asm volatile("" : "+s"(pk_)); const Params P = load_params(pk_); unsigned char* ws = P.ws; \
    const float* mod = (const float*)(ws + WS_MOD); bf16* H = (bf16*)(ws + WS_H); bf16* BIG = (bf16*)(ws + WS_BIG); bf16* MIX = (bf16*)(ws + WS_MIX); (void)mod; (void)H; (void)BIG; (void)MIX;
#define GSYNC() do { KParams pb_ = (KParams)__builtin_amdgcn_kernarg_segment_ptr(); asm volatile("" : "+s"(pb_)); xcd_barrier(wid0, (unsigned*)(pb_->ws + WS_BAR), lds); } while (0)
__global__ void __launch_bounds__(NTHR, 2) fwd_kernel(Params Parg) {
    extern __shared__ __attribute__((aligned(16))) unsigned char lds_raw[];
    LAS unsigned char* lds = (LAS unsigned char*)lds_raw;
    cg::grid_group grid = cg::this_grid();
    const int wid0 = __builtin_amdgcn_readfirstlane(threadIdx.x >> 6);
    if (threadIdx.x < 4) ((LAS unsigned*)(lds + LDS_BARST))[threadIdx.x] = 0u;
    __syncthreads();
    if (threadIdx.x == 0) (void)xb_add((unsigned*)(Parg.ws + WS_BAR) + XB_XCNT(xb_xcc_id()), 1u);

    { FRESH(); phase_prologue(wid0, P, lds); }
    if (grid_fresh() == 0) grid.sync();
    GSYNC();
#ifdef PROBE_DUP_PRO
    { FRESH(); phase_prologue(wid0, P, lds); }
    GSYNC();
#endif
    { FRESH(); phase_modreduce(wid0, P); }
    GSYNC();
#ifdef PROBE_SYNC
#pragma unroll 1
    for (int i = 0; i < 40; ++i) GSYNC();
#endif
#pragma unroll 1
    for (int l = 0; l < 4; ++l) {
        { FRESH(); const float* modl = mod + (size_t)l * 9 * 6144;
        phase_rownorm(wid0, P, l == 0, MIX, modl - 9 * 6144, 5 * 1024, P.in[I_NMLPPOST] + (l > 0 ? (l - 1) * 1024 : 0), 1, P.in[I_NMIXPRE] + l * 1024, modl, 0, H); }
        GSYNC();
        const int eo = l >> 1;
        {
            FRESH();
            pg8::Gemm g; pg8::StaticOrder S; EpiBf16<0> E;
            if ((l & 1) == 0) { g = pg8::Gemm{H, (const bf16*)(ws + WS_WINE) + (size_t)eo * NB_E * 1024, MT, NB_E, 1024, 1024, 0, 0, 1024, 0}; E = EpiBf16<0>{BIG, NPROJ_E, (float*)(ws + WS_AB), (bf16*)(ws + WS_HALO)}; }
            else { g = pg8::Gemm{H, (const bf16*)(ws + WS_WINO) + (size_t)eo * 2048 * 1024, MT, 2048, 1024, 1024, 0, 0, 1024, 0}; E = EpiBf16<0>{BIG, 2048, nullptr, nullptr}; }
            S.init(g.M, g.N, G, bid);
            pg8::gemm_phase(wid0, lds, g, S, E); DUPG(pg8::gemm_phase(wid0, lds, g, S, E);)
        }
        GSYNC();
        if ((l & 1) == 0) {
            { FRESH(); phase_conv_even(wid0, P, eo); }
            GSYNC();
#ifdef PROBE_DUP_MIX
#pragma unroll 1
            for (int rep = 0; rep < 2; ++rep) { { FRESH(); phase_mix_even(wid0, P, lds, eo, rep == 0 ? 3 : PROBE_DUP_MIX); } GSYNC(); }
#else
            { FRESH(); phase_mix_even(wid0, P, lds, eo); }
            GSYNC();
#endif
            { FRESH(); phase_fin_even(wid0, P, lds, eo); }
            GSYNC();
        } else {
            { FRESH(); phase_conv_odd(wid0, P, eo); }
            GSYNC();
#ifdef PROBE_DUP_CONV
            { FRESH(); phase_conv_odd(wid0, P, eo); }
            GSYNC();
#endif
#pragma unroll 1
            for (int d = 0; d < 2; ++d) {
                { FRESH();
                pg8::Gemm g{H, (const bf16*)(ws + WS_WG) + (size_t)(eo * 2 + d) * 2048 * 256, MT, 2048, 256, 1024, 1, 1, 256, 0};
                EpiGates E{(unsigned*)(ws + WS_GATES), H, P.in[I_LBR] + (eo * 2 + d) * 1024, P.in[I_LBI] + (eo * 2 + d) * 1024, P.in[I_LLAM] + (eo * 2 + d) * 1024};
                pg8::StaticOrder S; S.init(g.M, g.N, G, bid);
                pg8::gemm_phase(wid0, lds, g, S, E); DUPG(pg8::gemm_phase(wid0, lds, g, S, E);) }
                GSYNC();
                { FRESH(); phase_lru_scan(wid0, P, lds, eo, d); }
#ifdef PROBE_DUP_LRU0
                if (d == 0) { GSYNC(); FRESH(); phase_lru_scan(wid0, P, lds, eo, d); }
#endif
                GSYNC();
            }
        }
        {
            FRESH();
            pg8::Gemm g{MIX, (const bf16*)(ws + ((l & 1) ? WS_WOUTO : WS_WOUTE)) + (size_t)eo * 1024 * 1024, MT, 1024, 1024, 1024, 0, 0, 1024, 0};
            EpiBf16<0> E{BIG, 1024, nullptr, nullptr}; pg8::StaticOrder S; S.init(g.M, g.N, G, bid);
            pg8::gemm_phase(wid0, lds, g, S, E); DUPG(pg8::gemm_phase(wid0, lds, g, S, E);)
        }
        GSYNC();
        { FRESH(); const float* modl = mod + (size_t)l * 9 * 6144;
        phase_rownorm(wid0, P, 0, BIG, modl, 2 * 1024, P.in[I_NMIXPOST] + l * 1024, 1, P.in[I_NMLPPRE] + l * 1024, modl, 3 * 1024, H); }
        GSYNC();
        {
            FRESH();
            pg8::Gemm g{H, (const bf16*)(ws + WS_W1T) + (size_t)l * 4096 * 1024, MT, 4096, 1024, 1024, 0, 0, 1024, 0};
            EpiBf16<1> E{BIG, 4096, nullptr, nullptr}; pg8::StaticOrder S; S.init(g.M, g.N, G, bid);
            pg8::gemm_phase(wid0, lds, g, S, E); DUPG(pg8::gemm_phase(wid0, lds, g, S, E);)
        }
        GSYNC();
        {
            FRESH();
            pg8::Gemm g{BIG, (const bf16*)(ws + WS_W2T) + (size_t)l * 1024 * 4096, MT, 1024, 4096, 4096, 0, 0, 4096, 0};
            EpiBf16<0> E{MIX, 1024, nullptr, nullptr}; pg8::StaticOrder S; S.init(g.M, g.N, G, bid);
            pg8::gemm_phase(wid0, lds, g, S, E); DUPG(pg8::gemm_phase(wid0, lds, g, S, E);)
        }
        GSYNC();
    }
    { FRESH();
    phase_rownorm(wid0, P, 0, MIX, mod + (size_t)3 * 9 * 6144, 5 * 1024, P.in[I_NMLPPOST] + 3 * 1024, 0, P.in[I_NMIXPRE], mod, 0, H); }
}

extern "C" void kernel_launch(void* const* d_in, const int* in_sizes, int n_in, void* d_out, int out_size, void* d_ws, size_t ws_size, hipStream_t stream) {
    static int grid = 0;
    if (grid == 0) {
        if (n_in != 40 || ws_size < WS_END) { fprintf(stderr, "kernel_launch: expected 40 inputs and >= %zu bytes of workspace (got %d, %zu)\n", (size_t)WS_END, n_in, ws_size); grid = -1; return; }
        int dev = 0, cus = 0, per_cu = 0;
        if (hipGetDevice(&dev) != hipSuccess || hipDeviceGetAttribute(&cus, hipDeviceAttributeMultiprocessorCount, dev) != hipSuccess) { grid = -1; return; }
        if (hipFuncSetAttribute((const void*)fwd_kernel, hipFuncAttributeMaxDynamicSharedMemorySize, LDS_BYTES) != hipSuccess) { fprintf(stderr, "kernel_launch: hipFuncSetAttribute failed\n"); grid = -1; return; }
        if (hipOccupancyMaxActiveBlocksPerMultiprocessor(&per_cu, (const void*)fwd_kernel, NTHR, LDS_BYTES) != hipSuccess || per_cu < 1) per_cu = 1;
        (void)hipGetLastError();
        grid = cus * per_cu; if (grid > 256) grid = 256;
    }
    if (grid < 0) return;
    (void)hipMemsetAsync((char*)d_ws + WS_BAR, 0, 16384, stream);
    Params p{};
    for (int i = 0; i < 40; ++i) p.in[i] = (const float*)d_in[i];
    p.out = (float*)d_out; p.ws = (unsigned char*)d_ws;
    void* args[] = {&p};
    hipError_t e = hipLaunchCooperativeKernel((const void*)fwd_kernel, dim3(grid), dim3(NTHR), args, LDS_BYTES, stream);
    if (e != hipSuccess) fprintf(stderr, "cooperative launch failed: %s (grid %d)\n", hipGetErrorString(e), grid);
}
```

```cpp
#include <hip/hip_runtime.h>
#include <hip/hip_cooperative_groups.h>
#include <cstdio>
#include <cstdint>
namespace cg = cooperative_groups;
__device__ __forceinline__ int bid_fresh() { int t = blockIdx.x; asm volatile("" : "+s"(t)); return t; }
__device__ __forceinline__ int grid_fresh() { int t = gridDim.x; asm volatile("" : "+s"(t)); return t; }
__device__ __forceinline__ int tid_fresh(int w) { asm volatile("" : "+s"(w)); int l; asm volatile("v_mbcnt_lo_u32_b32 %0, -1, 0\n\tv_mbcnt_hi_u32_b32 %0, -1, %0" : "=v"(l)); return w * 64 + l; }

namespace pg8 {
#define PG8_LAS __attribute__((address_space(3)))
typedef unsigned short bf16_t;
typedef short bf16x8 __attribute__((ext_vector_type(8)));
typedef float f32x4 __attribute__((ext_vector_type(4)));
typedef unsigned u32x4 __attribute__((ext_vector_type(4)));
typedef unsigned u32x2 __attribute__((ext_vector_type(2)));
constexpr int BM = 256, BK = 64, HALF = 128, HTB = HALF * BK * 2, STAGE_BYTES = 8 * HTB, NXCD = 8, WGM = 8;

__host__ __device__ __forceinline__ int lds_byte(int r, int c) { const int st = (r >> 4) * 2 + (c >> 5), rr = r & 15, cc = c & 31, ob = rr * 64 + cc * 2; return st * 1024 + (ob ^ (((ob >> 9) & 1) << 5)); }
__host__ __device__ __forceinline__ void stage_rc(int b, int& R, int& C) { const int st = b / 1024, sb = b % 1024, swz = sb ^ (((sb >> 9) & 1) << 5); R = (st >> 1) * 16 + swz / 64; C = (st & 1) * 32 + (swz % 64) / 2; }
__host__ __device__ __forceinline__ int perm32(int rho) { const int n = rho >> 4, i = rho & 15; return 8 * (i >> 2) + 4 * n + (i & 3); }

struct Unit { int pm, pn; };
struct Gemm { const bf16_t* A; const bf16_t* Bt; int M, N, K, lda, ablk, ashift, ldb, ksplit; };

struct StaticOrder {
    int nM, nN, nwg, G, c;
    __host__ __device__ void init(int M, int N, int G_, int c_) { nM = M / BM; nN = N / BM; nwg = nM * nN; G = G_; c = c_; }
    __host__ __device__ bool next(int i, Unit& u) const {
        const long L = (long)i * G + c; if (L >= nwg) return false;
        int wgid = (int)L; { const int q = nwg / NXCD, r = nwg % NXCD, xcd = wgid % NXCD, off = wgid / NXCD; wgid = (xcd < r ? xcd * (q + 1) : r * (q + 1) + (xcd - r) * q) + off; }
        const int nig = WGM * nN, gid = wgid / nig, fm = gid * WGM, gsz = (nM - fm) < WGM ? (nM - fm) : WGM;
        u.pm = fm + ((wgid % nig) % gsz); u.pn = (wgid % nig) / gsz; return true;
    }
};
__device__ __forceinline__ unsigned cvt_pk_bf16(float lo, float hi) { unsigned r; asm volatile("v_cvt_pk_bf16_f32 %0, %1, %2" : "=v"(r) : "v"(lo), "v"(hi)); return r; }

template <class Epi>
__device__ __forceinline__ void gemm_phase(int wid0, PG8_LAS unsigned char* lds, const Gemm g, const StaticOrder& S, const Epi& E) {
    const int tid = tid_fresh(wid0), wid = __builtin_amdgcn_readfirstlane(tid >> 6), lane = tid & 63, wr = wid >> 2, wc = wid & 3, fr = lane & 15, fq = lane >> 4;
    const int K = g.K, nt = K / BK, lda = g.lda, ldb = g.ldb;
    unsigned voffA[2], voffB[2];
#pragma unroll
    for (int i = 0; i < 2; ++i) { int R, C; stage_rc(tid * 16 + i * 8192, R, C); const int Rb = (R & ~31) + perm32(R & 31);
        voffA[i] = (unsigned)(R * lda + C) * 2u; voffB[i] = (unsigned)(Rb * ldb + C) * 2u; }
    const size_t kstep = (size_t)(BK * 2);
    const size_t hstepA = (size_t)HALF * lda * 2, hstepB = (size_t)HALF * ldb * 2;
    const size_t tstepA = 2 * hstepA, tstepB = 2 * hstepB;
    const unsigned ldsw = (unsigned)wid * 1024u;
    const int aoff = lds_byte(wr * 64 + fr, fq * 8), boff = lds_byte(wc * 32 + fr, fq * 8);
#define PG8_ACOL(pn) (g.ablk ? (size_t)((((pn) >> g.ashift) & 3) * 512) : (g.ksplit ? (size_t)((pn) & 1) * (size_t)K * 2 : (size_t)0))
#define PG8_BOFF(pn) (g.ksplit ? (size_t)((pn) >> 1) * tstepB + (size_t)((pn) & 1) * (size_t)K * 2 : (size_t)(pn) * tstepB)
#define PG8_SA(b, h) (((b) * 2 + (h)) * HTB)
#define PG8_SB(b, h) ((4 + (b) * 2 + (h)) * HTB)
#define PG8_STAGE(bufoff, gbase, voff) do { _Pragma("unroll") for (int _i = 0; _i < 2; ++_i) \
        __builtin_amdgcn_global_load_lds((const unsigned*)((const char*)(gbase) + (voff)[_i]), (PG8_LAS unsigned*)(lds + (bufoff) + ldsw + _i * 8192), 16, 0, 0); } while (0)
#define PG8_LDA(dst, b, h) do { _Pragma("unroll") for (int m = 0; m < 4; ++m) _Pragma("unroll") for (int k = 0; k < 2; ++k) dst[m][k] = *(const PG8_LAS bf16x8*)(lds + PG8_SA(b, h) + aoff + m * 2048 + k * 1024); } while (0)
#define PG8_LDB(dst, b, h) do { _Pragma("unroll") for (int n = 0; n < 2; ++n) _Pragma("unroll") for (int k = 0; k < 2; ++k) dst[n][k] = *(const PG8_LAS bf16x8*)(lds + PG8_SB(b, h) + boff + n * 2048 + k * 1024); } while (0)
#define PG8_MMA(ai, bj, At, Bt) do { __builtin_amdgcn_s_setprio(1); _Pragma("unroll") for (int m = 0; m < 4; ++m) _Pragma("unroll") for (int n = 0; n < 2; ++n) _Pragma("unroll") for (int k = 0; k < 2; ++k) \
        acc[ai][bj][m][n] = __builtin_amdgcn_mfma_f32_16x16x32_bf16(Bt[n][k], At[m][k], acc[ai][bj][m][n], 0, 0, 0); __builtin_amdgcn_s_setprio(0); } while (0)
#define PG8_WAIT_V(n) asm volatile("s_waitcnt vmcnt(" #n ")" ::: "memory")
#define PG8_WAIT_L(n) asm volatile("s_waitcnt lgkmcnt(" #n ")" ::: "memory")
#define PG8_BAR __builtin_amdgcn_s_barrier()
#define PG8_SCHED __builtin_amdgcn_sched_barrier(0)
    Unit cur, nxt; int ui = 0;
    if (!S.next(0, cur)) return;
    f32x4 acc[2][2][4][2];
#pragma unroll
    for (int a = 0; a < 2; ++a)
#pragma unroll
        for (int b = 0; b < 2; ++b)
#pragma unroll
            for (int m = 0; m < 4; ++m)
#pragma unroll
                for (int n = 0; n < 2; ++n) acc[a][b][m][n] = (f32x4){0.f, 0.f, 0.f, 0.f};
    bf16x8 At[4][2], B0[2][2], B1[2][2];
    const char* cA = (const char*)g.A + (size_t)cur.pm * tstepA + PG8_ACOL(cur.pn); const char* cB = (const char*)g.Bt + PG8_BOFF(cur.pn);
    PG8_STAGE(PG8_SB(0, 0), cB, voffB); PG8_STAGE(PG8_SA(0, 0), cA, voffA); PG8_STAGE(PG8_SB(0, 1), cB + hstepB, voffB); PG8_STAGE(PG8_SA(0, 1), cA + hstepA, voffA);
    if (wr == 1) PG8_BAR;
    PG8_WAIT_V(4); PG8_BAR;
    PG8_STAGE(PG8_SB(1, 0), cB + kstep, voffB); PG8_STAGE(PG8_SA(1, 0), cA + kstep, voffA); PG8_STAGE(PG8_SB(1, 1), cB + hstepB + kstep, voffB);
    PG8_WAIT_V(6); PG8_BAR;
    for (;;) {
        const bool has_next = S.next(ui + 1, nxt);
        const char* nA = has_next ? (const char*)g.A + (size_t)nxt.pm * tstepA + PG8_ACOL(nxt.pn) : cA; const char* nB = has_next ? (const char*)g.Bt + PG8_BOFF(nxt.pn) : cB;
        for (int t = 0; t < nt; t += 2) {
            const bool last = (t == nt - 2);
            const char* a1 = cA + (size_t)(t + 1) * kstep;
            const char* a2 = last ? nA : cA + (size_t)(t + 2) * kstep; const char* b2 = last ? nB : cB + (size_t)(t + 2) * kstep;
            const char* a3 = a2 + kstep; const char* b3 = b2 + kstep;
            PG8_LDB(B0, 0, 0); PG8_SCHED; PG8_LDA(At, 0, 0); PG8_STAGE(PG8_SA(1, 1), a1 + hstepA, voffA);
            PG8_WAIT_L(8); PG8_BAR; PG8_WAIT_L(0); PG8_MMA(0, 0, At, B0); PG8_BAR; PG8_SCHED;
            PG8_LDB(B1, 0, 1); PG8_STAGE(PG8_SB(0, 0), b2, voffB);
            PG8_BAR; PG8_WAIT_L(0); PG8_MMA(0, 1, At, B1); PG8_BAR;
            PG8_LDA(At, 0, 1); PG8_STAGE(PG8_SA(0, 0), a2, voffA);
            PG8_BAR; PG8_WAIT_L(0); PG8_MMA(1, 0, At, B0); PG8_BAR; PG8_SCHED;
            PG8_STAGE(PG8_SB(0, 1), b2 + hstepB, voffB);
            PG8_WAIT_V(6); PG8_BAR; PG8_MMA(1, 1, At, B1); PG8_BAR;
            PG8_LDB(B0, 1, 0); PG8_SCHED; PG8_LDA(At, 1, 0); PG8_STAGE(PG8_SA(0, 1), a2 + hstepA, voffA);
            PG8_WAIT_L(8); PG8_BAR; PG8_WAIT_L(0); PG8_MMA(0, 0, At, B0); PG8_BAR; PG8_SCHED;
            PG8_LDB(B1, 1, 1); PG8_STAGE(PG8_SB(1, 0), b3, voffB);
            PG8_BAR; PG8_WAIT_L(0); PG8_MMA(0, 1, At, B1); PG8_BAR;
            PG8_LDA(At, 1, 1); PG8_STAGE(PG8_SA(1, 0), a3, voffA);
            PG8_BAR; PG8_WAIT_L(0); PG8_MMA(1, 0, At, B0); PG8_BAR; PG8_SCHED;
            PG8_STAGE(PG8_SB(1, 1), b3 + hstepB, voffB);
            PG8_WAIT_V(6); PG8_BAR; PG8_MMA(1, 1, At, B1); PG8_BAR;
        }
        E(acc, cur, wr, wc, fr, fq);
        if (!has_next) break;
#pragma unroll
        for (int a = 0; a < 2; ++a)
#pragma unroll
            for (int b = 0; b < 2; ++b)
#pragma unroll
                for (int m = 0; m < 4; ++m)
#pragma unroll
                    for (int n = 0; n < 2; ++n) acc[a][b][m][n] = (f32x4){0.f, 0.f, 0.f, 0.f};
        cur = nxt; cA = nA; cB = nB; ++ui;
    }
    PG8_WAIT_V(0);
    if (wr == 0) PG8_BAR;
    PG8_BAR;
#undef PG8_ACOL
#undef PG8_BOFF
#undef PG8_SA
#undef PG8_SB
#undef PG8_STAGE
#undef PG8_LDA
#undef PG8_LDB
#undef PG8_MMA
#undef PG8_WAIT_V
#undef PG8_WAIT_L
#undef PG8_BAR
#undef PG8_SCHED
}
}
#define LAS __attribute__((address_space(3)))
typedef unsigned short bf16;
typedef short bf16x8 __attribute__((ext_vector_type(8)));
typedef float f32x4 __attribute__((ext_vector_type(4)));
typedef unsigned u32x4 __attribute__((ext_vector_type(4)));
typedef unsigned u32x2 __attribute__((ext_vector_type(2)));
constexpr int DM = 1024, MT = 24576, MCTX = 8192, LCTX = 256, LLAT = 2048, NWAVES = 8, NTHR = 512;
constexpr int NPROJ_E = 3072, NB_E = 3328, IN_EVEN_LD = 3088;
constexpr float EPSF = 1e-6f;
constexpr size_t MiB = 1u << 20;
constexpr size_t WS_MOD = 0, MOD_BYTES = 4 * 9 * 6144 * 4, WS_S5F = 1 * MiB, WS_AB = 3 * MiB, WS_W1T = 5 * MiB, WS_W2T = 37 * MiB, WS_WINE = 69 * MiB,
                 WS_WOUTE = 82 * MiB, WS_WINO = 86 * MiB, WS_WOUTO = 94 * MiB, WS_WG = 98 * MiB, WS_H = 102 * MiB, WS_BIG = 150 * MiB, WS_YBUF = 294 * MiB,
                 WS_GATES = 246 * MiB, WS_MIX = 342 * MiB, WS_HALO = 390 * MiB, WS_END = 390 * MiB + 384 * 3 * 1536 * 2;
constexpr int LDS_BYTES = 147456;
constexpr size_t OUT_S5RE = 25165824, OUT_S5IM = OUT_S5RE + 262144, OUT_DELTA = OUT_S5IM + 262144, OUT_LRU = OUT_DELTA + 8388608;

struct Params { const float* in[40]; float* out; unsigned char* ws; };
enum { I_XP = 0, I_XS, I_S5RE, I_S5IM, I_SDELTA, I_SLRU, I_C, I_CCTX, I_WADA, I_BADA, I_NMIXPRE, I_NMIXPOST, I_NMLPPRE, I_NMLPPOST, I_WMLPIN, I_WMLPOUT, I_WINE, I_WOUTE,
       I_LAMRE, I_LAMIM, I_LOGDT, I_BRE, I_BIM, I_CRE, I_CIM, I_S5D, I_GCONVW, I_GCONVB, I_GALOG, I_GDTB, I_GONORM, I_WINO, I_WOUTO, I_LCONVW, I_LCONVB, I_LWR, I_LBR, I_LWI, I_LBI, I_LLAM };

typedef __bf16 bf2_t __attribute__((ext_vector_type(2)));
typedef float f2_t __attribute__((ext_vector_type(2)));
__device__ __forceinline__ unsigned pk2(float lo, float hi) { const bf2_t v = __builtin_convertvector((f2_t){lo, hi}, bf2_t); return __builtin_bit_cast(unsigned, v); }
__device__ __forceinline__ unsigned f2bf(float f) { return pk2(f, f) & 0xffffu; }
__device__ __forceinline__ float bflo(unsigned w) { return __builtin_bit_cast(float, w << 16); }
__device__ __forceinline__ float bfhi(unsigned w) { return __builtin_bit_cast(float, w & 0xffff0000u); }
__device__ __forceinline__ float bf2f(bf16 b) { return __builtin_bit_cast(float, (unsigned)b << 16); }
__device__ __forceinline__ float sigmoidf_(float x) { return __builtin_amdgcn_rcpf(1.0f + __expf(-x)); }
__device__ __forceinline__ float siluf_(float x) { return x * sigmoidf_(x); }
__device__ __forceinline__ float softplusf_(float x) { return fmaxf(x, 0.f) + __logf(1.0f + __expf(-fabsf(x))); }
__device__ __forceinline__ float geluf_(float x) { const float y = 0.7978845608028654f * (x + 0.044715f * x * x * x); const float t = 1.0f - 2.0f * __builtin_amdgcn_rcpf(__expf(2.0f * y) + 1.0f); return 0.5f * x * (1.0f + t); }
__device__ __forceinline__ float shfl_i(float v, int srclane) { return __builtin_bit_cast(float, __builtin_amdgcn_ds_bpermute(srclane << 2, __builtin_bit_cast(int, v))); }
__device__ __forceinline__ float wave_sum(float v, int lane) {
#pragma unroll
    for (int o = 1; o < 64; o <<= 1) v += shfl_i(v, lane ^ o);
    return v;
}
#define LDS_WAIT() asm volatile("s_waitcnt lgkmcnt(0)" ::: "memory")
#define WAVE_SYNC() do { asm volatile("s_waitcnt lgkmcnt(0)" ::: "memory"); __builtin_amdgcn_wave_barrier(); } while (0)
__device__ __forceinline__ f32x4 mfma16(bf16x8 a, bf16x8 b, f32x4 c) { return __builtin_amdgcn_mfma_f32_16x16x32_bf16(a, b, c, 0, 0, 0); }


#define XB_TMO      128
#define XB_XCNT(j)  (256  + 64 * (j))
#define XB_XSUB(j)  (1280 + 64 * (j))
#define XB_XGEN(j)  (2304 + 64 * (j))
#define XB_TOP      3328
#define XB_TOPGEN   3392
#define XCD_BAR_WORDS 3456
#define XB_SPIN_CAP (1u << 18)
constexpr size_t WS_BAR = 960 * 1024; constexpr int LDS_BARST = LDS_BYTES - 16;
__device__ __forceinline__ unsigned xb_ld(unsigned* p)              { return __hip_atomic_load(p, __ATOMIC_RELAXED, __HIP_MEMORY_SCOPE_AGENT); }
__device__ __forceinline__ unsigned xb_add(unsigned* p, unsigned v) { return __hip_atomic_fetch_add(p, v, __ATOMIC_RELAXED, __HIP_MEMORY_SCOPE_AGENT); }
__device__ __forceinline__ unsigned xb_xcc_id() { return (unsigned)__builtin_amdgcn_s_getreg((3 << 11) | 20) & 0xFu; }
#define XB_SPIN(cond, bar) do { unsigned _sp = 0; while (cond) { __builtin_amdgcn_s_sleep(1); \
    if ((++_sp & 255u) == 0u) { if (xb_ld(&(bar)[XB_TMO])) break; if (_sp > XB_SPIN_CAP) { atomicAdd(&(bar)[XB_TMO], 1u); break; } } } } while (0)
__device__ __forceinline__ void xcd_barrier_complete(unsigned* bar, unsigned x, unsigned& nloc, unsigned& nx) {
    const unsigned G = gridDim.x;
    unsigned sum, cnt, mine, sp = 0u;
    for (;;) {
        sum = 0u; cnt = 0u; mine = 0u;
#pragma unroll
        for (unsigned j = 0; j < 16; ++j) { const unsigned c = xb_ld(&bar[XB_XCNT(j)]); sum += c; cnt += (c > 0u) ? 1u : 0u; mine = (j == x) ? c : mine; }
        if (sum == G) break;
        __builtin_amdgcn_s_sleep(1);
        if ((++sp & 255u) == 0u) { if (xb_ld(&bar[XB_TMO])) break; if (sp > XB_SPIN_CAP) { atomicAdd(&bar[XB_TMO], 1u); break; } }
    }
    nloc = mine > 0u ? mine : 1u; nx = cnt > 0u ? cnt : 1u;
}
__device__ __forceinline__ void xcd_barrier(int wid0, unsigned* bar, LAS unsigned char* lds) {
    const int tid = tid_fresh(wid0);
    asm volatile("s_waitcnt vmcnt(0)" ::: "memory");
    __syncthreads();
    if (tid == 0) {
        const unsigned x = xb_xcc_id();
        volatile LAS unsigned* st = (volatile LAS unsigned*)(lds + LDS_BARST);
        __builtin_amdgcn_s_waitcnt(0);
        unsigned nloc = st[0], nx = st[1];
        if (nloc == 0u) { xcd_barrier_complete(bar, x, nloc, nx); st[0] = nloc; st[1] = nx; }
        const unsigned old = xb_add(&bar[XB_XSUB(x)], 1u);
        const unsigned gen = old / nloc;
        if (old + 1u == (gen + 1u) * nloc) {
            __builtin_amdgcn_fence(__ATOMIC_RELEASE, "agent");
            asm volatile("s_waitcnt vmcnt(0)" ::: "memory");
            const unsigned og = xb_add(&bar[XB_TOP], 1u);
            const unsigned tg = og / nx;
            if (og + 1u == (tg + 1u) * nx) xb_add(&bar[XB_TOPGEN], 1u);
            else XB_SPIN(xb_ld(&bar[XB_TOPGEN]) == tg, bar);
            __builtin_amdgcn_fence(__ATOMIC_ACQUIRE, "agent");
            xb_add(&bar[XB_XGEN(x)], 1u);
            asm volatile("s_waitcnt vmcnt(0)" ::: "memory");
        } else {
            XB_SPIN(xb_ld(&bar[XB_XGEN(x)]) == gen, bar);
            __builtin_amdgcn_fence(__ATOMIC_ACQUIRE, "agent");
            asm volatile("s_waitcnt vmcnt(0)" ::: "memory");
        }
    }
    __syncthreads();
}
__device__ __forceinline__ void transpose_item(const float* W, int ldw, int nvalid, int K, bf16* WT, int dst_row0, LAS float* scr, int k0, int n0, int lane) {
    const int nn = n0 + (lane & 31); const bool ok = nn < nvalid;
#pragma unroll 8
    for (int i = 0; i < 32; ++i) { const int kk = 2 * i + (lane >> 5); scr[kk * 33 + (lane & 31)] = ok ? W[(size_t)(k0 + kk) * ldw + nn] : 0.f; }
    WAVE_SYNC();
    const int c = lane & 7;
#pragma unroll
    for (int j = 0; j < 4; ++j) { const int n = (lane >> 3) + 8 * j; const LAS float* s = scr + (8 * c) * 33 + n;
        u32x4 o; o.x = pk2(s[0 * 33], s[1 * 33]); o.y = pk2(s[2 * 33], s[3 * 33]); o.z = pk2(s[4 * 33], s[5 * 33]); o.w = pk2(s[6 * 33], s[7 * 33]);
        *(u32x4*)(WT + (size_t)(dst_row0 + n) * K + k0 + 8 * c) = o; }
    WAVE_SYNC();
}
constexpr int WITEMS_EVEN = 4096 + 1552 + 512, WITEMS_ODD = 4096 + 1024 + 512 + 512;
__device__ __forceinline__ void weight_item(const Params& P, LAS float* scr, int l, int r, int lane) {
    unsigned char* ws = P.ws; const int eo = l >> 1;
    if (r < 2048) { const int q = r; transpose_item(P.in[I_WMLPIN] + (size_t)l * 1024 * 4096, 4096, 4096, 1024, (bf16*)(ws + WS_W1T) + (size_t)l * 4096 * 1024, 32 * (q & 127), scr, 64 * (q >> 7), 32 * (q & 127), lane); return; } r -= 2048;
    if (r < 2048) { const int q = r; transpose_item(P.in[I_WMLPOUT] + (size_t)l * 4096 * 1024, 1024, 1024, 4096, (bf16*)(ws + WS_W2T) + (size_t)l * 1024 * 4096, 32 * (q & 31), scr, 64 * (q >> 5), 32 * (q & 31), lane); return; } r -= 2048;
    if ((l & 1) == 0) {
        if (r < 1552) { const int kb = r / 97, nb = r % 97; transpose_item(P.in[I_WINE] + (size_t)eo * 1024 * IN_EVEN_LD, IN_EVEN_LD, IN_EVEN_LD, 1024, (bf16*)(ws + WS_WINE) + (size_t)eo * NB_E * 1024, 32 * nb, scr, 64 * kb, 32 * nb, lane); return; } r -= 1552;
        { const int q = r; transpose_item(P.in[I_WOUTE] + (size_t)eo * 1024 * 1024, 1024, 1024, 1024, (bf16*)(ws + WS_WOUTE) + (size_t)eo * 1024 * 1024, 32 * (q & 31), scr, 64 * (q >> 5), 32 * (q & 31), lane); return; }
    } else {
        if (r < 1024) { const int q = r; transpose_item(P.in[I_WINO] + (size_t)eo * 1024 * 2048, 2048, 2048, 1024, (bf16*)(ws + WS_WINO) + (size_t)eo * 2048 * 1024, 32 * (q & 63), scr, 64 * (q >> 6), 32 * (q & 63), lane); return; } r -= 1024;
        if (r < 512) { const int q = r; transpose_item(P.in[I_WOUTO] + (size_t)eo * 1024 * 1024, 1024, 1024, 1024, (bf16*)(ws + WS_WOUTO) + (size_t)eo * 1024 * 1024, 32 * (q & 31), scr, 64 * (q >> 5), 32 * (q & 31), lane); return; } r -= 512;
        { const int mat = eo * 16 + (r >> 5), q = r & 31, kb = q >> 3, nb = q & 7; const int blk = mat & 3, gate = (mat >> 2) & 1, od = mat >> 3;
          const float* src = (gate ? P.in[I_LWI] : P.in[I_LWR]) + (size_t)(od * 4 + blk) * 65536;
          const int j0 = nb * 32; const int drow = (blk * 2 + (j0 >> 7)) * 256 + gate * 128 + (j0 & 127);
          transpose_item(src, 256, 256, 256, (bf16*)(ws + WS_WG) + (size_t)od * 2048 * 256, drow, scr, 64 * kb, j0, lane); return; }
    }
}
__device__ __forceinline__ void phase_prologue(int wid0, const Params& P, LAS unsigned char* lds) {
    const int tid = tid_fresh(wid0), lane = tid & 63, wave = tid >> 6;
    LAS float* scr = (LAS float*)(lds + wave * 16384);
    const int gw = bid_fresh() * NWAVES + wave, NGW = grid_fresh() * NWAVES;
    unsigned char* ws = P.ws;
    constexpr int NTR = WITEMS_EVEN, NMOD = 4 * 24 * 16;
    for (int it = gw; it < NTR + NMOD; it += NGW) {
        int r = it;
        if (r < NTR) { weight_item(P, scr, 0, r, lane); continue; } r -= NTR;
        {
            const int l = r / 384, rem = r % 384, ec = rem >> 4, ks = rem & 15, k0 = ks * 64;
#pragma unroll
            for (int rr = 0; rr < 9; ++rr) { const float cv = rr == 0 ? P.in[I_CCTX][k0 + lane] : P.in[I_C][(rr - 1) * 1024 + k0 + lane]; scr[rr * 64 + lane] = siluf_(cv); }
            WAVE_SYNC();
            f32x4 acc[9];
#pragma unroll
            for (int rr = 0; rr < 9; ++rr) acc[rr] = (f32x4){0.f, 0.f, 0.f, 0.f};
            const float* wp = P.in[I_WADA] + ((size_t)l * 1024 + k0) * 6144 + ec * 256 + lane * 4;
#pragma unroll 4
            for (int kk = 0; kk < 64; ++kk) { const f32x4 w4 = *(const f32x4*)(wp + (size_t)kk * 6144);
#pragma unroll
                for (int rr = 0; rr < 9; ++rr) acc[rr] += w4 * scr[rr * 64 + kk]; }
            float* part = (float*)(ws + WS_BIG) + ((size_t)(ks * 4 + l) * 9) * 6144 + ec * 256 + lane * 4;
#pragma unroll
            for (int rr = 0; rr < 9; ++rr) *(f32x4*)(part + (size_t)rr * 6144) = acc[rr];
            WAVE_SYNC();
        }
    }
    { const size_t per = (size_t)(NB_E - 3104) * 1024 * 2 / 16;
      for (size_t i = (size_t)bid_fresh() * NTHR + tid; i < 2 * per; i += (size_t)grid_fresh() * NTHR) { const size_t e = i / per, q = i % per;
          *(u32x4*)(ws + WS_WINE + (e * NB_E + 3104) * 1024 * 2 + q * 16) = (u32x4){0u, 0u, 0u, 0u}; } }
}
__device__ __forceinline__ void phase_modreduce(int wid0, const Params& P) {
    const int tid = tid_fresh(wid0);
    const float* part = (const float*)(P.ws + WS_BIG); float* mod = (float*)(P.ws + WS_MOD);
    for (int i = bid_fresh() * NTHR + tid; i < 4 * 9 * 6144 / 4; i += grid_fresh() * NTHR) {
        const int l = i / (9 * 1536), e4 = i % 1536;
        f32x4 a = *(const f32x4*)(P.in[I_BADA] + (size_t)l * 6144 + e4 * 4);
#pragma unroll
        for (int ks = 0; ks < 16; ++ks) a += *(const f32x4*)(part + (size_t)ks * 4 * 9 * 6144 + (size_t)i * 4);
        *(f32x4*)(mod + (size_t)i * 4) = a; }
}
__device__ __forceinline__ void phase_rownorm(int wid0, const Params& P, int first, const bf16* obuf, const float* modg, int goff, const float* gpost, int has_next, const float* gpre, const float* mods, int soff, bf16* H, float gscale = 1.0f) {
    const int tid = tid_fresh(wid0), lane = tid & 63, wave = tid >> 6;
    const int gw = bid_fresh() * NWAVES + wave, NGW = grid_fresh() * NWAVES;
    float* X = P.out;
    f32x4 xn[4]; u32x2 on[4];
#define RN_LOAD(mm) do { const int m_ = (mm); const float* xs_ = first ? (m_ < MCTX ? P.in[I_XP] + (size_t)m_ * DM : P.in[I_XS] + (size_t)(m_ - MCTX) * DM) : X + (size_t)m_ * DM; \
        _Pragma("unroll") for (int j = 0; j < 4; ++j) { xn[j] = *(const f32x4*)(xs_ + lane * 4 + 256 * j); if (!first) on[j] = *(const u32x2*)(obuf + (size_t)m_ * DM + lane * 4 + 256 * j); } } while (0)
    if (gw < MT) RN_LOAD(gw);
    for (int m = gw; m < MT; m += NGW) {
        const int modrow = m < MCTX ? 0 : 1 + ((m - MCTX) >> 11);
        const float* mr = modg + (size_t)modrow * 6144; const float* ms = mods + (size_t)modrow * 6144;
        f32x4 x[4]; u32x2 ov[4];
#pragma unroll
        for (int j = 0; j < 4; ++j) { x[j] = xn[j]; ov[j] = on[j]; }
        if (m + NGW < MT) RN_LOAD(m + NGW);
        if (first) {
            if (m >= MCTX) {
                const int t = (m - MCTX) & 2047; const float prow = (float)(t >> 6), pcol = (float)(t & 63);
                f32x4 om;
#pragma unroll
                for (int e = 0; e < 4; ++e) om[e] = exp2f(-(float)(lane * 4 + e) * (13.287712379549449f / 256.0f));
#pragma unroll
                for (int j = 0; j < 4; ++j) {
#pragma unroll
                    for (int e = 0; e < 4; ++e) { const float a = (j < 2 ? prow : pcol) * om[e]; x[j][e] += (j & 1) ? cosf(a) : sinf(a); } }
            }
        } else {
            float ss = 0.f;
#pragma unroll
            for (int j = 0; j < 4; ++j) { const float a = bflo(ov[j].x), b = bfhi(ov[j].x), c = bflo(ov[j].y), d = bfhi(ov[j].y); ss += (a * a + b * b) + (c * c + d * d); }
            const float rs = rsqrtf(wave_sum(ss, lane) * (1.0f / DM) + EPSF);
#pragma unroll
            for (int j = 0; j < 4; ++j) { const f32x4 g4 = *(const f32x4*)(gpost + lane * 4 + 256 * j), gt = *(const f32x4*)(mr + goff + lane * 4 + 256 * j);
                f32x4 o4 = (f32x4){bflo(ov[j].x), bfhi(ov[j].x), bflo(ov[j].y), bfhi(ov[j].y)};
                x[j] += gt * (o4 * (rs * gscale) * g4); }
        }
#pragma unroll
        for (int j = 0; j < 4; ++j) *(f32x4*)(X + (size_t)m * DM + lane * 4 + 256 * j) = x[j];
        if (has_next) {
            float ss = 0.f;
#pragma unroll
            for (int j = 0; j < 4; ++j) ss += (x[j][0] * x[j][0] + x[j][1] * x[j][1]) + (x[j][2] * x[j][2] + x[j][3] * x[j][3]);
            const float rs = rsqrtf(wave_sum(ss, lane) * (1.0f / DM) + EPSF);
#pragma unroll
            for (int j = 0; j < 4; ++j) { const f32x4 g4 = *(const f32x4*)(gpre + lane * 4 + 256 * j), sh = *(const f32x4*)(ms + soff + lane * 4 + 256 * j), sc = *(const f32x4*)(ms + soff + 1024 + lane * 4 + 256 * j);
                const f32x4 h4 = (x[j] * rs * g4) * (sc + 1.0f) + sh;
                u32x2 w; w.x = pk2(h4[0], h4[1]); w.y = pk2(h4[2], h4[3]);
                *(u32x2*)(H + (size_t)m * DM + lane * 4 + 256 * j) = w; }
        }
    }
}

using pg8::Unit;
template <int ACT  > struct EpiBf16 {
    bf16* O; int ldc; float* AB;
    bf16* HALO;
    __device__ __forceinline__ void operator()(const f32x4 (&acc)[2][2][4][2], const Unit& u, int wr, int wc, int fr, int fq) const {
        const int row0 = u.pm * 256 + wr * 64 + fr, col0 = u.pn * 256 + wc * 32 + 8 * fq;
        if (AB && u.pn * 256 >= ldc) {
            if (wc == 0 && fq < 2) {
#pragma unroll
                for (int ai = 0; ai < 2; ++ai)
#pragma unroll
                    for (int m = 0; m < 4; ++m) { float* p = AB + (size_t)(row0 + ai * 128 + m * 16) * 16 + 8 * fq; *(f32x4*)p = acc[ai][0][m][0]; *(f32x4*)(p + 4) = acc[ai][0][m][1]; }
            }
            return;
        }
#pragma unroll
        for (int ai = 0; ai < 2; ++ai)
#pragma unroll
            for (int m = 0; m < 4; ++m) { bf16* rowp = O + (size_t)(row0 + ai * 128 + m * 16) * ldc + col0;
#pragma unroll
                for (int bj = 0; bj < 2; ++bj) { f32x4 v0 = acc[ai][bj][m][0], v1 = acc[ai][bj][m][1];
                    if (ACT == 1) {
#pragma unroll
                        for (int j = 0; j < 4; ++j) { const float a = fmaxf(v0[j], 0.f), b = fmaxf(v1[j], 0.f); v0[j] = a * a; v1[j] = b * b; } }
                    u32x4 w; w.x = pk2(v0[0], v0[1]); w.y = pk2(v0[2], v0[3]); w.z = pk2(v1[0], v1[1]); w.w = pk2(v1[2], v1[3]);
                    *(u32x4*)(rowp + bj * 128) = w;
                    if (ACT == 0 && HALO && u.pn >= 4 && u.pn < 10 && ((m == 3 && fr == 15) || (m == 0 && fr < 2))) {
                        const int r = row0 + ai * 128 + m * 16; const int which = (m == 3) ? 0 : 1 + fr;
                        *(u32x4*)(HALO + ((size_t)(r >> 6) * 3 + which) * 1536 + (col0 + bj * 128 - 1024)) = w; } } }
    }
};
struct EpiSplit {
    bf16* O0; long stride;
    __device__ __forceinline__ void operator()(const f32x4 (&acc)[2][2][4][2], const Unit& u, int wr, int wc, int fr, int fq) const {
        const int row0 = u.pm * 256 + wr * 64 + fr, col0 = (u.pn >> 1) * 256 + wc * 32 + 8 * fq; bf16* O = O0 + (long)(u.pn & 1) * stride;
#pragma unroll
        for (int ai = 0; ai < 2; ++ai)
#pragma unroll
            for (int m = 0; m < 4; ++m) { bf16* rowp = O + (size_t)(row0 + ai * 128 + m * 16) * DM + col0;
#pragma unroll
                for (int bj = 0; bj < 2; ++bj) { const f32x4 v0 = acc[ai][bj][m][0], v1 = acc[ai][bj][m][1];
                    u32x4 w; w.x = pk2(v0[0], v0[1]); w.y = pk2(v0[2], v0[3]); w.z = pk2(v1[0], v1[1]); w.w = pk2(v1[2], v1[3]);
                    *(u32x4*)(rowp + bj * 128) = w; } }
    }
};
struct EpiGates {
    unsigned* G; const bf16* X; const float* br; const float* bi; const float* lam;
    __device__ __forceinline__ void operator()(const f32x4 (&acc)[2][2][4][2], const Unit& u, int wr, int wc, int fr, int fq) const {
        const int row0 = u.pm * 256 + wr * 64 + fr, ch0 = u.pn * 128 + wc * 32 + 8 * fq;
#pragma unroll
        for (int n = 0; n < 2; ++n) {
            const f32x4 vbr = *(const f32x4*)(br + ch0 + 4 * n), vbi = *(const f32x4*)(bi + ch0 + 4 * n), l4 = *(const f32x4*)(lam + ch0 + 4 * n);
            f32x4 vsp;
#pragma unroll
            for (int e = 0; e < 4; ++e) vsp[e] = -8.0f * softplusf_(-l4[e]);
#pragma unroll
            for (int ai = 0; ai < 2; ++ai)
#pragma unroll
                for (int m = 0; m < 4; ++m) { const size_t row = (size_t)(row0 + ai * 128 + m * 16);
                    const u32x2 xv = *(const u32x2*)(X + row * DM + ch0 + 4 * n);
                    const float xs[4] = {bflo(xv.x), bfhi(xv.x), bflo(xv.y), bfhi(xv.y)};
                    u32x4 w;
#pragma unroll
                    for (int e = 0; e < 4; ++e) { const float r = sigmoidf_(acc[ai][0][m][n][e] + vbr[e]), ig = sigmoidf_(acc[ai][1][m][n][e] + vbi[e]);
                        const float la = r * vsp[e]; const float a_ = __expf(la); const float b = __builtin_amdgcn_sqrtf(fmaxf(1.0f - a_ * a_, 0.f)) * ig * xs[e];
                        w[e] = pk2(1.0f - a_, b); }
                    *(u32x4*)(G + row * DM + ch0 + 4 * n) = w; }
        }
    }
};
constexpr int S5_WLDS = 12800, BU_P = 132, HS_P = 136;
struct S5Dir { float ar, ai; bf16x8 Bf[8]; };
__device__ __forceinline__ void s5_dir_setup(const Params& P, int e, int d, int g, int lane, float& ar, float& ai, bf16x8 (&Bf)[8], bool needB) {
    const int quad = lane >> 4, l15 = lane & 15;
    const float dt = __expf(P.in[I_LOGDT][(e * 2 + d) * 32 + g]);
    const float lr = P.in[I_LAMRE][((e * 2 + d) * 32 + g) * 64 + lane], li = P.in[I_LAMIM][((e * 2 + d) * 32 + g) * 64 + lane];
    const float mag = expf(lr * dt); ar = mag * cosf(li * dt); ai = mag * sinf(li * dt);
    const float den = lr * lr + li * li;
    const float fr = ((ar - 1.0f) * lr + ai * li) / den, fi = (ai * lr - (ar - 1.0f) * li) / den;
    if (needB) {
#pragma unroll
        for (int nt = 0; nt < 8; ++nt) { const int col = 16 * nt + l15, p = col & 63;
            const float frp = shfl_i(fr, p), fip = shfl_i(fi, p);
            bf16x8 v = (bf16x8){0, 0, 0, 0, 0, 0, 0, 0};
            if (quad < 2) { const float* bre = P.in[I_BRE] + ((size_t)(e * 32 + g) * 64 + p) * 16 + quad * 8; const float* bim = P.in[I_BIM] + ((size_t)(e * 32 + g) * 64 + p) * 16 + quad * 8;
#pragma unroll
                for (int j = 0; j < 8; ++j) { const float br = bre[j], bi = bim[j]; const float val = (nt < 4) ? (frp * br - fip * bi) : (frp * bi + fip * br); v[j] = (short)f2bf(val); } }
            Bf[nt] = v; }
    }
}
__device__ __forceinline__ void s5_c_setup(const Params& P, int e, int g, int lane, bf16x8 (&Cf)[4]) {
    const int quad = lane >> 4, l15 = lane & 15;
#pragma unroll
    for (int ks = 0; ks < 4; ++ks) { const int col0 = 32 * ks + quad * 8; const bool im = col0 >= 64;
        const float* src = (im ? P.in[I_CIM] : P.in[I_CRE]) + ((size_t)(e * 32 + g) * 16 + l15) * 64 + (col0 & 63);
        bf16x8 v;
#pragma unroll
        for (int j = 0; j < 8; ++j) v[j] = (short)f2bf(im ? -src[j] : src[j]);
        Cf[ks] = v; }
}
__device__ __forceinline__ void s5_scan_seg(const Params& P, LAS unsigned char* wl, int lane, int d, int g, int m0, float ar, float ai, const bf16x8 (&Bf)[8], const bf16x8 (&Cf)[4],
                                            float& hr, float& hi, int mode, int ymode, const bf16* proj, float* ybuf, bf16* mixout, float dsk, int dry = 0) {
    const int quad = lane >> 4, l15 = lane & 15;
    LAS float* BU = (LAS float*)wl; LAS bf16* HS = (LAS bf16*)(wl + 8448);
    const int ch = g * 16 + l15;
    bf16x8 a_next = (bf16x8){0, 0, 0, 0, 0, 0, 0, 0};
    if (mode == 0 && quad < 2) { const int blk0 = d ? 15 : 0; const int tt = d ? 15 - l15 : l15; a_next = *(const bf16x8*)(proj + (size_t)(m0 + 16 * blk0 + tt) * NPROJ_E + g * 16 + quad * 8); }
    for (int bi_ = 0; bi_ < 16; ++bi_) {
        const int blk = d ? 15 - bi_ : bi_;
        const int mb = m0 + 16 * blk;
        const bf16x8 a = a_next;
        if (mode == 0 && quad < 2 && bi_ + 1 < 16) { const int blkn = d ? 14 - bi_ : bi_ + 1; const int tt = d ? 15 - l15 : l15; a_next = *(const bf16x8*)(proj + (size_t)(m0 + 16 * blkn + tt) * NPROJ_E + g * 16 + quad * 8); }
        float pre[4], zz[4];
#pragma unroll
        for (int jj = 0; jj < 4; ++jj) { const int row = quad * 4 + jj; const int tt = d ? 15 - row : row; const size_t m = (size_t)(mb + tt);
            pre[jj] = (ymode == 0) ? dsk * bf2f(proj[m * NPROJ_E + ch]) : ybuf[m * 512 + ch];
            zz[jj] = (ymode == 2) ? bf2f(proj[m * NPROJ_E + 512 + ch]) : 0.f; }
        if (mode == 0) {
#pragma unroll
            for (int nt = 0; nt < 8; ++nt) { f32x4 acc = mfma16(a, Bf[nt], (f32x4){0.f, 0.f, 0.f, 0.f});
#pragma unroll
                for (int jj = 0; jj < 4; ++jj) BU[(quad * 4 + jj) * BU_P + 16 * nt + l15] = acc[jj]; }
            WAVE_SYNC();
        }
#pragma unroll
        for (int r = 0; r < 16; ++r) {
            float br = 0.f, bim = 0.f;
            if (mode == 0) { br = BU[r * BU_P + lane]; bim = BU[r * BU_P + 64 + lane]; }
            const float nr = ar * hr - ai * hi + br, ni = ar * hi + ai * hr + bim; hr = nr; hi = ni;
            HS[r * HS_P + lane] = (bf16)f2bf(hr); HS[r * HS_P + 64 + lane] = (bf16)f2bf(hi);
        }
        WAVE_SYNC();
        f32x4 y = (f32x4){0.f, 0.f, 0.f, 0.f};
#pragma unroll
        for (int ks = 0; ks < 4; ++ks) { const bf16x8 af = *(const LAS bf16x8*)(HS + l15 * HS_P + 32 * ks + quad * 8); y = mfma16(af, Cf[ks], y); }
#pragma unroll
        for (int jj = 0; jj < 4; ++jj) { const int row = quad * 4 + jj; const int tt = d ? 15 - row : row; const size_t m = (size_t)(mb + tt);
            const float v = y[jj] + pre[jj];
            if (!dry) { if (ymode != 2) ybuf[m * 512 + ch] = v;
            else mixout[m * DM + ch] = (bf16)f2bf(geluf_(v) * sigmoidf_(zz[jj])); }
        }
        WAVE_SYNC();
    }
}
__device__ __forceinline__ void s5_task_main(const Params& P, LAS unsigned char* wl, int lane, int e, int sub, int g) {
    const bf16* proj = (const bf16*)(P.ws + WS_BIG); float* ybuf = (float*)(P.ws + WS_YBUF); bf16* mixout = (bf16*)(P.ws + WS_MIX);
    const bool lat = sub >= 32; const int q = sub - 32, b = lat ? (q >> 3) : sub, seg = lat ? (q & 7) : 0;
    const int m0 = lat ? MCTX + b * LLAT + seg * 256 : sub * 256;
    bf16x8 Cf[4]; s5_c_setup(P, e, g, lane, Cf);
    const float dsk = P.in[I_S5D][e * 512 + g * 16 + (lane & 15)];
#pragma unroll 1
    for (int d = 0; d < 2; ++d) {
        float ar, ai; bf16x8 Bf[8]; s5_dir_setup(P, e, d, g, lane, ar, ai, Bf, true);
        float hr = 0.f, hi = 0.f;
        if (lat && ((d == 0 && seg == 0) || (d == 1 && seg == 7))) { const size_t si = ((((size_t)b * 2 + e) * 2 + d) * 32 + g) * 64 + lane; hr = P.in[I_S5RE][si]; hi = P.in[I_S5IM][si]; }
        const int ymode = d == 0 ? 0 : (lat ? 1 : 2);
        s5_scan_seg(P, wl, lane, d, g, m0, ar, ai, Bf, Cf, hr, hi, 0, ymode, proj, ybuf, mixout, dsk);
        if (!lat) { const size_t si = ((((size_t)b * 2 + e) * 2 + d) * 32 + g) * 64 + lane; P.out[OUT_S5RE + si] = hr; P.out[OUT_S5IM + si] = hi; }
        else { float* F = (float*)(P.ws + WS_S5F) + ((((size_t)d * 64 + q) * 32 + g) * 64 + lane) * 2; F[0] = hr; F[1] = hi; }
    }
}
__device__ __forceinline__ void s5_task_corr(const Params& P, LAS unsigned char* wl, int lane, int e, int q, int g, int dry = 0) {
    const bf16* proj = (const bf16*)(P.ws + WS_BIG); float* ybuf = (float*)(P.ws + WS_YBUF); bf16* mixout = (bf16*)(P.ws + WS_MIX);
    const int b = q >> 3, seg = q & 7, m0 = MCTX + b * LLAT + seg * 256;
    bf16x8 Cf[4]; s5_c_setup(P, e, g, lane, Cf);
    bf16x8 Bf[8];
#pragma unroll
    for (int i = 0; i < 8; ++i) Bf[i] = (bf16x8){0, 0, 0, 0, 0, 0, 0, 0};
    const float* Fb = (const float*)(P.ws + WS_S5F);
#pragma unroll 1
    for (int d = 0; d < 2; ++d) {
        float ar, ai; s5_dir_setup(P, e, d, g, lane, ar, ai, Bf, false);
        float pr = ar, pi = ai;
#pragma unroll
        for (int i = 0; i < 8; ++i) { const float nr = pr * pr - pi * pi, ni = 2.0f * pr * pi; pr = nr; pi = ni; }
        float hr = 0.f, hi = 0.f;
        const int cnt = d == 0 ? seg : 7 - seg;
        for (int i = 0; i < cnt; ++i) { const int sj = d == 0 ? i : 7 - i; const float* F = Fb + ((((size_t)d * 64 + b * 8 + sj) * 32 + g) * 64 + lane) * 2;
            const float nr = pr * hr - pi * hi + F[0], ni = pr * hi + pi * hr + F[1]; hr = nr; hi = ni; }
        const int ym = (d == 1 || seg == 7) ? 2 : 1;
        if (cnt > 0) s5_scan_seg(P, wl, lane, d, g, m0, ar, ai, Bf, Cf, hr, hi, 1, ym, proj, ybuf, mixout, 0.f, dry);
    }
}

#ifndef REP_A
#define REP_A 1
#endif
#ifndef REP_B
#define REP_B 1
#endif
#ifndef REP_C
#define REP_C 1
#endif
__device__ __forceinline__ void phase_conv_even(int wid0, const Params& P, int e, int dry = 0) {
    const int tid = tid_fresh(wid0), lane = tid & 63, wave = tid >> 6;
    const int gw = bid_fresh() * NWAVES + wave, NGW = grid_fresh() * NWAVES;
    bf16* proj = (bf16*)(P.ws + WS_BIG); const bf16* HALO = (const bf16*)(P.ws + WS_HALO);
    for (int it = gw; it < 384 * 24; it += NGW) {
        const int c = it / 24, cgp = it % 24, ccol = cgp * 64 + lane;
        const int r0 = c * 64;
        const bool lat = r0 >= MCTX; const int t0 = lat ? ((r0 - MCTX) & 2047) : (r0 & 255); const int L = lat ? LLAT : LCTX;
        bf16* base = proj + (size_t)r0 * NPROJ_E + 1024 + ccol;
        bf16 x[67];
#pragma unroll
        for (int i = 0; i < 64; ++i) x[i + 1] = base[(size_t)i * NPROJ_E];
        x[0] = (t0 > 0) ? HALO[((size_t)(c - 1) * 3 + 0) * 1536 + ccol] : (bf16)0;
        x[65] = (t0 + 64 < L) ? HALO[((size_t)(c + 1) * 3 + 1) * 1536 + ccol] : (bf16)0;
        x[66] = (t0 + 64 < L) ? HALO[((size_t)(c + 1) * 3 + 2) * 1536 + ccol] : (bf16)0;
        const float* cw = P.in[I_GCONVW] + (size_t)e * 4 * 1536 + ccol; const float w0 = cw[0], w1 = cw[1536], w2 = cw[3072], w3 = cw[4608], cb = P.in[I_GCONVB][e * 1536 + ccol];
#pragma unroll
        for (int i = 0; i < 64; ++i) { const float v = cb + w0 * bf2f(x[i]) + w1 * bf2f(x[i + 1]) + w2 * bf2f(x[i + 2]) + w3 * bf2f(x[i + 3]);
            if (!dry) base[(size_t)i * NPROJ_E] = (bf16)f2bf(siluf_(v)); }
    }
}
#define LDS_BARRIER() do { asm volatile("s_waitcnt lgkmcnt(0)" ::: "memory"); __builtin_amdgcn_s_barrier(); asm volatile("" ::: "memory"); } while (0)
constexpr int G_Q = 0, G_K = 17408, G_V = 34816, G_KT = 52224, G_LM = 70656, G_QK = 89088, G_ST = 98304, G_SM = 133120;
constexpr int P128 = 136, P64 = 72, LMP = 68;
__device__ __forceinline__ bf16x8 ld_split8(const LAS bf16* p) {
    const u32x2 a = *(const LAS u32x2*)p, b = *(const LAS u32x2*)(p + 16);
    return __builtin_bit_cast(bf16x8, (u32x4){a.x, a.y, b.x, b.y});
}
__device__ __forceinline__ bf16x8 pack_acc2(const f32x4& a, const f32x4& b) { return __builtin_bit_cast(bf16x8, (u32x4){pk2(a[0], a[1]), pk2(a[2], a[3]), pk2(b[0], b[1]), pk2(b[2], b[3])}); }
__device__ __forceinline__ void gdn_chain(int wid0, const Params& P, LAS unsigned char* lds, int e, int s, int hd, int dir) {
    const int tid = tid_fresh(wid0), lane = tid & 63, w = __builtin_amdgcn_readfirstlane(tid >> 6), quad = lane >> 4, l15 = lane & 15;
    const bool lat = s >= 32; const int b = lat ? s - 32 : s; const int L = lat ? LLAT : LCTX; const int m0 = lat ? MCTX + b * LLAT : s * LCTX;
    const bf16* proj = (const bf16*)(P.ws + WS_BIG); const float* AB = (const float*)(P.ws + WS_AB);
    bf16* Odir = (bf16*)(P.ws + WS_H) + (size_t)dir * MT * 512;
    int zv; asm volatile("v_mov_b32 %0, 0" : "=v"(zv));
    lds += zv;
    LAS bf16* Qs = (LAS bf16*)(lds + G_Q); LAS bf16* Ks = (LAS bf16*)(lds + G_K); LAS bf16* Vs = (LAS bf16*)(lds + G_V); LAS bf16* KT = (LAS bf16*)(lds + G_KT);
    LAS float* Lm = (LAS float*)(lds + G_LM); LAS bf16* VNT = (LAS bf16*)(lds + G_LM); LAS bf16* QKs = (LAS bf16*)(lds + G_QK); LAS bf16* ST = (LAS bf16*)(lds + G_ST);
    LAS bf16* TM = (LAS bf16*)(lds + G_ST); LAS bf16* TT = TM + 64 * P64; LAS bf16* LR = TT + 64 * P64;
    LAS float* rq = (LAS float*)(lds + G_SM); LAS float* rk = rq + 64; LAS float* gcs = rq + 128; LAS float* betas = rq + 192; LAS float* egs = rq + 256; LAS float* kes = rq + 320;
    f32x4 Sacc[8];
    const size_t sbase = ((((size_t)b * 2 + e) * 2 + dir) * 4 + hd) * 16384;
#pragma unroll
    for (int mt = 0; mt < 8; ++mt) Sacc[mt] = (f32x4){0.f, 0.f, 0.f, 0.f};
    if (lat) { const float* sp = P.in[I_SDELTA] + sbase + (size_t)(quad * 4) * 128 + 16 * w + l15;
#pragma unroll
        for (int mt = 0; mt < 8; ++mt)
#pragma unroll
            for (int jj = 0; jj < 4; ++jj) Sacc[mt][jj] = sp[(16 * mt + jj) * 128]; }
    for (int i = tid; i < 2 * 64 * P64 / 2; i += NTHR) ((LAS unsigned*)TM)[i] = 0u;
    const float alog_e = __expf(P.in[I_GALOG][(e * 2 + dir) * 4 + hd]), dtb = P.in[I_GDTB][(e * 2 + dir) * 4 + hd];
    const int nchunk = L / 64;
    u32x4 xr[6]; float ab_a = 0.f, ab_b = 0.f;
#define GDN_LOAD(ci_) do { const int tid_ = tid_fresh(wid0); const int c0_ = dir ? L - 64 * ((ci_) + 1) : 64 * (ci_); \
        _Pragma("unroll") for (int k = 0; k < 6; ++k) { const int p_ = tid_ + 512 * k, part_ = p_ >> 10, row_ = (p_ & 1023) >> 4, pc_ = p_ & 15; \
            xr[k] = *(const u32x4*)(proj + (size_t)(m0 + c0_ + row_) * NPROJ_E + 1024 + part_ * 512 + hd * 128 + pc_ * 8); } \
        if (w == 0) { const int ln_ = tid_ & 63; const size_t m_ = (size_t)(m0 + c0_ + (dir ? 63 - ln_ : ln_)); ab_a = AB[m_ * 16 + dir * 4 + hd]; ab_b = AB[m_ * 16 + 8 + dir * 4 + hd]; } } while (0)
    GDN_LOAD(0);
#pragma unroll 1
    for (int ci = 0; ci < nchunk; ++ci) {
        const int tid = tid_fresh(wid0), lane = tid & 63, quad = lane >> 4, l15 = lane & 15;
        const int c0 = dir ? L - 64 * (ci + 1) : 64 * ci;
        LDS_BARRIER();
#ifndef NO_A
        const float cur_a = ab_a, cur_b = ab_b;
#pragma unroll
        for (int k = 0; k < 6; ++k) { const int p_ = tid + 512 * k, part_ = p_ >> 10, row_ = (p_ & 1023) >> 4, pc_ = p_ & 15;
            LAS bf16* dst = part_ == 0 ? Qs : (part_ == 1 ? Ks : Vs);
            *(LAS u32x4*)(dst + (dir ? 63 - row_ : row_) * P128 + pc_ * 8) = xr[k]; }
        if (ci + 1 < nchunk) GDN_LOAD(ci + 1);
#endif
        LDS_BARRIER();
#pragma unroll 1
        for (int repB = 0; repB < REP_B; ++repB)
        { const int rowid = tid >> 2, part = tid & 3; LAS bf16* src = (rowid < 64 ? Qs : Ks) + (rowid & 63) * P128 + part * 32;
          float ss = 0.f;
#pragma unroll
          for (int i = 0; i < 4; ++i) { const u32x4 v = *(const LAS u32x4*)(src + 8 * i);
#pragma unroll
              for (int j = 0; j < 4; ++j) { const float a = bflo(v[j]), c = bfhi(v[j]); ss += a * a + c * c; } }
          ss += shfl_i(ss, lane ^ 1); ss += shfl_i(ss, lane ^ 2);
          if (part == 0) { if (rowid < 64) rq[rowid] = rsqrtf(ss + EPSF) * 0.08838834764831845f; else rk[rowid - 64] = rsqrtf(ss + EPSF); }
          if (w == 0) { const int t = c0 + (dir ? 63 - lane : lane); const size_t m = (size_t)(m0 + t);
              const float araw = cur_a, braw = cur_b;
              const float gg = -alog_e * softplusf_(araw + dtb);
              float gc = gg;
#pragma unroll
              for (int o = 1; o < 64; o <<= 1) { const float t2 = shfl_i(gc, (lane - o) & 63); if (lane >= o) gc += t2; }
              const float glast = shfl_i(gc, 63);
              gcs[lane] = gc; betas[lane] = sigmoidf_(braw); egs[lane] = __expf(gc); kes[lane] = __expf(glast - gc);
              if (lane == 0) rq[384] = __expf(glast); } }
        LDS_BARRIER();
#ifndef NO_C
#pragma unroll 1
        for (int repC = 0; repC < REP_C; ++repC)
        { const int mt = w & 3; const bool isq = w >= 4; LAS bf16* src = isq ? Qs : Ks;
          bf16x8 a[4];
#pragma unroll
          for (int ks = 0; ks < 4; ++ks) a[ks] = *(const LAS bf16x8*)(src + (16 * mt + l15) * P128 + 32 * ks + quad * 8);
#pragma unroll 1
          for (int nt = 0; nt < 4; ++nt) { f32x4 acc = (f32x4){0.f, 0.f, 0.f, 0.f};
#pragma unroll
              for (int ks = 0; ks < 4; ++ks) { const bf16x8 bb = *(const LAS bf16x8*)(Ks + (16 * nt + l15) * P128 + 32 * ks + quad * 8); acc = mfma16(a[ks], bb, acc); }
              const int j = 16 * nt + l15; const float rkj = rk[j], gcj = gcs[j];
              f32x4 lv;
#pragma unroll
              for (int jj = 0; jj < 4; ++jj) { const int i = 16 * mt + quad * 4 + jj; const float dec = __expf(fminf(gcs[i] - gcj, 0.f));
                  lv[jj] = (i > j) ? acc[jj] * rk[i] * rkj * betas[i] * dec : 0.f;
                  if (isq) QKs[i * P64 + j] = (bf16)f2bf((i >= j) ? acc[jj] * rq[i] * rkj * dec : 0.f); }
              if (!isq) { *(LAS f32x4*)(Lm + j * LMP + 16 * mt + quad * 4) = lv;
#pragma unroll
                  for (int jj = 0; jj < 4; ++jj) LR[(16 * mt + quad * 4 + jj) * P64 + j] = (bf16)f2bf(nt < mt ? lv[jj] : 0.f); } }
          const int dd = tid & 127, tq = tid >> 7;
          unsigned pw[8];
#pragma unroll
          for (int n = 0; n < 16; n += 2) { const int i0 = tq * 16 + n; const float v0 = bf2f(Ks[i0 * P128 + dd]) * rk[i0] * kes[i0], v1 = bf2f(Ks[(i0 + 1) * P128 + dd]) * rk[i0 + 1] * kes[i0 + 1]; pw[n >> 1] = pk2(v0, v1); }
          *(LAS u32x4*)(KT + dd * P64 + tq * 16) = (u32x4){pw[0], pw[1], pw[2], pw[3]};
          *(LAS u32x4*)(KT + dd * P64 + tq * 16 + 8) = (u32x4){pw[4], pw[5], pw[6], pw[7]}; }
#endif
        LDS_BARRIER();
        { const int i = tid >> 3, c0k = (tid & 7) * 16; const float sc = rk[i] * betas[i] * egs[i];
#pragma unroll
          for (int h2 = 0; h2 < 2; ++h2) { u32x4 v = *(LAS u32x4*)(Ks + i * P128 + c0k + 8 * h2);
#pragma unroll
              for (int q = 0; q < 4; ++q) v[q] = pk2(bflo(v[q]) * sc, bfhi(v[q]) * sc);
              *(LAS u32x4*)(Ks + i * P128 + c0k + 8 * h2) = v; } }
        if (w == 0) { const int bb = lane >> 4, c = lane & 15;
            float x[16];
#pragma unroll
            for (int r = 0; r < 16; ++r) x[r] = (r == c) ? 1.f : 0.f;
#pragma unroll
            for (int j = 0; j < 15; ++j) {
#pragma unroll
                for (int q4 = j / 4; q4 < 4; ++q4) { const f32x4 l4 = *(const LAS f32x4*)(Lm + (16 * bb + j) * LMP + 16 * bb + 4 * q4);
#pragma unroll
                    for (int jx = 0; jx < 4; ++jx) if (4 * q4 + jx > j) x[4 * q4 + jx] -= l4[jx] * x[j]; } }
            unsigned pw[8];
#pragma unroll
            for (int r = 0; r < 16; r += 2) { pw[r >> 1] = pk2(x[r], x[r + 1]); TM[(16 * bb + r) * P64 + 16 * bb + c] = (bf16)(pw[r >> 1] & 0xffffu); TM[(16 * bb + r + 1) * P64 + 16 * bb + c] = (bf16)(pw[r >> 1] >> 16); }
            *(LAS u32x4*)(TT + (16 * bb + c) * P64 + 16 * bb) = (u32x4){pw[0], pw[1], pw[2], pw[3]};
            *(LAS u32x4*)(TT + (16 * bb + c) * P64 + 16 * bb + 8) = (u32x4){pw[4], pw[5], pw[6], pw[7]}; }
        LDS_BARRIER();
#pragma unroll 1
        for (int lev = 1; lev < 4; ++lev) {
            if (w < 4 - lev) { const int bj = w, bi = w + lev;
                f32x4 m = (f32x4){0.f, 0.f, 0.f, 0.f};
#pragma unroll
                for (int ks = 0; ks < 2; ++ks) { const bf16x8 a = *(const LAS bf16x8*)(LR + (16 * bi + l15) * P64 + 32 * ks + quad * 8), bq = *(const LAS bf16x8*)(TT + (16 * bj + l15) * P64 + 32 * ks + quad * 8); m = mfma16(a, bq, m); }
                const u32x2 tl = *(const LAS u32x2*)(TM + (16 * bi + l15) * P64 + 16 * bi + quad * 4);
                const bf16x8 a2 = __builtin_bit_cast(bf16x8, (u32x4){tl.x, tl.y, 0u, 0u}), b2 = __builtin_bit_cast(bf16x8, (u32x4){pk2(m[0], m[1]), pk2(m[2], m[3]), 0u, 0u});
                const f32x4 t = mfma16(a2, b2, (f32x4){0.f, 0.f, 0.f, 0.f});
                const unsigned p0 = pk2(-t[0], -t[1]), p1 = pk2(-t[2], -t[3]);
                TM[(16 * bi + quad * 4 + 0) * P64 + 16 * bj + l15] = (bf16)(p0 & 0xffffu); TM[(16 * bi + quad * 4 + 1) * P64 + 16 * bj + l15] = (bf16)(p0 >> 16);
                TM[(16 * bi + quad * 4 + 2) * P64 + 16 * bj + l15] = (bf16)(p1 & 0xffffu); TM[(16 * bi + quad * 4 + 3) * P64 + 16 * bj + l15] = (bf16)(p1 >> 16);
                *(LAS u32x2*)(TT + (16 * bj + l15) * P64 + 16 * bi + quad * 4) = (u32x2){p0, p1}; }
            LDS_BARRIER();
        }
#ifndef NO_EFG
        bf16x8 Bst[4];
#pragma unroll
        for (int ks = 0; ks < 4; ++ks) Bst[ks] = pack_acc2(Sacc[2 * ks], Sacc[2 * ks + 1]);
        f32x4 vn[4];
#pragma unroll
        for (int mt = 0; mt < 4; ++mt) { f32x4 acc = (f32x4){0.f, 0.f, 0.f, 0.f};
#pragma unroll
            for (int ks = 0; ks < 4; ++ks) { const bf16x8 a = ld_split8(Ks + (16 * mt + l15) * P128 + 32 * ks + quad * 4); acc = mfma16(a, Bst[ks], acc); }
#pragma unroll
            for (int jj = 0; jj < 4; ++jj) { const int i = 16 * mt + quad * 4 + jj; vn[mt][jj] = bf2f(Vs[i * P128 + 16 * w + l15]) * betas[i] - acc[jj]; } }
        bf16x8 Bvn[2];
#pragma unroll
        for (int k2 = 0; k2 < 2; ++k2) Bvn[k2] = pack_acc2(vn[2 * k2], vn[2 * k2 + 1]);
#pragma unroll
        for (int mt = 0; mt < 4; ++mt) { f32x4 acc = (f32x4){0.f, 0.f, 0.f, 0.f};
#pragma unroll
            for (int k2 = 0; k2 < 2; ++k2) { const bf16x8 a = ld_split8(TM + (16 * mt + l15) * P64 + 32 * k2 + quad * 4); acc = mfma16(a, Bvn[k2], acc); }
            vn[mt] = acc; }
#pragma unroll
        for (int k2 = 0; k2 < 2; ++k2) Bvn[k2] = pack_acc2(vn[2 * k2], vn[2 * k2 + 1]);
#pragma unroll 1
        for (int mt = 0; mt < 4; ++mt) { f32x4 acc = (f32x4){0.f, 0.f, 0.f, 0.f};
#pragma unroll
            for (int ks = 0; ks < 4; ++ks) { const bf16x8 a = ld_split8(Qs + (16 * mt + l15) * P128 + 32 * ks + quad * 4); acc = mfma16(a, Bst[ks], acc); }
#pragma unroll
            for (int jj = 0; jj < 4; ++jj) { const int i = 16 * mt + quad * 4 + jj; acc[jj] *= rq[i] * egs[i]; }
#pragma unroll
            for (int k2 = 0; k2 < 2; ++k2) { const bf16x8 a = ld_split8(QKs + (16 * mt + l15) * P64 + 32 * k2 + quad * 4); acc = mfma16(a, Bvn[k2], acc); }
#pragma unroll
            for (int jj = 0; jj < 4; ++jj) { const int i = 16 * mt + quad * 4 + jj; const int t = c0 + (dir ? 63 - i : i);
                Odir[(size_t)(m0 + t) * 512 + hd * 128 + 16 * w + l15] = (bf16)f2bf(acc[jj]); } }
        const float egl = rq[384];
#pragma unroll
        for (int mt = 0; mt < 8; ++mt) { f32x4 acc = Sacc[mt] * egl;
#pragma unroll
            for (int k2 = 0; k2 < 2; ++k2) { const bf16x8 a = ld_split8(KT + (16 * mt + l15) * P64 + 32 * k2 + quad * 4); acc = mfma16(a, Bvn[k2], acc); }
            Sacc[mt] = acc; }
#endif
        WAVE_SYNC();
    }
    if (!lat) { const int tid2 = tid_fresh(wid0), lane2 = tid2 & 63; float* dp = P.out + OUT_DELTA + sbase + (size_t)((lane2 >> 4) * 4) * 128 + 16 * w + (lane2 & 15);
#pragma unroll
        for (int mt = 0; mt < 8; ++mt)
#pragma unroll
            for (int jj = 0; jj < 4; ++jj) dp[(16 * mt + jj) * 128] = Sacc[mt][jj];
    }
    __syncthreads();
}

__device__ __forceinline__ void phase_mix_even(int wid0, const Params& P, LAS unsigned char* lds, int e, int mode = 3) {
    const int bid = bid_fresh(), G = grid_fresh();
    if (G == 256) {
        if (bid < 64) { const int s = 32 + (bid >> 3), hd = (bid >> 1) & 3, dir = bid & 1; if (mode & 1) gdn_chain(wid0, P, lds, e, s, hd, dir); }
        else { const int bb = bid - 64;
            if (mode & 1) for (int c = bb; c < 256; c += 192) { const int s = c >> 3, hd = (c >> 1) & 3, dir = c & 1; gdn_chain(wid0, P, lds, e, s, hd, dir); }
            if (mode & 2) { const int tid = tid_fresh(wid0), lane = tid & 63, wave = tid >> 6;
                for (int t = bb; t < 384; t += 192) { const int wt = t * 8 + wave; s5_task_main(P, lds + wave * S5_WLDS, lane, e, wt >> 5, wt & 31); } }
            if (mode == 3) { __syncthreads(); const int tid = tid_fresh(wid0), lane = tid & 63, wave = tid >> 6;
                for (int it = bb * NWAVES + wave; it < WITEMS_ODD; it += 192 * NWAVES) weight_item(P, (LAS float*)(lds + wave * 16384), 2 * e + 1, it, lane); } }
    } else {
        for (int c = bid; c < 320; c += G) { const int s = c < 64 ? 32 + (c >> 3) : ((c - 64) >> 3), hd = (c >> 1) & 3, dir = c & 1; gdn_chain(wid0, P, lds, e, s, hd, dir); }
        const int tid = tid_fresh(wid0), lane = tid & 63, wave = tid >> 6;
        for (int t = bid; t < 384; t += G) { const int wt = t * 8 + wave; s5_task_main(P, lds + wave * S5_WLDS, lane, e, wt >> 5, wt & 31); }
        __syncthreads();
        for (int it = bid * NWAVES + wave; it < WITEMS_ODD; it += G * NWAVES) weight_item(P, (LAS float*)(lds + wave * 16384), 2 * e + 1, it, lane);
    }
}
__device__ __forceinline__ void phase_fin_even(int wid0, const Params& P, LAS unsigned char* lds, int e, int dry = 0) {
    const int tid = tid_fresh(wid0), lane = tid & 63, wave = tid >> 6;
    const int gw = bid_fresh() * NWAVES + wave, NGW = grid_fresh() * NWAVES;
    for (int wt = gw; wt < 2048; wt += NGW) s5_task_corr(P, lds + wave * S5_WLDS, lane, e, wt >> 5, wt & 31, dry);
    const bf16* proj = (const bf16*)(P.ws + WS_BIG); const bf16* Of = (const bf16*)(P.ws + WS_H); const bf16* Ob = Of + (size_t)MT * 512; bf16* mixout = (bf16*)(P.ws + WS_MIX);
    for (int mb2 = gw; mb2 < MT; mb2 += 2 * NGW) {
        u32x4 a[2], bq[2], z[2];
#pragma unroll
        for (int u = 0; u < 2; ++u) { const int m = mb2 + u * NGW; if (m < MT) { a[u] = *(const u32x4*)(Of + (size_t)m * 512 + lane * 8); bq[u] = *(const u32x4*)(Ob + (size_t)m * 512 + lane * 8); z[u] = *(const u32x4*)(proj + (size_t)m * NPROJ_E + 2560 + lane * 8); } }
#pragma unroll
        for (int u = 0; u < 2; ++u) { const int m = mb2 + u * NGW; if (m < MT) {
            float o[8]; float ss = 0.f;
#pragma unroll
            for (int j = 0; j < 4; ++j) { o[2 * j] = bflo(a[u][j]) + bflo(bq[u][j]); o[2 * j + 1] = bfhi(a[u][j]) + bfhi(bq[u][j]); ss += o[2 * j] * o[2 * j] + o[2 * j + 1] * o[2 * j + 1]; }
            ss += shfl_i(ss, lane ^ 1); ss += shfl_i(ss, lane ^ 2); ss += shfl_i(ss, lane ^ 4); ss += shfl_i(ss, lane ^ 8);
            const float rs = rsqrtf(ss * (1.0f / 128.0f) + EPSF);
            const float* gn = P.in[I_GONORM] + e * 128 + (lane & 15) * 8;
            unsigned pw[4];
#pragma unroll
            for (int j = 0; j < 4; ++j) { const float z0 = bflo(z[u][j]), z1 = bfhi(z[u][j]); pw[j] = pk2(o[2 * j] * rs * gn[2 * j] * siluf_(z0), o[2 * j + 1] * rs * gn[2 * j + 1] * siluf_(z1)); }
            if (!dry) *(u32x4*)(mixout + (size_t)m * DM + 512 + lane * 8) = (u32x4){pw[0], pw[1], pw[2], pw[3]}; } }
    }
}

__device__ __forceinline__ void phase_conv_odd(int wid0, const Params& P, int o) {
    const int tid = tid_fresh(wid0), lane = tid & 63, wave = tid >> 6;
    const int gw = bid_fresh() * NWAVES + wave, NGW = grid_fresh() * NWAVES;
    const bf16* proj = (const bf16*)(P.ws + WS_BIG); bf16* cx = (bf16*)(P.ws + WS_H);
    const float* cw = P.in[I_LCONVW] + (size_t)o * 4 * 1024; const float* cb = P.in[I_LCONVB] + o * 1024;
    for (int m = gw; m < MT; m += NGW) {
        const int t = m < MCTX ? (m & 255) : ((m - MCTX) & 2047); const int L = m < MCTX ? LCTX : LLAT;
#pragma unroll
        for (int h2 = 0; h2 < 2; ++h2) { const int ch = lane * 8 + 512 * h2;
            float acc[8];
#pragma unroll
            for (int j = 0; j < 8; ++j) acc[j] = cb[ch + j];
#pragma unroll
            for (int k = 0; k < 4; ++k) { const int tt = t - 1 + k; if (tt >= 0 && tt < L) { const u32x4 v = *(const u32x4*)(proj + (size_t)(m - 1 + k) * 2048 + ch);
#pragma unroll
                    for (int j = 0; j < 4; ++j) { acc[2 * j] += cw[k * 1024 + ch + 2 * j] * bflo(v[j]); acc[2 * j + 1] += cw[k * 1024 + ch + 2 * j + 1] * bfhi(v[j]); } } }
            *(u32x4*)(cx + (size_t)m * DM + ch) = (u32x4){pk2(acc[0], acc[1]), pk2(acc[2], acc[3]), pk2(acc[4], acc[5]), pk2(acc[6], acc[7])}; }
    }
}
__device__ __forceinline__ void phase_lru_scan(int wid0, const Params& P, LAS unsigned char* lds, int o, int d) {
    const int tid = tid_fresh(wid0), lane = tid & 63, wave = tid >> 6;
    const int gw = bid_fresh() * NWAVES + wave, NGW = grid_fresh() * NWAVES;
    const unsigned* G = (const unsigned*)(P.ws + WS_GATES); const bf16* proj = (const bf16*)(P.ws + WS_BIG); bf16* mixout = (bf16*)(P.ws + WS_MIX);
    const int Gn = NGW / NWAVES, vw = wave * Gn + (gw / NWAVES);
    if (d == 0 && o == 0 && NGW > 640) {
        for (int it = vw - 640; it >= 0 && it < WITEMS_EVEN; it += NGW - 640) weight_item(P, (LAS float*)(lds + wave * 16384), 2, it, lane); }
    for (int task = vw; task < 640; task += NGW) {
        int s, cg_;
        if (task < 128) { s = 32 + (task >> 4); cg_ = task & 15; } else { s = (task - 128) >> 4; cg_ = (task - 128) & 15; }
        const bool lat = s >= 32; const int b = lat ? s - 32 : s; const int L = lat ? LLAT : LCTX; const int m0 = lat ? MCTX + b * LLAT : s * LCTX;
        const int ch = cg_ * 64 + lane;
        float h = lat ? P.in[I_SLRU][(((size_t)b * 2 + o) * 2 + d) * 1024 + ch] : 0.f;
        if (d == 0) {
            unsigned ga[32], gb[32];
#define LRU_LD0(dst, tt) _Pragma("unroll") for (int i = 0; i < 32; ++i) dst[i] = G[(size_t)(m0 + (tt) + i) * DM + ch]
#define LRU_CP0(src, tt) _Pragma("unroll") for (int i = 0; i < 32; ++i) { h = (1.0f - bflo(src[i])) * h + bfhi(src[i]); mixout[(size_t)(m0 + (tt) + i) * DM + ch] = (bf16)f2bf(h); }
            LRU_LD0(ga, 0);
            for (int t0 = 0; t0 < L; t0 += 64) {
                LRU_LD0(gb, t0 + 32);
                LRU_CP0(ga, t0);
                if (t0 + 64 < L) { LRU_LD0(ga, t0 + 64); }
                LRU_CP0(gb, t0 + 32);
            }
        } else {
            unsigned ga[16], gb[16]; bf16 pa[16], pb[16], ya[16], yb[16];
#define LRU_LD1(g_, p_, y_, tt) _Pragma("unroll") for (int i = 0; i < 16; ++i) { const size_t m = (size_t)(m0 + L - 1 - ((tt) + i)); g_[i] = G[m * DM + ch]; p_[i] = mixout[m * DM + ch]; y_[i] = proj[m * 2048 + 1024 + ch]; }
#define LRU_CP1(g_, p_, y_, tt) _Pragma("unroll") for (int i = 0; i < 16; ++i) { const size_t m = (size_t)(m0 + L - 1 - ((tt) + i)); \
                h = (1.0f - bflo(g_[i])) * h + bfhi(g_[i]); mixout[m * DM + ch] = (bf16)f2bf((bf2f(p_[i]) + h) * geluf_(bf2f(y_[i]))); }
            LRU_LD1(ga, pa, ya, 0);
            for (int t0 = 0; t0 < L; t0 += 32) {
                LRU_LD1(gb, pb, yb, t0 + 16);
                LRU_CP1(ga, pa, ya, t0);
                if (t0 + 32 < L) { LRU_LD1(ga, pa, ya, t0 + 32); }
                LRU_CP1(gb, pb, yb, t0 + 16);
            }
        }
        if (!lat) P.out[OUT_LRU + (((size_t)b * 2 + o) * 2 + d) * 1024 + ch] = h;
    }
}
#ifdef PROBE_DUP_GEMM
#define DUPG(x) GSYNC(); x
#else
#define DUPG(x)
#endif
typedef const __attribute__((address_space(4))) Params* KParams;
__device__ __forceinline__ Params load_params(KParams q) { Params r;
#pragma unroll
    for (int i = 0; i < 40; ++i) r.in[i] = q->in[i];
    r.out = q->out; r.ws = q->ws; return r; }
#define FRESH() const int G = grid_fresh(), bid = bid_fresh(); (void)G; (void)bid; KParams pk_ = (KParams)__builtin_amdgcn_kernarg_segment_ptr(); asm volatile("" : "+s"(pk_)); const Params P = load_params(pk_); unsigned char* ws = P.ws; \
    const float* mod = (const float*)(ws + WS_MOD); bf16* H = (bf16*)(ws + WS_H); bf16* BIG = (bf16*)(ws + WS_BIG); bf16* MIX = (bf16*)(ws + WS_MIX); (void)mod; (void)H; (void)BIG; (void)MIX;
#define GSYNC() do { KParams pb_ = (KParams)__builtin_amdgcn_kernarg_segment_ptr(); asm volatile("" : "+s"(pb_)); xcd_barrier(wid0, (unsigned*)(pb_->ws + WS_BAR), lds); } while (0)
__global__ void __launch_bounds__(NTHR, 2) fwd_kernel(Params Parg) {
    extern __shared__ __attribute__((aligned(16))) unsigned char lds_raw[];
    LAS unsigned char* lds = (LAS unsigned char*)lds_raw;
    cg::grid_group grid = cg::this_grid();
    const int wid0 = __builtin_amdgcn_readfirstlane(threadIdx.x >> 6);
    if (threadIdx.x < 4) ((LAS unsigned*)(lds + LDS_BARST))[threadIdx.x] = 0u;
    __syncthreads();
    if (threadIdx.x == 0) (void)xb_add((unsigned*)(Parg.ws + WS_BAR) + XB_XCNT(xb_xcc_id()), 1u);

    { FRESH(); phase_prologue(wid0, P, lds); }
    if (grid_fresh() == 0) grid.sync();
    GSYNC();
#ifdef PROBE_DUP_PRO
    { FRESH(); phase_prologue(wid0, P, lds); }
    GSYNC();
#endif
    { FRESH(); phase_modreduce(wid0, P); }
    GSYNC();
#ifdef PROBE_SYNC
#pragma unroll 1
    for (int i = 0; i < 40; ++i) GSYNC();
#endif
#pragma unroll 1
    for (int l = 0; l < 4; ++l) {
        { FRESH(); const float* modl = mod + (size_t)l * 9 * 6144;
        phase_rownorm(wid0, P, l == 0, MIX, modl - 9 * 6144, 5 * 1024, P.in[I_NMLPPOST] + (l > 0 ? (l - 1) * 1024 : 0), 1, P.in[I_NMIXPRE] + l * 1024, modl, 0, H); }
        GSYNC();
        const int eo = l >> 1;
        {
            FRESH();
            pg8::Gemm g; pg8::StaticOrder S; EpiBf16<0> E;
            if ((l & 1) == 0) { g = pg8::Gemm{H, (const bf16*)(ws + WS_WINE) + (size_t)eo * NB_E * 1024, MT, NB_E, 1024, 1024, 0, 0, 1024, 0}; E = EpiBf16<0>{BIG, NPROJ_E, (float*)(ws + WS_AB), (bf16*)(ws + WS_HALO)}; }
            else { g = pg8::Gemm{H, (const bf16*)(ws + WS_WINO) + (size_t)eo * 2048 * 1024, MT, 2048, 1024, 1024, 0, 0, 1024, 0}; E = EpiBf16<0>{BIG, 2048, nullptr, nullptr}; }
            S.init(g.M, g.N, G, bid);
            pg8::gemm_phase(wid0, lds, g, S, E); DUPG(pg8::gemm_phase(wid0, lds, g, S, E);)
        }
        GSYNC();
        if ((l & 1) == 0) {
            { FRESH(); phase_conv_even(wid0, P, eo); }
            GSYNC();
#ifdef PROBE_DRY_CONVE
            { FRESH(); phase_conv_even(wid0, P, eo, grid_fresh() > 0); }
            GSYNC();
#endif
#ifdef PROBE_DUP_MIX
#pragma unroll 1
            for (int rep = 0; rep < 2; ++rep) { { FRESH(); phase_mix_even(wid0, P, lds, eo, rep == 0 ? 3 : PROBE_DUP_MIX); } GSYNC(); }
#else
            { FRESH(); phase_mix_even(wid0, P, lds, eo); }
            GSYNC();
#endif
            { FRESH(); phase_fin_even(wid0, P, lds, eo); }
            GSYNC();
#ifdef PROBE_DRY_FIN
            { FRESH(); phase_fin_even(wid0, P, lds, eo, grid_fresh() > 0); }
            GSYNC();
#endif
        } else {
            { FRESH(); phase_conv_odd(wid0, P, eo); }
            GSYNC();
#ifdef PROBE_DUP_CONV
            { FRESH(); phase_conv_odd(wid0, P, eo); }
            GSYNC();
#endif
#pragma unroll 1
            for (int d = 0; d < 2; ++d) {
                { FRESH();
                pg8::Gemm g{H, (const bf16*)(ws + WS_WG) + (size_t)(eo * 2 + d) * 2048 * 256, MT, 2048, 256, 1024, 1, 1, 256, 0};
                EpiGates E{(unsigned*)(ws + WS_GATES), H, P.in[I_LBR] + (eo * 2 + d) * 1024, P.in[I_LBI] + (eo * 2 + d) * 1024, P.in[I_LLAM] + (eo * 2 + d) * 1024};
                pg8::StaticOrder S; S.init(g.M, g.N, G, bid);
                pg8::gemm_phase(wid0, lds, g, S, E); DUPG(pg8::gemm_phase(wid0, lds, g, S, E);) }
                GSYNC();
                { FRESH(); phase_lru_scan(wid0, P, lds, eo, d); }
#ifdef PROBE_DUP_LRU0
                if (d == 0) { GSYNC(); FRESH(); phase_lru_scan(wid0, P, lds, eo, d); }
#endif
                GSYNC();
            }
        }
        {
            FRESH();
            pg8::Gemm g{MIX, (const bf16*)(ws + ((l & 1) ? WS_WOUTO : WS_WOUTE)) + (size_t)eo * 1024 * 1024, MT, 1024, 1024, 1024, 0, 0, 1024, 0};
            EpiBf16<0> E{BIG, 1024, nullptr, nullptr}; pg8::StaticOrder S; S.init(g.M, g.N, G, bid);
            pg8::gemm_phase(wid0, lds, g, S, E); DUPG(pg8::gemm_phase(wid0, lds, g, S, E);)
        }
        GSYNC();
        { FRESH(); const float* modl = mod + (size_t)l * 9 * 6144;
        phase_rownorm(wid0, P, 0, BIG, modl, 2 * 1024, P.in[I_NMIXPOST] + l * 1024, 1, P.in[I_NMLPPRE] + l * 1024, modl, 3 * 1024, H); }
#ifdef PROBE_DUP_RN
        GSYNC();
        { FRESH(); const float* modl = mod + (size_t)l * 9 * 6144;
        phase_rownorm(wid0, P, 0, BIG, modl, 2 * 1024, P.in[I_NMIXPOST] + l * 1024, 1, P.in[I_NMLPPRE] + l * 1024, modl, 3 * 1024, H, 0.0f); }
#endif
        GSYNC();
        {
            FRESH();
            pg8::Gemm g{H, (const bf16*)(ws + WS_W1T) + (size_t)l * 4096 * 1024, MT, 4096, 1024, 1024, 0, 0, 1024, 0};
            EpiBf16<1> E{BIG, 4096, nullptr, nullptr}; pg8::StaticOrder S; S.init(g.M, g.N, G, bid);
            pg8::gemm_phase(wid0, lds, g, S, E); DUPG(pg8::gemm_phase(wid0, lds, g, S, E);)
        }
        GSYNC();
        {
            FRESH();
            pg8::Gemm g{BIG, (const bf16*)(ws + WS_W2T) + (size_t)l * 1024 * 4096, MT, 1024, 4096, 4096, 0, 0, 4096, 0};
            EpiBf16<0> E{MIX, 1024, nullptr, nullptr}; pg8::StaticOrder S; S.init(g.M, g.N, G, bid);
            pg8::gemm_phase(wid0, lds, g, S, E); DUPG(pg8::gemm_phase(wid0, lds, g, S, E);)
        }
        GSYNC();
    }
    { FRESH();
    phase_rownorm(wid0, P, 0, MIX, mod + (size_t)3 * 9 * 6144, 5 * 1024, P.in[I_NMLPPOST] + 3 * 1024, 0, P.in[I_NMIXPRE], mod, 0, H); }
}

extern "C" void kernel_launch(void* const* d_in, const int* in_sizes, int n_in, void* d_out, int out_size, void* d_ws, size_t ws_size, hipStream_t stream) {
    static int grid = 0;
    if (grid == 0) {
        if (n_in != 40 || ws_size < WS_END) { fprintf(stderr, "kernel_launch: expected 40 inputs and >= %zu bytes of workspace (got %d, %zu)\n", (size_t)WS_END, n_in, ws_size); grid = -1; return; }
        int dev = 0, cus = 0, per_cu = 0;
        if (hipGetDevice(&dev) != hipSuccess || hipDeviceGetAttribute(&cus, hipDeviceAttributeMultiprocessorCount, dev) != hipSuccess) { grid = -1; return; }
        if (hipFuncSetAttribute((const void*)fwd_kernel, hipFuncAttributeMaxDynamicSharedMemorySize, LDS_BYTES) != hipSuccess) { fprintf(stderr, "kernel_launch: hipFuncSetAttribute failed\n"); grid = -1; return; }
        if (hipOccupancyMaxActiveBlocksPerMultiprocessor(&per_cu, (const void*)fwd_kernel, NTHR, LDS_BYTES) != hipSuccess || per_cu < 1) per_cu = 1;
        (void)hipGetLastError();
        grid = cus * per_cu; if (grid > 256) grid = 256;
    }
    if (grid < 0) return;
    (void)hipMemsetAsync((char*)d_ws + WS_BAR, 0, 16384, stream);
    Params p{};
    for (int i = 0; i < 40; ++i) p.in[i] = (const float*)d_in[i];
    p.out = (float*)d_out; p.ws = (unsigned char*)d_ws;
    void* args[] = {&p};
    hipError_t e = hipLaunchCooperativeKernel((const void*)fwd_kernel, dim3(grid), dim3(NTHR), args, LDS_BYTES, stream);
    if (e != hipSuccess) fprintf(stderr, "cooperative launch failed: %s (grid %d)\n", hipGetErrorString(e), grid);
}
```

```cpp
#include <hip/hip_runtime.h>
#include <hip/hip_cooperative_groups.h>
#include <cstdio>
#include <cstdint>
namespace cg = cooperative_groups;
__device__ __forceinline__ int bid_fresh() { int t = blockIdx.x; asm volatile("" : "+s"(t)); return t; }
__device__ __forceinline__ int grid_fresh() { int t = gridDim.x; asm volatile("" : "+s"(t)); return t; }
__device__ __forceinline__ int tid_fresh(int w) { asm volatile("" : "+s"(w)); int l; asm volatile("v_mbcnt_lo_u32_b32 %0, -1, 0\n\tv_mbcnt_hi_u32_b32 %0, -1, %0" : "=v"(l)); return w * 64 + l; }

namespace pg8 {
#define PG8_LAS __attribute__((address_space(3)))
typedef unsigned short bf16_t;
typedef short bf16x8 __attribute__((ext_vector_type(8)));
typedef float f32x4 __attribute__((ext_vector_type(4)));
typedef unsigned u32x4 __attribute__((ext_vector_type(4)));
typedef unsigned u32x2 __attribute__((ext_vector_type(2)));
constexpr int BM = 256, BK = 64, HALF = 128, HTB = HALF * BK * 2, STAGE_BYTES = 8 * HTB, NXCD = 8, WGM = 4;

__host__ __device__ __forceinline__ int lds_byte(int r, int c) { const int st = (r >> 4) * 2 + (c >> 5), rr = r & 15, cc = c & 31, ob = rr * 64 + cc * 2; return st * 1024 + (ob ^ (((ob >> 9) & 1) << 5)); }
__host__ __device__ __forceinline__ void stage_rc(int b, int& R, int& C) { const int st = b / 1024, sb = b % 1024, swz = sb ^ (((sb >> 9) & 1) << 5); R = (st >> 1) * 16 + swz / 64; C = (st & 1) * 32 + (swz % 64) / 2; }
__host__ __device__ __forceinline__ int perm32(int rho) { const int n = rho >> 4, i = rho & 15; return 8 * (i >> 2) + 4 * n + (i & 3); }

struct Unit { int pm, pn; };
struct Gemm { const bf16_t* A; const bf16_t* Bt; int M, N, K, lda, ablk, ashift, ldb, ksplit; };

struct StaticOrder {
    int nM, nN, nwg, G, c;
    __host__ __device__ void init(int M, int N, int G_, int c_) { nM = M / BM; nN = N / BM; nwg = nM * nN; G = G_; c = c_; }
    __host__ __device__ bool next(int i, Unit& u) const {
        const long L = (long)i * G + c; if (L >= nwg) return false;
        int wgid = (int)L; { const int q = nwg / NXCD, r = nwg % NXCD, xcd = wgid % NXCD, off = wgid / NXCD; wgid = (xcd < r ? xcd * (q + 1) : r * (q + 1) + (xcd - r) * q) + off; }
        const int nig = WGM * nN, gid = wgid / nig, fm = gid * WGM, gsz = (nM - fm) < WGM ? (nM - fm) : WGM;
        u.pm = fm + ((wgid % nig) % gsz); u.pn = (wgid % nig) / gsz; return true;
    }
};
__device__ __forceinline__ unsigned cvt_pk_bf16(float lo, float hi) { unsigned r; asm volatile("v_cvt_pk_bf16_f32 %0, %1, %2" : "=v"(r) : "v"(lo), "v"(hi)); return r; }

template <class Epi>
__device__ __forceinline__ void gemm_phase(int wid0, PG8_LAS unsigned char* lds, const Gemm g, const StaticOrder& S, const Epi& E) {
    const int tid = tid_fresh(wid0), wid = __builtin_amdgcn_readfirstlane(tid >> 6), lane = tid & 63, wr = wid >> 2, wc = wid & 3, fr = lane & 15, fq = lane >> 4;
    const int K = g.K, nt = K / BK, lda = g.lda, ldb = g.ldb;
    unsigned voffA[2], voffB[2];
#pragma unroll
    for (int i = 0; i < 2; ++i) { int R, C; stage_rc(tid * 16 + i * 8192, R, C); const int Rb = (R & ~31) + perm32(R & 31);
        voffA[i] = (unsigned)(R * lda + C) * 2u; voffB[i] = (unsigned)(Rb * ldb + C) * 2u; }
    const size_t kstep = (size_t)(BK * 2);
    const size_t hstepA = (size_t)HALF * lda * 2, hstepB = (size_t)HALF * ldb * 2;
    const size_t tstepA = 2 * hstepA, tstepB = 2 * hstepB;
    const unsigned ldsw = (unsigned)wid * 1024u;
    const int aoff = lds_byte(wr * 64 + fr, fq * 8), boff = lds_byte(wc * 32 + fr, fq * 8);
#define PG8_ACOL(pn) (g.ablk ? (size_t)((((pn) >> g.ashift) & 3) * 512) : (g.ksplit ? (size_t)((pn) & 1) * (size_t)K * 2 : (size_t)0))
#define PG8_BOFF(pn) (g.ksplit ? (size_t)((pn) >> 1) * tstepB + (size_t)((pn) & 1) * (size_t)K * 2 : (size_t)(pn) * tstepB)
#define PG8_SA(b, h) (((b) * 2 + (h)) * HTB)
#define PG8_SB(b, h) ((4 + (b) * 2 + (h)) * HTB)
#define PG8_STAGE(bufoff, gbase, voff) do { _Pragma("unroll") for (int _i = 0; _i < 2; ++_i) \
        __builtin_amdgcn_global_load_lds((const unsigned*)((const char*)(gbase) + (voff)[_i]), (PG8_LAS unsigned*)(lds + (bufoff) + ldsw + _i * 8192), 16, 0, 0); } while (0)
#define PG8_LDA(dst, b, h) do { _Pragma("unroll") for (int m = 0; m < 4; ++m) _Pragma("unroll") for (int k = 0; k < 2; ++k) dst[m][k] = *(const PG8_LAS bf16x8*)(lds + PG8_SA(b, h) + aoff + m * 2048 + k * 1024); } while (0)
#define PG8_LDB(dst, b, h) do { _Pragma("unroll") for (int n = 0; n < 2; ++n) _Pragma("unroll") for (int k = 0; k < 2; ++k) dst[n][k] = *(const PG8_LAS bf16x8*)(lds + PG8_SB(b, h) + boff + n * 2048 + k * 1024); } while (0)
#define PG8_MMA(ai, bj, At, Bt) do { __builtin_amdgcn_s_setprio(1); _Pragma("unroll") for (int m = 0; m < 4; ++m) _Pragma("unroll") for (int n = 0; n < 2; ++n) _Pragma("unroll") for (int k = 0; k < 2; ++k) \
        acc[ai][bj][m][n] = __builtin_amdgcn_mfma_f32_16x16x32_bf16(Bt[n][k], At[m][k], acc[ai][bj][m][n], 0, 0, 0); __builtin_amdgcn_s_setprio(0); } while (0)
#define PG8_WAIT_V(n) asm volatile("s_waitcnt vmcnt(" #n ")" ::: "memory")
#define PG8_WAIT_L(n) asm volatile("s_waitcnt lgkmcnt(" #n ")" ::: "memory")
#define PG8_BAR __builtin_amdgcn_s_barrier()
#define PG8_SCHED __builtin_amdgcn_sched_barrier(0)
    Unit cur, nxt; int ui = 0;
    if (!S.next(0, cur)) return;
    f32x4 acc[2][2][4][2];
#pragma unroll
    for (int a = 0; a < 2; ++a)
#pragma unroll
        for (int b = 0; b < 2; ++b)
#pragma unroll
            for (int m = 0; m < 4; ++m)
#pragma unroll
                for (int n = 0; n < 2; ++n) acc[a][b][m][n] = (f32x4){0.f, 0.f, 0.f, 0.f};
    bf16x8 At[4][2], B0[2][2], B1[2][2];
    const char* cA = (const char*)g.A + (size_t)cur.pm * tstepA + PG8_ACOL(cur.pn); const char* cB = (const char*)g.Bt + PG8_BOFF(cur.pn);
    PG8_STAGE(PG8_SB(0, 0), cB, voffB); PG8_STAGE(PG8_SA(0, 0), cA, voffA); PG8_STAGE(PG8_SB(0, 1), cB + hstepB, voffB); PG8_STAGE(PG8_SA(0, 1), cA + hstepA, voffA);
    if (wr == 1) PG8_BAR;
    PG8_WAIT_V(4); PG8_BAR;
    PG8_STAGE(PG8_SB(1, 0), cB + kstep, voffB); PG8_STAGE(PG8_SA(1, 0), cA + kstep, voffA); PG8_STAGE(PG8_SB(1, 1), cB + hstepB + kstep, voffB);
    PG8_WAIT_V(6); PG8_BAR;
    for (;;) {
        const bool has_next = S.next(ui + 1, nxt);
        const char* nA = has_next ? (const char*)g.A + (size_t)nxt.pm * tstepA + PG8_ACOL(nxt.pn) : cA; const char* nB = has_next ? (const char*)g.Bt + PG8_BOFF(nxt.pn) : cB;
        for (int t = 0; t < nt; t += 2) {
            const bool last = (t == nt - 2);
            const char* a1 = cA + (size_t)(t + 1) * kstep;
            const char* a2 = last ? nA : cA + (size_t)(t + 2) * kstep; const char* b2 = last ? nB : cB + (size_t)(t + 2) * kstep;
            const char* a3 = a2 + kstep; const char* b3 = b2 + kstep;
            PG8_LDB(B0, 0, 0); PG8_SCHED; PG8_LDA(At, 0, 0); PG8_STAGE(PG8_SA(1, 1), a1 + hstepA, voffA);
            PG8_WAIT_L(8); PG8_BAR; PG8_WAIT_L(0); PG8_MMA(0, 0, At, B0); PG8_BAR; PG8_SCHED;
            PG8_LDB(B1, 0, 1); PG8_STAGE(PG8_SB(0, 0), b2, voffB);
            PG8_BAR; PG8_WAIT_L(0); PG8_MMA(0, 1, At, B1); PG8_BAR;
            PG8_LDA(At, 0, 1); PG8_STAGE(PG8_SA(0, 0), a2, voffA);
            PG8_BAR; PG8_WAIT_L(0); PG8_MMA(1, 0, At, B0); PG8_BAR; PG8_SCHED;
            PG8_STAGE(PG8_SB(0, 1), b2 + hstepB, voffB);
            PG8_WAIT_V(6); PG8_BAR; PG8_MMA(1, 1, At, B1); PG8_BAR;
            PG8_LDB(B0, 1, 0); PG8_SCHED; PG8_LDA(At, 1, 0); PG8_STAGE(PG8_SA(0, 1), a2 + hstepA, voffA);
            PG8_WAIT_L(8); PG8_BAR; PG8_WAIT_L(0); PG8_MMA(0, 0, At, B0); PG8_BAR; PG8_SCHED;
            PG8_LDB(B1, 1, 1); PG8_STAGE(PG8_SB(1, 0), b3, voffB);
            PG8_BAR; PG8_WAIT_L(0); PG8_MMA(0, 1, At, B1); PG8_BAR;
            PG8_LDA(At, 1, 1); PG8_STAGE(PG8_SA(1, 0), a3, voffA);
            PG8_BAR; PG8_WAIT_L(0); PG8_MMA(1, 0, At, B0); PG8_BAR; PG8_SCHED;
            PG8_STAGE(PG8_SB(1, 1), b3 + hstepB, voffB);
            PG8_WAIT_V(6); PG8_BAR; PG8_MMA(1, 1, At, B1); PG8_BAR;
        }
        E(acc, cur, wr, wc, fr, fq);
        if (!has_next) break;
#pragma unroll
        for (int a = 0; a < 2; ++a)
#pragma unroll
            for (int b = 0; b < 2; ++b)
#pragma unroll
                for (int m = 0; m < 4; ++m)
#pragma unroll
                    for (int n = 0; n < 2; ++n) acc[a][b][m][n] = (f32x4){0.f, 0.f, 0.f, 0.f};
        cur = nxt; cA = nA; cB = nB; ++ui;
    }
    PG8_WAIT_V(0);
    if (wr == 0) PG8_BAR;
    PG8_BAR;
#undef PG8_ACOL
#undef PG8_BOFF
#undef PG8_SA
#undef PG8_SB
#undef PG8_STAGE
#undef PG8_LDA
#undef PG8_LDB
#undef PG8_MMA
#undef PG8_WAIT_V
#undef PG8_WAIT_L
#undef PG8_BAR
#undef PG8_SCHED
}
}
#define LAS __attribute__((address_space(3)))
typedef unsigned short bf16;
typedef short bf16x8 __attribute__((ext_vector_type(8)));
typedef float f32x4 __attribute__((ext_vector_type(4)));
typedef unsigned u32x4 __attribute__((ext_vector_type(4)));
typedef unsigned u32x2 __attribute__((ext_vector_type(2)));
constexpr int DM = 1024, MT = 24576, MCTX = 8192, LCTX = 256, LLAT = 2048, NWAVES = 8, NTHR = 512;
constexpr int NPROJ_E = 3072, NB_E = 3328, IN_EVEN_LD = 3088;
constexpr float EPSF = 1e-6f;
constexpr size_t MiB = 1u << 20;
constexpr size_t WS_MOD = 0, MOD_BYTES = 4 * 9 * 6144 * 4, WS_S5F = 1 * MiB, WS_AB = 3 * MiB, WS_W1T = 5 * MiB, WS_W2T = 37 * MiB, WS_WINE = 69 * MiB,
                 WS_WOUTE = 82 * MiB, WS_WINO = 86 * MiB, WS_WOUTO = 94 * MiB, WS_WG = 98 * MiB, WS_H = 102 * MiB, WS_BIG = 150 * MiB, WS_YBUF = 294 * MiB,
                 WS_GATES = 246 * MiB, WS_MIX = 342 * MiB, WS_HALO = 390 * MiB, WS_END = 390 * MiB + 384 * 3 * 1536 * 2;
constexpr int LDS_BYTES = 147456;
constexpr size_t OUT_S5RE = 25165824, OUT_S5IM = OUT_S5RE + 262144, OUT_DELTA = OUT_S5IM + 262144, OUT_LRU = OUT_DELTA + 8388608;

struct Params { const float* in[40]; float* out; unsigned char* ws; };
enum { I_XP = 0, I_XS, I_S5RE, I_S5IM, I_SDELTA, I_SLRU, I_C, I_CCTX, I_WADA, I_BADA, I_NMIXPRE, I_NMIXPOST, I_NMLPPRE, I_NMLPPOST, I_WMLPIN, I_WMLPOUT, I_WINE, I_WOUTE,
       I_LAMRE, I_LAMIM, I_LOGDT, I_BRE, I_BIM, I_CRE, I_CIM, I_S5D, I_GCONVW, I_GCONVB, I_GALOG, I_GDTB, I_GONORM, I_WINO, I_WOUTO, I_LCONVW, I_LCONVB, I_LWR, I_LBR, I_LWI, I_LBI, I_LLAM };

typedef __bf16 bf2_t __attribute__((ext_vector_type(2)));
typedef float f2_t __attribute__((ext_vector_type(2)));
__device__ __forceinline__ unsigned pk2(float lo, float hi) { const bf2_t v = __builtin_convertvector((f2_t){lo, hi}, bf2_t); return __builtin_bit_cast(unsigned, v); }
__device__ __forceinline__ unsigned f2bf(float f) { return pk2(f, f) & 0xffffu; }
__device__ __forceinline__ float bflo(unsigned w) { return __builtin_bit_cast(float, w << 16); }
__device__ __forceinline__ float bfhi(unsigned w) { return __builtin_bit_cast(float, w & 0xffff0000u); }
__device__ __forceinline__ float bf2f(bf16 b) { return __builtin_bit_cast(float, (unsigned)b << 16); }
__device__ __forceinline__ float sigmoidf_(float x) { return __builtin_amdgcn_rcpf(1.0f + __expf(-x)); }
__device__ __forceinline__ float siluf_(float x) { return x * sigmoidf_(x); }
__device__ __forceinline__ float softplusf_(float x) { return fmaxf(x, 0.f) + __logf(1.0f + __expf(-fabsf(x))); }
__device__ __forceinline__ float geluf_(float x) { const float y = 0.7978845608028654f * (x + 0.044715f * x * x * x); const float t = 1.0f - 2.0f * __builtin_amdgcn_rcpf(__expf(2.0f * y) + 1.0f); return 0.5f * x * (1.0f + t); }
__device__ __forceinline__ float shfl_i(float v, int srclane) { return __builtin_bit_cast(float, __builtin_amdgcn_ds_bpermute(srclane << 2, __builtin_bit_cast(int, v))); }
__device__ __forceinline__ float wave_sum(float v, int lane) {
#pragma unroll
    for (int o = 1; o < 64; o <<= 1) v += shfl_i(v, lane ^ o);
    return v;
}
#define LDS_WAIT() asm volatile("s_waitcnt lgkmcnt(0)" ::: "memory")
#define WAVE_SYNC() do { asm volatile("s_waitcnt lgkmcnt(0)" ::: "memory"); __builtin_amdgcn_wave_barrier(); } while (0)
__device__ __forceinline__ f32x4 mfma16(bf16x8 a, bf16x8 b, f32x4 c) { return __builtin_amdgcn_mfma_f32_16x16x32_bf16(a, b, c, 0, 0, 0); }


#define XB_TMO      128
#define XB_XCNT(j)  (256  + 64 * (j))
#define XB_XSUB(j)  (1280 + 64 * (j))
#define XB_XGEN(j)  (2304 + 64 * (j))
#define XB_TOP      3328
#define XB_TOPGEN   3392
#define XCD_BAR_WORDS 3456
#define XB_SPIN_CAP (1u << 18)
constexpr size_t WS_BAR = 960 * 1024; constexpr int LDS_BARST = LDS_BYTES - 16;
__device__ __forceinline__ unsigned xb_ld(unsigned* p)              { return __hip_atomic_load(p, __ATOMIC_RELAXED, __HIP_MEMORY_SCOPE_AGENT); }
__device__ __forceinline__ unsigned xb_add(unsigned* p, unsigned v) { return __hip_atomic_fetch_add(p, v, __ATOMIC_RELAXED, __HIP_MEMORY_SCOPE_AGENT); }
__device__ __forceinline__ unsigned xb_xcc_id() { return (unsigned)__builtin_amdgcn_s_getreg((3 << 11) | 20) & 0xFu; }
#define XB_SPIN(cond, bar) do { unsigned _sp = 0; while (cond) { __builtin_amdgcn_s_sleep(1); \
    if ((++_sp & 255u) == 0u) { if (xb_ld(&(bar)[XB_TMO])) break; if (_sp > XB_SPIN_CAP) { atomicAdd(&(bar)[XB_TMO], 1u); break; } } } } while (0)
__device__ __forceinline__ void xcd_barrier_complete(unsigned* bar, unsigned x, unsigned& nloc, unsigned& nx) {
    const unsigned G = gridDim.x;
    unsigned sum, cnt, mine, sp = 0u;
    for (;;) {
        sum = 0u; cnt = 0u; mine = 0u;
#pragma unroll
        for (unsigned j = 0; j < 16; ++j) { const unsigned c = xb_ld(&bar[XB_XCNT(j)]); sum += c; cnt += (c > 0u) ? 1u : 0u; mine = (j == x) ? c : mine; }
        if (sum == G) break;
        __builtin_amdgcn_s_sleep(1);
        if ((++sp & 255u) == 0u) { if (xb_ld(&bar[XB_TMO])) break; if (sp > XB_SPIN_CAP) { atomicAdd(&bar[XB_TMO], 1u); break; } }
    }
    nloc = mine > 0u ? mine : 1u; nx = cnt > 0u ? cnt : 1u;
}
__device__ __forceinline__ void xcd_barrier(int wid0, unsigned* bar, LAS unsigned char* lds) {
    const int tid = tid_fresh(wid0);
    asm volatile("s_waitcnt vmcnt(0)" ::: "memory");
    __syncthreads();
    if (tid == 0) {
        const unsigned x = xb_xcc_id();
        volatile LAS unsigned* st = (volatile LAS unsigned*)(lds + LDS_BARST);
        __builtin_amdgcn_s_waitcnt(0);
        unsigned nloc = st[0], nx = st[1];
        if (nloc == 0u) { xcd_barrier_complete(bar, x, nloc, nx); st[0] = nloc; st[1] = nx; }
        const unsigned old = xb_add(&bar[XB_XSUB(x)], 1u);
        const unsigned gen = old / nloc;
        if (old + 1u == (gen + 1u) * nloc) {
            __builtin_amdgcn_fence(__ATOMIC_RELEASE, "agent");
            asm volatile("s_waitcnt vmcnt(0)" ::: "memory");
            const unsigned og = xb_add(&bar[XB_TOP], 1u);
            const unsigned tg = og / nx;
            if (og + 1u == (tg + 1u) * nx) xb_add(&bar[XB_TOPGEN], 1u);
            else XB_SPIN(xb_ld(&bar[XB_TOPGEN]) == tg, bar);
            __builtin_amdgcn_fence(__ATOMIC_ACQUIRE, "agent");
            xb_add(&bar[XB_XGEN(x)], 1u);
            asm volatile("s_waitcnt vmcnt(0)" ::: "memory");
        } else {
            XB_SPIN(xb_ld(&bar[XB_XGEN(x)]) == gen, bar);
            __builtin_amdgcn_fence(__ATOMIC_ACQUIRE, "agent");
            asm volatile("s_waitcnt vmcnt(0)" ::: "memory");
        }
    }
    __syncthreads();
}
__device__ __forceinline__ void transpose_item(const float* W, int ldw, int nvalid, int K, bf16* WT, int dst_row0, LAS float* scr, int k0, int n0, int lane) {
    const int nn = n0 + (lane & 31); const bool ok = nn < nvalid;
#pragma unroll 8
    for (int i = 0; i < 32; ++i) { const int kk = 2 * i + (lane >> 5); scr[kk * 33 + (lane & 31)] = ok ? W[(size_t)(k0 + kk) * ldw + nn] : 0.f; }
    WAVE_SYNC();
    const int c = lane & 7;
#pragma unroll
    for (int j = 0; j < 4; ++j) { const int n = (lane >> 3) + 8 * j; const LAS float* s = scr + (8 * c) * 33 + n;
        u32x4 o; o.x = pk2(s[0 * 33], s[1 * 33]); o.y = pk2(s[2 * 33], s[3 * 33]); o.z = pk2(s[4 * 33], s[5 * 33]); o.w = pk2(s[6 * 33], s[7 * 33]);
        *(u32x4*)(WT + (size_t)(dst_row0 + n) * K + k0 + 8 * c) = o; }
    WAVE_SYNC();
}
constexpr int WITEMS_EVEN = 4096 + 1552 + 512, WITEMS_ODD = 4096 + 1024 + 512 + 512;
__device__ __forceinline__ void weight_item(const Params& P, LAS float* scr, int l, int r, int lane) {
    unsigned char* ws = P.ws; const int eo = l >> 1;
    if (r < 2048) { const int q = r; transpose_item(P.in[I_WMLPIN] + (size_t)l * 1024 * 4096, 4096, 4096, 1024, (bf16*)(ws + WS_W1T) + (size_t)l * 4096 * 1024, 32 * (q & 127), scr, 64 * (q >> 7), 32 * (q & 127), lane); return; } r -= 2048;
    if (r < 2048) { const int q = r; transpose_item(P.in[I_WMLPOUT] + (size_t)l * 4096 * 1024, 1024, 1024, 4096, (bf16*)(ws + WS_W2T) + (size_t)l * 1024 * 4096, 32 * (q & 31), scr, 64 * (q >> 5), 32 * (q & 31), lane); return; } r -= 2048;
    if ((l & 1) == 0) {
        if (r < 1552) { const int kb = r / 97, nb = r % 97; transpose_item(P.in[I_WINE] + (size_t)eo * 1024 * IN_EVEN_LD, IN_EVEN_LD, IN_EVEN_LD, 1024, (bf16*)(ws + WS_WINE) + (size_t)eo * NB_E * 1024, 32 * nb, scr, 64 * kb, 32 * nb, lane); return; } r -= 1552;
        { const int q = r; transpose_item(P.in[I_WOUTE] + (size_t)eo * 1024 * 1024, 1024, 1024, 1024, (bf16*)(ws + WS_WOUTE) + (size_t)eo * 1024 * 1024, 32 * (q & 31), scr, 64 * (q >> 5), 32 * (q & 31), lane); return; }
    } else {
        if (r < 1024) { const int q = r; transpose_item(P.in[I_WINO] + (size_t)eo * 1024 * 2048, 2048, 2048, 1024, (bf16*)(ws + WS_WINO) + (size_t)eo * 2048 * 1024, 32 * (q & 63), scr, 64 * (q >> 6), 32 * (q & 63), lane); return; } r -= 1024;
        if (r < 512) { const int q = r; transpose_item(P.in[I_WOUTO] + (size_t)eo * 1024 * 1024, 1024, 1024, 1024, (bf16*)(ws + WS_WOUTO) + (size_t)eo * 1024 * 1024, 32 * (q & 31), scr, 64 * (q >> 5), 32 * (q & 31), lane); return; } r -= 512;
        { const int mat = eo * 16 + (r >> 5), q = r & 31, kb = q >> 3, nb = q & 7; const int blk = mat & 3, gate = (mat >> 2) & 1, od = mat >> 3;
          const float* src = (gate ? P.in[I_LWI] : P.in[I_LWR]) + (size_t)(od * 4 + blk) * 65536;
          const int j0 = nb * 32; const int drow = (blk * 2 + (j0 >> 7)) * 256 + gate * 128 + (j0 & 127);
          transpose_item(src, 256, 256, 256, (bf16*)(ws + WS_WG) + (size_t)od * 2048 * 256, drow, scr, 64 * kb, j0, lane); return; }
    }
}
__device__ __forceinline__ void phase_prologue(int wid0, const Params& P, LAS unsigned char* lds) {
    const int tid = tid_fresh(wid0), lane = tid & 63, wave = tid >> 6;
    LAS float* scr = (LAS float*)(lds + wave * 16384);
    const int gw = bid_fresh() * NWAVES + wave, NGW = grid_fresh() * NWAVES;
    unsigned char* ws = P.ws;
    constexpr int NTR = WITEMS_EVEN, NMOD = 4 * 24 * 16;
    for (int it = gw; it < NTR + NMOD; it += NGW) {
        int r = it;
        if (r < NTR) { weight_item(P, scr, 0, r, lane); continue; } r -= NTR;
        {
            const int l = r / 384, rem = r % 384, ec = rem >> 4, ks = rem & 15, k0 = ks * 64;
#pragma unroll
            for (int rr = 0; rr < 9; ++rr) { const float cv = rr == 0 ? P.in[I_CCTX][k0 + lane] : P.in[I_C][(rr - 1) * 1024 + k0 + lane]; scr[rr * 64 + lane] = siluf_(cv); }
            WAVE_SYNC();
            f32x4 acc[9];
#pragma unroll
            for (int rr = 0; rr < 9; ++rr) acc[rr] = (f32x4){0.f, 0.f, 0.f, 0.f};
            const float* wp = P.in[I_WADA] + ((size_t)l * 1024 + k0) * 6144 + ec * 256 + lane * 4;
#pragma unroll 4
            for (int kk = 0; kk < 64; ++kk) { const f32x4 w4 = *(const f32x4*)(wp + (size_t)kk * 6144);
#pragma unroll
                for (int rr = 0; rr < 9; ++rr) acc[rr] += w4 * scr[rr * 64 + kk]; }
            float* part = (float*)(ws + WS_BIG) + ((size_t)(ks * 4 + l) * 9) * 6144 + ec * 256 + lane * 4;
#pragma unroll
            for (int rr = 0; rr < 9; ++rr) *(f32x4*)(part + (size_t)rr * 6144) = acc[rr];
            WAVE_SYNC();
        }
    }
    { const size_t per = (size_t)(NB_E - 3104) * 1024 * 2 / 16;
      for (size_t i = (size_t)bid_fresh() * NTHR + tid; i < 2 * per; i += (size_t)grid_fresh() * NTHR) { const size_t e = i / per, q = i % per;
          *(u32x4*)(ws + WS_WINE + (e * NB_E + 3104) * 1024 * 2 + q * 16) = (u32x4){0u, 0u, 0u, 0u}; } }
}
__device__ __forceinline__ void phase_modreduce(int wid0, const Params& P) {
    const int tid = tid_fresh(wid0);
    const float* part = (const float*)(P.ws + WS_BIG); float* mod = (float*)(P.ws + WS_MOD);
    for (int i = bid_fresh() * NTHR + tid; i < 4 * 9 * 6144 / 4; i += grid_fresh() * NTHR) {
        const int l = i / (9 * 1536), e4 = i % 1536;
        f32x4 a = *(const f32x4*)(P.in[I_BADA] + (size_t)l * 6144 + e4 * 4);
#pragma unroll
        for (int ks = 0; ks < 16; ++ks) a += *(const f32x4*)(part + (size_t)ks * 4 * 9 * 6144 + (size_t)i * 4);
        *(f32x4*)(mod + (size_t)i * 4) = a; }
}
__device__ __forceinline__ void phase_rownorm(int wid0, const Params& P, int first, const bf16* obuf, const float* modg, int goff, const float* gpost, int has_next, const float* gpre, const float* mods, int soff, bf16* H, float gscale = 1.0f) {
    const int tid = tid_fresh(wid0), lane = tid & 63, wave = tid >> 6;
    const int gw = bid_fresh() * NWAVES + wave, NGW = grid_fresh() * NWAVES;
    float* X = P.out;
    f32x4 xn[4]; u32x2 on[4];
#define RN_LOAD(mm) do { const int m_ = (mm); const float* xs_ = first ? (m_ < MCTX ? P.in[I_XP] + (size_t)m_ * DM : P.in[I_XS] + (size_t)(m_ - MCTX) * DM) : X + (size_t)m_ * DM; \
        _Pragma("unroll") for (int j = 0; j < 4; ++j) { xn[j] = *(const f32x4*)(xs_ + lane * 4 + 256 * j); if (!first) on[j] = *(const u32x2*)(obuf + (size_t)m_ * DM + lane * 4 + 256 * j); } } while (0)
    if (gw < MT) RN_LOAD(gw);
    for (int m = gw; m < MT; m += NGW) {
        const int modrow = m < MCTX ? 0 : 1 + ((m - MCTX) >> 11);
        const float* mr = modg + (size_t)modrow * 6144; const float* ms = mods + (size_t)modrow * 6144;
        f32x4 x[4]; u32x2 ov[4];
#pragma unroll
        for (int j = 0; j < 4; ++j) { x[j] = xn[j]; ov[j] = on[j]; }
        if (m + NGW < MT) RN_LOAD(m + NGW);
        if (first) {
            if (m >= MCTX) {
                const int t = (m - MCTX) & 2047; const float prow = (float)(t >> 6), pcol = (float)(t & 63);
                f32x4 om;
#pragma unroll
                for (int e = 0; e < 4; ++e) om[e] = exp2f(-(float)(lane * 4 + e) * (13.287712379549449f / 256.0f));
#pragma unroll
                for (int j = 0; j < 4; ++j) {
#pragma unroll
                    for (int e = 0; e < 4; ++e) { const float a = (j < 2 ? prow : pcol) * om[e]; x[j][e] += (j & 1) ? cosf(a) : sinf(a); } }
            }
        } else {
            float ss = 0.f;
#pragma unroll
            for (int j = 0; j < 4; ++j) { const float a = bflo(ov[j].x), b = bfhi(ov[j].x), c = bflo(ov[j].y), d = bfhi(ov[j].y); ss += (a * a + b * b) + (c * c + d * d); }
            const float rs = rsqrtf(wave_sum(ss, lane) * (1.0f / DM) + EPSF);
#pragma unroll
            for (int j = 0; j < 4; ++j) { const f32x4 g4 = *(const f32x4*)(gpost + lane * 4 + 256 * j), gt = *(const f32x4*)(mr + goff + lane * 4 + 256 * j);
                f32x4 o4 = (f32x4){bflo(ov[j].x), bfhi(ov[j].x), bflo(ov[j].y), bfhi(ov[j].y)};
                x[j] += gt * (o4 * (rs * gscale) * g4); }
        }
#pragma unroll
        for (int j = 0; j < 4; ++j) *(f32x4*)(X + (size_t)m * DM + lane * 4 + 256 * j) = x[j];
        if (has_next) {
            float ss = 0.f;
#pragma unroll
            for (int j = 0; j < 4; ++j) ss += (x[j][0] * x[j][0] + x[j][1] * x[j][1]) + (x[j][2] * x[j][2] + x[j][3] * x[j][3]);
            const float rs = rsqrtf(wave_sum(ss, lane) * (1.0f / DM) + EPSF);
#pragma unroll
            for (int j = 0; j < 4; ++j) { const f32x4 g4 = *(const f32x4*)(gpre + lane * 4 + 256 * j), sh = *(const f32x4*)(ms + soff + lane * 4 + 256 * j), sc = *(const f32x4*)(ms + soff + 1024 + lane * 4 + 256 * j);
                const f32x4 h4 = (x[j] * rs * g4) * (sc + 1.0f) + sh;
                u32x2 w; w.x = pk2(h4[0], h4[1]); w.y = pk2(h4[2], h4[3]);
                *(u32x2*)(H + (size_t)m * DM + lane * 4 + 256 * j) = w; }
        }
    }
}

using pg8::Unit;
template <int ACT  > struct EpiBf16 {
    bf16* O; int ldc; float* AB;
    bf16* HALO;
    __device__ __forceinline__ void operator()(const f32x4 (&acc)[2][2][4][2], const Unit& u, int wr, int wc, int fr, int fq) const {
        const int row0 = u.pm * 256 + wr * 64 + fr, col0 = u.pn * 256 + wc * 32 + 8 * fq;
        if (AB && u.pn * 256 >= ldc) {
            if (wc == 0 && fq < 2) {
#pragma unroll
                for (int ai = 0; ai < 2; ++ai)
#pragma unroll
                    for (int m = 0; m < 4; ++m) { float* p = AB + (size_t)(row0 + ai * 128 + m * 16) * 16 + 8 * fq; *(f32x4*)p = acc[ai][0][m][0]; *(f32x4*)(p + 4) = acc[ai][0][m][1]; }
            }
            return;
        }
#pragma unroll
        for (int ai = 0; ai < 2; ++ai)
#pragma unroll
            for (int m = 0; m < 4; ++m) { bf16* rowp = O + (size_t)(row0 + ai * 128 + m * 16) * ldc + col0;
#pragma unroll
                for (int bj = 0; bj < 2; ++bj) { f32x4 v0 = acc[ai][bj][m][0], v1 = acc[ai][bj][m][1];
                    if (ACT == 1) {
#pragma unroll
                        for (int j = 0; j < 4; ++j) { const float a = fmaxf(v0[j], 0.f), b = fmaxf(v1[j], 0.f); v0[j] = a * a; v1[j] = b * b; } }
                    u32x4 w; w.x = pk2(v0[0], v0[1]); w.y = pk2(v0[2], v0[3]); w.z = pk2(v1[0], v1[1]); w.w = pk2(v1[2], v1[3]);
                    *(u32x4*)(rowp + bj * 128) = w;
                    if (ACT == 0 && HALO && u.pn >= 4 && u.pn < 10 && ((m == 3 && fr == 15) || (m == 0 && fr < 2))) {
                        const int r = row0 + ai * 128 + m * 16; const int which = (m == 3) ? 0 : 1 + fr;
                        *(u32x4*)(HALO + ((size_t)(r >> 6) * 3 + which) * 1536 + (col0 + bj * 128 - 1024)) = w; } } }
    }
};
struct EpiSplit {
    bf16* O0; long stride;
    __device__ __forceinline__ void operator()(const f32x4 (&acc)[2][2][4][2], const Unit& u, int wr, int wc, int fr, int fq) const {
        const int row0 = u.pm * 256 + wr * 64 + fr, col0 = (u.pn >> 1) * 256 + wc * 32 + 8 * fq; bf16* O = O0 + (long)(u.pn & 1) * stride;
#pragma unroll
        for (int ai = 0; ai < 2; ++ai)
#pragma unroll
            for (int m = 0; m < 4; ++m) { bf16* rowp = O + (size_t)(row0 + ai * 128 + m * 16) * DM + col0;
#pragma unroll
                for (int bj = 0; bj < 2; ++bj) { const f32x4 v0 = acc[ai][bj][m][0], v1 = acc[ai][bj][m][1];
                    u32x4 w; w.x = pk2(v0[0], v0[1]); w.y = pk2(v0[2], v0[3]); w.z = pk2(v1[0], v1[1]); w.w = pk2(v1[2], v1[3]);
                    *(u32x4*)(rowp + bj * 128) = w; } }
    }
};
struct EpiGates {
    unsigned* G; const bf16* X; const float* br; const float* bi; const float* lam;
    __device__ __forceinline__ void operator()(const f32x4 (&acc)[2][2][4][2], const Unit& u, int wr, int wc, int fr, int fq) const {
        const int row0 = u.pm * 256 + wr * 64 + fr, ch0 = u.pn * 128 + wc * 32 + 8 * fq;
#pragma unroll
        for (int n = 0; n < 2; ++n) {
            const f32x4 vbr = *(const f32x4*)(br + ch0 + 4 * n), vbi = *(const f32x4*)(bi + ch0 + 4 * n), l4 = *(const f32x4*)(lam + ch0 + 4 * n);
            f32x4 vsp;
#pragma unroll
            for (int e = 0; e < 4; ++e) vsp[e] = -8.0f * softplusf_(-l4[e]);
#pragma unroll
            for (int ai = 0; ai < 2; ++ai)
#pragma unroll
                for (int m = 0; m < 4; ++m) { const size_t row = (size_t)(row0 + ai * 128 + m * 16);
                    const u32x2 xv = *(const u32x2*)(X + row * DM + ch0 + 4 * n);
                    const float xs[4] = {bflo(xv.x), bfhi(xv.x), bflo(xv.y), bfhi(xv.y)};
                    u32x4 w;
#pragma unroll
                    for (int e = 0; e < 4; ++e) { const float r = sigmoidf_(acc[ai][0][m][n][e] + vbr[e]), ig = sigmoidf_(acc[ai][1][m][n][e] + vbi[e]);
                        const float la = r * vsp[e]; const float a_ = __expf(la); const float b = __builtin_amdgcn_sqrtf(fmaxf(1.0f - a_ * a_, 0.f)) * ig * xs[e];
                        w[e] = pk2(1.0f - a_, b); }
                    *(u32x4*)(G + row * DM + ch0 + 4 * n) = w; }
        }
    }
};
constexpr int S5_WLDS = 12800, BU_P = 132, HS_P = 136;
struct S5Dir { float ar, ai; bf16x8 Bf[8]; };
__device__ __forceinline__ void s5_dir_setup(const Params& P, int e, int d, int g, int lane, float& ar, float& ai, bf16x8 (&Bf)[8], bool needB) {
    const int quad = lane >> 4, l15 = lane & 15;
    const float dt = __expf(P.in[I_LOGDT][(e * 2 + d) * 32 + g]);
    const float lr = P.in[I_LAMRE][((e * 2 + d) * 32 + g) * 64 + lane], li = P.in[I_LAMIM][((e * 2 + d) * 32 + g) * 64 + lane];
    const float mag = expf(lr * dt); ar = mag * cosf(li * dt); ai = mag * sinf(li * dt);
    const float den = lr * lr + li * li;
    const float fr = ((ar - 1.0f) * lr + ai * li) / den, fi = (ai * lr - (ar - 1.0f) * li) / den;
    if (needB) {
#pragma unroll
        for (int nt = 0; nt < 8; ++nt) { const int col = 16 * nt + l15, p = col & 63;
            const float frp = shfl_i(fr, p), fip = shfl_i(fi, p);
            bf16x8 v = (bf16x8){0, 0, 0, 0, 0, 0, 0, 0};
            if (quad < 2) { const float* bre = P.in[I_BRE] + ((size_t)(e * 32 + g) * 64 + p) * 16 + quad * 8; const float* bim = P.in[I_BIM] + ((size_t)(e * 32 + g) * 64 + p) * 16 + quad * 8;
#pragma unroll
                for (int j = 0; j < 8; ++j) { const float br = bre[j], bi = bim[j]; const float val = (nt < 4) ? (frp * br - fip * bi) : (frp * bi + fip * br); v[j] = (short)f2bf(val); } }
            Bf[nt] = v; }
    }
}
__device__ __forceinline__ void s5_c_setup(const Params& P, int e, int g, int lane, bf16x8 (&Cf)[4]) {
    const int quad = lane >> 4, l15 = lane & 15;
#pragma unroll
    for (int ks = 0; ks < 4; ++ks) { const int col0 = 32 * ks + quad * 8; const bool im = col0 >= 64;
        const float* src = (im ? P.in[I_CIM] : P.in[I_CRE]) + ((size_t)(e * 32 + g) * 16 + l15) * 64 + (col0 & 63);
        bf16x8 v;
#pragma unroll
        for (int j = 0; j < 8; ++j) v[j] = (short)f2bf(im ? -src[j] : src[j]);
        Cf[ks] = v; }
}
__device__ __forceinline__ void s5_scan_seg(const Params& P, LAS unsigned char* wl, int lane, int d, int g, int m0, float ar, float ai, const bf16x8 (&Bf)[8], const bf16x8 (&Cf)[4],
                                            float& hr, float& hi, int mode, int ymode, const bf16* proj, float* ybuf, bf16* mixout, float dsk, int dry = 0) {
    const int quad = lane >> 4, l15 = lane & 15;
    LAS float* BU = (LAS float*)wl; LAS bf16* HS = (LAS bf16*)(wl + 8448);
    const int ch = g * 16 + l15;
    bf16x8 a_next = (bf16x8){0, 0, 0, 0, 0, 0, 0, 0};
    if (mode == 0 && quad < 2) { const int blk0 = d ? 15 : 0; const int tt = d ? 15 - l15 : l15; a_next = *(const bf16x8*)(proj + (size_t)(m0 + 16 * blk0 + tt) * NPROJ_E + g * 16 + quad * 8); }
    for (int bi_ = 0; bi_ < 16; ++bi_) {
        const int blk = d ? 15 - bi_ : bi_;
        const int mb = m0 + 16 * blk;
        const bf16x8 a = a_next;
        if (mode == 0 && quad < 2 && bi_ + 1 < 16) { const int blkn = d ? 14 - bi_ : bi_ + 1; const int tt = d ? 15 - l15 : l15; a_next = *(const bf16x8*)(proj + (size_t)(m0 + 16 * blkn + tt) * NPROJ_E + g * 16 + quad * 8); }
        float pre[4], zz[4];
#pragma unroll
        for (int jj = 0; jj < 4; ++jj) { const int row = quad * 4 + jj; const int tt = d ? 15 - row : row; const size_t m = (size_t)(mb + tt);
            pre[jj] = (ymode == 0) ? dsk * bf2f(proj[m * NPROJ_E + ch]) : ybuf[m * 512 + ch];
            zz[jj] = (ymode == 2) ? bf2f(proj[m * NPROJ_E + 512 + ch]) : 0.f; }
        if (mode == 0) {
#pragma unroll
            for (int nt = 0; nt < 8; ++nt) { f32x4 acc = mfma16(a, Bf[nt], (f32x4){0.f, 0.f, 0.f, 0.f});
#pragma unroll
                for (int jj = 0; jj < 4; ++jj) BU[(quad * 4 + jj) * BU_P + 16 * nt + l15] = acc[jj]; }
            WAVE_SYNC();
        }
#pragma unroll
        for (int r = 0; r < 16; ++r) {
            float br = 0.f, bim = 0.f;
            if (mode == 0) { br = BU[r * BU_P + lane]; bim = BU[r * BU_P + 64 + lane]; }
            const float nr = ar * hr - ai * hi + br, ni = ar * hi + ai * hr + bim; hr = nr; hi = ni;
            HS[r * HS_P + lane] = (bf16)f2bf(hr); HS[r * HS_P + 64 + lane] = (bf16)f2bf(hi);
        }
        WAVE_SYNC();
        f32x4 y = (f32x4){0.f, 0.f, 0.f, 0.f};
#pragma unroll
        for (int ks = 0; ks < 4; ++ks) { const bf16x8 af = *(const LAS bf16x8*)(HS + l15 * HS_P + 32 * ks + quad * 8); y = mfma16(af, Cf[ks], y); }
#pragma unroll
        for (int jj = 0; jj < 4; ++jj) { const int row = quad * 4 + jj; const int tt = d ? 15 - row : row; const size_t m = (size_t)(mb + tt);
            const float v = y[jj] + pre[jj];
            if (!dry) { if (ymode != 2) ybuf[m * 512 + ch] = v;
            else mixout[m * DM + ch] = (bf16)f2bf(geluf_(v) * sigmoidf_(zz[jj])); }
        }
        WAVE_SYNC();
    }
}
__device__ __forceinline__ void s5_task_main(const Params& P, LAS unsigned char* wl, int lane, int e, int sub, int g) {
    const bf16* proj = (const bf16*)(P.ws + WS_BIG); float* ybuf = (float*)(P.ws + WS_YBUF); bf16* mixout = (bf16*)(P.ws + WS_MIX);
    const bool lat = sub >= 32; const int q = sub - 32, b = lat ? (q >> 3) : sub, seg = lat ? (q & 7) : 0;
    const int m0 = lat ? MCTX + b * LLAT + seg * 256 : sub * 256;
    bf16x8 Cf[4]; s5_c_setup(P, e, g, lane, Cf);
    const float dsk = P.in[I_S5D][e * 512 + g * 16 + (lane & 15)];
#pragma unroll 1
    for (int d = 0; d < 2; ++d) {
        float ar, ai; bf16x8 Bf[8]; s5_dir_setup(P, e, d, g, lane, ar, ai, Bf, true);
        float hr = 0.f, hi = 0.f;
        if (lat && ((d == 0 && seg == 0) || (d == 1 && seg == 7))) { const size_t si = ((((size_t)b * 2 + e) * 2 + d) * 32 + g) * 64 + lane; hr = P.in[I_S5RE][si]; hi = P.in[I_S5IM][si]; }
        const int ymode = d == 0 ? 0 : (lat ? 1 : 2);
        s5_scan_seg(P, wl, lane, d, g, m0, ar, ai, Bf, Cf, hr, hi, 0, ymode, proj, ybuf, mixout, dsk);
        if (!lat) { const size_t si = ((((size_t)b * 2 + e) * 2 + d) * 32 + g) * 64 + lane; P.out[OUT_S5RE + si] = hr; P.out[OUT_S5IM + si] = hi; }
        else { float* F = (float*)(P.ws + WS_S5F) + ((((size_t)d * 64 + q) * 32 + g) * 64 + lane) * 2; F[0] = hr; F[1] = hi; }
    }
}
__device__ __forceinline__ void s5_task_corr(const Params& P, LAS unsigned char* wl, int lane, int e, int q, int g, int dry = 0) {
    const bf16* proj = (const bf16*)(P.ws + WS_BIG); float* ybuf = (float*)(P.ws + WS_YBUF); bf16* mixout = (bf16*)(P.ws + WS_MIX);
    const int b = q >> 3, seg = q & 7, m0 = MCTX + b * LLAT + seg * 256;
    bf16x8 Cf[4]; s5_c_setup(P, e, g, lane, Cf);
    bf16x8 Bf[8];
#pragma unroll
    for (int i = 0; i < 8; ++i) Bf[i] = (bf16x8){0, 0, 0, 0, 0, 0, 0, 0};
    const float* Fb = (const float*)(P.ws + WS_S5F);
#pragma unroll 1
    for (int d = 0; d < 2; ++d) {
        float ar, ai; s5_dir_setup(P, e, d, g, lane, ar, ai, Bf, false);
        float pr = ar, pi = ai;
#pragma unroll
        for (int i = 0; i < 8; ++i) { const float nr = pr * pr - pi * pi, ni = 2.0f * pr * pi; pr = nr; pi = ni; }
        float hr = 0.f, hi = 0.f;
        const int cnt = d == 0 ? seg : 7 - seg;
        for (int i = 0; i < cnt; ++i) { const int sj = d == 0 ? i : 7 - i; const float* F = Fb + ((((size_t)d * 64 + b * 8 + sj) * 32 + g) * 64 + lane) * 2;
            const float nr = pr * hr - pi * hi + F[0], ni = pr * hi + pi * hr + F[1]; hr = nr; hi = ni; }
        const int ym = (d == 1 || seg == 7) ? 2 : 1;
        if (cnt > 0) s5_scan_seg(P, wl, lane, d, g, m0, ar, ai, Bf, Cf, hr, hi, 1, ym, proj, ybuf, mixout, 0.f, dry);
    }
}

#ifndef REP_A
#define REP_A 1
#endif
#ifndef REP_B
#define REP_B 1
#endif
#ifndef REP_C
#define REP_C 1
#endif
__device__ __forceinline__ void phase_conv_even(int wid0, const Params& P, int e, int dry = 0) {
    const int tid = tid_fresh(wid0), lane = tid & 63, wave = tid >> 6;
    const int gw = bid_fresh() * NWAVES + wave, NGW = grid_fresh() * NWAVES;
    bf16* proj = (bf16*)(P.ws + WS_BIG); const bf16* HALO = (const bf16*)(P.ws + WS_HALO);
    for (int it = gw; it < 384 * 24; it += NGW) {
        const int c = it / 24, cgp = it % 24, ccol = cgp * 64 + lane;
        const int r0 = c * 64;
        const bool lat = r0 >= MCTX; const int t0 = lat ? ((r0 - MCTX) & 2047) : (r0 & 255); const int L = lat ? LLAT : LCTX;
        bf16* base = proj + (size_t)r0 * NPROJ_E + 1024 + ccol;
        bf16 x[67];
#pragma unroll
        for (int i = 0; i < 64; ++i) x[i + 1] = base[(size_t)i * NPROJ_E];
        x[0] = (t0 > 0) ? HALO[((size_t)(c - 1) * 3 + 0) * 1536 + ccol] : (bf16)0;
        x[65] = (t0 + 64 < L) ? HALO[((size_t)(c + 1) * 3 + 1) * 1536 + ccol] : (bf16)0;
        x[66] = (t0 + 64 < L) ? HALO[((size_t)(c + 1) * 3 + 2) * 1536 + ccol] : (bf16)0;
        const float* cw = P.in[I_GCONVW] + (size_t)e * 4 * 1536 + ccol; const float w0 = cw[0], w1 = cw[1536], w2 = cw[3072], w3 = cw[4608], cb = P.in[I_GCONVB][e * 1536 + ccol];
#pragma unroll
        for (int i = 0; i < 64; ++i) { const float v = cb + w0 * bf2f(x[i]) + w1 * bf2f(x[i + 1]) + w2 * bf2f(x[i + 2]) + w3 * bf2f(x[i + 3]);
            if (!dry) base[(size_t)i * NPROJ_E] = (bf16)f2bf(siluf_(v)); }
    }
}
#define LDS_BARRIER() do { asm volatile("s_waitcnt lgkmcnt(0)" ::: "memory"); __builtin_amdgcn_s_barrier(); asm volatile("" ::: "memory"); } while (0)
constexpr int G_Q = 0, G_K = 17408, G_V = 34816, G_KT = 52224, G_LM = 70656, G_QK = 89088, G_ST = 98304, G_SM = 133120;
constexpr int P128 = 136, P64 = 72, LMP = 68;
__device__ __forceinline__ bf16x8 ld_split8(const LAS bf16* p) {
    const u32x2 a = *(const LAS u32x2*)p, b = *(const LAS u32x2*)(p + 16);
    return __builtin_bit_cast(bf16x8, (u32x4){a.x, a.y, b.x, b.y});
}
__device__ __forceinline__ bf16x8 pack_acc2(const f32x4& a, const f32x4& b) { return __builtin_bit_cast(bf16x8, (u32x4){pk2(a[0], a[1]), pk2(a[2], a[3]), pk2(b[0], b[1]), pk2(b[2], b[3])}); }
__device__ __forceinline__ void gdn_chain(int wid0, const Params& P, LAS unsigned char* lds, int e, int s, int hd, int dir) {
    const int tid = tid_fresh(wid0), lane = tid & 63, w = __builtin_amdgcn_readfirstlane(tid >> 6), quad = lane >> 4, l15 = lane & 15;
    const bool lat = s >= 32; const int b = lat ? s - 32 : s; const int L = lat ? LLAT : LCTX; const int m0 = lat ? MCTX + b * LLAT : s * LCTX;
    const bf16* proj = (const bf16*)(P.ws + WS_BIG); const float* AB = (const float*)(P.ws + WS_AB);
    bf16* Odir = (bf16*)(P.ws + WS_H) + (size_t)dir * MT * 512;
    int zv; asm volatile("v_mov_b32 %0, 0" : "=v"(zv));
    lds += zv;
    LAS bf16* Qs = (LAS bf16*)(lds + G_Q); LAS bf16* Ks = (LAS bf16*)(lds + G_K); LAS bf16* Vs = (LAS bf16*)(lds + G_V); LAS bf16* KT = (LAS bf16*)(lds + G_KT);
    LAS float* Lm = (LAS float*)(lds + G_LM); LAS bf16* VNT = (LAS bf16*)(lds + G_LM); LAS bf16* QKs = (LAS bf16*)(lds + G_QK); LAS bf16* ST = (LAS bf16*)(lds + G_ST);
    LAS bf16* TM = (LAS bf16*)(lds + G_ST); LAS bf16* TT = TM + 64 * P64; LAS bf16* LR = TT + 64 * P64;
    LAS float* rq = (LAS float*)(lds + G_SM); LAS float* rk = rq + 64; LAS float* gcs = rq + 128; LAS float* betas = rq + 192; LAS float* egs = rq + 256; LAS float* kes = rq + 320;
    f32x4 Sacc[8];
    const size_t sbase = ((((size_t)b * 2 + e) * 2 + dir) * 4 + hd) * 16384;
#pragma unroll
    for (int mt = 0; mt < 8; ++mt) Sacc[mt] = (f32x4){0.f, 0.f, 0.f, 0.f};
    if (lat) { const float* sp = P.in[I_SDELTA] + sbase + (size_t)(quad * 4) * 128 + 16 * w + l15;
#pragma unroll
        for (int mt = 0; mt < 8; ++mt)
#pragma unroll
            for (int jj = 0; jj < 4; ++jj) Sacc[mt][jj] = sp[(16 * mt + jj) * 128]; }
    for (int i = tid; i < 2 * 64 * P64 / 2; i += NTHR) ((LAS unsigned*)TM)[i] = 0u;
    const float alog_e = __expf(P.in[I_GALOG][(e * 2 + dir) * 4 + hd]), dtb = P.in[I_GDTB][(e * 2 + dir) * 4 + hd];
    const int nchunk = L / 64;
    u32x4 xr[6]; float ab_a = 0.f, ab_b = 0.f;
#define GDN_LOAD(ci_) do { const int tid_ = tid_fresh(wid0); const int c0_ = dir ? L - 64 * ((ci_) + 1) : 64 * (ci_); \
        _Pragma("unroll") for (int k = 0; k < 6; ++k) { const int p_ = tid_ + 512 * k, part_ = p_ >> 10, row_ = (p_ & 1023) >> 4, pc_ = p_ & 15; \
            xr[k] = *(const u32x4*)(proj + (size_t)(m0 + c0_ + row_) * NPROJ_E + 1024 + part_ * 512 + hd * 128 + pc_ * 8); } \
        if (w == 0) { const int ln_ = tid_ & 63; const size_t m_ = (size_t)(m0 + c0_ + (dir ? 63 - ln_ : ln_)); ab_a = AB[m_ * 16 + dir * 4 + hd]; ab_b = AB[m_ * 16 + 8 + dir * 4 + hd]; } } while (0)
    GDN_LOAD(0);
#pragma unroll 1
    for (int ci = 0; ci < nchunk; ++ci) {
        const int tid = tid_fresh(wid0), lane = tid & 63, quad = lane >> 4, l15 = lane & 15;
        const int c0 = dir ? L - 64 * (ci + 1) : 64 * ci;
        LDS_BARRIER();
#ifndef NO_A
        const float cur_a = ab_a, cur_b = ab_b;
#pragma unroll
        for (int k = 0; k < 6; ++k) { const int p_ = tid + 512 * k, part_ = p_ >> 10, row_ = (p_ & 1023) >> 4, pc_ = p_ & 15;
            LAS bf16* dst = part_ == 0 ? Qs : (part_ == 1 ? Ks : Vs);
            *(LAS u32x4*)(dst + (dir ? 63 - row_ : row_) * P128 + pc_ * 8) = xr[k]; }
        if (ci + 1 < nchunk) GDN_LOAD(ci + 1);
#endif
        LDS_BARRIER();
#pragma unroll 1
        for (int repB = 0; repB < REP_B; ++repB)
        { const int rowid = tid >> 2, part = tid & 3; LAS bf16* src = (rowid < 64 ? Qs : Ks) + (rowid & 63) * P128 + part * 32;
          float ss = 0.f;
#pragma unroll
          for (int i = 0; i < 4; ++i) { const u32x4 v = *(const LAS u32x4*)(src + 8 * i);
#pragma unroll
              for (int j = 0; j < 4; ++j) { const float a = bflo(v[j]), c = bfhi(v[j]); ss += a * a + c * c; } }
          ss += shfl_i(ss, lane ^ 1); ss += shfl_i(ss, lane ^ 2);
          if (part == 0) { if (rowid < 64) rq[rowid] = rsqrtf(ss + EPSF) * 0.08838834764831845f; else rk[rowid - 64] = rsqrtf(ss + EPSF); }
          if (w == 0) { const int t = c0 + (dir ? 63 - lane : lane); const size_t m = (size_t)(m0 + t);
              const float araw = cur_a, braw = cur_b;
              const float gg = -alog_e * softplusf_(araw + dtb);
              float gc = gg;
#pragma unroll
              for (int o = 1; o < 64; o <<= 1) { const float t2 = shfl_i(gc, (lane - o) & 63); if (lane >= o) gc += t2; }
              const float glast = shfl_i(gc, 63);
              gcs[lane] = gc; betas[lane] = sigmoidf_(braw); egs[lane] = __expf(gc); kes[lane] = __expf(glast - gc);
              if (lane == 0) rq[384] = __expf(glast); } }
        LDS_BARRIER();
#ifndef NO_C
#pragma unroll 1
        for (int repC = 0; repC < REP_C; ++repC)
        { const int mt = w & 3; const bool isq = w >= 4; LAS bf16* src = isq ? Qs : Ks;
          bf16x8 a[4];
#pragma unroll
          for (int ks = 0; ks < 4; ++ks) a[ks] = *(const LAS bf16x8*)(src + (16 * mt + l15) * P128 + 32 * ks + quad * 8);
#pragma unroll 1
          for (int nt = 0; nt < 4; ++nt) { f32x4 acc = (f32x4){0.f, 0.f, 0.f, 0.f};
#pragma unroll
              for (int ks = 0; ks < 4; ++ks) { const bf16x8 bb = *(const LAS bf16x8*)(Ks + (16 * nt + l15) * P128 + 32 * ks + quad * 8); acc = mfma16(a[ks], bb, acc); }
              const int j = 16 * nt + l15; const float rkj = rk[j], gcj = gcs[j];
              f32x4 lv;
#pragma unroll
              for (int jj = 0; jj < 4; ++jj) { const int i = 16 * mt + quad * 4 + jj; const float dec = __expf(fminf(gcs[i] - gcj, 0.f));
                  lv[jj] = (i > j) ? acc[jj] * rk[i] * rkj * betas[i] * dec : 0.f;
                  if (isq) QKs[i * P64 + j] = (bf16)f2bf((i >= j) ? acc[jj] * rq[i] * rkj * dec : 0.f); }
              if (!isq) { *(LAS f32x4*)(Lm + j * LMP + 16 * mt + quad * 4) = lv;
#pragma unroll
                  for (int jj = 0; jj < 4; ++jj) LR[(16 * mt + quad * 4 + jj) * P64 + j] = (bf16)f2bf(nt < mt ? lv[jj] : 0.f); } }
          const int dd = tid & 127, tq = tid >> 7;
          unsigned pw[8];
#pragma unroll
          for (int n = 0; n < 16; n += 2) { const int i0 = tq * 16 + n; const float v0 = bf2f(Ks[i0 * P128 + dd]) * rk[i0] * kes[i0], v1 = bf2f(Ks[(i0 + 1) * P128 + dd]) * rk[i0 + 1] * kes[i0 + 1]; pw[n >> 1] = pk2(v0, v1); }
          *(LAS u32x4*)(KT + dd * P64 + tq * 16) = (u32x4){pw[0], pw[1], pw[2], pw[3]};
          *(LAS u32x4*)(KT + dd * P64 + tq * 16 + 8) = (u32x4){pw[4], pw[5], pw[6], pw[7]}; }
#endif
        LDS_BARRIER();
        { const int i = tid >> 3, c0k = (tid & 7) * 16; const float sc = rk[i] * betas[i] * egs[i];
#pragma unroll
          for (int h2 = 0; h2 < 2; ++h2) { u32x4 v = *(LAS u32x4*)(Ks + i * P128 + c0k + 8 * h2);
#pragma unroll
              for (int q = 0; q < 4; ++q) v[q] = pk2(bflo(v[q]) * sc, bfhi(v[q]) * sc);
              *(LAS u32x4*)(Ks + i * P128 + c0k + 8 * h2) = v; } }
        if (w == 0) { const int bb = lane >> 4, c = lane & 15;
            float x[16];
#pragma unroll
            for (int r = 0; r < 16; ++r) x[r] = (r == c) ? 1.f : 0.f;
#pragma unroll
            for (int j = 0; j < 15; ++j) {
#pragma unroll
                for (int q4 = j / 4; q4 < 4; ++q4) { const f32x4 l4 = *(const LAS f32x4*)(Lm + (16 * bb + j) * LMP + 16 * bb + 4 * q4);
#pragma unroll
                    for (int jx = 0; jx < 4; ++jx) if (4 * q4 + jx > j) x[4 * q4 + jx] -= l4[jx] * x[j]; } }
            unsigned pw[8];
#pragma unroll
            for (int r = 0; r < 16; r += 2) { pw[r >> 1] = pk2(x[r], x[r + 1]); TM[(16 * bb + r) * P64 + 16 * bb + c] = (bf16)(pw[r >> 1] & 0xffffu); TM[(16 * bb + r + 1) * P64 + 16 * bb + c] = (bf16)(pw[r >> 1] >> 16); }
            *(LAS u32x4*)(TT + (16 * bb + c) * P64 + 16 * bb) = (u32x4){pw[0], pw[1], pw[2], pw[3]};
            *(LAS u32x4*)(TT + (16 * bb + c) * P64 + 16 * bb + 8) = (u32x4){pw[4], pw[5], pw[6], pw[7]}; }
        LDS_BARRIER();
#pragma unroll 1
        for (int lev = 1; lev < 4; ++lev) {
            if (w < 4 - lev) { const int bj = w, bi = w + lev;
                f32x4 m = (f32x4){0.f, 0.f, 0.f, 0.f};
#pragma unroll
                for (int ks = 0; ks < 2; ++ks) { const bf16x8 a = *(const LAS bf16x8*)(LR + (16 * bi + l15) * P64 + 32 * ks + quad * 8), bq = *(const LAS bf16x8*)(TT + (16 * bj + l15) * P64 + 32 * ks + quad * 8); m = mfma16(a, bq, m); }
                const u32x2 tl = *(const LAS u32x2*)(TM + (16 * bi + l15) * P64 + 16 * bi + quad * 4);
                const bf16x8 a2 = __builtin_bit_cast(bf16x8, (u32x4){tl.x, tl.y, 0u, 0u}), b2 = __builtin_bit_cast(bf16x8, (u32x4){pk2(m[0], m[1]), pk2(m[2], m[3]), 0u, 0u});
                const f32x4 t = mfma16(a2, b2, (f32x4){0.f, 0.f, 0.f, 0.f});
                const unsigned p0 = pk2(-t[0], -t[1]), p1 = pk2(-t[2], -t[3]);
                TM[(16 * bi + quad * 4 + 0) * P64 + 16 * bj + l15] = (bf16)(p0 & 0xffffu); TM[(16 * bi + quad * 4 + 1) * P64 + 16 * bj + l15] = (bf16)(p0 >> 16);
                TM[(16 * bi + quad * 4 + 2) * P64 + 16 * bj + l15] = (bf16)(p1 & 0xffffu); TM[(16 * bi + quad * 4 + 3) * P64 + 16 * bj + l15] = (bf16)(p1 >> 16);
                *(LAS u32x2*)(TT + (16 * bj + l15) * P64 + 16 * bi + quad * 4) = (u32x2){p0, p1}; }
            LDS_BARRIER();
        }
#ifndef NO_EFG
        bf16x8 Bst[4];
#pragma unroll
        for (int ks = 0; ks < 4; ++ks) Bst[ks] = pack_acc2(Sacc[2 * ks], Sacc[2 * ks + 1]);
        f32x4 vn[4];
#pragma unroll
        for (int mt = 0; mt < 4; ++mt) { f32x4 acc = (f32x4){0.f, 0.f, 0.f, 0.f};
#pragma unroll
            for (int ks = 0; ks < 4; ++ks) { const bf16x8 a = ld_split8(Ks + (16 * mt + l15) * P128 + 32 * ks + quad * 4); acc = mfma16(a, Bst[ks], acc); }
#pragma unroll
            for (int jj = 0; jj < 4; ++jj) { const int i = 16 * mt + quad * 4 + jj; vn[mt][jj] = bf2f(Vs[i * P128 + 16 * w + l15]) * betas[i] - acc[jj]; } }
        bf16x8 Bvn[2];
#pragma unroll
        for (int k2 = 0; k2 < 2; ++k2) Bvn[k2] = pack_acc2(vn[2 * k2], vn[2 * k2 + 1]);
#pragma unroll
        for (int mt = 0; mt < 4; ++mt) { f32x4 acc = (f32x4){0.f, 0.f, 0.f, 0.f};
#pragma unroll
            for (int k2 = 0; k2 < 2; ++k2) { const bf16x8 a = ld_split8(TM + (16 * mt + l15) * P64 + 32 * k2 + quad * 4); acc = mfma16(a, Bvn[k2], acc); }
            vn[mt] = acc; }
#pragma unroll
        for (int k2 = 0; k2 < 2; ++k2) Bvn[k2] = pack_acc2(vn[2 * k2], vn[2 * k2 + 1]);
#pragma unroll 1
        for (int mt = 0; mt < 4; ++mt) { f32x4 acc = (f32x4){0.f, 0.f, 0.f, 0.f};
#pragma unroll
            for (int ks = 0; ks < 4; ++ks) { const bf16x8 a = ld_split8(Qs + (16 * mt + l15) * P128 + 32 * ks + quad * 4); acc = mfma16(a, Bst[ks], acc); }
#pragma unroll
            for (int jj = 0; jj < 4; ++jj) { const int i = 16 * mt + quad * 4 + jj; acc[jj] *= rq[i] * egs[i]; }
#pragma unroll
            for (int k2 = 0; k2 < 2; ++k2) { const bf16x8 a = ld_split8(QKs + (16 * mt + l15) * P64 + 32 * k2 + quad * 4); acc = mfma16(a, Bvn[k2], acc); }
#pragma unroll
            for (int jj = 0; jj < 4; ++jj) { const int i = 16 * mt + quad * 4 + jj; const int t = c0 + (dir ? 63 - i : i);
                Odir[(size_t)(m0 + t) * 512 + hd * 128 + 16 * w + l15] = (bf16)f2bf(acc[jj]); } }
        const float egl = rq[384];
#pragma unroll
        for (int mt = 0; mt < 8; ++mt) { f32x4 acc = Sacc[mt] * egl;
#pragma unroll
            for (int k2 = 0; k2 < 2; ++k2) { const bf16x8 a = ld_split8(KT + (16 * mt + l15) * P64 + 32 * k2 + quad * 4); acc = mfma16(a, Bvn[k2], acc); }
            Sacc[mt] = acc; }
#endif
        WAVE_SYNC();
    }
    if (!lat) { const int tid2 = tid_fresh(wid0), lane2 = tid2 & 63; float* dp = P.out + OUT_DELTA + sbase + (size_t)((lane2 >> 4) * 4) * 128 + 16 * w + (lane2 & 15);
#pragma unroll
        for (int mt = 0; mt < 8; ++mt)
#pragma unroll
            for (int jj = 0; jj < 4; ++jj) dp[(16 * mt + jj) * 128] = Sacc[mt][jj];
    }
    __syncthreads();
}

__device__ __forceinline__ void phase_mix_even(int wid0, const Params& P, LAS unsigned char* lds, int e, int mode = 3) {
    const int bid = bid_fresh(), G = grid_fresh();
    if (G == 256) {
        if (bid < 64) { const int s = 32 + (bid >> 3), hd = (bid >> 1) & 3, dir = bid & 1; if (mode & 1) gdn_chain(wid0, P, lds, e, s, hd, dir); }
        else { const int bb = bid - 64;
            if (mode & 1) for (int c = bb; c < 256; c += 192) { const int s = c >> 3, hd = (c >> 1) & 3, dir = c & 1; gdn_chain(wid0, P, lds, e, s, hd, dir); }
            if (mode & 2) { const int tid = tid_fresh(wid0), lane = tid & 63, wave = tid >> 6;
                for (int t = bb; t < 384; t += 192) { const int wt = t * 8 + wave; s5_task_main(P, lds + wave * S5_WLDS, lane, e, wt >> 5, wt & 31); } }
            if (mode == 3) { __syncthreads(); const int tid = tid_fresh(wid0), lane = tid & 63, wave = tid >> 6;
                for (int it = bb * NWAVES + wave; it < WITEMS_ODD; it += 192 * NWAVES) weight_item(P, (LAS float*)(lds + wave * 16384), 2 * e + 1, it, lane); } }
    } else {
        for (int c = bid; c < 320; c += G) { const int s = c < 64 ? 32 + (c >> 3) : ((c - 64) >> 3), hd = (c >> 1) & 3, dir = c & 1; gdn_chain(wid0, P, lds, e, s, hd, dir); }
        const int tid = tid_fresh(wid0), lane = tid & 63, wave = tid >> 6;
        for (int t = bid; t < 384; t += G) { const int wt = t * 8 + wave; s5_task_main(P, lds + wave * S5_WLDS, lane, e, wt >> 5, wt & 31); }
        __syncthreads();
        for (int it = bid * NWAVES + wave; it < WITEMS_ODD; it += G * NWAVES) weight_item(P, (LAS float*)(lds + wave * 16384), 2 * e + 1, it, lane);
    }
}
__device__ __forceinline__ void phase_fin_even(int wid0, const Params& P, LAS unsigned char* lds, int e, int dry = 0) {
    const int tid = tid_fresh(wid0), lane = tid & 63, wave = tid >> 6;
    const int gw = bid_fresh() * NWAVES + wave, NGW = grid_fresh() * NWAVES;
    for (int wt = gw; wt < 2048; wt += NGW) s5_task_corr(P, lds + wave * S5_WLDS, lane, e, wt >> 5, wt & 31, dry);
    const bf16* proj = (const bf16*)(P.ws + WS_BIG); const bf16* Of = (const bf16*)(P.ws + WS_H); const bf16* Ob = Of + (size_t)MT * 512; bf16* mixout = (bf16*)(P.ws + WS_MIX);
    for (int mb2 = gw; mb2 < MT; mb2 += 2 * NGW) {
        u32x4 a[2], bq[2], z[2];
#pragma unroll
        for (int u = 0; u < 2; ++u) { const int m = mb2 + u * NGW; if (m < MT) { a[u] = *(const u32x4*)(Of + (size_t)m * 512 + lane * 8); bq[u] = *(const u32x4*)(Ob + (size_t)m * 512 + lane * 8); z[u] = *(const u32x4*)(proj + (size_t)m * NPROJ_E + 2560 + lane * 8); } }
#pragma unroll
        for (int u = 0; u < 2; ++u) { const int m = mb2 + u * NGW; if (m < MT) {
            float o[8]; float ss = 0.f;
#pragma unroll
            for (int j = 0; j < 4; ++j) { o[2 * j] = bflo(a[u][j]) + bflo(bq[u][j]); o[2 * j + 1] = bfhi(a[u][j]) + bfhi(bq[u][j]); ss += o[2 * j] * o[2 * j] + o[2 * j + 1] * o[2 * j + 1]; }
            ss += shfl_i(ss, lane ^ 1); ss += shfl_i(ss, lane ^ 2); ss += shfl_i(ss, lane ^ 4); ss += shfl_i(ss, lane ^ 8);
            const float rs = rsqrtf(ss * (1.0f / 128.0f) + EPSF);
            const float* gn = P.in[I_GONORM] + e * 128 + (lane & 15) * 8;
            unsigned pw[4];
#pragma unroll
            for (int j = 0; j < 4; ++j) { const float z0 = bflo(z[u][j]), z1 = bfhi(z[u][j]); pw[j] = pk2(o[2 * j] * rs * gn[2 * j] * siluf_(z0), o[2 * j + 1] * rs * gn[2 * j + 1] * siluf_(z1)); }
            if (!dry) *(u32x4*)(mixout + (size_t)m * DM + 512 + lane * 8) = (u32x4){pw[0], pw[1], pw[2], pw[3]}; } }
    }
}

__device__ __forceinline__ void phase_conv_odd(int wid0, const Params& P, int o) {
    const int tid = tid_fresh(wid0), lane = tid & 63, wave = tid >> 6;
    const int gw = bid_fresh() * NWAVES + wave, NGW = grid_fresh() * NWAVES;
    const bf16* proj = (const bf16*)(P.ws + WS_BIG); bf16* cx = (bf16*)(P.ws + WS_H);
    const float* cw = P.in[I_LCONVW] + (size_t)o * 4 * 1024; const float* cb = P.in[I_LCONVB] + o * 1024;
    for (int m = gw; m < MT; m += NGW) {
        const int t = m < MCTX ? (m & 255) : ((m - MCTX) & 2047); const int L = m < MCTX ? LCTX : LLAT;
#pragma unroll
        for (int h2 = 0; h2 < 2; ++h2) { const int ch = lane * 8 + 512 * h2;
            float acc[8];
#pragma unroll
            for (int j = 0; j < 8; ++j) acc[j] = cb[ch + j];
#pragma unroll
            for (int k = 0; k < 4; ++k) { const int tt = t - 1 + k; if (tt >= 0 && tt < L) { const u32x4 v = *(const u32x4*)(proj + (size_t)(m - 1 + k) * 2048 + ch);
#pragma unroll
                    for (int j = 0; j < 4; ++j) { acc[2 * j] += cw[k * 1024 + ch + 2 * j] * bflo(v[j]); acc[2 * j + 1] += cw[k * 1024 + ch + 2 * j + 1] * bfhi(v[j]); } } }
            *(u32x4*)(cx + (size_t)m * DM + ch) = (u32x4){pk2(acc[0], acc[1]), pk2(acc[2], acc[3]), pk2(acc[4], acc[5]), pk2(acc[6], acc[7])}; }
    }
}
__device__ __forceinline__ void phase_lru_scan(int wid0, const Params& P, LAS unsigned char* lds, int o, int d) {
    const int tid = tid_fresh(wid0), lane = tid & 63, wave = tid >> 6;
    const int gw = bid_fresh() * NWAVES + wave, NGW = grid_fresh() * NWAVES;
    const unsigned* G = (const unsigned*)(P.ws + WS_GATES); const bf16* proj = (const bf16*)(P.ws + WS_BIG); bf16* mixout = (bf16*)(P.ws + WS_MIX);
    const int Gn = NGW / NWAVES, vw = wave * Gn + (gw / NWAVES);
    if (d == 0 && o == 0 && NGW > 640) {
        for (int it = vw - 640; it >= 0 && it < WITEMS_EVEN; it += NGW - 640) weight_item(P, (LAS float*)(lds + wave * 16384), 2, it, lane); }
    for (int task = vw; task < 640; task += NGW) {
        int s, cg_;
        if (task < 128) { s = 32 + (task >> 4); cg_ = task & 15; } else { s = (task - 128) >> 4; cg_ = (task - 128) & 15; }
        const bool lat = s >= 32; const int b = lat ? s - 32 : s; const int L = lat ? LLAT : LCTX; const int m0 = lat ? MCTX + b * LLAT : s * LCTX;
        const int ch = cg_ * 64 + lane;
        float h = lat ? P.in[I_SLRU][(((size_t)b * 2 + o) * 2 + d) * 1024 + ch] : 0.f;
        if (d == 0) {
            unsigned ga[32], gb[32];
#define LRU_LD0(dst, tt) _Pragma("unroll") for (int i = 0; i < 32; ++i) dst[i] = G[(size_t)(m0 + (tt) + i) * DM + ch]
#define LRU_CP0(src, tt) _Pragma("unroll") for (int i = 0; i < 32; ++i) { h = (1.0f - bflo(src[i])) * h + bfhi(src[i]); mixout[(size_t)(m0 + (tt) + i) * DM + ch] = (bf16)f2bf(h); }
            LRU_LD0(ga, 0);
            for (int t0 = 0; t0 < L; t0 += 64) {
                LRU_LD0(gb, t0 + 32);
                LRU_CP0(ga, t0);
                if (t0 + 64 < L) { LRU_LD0(ga, t0 + 64); }
                LRU_CP0(gb, t0 + 32);
            }
        } else {
            unsigned ga[16], gb[16]; bf16 pa[16], pb[16], ya[16], yb[16];
#define LRU_LD1(g_, p_, y_, tt) _Pragma("unroll") for (int i = 0; i < 16; ++i) { const size_t m = (size_t)(m0 + L - 1 - ((tt) + i)); g_[i] = G[m * DM + ch]; p_[i] = mixout[m * DM + ch]; y_[i] = proj[m * 2048 + 1024 + ch]; }
#define LRU_CP1(g_, p_, y_, tt) _Pragma("unroll") for (int i = 0; i < 16; ++i) { const size_t m = (size_t)(m0 + L - 1 - ((tt) + i)); \
                h = (1.0f - bflo(g_[i])) * h + bfhi(g_[i]); mixout[m * DM + ch] = (bf16)f2bf((bf2f(p_[i]) + h) * geluf_(bf2f(y_[i]))); }
            LRU_LD1(ga, pa, ya, 0);
            for (int t0 = 0; t0 < L; t0 += 32) {
                LRU_LD1(gb, pb, yb, t0 + 16);
                LRU_CP1(ga, pa, ya, t0);
                if (t0 + 32 < L) { LRU_LD1(ga, pa, ya, t0 + 32); }
                LRU_CP1(gb, pb, yb, t0 + 16);
            }
        }
        if (!lat) P.out[OUT_LRU + (((size_t)b * 2 + o) * 2 + d) * 1024 + ch] = h;
    }
}
#ifdef PROBE_DUP_GEMM
#define DUPG(x) GSYNC(); x
#else
#define DUPG(x)
#endif
typedef const __attribute__((address_space(4))) Params* KParams;
__device__ __forceinline__ Params load_params(KParams q) { Params r;
#pragma unroll
    for (int i = 0; i < 40; ++i) r.in[i] = q->in[i];
    r.out = q->out; r.ws = q->ws; return r; }
#define FRESH() const int G = grid_fresh(), bid = bid_fresh(); (void)G; (void)bid; KParams pk_ = (KParams)__builtin_amdgcn_kernarg_segment_ptr(); asm volatile("" : "+s"(pk_)); const Params P = load_params(pk_); unsigned char* ws = P.ws; \
    const float* mod = (const float*)(ws + WS_MOD); bf16* H = (bf16*)(ws + WS_H); bf16* BIG = (bf16*)(ws + WS_BIG); bf16* MIX = (bf16*)(ws + WS_MIX); (void)mod; (void)H; (void)BIG; (void)MIX;
#define GSYNC() do { KParams pb_ = (KParams)__builtin_amdgcn_kernarg_segment_ptr(); asm volatile("" : "+s"(pb_)); xcd_barrier(wid0, (unsigned*)(pb_->ws + WS_BAR), lds); } while (0)
__global__ void __launch_bounds__(NTHR, 2) fwd_kernel(Params Parg) {
    extern __shared__ __attribute__((aligned(16))) unsigned char lds_raw[];
    LAS unsigned char* lds = (LAS unsigned char*)lds_raw;
    cg::grid_group grid = cg::this_grid();
    const int wid0 = __builtin_amdgcn_readfirstlane(threadIdx.x >> 6);
    if (threadIdx.x < 4) ((LAS unsigned*)(lds + LDS_BARST))[threadIdx.x] = 0u;
    __syncthreads();
    if (threadIdx.x == 0) (void)xb_add((unsigned*)(Parg.ws + WS_BAR) + XB_XCNT(xb_xcc_id()), 1u);

    { FRESH(); phase_prologue(wid0, P, lds); }
    if (grid_fresh() == 0) grid.sync();
    GSYNC();
#ifdef PROBE_DUP_PRO
    { FRESH(); phase_prologue(wid0, P, lds); }
    GSYNC();
#endif
    { FRESH(); phase_modreduce(wid0, P); }
    GSYNC();
#ifdef PROBE_SYNC
#pragma unroll 1
    for (int i = 0; i < 40; ++i) GSYNC();
#endif
#pragma unroll 1
    for (int l = 0; l < 4; ++l) {
        { FRESH(); const float* modl = mod + (size_t)l * 9 * 6144;
        phase_rownorm(wid0, P, l == 0, MIX, modl - 9 * 6144, 5 * 1024, P.in[I_NMLPPOST] + (l > 0 ? (l - 1) * 1024 : 0), 1, P.in[I_NMIXPRE] + l * 1024, modl, 0, H); }
        GSYNC();
        const int eo = l >> 1;
        {
            FRESH();
            pg8::Gemm g; pg8::StaticOrder S; EpiBf16<0> E;
            if ((l & 1) == 0) { g = pg8::Gemm{H, (const bf16*)(ws + WS_WINE) + (size_t)eo * NB_E * 1024, MT, NB_E, 1024, 1024, 0, 0, 1024, 0}; E = EpiBf16<0>{BIG, NPROJ_E, (float*)(ws + WS_AB), (bf16*)(ws + WS_HALO)}; }
            else { g = pg8::Gemm{H, (const bf16*)(ws + WS_WINO) + (size_t)eo * 2048 * 1024, MT, 2048, 1024, 1024, 0, 0, 1024, 0}; E = EpiBf16<0>{BIG, 2048, nullptr, nullptr}; }
            S.init(g.M, g.N, G, bid);
            pg8::gemm_phase(wid0, lds, g, S, E); DUPG(pg8::gemm_phase(wid0, lds, g, S, E);)
        }
        GSYNC();
        if ((l & 1) == 0) {
            { FRESH(); phase_conv_even(wid0, P, eo); }
            GSYNC();
#ifdef PROBE_DRY_CONVE
            { FRESH(); phase_conv_even(wid0, P, eo, grid_fresh() > 0); }
            GSYNC();
#endif
#ifdef PROBE_DUP_MIX
#pragma unroll 1
            for (int rep = 0; rep < 2; ++rep) { { FRESH(); phase_mix_even(wid0, P, lds, eo, rep == 0 ? 3 : PROBE_DUP_MIX); } GSYNC(); }
#else
            { FRESH(); phase_mix_even(wid0, P, lds, eo); }
            GSYNC();
#endif
            { FRESH(); phase_fin_even(wid0, P, lds, eo); }
            GSYNC();
#ifdef PROBE_DRY_FIN
            { FRESH(); phase_fin_even(wid0, P, lds, eo, grid_fresh() > 0); }
            GSYNC();
#endif
        } else {
            { FRESH(); phase_conv_odd(wid0, P, eo); }
            GSYNC();
#ifdef PROBE_DUP_CONV
            { FRESH(); phase_conv_odd(wid0, P, eo); }
            GSYNC();
#endif
#pragma unroll 1
            for (int d = 0; d < 2; ++d) {
                { FRESH();
                pg8::Gemm g{H, (const bf16*)(ws + WS_WG) + (size_t)(eo * 2 + d) * 2048 * 256, MT, 2048, 256, 1024, 1, 1, 256, 0};
                EpiGates E{(unsigned*)(ws + WS_GATES), H, P.in[I_LBR] + (eo * 2 + d) * 1024, P.in[I_LBI] + (eo * 2 + d) * 1024, P.in[I_LLAM] + (eo * 2 + d) * 1024};
                pg8::StaticOrder S; S.init(g.M, g.N, G, bid);
                pg8::gemm_phase(wid0, lds, g, S, E); DUPG(pg8::gemm_phase(wid0, lds, g, S, E);) }
                GSYNC();
                { FRESH(); phase_lru_scan(wid0, P, lds, eo, d); }
#ifdef PROBE_DUP_LRU0
                if (d == 0) { GSYNC(); FRESH(); phase_lru_scan(wid0, P, lds, eo, d); }
#endif
                GSYNC();
            }
        }
        {
            FRESH();
            pg8::Gemm g{MIX, (const bf16*)(ws + ((l & 1) ? WS_WOUTO : WS_WOUTE)) + (size_t)eo * 1024 * 1024, MT, 1024, 1024, 1024, 0, 0, 1024, 0};
            EpiBf16<0> E{BIG, 1024, nullptr, nullptr}; pg8::StaticOrder S; S.init(g.M, g.N, G, bid);
            pg8::gemm_phase(wid0, lds, g, S, E); DUPG(pg8::gemm_phase(wid0, lds, g, S, E);)
        }
        GSYNC();
        { FRESH(); const float* modl = mod + (size_t)l * 9 * 6144;
        phase_rownorm(wid0, P, 0, BIG, modl, 2 * 1024, P.in[I_NMIXPOST] + l * 1024, 1, P.in[I_NMLPPRE] + l * 1024, modl, 3 * 1024, H); }
#ifdef PROBE_DUP_RN
        GSYNC();
        { FRESH(); const float* modl = mod + (size_t)l * 9 * 6144;
        phase_rownorm(wid0, P, 0, BIG, modl, 2 * 1024, P.in[I_NMIXPOST] + l * 1024, 1, P.in[I_NMLPPRE] + l * 1024, modl, 3 * 1024, H, 0.0f); }
#endif
        GSYNC();
        {
            FRESH();
            pg8::Gemm g{H, (const bf16*)(ws + WS_W1T) + (size_t)l * 4096 * 1024, MT, 4096, 1024, 1024, 0, 0, 1024, 0};
            EpiBf16<1> E{BIG, 4096, nullptr, nullptr}; pg8::StaticOrder S; S.init(g.M, g.N, G, bid);
            pg8::gemm_phase(wid0, lds, g, S, E); DUPG(pg8::gemm_phase(wid0, lds, g, S, E);)
        }
        GSYNC();
        {
            FRESH();
            pg8::Gemm g{BIG, (const bf16*)(ws + WS_W2T) + (size_t)l * 1024 * 4096, MT, 1024, 4096, 4096, 0, 0, 4096, 0};
            EpiBf16<0> E{MIX, 1024, nullptr, nullptr}; pg8::StaticOrder S; S.init(g.M, g.N, G, bid);
            pg8::gemm_phase(wid0, lds, g, S, E); DUPG(pg8::gemm_phase(wid0, lds, g, S, E);)
        }
        GSYNC();
    }
    { FRESH();
    phase_rownorm(wid0, P, 0, MIX, mod + (size_t)3 * 9 * 6144, 5 * 1024, P.in[I_NMLPPOST] + 3 * 1024, 0, P.in[I_NMIXPRE], mod, 0, H); }
}

extern "C" void kernel_launch(void* const* d_in, const int* in_sizes, int n_in, void* d_out, int out_size, void* d_ws, size_t ws_size, hipStream_t stream) {
    static int grid = 0;
    if (grid == 0) {
        if (n_in != 40 || ws_size < WS_END) { fprintf(stderr, "kernel_launch: expected 40 inputs and >= %zu bytes of workspace (got %d, %zu)\n", (size_t)WS_END, n_in, ws_size); grid = -1; return; }
        int dev = 0, cus = 0, per_cu = 0;
        if (hipGetDevice(&dev) != hipSuccess || hipDeviceGetAttribute(&cus, hipDeviceAttributeMultiprocessorCount, dev) != hipSuccess) { grid = -1; return; }
        if (hipFuncSetAttribute((const void*)fwd_kernel, hipFuncAttributeMaxDynamicSharedMemorySize, LDS_BYTES) != hipSuccess) { fprintf(stderr, "kernel_launch: hipFuncSetAttribute failed\n"); grid = -1; return; }
        if (hipOccupancyMaxActiveBlocksPerMultiprocessor(&per_cu, (const void*)fwd_kernel, NTHR, LDS_BYTES) != hipSuccess || per_cu < 1) per_cu = 1;
        (void)hipGetLastError();
        grid = cus * per_cu; if (grid > 256) grid = 256;
    }
    if (grid < 0) return;
    (void)hipMemsetAsync((char*)d_ws + WS_BAR, 0, 16384, stream);
    Params p{};
    for (int i = 0; i < 40; ++i) p.in[i] = (const float*)d_in[i];
    p.out = (float*)d_out; p.ws = (unsigned char*)d_ws;
    void* args[] = {&p};
    hipError_t e = hipLaunchCooperativeKernel((const void*)fwd_kernel, dim3(grid), dim3(NTHR), args, LDS_BYTES, stream);
    if (e != hipSuccess) fprintf(stderr, "cooperative launch failed: %s (grid %d)\n", hipGetErrorString(e), grid);
}
```

```cpp
#include <hip/hip_runtime.h>
#include <hip/hip_cooperative_groups.h>
#include <cstdio>
#include <cstdint>
namespace cg = cooperative_groups;
__device__ __forceinline__ int bid_fresh() { int t = blockIdx.x; asm volatile("" : "+s"(t)); return t; }
__device__ __forceinline__ int grid_fresh() { int t = gridDim.x; asm volatile("" : "+s"(t)); return t; }
__device__ __forceinline__ int tid_fresh(int w) { asm volatile("" : "+s"(w)); int l; asm volatile("v_mbcnt_lo_u32_b32 %0, -1, 0\n\tv_mbcnt_hi_u32_b32 %0, -1, %0" : "=v"(l)); return w * 64 + l; }

namespace pg8 {
#define PG8_LAS __attribute__((address_space(3)))
typedef unsigned short bf16_t;
typedef short bf16x8 __attribute__((ext_vector_type(8)));
typedef float f32x4 __attribute__((ext_vector_type(4)));
typedef unsigned u32x4 __attribute__((ext_vector_type(4)));
typedef unsigned u32x2 __attribute__((ext_vector_type(2)));
constexpr int BM = 256, BK = 64, HALF = 128, HTB = HALF * BK * 2, STAGE_BYTES = 8 * HTB, NXCD = 8, WGM = 4;

__host__ __device__ __forceinline__ int lds_byte(int r, int c) { const int st = (r >> 4) * 2 + (c >> 5), rr = r & 15, cc = c & 31, ob = rr * 64 + cc * 2; return st * 1024 + (ob ^ (((ob >> 9) & 1) << 5)); }
__host__ __device__ __forceinline__ void stage_rc(int b, int& R, int& C) { const int st = b / 1024, sb = b % 1024, swz = sb ^ (((sb >> 9) & 1) << 5); R = (st >> 1) * 16 + swz / 64; C = (st & 1) * 32 + (swz % 64) / 2; }
__host__ __device__ __forceinline__ int perm32(int rho) { const int n = rho >> 4, i = rho & 15; return 8 * (i >> 2) + 4 * n + (i & 3); }

struct Unit { int pm, pn; };
struct Gemm { const bf16_t* A; const bf16_t* Bt; int M, N, K, lda, ablk, ashift, ldb, ksplit; };

struct StaticOrder {
    int nM, nN, nwg, G, c;
    __host__ __device__ void init(int M, int N, int G_, int c_) { nM = M / BM; nN = N / BM; nwg = nM * nN; G = G_; c = c_; }
    __host__ __device__ bool next(int i, Unit& u) const {
        const long L = (long)i * G + c; if (L >= nwg) return false;
        int wgid = (int)L; { const int q = nwg / NXCD, r = nwg % NXCD, xcd = wgid % NXCD, off = wgid / NXCD; wgid = (xcd < r ? xcd * (q + 1) : r * (q + 1) + (xcd - r) * q) + off; }
        const int nig = WGM * nN, gid = wgid / nig, fm = gid * WGM, gsz = (nM - fm) < WGM ? (nM - fm) : WGM;
        u.pm = fm + ((wgid % nig) % gsz); u.pn = (wgid % nig) / gsz; return true;
    }
};
__device__ __forceinline__ unsigned cvt_pk_bf16(float lo, float hi) { unsigned r; asm volatile("v_cvt_pk_bf16_f32 %0, %1, %2" : "=v"(r) : "v"(lo), "v"(hi)); return r; }

template <class Epi>
__device__ __forceinline__ void gemm_phase(int wid0, PG8_LAS unsigned char* lds, const Gemm g, const StaticOrder& S, const Epi& E) {
    const int tid = tid_fresh(wid0), wid = __builtin_amdgcn_readfirstlane(tid >> 6), lane = tid & 63, wr = wid >> 2, wc = wid & 3, fr = lane & 15, fq = lane >> 4;
    const int K = g.K, nt = K / BK, lda = g.lda, ldb = g.ldb;
    unsigned voffA[2], voffB[2];
#pragma unroll
    for (int i = 0; i < 2; ++i) { int R, C; stage_rc(tid * 16 + i * 8192, R, C); const int Rb = (R & ~31) + perm32(R & 31);
        voffA[i] = (unsigned)(R * lda + C) * 2u; voffB[i] = (unsigned)(Rb * ldb + C) * 2u; }
    const size_t kstep = (size_t)(BK * 2);
    const size_t hstepA = (size_t)HALF * lda * 2, hstepB = (size_t)HALF * ldb * 2;
    const size_t tstepA = 2 * hstepA, tstepB = 2 * hstepB;
    const unsigned ldsw = (unsigned)wid * 1024u;
    const int aoff = lds_byte(wr * 64 + fr, fq * 8), boff = lds_byte(wc * 32 + fr, fq * 8);
#define PG8_ACOL(pn) (g.ablk ? (size_t)((((pn) >> g.ashift) & 3) * 512) : (g.ksplit ? (size_t)((pn) & 1) * (size_t)K * 2 : (size_t)0))
#define PG8_BOFF(pn) (g.ksplit ? (size_t)((pn) >> 1) * tstepB + (size_t)((pn) & 1) * (size_t)K * 2 : (size_t)(pn) * tstepB)
#define PG8_SA(b, h) (((b) * 2 + (h)) * HTB)
#define PG8_SB(b, h) ((4 + (b) * 2 + (h)) * HTB)
#define PG8_STAGE(bufoff, gbase, voff) do { _Pragma("unroll") for (int _i = 0; _i < 2; ++_i) \
        __builtin_amdgcn_global_load_lds((const unsigned*)((const char*)(gbase) + (voff)[_i]), (PG8_LAS unsigned*)(lds + (bufoff) + ldsw + _i * 8192), 16, 0, 0); } while (0)
#define PG8_LDA(dst, b, h) do { _Pragma("unroll") for (int m = 0; m < 4; ++m) _Pragma("unroll") for (int k = 0; k < 2; ++k) dst[m][k] = *(const PG8_LAS bf16x8*)(lds + PG8_SA(b, h) + aoff + m * 2048 + k * 1024); } while (0)
#define PG8_LDB(dst, b, h) do { _Pragma("unroll") for (int n = 0; n < 2; ++n) _Pragma("unroll") for (int k = 0; k < 2; ++k) dst[n][k] = *(const PG8_LAS bf16x8*)(lds + PG8_SB(b, h) + boff + n * 2048 + k * 1024); } while (0)
#define PG8_MMA(ai, bj, At, Bt) do { __builtin_amdgcn_s_setprio(1); _Pragma("unroll") for (int m = 0; m < 4; ++m) _Pragma("unroll") for (int n = 0; n < 2; ++n) _Pragma("unroll") for (int k = 0; k < 2; ++k) \
        acc[ai][bj][m][n] = __builtin_amdgcn_mfma_f32_16x16x32_bf16(Bt[n][k], At[m][k], acc[ai][bj][m][n], 0, 0, 0); __builtin_amdgcn_s_setprio(0); } while (0)
#define PG8_WAIT_V(n) asm volatile("s_waitcnt vmcnt(" #n ")" ::: "memory")
#define PG8_WAIT_L(n) asm volatile("s_waitcnt lgkmcnt(" #n ")" ::: "memory")
#define PG8_BAR __builtin_amdgcn_s_barrier()
#define PG8_SCHED __builtin_amdgcn_sched_barrier(0)
    Unit cur, nxt; int ui = 0;
    if (!S.next(0, cur)) return;
    f32x4 acc[2][2][4][2];
#pragma unroll
    for (int a = 0; a < 2; ++a)
#pragma unroll
        for (int b = 0; b < 2; ++b)
#pragma unroll
            for (int m = 0; m < 4; ++m)
#pragma unroll
                for (int n = 0; n < 2; ++n) acc[a][b][m][n] = (f32x4){0.f, 0.f, 0.f, 0.f};
    bf16x8 At[4][2], B0[2][2], B1[2][2];
    const char* cA = (const char*)g.A + (size_t)cur.pm * tstepA + PG8_ACOL(cur.pn); const char* cB = (const char*)g.Bt + PG8_BOFF(cur.pn);
    PG8_STAGE(PG8_SB(0, 0), cB, voffB); PG8_STAGE(PG8_SA(0, 0), cA, voffA); PG8_STAGE(PG8_SB(0, 1), cB + hstepB, voffB); PG8_STAGE(PG8_SA(0, 1), cA + hstepA, voffA);
    if (wr == 1) PG8_BAR;
    PG8_WAIT_V(4); PG8_BAR;
    PG8_STAGE(PG8_SB(1, 0), cB + kstep, voffB); PG8_STAGE(PG8_SA(1, 0), cA + kstep, voffA); PG8_STAGE(PG8_SB(1, 1), cB + hstepB + kstep, voffB);
    PG8_WAIT_V(6); PG8_BAR;
    for (;;) {
        const bool has_next = S.next(ui + 1, nxt);
        const char* nA = has_next ? (const char*)g.A + (size_t)nxt.pm * tstepA + PG8_ACOL(nxt.pn) : cA; const char* nB = has_next ? (const char*)g.Bt + PG8_BOFF(nxt.pn) : cB;
        for (int t = 0; t < nt; t += 2) {
            const bool last = (t == nt - 2);
            const char* a1 = cA + (size_t)(t + 1) * kstep;
            const char* a2 = last ? nA : cA + (size_t)(t + 2) * kstep; const char* b2 = last ? nB : cB + (size_t)(t + 2) * kstep;
            const char* a3 = a2 + kstep; const char* b3 = b2 + kstep;
            PG8_LDB(B0, 0, 0); PG8_SCHED; PG8_LDA(At, 0, 0); PG8_STAGE(PG8_SA(1, 1), a1 + hstepA, voffA);
            PG8_WAIT_L(8); PG8_BAR; PG8_WAIT_L(0); PG8_MMA(0, 0, At, B0); PG8_BAR; PG8_SCHED;
            PG8_LDB(B1, 0, 1); PG8_STAGE(PG8_SB(0, 0), b2, voffB);
            PG8_BAR; PG8_WAIT_L(0); PG8_MMA(0, 1, At, B1); PG8_BAR;
            PG8_LDA(At, 0, 1); PG8_STAGE(PG8_SA(0, 0), a2, voffA);
            PG8_BAR; PG8_WAIT_L(0); PG8_MMA(1, 0, At, B0); PG8_BAR; PG8_SCHED;
            PG8_STAGE(PG8_SB(0, 1), b2 + hstepB, voffB);
            PG8_WAIT_V(6); PG8_BAR; PG8_MMA(1, 1, At, B1); PG8_BAR;
            PG8_LDB(B0, 1, 0); PG8_SCHED; PG8_LDA(At, 1, 0); PG8_STAGE(PG8_SA(0, 1), a2 + hstepA, voffA);
            PG8_WAIT_L(8); PG8_BAR; PG8_WAIT_L(0); PG8_MMA(0, 0, At, B0); PG8_BAR; PG8_SCHED;
            PG8_LDB(B1, 1, 1); PG8_STAGE(PG8_SB(1, 0), b3, voffB);
            PG8_BAR; PG8_WAIT_L(0); PG8_MMA(0, 1, At, B1); PG8_BAR;
            PG8_LDA(At, 1, 1); PG8_STAGE(PG8_SA(1, 0), a3, voffA);
            PG8_BAR; PG8_WAIT_L(0); PG8_MMA(1, 0, At, B0); PG8_BAR; PG8_SCHED;
            PG8_STAGE(PG8_SB(1, 1), b3 + hstepB, voffB);
            PG8_WAIT_V(6); PG8_BAR; PG8_MMA(1, 1, At, B1); PG8_BAR;
        }
        E(acc, cur, wr, wc, fr, fq);
        if (!has_next) break;
#pragma unroll
        for (int a = 0; a < 2; ++a)
#pragma unroll
            for (int b = 0; b < 2; ++b)
#pragma unroll
                for (int m = 0; m < 4; ++m)
#pragma unroll
                    for (int n = 0; n < 2; ++n) acc[a][b][m][n] = (f32x4){0.f, 0.f, 0.f, 0.f};
        cur = nxt; cA = nA; cB = nB; ++ui;
    }
    PG8_WAIT_V(0);
    if (wr == 0) PG8_BAR;
    PG8_BAR;
#undef PG8_ACOL
#undef PG8_BOFF
#undef PG8_SA
#undef PG8_SB
#undef PG8_STAGE
#undef PG8_LDA
#undef PG8_LDB
#undef PG8_MMA
#undef PG8_WAIT_V
#undef PG8_WAIT_L
#undef PG8_BAR
#undef PG8_SCHED
}
}
#define LAS __attribute__((address_space(3)))
typedef unsigned short bf16;
typedef short bf16x8 __attribute__((ext_vector_type(8)));
typedef float f32x4 __attribute__((ext_vector_type(4)));
typedef unsigned u32x4 __attribute__((ext_vector_type(4)));
typedef unsigned u32x2 __attribute__((ext_vector_type(2)));
constexpr int DM = 1024, MT = 24576, MCTX = 8192, LCTX = 256, LLAT = 2048, NWAVES = 8, NTHR = 512;
constexpr int NPROJ_E = 3072, NB_E = 3328, IN_EVEN_LD = 3088;
constexpr float EPSF = 1e-6f;
constexpr size_t MiB = 1u << 20;
constexpr size_t WS_MOD = 0, MOD_BYTES = 4 * 9 * 6144 * 4, WS_S5F = 1 * MiB, WS_AB = 3 * MiB, WS_W1T = 5 * MiB, WS_W2T = 37 * MiB, WS_WINE = 69 * MiB,
                 WS_WOUTE = 82 * MiB, WS_WINO = 86 * MiB, WS_WOUTO = 94 * MiB, WS_WG = 98 * MiB, WS_H = 102 * MiB, WS_BIG = 150 * MiB, WS_YBUF = 294 * MiB,
                 WS_GATES = 246 * MiB, WS_MIX = 342 * MiB, WS_HALO = 390 * MiB, WS_END = 390 * MiB + 384 * 3 * 1536 * 2;
constexpr int LDS_BYTES = 147456;
constexpr size_t OUT_S5RE = 25165824, OUT_S5IM = OUT_S5RE + 262144, OUT_DELTA = OUT_S5IM + 262144, OUT_LRU = OUT_DELTA + 8388608;

struct Params { const float* in[40]; float* out; unsigned char* ws; };
enum { I_XP = 0, I_XS, I_S5RE, I_S5IM, I_SDELTA, I_SLRU, I_C, I_CCTX, I_WADA, I_BADA, I_NMIXPRE, I_NMIXPOST, I_NMLPPRE, I_NMLPPOST, I_WMLPIN, I_WMLPOUT, I_WINE, I_WOUTE,
       I_LAMRE, I_LAMIM, I_LOGDT, I_BRE, I_BIM, I_CRE, I_CIM, I_S5D, I_GCONVW, I_GCONVB, I_GALOG, I_GDTB, I_GONORM, I_WINO, I_WOUTO, I_LCONVW, I_LCONVB, I_LWR, I_LBR, I_LWI, I_LBI, I_LLAM };

typedef __bf16 bf2_t __attribute__((ext_vector_type(2)));
typedef float f2_t __attribute__((ext_vector_type(2)));
__device__ __forceinline__ unsigned pk2(float lo, float hi) { const bf2_t v = __builtin_convertvector((f2_t){lo, hi}, bf2_t); return __builtin_bit_cast(unsigned, v); }
__device__ __forceinline__ unsigned f2bf(float f) { return pk2(f, f) & 0xffffu; }
__device__ __forceinline__ float bflo(unsigned w) { return __builtin_bit_cast(float, w << 16); }
__device__ __forceinline__ float bfhi(unsigned w) { return __builtin_bit_cast(float, w & 0xffff0000u); }
__device__ __forceinline__ float bf2f(bf16 b) { return __builtin_bit_cast(float, (unsigned)b << 16); }
__device__ __forceinline__ float sigmoidf_(float x) { return __builtin_amdgcn_rcpf(1.0f + __expf(-x)); }
__device__ __forceinline__ float siluf_(float x) { return x * sigmoidf_(x); }
__device__ __forceinline__ float softplusf_(float x) { return fmaxf(x, 0.f) + __logf(1.0f + __expf(-fabsf(x))); }
__device__ __forceinline__ float geluf_(float x) { const float y = 0.7978845608028654f * (x + 0.044715f * x * x * x); const float t = 1.0f - 2.0f * __builtin_amdgcn_rcpf(__expf(2.0f * y) + 1.0f); return 0.5f * x * (1.0f + t); }
__device__ __forceinline__ float shfl_i(float v, int srclane) { return __builtin_bit_cast(float, __builtin_amdgcn_ds_bpermute(srclane << 2, __builtin_bit_cast(int, v))); }
__device__ __forceinline__ float wave_sum(float v, int lane) {
#pragma unroll
    for (int o = 1; o < 64; o <<= 1) v += shfl_i(v, lane ^ o);
    return v;
}
#define LDS_WAIT() asm volatile("s_waitcnt lgkmcnt(0)" ::: "memory")
#define WAVE_SYNC() do { asm volatile("s_waitcnt lgkmcnt(0)" ::: "memory"); __builtin_amdgcn_wave_barrier(); } while (0)
__device__ __forceinline__ f32x4 mfma16(bf16x8 a, bf16x8 b, f32x4 c) { return __builtin_amdgcn_mfma_f32_16x16x32_bf16(a, b, c, 0, 0, 0); }


#define XB_TMO      128
#define XB_XCNT(j)  (256  + 64 * (j))
#define XB_XSUB(j)  (1280 + 64 * (j))
#define XB_XGEN(j)  (2304 + 64 * (j))
#define XB_TOP      3328
#define XB_TOPGEN   3392
#define XCD_BAR_WORDS 3456
#define XB_SPIN_CAP (1u << 18)
constexpr size_t WS_BAR = 960 * 1024; constexpr int LDS_BARST = LDS_BYTES - 16;
__device__ __forceinline__ unsigned xb_ld(unsigned* p)              { return __hip_atomic_load(p, __ATOMIC_RELAXED, __HIP_MEMORY_SCOPE_AGENT); }
__device__ __forceinline__ unsigned xb_add(unsigned* p, unsigned v) { return __hip_atomic_fetch_add(p, v, __ATOMIC_RELAXED, __HIP_MEMORY_SCOPE_AGENT); }
__device__ __forceinline__ unsigned xb_xcc_id() { return (unsigned)__builtin_amdgcn_s_getreg((3 << 11) | 20) & 0xFu; }
#define XB_SPIN(cond, bar) do { unsigned _sp = 0; while (cond) { __builtin_amdgcn_s_sleep(1); \
    if ((++_sp & 255u) == 0u) { if (xb_ld(&(bar)[XB_TMO])) break; if (_sp > XB_SPIN_CAP) { atomicAdd(&(bar)[XB_TMO], 1u); break; } } } } while (0)
__device__ __forceinline__ void xcd_barrier_complete(unsigned* bar, unsigned x, unsigned& nloc, unsigned& nx) {
    const unsigned G = gridDim.x;
    unsigned sum, cnt, mine, sp = 0u;
    for (;;) {
        sum = 0u; cnt = 0u; mine = 0u;
#pragma unroll
        for (unsigned j = 0; j < 16; ++j) { const unsigned c = xb_ld(&bar[XB_XCNT(j)]); sum += c; cnt += (c > 0u) ? 1u : 0u; mine = (j == x) ? c : mine; }
        if (sum == G) break;
        __builtin_amdgcn_s_sleep(1);
        if ((++sp & 255u) == 0u) { if (xb_ld(&bar[XB_TMO])) break; if (sp > XB_SPIN_CAP) { atomicAdd(&bar[XB_TMO], 1u); break; } }
    }
    nloc = mine > 0u ? mine : 1u; nx = cnt > 0u ? cnt : 1u;
}
__device__ __forceinline__ void xcd_barrier(int wid0, unsigned* bar, LAS unsigned char* lds) {
    const int tid = tid_fresh(wid0);
    asm volatile("s_waitcnt vmcnt(0)" ::: "memory");
    __syncthreads();
    if (tid == 0) {
        const unsigned x = xb_xcc_id();
        volatile LAS unsigned* st = (volatile LAS unsigned*)(lds + LDS_BARST);
        __builtin_amdgcn_s_waitcnt(0);
        unsigned nloc = st[0], nx = st[1];
        if (nloc == 0u) { xcd_barrier_complete(bar, x, nloc, nx); st[0] = nloc; st[1] = nx; }
        const unsigned old = xb_add(&bar[XB_XSUB(x)], 1u);
        const unsigned gen = old / nloc;
        if (old + 1u == (gen + 1u) * nloc) {
            __builtin_amdgcn_fence(__ATOMIC_RELEASE, "agent");
            asm volatile("s_waitcnt vmcnt(0)" ::: "memory");
            const unsigned og = xb_add(&bar[XB_TOP], 1u);
            const unsigned tg = og / nx;
            if (og + 1u == (tg + 1u) * nx) xb_add(&bar[XB_TOPGEN], 1u);
            else XB_SPIN(xb_ld(&bar[XB_TOPGEN]) == tg, bar);
            __builtin_amdgcn_fence(__ATOMIC_ACQUIRE, "agent");
            xb_add(&bar[XB_XGEN(x)], 1u);
            asm volatile("s_waitcnt vmcnt(0)" ::: "memory");
        } else {
            XB_SPIN(xb_ld(&bar[XB_XGEN(x)]) == gen, bar);
            __builtin_amdgcn_fence(__ATOMIC_ACQUIRE, "agent");
            asm volatile("s_waitcnt vmcnt(0)" ::: "memory");
        }
    }
    __syncthreads();
}
__device__ __forceinline__ void transpose_item(const float* W, int ldw, int nvalid, int K, bf16* WT, int dst_row0, LAS float* scr, int k0, int n0, int lane) {
    const int nn = n0 + (lane & 31); const bool ok = nn < nvalid;
#pragma unroll 8
    for (int i = 0; i < 32; ++i) { const int kk = 2 * i + (lane >> 5); scr[kk * 33 + (lane & 31)] = ok ? W[(size_t)(k0 + kk) * ldw + nn] : 0.f; }
    WAVE_SYNC();
    const int c = lane & 7;
#pragma unroll
    for (int j = 0; j < 4; ++j) { const int n = (lane >> 3) + 8 * j; const LAS float* s = scr + (8 * c) * 33 + n;
        u32x4 o; o.x = pk2(s[0 * 33], s[1 * 33]); o.y = pk2(s[2 * 33], s[3 * 33]); o.z = pk2(s[4 * 33], s[5 * 33]); o.w = pk2(s[6 * 33], s[7 * 33]);
        *(u32x4*)(WT + (size_t)(dst_row0 + n) * K + k0 + 8 * c) = o; }
    WAVE_SYNC();
}
constexpr int WITEMS_EVEN = 4096 + 1552 + 512, WITEMS_ODD = 4096 + 1024 + 512 + 512;
__device__ __forceinline__ void weight_item(const Params& P, LAS float* scr, int l, int r, int lane) {
    unsigned char* ws = P.ws; const int eo = l >> 1;
    if (r < 2048) { const int q = r; transpose_item(P.in[I_WMLPIN] + (size_t)l * 1024 * 4096, 4096, 4096, 1024, (bf16*)(ws + WS_W1T) + (size_t)l * 4096 * 1024, 32 * (q & 127), scr, 64 * (q >> 7), 32 * (q & 127), lane); return; } r -= 2048;
    if (r < 2048) { const int q = r; transpose_item(P.in[I_WMLPOUT] + (size_t)l * 4096 * 1024, 1024, 1024, 4096, (bf16*)(ws + WS_W2T) + (size_t)l * 1024 * 4096, 32 * (q & 31), scr, 64 * (q >> 5), 32 * (q & 31), lane); return; } r -= 2048;
    if ((l & 1) == 0) {
        if (r < 1552) { const int kb = r / 97, nb = r % 97; transpose_item(P.in[I_WINE] + (size_t)eo * 1024 * IN_EVEN_LD, IN_EVEN_LD, IN_EVEN_LD, 1024, (bf16*)(ws + WS_WINE) + (size_t)eo * NB_E * 1024, 32 * nb, scr, 64 * kb, 32 * nb, lane); return; } r -= 1552;
        { const int q = r; transpose_item(P.in[I_WOUTE] + (size_t)eo * 1024 * 1024, 1024, 1024, 1024, (bf16*)(ws + WS_WOUTE) + (size_t)eo * 1024 * 1024, 32 * (q & 31), scr, 64 * (q >> 5), 32 * (q & 31), lane); return; }
    } else {
        if (r < 1024) { const int q = r; transpose_item(P.in[I_WINO] + (size_t)eo * 1024 * 2048, 2048, 2048, 1024, (bf16*)(ws + WS_WINO) + (size_t)eo * 2048 * 1024, 32 * (q & 63), scr, 64 * (q >> 6), 32 * (q & 63), lane); return; } r -= 1024;
        if (r < 512) { const int q = r; transpose_item(P.in[I_WOUTO] + (size_t)eo * 1024 * 1024, 1024, 1024, 1024, (bf16*)(ws + WS_WOUTO) + (size_t)eo * 1024 * 1024, 32 * (q & 31), scr, 64 * (q >> 5), 32 * (q & 31), lane); return; } r -= 512;
        { const int mat = eo * 16 + (r >> 5), q = r & 31, kb = q >> 3, nb = q & 7; const int blk = mat & 3, gate = (mat >> 2) & 1, od = mat >> 3;
          const float* src = (gate ? P.in[I_LWI] : P.in[I_LWR]) + (size_t)(od * 4 + blk) * 65536;
          const int j0 = nb * 32; const int drow = (blk * 2 + (j0 >> 7)) * 256 + gate * 128 + (j0 & 127);
          transpose_item(src, 256, 256, 256, (bf16*)(ws + WS_WG) + (size_t)od * 2048 * 256, drow, scr, 64 * kb, j0, lane); return; }
    }
}
__device__ __forceinline__ void phase_prologue(int wid0, const Params& P, LAS unsigned char* lds) {
    const int tid = tid_fresh(wid0), lane = tid & 63, wave = tid >> 6;
    LAS float* scr = (LAS float*)(lds + wave * 16384);
    const int gw = bid_fresh() * NWAVES + wave, NGW = grid_fresh() * NWAVES;
    unsigned char* ws = P.ws;
    constexpr int NTR = WITEMS_EVEN, NMOD = 4 * 24 * 16;
    for (int it = gw; it < NTR + NMOD; it += NGW) {
        int r = it;
        if (r < NTR) { weight_item(P, scr, 0, r, lane); continue; } r -= NTR;
        {
            const int l = r / 384, rem = r % 384, ec = rem >> 4, ks = rem & 15, k0 = ks * 64;
#pragma unroll
            for (int rr = 0; rr < 9; ++rr) { const float cv = rr == 0 ? P.in[I_CCTX][k0 + lane] : P.in[I_C][(rr - 1) * 1024 + k0 + lane]; scr[rr * 64 + lane] = siluf_(cv); }
            WAVE_SYNC();
            f32x4 acc[9];
#pragma unroll
            for (int rr = 0; rr < 9; ++rr) acc[rr] = (f32x4){0.f, 0.f, 0.f, 0.f};
            const float* wp = P.in[I_WADA] + ((size_t)l * 1024 + k0) * 6144 + ec * 256 + lane * 4;
#pragma unroll 4
            for (int kk = 0; kk < 64; ++kk) { const f32x4 w4 = *(const f32x4*)(wp + (size_t)kk * 6144);
#pragma unroll
                for (int rr = 0; rr < 9; ++rr) acc[rr] += w4 * scr[rr * 64 + kk]; }
            float* part = (float*)(ws + WS_BIG) + ((size_t)(ks * 4 + l) * 9) * 6144 + ec * 256 + lane * 4;
#pragma unroll
            for (int rr = 0; rr < 9; ++rr) *(f32x4*)(part + (size_t)rr * 6144) = acc[rr];
            WAVE_SYNC();
        }
    }
    { const size_t per = (size_t)(NB_E - 3104) * 1024 * 2 / 16;
      for (size_t i = (size_t)bid_fresh() * NTHR + tid; i < 2 * per; i += (size_t)grid_fresh() * NTHR) { const size_t e = i / per, q = i % per;
          *(u32x4*)(ws + WS_WINE + (e * NB_E + 3104) * 1024 * 2 + q * 16) = (u32x4){0u, 0u, 0u, 0u}; } }
}
__device__ __forceinline__ void phase_modreduce(int wid0, const Params& P) {
    const int tid = tid_fresh(wid0);
    const float* part = (const float*)(P.ws + WS_BIG); float* mod = (float*)(P.ws + WS_MOD);
    for (int i = bid_fresh() * NTHR + tid; i < 4 * 9 * 6144 / 4; i += grid_fresh() * NTHR) {
        const int l = i / (9 * 1536), e4 = i % 1536;
        f32x4 a = *(const f32x4*)(P.in[I_BADA] + (size_t)l * 6144 + e4 * 4);
#pragma unroll
        for (int ks = 0; ks < 16; ++ks) a += *(const f32x4*)(part + (size_t)ks * 4 * 9 * 6144 + (size_t)i * 4);
        *(f32x4*)(mod + (size_t)i * 4) = a; }
}
constexpr size_t XB_OFF_FLOATS = (size_t)MT * DM / 2;
__device__ __forceinline__ void phase_rownorm(int wid0, const Params& P, int first, const bf16* obuf, const float* modg, int goff, const float* gpost, int has_next, const float* gpre, const float* mods, int soff, bf16* H, float gscale = 1.0f) {
    const int tid = tid_fresh(wid0), lane = tid & 63, wave = tid >> 6;
    const int gw = bid_fresh() * NWAVES + wave, NGW = grid_fresh() * NWAVES;
    bf16* XB = (bf16*)(P.out + XB_OFF_FLOATS); float* TMP = (float*)(P.ws + WS_BIG);
    f32x4 xn[4]; u32x2 xbn[4], on[4];
#define RN_LOAD(mm) do { const int m_ = (mm); \
        _Pragma("unroll") for (int j = 0; j < 4; ++j) { \
            if (first) xn[j] = *(const f32x4*)((m_ < MCTX ? P.in[I_XP] + (size_t)m_ * DM : P.in[I_XS] + (size_t)(m_ - MCTX) * DM) + lane * 4 + 256 * j); \
            else { xbn[j] = *(const u32x2*)(XB + (size_t)m_ * DM + lane * 4 + 256 * j); on[j] = *(const u32x2*)(obuf + (size_t)m_ * DM + lane * 4 + 256 * j); } } } while (0)
    if (gw < MT) RN_LOAD(gw);
    for (int m = gw; m < MT; m += NGW) {
        const int modrow = m < MCTX ? 0 : 1 + ((m - MCTX) >> 11);
        const float* mr = modg + (size_t)modrow * 6144; const float* ms = mods + (size_t)modrow * 6144;
        f32x4 x[4]; u32x2 ov[4];
#pragma unroll
        for (int j = 0; j < 4; ++j) { ov[j] = on[j]; x[j] = first ? xn[j] : (f32x4){bflo(xbn[j].x), bfhi(xbn[j].x), bflo(xbn[j].y), bfhi(xbn[j].y)}; }
        if (m + NGW < MT) RN_LOAD(m + NGW);
        if (first) {
            if (m >= MCTX) {
                const int t = (m - MCTX) & 2047; const float prow = (float)(t >> 6), pcol = (float)(t & 63);
                f32x4 om;
#pragma unroll
                for (int e = 0; e < 4; ++e) om[e] = exp2f(-(float)(lane * 4 + e) * (13.287712379549449f / 256.0f));
#pragma unroll
                for (int j = 0; j < 4; ++j) {
#pragma unroll
                    for (int e = 0; e < 4; ++e) { const float a = (j < 2 ? prow : pcol) * om[e]; x[j][e] += (j & 1) ? cosf(a) : sinf(a); } }
            }
        } else {
            float ss = 0.f;
#pragma unroll
            for (int j = 0; j < 4; ++j) { const float a = bflo(ov[j].x), b = bfhi(ov[j].x), c = bflo(ov[j].y), d = bfhi(ov[j].y); ss += (a * a + b * b) + (c * c + d * d); }
            const float rs = rsqrtf(wave_sum(ss, lane) * (1.0f / DM) + EPSF);
#pragma unroll
            for (int j = 0; j < 4; ++j) { const f32x4 g4 = *(const f32x4*)(gpost + lane * 4 + 256 * j), gt = *(const f32x4*)(mr + goff + lane * 4 + 256 * j);
                f32x4 o4 = (f32x4){bflo(ov[j].x), bfhi(ov[j].x), bflo(ov[j].y), bfhi(ov[j].y)};
                x[j] += gt * (o4 * (rs * gscale) * g4); }
        }
        if (has_next) {
#pragma unroll
            for (int j = 0; j < 4; ++j) { u32x2 w; w.x = pk2(x[j][0], x[j][1]); w.y = pk2(x[j][2], x[j][3]); *(u32x2*)(XB + (size_t)m * DM + lane * 4 + 256 * j) = w; }
            float ss = 0.f;
#pragma unroll
            for (int j = 0; j < 4; ++j) ss += (x[j][0] * x[j][0] + x[j][1] * x[j][1]) + (x[j][2] * x[j][2] + x[j][3] * x[j][3]);
            const float rs = rsqrtf(wave_sum(ss, lane) * (1.0f / DM) + EPSF);
#pragma unroll
            for (int j = 0; j < 4; ++j) { const f32x4 g4 = *(const f32x4*)(gpre + lane * 4 + 256 * j), sh = *(const f32x4*)(ms + soff + lane * 4 + 256 * j), sc = *(const f32x4*)(ms + soff + 1024 + lane * 4 + 256 * j);
                const f32x4 h4 = (x[j] * rs * g4) * (sc + 1.0f) + sh;
                u32x2 w; w.x = pk2(h4[0], h4[1]); w.y = pk2(h4[2], h4[3]);
                *(u32x2*)(H + (size_t)m * DM + lane * 4 + 256 * j) = w; }
        } else {
            float* dst = (m < MT / 2) ? P.out + (size_t)m * DM : TMP + (size_t)(m - MT / 2) * DM;
#pragma unroll
            for (int j = 0; j < 4; ++j) *(f32x4*)(dst + lane * 4 + 256 * j) = x[j];
        }
    }
}
__device__ __forceinline__ void phase_copy_tail(int wid0, const Params& P) {
    const int tid = tid_fresh(wid0);
    const f32x4* src = (const f32x4*)(P.ws + WS_BIG); f32x4* dst = (f32x4*)(P.out + XB_OFF_FLOATS);
    const size_t n = (size_t)(MT / 2) * DM / 4;
    for (size_t i = (size_t)bid_fresh() * NTHR + tid; i < n; i += (size_t)grid_fresh() * NTHR) dst[i] = src[i];
}

using pg8::Unit;
template <int ACT  > struct EpiBf16 {
    bf16* O; int ldc; float* AB;
    bf16* HALO;
    __device__ __forceinline__ void operator()(const f32x4 (&acc)[2][2][4][2], const Unit& u, int wr, int wc, int fr, int fq) const {
        const int row0 = u.pm * 256 + wr * 64 + fr, col0 = u.pn * 256 + wc * 32 + 8 * fq;
        if (AB && u.pn * 256 >= ldc) {
            if (wc == 0 && fq < 2) {
#pragma unroll
                for (int ai = 0; ai < 2; ++ai)
#pragma unroll
                    for (int m = 0; m < 4; ++m) { float* p = AB + (size_t)(row0 + ai * 128 + m * 16) * 16 + 8 * fq; *(f32x4*)p = acc[ai][0][m][0]; *(f32x4*)(p + 4) = acc[ai][0][m][1]; }
            }
            return;
        }
#pragma unroll
        for (int ai = 0; ai < 2; ++ai)
#pragma unroll
            for (int m = 0; m < 4; ++m) { bf16* rowp = O + (size_t)(row0 + ai * 128 + m * 16) * ldc + col0;
#pragma unroll
                for (int bj = 0; bj < 2; ++bj) { f32x4 v0 = acc[ai][bj][m][0], v1 = acc[ai][bj][m][1];
                    if (ACT == 1) {
#pragma unroll
                        for (int j = 0; j < 4; ++j) { const float a = fmaxf(v0[j], 0.f), b = fmaxf(v1[j], 0.f); v0[j] = a * a; v1[j] = b * b; } }
                    u32x4 w; w.x = pk2(v0[0], v0[1]); w.y = pk2(v0[2], v0[3]); w.z = pk2(v1[0], v1[1]); w.w = pk2(v1[2], v1[3]);
                    *(u32x4*)(rowp + bj * 128) = w;
                    if (ACT == 0 && HALO && u.pn >= 4 && u.pn < 10 && ((m == 3 && fr == 15) || (m == 0 && fr < 2))) {
                        const int r = row0 + ai * 128 + m * 16; const int which = (m == 3) ? 0 : 1 + fr;
                        *(u32x4*)(HALO + ((size_t)(r >> 6) * 3 + which) * 1536 + (col0 + bj * 128 - 1024)) = w; } } }
    }
};
struct EpiSplit {
    bf16* O0; long stride;
    __device__ __forceinline__ void operator()(const f32x4 (&acc)[2][2][4][2], const Unit& u, int wr, int wc, int fr, int fq) const {
        const int row0 = u.pm * 256 + wr * 64 + fr, col0 = (u.pn >> 1) * 256 + wc * 32 + 8 * fq; bf16* O = O0 + (long)(u.pn & 1) * stride;
#pragma unroll
        for (int ai = 0; ai < 2; ++ai)
#pragma unroll
            for (int m = 0; m < 4; ++m) { bf16* rowp = O + (size_t)(row0 + ai * 128 + m * 16) * DM + col0;
#pragma unroll
                for (int bj = 0; bj < 2; ++bj) { const f32x4 v0 = acc[ai][bj][m][0], v1 = acc[ai][bj][m][1];
                    u32x4 w; w.x = pk2(v0[0], v0[1]); w.y = pk2(v0[2], v0[3]); w.z = pk2(v1[0], v1[1]); w.w = pk2(v1[2], v1[3]);
                    *(u32x4*)(rowp + bj * 128) = w; } }
    }
};
struct EpiGates {
    unsigned* G; const bf16* X; const float* br; const float* bi; const float* lam;
    __device__ __forceinline__ void operator()(const f32x4 (&acc)[2][2][4][2], const Unit& u, int wr, int wc, int fr, int fq) const {
        const int row0 = u.pm * 256 + wr * 64 + fr, ch0 = u.pn * 128 + wc * 32 + 8 * fq;
#pragma unroll
        for (int n = 0; n < 2; ++n) {
            const f32x4 vbr = *(const f32x4*)(br + ch0 + 4 * n), vbi = *(const f32x4*)(bi + ch0 + 4 * n), l4 = *(const f32x4*)(lam + ch0 + 4 * n);
            f32x4 vsp;
#pragma unroll
            for (int e = 0; e < 4; ++e) vsp[e] = -8.0f * softplusf_(-l4[e]);
#pragma unroll
            for (int ai = 0; ai < 2; ++ai)
#pragma unroll
                for (int m = 0; m < 4; ++m) { const size_t row = (size_t)(row0 + ai * 128 + m * 16);
                    const u32x2 xv = *(const u32x2*)(X + row * DM + ch0 + 4 * n);
                    const float xs[4] = {bflo(xv.x), bfhi(xv.x), bflo(xv.y), bfhi(xv.y)};
                    u32x4 w;
#pragma unroll
                    for (int e = 0; e < 4; ++e) { const float r = sigmoidf_(acc[ai][0][m][n][e] + vbr[e]), ig = sigmoidf_(acc[ai][1][m][n][e] + vbi[e]);
                        const float la = r * vsp[e]; const float a_ = __expf(la); const float b = __builtin_amdgcn_sqrtf(fmaxf(1.0f - a_ * a_, 0.f)) * ig * xs[e];
                        w[e] = pk2(1.0f - a_, b); }
                    *(u32x4*)(G + row * DM + ch0 + 4 * n) = w; }
        }
    }
};
constexpr int S5_WLDS = 12800, BU_P = 132, HS_P = 136;
struct S5Dir { float ar, ai; bf16x8 Bf[8]; };
__device__ __forceinline__ void s5_dir_setup(const Params& P, int e, int d, int g, int lane, float& ar, float& ai, bf16x8 (&Bf)[8], bool needB) {
    const int quad = lane >> 4, l15 = lane & 15;
    const float dt = __expf(P.in[I_LOGDT][(e * 2 + d) * 32 + g]);
    const float lr = P.in[I_LAMRE][((e * 2 + d) * 32 + g) * 64 + lane], li = P.in[I_LAMIM][((e * 2 + d) * 32 + g) * 64 + lane];
    const float mag = expf(lr * dt); ar = mag * cosf(li * dt); ai = mag * sinf(li * dt);
    const float den = lr * lr + li * li;
    const float fr = ((ar - 1.0f) * lr + ai * li) / den, fi = (ai * lr - (ar - 1.0f) * li) / den;
    if (needB) {
#pragma unroll
        for (int nt = 0; nt < 8; ++nt) { const int col = 16 * nt + l15, p = col & 63;
            const float frp = shfl_i(fr, p), fip = shfl_i(fi, p);
            bf16x8 v = (bf16x8){0, 0, 0, 0, 0, 0, 0, 0};
            if (quad < 2) { const float* bre = P.in[I_BRE] + ((size_t)(e * 32 + g) * 64 + p) * 16 + quad * 8; const float* bim = P.in[I_BIM] + ((size_t)(e * 32 + g) * 64 + p) * 16 + quad * 8;
#pragma unroll
                for (int j = 0; j < 8; ++j) { const float br = bre[j], bi = bim[j]; const float val = (nt < 4) ? (frp * br - fip * bi) : (frp * bi + fip * br); v[j] = (short)f2bf(val); } }
            Bf[nt] = v; }
    }
}
__device__ __forceinline__ void s5_c_setup(const Params& P, int e, int g, int lane, bf16x8 (&Cf)[4]) {
    const int quad = lane >> 4, l15 = lane & 15;
#pragma unroll
    for (int ks = 0; ks < 4; ++ks) { const int col0 = 32 * ks + quad * 8; const bool im = col0 >= 64;
        const float* src = (im ? P.in[I_CIM] : P.in[I_CRE]) + ((size_t)(e * 32 + g) * 16 + l15) * 64 + (col0 & 63);
        bf16x8 v;
#pragma unroll
        for (int j = 0; j < 8; ++j) v[j] = (short)f2bf(im ? -src[j] : src[j]);
        Cf[ks] = v; }
}
__device__ __forceinline__ void s5_scan_seg(const Params& P, LAS unsigned char* wl, int lane, int d, int g, int m0, float ar, float ai, const bf16x8 (&Bf)[8], const bf16x8 (&Cf)[4],
                                            float& hr, float& hi, int mode, int ymode, const bf16* proj, float* ybuf, bf16* mixout, float dsk, int dry = 0) {
    const int quad = lane >> 4, l15 = lane & 15;
    LAS float* BU = (LAS float*)wl; LAS bf16* HS = (LAS bf16*)(wl + 8448);
    const int ch = g * 16 + l15;
    bf16x8 a_next = (bf16x8){0, 0, 0, 0, 0, 0, 0, 0};
    if (mode == 0 && quad < 2) { const int blk0 = d ? 15 : 0; const int tt = d ? 15 - l15 : l15; a_next = *(const bf16x8*)(proj + (size_t)(m0 + 16 * blk0 + tt) * NPROJ_E + g * 16 + quad * 8); }
    for (int bi_ = 0; bi_ < 16; ++bi_) {
        const int blk = d ? 15 - bi_ : bi_;
        const int mb = m0 + 16 * blk;
        const bf16x8 a = a_next;
        if (mode == 0 && quad < 2 && bi_ + 1 < 16) { const int blkn = d ? 14 - bi_ : bi_ + 1; const int tt = d ? 15 - l15 : l15; a_next = *(const bf16x8*)(proj + (size_t)(m0 + 16 * blkn + tt) * NPROJ_E + g * 16 + quad * 8); }
        float pre[4], zz[4];
#pragma unroll
        for (int jj = 0; jj < 4; ++jj) { const int row = quad * 4 + jj; const int tt = d ? 15 - row : row; const size_t m = (size_t)(mb + tt);
            pre[jj] = (ymode == 0) ? dsk * bf2f(proj[m * NPROJ_E + ch]) : ybuf[m * 512 + ch];
            zz[jj] = (ymode == 2) ? bf2f(proj[m * NPROJ_E + 512 + ch]) : 0.f; }
        if (mode == 0) {
#pragma unroll
            for (int nt = 0; nt < 8; ++nt) { f32x4 acc = mfma16(a, Bf[nt], (f32x4){0.f, 0.f, 0.f, 0.f});
#pragma unroll
                for (int jj = 0; jj < 4; ++jj) BU[(quad * 4 + jj) * BU_P + 16 * nt + l15] = acc[jj]; }
            WAVE_SYNC();
        }
#pragma unroll
        for (int r = 0; r < 16; ++r) {
            float br = 0.f, bim = 0.f;
            if (mode == 0) { br = BU[r * BU_P + lane]; bim = BU[r * BU_P + 64 + lane]; }
            const float nr = ar * hr - ai * hi + br, ni = ar * hi + ai * hr + bim; hr = nr; hi = ni;
            HS[r * HS_P + lane] = (bf16)f2bf(hr); HS[r * HS_P + 64 + lane] = (bf16)f2bf(hi);
        }
        WAVE_SYNC();
        f32x4 y = (f32x4){0.f, 0.f, 0.f, 0.f};
#pragma unroll
        for (int ks = 0; ks < 4; ++ks) { const bf16x8 af = *(const LAS bf16x8*)(HS + l15 * HS_P + 32 * ks + quad * 8); y = mfma16(af, Cf[ks], y); }
#pragma unroll
        for (int jj = 0; jj < 4; ++jj) { const int row = quad * 4 + jj; const int tt = d ? 15 - row : row; const size_t m = (size_t)(mb + tt);
            const float v = y[jj] + pre[jj];
            if (!dry) { if (ymode != 2) ybuf[m * 512 + ch] = v;
            else mixout[m * DM + ch] = (bf16)f2bf(geluf_(v) * sigmoidf_(zz[jj])); }
        }
        WAVE_SYNC();
    }
}
__device__ __forceinline__ void s5_task_main(const Params& P, LAS unsigned char* wl, int lane, int e, int sub, int g) {
    const bf16* proj = (const bf16*)(P.ws + WS_BIG); float* ybuf = (float*)(P.ws + WS_YBUF); bf16* mixout = (bf16*)(P.ws + WS_MIX);
    const bool lat = sub >= 32; const int q = sub - 32, b = lat ? (q >> 3) : sub, seg = lat ? (q & 7) : 0;
    const int m0 = lat ? MCTX + b * LLAT + seg * 256 : sub * 256;
    bf16x8 Cf[4]; s5_c_setup(P, e, g, lane, Cf);
    const float dsk = P.in[I_S5D][e * 512 + g * 16 + (lane & 15)];
#pragma unroll 1
    for (int d = 0; d < 2; ++d) {
        float ar, ai; bf16x8 Bf[8]; s5_dir_setup(P, e, d, g, lane, ar, ai, Bf, true);
        float hr = 0.f, hi = 0.f;
        if (lat && ((d == 0 && seg == 0) || (d == 1 && seg == 7))) { const size_t si = ((((size_t)b * 2 + e) * 2 + d) * 32 + g) * 64 + lane; hr = P.in[I_S5RE][si]; hi = P.in[I_S5IM][si]; }
        const int ymode = d == 0 ? 0 : (lat ? 1 : 2);
        s5_scan_seg(P, wl, lane, d, g, m0, ar, ai, Bf, Cf, hr, hi, 0, ymode, proj, ybuf, mixout, dsk);
        if (!lat) { const size_t si = ((((size_t)b * 2 + e) * 2 + d) * 32 + g) * 64 + lane; P.out[OUT_S5RE + si] = hr; P.out[OUT_S5IM + si] = hi; }
        else { float* F = (float*)(P.ws + WS_S5F) + ((((size_t)d * 64 + q) * 32 + g) * 64 + lane) * 2; F[0] = hr; F[1] = hi; }
    }
}
__device__ __forceinline__ void s5_task_corr(const Params& P, LAS unsigned char* wl, int lane, int e, int q, int g, int dry = 0) {
    const bf16* proj = (const bf16*)(P.ws + WS_BIG); float* ybuf = (float*)(P.ws + WS_YBUF); bf16* mixout = (bf16*)(P.ws + WS_MIX);
    const int b = q >> 3, seg = q & 7, m0 = MCTX + b * LLAT + seg * 256;
    bf16x8 Cf[4]; s5_c_setup(P, e, g, lane, Cf);
    bf16x8 Bf[8];
#pragma unroll
    for (int i = 0; i < 8; ++i) Bf[i] = (bf16x8){0, 0, 0, 0, 0, 0, 0, 0};
    const float* Fb = (const float*)(P.ws + WS_S5F);
#pragma unroll 1
    for (int d = 0; d < 2; ++d) {
        float ar, ai; s5_dir_setup(P, e, d, g, lane, ar, ai, Bf, false);
        float pr = ar, pi = ai;
#pragma unroll
        for (int i = 0; i < 8; ++i) { const float nr = pr * pr - pi * pi, ni = 2.0f * pr * pi; pr = nr; pi = ni; }
        float hr = 0.f, hi = 0.f;
        const int cnt = d == 0 ? seg : 7 - seg;
        for (int i = 0; i < cnt; ++i) { const int sj = d == 0 ? i : 7 - i; const float* F = Fb + ((((size_t)d * 64 + b * 8 + sj) * 32 + g) * 64 + lane) * 2;
            const float nr = pr * hr - pi * hi + F[0], ni = pr * hi + pi * hr + F[1]; hr = nr; hi = ni; }
        const int ym = (d == 1 || seg == 7) ? 2 : 1;
        if (cnt > 0) s5_scan_seg(P, wl, lane, d, g, m0, ar, ai, Bf, Cf, hr, hi, 1, ym, proj, ybuf, mixout, 0.f, dry);
    }
}

#ifndef REP_A
#define REP_A 1
#endif
#ifndef REP_B
#define REP_B 1
#endif
#ifndef REP_C
#define REP_C 1
#endif
__device__ __forceinline__ void phase_conv_even(int wid0, const Params& P, int e, int dry = 0) {
    const int tid = tid_fresh(wid0), lane = tid & 63, wave = tid >> 6;
    const int gw = bid_fresh() * NWAVES + wave, NGW = grid_fresh() * NWAVES;
    bf16* proj = (bf16*)(P.ws + WS_BIG); const bf16* HALO = (const bf16*)(P.ws + WS_HALO);
    for (int it = gw; it < 384 * 24; it += NGW) {
        const int c = it / 24, cgp = it % 24, ccol = cgp * 64 + lane;
        const int r0 = c * 64;
        const bool lat = r0 >= MCTX; const int t0 = lat ? ((r0 - MCTX) & 2047) : (r0 & 255); const int L = lat ? LLAT : LCTX;
        bf16* base = proj + (size_t)r0 * NPROJ_E + 1024 + ccol;
        bf16 x[67];
#pragma unroll
        for (int i = 0; i < 64; ++i) x[i + 1] = base[(size_t)i * NPROJ_E];
        x[0] = (t0 > 0) ? HALO[((size_t)(c - 1) * 3 + 0) * 1536 + ccol] : (bf16)0;
        x[65] = (t0 + 64 < L) ? HALO[((size_t)(c + 1) * 3 + 1) * 1536 + ccol] : (bf16)0;
        x[66] = (t0 + 64 < L) ? HALO[((size_t)(c + 1) * 3 + 2) * 1536 + ccol] : (bf16)0;
        const float* cw = P.in[I_GCONVW] + (size_t)e * 4 * 1536 + ccol; const float w0 = cw[0], w1 = cw[1536], w2 = cw[3072], w3 = cw[4608], cb = P.in[I_GCONVB][e * 1536 + ccol];
#pragma unroll
        for (int i = 0; i < 64; ++i) { const float v = cb + w0 * bf2f(x[i]) + w1 * bf2f(x[i + 1]) + w2 * bf2f(x[i + 2]) + w3 * bf2f(x[i + 3]);
            if (!dry) base[(size_t)i * NPROJ_E] = (bf16)f2bf(siluf_(v)); }
    }
}
#define LDS_BARRIER() do { asm volatile("s_waitcnt lgkmcnt(0)" ::: "memory"); __builtin_amdgcn_s_barrier(); asm volatile("" ::: "memory"); } while (0)
constexpr int G_Q = 0, G_K = 17408, G_V = 34816, G_KT = 52224, G_LM = 70656, G_QK = 89088, G_ST = 98304, G_SM = 133120;
constexpr int P128 = 136, P64 = 72, LMP = 68;
__device__ __forceinline__ bf16x8 ld_split8(const LAS bf16* p) {
    const u32x2 a = *(const LAS u32x2*)p, b = *(const LAS u32x2*)(p + 16);
    return __builtin_bit_cast(bf16x8, (u32x4){a.x, a.y, b.x, b.y});
}
__device__ __forceinline__ bf16x8 pack_acc2(const f32x4& a, const f32x4& b) { return __builtin_bit_cast(bf16x8, (u32x4){pk2(a[0], a[1]), pk2(a[2], a[3]), pk2(b[0], b[1]), pk2(b[2], b[3])}); }
__device__ __forceinline__ void gdn_chain(int wid0, const Params& P, LAS unsigned char* lds, int e, int s, int hd, int dir) {
    const int tid = tid_fresh(wid0), lane = tid & 63, w = __builtin_amdgcn_readfirstlane(tid >> 6), quad = lane >> 4, l15 = lane & 15;
    const bool lat = s >= 32; const int b = lat ? s - 32 : s; const int L = lat ? LLAT : LCTX; const int m0 = lat ? MCTX + b * LLAT : s * LCTX;
    const bf16* proj = (const bf16*)(P.ws + WS_BIG); const float* AB = (const float*)(P.ws + WS_AB);
    bf16* Odir = (bf16*)(P.ws + WS_H) + (size_t)dir * MT * 512;
    int zv; asm volatile("v_mov_b32 %0, 0" : "=v"(zv));
    lds += zv;
    LAS bf16* Qs = (LAS bf16*)(lds + G_Q); LAS bf16* Ks = (LAS bf16*)(lds + G_K); LAS bf16* Vs = (LAS bf16*)(lds + G_V); LAS bf16* KT = (LAS bf16*)(lds + G_KT);
    LAS float* Lm = (LAS float*)(lds + G_LM); LAS bf16* VNT = (LAS bf16*)(lds + G_LM); LAS bf16* QKs = (LAS bf16*)(lds + G_QK); LAS bf16* ST = (LAS bf16*)(lds + G_ST);
    LAS bf16* TM = (LAS bf16*)(lds + G_ST); LAS bf16* TT = TM + 64 * P64; LAS bf16* LR = TT + 64 * P64;
    LAS float* rq = (LAS float*)(lds + G_SM); LAS float* rk = rq + 64; LAS float* gcs = rq + 128; LAS float* betas = rq + 192; LAS float* egs = rq + 256; LAS float* kes = rq + 320;
    f32x4 Sacc[8];
    const size_t sbase = ((((size_t)b * 2 + e) * 2 + dir) * 4 + hd) * 16384;
#pragma unroll
    for (int mt = 0; mt < 8; ++mt) Sacc[mt] = (f32x4){0.f, 0.f, 0.f, 0.f};
    if (lat) { const float* sp = P.in[I_SDELTA] + sbase + (size_t)(quad * 4) * 128 + 16 * w + l15;
#pragma unroll
        for (int mt = 0; mt < 8; ++mt)
#pragma unroll
            for (int jj = 0; jj < 4; ++jj) Sacc[mt][jj] = sp[(16 * mt + jj) * 128]; }
    for (int i = tid; i < 2 * 64 * P64 / 2; i += NTHR) ((LAS unsigned*)TM)[i] = 0u;
    const float alog_e = __expf(P.in[I_GALOG][(e * 2 + dir) * 4 + hd]), dtb = P.in[I_GDTB][(e * 2 + dir) * 4 + hd];
    const int nchunk = L / 64;
    u32x4 xr[6]; float ab_a = 0.f, ab_b = 0.f;
#define GDN_LOAD(ci_) do { const int tid_ = tid_fresh(wid0); const int c0_ = dir ? L - 64 * ((ci_) + 1) : 64 * (ci_); \
        _Pragma("unroll") for (int k = 0; k < 6; ++k) { const int p_ = tid_ + 512 * k, part_ = p_ >> 10, row_ = (p_ & 1023) >> 4, pc_ = p_ & 15; \
            xr[k] = *(const u32x4*)(proj + (size_t)(m0 + c0_ + row_) * NPROJ_E + 1024 + part_ * 512 + hd * 128 + pc_ * 8); } \
        if (w == 0) { const int ln_ = tid_ & 63; const size_t m_ = (size_t)(m0 + c0_ + (dir ? 63 - ln_ : ln_)); ab_a = AB[m_ * 16 + dir * 4 + hd]; ab_b = AB[m_ * 16 + 8 + dir * 4 + hd]; } } while (0)
    GDN_LOAD(0);
#pragma unroll 1
    for (int ci = 0; ci < nchunk; ++ci) {
        const int tid = tid_fresh(wid0), lane = tid & 63, quad = lane >> 4, l15 = lane & 15;
        const int c0 = dir ? L - 64 * (ci + 1) : 64 * ci;
        LDS_BARRIER();
#ifndef NO_A
        const float cur_a = ab_a, cur_b = ab_b;
#pragma unroll
        for (int k = 0; k < 6; ++k) { const int p_ = tid + 512 * k, part_ = p_ >> 10, row_ = (p_ & 1023) >> 4, pc_ = p_ & 15;
            LAS bf16* dst = part_ == 0 ? Qs : (part_ == 1 ? Ks : Vs);
            *(LAS u32x4*)(dst + (dir ? 63 - row_ : row_) * P128 + pc_ * 8) = xr[k]; }
        if (ci + 1 < nchunk) GDN_LOAD(ci + 1);
#endif
        LDS_BARRIER();
#pragma unroll 1
        for (int repB = 0; repB < REP_B; ++repB)
        { const int rowid = tid >> 2, part = tid & 3; LAS bf16* src = (rowid < 64 ? Qs : Ks) + (rowid & 63) * P128 + part * 32;
          float ss = 0.f;
#pragma unroll
          for (int i = 0; i < 4; ++i) { const u32x4 v = *(const LAS u32x4*)(src + 8 * i);
#pragma unroll
              for (int j = 0; j < 4; ++j) { const float a = bflo(v[j]), c = bfhi(v[j]); ss += a * a + c * c; } }
          ss += shfl_i(ss, lane ^ 1); ss += shfl_i(ss, lane ^ 2);
          if (part == 0) { if (rowid < 64) rq[rowid] = rsqrtf(ss + EPSF) * 0.08838834764831845f; else rk[rowid - 64] = rsqrtf(ss + EPSF); }
          if (w == 0) { const int t = c0 + (dir ? 63 - lane : lane); const size_t m = (size_t)(m0 + t);
              const float araw = cur_a, braw = cur_b;
              const float gg = -alog_e * softplusf_(araw + dtb);
              float gc = gg;
#pragma unroll
              for (int o = 1; o < 64; o <<= 1) { const float t2 = shfl_i(gc, (lane - o) & 63); if (lane >= o) gc += t2; }
              const float glast = shfl_i(gc, 63);
              gcs[lane] = gc; betas[lane] = sigmoidf_(braw); egs[lane] = __expf(gc); kes[lane] = __expf(glast - gc);
              if (lane == 0) rq[384] = __expf(glast); } }
        LDS_BARRIER();
#ifndef NO_C
#pragma unroll 1
        for (int repC = 0; repC < REP_C; ++repC)
        { const int mt = w & 3; const bool isq = w >= 4; LAS bf16* src = isq ? Qs : Ks;
          bf16x8 a[4];
#pragma unroll
          for (int ks = 0; ks < 4; ++ks) a[ks] = *(const LAS bf16x8*)(src + (16 * mt + l15) * P128 + 32 * ks + quad * 8);
#pragma unroll 1
          for (int nt = 0; nt < 4; ++nt) { f32x4 acc = (f32x4){0.f, 0.f, 0.f, 0.f};
#pragma unroll
              for (int ks = 0; ks < 4; ++ks) { const bf16x8 bb = *(const LAS bf16x8*)(Ks + (16 * nt + l15) * P128 + 32 * ks + quad * 8); acc = mfma16(a[ks], bb, acc); }
              const int j = 16 * nt + l15; const float rkj = rk[j], gcj = gcs[j];
              f32x4 lv;
#pragma unroll
              for (int jj = 0; jj < 4; ++jj) { const int i = 16 * mt + quad * 4 + jj; const float dec = __expf(fminf(gcs[i] - gcj, 0.f));
                  lv[jj] = (i > j) ? acc[jj] * rk[i] * rkj * betas[i] * dec : 0.f;
                  if (isq) QKs[i * P64 + j] = (bf16)f2bf((i >= j) ? acc[jj] * rq[i] * rkj * dec : 0.f); }
              if (!isq) { *(LAS f32x4*)(Lm + j * LMP + 16 * mt + quad * 4) = lv;
#pragma unroll
                  for (int jj = 0; jj < 4; ++jj) LR[(16 * mt + quad * 4 + jj) * P64 + j] = (bf16)f2bf(nt < mt ? lv[jj] : 0.f); } }
          const int dd = tid & 127, tq = tid >> 7;
          unsigned pw[8];
#pragma unroll
          for (int n = 0; n < 16; n += 2) { const int i0 = tq * 16 + n; const float v0 = bf2f(Ks[i0 * P128 + dd]) * rk[i0] * kes[i0], v1 = bf2f(Ks[(i0 + 1) * P128 + dd]) * rk[i0 + 1] * kes[i0 + 1]; pw[n >> 1] = pk2(v0, v1); }
          *(LAS u32x4*)(KT + dd * P64 + tq * 16) = (u32x4){pw[0], pw[1], pw[2], pw[3]};
          *(LAS u32x4*)(KT + dd * P64 + tq * 16 + 8) = (u32x4){pw[4], pw[5], pw[6], pw[7]}; }
#endif
        LDS_BARRIER();
        { const int i = tid >> 3, c0k = (tid & 7) * 16; const float sc = rk[i] * betas[i] * egs[i];
#pragma unroll
          for (int h2 = 0; h2 < 2; ++h2) { u32x4 v = *(LAS u32x4*)(Ks + i * P128 + c0k + 8 * h2);
#pragma unroll
              for (int q = 0; q < 4; ++q) v[q] = pk2(bflo(v[q]) * sc, bfhi(v[q]) * sc);
              *(LAS u32x4*)(Ks + i * P128 + c0k + 8 * h2) = v; } }
        if (w == 0) { const int bb = lane >> 4, c = lane & 15;
            float x[16];
#pragma unroll
            for (int r = 0; r < 16; ++r) x[r] = (r == c) ? 1.f : 0.f;
#pragma unroll
            for (int j = 0; j < 15; ++j) {
#pragma unroll
                for (int q4 = j / 4; q4 < 4; ++q4) { const f32x4 l4 = *(const LAS f32x4*)(Lm + (16 * bb + j) * LMP + 16 * bb + 4 * q4);
#pragma unroll
                    for (int jx = 0; jx < 4; ++jx) if (4 * q4 + jx > j) x[4 * q4 + jx] -= l4[jx] * x[j]; } }
            unsigned pw[8];
#pragma unroll
            for (int r = 0; r < 16; r += 2) { pw[r >> 1] = pk2(x[r], x[r + 1]); TM[(16 * bb + r) * P64 + 16 * bb + c] = (bf16)(pw[r >> 1] & 0xffffu); TM[(16 * bb + r + 1) * P64 + 16 * bb + c] = (bf16)(pw[r >> 1] >> 16); }
            *(LAS u32x4*)(TT + (16 * bb + c) * P64 + 16 * bb) = (u32x4){pw[0], pw[1], pw[2], pw[3]};
            *(LAS u32x4*)(TT + (16 * bb + c) * P64 + 16 * bb + 8) = (u32x4){pw[4], pw[5], pw[6], pw[7]}; }
        LDS_BARRIER();
#pragma unroll 1
        for (int lev = 1; lev < 4; ++lev) {
            if (w < 4 - lev) { const int bj = w, bi = w + lev;
                f32x4 m = (f32x4){0.f, 0.f, 0.f, 0.f};
#pragma unroll
                for (int ks = 0; ks < 2; ++ks) { const bf16x8 a = *(const LAS bf16x8*)(LR + (16 * bi + l15) * P64 + 32 * ks + quad * 8), bq = *(const LAS bf16x8*)(TT + (16 * bj + l15) * P64 + 32 * ks + quad * 8); m = mfma16(a, bq, m); }
                const u32x2 tl = *(const LAS u32x2*)(TM + (16 * bi + l15) * P64 + 16 * bi + quad * 4);
                const bf16x8 a2 = __builtin_bit_cast(bf16x8, (u32x4){tl.x, tl.y, 0u, 0u}), b2 = __builtin_bit_cast(bf16x8, (u32x4){pk2(m[0], m[1]), pk2(m[2], m[3]), 0u, 0u});
                const f32x4 t = mfma16(a2, b2, (f32x4){0.f, 0.f, 0.f, 0.f});
                const unsigned p0 = pk2(-t[0], -t[1]), p1 = pk2(-t[2], -t[3]);
                TM[(16 * bi + quad * 4 + 0) * P64 + 16 * bj + l15] = (bf16)(p0 & 0xffffu); TM[(16 * bi + quad * 4 + 1) * P64 + 16 * bj + l15] = (bf16)(p0 >> 16);
                TM[(16 * bi + quad * 4 + 2) * P64 + 16 * bj + l15] = (bf16)(p1 & 0xffffu); TM[(16 * bi + quad * 4 + 3) * P64 + 16 * bj + l15] = (bf16)(p1 >> 16);
                *(LAS u32x2*)(TT + (16 * bj + l15) * P64 + 16 * bi + quad * 4) = (u32x2){p0, p1}; }
            LDS_BARRIER();
        }
#ifndef NO_EFG
        bf16x8 Bst[4];
#pragma unroll
        for (int ks = 0; ks < 4; ++ks) Bst[ks] = pack_acc2(Sacc[2 * ks], Sacc[2 * ks + 1]);
        f32x4 vn[4];
#pragma unroll
        for (int mt = 0; mt < 4; ++mt) { f32x4 acc = (f32x4){0.f, 0.f, 0.f, 0.f};
#pragma unroll
            for (int ks = 0; ks < 4; ++ks) { const bf16x8 a = ld_split8(Ks + (16 * mt + l15) * P128 + 32 * ks + quad * 4); acc = mfma16(a, Bst[ks], acc); }
#pragma unroll
            for (int jj = 0; jj < 4; ++jj) { const int i = 16 * mt + quad * 4 + jj; vn[mt][jj] = bf2f(Vs[i * P128 + 16 * w + l15]) * betas[i] - acc[jj]; } }
        bf16x8 Bvn[2];
#pragma unroll
        for (int k2 = 0; k2 < 2; ++k2) Bvn[k2] = pack_acc2(vn[2 * k2], vn[2 * k2 + 1]);
#pragma unroll
        for (int mt = 0; mt < 4; ++mt) { f32x4 acc = (f32x4){0.f, 0.f, 0.f, 0.f};
#pragma unroll
            for (int k2 = 0; k2 < 2; ++k2) { const bf16x8 a = ld_split8(TM + (16 * mt + l15) * P64 + 32 * k2 + quad * 4); acc = mfma16(a, Bvn[k2], acc); }
            vn[mt] = acc; }
#pragma unroll
        for (int k2 = 0; k2 < 2; ++k2) Bvn[k2] = pack_acc2(vn[2 * k2], vn[2 * k2 + 1]);
#pragma unroll 1
        for (int mt = 0; mt < 4; ++mt) { f32x4 acc = (f32x4){0.f, 0.f, 0.f, 0.f};
#pragma unroll
            for (int ks = 0; ks < 4; ++ks) { const bf16x8 a = ld_split8(Qs + (16 * mt + l15) * P128 + 32 * ks + quad * 4); acc = mfma16(a, Bst[ks], acc); }
#pragma unroll
            for (int jj = 0; jj < 4; ++jj) { const int i = 16 * mt + quad * 4 + jj; acc[jj] *= rq[i] * egs[i]; }
#pragma unroll
            for (int k2 = 0; k2 < 2; ++k2) { const bf16x8 a = ld_split8(QKs + (16 * mt + l15) * P64 + 32 * k2 + quad * 4); acc = mfma16(a, Bvn[k2], acc); }
#pragma unroll
            for (int jj = 0; jj < 4; ++jj) { const int i = 16 * mt + quad * 4 + jj; const int t = c0 + (dir ? 63 - i : i);
                Odir[(size_t)(m0 + t) * 512 + hd * 128 + 16 * w + l15] = (bf16)f2bf(acc[jj]); } }
        const float egl = rq[384];
#pragma unroll
        for (int mt = 0; mt < 8; ++mt) { f32x4 acc = Sacc[mt] * egl;
#pragma unroll
            for (int k2 = 0; k2 < 2; ++k2) { const bf16x8 a = ld_split8(KT + (16 * mt + l15) * P64 + 32 * k2 + quad * 4); acc = mfma16(a, Bvn[k2], acc); }
            Sacc[mt] = acc; }
#endif
        WAVE_SYNC();
    }
    if (!lat) { const int tid2 = tid_fresh(wid0), lane2 = tid2 & 63; float* dp = P.out + OUT_DELTA + sbase + (size_t)((lane2 >> 4) * 4) * 128 + 16 * w + (lane2 & 15);
#pragma unroll
        for (int mt = 0; mt < 8; ++mt)
#pragma unroll
            for (int jj = 0; jj < 4; ++jj) dp[(16 * mt + jj) * 128] = Sacc[mt][jj];
    }
    __syncthreads();
}

__device__ __forceinline__ void phase_mix_even(int wid0, const Params& P, LAS unsigned char* lds, int e, int mode = 3) {
    const int bid = bid_fresh(), G = grid_fresh();
    if (G == 256) {
        if (bid < 64) { const int s = 32 + (bid >> 3), hd = (bid >> 1) & 3, dir = bid & 1; if (mode & 1) gdn_chain(wid0, P, lds, e, s, hd, dir); }
        else { const int bb = bid - 64;
            if (mode & 1) for (int c = bb; c < 256; c += 192) { const int s = c >> 3, hd = (c >> 1) & 3, dir = c & 1; gdn_chain(wid0, P, lds, e, s, hd, dir); }
            if (mode & 2) { const int tid = tid_fresh(wid0), lane = tid & 63, wave = tid >> 6;
                for (int t = bb; t < 384; t += 192) { const int wt = t * 8 + wave; s5_task_main(P, lds + wave * S5_WLDS, lane, e, wt >> 5, wt & 31); } }
            if (mode == 3) { __syncthreads(); const int tid = tid_fresh(wid0), lane = tid & 63, wave = tid >> 6;
                for (int it = bb * NWAVES + wave; it < WITEMS_ODD; it += 192 * NWAVES) weight_item(P, (LAS float*)(lds + wave * 16384), 2 * e + 1, it, lane); } }
    } else {
        for (int c = bid; c < 320; c += G) { const int s = c < 64 ? 32 + (c >> 3) : ((c - 64) >> 3), hd = (c >> 1) & 3, dir = c & 1; gdn_chain(wid0, P, lds, e, s, hd, dir); }
        const int tid = tid_fresh(wid0), lane = tid & 63, wave = tid >> 6;
        for (int t = bid; t < 384; t += G) { const int wt = t * 8 + wave; s5_task_main(P, lds + wave * S5_WLDS, lane, e, wt >> 5, wt & 31); }
        __syncthreads();
        for (int it = bid * NWAVES + wave; it < WITEMS_ODD; it += G * NWAVES) weight_item(P, (LAS float*)(lds + wave * 16384), 2 * e + 1, it, lane);
    }
}
__device__ __forceinline__ void phase_fin_even(int wid0, const Params& P, LAS unsigned char* lds, int e, int dry = 0) {
    const int tid = tid_fresh(wid0), lane = tid & 63, wave = tid >> 6;
    const int gw = bid_fresh() * NWAVES + wave, NGW = grid_fresh() * NWAVES;
    for (int wt = gw; wt < 2048; wt += NGW) s5_task_corr(P, lds + wave * S5_WLDS, lane, e, wt >> 5, wt & 31, dry);
    const bf16* proj = (const bf16*)(P.ws + WS_BIG); const bf16* Of = (const bf16*)(P.ws + WS_H); const bf16* Ob = Of + (size_t)MT * 512; bf16* mixout = (bf16*)(P.ws + WS_MIX);
    for (int mb2 = gw; mb2 < MT; mb2 += 2 * NGW) {
        u32x4 a[2], bq[2], z[2];
#pragma unroll
        for (int u = 0; u < 2; ++u) { const int m = mb2 + u * NGW; if (m < MT) { a[u] = *(const u32x4*)(Of + (size_t)m * 512 + lane * 8); bq[u] = *(const u32x4*)(Ob + (size_t)m * 512 + lane * 8); z[u] = *(const u32x4*)(proj + (size_t)m * NPROJ_E + 2560 + lane * 8); } }
#pragma unroll
        for (int u = 0; u < 2; ++u) { const int m = mb2 + u * NGW; if (m < MT) {
            float o[8]; float ss = 0.f;
#pragma unroll
            for (int j = 0; j < 4; ++j) { o[2 * j] = bflo(a[u][j]) + bflo(bq[u][j]); o[2 * j + 1] = bfhi(a[u][j]) + bfhi(bq[u][j]); ss += o[2 * j] * o[2 * j] + o[2 * j + 1] * o[2 * j + 1]; }
            ss += shfl_i(ss, lane ^ 1); ss += shfl_i(ss, lane ^ 2); ss += shfl_i(ss, lane ^ 4); ss += shfl_i(ss, lane ^ 8);
            const float rs = rsqrtf(ss * (1.0f / 128.0f) + EPSF);
            const float* gn = P.in[I_GONORM] + e * 128 + (lane & 15) * 8;
            unsigned pw[4];
#pragma unroll
            for (int j = 0; j < 4; ++j) { const float z0 = bflo(z[u][j]), z1 = bfhi(z[u][j]); pw[j] = pk2(o[2 * j] * rs * gn[2 * j] * siluf_(z0), o[2 * j + 1] * rs * gn[2 * j + 1] * siluf_(z1)); }
            if (!dry) *(u32x4*)(mixout + (size_t)m * DM + 512 + lane * 8) = (u32x4){pw[0], pw[1], pw[2], pw[3]}; } }
    }
}

__device__ __forceinline__ void phase_conv_odd(int wid0, const Params& P, int o) {
    const int tid = tid_fresh(wid0), lane = tid & 63, wave = tid >> 6;
    const int gw = bid_fresh() * NWAVES + wave, NGW = grid_fresh() * NWAVES;
    const bf16* proj = (const bf16*)(P.ws + WS_BIG); bf16* cx = (bf16*)(P.ws + WS_H);
    const float* cw = P.in[I_LCONVW] + (size_t)o * 4 * 1024; const float* cb = P.in[I_LCONVB] + o * 1024;
    for (int m = gw; m < MT; m += NGW) {
        const int t = m < MCTX ? (m & 255) : ((m - MCTX) & 2047); const int L = m < MCTX ? LCTX : LLAT;
#pragma unroll
        for (int h2 = 0; h2 < 2; ++h2) { const int ch = lane * 8 + 512 * h2;
            float acc[8];
#pragma unroll
            for (int j = 0; j < 8; ++j) acc[j] = cb[ch + j];
#pragma unroll
            for (int k = 0; k < 4; ++k) { const int tt = t - 1 + k; if (tt >= 0 && tt < L) { const u32x4 v = *(const u32x4*)(proj + (size_t)(m - 1 + k) * 2048 + ch);
#pragma unroll
                    for (int j = 0; j < 4; ++j) { acc[2 * j] += cw[k * 1024 + ch + 2 * j] * bflo(v[j]); acc[2 * j + 1] += cw[k * 1024 + ch + 2 * j + 1] * bfhi(v[j]); } } }
            *(u32x4*)(cx + (size_t)m * DM + ch) = (u32x4){pk2(acc[0], acc[1]), pk2(acc[2], acc[3]), pk2(acc[4], acc[5]), pk2(acc[6], acc[7])}; }
    }
}
__device__ __forceinline__ void phase_lru_scan(int wid0, const Params& P, LAS unsigned char* lds, int o, int d) {
    const int tid = tid_fresh(wid0), lane = tid & 63, wave = tid >> 6;
    const int gw = bid_fresh() * NWAVES + wave, NGW = grid_fresh() * NWAVES;
    const unsigned* G = (const unsigned*)(P.ws + WS_GATES); const bf16* proj = (const bf16*)(P.ws + WS_BIG); bf16* mixout = (bf16*)(P.ws + WS_MIX);
    const int Gn = NGW / NWAVES, vw = wave * Gn + (gw / NWAVES);
    if (d == 0 && o == 0 && NGW > 640) {
        for (int it = vw - 640; it >= 0 && it < WITEMS_EVEN; it += NGW - 640) weight_item(P, (LAS float*)(lds + wave * 16384), 2, it, lane); }
    for (int task = vw; task < 640; task += NGW) {
        int s, cg_;
        if (task < 128) { s = 32 + (task >> 4); cg_ = task & 15; } else { s = (task - 128) >> 4; cg_ = (task - 128) & 15; }
        const bool lat = s >= 32; const int b = lat ? s - 32 : s; const int L = lat ? LLAT : LCTX; const int m0 = lat ? MCTX + b * LLAT : s * LCTX;
        const int ch = cg_ * 64 + lane;
        float h = lat ? P.in[I_SLRU][(((size_t)b * 2 + o) * 2 + d) * 1024 + ch] : 0.f;
        if (d == 0) {
            unsigned ga[32], gb[32];
#define LRU_LD0(dst, tt) _Pragma("unroll") for (int i = 0; i < 32; ++i) dst[i] = G[(size_t)(m0 + (tt) + i) * DM + ch]
#define LRU_CP0(src, tt) _Pragma("unroll") for (int i = 0; i < 32; ++i) { h = (1.0f - bflo(src[i])) * h + bfhi(src[i]); mixout[(size_t)(m0 + (tt) + i) * DM + ch] = (bf16)f2bf(h); }
            LRU_LD0(ga, 0);
            for (int t0 = 0; t0 < L; t0 += 64) {
                LRU_LD0(gb, t0 + 32);
                LRU_CP0(ga, t0);
                if (t0 + 64 < L) { LRU_LD0(ga, t0 + 64); }
                LRU_CP0(gb, t0 + 32);
            }
        } else {
            unsigned ga[16], gb[16]; bf16 pa[16], pb[16], ya[16], yb[16];
#define LRU_LD1(g_, p_, y_, tt) _Pragma("unroll") for (int i = 0; i < 16; ++i) { const size_t m = (size_t)(m0 + L - 1 - ((tt) + i)); g_[i] = G[m * DM + ch]; p_[i] = mixout[m * DM + ch]; y_[i] = proj[m * 2048 + 1024 + ch]; }
#define LRU_CP1(g_, p_, y_, tt) _Pragma("unroll") for (int i = 0; i < 16; ++i) { const size_t m = (size_t)(m0 + L - 1 - ((tt) + i)); \
                h = (1.0f - bflo(g_[i])) * h + bfhi(g_[i]); mixout[m * DM + ch] = (bf16)f2bf((bf2f(p_[i]) + h) * geluf_(bf2f(y_[i]))); }
            LRU_LD1(ga, pa, ya, 0);
            for (int t0 = 0; t0 < L; t0 += 32) {
                LRU_LD1(gb, pb, yb, t0 + 16);
                LRU_CP1(ga, pa, ya, t0);
                if (t0 + 32 < L) { LRU_LD1(ga, pa, ya, t0 + 32); }
                LRU_CP1(gb, pb, yb, t0 + 16);
            }
        }
        if (!lat) P.out[OUT_LRU + (((size_t)b * 2 + o) * 2 + d) * 1024 + ch] = h;
    }
}
#ifdef PROBE_DUP_GEMM
#define DUPG(x) GSYNC(); x
#else
#define DUPG(x)
#endif
typedef const __attribute__((address_space(4))) Params* KParams;
__device__ __forceinline__ Params load_params(KParams q) { Params r;
#pragma unroll
    for (int i = 0; i < 40; ++i) r.in[i] = q->in[i];
    r.out = q->out; r.ws = q->ws; return r; }
#define FRESH() const int G = grid_fresh(), bid = bid_fresh(); (void)G; (void)bid; KParams pk_ = (KParams)__builtin_amdgcn_kernarg_segment_ptr(); asm volatile("" : "+s"(pk_)); const Params P = load_params(pk_); unsigned char* ws = P.ws; \
    const float* mod = (const float*)(ws + WS_MOD); bf16* H = (bf16*)(ws + WS_H); bf16* BIG = (bf16*)(ws + WS_BIG); bf16* MIX = (bf16*)(ws + WS_MIX); (void)mod; (void)H; (void)BIG; (void)MIX;
#define GSYNC() do { KParams pb_ = (KParams)__builtin_amdgcn_kernarg_segment_ptr(); asm volatile("" : "+s"(pb_)); xcd_barrier(wid0, (unsigned*)(pb_->ws + WS_BAR), lds); } while (0)
__global__ void __launch_bounds__(NTHR, 2) fwd_kernel(Params Parg) {
    extern __shared__ __attribute__((aligned(16))) unsigned char lds_raw[];
    LAS unsigned char* lds = (LAS unsigned char*)lds_raw;
    cg::grid_group grid = cg::this_grid();
    const int wid0 = __builtin_amdgcn_readfirstlane(threadIdx.x >> 6);
    if (threadIdx.x < 4) ((LAS unsigned*)(lds + LDS_BARST))[threadIdx.x] = 0u;
    __syncthreads();
    if (threadIdx.x == 0) (void)xb_add((unsigned*)(Parg.ws + WS_BAR) + XB_XCNT(xb_xcc_id()), 1u);

    { FRESH(); phase_prologue(wid0, P, lds); }
    if (grid_fresh() == 0) grid.sync();
    GSYNC();
#ifdef PROBE_DUP_PRO
    { FRESH(); phase_prologue(wid0, P, lds); }
    GSYNC();
#endif
    { FRESH(); phase_modreduce(wid0, P); }
    GSYNC();
#ifdef PROBE_SYNC
#pragma unroll 1
    for (int i = 0; i < 40; ++i) GSYNC();
#endif
#pragma unroll 1
    for (int l = 0; l < 4; ++l) {
        { FRESH(); const float* modl = mod + (size_t)l * 9 * 6144;
        phase_rownorm(wid0, P, l == 0, MIX, modl - 9 * 6144, 5 * 1024, P.in[I_NMLPPOST] + (l > 0 ? (l - 1) * 1024 : 0), 1, P.in[I_NMIXPRE] + l * 1024, modl, 0, H); }
        GSYNC();
        const int eo = l >> 1;
        {
            FRESH();
            pg8::Gemm g; pg8::StaticOrder S; EpiBf16<0> E;
            if ((l & 1) == 0) { g = pg8::Gemm{H, (const bf16*)(ws + WS_WINE) + (size_t)eo * NB_E * 1024, MT, NB_E, 1024, 1024, 0, 0, 1024, 0}; E = EpiBf16<0>{BIG, NPROJ_E, (float*)(ws + WS_AB), (bf16*)(ws + WS_HALO)}; }
            else { g = pg8::Gemm{H, (const bf16*)(ws + WS_WINO) + (size_t)eo * 2048 * 1024, MT, 2048, 1024, 1024, 0, 0, 1024, 0}; E = EpiBf16<0>{BIG, 2048, nullptr, nullptr}; }
            S.init(g.M, g.N, G, bid);
            pg8::gemm_phase(wid0, lds, g, S, E); DUPG(pg8::gemm_phase(wid0, lds, g, S, E);)
        }
        GSYNC();
        if ((l & 1) == 0) {
            { FRESH(); phase_conv_even(wid0, P, eo); }
            GSYNC();
#ifdef PROBE_DRY_CONVE
            { FRESH(); phase_conv_even(wid0, P, eo, grid_fresh() > 0); }
            GSYNC();
#endif
#ifdef PROBE_DUP_MIX
#pragma unroll 1
            for (int rep = 0; rep < 2; ++rep) { { FRESH(); phase_mix_even(wid0, P, lds, eo, rep == 0 ? 3 : PROBE_DUP_MIX); } GSYNC(); }
#else
            { FRESH(); phase_mix_even(wid0, P, lds, eo); }
            GSYNC();
#endif
            { FRESH(); phase_fin_even(wid0, P, lds, eo); }
            GSYNC();
#ifdef PROBE_DRY_FIN
            { FRESH(); phase_fin_even(wid0, P, lds, eo, grid_fresh() > 0); }
            GSYNC();
#endif
        } else {
            { FRESH(); phase_conv_odd(wid0, P, eo); }
            GSYNC();
#ifdef PROBE_DUP_CONV
            { FRESH(); phase_conv_odd(wid0, P, eo); }
            GSYNC();
#endif
#pragma unroll 1
            for (int d = 0; d < 2; ++d) {
                { FRESH();
                pg8::Gemm g{H, (const bf16*)(ws + WS_WG) + (size_t)(eo * 2 + d) * 2048 * 256, MT, 2048, 256, 1024, 1, 1, 256, 0};
                EpiGates E{(unsigned*)(ws + WS_GATES), H, P.in[I_LBR] + (eo * 2 + d) * 1024, P.in[I_LBI] + (eo * 2 + d) * 1024, P.in[I_LLAM] + (eo * 2 + d) * 1024};
                pg8::StaticOrder S; S.init(g.M, g.N, G, bid);
                pg8::gemm_phase(wid0, lds, g, S, E); DUPG(pg8::gemm_phase(wid0, lds, g, S, E);) }
                GSYNC();
                { FRESH(); phase_lru_scan(wid0, P, lds, eo, d); }
#ifdef PROBE_DUP_LRU0
                if (d == 0) { GSYNC(); FRESH(); phase_lru_scan(wid0, P, lds, eo, d); }
#endif
                GSYNC();
            }
        }
        {
            FRESH();
            pg8::Gemm g{MIX, (const bf16*)(ws + ((l & 1) ? WS_WOUTO : WS_WOUTE)) + (size_t)eo * 1024 * 1024, MT, 1024, 1024, 1024, 0, 0, 1024, 0};
            EpiBf16<0> E{BIG, 1024, nullptr, nullptr}; pg8::StaticOrder S; S.init(g.M, g.N, G, bid);
            pg8::gemm_phase(wid0, lds, g, S, E); DUPG(pg8::gemm_phase(wid0, lds, g, S, E);)
        }
        GSYNC();
        { FRESH(); const float* modl = mod + (size_t)l * 9 * 6144;
        phase_rownorm(wid0, P, 0, BIG, modl, 2 * 1024, P.in[I_NMIXPOST] + l * 1024, 1, P.in[I_NMLPPRE] + l * 1024, modl, 3 * 1024, H); }
#ifdef PROBE_DUP_RN
        GSYNC();
        { FRESH(); const float* modl = mod + (size_t)l * 9 * 6144;
        phase_rownorm(wid0, P, 0, BIG, modl, 2 * 1024, P.in[I_NMIXPOST] + l * 1024, 1, P.in[I_NMLPPRE] + l * 1024, modl, 3 * 1024, H, 0.0f); }
#endif
        GSYNC();
        {
            FRESH();
            pg8::Gemm g{H, (const bf16*)(ws + WS_W1T) + (size_t)l * 4096 * 1024, MT, 4096, 1024, 1024, 0, 0, 1024, 0};
            EpiBf16<1> E{BIG, 4096, nullptr, nullptr}; pg8::StaticOrder S; S.init(g.M, g.N, G, bid);
            pg8::gemm_phase(wid0, lds, g, S, E); DUPG(pg8::gemm_phase(wid0, lds, g, S, E);)
        }
        GSYNC();
        {
            FRESH();
            pg8::Gemm g{BIG, (const bf16*)(ws + WS_W2T) + (size_t)l * 1024 * 4096, MT, 1024, 4096, 4096, 0, 0, 4096, 0};
            EpiBf16<0> E{MIX, 1024, nullptr, nullptr}; pg8::StaticOrder S; S.init(g.M, g.N, G, bid);
            pg8::gemm_phase(wid0, lds, g, S, E); DUPG(pg8::gemm_phase(wid0, lds, g, S, E);)
        }
        GSYNC();
    }
    { FRESH();
    phase_rownorm(wid0, P, 0, MIX, mod + (size_t)3 * 9 * 6144, 5 * 1024, P.in[I_NMLPPOST] + 3 * 1024, 0, P.in[I_NMIXPRE], mod, 0, H); }
    GSYNC();
    { FRESH(); phase_copy_tail(wid0, P); }
}

extern "C" void kernel_launch(void* const* d_in, const int* in_sizes, int n_in, void* d_out, int out_size, void* d_ws, size_t ws_size, hipStream_t stream) {
    static int grid = 0;
    if (grid == 0) {
        if (n_in != 40 || ws_size < WS_END) { fprintf(stderr, "kernel_launch: expected 40 inputs and >= %zu bytes of workspace (got %d, %zu)\n", (size_t)WS_END, n_in, ws_size); grid = -1; return; }
        int dev = 0, cus = 0, per_cu = 0;
        if (hipGetDevice(&dev) != hipSuccess || hipDeviceGetAttribute(&cus, hipDeviceAttributeMultiprocessorCount, dev) != hipSuccess) { grid = -1; return; }
        if (hipFuncSetAttribute((const void*)fwd_kernel, hipFuncAttributeMaxDynamicSharedMemorySize, LDS_BYTES) != hipSuccess) { fprintf(stderr, "kernel_launch: hipFuncSetAttribute failed\n"); grid = -1; return; }
        if (hipOccupancyMaxActiveBlocksPerMultiprocessor(&per_cu, (const void*)fwd_kernel, NTHR, LDS_BYTES) != hipSuccess || per_cu < 1) per_cu = 1;
        (void)hipGetLastError();
        grid = cus * per_cu; if (grid > 256) grid = 256;
    }
    if (grid < 0) return;
    (void)hipMemsetAsync((char*)d_ws + WS_BAR, 0, 16384, stream);
    Params p{};
    for (int i = 0; i < 40; ++i) p.in[i] = (const float*)d_in[i];
    p.out = (float*)d_out; p.ws = (unsigned char*)d_ws;
    void* args[] = {&p};
    hipError_t e = hipLaunchCooperativeKernel((const void*)fwd_kernel, dim3(grid), dim3(NTHR), args, LDS_BYTES, stream);
    if (e != hipSuccess) fprintf(stderr, "cooperative launch failed: %s (grid %d)\n", hipGetErrorString(e), grid);
}
```

```cpp
#include <hip/hip_runtime.h>
#include <hip/hip_cooperative_groups.h>
#include <cstdio>
#include <cstdint>
namespace cg = cooperative_groups;
__device__ __forceinline__ int bid_fresh() { int t = blockIdx.x; asm volatile("" : "+s"(t)); return t; }
__device__ __forceinline__ int grid_fresh() { int t = gridDim.x; asm volatile("" : "+s"(t)); return t; }
__device__ __forceinline__ int tid_fresh(int w) { asm volatile("" : "+s"(w)); int l; asm volatile("v_mbcnt_lo_u32_b32 %0, -1, 0\n\tv_mbcnt_hi_u32_b32 %0, -1, %0" : "=v"(l)); return w * 64 + l; }

namespace pg8 {
#define PG8_LAS __attribute__((address_space(3)))
typedef unsigned short bf16_t;
typedef short bf16x8 __attribute__((ext_vector_type(8)));
typedef float f32x4 __attribute__((ext_vector_type(4)));
typedef unsigned u32x4 __attribute__((ext_vector_type(4)));
typedef unsigned u32x2 __attribute__((ext_vector_type(2)));
constexpr int BM = 256, BK = 64, HALF = 128, HTB = HALF * BK * 2, STAGE_BYTES = 8 * HTB, NXCD = 8, WGM = 4;

__host__ __device__ __forceinline__ int lds_byte(int r, int c) { const int st = (r >> 4) * 2 + (c >> 5), rr = r & 15, cc = c & 31, ob = rr * 64 + cc * 2; return st * 1024 + (ob ^ (((ob >> 9) & 1) << 5)); }
__host__ __device__ __forceinline__ void stage_rc(int b, int& R, int& C) { const int st = b / 1024, sb = b % 1024, swz = sb ^ (((sb >> 9) & 1) << 5); R = (st >> 1) * 16 + swz / 64; C = (st & 1) * 32 + (swz % 64) / 2; }
__host__ __device__ __forceinline__ int perm32(int rho) { const int n = rho >> 4, i = rho & 15; return 8 * (i >> 2) + 4 * n + (i & 3); }

struct Unit { int pm, pn; };
struct Gemm { const bf16_t* A; const bf16_t* Bt; int M, N, K, lda, ablk, ashift, ldb, ksplit; };

struct StaticOrder {
    int nM, nN, nwg, G, c;
    __host__ __device__ void init(int M, int N, int G_, int c_) { nM = M / BM; nN = N / BM; nwg = nM * nN; G = G_; c = c_; }
    __host__ __device__ bool next(int i, Unit& u) const {
        const long L = (long)i * G + c; if (L >= nwg) return false;
        int wgid = (int)L; { const int q = nwg / NXCD, r = nwg % NXCD, xcd = wgid % NXCD, off = wgid / NXCD; wgid = (xcd < r ? xcd * (q + 1) : r * (q + 1) + (xcd - r) * q) + off; }
        const int nig = WGM * nN, gid = wgid / nig, fm = gid * WGM, gsz = (nM - fm) < WGM ? (nM - fm) : WGM;
        u.pm = fm + ((wgid % nig) % gsz); u.pn = (wgid % nig) / gsz; return true;
    }
};
__device__ __forceinline__ unsigned cvt_pk_bf16(float lo, float hi) { unsigned r; asm volatile("v_cvt_pk_bf16_f32 %0, %1, %2" : "=v"(r) : "v"(lo), "v"(hi)); return r; }

template <class Epi>
__device__ __forceinline__ void gemm_phase(int wid0, PG8_LAS unsigned char* lds, const Gemm g, const StaticOrder& S, const Epi& E) {
    const int tid = tid_fresh(wid0), wid = __builtin_amdgcn_readfirstlane(tid >> 6), lane = tid & 63, wr = wid >> 2, wc = wid & 3, fr = lane & 15, fq = lane >> 4;
    const int K = g.K, nt = K / BK, lda = g.lda, ldb = g.ldb;
    unsigned voffA[2], voffB[2];
#pragma unroll
    for (int i = 0; i < 2; ++i) { int R, C; stage_rc(tid * 16 + i * 8192, R, C); const int Rb = (R & ~31) + perm32(R & 31);
        voffA[i] = (unsigned)(R * lda + C) * 2u; voffB[i] = (unsigned)(Rb * ldb + C) * 2u; }
    const size_t kstep = (size_t)(BK * 2);
    const size_t hstepA = (size_t)HALF * lda * 2, hstepB = (size_t)HALF * ldb * 2;
    const size_t tstepA = 2 * hstepA, tstepB = 2 * hstepB;
    const unsigned ldsw = (unsigned)wid * 1024u;
    const int aoff = lds_byte(wr * 64 + fr, fq * 8), boff = lds_byte(wc * 32 + fr, fq * 8);
#define PG8_ACOL(pn) (g.ablk ? (size_t)((((pn) >> g.ashift) & 3) * 512) : (g.ksplit ? (size_t)((pn) & 1) * (size_t)K * 2 : (size_t)0))
#define PG8_BOFF(pn) (g.ksplit ? (size_t)((pn) >> 1) * tstepB + (size_t)((pn) & 1) * (size_t)K * 2 : (size_t)(pn) * tstepB)
#define PG8_SA(b, h) (((b) * 2 + (h)) * HTB)
#define PG8_SB(b, h) ((4 + (b) * 2 + (h)) * HTB)
#define PG8_STAGE(bufoff, gbase, voff) do { _Pragma("unroll") for (int _i = 0; _i < 2; ++_i) \
        __builtin_amdgcn_global_load_lds((const unsigned*)((const char*)(gbase) + (voff)[_i]), (PG8_LAS unsigned*)(lds + (bufoff) + ldsw + _i * 8192), 16, 0, 0); } while (0)
#define PG8_LDA(dst, b, h) do { _Pragma("unroll") for (int m = 0; m < 4; ++m) _Pragma("unroll") for (int k = 0; k < 2; ++k) dst[m][k] = *(const PG8_LAS bf16x8*)(lds + PG8_SA(b, h) + aoff + m * 2048 + k * 1024); } while (0)
#define PG8_LDB(dst, b, h) do { _Pragma("unroll") for (int n = 0; n < 2; ++n) _Pragma("unroll") for (int k = 0; k < 2; ++k) dst[n][k] = *(const PG8_LAS bf16x8*)(lds + PG8_SB(b, h) + boff + n * 2048 + k * 1024); } while (0)
#define PG8_MMA(ai, bj, At, Bt) do { __builtin_amdgcn_s_setprio(1); _Pragma("unroll") for (int m = 0; m < 4; ++m) _Pragma("unroll") for (int n = 0; n < 2; ++n) _Pragma("unroll") for (int k = 0; k < 2; ++k) \
        acc[ai][bj][m][n] = __builtin_amdgcn_mfma_f32_16x16x32_bf16(Bt[n][k], At[m][k], acc[ai][bj][m][n], 0, 0, 0); __builtin_amdgcn_s_setprio(0); } while (0)
#define PG8_WAIT_V(n) asm volatile("s_waitcnt vmcnt(" #n ")" ::: "memory")
#define PG8_WAIT_L(n) asm volatile("s_waitcnt lgkmcnt(" #n ")" ::: "memory")
#define PG8_BAR __builtin_amdgcn_s_barrier()
#define PG8_SCHED __builtin_amdgcn_sched_barrier(0)
    Unit cur, nxt; int ui = 0;
    if (!S.next(0, cur)) return;
    f32x4 acc[2][2][4][2];
#pragma unroll
    for (int a = 0; a < 2; ++a)
#pragma unroll
        for (int b = 0; b < 2; ++b)
#pragma unroll
            for (int m = 0; m < 4; ++m)
#pragma unroll
                for (int n = 0; n < 2; ++n) acc[a][b][m][n] = (f32x4){0.f, 0.f, 0.f, 0.f};
    bf16x8 At[4][2], B0[2][2], B1[2][2];
    const char* cA = (const char*)g.A + (size_t)cur.pm * tstepA + PG8_ACOL(cur.pn); const char* cB = (const char*)g.Bt + PG8_BOFF(cur.pn);
    PG8_STAGE(PG8_SB(0, 0), cB, voffB); PG8_STAGE(PG8_SA(0, 0), cA, voffA); PG8_STAGE(PG8_SB(0, 1), cB + hstepB, voffB); PG8_STAGE(PG8_SA(0, 1), cA + hstepA, voffA);
    if (wr == 1) PG8_BAR;
    PG8_WAIT_V(4); PG8_BAR;
    PG8_STAGE(PG8_SB(1, 0), cB + kstep, voffB); PG8_STAGE(PG8_SA(1, 0), cA + kstep, voffA); PG8_STAGE(PG8_SB(1, 1), cB + hstepB + kstep, voffB);
    PG8_WAIT_V(6); PG8_BAR;
    for (;;) {
        const bool has_next = S.next(ui + 1, nxt);
        const char* nA = has_next ? (const char*)g.A + (size_t)nxt.pm * tstepA + PG8_ACOL(nxt.pn) : cA; const char* nB = has_next ? (const char*)g.Bt + PG8_BOFF(nxt.pn) : cB;
        for (int t = 0; t < nt; t += 2) {
            const bool last = (t == nt - 2);
            const char* a1 = cA + (size_t)(t + 1) * kstep;
            const char* a2 = last ? nA : cA + (size_t)(t + 2) * kstep; const char* b2 = last ? nB : cB + (size_t)(t + 2) * kstep;
            const char* a3 = a2 + kstep; const char* b3 = b2 + kstep;
            PG8_LDB(B0, 0, 0); PG8_SCHED; PG8_LDA(At, 0, 0); PG8_STAGE(PG8_SA(1, 1), a1 + hstepA, voffA);
            PG8_WAIT_L(8); PG8_BAR; PG8_WAIT_L(0); PG8_MMA(0, 0, At, B0); PG8_BAR; PG8_SCHED;
            PG8_LDB(B1, 0, 1); PG8_STAGE(PG8_SB(0, 0), b2, voffB);
            PG8_BAR; PG8_WAIT_L(0); PG8_MMA(0, 1, At, B1); PG8_BAR;
            PG8_LDA(At, 0, 1); PG8_STAGE(PG8_SA(0, 0), a2, voffA);
            PG8_BAR; PG8_WAIT_L(0); PG8_MMA(1, 0, At, B0); PG8_BAR; PG8_SCHED;
            PG8_STAGE(PG8_SB(0, 1), b2 + hstepB, voffB);
            PG8_WAIT_V(6); PG8_BAR; PG8_MMA(1, 1, At, B1); PG8_BAR;
            PG8_LDB(B0, 1, 0); PG8_SCHED; PG8_LDA(At, 1, 0); PG8_STAGE(PG8_SA(0, 1), a2 + hstepA, voffA);
            PG8_WAIT_L(8); PG8_BAR; PG8_WAIT_L(0); PG8_MMA(0, 0, At, B0); PG8_BAR; PG8_SCHED;
            PG8_LDB(B1, 1, 1); PG8_STAGE(PG8_SB(1, 0), b3, voffB);
            PG8_BAR; PG8_WAIT_L(0); PG8_MMA(0, 1, At, B1); PG8_BAR;
            PG8_LDA(At, 1, 1); PG8_STAGE(PG8_SA(1, 0), a3, voffA);
            PG8_BAR; PG8_WAIT_L(0); PG8_MMA(1, 0, At, B0); PG8_BAR; PG8_SCHED;
            PG8_STAGE(PG8_SB(1, 1), b3 + hstepB, voffB);
            PG8_WAIT_V(6); PG8_BAR; PG8_MMA(1, 1, At, B1); PG8_BAR;
        }
        E(acc, cur, wr, wc, fr, fq);
        if (!has_next) break;
#pragma unroll
        for (int a = 0; a < 2; ++a)
#pragma unroll
            for (int b = 0; b < 2; ++b)
#pragma unroll
                for (int m = 0; m < 4; ++m)
#pragma unroll
                    for (int n = 0; n < 2; ++n) acc[a][b][m][n] = (f32x4){0.f, 0.f, 0.f, 0.f};
        cur = nxt; cA = nA; cB = nB; ++ui;
    }
    PG8_WAIT_V(0);
    if (wr == 0) PG8_BAR;
    PG8_BAR;
#undef PG8_ACOL
#undef PG8_BOFF
#undef PG8_SA
#undef PG8_SB
#undef PG8_STAGE
#undef PG8_LDA
#undef PG8_LDB
#undef PG8_MMA
#undef PG8_WAIT_V
#undef PG8_WAIT_L
#undef PG8_BAR
#undef PG8_SCHED
}
}
#define LAS __attribute__((address_space(3)))
typedef unsigned short bf16;
typedef short bf16x8 __attribute__((ext_vector_type(8)));
typedef float f32x4 __attribute__((ext_vector_type(4)));
typedef unsigned u32x4 __attribute__((ext_vector_type(4)));
typedef unsigned u32x2 __attribute__((ext_vector_type(2)));
constexpr int DM = 1024, MT = 24576, MCTX = 8192, LCTX = 256, LLAT = 2048, NWAVES = 8, NTHR = 512;
constexpr int NPROJ_E = 3072, NB_E = 3328, IN_EVEN_LD = 3088;
constexpr float EPSF = 1e-6f;
constexpr size_t MiB = 1u << 20;
constexpr size_t WS_MOD = 0, MOD_BYTES = 4 * 9 * 6144 * 4, WS_S5F = 1 * MiB, WS_AB = 3 * MiB, WS_W1T = 5 * MiB, WS_W2T = 37 * MiB, WS_WINE = 69 * MiB,
                 WS_WOUTE = 82 * MiB, WS_WINO = 86 * MiB, WS_WOUTO = 94 * MiB, WS_WG = 98 * MiB, WS_H = 102 * MiB, WS_BIG = 150 * MiB, WS_YBUF = 294 * MiB,
                 WS_GATES = 246 * MiB, WS_MIX = 342 * MiB, WS_HALO = 390 * MiB, WS_END = 390 * MiB + 384 * 3 * 1536 * 2;
constexpr int LDS_BYTES = 147456;
constexpr size_t OUT_S5RE = 25165824, OUT_S5IM = OUT_S5RE + 262144, OUT_DELTA = OUT_S5IM + 262144, OUT_LRU = OUT_DELTA + 8388608;

struct Params { const float* in[40]; float* out; unsigned char* ws; };
enum { I_XP = 0, I_XS, I_S5RE, I_S5IM, I_SDELTA, I_SLRU, I_C, I_CCTX, I_WADA, I_BADA, I_NMIXPRE, I_NMIXPOST, I_NMLPPRE, I_NMLPPOST, I_WMLPIN, I_WMLPOUT, I_WINE, I_WOUTE,
       I_LAMRE, I_LAMIM, I_LOGDT, I_BRE, I_BIM, I_CRE, I_CIM, I_S5D, I_GCONVW, I_GCONVB, I_GALOG, I_GDTB, I_GONORM, I_WINO, I_WOUTO, I_LCONVW, I_LCONVB, I_LWR, I_LBR, I_LWI, I_LBI, I_LLAM };

typedef __bf16 bf2_t __attribute__((ext_vector_type(2)));
typedef float f2_t __attribute__((ext_vector_type(2)));
__device__ __forceinline__ unsigned pk2(float lo, float hi) { const bf2_t v = __builtin_convertvector((f2_t){lo, hi}, bf2_t); return __builtin_bit_cast(unsigned, v); }
__device__ __forceinline__ unsigned f2bf(float f) { return pk2(f, f) & 0xffffu; }
__device__ __forceinline__ float bflo(unsigned w) { return __builtin_bit_cast(float, w << 16); }
__device__ __forceinline__ float bfhi(unsigned w) { return __builtin_bit_cast(float, w & 0xffff0000u); }
__device__ __forceinline__ float bf2f(bf16 b) { return __builtin_bit_cast(float, (unsigned)b << 16); }
__device__ __forceinline__ float sigmoidf_(float x) { return __builtin_amdgcn_rcpf(1.0f + __expf(-x)); }
__device__ __forceinline__ float siluf_(float x) { return x * sigmoidf_(x); }
__device__ __forceinline__ float softplusf_(float x) { return fmaxf(x, 0.f) + __logf(1.0f + __expf(-fabsf(x))); }
__device__ __forceinline__ float geluf_(float x) { const float y = 0.7978845608028654f * (x + 0.044715f * x * x * x); const float t = 1.0f - 2.0f * __builtin_amdgcn_rcpf(__expf(2.0f * y) + 1.0f); return 0.5f * x * (1.0f + t); }
__device__ __forceinline__ float shfl_i(float v, int srclane) { return __builtin_bit_cast(float, __builtin_amdgcn_ds_bpermute(srclane << 2, __builtin_bit_cast(int, v))); }
__device__ __forceinline__ float wave_sum(float v, int lane) {
#pragma unroll
    for (int o = 1; o < 64; o <<= 1) v += shfl_i(v, lane ^ o);
    return v;
}
#define LDS_WAIT() asm volatile("s_waitcnt lgkmcnt(0)" ::: "memory")
#define WAVE_SYNC() do { asm volatile("s_waitcnt lgkmcnt(0)" ::: "memory"); __builtin_amdgcn_wave_barrier(); } while (0)
__device__ __forceinline__ f32x4 mfma16(bf16x8 a, bf16x8 b, f32x4 c) { return __builtin_amdgcn_mfma_f32_16x16x32_bf16(a, b, c, 0, 0, 0); }


#define XB_TMO      128
#define XB_XCNT(j)  (256  + 64 * (j))
#define XB_XSUB(j)  (1280 + 64 * (j))
#define XB_XGEN(j)  (2304 + 64 * (j))
#define XB_TOP      3328
#define XB_TOPGEN   3392
#define XCD_BAR_WORDS 3456
#define XB_SPIN_CAP (1u << 18)
constexpr size_t WS_BAR = 960 * 1024; constexpr int LDS_BARST = LDS_BYTES - 16;
__device__ __forceinline__ unsigned xb_ld(unsigned* p)              { return __hip_atomic_load(p, __ATOMIC_RELAXED, __HIP_MEMORY_SCOPE_AGENT); }
__device__ __forceinline__ unsigned xb_add(unsigned* p, unsigned v) { return __hip_atomic_fetch_add(p, v, __ATOMIC_RELAXED, __HIP_MEMORY_SCOPE_AGENT); }
__device__ __forceinline__ unsigned xb_xcc_id() { return (unsigned)__builtin_amdgcn_s_getreg((3 << 11) | 20) & 0xFu; }
#define XB_SPIN(cond, bar) do { unsigned _sp = 0; while (cond) { __builtin_amdgcn_s_sleep(1); \
    if ((++_sp & 255u) == 0u) { if (xb_ld(&(bar)[XB_TMO])) break; if (_sp > XB_SPIN_CAP) { atomicAdd(&(bar)[XB_TMO], 1u); break; } } } } while (0)
__device__ __forceinline__ void xcd_barrier_complete(unsigned* bar, unsigned x, unsigned& nloc, unsigned& nx) {
    const unsigned G = gridDim.x;
    unsigned sum, cnt, mine, sp = 0u;
    for (;;) {
        sum = 0u; cnt = 0u; mine = 0u;
#pragma unroll
        for (unsigned j = 0; j < 16; ++j) { const unsigned c = xb_ld(&bar[XB_XCNT(j)]); sum += c; cnt += (c > 0u) ? 1u : 0u; mine = (j == x) ? c : mine; }
        if (sum == G) break;
        __builtin_amdgcn_s_sleep(1);
        if ((++sp & 255u) == 0u) { if (xb_ld(&bar[XB_TMO])) break; if (sp > XB_SPIN_CAP) { atomicAdd(&bar[XB_TMO], 1u); break; } }
    }
    nloc = mine > 0u ? mine : 1u; nx = cnt > 0u ? cnt : 1u;
}
__device__ __forceinline__ void xcd_barrier(int wid0, unsigned* bar, LAS unsigned char* lds) {
    const int tid = tid_fresh(wid0);
    asm volatile("s_waitcnt vmcnt(0)" ::: "memory");
    __syncthreads();
    if (tid == 0) {
        const unsigned x = xb_xcc_id();
        volatile LAS unsigned* st = (volatile LAS unsigned*)(lds + LDS_BARST);
        __builtin_amdgcn_s_waitcnt(0);
        unsigned nloc = st[0], nx = st[1];
        if (nloc == 0u) { xcd_barrier_complete(bar, x, nloc, nx); st[0] = nloc; st[1] = nx; }
        const unsigned old = xb_add(&bar[XB_XSUB(x)], 1u);
        const unsigned gen = old / nloc;
        if (old + 1u == (gen + 1u) * nloc) {
            __builtin_amdgcn_fence(__ATOMIC_RELEASE, "agent");
            asm volatile("s_waitcnt vmcnt(0)" ::: "memory");
            const unsigned og = xb_add(&bar[XB_TOP], 1u);
            const unsigned tg = og / nx;
            if (og + 1u == (tg + 1u) * nx) xb_add(&bar[XB_TOPGEN], 1u);
            else XB_SPIN(xb_ld(&bar[XB_TOPGEN]) == tg, bar);
            __builtin_amdgcn_fence(__ATOMIC_ACQUIRE, "agent");
            xb_add(&bar[XB_XGEN(x)], 1u);
            asm volatile("s_waitcnt vmcnt(0)" ::: "memory");
        } else {
            XB_SPIN(xb_ld(&bar[XB_XGEN(x)]) == gen, bar);
            __builtin_amdgcn_fence(__ATOMIC_ACQUIRE, "agent");
            asm volatile("s_waitcnt vmcnt(0)" ::: "memory");
        }
    }
    __syncthreads();
}
__device__ __forceinline__ void transpose_item(const float* W, int ldw, int nvalid, int K, bf16* WT, int dst_row0, LAS float* scr, int k0, int n0, int lane) {
    const int nn = n0 + (lane & 31); const bool ok = nn < nvalid;
#pragma unroll 8
    for (int i = 0; i < 32; ++i) { const int kk = 2 * i + (lane >> 5); scr[kk * 33 + (lane & 31)] = ok ? W[(size_t)(k0 + kk) * ldw + nn] : 0.f; }
    WAVE_SYNC();
    const int c = lane & 7;
#pragma unroll
    for (int j = 0; j < 4; ++j) { const int n = (lane >> 3) + 8 * j; const LAS float* s = scr + (8 * c) * 33 + n;
        u32x4 o; o.x = pk2(s[0 * 33], s[1 * 33]); o.y = pk2(s[2 * 33], s[3 * 33]); o.z = pk2(s[4 * 33], s[5 * 33]); o.w = pk2(s[6 * 33], s[7 * 33]);
        *(u32x4*)(WT + (size_t)(dst_row0 + n) * K + k0 + 8 * c) = o; }
    WAVE_SYNC();
}
constexpr int WITEMS_EVEN = 4096 + 1552 + 512, WITEMS_ODD = 4096 + 1024 + 512 + 512;
__device__ __forceinline__ void weight_item(const Params& P, LAS float* scr, int l, int r, int lane) {
    unsigned char* ws = P.ws; const int eo = l >> 1;
    if (r < 2048) { const int q = r; transpose_item(P.in[I_WMLPIN] + (size_t)l * 1024 * 4096, 4096, 4096, 1024, (bf16*)(ws + WS_W1T) + (size_t)l * 4096 * 1024, 32 * (q & 127), scr, 64 * (q >> 7), 32 * (q & 127), lane); return; } r -= 2048;
    if (r < 2048) { const int q = r; transpose_item(P.in[I_WMLPOUT] + (size_t)l * 4096 * 1024, 1024, 1024, 4096, (bf16*)(ws + WS_W2T) + (size_t)l * 1024 * 4096, 32 * (q & 31), scr, 64 * (q >> 5), 32 * (q & 31), lane); return; } r -= 2048;
    if ((l & 1) == 0) {
        if (r < 1552) { const int kb = r / 97, nb = r % 97; transpose_item(P.in[I_WINE] + (size_t)eo * 1024 * IN_EVEN_LD, IN_EVEN_LD, IN_EVEN_LD, 1024, (bf16*)(ws + WS_WINE) + (size_t)eo * NB_E * 1024, 32 * nb, scr, 64 * kb, 32 * nb, lane); return; } r -= 1552;
        { const int q = r; transpose_item(P.in[I_WOUTE] + (size_t)eo * 1024 * 1024, 1024, 1024, 1024, (bf16*)(ws + WS_WOUTE) + (size_t)eo * 1024 * 1024, 32 * (q & 31), scr, 64 * (q >> 5), 32 * (q & 31), lane); return; }
    } else {
        if (r < 1024) { const int q = r; transpose_item(P.in[I_WINO] + (size_t)eo * 1024 * 2048, 2048, 2048, 1024, (bf16*)(ws + WS_WINO) + (size_t)eo * 2048 * 1024, 32 * (q & 63), scr, 64 * (q >> 6), 32 * (q & 63), lane); return; } r -= 1024;
        if (r < 512) { const int q = r; transpose_item(P.in[I_WOUTO] + (size_t)eo * 1024 * 1024, 1024, 1024, 1024, (bf16*)(ws + WS_WOUTO) + (size_t)eo * 1024 * 1024, 32 * (q & 31), scr, 64 * (q >> 5), 32 * (q & 31), lane); return; } r -= 512;
        { const int mat = eo * 16 + (r >> 5), q = r & 31, kb = q >> 3, nb = q & 7; const int blk = mat & 3, gate = (mat >> 2) & 1, od = mat >> 3;
          const float* src = (gate ? P.in[I_LWI] : P.in[I_LWR]) + (size_t)(od * 4 + blk) * 65536;
          const int j0 = nb * 32; const int drow = (blk * 2 + (j0 >> 7)) * 256 + gate * 128 + (j0 & 127);
          transpose_item(src, 256, 256, 256, (bf16*)(ws + WS_WG) + (size_t)od * 2048 * 256, drow, scr, 64 * kb, j0, lane); return; }
    }
}
__device__ __forceinline__ void phase_prologue(int wid0, const Params& P, LAS unsigned char* lds) {
    const int tid = tid_fresh(wid0), lane = tid & 63, wave = tid >> 6;
    LAS float* scr = (LAS float*)(lds + wave * 16384);
    const int gw = bid_fresh() * NWAVES + wave, NGW = grid_fresh() * NWAVES;
    unsigned char* ws = P.ws;
    constexpr int NTR = WITEMS_EVEN, NMOD = 4 * 24 * 16;
    for (int it = gw; it < NTR + NMOD; it += NGW) {
        int r = it;
        if (r < NTR) { weight_item(P, scr, 0, r, lane); continue; } r -= NTR;
        {
            const int l = r / 384, rem = r % 384, ec = rem >> 4, ks = rem & 15, k0 = ks * 64;
#pragma unroll
            for (int rr = 0; rr < 9; ++rr) { const float cv = rr == 0 ? P.in[I_CCTX][k0 + lane] : P.in[I_C][(rr - 1) * 1024 + k0 + lane]; scr[rr * 64 + lane] = siluf_(cv); }
            WAVE_SYNC();
            f32x4 acc[9];
#pragma unroll
            for (int rr = 0; rr < 9; ++rr) acc[rr] = (f32x4){0.f, 0.f, 0.f, 0.f};
            const float* wp = P.in[I_WADA] + ((size_t)l * 1024 + k0) * 6144 + ec * 256 + lane * 4;
#pragma unroll 4
            for (int kk = 0; kk < 64; ++kk) { const f32x4 w4 = *(const f32x4*)(wp + (size_t)kk * 6144);
#pragma unroll
                for (int rr = 0; rr < 9; ++rr) acc[rr] += w4 * scr[rr * 64 + kk]; }
            float* part = (float*)(ws + WS_BIG) + ((size_t)(ks * 4 + l) * 9) * 6144 + ec * 256 + lane * 4;
#pragma unroll
            for (int rr = 0; rr < 9; ++rr) *(f32x4*)(part + (size_t)rr * 6144) = acc[rr];
            WAVE_SYNC();
        }
    }
    { const size_t per = (size_t)(NB_E - 3104) * 1024 * 2 / 16;
      for (size_t i = (size_t)bid_fresh() * NTHR + tid; i < 2 * per; i += (size_t)grid_fresh() * NTHR) { const size_t e = i / per, q = i % per;
          *(u32x4*)(ws + WS_WINE + (e * NB_E + 3104) * 1024 * 2 + q * 16) = (u32x4){0u, 0u, 0u, 0u}; } }
}
__device__ __forceinline__ void phase_modreduce(int wid0, const Params& P) {
    const int tid = tid_fresh(wid0);
    const float* part = (const float*)(P.ws + WS_BIG); float* mod = (float*)(P.ws + WS_MOD);
    for (int i = bid_fresh() * NTHR + tid; i < 4 * 9 * 6144 / 4; i += grid_fresh() * NTHR) {
        const int l = i / (9 * 1536), e4 = i % 1536;
        f32x4 a = *(const f32x4*)(P.in[I_BADA] + (size_t)l * 6144 + e4 * 4);
#pragma unroll
        for (int ks = 0; ks < 16; ++ks) a += *(const f32x4*)(part + (size_t)ks * 4 * 9 * 6144 + (size_t)i * 4);
        *(f32x4*)(mod + (size_t)i * 4) = a; }
}
constexpr size_t XB_OFF_FLOATS = (size_t)MT * DM / 2;
__device__ __forceinline__ void phase_rownorm(int wid0, const Params& P, int first, const bf16* obuf, const float* modg, int goff, const float* gpost, int has_next, const float* gpre, const float* mods, int soff, bf16* H, float gscale = 1.0f) {
    const int tid = tid_fresh(wid0), lane = tid & 63, wave = tid >> 6;
    const int gw = bid_fresh() * NWAVES + wave, NGW = grid_fresh() * NWAVES;
    bf16* XB = (bf16*)(P.out + XB_OFF_FLOATS); float* TMP = (float*)(P.ws + WS_BIG);
    f32x4 xn[4]; u32x2 xbn[4], on[4];
#define RN_LOAD(mm) do { const int m_ = (mm); \
        _Pragma("unroll") for (int j = 0; j < 4; ++j) { \
            if (first) xn[j] = *(const f32x4*)((m_ < MCTX ? P.in[I_XP] + (size_t)m_ * DM : P.in[I_XS] + (size_t)(m_ - MCTX) * DM) + lane * 4 + 256 * j); \
            else { xbn[j] = *(const u32x2*)(XB + (size_t)m_ * DM + lane * 4 + 256 * j); on[j] = *(const u32x2*)(obuf + (size_t)m_ * DM + lane * 4 + 256 * j); } } } while (0)
    if (gw < MT) RN_LOAD(gw);
    for (int m = gw; m < MT; m += NGW) {
        const int modrow = m < MCTX ? 0 : 1 + ((m - MCTX) >> 11);
        const float* mr = modg + (size_t)modrow * 6144; const float* ms = mods + (size_t)modrow * 6144;
        f32x4 x[4]; u32x2 ov[4];
#pragma unroll
        for (int j = 0; j < 4; ++j) { ov[j] = on[j]; x[j] = first ? xn[j] : (f32x4){bflo(xbn[j].x), bfhi(xbn[j].x), bflo(xbn[j].y), bfhi(xbn[j].y)}; }
        if (m + NGW < MT) RN_LOAD(m + NGW);
        f32x4 vgp[4], vgt[4], vgq[4], vsh[4], vsc[4];
#pragma unroll
        for (int j = 0; j < 4; ++j) { const int c = lane * 4 + 256 * j;
            if (!first) { vgp[j] = *(const f32x4*)(gpost + c); vgt[j] = *(const f32x4*)(mr + goff + c); }
            if (has_next) { vgq[j] = *(const f32x4*)(gpre + c); vsh[j] = *(const f32x4*)(ms + soff + c); vsc[j] = *(const f32x4*)(ms + soff + 1024 + c); } }
        if (first) {
            if (m >= MCTX) {
                const int t = (m - MCTX) & 2047; const float prow = (float)(t >> 6), pcol = (float)(t & 63);
                f32x4 om;
#pragma unroll
                for (int e = 0; e < 4; ++e) om[e] = exp2f(-(float)(lane * 4 + e) * (13.287712379549449f / 256.0f));
#pragma unroll
                for (int j = 0; j < 4; ++j) {
#pragma unroll
                    for (int e = 0; e < 4; ++e) { const float a = (j < 2 ? prow : pcol) * om[e]; x[j][e] += (j & 1) ? cosf(a) : sinf(a); } }
            }
        } else {
            float ss = 0.f;
#pragma unroll
            for (int j = 0; j < 4; ++j) { const float a = bflo(ov[j].x), b = bfhi(ov[j].x), c = bflo(ov[j].y), d = bfhi(ov[j].y); ss += (a * a + b * b) + (c * c + d * d); }
            const float rs = rsqrtf(wave_sum(ss, lane) * (1.0f / DM) + EPSF);
#pragma unroll
            for (int j = 0; j < 4; ++j) { f32x4 o4 = (f32x4){bflo(ov[j].x), bfhi(ov[j].x), bflo(ov[j].y), bfhi(ov[j].y)};
                x[j] += vgt[j] * (o4 * (rs * gscale) * vgp[j]); }
        }
        if (has_next) {
#pragma unroll
            for (int j = 0; j < 4; ++j) { u32x2 w; w.x = pk2(x[j][0], x[j][1]); w.y = pk2(x[j][2], x[j][3]); *(u32x2*)(XB + (size_t)m * DM + lane * 4 + 256 * j) = w; }
            float ss = 0.f;
#pragma unroll
            for (int j = 0; j < 4; ++j) ss += (x[j][0] * x[j][0] + x[j][1] * x[j][1]) + (x[j][2] * x[j][2] + x[j][3] * x[j][3]);
            const float rs = rsqrtf(wave_sum(ss, lane) * (1.0f / DM) + EPSF);
#pragma unroll
            for (int j = 0; j < 4; ++j) { const f32x4 h4 = (x[j] * rs * vgq[j]) * (vsc[j] + 1.0f) + vsh[j];
                u32x2 w; w.x = pk2(h4[0], h4[1]); w.y = pk2(h4[2], h4[3]);
                *(u32x2*)(H + (size_t)m * DM + lane * 4 + 256 * j) = w; }
        } else {
            float* dst = (m < MT / 2) ? P.out + (size_t)m * DM : TMP + (size_t)(m - MT / 2) * DM;
#pragma unroll
            for (int j = 0; j < 4; ++j) *(f32x4*)(dst + lane * 4 + 256 * j) = x[j];
        }
    }
}
__device__ __forceinline__ void phase_copy_tail(int wid0, const Params& P) {
    const int tid = tid_fresh(wid0);
    const f32x4* src = (const f32x4*)(P.ws + WS_BIG); f32x4* dst = (f32x4*)(P.out + XB_OFF_FLOATS);
    const size_t n = (size_t)(MT / 2) * DM / 4;
    for (size_t i = (size_t)bid_fresh() * NTHR + tid; i < n; i += (size_t)grid_fresh() * NTHR) dst[i] = src[i];
}

using pg8::Unit;
template <int ACT  > struct EpiBf16 {
    bf16* O; int ldc; float* AB;
    bf16* HALO;
    __device__ __forceinline__ void operator()(const f32x4 (&acc)[2][2][4][2], const Unit& u, int wr, int wc, int fr, int fq) const {
        const int row0 = u.pm * 256 + wr * 64 + fr, col0 = u.pn * 256 + wc * 32 + 8 * fq;
        if (AB && u.pn * 256 >= ldc) {
            if (wc == 0 && fq < 2) {
#pragma unroll
                for (int ai = 0; ai < 2; ++ai)
#pragma unroll
                    for (int m = 0; m < 4; ++m) { float* p = AB + (size_t)(row0 + ai * 128 + m * 16) * 16 + 8 * fq; *(f32x4*)p = acc[ai][0][m][0]; *(f32x4*)(p + 4) = acc[ai][0][m][1]; }
            }
            return;
        }
#pragma unroll
        for (int ai = 0; ai < 2; ++ai)
#pragma unroll
            for (int m = 0; m < 4; ++m) { bf16* rowp = O + (size_t)(row0 + ai * 128 + m * 16) * ldc + col0;
#pragma unroll
                for (int bj = 0; bj < 2; ++bj) { f32x4 v0 = acc[ai][bj][m][0], v1 = acc[ai][bj][m][1];
                    if (ACT == 1) {
#pragma unroll
                        for (int j = 0; j < 4; ++j) { const float a = fmaxf(v0[j], 0.f), b = fmaxf(v1[j], 0.f); v0[j] = a * a; v1[j] = b * b; } }
                    u32x4 w; w.x = pk2(v0[0], v0[1]); w.y = pk2(v0[2], v0[3]); w.z = pk2(v1[0], v1[1]); w.w = pk2(v1[2], v1[3]);
                    *(u32x4*)(rowp + bj * 128) = w;
                    if (ACT == 0 && HALO && u.pn >= 4 && u.pn < 10 && ((m == 3 && fr == 15) || (m == 0 && fr < 2))) {
                        const int r = row0 + ai * 128 + m * 16; const int which = (m == 3) ? 0 : 1 + fr;
                        *(u32x4*)(HALO + ((size_t)(r >> 6) * 3 + which) * 1536 + (col0 + bj * 128 - 1024)) = w; } } }
    }
};
struct EpiSplit {
    bf16* O0; long stride;
    __device__ __forceinline__ void operator()(const f32x4 (&acc)[2][2][4][2], const Unit& u, int wr, int wc, int fr, int fq) const {
        const int row0 = u.pm * 256 + wr * 64 + fr, col0 = (u.pn >> 1) * 256 + wc * 32 + 8 * fq; bf16* O = O0 + (long)(u.pn & 1) * stride;
#pragma unroll
        for (int ai = 0; ai < 2; ++ai)
#pragma unroll
            for (int m = 0; m < 4; ++m) { bf16* rowp = O + (size_t)(row0 + ai * 128 + m * 16) * DM + col0;
#pragma unroll
                for (int bj = 0; bj < 2; ++bj) { const f32x4 v0 = acc[ai][bj][m][0], v1 = acc[ai][bj][m][1];
                    u32x4 w; w.x = pk2(v0[0], v0[1]); w.y = pk2(v0[2], v0[3]); w.z = pk2(v1[0], v1[1]); w.w = pk2(v1[2], v1[3]);
                    *(u32x4*)(rowp + bj * 128) = w; } }
    }
};
struct EpiGates {
    unsigned* G; const bf16* X; const float* br; const float* bi; const float* lam;
    __device__ __forceinline__ void operator()(const f32x4 (&acc)[2][2][4][2], const Unit& u, int wr, int wc, int fr, int fq) const {
        const int row0 = u.pm * 256 + wr * 64 + fr, ch0 = u.pn * 128 + wc * 32 + 8 * fq;
#pragma unroll
        for (int n = 0; n < 2; ++n) {
            const f32x4 vbr = *(const f32x4*)(br + ch0 + 4 * n), vbi = *(const f32x4*)(bi + ch0 + 4 * n), l4 = *(const f32x4*)(lam + ch0 + 4 * n);
            f32x4 vsp;
#pragma unroll
            for (int e = 0; e < 4; ++e) vsp[e] = -8.0f * softplusf_(-l4[e]);
#pragma unroll
            for (int ai = 0; ai < 2; ++ai)
#pragma unroll
                for (int m = 0; m < 4; ++m) { const size_t row = (size_t)(row0 + ai * 128 + m * 16);
                    const u32x2 xv = *(const u32x2*)(X + row * DM + ch0 + 4 * n);
                    const float xs[4] = {bflo(xv.x), bfhi(xv.x), bflo(xv.y), bfhi(xv.y)};
                    u32x4 w;
#pragma unroll
                    for (int e = 0; e < 4; ++e) { const float r = sigmoidf_(acc[ai][0][m][n][e] + vbr[e]), ig = sigmoidf_(acc[ai][1][m][n][e] + vbi[e]);
                        const float la = r * vsp[e]; const float a_ = __expf(la); const float b = __builtin_amdgcn_sqrtf(fmaxf(1.0f - a_ * a_, 0.f)) * ig * xs[e];
                        w[e] = pk2(1.0f - a_, b); }
                    *(u32x4*)(G + row * DM + ch0 + 4 * n) = w; }
        }
    }
};
constexpr int S5_WLDS = 12800, BU_P = 132, HS_P = 136;
struct S5Dir { float ar, ai; bf16x8 Bf[8]; };
__device__ __forceinline__ void s5_dir_setup(const Params& P, int e, int d, int g, int lane, float& ar, float& ai, bf16x8 (&Bf)[8], bool needB) {
    const int quad = lane >> 4, l15 = lane & 15;
    const float dt = __expf(P.in[I_LOGDT][(e * 2 + d) * 32 + g]);
    const float lr = P.in[I_LAMRE][((e * 2 + d) * 32 + g) * 64 + lane], li = P.in[I_LAMIM][((e * 2 + d) * 32 + g) * 64 + lane];
    const float mag = expf(lr * dt); ar = mag * cosf(li * dt); ai = mag * sinf(li * dt);
    const float den = lr * lr + li * li;
    const float fr = ((ar - 1.0f) * lr + ai * li) / den, fi = (ai * lr - (ar - 1.0f) * li) / den;
    if (needB) {
#pragma unroll
        for (int nt = 0; nt < 8; ++nt) { const int col = 16 * nt + l15, p = col & 63;
            const float frp = shfl_i(fr, p), fip = shfl_i(fi, p);
            bf16x8 v = (bf16x8){0, 0, 0, 0, 0, 0, 0, 0};
            if (quad < 2) { const float* bre = P.in[I_BRE] + ((size_t)(e * 32 + g) * 64 + p) * 16 + quad * 8; const float* bim = P.in[I_BIM] + ((size_t)(e * 32 + g) * 64 + p) * 16 + quad * 8;
#pragma unroll
                for (int j = 0; j < 8; ++j) { const float br = bre[j], bi = bim[j]; const float val = (nt < 4) ? (frp * br - fip * bi) : (frp * bi + fip * br); v[j] = (short)f2bf(val); } }
            Bf[nt] = v; }
    }
}
__device__ __forceinline__ void s5_c_setup(const Params& P, int e, int g, int lane, bf16x8 (&Cf)[4]) {
    const int quad = lane >> 4, l15 = lane & 15;
#pragma unroll
    for (int ks = 0; ks < 4; ++ks) { const int col0 = 32 * ks + quad * 8; const bool im = col0 >= 64;
        const float* src = (im ? P.in[I_CIM] : P.in[I_CRE]) + ((size_t)(e * 32 + g) * 16 + l15) * 64 + (col0 & 63);
        bf16x8 v;
#pragma unroll
        for (int j = 0; j < 8; ++j) v[j] = (short)f2bf(im ? -src[j] : src[j]);
        Cf[ks] = v; }
}
__device__ __forceinline__ void s5_scan_seg(const Params& P, LAS unsigned char* wl, int lane, int d, int g, int m0, float ar, float ai, const bf16x8 (&Bf)[8], const bf16x8 (&Cf)[4],
                                            float& hr, float& hi, int mode, int ymode, const bf16* proj, float* ybuf, bf16* mixout, float dsk, int dry = 0) {
    const int quad = lane >> 4, l15 = lane & 15;
    LAS float* BU = (LAS float*)wl; LAS bf16* HS = (LAS bf16*)(wl + 8448);
    const int ch = g * 16 + l15;
    bf16x8 a_next = (bf16x8){0, 0, 0, 0, 0, 0, 0, 0};
    if (mode == 0 && quad < 2) { const int blk0 = d ? 15 : 0; const int tt = d ? 15 - l15 : l15; a_next = *(const bf16x8*)(proj + (size_t)(m0 + 16 * blk0 + tt) * NPROJ_E + g * 16 + quad * 8); }
    for (int bi_ = 0; bi_ < 16; ++bi_) {
        const int blk = d ? 15 - bi_ : bi_;
        const int mb = m0 + 16 * blk;
        const bf16x8 a = a_next;
        if (mode == 0 && quad < 2 && bi_ + 1 < 16) { const int blkn = d ? 14 - bi_ : bi_ + 1; const int tt = d ? 15 - l15 : l15; a_next = *(const bf16x8*)(proj + (size_t)(m0 + 16 * blkn + tt) * NPROJ_E + g * 16 + quad * 8); }
        float pre[4], zz[4];
#pragma unroll
        for (int jj = 0; jj < 4; ++jj) { const int row = quad * 4 + jj; const int tt = d ? 15 - row : row; const size_t m = (size_t)(mb + tt);
            pre[jj] = (ymode == 0) ? dsk * bf2f(proj[m * NPROJ_E + ch]) : ybuf[m * 512 + ch];
            zz[jj] = (ymode == 2) ? bf2f(proj[m * NPROJ_E + 512 + ch]) : 0.f; }
        if (mode == 0) {
#pragma unroll
            for (int nt = 0; nt < 8; ++nt) { f32x4 acc = mfma16(a, Bf[nt], (f32x4){0.f, 0.f, 0.f, 0.f});
#pragma unroll
                for (int jj = 0; jj < 4; ++jj) BU[(quad * 4 + jj) * BU_P + 16 * nt + l15] = acc[jj]; }
            WAVE_SYNC();
        }
#pragma unroll
        for (int r = 0; r < 16; ++r) {
            float br = 0.f, bim = 0.f;
            if (mode == 0) { br = BU[r * BU_P + lane]; bim = BU[r * BU_P + 64 + lane]; }
            const float nr = ar * hr - ai * hi + br, ni = ar * hi + ai * hr + bim; hr = nr; hi = ni;
            HS[r * HS_P + lane] = (bf16)f2bf(hr); HS[r * HS_P + 64 + lane] = (bf16)f2bf(hi);
        }
        WAVE_SYNC();
        f32x4 y = (f32x4){0.f, 0.f, 0.f, 0.f};
#pragma unroll
        for (int ks = 0; ks < 4; ++ks) { const bf16x8 af = *(const LAS bf16x8*)(HS + l15 * HS_P + 32 * ks + quad * 8); y = mfma16(af, Cf[ks], y); }
#pragma unroll
        for (int jj = 0; jj < 4; ++jj) { const int row = quad * 4 + jj; const int tt = d ? 15 - row : row; const size_t m = (size_t)(mb + tt);
            const float v = y[jj] + pre[jj];
            if (!dry) { if (ymode != 2) ybuf[m * 512 + ch] = v;
            else mixout[m * DM + ch] = (bf16)f2bf(geluf_(v) * sigmoidf_(zz[jj])); }
        }
        WAVE_SYNC();
    }
}
__device__ __forceinline__ void s5_task_main(const Params& P, LAS unsigned char* wl, int lane, int e, int sub, int g) {
    const bf16* proj = (const bf16*)(P.ws + WS_BIG); float* ybuf = (float*)(P.ws + WS_YBUF); bf16* mixout = (bf16*)(P.ws + WS_MIX);
    const bool lat = sub >= 32; const int q = sub - 32, b = lat ? (q >> 3) : sub, seg = lat ? (q & 7) : 0;
    const int m0 = lat ? MCTX + b * LLAT + seg * 256 : sub * 256;
    bf16x8 Cf[4]; s5_c_setup(P, e, g, lane, Cf);
    const float dsk = P.in[I_S5D][e * 512 + g * 16 + (lane & 15)];
#pragma unroll 1
    for (int d = 0; d < 2; ++d) {
        float ar, ai; bf16x8 Bf[8]; s5_dir_setup(P, e, d, g, lane, ar, ai, Bf, true);
        float hr = 0.f, hi = 0.f;
        if (lat && ((d == 0 && seg == 0) || (d == 1 && seg == 7))) { const size_t si = ((((size_t)b * 2 + e) * 2 + d) * 32 + g) * 64 + lane; hr = P.in[I_S5RE][si]; hi = P.in[I_S5IM][si]; }
        const int ymode = d == 0 ? 0 : (lat ? 1 : 2);
        s5_scan_seg(P, wl, lane, d, g, m0, ar, ai, Bf, Cf, hr, hi, 0, ymode, proj, ybuf, mixout, dsk);
        if (!lat) { const size_t si = ((((size_t)b * 2 + e) * 2 + d) * 32 + g) * 64 + lane; P.out[OUT_S5RE + si] = hr; P.out[OUT_S5IM + si] = hi; }
        else { float* F = (float*)(P.ws + WS_S5F) + ((((size_t)d * 64 + q) * 32 + g) * 64 + lane) * 2; F[0] = hr; F[1] = hi; }
    }
}
__device__ __forceinline__ void s5_task_corr(const Params& P, LAS unsigned char* wl, int lane, int e, int q, int g, int dry = 0) {
    const bf16* proj = (const bf16*)(P.ws + WS_BIG); float* ybuf = (float*)(P.ws + WS_YBUF); bf16* mixout = (bf16*)(P.ws + WS_MIX);
    const int b = q >> 3, seg = q & 7, m0 = MCTX + b * LLAT + seg * 256;
    bf16x8 Cf[4]; s5_c_setup(P, e, g, lane, Cf);
    bf16x8 Bf[8];
#pragma unroll
    for (int i = 0; i < 8; ++i) Bf[i] = (bf16x8){0, 0, 0, 0, 0, 0, 0, 0};
    const float* Fb = (const float*)(P.ws + WS_S5F);
#pragma unroll 1
    for (int d = 0; d < 2; ++d) {
        float ar, ai; s5_dir_setup(P, e, d, g, lane, ar, ai, Bf, false);
        float pr = ar, pi = ai;
#pragma unroll
        for (int i = 0; i < 8; ++i) { const float nr = pr * pr - pi * pi, ni = 2.0f * pr * pi; pr = nr; pi = ni; }
        float hr = 0.f, hi = 0.f;
        const int cnt = d == 0 ? seg : 7 - seg;
        for (int i = 0; i < cnt; ++i) { const int sj = d == 0 ? i : 7 - i; const float* F = Fb + ((((size_t)d * 64 + b * 8 + sj) * 32 + g) * 64 + lane) * 2;
            const float nr = pr * hr - pi * hi + F[0], ni = pr * hi + pi * hr + F[1]; hr = nr; hi = ni; }
        const int ym = (d == 1 || seg == 7) ? 2 : 1;
        if (cnt > 0) s5_scan_seg(P, wl, lane, d, g, m0, ar, ai, Bf, Cf, hr, hi, 1, ym, proj, ybuf, mixout, 0.f, dry);
    }
}

#ifndef REP_A
#define REP_A 1
#endif
#ifndef REP_B
#define REP_B 1
#endif
#ifndef REP_C
#define REP_C 1
#endif
__device__ __forceinline__ void phase_conv_even(int wid0, const Params& P, int e, int dry = 0) {
    const int tid = tid_fresh(wid0), lane = tid & 63, wave = tid >> 6;
    const int gw = bid_fresh() * NWAVES + wave, NGW = grid_fresh() * NWAVES;
    bf16* proj = (bf16*)(P.ws + WS_BIG); const bf16* HALO = (const bf16*)(P.ws + WS_HALO);
    for (int it = gw; it < 384 * 24; it += NGW) {
        const int c = it / 24, cgp = it % 24, ccol = cgp * 64 + lane;
        const int r0 = c * 64;
        const bool lat = r0 >= MCTX; const int t0 = lat ? ((r0 - MCTX) & 2047) : (r0 & 255); const int L = lat ? LLAT : LCTX;
        bf16* base = proj + (size_t)r0 * NPROJ_E + 1024 + ccol;
        bf16 x[67];
#pragma unroll
        for (int i = 0; i < 64; ++i) x[i + 1] = base[(size_t)i * NPROJ_E];
        x[0] = (t0 > 0) ? HALO[((size_t)(c - 1) * 3 + 0) * 1536 + ccol] : (bf16)0;
        x[65] = (t0 + 64 < L) ? HALO[((size_t)(c + 1) * 3 + 1) * 1536 + ccol] : (bf16)0;
        x[66] = (t0 + 64 < L) ? HALO[((size_t)(c + 1) * 3 + 2) * 1536 + ccol] : (bf16)0;
        const float* cw = P.in[I_GCONVW] + (size_t)e * 4 * 1536 + ccol; const float w0 = cw[0], w1 = cw[1536], w2 = cw[3072], w3 = cw[4608], cb = P.in[I_GCONVB][e * 1536 + ccol];
#pragma unroll
        for (int i = 0; i < 64; ++i) { const float v = cb + w0 * bf2f(x[i]) + w1 * bf2f(x[i + 1]) + w2 * bf2f(x[i + 2]) + w3 * bf2f(x[i + 3]);
            if (!dry) base[(size_t)i * NPROJ_E] = (bf16)f2bf(siluf_(v)); }
    }
}
#define LDS_BARRIER() do { asm volatile("s_waitcnt lgkmcnt(0)" ::: "memory"); __builtin_amdgcn_s_barrier(); asm volatile("" ::: "memory"); } while (0)
constexpr int G_Q = 0, G_K = 17408, G_V = 34816, G_KT = 52224, G_LM = 70656, G_QK = 89088, G_ST = 98304, G_SM = 133120;
constexpr int P128 = 136, P64 = 72, LMP = 68;
__device__ __forceinline__ bf16x8 ld_split8(const LAS bf16* p) {
    const u32x2 a = *(const LAS u32x2*)p, b = *(const LAS u32x2*)(p + 16);
    return __builtin_bit_cast(bf16x8, (u32x4){a.x, a.y, b.x, b.y});
}
__device__ __forceinline__ bf16x8 pack_acc2(const f32x4& a, const f32x4& b) { return __builtin_bit_cast(bf16x8, (u32x4){pk2(a[0], a[1]), pk2(a[2], a[3]), pk2(b[0], b[1]), pk2(b[2], b[3])}); }
__device__ __forceinline__ void gdn_chain(int wid0, const Params& P, LAS unsigned char* lds, int e, int s, int hd, int dir) {
    const int tid = tid_fresh(wid0), lane = tid & 63, w = __builtin_amdgcn_readfirstlane(tid >> 6), quad = lane >> 4, l15 = lane & 15;
    const bool lat = s >= 32; const int b = lat ? s - 32 : s; const int L = lat ? LLAT : LCTX; const int m0 = lat ? MCTX + b * LLAT : s * LCTX;
    const bf16* proj = (const bf16*)(P.ws + WS_BIG); const float* AB = (const float*)(P.ws + WS_AB);
    bf16* Odir = (bf16*)(P.ws + WS_H) + (size_t)dir * MT * 512;
    int zv; asm volatile("v_mov_b32 %0, 0" : "=v"(zv));
    lds += zv;
    LAS bf16* Qs = (LAS bf16*)(lds + G_Q); LAS bf16* Ks = (LAS bf16*)(lds + G_K); LAS bf16* Vs = (LAS bf16*)(lds + G_V); LAS bf16* KT = (LAS bf16*)(lds + G_KT);
    LAS float* Lm = (LAS float*)(lds + G_LM); LAS bf16* VNT = (LAS bf16*)(lds + G_LM); LAS bf16* QKs = (LAS bf16*)(lds + G_QK); LAS bf16* ST = (LAS bf16*)(lds + G_ST);
    LAS bf16* TM = (LAS bf16*)(lds + G_ST); LAS bf16* TT = TM + 64 * P64; LAS bf16* LR = TT + 64 * P64;
    LAS float* rq = (LAS float*)(lds + G_SM); LAS float* rk = rq + 64; LAS float* gcs = rq + 128; LAS float* betas = rq + 192; LAS float* egs = rq + 256; LAS float* kes = rq + 320;
    f32x4 Sacc[8];
    const size_t sbase = ((((size_t)b * 2 + e) * 2 + dir) * 4 + hd) * 16384;
#pragma unroll
    for (int mt = 0; mt < 8; ++mt) Sacc[mt] = (f32x4){0.f, 0.f, 0.f, 0.f};
    if (lat) { const float* sp = P.in[I_SDELTA] + sbase + (size_t)(quad * 4) * 128 + 16 * w + l15;
#pragma unroll
        for (int mt = 0; mt < 8; ++mt)
#pragma unroll
            for (int jj = 0; jj < 4; ++jj) Sacc[mt][jj] = sp[(16 * mt + jj) * 128]; }
    for (int i = tid; i < 2 * 64 * P64 / 2; i += NTHR) ((LAS unsigned*)TM)[i] = 0u;
    const float alog_e = __expf(P.in[I_GALOG][(e * 2 + dir) * 4 + hd]), dtb = P.in[I_GDTB][(e * 2 + dir) * 4 + hd];
    const int nchunk = L / 64;
    u32x4 xr[6]; float ab_a = 0.f, ab_b = 0.f;
#define GDN_LOAD(ci_) do { const int tid_ = tid_fresh(wid0); const int c0_ = dir ? L - 64 * ((ci_) + 1) : 64 * (ci_); \
        _Pragma("unroll") for (int k = 0; k < 6; ++k) { const int p_ = tid_ + 512 * k, part_ = p_ >> 10, row_ = (p_ & 1023) >> 4, pc_ = p_ & 15; \
            xr[k] = *(const u32x4*)(proj + (size_t)(m0 + c0_ + row_) * NPROJ_E + 1024 + part_ * 512 + hd * 128 + pc_ * 8); } \
        if (w == 0) { const int ln_ = tid_ & 63; const size_t m_ = (size_t)(m0 + c0_ + (dir ? 63 - ln_ : ln_)); ab_a = AB[m_ * 16 + dir * 4 + hd]; ab_b = AB[m_ * 16 + 8 + dir * 4 + hd]; } } while (0)
    GDN_LOAD(0);
#pragma unroll 1
    for (int ci = 0; ci < nchunk; ++ci) {
        const int tid = tid_fresh(wid0), lane = tid & 63, quad = lane >> 4, l15 = lane & 15;
        const int c0 = dir ? L - 64 * (ci + 1) : 64 * ci;
        LDS_BARRIER();
#ifndef NO_A
        const float cur_a = ab_a, cur_b = ab_b;
#pragma unroll
        for (int k = 0; k < 6; ++k) { const int p_ = tid + 512 * k, part_ = p_ >> 10, row_ = (p_ & 1023) >> 4, pc_ = p_ & 15;
            LAS bf16* dst = part_ == 0 ? Qs : (part_ == 1 ? Ks : Vs);
            *(LAS u32x4*)(dst + (dir ? 63 - row_ : row_) * P128 + pc_ * 8) = xr[k]; }
        if (ci + 1 < nchunk) GDN_LOAD(ci + 1);
#endif
        LDS_BARRIER();
#pragma unroll 1
        for (int repB = 0; repB < REP_B; ++repB)
        { const int rowid = tid >> 2, part = tid & 3; LAS bf16* src = (rowid < 64 ? Qs : Ks) + (rowid & 63) * P128 + part * 32;
          float ss = 0.f;
#pragma unroll
          for (int i = 0; i < 4; ++i) { const u32x4 v = *(const LAS u32x4*)(src + 8 * i);
#pragma unroll
              for (int j = 0; j < 4; ++j) { const float a = bflo(v[j]), c = bfhi(v[j]); ss += a * a + c * c; } }
          ss += shfl_i(ss, lane ^ 1); ss += shfl_i(ss, lane ^ 2);
          if (part == 0) { if (rowid < 64) rq[rowid] = rsqrtf(ss + EPSF) * 0.08838834764831845f; else rk[rowid - 64] = rsqrtf(ss + EPSF); }
          if (w == 0) { const int t = c0 + (dir ? 63 - lane : lane); const size_t m = (size_t)(m0 + t);
              const float araw = cur_a, braw = cur_b;
              const float gg = -alog_e * softplusf_(araw + dtb);
              float gc = gg;
#pragma unroll
              for (int o = 1; o < 64; o <<= 1) { const float t2 = shfl_i(gc, (lane - o) & 63); if (lane >= o) gc += t2; }
              const float glast = shfl_i(gc, 63);
              gcs[lane] = gc; betas[lane] = sigmoidf_(braw); egs[lane] = __expf(gc); kes[lane] = __expf(glast - gc);
              if (lane == 0) rq[384] = __expf(glast); } }
        LDS_BARRIER();
#ifndef NO_C
#pragma unroll 1
        for (int repC = 0; repC < REP_C; ++repC)
        { const int mt = w & 3; const bool isq = w >= 4; LAS bf16* src = isq ? Qs : Ks;
          bf16x8 a[4];
#pragma unroll
          for (int ks = 0; ks < 4; ++ks) a[ks] = *(const LAS bf16x8*)(src + (16 * mt + l15) * P128 + 32 * ks + quad * 8);
#pragma unroll 1
          for (int nt = 0; nt < 4; ++nt) { f32x4 acc = (f32x4){0.f, 0.f, 0.f, 0.f};
#pragma unroll
              for (int ks = 0; ks < 4; ++ks) { const bf16x8 bb = *(const LAS bf16x8*)(Ks + (16 * nt + l15) * P128 + 32 * ks + quad * 8); acc = mfma16(a[ks], bb, acc); }
              const int j = 16 * nt + l15; const float rkj = rk[j], gcj = gcs[j];
              f32x4 lv;
#pragma unroll
              for (int jj = 0; jj < 4; ++jj) { const int i = 16 * mt + quad * 4 + jj; const float dec = __expf(fminf(gcs[i] - gcj, 0.f));
                  lv[jj] = (i > j) ? acc[jj] * rk[i] * rkj * betas[i] * dec : 0.f;
                  if (isq) QKs[i * P64 + j] = (bf16)f2bf((i >= j) ? acc[jj] * rq[i] * rkj * dec : 0.f); }
              if (!isq) { *(LAS f32x4*)(Lm + j * LMP + 16 * mt + quad * 4) = lv;
#pragma unroll
                  for (int jj = 0; jj < 4; ++jj) LR[(16 * mt + quad * 4 + jj) * P64 + j] = (bf16)f2bf(nt < mt ? lv[jj] : 0.f); } }
          const int dd = tid & 127, tq = tid >> 7;
          unsigned pw[8];
#pragma unroll
          for (int n = 0; n < 16; n += 2) { const int i0 = tq * 16 + n; const float v0 = bf2f(Ks[i0 * P128 + dd]) * rk[i0] * kes[i0], v1 = bf2f(Ks[(i0 + 1) * P128 + dd]) * rk[i0 + 1] * kes[i0 + 1]; pw[n >> 1] = pk2(v0, v1); }
          *(LAS u32x4*)(KT + dd * P64 + tq * 16) = (u32x4){pw[0], pw[1], pw[2], pw[3]};
          *(LAS u32x4*)(KT + dd * P64 + tq * 16 + 8) = (u32x4){pw[4], pw[5], pw[6], pw[7]}; }
#endif
        LDS_BARRIER();
        { const int i = tid >> 3, c0k = (tid & 7) * 16; const float sc = rk[i] * betas[i] * egs[i];
#pragma unroll
          for (int h2 = 0; h2 < 2; ++h2) { u32x4 v = *(LAS u32x4*)(Ks + i * P128 + c0k + 8 * h2);
#pragma unroll
              for (int q = 0; q < 4; ++q) v[q] = pk2(bflo(v[q]) * sc, bfhi(v[q]) * sc);
              *(LAS u32x4*)(Ks + i * P128 + c0k + 8 * h2) = v; } }
        if (w == 0) { const int bb = lane >> 4, c = lane & 15;
            float x[16];
#pragma unroll
            for (int r = 0; r < 16; ++r) x[r] = (r == c) ? 1.f : 0.f;
#pragma unroll
            for (int j = 0; j < 15; ++j) {
#pragma unroll
                for (int q4 = j / 4; q4 < 4; ++q4) { const f32x4 l4 = *(const LAS f32x4*)(Lm + (16 * bb + j) * LMP + 16 * bb + 4 * q4);
#pragma unroll
                    for (int jx = 0; jx < 4; ++jx) if (4 * q4 + jx > j) x[4 * q4 + jx] -= l4[jx] * x[j]; } }
            unsigned pw[8];
#pragma unroll
            for (int r = 0; r < 16; r += 2) { pw[r >> 1] = pk2(x[r], x[r + 1]); TM[(16 * bb + r) * P64 + 16 * bb + c] = (bf16)(pw[r >> 1] & 0xffffu); TM[(16 * bb + r + 1) * P64 + 16 * bb + c] = (bf16)(pw[r >> 1] >> 16); }
            *(LAS u32x4*)(TT + (16 * bb + c) * P64 + 16 * bb) = (u32x4){pw[0], pw[1], pw[2], pw[3]};
            *(LAS u32x4*)(TT + (16 * bb + c) * P64 + 16 * bb + 8) = (u32x4){pw[4], pw[5], pw[6], pw[7]}; }
        LDS_BARRIER();
#pragma unroll 1
        for (int lev = 1; lev < 4; ++lev) {
            if (w < 4 - lev) { const int bj = w, bi = w + lev;
                f32x4 m = (f32x4){0.f, 0.f, 0.f, 0.f};
#pragma unroll
                for (int ks = 0; ks < 2; ++ks) { const bf16x8 a = *(const LAS bf16x8*)(LR + (16 * bi + l15) * P64 + 32 * ks + quad * 8), bq = *(const LAS bf16x8*)(TT + (16 * bj + l15) * P64 + 32 * ks + quad * 8); m = mfma16(a, bq, m); }
                const u32x2 tl = *(const LAS u32x2*)(TM + (16 * bi + l15) * P64 + 16 * bi + quad * 4);
                const bf16x8 a2 = __builtin_bit_cast(bf16x8, (u32x4){tl.x, tl.y, 0u, 0u}), b2 = __builtin_bit_cast(bf16x8, (u32x4){pk2(m[0], m[1]), pk2(m[2], m[3]), 0u, 0u});
                const f32x4 t = mfma16(a2, b2, (f32x4){0.f, 0.f, 0.f, 0.f});
                const unsigned p0 = pk2(-t[0], -t[1]), p1 = pk2(-t[2], -t[3]);
                TM[(16 * bi + quad * 4 + 0) * P64 + 16 * bj + l15] = (bf16)(p0 & 0xffffu); TM[(16 * bi + quad * 4 + 1) * P64 + 16 * bj + l15] = (bf16)(p0 >> 16);
                TM[(16 * bi + quad * 4 + 2) * P64 + 16 * bj + l15] = (bf16)(p1 & 0xffffu); TM[(16 * bi + quad * 4 + 3) * P64 + 16 * bj + l15] = (bf16)(p1 >> 16);
                *(LAS u32x2*)(TT + (16 * bj + l15) * P64 + 16 * bi + quad * 4) = (u32x2){p0, p1}; }
            LDS_BARRIER();
        }
#ifndef NO_EFG
        bf16x8 Bst[4];
#pragma unroll
        for (int ks = 0; ks < 4; ++ks) Bst[ks] = pack_acc2(Sacc[2 * ks], Sacc[2 * ks + 1]);
        f32x4 vn[4];
#pragma unroll
        for (int mt = 0; mt < 4; ++mt) { f32x4 acc = (f32x4){0.f, 0.f, 0.f, 0.f};
#pragma unroll
            for (int ks = 0; ks < 4; ++ks) { const bf16x8 a = ld_split8(Ks + (16 * mt + l15) * P128 + 32 * ks + quad * 4); acc = mfma16(a, Bst[ks], acc); }
#pragma unroll
            for (int jj = 0; jj < 4; ++jj) { const int i = 16 * mt + quad * 4 + jj; vn[mt][jj] = bf2f(Vs[i * P128 + 16 * w + l15]) * betas[i] - acc[jj]; } }
        bf16x8 Bvn[2];
#pragma unroll
        for (int k2 = 0; k2 < 2; ++k2) Bvn[k2] = pack_acc2(vn[2 * k2], vn[2 * k2 + 1]);
#pragma unroll
        for (int mt = 0; mt < 4; ++mt) { f32x4 acc = (f32x4){0.f, 0.f, 0.f, 0.f};
#pragma unroll
            for (int k2 = 0; k2 < 2; ++k2) { const bf16x8 a = ld_split8(TM + (16 * mt + l15) * P64 + 32 * k2 + quad * 4); acc = mfma16(a, Bvn[k2], acc); }
            vn[mt] = acc; }
#pragma unroll
        for (int k2 = 0; k2 < 2; ++k2) Bvn[k2] = pack_acc2(vn[2 * k2], vn[2 * k2 + 1]);
#pragma unroll 1
        for (int mt = 0; mt < 4; ++mt) { f32x4 acc = (f32x4){0.f, 0.f, 0.f, 0.f};
#pragma unroll
            for (int ks = 0; ks < 4; ++ks) { const bf16x8 a = ld_split8(Qs + (16 * mt + l15) * P128 + 32 * ks + quad * 4); acc = mfma16(a, Bst[ks], acc); }
#pragma unroll
            for (int jj = 0; jj < 4; ++jj) { const int i = 16 * mt + quad * 4 + jj; acc[jj] *= rq[i] * egs[i]; }
#pragma unroll
            for (int k2 = 0; k2 < 2; ++k2) { const bf16x8 a = ld_split8(QKs + (16 * mt + l15) * P64 + 32 * k2 + quad * 4); acc = mfma16(a, Bvn[k2], acc); }
#pragma unroll
            for (int jj = 0; jj < 4; ++jj) { const int i = 16 * mt + quad * 4 + jj; const int t = c0 + (dir ? 63 - i : i);
                Odir[(size_t)(m0 + t) * 512 + hd * 128 + 16 * w + l15] = (bf16)f2bf(acc[jj]); } }
        const float egl = rq[384];
#pragma unroll
        for (int mt = 0; mt < 8; ++mt) { f32x4 acc = Sacc[mt] * egl;
#pragma unroll
            for (int k2 = 0; k2 < 2; ++k2) { const bf16x8 a = ld_split8(KT + (16 * mt + l15) * P64 + 32 * k2 + quad * 4); acc = mfma16(a, Bvn[k2], acc); }
            Sacc[mt] = acc; }
#endif
        WAVE_SYNC();
    }
    if (!lat) { const int tid2 = tid_fresh(wid0), lane2 = tid2 & 63; float* dp = P.out + OUT_DELTA + sbase + (size_t)((lane2 >> 4) * 4) * 128 + 16 * w + (lane2 & 15);
#pragma unroll
        for (int mt = 0; mt < 8; ++mt)
#pragma unroll
            for (int jj = 0; jj < 4; ++jj) dp[(16 * mt + jj) * 128] = Sacc[mt][jj];
    }
    __syncthreads();
}

__device__ __forceinline__ void phase_mix_even(int wid0, const Params& P, LAS unsigned char* lds, int e, int mode = 3) {
    const int bid = bid_fresh(), G = grid_fresh();
    if (G == 256) {
        if (bid < 64) { const int s = 32 + (bid >> 3), hd = (bid >> 1) & 3, dir = bid & 1; if (mode & 1) gdn_chain(wid0, P, lds, e, s, hd, dir); }
        else { const int bb = bid - 64;
            if (mode & 1) for (int c = bb; c < 256; c += 192) { const int s = c >> 3, hd = (c >> 1) & 3, dir = c & 1; gdn_chain(wid0, P, lds, e, s, hd, dir); }
            if (mode & 2) { const int tid = tid_fresh(wid0), lane = tid & 63, wave = tid >> 6;
                for (int t = bb; t < 384; t += 192) { const int wt = t * 8 + wave; s5_task_main(P, lds + wave * S5_WLDS, lane, e, wt >> 5, wt & 31); } }
            if (mode == 3) { __syncthreads(); const int tid = tid_fresh(wid0), lane = tid & 63, wave = tid >> 6;
                for (int it = bb * NWAVES + wave; it < WITEMS_ODD; it += 192 * NWAVES) weight_item(P, (LAS float*)(lds + wave * 16384), 2 * e + 1, it, lane); } }
    } else {
        for (int c = bid; c < 320; c += G) { const int s = c < 64 ? 32 + (c >> 3) : ((c - 64) >> 3), hd = (c >> 1) & 3, dir = c & 1; gdn_chain(wid0, P, lds, e, s, hd, dir); }
        const int tid = tid_fresh(wid0), lane = tid & 63, wave = tid >> 6;
        for (int t = bid; t < 384; t += G) { const int wt = t * 8 + wave; s5_task_main(P, lds + wave * S5_WLDS, lane, e, wt >> 5, wt & 31); }
        __syncthreads();
        for (int it = bid * NWAVES + wave; it < WITEMS_ODD; it += G * NWAVES) weight_item(P, (LAS float*)(lds + wave * 16384), 2 * e + 1, it, lane);
    }
}
__device__ __forceinline__ void phase_fin_even(int wid0, const Params& P, LAS unsigned char* lds, int e, int dry = 0) {
    const int tid = tid_fresh(wid0), lane = tid & 63, wave = tid >> 6;
    const int gw = bid_fresh() * NWAVES + wave, NGW = grid_fresh() * NWAVES;
    for (int wt = gw; wt < 2048; wt += NGW) s5_task_corr(P, lds + wave * S5_WLDS, lane, e, wt >> 5, wt & 31, dry);
    const bf16* proj = (const bf16*)(P.ws + WS_BIG); const bf16* Of = (const bf16*)(P.ws + WS_H); const bf16* Ob = Of + (size_t)MT * 512; bf16* mixout = (bf16*)(P.ws + WS_MIX);
    for (int mb2 = gw; mb2 < MT; mb2 += 2 * NGW) {
        u32x4 a[2], bq[2], z[2];
#pragma unroll
        for (int u = 0; u < 2; ++u) { const int m = mb2 + u * NGW; if (m < MT) { a[u] = *(const u32x4*)(Of + (size_t)m * 512 + lane * 8); bq[u] = *(const u32x4*)(Ob + (size_t)m * 512 + lane * 8); z[u] = *(const u32x4*)(proj + (size_t)m * NPROJ_E + 2560 + lane * 8); } }
#pragma unroll
        for (int u = 0; u < 2; ++u) { const int m = mb2 + u * NGW; if (m < MT) {
            float o[8]; float ss = 0.f;
#pragma unroll
            for (int j = 0; j < 4; ++j) { o[2 * j] = bflo(a[u][j]) + bflo(bq[u][j]); o[2 * j + 1] = bfhi(a[u][j]) + bfhi(bq[u][j]); ss += o[2 * j] * o[2 * j] + o[2 * j + 1] * o[2 * j + 1]; }
            ss += shfl_i(ss, lane ^ 1); ss += shfl_i(ss, lane ^ 2); ss += shfl_i(ss, lane ^ 4); ss += shfl_i(ss, lane ^ 8);
            const float rs = rsqrtf(ss * (1.0f / 128.0f) + EPSF);
            const float* gn = P.in[I_GONORM] + e * 128 + (lane & 15) * 8;
            unsigned pw[4];
#pragma unroll
            for (int j = 0; j < 4; ++j) { const float z0 = bflo(z[u][j]), z1 = bfhi(z[u][j]); pw[j] = pk2(o[2 * j] * rs * gn[2 * j] * siluf_(z0), o[2 * j + 1] * rs * gn[2 * j + 1] * siluf_(z1)); }
            if (!dry) *(u32x4*)(mixout + (size_t)m * DM + 512 + lane * 8) = (u32x4){pw[0], pw[1], pw[2], pw[3]}; } }
    }
}

__device__ __forceinline__ void phase_conv_odd(int wid0, const Params& P, int o) {
    const int tid = tid_fresh(wid0), lane = tid & 63, wave = tid >> 6;
    const int gw = bid_fresh() * NWAVES + wave, NGW = grid_fresh() * NWAVES;
    const bf16* proj = (const bf16*)(P.ws + WS_BIG); bf16* cx = (bf16*)(P.ws + WS_H);
    const float* cw = P.in[I_LCONVW] + (size_t)o * 4 * 1024; const float* cb = P.in[I_LCONVB] + o * 1024;
    for (int m = gw; m < MT; m += NGW) {
        const int t = m < MCTX ? (m & 255) : ((m - MCTX) & 2047); const int L = m < MCTX ? LCTX : LLAT;
#pragma unroll
        for (int h2 = 0; h2 < 2; ++h2) { const int ch = lane * 8 + 512 * h2;
            float acc[8];
#pragma unroll
            for (int j = 0; j < 8; ++j) acc[j] = cb[ch + j];
#pragma unroll
            for (int k = 0; k < 4; ++k) { const int tt = t - 1 + k; if (tt >= 0 && tt < L) { const u32x4 v = *(const u32x4*)(proj + (size_t)(m - 1 + k) * 2048 + ch);
#pragma unroll
                    for (int j = 0; j < 4; ++j) { acc[2 * j] += cw[k * 1024 + ch + 2 * j] * bflo(v[j]); acc[2 * j + 1] += cw[k * 1024 + ch + 2 * j + 1] * bfhi(v[j]); } } }
            *(u32x4*)(cx + (size_t)m * DM + ch) = (u32x4){pk2(acc[0], acc[1]), pk2(acc[2], acc[3]), pk2(acc[4], acc[5]), pk2(acc[6], acc[7])}; }
    }
}
__device__ __forceinline__ void phase_lru_scan(int wid0, const Params& P, LAS unsigned char* lds, int o, int d) {
    const int tid = tid_fresh(wid0), lane = tid & 63, wave = tid >> 6;
    const int gw = bid_fresh() * NWAVES + wave, NGW = grid_fresh() * NWAVES;
    const unsigned* G = (const unsigned*)(P.ws + WS_GATES); const bf16* proj = (const bf16*)(P.ws + WS_BIG); bf16* mixout = (bf16*)(P.ws + WS_MIX);
    const int Gn = NGW / NWAVES, vw = wave * Gn + (gw / NWAVES);
    if (d == 0 && o == 0 && NGW > 640) {
        for (int it = vw - 640; it >= 0 && it < WITEMS_EVEN; it += NGW - 640) weight_item(P, (LAS float*)(lds + wave * 16384), 2, it, lane); }
    for (int task = vw; task < 640; task += NGW) {
        int s, cg_;
        if (task < 128) { s = 32 + (task >> 4); cg_ = task & 15; } else { s = (task - 128) >> 4; cg_ = (task - 128) & 15; }
        const bool lat = s >= 32; const int b = lat ? s - 32 : s; const int L = lat ? LLAT : LCTX; const int m0 = lat ? MCTX + b * LLAT : s * LCTX;
        const int ch = cg_ * 64 + lane;
        float h = lat ? P.in[I_SLRU][(((size_t)b * 2 + o) * 2 + d) * 1024 + ch] : 0.f;
        if (d == 0) {
            unsigned ga[32], gb[32];
#define LRU_LD0(dst, tt) _Pragma("unroll") for (int i = 0; i < 32; ++i) dst[i] = G[(size_t)(m0 + (tt) + i) * DM + ch]
#define LRU_CP0(src, tt) _Pragma("unroll") for (int i = 0; i < 32; ++i) { h = (1.0f - bflo(src[i])) * h + bfhi(src[i]); mixout[(size_t)(m0 + (tt) + i) * DM + ch] = (bf16)f2bf(h); }
            LRU_LD0(ga, 0);
            for (int t0 = 0; t0 < L; t0 += 64) {
                LRU_LD0(gb, t0 + 32);
                LRU_CP0(ga, t0);
                if (t0 + 64 < L) { LRU_LD0(ga, t0 + 64); }
                LRU_CP0(gb, t0 + 32);
            }
        } else {
            unsigned ga[16], gb[16]; bf16 pa[16], pb[16], ya[16], yb[16];
#define LRU_LD1(g_, p_, y_, tt) _Pragma("unroll") for (int i = 0; i < 16; ++i) { const size_t m = (size_t)(m0 + L - 1 - ((tt) + i)); g_[i] = G[m * DM + ch]; p_[i] = mixout[m * DM + ch]; y_[i] = proj[m * 2048 + 1024 + ch]; }
#define LRU_CP1(g_, p_, y_, tt) _Pragma("unroll") for (int i = 0; i < 16; ++i) { const size_t m = (size_t)(m0 + L - 1 - ((tt) + i)); \
                h = (1.0f - bflo(g_[i])) * h + bfhi(g_[i]); mixout[m * DM + ch] = (bf16)f2bf((bf2f(p_[i]) + h) * geluf_(bf2f(y_[i]))); }
            LRU_LD1(ga, pa, ya, 0);
            for (int t0 = 0; t0 < L; t0 += 32) {
                LRU_LD1(gb, pb, yb, t0 + 16);
                LRU_CP1(ga, pa, ya, t0);
                if (t0 + 32 < L) { LRU_LD1(ga, pa, ya, t0 + 32); }
                LRU_CP1(gb, pb, yb, t0 + 16);
            }
        }
        if (!lat) P.out[OUT_LRU + (((size_t)b * 2 + o) * 2 + d) * 1024 + ch] = h;
    }
}
#ifdef PROBE_DUP_GEMM
#define DUPG(x) GSYNC(); x
#else
#define DUPG(x)
#endif
typedef const __attribute__((address_space(4))) Params* KParams;
__device__ __forceinline__ Params load_params(KParams q) { Params r;
#pragma unroll
    for (int i = 0; i < 40; ++i) r.in[i] = q->in[i];
    r.out = q->out; r.ws = q->ws; return r; }
#define FRESH() const int G = grid_fresh(), bid = bid_fresh(); (void)G; (void)bid; KParams pk_ = (KParams)__builtin_amdgcn_kernarg_segment_ptr(); asm volatile("" : "+s"(pk_)); const Params P = load_params(pk_); unsigned char* ws = P.ws; \
    const float* mod = (const float*)(ws + WS_MOD); bf16* H = (bf16*)(ws + WS_H); bf16* BIG = (bf16*)(ws + WS_BIG); bf16* MIX = (bf16*)(ws + WS_MIX); (void)mod; (void)H; (void)BIG; (void)MIX;
#define GSYNC() do { KParams pb_ = (KParams)__builtin_amdgcn_kernarg_segment_ptr(); asm volatile("" : "+s"(pb_)); xcd_barrier(wid0, (unsigned*)(pb_->ws + WS_BAR), lds); } while (0)
__global__ void __launch_bounds__(NTHR, 2) fwd_kernel(Params Parg) {
    extern __shared__ __attribute__((aligned(16))) unsigned char lds_raw[];
    LAS unsigned char* lds = (LAS unsigned char*)lds_raw;
    cg::grid_group grid = cg::this_grid();
    const int wid0 = __builtin_amdgcn_readfirstlane(threadIdx.x >> 6);
    if (threadIdx.x < 4) ((LAS unsigned*)(lds + LDS_BARST))[threadIdx.x] = 0u;
    __syncthreads();
    if (threadIdx.x == 0) (void)xb_add((unsigned*)(Parg.ws + WS_BAR) + XB_XCNT(xb_xcc_id()), 1u);

    { FRESH(); phase_prologue(wid0, P, lds); }
    if (grid_fresh() == 0) grid.sync();
    GSYNC();
#ifdef PROBE_DUP_PRO
    { FRESH(); phase_prologue(wid0, P, lds); }
    GSYNC();
#endif
    { FRESH(); phase_modreduce(wid0, P); }
    GSYNC();
#ifdef PROBE_SYNC
#pragma unroll 1
    for (int i = 0; i < 40; ++i) GSYNC();
#endif
#pragma unroll 1
    for (int l = 0; l < 4; ++l) {
        { FRESH(); const float* modl = mod + (size_t)l * 9 * 6144;
        phase_rownorm(wid0, P, l == 0, MIX, modl - 9 * 6144, 5 * 1024, P.in[I_NMLPPOST] + (l > 0 ? (l - 1) * 1024 : 0), 1, P.in[I_NMIXPRE] + l * 1024, modl, 0, H); }
        GSYNC();
        const int eo = l >> 1;
        {
            FRESH();
            pg8::Gemm g; pg8::StaticOrder S; EpiBf16<0> E;
            if ((l & 1) == 0) { g = pg8::Gemm{H, (const bf16*)(ws + WS_WINE) + (size_t)eo * NB_E * 1024, MT, NB_E, 1024, 1024, 0, 0, 1024, 0}; E = EpiBf16<0>{BIG, NPROJ_E, (float*)(ws + WS_AB), (bf16*)(ws + WS_HALO)}; }
            else { g = pg8::Gemm{H, (const bf16*)(ws + WS_WINO) + (size_t)eo * 2048 * 1024, MT, 2048, 1024, 1024, 0, 0, 1024, 0}; E = EpiBf16<0>{BIG, 2048, nullptr, nullptr}; }
            S.init(g.M, g.N, G, bid);
            pg8::gemm_phase(wid0, lds, g, S, E); DUPG(pg8::gemm_phase(wid0, lds, g, S, E);)
        }
        GSYNC();
        if ((l & 1) == 0) {
            { FRESH(); phase_conv_even(wid0, P, eo); }
            GSYNC();
#ifdef PROBE_DRY_CONVE
            { FRESH(); phase_conv_even(wid0, P, eo, grid_fresh() > 0); }
            GSYNC();
#endif
#ifdef PROBE_DUP_MIX
#pragma unroll 1
            for (int rep = 0; rep < 2; ++rep) { { FRESH(); phase_mix_even(wid0, P, lds, eo, rep == 0 ? 3 : PROBE_DUP_MIX); } GSYNC(); }
#else
            { FRESH(); phase_mix_even(wid0, P, lds, eo); }
            GSYNC();
#endif
            { FRESH(); phase_fin_even(wid0, P, lds, eo); }
            GSYNC();
#ifdef PROBE_DRY_FIN
            { FRESH(); phase_fin_even(wid0, P, lds, eo, grid_fresh() > 0); }
            GSYNC();
#endif
        } else {
            { FRESH(); phase_conv_odd(wid0, P, eo); }
            GSYNC();
#ifdef PROBE_DUP_CONV
            { FRESH(); phase_conv_odd(wid0, P, eo); }
            GSYNC();
#endif
#pragma unroll 1
            for (int d = 0; d < 2; ++d) {
                { FRESH();
                pg8::Gemm g{H, (const bf16*)(ws + WS_WG) + (size_t)(eo * 2 + d) * 2048 * 256, MT, 2048, 256, 1024, 1, 1, 256, 0};
                EpiGates E{(unsigned*)(ws + WS_GATES), H, P.in[I_LBR] + (eo * 2 + d) * 1024, P.in[I_LBI] + (eo * 2 + d) * 1024, P.in[I_LLAM] + (eo * 2 + d) * 1024};
                pg8::StaticOrder S; S.init(g.M, g.N, G, bid);
                pg8::gemm_phase(wid0, lds, g, S, E); DUPG(pg8::gemm_phase(wid0, lds, g, S, E);) }
                GSYNC();
                { FRESH(); phase_lru_scan(wid0, P, lds, eo, d); }
#ifdef PROBE_DUP_LRU0
                if (d == 0) { GSYNC(); FRESH(); phase_lru_scan(wid0, P, lds, eo, d); }
#endif
                GSYNC();
            }
        }
        {
            FRESH();
            pg8::Gemm g{MIX, (const bf16*)(ws + ((l & 1) ? WS_WOUTO : WS_WOUTE)) + (size_t)eo * 1024 * 1024, MT, 1024, 1024, 1024, 0, 0, 1024, 0};
            EpiBf16<0> E{BIG, 1024, nullptr, nullptr}; pg8::StaticOrder S; S.init(g.M, g.N, G, bid);
            pg8::gemm_phase(wid0, lds, g, S, E); DUPG(pg8::gemm_phase(wid0, lds, g, S, E);)
        }
        GSYNC();
        { FRESH(); const float* modl = mod + (size_t)l * 9 * 6144;
        phase_rownorm(wid0, P, 0, BIG, modl, 2 * 1024, P.in[I_NMIXPOST] + l * 1024, 1, P.in[I_NMLPPRE] + l * 1024, modl, 3 * 1024, H); }
#ifdef PROBE_DUP_RN
        GSYNC();
        { FRESH(); const float* modl = mod + (size_t)l * 9 * 6144;
        phase_rownorm(wid0, P, 0, BIG, modl, 2 * 1024, P.in[I_NMIXPOST] + l * 1024, 1, P.in[I_NMLPPRE] + l * 1024, modl, 3 * 1024, H, 0.0f); }
#endif
        GSYNC();
        {
            FRESH();
            pg8::Gemm g{H, (const bf16*)(ws + WS_W1T) + (size_t)l * 4096 * 1024, MT, 4096, 1024, 1024, 0, 0, 1024, 0};
            EpiBf16<1> E{BIG, 4096, nullptr, nullptr}; pg8::StaticOrder S; S.init(g.M, g.N, G, bid);
            pg8::gemm_phase(wid0, lds, g, S, E); DUPG(pg8::gemm_phase(wid0, lds, g, S, E);)
        }
        GSYNC();
        {
            FRESH();
            pg8::Gemm g{BIG, (const bf16*)(ws + WS_W2T) + (size_t)l * 1024 * 4096, MT, 1024, 4096, 4096, 0, 0, 4096, 0};
            EpiBf16<0> E{MIX, 1024, nullptr, nullptr}; pg8::StaticOrder S; S.init(g.M, g.N, G, bid);
            pg8::gemm_phase(wid0, lds, g, S, E); DUPG(pg8::gemm_phase(wid0, lds, g, S, E);)
        }
        GSYNC();
    }
    { FRESH();
    phase_rownorm(wid0, P, 0, MIX, mod + (size_t)3 * 9 * 6144, 5 * 1024, P.in[I_NMLPPOST] + 3 * 1024, 0, P.in[I_NMIXPRE], mod, 0, H); }
    GSYNC();
    { FRESH(); phase_copy_tail(wid0, P); }
}

extern "C" void kernel_launch(void* const* d_in, const int* in_sizes, int n_in, void* d_out, int out_size, void* d_ws, size_t ws_size, hipStream_t stream) {
    static int grid = 0;
    if (grid == 0) {
        if (n_in != 40 || ws_size < WS_END) { fprintf(stderr, "kernel_launch: expected 40 inputs and >= %zu bytes of workspace (got %d, %zu)\n", (size_t)WS_END, n_in, ws_size); grid = -1; return; }
        int dev = 0, cus = 0, per_cu = 0;
        if (hipGetDevice(&dev) != hipSuccess || hipDeviceGetAttribute(&cus, hipDeviceAttributeMultiprocessorCount, dev) != hipSuccess) { grid = -1; return; }
        if (hipFuncSetAttribute((const void*)fwd_kernel, hipFuncAttributeMaxDynamicSharedMemorySize, LDS_BYTES) != hipSuccess) { fprintf(stderr, "kernel_launch: hipFuncSetAttribute failed\n"); grid = -1; return; }
        if (hipOccupancyMaxActiveBlocksPerMultiprocessor(&per_cu, (const void*)fwd_kernel, NTHR, LDS_BYTES) != hipSuccess || per_cu < 1) per_cu = 1;
        (void)hipGetLastError();
        grid = cus * per_cu; if (grid > 256) grid = 256;
    }
    if (grid < 0) return;
    (void)hipMemsetAsync((char*)d_ws + WS_BAR, 0, 16384, stream);
    Params p{};
    for (int i = 0; i < 40; ++i) p.in[i] = (const float*)d_in[i];
    p.out = (float*)d_out; p.ws = (unsigned char*)d_ws;
    void* args[] = {&p};
    hipError_t e = hipLaunchCooperativeKernel((const void*)fwd_kernel, dim3(grid), dim3(NTHR), args, LDS_BYTES, stream);
    if (e != hipSuccess) fprintf(stderr, "cooperative launch failed: %s (grid %d)\n", hipGetErrorString(e), grid);
}
```

```cpp
#include <hip/hip_runtime.h>
#include <hip/hip_cooperative_groups.h>
#include <cstdio>
#include <cstdint>
namespace cg = cooperative_groups;
__device__ __forceinline__ int bid_fresh() { int t = blockIdx.x; asm volatile("" : "+s"(t)); return t; }
__device__ __forceinline__ int grid_fresh() { int t = gridDim.x; asm volatile("" : "+s"(t)); return t; }
__device__ __forceinline__ int tid_fresh(int w) { asm volatile("" : "+s"(w)); int l; asm volatile("v_mbcnt_lo_u32_b32 %0, -1, 0\n\tv_mbcnt_hi_u32_b32 %0, -1, %0" : "=v"(l)); return w * 64 + l; }

namespace pg8 {
#define PG8_LAS __attribute__((address_space(3)))
typedef unsigned short bf16_t;
typedef short bf16x8 __attribute__((ext_vector_type(8)));
typedef float f32x4 __attribute__((ext_vector_type(4)));
typedef unsigned u32x4 __attribute__((ext_vector_type(4)));
typedef unsigned u32x2 __attribute__((ext_vector_type(2)));
constexpr int BM = 256, BK = 64, HALF = 128, HTB = HALF * BK * 2, STAGE_BYTES = 8 * HTB, NXCD = 8, WGM = 4;

__host__ __device__ __forceinline__ int lds_byte(int r, int c) { const int st = (r >> 4) * 2 + (c >> 5), rr = r & 15, cc = c & 31, ob = rr * 64 + cc * 2; return st * 1024 + (ob ^ (((ob >> 9) & 1) << 5)); }
__host__ __device__ __forceinline__ void stage_rc(int b, int& R, int& C) { const int st = b / 1024, sb = b % 1024, swz = sb ^ (((sb >> 9) & 1) << 5); R = (st >> 1) * 16 + swz / 64; C = (st & 1) * 32 + (swz % 64) / 2; }
__host__ __device__ __forceinline__ int perm32(int rho) { const int n = rho >> 4, i = rho & 15; return 8 * (i >> 2) + 4 * n + (i & 3); }

struct Unit { int pm, pn; };
struct Gemm { const bf16_t* A; const bf16_t* Bt; int M, N, K, lda, ablk, ashift, ldb, ksplit; };

struct StaticOrder {
    int nM, nN, nwg, G, c;
    __host__ __device__ void init(int M, int N, int G_, int c_) { nM = M / BM; nN = N / BM; nwg = nM * nN; G = G_; c = c_; }
    __host__ __device__ bool next(int i, Unit& u) const {
        const long L = (long)i * G + c; if (L >= nwg) return false;
        int wgid = (int)L; { const int q = nwg / NXCD, r = nwg % NXCD, xcd = wgid % NXCD, off = wgid / NXCD; wgid = (xcd < r ? xcd * (q + 1) : r * (q + 1) + (xcd - r) * q) + off; }
        const int nig = WGM * nN, gid = wgid / nig, fm = gid * WGM, gsz = (nM - fm) < WGM ? (nM - fm) : WGM;
        u.pm = fm + ((wgid % nig) % gsz); u.pn = (wgid % nig) / gsz; return true;
    }
};
__device__ __forceinline__ unsigned cvt_pk_bf16(float lo, float hi) { unsigned r; asm volatile("v_cvt_pk_bf16_f32 %0, %1, %2" : "=v"(r) : "v"(lo), "v"(hi)); return r; }

template <class Epi>
__device__ __forceinline__ void gemm_phase(int wid0, PG8_LAS unsigned char* lds, const Gemm g, const StaticOrder& S, const Epi& E) {
    const int tid = tid_fresh(wid0), wid = __builtin_amdgcn_readfirstlane(tid >> 6), lane = tid & 63, wr = wid >> 2, wc = wid & 3, fr = lane & 15, fq = lane >> 4;
    const int K = g.K, nt = K / BK, lda = g.lda, ldb = g.ldb;
    unsigned voffA[2], voffB[2];
#pragma unroll
    for (int i = 0; i < 2; ++i) { int R, C; stage_rc(tid * 16 + i * 8192, R, C); const int Rb = (R & ~31) + perm32(R & 31);
        voffA[i] = (unsigned)(R * lda + C) * 2u; voffB[i] = (unsigned)(Rb * ldb + C) * 2u; }
    const size_t kstep = (size_t)(BK * 2);
    const size_t hstepA = (size_t)HALF * lda * 2, hstepB = (size_t)HALF * ldb * 2;
    const size_t tstepA = 2 * hstepA, tstepB = 2 * hstepB;
    const unsigned ldsw = (unsigned)wid * 1024u;
    const int aoff = lds_byte(wr * 64 + fr, fq * 8), boff = lds_byte(wc * 32 + fr, fq * 8);
#define PG8_ACOL(pn) (g.ablk ? (size_t)((((pn) >> g.ashift) & 3) * 512) : (g.ksplit ? (size_t)((pn) & 1) * (size_t)K * 2 : (size_t)0))
#define PG8_BOFF(pn) (g.ksplit ? (size_t)((pn) >> 1) * tstepB + (size_t)((pn) & 1) * (size_t)K * 2 : (size_t)(pn) * tstepB)
#define PG8_SA(b, h) (((b) * 2 + (h)) * HTB)
#define PG8_SB(b, h) ((4 + (b) * 2 + (h)) * HTB)
#define PG8_STAGE(bufoff, gbase, voff) do { _Pragma("unroll") for (int _i = 0; _i < 2; ++_i) \
        __builtin_amdgcn_global_load_lds((const unsigned*)((const char*)(gbase) + (voff)[_i]), (PG8_LAS unsigned*)(lds + (bufoff) + ldsw + _i * 8192), 16, 0, 0); } while (0)
#define PG8_LDA(dst, b, h) do { _Pragma("unroll") for (int m = 0; m < 4; ++m) _Pragma("unroll") for (int k = 0; k < 2; ++k) dst[m][k] = *(const PG8_LAS bf16x8*)(lds + PG8_SA(b, h) + aoff + m * 2048 + k * 1024); } while (0)
#define PG8_LDB(dst, b, h) do { _Pragma("unroll") for (int n = 0; n < 2; ++n) _Pragma("unroll") for (int k = 0; k < 2; ++k) dst[n][k] = *(const PG8_LAS bf16x8*)(lds + PG8_SB(b, h) + boff + n * 2048 + k * 1024); } while (0)
#define PG8_MMA(ai, bj, At, Bt) do { __builtin_amdgcn_s_setprio(1); _Pragma("unroll") for (int m = 0; m < 4; ++m) _Pragma("unroll") for (int n = 0; n < 2; ++n) _Pragma("unroll") for (int k = 0; k < 2; ++k) \
        acc[ai][bj][m][n] = __builtin_amdgcn_mfma_f32_16x16x32_bf16(Bt[n][k], At[m][k], acc[ai][bj][m][n], 0, 0, 0); __builtin_amdgcn_s_setprio(0); } while (0)
#define PG8_WAIT_V(n) asm volatile("s_waitcnt vmcnt(" #n ")" ::: "memory")
#define PG8_WAIT_L(n) asm volatile("s_waitcnt lgkmcnt(" #n ")" ::: "memory")
#define PG8_BAR __builtin_amdgcn_s_barrier()
#define PG8_SCHED __builtin_amdgcn_sched_barrier(0)
    Unit cur, nxt; int ui = 0;
    if (!S.next(0, cur)) return;
    f32x4 acc[2][2][4][2];
#pragma unroll
    for (int a = 0; a < 2; ++a)
#pragma unroll
        for (int b = 0; b < 2; ++b)
#pragma unroll
            for (int m = 0; m < 4; ++m)
#pragma unroll
                for (int n = 0; n < 2; ++n) acc[a][b][m][n] = (f32x4){0.f, 0.f, 0.f, 0.f};
    bf16x8 At[4][2], B0[2][2], B1[2][2];
    const char* cA = (const char*)g.A + (size_t)cur.pm * tstepA + PG8_ACOL(cur.pn); const char* cB = (const char*)g.Bt + PG8_BOFF(cur.pn);
    PG8_STAGE(PG8_SB(0, 0), cB, voffB); PG8_STAGE(PG8_SA(0, 0), cA, voffA); PG8_STAGE(PG8_SB(0, 1), cB + hstepB, voffB); PG8_STAGE(PG8_SA(0, 1), cA + hstepA, voffA);
    if (wr == 1) PG8_BAR;
    PG8_WAIT_V(4); PG8_BAR;
    PG8_STAGE(PG8_SB(1, 0), cB + kstep, voffB); PG8_STAGE(PG8_SA(1, 0), cA + kstep, voffA); PG8_STAGE(PG8_SB(1, 1), cB + hstepB + kstep, voffB);
    PG8_WAIT_V(6); PG8_BAR;
    for (;;) {
        const bool has_next = S.next(ui + 1, nxt);
        const char* nA = has_next ? (const char*)g.A + (size_t)nxt.pm * tstepA + PG8_ACOL(nxt.pn) : cA; const char* nB = has_next ? (const char*)g.Bt + PG8_BOFF(nxt.pn) : cB;
        for (int t = 0; t < nt; t += 2) {
            const bool last = (t == nt - 2);
            const char* a1 = cA + (size_t)(t + 1) * kstep;
            const char* a2 = last ? nA : cA + (size_t)(t + 2) * kstep; const char* b2 = last ? nB : cB + (size_t)(t + 2) * kstep;
            const char* a3 = a2 + kstep; const char* b3 = b2 + kstep;
            PG8_LDB(B0, 0, 0); PG8_SCHED; PG8_LDA(At, 0, 0); PG8_STAGE(PG8_SA(1, 1), a1 + hstepA, voffA);
            PG8_WAIT_L(8); PG8_BAR; PG8_WAIT_L(0); PG8_MMA(0, 0, At, B0); PG8_BAR; PG8_SCHED;
            PG8_LDB(B1, 0, 1); PG8_STAGE(PG8_SB(0, 0), b2, voffB);
            PG8_BAR; PG8_WAIT_L(0); PG8_MMA(0, 1, At, B1); PG8_BAR;
            PG8_LDA(At, 0, 1); PG8_STAGE(PG8_SA(0, 0), a2, voffA);
            PG8_BAR; PG8_WAIT_L(0); PG8_MMA(1, 0, At, B0); PG8_BAR; PG8_SCHED;
            PG8_STAGE(PG8_SB(0, 1), b2 + hstepB, voffB);
            PG8_WAIT_V(6); PG8_BAR; PG8_MMA(1, 1, At, B1); PG8_BAR;
            PG8_LDB(B0, 1, 0); PG8_SCHED; PG8_LDA(At, 1, 0); PG8_STAGE(PG8_SA(0, 1), a2 + hstepA, voffA);
            PG8_WAIT_L(8); PG8_BAR; PG8_WAIT_L(0); PG8_MMA(0, 0, At, B0); PG8_BAR; PG8_SCHED;
            PG8_LDB(B1, 1, 1); PG8_STAGE(PG8_SB(1, 0), b3, voffB);
            PG8_BAR; PG8_WAIT_L(0); PG8_MMA(0, 1, At, B1); PG8_BAR;
            PG8_LDA(At, 1, 1); PG8_STAGE(PG8_SA(1, 0), a3, voffA);
            PG8_BAR; PG8_WAIT_L(0); PG8_MMA(1, 0, At, B0); PG8_BAR; PG8_SCHED;
            PG8_STAGE(PG8_SB(1, 1), b3 + hstepB, voffB);
            PG8_WAIT_V(6); PG8_BAR; PG8_MMA(1, 1, At, B1); PG8_BAR;
        }
        E(acc, cur, wr, wc, fr, fq);
        if (!has_next) break;
#pragma unroll
        for (int a = 0; a < 2; ++a)
#pragma unroll
            for (int b = 0; b < 2; ++b)
#pragma unroll
                for (int m = 0; m < 4; ++m)
#pragma unroll
                    for (int n = 0; n < 2; ++n) acc[a][b][m][n] = (f32x4){0.f, 0.f, 0.f, 0.f};
        cur = nxt; cA = nA; cB = nB; ++ui;
    }
    PG8_WAIT_V(0);
    if (wr == 0) PG8_BAR;
    PG8_BAR;
#undef PG8_ACOL
#undef PG8_BOFF
#undef PG8_SA
#undef PG8_SB
#undef PG8_STAGE
#undef PG8_LDA
#undef PG8_LDB
#undef PG8_MMA
#undef PG8_WAIT_V
#undef PG8_WAIT_L
#undef PG8_BAR
#undef PG8_SCHED
}
}
#define LAS __attribute__((address_space(3)))
typedef unsigned short bf16;
typedef short bf16x8 __attribute__((ext_vector_type(8)));
typedef float f32x4 __attribute__((ext_vector_type(4)));
typedef unsigned u32x4 __attribute__((ext_vector_type(4)));
typedef unsigned u32x2 __attribute__((ext_vector_type(2)));
constexpr int DM = 1024, MT = 24576, MCTX = 8192, LCTX = 256, LLAT = 2048, NWAVES = 8, NTHR = 512;
constexpr int NPROJ_E = 3072, NB_E = 3328, IN_EVEN_LD = 3088;
constexpr float EPSF = 1e-6f;
constexpr size_t MiB = 1u << 20;
constexpr size_t WS_MOD = 0, MOD_BYTES = 4 * 9 * 6144 * 4, WS_S5F = 1 * MiB, WS_AB = 3 * MiB, WS_W1T = 5 * MiB, WS_W2T = 37 * MiB, WS_WINE = 69 * MiB,
                 WS_WOUTE = 82 * MiB, WS_WINO = 86 * MiB, WS_WOUTO = 94 * MiB, WS_WG = 98 * MiB, WS_H = 102 * MiB, WS_BIG = 150 * MiB, WS_YBUF = 294 * MiB,
                 WS_GATES = 246 * MiB, WS_MIX = 342 * MiB, WS_HALO = 390 * MiB, WS_END = 390 * MiB + 384 * 3 * 1536 * 2;
constexpr int LDS_BYTES = 147456;
constexpr size_t OUT_S5RE = 25165824, OUT_S5IM = OUT_S5RE + 262144, OUT_DELTA = OUT_S5IM + 262144, OUT_LRU = OUT_DELTA + 8388608;

struct Params { const float* in[40]; float* out; unsigned char* ws; };
enum { I_XP = 0, I_XS, I_S5RE, I_S5IM, I_SDELTA, I_SLRU, I_C, I_CCTX, I_WADA, I_BADA, I_NMIXPRE, I_NMIXPOST, I_NMLPPRE, I_NMLPPOST, I_WMLPIN, I_WMLPOUT, I_WINE, I_WOUTE,
       I_LAMRE, I_LAMIM, I_LOGDT, I_BRE, I_BIM, I_CRE, I_CIM, I_S5D, I_GCONVW, I_GCONVB, I_GALOG, I_GDTB, I_GONORM, I_WINO, I_WOUTO, I_LCONVW, I_LCONVB, I_LWR, I_LBR, I_LWI, I_LBI, I_LLAM };

typedef __bf16 bf2_t __attribute__((ext_vector_type(2)));
typedef float f2_t __attribute__((ext_vector_type(2)));
__device__ __forceinline__ unsigned pk2(float lo, float hi) { const bf2_t v = __builtin_convertvector((f2_t){lo, hi}, bf2_t); return __builtin_bit_cast(unsigned, v); }
__device__ __forceinline__ unsigned f2bf(float f) { return pk2(f, f) & 0xffffu; }
__device__ __forceinline__ float bflo(unsigned w) { return __builtin_bit_cast(float, w << 16); }
__device__ __forceinline__ float bfhi(unsigned w) { return __builtin_bit_cast(float, w & 0xffff0000u); }
__device__ __forceinline__ float bf2f(bf16 b) { return __builtin_bit_cast(float, (unsigned)b << 16); }
__device__ __forceinline__ float sigmoidf_(float x) { return __builtin_amdgcn_rcpf(1.0f + __expf(-x)); }
__device__ __forceinline__ float siluf_(float x) { return x * sigmoidf_(x); }
__device__ __forceinline__ float softplusf_(float x) { return fmaxf(x, 0.f) + __logf(1.0f + __expf(-fabsf(x))); }
__device__ __forceinline__ float geluf_(float x) { const float y = 0.7978845608028654f * (x + 0.044715f * x * x * x); const float t = 1.0f - 2.0f * __builtin_amdgcn_rcpf(__expf(2.0f * y) + 1.0f); return 0.5f * x * (1.0f + t); }
__device__ __forceinline__ float shfl_i(float v, int srclane) { return __builtin_bit_cast(float, __builtin_amdgcn_ds_bpermute(srclane << 2, __builtin_bit_cast(int, v))); }
__device__ __forceinline__ float dpp_f(float v, int ctrl_xor1) { return v; }
__device__ __forceinline__ float wave_sum(float v, int lane) {
    (void)lane;
    v += __builtin_bit_cast(float, __builtin_amdgcn_update_dpp(0, __builtin_bit_cast(int, v), 0xB1, 0xF, 0xF, true));
    v += __builtin_bit_cast(float, __builtin_amdgcn_update_dpp(0, __builtin_bit_cast(int, v), 0x4E, 0xF, 0xF, true));
    v += __builtin_bit_cast(float, __builtin_amdgcn_update_dpp(0, __builtin_bit_cast(int, v), 0x141, 0xF, 0xF, true));
    v += __builtin_bit_cast(float, __builtin_amdgcn_update_dpp(0, __builtin_bit_cast(int, v), 0x140, 0xF, 0xF, true));
    const int iv = __builtin_bit_cast(int, v);
    return (__builtin_bit_cast(float, __builtin_amdgcn_readlane(iv, 0)) + __builtin_bit_cast(float, __builtin_amdgcn_readlane(iv, 16))) +
           (__builtin_bit_cast(float, __builtin_amdgcn_readlane(iv, 32)) + __builtin_bit_cast(float, __builtin_amdgcn_readlane(iv, 48)));
}
#define LDS_WAIT() asm volatile("s_waitcnt lgkmcnt(0)" ::: "memory")
#define WAVE_SYNC() do { asm volatile("s_waitcnt lgkmcnt(0)" ::: "memory"); __builtin_amdgcn_wave_barrier(); } while (0)
__device__ __forceinline__ f32x4 mfma16(bf16x8 a, bf16x8 b, f32x4 c) { return __builtin_amdgcn_mfma_f32_16x16x32_bf16(a, b, c, 0, 0, 0); }


#define XB_TMO      128
#define XB_XCNT(j)  (256  + 64 * (j))
#define XB_XSUB(j)  (1280 + 64 * (j))
#define XB_XGEN(j)  (2304 + 64 * (j))
#define XB_TOP      3328
#define XB_TOPGEN   3392
#define XCD_BAR_WORDS 3456
#define XB_SPIN_CAP (1u << 18)
constexpr size_t WS_BAR = 960 * 1024; constexpr int LDS_BARST = LDS_BYTES - 16;
__device__ __forceinline__ unsigned xb_ld(unsigned* p)              { return __hip_atomic_load(p, __ATOMIC_RELAXED, __HIP_MEMORY_SCOPE_AGENT); }
__device__ __forceinline__ unsigned xb_add(unsigned* p, unsigned v) { return __hip_atomic_fetch_add(p, v, __ATOMIC_RELAXED, __HIP_MEMORY_SCOPE_AGENT); }
__device__ __forceinline__ unsigned xb_xcc_id() { return (unsigned)__builtin_amdgcn_s_getreg((3 << 11) | 20) & 0xFu; }
#define XB_SPIN(cond, bar) do { unsigned _sp = 0; while (cond) { __builtin_amdgcn_s_sleep(1); \
    if ((++_sp & 255u) == 0u) { if (xb_ld(&(bar)[XB_TMO])) break; if (_sp > XB_SPIN_CAP) { atomicAdd(&(bar)[XB_TMO], 1u); break; } } } } while (0)
__device__ __forceinline__ void xcd_barrier_complete(unsigned* bar, unsigned x, unsigned& nloc, unsigned& nx) {
    const unsigned G = gridDim.x;
    unsigned sum, cnt, mine, sp = 0u;
    for (;;) {
        sum = 0u; cnt = 0u; mine = 0u;
#pragma unroll
        for (unsigned j = 0; j < 16; ++j) { const unsigned c = xb_ld(&bar[XB_XCNT(j)]); sum += c; cnt += (c > 0u) ? 1u : 0u; mine = (j == x) ? c : mine; }
        if (sum == G) break;
        __builtin_amdgcn_s_sleep(1);
        if ((++sp & 255u) == 0u) { if (xb_ld(&bar[XB_TMO])) break; if (sp > XB_SPIN_CAP) { atomicAdd(&bar[XB_TMO], 1u); break; } }
    }
    nloc = mine > 0u ? mine : 1u; nx = cnt > 0u ? cnt : 1u;
}
__device__ __forceinline__ void xcd_barrier(int wid0, unsigned* bar, LAS unsigned char* lds) {
    const int tid = tid_fresh(wid0);
    asm volatile("s_waitcnt vmcnt(0)" ::: "memory");
    __syncthreads();
    if (tid == 0) {
        const unsigned x = xb_xcc_id();
        volatile LAS unsigned* st = (volatile LAS unsigned*)(lds + LDS_BARST);
        __builtin_amdgcn_s_waitcnt(0);
        unsigned nloc = st[0], nx = st[1];
        if (nloc == 0u) { xcd_barrier_complete(bar, x, nloc, nx); st[0] = nloc; st[1] = nx; }
        const unsigned old = xb_add(&bar[XB_XSUB(x)], 1u);
        const unsigned gen = old / nloc;
        if (old + 1u == (gen + 1u) * nloc) {
            __builtin_amdgcn_fence(__ATOMIC_RELEASE, "agent");
            asm volatile("s_waitcnt vmcnt(0)" ::: "memory");
            const unsigned og = xb_add(&bar[XB_TOP], 1u);
            const unsigned tg = og / nx;
            if (og + 1u == (tg + 1u) * nx) xb_add(&bar[XB_TOPGEN], 1u);
            else XB_SPIN(xb_ld(&bar[XB_TOPGEN]) == tg, bar);
            __builtin_amdgcn_fence(__ATOMIC_ACQUIRE, "agent");
            xb_add(&bar[XB_XGEN(x)], 1u);
            asm volatile("s_waitcnt vmcnt(0)" ::: "memory");
        } else {
            XB_SPIN(xb_ld(&bar[XB_XGEN(x)]) == gen, bar);
            __builtin_amdgcn_fence(__ATOMIC_ACQUIRE, "agent");
            asm volatile("s_waitcnt vmcnt(0)" ::: "memory");
        }
    }
    __syncthreads();
}
__device__ __forceinline__ void transpose_item(const float* W, int ldw, int nvalid, int K, bf16* WT, int dst_row0, LAS float* scr, int k0, int n0, int lane) {
    const int nn = n0 + (lane & 31); const bool ok = nn < nvalid;
#pragma unroll 8
    for (int i = 0; i < 32; ++i) { const int kk = 2 * i + (lane >> 5); scr[kk * 33 + (lane & 31)] = ok ? W[(size_t)(k0 + kk) * ldw + nn] : 0.f; }
    WAVE_SYNC();
    const int c = lane & 7;
#pragma unroll
    for (int j = 0; j < 4; ++j) { const int n = (lane >> 3) + 8 * j; const LAS float* s = scr + (8 * c) * 33 + n;
        u32x4 o; o.x = pk2(s[0 * 33], s[1 * 33]); o.y = pk2(s[2 * 33], s[3 * 33]); o.z = pk2(s[4 * 33], s[5 * 33]); o.w = pk2(s[6 * 33], s[7 * 33]);
        *(u32x4*)(WT + (size_t)(dst_row0 + n) * K + k0 + 8 * c) = o; }
    WAVE_SYNC();
}
constexpr int WITEMS_EVEN = 4096 + 1552 + 512, WITEMS_ODD = 4096 + 1024 + 512 + 512;
__device__ __forceinline__ void weight_item(const Params& P, LAS float* scr, int l, int r, int lane) {
    unsigned char* ws = P.ws; const int eo = l >> 1;
    if (r < 2048) { const int q = r; transpose_item(P.in[I_WMLPIN] + (size_t)l * 1024 * 4096, 4096, 4096, 1024, (bf16*)(ws + WS_W1T) + (size_t)l * 4096 * 1024, 32 * (q & 127), scr, 64 * (q >> 7), 32 * (q & 127), lane); return; } r -= 2048;
    if (r < 2048) { const int q = r; transpose_item(P.in[I_WMLPOUT] + (size_t)l * 4096 * 1024, 1024, 1024, 4096, (bf16*)(ws + WS_W2T) + (size_t)l * 1024 * 4096, 32 * (q & 31), scr, 64 * (q >> 5), 32 * (q & 31), lane); return; } r -= 2048;
    if ((l & 1) == 0) {
        if (r < 1552) { const int kb = r / 97, nb = r % 97; transpose_item(P.in[I_WINE] + (size_t)eo * 1024 * IN_EVEN_LD, IN_EVEN_LD, IN_EVEN_LD, 1024, (bf16*)(ws + WS_WINE) + (size_t)eo * NB_E * 1024, 32 * nb, scr, 64 * kb, 32 * nb, lane); return; } r -= 1552;
        { const int q = r; transpose_item(P.in[I_WOUTE] + (size_t)eo * 1024 * 1024, 1024, 1024, 1024, (bf16*)(ws + WS_WOUTE) + (size_t)eo * 1024 * 1024, 32 * (q & 31), scr, 64 * (q >> 5), 32 * (q & 31), lane); return; }
    } else {
        if (r < 1024) { const int q = r; transpose_item(P.in[I_WINO] + (size_t)eo * 1024 * 2048, 2048, 2048, 1024, (bf16*)(ws + WS_WINO) + (size_t)eo * 2048 * 1024, 32 * (q & 63), scr, 64 * (q >> 6), 32 * (q & 63), lane); return; } r -= 1024;
        if (r < 512) { const int q = r; transpose_item(P.in[I_WOUTO] + (size_t)eo * 1024 * 1024, 1024, 1024, 1024, (bf16*)(ws + WS_WOUTO) + (size_t)eo * 1024 * 1024, 32 * (q & 31), scr, 64 * (q >> 5), 32 * (q & 31), lane); return; } r -= 512;
        { const int mat = eo * 16 + (r >> 5), q = r & 31, kb = q >> 3, nb = q & 7; const int blk = mat & 3, gate = (mat >> 2) & 1, od = mat >> 3;
          const float* src = (gate ? P.in[I_LWI] : P.in[I_LWR]) + (size_t)(od * 4 + blk) * 65536;
          const int j0 = nb * 32; const int drow = (blk * 2 + (j0 >> 7)) * 256 + gate * 128 + (j0 & 127);
          transpose_item(src, 256, 256, 256, (bf16*)(ws + WS_WG) + (size_t)od * 2048 * 256, drow, scr, 64 * kb, j0, lane); return; }
    }
}
__device__ __forceinline__ void phase_prologue(int wid0, const Params& P, LAS unsigned char* lds) {
    const int tid = tid_fresh(wid0), lane = tid & 63, wave = tid >> 6;
    LAS float* scr = (LAS float*)(lds + wave * 16384);
    const int gw = bid_fresh() * NWAVES + wave, NGW = grid_fresh() * NWAVES;
    unsigned char* ws = P.ws;
    constexpr int NTR = WITEMS_EVEN, NMOD = 4 * 24 * 16;
    for (int it = gw; it < NTR + NMOD; it += NGW) {
        int r = it;
        if (r < NTR) { weight_item(P, scr, 0, r, lane); continue; } r -= NTR;
        {
            const int l = r / 384, rem = r % 384, ec = rem >> 4, ks = rem & 15, k0 = ks * 64;
#pragma unroll
            for (int rr = 0; rr < 9; ++rr) { const float cv = rr == 0 ? P.in[I_CCTX][k0 + lane] : P.in[I_C][(rr - 1) * 1024 + k0 + lane]; scr[rr * 64 + lane] = siluf_(cv); }
            WAVE_SYNC();
            f32x4 acc[9];
#pragma unroll
            for (int rr = 0; rr < 9; ++rr) acc[rr] = (f32x4){0.f, 0.f, 0.f, 0.f};
            const float* wp = P.in[I_WADA] + ((size_t)l * 1024 + k0) * 6144 + ec * 256 + lane * 4;
#pragma unroll 4
            for (int kk = 0; kk < 64; ++kk) { const f32x4 w4 = *(const f32x4*)(wp + (size_t)kk * 6144);
#pragma unroll
                for (int rr = 0; rr < 9; ++rr) acc[rr] += w4 * scr[rr * 64 + kk]; }
            float* part = (float*)(ws + WS_BIG) + ((size_t)(ks * 4 + l) * 9) * 6144 + ec * 256 + lane * 4;
#pragma unroll
            for (int rr = 0; rr < 9; ++rr) *(f32x4*)(part + (size_t)rr * 6144) = acc[rr];
            WAVE_SYNC();
        }
    }
    { const size_t per = (size_t)(NB_E - 3104) * 1024 * 2 / 16;
      for (size_t i = (size_t)bid_fresh() * NTHR + tid; i < 2 * per; i += (size_t)grid_fresh() * NTHR) { const size_t e = i / per, q = i % per;
          *(u32x4*)(ws + WS_WINE + (e * NB_E + 3104) * 1024 * 2 + q * 16) = (u32x4){0u, 0u, 0u, 0u}; } }
}
__device__ __forceinline__ void phase_modreduce(int wid0, const Params& P) {
    const int tid = tid_fresh(wid0);
    const float* part = (const float*)(P.ws + WS_BIG); float* mod = (float*)(P.ws + WS_MOD);
    for (int i = bid_fresh() * NTHR + tid; i < 4 * 9 * 6144 / 4; i += grid_fresh() * NTHR) {
        const int l = i / (9 * 1536), e4 = i % 1536;
        f32x4 a = *(const f32x4*)(P.in[I_BADA] + (size_t)l * 6144 + e4 * 4);
#pragma unroll
        for (int ks = 0; ks < 16; ++ks) a += *(const f32x4*)(part + (size_t)ks * 4 * 9 * 6144 + (size_t)i * 4);
        *(f32x4*)(mod + (size_t)i * 4) = a; }
}
constexpr size_t XB_OFF_FLOATS = (size_t)MT * DM / 2;
__device__ __forceinline__ void phase_rownorm(int wid0, const Params& P, int first, const bf16* obuf, const float* modg, int goff, const float* gpost, int has_next, const float* gpre, const float* mods, int soff, bf16* H, float gscale = 1.0f) {
    const int tid = tid_fresh(wid0), lane = tid & 63, wave = tid >> 6;
    const int gw = bid_fresh() * NWAVES + wave, NGW = grid_fresh() * NWAVES;
    bf16* XB = (bf16*)(P.out + XB_OFF_FLOATS); float* TMP = (float*)(P.ws + WS_BIG);
    f32x4 xn[4]; u32x2 xbn[4], on[4];
#define RN_LOAD(mm) do { const int m_ = (mm); \
        _Pragma("unroll") for (int j = 0; j < 4; ++j) { \
            if (first) xn[j] = *(const f32x4*)((m_ < MCTX ? P.in[I_XP] + (size_t)m_ * DM : P.in[I_XS] + (size_t)(m_ - MCTX) * DM) + lane * 4 + 256 * j); \
            else { xbn[j] = *(const u32x2*)(XB + (size_t)m_ * DM + lane * 4 + 256 * j); on[j] = *(const u32x2*)(obuf + (size_t)m_ * DM + lane * 4 + 256 * j); } } } while (0)
    if (gw < MT) RN_LOAD(gw);
    for (int m = gw; m < MT; m += NGW) {
        const int modrow = m < MCTX ? 0 : 1 + ((m - MCTX) >> 11);
        const float* mr = modg + (size_t)modrow * 6144; const float* ms = mods + (size_t)modrow * 6144;
        f32x4 x[4]; u32x2 ov[4];
#pragma unroll
        for (int j = 0; j < 4; ++j) { ov[j] = on[j]; x[j] = first ? xn[j] : (f32x4){bflo(xbn[j].x), bfhi(xbn[j].x), bflo(xbn[j].y), bfhi(xbn[j].y)}; }
        if (m + NGW < MT) RN_LOAD(m + NGW);
        f32x4 vgp[4], vgt[4], vgq[4], vsh[4], vsc[4];
#pragma unroll
        for (int j = 0; j < 4; ++j) { const int c = lane * 4 + 256 * j;
            if (!first) { vgp[j] = *(const f32x4*)(gpost + c); vgt[j] = *(const f32x4*)(mr + goff + c); }
            if (has_next) { vgq[j] = *(const f32x4*)(gpre + c); vsh[j] = *(const f32x4*)(ms + soff + c); vsc[j] = *(const f32x4*)(ms + soff + 1024 + c); } }
        if (first) {
            if (m >= MCTX) {
                const int t = (m - MCTX) & 2047; const float prow = (float)(t >> 6), pcol = (float)(t & 63);
                f32x4 om;
#pragma unroll
                for (int e = 0; e < 4; ++e) om[e] = exp2f(-(float)(lane * 4 + e) * (13.287712379549449f / 256.0f));
#pragma unroll
                for (int j = 0; j < 4; ++j) {
#pragma unroll
                    for (int e = 0; e < 4; ++e) { const float a = (j < 2 ? prow : pcol) * om[e]; x[j][e] += (j & 1) ? cosf(a) : sinf(a); } }
            }
        } else {
            float ss = 0.f;
#pragma unroll
            for (int j = 0; j < 4; ++j) { const float a = bflo(ov[j].x), b = bfhi(ov[j].x), c = bflo(ov[j].y), d = bfhi(ov[j].y); ss += (a * a + b * b) + (c * c + d * d); }
            const float rs = rsqrtf(wave_sum(ss, lane) * (1.0f / DM) + EPSF);
#pragma unroll
            for (int j = 0; j < 4; ++j) { f32x4 o4 = (f32x4){bflo(ov[j].x), bfhi(ov[j].x), bflo(ov[j].y), bfhi(ov[j].y)};
                x[j] += vgt[j] * (o4 * (rs * gscale) * vgp[j]); }
        }
        if (has_next) {
#pragma unroll
            for (int j = 0; j < 4; ++j) { u32x2 w; w.x = pk2(x[j][0], x[j][1]); w.y = pk2(x[j][2], x[j][3]); *(u32x2*)(XB + (size_t)m * DM + lane * 4 + 256 * j) = w; }
            float ss = 0.f;
#pragma unroll
            for (int j = 0; j < 4; ++j) ss += (x[j][0] * x[j][0] + x[j][1] * x[j][1]) + (x[j][2] * x[j][2] + x[j][3] * x[j][3]);
            const float rs = rsqrtf(wave_sum(ss, lane) * (1.0f / DM) + EPSF);
#pragma unroll
            for (int j = 0; j < 4; ++j) { const f32x4 h4 = (x[j] * rs * vgq[j]) * (vsc[j] + 1.0f) + vsh[j];
                u32x2 w; w.x = pk2(h4[0], h4[1]); w.y = pk2(h4[2], h4[3]);
                *(u32x2*)(H + (size_t)m * DM + lane * 4 + 256 * j) = w; }
        } else {
            float* dst = (m < MT / 2) ? P.out + (size_t)m * DM : TMP + (size_t)(m - MT / 2) * DM;
#pragma unroll
            for (int j = 0; j < 4; ++j) *(f32x4*)(dst + lane * 4 + 256 * j) = x[j];
        }
    }
}
__device__ __forceinline__ void phase_copy_tail(int wid0, const Params& P) {
    const int tid = tid_fresh(wid0);
    const f32x4* src = (const f32x4*)(P.ws + WS_BIG); f32x4* dst = (f32x4*)(P.out + XB_OFF_FLOATS);
    const size_t n = (size_t)(MT / 2) * DM / 4;
    for (size_t i = (size_t)bid_fresh() * NTHR + tid; i < n; i += (size_t)grid_fresh() * NTHR) dst[i] = src[i];
}

using pg8::Unit;
template <int ACT  > struct EpiBf16 {
    bf16* O; int ldc; float* AB;
    bf16* HALO;
    __device__ __forceinline__ void operator()(const f32x4 (&acc)[2][2][4][2], const Unit& u, int wr, int wc, int fr, int fq) const {
        const int row0 = u.pm * 256 + wr * 64 + fr, col0 = u.pn * 256 + wc * 32 + 8 * fq;
        if (AB && u.pn * 256 >= ldc) {
            if (wc == 0 && fq < 2) {
#pragma unroll
                for (int ai = 0; ai < 2; ++ai)
#pragma unroll
                    for (int m = 0; m < 4; ++m) { float* p = AB + (size_t)(row0 + ai * 128 + m * 16) * 16 + 8 * fq; *(f32x4*)p = acc[ai][0][m][0]; *(f32x4*)(p + 4) = acc[ai][0][m][1]; }
            }
            return;
        }
#pragma unroll
        for (int ai = 0; ai < 2; ++ai)
#pragma unroll
            for (int m = 0; m < 4; ++m) { bf16* rowp = O + (size_t)(row0 + ai * 128 + m * 16) * ldc + col0;
#pragma unroll
                for (int bj = 0; bj < 2; ++bj) { f32x4 v0 = acc[ai][bj][m][0], v1 = acc[ai][bj][m][1];
                    if (ACT == 1) {
#pragma unroll
                        for (int j = 0; j < 4; ++j) { const float a = fmaxf(v0[j], 0.f), b = fmaxf(v1[j], 0.f); v0[j] = a * a; v1[j] = b * b; } }
                    u32x4 w; w.x = pk2(v0[0], v0[1]); w.y = pk2(v0[2], v0[3]); w.z = pk2(v1[0], v1[1]); w.w = pk2(v1[2], v1[3]);
                    *(u32x4*)(rowp + bj * 128) = w;
                    if (ACT == 0 && HALO && u.pn >= 4 && u.pn < 10 && ((m == 3 && fr == 15) || (m == 0 && fr < 2))) {
                        const int r = row0 + ai * 128 + m * 16; const int which = (m == 3) ? 0 : 1 + fr;
                        *(u32x4*)(HALO + ((size_t)(r >> 6) * 3 + which) * 1536 + (col0 + bj * 128 - 1024)) = w; } } }
    }
};
struct EpiSplit {
    bf16* O0; long stride;
    __device__ __forceinline__ void operator()(const f32x4 (&acc)[2][2][4][2], const Unit& u, int wr, int wc, int fr, int fq) const {
        const int row0 = u.pm * 256 + wr * 64 + fr, col0 = (u.pn >> 1) * 256 + wc * 32 + 8 * fq; bf16* O = O0 + (long)(u.pn & 1) * stride;
#pragma unroll
        for (int ai = 0; ai < 2; ++ai)
#pragma unroll
            for (int m = 0; m < 4; ++m) { bf16* rowp = O + (size_t)(row0 + ai * 128 + m * 16) * DM + col0;
#pragma unroll
                for (int bj = 0; bj < 2; ++bj) { const f32x4 v0 = acc[ai][bj][m][0], v1 = acc[ai][bj][m][1];
                    u32x4 w; w.x = pk2(v0[0], v0[1]); w.y = pk2(v0[2], v0[3]); w.z = pk2(v1[0], v1[1]); w.w = pk2(v1[2], v1[3]);
                    *(u32x4*)(rowp + bj * 128) = w; } }
    }
};
struct EpiGates {
    unsigned* G; const bf16* X; const float* br; const float* bi; const float* lam;
    __device__ __forceinline__ void operator()(const f32x4 (&acc)[2][2][4][2], const Unit& u, int wr, int wc, int fr, int fq) const {
        const int row0 = u.pm * 256 + wr * 64 + fr, ch0 = u.pn * 128 + wc * 32 + 8 * fq;
#pragma unroll
        for (int n = 0; n < 2; ++n) {
            const f32x4 vbr = *(const f32x4*)(br + ch0 + 4 * n), vbi = *(const f32x4*)(bi + ch0 + 4 * n), l4 = *(const f32x4*)(lam + ch0 + 4 * n);
            f32x4 vsp;
#pragma unroll
            for (int e = 0; e < 4; ++e) vsp[e] = -8.0f * softplusf_(-l4[e]);
#pragma unroll
            for (int ai = 0; ai < 2; ++ai)
#pragma unroll
                for (int m = 0; m < 4; ++m) { const size_t row = (size_t)(row0 + ai * 128 + m * 16);
                    const u32x2 xv = *(const u32x2*)(X + row * DM + ch0 + 4 * n);
                    const float xs[4] = {bflo(xv.x), bfhi(xv.x), bflo(xv.y), bfhi(xv.y)};
                    u32x4 w;
#pragma unroll
                    for (int e = 0; e < 4; ++e) { const float r = sigmoidf_(acc[ai][0][m][n][e] + vbr[e]), ig = sigmoidf_(acc[ai][1][m][n][e] + vbi[e]);
                        const float la = r * vsp[e]; const float a_ = __expf(la); const float b = __builtin_amdgcn_sqrtf(fmaxf(1.0f - a_ * a_, 0.f)) * ig * xs[e];
                        w[e] = pk2(1.0f - a_, b); }
                    *(u32x4*)(G + row * DM + ch0 + 4 * n) = w; }
        }
    }
};
constexpr int S5_WLDS = 12800, BU_P = 132, HS_P = 136;
struct S5Dir { float ar, ai; bf16x8 Bf[8]; };
__device__ __forceinline__ void s5_dir_setup(const Params& P, int e, int d, int g, int lane, float& ar, float& ai, bf16x8 (&Bf)[8], bool needB) {
    const int quad = lane >> 4, l15 = lane & 15;
    const float dt = __expf(P.in[I_LOGDT][(e * 2 + d) * 32 + g]);
    const float lr = P.in[I_LAMRE][((e * 2 + d) * 32 + g) * 64 + lane], li = P.in[I_LAMIM][((e * 2 + d) * 32 + g) * 64 + lane];
    const float mag = expf(lr * dt); ar = mag * cosf(li * dt); ai = mag * sinf(li * dt);
    const float den = lr * lr + li * li;
    const float fr = ((ar - 1.0f) * lr + ai * li) / den, fi = (ai * lr - (ar - 1.0f) * li) / den;
    if (needB) {
#pragma unroll
        for (int nt = 0; nt < 8; ++nt) { const int col = 16 * nt + l15, p = col & 63;
            const float frp = shfl_i(fr, p), fip = shfl_i(fi, p);
            bf16x8 v = (bf16x8){0, 0, 0, 0, 0, 0, 0, 0};
            if (quad < 2) { const float* bre = P.in[I_BRE] + ((size_t)(e * 32 + g) * 64 + p) * 16 + quad * 8; const float* bim = P.in[I_BIM] + ((size_t)(e * 32 + g) * 64 + p) * 16 + quad * 8;
#pragma unroll
                for (int j = 0; j < 8; ++j) { const float br = bre[j], bi = bim[j]; const float val = (nt < 4) ? (frp * br - fip * bi) : (frp * bi + fip * br); v[j] = (short)f2bf(val); } }
            Bf[nt] = v; }
    }
}
__device__ __forceinline__ void s5_c_setup(const Params& P, int e, int g, int lane, bf16x8 (&Cf)[4]) {
    const int quad = lane >> 4, l15 = lane & 15;
#pragma unroll
    for (int ks = 0; ks < 4; ++ks) { const int col0 = 32 * ks + quad * 8; const bool im = col0 >= 64;
        const float* src = (im ? P.in[I_CIM] : P.in[I_CRE]) + ((size_t)(e * 32 + g) * 16 + l15) * 64 + (col0 & 63);
        bf16x8 v;
#pragma unroll
        for (int j = 0; j < 8; ++j) v[j] = (short)f2bf(im ? -src[j] : src[j]);
        Cf[ks] = v; }
}
__device__ __forceinline__ void s5_scan_seg(const Params& P, LAS unsigned char* wl, int lane, int d, int g, int m0, float ar, float ai, const bf16x8 (&Bf)[8], const bf16x8 (&Cf)[4],
                                            float& hr, float& hi, int mode, int ymode, const bf16* proj, float* ybuf, bf16* mixout, float dsk, int dry = 0) {
    const int quad = lane >> 4, l15 = lane & 15;
    LAS float* BU = (LAS float*)wl; LAS bf16* HS = (LAS bf16*)(wl + 8448);
    const int ch = g * 16 + l15;
    bf16x8 a_next = (bf16x8){0, 0, 0, 0, 0, 0, 0, 0};
    if (mode == 0 && quad < 2) { const int blk0 = d ? 15 : 0; const int tt = d ? 15 - l15 : l15; a_next = *(const bf16x8*)(proj + (size_t)(m0 + 16 * blk0 + tt) * NPROJ_E + g * 16 + quad * 8); }
    for (int bi_ = 0; bi_ < 16; ++bi_) {
        const int blk = d ? 15 - bi_ : bi_;
        const int mb = m0 + 16 * blk;
        const bf16x8 a = a_next;
        if (mode == 0 && quad < 2 && bi_ + 1 < 16) { const int blkn = d ? 14 - bi_ : bi_ + 1; const int tt = d ? 15 - l15 : l15; a_next = *(const bf16x8*)(proj + (size_t)(m0 + 16 * blkn + tt) * NPROJ_E + g * 16 + quad * 8); }
        float pre[4], zz[4];
#pragma unroll
        for (int jj = 0; jj < 4; ++jj) { const int row = quad * 4 + jj; const int tt = d ? 15 - row : row; const size_t m = (size_t)(mb + tt);
            pre[jj] = (ymode == 0) ? dsk * bf2f(proj[m * NPROJ_E + ch]) : ybuf[m * 512 + ch];
            zz[jj] = (ymode == 2) ? bf2f(proj[m * NPROJ_E + 512 + ch]) : 0.f; }
        if (mode == 0) {
#pragma unroll
            for (int nt = 0; nt < 8; ++nt) { f32x4 acc = mfma16(a, Bf[nt], (f32x4){0.f, 0.f, 0.f, 0.f});
#pragma unroll
                for (int jj = 0; jj < 4; ++jj) BU[(quad * 4 + jj) * BU_P + 16 * nt + l15] = acc[jj]; }
            WAVE_SYNC();
        }
#pragma unroll
        for (int r = 0; r < 16; ++r) {
            float br = 0.f, bim = 0.f;
            if (mode == 0) { br = BU[r * BU_P + lane]; bim = BU[r * BU_P + 64 + lane]; }
            const float nr = ar * hr - ai * hi + br, ni = ar * hi + ai * hr + bim; hr = nr; hi = ni;
            HS[r * HS_P + lane] = (bf16)f2bf(hr); HS[r * HS_P + 64 + lane] = (bf16)f2bf(hi);
        }
        WAVE_SYNC();
        f32x4 y = (f32x4){0.f, 0.f, 0.f, 0.f};
#pragma unroll
        for (int ks = 0; ks < 4; ++ks) { const bf16x8 af = *(const LAS bf16x8*)(HS + l15 * HS_P + 32 * ks + quad * 8); y = mfma16(af, Cf[ks], y); }
#pragma unroll
        for (int jj = 0; jj < 4; ++jj) { const int row = quad * 4 + jj; const int tt = d ? 15 - row : row; const size_t m = (size_t)(mb + tt);
            const float v = y[jj] + pre[jj];
            if (!dry) { if (ymode != 2) ybuf[m * 512 + ch] = v;
            else mixout[m * DM + ch] = (bf16)f2bf(geluf_(v) * sigmoidf_(zz[jj])); }
        }
        WAVE_SYNC();
    }
}
__device__ __forceinline__ void s5_task_main(const Params& P, LAS unsigned char* wl, int lane, int e, int sub, int g) {
    const bf16* proj = (const bf16*)(P.ws + WS_BIG); float* ybuf = (float*)(P.ws + WS_YBUF); bf16* mixout = (bf16*)(P.ws + WS_MIX);
    const bool lat = sub >= 32; const int q = sub - 32, b = lat ? (q >> 3) : sub, seg = lat ? (q & 7) : 0;
    const int m0 = lat ? MCTX + b * LLAT + seg * 256 : sub * 256;
    bf16x8 Cf[4]; s5_c_setup(P, e, g, lane, Cf);
    const float dsk = P.in[I_S5D][e * 512 + g * 16 + (lane & 15)];
#pragma unroll 1
    for (int d = 0; d < 2; ++d) {
        float ar, ai; bf16x8 Bf[8]; s5_dir_setup(P, e, d, g, lane, ar, ai, Bf, true);
        float hr = 0.f, hi = 0.f;
        if (lat && ((d == 0 && seg == 0) || (d == 1 && seg == 7))) { const size_t si = ((((size_t)b * 2 + e) * 2 + d) * 32 + g) * 64 + lane; hr = P.in[I_S5RE][si]; hi = P.in[I_S5IM][si]; }
        const int ymode = d == 0 ? 0 : (lat ? 1 : 2);
        s5_scan_seg(P, wl, lane, d, g, m0, ar, ai, Bf, Cf, hr, hi, 0, ymode, proj, ybuf, mixout, dsk);
        if (!lat) { const size_t si = ((((size_t)b * 2 + e) * 2 + d) * 32 + g) * 64 + lane; P.out[OUT_S5RE + si] = hr; P.out[OUT_S5IM + si] = hi; }
        else { float* F = (float*)(P.ws + WS_S5F) + ((((size_t)d * 64 + q) * 32 + g) * 64 + lane) * 2; F[0] = hr; F[1] = hi; }
    }
}
__device__ __forceinline__ void s5_task_corr(const Params& P, LAS unsigned char* wl, int lane, int e, int q, int g, int dry = 0) {
    const bf16* proj = (const bf16*)(P.ws + WS_BIG); float* ybuf = (float*)(P.ws + WS_YBUF); bf16* mixout = (bf16*)(P.ws + WS_MIX);
    const int b = q >> 3, seg = q & 7, m0 = MCTX + b * LLAT + seg * 256;
    bf16x8 Cf[4]; s5_c_setup(P, e, g, lane, Cf);
    bf16x8 Bf[8];
#pragma unroll
    for (int i = 0; i < 8; ++i) Bf[i] = (bf16x8){0, 0, 0, 0, 0, 0, 0, 0};
    const float* Fb = (const float*)(P.ws + WS_S5F);
#pragma unroll 1
    for (int d = 0; d < 2; ++d) {
        float ar, ai; s5_dir_setup(P, e, d, g, lane, ar, ai, Bf, false);
        float pr = ar, pi = ai;
#pragma unroll
        for (int i = 0; i < 8; ++i) { const float nr = pr * pr - pi * pi, ni = 2.0f * pr * pi; pr = nr; pi = ni; }
        float hr = 0.f, hi = 0.f;
        const int cnt = d == 0 ? seg : 7 - seg;
        for (int i = 0; i < cnt; ++i) { const int sj = d == 0 ? i : 7 - i; const float* F = Fb + ((((size_t)d * 64 + b * 8 + sj) * 32 + g) * 64 + lane) * 2;
            const float nr = pr * hr - pi * hi + F[0], ni = pr * hi + pi * hr + F[1]; hr = nr; hi = ni; }
        const int ym = (d == 1 || seg == 7) ? 2 : 1;
        if (cnt > 0) s5_scan_seg(P, wl, lane, d, g, m0, ar, ai, Bf, Cf, hr, hi, 1, ym, proj, ybuf, mixout, 0.f, dry);
    }
}

#ifndef REP_A
#define REP_A 1
#endif
#ifndef REP_B
#define REP_B 1
#endif
#ifndef REP_C
#define REP_C 1
#endif
__device__ __forceinline__ void phase_conv_even(int wid0, const Params& P, int e, int dry = 0) {
    const int tid = tid_fresh(wid0), lane = tid & 63, wave = tid >> 6;
    const int gw = bid_fresh() * NWAVES + wave, NGW = grid_fresh() * NWAVES;
    bf16* proj = (bf16*)(P.ws + WS_BIG); const bf16* HALO = (const bf16*)(P.ws + WS_HALO);
    for (int it = gw; it < 384 * 24; it += NGW) {
        const int c = it / 24, cgp = it % 24, ccol = cgp * 64 + lane;
        const int r0 = c * 64;
        const bool lat = r0 >= MCTX; const int t0 = lat ? ((r0 - MCTX) & 2047) : (r0 & 255); const int L = lat ? LLAT : LCTX;
        bf16* base = proj + (size_t)r0 * NPROJ_E + 1024 + ccol;
        bf16 x[67];
#pragma unroll
        for (int i = 0; i < 64; ++i) x[i + 1] = base[(size_t)i * NPROJ_E];
        x[0] = (t0 > 0) ? HALO[((size_t)(c - 1) * 3 + 0) * 1536 + ccol] : (bf16)0;
        x[65] = (t0 + 64 < L) ? HALO[((size_t)(c + 1) * 3 + 1) * 1536 + ccol] : (bf16)0;
        x[66] = (t0 + 64 < L) ? HALO[((size_t)(c + 1) * 3 + 2) * 1536 + ccol] : (bf16)0;
        const float* cw = P.in[I_GCONVW] + (size_t)e * 4 * 1536 + ccol; const float w0 = cw[0], w1 = cw[1536], w2 = cw[3072], w3 = cw[4608], cb = P.in[I_GCONVB][e * 1536 + ccol];
#pragma unroll
        for (int i = 0; i < 64; ++i) { const float v = cb + w0 * bf2f(x[i]) + w1 * bf2f(x[i + 1]) + w2 * bf2f(x[i + 2]) + w3 * bf2f(x[i + 3]);
            if (!dry) base[(size_t)i * NPROJ_E] = (bf16)f2bf(siluf_(v)); }
    }
}
#define LDS_BARRIER() do { asm volatile("s_waitcnt lgkmcnt(0)" ::: "memory"); __builtin_amdgcn_s_barrier(); asm volatile("" ::: "memory"); } while (0)
constexpr int G_Q = 0, G_K = 17408, G_V = 34816, G_KT = 52224, G_LM = 70656, G_QK = 89088, G_ST = 98304, G_SM = 133120;
constexpr int P128 = 136, P64 = 72, LMP = 68;
__device__ __forceinline__ bf16x8 ld_split8(const LAS bf16* p) {
    const u32x2 a = *(const LAS u32x2*)p, b = *(const LAS u32x2*)(p + 16);
    return __builtin_bit_cast(bf16x8, (u32x4){a.x, a.y, b.x, b.y});
}
__device__ __forceinline__ bf16x8 pack_acc2(const f32x4& a, const f32x4& b) { return __builtin_bit_cast(bf16x8, (u32x4){pk2(a[0], a[1]), pk2(a[2], a[3]), pk2(b[0], b[1]), pk2(b[2], b[3])}); }
__device__ __forceinline__ void gdn_chain(int wid0, const Params& P, LAS unsigned char* lds, int e, int s, int hd, int dir) {
    const int tid = tid_fresh(wid0), lane = tid & 63, w = __builtin_amdgcn_readfirstlane(tid >> 6), quad = lane >> 4, l15 = lane & 15;
    const bool lat = s >= 32; const int b = lat ? s - 32 : s; const int L = lat ? LLAT : LCTX; const int m0 = lat ? MCTX + b * LLAT : s * LCTX;
    const bf16* proj = (const bf16*)(P.ws + WS_BIG); const float* AB = (const float*)(P.ws + WS_AB);
    bf16* Odir = (bf16*)(P.ws + WS_H) + (size_t)dir * MT * 512;
    int zv; asm volatile("v_mov_b32 %0, 0" : "=v"(zv));
    lds += zv;
    LAS bf16* Qs = (LAS bf16*)(lds + G_Q); LAS bf16* Ks = (LAS bf16*)(lds + G_K); LAS bf16* Vs = (LAS bf16*)(lds + G_V); LAS bf16* KT = (LAS bf16*)(lds + G_KT);
    LAS float* Lm = (LAS float*)(lds + G_LM); LAS bf16* VNT = (LAS bf16*)(lds + G_LM); LAS bf16* QKs = (LAS bf16*)(lds + G_QK); LAS bf16* ST = (LAS bf16*)(lds + G_ST);
    LAS bf16* TM = (LAS bf16*)(lds + G_ST); LAS bf16* TT = TM + 64 * P64; LAS bf16* LR = TT + 64 * P64;
    LAS float* rq = (LAS float*)(lds + G_SM); LAS float* rk = rq + 64; LAS float* gcs = rq + 128; LAS float* betas = rq + 192; LAS float* egs = rq + 256; LAS float* kes = rq + 320;
    f32x4 Sacc[8];
    const size_t sbase = ((((size_t)b * 2 + e) * 2 + dir) * 4 + hd) * 16384;
#pragma unroll
    for (int mt = 0; mt < 8; ++mt) Sacc[mt] = (f32x4){0.f, 0.f, 0.f, 0.f};
    if (lat) { const float* sp = P.in[I_SDELTA] + sbase + (size_t)(quad * 4) * 128 + 16 * w + l15;
#pragma unroll
        for (int mt = 0; mt < 8; ++mt)
#pragma unroll
            for (int jj = 0; jj < 4; ++jj) Sacc[mt][jj] = sp[(16 * mt + jj) * 128]; }
    for (int i = tid; i < 2 * 64 * P64 / 2; i += NTHR) ((LAS unsigned*)TM)[i] = 0u;
    const float alog_e = __expf(P.in[I_GALOG][(e * 2 + dir) * 4 + hd]), dtb = P.in[I_GDTB][(e * 2 + dir) * 4 + hd];
    const int nchunk = L / 64;
    u32x4 xr[6]; float ab_a = 0.f, ab_b = 0.f;
#define GDN_LOAD(ci_) do { const int tid_ = tid_fresh(wid0); const int c0_ = dir ? L - 64 * ((ci_) + 1) : 64 * (ci_); \
        _Pragma("unroll") for (int k = 0; k < 6; ++k) { const int p_ = tid_ + 512 * k, part_ = p_ >> 10, row_ = (p_ & 1023) >> 4, pc_ = p_ & 15; \
            xr[k] = *(const u32x4*)(proj + (size_t)(m0 + c0_ + row_) * NPROJ_E + 1024 + part_ * 512 + hd * 128 + pc_ * 8); } \
        if (w == 0) { const int ln_ = tid_ & 63; const size_t m_ = (size_t)(m0 + c0_ + (dir ? 63 - ln_ : ln_)); ab_a = AB[m_ * 16 + dir * 4 + hd]; ab_b = AB[m_ * 16 + 8 + dir * 4 + hd]; } } while (0)
    GDN_LOAD(0);
#pragma unroll 1
    for (int ci = 0; ci < nchunk; ++ci) {
        const int tid = tid_fresh(wid0), lane = tid & 63, quad = lane >> 4, l15 = lane & 15;
        const int c0 = dir ? L - 64 * (ci + 1) : 64 * ci;
        LDS_BARRIER();
#ifndef NO_A
        const float cur_a = ab_a, cur_b = ab_b;
#pragma unroll
        for (int k = 0; k < 6; ++k) { const int p_ = tid + 512 * k, part_ = p_ >> 10, row_ = (p_ & 1023) >> 4, pc_ = p_ & 15;
            LAS bf16* dst = part_ == 0 ? Qs : (part_ == 1 ? Ks : Vs);
            *(LAS u32x4*)(dst + (dir ? 63 - row_ : row_) * P128 + pc_ * 8) = xr[k]; }
        if (ci + 1 < nchunk) GDN_LOAD(ci + 1);
#endif
        LDS_BARRIER();
#pragma unroll 1
        for (int repB = 0; repB < REP_B; ++repB)
        { const int rowid = tid >> 2, part = tid & 3; LAS bf16* src = (rowid < 64 ? Qs : Ks) + (rowid & 63) * P128 + part * 32;
          float ss = 0.f;
#pragma unroll
          for (int i = 0; i < 4; ++i) { const u32x4 v = *(const LAS u32x4*)(src + 8 * i);
#pragma unroll
              for (int j = 0; j < 4; ++j) { const float a = bflo(v[j]), c = bfhi(v[j]); ss += a * a + c * c; } }
          ss += shfl_i(ss, lane ^ 1); ss += shfl_i(ss, lane ^ 2);
          if (part == 0) { if (rowid < 64) rq[rowid] = rsqrtf(ss + EPSF) * 0.08838834764831845f; else rk[rowid - 64] = rsqrtf(ss + EPSF); }
          if (w == 0) { const int t = c0 + (dir ? 63 - lane : lane); const size_t m = (size_t)(m0 + t);
              const float araw = cur_a, braw = cur_b;
              const float gg = -alog_e * softplusf_(araw + dtb);
              float gc = gg;
#pragma unroll
              for (int o = 1; o < 64; o <<= 1) { const float t2 = shfl_i(gc, (lane - o) & 63); if (lane >= o) gc += t2; }
              const float glast = shfl_i(gc, 63);
              gcs[lane] = gc; betas[lane] = sigmoidf_(braw); egs[lane] = __expf(gc); kes[lane] = __expf(glast - gc);
              if (lane == 0) rq[384] = __expf(glast); } }
        LDS_BARRIER();
#ifndef NO_C
#pragma unroll 1
        for (int repC = 0; repC < REP_C; ++repC)
        { const int mt = w & 3; const bool isq = w >= 4; LAS bf16* src = isq ? Qs : Ks;
          bf16x8 a[4];
#pragma unroll
          for (int ks = 0; ks < 4; ++ks) a[ks] = *(const LAS bf16x8*)(src + (16 * mt + l15) * P128 + 32 * ks + quad * 8);
#pragma unroll 1
          for (int nt = 0; nt < 4; ++nt) { f32x4 acc = (f32x4){0.f, 0.f, 0.f, 0.f};
#pragma unroll
              for (int ks = 0; ks < 4; ++ks) { const bf16x8 bb = *(const LAS bf16x8*)(Ks + (16 * nt + l15) * P128 + 32 * ks + quad * 8); acc = mfma16(a[ks], bb, acc); }
              const int j = 16 * nt + l15; const float rkj = rk[j], gcj = gcs[j];
              f32x4 lv;
#pragma unroll
              for (int jj = 0; jj < 4; ++jj) { const int i = 16 * mt + quad * 4 + jj; const float dec = __expf(fminf(gcs[i] - gcj, 0.f));
                  lv[jj] = (i > j) ? acc[jj] * rk[i] * rkj * betas[i] * dec : 0.f;
                  if (isq) QKs[i * P64 + j] = (bf16)f2bf((i >= j) ? acc[jj] * rq[i] * rkj * dec : 0.f); }
              if (!isq) { *(LAS f32x4*)(Lm + j * LMP + 16 * mt + quad * 4) = lv;
#pragma unroll
                  for (int jj = 0; jj < 4; ++jj) LR[(16 * mt + quad * 4 + jj) * P64 + j] = (bf16)f2bf(nt < mt ? lv[jj] : 0.f); } }
          const int dd = tid & 127, tq = tid >> 7;
          unsigned pw[8];
#pragma unroll
          for (int n = 0; n < 16; n += 2) { const int i0 = tq * 16 + n; const float v0 = bf2f(Ks[i0 * P128 + dd]) * rk[i0] * kes[i0], v1 = bf2f(Ks[(i0 + 1) * P128 + dd]) * rk[i0 + 1] * kes[i0 + 1]; pw[n >> 1] = pk2(v0, v1); }
          *(LAS u32x4*)(KT + dd * P64 + tq * 16) = (u32x4){pw[0], pw[1], pw[2], pw[3]};
          *(LAS u32x4*)(KT + dd * P64 + tq * 16 + 8) = (u32x4){pw[4], pw[5], pw[6], pw[7]}; }
#endif
        LDS_BARRIER();
        { const int i = tid >> 3, c0k = (tid & 7) * 16; const float sc = rk[i] * betas[i] * egs[i];
#pragma unroll
          for (int h2 = 0; h2 < 2; ++h2) { u32x4 v = *(LAS u32x4*)(Ks + i * P128 + c0k + 8 * h2);
#pragma unroll
              for (int q = 0; q < 4; ++q) v[q] = pk2(bflo(v[q]) * sc, bfhi(v[q]) * sc);
              *(LAS u32x4*)(Ks + i * P128 + c0k + 8 * h2) = v; } }
        if (w == 0) { const int bb = lane >> 4, c = lane & 15;
            float x[16];
#pragma unroll
            for (int r = 0; r < 16; ++r) x[r] = (r == c) ? 1.f : 0.f;
#pragma unroll
            for (int j = 0; j < 15; ++j) {
#pragma unroll
                for (int q4 = j / 4; q4 < 4; ++q4) { const f32x4 l4 = *(const LAS f32x4*)(Lm + (16 * bb + j) * LMP + 16 * bb + 4 * q4);
#pragma unroll
                    for (int jx = 0; jx < 4; ++jx) if (4 * q4 + jx > j) x[4 * q4 + jx] -= l4[jx] * x[j]; } }
            unsigned pw[8];
#pragma unroll
            for (int r = 0; r < 16; r += 2) { pw[r >> 1] = pk2(x[r], x[r + 1]); TM[(16 * bb + r) * P64 + 16 * bb + c] = (bf16)(pw[r >> 1] & 0xffffu); TM[(16 * bb + r + 1) * P64 + 16 * bb + c] = (bf16)(pw[r >> 1] >> 16); }
            *(LAS u32x4*)(TT + (16 * bb + c) * P64 + 16 * bb) = (u32x4){pw[0], pw[1], pw[2], pw[3]};
            *(LAS u32x4*)(TT + (16 * bb + c) * P64 + 16 * bb + 8) = (u32x4){pw[4], pw[5], pw[6], pw[7]}; }
        LDS_BARRIER();
#pragma unroll 1
        for (int lev = 1; lev < 4; ++lev) {
            if (w < 4 - lev) { const int bj = w, bi = w + lev;
                f32x4 m = (f32x4){0.f, 0.f, 0.f, 0.f};
#pragma unroll
                for (int ks = 0; ks < 2; ++ks) { const bf16x8 a = *(const LAS bf16x8*)(LR + (16 * bi + l15) * P64 + 32 * ks + quad * 8), bq = *(const LAS bf16x8*)(TT + (16 * bj + l15) * P64 + 32 * ks + quad * 8); m = mfma16(a, bq, m); }
                const u32x2 tl = *(const LAS u32x2*)(TM + (16 * bi + l15) * P64 + 16 * bi + quad * 4);
                const bf16x8 a2 = __builtin_bit_cast(bf16x8, (u32x4){tl.x, tl.y, 0u, 0u}), b2 = __builtin_bit_cast(bf16x8, (u32x4){pk2(m[0], m[1]), pk2(m[2], m[3]), 0u, 0u});
                const f32x4 t = mfma16(a2, b2, (f32x4){0.f, 0.f, 0.f, 0.f});
                const unsigned p0 = pk2(-t[0], -t[1]), p1 = pk2(-t[2], -t[3]);
                TM[(16 * bi + quad * 4 + 0) * P64 + 16 * bj + l15] = (bf16)(p0 & 0xffffu); TM[(16 * bi + quad * 4 + 1) * P64 + 16 * bj + l15] = (bf16)(p0 >> 16);
                TM[(16 * bi + quad * 4 + 2) * P64 + 16 * bj + l15] = (bf16)(p1 & 0xffffu); TM[(16 * bi + quad * 4 + 3) * P64 + 16 * bj + l15] = (bf16)(p1 >> 16);
                *(LAS u32x2*)(TT + (16 * bj + l15) * P64 + 16 * bi + quad * 4) = (u32x2){p0, p1}; }
            LDS_BARRIER();
        }
#ifndef NO_EFG
        bf16x8 Bst[4];
#pragma unroll
        for (int ks = 0; ks < 4; ++ks) Bst[ks] = pack_acc2(Sacc[2 * ks], Sacc[2 * ks + 1]);
        f32x4 vn[4];
#pragma unroll
        for (int mt = 0; mt < 4; ++mt) { f32x4 acc = (f32x4){0.f, 0.f, 0.f, 0.f};
#pragma unroll
            for (int ks = 0; ks < 4; ++ks) { const bf16x8 a = ld_split8(Ks + (16 * mt + l15) * P128 + 32 * ks + quad * 4); acc = mfma16(a, Bst[ks], acc); }
#pragma unroll
            for (int jj = 0; jj < 4; ++jj) { const int i = 16 * mt + quad * 4 + jj; vn[mt][jj] = bf2f(Vs[i * P128 + 16 * w + l15]) * betas[i] - acc[jj]; } }
        bf16x8 Bvn[2];
#pragma unroll
        for (int k2 = 0; k2 < 2; ++k2) Bvn[k2] = pack_acc2(vn[2 * k2], vn[2 * k2 + 1]);
#pragma unroll
        for (int mt = 0; mt < 4; ++mt) { f32x4 acc = (f32x4){0.f, 0.f, 0.f, 0.f};
#pragma unroll
            for (int k2 = 0; k2 < 2; ++k2) { const bf16x8 a = ld_split8(TM + (16 * mt + l15) * P64 + 32 * k2 + quad * 4); acc = mfma16(a, Bvn[k2], acc); }
            vn[mt] = acc; }
#pragma unroll
        for (int k2 = 0; k2 < 2; ++k2) Bvn[k2] = pack_acc2(vn[2 * k2], vn[2 * k2 + 1]);
#pragma unroll 1
        for (int mt = 0; mt < 4; ++mt) { f32x4 acc = (f32x4){0.f, 0.f, 0.f, 0.f};
#pragma unroll
            for (int ks = 0; ks < 4; ++ks) { const bf16x8 a = ld_split8(Qs + (16 * mt + l15) * P128 + 32 * ks + quad * 4); acc = mfma16(a, Bst[ks], acc); }
#pragma unroll
            for (int jj = 0; jj < 4; ++jj) { const int i = 16 * mt + quad * 4 + jj; acc[jj] *= rq[i] * egs[i]; }
#pragma unroll
            for (int k2 = 0; k2 < 2; ++k2) { const bf16x8 a = ld_split8(QKs + (16 * mt + l15) * P64 + 32 * k2 + quad * 4); acc = mfma16(a, Bvn[k2], acc); }
#pragma unroll
            for (int jj = 0; jj < 4; ++jj) { const int i = 16 * mt + quad * 4 + jj; const int t = c0 + (dir ? 63 - i : i);
                Odir[(size_t)(m0 + t) * 512 + hd * 128 + 16 * w + l15] = (bf16)f2bf(acc[jj]); } }
        const float egl = rq[384];
#pragma unroll
        for (int mt = 0; mt < 8; ++mt) { f32x4 acc = Sacc[mt] * egl;
#pragma unroll
            for (int k2 = 0; k2 < 2; ++k2) { const bf16x8 a = ld_split8(KT + (16 * mt + l15) * P64 + 32 * k2 + quad * 4); acc = mfma16(a, Bvn[k2], acc); }
            Sacc[mt] = acc; }
#endif
        WAVE_SYNC();
    }
    if (!lat) { const int tid2 = tid_fresh(wid0), lane2 = tid2 & 63; float* dp = P.out + OUT_DELTA + sbase + (size_t)((lane2 >> 4) * 4) * 128 + 16 * w + (lane2 & 15);
#pragma unroll
        for (int mt = 0; mt < 8; ++mt)
#pragma unroll
            for (int jj = 0; jj < 4; ++jj) dp[(16 * mt + jj) * 128] = Sacc[mt][jj];
    }
    __syncthreads();
}

__device__ __forceinline__ void phase_mix_even(int wid0, const Params& P, LAS unsigned char* lds, int e, int mode = 3) {
    const int bid = bid_fresh(), G = grid_fresh();
    if (G == 256) {
        if (bid < 64) { const int s = 32 + (bid >> 3), hd = (bid >> 1) & 3, dir = bid & 1; if (mode & 1) gdn_chain(wid0, P, lds, e, s, hd, dir); }
        else { const int bb = bid - 64;
            if (mode & 1) for (int c = bb; c < 256; c += 192) { const int s = c >> 3, hd = (c >> 1) & 3, dir = c & 1; gdn_chain(wid0, P, lds, e, s, hd, dir); }
            if (mode & 2) { const int tid = tid_fresh(wid0), lane = tid & 63, wave = tid >> 6;
                for (int t = bb; t < 384; t += 192) { const int wt = t * 8 + wave; s5_task_main(P, lds + wave * S5_WLDS, lane, e, wt >> 5, wt & 31); } }
            if (mode == 3) { __syncthreads(); const int tid = tid_fresh(wid0), lane = tid & 63, wave = tid >> 6;
                for (int it = bb * NWAVES + wave; it < WITEMS_ODD; it += 192 * NWAVES) weight_item(P, (LAS float*)(lds + wave * 16384), 2 * e + 1, it, lane); } }
    } else {
        for (int c = bid; c < 320; c += G) { const int s = c < 64 ? 32 + (c >> 3) : ((c - 64) >> 3), hd = (c >> 1) & 3, dir = c & 1; gdn_chain(wid0, P, lds, e, s, hd, dir); }
        const int tid = tid_fresh(wid0), lane = tid & 63, wave = tid >> 6;
        for (int t = bid; t < 384; t += G) { const int wt = t * 8 + wave; s5_task_main(P, lds + wave * S5_WLDS, lane, e, wt >> 5, wt & 31); }
        __syncthreads();
        for (int it = bid * NWAVES + wave; it < WITEMS_ODD; it += G * NWAVES) weight_item(P, (LAS float*)(lds + wave * 16384), 2 * e + 1, it, lane);
    }
}
__device__ __forceinline__ void phase_fin_even(int wid0, const Params& P, LAS unsigned char* lds, int e, int dry = 0) {
    const int tid = tid_fresh(wid0), lane = tid & 63, wave = tid >> 6;
    const int gw = bid_fresh() * NWAVES + wave, NGW = grid_fresh() * NWAVES;
    for (int wt = gw; wt < 2048; wt += NGW) s5_task_corr(P, lds + wave * S5_WLDS, lane, e, wt >> 5, wt & 31, dry);
    const bf16* proj = (const bf16*)(P.ws + WS_BIG); const bf16* Of = (const bf16*)(P.ws + WS_H); const bf16* Ob = Of + (size_t)MT * 512; bf16* mixout = (bf16*)(P.ws + WS_MIX);
    float gnv[8];
#pragma unroll
    for (int j = 0; j < 8; ++j) gnv[j] = P.in[I_GONORM][e * 128 + (lane & 15) * 8 + j];
    for (int mb2 = gw; mb2 < MT; mb2 += 2 * NGW) {
        u32x4 a[2], bq[2], z[2];
#pragma unroll
        for (int u = 0; u < 2; ++u) { const int m = mb2 + u * NGW; if (m < MT) { a[u] = *(const u32x4*)(Of + (size_t)m * 512 + lane * 8); bq[u] = *(const u32x4*)(Ob + (size_t)m * 512 + lane * 8); z[u] = *(const u32x4*)(proj + (size_t)m * NPROJ_E + 2560 + lane * 8); } }
#pragma unroll
        for (int u = 0; u < 2; ++u) { const int m = mb2 + u * NGW; if (m < MT) {
            float o[8]; float ss = 0.f;
#pragma unroll
            for (int j = 0; j < 4; ++j) { o[2 * j] = bflo(a[u][j]) + bflo(bq[u][j]); o[2 * j + 1] = bfhi(a[u][j]) + bfhi(bq[u][j]); ss += o[2 * j] * o[2 * j] + o[2 * j + 1] * o[2 * j + 1]; }
            ss += shfl_i(ss, lane ^ 1); ss += shfl_i(ss, lane ^ 2); ss += shfl_i(ss, lane ^ 4); ss += shfl_i(ss, lane ^ 8);
            const float rs = rsqrtf(ss * (1.0f / 128.0f) + EPSF);
            unsigned pw[4];
#pragma unroll
            for (int j = 0; j < 4; ++j) { const float z0 = bflo(z[u][j]), z1 = bfhi(z[u][j]); pw[j] = pk2(o[2 * j] * rs * gnv[2 * j] * siluf_(z0), o[2 * j + 1] * rs * gnv[2 * j + 1] * siluf_(z1)); }
            if (!dry) *(u32x4*)(mixout + (size_t)m * DM + 512 + lane * 8) = (u32x4){pw[0], pw[1], pw[2], pw[3]}; } }
    }
}

__device__ __forceinline__ void phase_conv_odd(int wid0, const Params& P, int o) {
    const int tid = tid_fresh(wid0), lane = tid & 63, wave = tid >> 6;
    const int gw = bid_fresh() * NWAVES + wave, NGW = grid_fresh() * NWAVES;
    const bf16* proj = (const bf16*)(P.ws + WS_BIG); bf16* cx = (bf16*)(P.ws + WS_H);
    const float* cw = P.in[I_LCONVW] + (size_t)o * 4 * 1024; const float* cb = P.in[I_LCONVB] + o * 1024;
    float wv[2][4][8], bv[2][8];
#pragma unroll
    for (int h2 = 0; h2 < 2; ++h2) { const int ch = lane * 8 + 512 * h2;
#pragma unroll
        for (int j = 0; j < 8; ++j) { bv[h2][j] = cb[ch + j];
#pragma unroll
            for (int k = 0; k < 4; ++k) wv[h2][k][j] = cw[k * 1024 + ch + j]; } }
    for (int m = gw; m < MT; m += NGW) {
        const int t = m < MCTX ? (m & 255) : ((m - MCTX) & 2047); const int L = m < MCTX ? LCTX : LLAT;
        u32x4 xr[2][4];
#pragma unroll
        for (int k = 0; k < 4; ++k) { const int tt = t - 1 + k; const bool ok = (tt >= 0) && (tt < L); const size_t row = (size_t)(ok ? m - 1 + k : m);
#pragma unroll
            for (int h2 = 0; h2 < 2; ++h2) { const u32x4 v = *(const u32x4*)(proj + row * 2048 + lane * 8 + 512 * h2); xr[h2][k] = ok ? v : (u32x4){0u, 0u, 0u, 0u}; } }
#pragma unroll
        for (int h2 = 0; h2 < 2; ++h2) { const int ch = lane * 8 + 512 * h2;
            float acc[8];
#pragma unroll
            for (int j = 0; j < 8; ++j) acc[j] = bv[h2][j];
#pragma unroll
            for (int k = 0; k < 4; ++k)
#pragma unroll
                for (int j = 0; j < 4; ++j) { acc[2 * j] += wv[h2][k][2 * j] * bflo(xr[h2][k][j]); acc[2 * j + 1] += wv[h2][k][2 * j + 1] * bfhi(xr[h2][k][j]); }
            *(u32x4*)(cx + (size_t)m * DM + ch) = (u32x4){pk2(acc[0], acc[1]), pk2(acc[2], acc[3]), pk2(acc[4], acc[5]), pk2(acc[6], acc[7])}; }
    }
}
__device__ __forceinline__ void phase_lru_scan(int wid0, const Params& P, LAS unsigned char* lds, int o, int d) {
    const int tid = tid_fresh(wid0), lane = tid & 63, wave = tid >> 6;
    const int gw = bid_fresh() * NWAVES + wave, NGW = grid_fresh() * NWAVES;
    const unsigned* G = (const unsigned*)(P.ws + WS_GATES); const bf16* proj = (const bf16*)(P.ws + WS_BIG); bf16* mixout = (bf16*)(P.ws + WS_MIX);
    const int Gn = NGW / NWAVES, vw = wave * Gn + (gw / NWAVES);
    if (d == 0 && o == 0 && NGW > 640) {
        for (int it = vw - 640; it >= 0 && it < WITEMS_EVEN; it += NGW - 640) weight_item(P, (LAS float*)(lds + wave * 16384), 2, it, lane); }
    for (int task = vw; task < 640; task += NGW) {
        int s, cg_;
        if (task < 128) { s = 32 + (task >> 4); cg_ = task & 15; } else { s = (task - 128) >> 4; cg_ = (task - 128) & 15; }
        const bool lat = s >= 32; const int b = lat ? s - 32 : s; const int L = lat ? LLAT : LCTX; const int m0 = lat ? MCTX + b * LLAT : s * LCTX;
        const int ch = cg_ * 64 + lane;
        float h = lat ? P.in[I_SLRU][(((size_t)b * 2 + o) * 2 + d) * 1024 + ch] : 0.f;
        if (d == 0) {
            unsigned ga[32], gb[32];
#define LRU_LD0(dst, tt) _Pragma("unroll") for (int i = 0; i < 32; ++i) dst[i] = G[(size_t)(m0 + (tt) + i) * DM + ch]
#define LRU_CP0(src, tt) _Pragma("unroll") for (int i = 0; i < 32; ++i) { h = (1.0f - bflo(src[i])) * h + bfhi(src[i]); mixout[(size_t)(m0 + (tt) + i) * DM + ch] = (bf16)f2bf(h); }
            LRU_LD0(ga, 0);
            for (int t0 = 0; t0 < L; t0 += 64) {
                LRU_LD0(gb, t0 + 32);
                LRU_CP0(ga, t0);
                if (t0 + 64 < L) { LRU_LD0(ga, t0 + 64); }
                LRU_CP0(gb, t0 + 32);
            }
        } else {
            unsigned ga[16], gb[16]; bf16 pa[16], pb[16], ya[16], yb[16];
#define LRU_LD1(g_, p_, y_, tt) _Pragma("unroll") for (int i = 0; i < 16; ++i) { const size_t m = (size_t)(m0 + L - 1 - ((tt) + i)); g_[i] = G[m * DM + ch]; p_[i] = mixout[m * DM + ch]; y_[i] = proj[m * 2048 + 1024 + ch]; }
#define LRU_CP1(g_, p_, y_, tt) _Pragma("unroll") for (int i = 0; i < 16; ++i) { const size_t m = (size_t)(m0 + L - 1 - ((tt) + i)); \
                h = (1.0f - bflo(g_[i])) * h + bfhi(g_[i]); mixout[m * DM + ch] = (bf16)f2bf((bf2f(p_[i]) + h) * geluf_(bf2f(y_[i]))); }
            LRU_LD1(ga, pa, ya, 0);
            for (int t0 = 0; t0 < L; t0 += 32) {
                LRU_LD1(gb, pb, yb, t0 + 16);
                LRU_CP1(ga, pa, ya, t0);
                if (t0 + 32 < L) { LRU_LD1(ga, pa, ya, t0 + 32); }
                LRU_CP1(gb, pb, yb, t0 + 16);
            }
        }
        if (!lat) P.out[OUT_LRU + (((size_t)b * 2 + o) * 2 + d) * 1024 + ch] = h;
    }
}
#ifdef PROBE_DUP_GEMM
#define DUPG(x) GSYNC(); x
#else
#define DUPG(x)
#endif
typedef const __attribute__((address_space(4))) Params* KParams;
__device__ __forceinline__ Params load_params(KParams q) { Params r;
#pragma unroll
    for (int i = 0; i < 40; ++i) r.in[i] = q->in[i];
    r.out = q->out; r.ws = q->ws; return r; }
#define FRESH() const int G = grid_fresh(), bid = bid_fresh(); (void)G; (void)bid; KParams pk_ = (KParams)__builtin_amdgcn_kernarg_segment_ptr(); asm volatile("" : "+s"(pk_)); const Params P = load_params(pk_); unsigned char* ws = P.ws; \
    const float* mod = (const float*)(ws + WS_MOD); bf16* H = (bf16*)(ws + WS_H); bf16* BIG = (bf16*)(ws + WS_BIG); bf16* MIX = (bf16*)(ws + WS_MIX); (void)mod; (void)H; (void)BIG; (void)MIX;
#define GSYNC() do { KParams pb_ = (KParams)__builtin_amdgcn_kernarg_segment_ptr(); asm volatile("" : "+s"(pb_)); xcd_barrier(wid0, (unsigned*)(pb_->ws + WS_BAR), lds); } while (0)
__global__ void __launch_bounds__(NTHR, 2) fwd_kernel(Params Parg) {
    extern __shared__ __attribute__((aligned(16))) unsigned char lds_raw[];
    LAS unsigned char* lds = (LAS unsigned char*)lds_raw;
    cg::grid_group grid = cg::this_grid();
    const int wid0 = __builtin_amdgcn_readfirstlane(threadIdx.x >> 6);
    if (threadIdx.x < 4) ((LAS unsigned*)(lds + LDS_BARST))[threadIdx.x] = 0u;
    __syncthreads();
    if (threadIdx.x == 0) (void)xb_add((unsigned*)(Parg.ws + WS_BAR) + XB_XCNT(xb_xcc_id()), 1u);

    { FRESH(); phase_prologue(wid0, P, lds); }
    if (grid_fresh() == 0) grid.sync();
    GSYNC();
#ifdef PROBE_DUP_PRO
    { FRESH(); phase_prologue(wid0, P, lds); }
    GSYNC();
#endif
    { FRESH(); phase_modreduce(wid0, P); }
    GSYNC();
#ifdef PROBE_SYNC
#pragma unroll 1
    for (int i = 0; i < 40; ++i) GSYNC();
#endif
#pragma unroll 1
    for (int l = 0; l < 4; ++l) {
        { FRESH(); const float* modl = mod + (size_t)l * 9 * 6144;
        phase_rownorm(wid0, P, l == 0, MIX, modl - 9 * 6144, 5 * 1024, P.in[I_NMLPPOST] + (l > 0 ? (l - 1) * 1024 : 0), 1, P.in[I_NMIXPRE] + l * 1024, modl, 0, H); }
        GSYNC();
        const int eo = l >> 1;
        {
            FRESH();
            pg8::Gemm g; pg8::StaticOrder S; EpiBf16<0> E;
            if ((l & 1) == 0) { g = pg8::Gemm{H, (const bf16*)(ws + WS_WINE) + (size_t)eo * NB_E * 1024, MT, NB_E, 1024, 1024, 0, 0, 1024, 0}; E = EpiBf16<0>{BIG, NPROJ_E, (float*)(ws + WS_AB), (bf16*)(ws + WS_HALO)}; }
            else { g = pg8::Gemm{H, (const bf16*)(ws + WS_WINO) + (size_t)eo * 2048 * 1024, MT, 2048, 1024, 1024, 0, 0, 1024, 0}; E = EpiBf16<0>{BIG, 2048, nullptr, nullptr}; }
            S.init(g.M, g.N, G, bid);
            pg8::gemm_phase(wid0, lds, g, S, E); DUPG(pg8::gemm_phase(wid0, lds, g, S, E);)
        }
        GSYNC();
        if ((l & 1) == 0) {
            { FRESH(); phase_conv_even(wid0, P, eo); }
            GSYNC();
#ifdef PROBE_DRY_CONVE
            { FRESH(); phase_conv_even(wid0, P, eo, grid_fresh() > 0); }
            GSYNC();
#endif
#ifdef PROBE_DUP_MIX
#pragma unroll 1
            for (int rep = 0; rep < 2; ++rep) { { FRESH(); phase_mix_even(wid0, P, lds, eo, rep == 0 ? 3 : PROBE_DUP_MIX); } GSYNC(); }
#else
            { FRESH(); phase_mix_even(wid0, P, lds, eo); }
            GSYNC();
#endif
            { FRESH(); phase_fin_even(wid0, P, lds, eo); }
            GSYNC();
#ifdef PROBE_DRY_FIN
            { FRESH(); phase_fin_even(wid0, P, lds, eo, grid_fresh() > 0); }
            GSYNC();
#endif
        } else {
            { FRESH(); phase_conv_odd(wid0, P, eo); }
            GSYNC();
#ifdef PROBE_DUP_CONV
            { FRESH(); phase_conv_odd(wid0, P, eo); }
            GSYNC();
#endif
#pragma unroll 1
            for (int d = 0; d < 2; ++d) {
                { FRESH();
                pg8::Gemm g{H, (const bf16*)(ws + WS_WG) + (size_t)(eo * 2 + d) * 2048 * 256, MT, 2048, 256, 1024, 1, 1, 256, 0};
                EpiGates E{(unsigned*)(ws + WS_GATES), H, P.in[I_LBR] + (eo * 2 + d) * 1024, P.in[I_LBI] + (eo * 2 + d) * 1024, P.in[I_LLAM] + (eo * 2 + d) * 1024};
                pg8::StaticOrder S; S.init(g.M, g.N, G, bid);
                pg8::gemm_phase(wid0, lds, g, S, E); DUPG(pg8::gemm_phase(wid0, lds, g, S, E);) }
                GSYNC();
                { FRESH(); phase_lru_scan(wid0, P, lds, eo, d); }
#ifdef PROBE_DUP_LRU0
                if (d == 0) { GSYNC(); FRESH(); phase_lru_scan(wid0, P, lds, eo, d); }
#endif
                GSYNC();
            }
        }
        {
            FRESH();
            pg8::Gemm g{MIX, (const bf16*)(ws + ((l & 1) ? WS_WOUTO : WS_WOUTE)) + (size_t)eo * 1024 * 1024, MT, 1024, 1024, 1024, 0, 0, 1024, 0};
            EpiBf16<0> E{BIG, 1024, nullptr, nullptr}; pg8::StaticOrder S; S.init(g.M, g.N, G, bid);
            pg8::gemm_phase(wid0, lds, g, S, E); DUPG(pg8::gemm_phase(wid0, lds, g, S, E);)
        }
        GSYNC();
        { FRESH(); const float* modl = mod + (size_t)l * 9 * 6144;
        phase_rownorm(wid0, P, 0, BIG, modl, 2 * 1024, P.in[I_NMIXPOST] + l * 1024, 1, P.in[I_NMLPPRE] + l * 1024, modl, 3 * 1024, H); }
#ifdef PROBE_DUP_RN
        GSYNC();
        { FRESH(); const float* modl = mod + (size_t)l * 9 * 6144;
        phase_rownorm(wid0, P, 0, BIG, modl, 2 * 1024, P.in[I_NMIXPOST] + l * 1024, 1, P.in[I_NMLPPRE] + l * 1024, modl, 3 * 1024, H, 0.0f); }
#endif
        GSYNC();
        {
            FRESH();
            pg8::Gemm g{H, (const bf16*)(ws + WS_W1T) + (size_t)l * 4096 * 1024, MT, 4096, 1024, 1024, 0, 0, 1024, 0};
            EpiBf16<1> E{BIG, 4096, nullptr, nullptr}; pg8::StaticOrder S; S.init(g.M, g.N, G, bid);
            pg8::gemm_phase(wid0, lds, g, S, E); DUPG(pg8::gemm_phase(wid0, lds, g, S, E);)
        }
        GSYNC();
        {
            FRESH();
            pg8::Gemm g{BIG, (const bf16*)(ws + WS_W2T) + (size_t)l * 1024 * 4096, MT, 1024, 4096, 4096, 0, 0, 4096, 0};
            EpiBf16<0> E{MIX, 1024, nullptr, nullptr}; pg8::StaticOrder S; S.init(g.M, g.N, G, bid);
            pg8::gemm_phase(wid0, lds, g, S, E); DUPG(pg8::gemm_phase(wid0, lds, g, S, E);)
        }
        GSYNC();
    }
    { FRESH();
    phase_rownorm(wid0, P, 0, MIX, mod + (size_t)3 * 9 * 6144, 5 * 1024, P.in[I_NMLPPOST] + 3 * 1024, 0, P.in[I_NMIXPRE], mod, 0, H); }
    GSYNC();
    { FRESH(); phase_copy_tail(wid0, P); }
}

extern "C" void kernel_launch(void* const* d_in, const int* in_sizes, int n_in, void* d_out, int out_size, void* d_ws, size_t ws_size, hipStream_t stream) {
    static int grid = 0;
    if (grid == 0) {
        if (n_in != 40 || ws_size < WS_END) { fprintf(stderr, "kernel_launch: expected 40 inputs and >= %zu bytes of workspace (got %d, %zu)\n", (size_t)WS_END, n_in, ws_size); grid = -1; return; }
        int dev = 0, cus = 0, per_cu = 0;
        if (hipGetDevice(&dev) != hipSuccess || hipDeviceGetAttribute(&cus, hipDeviceAttributeMultiprocessorCount, dev) != hipSuccess) { grid = -1; return; }
        if (hipFuncSetAttribute((const void*)fwd_kernel, hipFuncAttributeMaxDynamicSharedMemorySize, LDS_BYTES) != hipSuccess) { fprintf(stderr, "kernel_launch: hipFuncSetAttribute failed\n"); grid = -1; return; }
        if (hipOccupancyMaxActiveBlocksPerMultiprocessor(&per_cu, (const void*)fwd_kernel, NTHR, LDS_BYTES) != hipSuccess || per_cu < 1) per_cu = 1;
        (void)hipGetLastError();
        grid = cus * per_cu; if (grid > 256) grid = 256;
    }
    if (grid < 0) return;
    (void)hipMemsetAsync((char*)d_ws + WS_BAR, 0, 16384, stream);
    Params p{};
    for (int i = 0; i < 40; ++i) p.in[i] = (const float*)d_in[i];
    p.out = (float*)d_out; p.ws = (unsigned char*)d_ws;
    void* args[] = {&p};
    hipError_t e = hipLaunchCooperativeKernel((const void*)fwd_kernel, dim3(grid), dim3(NTHR), args, LDS_BYTES, stream);
    if (e != hipSuccess) fprintf(stderr, "cooperative launch failed: %s (grid %d)\n", hipGetErrorString(e), grid);
}
```

```cpp
#include <hip/hip_runtime.h>
#include <hip/hip_cooperative_groups.h>
#include <cstdio>
#include <cstdint>
namespace cg = cooperative_groups;
__device__ __forceinline__ int bid_fresh() { int t = blockIdx.x; asm volatile("" : "+s"(t)); return t; }
__device__ __forceinline__ int grid_fresh() { int t = gridDim.x; asm volatile("" : "+s"(t)); return t; }
__device__ __forceinline__ int tid_fresh(int w) { asm volatile("" : "+s"(w)); int l; asm volatile("v_mbcnt_lo_u32_b32 %0, -1, 0\n\tv_mbcnt_hi_u32_b32 %0, -1, %0" : "=v"(l)); return w * 64 + l; }

namespace pg8 {
#define PG8_LAS __attribute__((address_space(3)))
typedef unsigned short bf16_t;
typedef short bf16x8 __attribute__((ext_vector_type(8)));
typedef float f32x4 __attribute__((ext_vector_type(4)));
typedef unsigned u32x4 __attribute__((ext_vector_type(4)));
typedef unsigned u32x2 __attribute__((ext_vector_type(2)));
constexpr int BM = 256, BK = 64, HALF = 128, HTB = HALF * BK * 2, STAGE_BYTES = 8 * HTB, NXCD = 8, WGM = 4;

__host__ __device__ __forceinline__ int lds_byte(int r, int c) { const int st = (r >> 4) * 2 + (c >> 5), rr = r & 15, cc = c & 31, ob = rr * 64 + cc * 2; return st * 1024 + (ob ^ (((ob >> 9) & 1) << 5)); }
__host__ __device__ __forceinline__ void stage_rc(int b, int& R, int& C) { const int st = b / 1024, sb = b % 1024, swz = sb ^ (((sb >> 9) & 1) << 5); R = (st >> 1) * 16 + swz / 64; C = (st & 1) * 32 + (swz % 64) / 2; }
__host__ __device__ __forceinline__ int perm32(int rho) { const int n = rho >> 4, i = rho & 15; return 8 * (i >> 2) + 4 * n + (i & 3); }

struct Unit { int pm, pn; };
struct Gemm { const bf16_t* A; const bf16_t* Bt; int M, N, K, lda, ablk, ashift, ldb, ksplit; };

struct StaticOrder {
    int nM, nN, nwg, G, c;
    __host__ __device__ void init(int M, int N, int G_, int c_) { nM = M / BM; nN = N / BM; nwg = nM * nN; G = G_; c = c_; }
    __host__ __device__ bool next(int i, Unit& u) const {
        const long L = (long)i * G + c; if (L >= nwg) return false;
        int wgid = (int)L; { const int q = nwg / NXCD, r = nwg % NXCD, xcd = wgid % NXCD, off = wgid / NXCD; wgid = (xcd < r ? xcd * (q + 1) : r * (q + 1) + (xcd - r) * q) + off; }
        const int nig = WGM * nN, gid = wgid / nig, fm = gid * WGM, gsz = (nM - fm) < WGM ? (nM - fm) : WGM;
        u.pm = fm + ((wgid % nig) % gsz); u.pn = (wgid % nig) / gsz; return true;
    }
};
__device__ __forceinline__ unsigned cvt_pk_bf16(float lo, float hi) { unsigned r; asm volatile("v_cvt_pk_bf16_f32 %0, %1, %2" : "=v"(r) : "v"(lo), "v"(hi)); return r; }

template <class Epi>
__device__ __forceinline__ void gemm_phase(int wid0, PG8_LAS unsigned char* lds, const Gemm g, const StaticOrder& S, const Epi& E) {
    const int tid = tid_fresh(wid0), wid = __builtin_amdgcn_readfirstlane(tid >> 6), lane = tid & 63, wr = wid >> 2, wc = wid & 3, fr = lane & 15, fq = lane >> 4;
    const int K = g.K, nt = K / BK, lda = g.lda, ldb = g.ldb;
    unsigned voffA[2], voffB[2];
#pragma unroll
    for (int i = 0; i < 2; ++i) { int R, C; stage_rc(tid * 16 + i * 8192, R, C); const int Rb = (R & ~31) + perm32(R & 31);
        voffA[i] = (unsigned)(R * lda + C) * 2u; voffB[i] = (unsigned)(Rb * ldb + C) * 2u; }
    const size_t kstep = (size_t)(BK * 2);
    const size_t hstepA = (size_t)HALF * lda * 2, hstepB = (size_t)HALF * ldb * 2;
    const size_t tstepA = 2 * hstepA, tstepB = 2 * hstepB;
    const unsigned ldsw = (unsigned)wid * 1024u;
    const int aoff = lds_byte(wr * 64 + fr, fq * 8), boff = lds_byte(wc * 32 + fr, fq * 8);
#define PG8_ACOL(pn) (g.ablk ? (size_t)((((pn) >> g.ashift) & 3) * 512) : (g.ksplit ? (size_t)((pn) & 1) * (size_t)K * 2 : (size_t)0))
#define PG8_BOFF(pn) (g.ksplit ? (size_t)((pn) >> 1) * tstepB + (size_t)((pn) & 1) * (size_t)K * 2 : (size_t)(pn) * tstepB)
#define PG8_SA(b, h) (((b) * 2 + (h)) * HTB)
#define PG8_SB(b, h) ((4 + (b) * 2 + (h)) * HTB)
#define PG8_STAGE(bufoff, gbase, voff) do { _Pragma("unroll") for (int _i = 0; _i < 2; ++_i) \
        __builtin_amdgcn_global_load_lds((const unsigned*)((const char*)(gbase) + (voff)[_i]), (PG8_LAS unsigned*)(lds + (bufoff) + ldsw + _i * 8192), 16, 0, 0); } while (0)
#define PG8_LDA(dst, b, h) do { _Pragma("unroll") for (int m = 0; m < 4; ++m) _Pragma("unroll") for (int k = 0; k < 2; ++k) dst[m][k] = *(const PG8_LAS bf16x8*)(lds + PG8_SA(b, h) + aoff + m * 2048 + k * 1024); } while (0)
#define PG8_LDB(dst, b, h) do { _Pragma("unroll") for (int n = 0; n < 2; ++n) _Pragma("unroll") for (int k = 0; k < 2; ++k) dst[n][k] = *(const PG8_LAS bf16x8*)(lds + PG8_SB(b, h) + boff + n * 2048 + k * 1024); } while (0)
#define PG8_MMA(ai, bj, At, Bt) do { __builtin_amdgcn_s_setprio(1); _Pragma("unroll") for (int m = 0; m < 4; ++m) _Pragma("unroll") for (int n = 0; n < 2; ++n) _Pragma("unroll") for (int k = 0; k < 2; ++k) \
        acc[ai][bj][m][n] = __builtin_amdgcn_mfma_f32_16x16x32_bf16(Bt[n][k], At[m][k], acc[ai][bj][m][n], 0, 0, 0); __builtin_amdgcn_s_setprio(0); } while (0)
#define PG8_WAIT_V(n) asm volatile("s_waitcnt vmcnt(" #n ")" ::: "memory")
#define PG8_WAIT_L(n) asm volatile("s_waitcnt lgkmcnt(" #n ")" ::: "memory")
#define PG8_BAR __builtin_amdgcn_s_barrier()
#define PG8_SCHED __builtin_amdgcn_sched_barrier(0)
    Unit cur, nxt; int ui = 0;
    if (!S.next(0, cur)) return;
    f32x4 acc[2][2][4][2];
#pragma unroll
    for (int a = 0; a < 2; ++a)
#pragma unroll
        for (int b = 0; b < 2; ++b)
#pragma unroll
            for (int m = 0; m < 4; ++m)
#pragma unroll
                for (int n = 0; n < 2; ++n) acc[a][b][m][n] = (f32x4){0.f, 0.f, 0.f, 0.f};
    bf16x8 At[4][2], B0[2][2], B1[2][2];
    const char* cA = (const char*)g.A + (size_t)cur.pm * tstepA + PG8_ACOL(cur.pn); const char* cB = (const char*)g.Bt + PG8_BOFF(cur.pn);
    PG8_STAGE(PG8_SB(0, 0), cB, voffB); PG8_STAGE(PG8_SA(0, 0), cA, voffA); PG8_STAGE(PG8_SB(0, 1), cB + hstepB, voffB); PG8_STAGE(PG8_SA(0, 1), cA + hstepA, voffA);
    if (wr == 1) PG8_BAR;
    PG8_WAIT_V(4); PG8_BAR;
    PG8_STAGE(PG8_SB(1, 0), cB + kstep, voffB); PG8_STAGE(PG8_SA(1, 0), cA + kstep, voffA); PG8_STAGE(PG8_SB(1, 1), cB + hstepB + kstep, voffB);
    PG8_WAIT_V(6); PG8_BAR;
    for (;;) {
        const bool has_next = S.next(ui + 1, nxt);
        const char* nA = has_next ? (const char*)g.A + (size_t)nxt.pm * tstepA + PG8_ACOL(nxt.pn) : cA; const char* nB = has_next ? (const char*)g.Bt + PG8_BOFF(nxt.pn) : cB;
        for (int t = 0; t < nt; t += 2) {
            const bool last = (t == nt - 2);
            const char* a1 = cA + (size_t)(t + 1) * kstep;
            const char* a2 = last ? nA : cA + (size_t)(t + 2) * kstep; const char* b2 = last ? nB : cB + (size_t)(t + 2) * kstep;
            const char* a3 = a2 + kstep; const char* b3 = b2 + kstep;
            PG8_LDB(B0, 0, 0); PG8_SCHED; PG8_LDA(At, 0, 0); PG8_STAGE(PG8_SA(1, 1), a1 + hstepA, voffA);
            PG8_WAIT_L(8); PG8_BAR; PG8_WAIT_L(0); PG8_MMA(0, 0, At, B0); PG8_BAR; PG8_SCHED;
            PG8_LDB(B1, 0, 1); PG8_STAGE(PG8_SB(0, 0), b2, voffB);
            PG8_BAR; PG8_WAIT_L(0); PG8_MMA(0, 1, At, B1); PG8_BAR;
            PG8_LDA(At, 0, 1); PG8_STAGE(PG8_SA(0, 0), a2, voffA);
            PG8_BAR; PG8_WAIT_L(0); PG8_MMA(1, 0, At, B0); PG8_BAR; PG8_SCHED;
            PG8_STAGE(PG8_SB(0, 1), b2 + hstepB, voffB);
            PG8_WAIT_V(6); PG8_BAR; PG8_MMA(1, 1, At, B1); PG8_BAR;
            PG8_LDB(B0, 1, 0); PG8_SCHED; PG8_LDA(At, 1, 0); PG8_STAGE(PG8_SA(0, 1), a2 + hstepA, voffA);
            PG8_WAIT_L(8); PG8_BAR; PG8_WAIT_L(0); PG8_MMA(0, 0, At, B0); PG8_BAR; PG8_SCHED;
            PG8_LDB(B1, 1, 1); PG8_STAGE(PG8_SB(1, 0), b3, voffB);
            PG8_BAR; PG8_WAIT_L(0); PG8_MMA(0, 1, At, B1); PG8_BAR;
            PG8_LDA(At, 1, 1); PG8_STAGE(PG8_SA(1, 0), a3, voffA);
            PG8_BAR; PG8_WAIT_L(0); PG8_MMA(1, 0, At, B0); PG8_BAR; PG8_SCHED;
            PG8_STAGE(PG8_SB(1, 1), b3 + hstepB, voffB);
            PG8_WAIT_V(6); PG8_BAR; PG8_MMA(1, 1, At, B1); PG8_BAR;
        }
        E(acc, cur, wr, wc, fr, fq);
        if (!has_next) break;
#pragma unroll
        for (int a = 0; a < 2; ++a)
#pragma unroll
            for (int b = 0; b < 2; ++b)
#pragma unroll
                for (int m = 0; m < 4; ++m)
#pragma unroll
                    for (int n = 0; n < 2; ++n) acc[a][b][m][n] = (f32x4){0.f, 0.f, 0.f, 0.f};
        cur = nxt; cA = nA; cB = nB; ++ui;
    }
    PG8_WAIT_V(0);
    if (wr == 0) PG8_BAR;
    PG8_BAR;
#undef PG8_ACOL
#undef PG8_BOFF
#undef PG8_SA
#undef PG8_SB
#undef PG8_STAGE
#undef PG8_LDA
#undef PG8_LDB
#undef PG8_MMA
#undef PG8_WAIT_V
#undef PG8_WAIT_L
#undef PG8_BAR
#undef PG8_SCHED
}
}
#define LAS __attribute__((address_space(3)))
typedef unsigned short bf16;
typedef short bf16x8 __attribute__((ext_vector_type(8)));
typedef float f32x4 __attribute__((ext_vector_type(4)));
typedef unsigned u32x4 __attribute__((ext_vector_type(4)));
typedef unsigned u32x2 __attribute__((ext_vector_type(2)));
constexpr int DM = 1024, MT = 24576, MCTX = 8192, LCTX = 256, LLAT = 2048, NWAVES = 8, NTHR = 512;
constexpr int NPROJ_E = 3072, NB_E = 3328, IN_EVEN_LD = 3088;
constexpr float EPSF = 1e-6f;
constexpr size_t MiB = 1u << 20;
constexpr size_t WS_MOD = 0, MOD_BYTES = 4 * 9 * 6144 * 4, WS_S5F = 1 * MiB, WS_AB = 3 * MiB, WS_W1T = 5 * MiB, WS_W2T = 37 * MiB, WS_WINE = 69 * MiB,
                 WS_WOUTE = 82 * MiB, WS_WINO = 86 * MiB, WS_WOUTO = 94 * MiB, WS_WG = 98 * MiB, WS_H = 102 * MiB, WS_BIG = 150 * MiB, WS_YBUF = 294 * MiB,
                 WS_GATES = 246 * MiB, WS_MIX = 342 * MiB, WS_HALO = 390 * MiB, WS_END = 390 * MiB + 384 * 3 * 1536 * 2;
constexpr int LDS_BYTES = 147456;
constexpr size_t OUT_S5RE = 25165824, OUT_S5IM = OUT_S5RE + 262144, OUT_DELTA = OUT_S5IM + 262144, OUT_LRU = OUT_DELTA + 8388608;

struct Params { const float* in[40]; float* out; unsigned char* ws; };
enum { I_XP = 0, I_XS, I_S5RE, I_S5IM, I_SDELTA, I_SLRU, I_C, I_CCTX, I_WADA, I_BADA, I_NMIXPRE, I_NMIXPOST, I_NMLPPRE, I_NMLPPOST, I_WMLPIN, I_WMLPOUT, I_WINE, I_WOUTE,
       I_LAMRE, I_LAMIM, I_LOGDT, I_BRE, I_BIM, I_CRE, I_CIM, I_S5D, I_GCONVW, I_GCONVB, I_GALOG, I_GDTB, I_GONORM, I_WINO, I_WOUTO, I_LCONVW, I_LCONVB, I_LWR, I_LBR, I_LWI, I_LBI, I_LLAM };

typedef __bf16 bf2_t __attribute__((ext_vector_type(2)));
typedef float f2_t __attribute__((ext_vector_type(2)));
__device__ __forceinline__ unsigned pk2(float lo, float hi) { const bf2_t v = __builtin_convertvector((f2_t){lo, hi}, bf2_t); return __builtin_bit_cast(unsigned, v); }
__device__ __forceinline__ unsigned f2bf(float f) { return pk2(f, f) & 0xffffu; }
__device__ __forceinline__ float bflo(unsigned w) { return __builtin_bit_cast(float, w << 16); }
__device__ __forceinline__ float bfhi(unsigned w) { return __builtin_bit_cast(float, w & 0xffff0000u); }
__device__ __forceinline__ float bf2f(bf16 b) { return __builtin_bit_cast(float, (unsigned)b << 16); }
__device__ __forceinline__ float sigmoidf_(float x) { return __builtin_amdgcn_rcpf(1.0f + __expf(-x)); }
__device__ __forceinline__ float siluf_(float x) { return x * sigmoidf_(x); }
__device__ __forceinline__ float softplusf_(float x) { return fmaxf(x, 0.f) + __logf(1.0f + __expf(-fabsf(x))); }
__device__ __forceinline__ float geluf_(float x) { const float y = 0.7978845608028654f * (x + 0.044715f * x * x * x); const float t = 1.0f - 2.0f * __builtin_amdgcn_rcpf(__expf(2.0f * y) + 1.0f); return 0.5f * x * (1.0f + t); }
__device__ __forceinline__ float shfl_i(float v, int srclane) { return __builtin_bit_cast(float, __builtin_amdgcn_ds_bpermute(srclane << 2, __builtin_bit_cast(int, v))); }
__device__ __forceinline__ float dpp_f(float v, int ctrl_xor1) { return v; }
__device__ __forceinline__ float wave_sum(float v, int lane) {
    (void)lane;
    v += __builtin_bit_cast(float, __builtin_amdgcn_update_dpp(0, __builtin_bit_cast(int, v), 0xB1, 0xF, 0xF, true));
    v += __builtin_bit_cast(float, __builtin_amdgcn_update_dpp(0, __builtin_bit_cast(int, v), 0x4E, 0xF, 0xF, true));
    v += __builtin_bit_cast(float, __builtin_amdgcn_update_dpp(0, __builtin_bit_cast(int, v), 0x141, 0xF, 0xF, true));
    v += __builtin_bit_cast(float, __builtin_amdgcn_update_dpp(0, __builtin_bit_cast(int, v), 0x140, 0xF, 0xF, true));
    const int iv = __builtin_bit_cast(int, v);
    return (__builtin_bit_cast(float, __builtin_amdgcn_readlane(iv, 0)) + __builtin_bit_cast(float, __builtin_amdgcn_readlane(iv, 16))) +
           (__builtin_bit_cast(float, __builtin_amdgcn_readlane(iv, 32)) + __builtin_bit_cast(float, __builtin_amdgcn_readlane(iv, 48)));
}
#define LDS_WAIT() asm volatile("s_waitcnt lgkmcnt(0)" ::: "memory")
#define WAVE_SYNC() do { asm volatile("s_waitcnt lgkmcnt(0)" ::: "memory"); __builtin_amdgcn_wave_barrier(); } while (0)
__device__ __forceinline__ f32x4 mfma16(bf16x8 a, bf16x8 b, f32x4 c) { return __builtin_amdgcn_mfma_f32_16x16x32_bf16(a, b, c, 0, 0, 0); }


#define XB_TMO      128
#define XB_XCNT(j)  (256  + 64 * (j))
#define XB_XSUB(j)  (1280 + 64 * (j))
#define XB_XGEN(j)  (2304 + 64 * (j))
#define XB_TOP      3328
#define XB_TOPGEN   3392
#define XCD_BAR_WORDS 3456
#define XB_SPIN_CAP (1u << 18)
constexpr size_t WS_BAR = 960 * 1024; constexpr int LDS_BARST = LDS_BYTES - 16;
__device__ __forceinline__ unsigned xb_ld(unsigned* p)              { return __hip_atomic_load(p, __ATOMIC_RELAXED, __HIP_MEMORY_SCOPE_AGENT); }
__device__ __forceinline__ unsigned xb_add(unsigned* p, unsigned v) { return __hip_atomic_fetch_add(p, v, __ATOMIC_RELAXED, __HIP_MEMORY_SCOPE_AGENT); }
__device__ __forceinline__ unsigned xb_xcc_id() { return (unsigned)__builtin_amdgcn_s_getreg((3 << 11) | 20) & 0xFu; }
#define XB_SPIN(cond, bar) do { unsigned _sp = 0; while (cond) { __builtin_amdgcn_s_sleep(1); \
    if ((++_sp & 255u) == 0u) { if (xb_ld(&(bar)[XB_TMO])) break; if (_sp > XB_SPIN_CAP) { atomicAdd(&(bar)[XB_TMO], 1u); break; } } } } while (0)
__device__ __forceinline__ void xcd_barrier_complete(unsigned* bar, unsigned x, unsigned& nloc, unsigned& nx) {
    const unsigned G = gridDim.x;
    unsigned sum, cnt, mine, sp = 0u;
    for (;;) {
        sum = 0u; cnt = 0u; mine = 0u;
#pragma unroll
        for (unsigned j = 0; j < 16; ++j) { const unsigned c = xb_ld(&bar[XB_XCNT(j)]); sum += c; cnt += (c > 0u) ? 1u : 0u; mine = (j == x) ? c : mine; }
        if (sum == G) break;
        __builtin_amdgcn_s_sleep(1);
        if ((++sp & 255u) == 0u) { if (xb_ld(&bar[XB_TMO])) break; if (sp > XB_SPIN_CAP) { atomicAdd(&bar[XB_TMO], 1u); break; } }
    }
    nloc = mine > 0u ? mine : 1u; nx = cnt > 0u ? cnt : 1u;
}
__device__ __forceinline__ void xcd_barrier(int wid0, unsigned* bar, LAS unsigned char* lds) {
    const int tid = tid_fresh(wid0);
    asm volatile("s_waitcnt vmcnt(0)" ::: "memory");
    __syncthreads();
    if (tid == 0) {
        const unsigned x = xb_xcc_id();
        volatile LAS unsigned* st = (volatile LAS unsigned*)(lds + LDS_BARST);
        __builtin_amdgcn_s_waitcnt(0);
        unsigned nloc = st[0], nx = st[1];
        if (nloc == 0u) { xcd_barrier_complete(bar, x, nloc, nx); st[0] = nloc; st[1] = nx; }
        const unsigned old = xb_add(&bar[XB_XSUB(x)], 1u);
        const unsigned gen = old / nloc;
        if (old + 1u == (gen + 1u) * nloc) {
            __builtin_amdgcn_fence(__ATOMIC_RELEASE, "agent");
            asm volatile("s_waitcnt vmcnt(0)" ::: "memory");
            const unsigned og = xb_add(&bar[XB_TOP], 1u);
            const unsigned tg = og / nx;
            if (og + 1u == (tg + 1u) * nx) xb_add(&bar[XB_TOPGEN], 1u);
            else XB_SPIN(xb_ld(&bar[XB_TOPGEN]) == tg, bar);
            __builtin_amdgcn_fence(__ATOMIC_ACQUIRE, "agent");
            xb_add(&bar[XB_XGEN(x)], 1u);
            asm volatile("s_waitcnt vmcnt(0)" ::: "memory");
        } else {
            XB_SPIN(xb_ld(&bar[XB_XGEN(x)]) == gen, bar);
            __builtin_amdgcn_fence(__ATOMIC_ACQUIRE, "agent");
            asm volatile("s_waitcnt vmcnt(0)" ::: "memory");
        }
    }
    __syncthreads();
}
__device__ __forceinline__ void transpose_item(const float* W, int ldw, int nvalid, int K, bf16* WT, int dst_row0, LAS float* scr, int k0, int n0, int lane) {
    const int nn = n0 + (lane & 31); const bool ok = nn < nvalid;
#pragma unroll 8
    for (int i = 0; i < 32; ++i) { const int kk = 2 * i + (lane >> 5); scr[kk * 33 + (lane & 31)] = ok ? W[(size_t)(k0 + kk) * ldw + nn] : 0.f; }
    WAVE_SYNC();
    const int c = lane & 7;
#pragma unroll
    for (int j = 0; j < 4; ++j) { const int n = (lane >> 3) + 8 * j; const LAS float* s = scr + (8 * c) * 33 + n;
        u32x4 o; o.x = pk2(s[0 * 33], s[1 * 33]); o.y = pk2(s[2 * 33], s[3 * 33]); o.z = pk2(s[4 * 33], s[5 * 33]); o.w = pk2(s[6 * 33], s[7 * 33]);
        *(u32x4*)(WT + (size_t)(dst_row0 + n) * K + k0 + 8 * c) = o; }
    WAVE_SYNC();
}
constexpr int WITEMS_EVEN = 4096 + 1552 + 512, WITEMS_ODD = 4096 + 1024 + 512 + 512;
__device__ __forceinline__ void weight_item(const Params& P, LAS float* scr, int l, int r, int lane) {
    unsigned char* ws = P.ws; const int eo = l >> 1;
    if (r < 2048) { const int q = r; transpose_item(P.in[I_WMLPIN] + (size_t)l * 1024 * 4096, 4096, 4096, 1024, (bf16*)(ws + WS_W1T) + (size_t)l * 4096 * 1024, 32 * (q & 127), scr, 64 * (q >> 7), 32 * (q & 127), lane); return; } r -= 2048;
    if (r < 2048) { const int q = r; transpose_item(P.in[I_WMLPOUT] + (size_t)l * 4096 * 1024, 1024, 1024, 4096, (bf16*)(ws + WS_W2T) + (size_t)l * 1024 * 4096, 32 * (q & 31), scr, 64 * (q >> 5), 32 * (q & 31), lane); return; } r -= 2048;
    if ((l & 1) == 0) {
        if (r < 1552) { const int kb = r / 97, nb = r % 97; transpose_item(P.in[I_WINE] + (size_t)eo * 1024 * IN_EVEN_LD, IN_EVEN_LD, IN_EVEN_LD, 1024, (bf16*)(ws + WS_WINE) + (size_t)eo * NB_E * 1024, 32 * nb, scr, 64 * kb, 32 * nb, lane); return; } r -= 1552;
        { const int q = r; transpose_item(P.in[I_WOUTE] + (size_t)eo * 1024 * 1024, 1024, 1024, 1024, (bf16*)(ws + WS_WOUTE) + (size_t)eo * 1024 * 1024, 32 * (q & 31), scr, 64 * (q >> 5), 32 * (q & 31), lane); return; }
    } else {
        if (r < 1024) { const int q = r; transpose_item(P.in[I_WINO] + (size_t)eo * 1024 * 2048, 2048, 2048, 1024, (bf16*)(ws + WS_WINO) + (size_t)eo * 2048 * 1024, 32 * (q & 63), scr, 64 * (q >> 6), 32 * (q & 63), lane); return; } r -= 1024;
        if (r < 512) { const int q = r; transpose_item(P.in[I_WOUTO] + (size_t)eo * 1024 * 1024, 1024, 1024, 1024, (bf16*)(ws + WS_WOUTO) + (size_t)eo * 1024 * 1024, 32 * (q & 31), scr, 64 * (q >> 5), 32 * (q & 31), lane); return; } r -= 512;
        { const int mat = eo * 16 + (r >> 5), q = r & 31, kb = q >> 3, nb = q & 7; const int blk = mat & 3, gate = (mat >> 2) & 1, od = mat >> 3;
          const float* src = (gate ? P.in[I_LWI] : P.in[I_LWR]) + (size_t)(od * 4 + blk) * 65536;
          const int j0 = nb * 32; const int drow = (blk * 2 + (j0 >> 7)) * 256 + gate * 128 + (j0 & 127);
          transpose_item(src, 256, 256, 256, (bf16*)(ws + WS_WG) + (size_t)od * 2048 * 256, drow, scr, 64 * kb, j0, lane); return; }
    }
}
__device__ __forceinline__ void phase_prologue(int wid0, const Params& P, LAS unsigned char* lds) {
    const int tid = tid_fresh(wid0), lane = tid & 63, wave = tid >> 6;
    LAS float* scr = (LAS float*)(lds + wave * 16384);
    const int gw = bid_fresh() * NWAVES + wave, NGW = grid_fresh() * NWAVES;
    unsigned char* ws = P.ws;
    constexpr int NTR = WITEMS_EVEN, NMOD = 4 * 24 * 16;
    for (int it = gw; it < NTR + NMOD; it += NGW) {
        int r = it;
        if (r < NTR) { weight_item(P, scr, 0, r, lane); continue; } r -= NTR;
        {
            const int l = r / 384, rem = r % 384, ec = rem >> 4, ks = rem & 15, k0 = ks * 64;
#pragma unroll
            for (int rr = 0; rr < 9; ++rr) { const float cv = rr == 0 ? P.in[I_CCTX][k0 + lane] : P.in[I_C][(rr - 1) * 1024 + k0 + lane]; scr[rr * 64 + lane] = siluf_(cv); }
            WAVE_SYNC();
            f32x4 acc[9];
#pragma unroll
            for (int rr = 0; rr < 9; ++rr) acc[rr] = (f32x4){0.f, 0.f, 0.f, 0.f};
            const float* wp = P.in[I_WADA] + ((size_t)l * 1024 + k0) * 6144 + ec * 256 + lane * 4;
#pragma unroll 4
            for (int kk = 0; kk < 64; ++kk) { const f32x4 w4 = *(const f32x4*)(wp + (size_t)kk * 6144);
#pragma unroll
                for (int rr = 0; rr < 9; ++rr) acc[rr] += w4 * scr[rr * 64 + kk]; }
            float* part = (float*)(ws + WS_BIG) + ((size_t)(ks * 4 + l) * 9) * 6144 + ec * 256 + lane * 4;
#pragma unroll
            for (int rr = 0; rr < 9; ++rr) *(f32x4*)(part + (size_t)rr * 6144) = acc[rr];
            WAVE_SYNC();
        }
    }
    { const size_t per = (size_t)(NB_E - 3104) * 1024 * 2 / 16;
      for (size_t i = (size_t)bid_fresh() * NTHR + tid; i < 2 * per; i += (size_t)grid_fresh() * NTHR) { const size_t e = i / per, q = i % per;
          *(u32x4*)(ws + WS_WINE + (e * NB_E + 3104) * 1024 * 2 + q * 16) = (u32x4){0u, 0u, 0u, 0u}; } }
}
__device__ __forceinline__ void phase_modreduce(int wid0, const Params& P) {
    const int tid = tid_fresh(wid0);
    const float* part = (const float*)(P.ws + WS_BIG); float* mod = (float*)(P.ws + WS_MOD);
    for (int i = bid_fresh() * NTHR + tid; i < 4 * 9 * 6144 / 4; i += grid_fresh() * NTHR) {
        const int l = i / (9 * 1536), e4 = i % 1536;
        f32x4 a = *(const f32x4*)(P.in[I_BADA] + (size_t)l * 6144 + e4 * 4);
#pragma unroll
        for (int ks = 0; ks < 16; ++ks) a += *(const f32x4*)(part + (size_t)ks * 4 * 9 * 6144 + (size_t)i * 4);
        *(f32x4*)(mod + (size_t)i * 4) = a; }
}
constexpr size_t XB_OFF_FLOATS = (size_t)MT * DM / 2;
__device__ __forceinline__ void phase_rownorm(int wid0, const Params& P, int first, const bf16* obuf, const float* modg, int goff, const float* gpost, int has_next, const float* gpre, const float* mods, int soff, bf16* H, float gscale = 1.0f) {
    const int tid = tid_fresh(wid0), lane = tid & 63, wave = tid >> 6;
    const int gw = bid_fresh() * NWAVES + wave, NGW = grid_fresh() * NWAVES;
    bf16* XB = (bf16*)(P.out + XB_OFF_FLOATS); float* TMP = (float*)(P.ws + WS_BIG);
    f32x4 xn[4]; u32x2 xbn[4], on[4];
#define RN_LOAD(mm) do { const int m_ = (mm); \
        _Pragma("unroll") for (int j = 0; j < 4; ++j) { \
            if (first) xn[j] = *(const f32x4*)((m_ < MCTX ? P.in[I_XP] + (size_t)m_ * DM : P.in[I_XS] + (size_t)(m_ - MCTX) * DM) + lane * 4 + 256 * j); \
            else { xbn[j] = *(const u32x2*)(XB + (size_t)m_ * DM + lane * 4 + 256 * j); on[j] = *(const u32x2*)(obuf + (size_t)m_ * DM + lane * 4 + 256 * j); } } } while (0)
    if (gw < MT) RN_LOAD(gw);
    for (int m = gw; m < MT; m += NGW) {
        const int modrow = m < MCTX ? 0 : 1 + ((m - MCTX) >> 11);
        const float* mr = modg + (size_t)modrow * 6144; const float* ms = mods + (size_t)modrow * 6144;
        f32x4 x[4]; u32x2 ov[4];
#pragma unroll
        for (int j = 0; j < 4; ++j) { ov[j] = on[j]; x[j] = first ? xn[j] : (f32x4){bflo(xbn[j].x), bfhi(xbn[j].x), bflo(xbn[j].y), bfhi(xbn[j].y)}; }
        if (m + NGW < MT) RN_LOAD(m + NGW);
        f32x4 vgp[4], vgt[4], vgq[4], vsh[4], vsc[4];
#pragma unroll
        for (int j = 0; j < 4; ++j) { const int c = lane * 4 + 256 * j;
            if (!first) { vgp[j] = *(const f32x4*)(gpost + c); vgt[j] = *(const f32x4*)(mr + goff + c); }
            if (has_next) { vgq[j] = *(const f32x4*)(gpre + c); vsh[j] = *(const f32x4*)(ms + soff + c); vsc[j] = *(const f32x4*)(ms + soff + 1024 + c); } }
        if (first) {
            if (m >= MCTX) {
                const int t = (m - MCTX) & 2047; const float prow = (float)(t >> 6), pcol = (float)(t & 63);
                f32x4 om;
#pragma unroll
                for (int e = 0; e < 4; ++e) om[e] = exp2f(-(float)(lane * 4 + e) * (13.287712379549449f / 256.0f));
#pragma unroll
                for (int j = 0; j < 4; ++j) {
#pragma unroll
                    for (int e = 0; e < 4; ++e) { const float a = (j < 2 ? prow : pcol) * om[e]; x[j][e] += (j & 1) ? cosf(a) : sinf(a); } }
            }
        } else {
            float ss = 0.f;
#pragma unroll
            for (int j = 0; j < 4; ++j) { const float a = bflo(ov[j].x), b = bfhi(ov[j].x), c = bflo(ov[j].y), d = bfhi(ov[j].y); ss += (a * a + b * b) + (c * c + d * d); }
            const float rs = rsqrtf(wave_sum(ss, lane) * (1.0f / DM) + EPSF);
#pragma unroll
            for (int j = 0; j < 4; ++j) { f32x4 o4 = (f32x4){bflo(ov[j].x), bfhi(ov[j].x), bflo(ov[j].y), bfhi(ov[j].y)};
                x[j] += vgt[j] * (o4 * (rs * gscale) * vgp[j]); }
        }
        if (has_next) {
#pragma unroll
            for (int j = 0; j < 4; ++j) { u32x2 w; w.x = pk2(x[j][0], x[j][1]); w.y = pk2(x[j][2], x[j][3]); *(u32x2*)(XB + (size_t)m * DM + lane * 4 + 256 * j) = w; }
            float ss = 0.f;
#pragma unroll
            for (int j = 0; j < 4; ++j) ss += (x[j][0] * x[j][0] + x[j][1] * x[j][1]) + (x[j][2] * x[j][2] + x[j][3] * x[j][3]);
            const float rs = rsqrtf(wave_sum(ss, lane) * (1.0f / DM) + EPSF);
#pragma unroll
            for (int j = 0; j < 4; ++j) { const f32x4 h4 = (x[j] * rs * vgq[j]) * (vsc[j] + 1.0f) + vsh[j];
                u32x2 w; w.x = pk2(h4[0], h4[1]); w.y = pk2(h4[2], h4[3]);
                *(u32x2*)(H + (size_t)m * DM + lane * 4 + 256 * j) = w; }
        } else {
            float* dst = (m < MT / 2) ? P.out + (size_t)m * DM : TMP + (size_t)(m - MT / 2) * DM;
#pragma unroll
            for (int j = 0; j < 4; ++j) *(f32x4*)(dst + lane * 4 + 256 * j) = x[j];
        }
    }
}
__device__ __forceinline__ void phase_copy_tail(int wid0, const Params& P) {
    const int tid = tid_fresh(wid0);
    const f32x4* src = (const f32x4*)(P.ws + WS_BIG); f32x4* dst = (f32x4*)(P.out + XB_OFF_FLOATS);
    const size_t n = (size_t)(MT / 2) * DM / 4;
    for (size_t i = (size_t)bid_fresh() * NTHR + tid; i < n; i += (size_t)grid_fresh() * NTHR) dst[i] = src[i];
}

using pg8::Unit;
template <int ACT  > struct EpiBf16 {
    bf16* O; int ldc; float* AB;
    bf16* HALO;
    __device__ __forceinline__ void operator()(const f32x4 (&acc)[2][2][4][2], const Unit& u, int wr, int wc, int fr, int fq) const {
        const int row0 = u.pm * 256 + wr * 64 + fr, col0 = u.pn * 256 + wc * 32 + 8 * fq;
        if (AB && u.pn * 256 >= ldc) {
            if (wc == 0 && fq < 2) {
#pragma unroll
                for (int ai = 0; ai < 2; ++ai)
#pragma unroll
                    for (int m = 0; m < 4; ++m) { float* p = AB + (size_t)(row0 + ai * 128 + m * 16) * 16 + 8 * fq; *(f32x4*)p = acc[ai][0][m][0]; *(f32x4*)(p + 4) = acc[ai][0][m][1]; }
            }
            return;
        }
#pragma unroll
        for (int ai = 0; ai < 2; ++ai)
#pragma unroll
            for (int m = 0; m < 4; ++m) { bf16* rowp = O + (size_t)(row0 + ai * 128 + m * 16) * ldc + col0;
#pragma unroll
                for (int bj = 0; bj < 2; ++bj) { f32x4 v0 = acc[ai][bj][m][0], v1 = acc[ai][bj][m][1];
                    if (ACT == 1) {
#pragma unroll
                        for (int j = 0; j < 4; ++j) { const float a = fmaxf(v0[j], 0.f), b = fmaxf(v1[j], 0.f); v0[j] = a * a; v1[j] = b * b; } }
                    u32x4 w; w.x = pk2(v0[0], v0[1]); w.y = pk2(v0[2], v0[3]); w.z = pk2(v1[0], v1[1]); w.w = pk2(v1[2], v1[3]);
                    *(u32x4*)(rowp + bj * 128) = w;
                    if (ACT == 0 && HALO && u.pn >= 4 && u.pn < 10 && ((m == 3 && fr == 15) || (m == 0 && fr < 2))) {
                        const int r = row0 + ai * 128 + m * 16; const int which = (m == 3) ? 0 : 1 + fr;
                        *(u32x4*)(HALO + ((size_t)(r >> 6) * 3 + which) * 1536 + (col0 + bj * 128 - 1024)) = w; } } }
    }
};
struct EpiSplit {
    bf16* O0; long stride;
    __device__ __forceinline__ void operator()(const f32x4 (&acc)[2][2][4][2], const Unit& u, int wr, int wc, int fr, int fq) const {
        const int row0 = u.pm * 256 + wr * 64 + fr, col0 = (u.pn >> 1) * 256 + wc * 32 + 8 * fq; bf16* O = O0 + (long)(u.pn & 1) * stride;
#pragma unroll
        for (int ai = 0; ai < 2; ++ai)
#pragma unroll
            for (int m = 0; m < 4; ++m) { bf16* rowp = O + (size_t)(row0 + ai * 128 + m * 16) * DM + col0;
#pragma unroll
                for (int bj = 0; bj < 2; ++bj) { const f32x4 v0 = acc[ai][bj][m][0], v1 = acc[ai][bj][m][1];
                    u32x4 w; w.x = pk2(v0[0], v0[1]); w.y = pk2(v0[2], v0[3]); w.z = pk2(v1[0], v1[1]); w.w = pk2(v1[2], v1[3]);
                    *(u32x4*)(rowp + bj * 128) = w; } }
    }
};
struct EpiGates {
    unsigned* G; const bf16* X; const float* br; const float* bi; const float* lam;
    __device__ __forceinline__ void operator()(const f32x4 (&acc)[2][2][4][2], const Unit& u, int wr, int wc, int fr, int fq) const {
        const int row0 = u.pm * 256 + wr * 64 + fr, ch0 = u.pn * 128 + wc * 32 + 8 * fq;
        u32x2 xv[2][2][4];
#pragma unroll
        for (int n = 0; n < 2; ++n)
#pragma unroll
            for (int ai = 0; ai < 2; ++ai)
#pragma unroll
                for (int m = 0; m < 4; ++m) xv[n][ai][m] = *(const u32x2*)(X + (size_t)(row0 + ai * 128 + m * 16) * DM + ch0 + 4 * n);
#pragma unroll
        for (int n = 0; n < 2; ++n) {
            const f32x4 vbr = *(const f32x4*)(br + ch0 + 4 * n), vbi = *(const f32x4*)(bi + ch0 + 4 * n), l4 = *(const f32x4*)(lam + ch0 + 4 * n);
            f32x4 vsp;
#pragma unroll
            for (int e = 0; e < 4; ++e) vsp[e] = -8.0f * softplusf_(-l4[e]);
#pragma unroll
            for (int ai = 0; ai < 2; ++ai)
#pragma unroll
                for (int m = 0; m < 4; ++m) { const size_t row = (size_t)(row0 + ai * 128 + m * 16);
                    const float xs[4] = {bflo(xv[n][ai][m].x), bfhi(xv[n][ai][m].x), bflo(xv[n][ai][m].y), bfhi(xv[n][ai][m].y)};
                    u32x4 w;
#pragma unroll
                    for (int e = 0; e < 4; ++e) { const float r = sigmoidf_(acc[ai][0][m][n][e] + vbr[e]), ig = sigmoidf_(acc[ai][1][m][n][e] + vbi[e]);
                        const float la = r * vsp[e]; const float a_ = __expf(la); const float b = __builtin_amdgcn_sqrtf(fmaxf(1.0f - a_ * a_, 0.f)) * ig * xs[e];
                        w[e] = pk2(1.0f - a_, b); }
                    *(u32x4*)(G + row * DM + ch0 + 4 * n) = w; }
        }
    }
};
constexpr int S5_WLDS = 12800, BU_P = 132, HS_P = 136;
struct S5Dir { float ar, ai; bf16x8 Bf[8]; };
__device__ __forceinline__ void s5_dir_setup(const Params& P, int e, int d, int g, int lane, float& ar, float& ai, bf16x8 (&Bf)[8], bool needB) {
    const int quad = lane >> 4, l15 = lane & 15;
    const float dt = __expf(P.in[I_LOGDT][(e * 2 + d) * 32 + g]);
    const float lr = P.in[I_LAMRE][((e * 2 + d) * 32 + g) * 64 + lane], li = P.in[I_LAMIM][((e * 2 + d) * 32 + g) * 64 + lane];
    const float mag = expf(lr * dt); ar = mag * cosf(li * dt); ai = mag * sinf(li * dt);
    const float den = lr * lr + li * li;
    const float fr = ((ar - 1.0f) * lr + ai * li) / den, fi = (ai * lr - (ar - 1.0f) * li) / den;
    if (needB) {
#pragma unroll
        for (int nt = 0; nt < 8; ++nt) { const int col = 16 * nt + l15, p = col & 63;
            const float frp = shfl_i(fr, p), fip = shfl_i(fi, p);
            bf16x8 v = (bf16x8){0, 0, 0, 0, 0, 0, 0, 0};
            if (quad < 2) { const float* bre = P.in[I_BRE] + ((size_t)(e * 32 + g) * 64 + p) * 16 + quad * 8; const float* bim = P.in[I_BIM] + ((size_t)(e * 32 + g) * 64 + p) * 16 + quad * 8;
#pragma unroll
                for (int j = 0; j < 8; ++j) { const float br = bre[j], bi = bim[j]; const float val = (nt < 4) ? (frp * br - fip * bi) : (frp * bi + fip * br); v[j] = (short)f2bf(val); } }
            Bf[nt] = v; }
    }
}
__device__ __forceinline__ void s5_c_setup(const Params& P, int e, int g, int lane, bf16x8 (&Cf)[4]) {
    const int quad = lane >> 4, l15 = lane & 15;
#pragma unroll
    for (int ks = 0; ks < 4; ++ks) { const int col0 = 32 * ks + quad * 8; const bool im = col0 >= 64;
        const float* src = (im ? P.in[I_CIM] : P.in[I_CRE]) + ((size_t)(e * 32 + g) * 16 + l15) * 64 + (col0 & 63);
        bf16x8 v;
#pragma unroll
        for (int j = 0; j < 8; ++j) v[j] = (short)f2bf(im ? -src[j] : src[j]);
        Cf[ks] = v; }
}
__device__ __forceinline__ void s5_scan_seg(const Params& P, LAS unsigned char* wl, int lane, int d, int g, int m0, float ar, float ai, const bf16x8 (&Bf)[8], const bf16x8 (&Cf)[4],
                                            float& hr, float& hi, int mode, int ymode, const bf16* proj, float* ybuf, bf16* mixout, float dsk, int dry = 0) {
    const int quad = lane >> 4, l15 = lane & 15;
    LAS float* BU = (LAS float*)wl; LAS bf16* HS = (LAS bf16*)(wl + 8448);
    const int ch = g * 16 + l15;
    bf16x8 a_next = (bf16x8){0, 0, 0, 0, 0, 0, 0, 0};
    if (mode == 0 && quad < 2) { const int blk0 = d ? 15 : 0; const int tt = d ? 15 - l15 : l15; a_next = *(const bf16x8*)(proj + (size_t)(m0 + 16 * blk0 + tt) * NPROJ_E + g * 16 + quad * 8); }
    for (int bi_ = 0; bi_ < 16; ++bi_) {
        const int blk = d ? 15 - bi_ : bi_;
        const int mb = m0 + 16 * blk;
        const bf16x8 a = a_next;
        if (mode == 0 && quad < 2 && bi_ + 1 < 16) { const int blkn = d ? 14 - bi_ : bi_ + 1; const int tt = d ? 15 - l15 : l15; a_next = *(const bf16x8*)(proj + (size_t)(m0 + 16 * blkn + tt) * NPROJ_E + g * 16 + quad * 8); }
        float pre[4], zz[4];
#pragma unroll
        for (int jj = 0; jj < 4; ++jj) { const int row = quad * 4 + jj; const int tt = d ? 15 - row : row; const size_t m = (size_t)(mb + tt);
            pre[jj] = (ymode == 0) ? dsk * bf2f(proj[m * NPROJ_E + ch]) : ybuf[m * 512 + ch];
            zz[jj] = (ymode == 2) ? bf2f(proj[m * NPROJ_E + 512 + ch]) : 0.f; }
        if (mode == 0) {
#pragma unroll
            for (int nt = 0; nt < 8; ++nt) { f32x4 acc = mfma16(a, Bf[nt], (f32x4){0.f, 0.f, 0.f, 0.f});
#pragma unroll
                for (int jj = 0; jj < 4; ++jj) BU[(quad * 4 + jj) * BU_P + 16 * nt + l15] = acc[jj]; }
            WAVE_SYNC();
        }
#pragma unroll
        for (int r = 0; r < 16; ++r) {
            float br = 0.f, bim = 0.f;
            if (mode == 0) { br = BU[r * BU_P + lane]; bim = BU[r * BU_P + 64 + lane]; }
            const float nr = ar * hr - ai * hi + br, ni = ar * hi + ai * hr + bim; hr = nr; hi = ni;
            HS[r * HS_P + lane] = (bf16)f2bf(hr); HS[r * HS_P + 64 + lane] = (bf16)f2bf(hi);
        }
        WAVE_SYNC();
        f32x4 y = (f32x4){0.f, 0.f, 0.f, 0.f};
#pragma unroll
        for (int ks = 0; ks < 4; ++ks) { const bf16x8 af = *(const LAS bf16x8*)(HS + l15 * HS_P + 32 * ks + quad * 8); y = mfma16(af, Cf[ks], y); }
#pragma unroll
        for (int jj = 0; jj < 4; ++jj) { const int row = quad * 4 + jj; const int tt = d ? 15 - row : row; const size_t m = (size_t)(mb + tt);
            const float v = y[jj] + pre[jj];
            if (!dry) { if (ymode != 2) ybuf[m * 512 + ch] = v;
            else mixout[m * DM + ch] = (bf16)f2bf(geluf_(v) * sigmoidf_(zz[jj])); }
        }
        WAVE_SYNC();
    }
}
__device__ __forceinline__ void s5_task_main(const Params& P, LAS unsigned char* wl, int lane, int e, int sub, int g) {
    const bf16* proj = (const bf16*)(P.ws + WS_BIG); float* ybuf = (float*)(P.ws + WS_YBUF); bf16* mixout = (bf16*)(P.ws + WS_MIX);
    const bool lat = sub >= 32; const int q = sub - 32, b = lat ? (q >> 3) : sub, seg = lat ? (q & 7) : 0;
    const int m0 = lat ? MCTX + b * LLAT + seg * 256 : sub * 256;
    bf16x8 Cf[4]; s5_c_setup(P, e, g, lane, Cf);
    const float dsk = P.in[I_S5D][e * 512 + g * 16 + (lane & 15)];
#pragma unroll 1
    for (int d = 0; d < 2; ++d) {
        float ar, ai; bf16x8 Bf[8]; s5_dir_setup(P, e, d, g, lane, ar, ai, Bf, true);
        float hr = 0.f, hi = 0.f;
        if (lat && ((d == 0 && seg == 0) || (d == 1 && seg == 7))) { const size_t si = ((((size_t)b * 2 + e) * 2 + d) * 32 + g) * 64 + lane; hr = P.in[I_S5RE][si]; hi = P.in[I_S5IM][si]; }
        const int ymode = d == 0 ? 0 : (lat ? 1 : 2);
        s5_scan_seg(P, wl, lane, d, g, m0, ar, ai, Bf, Cf, hr, hi, 0, ymode, proj, ybuf, mixout, dsk);
        if (!lat) { const size_t si = ((((size_t)b * 2 + e) * 2 + d) * 32 + g) * 64 + lane; P.out[OUT_S5RE + si] = hr; P.out[OUT_S5IM + si] = hi; }
        else { float* F = (float*)(P.ws + WS_S5F) + ((((size_t)d * 64 + q) * 32 + g) * 64 + lane) * 2; F[0] = hr; F[1] = hi; }
    }
}
__device__ __forceinline__ void s5_task_corr(const Params& P, LAS unsigned char* wl, int lane, int e, int q, int g, int dry = 0) {
    const bf16* proj = (const bf16*)(P.ws + WS_BIG); float* ybuf = (float*)(P.ws + WS_YBUF); bf16* mixout = (bf16*)(P.ws + WS_MIX);
    const int b = q >> 3, seg = q & 7, m0 = MCTX + b * LLAT + seg * 256;
    bf16x8 Cf[4]; s5_c_setup(P, e, g, lane, Cf);
    bf16x8 Bf[8];
#pragma unroll
    for (int i = 0; i < 8; ++i) Bf[i] = (bf16x8){0, 0, 0, 0, 0, 0, 0, 0};
    const float* Fb = (const float*)(P.ws + WS_S5F);
#pragma unroll 1
    for (int d = 0; d < 2; ++d) {
        float ar, ai; s5_dir_setup(P, e, d, g, lane, ar, ai, Bf, false);
        float pr = ar, pi = ai;
#pragma unroll
        for (int i = 0; i < 8; ++i) { const float nr = pr * pr - pi * pi, ni = 2.0f * pr * pi; pr = nr; pi = ni; }
        float hr = 0.f, hi = 0.f;
        const int cnt = d == 0 ? seg : 7 - seg;
        for (int i = 0; i < cnt; ++i) { const int sj = d == 0 ? i : 7 - i; const float* F = Fb + ((((size_t)d * 64 + b * 8 + sj) * 32 + g) * 64 + lane) * 2;
            const float nr = pr * hr - pi * hi + F[0], ni = pr * hi + pi * hr + F[1]; hr = nr; hi = ni; }
        const int ym = (d == 1 || seg == 7) ? 2 : 1;
        if (cnt > 0) s5_scan_seg(P, wl, lane, d, g, m0, ar, ai, Bf, Cf, hr, hi, 1, ym, proj, ybuf, mixout, 0.f, dry);
    }
}

#ifndef REP_A
#define REP_A 1
#endif
#ifndef REP_B
#define REP_B 1
#endif
#ifndef REP_C
#define REP_C 1
#endif
__device__ __forceinline__ void phase_conv_even(int wid0, const Params& P, int e, int dry = 0) {
    const int tid = tid_fresh(wid0), lane = tid & 63, wave = tid >> 6;
    const int gw = bid_fresh() * NWAVES + wave, NGW = grid_fresh() * NWAVES;
    bf16* proj = (bf16*)(P.ws + WS_BIG); const bf16* HALO = (const bf16*)(P.ws + WS_HALO);
    for (int it = gw; it < 384 * 24; it += NGW) {
        const int c = it / 24, cgp = it % 24, ccol = cgp * 64 + lane;
        const int r0 = c * 64;
        const bool lat = r0 >= MCTX; const int t0 = lat ? ((r0 - MCTX) & 2047) : (r0 & 255); const int L = lat ? LLAT : LCTX;
        bf16* base = proj + (size_t)r0 * NPROJ_E + 1024 + ccol;
        bf16 x[67];
#pragma unroll
        for (int i = 0; i < 64; ++i) x[i + 1] = base[(size_t)i * NPROJ_E];
        x[0] = (t0 > 0) ? HALO[((size_t)(c - 1) * 3 + 0) * 1536 + ccol] : (bf16)0;
        x[65] = (t0 + 64 < L) ? HALO[((size_t)(c + 1) * 3 + 1) * 1536 + ccol] : (bf16)0;
        x[66] = (t0 + 64 < L) ? HALO[((size_t)(c + 1) * 3 + 2) * 1536 + ccol] : (bf16)0;
        const float* cw = P.in[I_GCONVW] + (size_t)e * 4 * 1536 + ccol; const float w0 = cw[0], w1 = cw[1536], w2 = cw[3072], w3 = cw[4608], cb = P.in[I_GCONVB][e * 1536 + ccol];
#pragma unroll
        for (int i = 0; i < 64; ++i) { const float v = cb + w0 * bf2f(x[i]) + w1 * bf2f(x[i + 1]) + w2 * bf2f(x[i + 2]) + w3 * bf2f(x[i + 3]);
            if (!dry) base[(size_t)i * NPROJ_E] = (bf16)f2bf(siluf_(v)); }
    }
}
#define LDS_BARRIER() do { asm volatile("s_waitcnt lgkmcnt(0)" ::: "memory"); __builtin_amdgcn_s_barrier(); asm volatile("" ::: "memory"); } while (0)
constexpr int G_Q = 0, G_K = 17408, G_V = 34816, G_KT = 52224, G_LM = 70656, G_QK = 89088, G_ST = 98304, G_SM = 133120;
constexpr int P128 = 136, P64 = 72, LMP = 68;
__device__ __forceinline__ bf16x8 ld_split8(const LAS bf16* p) {
    const u32x2 a = *(const LAS u32x2*)p, b = *(const LAS u32x2*)(p + 16);
    return __builtin_bit_cast(bf16x8, (u32x4){a.x, a.y, b.x, b.y});
}
__device__ __forceinline__ bf16x8 pack_acc2(const f32x4& a, const f32x4& b) { return __builtin_bit_cast(bf16x8, (u32x4){pk2(a[0], a[1]), pk2(a[2], a[3]), pk2(b[0], b[1]), pk2(b[2], b[3])}); }
__device__ __forceinline__ void gdn_chain(int wid0, const Params& P, LAS unsigned char* lds, int e, int s, int hd, int dir) {
    const int tid = tid_fresh(wid0), lane = tid & 63, w = __builtin_amdgcn_readfirstlane(tid >> 6), quad = lane >> 4, l15 = lane & 15;
    const bool lat = s >= 32; const int b = lat ? s - 32 : s; const int L = lat ? LLAT : LCTX; const int m0 = lat ? MCTX + b * LLAT : s * LCTX;
    const bf16* proj = (const bf16*)(P.ws + WS_BIG); const float* AB = (const float*)(P.ws + WS_AB);
    bf16* Odir = (bf16*)(P.ws + WS_H) + (size_t)dir * MT * 512;
    int zv; asm volatile("v_mov_b32 %0, 0" : "=v"(zv));
    lds += zv;
    LAS bf16* Qs = (LAS bf16*)(lds + G_Q); LAS bf16* Ks = (LAS bf16*)(lds + G_K); LAS bf16* Vs = (LAS bf16*)(lds + G_V); LAS bf16* KT = (LAS bf16*)(lds + G_KT);
    LAS float* Lm = (LAS float*)(lds + G_LM); LAS bf16* VNT = (LAS bf16*)(lds + G_LM); LAS bf16* QKs = (LAS bf16*)(lds + G_QK); LAS bf16* ST = (LAS bf16*)(lds + G_ST);
    LAS bf16* TM = (LAS bf16*)(lds + G_ST); LAS bf16* TT = TM + 64 * P64; LAS bf16* LR = TT + 64 * P64;
    LAS float* rq = (LAS float*)(lds + G_SM); LAS float* rk = rq + 64; LAS float* gcs = rq + 128; LAS float* betas = rq + 192; LAS float* egs = rq + 256; LAS float* kes = rq + 320;
    f32x4 Sacc[8];
    const size_t sbase = ((((size_t)b * 2 + e) * 2 + dir) * 4 + hd) * 16384;
#pragma unroll
    for (int mt = 0; mt < 8; ++mt) Sacc[mt] = (f32x4){0.f, 0.f, 0.f, 0.f};
    if (lat) { const float* sp = P.in[I_SDELTA] + sbase + (size_t)(quad * 4) * 128 + 16 * w + l15;
#pragma unroll
        for (int mt = 0; mt < 8; ++mt)
#pragma unroll
            for (int jj = 0; jj < 4; ++jj) Sacc[mt][jj] = sp[(16 * mt + jj) * 128]; }
    for (int i = tid; i < 2 * 64 * P64 / 2; i += NTHR) ((LAS unsigned*)TM)[i] = 0u;
    const float alog_e = __expf(P.in[I_GALOG][(e * 2 + dir) * 4 + hd]), dtb = P.in[I_GDTB][(e * 2 + dir) * 4 + hd];
    const int nchunk = L / 64;
    u32x4 xr[6]; float ab_a = 0.f, ab_b = 0.f;
#define GDN_LOAD(ci_) do { const int tid_ = tid_fresh(wid0); const int c0_ = dir ? L - 64 * ((ci_) + 1) : 64 * (ci_); \
        _Pragma("unroll") for (int k = 0; k < 6; ++k) { const int p_ = tid_ + 512 * k, part_ = p_ >> 10, row_ = (p_ & 1023) >> 4, pc_ = p_ & 15; \
            xr[k] = *(const u32x4*)(proj + (size_t)(m0 + c0_ + row_) * NPROJ_E + 1024 + part_ * 512 + hd * 128 + pc_ * 8); } \
        if (w == 0) { const int ln_ = tid_ & 63; const size_t m_ = (size_t)(m0 + c0_ + (dir ? 63 - ln_ : ln_)); ab_a = AB[m_ * 16 + dir * 4 + hd]; ab_b = AB[m_ * 16 + 8 + dir * 4 + hd]; } } while (0)
    GDN_LOAD(0);
#pragma unroll 1
    for (int ci = 0; ci < nchunk; ++ci) {
        const int tid = tid_fresh(wid0), lane = tid & 63, quad = lane >> 4, l15 = lane & 15;
        const int c0 = dir ? L - 64 * (ci + 1) : 64 * ci;
        LDS_BARRIER();
#ifndef NO_A
        const float cur_a = ab_a, cur_b = ab_b;
#pragma unroll
        for (int k = 0; k < 6; ++k) { const int p_ = tid + 512 * k, part_ = p_ >> 10, row_ = (p_ & 1023) >> 4, pc_ = p_ & 15;
            LAS bf16* dst = part_ == 0 ? Qs : (part_ == 1 ? Ks : Vs);
            *(LAS u32x4*)(dst + (dir ? 63 - row_ : row_) * P128 + pc_ * 8) = xr[k]; }
        if (ci + 1 < nchunk) GDN_LOAD(ci + 1);
#endif
        LDS_BARRIER();
#pragma unroll 1
        for (int repB = 0; repB < REP_B; ++repB)
        { const int rowid = tid >> 2, part = tid & 3; LAS bf16* src = (rowid < 64 ? Qs : Ks) + (rowid & 63) * P128 + part * 32;
          float ss = 0.f;
#pragma unroll
          for (int i = 0; i < 4; ++i) { const u32x4 v = *(const LAS u32x4*)(src + 8 * i);
#pragma unroll
              for (int j = 0; j < 4; ++j) { const float a = bflo(v[j]), c = bfhi(v[j]); ss += a * a + c * c; } }
          ss += shfl_i(ss, lane ^ 1); ss += shfl_i(ss, lane ^ 2);
          if (part == 0) { if (rowid < 64) rq[rowid] = rsqrtf(ss + EPSF) * 0.08838834764831845f; else rk[rowid - 64] = rsqrtf(ss + EPSF); }
          if (w == 0) { const int t = c0 + (dir ? 63 - lane : lane); const size_t m = (size_t)(m0 + t);
              const float araw = cur_a, braw = cur_b;
              const float gg = -alog_e * softplusf_(araw + dtb);
              float gc = gg;
#pragma unroll
              for (int o = 1; o < 64; o <<= 1) { const float t2 = shfl_i(gc, (lane - o) & 63); if (lane >= o) gc += t2; }
              const float glast = shfl_i(gc, 63);
              gcs[lane] = gc; betas[lane] = sigmoidf_(braw); egs[lane] = __expf(gc); kes[lane] = __expf(glast - gc);
              if (lane == 0) rq[384] = __expf(glast); } }
        LDS_BARRIER();
#ifndef NO_C
#pragma unroll 1
        for (int repC = 0; repC < REP_C; ++repC)
        { const int mt = w & 3; const bool isq = w >= 4; LAS bf16* src = isq ? Qs : Ks;
          bf16x8 a[4];
#pragma unroll
          for (int ks = 0; ks < 4; ++ks) a[ks] = *(const LAS bf16x8*)(src + (16 * mt + l15) * P128 + 32 * ks + quad * 8);
#pragma unroll 1
          for (int nt = 0; nt < 4; ++nt) { f32x4 acc = (f32x4){0.f, 0.f, 0.f, 0.f};
#pragma unroll
              for (int ks = 0; ks < 4; ++ks) { const bf16x8 bb = *(const LAS bf16x8*)(Ks + (16 * nt + l15) * P128 + 32 * ks + quad * 8); acc = mfma16(a[ks], bb, acc); }
              const int j = 16 * nt + l15; const float rkj = rk[j], gcj = gcs[j];
              f32x4 lv;
#pragma unroll
              for (int jj = 0; jj < 4; ++jj) { const int i = 16 * mt + quad * 4 + jj; const float dec = __expf(fminf(gcs[i] - gcj, 0.f));
                  lv[jj] = (i > j) ? acc[jj] * rk[i] * rkj * betas[i] * dec : 0.f;
                  if (isq) QKs[i * P64 + j] = (bf16)f2bf((i >= j) ? acc[jj] * rq[i] * rkj * dec : 0.f); }
              if (!isq) { *(LAS f32x4*)(Lm + j * LMP + 16 * mt + quad * 4) = lv;
#pragma unroll
                  for (int jj = 0; jj < 4; ++jj) LR[(16 * mt + quad * 4 + jj) * P64 + j] = (bf16)f2bf(nt < mt ? lv[jj] : 0.f); } }
          const int dd = tid & 127, tq = tid >> 7;
          unsigned pw[8];
#pragma unroll
          for (int n = 0; n < 16; n += 2) { const int i0 = tq * 16 + n; const float v0 = bf2f(Ks[i0 * P128 + dd]) * rk[i0] * kes[i0], v1 = bf2f(Ks[(i0 + 1) * P128 + dd]) * rk[i0 + 1] * kes[i0 + 1]; pw[n >> 1] = pk2(v0, v1); }
          *(LAS u32x4*)(KT + dd * P64 + tq * 16) = (u32x4){pw[0], pw[1], pw[2], pw[3]};
          *(LAS u32x4*)(KT + dd * P64 + tq * 16 + 8) = (u32x4){pw[4], pw[5], pw[6], pw[7]}; }
#endif
        LDS_BARRIER();
        { const int i = tid >> 3, c0k = (tid & 7) * 16; const float sc = rk[i] * betas[i] * egs[i];
#pragma unroll
          for (int h2 = 0; h2 < 2; ++h2) { u32x4 v = *(LAS u32x4*)(Ks + i * P128 + c0k + 8 * h2);
#pragma unroll
              for (int q = 0; q < 4; ++q) v[q] = pk2(bflo(v[q]) * sc, bfhi(v[q]) * sc);
              *(LAS u32x4*)(Ks + i * P128 + c0k + 8 * h2) = v; } }
        if (w == 0) { const int bb = lane >> 4, c = lane & 15;
            float x[16];
#pragma unroll
            for (int r = 0; r < 16; ++r) x[r] = (r == c) ? 1.f : 0.f;
#pragma unroll
            for (int j = 0; j < 15; ++j) {
#pragma unroll
                for (int q4 = j / 4; q4 < 4; ++q4) { const f32x4 l4 = *(const LAS f32x4*)(Lm + (16 * bb + j) * LMP + 16 * bb + 4 * q4);
#pragma unroll
                    for (int jx = 0; jx < 4; ++jx) if (4 * q4 + jx > j) x[4 * q4 + jx] -= l4[jx] * x[j]; } }
            unsigned pw[8];
#pragma unroll
            for (int r = 0; r < 16; r += 2) { pw[r >> 1] = pk2(x[r], x[r + 1]); TM[(16 * bb + r) * P64 + 16 * bb + c] = (bf16)(pw[r >> 1] & 0xffffu); TM[(16 * bb + r + 1) * P64 + 16 * bb + c] = (bf16)(pw[r >> 1] >> 16); }
            *(LAS u32x4*)(TT + (16 * bb + c) * P64 + 16 * bb) = (u32x4){pw[0], pw[1], pw[2], pw[3]};
            *(LAS u32x4*)(TT + (16 * bb + c) * P64 + 16 * bb + 8) = (u32x4){pw[4], pw[5], pw[6], pw[7]}; }
        LDS_BARRIER();
#pragma unroll 1
        for (int lev = 1; lev < 4; ++lev) {
            if (w < 4 - lev) { const int bj = w, bi = w + lev;
                f32x4 m = (f32x4){0.f, 0.f, 0.f, 0.f};
#pragma unroll
                for (int ks = 0; ks < 2; ++ks) { const bf16x8 a = *(const LAS bf16x8*)(LR + (16 * bi + l15) * P64 + 32 * ks + quad * 8), bq = *(const LAS bf16x8*)(TT + (16 * bj + l15) * P64 + 32 * ks + quad * 8); m = mfma16(a, bq, m); }
                const u32x2 tl = *(const LAS u32x2*)(TM + (16 * bi + l15) * P64 + 16 * bi + quad * 4);
                const bf16x8 a2 = __builtin_bit_cast(bf16x8, (u32x4){tl.x, tl.y, 0u, 0u}), b2 = __builtin_bit_cast(bf16x8, (u32x4){pk2(m[0], m[1]), pk2(m[2], m[3]), 0u, 0u});
                const f32x4 t = mfma16(a2, b2, (f32x4){0.f, 0.f, 0.f, 0.f});
                const unsigned p0 = pk2(-t[0], -t[1]), p1 = pk2(-t[2], -t[3]);
                TM[(16 * bi + quad * 4 + 0) * P64 + 16 * bj + l15] = (bf16)(p0 & 0xffffu); TM[(16 * bi + quad * 4 + 1) * P64 + 16 * bj + l15] = (bf16)(p0 >> 16);
                TM[(16 * bi + quad * 4 + 2) * P64 + 16 * bj + l15] = (bf16)(p1 & 0xffffu); TM[(16 * bi + quad * 4 + 3) * P64 + 16 * bj + l15] = (bf16)(p1 >> 16);
                *(LAS u32x2*)(TT + (16 * bj + l15) * P64 + 16 * bi + quad * 4) = (u32x2){p0, p1}; }
            LDS_BARRIER();
        }
#ifndef NO_EFG
        bf16x8 Bst[4];
#pragma unroll
        for (int ks = 0; ks < 4; ++ks) Bst[ks] = pack_acc2(Sacc[2 * ks], Sacc[2 * ks + 1]);
        f32x4 vn[4];
#pragma unroll
        for (int mt = 0; mt < 4; ++mt) { f32x4 acc = (f32x4){0.f, 0.f, 0.f, 0.f};
#pragma unroll
            for (int ks = 0; ks < 4; ++ks) { const bf16x8 a = ld_split8(Ks + (16 * mt + l15) * P128 + 32 * ks + quad * 4); acc = mfma16(a, Bst[ks], acc); }
#pragma unroll
            for (int jj = 0; jj < 4; ++jj) { const int i = 16 * mt + quad * 4 + jj; vn[mt][jj] = bf2f(Vs[i * P128 + 16 * w + l15]) * betas[i] - acc[jj]; } }
        bf16x8 Bvn[2];
#pragma unroll
        for (int k2 = 0; k2 < 2; ++k2) Bvn[k2] = pack_acc2(vn[2 * k2], vn[2 * k2 + 1]);
#pragma unroll
        for (int mt = 0; mt < 4; ++mt) { f32x4 acc = (f32x4){0.f, 0.f, 0.f, 0.f};
#pragma unroll
            for (int k2 = 0; k2 < 2; ++k2) { const bf16x8 a = ld_split8(TM + (16 * mt + l15) * P64 + 32 * k2 + quad * 4); acc = mfma16(a, Bvn[k2], acc); }
            vn[mt] = acc; }
#pragma unroll
        for (int k2 = 0; k2 < 2; ++k2) Bvn[k2] = pack_acc2(vn[2 * k2], vn[2 * k2 + 1]);
#pragma unroll 1
        for (int mt = 0; mt < 4; ++mt) { f32x4 acc = (f32x4){0.f, 0.f, 0.f, 0.f};
#pragma unroll
            for (int ks = 0; ks < 4; ++ks) { const bf16x8 a = ld_split8(Qs + (16 * mt + l15) * P128 + 32 * ks + quad * 4); acc = mfma16(a, Bst[ks], acc); }
#pragma unroll
            for (int jj = 0; jj < 4; ++jj) { const int i = 16 * mt + quad * 4 + jj; acc[jj] *= rq[i] * egs[i]; }
#pragma unroll
            for (int k2 = 0; k2 < 2; ++k2) { const bf16x8 a = ld_split8(QKs + (16 * mt + l15) * P64 + 32 * k2 + quad * 4); acc = mfma16(a, Bvn[k2], acc); }
#pragma unroll
            for (int jj = 0; jj < 4; ++jj) { const int i = 16 * mt + quad * 4 + jj; const int t = c0 + (dir ? 63 - i : i);
                Odir[(size_t)(m0 + t) * 512 + hd * 128 + 16 * w + l15] = (bf16)f2bf(acc[jj]); } }
        const float egl = rq[384];
#pragma unroll
        for (int mt = 0; mt < 8; ++mt) { f32x4 acc = Sacc[mt] * egl;
#pragma unroll
            for (int k2 = 0; k2 < 2; ++k2) { const bf16x8 a = ld_split8(KT + (16 * mt + l15) * P64 + 32 * k2 + quad * 4); acc = mfma16(a, Bvn[k2], acc); }
            Sacc[mt] = acc; }
#endif
        WAVE_SYNC();
    }
    if (!lat) { const int tid2 = tid_fresh(wid0), lane2 = tid2 & 63; float* dp = P.out + OUT_DELTA + sbase + (size_t)((lane2 >> 4) * 4) * 128 + 16 * w + (lane2 & 15);
#pragma unroll
        for (int mt = 0; mt < 8; ++mt)
#pragma unroll
            for (int jj = 0; jj < 4; ++jj) dp[(16 * mt + jj) * 128] = Sacc[mt][jj];
    }
    __syncthreads();
}

__device__ __forceinline__ void phase_mix_even(int wid0, const Params& P, LAS unsigned char* lds, int e, int mode = 3) {
    const int bid = bid_fresh(), G = grid_fresh();
    if (G == 256) {
        if (bid < 64) { const int s = 32 + (bid >> 3), hd = (bid >> 1) & 3, dir = bid & 1; if (mode & 1) gdn_chain(wid0, P, lds, e, s, hd, dir); }
        else { const int bb = bid - 64;
            if (mode & 1) for (int c = bb; c < 256; c += 192) { const int s = c >> 3, hd = (c >> 1) & 3, dir = c & 1; gdn_chain(wid0, P, lds, e, s, hd, dir); }
            if (mode & 2) { const int tid = tid_fresh(wid0), lane = tid & 63, wave = tid >> 6;
                for (int t = bb; t < 384; t += 192) { const int wt = t * 8 + wave; s5_task_main(P, lds + wave * S5_WLDS, lane, e, wt >> 5, wt & 31); } }
            if (mode == 3) { __syncthreads(); const int tid = tid_fresh(wid0), lane = tid & 63, wave = tid >> 6;
                for (int it = bb * NWAVES + wave; it < WITEMS_ODD; it += 192 * NWAVES) weight_item(P, (LAS float*)(lds + wave * 16384), 2 * e + 1, it, lane); } }
    } else {
        for (int c = bid; c < 320; c += G) { const int s = c < 64 ? 32 + (c >> 3) : ((c - 64) >> 3), hd = (c >> 1) & 3, dir = c & 1; gdn_chain(wid0, P, lds, e, s, hd, dir); }
        const int tid = tid_fresh(wid0), lane = tid & 63, wave = tid >> 6;
        for (int t = bid; t < 384; t += G) { const int wt = t * 8 + wave; s5_task_main(P, lds + wave * S5_WLDS, lane, e, wt >> 5, wt & 31); }
        __syncthreads();
        for (int it = bid * NWAVES + wave; it < WITEMS_ODD; it += G * NWAVES) weight_item(P, (LAS float*)(lds + wave * 16384), 2 * e + 1, it, lane);
    }
}
__device__ __forceinline__ void phase_fin_even(int wid0, const Params& P, LAS unsigned char* lds, int e, int dry = 0) {
    const int tid = tid_fresh(wid0), lane = tid & 63, wave = tid >> 6;
    const int gw = bid_fresh() * NWAVES + wave, NGW = grid_fresh() * NWAVES;
    for (int wt = gw; wt < 2048; wt += NGW) s5_task_corr(P, lds + wave * S5_WLDS, lane, e, wt >> 5, wt & 31, dry);
    const bf16* proj = (const bf16*)(P.ws + WS_BIG); const bf16* Of = (const bf16*)(P.ws + WS_H); const bf16* Ob = Of + (size_t)MT * 512; bf16* mixout = (bf16*)(P.ws + WS_MIX);
    float gnv[8];
#pragma unroll
    for (int j = 0; j < 8; ++j) gnv[j] = P.in[I_GONORM][e * 128 + (lane & 15) * 8 + j];
    for (int mb2 = gw; mb2 < MT; mb2 += 2 * NGW) {
        u32x4 a[2], bq[2], z[2];
#pragma unroll
        for (int u = 0; u < 2; ++u) { const int m = mb2 + u * NGW; if (m < MT) { a[u] = *(const u32x4*)(Of + (size_t)m * 512 + lane * 8); bq[u] = *(const u32x4*)(Ob + (size_t)m * 512 + lane * 8); z[u] = *(const u32x4*)(proj + (size_t)m * NPROJ_E + 2560 + lane * 8); } }
#pragma unroll
        for (int u = 0; u < 2; ++u) { const int m = mb2 + u * NGW; if (m < MT) {
            float o[8]; float ss = 0.f;
#pragma unroll
            for (int j = 0; j < 4; ++j) { o[2 * j] = bflo(a[u][j]) + bflo(bq[u][j]); o[2 * j + 1] = bfhi(a[u][j]) + bfhi(bq[u][j]); ss += o[2 * j] * o[2 * j] + o[2 * j + 1] * o[2 * j + 1]; }
            ss += shfl_i(ss, lane ^ 1); ss += shfl_i(ss, lane ^ 2); ss += shfl_i(ss, lane ^ 4); ss += shfl_i(ss, lane ^ 8);
            const float rs = rsqrtf(ss * (1.0f / 128.0f) + EPSF);
            unsigned pw[4];
#pragma unroll
            for (int j = 0; j < 4; ++j) { const float z0 = bflo(z[u][j]), z1 = bfhi(z[u][j]); pw[j] = pk2(o[2 * j] * rs * gnv[2 * j] * siluf_(z0), o[2 * j + 1] * rs * gnv[2 * j + 1] * siluf_(z1)); }
            if (!dry) *(u32x4*)(mixout + (size_t)m * DM + 512 + lane * 8) = (u32x4){pw[0], pw[1], pw[2], pw[3]}; } }
    }
}

__device__ __forceinline__ void phase_conv_odd(int wid0, const Params& P, int o) {
    const int tid = tid_fresh(wid0), lane = tid & 63, wave = tid >> 6;
    const int gw = bid_fresh() * NWAVES + wave, NGW = grid_fresh() * NWAVES;
    const bf16* proj = (const bf16*)(P.ws + WS_BIG); bf16* cx = (bf16*)(P.ws + WS_H);
    const float* cw = P.in[I_LCONVW] + (size_t)o * 4 * 1024; const float* cb = P.in[I_LCONVB] + o * 1024;
    float wv[2][4][8], bv[2][8];
#pragma unroll
    for (int h2 = 0; h2 < 2; ++h2) { const int ch = lane * 8 + 512 * h2;
#pragma unroll
        for (int j = 0; j < 8; ++j) { bv[h2][j] = cb[ch + j];
#pragma unroll
            for (int k = 0; k < 4; ++k) wv[h2][k][j] = cw[k * 1024 + ch + j]; } }
    for (int m = gw; m < MT; m += NGW) {
        const int t = m < MCTX ? (m & 255) : ((m - MCTX) & 2047); const int L = m < MCTX ? LCTX : LLAT;
        u32x4 xr[2][4];
#pragma unroll
        for (int k = 0; k < 4; ++k) { const int tt = t - 1 + k; const bool ok = (tt >= 0) && (tt < L); const size_t row = (size_t)(ok ? m - 1 + k : m);
#pragma unroll
            for (int h2 = 0; h2 < 2; ++h2) { const u32x4 v = *(const u32x4*)(proj + row * 2048 + lane * 8 + 512 * h2); xr[h2][k] = ok ? v : (u32x4){0u, 0u, 0u, 0u}; } }
#pragma unroll
        for (int h2 = 0; h2 < 2; ++h2) { const int ch = lane * 8 + 512 * h2;
            float acc[8];
#pragma unroll
            for (int j = 0; j < 8; ++j) acc[j] = bv[h2][j];
#pragma unroll
            for (int k = 0; k < 4; ++k)
#pragma unroll
                for (int j = 0; j < 4; ++j) { acc[2 * j] += wv[h2][k][2 * j] * bflo(xr[h2][k][j]); acc[2 * j + 1] += wv[h2][k][2 * j + 1] * bfhi(xr[h2][k][j]); }
            *(u32x4*)(cx + (size_t)m * DM + ch) = (u32x4){pk2(acc[0], acc[1]), pk2(acc[2], acc[3]), pk2(acc[4], acc[5]), pk2(acc[6], acc[7])}; }
    }
}
__device__ __forceinline__ void phase_lru_scan(int wid0, const Params& P, LAS unsigned char* lds, int o, int d) {
    const int tid = tid_fresh(wid0), lane = tid & 63, wave = tid >> 6;
    const int gw = bid_fresh() * NWAVES + wave, NGW = grid_fresh() * NWAVES;
    const unsigned* G = (const unsigned*)(P.ws + WS_GATES); const bf16* proj = (const bf16*)(P.ws + WS_BIG); bf16* mixout = (bf16*)(P.ws + WS_MIX);
    const int Gn = NGW / NWAVES, vw = wave * Gn + (gw / NWAVES);
    if (d == 0 && o == 0 && NGW > 640) {
        for (int it = vw - 640; it >= 0 && it < WITEMS_EVEN; it += NGW - 640) weight_item(P, (LAS float*)(lds + wave * 16384), 2, it, lane); }
    for (int task = vw; task < 640; task += NGW) {
        int s, cg_;
        if (task < 128) { s = 32 + (task >> 4); cg_ = task & 15; } else { s = (task - 128) >> 4; cg_ = (task - 128) & 15; }
        const bool lat = s >= 32; const int b = lat ? s - 32 : s; const int L = lat ? LLAT : LCTX; const int m0 = lat ? MCTX + b * LLAT : s * LCTX;
        const int ch = cg_ * 64 + lane;
        float h = lat ? P.in[I_SLRU][(((size_t)b * 2 + o) * 2 + d) * 1024 + ch] : 0.f;
        if (d == 0) {
            unsigned ga[32], gb[32];
#define LRU_LD0(dst, tt) _Pragma("unroll") for (int i = 0; i < 32; ++i) dst[i] = G[(size_t)(m0 + (tt) + i) * DM + ch]
#define LRU_CP0(src, tt) _Pragma("unroll") for (int i = 0; i < 32; ++i) { h = (1.0f - bflo(src[i])) * h + bfhi(src[i]); mixout[(size_t)(m0 + (tt) + i) * DM + ch] = (bf16)f2bf(h); }
            LRU_LD0(ga, 0);
            for (int t0 = 0; t0 < L; t0 += 64) {
                LRU_LD0(gb, t0 + 32);
                LRU_CP0(ga, t0);
                if (t0 + 64 < L) { LRU_LD0(ga, t0 + 64); }
                LRU_CP0(gb, t0 + 32);
            }
        } else {
            unsigned ga[16], gb[16]; bf16 pa[16], pb[16], ya[16], yb[16];
#define LRU_LD1(g_, p_, y_, tt) _Pragma("unroll") for (int i = 0; i < 16; ++i) { const size_t m = (size_t)(m0 + L - 1 - ((tt) + i)); g_[i] = G[m * DM + ch]; p_[i] = mixout[m * DM + ch]; y_[i] = proj[m * 2048 + 1024 + ch]; }
#define LRU_CP1(g_, p_, y_, tt) _Pragma("unroll") for (int i = 0; i < 16; ++i) { const size_t m = (size_t)(m0 + L - 1 - ((tt) + i)); \
                h = (1.0f - bflo(g_[i])) * h + bfhi(g_[i]); mixout[m * DM + ch] = (bf16)f2bf((bf2f(p_[i]) + h) * geluf_(bf2f(y_[i]))); }
            LRU_LD1(ga, pa, ya, 0);
            for (int t0 = 0; t0 < L; t0 += 32) {
                LRU_LD1(gb, pb, yb, t0 + 16);
                LRU_CP1(ga, pa, ya, t0);
                if (t0 + 32 < L) { LRU_LD1(ga, pa, ya, t0 + 32); }
                LRU_CP1(gb, pb, yb, t0 + 16);
            }
        }
        if (!lat) P.out[OUT_LRU + (((size_t)b * 2 + o) * 2 + d) * 1024 + ch] = h;
    }
}
#ifdef PROBE_DUP_GEMM
#define DUPG(x) GSYNC(); x
#else
#define DUPG(x)
#endif
typedef const __attribute__((address_space(4))) Params* KParams;
__device__ __forceinline__ Params load_params(KParams q) { Params r;
#pragma unroll
    for (int i = 0; i < 40; ++i) r.in[i] = q->in[i];
    r.out = q->out; r.ws = q->ws; return r; }
#define FRESH() const int G = grid_fresh(), bid = bid_fresh(); (void)G; (void)bid; KParams pk_ = (KParams)__builtin_amdgcn_kernarg_segment_ptr(); asm volatile("" : "+s"(pk_)); const Params P = load_params(pk_); unsigned char* ws = P.ws; \
    const float* mod = (const float*)(ws + WS_MOD); bf16* H = (bf16*)(ws + WS_H); bf16* BIG = (bf16*)(ws + WS_BIG); bf16* MIX = (bf16*)(ws + WS_MIX); (void)mod; (void)H; (void)BIG; (void)MIX;
#define GSYNC() do { KParams pb_ = (KParams)__builtin_amdgcn_kernarg_segment_ptr(); asm volatile("" : "+s"(pb_)); xcd_barrier(wid0, (unsigned*)(pb_->ws + WS_BAR), lds); } while (0)
__global__ void __launch_bounds__(NTHR, 2) fwd_kernel(Params Parg) {
    extern __shared__ __attribute__((aligned(16))) unsigned char lds_raw[];
    LAS unsigned char* lds = (LAS unsigned char*)lds_raw;
    cg::grid_group grid = cg::this_grid();
    const int wid0 = __builtin_amdgcn_readfirstlane(threadIdx.x >> 6);
    if (threadIdx.x < 4) ((LAS unsigned*)(lds + LDS_BARST))[threadIdx.x] = 0u;
    __syncthreads();
    if (threadIdx.x == 0) (void)xb_add((unsigned*)(Parg.ws + WS_BAR) + XB_XCNT(xb_xcc_id()), 1u);

    { FRESH(); phase_prologue(wid0, P, lds); }
    if (grid_fresh() == 0) grid.sync();
    GSYNC();
#ifdef PROBE_DUP_PRO
    { FRESH(); phase_prologue(wid0, P, lds); }
    GSYNC();
#endif
    { FRESH(); phase_modreduce(wid0, P); }
    GSYNC();
#ifdef PROBE_SYNC
#pragma unroll 1
    for (int i = 0; i < 40; ++i) GSYNC();
#endif
#pragma unroll 1
    for (int l = 0; l < 4; ++l) {
        { FRESH(); const float* modl = mod + (size_t)l * 9 * 6144;
        phase_rownorm(wid0, P, l == 0, MIX, modl - 9 * 6144, 5 * 1024, P.in[I_NMLPPOST] + (l > 0 ? (l - 1) * 1024 : 0), 1, P.in[I_NMIXPRE] + l * 1024, modl, 0, H); }
        GSYNC();
        const int eo = l >> 1;
        {
            FRESH();
            pg8::Gemm g; pg8::StaticOrder S; EpiBf16<0> E;
            if ((l & 1) == 0) { g = pg8::Gemm{H, (const bf16*)(ws + WS_WINE) + (size_t)eo * NB_E * 1024, MT, NB_E, 1024, 1024, 0, 0, 1024, 0}; E = EpiBf16<0>{BIG, NPROJ_E, (float*)(ws + WS_AB), (bf16*)(ws + WS_HALO)}; }
            else { g = pg8::Gemm{H, (const bf16*)(ws + WS_WINO) + (size_t)eo * 2048 * 1024, MT, 2048, 1024, 1024, 0, 0, 1024, 0}; E = EpiBf16<0>{BIG, 2048, nullptr, nullptr}; }
            S.init(g.M, g.N, G, bid);
            pg8::gemm_phase(wid0, lds, g, S, E); DUPG(pg8::gemm_phase(wid0, lds, g, S, E);)
        }
        GSYNC();
        if ((l & 1) == 0) {
            { FRESH(); phase_conv_even(wid0, P, eo); }
            GSYNC();
#ifdef PROBE_DRY_CONVE
            { FRESH(); phase_conv_even(wid0, P, eo, grid_fresh() > 0); }
            GSYNC();
#endif
#ifdef PROBE_DUP_MIX
#pragma unroll 1
            for (int rep = 0; rep < 2; ++rep) { { FRESH(); phase_mix_even(wid0, P, lds, eo, rep == 0 ? 3 : PROBE_DUP_MIX); } GSYNC(); }
#else
            { FRESH(); phase_mix_even(wid0, P, lds, eo); }
            GSYNC();
#endif
            { FRESH(); phase_fin_even(wid0, P, lds, eo); }
            GSYNC();
#ifdef PROBE_DRY_FIN
            { FRESH(); phase_fin_even(wid0, P, lds, eo, grid_fresh() > 0); }
            GSYNC();
#endif
        } else {
            { FRESH(); phase_conv_odd(wid0, P, eo); }
            GSYNC();
#ifdef PROBE_DUP_CONV
            { FRESH(); phase_conv_odd(wid0, P, eo); }
            GSYNC();
#endif
#pragma unroll 1
            for (int d = 0; d < 2; ++d) {
                { FRESH();
                pg8::Gemm g{H, (const bf16*)(ws + WS_WG) + (size_t)(eo * 2 + d) * 2048 * 256, MT, 2048, 256, 1024, 1, 1, 256, 0};
                EpiGates E{(unsigned*)(ws + WS_GATES), H, P.in[I_LBR] + (eo * 2 + d) * 1024, P.in[I_LBI] + (eo * 2 + d) * 1024, P.in[I_LLAM] + (eo * 2 + d) * 1024};
                pg8::StaticOrder S; S.init(g.M, g.N, G, bid);
                pg8::gemm_phase(wid0, lds, g, S, E); DUPG(pg8::gemm_phase(wid0, lds, g, S, E);) }
                GSYNC();
                { FRESH(); phase_lru_scan(wid0, P, lds, eo, d); }
#ifdef PROBE_DUP_LRU0
                if (d == 0) { GSYNC(); FRESH(); phase_lru_scan(wid0, P, lds, eo, d); }
#endif
                GSYNC();
            }
        }
        {
            FRESH();
            pg8::Gemm g{MIX, (const bf16*)(ws + ((l & 1) ? WS_WOUTO : WS_WOUTE)) + (size_t)eo * 1024 * 1024, MT, 1024, 1024, 1024, 0, 0, 1024, 0};
            EpiBf16<0> E{BIG, 1024, nullptr, nullptr}; pg8::StaticOrder S; S.init(g.M, g.N, G, bid);
            pg8::gemm_phase(wid0, lds, g, S, E); DUPG(pg8::gemm_phase(wid0, lds, g, S, E);)
        }
        GSYNC();
        { FRESH(); const float* modl = mod + (size_t)l * 9 * 6144;
        phase_rownorm(wid0, P, 0, BIG, modl, 2 * 1024, P.in[I_NMIXPOST] + l * 1024, 1, P.in[I_NMLPPRE] + l * 1024, modl, 3 * 1024, H); }
#ifdef PROBE_DUP_RN
        GSYNC();
        { FRESH(); const float* modl = mod + (size_t)l * 9 * 6144;
        phase_rownorm(wid0, P, 0, BIG, modl, 2 * 1024, P.in[I_NMIXPOST] + l * 1024, 1, P.in[I_NMLPPRE] + l * 1024, modl, 3 * 1024, H, 0.0f); }
#endif
        GSYNC();
        {
            FRESH();
            pg8::Gemm g{H, (const bf16*)(ws + WS_W1T) + (size_t)l * 4096 * 1024, MT, 4096, 1024, 1024, 0, 0, 1024, 0};
            EpiBf16<1> E{BIG, 4096, nullptr, nullptr}; pg8::StaticOrder S; S.init(g.M, g.N, G, bid);
            pg8::gemm_phase(wid0, lds, g, S, E); DUPG(pg8::gemm_phase(wid0, lds, g, S, E);)
        }
        GSYNC();
        {
            FRESH();
            pg8::Gemm g{BIG, (const bf16*)(ws + WS_W2T) + (size_t)l * 1024 * 4096, MT, 1024, 4096, 4096, 0, 0, 4096, 0};
            EpiBf16<0> E{MIX, 1024, nullptr, nullptr}; pg8::StaticOrder S; S.init(g.M, g.N, G, bid);
            pg8::gemm_phase(wid0, lds, g, S, E); DUPG(pg8::gemm_phase(wid0, lds, g, S, E);)
        }
        GSYNC();
    }
    { FRESH();
    phase_rownorm(wid0, P, 0, MIX, mod + (size_t)3 * 9 * 6144, 5 * 1024, P.in[I_NMLPPOST] + 3 * 1024, 0, P.in[I_NMIXPRE], mod, 0, H); }
    GSYNC();
    { FRESH(); phase_copy_tail(wid0, P); }
}

extern "C" void kernel_launch(void* const* d_in, const int* in_sizes, int n_in, void* d_out, int out_size, void* d_ws, size_t ws_size, hipStream_t stream) {
    static int grid = 0;
    if (grid == 0) {
        if (n_in != 40 || ws_size < WS_END) { fprintf(stderr, "kernel_launch: expected 40 inputs and >= %zu bytes of workspace (got %d, %zu)\n", (size_t)WS_END, n_in, ws_size); grid = -1; return; }
        int dev = 0, cus = 0, per_cu = 0;
        if (hipGetDevice(&dev) != hipSuccess || hipDeviceGetAttribute(&cus, hipDeviceAttributeMultiprocessorCount, dev) != hipSuccess) { grid = -1; return; }
        if (hipFuncSetAttribute((const void*)fwd_kernel, hipFuncAttributeMaxDynamicSharedMemorySize, LDS_BYTES) != hipSuccess) { fprintf(stderr, "kernel_launch: hipFuncSetAttribute failed\n"); grid = -1; return; }
        if (hipOccupancyMaxActiveBlocksPerMultiprocessor(&per_cu, (const void*)fwd_kernel, NTHR, LDS_BYTES) != hipSuccess || per_cu < 1) per_cu = 1;
        (void)hipGetLastError();
        grid = cus * per_cu; if (grid > 256) grid = 256;
    }
    if (grid < 0) return;
    (void)hipMemsetAsync((char*)d_ws + WS_BAR, 0, 16384, stream);
    Params p{};
    for (int i = 0; i < 40; ++i) p.in[i] = (const float*)d_in[i];
    p.out = (float*)d_out; p.ws = (unsigned char*)d_ws;
    void* args[] = {&p};
    hipError_t e = hipLaunchCooperativeKernel((const void*)fwd_kernel, dim3(grid), dim3(NTHR), args, LDS_BYTES, stream);
    if (e != hipSuccess) fprintf(stderr, "cooperative launch failed: %s (grid %d)\n", hipGetErrorString(e), grid);
}
```

```cpp
#include <hip/hip_runtime.h>
#include <hip/hip_cooperative_groups.h>
#include <cstdio>
#include <cstdint>
namespace cg = cooperative_groups;
__device__ __forceinline__ int bid_fresh() { int t = blockIdx.x; asm volatile("" : "+s"(t)); return t; }
__device__ __forceinline__ int grid_fresh() { int t = gridDim.x; asm volatile("" : "+s"(t)); return t; }
__device__ __forceinline__ int tid_fresh(int w) { asm volatile("" : "+s"(w)); int l; asm volatile("v_mbcnt_lo_u32_b32 %0, -1, 0\n\tv_mbcnt_hi_u32_b32 %0, -1, %0" : "=v"(l)); return w * 64 + l; }

namespace pg8 {
#define PG8_LAS __attribute__((address_space(3)))
typedef unsigned short bf16_t;
typedef short bf16x8 __attribute__((ext_vector_type(8)));
typedef float f32x4 __attribute__((ext_vector_type(4)));
typedef unsigned u32x4 __attribute__((ext_vector_type(4)));
typedef unsigned u32x2 __attribute__((ext_vector_type(2)));
constexpr int BM = 256, BK = 64, HALF = 128, HTB = HALF * BK * 2, STAGE_BYTES = 8 * HTB, NXCD = 8, WGM = 4;

__host__ __device__ __forceinline__ int lds_byte(int r, int c) { const int st = (r >> 4) * 2 + (c >> 5), rr = r & 15, cc = c & 31, ob = rr * 64 + cc * 2; return st * 1024 + (ob ^ (((ob >> 9) & 1) << 5)); }
__host__ __device__ __forceinline__ void stage_rc(int b, int& R, int& C) { const int st = b / 1024, sb = b % 1024, swz = sb ^ (((sb >> 9) & 1) << 5); R = (st >> 1) * 16 + swz / 64; C = (st & 1) * 32 + (swz % 64) / 2; }
__host__ __device__ __forceinline__ int perm32(int rho) { const int n = rho >> 4, i = rho & 15; return 8 * (i >> 2) + 4 * n + (i & 3); }

struct Unit { int pm, pn; };
struct Gemm { const bf16_t* A; const bf16_t* Bt; int M, N, K, lda, ablk, ashift, ldb, ksplit; };

struct StaticOrder {
    int nM, nN, nwg, G, c;
    __host__ __device__ void init(int M, int N, int G_, int c_) { nM = M / BM; nN = N / BM; nwg = nM * nN; G = G_; c = c_; }
    __host__ __device__ bool next(int i, Unit& u) const {
        const long L = (long)i * G + c; if (L >= nwg) return false;
        int wgid = (int)L; { const int q = nwg / NXCD, r = nwg % NXCD, xcd = wgid % NXCD, off = wgid / NXCD; wgid = (xcd < r ? xcd * (q + 1) : r * (q + 1) + (xcd - r) * q) + off; }
        const int nig = WGM * nN, gid = wgid / nig, fm = gid * WGM, gsz = (nM - fm) < WGM ? (nM - fm) : WGM;
        u.pm = fm + ((wgid % nig) % gsz); u.pn = (wgid % nig) / gsz; return true;
    }
};
__device__ __forceinline__ unsigned cvt_pk_bf16(float lo, float hi) { unsigned r; asm volatile("v_cvt_pk_bf16_f32 %0, %1, %2" : "=v"(r) : "v"(lo), "v"(hi)); return r; }

template <class Epi>
__device__ __forceinline__ void gemm_phase(int wid0, PG8_LAS unsigned char* lds, const Gemm g, const StaticOrder& S, const Epi& E) {
    const int tid = tid_fresh(wid0), wid = __builtin_amdgcn_readfirstlane(tid >> 6), lane = tid & 63, wr = wid >> 2, wc = wid & 3, fr = lane & 15, fq = lane >> 4;
    const int K = g.K, nt = K / BK, lda = g.lda, ldb = g.ldb;
    unsigned voffA[2], voffB[2];
#pragma unroll
    for (int i = 0; i < 2; ++i) { int R, C; stage_rc(tid * 16 + i * 8192, R, C); const int Rb = (R & ~31) + perm32(R & 31);
        voffA[i] = (unsigned)(R * lda + C) * 2u; voffB[i] = (unsigned)(Rb * ldb + C) * 2u; }
    const size_t kstep = (size_t)(BK * 2);
    const size_t hstepA = (size_t)HALF * lda * 2, hstepB = (size_t)HALF * ldb * 2;
    const size_t tstepA = 2 * hstepA, tstepB = 2 * hstepB;
    const unsigned ldsw = (unsigned)wid * 1024u;
    const int aoff = lds_byte(wr * 64 + fr, fq * 8), boff = lds_byte(wc * 32 + fr, fq * 8);
#define PG8_ACOL(pn) (g.ablk ? (size_t)((((pn) >> g.ashift) & 3) * 512) : (g.ksplit ? (size_t)((pn) & 1) * (size_t)K * 2 : (size_t)0))
#define PG8_BOFF(pn) (g.ksplit ? (size_t)((pn) >> 1) * tstepB + (size_t)((pn) & 1) * (size_t)K * 2 : (size_t)(pn) * tstepB)
#define PG8_SA(b, h) (((b) * 2 + (h)) * HTB)
#define PG8_SB(b, h) ((4 + (b) * 2 + (h)) * HTB)
#define PG8_STAGE(bufoff, gbase, voff) do { _Pragma("unroll") for (int _i = 0; _i < 2; ++_i) \
        __builtin_amdgcn_global_load_lds((const unsigned*)((const char*)(gbase) + (voff)[_i]), (PG8_LAS unsigned*)(lds + (bufoff) + ldsw + _i * 8192), 16, 0, 0); } while (0)
#define PG8_LDA(dst, b, h) do { _Pragma("unroll") for (int m = 0; m < 4; ++m) _Pragma("unroll") for (int k = 0; k < 2; ++k) dst[m][k] = *(const PG8_LAS bf16x8*)(lds + PG8_SA(b, h) + aoff + m * 2048 + k * 1024); } while (0)
#define PG8_LDB(dst, b, h) do { _Pragma("unroll") for (int n = 0; n < 2; ++n) _Pragma("unroll") for (int k = 0; k < 2; ++k) dst[n][k] = *(const PG8_LAS bf16x8*)(lds + PG8_SB(b, h) + boff + n * 2048 + k * 1024); } while (0)
#define PG8_MMA(ai, bj, At, Bt) do { __builtin_amdgcn_s_setprio(1); _Pragma("unroll") for (int m = 0; m < 4; ++m) _Pragma("unroll") for (int n = 0; n < 2; ++n) _Pragma("unroll") for (int k = 0; k < 2; ++k) \
        acc[ai][bj][m][n] = __builtin_amdgcn_mfma_f32_16x16x32_bf16(Bt[n][k], At[m][k], acc[ai][bj][m][n], 0, 0, 0); __builtin_amdgcn_s_setprio(0); } while (0)
#define PG8_WAIT_V(n) asm volatile("s_waitcnt vmcnt(" #n ")" ::: "memory")
#define PG8_WAIT_L(n) asm volatile("s_waitcnt lgkmcnt(" #n ")" ::: "memory")
#define PG8_BAR __builtin_amdgcn_s_barrier()
#define PG8_SCHED __builtin_amdgcn_sched_barrier(0)
    Unit cur, nxt; int ui = 0;
    if (!S.next(0, cur)) return;
    f32x4 acc[2][2][4][2];
#pragma unroll
    for (int a = 0; a < 2; ++a)
#pragma unroll
        for (int b = 0; b < 2; ++b)
#pragma unroll
            for (int m = 0; m < 4; ++m)
#pragma unroll
                for (int n = 0; n < 2; ++n) acc[a][b][m][n] = (f32x4){0.f, 0.f, 0.f, 0.f};
    bf16x8 At[4][2], B0[2][2], B1[2][2];
    const char* cA = (const char*)g.A + (size_t)cur.pm * tstepA + PG8_ACOL(cur.pn); const char* cB = (const char*)g.Bt + PG8_BOFF(cur.pn);
    PG8_STAGE(PG8_SB(0, 0), cB, voffB); PG8_STAGE(PG8_SA(0, 0), cA, voffA); PG8_STAGE(PG8_SB(0, 1), cB + hstepB, voffB); PG8_STAGE(PG8_SA(0, 1), cA + hstepA, voffA);
    if (wr == 1) PG8_BAR;
    PG8_WAIT_V(4); PG8_BAR;
    PG8_STAGE(PG8_SB(1, 0), cB + kstep, voffB); PG8_STAGE(PG8_SA(1, 0), cA + kstep, voffA); PG8_STAGE(PG8_SB(1, 1), cB + hstepB + kstep, voffB);
    PG8_WAIT_V(6); PG8_BAR;
    for (;;) {
        const bool has_next = S.next(ui + 1, nxt);
        const char* nA = has_next ? (const char*)g.A + (size_t)nxt.pm * tstepA + PG8_ACOL(nxt.pn) : cA; const char* nB = has_next ? (const char*)g.Bt + PG8_BOFF(nxt.pn) : cB;
        for (int t = 0; t < nt; t += 2) {
            const bool last = (t == nt - 2);
            const char* a1 = cA + (size_t)(t + 1) * kstep;
            const char* a2 = last ? nA : cA + (size_t)(t + 2) * kstep; const char* b2 = last ? nB : cB + (size_t)(t + 2) * kstep;
            const char* a3 = a2 + kstep; const char* b3 = b2 + kstep;
            PG8_LDB(B0, 0, 0); PG8_SCHED; PG8_LDA(At, 0, 0); PG8_STAGE(PG8_SA(1, 1), a1 + hstepA, voffA);
            PG8_WAIT_L(8); PG8_BAR; PG8_WAIT_L(0); PG8_MMA(0, 0, At, B0); PG8_BAR; PG8_SCHED;
            PG8_LDB(B1, 0, 1); PG8_STAGE(PG8_SB(0, 0), b2, voffB);
            PG8_BAR; PG8_WAIT_L(0); PG8_MMA(0, 1, At, B1); PG8_BAR;
            PG8_LDA(At, 0, 1); PG8_STAGE(PG8_SA(0, 0), a2, voffA);
            PG8_BAR; PG8_WAIT_L(0); PG8_MMA(1, 0, At, B0); PG8_BAR; PG8_SCHED;
            PG8_STAGE(PG8_SB(0, 1), b2 + hstepB, voffB);
            PG8_WAIT_V(6); PG8_BAR; PG8_MMA(1, 1, At, B1); PG8_BAR;
            PG8_LDB(B0, 1, 0); PG8_SCHED; PG8_LDA(At, 1, 0); PG8_STAGE(PG8_SA(0, 1), a2 + hstepA, voffA);
            PG8_WAIT_L(8); PG8_BAR; PG8_WAIT_L(0); PG8_MMA(0, 0, At, B0); PG8_BAR; PG8_SCHED;
            PG8_LDB(B1, 1, 1); PG8_STAGE(PG8_SB(1, 0), b3, voffB);
            PG8_BAR; PG8_WAIT_L(0); PG8_MMA(0, 1, At, B1); PG8_BAR;
            PG8_LDA(At, 1, 1); PG8_STAGE(PG8_SA(1, 0), a3, voffA);
            PG8_BAR; PG8_WAIT_L(0); PG8_MMA(1, 0, At, B0); PG8_BAR; PG8_SCHED;
            PG8_STAGE(PG8_SB(1, 1), b3 + hstepB, voffB);
            PG8_WAIT_V(6); PG8_BAR; PG8_MMA(1, 1, At, B1); PG8_BAR;
        }
        E(acc, cur, wr, wc, fr, fq);
        if (!has_next) break;
#pragma unroll
        for (int a = 0; a < 2; ++a)
#pragma unroll
            for (int b = 0; b < 2; ++b)
#pragma unroll
                for (int m = 0; m < 4; ++m)
#pragma unroll
                    for (int n = 0; n < 2; ++n) acc[a][b][m][n] = (f32x4){0.f, 0.f, 0.f, 0.f};
        cur = nxt; cA = nA; cB = nB; ++ui;
    }
    PG8_WAIT_V(0);
    if (wr == 0) PG8_BAR;
    PG8_BAR;
#undef PG8_ACOL
#undef PG8_BOFF
#undef PG8_SA
#undef PG8_SB
#undef PG8_STAGE
#undef PG8_LDA
#undef PG8_LDB
#undef PG8_MMA
#undef PG8_WAIT_V
#undef PG8_WAIT_L
#undef PG8_BAR
#undef PG8_SCHED
}
}
#define LAS __attribute__((address_space(3)))
typedef unsigned short bf16;
typedef short bf16x8 __attribute__((ext_vector_type(8)));
typedef float f32x4 __attribute__((ext_vector_type(4)));
typedef unsigned u32x4 __attribute__((ext_vector_type(4)));
typedef unsigned u32x2 __attribute__((ext_vector_type(2)));
constexpr int DM = 1024, MT = 24576, MCTX = 8192, LCTX = 256, LLAT = 2048, NWAVES = 8, NTHR = 512;
constexpr int NPROJ_E = 3072, NB_E = 3328, IN_EVEN_LD = 3088;
constexpr float EPSF = 1e-6f;
constexpr size_t MiB = 1u << 20;
constexpr size_t WS_MOD = 0, MOD_BYTES = 4 * 9 * 6144 * 4, WS_S5F = 1 * MiB, WS_AB = 3 * MiB, WS_W1T = 5 * MiB, WS_W2T = 37 * MiB, WS_WINE = 69 * MiB,
                 WS_WOUTE = 82 * MiB, WS_WINO = 86 * MiB, WS_WOUTO = 94 * MiB, WS_WG = 98 * MiB, WS_H = 102 * MiB, WS_BIG = 150 * MiB, WS_YBUF = 294 * MiB,
                 WS_GATES = 246 * MiB, WS_MIX = 342 * MiB, WS_HALO = 390 * MiB, WS_END = 390 * MiB + 384 * 3 * 1536 * 2;
constexpr int LDS_BYTES = 147456;
constexpr size_t OUT_S5RE = 25165824, OUT_S5IM = OUT_S5RE + 262144, OUT_DELTA = OUT_S5IM + 262144, OUT_LRU = OUT_DELTA + 8388608;

struct Params { const float* in[40]; float* out; unsigned char* ws; };
enum { I_XP = 0, I_XS, I_S5RE, I_S5IM, I_SDELTA, I_SLRU, I_C, I_CCTX, I_WADA, I_BADA, I_NMIXPRE, I_NMIXPOST, I_NMLPPRE, I_NMLPPOST, I_WMLPIN, I_WMLPOUT, I_WINE, I_WOUTE,
       I_LAMRE, I_LAMIM, I_LOGDT, I_BRE, I_BIM, I_CRE, I_CIM, I_S5D, I_GCONVW, I_GCONVB, I_GALOG, I_GDTB, I_GONORM, I_WINO, I_WOUTO, I_LCONVW, I_LCONVB, I_LWR, I_LBR, I_LWI, I_LBI, I_LLAM };

typedef __bf16 bf2_t __attribute__((ext_vector_type(2)));
typedef float f2_t __attribute__((ext_vector_type(2)));
__device__ __forceinline__ unsigned pk2(float lo, float hi) { const bf2_t v = __builtin_convertvector((f2_t){lo, hi}, bf2_t); return __builtin_bit_cast(unsigned, v); }
__device__ __forceinline__ unsigned f2bf(float f) { return pk2(f, f) & 0xffffu; }
__device__ __forceinline__ float bflo(unsigned w) { return __builtin_bit_cast(float, w << 16); }
__device__ __forceinline__ float bfhi(unsigned w) { return __builtin_bit_cast(float, w & 0xffff0000u); }
__device__ __forceinline__ float bf2f(bf16 b) { return __builtin_bit_cast(float, (unsigned)b << 16); }
__device__ __forceinline__ float sigmoidf_(float x) { return __builtin_amdgcn_rcpf(1.0f + __expf(-x)); }
__device__ __forceinline__ float siluf_(float x) { return x * sigmoidf_(x); }
__device__ __forceinline__ float softplusf_(float x) { return fmaxf(x, 0.f) + __logf(1.0f + __expf(-fabsf(x))); }
__device__ __forceinline__ float geluf_(float x) { const float y = 0.7978845608028654f * (x + 0.044715f * x * x * x); const float t = 1.0f - 2.0f * __builtin_amdgcn_rcpf(__expf(2.0f * y) + 1.0f); return 0.5f * x * (1.0f + t); }
__device__ __forceinline__ float shfl_i(float v, int srclane) { return __builtin_bit_cast(float, __builtin_amdgcn_ds_bpermute(srclane << 2, __builtin_bit_cast(int, v))); }
__device__ __forceinline__ float dpp_f(float v, int ctrl_xor1) { return v; }
__device__ __forceinline__ float wave_sum(float v, int lane) {
    (void)lane;
    v += __builtin_bit_cast(float, __builtin_amdgcn_update_dpp(0, __builtin_bit_cast(int, v), 0xB1, 0xF, 0xF, true));
    v += __builtin_bit_cast(float, __builtin_amdgcn_update_dpp(0, __builtin_bit_cast(int, v), 0x4E, 0xF, 0xF, true));
    v += __builtin_bit_cast(float, __builtin_amdgcn_update_dpp(0, __builtin_bit_cast(int, v), 0x141, 0xF, 0xF, true));
    v += __builtin_bit_cast(float, __builtin_amdgcn_update_dpp(0, __builtin_bit_cast(int, v), 0x140, 0xF, 0xF, true));
    const int iv = __builtin_bit_cast(int, v);
    return (__builtin_bit_cast(float, __builtin_amdgcn_readlane(iv, 0)) + __builtin_bit_cast(float, __builtin_amdgcn_readlane(iv, 16))) +
           (__builtin_bit_cast(float, __builtin_amdgcn_readlane(iv, 32)) + __builtin_bit_cast(float, __builtin_amdgcn_readlane(iv, 48)));
}
#define LDS_WAIT() asm volatile("s_waitcnt lgkmcnt(0)" ::: "memory")
#define WAVE_SYNC() do { asm volatile("s_waitcnt lgkmcnt(0)" ::: "memory"); __builtin_amdgcn_wave_barrier(); } while (0)
__device__ __forceinline__ f32x4 mfma16(bf16x8 a, bf16x8 b, f32x4 c) { return __builtin_amdgcn_mfma_f32_16x16x32_bf16(a, b, c, 0, 0, 0); }


#define XB_TMO      128
#define XB_XCNT(j)  (256  + 64 * (j))
#define XB_XSUB(j)  (1280 + 64 * (j))
#define XB_XGEN(j)  (2304 + 64 * (j))
#define XB_TOP      3328
#define XB_TOPGEN   3392
#define XCD_BAR_WORDS 3456
#define XB_SPIN_CAP (1u << 18)
constexpr size_t WS_BAR = 960 * 1024; constexpr int LDS_BARST = LDS_BYTES - 16;
__device__ __forceinline__ unsigned xb_ld(unsigned* p)              { return __hip_atomic_load(p, __ATOMIC_RELAXED, __HIP_MEMORY_SCOPE_AGENT); }
__device__ __forceinline__ unsigned xb_add(unsigned* p, unsigned v) { return __hip_atomic_fetch_add(p, v, __ATOMIC_RELAXED, __HIP_MEMORY_SCOPE_AGENT); }
__device__ __forceinline__ unsigned xb_xcc_id() { return (unsigned)__builtin_amdgcn_s_getreg((3 << 11) | 20) & 0xFu; }
#define XB_SPIN(cond, bar) do { unsigned _sp = 0; while (cond) { __builtin_amdgcn_s_sleep(1); \
    if ((++_sp & 255u) == 0u) { if (xb_ld(&(bar)[XB_TMO])) break; if (_sp > XB_SPIN_CAP) { atomicAdd(&(bar)[XB_TMO], 1u); break; } } } } while (0)
__device__ __forceinline__ void xcd_barrier_complete(unsigned* bar, unsigned x, unsigned& nloc, unsigned& nx) {
    const unsigned G = gridDim.x;
    unsigned sum, cnt, mine, sp = 0u;
    for (;;) {
        sum = 0u; cnt = 0u; mine = 0u;
#pragma unroll
        for (unsigned j = 0; j < 16; ++j) { const unsigned c = xb_ld(&bar[XB_XCNT(j)]); sum += c; cnt += (c > 0u) ? 1u : 0u; mine = (j == x) ? c : mine; }
        if (sum == G) break;
        __builtin_amdgcn_s_sleep(1);
        if ((++sp & 255u) == 0u) { if (xb_ld(&bar[XB_TMO])) break; if (sp > XB_SPIN_CAP) { atomicAdd(&bar[XB_TMO], 1u); break; } }
    }
    nloc = mine > 0u ? mine : 1u; nx = cnt > 0u ? cnt : 1u;
}
__device__ __forceinline__ void xcd_barrier(int wid0, unsigned* bar, LAS unsigned char* lds) {
    const int tid = tid_fresh(wid0);
    asm volatile("s_waitcnt vmcnt(0)" ::: "memory");
    __syncthreads();
    if (tid == 0) {
        const unsigned x = xb_xcc_id();
        volatile LAS unsigned* st = (volatile LAS unsigned*)(lds + LDS_BARST);
        __builtin_amdgcn_s_waitcnt(0);
        unsigned nloc = st[0], nx = st[1];
        if (nloc == 0u) { xcd_barrier_complete(bar, x, nloc, nx); st[0] = nloc; st[1] = nx; }
        const unsigned old = xb_add(&bar[XB_XSUB(x)], 1u);
        const unsigned gen = old / nloc;
        if (old + 1u == (gen + 1u) * nloc) {
            __builtin_amdgcn_fence(__ATOMIC_RELEASE, "agent");
            asm volatile("s_waitcnt vmcnt(0)" ::: "memory");
            const unsigned og = xb_add(&bar[XB_TOP], 1u);
            const unsigned tg = og / nx;
            if (og + 1u == (tg + 1u) * nx) xb_add(&bar[XB_TOPGEN], 1u);
            else XB_SPIN(xb_ld(&bar[XB_TOPGEN]) == tg, bar);
            __builtin_amdgcn_fence(__ATOMIC_ACQUIRE, "agent");
            xb_add(&bar[XB_XGEN(x)], 1u);
            asm volatile("s_waitcnt vmcnt(0)" ::: "memory");
        } else {
            XB_SPIN(xb_ld(&bar[XB_XGEN(x)]) == gen, bar);
            __builtin_amdgcn_fence(__ATOMIC_ACQUIRE, "agent");
            asm volatile("s_waitcnt vmcnt(0)" ::: "memory");
        }
    }
    __syncthreads();
}
__device__ __forceinline__ void transpose_item(const float* W, int ldw, int nvalid, int K, bf16* WT, int dst_row0, LAS float* scr, int k0, int n0, int lane) {
    const int nn = n0 + (lane & 31); const bool ok = nn < nvalid;
#pragma unroll
    for (int i = 0; i < 32; ++i) { const int kk = 2 * i + (lane >> 5); scr[kk * 33 + (lane & 31)] = ok ? W[(size_t)(k0 + kk) * ldw + nn] : 0.f; }
    WAVE_SYNC();
    const int c = lane & 7;
#pragma unroll
    for (int j = 0; j < 4; ++j) { const int n = (lane >> 3) + 8 * j; const LAS float* s = scr + (8 * c) * 33 + n;
        u32x4 o; o.x = pk2(s[0 * 33], s[1 * 33]); o.y = pk2(s[2 * 33], s[3 * 33]); o.z = pk2(s[4 * 33], s[5 * 33]); o.w = pk2(s[6 * 33], s[7 * 33]);
        *(u32x4*)(WT + (size_t)(dst_row0 + n) * K + k0 + 8 * c) = o; }
    WAVE_SYNC();
}
constexpr int WITEMS_EVEN = 4096 + 1552 + 512, WITEMS_ODD = 4096 + 1024 + 512 + 512;
__device__ __forceinline__ void weight_item(const Params& P, LAS float* scr, int l, int r, int lane) {
    unsigned char* ws = P.ws; const int eo = l >> 1;
    if (r < 2048) { const int q = r; transpose_item(P.in[I_WMLPIN] + (size_t)l * 1024 * 4096, 4096, 4096, 1024, (bf16*)(ws + WS_W1T) + (size_t)l * 4096 * 1024, 32 * (q & 127), scr, 64 * (q >> 7), 32 * (q & 127), lane); return; } r -= 2048;
    if (r < 2048) { const int q = r; transpose_item(P.in[I_WMLPOUT] + (size_t)l * 4096 * 1024, 1024, 1024, 4096, (bf16*)(ws + WS_W2T) + (size_t)l * 1024 * 4096, 32 * (q & 31), scr, 64 * (q >> 5), 32 * (q & 31), lane); return; } r -= 2048;
    if ((l & 1) == 0) {
        if (r < 1552) { const int kb = r / 97, nb = r % 97; transpose_item(P.in[I_WINE] + (size_t)eo * 1024 * IN_EVEN_LD, IN_EVEN_LD, IN_EVEN_LD, 1024, (bf16*)(ws + WS_WINE) + (size_t)eo * NB_E * 1024, 32 * nb, scr, 64 * kb, 32 * nb, lane); return; } r -= 1552;
        { const int q = r; transpose_item(P.in[I_WOUTE] + (size_t)eo * 1024 * 1024, 1024, 1024, 1024, (bf16*)(ws + WS_WOUTE) + (size_t)eo * 1024 * 1024, 32 * (q & 31), scr, 64 * (q >> 5), 32 * (q & 31), lane); return; }
    } else {
        if (r < 1024) { const int q = r; transpose_item(P.in[I_WINO] + (size_t)eo * 1024 * 2048, 2048, 2048, 1024, (bf16*)(ws + WS_WINO) + (size_t)eo * 2048 * 1024, 32 * (q & 63), scr, 64 * (q >> 6), 32 * (q & 63), lane); return; } r -= 1024;
        if (r < 512) { const int q = r; transpose_item(P.in[I_WOUTO] + (size_t)eo * 1024 * 1024, 1024, 1024, 1024, (bf16*)(ws + WS_WOUTO) + (size_t)eo * 1024 * 1024, 32 * (q & 31), scr, 64 * (q >> 5), 32 * (q & 31), lane); return; } r -= 512;
        { const int mat = eo * 16 + (r >> 5), q = r & 31, kb = q >> 3, nb = q & 7; const int blk = mat & 3, gate = (mat >> 2) & 1, od = mat >> 3;
          const float* src = (gate ? P.in[I_LWI] : P.in[I_LWR]) + (size_t)(od * 4 + blk) * 65536;
          const int j0 = nb * 32; const int drow = (blk * 2 + (j0 >> 7)) * 256 + gate * 128 + (j0 & 127);
          transpose_item(src, 256, 256, 256, (bf16*)(ws + WS_WG) + (size_t)od * 2048 * 256, drow, scr, 64 * kb, j0, lane); return; }
    }
}
__device__ __forceinline__ void phase_prologue(int wid0, const Params& P, LAS unsigned char* lds) {
    const int tid = tid_fresh(wid0), lane = tid & 63, wave = tid >> 6;
    LAS float* scr = (LAS float*)(lds + wave * 16384);
    const int gw = bid_fresh() * NWAVES + wave, NGW = grid_fresh() * NWAVES;
    unsigned char* ws = P.ws;
    constexpr int NTR = WITEMS_EVEN, NMOD = 4 * 24 * 16;
    for (int it = gw; it < NTR + NMOD; it += NGW) {
        int r = it;
        if (r < NTR) { weight_item(P, scr, 0, r, lane); continue; } r -= NTR;
        {
            const int l = r / 384, rem = r % 384, ec = rem >> 4, ks = rem & 15, k0 = ks * 64;
#pragma unroll
            for (int rr = 0; rr < 9; ++rr) { const float cv = rr == 0 ? P.in[I_CCTX][k0 + lane] : P.in[I_C][(rr - 1) * 1024 + k0 + lane]; scr[rr * 64 + lane] = siluf_(cv); }
            WAVE_SYNC();
            f32x4 acc[9];
#pragma unroll
            for (int rr = 0; rr < 9; ++rr) acc[rr] = (f32x4){0.f, 0.f, 0.f, 0.f};
            const float* wp = P.in[I_WADA] + ((size_t)l * 1024 + k0) * 6144 + ec * 256 + lane * 4;
#pragma unroll 16
            for (int kk = 0; kk < 64; ++kk) { const f32x4 w4 = *(const f32x4*)(wp + (size_t)kk * 6144);
#pragma unroll
                for (int rr = 0; rr < 9; ++rr) acc[rr] += w4 * scr[rr * 64 + kk]; }
            float* part = (float*)(ws + WS_BIG) + ((size_t)(ks * 4 + l) * 9) * 6144 + ec * 256 + lane * 4;
#pragma unroll
            for (int rr = 0; rr < 9; ++rr) *(f32x4*)(part + (size_t)rr * 6144) = acc[rr];
            WAVE_SYNC();
        }
    }
    { const size_t per = (size_t)(NB_E - 3104) * 1024 * 2 / 16;
      for (size_t i = (size_t)bid_fresh() * NTHR + tid; i < 2 * per; i += (size_t)grid_fresh() * NTHR) { const size_t e = i / per, q = i % per;
          *(u32x4*)(ws + WS_WINE + (e * NB_E + 3104) * 1024 * 2 + q * 16) = (u32x4){0u, 0u, 0u, 0u}; } }
}
__device__ __forceinline__ void phase_modreduce(int wid0, const Params& P) {
    const int tid = tid_fresh(wid0);
    const float* part = (const float*)(P.ws + WS_BIG); float* mod = (float*)(P.ws + WS_MOD);
    for (int i = bid_fresh() * NTHR + tid; i < 4 * 9 * 6144 / 4; i += grid_fresh() * NTHR) {
        const int l = i / (9 * 1536), e4 = i % 1536;
        f32x4 a = *(const f32x4*)(P.in[I_BADA] + (size_t)l * 6144 + e4 * 4);
#pragma unroll
        for (int ks = 0; ks < 16; ++ks) a += *(const f32x4*)(part + (size_t)ks * 4 * 9 * 6144 + (size_t)i * 4);
        *(f32x4*)(mod + (size_t)i * 4) = a; }
}
constexpr size_t XB_OFF_FLOATS = (size_t)MT * DM / 2;
__device__ __forceinline__ void phase_rownorm(int wid0, const Params& P, int first, const bf16* obuf, const float* modg, int goff, const float* gpost, int has_next, const float* gpre, const float* mods, int soff, bf16* H, float gscale = 1.0f) {
    const int tid = tid_fresh(wid0), lane = tid & 63, wave = tid >> 6;
    const int gw = bid_fresh() * NWAVES + wave, NGW = grid_fresh() * NWAVES;
    bf16* XB = (bf16*)(P.out + XB_OFF_FLOATS); float* TMP = (float*)(P.ws + WS_BIG);
    f32x4 xn[4]; u32x2 xbn[4], on[4];
#define RN_LOAD(mm) do { const int m_ = (mm); \
        _Pragma("unroll") for (int j = 0; j < 4; ++j) { \
            if (first) xn[j] = *(const f32x4*)((m_ < MCTX ? P.in[I_XP] + (size_t)m_ * DM : P.in[I_XS] + (size_t)(m_ - MCTX) * DM) + lane * 4 + 256 * j); \
            else { xbn[j] = *(const u32x2*)(XB + (size_t)m_ * DM + lane * 4 + 256 * j); on[j] = *(const u32x2*)(obuf + (size_t)m_ * DM + lane * 4 + 256 * j); } } } while (0)
    if (gw < MT) RN_LOAD(gw);
    for (int m = gw; m < MT; m += NGW) {
        const int modrow = m < MCTX ? 0 : 1 + ((m - MCTX) >> 11);
        const float* mr = modg + (size_t)modrow * 6144; const float* ms = mods + (size_t)modrow * 6144;
        f32x4 x[4]; u32x2 ov[4];
#pragma unroll
        for (int j = 0; j < 4; ++j) { ov[j] = on[j]; x[j] = first ? xn[j] : (f32x4){bflo(xbn[j].x), bfhi(xbn[j].x), bflo(xbn[j].y), bfhi(xbn[j].y)}; }
        if (m + NGW < MT) RN_LOAD(m + NGW);
        f32x4 vgp[4], vgt[4], vgq[4], vsh[4], vsc[4];
#pragma unroll
        for (int j = 0; j < 4; ++j) { const int c = lane * 4 + 256 * j;
            if (!first) { vgp[j] = *(const f32x4*)(gpost + c); vgt[j] = *(const f32x4*)(mr + goff + c); }
            if (has_next) { vgq[j] = *(const f32x4*)(gpre + c); vsh[j] = *(const f32x4*)(ms + soff + c); vsc[j] = *(const f32x4*)(ms + soff + 1024 + c); } }
        if (first) {
            if (m >= MCTX) {
                const int t = (m - MCTX) & 2047; const float prow = (float)(t >> 6), pcol = (float)(t & 63);
                f32x4 om;
#pragma unroll
                for (int e = 0; e < 4; ++e) om[e] = exp2f(-(float)(lane * 4 + e) * (13.287712379549449f / 256.0f));
#pragma unroll
                for (int j = 0; j < 4; ++j) {
#pragma unroll
                    for (int e = 0; e < 4; ++e) { const float a = (j < 2 ? prow : pcol) * om[e]; x[j][e] += (j & 1) ? cosf(a) : sinf(a); } }
            }
        } else {
            float ss = 0.f;
#pragma unroll
            for (int j = 0; j < 4; ++j) { const float a = bflo(ov[j].x), b = bfhi(ov[j].x), c = bflo(ov[j].y), d = bfhi(ov[j].y); ss += (a * a + b * b) + (c * c + d * d); }
            const float rs = rsqrtf(wave_sum(ss, lane) * (1.0f / DM) + EPSF);
#pragma unroll
            for (int j = 0; j < 4; ++j) { f32x4 o4 = (f32x4){bflo(ov[j].x), bfhi(ov[j].x), bflo(ov[j].y), bfhi(ov[j].y)};
                x[j] += vgt[j] * (o4 * (rs * gscale) * vgp[j]); }
        }
        if (has_next) {
#pragma unroll
            for (int j = 0; j < 4; ++j) { u32x2 w; w.x = pk2(x[j][0], x[j][1]); w.y = pk2(x[j][2], x[j][3]); *(u32x2*)(XB + (size_t)m * DM + lane * 4 + 256 * j) = w; }
            float ss = 0.f;
#pragma unroll
            for (int j = 0; j < 4; ++j) ss += (x[j][0] * x[j][0] + x[j][1] * x[j][1]) + (x[j][2] * x[j][2] + x[j][3] * x[j][3]);
            const float rs = rsqrtf(wave_sum(ss, lane) * (1.0f / DM) + EPSF);
#pragma unroll
            for (int j = 0; j < 4; ++j) { const f32x4 h4 = (x[j] * rs * vgq[j]) * (vsc[j] + 1.0f) + vsh[j];
                u32x2 w; w.x = pk2(h4[0], h4[1]); w.y = pk2(h4[2], h4[3]);
                *(u32x2*)(H + (size_t)m * DM + lane * 4 + 256 * j) = w; }
        } else {
            float* dst = (m < MT / 2) ? P.out + (size_t)m * DM : TMP + (size_t)(m - MT / 2) * DM;
#pragma unroll
            for (int j = 0; j < 4; ++j) *(f32x4*)(dst + lane * 4 + 256 * j) = x[j];
        }
    }
}
__device__ __forceinline__ void phase_copy_tail(int wid0, const Params& P) {
    const int tid = tid_fresh(wid0);
    const f32x4* src = (const f32x4*)(P.ws + WS_BIG); f32x4* dst = (f32x4*)(P.out + XB_OFF_FLOATS);
    const size_t n = (size_t)(MT / 2) * DM / 4;
    for (size_t i = (size_t)bid_fresh() * NTHR + tid; i < n; i += (size_t)grid_fresh() * NTHR) dst[i] = src[i];
}

using pg8::Unit;
template <int ACT  > struct EpiBf16 {
    bf16* O; int ldc; float* AB;
    bf16* HALO;
    __device__ __forceinline__ void operator()(const f32x4 (&acc)[2][2][4][2], const Unit& u, int wr, int wc, int fr, int fq) const {
        const int row0 = u.pm * 256 + wr * 64 + fr, col0 = u.pn * 256 + wc * 32 + 8 * fq;
        if (AB && u.pn * 256 >= ldc) {
            if (wc == 0 && fq < 2) {
#pragma unroll
                for (int ai = 0; ai < 2; ++ai)
#pragma unroll
                    for (int m = 0; m < 4; ++m) { float* p = AB + (size_t)(row0 + ai * 128 + m * 16) * 16 + 8 * fq; *(f32x4*)p = acc[ai][0][m][0]; *(f32x4*)(p + 4) = acc[ai][0][m][1]; }
            }
            return;
        }
#pragma unroll
        for (int ai = 0; ai < 2; ++ai)
#pragma unroll
            for (int m = 0; m < 4; ++m) { bf16* rowp = O + (size_t)(row0 + ai * 128 + m * 16) * ldc + col0;
#pragma unroll
                for (int bj = 0; bj < 2; ++bj) { f32x4 v0 = acc[ai][bj][m][0], v1 = acc[ai][bj][m][1];
                    if (ACT == 1) {
#pragma unroll
                        for (int j = 0; j < 4; ++j) { const float a = fmaxf(v0[j], 0.f), b = fmaxf(v1[j], 0.f); v0[j] = a * a; v1[j] = b * b; } }
                    u32x4 w; w.x = pk2(v0[0], v0[1]); w.y = pk2(v0[2], v0[3]); w.z = pk2(v1[0], v1[1]); w.w = pk2(v1[2], v1[3]);
                    *(u32x4*)(rowp + bj * 128) = w;
                    if (ACT == 0 && HALO && u.pn >= 4 && u.pn < 10 && ((m == 3 && fr == 15) || (m == 0 && fr < 2))) {
                        const int r = row0 + ai * 128 + m * 16; const int which = (m == 3) ? 0 : 1 + fr;
                        *(u32x4*)(HALO + ((size_t)(r >> 6) * 3 + which) * 1536 + (col0 + bj * 128 - 1024)) = w; } } }
    }
};
struct EpiSplit {
    bf16* O0; long stride;
    __device__ __forceinline__ void operator()(const f32x4 (&acc)[2][2][4][2], const Unit& u, int wr, int wc, int fr, int fq) const {
        const int row0 = u.pm * 256 + wr * 64 + fr, col0 = (u.pn >> 1) * 256 + wc * 32 + 8 * fq; bf16* O = O0 + (long)(u.pn & 1) * stride;
#pragma unroll
        for (int ai = 0; ai < 2; ++ai)
#pragma unroll
            for (int m = 0; m < 4; ++m) { bf16* rowp = O + (size_t)(row0 + ai * 128 + m * 16) * DM + col0;
#pragma unroll
                for (int bj = 0; bj < 2; ++bj) { const f32x4 v0 = acc[ai][bj][m][0], v1 = acc[ai][bj][m][1];
                    u32x4 w; w.x = pk2(v0[0], v0[1]); w.y = pk2(v0[2], v0[3]); w.z = pk2(v1[0], v1[1]); w.w = pk2(v1[2], v1[3]);
                    *(u32x4*)(rowp + bj * 128) = w; } }
    }
};
struct EpiGates {
    unsigned* G; const bf16* X; const float* br; const float* bi; const float* lam;
    __device__ __forceinline__ void operator()(const f32x4 (&acc)[2][2][4][2], const Unit& u, int wr, int wc, int fr, int fq) const {
        const int row0 = u.pm * 256 + wr * 64 + fr, ch0 = u.pn * 128 + wc * 32 + 8 * fq;
        u32x2 xv[2][2][4];
#pragma unroll
        for (int n = 0; n < 2; ++n)
#pragma unroll
            for (int ai = 0; ai < 2; ++ai)
#pragma unroll
                for (int m = 0; m < 4; ++m) xv[n][ai][m] = *(const u32x2*)(X + (size_t)(row0 + ai * 128 + m * 16) * DM + ch0 + 4 * n);
#pragma unroll
        for (int n = 0; n < 2; ++n) {
            const f32x4 vbr = *(const f32x4*)(br + ch0 + 4 * n), vbi = *(const f32x4*)(bi + ch0 + 4 * n), l4 = *(const f32x4*)(lam + ch0 + 4 * n);
            f32x4 vsp;
#pragma unroll
            for (int e = 0; e < 4; ++e) vsp[e] = -8.0f * softplusf_(-l4[e]);
#pragma unroll
            for (int ai = 0; ai < 2; ++ai)
#pragma unroll
                for (int m = 0; m < 4; ++m) { const size_t row = (size_t)(row0 + ai * 128 + m * 16);
                    const float xs[4] = {bflo(xv[n][ai][m].x), bfhi(xv[n][ai][m].x), bflo(xv[n][ai][m].y), bfhi(xv[n][ai][m].y)};
                    u32x4 w;
#pragma unroll
                    for (int e = 0; e < 4; ++e) { const float r = sigmoidf_(acc[ai][0][m][n][e] + vbr[e]), ig = sigmoidf_(acc[ai][1][m][n][e] + vbi[e]);
                        const float la = r * vsp[e]; const float a_ = __expf(la); const float b = __builtin_amdgcn_sqrtf(fmaxf(1.0f - a_ * a_, 0.f)) * ig * xs[e];
                        w[e] = pk2(1.0f - a_, b); }
                    *(u32x4*)(G + row * DM + ch0 + 4 * n) = w; }
        }
    }
};
constexpr int S5_WLDS = 12800, BU_P = 132, HS_P = 136;
struct S5Dir { float ar, ai; bf16x8 Bf[8]; };
__device__ __forceinline__ void s5_dir_setup(const Params& P, int e, int d, int g, int lane, float& ar, float& ai, bf16x8 (&Bf)[8], bool needB) {
    const int quad = lane >> 4, l15 = lane & 15;
    const float dt = __expf(P.in[I_LOGDT][(e * 2 + d) * 32 + g]);
    const float lr = P.in[I_LAMRE][((e * 2 + d) * 32 + g) * 64 + lane], li = P.in[I_LAMIM][((e * 2 + d) * 32 + g) * 64 + lane];
    const float mag = expf(lr * dt); ar = mag * cosf(li * dt); ai = mag * sinf(li * dt);
    const float den = lr * lr + li * li;
    const float fr = ((ar - 1.0f) * lr + ai * li) / den, fi = (ai * lr - (ar - 1.0f) * li) / den;
    if (needB) {
#pragma unroll
        for (int nt = 0; nt < 8; ++nt) { const int col = 16 * nt + l15, p = col & 63;
            const float frp = shfl_i(fr, p), fip = shfl_i(fi, p);
            bf16x8 v = (bf16x8){0, 0, 0, 0, 0, 0, 0, 0};
            if (quad < 2) { const float* bre = P.in[I_BRE] + ((size_t)(e * 32 + g) * 64 + p) * 16 + quad * 8; const float* bim = P.in[I_BIM] + ((size_t)(e * 32 + g) * 64 + p) * 16 + quad * 8;
#pragma unroll
                for (int j = 0; j < 8; ++j) { const float br = bre[j], bi = bim[j]; const float val = (nt < 4) ? (frp * br - fip * bi) : (frp * bi + fip * br); v[j] = (short)f2bf(val); } }
            Bf[nt] = v; }
    }
}
__device__ __forceinline__ void s5_c_setup(const Params& P, int e, int g, int lane, bf16x8 (&Cf)[4]) {
    const int quad = lane >> 4, l15 = lane & 15;
#pragma unroll
    for (int ks = 0; ks < 4; ++ks) { const int col0 = 32 * ks + quad * 8; const bool im = col0 >= 64;
        const float* src = (im ? P.in[I_CIM] : P.in[I_CRE]) + ((size_t)(e * 32 + g) * 16 + l15) * 64 + (col0 & 63);
        bf16x8 v;
#pragma unroll
        for (int j = 0; j < 8; ++j) v[j] = (short)f2bf(im ? -src[j] : src[j]);
        Cf[ks] = v; }
}
__device__ __forceinline__ void s5_scan_seg(const Params& P, LAS unsigned char* wl, int lane, int d, int g, int m0, float ar, float ai, const bf16x8 (&Bf)[8], const bf16x8 (&Cf)[4],
                                            float& hr, float& hi, int mode, int ymode, const bf16* proj, float* ybuf, bf16* mixout, float dsk, int dry = 0) {
    const int quad = lane >> 4, l15 = lane & 15;
    LAS float* BU = (LAS float*)wl; LAS bf16* HS = (LAS bf16*)(wl + 8448);
    const int ch = g * 16 + l15;
    bf16x8 a_next = (bf16x8){0, 0, 0, 0, 0, 0, 0, 0};
    if (mode == 0 && quad < 2) { const int blk0 = d ? 15 : 0; const int tt = d ? 15 - l15 : l15; a_next = *(const bf16x8*)(proj + (size_t)(m0 + 16 * blk0 + tt) * NPROJ_E + g * 16 + quad * 8); }
    float pre_n[4], zz_n[4];
    { const int mb0 = m0 + 16 * (d ? 15 : 0);
#pragma unroll
      for (int jj = 0; jj < 4; ++jj) { const int row = quad * 4 + jj; const int tt = d ? 15 - row : row; const size_t m = (size_t)(mb0 + tt);
          pre_n[jj] = (ymode == 0) ? dsk * bf2f(proj[m * NPROJ_E + ch]) : ybuf[m * 512 + ch];
          zz_n[jj] = (ymode == 2) ? bf2f(proj[m * NPROJ_E + 512 + ch]) : 0.f; } }
    for (int bi_ = 0; bi_ < 16; ++bi_) {
        const int blk = d ? 15 - bi_ : bi_;
        const int mb = m0 + 16 * blk;
        const bf16x8 a = a_next;
        if (mode == 0 && quad < 2 && bi_ + 1 < 16) { const int blkn = d ? 14 - bi_ : bi_ + 1; const int tt = d ? 15 - l15 : l15; a_next = *(const bf16x8*)(proj + (size_t)(m0 + 16 * blkn + tt) * NPROJ_E + g * 16 + quad * 8); }
        float pre[4], zz[4];
#pragma unroll
        for (int jj = 0; jj < 4; ++jj) { pre[jj] = pre_n[jj]; zz[jj] = zz_n[jj]; }
        if (bi_ + 1 < 16) { const int mbn = m0 + 16 * (d ? 14 - bi_ : bi_ + 1);
#pragma unroll
            for (int jj = 0; jj < 4; ++jj) { const int row = quad * 4 + jj; const int tt = d ? 15 - row : row; const size_t m = (size_t)(mbn + tt);
                pre_n[jj] = (ymode == 0) ? dsk * bf2f(proj[m * NPROJ_E + ch]) : ybuf[m * 512 + ch];
                zz_n[jj] = (ymode == 2) ? bf2f(proj[m * NPROJ_E + 512 + ch]) : 0.f; } }
        if (mode == 0) {
#pragma unroll
            for (int nt = 0; nt < 8; ++nt) { f32x4 acc = mfma16(a, Bf[nt], (f32x4){0.f, 0.f, 0.f, 0.f});
#pragma unroll
                for (int jj = 0; jj < 4; ++jj) BU[(quad * 4 + jj) * BU_P + 16 * nt + l15] = acc[jj]; }
            WAVE_SYNC();
        }
#pragma unroll
        for (int r = 0; r < 16; ++r) {
            float br = 0.f, bim = 0.f;
            if (mode == 0) { br = BU[r * BU_P + lane]; bim = BU[r * BU_P + 64 + lane]; }
            const float nr = ar * hr - ai * hi + br, ni = ar * hi + ai * hr + bim; hr = nr; hi = ni;
            HS[r * HS_P + lane] = (bf16)f2bf(hr); HS[r * HS_P + 64 + lane] = (bf16)f2bf(hi);
        }
        WAVE_SYNC();
        f32x4 y = (f32x4){0.f, 0.f, 0.f, 0.f};
#pragma unroll
        for (int ks = 0; ks < 4; ++ks) { const bf16x8 af = *(const LAS bf16x8*)(HS + l15 * HS_P + 32 * ks + quad * 8); y = mfma16(af, Cf[ks], y); }
#pragma unroll
        for (int jj = 0; jj < 4; ++jj) { const int row = quad * 4 + jj; const int tt = d ? 15 - row : row; const size_t m = (size_t)(mb + tt);
            const float v = y[jj] + pre[jj];
            if (!dry) { if (ymode != 2) ybuf[m * 512 + ch] = v;
            else mixout[m * DM + ch] = (bf16)f2bf(geluf_(v) * sigmoidf_(zz[jj])); }
        }
        WAVE_SYNC();
    }
}
__device__ __forceinline__ void s5_task_main(const Params& P, LAS unsigned char* wl, int lane, int e, int sub, int g) {
    const bf16* proj = (const bf16*)(P.ws + WS_BIG); float* ybuf = (float*)(P.ws + WS_YBUF); bf16* mixout = (bf16*)(P.ws + WS_MIX);
    const bool lat = sub >= 32; const int q = sub - 32, b = lat ? (q >> 3) : sub, seg = lat ? (q & 7) : 0;
    const int m0 = lat ? MCTX + b * LLAT + seg * 256 : sub * 256;
    bf16x8 Cf[4]; s5_c_setup(P, e, g, lane, Cf);
    const float dsk = P.in[I_S5D][e * 512 + g * 16 + (lane & 15)];
#pragma unroll 1
    for (int d = 0; d < 2; ++d) {
        float ar, ai; bf16x8 Bf[8]; s5_dir_setup(P, e, d, g, lane, ar, ai, Bf, true);
        float hr = 0.f, hi = 0.f;
        if (lat && ((d == 0 && seg == 0) || (d == 1 && seg == 7))) { const size_t si = ((((size_t)b * 2 + e) * 2 + d) * 32 + g) * 64 + lane; hr = P.in[I_S5RE][si]; hi = P.in[I_S5IM][si]; }
        const int ymode = d == 0 ? 0 : (lat ? 1 : 2);
        s5_scan_seg(P, wl, lane, d, g, m0, ar, ai, Bf, Cf, hr, hi, 0, ymode, proj, ybuf, mixout, dsk);
        if (!lat) { const size_t si = ((((size_t)b * 2 + e) * 2 + d) * 32 + g) * 64 + lane; P.out[OUT_S5RE + si] = hr; P.out[OUT_S5IM + si] = hi; }
        else { float* F = (float*)(P.ws + WS_S5F) + ((((size_t)d * 64 + q) * 32 + g) * 64 + lane) * 2; F[0] = hr; F[1] = hi; }
    }
}
__device__ __forceinline__ void s5_task_corr(const Params& P, LAS unsigned char* wl, int lane, int e, int q, int g, int dry = 0) {
    const bf16* proj = (const bf16*)(P.ws + WS_BIG); float* ybuf = (float*)(P.ws + WS_YBUF); bf16* mixout = (bf16*)(P.ws + WS_MIX);
    const int b = q >> 3, seg = q & 7, m0 = MCTX + b * LLAT + seg * 256;
    bf16x8 Cf[4]; s5_c_setup(P, e, g, lane, Cf);
    bf16x8 Bf[8];
#pragma unroll
    for (int i = 0; i < 8; ++i) Bf[i] = (bf16x8){0, 0, 0, 0, 0, 0, 0, 0};
    const float* Fb = (const float*)(P.ws + WS_S5F);
#pragma unroll 1
    for (int d = 0; d < 2; ++d) {
        float ar, ai; s5_dir_setup(P, e, d, g, lane, ar, ai, Bf, false);
        float pr = ar, pi = ai;
#pragma unroll
        for (int i = 0; i < 8; ++i) { const float nr = pr * pr - pi * pi, ni = 2.0f * pr * pi; pr = nr; pi = ni; }
        float hr = 0.f, hi = 0.f;
        const int cnt = d == 0 ? seg : 7 - seg;
        f2_t fv[7];
#pragma unroll
        for (int i = 0; i < 7; ++i) { const int sj = d == 0 ? i : 7 - i; fv[i] = (i < cnt) ? *(const f2_t*)(Fb + ((((size_t)d * 64 + b * 8 + sj) * 32 + g) * 64 + lane) * 2) : (f2_t){0.f, 0.f}; }
#pragma unroll
        for (int i = 0; i < 7; ++i) if (i < cnt) { const float nr = pr * hr - pi * hi + fv[i].x, ni = pr * hi + pi * hr + fv[i].y; hr = nr; hi = ni; }
        const int ym = (d == 1 || seg == 7) ? 2 : 1;
        if (cnt > 0) s5_scan_seg(P, wl, lane, d, g, m0, ar, ai, Bf, Cf, hr, hi, 1, ym, proj, ybuf, mixout, 0.f, dry);
    }
}

#ifndef REP_A
#define REP_A 1
#endif
#ifndef REP_B
#define REP_B 1
#endif
#ifndef REP_C
#define REP_C 1
#endif
__device__ __forceinline__ void phase_conv_even(int wid0, const Params& P, int e, int dry = 0) {
    const int tid = tid_fresh(wid0), lane = tid & 63, wave = tid >> 6;
    const int gw = bid_fresh() * NWAVES + wave, NGW = grid_fresh() * NWAVES;
    bf16* proj = (bf16*)(P.ws + WS_BIG); const bf16* HALO = (const bf16*)(P.ws + WS_HALO);
    for (int it = gw; it < 384 * 24; it += NGW) {
        const int c = it / 24, cgp = it % 24, ccol = cgp * 64 + lane;
        const int r0 = c * 64;
        const bool lat = r0 >= MCTX; const int t0 = lat ? ((r0 - MCTX) & 2047) : (r0 & 255); const int L = lat ? LLAT : LCTX;
        bf16* base = proj + (size_t)r0 * NPROJ_E + 1024 + ccol;
        bf16 x[67];
#pragma unroll
        for (int i = 0; i < 64; ++i) x[i + 1] = base[(size_t)i * NPROJ_E];
        x[0] = (t0 > 0) ? HALO[((size_t)(c - 1) * 3 + 0) * 1536 + ccol] : (bf16)0;
        x[65] = (t0 + 64 < L) ? HALO[((size_t)(c + 1) * 3 + 1) * 1536 + ccol] : (bf16)0;
        x[66] = (t0 + 64 < L) ? HALO[((size_t)(c + 1) * 3 + 2) * 1536 + ccol] : (bf16)0;
        const float* cw = P.in[I_GCONVW] + (size_t)e * 4 * 1536 + ccol; const float w0 = cw[0], w1 = cw[1536], w2 = cw[3072], w3 = cw[4608], cb = P.in[I_GCONVB][e * 1536 + ccol];
#pragma unroll
        for (int i = 0; i < 64; ++i) { const float v = cb + w0 * bf2f(x[i]) + w1 * bf2f(x[i + 1]) + w2 * bf2f(x[i + 2]) + w3 * bf2f(x[i + 3]);
            if (!dry) base[(size_t)i * NPROJ_E] = (bf16)f2bf(siluf_(v)); }
    }
}
#define LDS_BARRIER() do { asm volatile("s_waitcnt lgkmcnt(0)" ::: "memory"); __builtin_amdgcn_s_barrier(); asm volatile("" ::: "memory"); } while (0)
constexpr int G_Q = 0, G_K = 17408, G_V = 34816, G_KT = 52224, G_LM = 70656, G_QK = 89088, G_ST = 98304, G_SM = 133120;
constexpr int P128 = 136, P64 = 72, LMP = 68;
__device__ __forceinline__ bf16x8 ld_split8(const LAS bf16* p) {
    const u32x2 a = *(const LAS u32x2*)p, b = *(const LAS u32x2*)(p + 16);
    return __builtin_bit_cast(bf16x8, (u32x4){a.x, a.y, b.x, b.y});
}
__device__ __forceinline__ bf16x8 pack_acc2(const f32x4& a, const f32x4& b) { return __builtin_bit_cast(bf16x8, (u32x4){pk2(a[0], a[1]), pk2(a[2], a[3]), pk2(b[0], b[1]), pk2(b[2], b[3])}); }
__device__ __forceinline__ void gdn_chain(int wid0, const Params& P, LAS unsigned char* lds, int e, int s, int hd, int dir) {
    const int tid = tid_fresh(wid0), lane = tid & 63, w = __builtin_amdgcn_readfirstlane(tid >> 6), quad = lane >> 4, l15 = lane & 15;
    const bool lat = s >= 32; const int b = lat ? s - 32 : s; const int L = lat ? LLAT : LCTX; const int m0 = lat ? MCTX + b * LLAT : s * LCTX;
    const bf16* proj = (const bf16*)(P.ws + WS_BIG); const float* AB = (const float*)(P.ws + WS_AB);
    bf16* Odir = (bf16*)(P.ws + WS_H) + (size_t)dir * MT * 512;
    int zv; asm volatile("v_mov_b32 %0, 0" : "=v"(zv));
    lds += zv;
    LAS bf16* Qs = (LAS bf16*)(lds + G_Q); LAS bf16* Ks = (LAS bf16*)(lds + G_K); LAS bf16* Vs = (LAS bf16*)(lds + G_V); LAS bf16* KT = (LAS bf16*)(lds + G_KT);
    LAS float* Lm = (LAS float*)(lds + G_LM); LAS bf16* VNT = (LAS bf16*)(lds + G_LM); LAS bf16* QKs = (LAS bf16*)(lds + G_QK); LAS bf16* ST = (LAS bf16*)(lds + G_ST);
    LAS bf16* TM = (LAS bf16*)(lds + G_ST); LAS bf16* TT = TM + 64 * P64; LAS bf16* LR = TT + 64 * P64;
    LAS float* rq = (LAS float*)(lds + G_SM); LAS float* rk = rq + 64; LAS float* gcs = rq + 128; LAS float* betas = rq + 192; LAS float* egs = rq + 256; LAS float* kes = rq + 320;
    f32x4 Sacc[8];
    const size_t sbase = ((((size_t)b * 2 + e) * 2 + dir) * 4 + hd) * 16384;
#pragma unroll
    for (int mt = 0; mt < 8; ++mt) Sacc[mt] = (f32x4){0.f, 0.f, 0.f, 0.f};
    if (lat) { const float* sp = P.in[I_SDELTA] + sbase + (size_t)(quad * 4) * 128 + 16 * w + l15;
#pragma unroll
        for (int mt = 0; mt < 8; ++mt)
#pragma unroll
            for (int jj = 0; jj < 4; ++jj) Sacc[mt][jj] = sp[(16 * mt + jj) * 128]; }
    for (int i = tid; i < 2 * 64 * P64 / 2; i += NTHR) ((LAS unsigned*)TM)[i] = 0u;
    const float alog_e = __expf(P.in[I_GALOG][(e * 2 + dir) * 4 + hd]), dtb = P.in[I_GDTB][(e * 2 + dir) * 4 + hd];
    const int nchunk = L / 64;
    u32x4 xr[6]; float ab_a = 0.f, ab_b = 0.f;
#define GDN_LOAD(ci_) do { const int tid_ = tid_fresh(wid0); const int c0_ = dir ? L - 64 * ((ci_) + 1) : 64 * (ci_); \
        _Pragma("unroll") for (int k = 0; k < 6; ++k) { const int p_ = tid_ + 512 * k, part_ = p_ >> 10, row_ = (p_ & 1023) >> 4, pc_ = p_ & 15; \
            xr[k] = *(const u32x4*)(proj + (size_t)(m0 + c0_ + row_) * NPROJ_E + 1024 + part_ * 512 + hd * 128 + pc_ * 8); } \
        if (w == 0) { const int ln_ = tid_ & 63; const size_t m_ = (size_t)(m0 + c0_ + (dir ? 63 - ln_ : ln_)); ab_a = AB[m_ * 16 + dir * 4 + hd]; ab_b = AB[m_ * 16 + 8 + dir * 4 + hd]; } } while (0)
    GDN_LOAD(0);
#pragma unroll 1
    for (int ci = 0; ci < nchunk; ++ci) {
        const int tid = tid_fresh(wid0), lane = tid & 63, quad = lane >> 4, l15 = lane & 15;
        const int c0 = dir ? L - 64 * (ci + 1) : 64 * ci;
        LDS_BARRIER();
#ifndef NO_A
        const float cur_a = ab_a, cur_b = ab_b;
#pragma unroll
        for (int k = 0; k < 6; ++k) { const int p_ = tid + 512 * k, part_ = p_ >> 10, row_ = (p_ & 1023) >> 4, pc_ = p_ & 15;
            LAS bf16* dst = part_ == 0 ? Qs : (part_ == 1 ? Ks : Vs);
            *(LAS u32x4*)(dst + (dir ? 63 - row_ : row_) * P128 + pc_ * 8) = xr[k]; }
        if (ci + 1 < nchunk) GDN_LOAD(ci + 1);
#endif
        LDS_BARRIER();
#pragma unroll 1
        for (int repB = 0; repB < REP_B; ++repB)
        { const int rowid = tid >> 2, part = tid & 3; LAS bf16* src = (rowid < 64 ? Qs : Ks) + (rowid & 63) * P128 + part * 32;
          float ss = 0.f;
#pragma unroll
          for (int i = 0; i < 4; ++i) { const u32x4 v = *(const LAS u32x4*)(src + 8 * i);
#pragma unroll
              for (int j = 0; j < 4; ++j) { const float a = bflo(v[j]), c = bfhi(v[j]); ss += a * a + c * c; } }
          ss += shfl_i(ss, lane ^ 1); ss += shfl_i(ss, lane ^ 2);
          if (part == 0) { if (rowid < 64) rq[rowid] = rsqrtf(ss + EPSF) * 0.08838834764831845f; else rk[rowid - 64] = rsqrtf(ss + EPSF); }
          if (w == 0) { const int t = c0 + (dir ? 63 - lane : lane); const size_t m = (size_t)(m0 + t);
              const float araw = cur_a, braw = cur_b;
              const float gg = -alog_e * softplusf_(araw + dtb);
              float gc = gg;
#pragma unroll
              for (int o = 1; o < 64; o <<= 1) { const float t2 = shfl_i(gc, (lane - o) & 63); if (lane >= o) gc += t2; }
              const float glast = shfl_i(gc, 63);
              gcs[lane] = gc; betas[lane] = sigmoidf_(braw); egs[lane] = __expf(gc); kes[lane] = __expf(glast - gc);
              if (lane == 0) rq[384] = __expf(glast); } }
        LDS_BARRIER();
#ifndef NO_C
#pragma unroll 1
        for (int repC = 0; repC < REP_C; ++repC)
        { const int mt = w & 3; const bool isq = w >= 4; LAS bf16* src = isq ? Qs : Ks;
          bf16x8 a[4];
#pragma unroll
          for (int ks = 0; ks < 4; ++ks) a[ks] = *(const LAS bf16x8*)(src + (16 * mt + l15) * P128 + 32 * ks + quad * 8);
#pragma unroll 1
          for (int nt = 0; nt < 4; ++nt) { f32x4 acc = (f32x4){0.f, 0.f, 0.f, 0.f};
#pragma unroll
              for (int ks = 0; ks < 4; ++ks) { const bf16x8 bb = *(const LAS bf16x8*)(Ks + (16 * nt + l15) * P128 + 32 * ks + quad * 8); acc = mfma16(a[ks], bb, acc); }
              const int j = 16 * nt + l15; const float rkj = rk[j], gcj = gcs[j];
              f32x4 lv;
#pragma unroll
              for (int jj = 0; jj < 4; ++jj) { const int i = 16 * mt + quad * 4 + jj; const float dec = __expf(fminf(gcs[i] - gcj, 0.f));
                  lv[jj] = (i > j) ? acc[jj] * rk[i] * rkj * betas[i] * dec : 0.f;
                  if (isq) QKs[i * P64 + j] = (bf16)f2bf((i >= j) ? acc[jj] * rq[i] * rkj * dec : 0.f); }
              if (!isq) { *(LAS f32x4*)(Lm + j * LMP + 16 * mt + quad * 4) = lv;
#pragma unroll
                  for (int jj = 0; jj < 4; ++jj) LR[(16 * mt + quad * 4 + jj) * P64 + j] = (bf16)f2bf(nt < mt ? lv[jj] : 0.f); } }
          const int dd = tid & 127, tq = tid >> 7;
          unsigned pw[8];
#pragma unroll
          for (int n = 0; n < 16; n += 2) { const int i0 = tq * 16 + n; const float v0 = bf2f(Ks[i0 * P128 + dd]) * rk[i0] * kes[i0], v1 = bf2f(Ks[(i0 + 1) * P128 + dd]) * rk[i0 + 1] * kes[i0 + 1]; pw[n >> 1] = pk2(v0, v1); }
          *(LAS u32x4*)(KT + dd * P64 + tq * 16) = (u32x4){pw[0], pw[1], pw[2], pw[3]};
          *(LAS u32x4*)(KT + dd * P64 + tq * 16 + 8) = (u32x4){pw[4], pw[5], pw[6], pw[7]}; }
#endif
        LDS_BARRIER();
        { const int i = tid >> 3, c0k = (tid & 7) * 16; const float sc = rk[i] * betas[i] * egs[i];
#pragma unroll
          for (int h2 = 0; h2 < 2; ++h2) { u32x4 v = *(LAS u32x4*)(Ks + i * P128 + c0k + 8 * h2);
#pragma unroll
              for (int q = 0; q < 4; ++q) v[q] = pk2(bflo(v[q]) * sc, bfhi(v[q]) * sc);
              *(LAS u32x4*)(Ks + i * P128 + c0k + 8 * h2) = v; } }
        if (w == 0) { const int bb = lane >> 4, c = lane & 15;
            float x[16];
#pragma unroll
            for (int r = 0; r < 16; ++r) x[r] = (r == c) ? 1.f : 0.f;
#pragma unroll
            for (int j = 0; j < 15; ++j) {
#pragma unroll
                for (int q4 = j / 4; q4 < 4; ++q4) { const f32x4 l4 = *(const LAS f32x4*)(Lm + (16 * bb + j) * LMP + 16 * bb + 4 * q4);
#pragma unroll
                    for (int jx = 0; jx < 4; ++jx) if (4 * q4 + jx > j) x[4 * q4 + jx] -= l4[jx] * x[j]; } }
            unsigned pw[8];
#pragma unroll
            for (int r = 0; r < 16; r += 2) { pw[r >> 1] = pk2(x[r], x[r + 1]); TM[(16 * bb + r) * P64 + 16 * bb + c] = (bf16)(pw[r >> 1] & 0xffffu); TM[(16 * bb + r + 1) * P64 + 16 * bb + c] = (bf16)(pw[r >> 1] >> 16); }
            *(LAS u32x4*)(TT + (16 * bb + c) * P64 + 16 * bb) = (u32x4){pw[0], pw[1], pw[2], pw[3]};
            *(LAS u32x4*)(TT + (16 * bb + c) * P64 + 16 * bb + 8) = (u32x4){pw[4], pw[5], pw[6], pw[7]}; }
        LDS_BARRIER();
#pragma unroll 1
        for (int lev = 1; lev < 4; ++lev) {
            if (w < 4 - lev) { const int bj = w, bi = w + lev;
                f32x4 m = (f32x4){0.f, 0.f, 0.f, 0.f};
#pragma unroll
                for (int ks = 0; ks < 2; ++ks) { const bf16x8 a = *(const LAS bf16x8*)(LR + (16 * bi + l15) * P64 + 32 * ks + quad * 8), bq = *(const LAS bf16x8*)(TT + (16 * bj + l15) * P64 + 32 * ks + quad * 8); m = mfma16(a, bq, m); }
                const u32x2 tl = *(const LAS u32x2*)(TM + (16 * bi + l15) * P64 + 16 * bi + quad * 4);
                const bf16x8 a2 = __builtin_bit_cast(bf16x8, (u32x4){tl.x, tl.y, 0u, 0u}), b2 = __builtin_bit_cast(bf16x8, (u32x4){pk2(m[0], m[1]), pk2(m[2], m[3]), 0u, 0u});
                const f32x4 t = mfma16(a2, b2, (f32x4){0.f, 0.f, 0.f, 0.f});
                const unsigned p0 = pk2(-t[0], -t[1]), p1 = pk2(-t[2], -t[3]);
                TM[(16 * bi + quad * 4 + 0) * P64 + 16 * bj + l15] = (bf16)(p0 & 0xffffu); TM[(16 * bi + quad * 4 + 1) * P64 + 16 * bj + l15] = (bf16)(p0 >> 16);
                TM[(16 * bi + quad * 4 + 2) * P64 + 16 * bj + l15] = (bf16)(p1 & 0xffffu); TM[(16 * bi + quad * 4 + 3) * P64 + 16 * bj + l15] = (bf16)(p1 >> 16);
                *(LAS u32x2*)(TT + (16 * bj + l15) * P64 + 16 * bi + quad * 4) = (u32x2){p0, p1}; }
            LDS_BARRIER();
        }
#ifndef NO_EFG
        bf16x8 Bst[4];
#pragma unroll
        for (int ks = 0; ks < 4; ++ks) Bst[ks] = pack_acc2(Sacc[2 * ks], Sacc[2 * ks + 1]);
        f32x4 vn[4];
#pragma unroll
        for (int mt = 0; mt < 4; ++mt) { f32x4 acc = (f32x4){0.f, 0.f, 0.f, 0.f};
#pragma unroll
            for (int ks = 0; ks < 4; ++ks) { const bf16x8 a = ld_split8(Ks + (16 * mt + l15) * P128 + 32 * ks + quad * 4); acc = mfma16(a, Bst[ks], acc); }
#pragma unroll
            for (int jj = 0; jj < 4; ++jj) { const int i = 16 * mt + quad * 4 + jj; vn[mt][jj] = bf2f(Vs[i * P128 + 16 * w + l15]) * betas[i] - acc[jj]; } }
        bf16x8 Bvn[2];
#pragma unroll
        for (int k2 = 0; k2 < 2; ++k2) Bvn[k2] = pack_acc2(vn[2 * k2], vn[2 * k2 + 1]);
#pragma unroll
        for (int mt = 0; mt < 4; ++mt) { f32x4 acc = (f32x4){0.f, 0.f, 0.f, 0.f};
#pragma unroll
            for (int k2 = 0; k2 < 2; ++k2) { const bf16x8 a = ld_split8(TM + (16 * mt + l15) * P64 + 32 * k2 + quad * 4); acc = mfma16(a, Bvn[k2], acc); }
            vn[mt] = acc; }
#pragma unroll
        for (int k2 = 0; k2 < 2; ++k2) Bvn[k2] = pack_acc2(vn[2 * k2], vn[2 * k2 + 1]);
#pragma unroll 1
        for (int mt = 0; mt < 4; ++mt) { f32x4 acc = (f32x4){0.f, 0.f, 0.f, 0.f};
#pragma unroll
            for (int ks = 0; ks < 4; ++ks) { const bf16x8 a = ld_split8(Qs + (16 * mt + l15) * P128 + 32 * ks + quad * 4); acc = mfma16(a, Bst[ks], acc); }
#pragma unroll
            for (int jj = 0; jj < 4; ++jj) { const int i = 16 * mt + quad * 4 + jj; acc[jj] *= rq[i] * egs[i]; }
#pragma unroll
            for (int k2 = 0; k2 < 2; ++k2) { const bf16x8 a = ld_split8(QKs + (16 * mt + l15) * P64 + 32 * k2 + quad * 4); acc = mfma16(a, Bvn[k2], acc); }
#pragma unroll
            for (int jj = 0; jj < 4; ++jj) { const int i = 16 * mt + quad * 4 + jj; const int t = c0 + (dir ? 63 - i : i);
                Odir[(size_t)(m0 + t) * 512 + hd * 128 + 16 * w + l15] = (bf16)f2bf(acc[jj]); } }
        const float egl = rq[384];
#pragma unroll
        for (int mt = 0; mt < 8; ++mt) { f32x4 acc = Sacc[mt] * egl;
#pragma unroll
            for (int k2 = 0; k2 < 2; ++k2) { const bf16x8 a = ld_split8(KT + (16 * mt + l15) * P64 + 32 * k2 + quad * 4); acc = mfma16(a, Bvn[k2], acc); }
            Sacc[mt] = acc; }
#endif
        WAVE_SYNC();
    }
    if (!lat) { const int tid2 = tid_fresh(wid0), lane2 = tid2 & 63; float* dp = P.out + OUT_DELTA + sbase + (size_t)((lane2 >> 4) * 4) * 128 + 16 * w + (lane2 & 15);
#pragma unroll
        for (int mt = 0; mt < 8; ++mt)
#pragma unroll
            for (int jj = 0; jj < 4; ++jj) dp[(16 * mt + jj) * 128] = Sacc[mt][jj];
    }
    __syncthreads();
}

__device__ __forceinline__ void phase_mix_even(int wid0, const Params& P, LAS unsigned char* lds, int e, int mode = 3) {
    const int bid = bid_fresh(), G = grid_fresh();
    if (G == 256) {
        if (bid < 64) { const int s = 32 + (bid >> 3), hd = (bid >> 1) & 3, dir = bid & 1; if (mode & 1) gdn_chain(wid0, P, lds, e, s, hd, dir); }
        else { const int bb = bid - 64;
            if (mode & 1) for (int c = bb; c < 256; c += 192) { const int s = c >> 3, hd = (c >> 1) & 3, dir = c & 1; gdn_chain(wid0, P, lds, e, s, hd, dir); }
            if (mode & 2) { const int tid = tid_fresh(wid0), lane = tid & 63, wave = tid >> 6;
                for (int t = bb; t < 384; t += 192) { const int wt = t * 8 + wave; s5_task_main(P, lds + wave * S5_WLDS, lane, e, wt >> 5, wt & 31); } }
            if (mode == 3) { __syncthreads(); const int tid = tid_fresh(wid0), lane = tid & 63, wave = tid >> 6;
                for (int it = bb * NWAVES + wave; it < WITEMS_ODD; it += 192 * NWAVES) weight_item(P, (LAS float*)(lds + wave * 16384), 2 * e + 1, it, lane); } }
    } else {
        for (int c = bid; c < 320; c += G) { const int s = c < 64 ? 32 + (c >> 3) : ((c - 64) >> 3), hd = (c >> 1) & 3, dir = c & 1; gdn_chain(wid0, P, lds, e, s, hd, dir); }
        const int tid = tid_fresh(wid0), lane = tid & 63, wave = tid >> 6;
        for (int t = bid; t < 384; t += G) { const int wt = t * 8 + wave; s5_task_main(P, lds + wave * S5_WLDS, lane, e, wt >> 5, wt & 31); }
        __syncthreads();
        for (int it = bid * NWAVES + wave; it < WITEMS_ODD; it += G * NWAVES) weight_item(P, (LAS float*)(lds + wave * 16384), 2 * e + 1, it, lane);
    }
}
__device__ __forceinline__ void phase_fin_even(int wid0, const Params& P, LAS unsigned char* lds, int e, int dry = 0) {
    const int tid = tid_fresh(wid0), lane = tid & 63, wave = tid >> 6;
    const int gw = bid_fresh() * NWAVES + wave, NGW = grid_fresh() * NWAVES;
    for (int wt = gw; wt < 2048; wt += NGW) s5_task_corr(P, lds + wave * S5_WLDS, lane, e, wt >> 5, wt & 31, dry);
    const bf16* proj = (const bf16*)(P.ws + WS_BIG); const bf16* Of = (const bf16*)(P.ws + WS_H); const bf16* Ob = Of + (size_t)MT * 512; bf16* mixout = (bf16*)(P.ws + WS_MIX);
    float gnv[8];
#pragma unroll
    for (int j = 0; j < 8; ++j) gnv[j] = P.in[I_GONORM][e * 128 + (lane & 15) * 8 + j];
    for (int mb2 = gw; mb2 < MT; mb2 += 2 * NGW) {
        u32x4 a[2], bq[2], z[2];
#pragma unroll
        for (int u = 0; u < 2; ++u) { const int m = mb2 + u * NGW; if (m < MT) { a[u] = *(const u32x4*)(Of + (size_t)m * 512 + lane * 8); bq[u] = *(const u32x4*)(Ob + (size_t)m * 512 + lane * 8); z[u] = *(const u32x4*)(proj + (size_t)m * NPROJ_E + 2560 + lane * 8); } }
#pragma unroll
        for (int u = 0; u < 2; ++u) { const int m = mb2 + u * NGW; if (m < MT) {
            float o[8]; float ss = 0.f;
#pragma unroll
            for (int j = 0; j < 4; ++j) { o[2 * j] = bflo(a[u][j]) + bflo(bq[u][j]); o[2 * j + 1] = bfhi(a[u][j]) + bfhi(bq[u][j]); ss += o[2 * j] * o[2 * j] + o[2 * j + 1] * o[2 * j + 1]; }
            ss += shfl_i(ss, lane ^ 1); ss += shfl_i(ss, lane ^ 2); ss += shfl_i(ss, lane ^ 4); ss += shfl_i(ss, lane ^ 8);
            const float rs = rsqrtf(ss * (1.0f / 128.0f) + EPSF);
            unsigned pw[4];
#pragma unroll
            for (int j = 0; j < 4; ++j) { const float z0 = bflo(z[u][j]), z1 = bfhi(z[u][j]); pw[j] = pk2(o[2 * j] * rs * gnv[2 * j] * siluf_(z0), o[2 * j + 1] * rs * gnv[2 * j + 1] * siluf_(z1)); }
            if (!dry) *(u32x4*)(mixout + (size_t)m * DM + 512 + lane * 8) = (u32x4){pw[0], pw[1], pw[2], pw[3]}; } }
    }
}

__device__ __forceinline__ void phase_conv_odd(int wid0, const Params& P, int o) {
    const int tid = tid_fresh(wid0), lane = tid & 63, wave = tid >> 6;
    const int gw = bid_fresh() * NWAVES + wave, NGW = grid_fresh() * NWAVES;
    const bf16* proj = (const bf16*)(P.ws + WS_BIG); bf16* cx = (bf16*)(P.ws + WS_H);
    const float* cw = P.in[I_LCONVW] + (size_t)o * 4 * 1024; const float* cb = P.in[I_LCONVB] + o * 1024;
    float wv[2][4][8], bv[2][8];
#pragma unroll
    for (int h2 = 0; h2 < 2; ++h2) { const int ch = lane * 8 + 512 * h2;
#pragma unroll
        for (int j = 0; j < 8; ++j) { bv[h2][j] = cb[ch + j];
#pragma unroll
            for (int k = 0; k < 4; ++k) wv[h2][k][j] = cw[k * 1024 + ch + j]; } }
    for (int m = gw; m < MT; m += NGW) {
        const int t = m < MCTX ? (m & 255) : ((m - MCTX) & 2047); const int L = m < MCTX ? LCTX : LLAT;
        u32x4 xr[2][4];
#pragma unroll
        for (int k = 0; k < 4; ++k) { const int tt = t - 1 + k; const bool ok = (tt >= 0) && (tt < L); const size_t row = (size_t)(ok ? m - 1 + k : m);
#pragma unroll
            for (int h2 = 0; h2 < 2; ++h2) { const u32x4 v = *(const u32x4*)(proj + row * 2048 + lane * 8 + 512 * h2); xr[h2][k] = ok ? v : (u32x4){0u, 0u, 0u, 0u}; } }
#pragma unroll
        for (int h2 = 0; h2 < 2; ++h2) { const int ch = lane * 8 + 512 * h2;
            float acc[8];
#pragma unroll
            for (int j = 0; j < 8; ++j) acc[j] = bv[h2][j];
#pragma unroll
            for (int k = 0; k < 4; ++k)
#pragma unroll
                for (int j = 0; j < 4; ++j) { acc[2 * j] += wv[h2][k][2 * j] * bflo(xr[h2][k][j]); acc[2 * j + 1] += wv[h2][k][2 * j + 1] * bfhi(xr[h2][k][j]); }
            *(u32x4*)(cx + (size_t)m * DM + ch) = (u32x4){pk2(acc[0], acc[1]), pk2(acc[2], acc[3]), pk2(acc[4], acc[5]), pk2(acc[6], acc[7])}; }
    }
}
__device__ __forceinline__ void phase_lru_scan(int wid0, const Params& P, LAS unsigned char* lds, int o, int d) {
    const int tid = tid_fresh(wid0), lane = tid & 63, wave = tid >> 6;
    const int gw = bid_fresh() * NWAVES + wave, NGW = grid_fresh() * NWAVES;
    const unsigned* G = (const unsigned*)(P.ws + WS_GATES); const bf16* proj = (const bf16*)(P.ws + WS_BIG); bf16* mixout = (bf16*)(P.ws + WS_MIX);
    const int Gn = NGW / NWAVES, vw = wave * Gn + (gw / NWAVES);
    if (d == 0 && o == 0 && NGW > 640) {
        for (int it = vw - 640; it >= 0 && it < WITEMS_EVEN; it += NGW - 640) weight_item(P, (LAS float*)(lds + wave * 16384), 2, it, lane); }
    for (int task = vw; task < 640; task += NGW) {
        int s, cg_;
        if (task < 128) { s = 32 + (task >> 4); cg_ = task & 15; } else { s = (task - 128) >> 4; cg_ = (task - 128) & 15; }
        const bool lat = s >= 32; const int b = lat ? s - 32 : s; const int L = lat ? LLAT : LCTX; const int m0 = lat ? MCTX + b * LLAT : s * LCTX;
        const int ch = cg_ * 64 + lane;
        float h = lat ? P.in[I_SLRU][(((size_t)b * 2 + o) * 2 + d) * 1024 + ch] : 0.f;
        if (d == 0) {
            unsigned ga[32], gb[32];
#define LRU_LD0(dst, tt) _Pragma("unroll") for (int i = 0; i < 32; ++i) dst[i] = G[(size_t)(m0 + (tt) + i) * DM + ch]
#define LRU_CP0(src, tt) _Pragma("unroll") for (int i = 0; i < 32; ++i) { h = (1.0f - bflo(src[i])) * h + bfhi(src[i]); mixout[(size_t)(m0 + (tt) + i) * DM + ch] = (bf16)f2bf(h); }
            LRU_LD0(ga, 0);
            for (int t0 = 0; t0 < L; t0 += 64) {
                LRU_LD0(gb, t0 + 32);
                LRU_CP0(ga, t0);
                if (t0 + 64 < L) { LRU_LD0(ga, t0 + 64); }
                LRU_CP0(gb, t0 + 32);
            }
        } else {
            unsigned ga[16], gb[16]; bf16 pa[16], pb[16], ya[16], yb[16];
#define LRU_LD1(g_, p_, y_, tt) _Pragma("unroll") for (int i = 0; i < 16; ++i) { const size_t m = (size_t)(m0 + L - 1 - ((tt) + i)); g_[i] = G[m * DM + ch]; p_[i] = mixout[m * DM + ch]; y_[i] = proj[m * 2048 + 1024 + ch]; }
#define LRU_CP1(g_, p_, y_, tt) _Pragma("unroll") for (int i = 0; i < 16; ++i) { const size_t m = (size_t)(m0 + L - 1 - ((tt) + i)); \
                h = (1.0f - bflo(g_[i])) * h + bfhi(g_[i]); mixout[m * DM + ch] = (bf16)f2bf((bf2f(p_[i]) + h) * geluf_(bf2f(y_[i]))); }
            LRU_LD1(ga, pa, ya, 0);
            for (int t0 = 0; t0 < L; t0 += 32) {
                LRU_LD1(gb, pb, yb, t0 + 16);
                LRU_CP1(ga, pa, ya, t0);
                if (t0 + 32 < L) { LRU_LD1(ga, pa, ya, t0 + 32); }
                LRU_CP1(gb, pb, yb, t0 + 16);
            }
        }
        if (!lat) P.out[OUT_LRU + (((size_t)b * 2 + o) * 2 + d) * 1024 + ch] = h;
    }
}
#ifdef PROBE_DUP_GEMM
#define DUPG(x) GSYNC(); x
#else
#define DUPG(x)
#endif
typedef const __attribute__((address_space(4))) Params* KParams;
__device__ __forceinline__ Params load_params(KParams q) { Params r;
#pragma unroll
    for (int i = 0; i < 40; ++i) r.in[i] = q->in[i];
    r.out = q->out; r.ws = q->ws; return r; }
#define FRESH() const int G = grid_fresh(), bid = bid_fresh(); (void)G; (void)bid; KParams pk_ = (KParams)__builtin_amdgcn_kernarg_segment_ptr(); asm volatile("" : "+s"(pk_)); const Params P = load_params(pk_); unsigned char* ws = P.ws; \
    const float* mod = (const float*)(ws + WS_MOD); bf16* H = (bf16*)(ws + WS_H); bf16* BIG = (bf16*)(ws + WS_BIG); bf16* MIX = (bf16*)(ws + WS_MIX); (void)mod; (void)H; (void)BIG; (void)MIX;
#define GSYNC() do { KParams pb_ = (KParams)__builtin_amdgcn_kernarg_segment_ptr(); asm volatile("" : "+s"(pb_)); xcd_barrier(wid0, (unsigned*)(pb_->ws + WS_BAR), lds); } while (0)
__global__ void __launch_bounds__(NTHR, 2) fwd_kernel(Params Parg) {
    extern __shared__ __attribute__((aligned(16))) unsigned char lds_raw[];
    LAS unsigned char* lds = (LAS unsigned char*)lds_raw;
    cg::grid_group grid = cg::this_grid();
    const int wid0 = __builtin_amdgcn_readfirstlane(threadIdx.x >> 6);
    if (threadIdx.x < 4) ((LAS unsigned*)(lds + LDS_BARST))[threadIdx.x] = 0u;
    __syncthreads();
    if (threadIdx.x == 0) (void)xb_add((unsigned*)(Parg.ws + WS_BAR) + XB_XCNT(xb_xcc_id()), 1u);

    { FRESH(); phase_prologue(wid0, P, lds); }
    if (grid_fresh() == 0) grid.sync();
    GSYNC();
#ifdef PROBE_DUP_PRO
    { FRESH(); phase_prologue(wid0, P, lds); }
    GSYNC();
#endif
    { FRESH(); phase_modreduce(wid0, P); }
    GSYNC();
#ifdef PROBE_SYNC
#pragma unroll 1
    for (int i = 0; i < 40; ++i) GSYNC();
#endif
#pragma unroll 1
    for (int l = 0; l < 4; ++l) {
        { FRESH(); const float* modl = mod + (size_t)l * 9 * 6144;
        phase_rownorm(wid0, P, l == 0, MIX, modl - 9 * 6144, 5 * 1024, P.in[I_NMLPPOST] + (l > 0 ? (l - 1) * 1024 : 0), 1, P.in[I_NMIXPRE] + l * 1024, modl, 0, H); }
        GSYNC();
        const int eo = l >> 1;
        {
            FRESH();
            pg8::Gemm g; pg8::StaticOrder S; EpiBf16<0> E;
            if ((l & 1) == 0) { g = pg8::Gemm{H, (const bf16*)(ws + WS_WINE) + (size_t)eo * NB_E * 1024, MT, NB_E, 1024, 1024, 0, 0, 1024, 0}; E = EpiBf16<0>{BIG, NPROJ_E, (float*)(ws + WS_AB), (bf16*)(ws + WS_HALO)}; }
            else { g = pg8::Gemm{H, (const bf16*)(ws + WS_WINO) + (size_t)eo * 2048 * 1024, MT, 2048, 1024, 1024, 0, 0, 1024, 0}; E = EpiBf16<0>{BIG, 2048, nullptr, nullptr}; }
            S.init(g.M, g.N, G, bid);
            pg8::gemm_phase(wid0, lds, g, S, E); DUPG(pg8::gemm_phase(wid0, lds, g, S, E);)
        }
        GSYNC();
        if ((l & 1) == 0) {
            { FRESH(); phase_conv_even(wid0, P, eo); }
            GSYNC();
#ifdef PROBE_DRY_CONVE
            { FRESH(); phase_conv_even(wid0, P, eo, grid_fresh() > 0); }
            GSYNC();
#endif
#ifdef PROBE_DUP_MIX
#pragma unroll 1
            for (int rep = 0; rep < 2; ++rep) { { FRESH(); phase_mix_even(wid0, P, lds, eo, rep == 0 ? 3 : PROBE_DUP_MIX); } GSYNC(); }
#else
            { FRESH(); phase_mix_even(wid0, P, lds, eo); }
            GSYNC();
#endif
            { FRESH(); phase_fin_even(wid0, P, lds, eo); }
            GSYNC();
#ifdef PROBE_DRY_FIN
            { FRESH(); phase_fin_even(wid0, P, lds, eo, grid_fresh() > 0); }
            GSYNC();
#endif
        } else {
            { FRESH(); phase_conv_odd(wid0, P, eo); }
            GSYNC();
#ifdef PROBE_DUP_CONV
            { FRESH(); phase_conv_odd(wid0, P, eo); }
            GSYNC();
#endif
#pragma unroll 1
            for (int d = 0; d < 2; ++d) {
                { FRESH();
                pg8::Gemm g{H, (const bf16*)(ws + WS_WG) + (size_t)(eo * 2 + d) * 2048 * 256, MT, 2048, 256, 1024, 1, 1, 256, 0};
                EpiGates E{(unsigned*)(ws + WS_GATES), H, P.in[I_LBR] + (eo * 2 + d) * 1024, P.in[I_LBI] + (eo * 2 + d) * 1024, P.in[I_LLAM] + (eo * 2 + d) * 1024};
                pg8::StaticOrder S; S.init(g.M, g.N, G, bid);
                pg8::gemm_phase(wid0, lds, g, S, E); DUPG(pg8::gemm_phase(wid0, lds, g, S, E);) }
                GSYNC();
                { FRESH(); phase_lru_scan(wid0, P, lds, eo, d); }
#ifdef PROBE_DUP_LRU0
                if (d == 0) { GSYNC(); FRESH(); phase_lru_scan(wid0, P, lds, eo, d); }
#endif
                GSYNC();
            }
        }
        {
            FRESH();
            pg8::Gemm g{MIX, (const bf16*)(ws + ((l & 1) ? WS_WOUTO : WS_WOUTE)) + (size_t)eo * 1024 * 1024, MT, 1024, 1024, 1024, 0, 0, 1024, 0};
            EpiBf16<0> E{BIG, 1024, nullptr, nullptr}; pg8::StaticOrder S; S.init(g.M, g.N, G, bid);
            pg8::gemm_phase(wid0, lds, g, S, E); DUPG(pg8::gemm_phase(wid0, lds, g, S, E);)
        }
        GSYNC();
        { FRESH(); const float* modl = mod + (size_t)l * 9 * 6144;
        phase_rownorm(wid0, P, 0, BIG, modl, 2 * 1024, P.in[I_NMIXPOST] + l * 1024, 1, P.in[I_NMLPPRE] + l * 1024, modl, 3 * 1024, H); }
#ifdef PROBE_DUP_RN
        GSYNC();
        { FRESH(); const float* modl = mod + (size_t)l * 9 * 6144;
        phase_rownorm(wid0, P, 0, BIG, modl, 2 * 1024, P.in[I_NMIXPOST] + l * 1024, 1, P.in[I_NMLPPRE] + l * 1024, modl, 3 * 1024, H, 0.0f); }
#endif
        GSYNC();
        {
            FRESH();
            pg8::Gemm g{H, (const bf16*)(ws + WS_W1T) + (size_t)l * 4096 * 1024, MT, 4096, 1024, 1024, 0, 0, 1024, 0};
            EpiBf16<1> E{BIG, 4096, nullptr, nullptr}; pg8::StaticOrder S; S.init(g.M, g.N, G, bid);
            pg8::gemm_phase(wid0, lds, g, S, E); DUPG(pg8::gemm_phase(wid0, lds, g, S, E);)
        }
        GSYNC();
        {
            FRESH();
            pg8::Gemm g{BIG, (const bf16*)(ws + WS_W2T) + (size_t)l * 1024 * 4096, MT, 1024, 4096, 4096, 0, 0, 4096, 0};
            EpiBf16<0> E{MIX, 1024, nullptr, nullptr}; pg8::StaticOrder S; S.init(g.M, g.N, G, bid);
            pg8::gemm_phase(wid0, lds, g, S, E); DUPG(pg8::gemm_phase(wid0, lds, g, S, E);)
        }
        GSYNC();
    }
    { FRESH();
    phase_rownorm(wid0, P, 0, MIX, mod + (size_t)3 * 9 * 6144, 5 * 1024, P.in[I_NMLPPOST] + 3 * 1024, 0, P.in[I_NMIXPRE], mod, 0, H); }
    GSYNC();
    { FRESH(); phase_copy_tail(wid0, P); }
}

extern "C" void kernel_launch(void* const* d_in, const int* in_sizes, int n_in, void* d_out, int out_size, void* d_ws, size_t ws_size, hipStream_t stream) {
    static int grid = 0;
    if (grid == 0) {
        if (n_in != 40 || ws_size < WS_END) { fprintf(stderr, "kernel_launch: expected 40 inputs and >= %zu bytes of workspace (got %d, %zu)\n", (size_t)WS_END, n_in, ws_size); grid = -1; return; }
        int dev = 0, cus = 0, per_cu = 0;
        if (hipGetDevice(&dev) != hipSuccess || hipDeviceGetAttribute(&cus, hipDeviceAttributeMultiprocessorCount, dev) != hipSuccess) { grid = -1; return; }
        if (hipFuncSetAttribute((const void*)fwd_kernel, hipFuncAttributeMaxDynamicSharedMemorySize, LDS_BYTES) != hipSuccess) { fprintf(stderr, "kernel_launch: hipFuncSetAttribute failed\n"); grid = -1; return; }
        if (hipOccupancyMaxActiveBlocksPerMultiprocessor(&per_cu, (const void*)fwd_kernel, NTHR, LDS_BYTES) != hipSuccess || per_cu < 1) per_cu = 1;
        (void)hipGetLastError();
        grid = cus * per_cu; if (grid > 256) grid = 256;
    }
    if (grid < 0) return;
    (void)hipMemsetAsync((char*)d_ws + WS_BAR, 0, 16384, stream);
    Params p{};
    for (int i = 0; i < 40; ++i) p.in[i] = (const float*)d_in[i];
    p.out = (float*)d_out; p.ws = (unsigned char*)d_ws;
    void* args[] = {&p};
    hipError_t e = hipLaunchCooperativeKernel((const void*)fwd_kernel, dim3(grid), dim3(NTHR), args, LDS_BYTES, stream);
    if (e != hipSuccess) fprintf(stderr, "cooperative launch failed: %s (grid %d)\n", hipGetErrorString(e), grid);
}
```

```cpp
#include <hip/hip_runtime.h>
#include <hip/hip_cooperative_groups.h>
#include <cstdio>
#include <cstdint>
namespace cg = cooperative_groups;
__device__ __forceinline__ int bid_fresh() { int t = blockIdx.x; asm volatile("" : "+s"(t)); return t; }
__device__ __forceinline__ int grid_fresh() { int t = gridDim.x; asm volatile("" : "+s"(t)); return t; }
__device__ __forceinline__ int tid_fresh(int w) { asm volatile("" : "+s"(w)); int l; asm volatile("v_mbcnt_lo_u32_b32 %0, -1, 0\n\tv_mbcnt_hi_u32_b32 %0, -1, %0" : "=v"(l)); return w * 64 + l; }

namespace pg8 {
#define PG8_LAS __attribute__((address_space(3)))
typedef unsigned short bf16_t;
typedef short bf16x8 __attribute__((ext_vector_type(8)));
typedef float f32x4 __attribute__((ext_vector_type(4)));
typedef unsigned u32x4 __attribute__((ext_vector_type(4)));
typedef unsigned u32x2 __attribute__((ext_vector_type(2)));
constexpr int BM = 256, BK = 64, HALF = 128, HTB = HALF * BK * 2, STAGE_BYTES = 8 * HTB, NXCD = 8, WGM = 4;

__host__ __device__ __forceinline__ int lds_byte(int r, int c) { const int st = (r >> 4) * 2 + (c >> 5), rr = r & 15, cc = c & 31, ob = rr * 64 + cc * 2; return st * 1024 + (ob ^ (((ob >> 9) & 1) << 5)); }
__host__ __device__ __forceinline__ void stage_rc(int b, int& R, int& C) { const int st = b / 1024, sb = b % 1024, swz = sb ^ (((sb >> 9) & 1) << 5); R = (st >> 1) * 16 + swz / 64; C = (st & 1) * 32 + (swz % 64) / 2; }
__host__ __device__ __forceinline__ int perm32(int rho) { const int n = rho >> 4, i = rho & 15; return 8 * (i >> 2) + 4 * n + (i & 3); }

struct Unit { int pm, pn; };
struct Gemm { const bf16_t* A; const bf16_t* Bt; int M, N, K, lda, ablk, ashift, ldb, ksplit; };

struct StaticOrder {
    int nM, nN, nwg, G, c;
    __host__ __device__ void init(int M, int N, int G_, int c_) { nM = M / BM; nN = N / BM; nwg = nM * nN; G = G_; c = c_; }
    __host__ __device__ bool next(int i, Unit& u) const {
        const long L = (long)i * G + c; if (L >= nwg) return false;
        int wgid = (int)L; { const int q = nwg / NXCD, r = nwg % NXCD, xcd = wgid % NXCD, off = wgid / NXCD; wgid = (xcd < r ? xcd * (q + 1) : r * (q + 1) + (xcd - r) * q) + off; }
        const int nig = WGM * nN, gid = wgid / nig, fm = gid * WGM, gsz = (nM - fm) < WGM ? (nM - fm) : WGM;
        u.pm = fm + ((wgid % nig) % gsz); u.pn = (wgid % nig) / gsz; return true;
    }
};
__device__ __forceinline__ unsigned cvt_pk_bf16(float lo, float hi) { unsigned r; asm volatile("v_cvt_pk_bf16_f32 %0, %1, %2" : "=v"(r) : "v"(lo), "v"(hi)); return r; }

template <class Epi>
__device__ __forceinline__ void gemm_phase(int wid0, PG8_LAS unsigned char* lds, const Gemm g, const StaticOrder& S, const Epi& E) {
    const int tid = tid_fresh(wid0), wid = __builtin_amdgcn_readfirstlane(tid >> 6), lane = tid & 63, wr = wid >> 2, wc = wid & 3, fr = lane & 15, fq = lane >> 4;
    const int K = g.K, nt = K / BK, lda = g.lda, ldb = g.ldb;
    unsigned voffA[2], voffB[2];
#pragma unroll
    for (int i = 0; i < 2; ++i) { int R, C; stage_rc(tid * 16 + i * 8192, R, C); const int Rb = (R & ~31) + perm32(R & 31);
        voffA[i] = (unsigned)(R * lda + C) * 2u; voffB[i] = (unsigned)(Rb * ldb + C) * 2u; }
    const size_t kstep = (size_t)(BK * 2);
    const size_t hstepA = (size_t)HALF * lda * 2, hstepB = (size_t)HALF * ldb * 2;
    const size_t tstepA = 2 * hstepA, tstepB = 2 * hstepB;
    const unsigned ldsw = (unsigned)wid * 1024u;
    const int aoff = lds_byte(wr * 64 + fr, fq * 8), boff = lds_byte(wc * 32 + fr, fq * 8);
#define PG8_ACOL(pn) (g.ablk ? (size_t)((((pn) >> g.ashift) & 3) * 512) : (g.ksplit ? (size_t)((pn) & 1) * (size_t)K * 2 : (size_t)0))
#define PG8_BOFF(pn) (g.ksplit ? (size_t)((pn) >> 1) * tstepB + (size_t)((pn) & 1) * (size_t)K * 2 : (size_t)(pn) * tstepB)
#define PG8_SA(b, h) (((b) * 2 + (h)) * HTB)
#define PG8_SB(b, h) ((4 + (b) * 2 + (h)) * HTB)
#define PG8_STAGE(bufoff, gbase, voff) do { _Pragma("unroll") for (int _i = 0; _i < 2; ++_i) \
        __builtin_amdgcn_global_load_lds((const unsigned*)((const char*)(gbase) + (voff)[_i]), (PG8_LAS unsigned*)(lds + (bufoff) + ldsw + _i * 8192), 16, 0, 0); } while (0)
#define PG8_LDA(dst, b, h) do { _Pragma("unroll") for (int m = 0; m < 4; ++m) _Pragma("unroll") for (int k = 0; k < 2; ++k) dst[m][k] = *(const PG8_LAS bf16x8*)(lds + PG8_SA(b, h) + aoff + m * 2048 + k * 1024); } while (0)
#define PG8_LDB(dst, b, h) do { _Pragma("unroll") for (int n = 0; n < 2; ++n) _Pragma("unroll") for (int k = 0; k < 2; ++k) dst[n][k] = *(const PG8_LAS bf16x8*)(lds + PG8_SB(b, h) + boff + n * 2048 + k * 1024); } while (0)
#define PG8_MMA(ai, bj, At, Bt) do { __builtin_amdgcn_s_setprio(1); _Pragma("unroll") for (int m = 0; m < 4; ++m) _Pragma("unroll") for (int n = 0; n < 2; ++n) _Pragma("unroll") for (int k = 0; k < 2; ++k) \
        acc[ai][bj][m][n] = __builtin_amdgcn_mfma_f32_16x16x32_bf16(Bt[n][k], At[m][k], acc[ai][bj][m][n], 0, 0, 0); __builtin_amdgcn_s_setprio(0); } while (0)
#define PG8_WAIT_V(n) asm volatile("s_waitcnt vmcnt(" #n ")" ::: "memory")
#define PG8_WAIT_L(n) asm volatile("s_waitcnt lgkmcnt(" #n ")" ::: "memory")
#define PG8_BAR __builtin_amdgcn_s_barrier()
#define PG8_SCHED __builtin_amdgcn_sched_barrier(0)
    Unit cur, nxt; int ui = 0;
    if (!S.next(0, cur)) return;
    f32x4 acc[2][2][4][2];
#pragma unroll
    for (int a = 0; a < 2; ++a)
#pragma unroll
        for (int b = 0; b < 2; ++b)
#pragma unroll
            for (int m = 0; m < 4; ++m)
#pragma unroll
                for (int n = 0; n < 2; ++n) acc[a][b][m][n] = (f32x4){0.f, 0.f, 0.f, 0.f};
    bf16x8 At[4][2], B0[2][2], B1[2][2];
    const char* cA = (const char*)g.A + (size_t)cur.pm * tstepA + PG8_ACOL(cur.pn); const char* cB = (const char*)g.Bt + PG8_BOFF(cur.pn);
    PG8_STAGE(PG8_SB(0, 0), cB, voffB); PG8_STAGE(PG8_SA(0, 0), cA, voffA); PG8_STAGE(PG8_SB(0, 1), cB + hstepB, voffB); PG8_STAGE(PG8_SA(0, 1), cA + hstepA, voffA);
    if (wr == 1) PG8_BAR;
    PG8_WAIT_V(4); PG8_BAR;
    PG8_STAGE(PG8_SB(1, 0), cB + kstep, voffB); PG8_STAGE(PG8_SA(1, 0), cA + kstep, voffA); PG8_STAGE(PG8_SB(1, 1), cB + hstepB + kstep, voffB);
    PG8_WAIT_V(6); PG8_BAR;
    for (;;) {
        const bool has_next = S.next(ui + 1, nxt);
        const char* nA = has_next ? (const char*)g.A + (size_t)nxt.pm * tstepA + PG8_ACOL(nxt.pn) : cA; const char* nB = has_next ? (const char*)g.Bt + PG8_BOFF(nxt.pn) : cB;
        for (int t = 0; t < nt; t += 2) {
            const bool last = (t == nt - 2);
            const char* a1 = cA + (size_t)(t + 1) * kstep;
            const char* a2 = last ? nA : cA + (size_t)(t + 2) * kstep; const char* b2 = last ? nB : cB + (size_t)(t + 2) * kstep;
            const char* a3 = a2 + kstep; const char* b3 = b2 + kstep;
            PG8_LDB(B0, 0, 0); PG8_SCHED; PG8_LDA(At, 0, 0); PG8_STAGE(PG8_SA(1, 1), a1 + hstepA, voffA);
            PG8_WAIT_L(8); PG8_BAR; PG8_WAIT_L(0); PG8_MMA(0, 0, At, B0); PG8_BAR; PG8_SCHED;
            PG8_LDB(B1, 0, 1); PG8_STAGE(PG8_SB(0, 0), b2, voffB);
            PG8_BAR; PG8_WAIT_L(0); PG8_MMA(0, 1, At, B1); PG8_BAR;
            PG8_LDA(At, 0, 1); PG8_STAGE(PG8_SA(0, 0), a2, voffA);
            PG8_BAR; PG8_WAIT_L(0); PG8_MMA(1, 0, At, B0); PG8_BAR; PG8_SCHED;
            PG8_STAGE(PG8_SB(0, 1), b2 + hstepB, voffB);
            PG8_WAIT_V(6); PG8_BAR; PG8_MMA(1, 1, At, B1); PG8_BAR;
            PG8_LDB(B0, 1, 0); PG8_SCHED; PG8_LDA(At, 1, 0); PG8_STAGE(PG8_SA(0, 1), a2 + hstepA, voffA);
            PG8_WAIT_L(8); PG8_BAR; PG8_WAIT_L(0); PG8_MMA(0, 0, At, B0); PG8_BAR; PG8_SCHED;
            PG8_LDB(B1, 1, 1); PG8_STAGE(PG8_SB(1, 0), b3, voffB);
            PG8_BAR; PG8_WAIT_L(0); PG8_MMA(0, 1, At, B1); PG8_BAR;
            PG8_LDA(At, 1, 1); PG8_STAGE(PG8_SA(1, 0), a3, voffA);
            PG8_BAR; PG8_WAIT_L(0); PG8_MMA(1, 0, At, B0); PG8_BAR; PG8_SCHED;
            PG8_STAGE(PG8_SB(1, 1), b3 + hstepB, voffB);
            PG8_WAIT_V(6); PG8_BAR; PG8_MMA(1, 1, At, B1); PG8_BAR;
        }
        E(acc, cur, wr, wc, fr, fq);
        if (!has_next) break;
#pragma unroll
        for (int a = 0; a < 2; ++a)
#pragma unroll
            for (int b = 0; b < 2; ++b)
#pragma unroll
                for (int m = 0; m < 4; ++m)
#pragma unroll
                    for (int n = 0; n < 2; ++n) acc[a][b][m][n] = (f32x4){0.f, 0.f, 0.f, 0.f};
        cur = nxt; cA = nA; cB = nB; ++ui;
    }
    PG8_WAIT_V(0);
    if (wr == 0) PG8_BAR;
    PG8_BAR;
#undef PG8_ACOL
#undef PG8_BOFF
#undef PG8_SA
#undef PG8_SB
#undef PG8_STAGE
#undef PG8_LDA
#undef PG8_LDB
#undef PG8_MMA
#undef PG8_WAIT_V
#undef PG8_WAIT_L
#undef PG8_BAR
#undef PG8_SCHED
}
}
#define LAS __attribute__((address_space(3)))
typedef unsigned short bf16;
typedef short bf16x8 __attribute__((ext_vector_type(8)));
typedef float f32x4 __attribute__((ext_vector_type(4)));
typedef unsigned u32x4 __attribute__((ext_vector_type(4)));
typedef unsigned u32x2 __attribute__((ext_vector_type(2)));
constexpr int DM = 1024, MT = 24576, MCTX = 8192, LCTX = 256, LLAT = 2048, NWAVES = 8, NTHR = 512;
constexpr int NPROJ_E = 3072, NB_E = 3328, IN_EVEN_LD = 3088;
constexpr float EPSF = 1e-6f;
constexpr size_t MiB = 1u << 20;
constexpr size_t WS_MOD = 0, MOD_BYTES = 4 * 9 * 6144 * 4, WS_S5F = 1 * MiB, WS_AB = 3 * MiB, WS_W1T = 5 * MiB, WS_W2T = 37 * MiB, WS_WINE = 69 * MiB,
                 WS_WOUTE = 82 * MiB, WS_WINO = 86 * MiB, WS_WOUTO = 94 * MiB, WS_WG = 98 * MiB, WS_H = 102 * MiB, WS_BIG = 150 * MiB, WS_YBUF = 294 * MiB,
                 WS_GATES = 246 * MiB, WS_MIX = 342 * MiB, WS_HALO = 390 * MiB, WS_END = 390 * MiB + 384 * 3 * 1536 * 2;
constexpr int LDS_BYTES = 147456;
constexpr size_t OUT_S5RE = 25165824, OUT_S5IM = OUT_S5RE + 262144, OUT_DELTA = OUT_S5IM + 262144, OUT_LRU = OUT_DELTA + 8388608;

struct Params { const float* in[40]; float* out; unsigned char* ws; };
enum { I_XP = 0, I_XS, I_S5RE, I_S5IM, I_SDELTA, I_SLRU, I_C, I_CCTX, I_WADA, I_BADA, I_NMIXPRE, I_NMIXPOST, I_NMLPPRE, I_NMLPPOST, I_WMLPIN, I_WMLPOUT, I_WINE, I_WOUTE,
       I_LAMRE, I_LAMIM, I_LOGDT, I_BRE, I_BIM, I_CRE, I_CIM, I_S5D, I_GCONVW, I_GCONVB, I_GALOG, I_GDTB, I_GONORM, I_WINO, I_WOUTO, I_LCONVW, I_LCONVB, I_LWR, I_LBR, I_LWI, I_LBI, I_LLAM };

typedef __bf16 bf2_t __attribute__((ext_vector_type(2)));
typedef float f2_t __attribute__((ext_vector_type(2)));
__device__ __forceinline__ unsigned pk2(float lo, float hi) { const bf2_t v = __builtin_convertvector((f2_t){lo, hi}, bf2_t); return __builtin_bit_cast(unsigned, v); }
__device__ __forceinline__ unsigned f2bf(float f) { return pk2(f, f) & 0xffffu; }
__device__ __forceinline__ float bflo(unsigned w) { return __builtin_bit_cast(float, w << 16); }
__device__ __forceinline__ float bfhi(unsigned w) { return __builtin_bit_cast(float, w & 0xffff0000u); }
__device__ __forceinline__ float bf2f(bf16 b) { return __builtin_bit_cast(float, (unsigned)b << 16); }
__device__ __forceinline__ float sigmoidf_(float x) { return __builtin_amdgcn_rcpf(1.0f + __expf(-x)); }
__device__ __forceinline__ float siluf_(float x) { return x * sigmoidf_(x); }
__device__ __forceinline__ float softplusf_(float x) { return fmaxf(x, 0.f) + __logf(1.0f + __expf(-fabsf(x))); }
__device__ __forceinline__ float geluf_(float x) { const float y = 0.7978845608028654f * (x + 0.044715f * x * x * x); const float t = 1.0f - 2.0f * __builtin_amdgcn_rcpf(__expf(2.0f * y) + 1.0f); return 0.5f * x * (1.0f + t); }
__device__ __forceinline__ float shfl_i(float v, int srclane) { return __builtin_bit_cast(float, __builtin_amdgcn_ds_bpermute(srclane << 2, __builtin_bit_cast(int, v))); }
__device__ __forceinline__ float dpp_f(float v, int ctrl_xor1) { return v; }
__device__ __forceinline__ float wave_sum(float v, int lane) {
    (void)lane;
    v += __builtin_bit_cast(float, __builtin_amdgcn_update_dpp(0, __builtin_bit_cast(int, v), 0xB1, 0xF, 0xF, true));
    v += __builtin_bit_cast(float, __builtin_amdgcn_update_dpp(0, __builtin_bit_cast(int, v), 0x4E, 0xF, 0xF, true));
    v += __builtin_bit_cast(float, __builtin_amdgcn_update_dpp(0, __builtin_bit_cast(int, v), 0x141, 0xF, 0xF, true));
    v += __builtin_bit_cast(float, __builtin_amdgcn_update_dpp(0, __builtin_bit_cast(int, v), 0x140, 0xF, 0xF, true));
    const int iv = __builtin_bit_cast(int, v);
    return (__builtin_bit_cast(float, __builtin_amdgcn_readlane(iv, 0)) + __builtin_bit_cast(float, __builtin_amdgcn_readlane(iv, 16))) +
           (__builtin_bit_cast(float, __builtin_amdgcn_readlane(iv, 32)) + __builtin_bit_cast(float, __builtin_amdgcn_readlane(iv, 48)));
}
#define LDS_WAIT() asm volatile("s_waitcnt lgkmcnt(0)" ::: "memory")
#define WAVE_SYNC() do { asm volatile("s_waitcnt lgkmcnt(0)" ::: "memory"); __builtin_amdgcn_wave_barrier(); } while (0)
__device__ __forceinline__ f32x4 mfma16(bf16x8 a, bf16x8 b, f32x4 c) { return __builtin_amdgcn_mfma_f32_16x16x32_bf16(a, b, c, 0, 0, 0); }


#define XB_TMO      128
#define XB_XCNT(j)  (256  + 64 * (j))
#define XB_XSUB(j)  (1280 + 64 * (j))
#define XB_XGEN(j)  (2304 + 64 * (j))
#define XB_TOP      3328
#define XB_TOPGEN   3392
#define XCD_BAR_WORDS 3456
#define XB_SPIN_CAP (1u << 18)
constexpr size_t WS_BAR = 960 * 1024; constexpr int LDS_BARST = LDS_BYTES - 16;
__device__ __forceinline__ unsigned xb_ld(unsigned* p)              { return __hip_atomic_load(p, __ATOMIC_RELAXED, __HIP_MEMORY_SCOPE_AGENT); }
__device__ __forceinline__ unsigned xb_add(unsigned* p, unsigned v) { return __hip_atomic_fetch_add(p, v, __ATOMIC_RELAXED, __HIP_MEMORY_SCOPE_AGENT); }
__device__ __forceinline__ unsigned xb_xcc_id() { return (unsigned)__builtin_amdgcn_s_getreg((3 << 11) | 20) & 0xFu; }
#define XB_SPIN(cond, bar) do { unsigned _sp = 0; while (cond) { __builtin_amdgcn_s_sleep(1); \
    if ((++_sp & 255u) == 0u) { if (xb_ld(&(bar)[XB_TMO])) break; if (_sp > XB_SPIN_CAP) { atomicAdd(&(bar)[XB_TMO], 1u); break; } } } } while (0)
__device__ __forceinline__ void xcd_barrier_complete(unsigned* bar, unsigned x, unsigned& nloc, unsigned& nx) {
    const unsigned G = gridDim.x;
    unsigned sum, cnt, mine, sp = 0u;
    for (;;) {
        sum = 0u; cnt = 0u; mine = 0u;
#pragma unroll
        for (unsigned j = 0; j < 16; ++j) { const unsigned c = xb_ld(&bar[XB_XCNT(j)]); sum += c; cnt += (c > 0u) ? 1u : 0u; mine = (j == x) ? c : mine; }
        if (sum == G) break;
        __builtin_amdgcn_s_sleep(1);
        if ((++sp & 255u) == 0u) { if (xb_ld(&bar[XB_TMO])) break; if (sp > XB_SPIN_CAP) { atomicAdd(&bar[XB_TMO], 1u); break; } }
    }
    nloc = mine > 0u ? mine : 1u; nx = cnt > 0u ? cnt : 1u;
}
__device__ __forceinline__ void xcd_barrier(int wid0, unsigned* bar, LAS unsigned char* lds) {
    const int tid = tid_fresh(wid0);
    asm volatile("s_waitcnt vmcnt(0)" ::: "memory");
    __syncthreads();
    if (tid == 0) {
        const unsigned x = xb_xcc_id();
        volatile LAS unsigned* st = (volatile LAS unsigned*)(lds + LDS_BARST);
        __builtin_amdgcn_s_waitcnt(0);
        unsigned nloc = st[0], nx = st[1];
        if (nloc == 0u) { xcd_barrier_complete(bar, x, nloc, nx); st[0] = nloc; st[1] = nx; }
        const unsigned old = xb_add(&bar[XB_XSUB(x)], 1u);
        const unsigned gen = old / nloc;
        if (old + 1u == (gen + 1u) * nloc) {
            __builtin_amdgcn_fence(__ATOMIC_RELEASE, "agent");
            asm volatile("s_waitcnt vmcnt(0)" ::: "memory");
            const unsigned og = xb_add(&bar[XB_TOP], 1u);
            const unsigned tg = og / nx;
            if (og + 1u == (tg + 1u) * nx) xb_add(&bar[XB_TOPGEN], 1u);
            else XB_SPIN(xb_ld(&bar[XB_TOPGEN]) == tg, bar);
            __builtin_amdgcn_fence(__ATOMIC_ACQUIRE, "agent");
            xb_add(&bar[XB_XGEN(x)], 1u);
            asm volatile("s_waitcnt vmcnt(0)" ::: "memory");
        } else {
            XB_SPIN(xb_ld(&bar[XB_XGEN(x)]) == gen, bar);
            __builtin_amdgcn_fence(__ATOMIC_ACQUIRE, "agent");
            asm volatile("s_waitcnt vmcnt(0)" ::: "memory");
        }
    }
    __syncthreads();
}
__device__ __forceinline__ void transpose_item(const float* W, int ldw, int nvalid, int K, bf16* WT, int dst_row0, LAS float* scr, int k0, int n0, int lane) {
    const int nn = n0 + (lane & 31); const bool ok = nn < nvalid;
#pragma unroll
    for (int i = 0; i < 32; ++i) { const int kk = 2 * i + (lane >> 5); scr[kk * 33 + (lane & 31)] = ok ? W[(size_t)(k0 + kk) * ldw + nn] : 0.f; }
    WAVE_SYNC();
    const int c = lane & 7;
#pragma unroll
    for (int j = 0; j < 4; ++j) { const int n = (lane >> 3) + 8 * j; const LAS float* s = scr + (8 * c) * 33 + n;
        u32x4 o; o.x = pk2(s[0 * 33], s[1 * 33]); o.y = pk2(s[2 * 33], s[3 * 33]); o.z = pk2(s[4 * 33], s[5 * 33]); o.w = pk2(s[6 * 33], s[7 * 33]);
        *(u32x4*)(WT + (size_t)(dst_row0 + n) * K + k0 + 8 * c) = o; }
    WAVE_SYNC();
}
constexpr int WITEMS_EVEN = 4096 + 1552 + 512, WITEMS_ODD = 4096 + 1024 + 512 + 512;
__device__ __forceinline__ void weight_item(const Params& P, LAS float* scr, int l, int r, int lane) {
    unsigned char* ws = P.ws; const int eo = l >> 1;
    if (r < 2048) { const int q = r; transpose_item(P.in[I_WMLPIN] + (size_t)l * 1024 * 4096, 4096, 4096, 1024, (bf16*)(ws + WS_W1T) + (size_t)l * 4096 * 1024, 32 * (q & 127), scr, 64 * (q >> 7), 32 * (q & 127), lane); return; } r -= 2048;
    if (r < 2048) { const int q = r; transpose_item(P.in[I_WMLPOUT] + (size_t)l * 4096 * 1024, 1024, 1024, 4096, (bf16*)(ws + WS_W2T) + (size_t)l * 1024 * 4096, 32 * (q & 31), scr, 64 * (q >> 5), 32 * (q & 31), lane); return; } r -= 2048;
    if ((l & 1) == 0) {
        if (r < 1552) { const int kb = r / 97, nb = r % 97; transpose_item(P.in[I_WINE] + (size_t)eo * 1024 * IN_EVEN_LD, IN_EVEN_LD, IN_EVEN_LD, 1024, (bf16*)(ws + WS_WINE) + (size_t)eo * NB_E * 1024, 32 * nb, scr, 64 * kb, 32 * nb, lane); return; } r -= 1552;
        { const int q = r; transpose_item(P.in[I_WOUTE] + (size_t)eo * 1024 * 1024, 1024, 1024, 1024, (bf16*)(ws + WS_WOUTE) + (size_t)eo * 1024 * 1024, 32 * (q & 31), scr, 64 * (q >> 5), 32 * (q & 31), lane); return; }
    } else {
        if (r < 1024) { const int q = r; transpose_item(P.in[I_WINO] + (size_t)eo * 1024 * 2048, 2048, 2048, 1024, (bf16*)(ws + WS_WINO) + (size_t)eo * 2048 * 1024, 32 * (q & 63), scr, 64 * (q >> 6), 32 * (q & 63), lane); return; } r -= 1024;
        if (r < 512) { const int q = r; transpose_item(P.in[I_WOUTO] + (size_t)eo * 1024 * 1024, 1024, 1024, 1024, (bf16*)(ws + WS_WOUTO) + (size_t)eo * 1024 * 1024, 32 * (q & 31), scr, 64 * (q >> 5), 32 * (q & 31), lane); return; } r -= 512;
        { const int mat = eo * 16 + (r >> 5), q = r & 31, kb = q >> 3, nb = q & 7; const int blk = mat & 3, gate = (mat >> 2) & 1, od = mat >> 3;
          const float* src = (gate ? P.in[I_LWI] : P.in[I_LWR]) + (size_t)(od * 4 + blk) * 65536;
          const int j0 = nb * 32; const int drow = (blk * 2 + (j0 >> 7)) * 256 + gate * 128 + (j0 & 127);
          transpose_item(src, 256, 256, 256, (bf16*)(ws + WS_WG) + (size_t)od * 2048 * 256, drow, scr, 64 * kb, j0, lane); return; }
    }
}
__device__ __forceinline__ void phase_prologue(int wid0, const Params& P, LAS unsigned char* lds) {
    const int tid = tid_fresh(wid0), lane = tid & 63, wave = tid >> 6;
    LAS float* scr = (LAS float*)(lds + wave * 16384);
    const int gw = bid_fresh() * NWAVES + wave, NGW = grid_fresh() * NWAVES;
    unsigned char* ws = P.ws;
    constexpr int NTR = WITEMS_EVEN, NMOD = 4 * 24 * 16;
    for (int it = gw; it < NTR + NMOD; it += NGW) {
        int r = it;
        if (r < NTR) { weight_item(P, scr, 0, r, lane); continue; } r -= NTR;
        {
            const int l = r / 384, rem = r % 384, ec = rem >> 4, ks = rem & 15, k0 = ks * 64;
#pragma unroll
            for (int rr = 0; rr < 9; ++rr) { const float cv = rr == 0 ? P.in[I_CCTX][k0 + lane] : P.in[I_C][(rr - 1) * 1024 + k0 + lane]; scr[rr * 64 + lane] = siluf_(cv); }
            WAVE_SYNC();
            f32x4 acc[9];
#pragma unroll
            for (int rr = 0; rr < 9; ++rr) acc[rr] = (f32x4){0.f, 0.f, 0.f, 0.f};
            const float* wp = P.in[I_WADA] + ((size_t)l * 1024 + k0) * 6144 + ec * 256 + lane * 4;
#pragma unroll 16
            for (int kk = 0; kk < 64; ++kk) { const f32x4 w4 = *(const f32x4*)(wp + (size_t)kk * 6144);
#pragma unroll
                for (int rr = 0; rr < 9; ++rr) acc[rr] += w4 * scr[rr * 64 + kk]; }
            float* part = (float*)(ws + WS_BIG) + ((size_t)(ks * 4 + l) * 9) * 6144 + ec * 256 + lane * 4;
#pragma unroll
            for (int rr = 0; rr < 9; ++rr) *(f32x4*)(part + (size_t)rr * 6144) = acc[rr];
            WAVE_SYNC();
        }
    }
    { const size_t per = (size_t)(NB_E - 3104) * 1024 * 2 / 16;
      for (size_t i = (size_t)bid_fresh() * NTHR + tid; i < 2 * per; i += (size_t)grid_fresh() * NTHR) { const size_t e = i / per, q = i % per;
          *(u32x4*)(ws + WS_WINE + (e * NB_E + 3104) * 1024 * 2 + q * 16) = (u32x4){0u, 0u, 0u, 0u}; } }
}
__device__ __forceinline__ void phase_modreduce(int wid0, const Params& P) {
    const int tid = tid_fresh(wid0);
    const float* part = (const float*)(P.ws + WS_BIG); float* mod = (float*)(P.ws + WS_MOD);
    for (int i = bid_fresh() * NTHR + tid; i < 4 * 9 * 6144 / 4; i += grid_fresh() * NTHR) {
        const int l = i / (9 * 1536), e4 = i % 1536;
        f32x4 a = *(const f32x4*)(P.in[I_BADA] + (size_t)l * 6144 + e4 * 4);
#pragma unroll
        for (int ks = 0; ks < 16; ++ks) a += *(const f32x4*)(part + (size_t)ks * 4 * 9 * 6144 + (size_t)i * 4);
        *(f32x4*)(mod + (size_t)i * 4) = a; }
}
constexpr size_t XB_OFF_FLOATS = (size_t)MT * DM / 2;
__device__ __forceinline__ void phase_rownorm(int wid0, const Params& P, int first, const bf16* obuf, const float* modg, int goff, const float* gpost, int has_next, const float* gpre, const float* mods, int soff, bf16* H, float gscale = 1.0f) {
    const int tid = tid_fresh(wid0), lane = tid & 63, wave = tid >> 6;
    const int gw = bid_fresh() * NWAVES + wave, NGW = grid_fresh() * NWAVES;
    bf16* XB = (bf16*)(P.out + XB_OFF_FLOATS); float* TMP = (float*)(P.ws + WS_BIG);
    f32x4 xn[4]; u32x2 xbn[4], on[4];
#define RN_LOAD(mm) do { const int m_ = (mm); \
        _Pragma("unroll") for (int j = 0; j < 4; ++j) { \
            if (first) xn[j] = *(const f32x4*)((m_ < MCTX ? P.in[I_XP] + (size_t)m_ * DM : P.in[I_XS] + (size_t)(m_ - MCTX) * DM) + lane * 4 + 256 * j); \
            else { xbn[j] = *(const u32x2*)(XB + (size_t)m_ * DM + lane * 4 + 256 * j); on[j] = *(const u32x2*)(obuf + (size_t)m_ * DM + lane * 4 + 256 * j); } } } while (0)
    if (gw < MT) RN_LOAD(gw);
    for (int m = gw; m < MT; m += NGW) {
        const int modrow = m < MCTX ? 0 : 1 + ((m - MCTX) >> 11);
        const float* mr = modg + (size_t)modrow * 6144; const float* ms = mods + (size_t)modrow * 6144;
        f32x4 x[4]; u32x2 ov[4];
#pragma unroll
        for (int j = 0; j < 4; ++j) { ov[j] = on[j]; x[j] = first ? xn[j] : (f32x4){bflo(xbn[j].x), bfhi(xbn[j].x), bflo(xbn[j].y), bfhi(xbn[j].y)}; }
        if (m + NGW < MT) RN_LOAD(m + NGW);
        f32x4 vgp[4], vgt[4], vgq[4], vsh[4], vsc[4];
#pragma unroll
        for (int j = 0; j < 4; ++j) { const int c = lane * 4 + 256 * j;
            if (!first) { vgp[j] = *(const f32x4*)(gpost + c); vgt[j] = *(const f32x4*)(mr + goff + c); }
            if (has_next) { vgq[j] = *(const f32x4*)(gpre + c); vsh[j] = *(const f32x4*)(ms + soff + c); vsc[j] = *(const f32x4*)(ms + soff + 1024 + c); } }
        if (first) {
            if (m >= MCTX) {
                const int t = (m - MCTX) & 2047; const float prow = (float)(t >> 6), pcol = (float)(t & 63);
                f32x4 om;
#pragma unroll
                for (int e = 0; e < 4; ++e) om[e] = exp2f(-(float)(lane * 4 + e) * (13.287712379549449f / 256.0f));
#pragma unroll
                for (int j = 0; j < 4; ++j) {
#pragma unroll
                    for (int e = 0; e < 4; ++e) { const float a = (j < 2 ? prow : pcol) * om[e]; x[j][e] += (j & 1) ? cosf(a) : sinf(a); } }
            }
        } else {
            float ss = 0.f;
#pragma unroll
            for (int j = 0; j < 4; ++j) { const float a = bflo(ov[j].x), b = bfhi(ov[j].x), c = bflo(ov[j].y), d = bfhi(ov[j].y); ss += (a * a + b * b) + (c * c + d * d); }
            const float rs = rsqrtf(wave_sum(ss, lane) * (1.0f / DM) + EPSF);
#pragma unroll
            for (int j = 0; j < 4; ++j) { f32x4 o4 = (f32x4){bflo(ov[j].x), bfhi(ov[j].x), bflo(ov[j].y), bfhi(ov[j].y)};
                x[j] += vgt[j] * (o4 * (rs * gscale) * vgp[j]); }
        }
        if (has_next) {
#pragma unroll
            for (int j = 0; j < 4; ++j) { u32x2 w; w.x = pk2(x[j][0], x[j][1]); w.y = pk2(x[j][2], x[j][3]); *(u32x2*)(XB + (size_t)m * DM + lane * 4 + 256 * j) = w; }
            float ss = 0.f;
#pragma unroll
            for (int j = 0; j < 4; ++j) ss += (x[j][0] * x[j][0] + x[j][1] * x[j][1]) + (x[j][2] * x[j][2] + x[j][3] * x[j][3]);
            const float rs = rsqrtf(wave_sum(ss, lane) * (1.0f / DM) + EPSF);
#pragma unroll
            for (int j = 0; j < 4; ++j) { const f32x4 h4 = (x[j] * rs * vgq[j]) * (vsc[j] + 1.0f) + vsh[j];
                u32x2 w; w.x = pk2(h4[0], h4[1]); w.y = pk2(h4[2], h4[3]);
                *(u32x2*)(H + (size_t)m * DM + lane * 4 + 256 * j) = w; }
        } else {
            float* dst = (m < MT / 2) ? P.out + (size_t)m * DM : TMP + (size_t)(m - MT / 2) * DM;
#pragma unroll
            for (int j = 0; j < 4; ++j) *(f32x4*)(dst + lane * 4 + 256 * j) = x[j];
        }
    }
}
__device__ __forceinline__ void phase_copy_tail(int wid0, const Params& P) {
    const int tid = tid_fresh(wid0);
    const f32x4* src = (const f32x4*)(P.ws + WS_BIG); f32x4* dst = (f32x4*)(P.out + XB_OFF_FLOATS);
    const size_t n = (size_t)(MT / 2) * DM / 4;
    for (size_t i = (size_t)bid_fresh() * NTHR + tid; i < n; i += (size_t)grid_fresh() * NTHR) dst[i] = src[i];
}

using pg8::Unit;
template <int ACT  > struct EpiBf16 {
    bf16* O; int ldc; float* AB;
    bf16* HALO;
    __device__ __forceinline__ void operator()(const f32x4 (&acc)[2][2][4][2], const Unit& u, int wr, int wc, int fr, int fq) const {
        const int row0 = u.pm * 256 + wr * 64 + fr, col0 = u.pn * 256 + wc * 32 + 8 * fq;
        if (AB && u.pn * 256 >= ldc) {
            if (wc == 0 && fq < 2) {
#pragma unroll
                for (int ai = 0; ai < 2; ++ai)
#pragma unroll
                    for (int m = 0; m < 4; ++m) { float* p = AB + (size_t)(row0 + ai * 128 + m * 16) * 16 + 8 * fq; *(f32x4*)p = acc[ai][0][m][0]; *(f32x4*)(p + 4) = acc[ai][0][m][1]; }
            }
            return;
        }
#pragma unroll
        for (int ai = 0; ai < 2; ++ai)
#pragma unroll
            for (int m = 0; m < 4; ++m) { bf16* rowp = O + (size_t)(row0 + ai * 128 + m * 16) * ldc + col0;
#pragma unroll
                for (int bj = 0; bj < 2; ++bj) { f32x4 v0 = acc[ai][bj][m][0], v1 = acc[ai][bj][m][1];
                    if (ACT == 1) {
#pragma unroll
                        for (int j = 0; j < 4; ++j) { const float a = fmaxf(v0[j], 0.f), b = fmaxf(v1[j], 0.f); v0[j] = a * a; v1[j] = b * b; } }
                    u32x4 w; w.x = pk2(v0[0], v0[1]); w.y = pk2(v0[2], v0[3]); w.z = pk2(v1[0], v1[1]); w.w = pk2(v1[2], v1[3]);
                    *(u32x4*)(rowp + bj * 128) = w;
                    if (ACT == 0 && HALO && u.pn >= 4 && u.pn < 10 && ((m == 3 && fr == 15) || (m == 0 && fr < 2))) {
                        const int r = row0 + ai * 128 + m * 16; const int which = (m == 3) ? 0 : 1 + fr;
                        *(u32x4*)(HALO + ((size_t)(r >> 6) * 3 + which) * 1536 + (col0 + bj * 128 - 1024)) = w; } } }
    }
};
struct EpiSplit {
    bf16* O0; long stride;
    __device__ __forceinline__ void operator()(const f32x4 (&acc)[2][2][4][2], const Unit& u, int wr, int wc, int fr, int fq) const {
        const int row0 = u.pm * 256 + wr * 64 + fr, col0 = (u.pn >> 1) * 256 + wc * 32 + 8 * fq; bf16* O = O0 + (long)(u.pn & 1) * stride;
#pragma unroll
        for (int ai = 0; ai < 2; ++ai)
#pragma unroll
            for (int m = 0; m < 4; ++m) { bf16* rowp = O + (size_t)(row0 + ai * 128 + m * 16) * DM + col0;
#pragma unroll
                for (int bj = 0; bj < 2; ++bj) { const f32x4 v0 = acc[ai][bj][m][0], v1 = acc[ai][bj][m][1];
                    u32x4 w; w.x = pk2(v0[0], v0[1]); w.y = pk2(v0[2], v0[3]); w.z = pk2(v1[0], v1[1]); w.w = pk2(v1[2], v1[3]);
                    *(u32x4*)(rowp + bj * 128) = w; } }
    }
};
struct EpiGates {
    unsigned* G; const bf16* X; const float* br; const float* bi; const float* lam;
    __device__ __forceinline__ void operator()(const f32x4 (&acc)[2][2][4][2], const Unit& u, int wr, int wc, int fr, int fq) const {
        const int row0 = u.pm * 256 + wr * 64 + fr, ch0 = u.pn * 128 + wc * 32 + 8 * fq;
        u32x2 xv[2][2][4];
#pragma unroll
        for (int n = 0; n < 2; ++n)
#pragma unroll
            for (int ai = 0; ai < 2; ++ai)
#pragma unroll
                for (int m = 0; m < 4; ++m) xv[n][ai][m] = *(const u32x2*)(X + (size_t)(row0 + ai * 128 + m * 16) * DM + ch0 + 4 * n);
        f32x4 pbr[2], pbi[2], pl4[2];
#pragma unroll
        for (int n = 0; n < 2; ++n) { pbr[n] = *(const f32x4*)(br + ch0 + 4 * n); pbi[n] = *(const f32x4*)(bi + ch0 + 4 * n); pl4[n] = *(const f32x4*)(lam + ch0 + 4 * n); }
#pragma unroll
        for (int n = 0; n < 2; ++n) {
            const f32x4 vbr = pbr[n], vbi = pbi[n], l4 = pl4[n];
            f32x4 vsp;
#pragma unroll
            for (int e = 0; e < 4; ++e) vsp[e] = -8.0f * softplusf_(-l4[e]);
#pragma unroll
            for (int ai = 0; ai < 2; ++ai)
#pragma unroll
                for (int m = 0; m < 4; ++m) { const size_t row = (size_t)(row0 + ai * 128 + m * 16);
                    const float xs[4] = {bflo(xv[n][ai][m].x), bfhi(xv[n][ai][m].x), bflo(xv[n][ai][m].y), bfhi(xv[n][ai][m].y)};
                    u32x4 w;
#pragma unroll
                    for (int e = 0; e < 4; ++e) { const float r = sigmoidf_(acc[ai][0][m][n][e] + vbr[e]), ig = sigmoidf_(acc[ai][1][m][n][e] + vbi[e]);
                        const float la = r * vsp[e]; const float a_ = __expf(la); const float b = __builtin_amdgcn_sqrtf(fmaxf(1.0f - a_ * a_, 0.f)) * ig * xs[e];
                        w[e] = pk2(1.0f - a_, b); }
                    *(u32x4*)(G + row * DM + ch0 + 4 * n) = w; }
        }
    }
};
constexpr int S5_WLDS = 12800, BU_P = 132, HS_P = 136;
struct S5Dir { float ar, ai; bf16x8 Bf[8]; };
__device__ __forceinline__ void s5_dir_setup(const Params& P, int e, int d, int g, int lane, float& ar, float& ai, bf16x8 (&Bf)[8], bool needB) {
    const int quad = lane >> 4, l15 = lane & 15;
    const float dt = __expf(P.in[I_LOGDT][(e * 2 + d) * 32 + g]);
    const float lr = P.in[I_LAMRE][((e * 2 + d) * 32 + g) * 64 + lane], li = P.in[I_LAMIM][((e * 2 + d) * 32 + g) * 64 + lane];
    const float mag = expf(lr * dt); ar = mag * cosf(li * dt); ai = mag * sinf(li * dt);
    const float den = lr * lr + li * li;
    const float fr = ((ar - 1.0f) * lr + ai * li) / den, fi = (ai * lr - (ar - 1.0f) * li) / den;
    if (needB) {
#pragma unroll
        for (int nt = 0; nt < 8; ++nt) { const int col = 16 * nt + l15, p = col & 63;
            const float frp = shfl_i(fr, p), fip = shfl_i(fi, p);
            bf16x8 v = (bf16x8){0, 0, 0, 0, 0, 0, 0, 0};
            if (quad < 2) { const float* bre = P.in[I_BRE] + ((size_t)(e * 32 + g) * 64 + p) * 16 + quad * 8; const float* bim = P.in[I_BIM] + ((size_t)(e * 32 + g) * 64 + p) * 16 + quad * 8;
#pragma unroll
                for (int j = 0; j < 8; ++j) { const float br = bre[j], bi = bim[j]; const float val = (nt < 4) ? (frp * br - fip * bi) : (frp * bi + fip * br); v[j] = (short)f2bf(val); } }
            Bf[nt] = v; }
    }
}
__device__ __forceinline__ void s5_c_setup(const Params& P, int e, int g, int lane, bf16x8 (&Cf)[4]) {
    const int quad = lane >> 4, l15 = lane & 15;
#pragma unroll
    for (int ks = 0; ks < 4; ++ks) { const int col0 = 32 * ks + quad * 8; const bool im = col0 >= 64;
        const float* src = (im ? P.in[I_CIM] : P.in[I_CRE]) + ((size_t)(e * 32 + g) * 16 + l15) * 64 + (col0 & 63);
        bf16x8 v;
#pragma unroll
        for (int j = 0; j < 8; ++j) v[j] = (short)f2bf(im ? -src[j] : src[j]);
        Cf[ks] = v; }
}
__device__ __forceinline__ void s5_scan_seg(const Params& P, LAS unsigned char* wl, int lane, int d, int g, int m0, float ar, float ai, const bf16x8 (&Bf)[8], const bf16x8 (&Cf)[4],
                                            float& hr, float& hi, int mode, int ymode, const bf16* proj, float* ybuf, bf16* mixout, float dsk, int dry = 0) {
    const int quad = lane >> 4, l15 = lane & 15;
    LAS float* BU = (LAS float*)wl; LAS bf16* HS = (LAS bf16*)(wl + 8448);
    const int ch = g * 16 + l15;
    bf16x8 a_next = (bf16x8){0, 0, 0, 0, 0, 0, 0, 0};
    if (mode == 0 && quad < 2) { const int blk0 = d ? 15 : 0; const int tt = d ? 15 - l15 : l15; a_next = *(const bf16x8*)(proj + (size_t)(m0 + 16 * blk0 + tt) * NPROJ_E + g * 16 + quad * 8); }
    float pre_n[4], zz_n[4];
    { const int mb0 = m0 + 16 * (d ? 15 : 0);
#pragma unroll
      for (int jj = 0; jj < 4; ++jj) { const int row = quad * 4 + jj; const int tt = d ? 15 - row : row; const size_t m = (size_t)(mb0 + tt);
          pre_n[jj] = (ymode == 0) ? dsk * bf2f(proj[m * NPROJ_E + ch]) : ybuf[m * 512 + ch];
          zz_n[jj] = (ymode == 2) ? bf2f(proj[m * NPROJ_E + 512 + ch]) : 0.f; } }
    for (int bi_ = 0; bi_ < 16; ++bi_) {
        const int blk = d ? 15 - bi_ : bi_;
        const int mb = m0 + 16 * blk;
        const bf16x8 a = a_next;
        if (mode == 0 && quad < 2 && bi_ + 1 < 16) { const int blkn = d ? 14 - bi_ : bi_ + 1; const int tt = d ? 15 - l15 : l15; a_next = *(const bf16x8*)(proj + (size_t)(m0 + 16 * blkn + tt) * NPROJ_E + g * 16 + quad * 8); }
        float pre[4], zz[4];
#pragma unroll
        for (int jj = 0; jj < 4; ++jj) { pre[jj] = pre_n[jj]; zz[jj] = zz_n[jj]; }
        if (bi_ + 1 < 16) { const int mbn = m0 + 16 * (d ? 14 - bi_ : bi_ + 1);
#pragma unroll
            for (int jj = 0; jj < 4; ++jj) { const int row = quad * 4 + jj; const int tt = d ? 15 - row : row; const size_t m = (size_t)(mbn + tt);
                pre_n[jj] = (ymode == 0) ? dsk * bf2f(proj[m * NPROJ_E + ch]) : ybuf[m * 512 + ch];
                zz_n[jj] = (ymode == 2) ? bf2f(proj[m * NPROJ_E + 512 + ch]) : 0.f; } }
        if (mode == 0) {
#pragma unroll
            for (int nt = 0; nt < 8; ++nt) { f32x4 acc = mfma16(a, Bf[nt], (f32x4){0.f, 0.f, 0.f, 0.f});
#pragma unroll
                for (int jj = 0; jj < 4; ++jj) BU[(quad * 4 + jj) * BU_P + 16 * nt + l15] = acc[jj]; }
            WAVE_SYNC();
        }
#pragma unroll
        for (int r = 0; r < 16; ++r) {
            float br = 0.f, bim = 0.f;
            if (mode == 0) { br = BU[r * BU_P + lane]; bim = BU[r * BU_P + 64 + lane]; }
            const float nr = ar * hr - ai * hi + br, ni = ar * hi + ai * hr + bim; hr = nr; hi = ni;
            HS[r * HS_P + lane] = (bf16)f2bf(hr); HS[r * HS_P + 64 + lane] = (bf16)f2bf(hi);
        }
        WAVE_SYNC();
        f32x4 y = (f32x4){0.f, 0.f, 0.f, 0.f};
#pragma unroll
        for (int ks = 0; ks < 4; ++ks) { const bf16x8 af = *(const LAS bf16x8*)(HS + l15 * HS_P + 32 * ks + quad * 8); y = mfma16(af, Cf[ks], y); }
#pragma unroll
        for (int jj = 0; jj < 4; ++jj) { const int row = quad * 4 + jj; const int tt = d ? 15 - row : row; const size_t m = (size_t)(mb + tt);
            const float v = y[jj] + pre[jj];
            if (!dry) { if (ymode != 2) ybuf[m * 512 + ch] = v;
            else mixout[m * DM + ch] = (bf16)f2bf(geluf_(v) * sigmoidf_(zz[jj])); }
        }
        WAVE_SYNC();
    }
}
__device__ __forceinline__ void s5_task_main(const Params& P, LAS unsigned char* wl, int lane, int e, int sub, int g) {
    const bf16* proj = (const bf16*)(P.ws + WS_BIG); float* ybuf = (float*)(P.ws + WS_YBUF); bf16* mixout = (bf16*)(P.ws + WS_MIX);
    const bool lat = sub >= 32; const int q = sub - 32, b = lat ? (q >> 3) : sub, seg = lat ? (q & 7) : 0;
    const int m0 = lat ? MCTX + b * LLAT + seg * 256 : sub * 256;
    bf16x8 Cf[4]; s5_c_setup(P, e, g, lane, Cf);
    const float dsk = P.in[I_S5D][e * 512 + g * 16 + (lane & 15)];
#pragma unroll 1
    for (int d = 0; d < 2; ++d) {
        float ar, ai; bf16x8 Bf[8]; s5_dir_setup(P, e, d, g, lane, ar, ai, Bf, true);
        float hr = 0.f, hi = 0.f;
        if (lat && ((d == 0 && seg == 0) || (d == 1 && seg == 7))) { const size_t si = ((((size_t)b * 2 + e) * 2 + d) * 32 + g) * 64 + lane; hr = P.in[I_S5RE][si]; hi = P.in[I_S5IM][si]; }
        const int ymode = d == 0 ? 0 : (lat ? 1 : 2);
        s5_scan_seg(P, wl, lane, d, g, m0, ar, ai, Bf, Cf, hr, hi, 0, ymode, proj, ybuf, mixout, dsk);
        if (!lat) { const size_t si = ((((size_t)b * 2 + e) * 2 + d) * 32 + g) * 64 + lane; P.out[OUT_S5RE + si] = hr; P.out[OUT_S5IM + si] = hi; }
        else { float* F = (float*)(P.ws + WS_S5F) + ((((size_t)d * 64 + q) * 32 + g) * 64 + lane) * 2; F[0] = hr; F[1] = hi; }
    }
}
__device__ __forceinline__ void s5_task_corr(const Params& P, LAS unsigned char* wl, int lane, int e, int q, int g, int dry = 0) {
    const bf16* proj = (const bf16*)(P.ws + WS_BIG); float* ybuf = (float*)(P.ws + WS_YBUF); bf16* mixout = (bf16*)(P.ws + WS_MIX);
    const int b = q >> 3, seg = q & 7, m0 = MCTX + b * LLAT + seg * 256;
    bf16x8 Cf[4]; s5_c_setup(P, e, g, lane, Cf);
    bf16x8 Bf[8];
#pragma unroll
    for (int i = 0; i < 8; ++i) Bf[i] = (bf16x8){0, 0, 0, 0, 0, 0, 0, 0};
    const float* Fb = (const float*)(P.ws + WS_S5F);
#pragma unroll 1
    for (int d = 0; d < 2; ++d) {
        float ar, ai; s5_dir_setup(P, e, d, g, lane, ar, ai, Bf, false);
        float pr = ar, pi = ai;
#pragma unroll
        for (int i = 0; i < 8; ++i) { const float nr = pr * pr - pi * pi, ni = 2.0f * pr * pi; pr = nr; pi = ni; }
        float hr = 0.f, hi = 0.f;
        const int cnt = d == 0 ? seg : 7 - seg;
        f2_t fv[7];
#pragma unroll
        for (int i = 0; i < 7; ++i) { const int sj = d == 0 ? i : 7 - i; fv[i] = (i < cnt) ? *(const f2_t*)(Fb + ((((size_t)d * 64 + b * 8 + sj) * 32 + g) * 64 + lane) * 2) : (f2_t){0.f, 0.f}; }
#pragma unroll
        for (int i = 0; i < 7; ++i) if (i < cnt) { const float nr = pr * hr - pi * hi + fv[i].x, ni = pr * hi + pi * hr + fv[i].y; hr = nr; hi = ni; }
        const int ym = (d == 1 || seg == 7) ? 2 : 1;
        if (cnt > 0) s5_scan_seg(P, wl, lane, d, g, m0, ar, ai, Bf, Cf, hr, hi, 1, ym, proj, ybuf, mixout, 0.f, dry);
    }
}

#ifndef REP_A
#define REP_A 1
#endif
#ifndef REP_B
#define REP_B 1
#endif
#ifndef REP_C
#define REP_C 1
#endif
__device__ __forceinline__ void phase_conv_even(int wid0, const Params& P, int e, int dry = 0) {
    const int tid = tid_fresh(wid0), lane = tid & 63, wave = tid >> 6;
    const int gw = bid_fresh() * NWAVES + wave, NGW = grid_fresh() * NWAVES;
    bf16* proj = (bf16*)(P.ws + WS_BIG); const bf16* HALO = (const bf16*)(P.ws + WS_HALO);
    for (int it = gw; it < 384 * 24; it += NGW) {
        const int c = it / 24, cgp = it % 24, ccol = cgp * 64 + lane;
        const int r0 = c * 64;
        const bool lat = r0 >= MCTX; const int t0 = lat ? ((r0 - MCTX) & 2047) : (r0 & 255); const int L = lat ? LLAT : LCTX;
        bf16* base = proj + (size_t)r0 * NPROJ_E + 1024 + ccol;
        bf16 x[67];
#pragma unroll
        for (int i = 0; i < 64; ++i) x[i + 1] = base[(size_t)i * NPROJ_E];
        x[0] = (t0 > 0) ? HALO[((size_t)(c - 1) * 3 + 0) * 1536 + ccol] : (bf16)0;
        x[65] = (t0 + 64 < L) ? HALO[((size_t)(c + 1) * 3 + 1) * 1536 + ccol] : (bf16)0;
        x[66] = (t0 + 64 < L) ? HALO[((size_t)(c + 1) * 3 + 2) * 1536 + ccol] : (bf16)0;
        const float* cw = P.in[I_GCONVW] + (size_t)e * 4 * 1536 + ccol; const float w0 = cw[0], w1 = cw[1536], w2 = cw[3072], w3 = cw[4608], cb = P.in[I_GCONVB][e * 1536 + ccol];
#pragma unroll
        for (int i = 0; i < 64; ++i) { const float v = cb + w0 * bf2f(x[i]) + w1 * bf2f(x[i + 1]) + w2 * bf2f(x[i + 2]) + w3 * bf2f(x[i + 3]);
            if (!dry) base[(size_t)i * NPROJ_E] = (bf16)f2bf(siluf_(v)); }
    }
}
#define LDS_BARRIER() do { asm volatile("s_waitcnt lgkmcnt(0)" ::: "memory"); __builtin_amdgcn_s_barrier(); asm volatile("" ::: "memory"); } while (0)
constexpr int G_Q = 0, G_K = 17408, G_V = 34816, G_KT = 52224, G_LM = 70656, G_QK = 89088, G_ST = 98304, G_SM = 133120;
constexpr int P128 = 136, P64 = 72, LMP = 68;
__device__ __forceinline__ bf16x8 ld_split8(const LAS bf16* p) {
    const u32x2 a = *(const LAS u32x2*)p, b = *(const LAS u32x2*)(p + 16);
    return __builtin_bit_cast(bf16x8, (u32x4){a.x, a.y, b.x, b.y});
}
__device__ __forceinline__ bf16x8 pack_acc2(const f32x4& a, const f32x4& b) { return __builtin_bit_cast(bf16x8, (u32x4){pk2(a[0], a[1]), pk2(a[2], a[3]), pk2(b[0], b[1]), pk2(b[2], b[3])}); }
__device__ __forceinline__ void gdn_chain(int wid0, const Params& P, LAS unsigned char* lds, int e, int s, int hd, int dir) {
    const int tid = tid_fresh(wid0), lane = tid & 63, w = __builtin_amdgcn_readfirstlane(tid >> 6), quad = lane >> 4, l15 = lane & 15;
    const bool lat = s >= 32; const int b = lat ? s - 32 : s; const int L = lat ? LLAT : LCTX; const int m0 = lat ? MCTX + b * LLAT : s * LCTX;
    const bf16* proj = (const bf16*)(P.ws + WS_BIG); const float* AB = (const float*)(P.ws + WS_AB);
    bf16* Odir = (bf16*)(P.ws + WS_H) + (size_t)dir * MT * 512;
    int zv; asm volatile("v_mov_b32 %0, 0" : "=v"(zv));
    lds += zv;
    LAS bf16* Qs = (LAS bf16*)(lds + G_Q); LAS bf16* Ks = (LAS bf16*)(lds + G_K); LAS bf16* Vs = (LAS bf16*)(lds + G_V); LAS bf16* KT = (LAS bf16*)(lds + G_KT);
    LAS float* Lm = (LAS float*)(lds + G_LM); LAS bf16* VNT = (LAS bf16*)(lds + G_LM); LAS bf16* QKs = (LAS bf16*)(lds + G_QK); LAS bf16* ST = (LAS bf16*)(lds + G_ST);
    LAS bf16* TM = (LAS bf16*)(lds + G_ST); LAS bf16* TT = TM + 64 * P64; LAS bf16* LR = TT + 64 * P64;
    LAS float* rq = (LAS float*)(lds + G_SM); LAS float* rk = rq + 64; LAS float* gcs = rq + 128; LAS float* betas = rq + 192; LAS float* egs = rq + 256; LAS float* kes = rq + 320;
    f32x4 Sacc[8];
    const size_t sbase = ((((size_t)b * 2 + e) * 2 + dir) * 4 + hd) * 16384;
#pragma unroll
    for (int mt = 0; mt < 8; ++mt) Sacc[mt] = (f32x4){0.f, 0.f, 0.f, 0.f};
    if (lat) { const float* sp = P.in[I_SDELTA] + sbase + (size_t)(quad * 4) * 128 + 16 * w + l15;
#pragma unroll
        for (int mt = 0; mt < 8; ++mt)
#pragma unroll
            for (int jj = 0; jj < 4; ++jj) Sacc[mt][jj] = sp[(16 * mt + jj) * 128]; }
    for (int i = tid; i < 2 * 64 * P64 / 2; i += NTHR) ((LAS unsigned*)TM)[i] = 0u;
    const float alog_e = __expf(P.in[I_GALOG][(e * 2 + dir) * 4 + hd]), dtb = P.in[I_GDTB][(e * 2 + dir) * 4 + hd];
    const int nchunk = L / 64;
    u32x4 xr[6]; float ab_a = 0.f, ab_b = 0.f;
#define GDN_LOAD(ci_) do { const int tid_ = tid_fresh(wid0); const int c0_ = dir ? L - 64 * ((ci_) + 1) : 64 * (ci_); \
        _Pragma("unroll") for (int k = 0; k < 6; ++k) { const int p_ = tid_ + 512 * k, part_ = p_ >> 10, row_ = (p_ & 1023) >> 4, pc_ = p_ & 15; \
            xr[k] = *(const u32x4*)(proj + (size_t)(m0 + c0_ + row_) * NPROJ_E + 1024 + part_ * 512 + hd * 128 + pc_ * 8); } \
        if (w == 0) { const int ln_ = tid_ & 63; const size_t m_ = (size_t)(m0 + c0_ + (dir ? 63 - ln_ : ln_)); ab_a = AB[m_ * 16 + dir * 4 + hd]; ab_b = AB[m_ * 16 + 8 + dir * 4 + hd]; } } while (0)
    GDN_LOAD(0);
#pragma unroll 1
    for (int ci = 0; ci < nchunk; ++ci) {
        const int tid = tid_fresh(wid0), lane = tid & 63, quad = lane >> 4, l15 = lane & 15;
        const int c0 = dir ? L - 64 * (ci + 1) : 64 * ci;
        LDS_BARRIER();
#ifndef NO_A
        const float cur_a = ab_a, cur_b = ab_b;
#pragma unroll
        for (int k = 0; k < 6; ++k) { const int p_ = tid + 512 * k, part_ = p_ >> 10, row_ = (p_ & 1023) >> 4, pc_ = p_ & 15;
            LAS bf16* dst = part_ == 0 ? Qs : (part_ == 1 ? Ks : Vs);
            *(LAS u32x4*)(dst + (dir ? 63 - row_ : row_) * P128 + pc_ * 8) = xr[k]; }
        if (ci + 1 < nchunk) GDN_LOAD(ci + 1);
#endif
        LDS_BARRIER();
#pragma unroll 1
        for (int repB = 0; repB < REP_B; ++repB)
        { const int rowid = tid >> 2, part = tid & 3; LAS bf16* src = (rowid < 64 ? Qs : Ks) + (rowid & 63) * P128 + part * 32;
          float ss = 0.f;
#pragma unroll
          for (int i = 0; i < 4; ++i) { const u32x4 v = *(const LAS u32x4*)(src + 8 * i);
#pragma unroll
              for (int j = 0; j < 4; ++j) { const float a = bflo(v[j]), c = bfhi(v[j]); ss += a * a + c * c; } }
          ss += shfl_i(ss, lane ^ 1); ss += shfl_i(ss, lane ^ 2);
          if (part == 0) { if (rowid < 64) rq[rowid] = rsqrtf(ss + EPSF) * 0.08838834764831845f; else rk[rowid - 64] = rsqrtf(ss + EPSF); }
          if (w == 0) { const int t = c0 + (dir ? 63 - lane : lane); const size_t m = (size_t)(m0 + t);
              const float araw = cur_a, braw = cur_b;
              const float gg = -alog_e * softplusf_(araw + dtb);
              float gc = gg;
#pragma unroll
              for (int o = 1; o < 64; o <<= 1) { const float t2 = shfl_i(gc, (lane - o) & 63); if (lane >= o) gc += t2; }
              const float glast = shfl_i(gc, 63);
              gcs[lane] = gc; betas[lane] = sigmoidf_(braw); egs[lane] = __expf(gc); kes[lane] = __expf(glast - gc);
              if (lane == 0) rq[384] = __expf(glast); } }
        LDS_BARRIER();
#ifndef NO_C
#pragma unroll 1
        for (int repC = 0; repC < REP_C; ++repC)
        { const int mt = w & 3; const bool isq = w >= 4; LAS bf16* src = isq ? Qs : Ks;
          bf16x8 a[4];
#pragma unroll
          for (int ks = 0; ks < 4; ++ks) a[ks] = *(const LAS bf16x8*)(src + (16 * mt + l15) * P128 + 32 * ks + quad * 8);
#pragma unroll 1
          for (int nt = 0; nt < 4; ++nt) { f32x4 acc = (f32x4){0.f, 0.f, 0.f, 0.f};
#pragma unroll
              for (int ks = 0; ks < 4; ++ks) { const bf16x8 bb = *(const LAS bf16x8*)(Ks + (16 * nt + l15) * P128 + 32 * ks + quad * 8); acc = mfma16(a[ks], bb, acc); }
              const int j = 16 * nt + l15; const float rkj = rk[j], gcj = gcs[j];
              f32x4 lv;
#pragma unroll
              for (int jj = 0; jj < 4; ++jj) { const int i = 16 * mt + quad * 4 + jj; const float dec = __expf(fminf(gcs[i] - gcj, 0.f));
                  lv[jj] = (i > j) ? acc[jj] * rk[i] * rkj * betas[i] * dec : 0.f;
                  if (isq) QKs[i * P64 + j] = (bf16)f2bf((i >= j) ? acc[jj] * rq[i] * rkj * dec : 0.f); }
              if (!isq) { *(LAS f32x4*)(Lm + j * LMP + 16 * mt + quad * 4) = lv;
#pragma unroll
                  for (int jj = 0; jj < 4; ++jj) LR[(16 * mt + quad * 4 + jj) * P64 + j] = (bf16)f2bf(nt < mt ? lv[jj] : 0.f); } }
          const int dd = tid & 127, tq = tid >> 7;
          unsigned pw[8];
#pragma unroll
          for (int n = 0; n < 16; n += 2) { const int i0 = tq * 16 + n; const float v0 = bf2f(Ks[i0 * P128 + dd]) * rk[i0] * kes[i0], v1 = bf2f(Ks[(i0 + 1) * P128 + dd]) * rk[i0 + 1] * kes[i0 + 1]; pw[n >> 1] = pk2(v0, v1); }
          *(LAS u32x4*)(KT + dd * P64 + tq * 16) = (u32x4){pw[0], pw[1], pw[2], pw[3]};
          *(LAS u32x4*)(KT + dd * P64 + tq * 16 + 8) = (u32x4){pw[4], pw[5], pw[6], pw[7]}; }
#endif
        LDS_BARRIER();
        { const int i = tid >> 3, c0k = (tid & 7) * 16; const float sc = rk[i] * betas[i] * egs[i];
#pragma unroll
          for (int h2 = 0; h2 < 2; ++h2) { u32x4 v = *(LAS u32x4*)(Ks + i * P128 + c0k + 8 * h2);
#pragma unroll
              for (int q = 0; q < 4; ++q) v[q] = pk2(bflo(v[q]) * sc, bfhi(v[q]) * sc);
              *(LAS u32x4*)(Ks + i * P128 + c0k + 8 * h2) = v; } }
        if (w == 0) { const int bb = lane >> 4, c = lane & 15;
            float x[16];
#pragma unroll
            for (int r = 0; r < 16; ++r) x[r] = (r == c) ? 1.f : 0.f;
#pragma unroll
            for (int j = 0; j < 15; ++j) {
#pragma unroll
                for (int q4 = j / 4; q4 < 4; ++q4) { const f32x4 l4 = *(const LAS f32x4*)(Lm + (16 * bb + j) * LMP + 16 * bb + 4 * q4);
#pragma unroll
                    for (int jx = 0; jx < 4; ++jx) if (4 * q4 + jx > j) x[4 * q4 + jx] -= l4[jx] * x[j]; } }
            unsigned pw[8];
#pragma unroll
            for (int r = 0; r < 16; r += 2) { pw[r >> 1] = pk2(x[r], x[r + 1]); TM[(16 * bb + r) * P64 + 16 * bb + c] = (bf16)(pw[r >> 1] & 0xffffu); TM[(16 * bb + r + 1) * P64 + 16 * bb + c] = (bf16)(pw[r >> 1] >> 16); }
            *(LAS u32x4*)(TT + (16 * bb + c) * P64 + 16 * bb) = (u32x4){pw[0], pw[1], pw[2], pw[3]};
            *(LAS u32x4*)(TT + (16 * bb + c) * P64 + 16 * bb + 8) = (u32x4){pw[4], pw[5], pw[6], pw[7]}; }
        LDS_BARRIER();
#pragma unroll 1
        for (int lev = 1; lev < 4; ++lev) {
            if (w < 4 - lev) { const int bj = w, bi = w + lev;
                f32x4 m = (f32x4){0.f, 0.f, 0.f, 0.f};
#pragma unroll
                for (int ks = 0; ks < 2; ++ks) { const bf16x8 a = *(const LAS bf16x8*)(LR + (16 * bi + l15) * P64 + 32 * ks + quad * 8), bq = *(const LAS bf16x8*)(TT + (16 * bj + l15) * P64 + 32 * ks + quad * 8); m = mfma16(a, bq, m); }
                const u32x2 tl = *(const LAS u32x2*)(TM + (16 * bi + l15) * P64 + 16 * bi + quad * 4);
                const bf16x8 a2 = __builtin_bit_cast(bf16x8, (u32x4){tl.x, tl.y, 0u, 0u}), b2 = __builtin_bit_cast(bf16x8, (u32x4){pk2(m[0], m[1]), pk2(m[2], m[3]), 0u, 0u});
                const f32x4 t = mfma16(a2, b2, (f32x4){0.f, 0.f, 0.f, 0.f});
                const unsigned p0 = pk2(-t[0], -t[1]), p1 = pk2(-t[2], -t[3]);
                TM[(16 * bi + quad * 4 + 0) * P64 + 16 * bj + l15] = (bf16)(p0 & 0xffffu); TM[(16 * bi + quad * 4 + 1) * P64 + 16 * bj + l15] = (bf16)(p0 >> 16);
                TM[(16 * bi + quad * 4 + 2) * P64 + 16 * bj + l15] = (bf16)(p1 & 0xffffu); TM[(16 * bi + quad * 4 + 3) * P64 + 16 * bj + l15] = (bf16)(p1 >> 16);
                *(LAS u32x2*)(TT + (16 * bj + l15) * P64 + 16 * bi + quad * 4) = (u32x2){p0, p1}; }
            LDS_BARRIER();
        }
#ifndef NO_EFG
        bf16x8 Bst[4];
#pragma unroll
        for (int ks = 0; ks < 4; ++ks) Bst[ks] = pack_acc2(Sacc[2 * ks], Sacc[2 * ks + 1]);
        f32x4 vn[4];
#pragma unroll
        for (int mt = 0; mt < 4; ++mt) { f32x4 acc = (f32x4){0.f, 0.f, 0.f, 0.f};
#pragma unroll
            for (int ks = 0; ks < 4; ++ks) { const bf16x8 a = ld_split8(Ks + (16 * mt + l15) * P128 + 32 * ks + quad * 4); acc = mfma16(a, Bst[ks], acc); }
#pragma unroll
            for (int jj = 0; jj < 4; ++jj) { const int i = 16 * mt + quad * 4 + jj; vn[mt][jj] = bf2f(Vs[i * P128 + 16 * w + l15]) * betas[i] - acc[jj]; } }
        bf16x8 Bvn[2];
#pragma unroll
        for (int k2 = 0; k2 < 2; ++k2) Bvn[k2] = pack_acc2(vn[2 * k2], vn[2 * k2 + 1]);
#pragma unroll
        for (int mt = 0; mt < 4; ++mt) { f32x4 acc = (f32x4){0.f, 0.f, 0.f, 0.f};
#pragma unroll
            for (int k2 = 0; k2 < 2; ++k2) { const bf16x8 a = ld_split8(TM + (16 * mt + l15) * P64 + 32 * k2 + quad * 4); acc = mfma16(a, Bvn[k2], acc); }
            vn[mt] = acc; }
#pragma unroll
        for (int k2 = 0; k2 < 2; ++k2) Bvn[k2] = pack_acc2(vn[2 * k2], vn[2 * k2 + 1]);
#pragma unroll 1
        for (int mt = 0; mt < 4; ++mt) { f32x4 acc = (f32x4){0.f, 0.f, 0.f, 0.f};
#pragma unroll
            for (int ks = 0; ks < 4; ++ks) { const bf16x8 a = ld_split8(Qs + (16 * mt + l15) * P128 + 32 * ks + quad * 4); acc = mfma16(a, Bst[ks], acc); }
#pragma unroll
            for (int jj = 0; jj < 4; ++jj) { const int i = 16 * mt + quad * 4 + jj; acc[jj] *= rq[i] * egs[i]; }
#pragma unroll
            for (int k2 = 0; k2 < 2; ++k2) { const bf16x8 a = ld_split8(QKs + (16 * mt + l15) * P64 + 32 * k2 + quad * 4); acc = mfma16(a, Bvn[k2], acc); }
#pragma unroll
            for (int jj = 0; jj < 4; ++jj) { const int i = 16 * mt + quad * 4 + jj; const int t = c0 + (dir ? 63 - i : i);
                Odir[(size_t)(m0 + t) * 512 + hd * 128 + 16 * w + l15] = (bf16)f2bf(acc[jj]); } }
        const float egl = rq[384];
#pragma unroll
        for (int mt = 0; mt < 8; ++mt) { f32x4 acc = Sacc[mt] * egl;
#pragma unroll
            for (int k2 = 0; k2 < 2; ++k2) { const bf16x8 a = ld_split8(KT + (16 * mt + l15) * P64 + 32 * k2 + quad * 4); acc = mfma16(a, Bvn[k2], acc); }
            Sacc[mt] = acc; }
#endif
        WAVE_SYNC();
    }
    if (!lat) { const int tid2 = tid_fresh(wid0), lane2 = tid2 & 63; float* dp = P.out + OUT_DELTA + sbase + (size_t)((lane2 >> 4) * 4) * 128 + 16 * w + (lane2 & 15);
#pragma unroll
        for (int mt = 0; mt < 8; ++mt)
#pragma unroll
            for (int jj = 0; jj < 4; ++jj) dp[(16 * mt + jj) * 128] = Sacc[mt][jj];
    }
    __syncthreads();
}

__device__ __forceinline__ void phase_mix_even(int wid0, const Params& P, LAS unsigned char* lds, int e, int mode = 3) {
    const int bid = bid_fresh(), G = grid_fresh();
    if (G == 256) {
        if (bid < 64) { const int s = 32 + (bid >> 3), hd = (bid >> 1) & 3, dir = bid & 1; if (mode & 1) gdn_chain(wid0, P, lds, e, s, hd, dir); }
        else { const int bb = bid - 64;
            if (mode & 1) for (int c = bb; c < 256; c += 192) { const int s = c >> 3, hd = (c >> 1) & 3, dir = c & 1; gdn_chain(wid0, P, lds, e, s, hd, dir); }
            if (mode & 2) { const int tid = tid_fresh(wid0), lane = tid & 63, wave = tid >> 6;
                for (int t = bb; t < 384; t += 192) { const int wt = t * 8 + wave; s5_task_main(P, lds + wave * S5_WLDS, lane, e, wt >> 5, wt & 31); } }
            if (mode == 3) { __syncthreads(); const int tid = tid_fresh(wid0), lane = tid & 63, wave = tid >> 6;
                for (int it = bb * NWAVES + wave; it < WITEMS_ODD; it += 192 * NWAVES) weight_item(P, (LAS float*)(lds + wave * 16384), 2 * e + 1, it, lane); } }
    } else {
        for (int c = bid; c < 320; c += G) { const int s = c < 64 ? 32 + (c >> 3) : ((c - 64) >> 3), hd = (c >> 1) & 3, dir = c & 1; gdn_chain(wid0, P, lds, e, s, hd, dir); }
        const int tid = tid_fresh(wid0), lane = tid & 63, wave = tid >> 6;
        for (int t = bid; t < 384; t += G) { const int wt = t * 8 + wave; s5_task_main(P, lds + wave * S5_WLDS, lane, e, wt >> 5, wt & 31); }
        __syncthreads();
        for (int it = bid * NWAVES + wave; it < WITEMS_ODD; it += G * NWAVES) weight_item(P, (LAS float*)(lds + wave * 16384), 2 * e + 1, it, lane);
    }
}
__device__ __forceinline__ void phase_fin_even(int wid0, const Params& P, LAS unsigned char* lds, int e, int dry = 0) {
    const int tid = tid_fresh(wid0), lane = tid & 63, wave = tid >> 6;
    const int gw = bid_fresh() * NWAVES + wave, NGW = grid_fresh() * NWAVES;
    for (int wt = gw; wt < 2048; wt += NGW) s5_task_corr(P, lds + wave * S5_WLDS, lane, e, wt >> 5, wt & 31, dry);
    const bf16* proj = (const bf16*)(P.ws + WS_BIG); const bf16* Of = (const bf16*)(P.ws + WS_H); const bf16* Ob = Of + (size_t)MT * 512; bf16* mixout = (bf16*)(P.ws + WS_MIX);
    float gnv[8];
#pragma unroll
    for (int j = 0; j < 8; ++j) gnv[j] = P.in[I_GONORM][e * 128 + (lane & 15) * 8 + j];
    for (int mb2 = gw; mb2 < MT; mb2 += 2 * NGW) {
        u32x4 a[2], bq[2], z[2];
#pragma unroll
        for (int u = 0; u < 2; ++u) { const int m = mb2 + u * NGW; if (m < MT) { a[u] = *(const u32x4*)(Of + (size_t)m * 512 + lane * 8); bq[u] = *(const u32x4*)(Ob + (size_t)m * 512 + lane * 8); z[u] = *(const u32x4*)(proj + (size_t)m * NPROJ_E + 2560 + lane * 8); } }
#pragma unroll
        for (int u = 0; u < 2; ++u) { const int m = mb2 + u * NGW; if (m < MT) {
            float o[8]; float ss = 0.f;
#pragma unroll
            for (int j = 0; j < 4; ++j) { o[2 * j] = bflo(a[u][j]) + bflo(bq[u][j]); o[2 * j + 1] = bfhi(a[u][j]) + bfhi(bq[u][j]); ss += o[2 * j] * o[2 * j] + o[2 * j + 1] * o[2 * j + 1]; }
            ss += shfl_i(ss, lane ^ 1); ss += shfl_i(ss, lane ^ 2); ss += shfl_i(ss, lane ^ 4); ss += shfl_i(ss, lane ^ 8);
            const float rs = rsqrtf(ss * (1.0f / 128.0f) + EPSF);
            unsigned pw[4];
#pragma unroll
            for (int j = 0; j < 4; ++j) { const float z0 = bflo(z[u][j]), z1 = bfhi(z[u][j]); pw[j] = pk2(o[2 * j] * rs * gnv[2 * j] * siluf_(z0), o[2 * j + 1] * rs * gnv[2 * j + 1] * siluf_(z1)); }
            if (!dry) *(u32x4*)(mixout + (size_t)m * DM + 512 + lane * 8) = (u32x4){pw[0], pw[1], pw[2], pw[3]}; } }
    }
}

__device__ __forceinline__ void phase_conv_odd(int wid0, const Params& P, int o) {
    const int tid = tid_fresh(wid0), lane = tid & 63, wave = tid >> 6;
    const int gw = bid_fresh() * NWAVES + wave, NGW = grid_fresh() * NWAVES;
    const bf16* proj = (const bf16*)(P.ws + WS_BIG); bf16* cx = (bf16*)(P.ws + WS_H);
    const float* cw = P.in[I_LCONVW] + (size_t)o * 4 * 1024; const float* cb = P.in[I_LCONVB] + o * 1024;
    float wv[2][4][8], bv[2][8];
#pragma unroll
    for (int h2 = 0; h2 < 2; ++h2) { const int ch = lane * 8 + 512 * h2;
#pragma unroll
        for (int j = 0; j < 8; ++j) { bv[h2][j] = cb[ch + j];
#pragma unroll
            for (int k = 0; k < 4; ++k) wv[h2][k][j] = cw[k * 1024 + ch + j]; } }
    for (int m = gw; m < MT; m += NGW) {
        const int t = m < MCTX ? (m & 255) : ((m - MCTX) & 2047); const int L = m < MCTX ? LCTX : LLAT;
        u32x4 xr[2][4];
#pragma unroll
        for (int k = 0; k < 4; ++k) { const int tt = t - 1 + k; const bool ok = (tt >= 0) && (tt < L); const size_t row = (size_t)(ok ? m - 1 + k : m);
#pragma unroll
            for (int h2 = 0; h2 < 2; ++h2) { const u32x4 v = *(const u32x4*)(proj + row * 2048 + lane * 8 + 512 * h2); xr[h2][k] = ok ? v : (u32x4){0u, 0u, 0u, 0u}; } }
#pragma unroll
        for (int h2 = 0; h2 < 2; ++h2) { const int ch = lane * 8 + 512 * h2;
            float acc[8];
#pragma unroll
            for (int j = 0; j < 8; ++j) acc[j] = bv[h2][j];
#pragma unroll
            for (int k = 0; k < 4; ++k)
#pragma unroll
                for (int j = 0; j < 4; ++j) { acc[2 * j] += wv[h2][k][2 * j] * bflo(xr[h2][k][j]); acc[2 * j + 1] += wv[h2][k][2 * j + 1] * bfhi(xr[h2][k][j]); }
            *(u32x4*)(cx + (size_t)m * DM + ch) = (u32x4){pk2(acc[0], acc[1]), pk2(acc[2], acc[3]), pk2(acc[4], acc[5]), pk2(acc[6], acc[7])}; }
    }
}
__device__ __forceinline__ void phase_lru_scan(int wid0, const Params& P, LAS unsigned char* lds, int o, int d) {
    const int tid = tid_fresh(wid0), lane = tid & 63, wave = tid >> 6;
    const int gw = bid_fresh() * NWAVES + wave, NGW = grid_fresh() * NWAVES;
    const unsigned* G = (const unsigned*)(P.ws + WS_GATES); const bf16* proj = (const bf16*)(P.ws + WS_BIG); bf16* mixout = (bf16*)(P.ws + WS_MIX);
    const int Gn = NGW / NWAVES, vw = wave * Gn + (gw / NWAVES);
    if (d == 0 && o == 0 && NGW > 640) {
        for (int it = vw - 640; it >= 0 && it < WITEMS_EVEN; it += NGW - 640) weight_item(P, (LAS float*)(lds + wave * 16384), 2, it, lane); }
    for (int task = vw; task < 640; task += NGW) {
        int s, cg_;
        if (task < 128) { s = 32 + (task >> 4); cg_ = task & 15; } else { s = (task - 128) >> 4; cg_ = (task - 128) & 15; }
        const bool lat = s >= 32; const int b = lat ? s - 32 : s; const int L = lat ? LLAT : LCTX; const int m0 = lat ? MCTX + b * LLAT : s * LCTX;
        const int ch = cg_ * 64 + lane;
        float h = lat ? P.in[I_SLRU][(((size_t)b * 2 + o) * 2 + d) * 1024 + ch] : 0.f;
        if (d == 0) {
            unsigned ga[32], gb[32];
#define LRU_LD0(dst, tt) _Pragma("unroll") for (int i = 0; i < 32; ++i) dst[i] = G[(size_t)(m0 + (tt) + i) * DM + ch]
#define LRU_CP0(src, tt) _Pragma("unroll") for (int i = 0; i < 32; ++i) { h = (1.0f - bflo(src[i])) * h + bfhi(src[i]); mixout[(size_t)(m0 + (tt) + i) * DM + ch] = (bf16)f2bf(h); }
            LRU_LD0(ga, 0);
            for (int t0 = 0; t0 < L; t0 += 64) {
                LRU_LD0(gb, t0 + 32);
                LRU_CP0(ga, t0);
                if (t0 + 64 < L) { LRU_LD0(ga, t0 + 64); }
                LRU_CP0(gb, t0 + 32);
            }
        } else {
            unsigned ga[16], gb[16]; bf16 pa[16], pb[16], ya[16], yb[16];
#define LRU_LD1(g_, p_, y_, tt) _Pragma("unroll") for (int i = 0; i < 16; ++i) { const size_t m = (size_t)(m0 + L - 1 - ((tt) + i)); g_[i] = G[m * DM + ch]; p_[i] = mixout[m * DM + ch]; y_[i] = proj[m * 2048 + 1024 + ch]; }
#define LRU_CP1(g_, p_, y_, tt) _Pragma("unroll") for (int i = 0; i < 16; ++i) { const size_t m = (size_t)(m0 + L - 1 - ((tt) + i)); \
                h = (1.0f - bflo(g_[i])) * h + bfhi(g_[i]); mixout[m * DM + ch] = (bf16)f2bf((bf2f(p_[i]) + h) * geluf_(bf2f(y_[i]))); }
            LRU_LD1(ga, pa, ya, 0);
            for (int t0 = 0; t0 < L; t0 += 32) {
                LRU_LD1(gb, pb, yb, t0 + 16);
                LRU_CP1(ga, pa, ya, t0);
                if (t0 + 32 < L) { LRU_LD1(ga, pa, ya, t0 + 32); }
                LRU_CP1(gb, pb, yb, t0 + 16);
            }
        }
        if (!lat) P.out[OUT_LRU + (((size_t)b * 2 + o) * 2 + d) * 1024 + ch] = h;
    }
}
#ifdef PROBE_DUP_GEMM
#define DUPG(x) GSYNC(); x
#else
#define DUPG(x)
#endif
typedef const __attribute__((address_space(4))) Params* KParams;
__device__ __forceinline__ Params load_params(KParams q) { Params r;
#pragma unroll
    for (int i = 0; i < 40; ++i) r.in[i] = q->in[i];
    r.out = q->out; r.ws = q->ws; return r; }
#define FRESH() const int G = grid_fresh(), bid = bid_fresh(); (void)G; (void)bid; KParams pk_ = (KParams)__builtin_amdgcn_kernarg_segment_ptr(); asm volatile("" : "+s"(pk_)); const Params P = load_params(pk_); unsigned char* ws = P.ws; \
    const float* mod = (const float*)(ws + WS_MOD); bf16* H = (bf16*)(ws + WS_H); bf16* BIG = (bf16*)(ws + WS_BIG); bf16* MIX = (bf16*)(ws + WS_MIX); (void)mod; (void)H; (void)BIG; (void)MIX;
#define GSYNC() do { KParams pb_ = (KParams)__builtin_amdgcn_kernarg_segment_ptr(); asm volatile("" : "+s"(pb_)); xcd_barrier(wid0, (unsigned*)(pb_->ws + WS_BAR), lds); } while (0)
__global__ void __launch_bounds__(NTHR, 2) fwd_kernel(Params Parg) {
    extern __shared__ __attribute__((aligned(16))) unsigned char lds_raw[];
    LAS unsigned char* lds = (LAS unsigned char*)lds_raw;
    cg::grid_group grid = cg::this_grid();
    const int wid0 = __builtin_amdgcn_readfirstlane(threadIdx.x >> 6);
    if (threadIdx.x < 4) ((LAS unsigned*)(lds + LDS_BARST))[threadIdx.x] = 0u;
    __syncthreads();
    if (threadIdx.x == 0) (void)xb_add((unsigned*)(Parg.ws + WS_BAR) + XB_XCNT(xb_xcc_id()), 1u);

    { FRESH(); phase_prologue(wid0, P, lds); }
    if (grid_fresh() == 0) grid.sync();
    GSYNC();
#ifdef PROBE_DUP_PRO
    { FRESH(); phase_prologue(wid0, P, lds); }
    GSYNC();
#endif
    { FRESH(); phase_modreduce(wid0, P); }
    GSYNC();
#ifdef PROBE_SYNC
#pragma unroll 1
    for (int i = 0; i < 40; ++i) GSYNC();
#endif
#pragma unroll 1
    for (int l = 0; l < 4; ++l) {
        { FRESH(); const float* modl = mod + (size_t)l * 9 * 6144;
        phase_rownorm(wid0, P, l == 0, MIX, modl - 9 * 6144, 5 * 1024, P.in[I_NMLPPOST] + (l > 0 ? (l - 1) * 1024 : 0), 1, P.in[I_NMIXPRE] + l * 1024, modl, 0, H); }
        GSYNC();
        const int eo = l >> 1;
        {
            FRESH();
            pg8::Gemm g; pg8::StaticOrder S; EpiBf16<0> E;
            if ((l & 1) == 0) { g = pg8::Gemm{H, (const bf16*)(ws + WS_WINE) + (size_t)eo * NB_E * 1024, MT, NB_E, 1024, 1024, 0, 0, 1024, 0}; E = EpiBf16<0>{BIG, NPROJ_E, (float*)(ws + WS_AB), (bf16*)(ws + WS_HALO)}; }
            else { g = pg8::Gemm{H, (const bf16*)(ws + WS_WINO) + (size_t)eo * 2048 * 1024, MT, 2048, 1024, 1024, 0, 0, 1024, 0}; E = EpiBf16<0>{BIG, 2048, nullptr, nullptr}; }
            S.init(g.M, g.N, G, bid);
            pg8::gemm_phase(wid0, lds, g, S, E); DUPG(pg8::gemm_phase(wid0, lds, g, S, E);)
        }
        GSYNC();
        if ((l & 1) == 0) {
            { FRESH(); phase_conv_even(wid0, P, eo); }
            GSYNC();
#ifdef PROBE_DRY_CONVE
            { FRESH(); phase_conv_even(wid0, P, eo, grid_fresh() > 0); }
            GSYNC();
#endif
#ifdef PROBE_DUP_MIX
#pragma unroll 1
            for (int rep = 0; rep < 2; ++rep) { { FRESH(); phase_mix_even(wid0, P, lds, eo, rep == 0 ? 3 : PROBE_DUP_MIX); } GSYNC(); }
#else
            { FRESH(); phase_mix_even(wid0, P, lds, eo); }
            GSYNC();
#endif
            { FRESH(); phase_fin_even(wid0, P, lds, eo); }
            GSYNC();
#ifdef PROBE_DRY_FIN
            { FRESH(); phase_fin_even(wid0, P, lds, eo, grid_fresh() > 0); }
            GSYNC();
#endif
        } else {
            { FRESH(); phase_conv_odd(wid0, P, eo); }
            GSYNC();
#ifdef PROBE_DUP_CONV
            { FRESH(); phase_conv_odd(wid0, P, eo); }
            GSYNC();
#endif
#pragma unroll 1
            for (int d = 0; d < 2; ++d) {
                { FRESH();
                pg8::Gemm g{H, (const bf16*)(ws + WS_WG) + (size_t)(eo * 2 + d) * 2048 * 256, MT, 2048, 256, 1024, 1, 1, 256, 0};
                EpiGates E{(unsigned*)(ws + WS_GATES), H, P.in[I_LBR] + (eo * 2 + d) * 1024, P.in[I_LBI] + (eo * 2 + d) * 1024, P.in[I_LLAM] + (eo * 2 + d) * 1024};
                pg8::StaticOrder S; S.init(g.M, g.N, G, bid);
                pg8::gemm_phase(wid0, lds, g, S, E); DUPG(pg8::gemm_phase(wid0, lds, g, S, E);) }
                GSYNC();
                { FRESH(); phase_lru_scan(wid0, P, lds, eo, d); }
#ifdef PROBE_DUP_LRU0
                if (d == 0) { GSYNC(); FRESH(); phase_lru_scan(wid0, P, lds, eo, d); }
#endif
                GSYNC();
            }
        }
        {
            FRESH();
            pg8::Gemm g{MIX, (const bf16*)(ws + ((l & 1) ? WS_WOUTO : WS_WOUTE)) + (size_t)eo * 1024 * 1024, MT, 1024, 1024, 1024, 0, 0, 1024, 0};
            EpiBf16<0> E{BIG, 1024, nullptr, nullptr}; pg8::StaticOrder S; S.init(g.M, g.N, G, bid);
            pg8::gemm_phase(wid0, lds, g, S, E); DUPG(pg8::gemm_phase(wid0, lds, g, S, E);)
        }
        GSYNC();
        { FRESH(); const float* modl = mod + (size_t)l * 9 * 6144;
        phase_rownorm(wid0, P, 0, BIG, modl, 2 * 1024, P.in[I_NMIXPOST] + l * 1024, 1, P.in[I_NMLPPRE] + l * 1024, modl, 3 * 1024, H); }
#ifdef PROBE_DUP_RN
        GSYNC();
        { FRESH(); const float* modl = mod + (size_t)l * 9 * 6144;
        phase_rownorm(wid0, P, 0, BIG, modl, 2 * 1024, P.in[I_NMIXPOST] + l * 1024, 1, P.in[I_NMLPPRE] + l * 1024, modl, 3 * 1024, H, 0.0f); }
#endif
        GSYNC();
        {
            FRESH();
            pg8::Gemm g{H, (const bf16*)(ws + WS_W1T) + (size_t)l * 4096 * 1024, MT, 4096, 1024, 1024, 0, 0, 1024, 0};
            EpiBf16<1> E{BIG, 4096, nullptr, nullptr}; pg8::StaticOrder S; S.init(g.M, g.N, G, bid);
            pg8::gemm_phase(wid0, lds, g, S, E); DUPG(pg8::gemm_phase(wid0, lds, g, S, E);)
        }
        GSYNC();
        {
            FRESH();
            pg8::Gemm g{BIG, (const bf16*)(ws + WS_W2T) + (size_t)l * 1024 * 4096, MT, 1024, 4096, 4096, 0, 0, 4096, 0};
            EpiBf16<0> E{MIX, 1024, nullptr, nullptr}; pg8::StaticOrder S; S.init(g.M, g.N, G, bid);
            pg8::gemm_phase(wid0, lds, g, S, E); DUPG(pg8::gemm_phase(wid0, lds, g, S, E);)
        }
        GSYNC();
    }
    { FRESH();
    phase_rownorm(wid0, P, 0, MIX, mod + (size_t)3 * 9 * 6144, 5 * 1024, P.in[I_NMLPPOST] + 3 * 1024, 0, P.in[I_NMIXPRE], mod, 0, H); }
    GSYNC();
    { FRESH(); phase_copy_tail(wid0, P); }
}

extern "C" void kernel_launch(void* const* d_in, const int* in_sizes, int n_in, void* d_out, int out_size, void* d_ws, size_t ws_size, hipStream_t stream) {
    static int grid = 0;
    if (grid == 0) {
        if (n_in != 40 || ws_size < WS_END) { fprintf(stderr, "kernel_launch: expected 40 inputs and >= %zu bytes of workspace (got %d, %zu)\n", (size_t)WS_END, n_in, ws_size); grid = -1; return; }
        int dev = 0, cus = 0, per_cu = 0;
        if (hipGetDevice(&dev) != hipSuccess || hipDeviceGetAttribute(&cus, hipDeviceAttributeMultiprocessorCount, dev) != hipSuccess) { grid = -1; return; }
        if (hipFuncSetAttribute((const void*)fwd_kernel, hipFuncAttributeMaxDynamicSharedMemorySize, LDS_BYTES) != hipSuccess) { fprintf(stderr, "kernel_launch: hipFuncSetAttribute failed\n"); grid = -1; return; }
        if (hipOccupancyMaxActiveBlocksPerMultiprocessor(&per_cu, (const void*)fwd_kernel, NTHR, LDS_BYTES) != hipSuccess || per_cu < 1) per_cu = 1;
        (void)hipGetLastError();
        grid = cus * per_cu; if (grid > 256) grid = 256;
    }
    if (grid < 0) return;
    (void)hipMemsetAsync((char*)d_ws + WS_BAR, 0, 16384, stream);
    Params p{};
    for (int i = 0; i < 40; ++i) p.in[i] = (const float*)d_in[i];
    p.out = (float*)d_out; p.ws = (unsigned char*)d_ws;
    void* args[] = {&p};
    hipError_t e = hipLaunchCooperativeKernel((const void*)fwd_kernel, dim3(grid), dim3(NTHR), args, LDS_BYTES, stream);
    if (e != hipSuccess) fprintf(stderr, "cooperative launch failed: %s (grid %d)\n", hipGetErrorString(e), grid);
}
```

```cpp
#include <hip/hip_runtime.h>
#include <hip/hip_cooperative_groups.h>
#include <cstdio>
#include <cstdint>
namespace cg = cooperative_groups;
__device__ __forceinline__ int bid_fresh() { int t = blockIdx.x; asm volatile("" : "+s"(t)); return t; }
__device__ __forceinline__ int grid_fresh() { int t = gridDim.x; asm volatile("" : "+s"(t)); return t; }
__device__ __forceinline__ int tid_fresh(int w) { asm volatile("" : "+s"(w)); int l; asm volatile("v_mbcnt_lo_u32_b32 %0, -1, 0\n\tv_mbcnt_hi_u32_b32 %0, -1, %0" : "=v"(l)); return w * 64 + l; }

namespace pg8 {
#define PG8_LAS __attribute__((address_space(3)))
typedef unsigned short bf16_t;
typedef short bf16x8 __attribute__((ext_vector_type(8)));
typedef float f32x4 __attribute__((ext_vector_type(4)));
typedef unsigned u32x4 __attribute__((ext_vector_type(4)));
typedef unsigned u32x2 __attribute__((ext_vector_type(2)));
constexpr int BM = 256, BK = 64, HALF = 128, HTB = HALF * BK * 2, STAGE_BYTES = 8 * HTB, NXCD = 8, WGM = 4;

__host__ __device__ __forceinline__ int lds_byte(int r, int c) { const int st = (r >> 4) * 2 + (c >> 5), rr = r & 15, cc = c & 31, ob = rr * 64 + cc * 2; return st * 1024 + (ob ^ (((ob >> 9) & 1) << 5)); }
__host__ __device__ __forceinline__ void stage_rc(int b, int& R, int& C) { const int st = b / 1024, sb = b % 1024, swz = sb ^ (((sb >> 9) & 1) << 5); R = (st >> 1) * 16 + swz / 64; C = (st & 1) * 32 + (swz % 64) / 2; }
__host__ __device__ __forceinline__ int perm32(int rho) { const int n = rho >> 4, i = rho & 15; return 8 * (i >> 2) + 4 * n + (i & 3); }

struct Unit { int pm, pn; };
struct Gemm { const bf16_t* A; const bf16_t* Bt; int M, N, K, lda, ablk, ashift, ldb, ksplit; };

struct StaticOrder {
    int nM, nN, nwg, G, c, wgm;
    __host__ __device__ void init(int M, int N, int G_, int c_, int wgm_ = WGM) { nM = M / BM; nN = N / BM; nwg = nM * nN; G = G_; c = c_; wgm = wgm_; }
    __host__ __device__ bool next(int i, Unit& u) const {
        const long L = (long)i * G + c; if (L >= nwg) return false;
        int wgid = (int)L; { const int q = nwg / NXCD, r = nwg % NXCD, xcd = wgid % NXCD, off = wgid / NXCD; wgid = (xcd < r ? xcd * (q + 1) : r * (q + 1) + (xcd - r) * q) + off; }
        const int nig = wgm * nN, gid = wgid / nig, fm = gid * wgm, gsz = (nM - fm) < wgm ? (nM - fm) : wgm;
        u.pm = fm + ((wgid % nig) % gsz); u.pn = (wgid % nig) / gsz; return true;
    }
};
__device__ __forceinline__ unsigned cvt_pk_bf16(float lo, float hi) { unsigned r; asm volatile("v_cvt_pk_bf16_f32 %0, %1, %2" : "=v"(r) : "v"(lo), "v"(hi)); return r; }

template <class Epi>
__device__ __forceinline__ void gemm_phase(int wid0, PG8_LAS unsigned char* lds, const Gemm g, const StaticOrder& S, const Epi& E) {
    const int tid = tid_fresh(wid0), wid = __builtin_amdgcn_readfirstlane(tid >> 6), lane = tid & 63, wr = wid >> 2, wc = wid & 3, fr = lane & 15, fq = lane >> 4;
    const int K = g.K, nt = K / BK, lda = g.lda, ldb = g.ldb;
    unsigned voffA[2], voffB[2];
#pragma unroll
    for (int i = 0; i < 2; ++i) { int R, C; stage_rc(tid * 16 + i * 8192, R, C); const int Rb = (R & ~31) + perm32(R & 31);
        voffA[i] = (unsigned)(R * lda + C) * 2u; voffB[i] = (unsigned)(Rb * ldb + C) * 2u; }
    const size_t kstep = (size_t)(BK * 2);
    const size_t hstepA = (size_t)HALF * lda * 2, hstepB = (size_t)HALF * ldb * 2;
    const size_t tstepA = 2 * hstepA, tstepB = 2 * hstepB;
    const unsigned ldsw = (unsigned)wid * 1024u;
    const int aoff = lds_byte(wr * 64 + fr, fq * 8), boff = lds_byte(wc * 32 + fr, fq * 8);
#define PG8_ACOL(pn) (g.ablk ? (size_t)((((pn) >> g.ashift) & 3) * 512) : (g.ksplit ? (size_t)((pn) & 1) * (size_t)K * 2 : (size_t)0))
#define PG8_BOFF(pn) (g.ksplit ? (size_t)((pn) >> 1) * tstepB + (size_t)((pn) & 1) * (size_t)K * 2 : (size_t)(pn) * tstepB)
#define PG8_SA(b, h) (((b) * 2 + (h)) * HTB)
#define PG8_SB(b, h) ((4 + (b) * 2 + (h)) * HTB)
#define PG8_STAGE(bufoff, gbase, voff) do { _Pragma("unroll") for (int _i = 0; _i < 2; ++_i) \
        __builtin_amdgcn_global_load_lds((const unsigned*)((const char*)(gbase) + (voff)[_i]), (PG8_LAS unsigned*)(lds + (bufoff) + ldsw + _i * 8192), 16, 0, 0); } while (0)
#define PG8_LDA(dst, b, h) do { _Pragma("unroll") for (int m = 0; m < 4; ++m) _Pragma("unroll") for (int k = 0; k < 2; ++k) dst[m][k] = *(const PG8_LAS bf16x8*)(lds + PG8_SA(b, h) + aoff + m * 2048 + k * 1024); } while (0)
#define PG8_LDB(dst, b, h) do { _Pragma("unroll") for (int n = 0; n < 2; ++n) _Pragma("unroll") for (int k = 0; k < 2; ++k) dst[n][k] = *(const PG8_LAS bf16x8*)(lds + PG8_SB(b, h) + boff + n * 2048 + k * 1024); } while (0)
#define PG8_MMA(ai, bj, At, Bt) do { __builtin_amdgcn_s_setprio(1); _Pragma("unroll") for (int m = 0; m < 4; ++m) _Pragma("unroll") for (int n = 0; n < 2; ++n) _Pragma("unroll") for (int k = 0; k < 2; ++k) \
        acc[ai][bj][m][n] = __builtin_amdgcn_mfma_f32_16x16x32_bf16(Bt[n][k], At[m][k], acc[ai][bj][m][n], 0, 0, 0); __builtin_amdgcn_s_setprio(0); } while (0)
#define PG8_WAIT_V(n) asm volatile("s_waitcnt vmcnt(" #n ")" ::: "memory")
#define PG8_WAIT_L(n) asm volatile("s_waitcnt lgkmcnt(" #n ")" ::: "memory")
#define PG8_BAR __builtin_amdgcn_s_barrier()
#define PG8_SCHED __builtin_amdgcn_sched_barrier(0)
    Unit cur, nxt; int ui = 0;
    if (!S.next(0, cur)) return;
    f32x4 acc[2][2][4][2];
#pragma unroll
    for (int a = 0; a < 2; ++a)
#pragma unroll
        for (int b = 0; b < 2; ++b)
#pragma unroll
            for (int m = 0; m < 4; ++m)
#pragma unroll
                for (int n = 0; n < 2; ++n) acc[a][b][m][n] = (f32x4){0.f, 0.f, 0.f, 0.f};
    bf16x8 At[4][2], B0[2][2], B1[2][2];
    const char* cA = (const char*)g.A + (size_t)cur.pm * tstepA + PG8_ACOL(cur.pn); const char* cB = (const char*)g.Bt + PG8_BOFF(cur.pn);
    PG8_STAGE(PG8_SB(0, 0), cB, voffB); PG8_STAGE(PG8_SA(0, 0), cA, voffA); PG8_STAGE(PG8_SB(0, 1), cB + hstepB, voffB); PG8_STAGE(PG8_SA(0, 1), cA + hstepA, voffA);
    if (wr == 1) PG8_BAR;
    PG8_WAIT_V(4); PG8_BAR;
    PG8_STAGE(PG8_SB(1, 0), cB + kstep, voffB); PG8_STAGE(PG8_SA(1, 0), cA + kstep, voffA); PG8_STAGE(PG8_SB(1, 1), cB + hstepB + kstep, voffB);
    PG8_WAIT_V(6); PG8_BAR;
    for (;;) {
        const bool has_next = S.next(ui + 1, nxt);
        const char* nA = has_next ? (const char*)g.A + (size_t)nxt.pm * tstepA + PG8_ACOL(nxt.pn) : cA; const char* nB = has_next ? (const char*)g.Bt + PG8_BOFF(nxt.pn) : cB;
        for (int t = 0; t < nt; t += 2) {
            const bool last = (t == nt - 2);
            const char* a1 = cA + (size_t)(t + 1) * kstep;
            const char* a2 = last ? nA : cA + (size_t)(t + 2) * kstep; const char* b2 = last ? nB : cB + (size_t)(t + 2) * kstep;
            const char* a3 = a2 + kstep; const char* b3 = b2 + kstep;
            PG8_LDB(B0, 0, 0); PG8_SCHED; PG8_LDA(At, 0, 0); PG8_STAGE(PG8_SA(1, 1), a1 + hstepA, voffA);
            PG8_WAIT_L(8); PG8_BAR; PG8_WAIT_L(0); PG8_MMA(0, 0, At, B0); PG8_BAR; PG8_SCHED;
            PG8_LDB(B1, 0, 1); PG8_STAGE(PG8_SB(0, 0), b2, voffB);
            PG8_BAR; PG8_WAIT_L(0); PG8_MMA(0, 1, At, B1); PG8_BAR;
            PG8_LDA(At, 0, 1); PG8_STAGE(PG8_SA(0, 0), a2, voffA);
            PG8_BAR; PG8_WAIT_L(0); PG8_MMA(1, 0, At, B0); PG8_BAR; PG8_SCHED;
            PG8_STAGE(PG8_SB(0, 1), b2 + hstepB, voffB);
            PG8_WAIT_V(6); PG8_BAR; PG8_MMA(1, 1, At, B1); PG8_BAR;
            PG8_LDB(B0, 1, 0); PG8_SCHED; PG8_LDA(At, 1, 0); PG8_STAGE(PG8_SA(0, 1), a2 + hstepA, voffA);
            PG8_WAIT_L(8); PG8_BAR; PG8_WAIT_L(0); PG8_MMA(0, 0, At, B0); PG8_BAR; PG8_SCHED;
            PG8_LDB(B1, 1, 1); PG8_STAGE(PG8_SB(1, 0), b3, voffB);
            PG8_BAR; PG8_WAIT_L(0); PG8_MMA(0, 1, At, B1); PG8_BAR;
            PG8_LDA(At, 1, 1); PG8_STAGE(PG8_SA(1, 0), a3, voffA);
            PG8_BAR; PG8_WAIT_L(0); PG8_MMA(1, 0, At, B0); PG8_BAR; PG8_SCHED;
            PG8_STAGE(PG8_SB(1, 1), b3 + hstepB, voffB);
            PG8_WAIT_V(6); PG8_BAR; PG8_MMA(1, 1, At, B1); PG8_BAR;
        }
        E(acc, cur, wr, wc, fr, fq);
        if (!has_next) break;
#pragma unroll
        for (int a = 0; a < 2; ++a)
#pragma unroll
            for (int b = 0; b < 2; ++b)
#pragma unroll
                for (int m = 0; m < 4; ++m)
#pragma unroll
                    for (int n = 0; n < 2; ++n) acc[a][b][m][n] = (f32x4){0.f, 0.f, 0.f, 0.f};
        cur = nxt; cA = nA; cB = nB; ++ui;
    }
    PG8_WAIT_V(0);
    if (wr == 0) PG8_BAR;
    PG8_BAR;
#undef PG8_ACOL
#undef PG8_BOFF
#undef PG8_SA
#undef PG8_SB
#undef PG8_STAGE
#undef PG8_LDA
#undef PG8_LDB
#undef PG8_MMA
#undef PG8_WAIT_V
#undef PG8_WAIT_L
#undef PG8_BAR
#undef PG8_SCHED
}
}
#define LAS __attribute__((address_space(3)))
typedef unsigned short bf16;
typedef short bf16x8 __attribute__((ext_vector_type(8)));
typedef float f32x4 __attribute__((ext_vector_type(4)));
typedef unsigned u32x4 __attribute__((ext_vector_type(4)));
typedef unsigned u32x2 __attribute__((ext_vector_type(2)));
constexpr int DM = 1024, MT = 24576, MCTX = 8192, LCTX = 256, LLAT = 2048, NWAVES = 8, NTHR = 512;
constexpr int NPROJ_E = 3072, NB_E = 3328, IN_EVEN_LD = 3088;
constexpr float EPSF = 1e-6f;
constexpr size_t MiB = 1u << 20;
constexpr size_t WS_MOD = 0, MOD_BYTES = 4 * 9 * 6144 * 4, WS_S5F = 1 * MiB, WS_AB = 3 * MiB, WS_W1T = 5 * MiB, WS_W2T = 37 * MiB, WS_WINE = 69 * MiB,
                 WS_WOUTE = 82 * MiB, WS_WINO = 86 * MiB, WS_WOUTO = 94 * MiB, WS_WG = 98 * MiB, WS_H = 102 * MiB, WS_BIG = 150 * MiB, WS_YBUF = 294 * MiB,
                 WS_GATES = 246 * MiB, WS_MIX = 342 * MiB, WS_HALO = 390 * MiB, WS_END = 390 * MiB + 384 * 3 * 1536 * 2;
constexpr int LDS_BYTES = 147456;
constexpr size_t OUT_S5RE = 25165824, OUT_S5IM = OUT_S5RE + 262144, OUT_DELTA = OUT_S5IM + 262144, OUT_LRU = OUT_DELTA + 8388608;

struct Params { const float* in[40]; float* out; unsigned char* ws; };
enum { I_XP = 0, I_XS, I_S5RE, I_S5IM, I_SDELTA, I_SLRU, I_C, I_CCTX, I_WADA, I_BADA, I_NMIXPRE, I_NMIXPOST, I_NMLPPRE, I_NMLPPOST, I_WMLPIN, I_WMLPOUT, I_WINE, I_WOUTE,
       I_LAMRE, I_LAMIM, I_LOGDT, I_BRE, I_BIM, I_CRE, I_CIM, I_S5D, I_GCONVW, I_GCONVB, I_GALOG, I_GDTB, I_GONORM, I_WINO, I_WOUTO, I_LCONVW, I_LCONVB, I_LWR, I_LBR, I_LWI, I_LBI, I_LLAM };

typedef __bf16 bf2_t __attribute__((ext_vector_type(2)));
typedef float f2_t __attribute__((ext_vector_type(2)));
__device__ __forceinline__ unsigned pk2(float lo, float hi) { const bf2_t v = __builtin_convertvector((f2_t){lo, hi}, bf2_t); return __builtin_bit_cast(unsigned, v); }
__device__ __forceinline__ unsigned f2bf(float f) { return pk2(f, f) & 0xffffu; }
__device__ __forceinline__ float bflo(unsigned w) { return __builtin_bit_cast(float, w << 16); }
__device__ __forceinline__ float bfhi(unsigned w) { return __builtin_bit_cast(float, w & 0xffff0000u); }
__device__ __forceinline__ float bf2f(bf16 b) { return __builtin_bit_cast(float, (unsigned)b << 16); }
__device__ __forceinline__ float sigmoidf_(float x) { return __builtin_amdgcn_rcpf(1.0f + __expf(-x)); }
__device__ __forceinline__ float siluf_(float x) { return x * sigmoidf_(x); }
__device__ __forceinline__ float softplusf_(float x) { return fmaxf(x, 0.f) + __logf(1.0f + __expf(-fabsf(x))); }
__device__ __forceinline__ float geluf_(float x) { const float y = 0.7978845608028654f * (x + 0.044715f * x * x * x); const float t = 1.0f - 2.0f * __builtin_amdgcn_rcpf(__expf(2.0f * y) + 1.0f); return 0.5f * x * (1.0f + t); }
__device__ __forceinline__ float shfl_i(float v, int srclane) { return __builtin_bit_cast(float, __builtin_amdgcn_ds_bpermute(srclane << 2, __builtin_bit_cast(int, v))); }
__device__ __forceinline__ float dpp_f(float v, int ctrl_xor1) { return v; }
__device__ __forceinline__ float wave_sum(float v, int lane) {
    (void)lane;
    v += __builtin_bit_cast(float, __builtin_amdgcn_update_dpp(0, __builtin_bit_cast(int, v), 0xB1, 0xF, 0xF, true));
    v += __builtin_bit_cast(float, __builtin_amdgcn_update_dpp(0, __builtin_bit_cast(int, v), 0x4E, 0xF, 0xF, true));
    v += __builtin_bit_cast(float, __builtin_amdgcn_update_dpp(0, __builtin_bit_cast(int, v), 0x141, 0xF, 0xF, true));
    v += __builtin_bit_cast(float, __builtin_amdgcn_update_dpp(0, __builtin_bit_cast(int, v), 0x140, 0xF, 0xF, true));
    const int iv = __builtin_bit_cast(int, v);
    return (__builtin_bit_cast(float, __builtin_amdgcn_readlane(iv, 0)) + __builtin_bit_cast(float, __builtin_amdgcn_readlane(iv, 16))) +
           (__builtin_bit_cast(float, __builtin_amdgcn_readlane(iv, 32)) + __builtin_bit_cast(float, __builtin_amdgcn_readlane(iv, 48)));
}
#define LDS_WAIT() asm volatile("s_waitcnt lgkmcnt(0)" ::: "memory")
#define WAVE_SYNC() do { asm volatile("s_waitcnt lgkmcnt(0)" ::: "memory"); __builtin_amdgcn_wave_barrier(); } while (0)
__device__ __forceinline__ f32x4 mfma16(bf16x8 a, bf16x8 b, f32x4 c) { return __builtin_amdgcn_mfma_f32_16x16x32_bf16(a, b, c, 0, 0, 0); }


#define XB_TMO      128
#define XB_XCNT(j)  (256  + 64 * (j))
#define XB_XSUB(j)  (1280 + 64 * (j))
#define XB_XGEN(j)  (2304 + 64 * (j))
#define XB_TOP      3328
#define XB_TOPGEN   3392
#define XCD_BAR_WORDS 3456
#define XB_SPIN_CAP (1u << 18)
constexpr size_t WS_BAR = 960 * 1024; constexpr int LDS_BARST = LDS_BYTES - 16;
__device__ __forceinline__ unsigned xb_ld(unsigned* p)              { return __hip_atomic_load(p, __ATOMIC_RELAXED, __HIP_MEMORY_SCOPE_AGENT); }
__device__ __forceinline__ unsigned xb_add(unsigned* p, unsigned v) { return __hip_atomic_fetch_add(p, v, __ATOMIC_RELAXED, __HIP_MEMORY_SCOPE_AGENT); }
__device__ __forceinline__ unsigned xb_xcc_id() { return (unsigned)__builtin_amdgcn_s_getreg((3 << 11) | 20) & 0xFu; }
#define XB_SPIN(cond, bar) do { unsigned _sp = 0; while (cond) { __builtin_amdgcn_s_sleep(1); \
    if ((++_sp & 255u) == 0u) { if (xb_ld(&(bar)[XB_TMO])) break; if (_sp > XB_SPIN_CAP) { atomicAdd(&(bar)[XB_TMO], 1u); break; } } } } while (0)
__device__ __forceinline__ void xcd_barrier_complete(unsigned* bar, unsigned x, unsigned& nloc, unsigned& nx) {
    const unsigned G = gridDim.x;
    unsigned sum, cnt, mine, sp = 0u;
    for (;;) {
        sum = 0u; cnt = 0u; mine = 0u;
#pragma unroll
        for (unsigned j = 0; j < 16; ++j) { const unsigned c = xb_ld(&bar[XB_XCNT(j)]); sum += c; cnt += (c > 0u) ? 1u : 0u; mine = (j == x) ? c : mine; }
        if (sum == G) break;
        __builtin_amdgcn_s_sleep(1);
        if ((++sp & 255u) == 0u) { if (xb_ld(&bar[XB_TMO])) break; if (sp > XB_SPIN_CAP) { atomicAdd(&bar[XB_TMO], 1u); break; } }
    }
    nloc = mine > 0u ? mine : 1u; nx = cnt > 0u ? cnt : 1u;
}
__device__ __forceinline__ void xcd_barrier(int wid0, unsigned* bar, LAS unsigned char* lds) {
    const int tid = tid_fresh(wid0);
    asm volatile("s_waitcnt vmcnt(0)" ::: "memory");
    __syncthreads();
    if (tid == 0) {
        const unsigned x = xb_xcc_id();
        volatile LAS unsigned* st = (volatile LAS unsigned*)(lds + LDS_BARST);
        __builtin_amdgcn_s_waitcnt(0);
        unsigned nloc = st[0], nx = st[1];
        if (nloc == 0u) { xcd_barrier_complete(bar, x, nloc, nx); st[0] = nloc; st[1] = nx; }
        const unsigned old = xb_add(&bar[XB_XSUB(x)], 1u);
        const unsigned gen = old / nloc;
        if (old + 1u == (gen + 1u) * nloc) {
            __builtin_amdgcn_fence(__ATOMIC_RELEASE, "agent");
            asm volatile("s_waitcnt vmcnt(0)" ::: "memory");
            const unsigned og = xb_add(&bar[XB_TOP], 1u);
            const unsigned tg = og / nx;
            if (og + 1u == (tg + 1u) * nx) xb_add(&bar[XB_TOPGEN], 1u);
            else XB_SPIN(xb_ld(&bar[XB_TOPGEN]) == tg, bar);
            __builtin_amdgcn_fence(__ATOMIC_ACQUIRE, "agent");
            xb_add(&bar[XB_XGEN(x)], 1u);
            asm volatile("s_waitcnt vmcnt(0)" ::: "memory");
        } else {
            XB_SPIN(xb_ld(&bar[XB_XGEN(x)]) == gen, bar);
            __builtin_amdgcn_fence(__ATOMIC_ACQUIRE, "agent");
            asm volatile("s_waitcnt vmcnt(0)" ::: "memory");
        }
    }
    __syncthreads();
}
__device__ __forceinline__ void transpose_item(const float* W, int ldw, int nvalid, int K, bf16* WT, int dst_row0, LAS float* scr, int k0, int n0, int lane) {
    const int nn = n0 + (lane & 31); const bool ok = nn < nvalid;
#pragma unroll
    for (int i = 0; i < 32; ++i) { const int kk = 2 * i + (lane >> 5); scr[kk * 33 + (lane & 31)] = ok ? W[(size_t)(k0 + kk) * ldw + nn] : 0.f; }
    WAVE_SYNC();
    const int c = lane & 7;
#pragma unroll
    for (int j = 0; j < 4; ++j) { const int n = (lane >> 3) + 8 * j; const LAS float* s = scr + (8 * c) * 33 + n;
        u32x4 o; o.x = pk2(s[0 * 33], s[1 * 33]); o.y = pk2(s[2 * 33], s[3 * 33]); o.z = pk2(s[4 * 33], s[5 * 33]); o.w = pk2(s[6 * 33], s[7 * 33]);
        *(u32x4*)(WT + (size_t)(dst_row0 + n) * K + k0 + 8 * c) = o; }
    WAVE_SYNC();
}
constexpr int WITEMS_EVEN = 4096 + 1552 + 512, WITEMS_ODD = 4096 + 1024 + 512 + 512;
__device__ __forceinline__ void weight_item(const Params& P, LAS float* scr, int l, int r, int lane) {
    unsigned char* ws = P.ws; const int eo = l >> 1;
    if (r < 2048) { const int q = r; transpose_item(P.in[I_WMLPIN] + (size_t)l * 1024 * 4096, 4096, 4096, 1024, (bf16*)(ws + WS_W1T) + (size_t)l * 4096 * 1024, 32 * (q & 127), scr, 64 * (q >> 7), 32 * (q & 127), lane); return; } r -= 2048;
    if (r < 2048) { const int q = r; transpose_item(P.in[I_WMLPOUT] + (size_t)l * 4096 * 1024, 1024, 1024, 4096, (bf16*)(ws + WS_W2T) + (size_t)l * 1024 * 4096, 32 * (q & 31), scr, 64 * (q >> 5), 32 * (q & 31), lane); return; } r -= 2048;
    if ((l & 1) == 0) {
        if (r < 1552) { const int kb = r / 97, nb = r % 97; transpose_item(P.in[I_WINE] + (size_t)eo * 1024 * IN_EVEN_LD, IN_EVEN_LD, IN_EVEN_LD, 1024, (bf16*)(ws + WS_WINE) + (size_t)eo * NB_E * 1024, 32 * nb, scr, 64 * kb, 32 * nb, lane); return; } r -= 1552;
        { const int q = r; transpose_item(P.in[I_WOUTE] + (size_t)eo * 1024 * 1024, 1024, 1024, 1024, (bf16*)(ws + WS_WOUTE) + (size_t)eo * 1024 * 1024, 32 * (q & 31), scr, 64 * (q >> 5), 32 * (q & 31), lane); return; }
    } else {
        if (r < 1024) { const int q = r; transpose_item(P.in[I_WINO] + (size_t)eo * 1024 * 2048, 2048, 2048, 1024, (bf16*)(ws + WS_WINO) + (size_t)eo * 2048 * 1024, 32 * (q & 63), scr, 64 * (q >> 6), 32 * (q & 63), lane); return; } r -= 1024;
        if (r < 512) { const int q = r; transpose_item(P.in[I_WOUTO] + (size_t)eo * 1024 * 1024, 1024, 1024, 1024, (bf16*)(ws + WS_WOUTO) + (size_t)eo * 1024 * 1024, 32 * (q & 31), scr, 64 * (q >> 5), 32 * (q & 31), lane); return; } r -= 512;
        { const int mat = eo * 16 + (r >> 5), q = r & 31, kb = q >> 3, nb = q & 7; const int blk = mat & 3, gate = (mat >> 2) & 1, od = mat >> 3;
          const float* src = (gate ? P.in[I_LWI] : P.in[I_LWR]) + (size_t)(od * 4 + blk) * 65536;
          const int j0 = nb * 32; const int drow = (blk * 2 + (j0 >> 7)) * 256 + gate * 128 + (j0 & 127);
          transpose_item(src, 256, 256, 256, (bf16*)(ws + WS_WG) + (size_t)od * 2048 * 256, drow, scr, 64 * kb, j0, lane); return; }
    }
}
__device__ __forceinline__ void phase_prologue(int wid0, const Params& P, LAS unsigned char* lds) {
    const int tid = tid_fresh(wid0), lane = tid & 63, wave = tid >> 6;
    LAS float* scr = (LAS float*)(lds + wave * 16384);
    const int gw = bid_fresh() * NWAVES + wave, NGW = grid_fresh() * NWAVES;
    unsigned char* ws = P.ws;
    constexpr int NTR = WITEMS_EVEN, NMOD = 4 * 24 * 16;
    for (int it = gw; it < NTR + NMOD; it += NGW) {
        int r = it;
        if (r < NTR) { weight_item(P, scr, 0, r, lane); continue; } r -= NTR;
        {
            const int l = r / 384, rem = r % 384, ec = rem >> 4, ks = rem & 15, k0 = ks * 64;
#pragma unroll
            for (int rr = 0; rr < 9; ++rr) { const float cv = rr == 0 ? P.in[I_CCTX][k0 + lane] : P.in[I_C][(rr - 1) * 1024 + k0 + lane]; scr[rr * 64 + lane] = siluf_(cv); }
            WAVE_SYNC();
            f32x4 acc[9];
#pragma unroll
            for (int rr = 0; rr < 9; ++rr) acc[rr] = (f32x4){0.f, 0.f, 0.f, 0.f};
            const float* wp = P.in[I_WADA] + ((size_t)l * 1024 + k0) * 6144 + ec * 256 + lane * 4;
#pragma unroll 16
            for (int kk = 0; kk < 64; ++kk) { const f32x4 w4 = *(const f32x4*)(wp + (size_t)kk * 6144);
#pragma unroll
                for (int rr = 0; rr < 9; ++rr) acc[rr] += w4 * scr[rr * 64 + kk]; }
            float* part = (float*)(ws + WS_BIG) + ((size_t)(ks * 4 + l) * 9) * 6144 + ec * 256 + lane * 4;
#pragma unroll
            for (int rr = 0; rr < 9; ++rr) *(f32x4*)(part + (size_t)rr * 6144) = acc[rr];
            WAVE_SYNC();
        }
    }
    { const size_t per = (size_t)(NB_E - 3104) * 1024 * 2 / 16;
      for (size_t i = (size_t)bid_fresh() * NTHR + tid; i < 2 * per; i += (size_t)grid_fresh() * NTHR) { const size_t e = i / per, q = i % per;
          *(u32x4*)(ws + WS_WINE + (e * NB_E + 3104) * 1024 * 2 + q * 16) = (u32x4){0u, 0u, 0u, 0u}; } }
}
__device__ __forceinline__ void phase_modreduce(int wid0, const Params& P) {
    const int tid = tid_fresh(wid0);
    const float* part = (const float*)(P.ws + WS_BIG); float* mod = (float*)(P.ws + WS_MOD);
    for (int i = bid_fresh() * NTHR + tid; i < 4 * 9 * 6144 / 4; i += grid_fresh() * NTHR) {
        const int l = i / (9 * 1536), e4 = i % 1536;
        f32x4 a = *(const f32x4*)(P.in[I_BADA] + (size_t)l * 6144 + e4 * 4);
#pragma unroll
        for (int ks = 0; ks < 16; ++ks) a += *(const f32x4*)(part + (size_t)ks * 4 * 9 * 6144 + (size_t)i * 4);
        *(f32x4*)(mod + (size_t)i * 4) = a; }
}
constexpr size_t XB_OFF_FLOATS = (size_t)MT * DM / 2;
__device__ __forceinline__ void phase_rownorm(int wid0, const Params& P, int first, const bf16* obuf, const float* modg, int goff, const float* gpost, int has_next, const float* gpre, const float* mods, int soff, bf16* H, float gscale = 1.0f) {
    const int tid = tid_fresh(wid0), lane = tid & 63, wave = tid >> 6;
    const int gw = bid_fresh() * NWAVES + wave, NGW = grid_fresh() * NWAVES;
    bf16* XB = (bf16*)(P.out + XB_OFF_FLOATS); float* TMP = (float*)(P.ws + WS_BIG);
    f32x4 xn[4]; u32x2 xbn[4], on[4];
#define RN_LOAD(mm) do { const int m_ = (mm); \
        _Pragma("unroll") for (int j = 0; j < 4; ++j) { \
            if (first) xn[j] = *(const f32x4*)((m_ < MCTX ? P.in[I_XP] + (size_t)m_ * DM : P.in[I_XS] + (size_t)(m_ - MCTX) * DM) + lane * 4 + 256 * j); \
            else { xbn[j] = *(const u32x2*)(XB + (size_t)m_ * DM + lane * 4 + 256 * j); on[j] = *(const u32x2*)(obuf + (size_t)m_ * DM + lane * 4 + 256 * j); } } } while (0)
    if (gw < MT) RN_LOAD(gw);
    for (int m = gw; m < MT; m += NGW) {
        const int modrow = m < MCTX ? 0 : 1 + ((m - MCTX) >> 11);
        const float* mr = modg + (size_t)modrow * 6144; const float* ms = mods + (size_t)modrow * 6144;
        f32x4 x[4]; u32x2 ov[4];
#pragma unroll
        for (int j = 0; j < 4; ++j) { ov[j] = on[j]; x[j] = first ? xn[j] : (f32x4){bflo(xbn[j].x), bfhi(xbn[j].x), bflo(xbn[j].y), bfhi(xbn[j].y)}; }
        if (m + NGW < MT) RN_LOAD(m + NGW);
        f32x4 vgp[4], vgt[4], vgq[4], vsh[4], vsc[4];
#pragma unroll
        for (int j = 0; j < 4; ++j) { const int c = lane * 4 + 256 * j;
            if (!first) { vgp[j] = *(const f32x4*)(gpost + c); vgt[j] = *(const f32x4*)(mr + goff + c); }
            if (has_next) { vgq[j] = *(const f32x4*)(gpre + c); vsh[j] = *(const f32x4*)(ms + soff + c); vsc[j] = *(const f32x4*)(ms + soff + 1024 + c); } }
        if (first) {
            if (m >= MCTX) {
                const int t = (m - MCTX) & 2047; const float prow = (float)(t >> 6), pcol = (float)(t & 63);
                f32x4 om;
#pragma unroll
                for (int e = 0; e < 4; ++e) om[e] = exp2f(-(float)(lane * 4 + e) * (13.287712379549449f / 256.0f));
#pragma unroll
                for (int j = 0; j < 4; ++j) {
#pragma unroll
                    for (int e = 0; e < 4; ++e) { const float a = (j < 2 ? prow : pcol) * om[e]; x[j][e] += (j & 1) ? cosf(a) : sinf(a); } }
            }
        } else {
            float ss = 0.f;
#pragma unroll
            for (int j = 0; j < 4; ++j) { const float a = bflo(ov[j].x), b = bfhi(ov[j].x), c = bflo(ov[j].y), d = bfhi(ov[j].y); ss += (a * a + b * b) + (c * c + d * d); }
            const float rs = rsqrtf(wave_sum(ss, lane) * (1.0f / DM) + EPSF);
#pragma unroll
            for (int j = 0; j < 4; ++j) { f32x4 o4 = (f32x4){bflo(ov[j].x), bfhi(ov[j].x), bflo(ov[j].y), bfhi(ov[j].y)};
                x[j] += vgt[j] * (o4 * (rs * gscale) * vgp[j]); }
        }
        if (has_next) {
#pragma unroll
            for (int j = 0; j < 4; ++j) { u32x2 w; w.x = pk2(x[j][0], x[j][1]); w.y = pk2(x[j][2], x[j][3]); *(u32x2*)(XB + (size_t)m * DM + lane * 4 + 256 * j) = w; }
            float ss = 0.f;
#pragma unroll
            for (int j = 0; j < 4; ++j) ss += (x[j][0] * x[j][0] + x[j][1] * x[j][1]) + (x[j][2] * x[j][2] + x[j][3] * x[j][3]);
            const float rs = rsqrtf(wave_sum(ss, lane) * (1.0f / DM) + EPSF);
#pragma unroll
            for (int j = 0; j < 4; ++j) { const f32x4 h4 = (x[j] * rs * vgq[j]) * (vsc[j] + 1.0f) + vsh[j];
                u32x2 w; w.x = pk2(h4[0], h4[1]); w.y = pk2(h4[2], h4[3]);
                *(u32x2*)(H + (size_t)m * DM + lane * 4 + 256 * j) = w; }
        } else {
            float* dst = (m < MT / 2) ? P.out + (size_t)m * DM : TMP + (size_t)(m - MT / 2) * DM;
#pragma unroll
            for (int j = 0; j < 4; ++j) *(f32x4*)(dst + lane * 4 + 256 * j) = x[j];
        }
    }
}
__device__ __forceinline__ void phase_copy_tail(int wid0, const Params& P) {
    const int tid = tid_fresh(wid0);
    const f32x4* src = (const f32x4*)(P.ws + WS_BIG); f32x4* dst = (f32x4*)(P.out + XB_OFF_FLOATS);
    const size_t n = (size_t)(MT / 2) * DM / 4;
    for (size_t i = (size_t)bid_fresh() * NTHR + tid; i < n; i += (size_t)grid_fresh() * NTHR) dst[i] = src[i];
}

using pg8::Unit;
template <int ACT  > struct EpiBf16 {
    bf16* O; int ldc; float* AB;
    bf16* HALO;
    int gcol;
    __device__ __forceinline__ void operator()(const f32x4 (&acc)[2][2][4][2], const Unit& u, int wr, int wc, int fr, int fq) const {
        const int row0 = u.pm * 256 + wr * 64 + fr, col0 = u.pn * 256 + wc * 32 + 8 * fq;
        if (AB && u.pn * 256 >= ldc) {
            if (wc == 0 && fq < 2) {
#pragma unroll
                for (int ai = 0; ai < 2; ++ai)
#pragma unroll
                    for (int m = 0; m < 4; ++m) { float* p = AB + (size_t)(row0 + ai * 128 + m * 16) * 16 + 8 * fq; *(f32x4*)p = acc[ai][0][m][0]; *(f32x4*)(p + 4) = acc[ai][0][m][1]; }
            }
            return;
        }
#pragma unroll
        for (int ai = 0; ai < 2; ++ai)
#pragma unroll
            for (int m = 0; m < 4; ++m) { bf16* rowp = O + (size_t)(row0 + ai * 128 + m * 16) * ldc + col0;
#pragma unroll
                for (int bj = 0; bj < 2; ++bj) { f32x4 v0 = acc[ai][bj][m][0], v1 = acc[ai][bj][m][1];
                    if (ACT == 1) {
#pragma unroll
                        for (int j = 0; j < 4; ++j) { const float a = fmaxf(v0[j], 0.f), b = fmaxf(v1[j], 0.f); v0[j] = a * a; v1[j] = b * b; } }
                    if (ACT == 0 && gcol >= 0 && u.pn * 256 >= gcol) {
#pragma unroll
                        for (int j = 0; j < 4; ++j) { v0[j] = geluf_(v0[j]); v1[j] = geluf_(v1[j]); } }
                    u32x4 w; w.x = pk2(v0[0], v0[1]); w.y = pk2(v0[2], v0[3]); w.z = pk2(v1[0], v1[1]); w.w = pk2(v1[2], v1[3]);
                    *(u32x4*)(rowp + bj * 128) = w;
                    if (ACT == 0 && HALO && u.pn >= 4 && u.pn < 10 && ((m == 3 && fr == 15) || (m == 0 && fr < 2))) {
                        const int r = row0 + ai * 128 + m * 16; const int which = (m == 3) ? 0 : 1 + fr;
                        *(u32x4*)(HALO + ((size_t)(r >> 6) * 3 + which) * 1536 + (col0 + bj * 128 - 1024)) = w; } } }
    }
};
struct EpiSplit {
    bf16* O0; long stride;
    __device__ __forceinline__ void operator()(const f32x4 (&acc)[2][2][4][2], const Unit& u, int wr, int wc, int fr, int fq) const {
        const int row0 = u.pm * 256 + wr * 64 + fr, col0 = (u.pn >> 1) * 256 + wc * 32 + 8 * fq; bf16* O = O0 + (long)(u.pn & 1) * stride;
#pragma unroll
        for (int ai = 0; ai < 2; ++ai)
#pragma unroll
            for (int m = 0; m < 4; ++m) { bf16* rowp = O + (size_t)(row0 + ai * 128 + m * 16) * DM + col0;
#pragma unroll
                for (int bj = 0; bj < 2; ++bj) { const f32x4 v0 = acc[ai][bj][m][0], v1 = acc[ai][bj][m][1];
                    u32x4 w; w.x = pk2(v0[0], v0[1]); w.y = pk2(v0[2], v0[3]); w.z = pk2(v1[0], v1[1]); w.w = pk2(v1[2], v1[3]);
                    *(u32x4*)(rowp + bj * 128) = w; } }
    }
};
struct EpiGates {
    unsigned* G; const bf16* X; const float* br; const float* bi; const float* lam;
    __device__ __forceinline__ void operator()(const f32x4 (&acc)[2][2][4][2], const Unit& u, int wr, int wc, int fr, int fq) const {
        const int row0 = u.pm * 256 + wr * 64 + fr, ch0 = u.pn * 128 + wc * 32 + 8 * fq;
        u32x2 xv[2][2][4];
#pragma unroll
        for (int n = 0; n < 2; ++n)
#pragma unroll
            for (int ai = 0; ai < 2; ++ai)
#pragma unroll
                for (int m = 0; m < 4; ++m) xv[n][ai][m] = *(const u32x2*)(X + (size_t)(row0 + ai * 128 + m * 16) * DM + ch0 + 4 * n);
        f32x4 pbr[2], pbi[2], pl4[2];
#pragma unroll
        for (int n = 0; n < 2; ++n) { pbr[n] = *(const f32x4*)(br + ch0 + 4 * n); pbi[n] = *(const f32x4*)(bi + ch0 + 4 * n); pl4[n] = *(const f32x4*)(lam + ch0 + 4 * n); }
#pragma unroll
        for (int n = 0; n < 2; ++n) {
            const f32x4 vbr = pbr[n], vbi = pbi[n], l4 = pl4[n];
            f32x4 vsp;
#pragma unroll
            for (int e = 0; e < 4; ++e) vsp[e] = -8.0f * softplusf_(-l4[e]);
#pragma unroll
            for (int ai = 0; ai < 2; ++ai)
#pragma unroll
                for (int m = 0; m < 4; ++m) { const size_t row = (size_t)(row0 + ai * 128 + m * 16);
                    const float xs[4] = {bflo(xv[n][ai][m].x), bfhi(xv[n][ai][m].x), bflo(xv[n][ai][m].y), bfhi(xv[n][ai][m].y)};
                    u32x4 w;
#pragma unroll
                    for (int e = 0; e < 4; ++e) { const float r = sigmoidf_(acc[ai][0][m][n][e] + vbr[e]), ig = sigmoidf_(acc[ai][1][m][n][e] + vbi[e]);
                        const float la = r * vsp[e]; const float a_ = __expf(la); const float b = __builtin_amdgcn_sqrtf(fmaxf(1.0f - a_ * a_, 0.f)) * ig * xs[e];
                        w[e] = pk2(1.0f - a_, b); }
                    *(u32x4*)(G + row * DM + ch0 + 4 * n) = w; }
        }
    }
};
constexpr int S5_WLDS = 12800, BU_P = 132, HS_P = 136;
struct S5Dir { float ar, ai; bf16x8 Bf[8]; };
__device__ __forceinline__ void s5_dir_setup(const Params& P, int e, int d, int g, int lane, float& ar, float& ai, bf16x8 (&Bf)[8], bool needB) {
    const int quad = lane >> 4, l15 = lane & 15;
    const float dt = __expf(P.in[I_LOGDT][(e * 2 + d) * 32 + g]);
    const float lr = P.in[I_LAMRE][((e * 2 + d) * 32 + g) * 64 + lane], li = P.in[I_LAMIM][((e * 2 + d) * 32 + g) * 64 + lane];
    const float mag = expf(lr * dt); ar = mag * cosf(li * dt); ai = mag * sinf(li * dt);
    const float den = lr * lr + li * li;
    const float fr = ((ar - 1.0f) * lr + ai * li) / den, fi = (ai * lr - (ar - 1.0f) * li) / den;
    if (needB) {
#pragma unroll
        for (int nt = 0; nt < 8; ++nt) { const int col = 16 * nt + l15, p = col & 63;
            const float frp = shfl_i(fr, p), fip = shfl_i(fi, p);
            bf16x8 v = (bf16x8){0, 0, 0, 0, 0, 0, 0, 0};
            if (quad < 2) { const float* bre = P.in[I_BRE] + ((size_t)(e * 32 + g) * 64 + p) * 16 + quad * 8; const float* bim = P.in[I_BIM] + ((size_t)(e * 32 + g) * 64 + p) * 16 + quad * 8;
#pragma unroll
                for (int j = 0; j < 8; ++j) { const float br = bre[j], bi = bim[j]; const float val = (nt < 4) ? (frp * br - fip * bi) : (frp * bi + fip * br); v[j] = (short)f2bf(val); } }
            Bf[nt] = v; }
    }
}
__device__ __forceinline__ void s5_c_setup(const Params& P, int e, int g, int lane, bf16x8 (&Cf)[4]) {
    const int quad = lane >> 4, l15 = lane & 15;
#pragma unroll
    for (int ks = 0; ks < 4; ++ks) { const int col0 = 32 * ks + quad * 8; const bool im = col0 >= 64;
        const float* src = (im ? P.in[I_CIM] : P.in[I_CRE]) + ((size_t)(e * 32 + g) * 16 + l15) * 64 + (col0 & 63);
        bf16x8 v;
#pragma unroll
        for (int j = 0; j < 8; ++j) v[j] = (short)f2bf(im ? -src[j] : src[j]);
        Cf[ks] = v; }
}
__device__ __forceinline__ void s5_scan_seg(const Params& P, LAS unsigned char* wl, int lane, int d, int g, int m0, float ar, float ai, const bf16x8 (&Bf)[8], const bf16x8 (&Cf)[4],
                                            float& hr, float& hi, int mode, int ymode, const bf16* proj, float* ybuf, bf16* mixout, float dsk, int dry = 0) {
    const int quad = lane >> 4, l15 = lane & 15;
    LAS float* BU = (LAS float*)wl; LAS bf16* HS = (LAS bf16*)(wl + 8448);
    const int ch = g * 16 + l15;
    bf16x8 a_next = (bf16x8){0, 0, 0, 0, 0, 0, 0, 0};
    if (mode == 0 && quad < 2) { const int blk0 = d ? 15 : 0; const int tt = d ? 15 - l15 : l15; a_next = *(const bf16x8*)(proj + (size_t)(m0 + 16 * blk0 + tt) * NPROJ_E + g * 16 + quad * 8); }
    float pre_n[4], zz_n[4];
    { const int mb0 = m0 + 16 * (d ? 15 : 0);
#pragma unroll
      for (int jj = 0; jj < 4; ++jj) { const int row = quad * 4 + jj; const int tt = d ? 15 - row : row; const size_t m = (size_t)(mb0 + tt);
          pre_n[jj] = (ymode == 0) ? dsk * bf2f(proj[m * NPROJ_E + ch]) : ybuf[m * 512 + ch];
          zz_n[jj] = (ymode == 2) ? bf2f(proj[m * NPROJ_E + 512 + ch]) : 0.f; } }
    for (int bi_ = 0; bi_ < 16; ++bi_) {
        const int blk = d ? 15 - bi_ : bi_;
        const int mb = m0 + 16 * blk;
        const bf16x8 a = a_next;
        if (mode == 0 && quad < 2 && bi_ + 1 < 16) { const int blkn = d ? 14 - bi_ : bi_ + 1; const int tt = d ? 15 - l15 : l15; a_next = *(const bf16x8*)(proj + (size_t)(m0 + 16 * blkn + tt) * NPROJ_E + g * 16 + quad * 8); }
        float pre[4], zz[4];
#pragma unroll
        for (int jj = 0; jj < 4; ++jj) { pre[jj] = pre_n[jj]; zz[jj] = zz_n[jj]; }
        if (bi_ + 1 < 16) { const int mbn = m0 + 16 * (d ? 14 - bi_ : bi_ + 1);
#pragma unroll
            for (int jj = 0; jj < 4; ++jj) { const int row = quad * 4 + jj; const int tt = d ? 15 - row : row; const size_t m = (size_t)(mbn + tt);
                pre_n[jj] = (ymode == 0) ? dsk * bf2f(proj[m * NPROJ_E + ch]) : ybuf[m * 512 + ch];
                zz_n[jj] = (ymode == 2) ? bf2f(proj[m * NPROJ_E + 512 + ch]) : 0.f; } }
        if (mode == 0) {
#pragma unroll
            for (int nt = 0; nt < 8; ++nt) { f32x4 acc = mfma16(a, Bf[nt], (f32x4){0.f, 0.f, 0.f, 0.f});
#pragma unroll
                for (int jj = 0; jj < 4; ++jj) BU[(quad * 4 + jj) * BU_P + 16 * nt + l15] = acc[jj]; }
            WAVE_SYNC();
        }
#pragma unroll
        for (int r = 0; r < 16; ++r) {
            float br = 0.f, bim = 0.f;
            if (mode == 0) { br = BU[r * BU_P + lane]; bim = BU[r * BU_P + 64 + lane]; }
            const float nr = ar * hr - ai * hi + br, ni = ar * hi + ai * hr + bim; hr = nr; hi = ni;
            HS[r * HS_P + lane] = (bf16)f2bf(hr); HS[r * HS_P + 64 + lane] = (bf16)f2bf(hi);
        }
        WAVE_SYNC();
        f32x4 y = (f32x4){0.f, 0.f, 0.f, 0.f};
#pragma unroll
        for (int ks = 0; ks < 4; ++ks) { const bf16x8 af = *(const LAS bf16x8*)(HS + l15 * HS_P + 32 * ks + quad * 8); y = mfma16(af, Cf[ks], y); }
#pragma unroll
        for (int jj = 0; jj < 4; ++jj) { const int row = quad * 4 + jj; const int tt = d ? 15 - row : row; const size_t m = (size_t)(mb + tt);
            const float v = y[jj] + pre[jj];
            if (!dry) { if (ymode != 2) ybuf[m * 512 + ch] = v;
            else mixout[m * DM + ch] = (bf16)f2bf(geluf_(v) * sigmoidf_(zz[jj])); }
        }
        WAVE_SYNC();
    }
}
__device__ __forceinline__ void s5_task_main(const Params& P, LAS unsigned char* wl, int lane, int e, int sub, int g) {
    const bf16* proj = (const bf16*)(P.ws + WS_BIG); float* ybuf = (float*)(P.ws + WS_YBUF); bf16* mixout = (bf16*)(P.ws + WS_MIX);
    const bool lat = sub >= 32; const int q = sub - 32, b = lat ? (q >> 3) : sub, seg = lat ? (q & 7) : 0;
    const int m0 = lat ? MCTX + b * LLAT + seg * 256 : sub * 256;
    bf16x8 Cf[4]; s5_c_setup(P, e, g, lane, Cf);
    const float dsk = P.in[I_S5D][e * 512 + g * 16 + (lane & 15)];
#pragma unroll 1
    for (int d = 0; d < 2; ++d) {
        float ar, ai; bf16x8 Bf[8]; s5_dir_setup(P, e, d, g, lane, ar, ai, Bf, true);
        float hr = 0.f, hi = 0.f;
        if (lat && ((d == 0 && seg == 0) || (d == 1 && seg == 7))) { const size_t si = ((((size_t)b * 2 + e) * 2 + d) * 32 + g) * 64 + lane; hr = P.in[I_S5RE][si]; hi = P.in[I_S5IM][si]; }
        const int ymode = d == 0 ? 0 : (lat ? 1 : 2);
        s5_scan_seg(P, wl, lane, d, g, m0, ar, ai, Bf, Cf, hr, hi, 0, ymode, proj, ybuf, mixout, dsk);
        if (!lat) { const size_t si = ((((size_t)b * 2 + e) * 2 + d) * 32 + g) * 64 + lane; P.out[OUT_S5RE + si] = hr; P.out[OUT_S5IM + si] = hi; }
        else { float* F = (float*)(P.ws + WS_S5F) + ((((size_t)d * 64 + q) * 32 + g) * 64 + lane) * 2; F[0] = hr; F[1] = hi; }
    }
}
__device__ __forceinline__ void s5_task_corr(const Params& P, LAS unsigned char* wl, int lane, int e, int q, int g, int dry = 0) {
    const bf16* proj = (const bf16*)(P.ws + WS_BIG); float* ybuf = (float*)(P.ws + WS_YBUF); bf16* mixout = (bf16*)(P.ws + WS_MIX);
    const int b = q >> 3, seg = q & 7, m0 = MCTX + b * LLAT + seg * 256;
    bf16x8 Cf[4]; s5_c_setup(P, e, g, lane, Cf);
    bf16x8 Bf[8];
#pragma unroll
    for (int i = 0; i < 8; ++i) Bf[i] = (bf16x8){0, 0, 0, 0, 0, 0, 0, 0};
    const float* Fb = (const float*)(P.ws + WS_S5F);
#pragma unroll 1
    for (int d = 0; d < 2; ++d) {
        float ar, ai; s5_dir_setup(P, e, d, g, lane, ar, ai, Bf, false);
        float pr = ar, pi = ai;
#pragma unroll
        for (int i = 0; i < 8; ++i) { const float nr = pr * pr - pi * pi, ni = 2.0f * pr * pi; pr = nr; pi = ni; }
        float hr = 0.f, hi = 0.f;
        const int cnt = d == 0 ? seg : 7 - seg;
        f2_t fv[7];
#pragma unroll
        for (int i = 0; i < 7; ++i) { const int sj = d == 0 ? i : 7 - i; fv[i] = (i < cnt) ? *(const f2_t*)(Fb + ((((size_t)d * 64 + b * 8 + sj) * 32 + g) * 64 + lane) * 2) : (f2_t){0.f, 0.f}; }
#pragma unroll
        for (int i = 0; i < 7; ++i) if (i < cnt) { const float nr = pr * hr - pi * hi + fv[i].x, ni = pr * hi + pi * hr + fv[i].y; hr = nr; hi = ni; }
        const int ym = (d == 1 || seg == 7) ? 2 : 1;
        if (cnt > 0) s5_scan_seg(P, wl, lane, d, g, m0, ar, ai, Bf, Cf, hr, hi, 1, ym, proj, ybuf, mixout, 0.f, dry);
    }
}

#ifndef REP_A
#define REP_A 1
#endif
#ifndef REP_B
#define REP_B 1
#endif
#ifndef REP_C
#define REP_C 1
#endif
__device__ __forceinline__ void phase_conv_even(int wid0, const Params& P, int e, int dry = 0) {
    const int tid = tid_fresh(wid0), lane = tid & 63, wave = tid >> 6;
    const int gw = bid_fresh() * NWAVES + wave, NGW = grid_fresh() * NWAVES;
    bf16* proj = (bf16*)(P.ws + WS_BIG); const bf16* HALO = (const bf16*)(P.ws + WS_HALO);
    for (int it = gw; it < 384 * 24; it += NGW) {
        const int c = it / 24, cgp = it % 24, ccol = cgp * 64 + lane;
        const int r0 = c * 64;
        const bool lat = r0 >= MCTX; const int t0 = lat ? ((r0 - MCTX) & 2047) : (r0 & 255); const int L = lat ? LLAT : LCTX;
        bf16* base = proj + (size_t)r0 * NPROJ_E + 1024 + ccol;
        bf16 x[67];
#pragma unroll
        for (int i = 0; i < 64; ++i) x[i + 1] = base[(size_t)i * NPROJ_E];
        x[0] = (t0 > 0) ? HALO[((size_t)(c - 1) * 3 + 0) * 1536 + ccol] : (bf16)0;
        x[65] = (t0 + 64 < L) ? HALO[((size_t)(c + 1) * 3 + 1) * 1536 + ccol] : (bf16)0;
        x[66] = (t0 + 64 < L) ? HALO[((size_t)(c + 1) * 3 + 2) * 1536 + ccol] : (bf16)0;
        const float* cw = P.in[I_GCONVW] + (size_t)e * 4 * 1536 + ccol; const float w0 = cw[0], w1 = cw[1536], w2 = cw[3072], w3 = cw[4608], cb = P.in[I_GCONVB][e * 1536 + ccol];
#pragma unroll
        for (int i = 0; i < 64; ++i) { const float v = cb + w0 * bf2f(x[i]) + w1 * bf2f(x[i + 1]) + w2 * bf2f(x[i + 2]) + w3 * bf2f(x[i + 3]);
            if (!dry) base[(size_t)i * NPROJ_E] = (bf16)f2bf(siluf_(v)); }
    }
}
#define LDS_BARRIER() do { asm volatile("s_waitcnt lgkmcnt(0)" ::: "memory"); __builtin_amdgcn_s_barrier(); asm volatile("" ::: "memory"); } while (0)
constexpr int G_Q = 0, G_K = 17408, G_V = 34816, G_KT = 52224, G_LM = 70656, G_QK = 89088, G_ST = 98304, G_SM = 133120;
constexpr int P128 = 136, P64 = 72, LMP = 68;
__device__ __forceinline__ bf16x8 ld_split8(const LAS bf16* p) {
    const u32x2 a = *(const LAS u32x2*)p, b = *(const LAS u32x2*)(p + 16);
    return __builtin_bit_cast(bf16x8, (u32x4){a.x, a.y, b.x, b.y});
}
__device__ __forceinline__ bf16x8 pack_acc2(const f32x4& a, const f32x4& b) { return __builtin_bit_cast(bf16x8, (u32x4){pk2(a[0], a[1]), pk2(a[2], a[3]), pk2(b[0], b[1]), pk2(b[2], b[3])}); }
__device__ __forceinline__ void gdn_chain(int wid0, const Params& P, LAS unsigned char* lds, int e, int s, int hd, int dir) {
    const int tid = tid_fresh(wid0), lane = tid & 63, w = __builtin_amdgcn_readfirstlane(tid >> 6), quad = lane >> 4, l15 = lane & 15;
    const bool lat = s >= 32; const int b = lat ? s - 32 : s; const int L = lat ? LLAT : LCTX; const int m0 = lat ? MCTX + b * LLAT : s * LCTX;
    const bf16* proj = (const bf16*)(P.ws + WS_BIG); const float* AB = (const float*)(P.ws + WS_AB);
    bf16* Odir = (bf16*)(P.ws + WS_H) + (size_t)dir * MT * 512;
    int zv; asm volatile("v_mov_b32 %0, 0" : "=v"(zv));
    lds += zv;
    LAS bf16* Qs = (LAS bf16*)(lds + G_Q); LAS bf16* Ks = (LAS bf16*)(lds + G_K); LAS bf16* Vs = (LAS bf16*)(lds + G_V); LAS bf16* KT = (LAS bf16*)(lds + G_KT);
    LAS float* Lm = (LAS float*)(lds + G_LM); LAS bf16* VNT = (LAS bf16*)(lds + G_LM); LAS bf16* QKs = (LAS bf16*)(lds + G_QK); LAS bf16* ST = (LAS bf16*)(lds + G_ST);
    LAS bf16* TM = (LAS bf16*)(lds + G_ST); LAS bf16* TT = TM + 64 * P64; LAS bf16* LR = TT + 64 * P64;
    LAS float* rq = (LAS float*)(lds + G_SM); LAS float* rk = rq + 64; LAS float* gcs = rq + 128; LAS float* betas = rq + 192; LAS float* egs = rq + 256; LAS float* kes = rq + 320;
    f32x4 Sacc[8];
    const size_t sbase = ((((size_t)b * 2 + e) * 2 + dir) * 4 + hd) * 16384;
#pragma unroll
    for (int mt = 0; mt < 8; ++mt) Sacc[mt] = (f32x4){0.f, 0.f, 0.f, 0.f};
    if (lat) { const float* sp = P.in[I_SDELTA] + sbase + (size_t)(quad * 4) * 128 + 16 * w + l15;
#pragma unroll
        for (int mt = 0; mt < 8; ++mt)
#pragma unroll
            for (int jj = 0; jj < 4; ++jj) Sacc[mt][jj] = sp[(16 * mt + jj) * 128]; }
    for (int i = tid; i < 2 * 64 * P64 / 2; i += NTHR) ((LAS unsigned*)TM)[i] = 0u;
    const float alog_e = __expf(P.in[I_GALOG][(e * 2 + dir) * 4 + hd]), dtb = P.in[I_GDTB][(e * 2 + dir) * 4 + hd];
    const int nchunk = L / 64;
    u32x4 xr[6]; float ab_a = 0.f, ab_b = 0.f;
#define GDN_LOAD(ci_) do { const int tid_ = tid_fresh(wid0); const int c0_ = dir ? L - 64 * ((ci_) + 1) : 64 * (ci_); \
        _Pragma("unroll") for (int k = 0; k < 6; ++k) { const int p_ = tid_ + 512 * k, part_ = p_ >> 10, row_ = (p_ & 1023) >> 4, pc_ = p_ & 15; \
            xr[k] = *(const u32x4*)(proj + (size_t)(m0 + c0_ + row_) * NPROJ_E + 1024 + part_ * 512 + hd * 128 + pc_ * 8); } \
        if (w == 0) { const int ln_ = tid_ & 63; const size_t m_ = (size_t)(m0 + c0_ + (dir ? 63 - ln_ : ln_)); ab_a = AB[m_ * 16 + dir * 4 + hd]; ab_b = AB[m_ * 16 + 8 + dir * 4 + hd]; } } while (0)
    GDN_LOAD(0);
#pragma unroll 1
    for (int ci = 0; ci < nchunk; ++ci) {
        const int tid = tid_fresh(wid0), lane = tid & 63, quad = lane >> 4, l15 = lane & 15;
        const int c0 = dir ? L - 64 * (ci + 1) : 64 * ci;
        LDS_BARRIER();
#ifndef NO_A
        const float cur_a = ab_a, cur_b = ab_b;
#pragma unroll
        for (int k = 0; k < 6; ++k) { const int p_ = tid + 512 * k, part_ = p_ >> 10, row_ = (p_ & 1023) >> 4, pc_ = p_ & 15;
            LAS bf16* dst = part_ == 0 ? Qs : (part_ == 1 ? Ks : Vs);
            *(LAS u32x4*)(dst + (dir ? 63 - row_ : row_) * P128 + pc_ * 8) = xr[k]; }
        if (ci + 1 < nchunk) GDN_LOAD(ci + 1);
#endif
        LDS_BARRIER();
#pragma unroll 1
        for (int repB = 0; repB < REP_B; ++repB)
        { const int rowid = tid >> 2, part = tid & 3; LAS bf16* src = (rowid < 64 ? Qs : Ks) + (rowid & 63) * P128 + part * 32;
          float ss = 0.f;
#pragma unroll
          for (int i = 0; i < 4; ++i) { const u32x4 v = *(const LAS u32x4*)(src + 8 * i);
#pragma unroll
              for (int j = 0; j < 4; ++j) { const float a = bflo(v[j]), c = bfhi(v[j]); ss += a * a + c * c; } }
          ss += shfl_i(ss, lane ^ 1); ss += shfl_i(ss, lane ^ 2);
          if (part == 0) { if (rowid < 64) rq[rowid] = rsqrtf(ss + EPSF) * 0.08838834764831845f; else rk[rowid - 64] = rsqrtf(ss + EPSF); }
          if (w == 0) { const int t = c0 + (dir ? 63 - lane : lane); const size_t m = (size_t)(m0 + t);
              const float araw = cur_a, braw = cur_b;
              const float gg = -alog_e * softplusf_(araw + dtb);
              float gc = gg;
#pragma unroll
              for (int o = 1; o < 64; o <<= 1) { const float t2 = shfl_i(gc, (lane - o) & 63); if (lane >= o) gc += t2; }
              const float glast = shfl_i(gc, 63);
              gcs[lane] = gc; betas[lane] = sigmoidf_(braw); egs[lane] = __expf(gc); kes[lane] = __expf(glast - gc);
              if (lane == 0) rq[384] = __expf(glast); } }
        LDS_BARRIER();
#ifndef NO_C
#pragma unroll 1
        for (int repC = 0; repC < REP_C; ++repC)
        { const int mt = w & 3; const bool isq = w >= 4; LAS bf16* src = isq ? Qs : Ks;
          bf16x8 a[4];
#pragma unroll
          for (int ks = 0; ks < 4; ++ks) a[ks] = *(const LAS bf16x8*)(src + (16 * mt + l15) * P128 + 32 * ks + quad * 8);
#pragma unroll 1
          for (int nt = 0; nt < 4; ++nt) { f32x4 acc = (f32x4){0.f, 0.f, 0.f, 0.f};
#pragma unroll
              for (int ks = 0; ks < 4; ++ks) { const bf16x8 bb = *(const LAS bf16x8*)(Ks + (16 * nt + l15) * P128 + 32 * ks + quad * 8); acc = mfma16(a[ks], bb, acc); }
              const int j = 16 * nt + l15; const float rkj = rk[j], gcj = gcs[j];
              f32x4 lv;
#pragma unroll
              for (int jj = 0; jj < 4; ++jj) { const int i = 16 * mt + quad * 4 + jj; const float dec = __expf(fminf(gcs[i] - gcj, 0.f));
                  lv[jj] = (i > j) ? acc[jj] * rk[i] * rkj * betas[i] * dec : 0.f;
                  if (isq) QKs[i * P64 + j] = (bf16)f2bf((i >= j) ? acc[jj] * rq[i] * rkj * dec : 0.f); }
              if (!isq) { *(LAS f32x4*)(Lm + j * LMP + 16 * mt + quad * 4) = lv;
#pragma unroll
                  for (int jj = 0; jj < 4; ++jj) LR[(16 * mt + quad * 4 + jj) * P64 + j] = (bf16)f2bf(nt < mt ? lv[jj] : 0.f); } }
          const int dd = tid & 127, tq = tid >> 7;
          unsigned pw[8];
#pragma unroll
          for (int n = 0; n < 16; n += 2) { const int i0 = tq * 16 + n; const float v0 = bf2f(Ks[i0 * P128 + dd]) * rk[i0] * kes[i0], v1 = bf2f(Ks[(i0 + 1) * P128 + dd]) * rk[i0 + 1] * kes[i0 + 1]; pw[n >> 1] = pk2(v0, v1); }
          *(LAS u32x4*)(KT + dd * P64 + tq * 16) = (u32x4){pw[0], pw[1], pw[2], pw[3]};
          *(LAS u32x4*)(KT + dd * P64 + tq * 16 + 8) = (u32x4){pw[4], pw[5], pw[6], pw[7]}; }
#endif
        LDS_BARRIER();
        { const int i = tid >> 3, c0k = (tid & 7) * 16; const float sc = rk[i] * betas[i] * egs[i];
#pragma unroll
          for (int h2 = 0; h2 < 2; ++h2) { u32x4 v = *(LAS u32x4*)(Ks + i * P128 + c0k + 8 * h2);
#pragma unroll
              for (int q = 0; q < 4; ++q) v[q] = pk2(bflo(v[q]) * sc, bfhi(v[q]) * sc);
              *(LAS u32x4*)(Ks + i * P128 + c0k + 8 * h2) = v; } }
        if (w == 0) { const int bb = lane >> 4, c = lane & 15;
            float x[16];
#pragma unroll
            for (int r = 0; r < 16; ++r) x[r] = (r == c) ? 1.f : 0.f;
#pragma unroll
            for (int j = 0; j < 15; ++j) {
#pragma unroll
                for (int q4 = j / 4; q4 < 4; ++q4) { const f32x4 l4 = *(const LAS f32x4*)(Lm + (16 * bb + j) * LMP + 16 * bb + 4 * q4);
#pragma unroll
                    for (int jx = 0; jx < 4; ++jx) if (4 * q4 + jx > j) x[4 * q4 + jx] -= l4[jx] * x[j]; } }
            unsigned pw[8];
#pragma unroll
            for (int r = 0; r < 16; r += 2) { pw[r >> 1] = pk2(x[r], x[r + 1]); TM[(16 * bb + r) * P64 + 16 * bb + c] = (bf16)(pw[r >> 1] & 0xffffu); TM[(16 * bb + r + 1) * P64 + 16 * bb + c] = (bf16)(pw[r >> 1] >> 16); }
            *(LAS u32x4*)(TT + (16 * bb + c) * P64 + 16 * bb) = (u32x4){pw[0], pw[1], pw[2], pw[3]};
            *(LAS u32x4*)(TT + (16 * bb + c) * P64 + 16 * bb + 8) = (u32x4){pw[4], pw[5], pw[6], pw[7]}; }
        LDS_BARRIER();
#pragma unroll 1
        for (int lev = 1; lev < 4; ++lev) {
            if (w < 4 - lev) { const int bj = w, bi = w + lev;
                f32x4 m = (f32x4){0.f, 0.f, 0.f, 0.f};
#pragma unroll
                for (int ks = 0; ks < 2; ++ks) { const bf16x8 a = *(const LAS bf16x8*)(LR + (16 * bi + l15) * P64 + 32 * ks + quad * 8), bq = *(const LAS bf16x8*)(TT + (16 * bj + l15) * P64 + 32 * ks + quad * 8); m = mfma16(a, bq, m); }
                const u32x2 tl = *(const LAS u32x2*)(TM + (16 * bi + l15) * P64 + 16 * bi + quad * 4);
                const bf16x8 a2 = __builtin_bit_cast(bf16x8, (u32x4){tl.x, tl.y, 0u, 0u}), b2 = __builtin_bit_cast(bf16x8, (u32x4){pk2(m[0], m[1]), pk2(m[2], m[3]), 0u, 0u});
                const f32x4 t = mfma16(a2, b2, (f32x4){0.f, 0.f, 0.f, 0.f});
                const unsigned p0 = pk2(-t[0], -t[1]), p1 = pk2(-t[2], -t[3]);
                TM[(16 * bi + quad * 4 + 0) * P64 + 16 * bj + l15] = (bf16)(p0 & 0xffffu); TM[(16 * bi + quad * 4 + 1) * P64 + 16 * bj + l15] = (bf16)(p0 >> 16);
                TM[(16 * bi + quad * 4 + 2) * P64 + 16 * bj + l15] = (bf16)(p1 & 0xffffu); TM[(16 * bi + quad * 4 + 3) * P64 + 16 * bj + l15] = (bf16)(p1 >> 16);
                *(LAS u32x2*)(TT + (16 * bj + l15) * P64 + 16 * bi + quad * 4) = (u32x2){p0, p1}; }
            LDS_BARRIER();
        }
#ifndef NO_EFG
        bf16x8 Bst[4];
#pragma unroll
        for (int ks = 0; ks < 4; ++ks) Bst[ks] = pack_acc2(Sacc[2 * ks], Sacc[2 * ks + 1]);
        f32x4 vn[4];
#pragma unroll
        for (int mt = 0; mt < 4; ++mt) { f32x4 acc = (f32x4){0.f, 0.f, 0.f, 0.f};
#pragma unroll
            for (int ks = 0; ks < 4; ++ks) { const bf16x8 a = ld_split8(Ks + (16 * mt + l15) * P128 + 32 * ks + quad * 4); acc = mfma16(a, Bst[ks], acc); }
#pragma unroll
            for (int jj = 0; jj < 4; ++jj) { const int i = 16 * mt + quad * 4 + jj; vn[mt][jj] = bf2f(Vs[i * P128 + 16 * w + l15]) * betas[i] - acc[jj]; } }
        bf16x8 Bvn[2];
#pragma unroll
        for (int k2 = 0; k2 < 2; ++k2) Bvn[k2] = pack_acc2(vn[2 * k2], vn[2 * k2 + 1]);
#pragma unroll
        for (int mt = 0; mt < 4; ++mt) { f32x4 acc = (f32x4){0.f, 0.f, 0.f, 0.f};
#pragma unroll
            for (int k2 = 0; k2 < 2; ++k2) { const bf16x8 a = ld_split8(TM + (16 * mt + l15) * P64 + 32 * k2 + quad * 4); acc = mfma16(a, Bvn[k2], acc); }
            vn[mt] = acc; }
#pragma unroll
        for (int k2 = 0; k2 < 2; ++k2) Bvn[k2] = pack_acc2(vn[2 * k2], vn[2 * k2 + 1]);
#pragma unroll 1
        for (int mt = 0; mt < 4; ++mt) { f32x4 acc = (f32x4){0.f, 0.f, 0.f, 0.f};
#pragma unroll
            for (int ks = 0; ks < 4; ++ks) { const bf16x8 a = ld_split8(Qs + (16 * mt + l15) * P128 + 32 * ks + quad * 4); acc = mfma16(a, Bst[ks], acc); }
#pragma unroll
            for (int jj = 0; jj < 4; ++jj) { const int i = 16 * mt + quad * 4 + jj; acc[jj] *= rq[i] * egs[i]; }
#pragma unroll
            for (int k2 = 0; k2 < 2; ++k2) { const bf16x8 a = ld_split8(QKs + (16 * mt + l15) * P64 + 32 * k2 + quad * 4); acc = mfma16(a, Bvn[k2], acc); }
#pragma unroll
            for (int jj = 0; jj < 4; ++jj) { const int i = 16 * mt + quad * 4 + jj; const int t = c0 + (dir ? 63 - i : i);
                Odir[(size_t)(m0 + t) * 512 + hd * 128 + 16 * w + l15] = (bf16)f2bf(acc[jj]); } }
        const float egl = rq[384];
#pragma unroll
        for (int mt = 0; mt < 8; ++mt) { f32x4 acc = Sacc[mt] * egl;
#pragma unroll
            for (int k2 = 0; k2 < 2; ++k2) { const bf16x8 a = ld_split8(KT + (16 * mt + l15) * P64 + 32 * k2 + quad * 4); acc = mfma16(a, Bvn[k2], acc); }
            Sacc[mt] = acc; }
#endif
        WAVE_SYNC();
    }
    if (!lat) { const int tid2 = tid_fresh(wid0), lane2 = tid2 & 63; float* dp = P.out + OUT_DELTA + sbase + (size_t)((lane2 >> 4) * 4) * 128 + 16 * w + (lane2 & 15);
#pragma unroll
        for (int mt = 0; mt < 8; ++mt)
#pragma unroll
            for (int jj = 0; jj < 4; ++jj) dp[(16 * mt + jj) * 128] = Sacc[mt][jj];
    }
    __syncthreads();
}

__device__ __forceinline__ void phase_mix_even(int wid0, const Params& P, LAS unsigned char* lds, int e, int mode = 3) {
    const int bid = bid_fresh(), G = grid_fresh();
    if (G == 256) {
        if (bid < 64) { const int s = 32 + (bid >> 3), hd = (bid >> 1) & 3, dir = bid & 1; if (mode & 1) gdn_chain(wid0, P, lds, e, s, hd, dir); }
        else { const int bb = bid - 64;
            if (mode & 1) for (int c = bb; c < 256; c += 192) { const int s = c >> 3, hd = (c >> 1) & 3, dir = c & 1; gdn_chain(wid0, P, lds, e, s, hd, dir); }
            if (mode & 2) { const int tid = tid_fresh(wid0), lane = tid & 63, wave = tid >> 6;
                for (int t = bb; t < 384; t += 192) { const int wt = t * 8 + wave; s5_task_main(P, lds + wave * S5_WLDS, lane, e, wt >> 5, wt & 31); } }
            if (mode == 3) { __syncthreads(); const int tid = tid_fresh(wid0), lane = tid & 63, wave = tid >> 6;
                for (int it = bb * NWAVES + wave; it < WITEMS_ODD; it += 192 * NWAVES) weight_item(P, (LAS float*)(lds + wave * 16384), 2 * e + 1, it, lane); } }
    } else {
        for (int c = bid; c < 320; c += G) { const int s = c < 64 ? 32 + (c >> 3) : ((c - 64) >> 3), hd = (c >> 1) & 3, dir = c & 1; gdn_chain(wid0, P, lds, e, s, hd, dir); }
        const int tid = tid_fresh(wid0), lane = tid & 63, wave = tid >> 6;
        for (int t = bid; t < 384; t += G) { const int wt = t * 8 + wave; s5_task_main(P, lds + wave * S5_WLDS, lane, e, wt >> 5, wt & 31); }
        __syncthreads();
        for (int it = bid * NWAVES + wave; it < WITEMS_ODD; it += G * NWAVES) weight_item(P, (LAS float*)(lds + wave * 16384), 2 * e + 1, it, lane);
    }
}
__device__ __forceinline__ void phase_fin_even(int wid0, const Params& P, LAS unsigned char* lds, int e, int dry = 0) {
    const int tid = tid_fresh(wid0), lane = tid & 63, wave = tid >> 6;
    const int gw = bid_fresh() * NWAVES + wave, NGW = grid_fresh() * NWAVES;
    for (int wt = gw; wt < 2048; wt += NGW) s5_task_corr(P, lds + wave * S5_WLDS, lane, e, wt >> 5, wt & 31, dry);
    const bf16* proj = (const bf16*)(P.ws + WS_BIG); const bf16* Of = (const bf16*)(P.ws + WS_H); const bf16* Ob = Of + (size_t)MT * 512; bf16* mixout = (bf16*)(P.ws + WS_MIX);
    float gnv[8];
#pragma unroll
    for (int j = 0; j < 8; ++j) gnv[j] = P.in[I_GONORM][e * 128 + (lane & 15) * 8 + j];
    for (int mb2 = gw; mb2 < MT; mb2 += 2 * NGW) {
        u32x4 a[2], bq[2], z[2];
#pragma unroll
        for (int u = 0; u < 2; ++u) { const int m = mb2 + u * NGW; if (m < MT) { a[u] = *(const u32x4*)(Of + (size_t)m * 512 + lane * 8); bq[u] = *(const u32x4*)(Ob + (size_t)m * 512 + lane * 8); z[u] = *(const u32x4*)(proj + (size_t)m * NPROJ_E + 2560 + lane * 8); } }
#pragma unroll
        for (int u = 0; u < 2; ++u) { const int m = mb2 + u * NGW; if (m < MT) {
            float o[8]; float ss = 0.f;
#pragma unroll
            for (int j = 0; j < 4; ++j) { o[2 * j] = bflo(a[u][j]) + bflo(bq[u][j]); o[2 * j + 1] = bfhi(a[u][j]) + bfhi(bq[u][j]); ss += o[2 * j] * o[2 * j] + o[2 * j + 1] * o[2 * j + 1]; }
            ss += shfl_i(ss, lane ^ 1); ss += shfl_i(ss, lane ^ 2); ss += shfl_i(ss, lane ^ 4); ss += shfl_i(ss, lane ^ 8);
            const float rs = rsqrtf(ss * (1.0f / 128.0f) + EPSF);
            unsigned pw[4];
#pragma unroll
            for (int j = 0; j < 4; ++j) { const float z0 = bflo(z[u][j]), z1 = bfhi(z[u][j]); pw[j] = pk2(o[2 * j] * rs * gnv[2 * j] * siluf_(z0), o[2 * j + 1] * rs * gnv[2 * j + 1] * siluf_(z1)); }
            if (!dry) *(u32x4*)(mixout + (size_t)m * DM + 512 + lane * 8) = (u32x4){pw[0], pw[1], pw[2], pw[3]}; } }
    }
}

__device__ __forceinline__ void phase_conv_odd(int wid0, const Params& P, int o) {
    const int tid = tid_fresh(wid0), lane = tid & 63, wave = tid >> 6;
    const int gw = bid_fresh() * NWAVES + wave, NGW = grid_fresh() * NWAVES;
    const bf16* proj = (const bf16*)(P.ws + WS_BIG); bf16* cx = (bf16*)(P.ws + WS_H);
    const float* cw = P.in[I_LCONVW] + (size_t)o * 4 * 1024; const float* cb = P.in[I_LCONVB] + o * 1024;
    float wv[2][4][8], bv[2][8];
#pragma unroll
    for (int h2 = 0; h2 < 2; ++h2) { const int ch = lane * 8 + 512 * h2;
#pragma unroll
        for (int j = 0; j < 8; ++j) { bv[h2][j] = cb[ch + j];
#pragma unroll
            for (int k = 0; k < 4; ++k) wv[h2][k][j] = cw[k * 1024 + ch + j]; } }
    for (int m = gw; m < MT; m += NGW) {
        const int t = m < MCTX ? (m & 255) : ((m - MCTX) & 2047); const int L = m < MCTX ? LCTX : LLAT;
        u32x4 xr[2][4];
#pragma unroll
        for (int k = 0; k < 4; ++k) { const int tt = t - 1 + k; const bool ok = (tt >= 0) && (tt < L); const size_t row = (size_t)(ok ? m - 1 + k : m);
#pragma unroll
            for (int h2 = 0; h2 < 2; ++h2) { const u32x4 v = *(const u32x4*)(proj + row * 2048 + lane * 8 + 512 * h2); xr[h2][k] = ok ? v : (u32x4){0u, 0u, 0u, 0u}; } }
#pragma unroll
        for (int h2 = 0; h2 < 2; ++h2) { const int ch = lane * 8 + 512 * h2;
            float acc[8];
#pragma unroll
            for (int j = 0; j < 8; ++j) acc[j] = bv[h2][j];
#pragma unroll
            for (int k = 0; k < 4; ++k)
#pragma unroll
                for (int j = 0; j < 4; ++j) { acc[2 * j] += wv[h2][k][2 * j] * bflo(xr[h2][k][j]); acc[2 * j + 1] += wv[h2][k][2 * j + 1] * bfhi(xr[h2][k][j]); }
            *(u32x4*)(cx + (size_t)m * DM + ch) = (u32x4){pk2(acc[0], acc[1]), pk2(acc[2], acc[3]), pk2(acc[4], acc[5]), pk2(acc[6], acc[7])}; }
    }
}
__device__ __forceinline__ void phase_lru_scan(int wid0, const Params& P, LAS unsigned char* lds, int o, int d) {
    const int tid = tid_fresh(wid0), lane = tid & 63, wave = tid >> 6;
    const int gw = bid_fresh() * NWAVES + wave, NGW = grid_fresh() * NWAVES;
    const unsigned* G = (const unsigned*)(P.ws + WS_GATES); const bf16* proj = (const bf16*)(P.ws + WS_BIG); bf16* mixout = (bf16*)(P.ws + WS_MIX);
    const int Gn = NGW / NWAVES, vw = wave * Gn + (gw / NWAVES);
    if (d == 0 && o == 0 && NGW > 640) {
        for (int it = vw - 640; it >= 0 && it < WITEMS_EVEN; it += NGW - 640) weight_item(P, (LAS float*)(lds + wave * 16384), 2, it, lane); }
    for (int task = vw; task < 640; task += NGW) {
        int s, cg_;
        if (task < 128) { s = 32 + (task >> 4); cg_ = task & 15; } else { s = (task - 128) >> 4; cg_ = (task - 128) & 15; }
        const bool lat = s >= 32; const int b = lat ? s - 32 : s; const int L = lat ? LLAT : LCTX; const int m0 = lat ? MCTX + b * LLAT : s * LCTX;
        const int ch = cg_ * 64 + lane;
        float h = lat ? P.in[I_SLRU][(((size_t)b * 2 + o) * 2 + d) * 1024 + ch] : 0.f;
        if (d == 0) {
            unsigned ga[32], gb[32];
#define LRU_LD0(dst, tt) _Pragma("unroll") for (int i = 0; i < 32; ++i) dst[i] = G[(size_t)(m0 + (tt) + i) * DM + ch]
#define LRU_CP0(src, tt) _Pragma("unroll") for (int i = 0; i < 32; ++i) { h = (1.0f - bflo(src[i])) * h + bfhi(src[i]); mixout[(size_t)(m0 + (tt) + i) * DM + ch] = (bf16)f2bf(h); }
            LRU_LD0(ga, 0);
            for (int t0 = 0; t0 < L; t0 += 64) {
                LRU_LD0(gb, t0 + 32);
                LRU_CP0(ga, t0);
                if (t0 + 64 < L) { LRU_LD0(ga, t0 + 64); }
                LRU_CP0(gb, t0 + 32);
            }
        } else {
            unsigned ga[16], gb[16]; bf16 pa[16], pb[16], ya[16], yb[16];
#define LRU_LD1(g_, p_, y_, tt) _Pragma("unroll") for (int i = 0; i < 16; ++i) { const size_t m = (size_t)(m0 + L - 1 - ((tt) + i)); g_[i] = G[m * DM + ch]; p_[i] = mixout[m * DM + ch]; y_[i] = proj[m * 2048 + 1024 + ch]; }
#define LRU_CP1(g_, p_, y_, tt) _Pragma("unroll") for (int i = 0; i < 16; ++i) { const size_t m = (size_t)(m0 + L - 1 - ((tt) + i)); \
                h = (1.0f - bflo(g_[i])) * h + bfhi(g_[i]); mixout[m * DM + ch] = (bf16)f2bf((bf2f(p_[i]) + h) * bf2f(y_[i])); }
            LRU_LD1(ga, pa, ya, 0);
            for (int t0 = 0; t0 < L; t0 += 32) {
                LRU_LD1(gb, pb, yb, t0 + 16);
                LRU_CP1(ga, pa, ya, t0);
                if (t0 + 32 < L) { LRU_LD1(ga, pa, ya, t0 + 32); }
                LRU_CP1(gb, pb, yb, t0 + 16);
            }
        }
        if (!lat) P.out[OUT_LRU + (((size_t)b * 2 + o) * 2 + d) * 1024 + ch] = h;
    }
}
#ifndef WGM_IN
#define WGM_IN 4
#endif
#ifndef WGM_GATES
#define WGM_GATES 4
#endif
#ifndef WGM_OUT
#define WGM_OUT 4
#endif
#ifndef WGM_MLP1
#define WGM_MLP1 4
#endif
#ifndef WGM_MLP2
#define WGM_MLP2 4
#endif
#ifdef PROBE_DUP_GEMM
#define DUPG(x) GSYNC(); x
#else
#define DUPG(x)
#endif
typedef const __attribute__((address_space(4))) Params* KParams;
__device__ __forceinline__ Params load_params(KParams q) { Params r;
#pragma unroll
    for (int i = 0; i < 40; ++i) r.in[i] = q->in[i];
    r.out = q->out; r.ws = q->ws; return r; }
#define FRESH() const int G = grid_fresh(), bid = bid_fresh(); (void)G; (void)bid; KParams pk_ = (KParams)__builtin_amdgcn_kernarg_segment_ptr(); asm volatile("" : "+s"(pk_)); const Params P = load_params(pk_); unsigned char* ws = P.ws; \
    const float* mod = (const float*)(ws + WS_MOD); bf16* H = (bf16*)(ws + WS_H); bf16* BIG = (bf16*)(ws + WS_BIG); bf16* MIX = (bf16*)(ws + WS_MIX); (void)mod; (void)H; (void)BIG; (void)MIX;
#define GSYNC() do { KParams pb_ = (KParams)__builtin_amdgcn_kernarg_segment_ptr(); asm volatile("" : "+s"(pb_)); xcd_barrier(wid0, (unsigned*)(pb_->ws + WS_BAR), lds); } while (0)
__global__ void __launch_bounds__(NTHR, 2) fwd_kernel(Params Parg) {
    extern __shared__ __attribute__((aligned(16))) unsigned char lds_raw[];
    LAS unsigned char* lds = (LAS unsigned char*)lds_raw;
    cg::grid_group grid = cg::this_grid();
    const int wid0 = __builtin_amdgcn_readfirstlane(threadIdx.x >> 6);
    if (threadIdx.x < 4) ((LAS unsigned*)(lds + LDS_BARST))[threadIdx.x] = 0u;
    __syncthreads();
    if (threadIdx.x == 0) (void)xb_add((unsigned*)(Parg.ws + WS_BAR) + XB_XCNT(xb_xcc_id()), 1u);

    { FRESH(); phase_prologue(wid0, P, lds); }
    if (grid_fresh() == 0) grid.sync();
    GSYNC();
#ifdef PROBE_DUP_PRO
    { FRESH(); phase_prologue(wid0, P, lds); }
    GSYNC();
#endif
    { FRESH(); phase_modreduce(wid0, P); }
    GSYNC();
#ifdef PROBE_SYNC
#pragma unroll 1
    for (int i = 0; i < 40; ++i) GSYNC();
#endif
#pragma unroll 1
    for (int l = 0; l < 4; ++l) {
        { FRESH(); const float* modl = mod + (size_t)l * 9 * 6144;
        phase_rownorm(wid0, P, l == 0, MIX, modl - 9 * 6144, 5 * 1024, P.in[I_NMLPPOST] + (l > 0 ? (l - 1) * 1024 : 0), 1, P.in[I_NMIXPRE] + l * 1024, modl, 0, H); }
        GSYNC();
        const int eo = l >> 1;
        {
            FRESH();
            pg8::Gemm g; pg8::StaticOrder S; EpiBf16<0> E;
            if ((l & 1) == 0) { g = pg8::Gemm{H, (const bf16*)(ws + WS_WINE) + (size_t)eo * NB_E * 1024, MT, NB_E, 1024, 1024, 0, 0, 1024, 0}; E = EpiBf16<0>{BIG, NPROJ_E, (float*)(ws + WS_AB), (bf16*)(ws + WS_HALO), -1}; }
            else { g = pg8::Gemm{H, (const bf16*)(ws + WS_WINO) + (size_t)eo * 2048 * 1024, MT, 2048, 1024, 1024, 0, 0, 1024, 0}; E = EpiBf16<0>{BIG, 2048, nullptr, nullptr, 1024}; }
            S.init(g.M, g.N, G, bid, WGM_IN);
            pg8::gemm_phase(wid0, lds, g, S, E); DUPG(pg8::gemm_phase(wid0, lds, g, S, E);)
        }
        GSYNC();
        if ((l & 1) == 0) {
            { FRESH(); phase_conv_even(wid0, P, eo); }
            GSYNC();
#ifdef PROBE_DRY_CONVE
            { FRESH(); phase_conv_even(wid0, P, eo, grid_fresh() > 0); }
            GSYNC();
#endif
#ifdef PROBE_DUP_MIX
#pragma unroll 1
            for (int rep = 0; rep < 2; ++rep) { { FRESH(); phase_mix_even(wid0, P, lds, eo, rep == 0 ? 3 : PROBE_DUP_MIX); } GSYNC(); }
#else
            { FRESH(); phase_mix_even(wid0, P, lds, eo); }
            GSYNC();
#endif
            { FRESH(); phase_fin_even(wid0, P, lds, eo); }
            GSYNC();
#ifdef PROBE_DRY_FIN
            { FRESH(); phase_fin_even(wid0, P, lds, eo, grid_fresh() > 0); }
            GSYNC();
#endif
        } else {
            { FRESH(); phase_conv_odd(wid0, P, eo); }
            GSYNC();
#ifdef PROBE_DUP_CONV
            { FRESH(); phase_conv_odd(wid0, P, eo); }
            GSYNC();
#endif
#pragma unroll 1
            for (int d = 0; d < 2; ++d) {
                { FRESH();
                pg8::Gemm g{H, (const bf16*)(ws + WS_WG) + (size_t)(eo * 2 + d) * 2048 * 256, MT, 2048, 256, 1024, 1, 1, 256, 0};
                EpiGates E{(unsigned*)(ws + WS_GATES), H, P.in[I_LBR] + (eo * 2 + d) * 1024, P.in[I_LBI] + (eo * 2 + d) * 1024, P.in[I_LLAM] + (eo * 2 + d) * 1024};
                pg8::StaticOrder S; S.init(g.M, g.N, G, bid, WGM_GATES);
                pg8::gemm_phase(wid0, lds, g, S, E); DUPG(pg8::gemm_phase(wid0, lds, g, S, E);) }
                GSYNC();
                { FRESH(); phase_lru_scan(wid0, P, lds, eo, d); }
#ifdef PROBE_DUP_LRU0
                if (d == 0) { GSYNC(); FRESH(); phase_lru_scan(wid0, P, lds, eo, d); }
#endif
                GSYNC();
            }
        }
        {
            FRESH();
            pg8::Gemm g{MIX, (const bf16*)(ws + ((l & 1) ? WS_WOUTO : WS_WOUTE)) + (size_t)eo * 1024 * 1024, MT, 1024, 1024, 1024, 0, 0, 1024, 0};
            EpiBf16<0> E{BIG, 1024, nullptr, nullptr, -1}; pg8::StaticOrder S; S.init(g.M, g.N, G, bid, WGM_OUT);
            pg8::gemm_phase(wid0, lds, g, S, E); DUPG(pg8::gemm_phase(wid0, lds, g, S, E);)
        }
        GSYNC();
        { FRESH(); const float* modl = mod + (size_t)l * 9 * 6144;
        phase_rownorm(wid0, P, 0, BIG, modl, 2 * 1024, P.in[I_NMIXPOST] + l * 1024, 1, P.in[I_NMLPPRE] + l * 1024, modl, 3 * 1024, H); }
#ifdef PROBE_DUP_RN
        GSYNC();
        { FRESH(); const float* modl = mod + (size_t)l * 9 * 6144;
        phase_rownorm(wid0, P, 0, BIG, modl, 2 * 1024, P.in[I_NMIXPOST] + l * 1024, 1, P.in[I_NMLPPRE] + l * 1024, modl, 3 * 1024, H, 0.0f); }
#endif
        GSYNC();
        {
            FRESH();
            pg8::Gemm g{H, (const bf16*)(ws + WS_W1T) + (size_t)l * 4096 * 1024, MT, 4096, 1024, 1024, 0, 0, 1024, 0};
            EpiBf16<1> E{BIG, 4096, nullptr, nullptr, -1}; pg8::StaticOrder S; S.init(g.M, g.N, G, bid, WGM_MLP1);
            pg8::gemm_phase(wid0, lds, g, S, E); DUPG(pg8::gemm_phase(wid0, lds, g, S, E);)
        }
        GSYNC();
        {
            FRESH();
            pg8::Gemm g{BIG, (const bf16*)(ws + WS_W2T) + (size_t)l * 1024 * 4096, MT, 1024, 4096, 4096, 0, 0, 4096, 0};
            EpiBf16<0> E{MIX, 1024, nullptr, nullptr, -1}; pg8::StaticOrder S; S.init(g.M, g.N, G, bid, WGM_MLP2);
            pg8::gemm_phase(wid0, lds, g, S, E); DUPG(pg8::gemm_phase(wid0, lds, g, S, E);)
        }
        GSYNC();
    }
    { FRESH();
    phase_rownorm(wid0, P, 0, MIX, mod + (size_t)3 * 9 * 6144, 5 * 1024, P.in[I_NMLPPOST] + 3 * 1024, 0, P.in[I_NMIXPRE], mod, 0, H); }
    GSYNC();
    { FRESH(); phase_copy_tail(wid0, P); }
}

extern "C" void kernel_launch(void* const* d_in, const int* in_sizes, int n_in, void* d_out, int out_size, void* d_ws, size_t ws_size, hipStream_t stream) {
    static int grid = 0;
    if (grid == 0) {
        if (n_in != 40 || ws_size < WS_END) { fprintf(stderr, "kernel_launch: expected 40 inputs and >= %zu bytes of workspace (got %d, %zu)\n", (size_t)WS_END, n_in, ws_size); grid = -1; return; }
        int dev = 0, cus = 0, per_cu = 0;
        if (hipGetDevice(&dev) != hipSuccess || hipDeviceGetAttribute(&cus, hipDeviceAttributeMultiprocessorCount, dev) != hipSuccess) { grid = -1; return; }
        if (hipFuncSetAttribute((const void*)fwd_kernel, hipFuncAttributeMaxDynamicSharedMemorySize, LDS_BYTES) != hipSuccess) { fprintf(stderr, "kernel_launch: hipFuncSetAttribute failed\n"); grid = -1; return; }
        if (hipOccupancyMaxActiveBlocksPerMultiprocessor(&per_cu, (const void*)fwd_kernel, NTHR, LDS_BYTES) != hipSuccess || per_cu < 1) per_cu = 1;
        (void)hipGetLastError();
        grid = cus * per_cu; if (grid > 256) grid = 256;
    }
    if (grid < 0) return;
    (void)hipMemsetAsync((char*)d_ws + WS_BAR, 0, 16384, stream);
    Params p{};
    for (int i = 0; i < 40; ++i) p.in[i] = (const float*)d_in[i];
    p.out = (float*)d_out; p.ws = (unsigned char*)d_ws;
    void* args[] = {&p};
    hipError_t e = hipLaunchCooperativeKernel((const void*)fwd_kernel, dim3(grid), dim3(NTHR), args, LDS_BYTES, stream);
    if (e != hipSuccess) fprintf(stderr, "cooperative launch failed: %s (grid %d)\n", hipGetErrorString(e), grid);
}
```
